# Optimizing an MI355X kernel written in HIP

```python
import math
import jax
import jax.numpy as jnp
from jax import lax
import numpy as np

D_MODEL = 1024
BATCH = 8
SEQ = 8192
DEPTH = 2

CHUNK = 64
Q_BLOCK = 128

N_MIXERS = 4
W_GROUP = D_MODEL // N_MIXERS

RWKV_HEAD = 64
RWKV_HEADS = W_GROUP // RWKV_HEAD
RWKV_W_RANK = 32
RWKV_A_RANK = 32
RWKV_G_RANK = 64
RWKV_LN_EPS = 64e-5

S5_GROUP = 16
S5_GROUPS = W_GROUP // S5_GROUP
S5_STATE = 64
S5_DT_MIN = 1e-3
S5_DT_MAX = 1e-1

MLA_HEADS = 4
MLA_NOPE = 64
MLA_ROPE = 32
MLA_QK = MLA_NOPE + MLA_ROPE
MLA_V = W_GROUP // MLA_HEADS
MLA_Q_RANK = 256
MLA_KV_RANK = 128
ROPE_THETA = 10000.0

LRU_BLOCKS = 4
LRU_BLOCK = W_GROUP // LRU_BLOCKS
LRU_C = 8.0
CONV_WIDTH = 4

N_GROUPS = 4
EXPERTS_PER_GROUP = 8
N_EXPERTS = N_GROUPS * EXPERTS_PER_GROUP
TOP_K = 2
D_FF_EXPERT = 512
MOE_BLOCK = 256

NORM_EPS = 1e-6

RWKV_SPLITS = (W_GROUP, W_GROUP, W_GROUP, RWKV_W_RANK, RWKV_A_RANK, RWKV_G_RANK)
RWKV_IN = sum(RWKV_SPLITS)
IN_SPLITS = (RWKV_IN, W_GROUP, MLA_Q_RANK, MLA_KV_RANK, MLA_ROPE, W_GROUP, W_GROUP)
D_IN = sum(IN_SPLITS)

kernel_name = 'hybrid_chunk_causal_streaming_trunk'


def _split(t, sizes):
    idx = [int(i) for i in np.cumsum(sizes)[:-1]]
    return jnp.split(t, idx, axis=-1)


def rms_norm(x, g, eps=NORM_EPS):
    xf = x.astype(jnp.float32)
    y = xf * lax.rsqrt(jnp.mean(xf * xf, axis=-1, keepdims=True) + eps)
    return (y * g.astype(jnp.float32)).astype(x.dtype)


def rope(t, pos):
    half = MLA_ROPE // 2
    inv_freq = jnp.power(ROPE_THETA, -jnp.arange(half, dtype=jnp.float32) * 2.0 / MLA_ROPE)
    ang = pos.astype(jnp.float32)[..., None] * inv_freq
    cos = jnp.cos(ang)[:, :, None, :]
    sin = jnp.sin(ang)[:, :, None, :]
    tf = t.astype(jnp.float32)
    t1, t2 = tf[..., :half], tf[..., half:]
    return jnp.concatenate([t1 * cos - t2 * sin, t1 * sin + t2 * cos], axis=-1).astype(t.dtype)


def rwkv7_mixer(z, mu, w0, w2, a0, a2, g2, k_k, k_a, r_k, ln_w, ln_b):
    Bsz, S, _ = z.shape
    z = z.astype(jnp.float32)
    z_prev = jnp.pad(z, ((0, 0), (1, 0), (0, 0)))[:, :-1]
    z = z + (z_prev - z) * mu
    r, k, v, w_lo, a_lo, g_lo = _split(z, RWKV_SPLITS)
    w = -jax.nn.softplus(-(w0 + jnp.tanh(w_lo) @ w2)) - 0.5
    decay = jnp.exp(-jnp.exp(w))
    a = jax.nn.sigmoid(a0 + a_lo @ a2)
    g = jax.nn.sigmoid(g_lo) @ g2

    def heads(t):
        return t.reshape(Bsz, S, RWKV_HEADS, RWKV_HEAD)

    kk = heads(k * k_k)
    kk = kk / jnp.maximum(jnp.linalg.norm(kk, axis=-1, keepdims=True), 1e-12)
    k = k * (1.0 + (a - 1.0) * k_a)
    r_h, k_h, v_h, w_h, a_h = heads(r), heads(k), heads(v), heads(decay), heads(a)

    def step(state, inp):
        r_t, w_t, k_t, v_t, kk_t, a_t = inp
        sa = jnp.einsum('bhvk,bhk->bhv', state, -kk_t)
        state = (state * w_t[:, :, None, :]
                 + sa[..., None] * (kk_t * a_t)[:, :, None, :]
                 + v_t[..., None] * k_t[:, :, None, :])
        return state, jnp.einsum('bhvk,bhk->bhv', state, r_t)

    def tm(t):
        return jnp.swapaxes(t, 0, 1)

    s0 = jnp.zeros((Bsz, RWKV_HEADS, RWKV_HEAD, RWKV_HEAD), jnp.float32)
    _, y = lax.scan(step, s0, (tm(r_h), tm(w_h), tm(k_h), tm(v_h), tm(kk), tm(a_h)))
    y = tm(y)
    mean = jnp.mean(y, axis=-1, keepdims=True)
    var = jnp.mean(jnp.square(y - mean), axis=-1, keepdims=True)
    y = ((y - mean) * lax.rsqrt(var + RWKV_LN_EPS) * ln_w.reshape(RWKV_HEADS, RWKV_HEAD)
         + ln_b.reshape(RWKV_HEADS, RWKV_HEAD))
    bonus = jnp.sum(r_h * k_h * r_k, axis=-1, keepdims=True) * v_h
    return (y + bonus).reshape(Bsz, S, W_GROUP) * g


def s5_mixer(u, lam_re, lam_im, b_re, b_im, c_re, c_im, d, log_dt, glu_w, glu_b):
    Bsz, S, _ = u.shape
    f32 = jnp.float32
    lam_re, lam_im, b_re, b_im, c_re, c_im = (t.astype(f32) for t in (lam_re, lam_im, b_re, b_im, c_re, c_im))
    uf = u.astype(f32)
    dt = jnp.exp(log_dt.astype(f32))[:, None]
    mag = jnp.exp(lam_re * dt)
    a_re = mag * jnp.cos(lam_im * dt)
    a_im = mag * jnp.sin(lam_im * dt)
    den = lam_re * lam_re + lam_im * lam_im
    q_re = ((a_re - 1.0) * lam_re + a_im * lam_im) / den
    q_im = (a_im * lam_re - (a_re - 1.0) * lam_im) / den
    bb_re = q_re[..., None] * b_re - q_im[..., None] * b_im
    bb_im = q_re[..., None] * b_im + q_im[..., None] * b_re
    ug = uf.reshape(Bsz, S, S5_GROUPS, S5_GROUP)
    bu_re = jnp.einsum('bsgi,gpi->bsgp', ug, bb_re)
    bu_im = jnp.einsum('bsgi,gpi->bsgp', ug, bb_im)
    shape = (1, S, S5_GROUPS, S5_STATE)
    ar = jnp.broadcast_to(a_re, shape)
    ai = jnp.broadcast_to(a_im, shape)

    def combine(e1, e2):
        a1r, a1i, b1r, b1i = e1
        a2r, a2i, b2r, b2i = e2
        return (a2r * a1r - a2i * a1i, a2r * a1i + a2i * a1r,
                a2r * b1r - a2i * b1i + b2r, a2r * b1i + a2i * b1r + b2i)

    _, _, h_re, h_im = lax.associative_scan(combine, (ar, ai, bu_re, bu_im), axis=1)
    y = jnp.einsum('bsgp,gip->bsgi', h_re, c_re) - jnp.einsum('bsgp,gip->bsgi', h_im, c_im)
    y = y.reshape(Bsz, S, W_GROUP) + d * uf
    y = jax.nn.gelu(y)
    return y * jax.nn.sigmoid(y @ glu_w + glu_b)


def mla_mixer(q_a, kv_a, k_pe, pos, q_norm_g, w_uq, kv_norm_g, w_ukv, q_head_g, k_head_g):
    Bsz, S, _ = q_a.shape
    q = (rms_norm(q_a, q_norm_g) @ w_uq).reshape(Bsz, S, MLA_HEADS, MLA_QK)
    kv = (rms_norm(kv_a, kv_norm_g) @ w_ukv).reshape(Bsz, S, MLA_HEADS, MLA_NOPE + MLA_V)
    k_nope, v = kv[..., :MLA_NOPE], kv[..., MLA_NOPE:]
    k = jnp.concatenate([k_nope, jnp.broadcast_to(k_pe[:, :, None, :], (Bsz, S, MLA_HEADS, MLA_ROPE))], axis=-1)
    q = rms_norm(q, q_head_g)
    k = rms_norm(k, k_head_g)
    q = jnp.concatenate([q[..., :MLA_NOPE], rope(q[..., MLA_NOPE:], pos)], axis=-1)
    k = jnp.concatenate([k[..., :MLA_NOPE], rope(k[..., MLA_NOPE:], pos)], axis=-1)
    n_blk = S // Q_BLOCK
    q_blocks = q.reshape(Bsz, n_blk, Q_BLOCK, MLA_HEADS, MLA_QK).transpose(1, 0, 2, 3, 4)
    key_chunk = jnp.arange(S) // CHUNK
    scale = MLA_QK ** -0.5

    def attend(args):
        qb, j = args
        s = jnp.einsum('bqhd,bkhd->bhqk', qb, k).astype(jnp.float32) * scale
        q_chunk = (j * Q_BLOCK + jnp.arange(Q_BLOCK)) // CHUNK
        mask = key_chunk[None, :] <= q_chunk[:, None]
        s = jnp.where(mask, s, -jnp.inf)
        p = jax.nn.softmax(s, axis=-1).astype(v.dtype)
        return jnp.einsum('bhqk,bkhd->bqhd', p, v)

    o = lax.map(attend, (q_blocks, jnp.arange(n_blk)))
    return o.transpose(1, 0, 2, 3, 4).reshape(Bsz, S, MLA_HEADS * MLA_V)


def rglru_mixer(x_in, gate, conv_w, conv_b, w_a, b_a, w_x, b_x, lam):
    Bsz, S, W = x_in.shape
    xc = lax.conv_general_dilated(x_in, conv_w[:, None, :], window_strides=(1,),
                                  padding=[(CONV_WIDTH - 1, 0)],
                                  dimension_numbers=('NWC', 'WIO', 'NWC'),
                                  feature_group_count=W) + conv_b
    xb = xc.reshape(Bsz, S, LRU_BLOCKS, LRU_BLOCK)
    r = jax.nn.sigmoid(jnp.einsum('bsnk,nkj->bsnj', xb, w_a).reshape(Bsz, S, W) + b_a)
    i = jax.nn.sigmoid(jnp.einsum('bsnk,nkj->bsnj', xb, w_x).reshape(Bsz, S, W) + b_x)
    log_a = (-LRU_C * r * jax.nn.softplus(-lam)).astype(jnp.float32)
    a = jnp.exp(log_a)
    b = jnp.sqrt(-jnp.expm1(2.0 * log_a)) * (i * xc).astype(jnp.float32)

    def combine(e1, e2):
        a1, b1 = e1
        a2, b2 = e2
        return (a1 * a2, a2 * b1 + b2)

    _, h = lax.associative_scan(combine, (a, b), axis=1)
    return h.astype(x_in.dtype) * jax.nn.gelu(gate)


def hier_moe(h, w_group, b_group, w_expert, b_expert, w1, w3, w2):
    Bsz, S, D = h.shape
    T = Bsz * S
    xt = h.reshape(T, D)
    p_group = jax.nn.softmax((xt @ w_group + b_group).astype(jnp.float32), axis=-1)
    g_sel = jnp.argmax(p_group, axis=-1).astype(jnp.int32)
    g_prob = jnp.max(p_group, axis=-1)
    logit_e = (xt @ w_expert + b_expert).astype(jnp.float32).reshape(T, N_GROUPS, EXPERTS_PER_GROUP)
    logit_e = jnp.take_along_axis(logit_e, g_sel[:, None, None], axis=1)[:, 0]
    p_e = jax.nn.softmax(logit_e, axis=-1)
    top_p, top_i = lax.top_k(p_e, TOP_K)
    gate = (g_prob[:, None] * top_p / jnp.sum(top_p, axis=-1, keepdims=True)).reshape(-1)
    expert = (g_sel[:, None] * EXPERTS_PER_GROUP + top_i.astype(jnp.int32)).reshape(-1)
    tok = jnp.repeat(jnp.arange(T, dtype=jnp.int32), TOP_K)

    n_assign = T * TOP_K
    n_blocks = -(-n_assign // MOE_BLOCK) + N_EXPERTS
    n_rows = n_blocks * MOE_BLOCK
    order = jnp.argsort(expert)
    e_s, tok_s, w_s = expert[order], tok[order], gate[order]
    counts = jax.ops.segment_sum(jnp.ones_like(e_s), e_s, num_segments=N_EXPERTS)
    start = jnp.cumsum(counts) - counts
    pcounts = (counts + MOE_BLOCK - 1) // MOE_BLOCK * MOE_BLOCK
    pend = jnp.cumsum(pcounts)
    pstart = pend - pcounts
    dest = pstart[e_s] + (jnp.arange(n_assign, dtype=jnp.int32) - start[e_s])
    row_tok = jnp.zeros((n_rows,), jnp.int32).at[dest].set(tok_s)
    row_w = jnp.zeros((n_rows,), w_s.dtype).at[dest].set(w_s)
    blk_start = jnp.arange(n_blocks, dtype=jnp.int32) * MOE_BLOCK
    blk_expert = jnp.minimum(jnp.searchsorted(pend, blk_start, side='right'), N_EXPERTS - 1)

    def expert_block(args):
        toks, e = args
        xb = xt[toks]
        hid = jax.nn.silu(xb @ w1[e]) * (xb @ w3[e])
        return hid @ w2[e]

    yb = lax.map(expert_block, (row_tok.reshape(n_blocks, MOE_BLOCK), blk_expert))
    contrib = yb.reshape(n_rows, D) * row_w[:, None].astype(yb.dtype)
    y = jnp.zeros((T, D), yb.dtype).at[row_tok].add(contrib)
    return y.reshape(Bsz, S, D)


def setup_inputs(seed: int = 0) -> dict:
    key = jax.random.key(seed)
    ks = iter(jax.random.split(key, 64))
    L, D, W = DEPTH, D_MODEL, W_GROUP

    def nrm(shape, scale):
        return jax.random.normal(next(ks), shape, jnp.float32) * scale

    def unif(shape, lo, hi):
        return jax.random.uniform(next(ks), shape, jnp.float32, lo, hi)

    x = nrm((BATCH, SEQ, D), 1.0)
    c = nrm((BATCH, D), 1.0)
    pos_offset = jax.random.randint(next(ks), (BATCH,), 0, 65536, dtype=jnp.int32)
    ada_w = nrm((L, D, 6 * D), 0.3 * D ** -0.5)
    ada_b = nrm((L, 6 * D), 0.02)
    norm1_g = 1.0 + nrm((L, D), 0.02)
    w_in = nrm((L, D, D_IN), D ** -0.5)
    rwkv_mu = unif((L, RWKV_IN), 0.0, 1.0)
    rwkv_w0 = jnp.linspace(-6.0, -1.0, W, dtype=jnp.float32)[None, :] + nrm((L, W), 0.1)
    rwkv_w2 = nrm((L, RWKV_W_RANK, W), 0.1 * RWKV_W_RANK ** -0.5)
    rwkv_a0 = nrm((L, W), 0.1)
    rwkv_a2 = nrm((L, RWKV_A_RANK, W), 0.1 * RWKV_A_RANK ** -0.5)
    rwkv_g2 = nrm((L, RWKV_G_RANK, W), RWKV_G_RANK ** -0.5)
    rwkv_k_k = 0.85 + nrm((L, W), 0.02)
    rwkv_k_a = 1.0 + nrm((L, W), 0.02)
    rwkv_r_k = nrm((L, RWKV_HEADS, RWKV_HEAD), 0.1)
    rwkv_ln_w = 1.0 + nrm((L, W), 0.02)
    rwkv_ln_b = nrm((L, W), 0.02)
    s5_lambda_re = -0.5 + nrm((L, S5_GROUPS, S5_STATE), 0.01)
    s5_lambda_im = (math.pi * jnp.arange(S5_STATE, dtype=jnp.float32))[None, None, :] + nrm((L, S5_GROUPS, S5_STATE), 0.01)
    s5_b_re = nrm((L, S5_GROUPS, S5_STATE, S5_GROUP), (2 * S5_GROUP) ** -0.5)
    s5_b_im = nrm((L, S5_GROUPS, S5_STATE, S5_GROUP), (2 * S5_GROUP) ** -0.5)
    s5_c_re = nrm((L, S5_GROUPS, S5_GROUP, S5_STATE), 0.7)
    s5_c_im = nrm((L, S5_GROUPS, S5_GROUP, S5_STATE), 0.7)
    s5_d = nrm((L, W), 0.5)
    s5_log_dt = unif((L, S5_GROUPS), math.log(S5_DT_MIN), math.log(S5_DT_MAX))
    s5_glu_w = nrm((L, W, W), W ** -0.5)
    s5_glu_b = nrm((L, W), 0.02)
    mla_q_norm_g = 1.0 + nrm((L, MLA_Q_RANK), 0.02)
    mla_w_uq = nrm((L, MLA_Q_RANK, MLA_HEADS * MLA_QK), MLA_Q_RANK ** -0.5)
    mla_kv_norm_g = 1.0 + nrm((L, MLA_KV_RANK), 0.02)
    mla_w_ukv = nrm((L, MLA_KV_RANK, MLA_HEADS * (MLA_NOPE + MLA_V)), MLA_KV_RANK ** -0.5)
    mla_q_head_g = 1.0 + nrm((L, MLA_QK), 0.02)
    mla_k_head_g = 1.0 + nrm((L, MLA_QK), 0.02)
    lru_conv_w = nrm((L, CONV_WIDTH, W), CONV_WIDTH ** -0.5)
    lru_conv_b = nrm((L, W), 0.02)
    lru_w_a = nrm((L, LRU_BLOCKS, LRU_BLOCK, LRU_BLOCK), LRU_BLOCK ** -0.5)
    lru_b_a = nrm((L, W), 0.02)
    lru_w_x = nrm((L, LRU_BLOCKS, LRU_BLOCK, LRU_BLOCK), LRU_BLOCK ** -0.5)
    lru_b_x = nrm((L, W), 0.02)
    a_c = unif((L, W), 0.9, 0.999) ** (1.0 / LRU_C)
    lru_lambda = jnp.log(a_c) - jnp.log1p(-a_c)
    branch_norm_g = 1.0 + nrm((L, 3, W), 0.02)
    w_out = nrm((L, D, D), D ** -0.5)
    norm2_g = 1.0 + nrm((L, D), 0.02)
    moe_w_group = nrm((L, D, N_GROUPS), D ** -0.5)
    moe_b_group = nrm((L, N_GROUPS), 0.01)
    moe_w_expert = nrm((L, D, N_EXPERTS), D ** -0.5)
    moe_b_expert = nrm((L, N_EXPERTS), 0.01)
    moe_w1 = nrm((L, N_EXPERTS, D, D_FF_EXPERT), D ** -0.5)
    moe_w3 = nrm((L, N_EXPERTS, D, D_FF_EXPERT), D ** -0.5)
    moe_w2 = nrm((L, N_EXPERTS, D_FF_EXPERT, D), D_FF_EXPERT ** -0.5)
    return {'x': x, 'c': c, 'pos_offset': pos_offset, 'ada_w': ada_w, 'ada_b': ada_b,
            'norm1_g': norm1_g, 'w_in': w_in, 'rwkv_mu': rwkv_mu, 'rwkv_w0': rwkv_w0,
            'rwkv_w2': rwkv_w2, 'rwkv_a0': rwkv_a0, 'rwkv_a2': rwkv_a2, 'rwkv_g2': rwkv_g2,
            'rwkv_k_k': rwkv_k_k, 'rwkv_k_a': rwkv_k_a, 'rwkv_r_k': rwkv_r_k,
            'rwkv_ln_w': rwkv_ln_w, 'rwkv_ln_b': rwkv_ln_b, 's5_lambda_re': s5_lambda_re,
            's5_lambda_im': s5_lambda_im, 's5_b_re': s5_b_re, 's5_b_im': s5_b_im,
            's5_c_re': s5_c_re, 's5_c_im': s5_c_im, 's5_d': s5_d, 's5_log_dt': s5_log_dt,
            's5_glu_w': s5_glu_w, 's5_glu_b': s5_glu_b, 'mla_q_norm_g': mla_q_norm_g,
            'mla_w_uq': mla_w_uq, 'mla_kv_norm_g': mla_kv_norm_g, 'mla_w_ukv': mla_w_ukv,
            'mla_q_head_g': mla_q_head_g, 'mla_k_head_g': mla_k_head_g,
            'lru_conv_w': lru_conv_w, 'lru_conv_b': lru_conv_b, 'lru_w_a': lru_w_a,
            'lru_b_a': lru_b_a, 'lru_w_x': lru_w_x, 'lru_b_x': lru_b_x, 'lru_lambda': lru_lambda,
            'branch_norm_g': branch_norm_g, 'w_out': w_out, 'norm2_g': norm2_g,
            'moe_w_group': moe_w_group, 'moe_b_group': moe_b_group,
            'moe_w_expert': moe_w_expert, 'moe_b_expert': moe_b_expert,
            'moe_w1': moe_w1, 'moe_w3': moe_w3, 'moe_w2': moe_w2}


def reference(x, c, pos_offset, ada_w, ada_b, norm1_g, w_in, rwkv_mu, rwkv_w0, rwkv_w2,
              rwkv_a0, rwkv_a2, rwkv_g2, rwkv_k_k, rwkv_k_a, rwkv_r_k, rwkv_ln_w, rwkv_ln_b,
              s5_lambda_re, s5_lambda_im, s5_b_re, s5_b_im, s5_c_re, s5_c_im, s5_d, s5_log_dt,
              s5_glu_w, s5_glu_b, mla_q_norm_g, mla_w_uq, mla_kv_norm_g, mla_w_ukv,
              mla_q_head_g, mla_k_head_g, lru_conv_w, lru_conv_b, lru_w_a, lru_b_a, lru_w_x,
              lru_b_x, lru_lambda, branch_norm_g, w_out, norm2_g, moe_w_group, moe_b_group,
              moe_w_expert, moe_b_expert, moe_w1, moe_w3, moe_w2):
    Bsz, S, _ = x.shape
    pos = pos_offset[:, None] + jnp.arange(S, dtype=jnp.int32)[None, :]
    cond = jax.nn.silu(c)
    for l in range(DEPTH):
        mod = cond @ ada_w[l] + ada_b[l]
        sh1, sc1, gt1, sh2, sc2, gt2 = [m[:, None, :] for m in jnp.split(mod, 6, axis=-1)]
        h = rms_norm(x, norm1_g[l]) * (1.0 + sc1) + sh1
        z = h @ w_in[l]
        z_rwkv, z_s5, q_a, kv_a, k_pe, z_lru, z_gate = _split(z, IN_SPLITS)
        y_a = rwkv7_mixer(z_rwkv, rwkv_mu[l], rwkv_w0[l], rwkv_w2[l], rwkv_a0[l], rwkv_a2[l],
                          rwkv_g2[l], rwkv_k_k[l], rwkv_k_a[l], rwkv_r_k[l], rwkv_ln_w[l], rwkv_ln_b[l])
        y_b = s5_mixer(z_s5, s5_lambda_re[l], s5_lambda_im[l], s5_b_re[l], s5_b_im[l], s5_c_re[l],
                       s5_c_im[l], s5_d[l], s5_log_dt[l], s5_glu_w[l], s5_glu_b[l])
        y_c = mla_mixer(q_a, kv_a, k_pe, pos, mla_q_norm_g[l], mla_w_uq[l], mla_kv_norm_g[l],
                        mla_w_ukv[l], mla_q_head_g[l], mla_k_head_g[l])
        y_d = rglru_mixer(z_lru, z_gate, lru_conv_w[l], lru_conv_b[l], lru_w_a[l], lru_b_a[l],
                          lru_w_x[l], lru_b_x[l], lru_lambda[l])
        mix = jnp.concatenate([y_a.astype(h.dtype),
                               rms_norm(y_b.astype(h.dtype), branch_norm_g[l, 0]),
                               rms_norm(y_c.astype(h.dtype), branch_norm_g[l, 1]),
                               rms_norm(y_d.astype(h.dtype), branch_norm_g[l, 2])], axis=-1)
        x = x + gt1 * (mix @ w_out[l])
        h2 = rms_norm(x, norm2_g[l]) * (1.0 + sc2) + sh2
        x = x + gt2 * hier_moe(h2, moe_w_group[l], moe_b_group[l], moe_w_expert[l],
                               moe_b_expert[l], moe_w1[l], moe_w3[l], moe_w2[l])
    return x
```

```cpp
#include <hip/hip_runtime.h>
#include <cstdio>
#include <cstdint>

#define LAS __attribute__((address_space(3)))
#define GAS __attribute__((address_space(1)))
#define DI __device__ __forceinline__
typedef unsigned short bf16_t;
typedef short bf16x8 __attribute__((ext_vector_type(8)));
typedef short s16x4 __attribute__((ext_vector_type(4)));
typedef float f32x4 __attribute__((ext_vector_type(4)));
typedef float f32x2 __attribute__((ext_vector_type(2)));
typedef float f32x16 __attribute__((ext_vector_type(16)));
typedef unsigned u32x4 __attribute__((ext_vector_type(4)));
typedef unsigned u32x2 __attribute__((ext_vector_type(2)));
typedef __bf16 bf16x2_t __attribute__((ext_vector_type(2)));

constexpr int NB = 8, SEQ = 8192, DM = 1024, T = NB * SEQ, DEPTH = 2;
constexpr int WG = 256;
constexpr int ZS = 2304;
constexpr int ZC_R = 0, ZC_K = 256, ZC_V = 512, ZC_WLO = 768, ZC_ALO = 800, ZC_GLO = 832, ZC_S5 = 896, ZC_QA = 1152, ZC_KVA = 1408, ZC_KPE = 1536, ZC_LX = 1568, ZC_LG = 1824, D_IN = 2080;
constexpr int NEXP = 32, DFF = 512;
constexpr float NORM_EPS = 1e-6f;

DI unsigned f2bf(float f) { unsigned u = __float_as_uint(f); return (u + 0x7fffu + ((u >> 16) & 1u)) >> 16; }
DI unsigned pk2(float lo, float hi) { f32x2 v = {lo, hi}; bf16x2_t b = __builtin_convertvector(v, bf16x2_t); return __builtin_bit_cast(unsigned, b); }
DI float bflo(unsigned u) { return __uint_as_float(u << 16); }
DI float bfhi(unsigned u) { return __uint_as_float(u & 0xffff0000u); }
DI float bf2f(bf16_t b) { return __uint_as_float(((unsigned)b) << 16); }
DI int lane_opaque() { int l = __builtin_amdgcn_mbcnt_hi(-1, __builtin_amdgcn_mbcnt_lo(-1, 0)); asm volatile("" : "+v"(l)); return l; }
DI float shfl_xor_l(float v, int o, int lane) { return __int_as_float(__builtin_amdgcn_ds_bpermute((lane ^ o) << 2, __float_as_int(v))); }
DI float wave_sum(float v) {
    const int l = lane_opaque();
#pragma unroll
    for (int o = 1; o < 64; o <<= 1) v += shfl_xor_l(v, o, l);
    return v;
}
DI float sigmoidf_(float x) { return 1.f / (1.f + __expf(-x)); }
DI float softplusf_(float x) { return fmaxf(x, 0.f) + log1pf(__expf(-fabsf(x))); }
DI float gelu_tanh(float x) { const float u = 0.7978845608028654f * (x + 0.044715f * x * x * x); return 0.5f * x * (1.f + tanhf(u)); }
DI float siluf_(float x) { return x / (1.f + __expf(-x)); }

namespace pg8 {
constexpr int BM = 256, BK = 64, HALF = 128, HTB = HALF * BK * 2, STAGE_BYTES = 8 * HTB;
DI int lds_byte(int r, int c) { const int st = (r >> 4) * 2 + (c >> 5), rr = r & 15, cc = c & 31, ob = rr * 64 + cc * 2; return st * 1024 + (ob ^ (((ob >> 9) & 1) << 5)); }
DI void stage_rc(int b, int& R, int& C) { const int st = b / 1024, sb = b % 1024, swz = sb ^ (((sb >> 9) & 1) << 5); R = (st >> 1) * 16 + swz / 64; C = (st & 1) * 32 + (swz % 64) / 2; }
DI int perm32(int rho) { const int n = rho >> 4, i = rho & 15; return 8 * (i >> 2) + 4 * n + (i & 3); }

struct Unit { int pm, pn, e, blk; };

template <class Epi, class P>
DI void gemm_phase(LAS unsigned char* lds, const P& S, const Epi& E, int tid_in) {
    const int tid = tid_in, wid = __builtin_amdgcn_readfirstlane(tid >> 6), lane = tid & 63, wr = wid >> 2, wc = wid & 3, fr = lane & 15, fq = lane >> 4;
    const int nt = S.nt;
    int Rr[2], Cc[2];
    unsigned voffB[2], offC[2][2], offN[2][2];
#pragma unroll
    for (int i = 0; i < 2; ++i) { int R, C; stage_rc(tid * 16 + i * 8192, R, C); Rr[i] = R; Cc[i] = C; const int Rb = Epi::PERM ? ((R & ~31) + perm32(R & 31)) : R;
        voffB[i] = (unsigned)(Rb * S.ldb + C) * 2u; }
    const size_t kstep = (size_t)(BK * 2);
    const size_t hstepB = (size_t)HALF * S.ldb * 2;
    const unsigned ldsw = (unsigned)wid * 1024u;
    const int aoff = lds_byte(wr * 64 + fr, fq * 8), boff = lds_byte(wc * 32 + fr, fq * 8);
#define PG8_SA(b, h) (((b) * 2 + (h)) * HTB)
#define PG8_SB(b, h) ((4 + (b) * 2 + (h)) * HTB)
#define PG8_STAGE(bufoff, gbase, voff) do { _Pragma("unroll") for (int _i = 0; _i < 2; ++_i) \
        __builtin_amdgcn_global_load_lds((const unsigned*)((const char*)(gbase) + (voff)[_i]), (LAS unsigned*)(lds + (bufoff) + ldsw + _i * 8192), 16, 0, 0); } while (0)
#define PG8_LDA(dst, b, h) do { _Pragma("unroll") for (int m = 0; m < 4; ++m) _Pragma("unroll") for (int k = 0; k < 2; ++k) dst[m][k] = *(const LAS bf16x8*)(lds + PG8_SA(b, h) + aoff + m * 2048 + k * 1024); } while (0)
#define PG8_LDB(dst, b, h) do { _Pragma("unroll") for (int n = 0; n < 2; ++n) _Pragma("unroll") for (int k = 0; k < 2; ++k) dst[n][k] = *(const LAS bf16x8*)(lds + PG8_SB(b, h) + boff + n * 2048 + k * 1024); } while (0)
#define PG8_MMA(ai, bj, At, Bt) do { __builtin_amdgcn_s_setprio(1); _Pragma("unroll") for (int m = 0; m < 4; ++m) _Pragma("unroll") for (int n = 0; n < 2; ++n) _Pragma("unroll") for (int k = 0; k < 2; ++k) \
        acc[ai][bj][m][n] = __builtin_amdgcn_mfma_f32_16x16x32_bf16(Bt[n][k], At[m][k], acc[ai][bj][m][n], 0, 0, 0); __builtin_amdgcn_s_setprio(0); } while (0)
#define PG8_WAIT_V(n) asm volatile("s_waitcnt vmcnt(" #n ")" ::: "memory")
#define PG8_WAIT_L(n) asm volatile("s_waitcnt lgkmcnt(" #n ")" ::: "memory")
#define PG8_BAR __builtin_amdgcn_s_barrier()
#define PG8_SCHED __builtin_amdgcn_sched_barrier(0)
    Unit cur, nxt; int ui = 0;
    if (!S.next(0, cur)) return;
    f32x4 acc[2][2][4][2];
#pragma unroll
    for (int a = 0; a < 2; ++a)
#pragma unroll
        for (int b = 0; b < 2; ++b)
#pragma unroll
            for (int m = 0; m < 4; ++m)
#pragma unroll
                for (int n = 0; n < 2; ++n) acc[a][b][m][n] = (f32x4){0.f, 0.f, 0.f, 0.f};
    bf16x8 At[4][2], B0[2][2], B1[2][2];
    const char* cA = S.a_base(cur); const char* cB = S.b_base(cur);
#pragma unroll
    for (int h = 0; h < 2; ++h)
#pragma unroll
        for (int i = 0; i < 2; ++i) { offC[h][i] = S.a_off(cur, h * HALF + Rr[i]) + (unsigned)Cc[i] * 2u; offN[h][i] = offC[h][i]; }
    PG8_STAGE(PG8_SB(0, 0), cB, voffB); PG8_STAGE(PG8_SB(0, 1), cB + hstepB, voffB); PG8_STAGE(PG8_SA(0, 0), cA, offC[0]); PG8_STAGE(PG8_SA(0, 1), cA, offC[1]);
    if (wr == 1) PG8_BAR;
    PG8_WAIT_V(2); PG8_BAR;
    PG8_STAGE(PG8_SB(1, 0), cB + kstep, voffB); PG8_STAGE(PG8_SA(1, 0), cA + kstep, offC[0]); PG8_STAGE(PG8_SB(1, 1), cB + hstepB + kstep, voffB);
    PG8_WAIT_V(6); PG8_BAR;
    for (;;) {
        const bool has_next = S.next(ui + 1, nxt);
        const char* nA = has_next ? S.a_base(nxt) : cA; const char* nB = has_next ? S.b_base(nxt) : cB;
        for (int t = 0; t < nt; t += 2) {
            const bool last = (t == nt - 2);
            const char* a1 = cA + (size_t)(t + 1) * kstep;
            const char* a2 = last ? nA : cA + (size_t)(t + 2) * kstep; const char* b2 = last ? nB : cB + (size_t)(t + 2) * kstep;
            const char* a3 = a2 + kstep; const char* b3 = b2 + kstep;
            if (last && has_next) {
#pragma unroll
                for (int h = 0; h < 2; ++h)
#pragma unroll
                    for (int i = 0; i < 2; ++i) offN[h][i] = S.a_off(nxt, h * HALF + Rr[i]) + (unsigned)Cc[i] * 2u;
            }
            unsigned o2[2][2];
#pragma unroll
            for (int h = 0; h < 2; ++h)
#pragma unroll
                for (int i = 0; i < 2; ++i) o2[h][i] = last ? offN[h][i] : offC[h][i];
            PG8_LDB(B0, 0, 0); PG8_LDB(B1, 0, 1); PG8_SCHED; PG8_LDA(At, 0, 0); PG8_STAGE(PG8_SA(1, 1), a1, offC[1]);
            PG8_WAIT_V(8); PG8_WAIT_L(0); PG8_BAR; PG8_MMA(0, 0, At, B0); PG8_MMA(0, 1, At, B1); PG8_BAR; PG8_SCHED;
            PG8_LDA(At, 0, 1); PG8_STAGE(PG8_SB(0, 0), b2, voffB); PG8_STAGE(PG8_SB(0, 1), b2 + hstepB, voffB); PG8_STAGE(PG8_SA(0, 0), a2, o2[0]);
            PG8_WAIT_V(8); PG8_WAIT_L(0); PG8_BAR; PG8_MMA(1, 0, At, B0); PG8_MMA(1, 1, At, B1); PG8_BAR; PG8_SCHED;
            PG8_LDB(B0, 1, 0); PG8_LDB(B1, 1, 1); PG8_SCHED; PG8_LDA(At, 1, 0); PG8_STAGE(PG8_SA(0, 1), a2, o2[1]);
            PG8_WAIT_V(8); PG8_WAIT_L(0); PG8_BAR; PG8_MMA(0, 0, At, B0); PG8_MMA(0, 1, At, B1); PG8_BAR; PG8_SCHED;
            PG8_LDA(At, 1, 1); PG8_STAGE(PG8_SB(1, 0), b3, voffB); PG8_STAGE(PG8_SB(1, 1), b3 + hstepB, voffB); PG8_STAGE(PG8_SA(1, 0), a3, o2[0]);
            PG8_WAIT_V(8); PG8_WAIT_L(0); PG8_BAR; PG8_MMA(1, 0, At, B0); PG8_MMA(1, 1, At, B1); PG8_BAR; PG8_SCHED;
        }
        if (wr == 0) PG8_BAR;
        E(acc, cur, wr, wc, fr, fq);
        if (!has_next) break;
#pragma unroll
        for (int a = 0; a < 2; ++a)
#pragma unroll
            for (int b = 0; b < 2; ++b)
#pragma unroll
                for (int m = 0; m < 4; ++m)
#pragma unroll
                    for (int n = 0; n < 2; ++n) acc[a][b][m][n] = (f32x4){0.f, 0.f, 0.f, 0.f};
        cur = nxt; cA = nA; cB = nB; ++ui;
#pragma unroll
        for (int h = 0; h < 2; ++h)
#pragma unroll
            for (int i = 0; i < 2; ++i) offC[h][i] = offN[h][i];
        if (wr == 1) PG8_BAR;
    }
    PG8_WAIT_V(0);
    PG8_BAR;
#undef PG8_SA
#undef PG8_SB
#undef PG8_STAGE
#undef PG8_LDA
#undef PG8_LDB
#undef PG8_MMA
#undef PG8_WAIT_V
#undef PG8_WAIT_L
#undef PG8_BAR
#undef PG8_SCHED
}

struct PlainProb {
    const char* A; const char* Bt; int lda, ldb, nt, nM, nN, G, c;
    DI bool next(int i, Unit& u) const {
        const long L = (long)i * G + c; const int nwg = nM * nN; if (L >= nwg) return false;
        int wgid = (int)L; { const int q = nwg / 8, r = nwg % 8, xcd = wgid % 8, off = wgid / 8; wgid = (xcd < r ? xcd * (q + 1) : r * (q + 1) + (xcd - r) * q) + off; }
        const int nig = 8 * nN, gid = wgid / nig, fm = gid * 8, gsz = (nM - fm) < 8 ? (nM - fm) : 8;
        u.pm = fm + ((wgid % nig) % gsz); u.pn = (wgid % nig) / gsz; u.e = 0; u.blk = 0; return true;
    }
    DI const char* a_base(const Unit& u) const { return A + (size_t)u.pm * 256 * lda * 2; }
    DI const char* b_base(const Unit& u) const { return Bt + (size_t)u.pn * 256 * ldb * 2; }
    DI unsigned a_off(const Unit&, int row) const { return (unsigned)row * (unsigned)lda * 2u; }
};
}

constexpr size_t MiB = 1u << 20;
constexpr size_t WS_CTL = 0, CTL_ZERO_BYTES = 1 * MiB;
constexpr size_t WS_MOD = 1 * MiB;
constexpr size_t WS_RT_EID = 3 * MiB;
constexpr size_t WS_RT_GATE = WS_RT_EID + 512 * 1024;
constexpr size_t WS_RT_PIE = WS_RT_GATE + 512 * 1024;
constexpr size_t WS_RT_SORT = WS_RT_PIE + 512 * 1024;
constexpr size_t WS_WIN = 8 * MiB;
constexpr size_t WS_WOUT = 17 * MiB;
constexpr size_t WS_WMLA = 21 * MiB;
constexpr size_t WS_WGLU = 23 * MiB;
constexpr size_t WS_H = 24 * MiB;
constexpr size_t WS_Z = 152 * MiB;
constexpr size_t WS_WM1 = WS_Z;
constexpr size_t WS_WM2 = WS_Z + 64 * MiB;
constexpr size_t WS_MIX = 440 * MiB;
constexpr size_t WS_HID = WS_MIX;
constexpr size_t WS_Y = 569 * MiB;
constexpr size_t WS_Q = 825 * MiB;
constexpr size_t WS_K = 873 * MiB;
constexpr size_t WS_VT = 921 * MiB;
constexpr size_t WS_TAIL = 953 * MiB;
constexpr size_t WS_END = 1017 * MiB;
constexpr size_t WS_AMLA = WS_TAIL;
constexpr size_t WS_QKVRAW = WS_Y;
constexpr size_t WS_ATTO = WS_H;
constexpr size_t WS_RW_R = WS_Y, WS_RW_K = WS_Y + 32 * MiB, WS_RW_V = WS_Y + 64 * MiB, WS_RW_KK = WS_Y + 96 * MiB, WS_RW_B = WS_Y + 128 * MiB, WS_RW_G = WS_Y + 160 * MiB;
constexpr size_t WS_RW_W = WS_Y + 192 * MiB;
constexpr size_t WS_RW_Y = WS_H + 32 * MiB;
constexpr size_t WS_YS5 = WS_H + 96 * MiB;
constexpr size_t WS_YS5G = WS_TAIL;
constexpr size_t WS_YL = WS_TAIL + 32 * MiB;
constexpr size_t WS_LA = WS_Y, WS_LB = WS_Y + 64 * MiB;
constexpr size_t WS_S5END = 2 * MiB;
constexpr size_t WS_LSUM = 5 * MiB + 512 * 1024;
static_assert(WS_RT_SORT + 512 * 1024 <= WS_LSUM && WS_LSUM + 2 * MiB <= WS_WIN && WS_S5END + 1 * MiB <= WS_RT_EID, "map");

constexpr int CW_BAR = 4096;
constexpr int CW_CNT = 16384;
constexpr int CW_UTAB = 20480;

constexpr int NWAVES = 8, NTHR = 512;
constexpr int LDS_BYTES = 155648;
constexpr int MISC_OFF = 155648 - 256;

struct Args { const float* in[51]; const int* pos_off; float* out; unsigned char* ws; int ph_lo, ph_hi, use_bar, pad; };
typedef const __attribute__((address_space(4))) Args CArgs;
DI CArgs* get_args() { CArgs* ap = (CArgs*)__builtin_amdgcn_kernarg_segment_ptr(); asm volatile("" : "+s"(ap)); return ap; }

#define XB_TMO      128
#define XB_XCNT(j)  (256  + 64 * (j))
#define XB_XSUB(j)  (1280 + 64 * (j))
#define XB_XGEN(j)  (2304 + 64 * (j))
#define XB_TOP      3328
#define XB_TOPGEN   3392
#define XCD_BAR_WORDS 3456
#define XB_SPIN_CAP (1u << 18)
DI unsigned xb_ld(unsigned* p)              { return __hip_atomic_load(p, __ATOMIC_RELAXED, __HIP_MEMORY_SCOPE_AGENT); }
DI unsigned xb_add(unsigned* p, unsigned v) { return __hip_atomic_fetch_add(p, v, __ATOMIC_RELAXED, __HIP_MEMORY_SCOPE_AGENT); }
DI unsigned xb_xcc_id() { return (unsigned)__builtin_amdgcn_s_getreg((3 << 11) | 20) & 0xFu; }
#define XB_SPIN(cond, bar) do { unsigned _sp = 0; while (cond) { __builtin_amdgcn_s_sleep(1); \
    if ((++_sp & 255u) == 0u) { if (xb_ld(&(bar)[XB_TMO])) break; if (_sp > XB_SPIN_CAP) { atomicAdd(&(bar)[XB_TMO], 1u); break; } } } } while (0)
struct XcdBarrier { unsigned* bar; unsigned x; volatile LAS unsigned* st; };
DI XcdBarrier xcd_barrier_post(unsigned* bar, volatile LAS unsigned* st) {
    XcdBarrier b; b.bar = bar; b.x = xb_xcc_id(); b.st = st;
    if (threadIdx.x == 0) (void)xb_add(&bar[XB_XCNT(b.x)], 1u);
    return b;
}
DI void xcd_barrier_complete(unsigned* bar, unsigned x, unsigned& nloc, unsigned& nx) {
    const unsigned G = gridDim.x * gridDim.y * gridDim.z;
    unsigned sum, cnt, mine, sp = 0u;
    for (;;) {
        sum = 0u; cnt = 0u; mine = 0u;
#pragma unroll
        for (unsigned j = 0; j < 16; ++j) { const unsigned c = xb_ld(&bar[XB_XCNT(j)]); sum += c; cnt += (c > 0u) ? 1u : 0u; mine = (j == x) ? c : mine; }
        if (sum == G) break;
        __builtin_amdgcn_s_sleep(1);
        if ((++sp & 255u) == 0u) { if (xb_ld(&bar[XB_TMO])) break; if (sp > XB_SPIN_CAP) { atomicAdd(&bar[XB_TMO], 1u); break; } }
    }
    nloc = mine > 0u ? mine : 1u; nx = cnt > 0u ? cnt : 1u;
}
DI void xcd_barrier(const XcdBarrier& b) {
    asm volatile("s_waitcnt vmcnt(0)" ::: "memory");
    __syncthreads();
    if (threadIdx.x == 0) {
        unsigned* bar = b.bar;
        __builtin_amdgcn_s_waitcnt(0);
        unsigned nloc = b.st[0], nx = b.st[1];
        if (nloc == 0u) { xcd_barrier_complete(bar, b.x, nloc, nx); b.st[0] = nloc; b.st[1] = nx; }
        const unsigned old = xb_add(&bar[XB_XSUB(b.x)], 1u);
        const unsigned gen = old / nloc;
        if (old + 1u == (gen + 1u) * nloc) {
            __builtin_amdgcn_fence(__ATOMIC_RELEASE, "agent");
            asm volatile("s_waitcnt vmcnt(0)" ::: "memory");
            const unsigned og = xb_add(&bar[XB_TOP], 1u);
            const unsigned tg = og / nx;
            if (og + 1u == (tg + 1u) * nx) xb_add(&bar[XB_TOPGEN], 1u);
            else XB_SPIN(xb_ld(&bar[XB_TOPGEN]) == tg, bar);
            __builtin_amdgcn_fence(__ATOMIC_ACQUIRE, "agent");
            xb_add(&bar[XB_XGEN(b.x)], 1u);
            asm volatile("s_waitcnt vmcnt(0)" ::: "memory");
        } else {
            XB_SPIN(xb_ld(&bar[XB_XGEN(b.x)]) == gen, bar);
            __builtin_amdgcn_fence(__ATOMIC_ACQUIRE, "agent");
            asm volatile("s_waitcnt vmcnt(0)" ::: "memory");
        }
    }
    __syncthreads();
}

struct EpiBf16Plain {
    static constexpr bool PERM = true;
    bf16_t* O; int ldc;
    DI void operator()(const f32x4 (&acc)[2][2][4][2], const pg8::Unit& u, int wr, int wc, int fr, int fq) const {
        const int row0 = u.pm * 256 + wr * 64 + fr, col0 = u.pn * 256 + wc * 32 + 8 * fq;
#pragma unroll
        for (int ai = 0; ai < 2; ++ai)
#pragma unroll
            for (int m = 0; m < 4; ++m) { bf16_t* rowp = O + (size_t)(row0 + ai * 128 + m * 16) * ldc + col0;
#pragma unroll
                for (int bj = 0; bj < 2; ++bj) { const f32x4 v0 = acc[ai][bj][m][0], v1 = acc[ai][bj][m][1];
                    u32x4 w; w.x = pk2(v0[0], v0[1]); w.y = pk2(v0[2], v0[3]); w.z = pk2(v1[0], v1[1]); w.w = pk2(v1[2], v1[3]);
                    *(u32x4*)(rowp + bj * 128) = w; } }
    }
};
struct EpiResGate {
    static constexpr bool PERM = false;
    const float* xin; float* out; const float* gt;
    DI void operator()(const f32x4 (&acc)[2][2][4][2], const pg8::Unit& u, int wr, int wc, int fr, int fq) const {
        const int row0 = u.pm * 256 + wr * 64 + fr, col0 = u.pn * 256 + wc * 32 + 4 * fq;
        const int b = (u.pm * 256) / SEQ;
        f32x4 g[2][2];
#pragma unroll
        for (int bj = 0; bj < 2; ++bj)
#pragma unroll
            for (int n = 0; n < 2; ++n) g[bj][n] = *(const f32x4*)(gt + (size_t)b * 6144 + col0 + bj * 128 + n * 16);
#pragma unroll
        for (int ai = 0; ai < 2; ++ai)
#pragma unroll
            for (int m = 0; m < 4; ++m) { const size_t ro = (size_t)(row0 + ai * 128 + m * 16) * DM + col0;
#pragma unroll
                for (int bj = 0; bj < 2; ++bj)
#pragma unroll
                    for (int n = 0; n < 2; ++n) { const f32x4 xv = *(const f32x4*)(xin + ro + bj * 128 + n * 16);
                        *(f32x4*)(out + ro + bj * 128 + n * 16) = xv + g[bj][n] * acc[ai][bj][m][n]; } }
    }
};
struct EpiGlu {
    static constexpr bool PERM = true;
    const bf16_t* Y; bf16_t* O; const float* bias;
    DI void operator()(const f32x4 (&acc)[2][2][4][2], const pg8::Unit& u, int wr, int wc, int fr, int fq) const {
        const int row0 = u.pm * 256 + wr * 64 + fr, col0 = wc * 32 + 8 * fq;
#pragma unroll
        for (int ai = 0; ai < 2; ++ai)
#pragma unroll
            for (int m = 0; m < 4; ++m) { const size_t ro = (size_t)(row0 + ai * 128 + m * 16) * 256 + col0;
#pragma unroll
                for (int bj = 0; bj < 2; ++bj) { const u32x4 yv = *(const u32x4*)(Y + ro + bj * 128);
                    const f32x4 b0 = *(const f32x4*)(bias + col0 + bj * 128), b1 = *(const f32x4*)(bias + col0 + bj * 128 + 4);
                    const f32x4 v0 = acc[ai][bj][m][0] + b0, v1 = acc[ai][bj][m][1] + b1;
                    u32x4 w;
                    w.x = pk2(bflo(yv.x) * sigmoidf_(v0[0]), bfhi(yv.x) * sigmoidf_(v0[1]));
                    w.y = pk2(bflo(yv.y) * sigmoidf_(v0[2]), bfhi(yv.y) * sigmoidf_(v0[3]));
                    w.z = pk2(bflo(yv.z) * sigmoidf_(v1[0]), bfhi(yv.z) * sigmoidf_(v1[1]));
                    w.w = pk2(bflo(yv.w) * sigmoidf_(v1[2]), bfhi(yv.w) * sigmoidf_(v1[3]));
                    *(u32x4*)(O + ro + bj * 128) = w; } }
    }
};

struct Frame { LAS unsigned char* lds; int tid, lane, wave, G, bid, gw, ngw; };

DI Frame make_frame(LAS unsigned char* lds, int wave0) {
    Frame F; F.lds = lds; int w = wave0; asm volatile("" : "+s"(w)); F.wave = w; F.lane = lane_opaque(); F.tid = w * 64 + F.lane;
    F.G = gridDim.x; F.bid = blockIdx.x; F.gw = F.bid * NWAVES + F.wave; F.ngw = F.G * NWAVES; return F;
}
DI void transpose_item(const float* src, int ld_src, int k0, int n0, bf16_t* dst, int ldd, int nd0, int kd0, LAS float* scr, int lane) {
#pragma unroll 8
    for (int i = 0; i < 32; ++i) { const int kk = 2 * i + (lane >> 5); scr[kk * 33 + (lane & 31)] = src[(size_t)(k0 + kk) * ld_src + n0 + (lane & 31)]; }
    asm volatile("s_waitcnt lgkmcnt(0)" ::: "memory");
    const int c = lane & 7;
#pragma unroll
    for (int j = 0; j < 4; ++j) { const int n = (lane >> 3) + 8 * j; const LAS float* s = scr + (8 * c) * 33 + n;
        u32x4 o; o.x = pk2(s[0 * 33], s[1 * 33]); o.y = pk2(s[2 * 33], s[3 * 33]); o.z = pk2(s[4 * 33], s[5 * 33]); o.w = pk2(s[6 * 33], s[7 * 33]);
        *(u32x4*)(dst + (size_t)(nd0 + n) * ldd + kd0 + 8 * c) = o; }
    asm volatile("s_waitcnt lgkmcnt(0)" ::: "memory");
}
DI void zero_rows(bf16_t* dst, int ld, int r0, int nr, int c0, int nc, int gw, int ngw, int lane) {
    for (int r = gw; r < nr; r += ngw) for (int c = lane * 8; c < nc; c += 512) *(u32x4*)(dst + (size_t)(r0 + r) * ld + c0 + c) = (u32x4){0u, 0u, 0u, 0u};
}

DI void phase_prologue(const Frame& F, CArgs& A) {
    unsigned char* ws = A.ws;
    LAS float* sc = (LAS float*)F.lds;
    LAS float* part = (LAS float*)(F.lds + 32768);
    for (int i = F.tid; i < 8192; i += NTHR) sc[i] = siluf_(A.in[1][i]);
    __syncthreads();
    float* MOD = (float*)(ws + WS_MOD);
    for (int item = F.bid; item < 192; item += F.G) {
        const int l = item / 96, n0 = (item % 96) * 64, nl = F.tid & 63, kg = F.tid >> 6;
        const float* W = A.in[3] + (size_t)l * 1024 * 6144 + n0 + nl;
        float acc[8];
#pragma unroll
        for (int b = 0; b < 8; ++b) acc[b] = 0.f;
        for (int k = kg * 128; k < kg * 128 + 128; ++k) { const float w = W[(size_t)k * 6144];
#pragma unroll
            for (int b = 0; b < 8; ++b) acc[b] += sc[b * 1024 + k] * w; }
#pragma unroll
        for (int b = 0; b < 8; ++b) part[(kg * 8 + b) * 64 + nl] = acc[b];
        __syncthreads();
        { const int b = F.tid >> 6; float s = A.in[4][l * 6144 + n0 + nl];
#pragma unroll
          for (int g = 0; g < 8; ++g) s += part[(g * 8 + b) * 64 + nl];
          MOD[((size_t)l * 8 + b) * 6144 + n0 + nl] = s; }
        __syncthreads();
    }
    LAS float* scr = (LAS float*)(F.lds + F.wave * 8448);
    bf16_t* WIN = (bf16_t*)(ws + WS_WIN); bf16_t* WOUT = (bf16_t*)(ws + WS_WOUT); bf16_t* WMLA = (bf16_t*)(ws + WS_WMLA); bf16_t* WGLU = (bf16_t*)(ws + WS_WGLU);
    constexpr int I_IN = 16 * 65, I_OUT = 16 * 32, I_Q = 4 * 12, I_KV = 2 * 16, I_GLU = 4 * 8, I_L = I_IN + I_OUT + I_Q + I_KV + I_GLU;
    for (int it = F.gw; it < 2 * I_L; it += F.ngw) {
        const int l = it / I_L; int r = it % I_L;
        if (r < I_IN) { transpose_item(A.in[6] + (size_t)l * 1024 * D_IN, D_IN, 64 * (r / 65), 32 * (r % 65), WIN + (size_t)l * ZS * 1024, 1024, 32 * (r % 65), 64 * (r / 65), scr, F.lane); continue; } r -= I_IN;
        if (r < I_OUT) { transpose_item(A.in[42] + (size_t)l * 1024 * 1024, 1024, 64 * (r / 32), 32 * (r % 32), WOUT + (size_t)l * 1024 * 1024, 1024, 32 * (r % 32), 64 * (r / 32), scr, F.lane); continue; } r -= I_OUT;
        if (r < I_Q) { transpose_item(A.in[29] + (size_t)l * 256 * 384, 384, 64 * (r / 12), 32 * (r % 12), WMLA + (size_t)l * 1024 * 512, 512, 32 * (r % 12), 64 * (r / 12), scr, F.lane); continue; } r -= I_Q;
        if (r < I_KV) { transpose_item(A.in[31] + (size_t)l * 128 * 512, 512, 64 * (r / 16), 32 * (r % 16), WMLA + (size_t)l * 1024 * 512, 512, 384 + 32 * (r % 16), 256 + 64 * (r / 16), scr, F.lane); continue; } r -= I_KV;
        transpose_item(A.in[26] + (size_t)l * 256 * 256, 256, 64 * (r / 8), 32 * (r % 8), WGLU + (size_t)l * 256 * 256, 256, 32 * (r % 8), 64 * (r / 8), scr, F.lane);
    }
    for (int l = 0; l < 2; ++l) {
        zero_rows(WIN + (size_t)l * ZS * 1024, 1024, D_IN, ZS - D_IN, 0, 1024, F.gw, F.ngw, F.lane);
        bf16_t* wm = WMLA + (size_t)l * 1024 * 512;
        zero_rows(wm, 512, 0, 384, 256, 256, F.gw, F.ngw, F.lane);
        zero_rows(wm, 512, 384, 512, 0, 256, F.gw, F.ngw, F.lane);
        zero_rows(wm, 512, 384, 512, 384, 128, F.gw, F.ngw, F.lane);
        zero_rows(wm, 512, 896, 128, 0, 512, F.gw, F.ngw, F.lane);
    }
}

DI void phase_norm1(const Frame& F, CArgs& A, int l) {
    const float* MODL = (const float*)(A.ws + WS_MOD) + (size_t)l * 8 * 6144;
    const float* g = A.in[5] + l * 1024;
    const bf16_t* Y = (const bf16_t*)(A.ws + WS_Y);
    bf16_t* H = (bf16_t*)(A.ws + WS_H);
    const float* src = (l == 0) ? A.in[0] : A.out;
    for (int row = F.gw; row < T; row += F.ngw) {
        const int b = row / SEQ;
        f32x4 v[4]; float ss = 0.f;
#pragma unroll
        for (int j = 0; j < 4; ++j) { const int col = 4 * (64 * j + F.lane);
            v[j] = *(const f32x4*)(src + (size_t)row * DM + col);
            if (l > 0) { const u32x2 y0 = *(const u32x2*)(Y + (size_t)(2 * row) * DM + col), y1 = *(const u32x2*)(Y + (size_t)(2 * row + 1) * DM + col);
                v[j][0] += bflo(y0.x) + bflo(y1.x); v[j][1] += bfhi(y0.x) + bfhi(y1.x); v[j][2] += bflo(y0.y) + bflo(y1.y); v[j][3] += bfhi(y0.y) + bfhi(y1.y);
                *(f32x4*)(A.out + (size_t)row * DM + col) = v[j]; }
            ss += v[j][0] * v[j][0] + v[j][1] * v[j][1] + v[j][2] * v[j][2] + v[j][3] * v[j][3]; }
        const float rstd = rsqrtf(wave_sum(ss) * (1.f / DM) + NORM_EPS);
#pragma unroll
        for (int j = 0; j < 4; ++j) { const int col = 4 * (64 * j + F.lane);
            const f32x4 gg = *(const f32x4*)(g + col), sh = *(const f32x4*)(MODL + (size_t)b * 6144 + col), scv = *(const f32x4*)(MODL + (size_t)b * 6144 + 1024 + col);
            const f32x4 hv = v[j] * rstd * gg * (scv + 1.f) + sh;
            u32x2 o; o.x = pk2(hv[0], hv[1]); o.y = pk2(hv[2], hv[3]);
            *(u32x2*)(H + (size_t)row * DM + col) = o; }
    }
}

DI void phase_mla_prep(const Frame& F, CArgs& A, int l) {
    const bf16_t* Z = (const bf16_t*)(A.ws + WS_Z); bf16_t* AM = (bf16_t*)(A.ws + WS_AMLA);
    const float* qg = A.in[28] + l * 256; const float* kg = A.in[30] + l * 128;
    for (int row = F.gw; row < T; row += F.ngw) {
        const bf16_t* zr = Z + (size_t)row * ZS;
        const u32x2 qv = *(const u32x2*)(zr + ZC_QA + 4 * F.lane); const unsigned kv = *(const unsigned*)(zr + ZC_KVA + 2 * F.lane);
        const float q0 = bflo(qv.x), q1 = bfhi(qv.x), q2 = bflo(qv.y), q3 = bfhi(qv.y), k0 = bflo(kv), k1 = bfhi(kv);
        const float rq = rsqrtf(wave_sum(q0 * q0 + q1 * q1 + q2 * q2 + q3 * q3) * (1.f / 256.f) + NORM_EPS);
        const float rk = rsqrtf(wave_sum(k0 * k0 + k1 * k1) * (1.f / 128.f) + NORM_EPS);
        const f32x4 g4 = *(const f32x4*)(qg + 4 * F.lane); const f32x2 g2 = *(const f32x2*)(kg + 2 * F.lane);
        u32x2 o; o.x = pk2(q0 * rq * g4[0], q1 * rq * g4[1]); o.y = pk2(q2 * rq * g4[2], q3 * rq * g4[3]);
        bf16_t* ar = AM + (size_t)row * 512;
        *(u32x2*)(ar + 4 * F.lane) = o;
        *(unsigned*)(ar + 256 + 2 * F.lane) = pk2(k0 * rk * g2[0], k1 * rk * g2[1]);
        *(unsigned*)(ar + 384 + 2 * F.lane) = 0u;
    }
}

DI void phase_mla_post(const Frame& F, CArgs& A, int l) {
    const bf16_t* Z = (const bf16_t*)(A.ws + WS_Z); const bf16_t* RAW = (const bf16_t*)(A.ws + WS_QKVRAW);
    bf16_t* Q = (bf16_t*)(A.ws + WS_Q); bf16_t* K = (bf16_t*)(A.ws + WS_K); bf16_t* VT = (bf16_t*)(A.ws + WS_VT);
    LAS float* cs = (LAS float*)F.lds;
    LAS bf16_t* vt = (LAS bf16_t*)(F.lds + 8192);
    const float* qhg = A.in[32] + l * 96; const float* khg = A.in[33] + l * 96;
    for (int tile = F.bid; tile < T / 64; tile += F.G) {
        const int t0 = tile * 64, b = t0 / SEQ, s0 = t0 % SEQ;
        for (int idx = F.tid; idx < 1024; idx += NTHR) { const int tok = idx >> 4, i = idx & 15;
            const int pos = A.pos_off[b] + s0 + tok; const float inv = powf(10000.f, -(float)i * (1.f / 16.f));
            double ang = (double)(float)pos * (double)inv; ang -= 6.283185307179586 * floor(ang * 0.15915494309189535);
            float sn, cn; sincosf((float)ang, &sn, &cn); cs[idx * 2] = cn; cs[idx * 2 + 1] = sn; }
        __syncthreads();
        const int tok = F.tid >> 3, sub = F.tid & 7, h = sub >> 1, isk = sub & 1, t = t0 + tok;
        {
            float v[96];
            const bf16_t* p0 = isk ? RAW + (size_t)t * 1024 + 384 + 128 * h : RAW + (size_t)t * 1024 + 96 * h;
            const bf16_t* p1 = isk ? Z + (size_t)t * ZS + ZC_KPE : p0 + 64;
#pragma unroll
            for (int c = 0; c < 8; ++c) { const u32x4 w = *(const u32x4*)(p0 + 8 * c);
                v[8 * c] = bflo(w.x); v[8 * c + 1] = bfhi(w.x); v[8 * c + 2] = bflo(w.y); v[8 * c + 3] = bfhi(w.y); v[8 * c + 4] = bflo(w.z); v[8 * c + 5] = bfhi(w.z); v[8 * c + 6] = bflo(w.w); v[8 * c + 7] = bfhi(w.w); }
#pragma unroll
            for (int c = 0; c < 4; ++c) { const u32x4 w = *(const u32x4*)(p1 + 8 * c);
                v[64 + 8 * c] = bflo(w.x); v[65 + 8 * c] = bfhi(w.x); v[66 + 8 * c] = bflo(w.y); v[67 + 8 * c] = bfhi(w.y); v[68 + 8 * c] = bflo(w.z); v[69 + 8 * c] = bfhi(w.z); v[70 + 8 * c] = bflo(w.w); v[71 + 8 * c] = bfhi(w.w); }
            float ss = 0.f;
#pragma unroll
            for (int i = 0; i < 96; ++i) ss += v[i] * v[i];
            const float r = rsqrtf(ss * (1.f / 96.f) + NORM_EPS);
            const float* hg = isk ? khg : qhg;
#pragma unroll
            for (int i = 0; i < 96; ++i) v[i] = v[i] * r * hg[i];
#pragma unroll
            for (int i = 0; i < 16; ++i) { const float cn = cs[(tok * 16 + i) * 2], sn = cs[(tok * 16 + i) * 2 + 1]; const float x1 = v[64 + i], x2 = v[80 + i];
                v[64 + i] = x1 * cn - x2 * sn; v[80 + i] = x1 * sn + x2 * cn; }
            bf16_t* dst = (isk ? K : Q) + ((size_t)t * 4 + h) * 96;
#pragma unroll
            for (int c = 0; c < 12; ++c) { u32x4 w; w.x = pk2(v[8 * c], v[8 * c + 1]); w.y = pk2(v[8 * c + 2], v[8 * c + 3]); w.z = pk2(v[8 * c + 4], v[8 * c + 5]); w.w = pk2(v[8 * c + 6], v[8 * c + 7]);
                *(u32x4*)(dst + 8 * c) = w; }
        }
        {
            const bf16_t* pv = RAW + (size_t)t * 1024 + 384 + 128 * h + 64 + 32 * isk;
#pragma unroll
            for (int c = 0; c < 4; ++c) { const u32x4 w = *(const u32x4*)(pv + 8 * c); const int r0 = h * 64 + 32 * isk + 8 * c;
                vt[(r0 + 0) * 72 + tok] = (bf16_t)(w.x & 0xffffu); vt[(r0 + 1) * 72 + tok] = (bf16_t)(w.x >> 16);
                vt[(r0 + 2) * 72 + tok] = (bf16_t)(w.y & 0xffffu); vt[(r0 + 3) * 72 + tok] = (bf16_t)(w.y >> 16);
                vt[(r0 + 4) * 72 + tok] = (bf16_t)(w.z & 0xffffu); vt[(r0 + 5) * 72 + tok] = (bf16_t)(w.z >> 16);
                vt[(r0 + 6) * 72 + tok] = (bf16_t)(w.w & 0xffffu); vt[(r0 + 7) * 72 + tok] = (bf16_t)(w.w >> 16); }
        }
        __syncthreads();
        { const int row = F.tid >> 1, hf = F.tid & 1;
          bf16_t* dst = VT + ((size_t)(b * 4) * 64 + row) * SEQ + s0 + 32 * hf;
#pragma unroll
          for (int c = 0; c < 4; ++c) *(u32x4*)(dst + 8 * c) = *(const LAS u32x4*)(vt + row * 72 + 32 * hf + 8 * c); }
        __syncthreads();
    }
}

DI void attn_unit(const Frame& F, const bf16_t* Q, const bf16_t* K, const bf16_t* VT, bf16_t* O, int bh, int u) {
    constexpr int KP = 208, VP = 144, KB = 64 * KP, VB = 64 * VP;
    LAS unsigned char* Ks = F.lds; LAS unsigned char* Vs = F.lds + 2 * KB;
    const int b = bh >> 2, h = bh & 3, lane = F.lane, w = F.wave, ql = lane & 31, hh = lane >> 5;
    const int ntile = 4 * u + 4, myl = 4 * u + (w >> 1);
    const size_t tq = (size_t)b * SEQ + 256 * u + 32 * w + ql;
    bf16x8 qf[6];
#pragma unroll
    for (int s = 0; s < 6; ++s) qf[s] = *(const bf16x8*)(Q + (tq * 4 + h) * 96 + 16 * s + 8 * hh);
    f32x16 ot[2];
#pragma unroll
    for (int i = 0; i < 16; ++i) { ot[0][i] = 0.f; ot[1][i] = 0.f; }
    float mrun = -INFINITY, lrun = 0.f;
    const float c2 = 0.10206207261596577f * 1.4426950408889634f;
    const int kp0 = F.tid, kp1 = F.tid + 512;
    const size_t kbase = ((size_t)b * SEQ * 4 + h) * 96;
    const bf16_t* vsrc = VT + ((size_t)bh * 64 + (F.tid >> 3)) * SEQ + 8 * (F.tid & 7);
    u32x4 rk0, rk1, rv;
    rk1 = (u32x4){0u, 0u, 0u, 0u};
#define ATT_LOAD(j) do { rk0 = *(const u32x4*)(K + kbase + (size_t)(64 * (j) + kp0 / 12) * 384 + 8 * (kp0 % 12)); \
        if (kp1 < 768) rk1 = *(const u32x4*)(K + kbase + (size_t)(64 * (j) + kp1 / 12) * 384 + 8 * (kp1 % 12)); \
        rv = *(const u32x4*)(vsrc + 64 * (j)); } while (0)
#define ATT_STORE(buf) do { *(LAS u32x4*)(Ks + (buf) * KB + (kp0 / 12) * KP + (kp0 % 12) * 16) = rk0; \
        if (kp1 < 768) *(LAS u32x4*)(Ks + (buf) * KB + (kp1 / 12) * KP + (kp1 % 12) * 16) = rk1; \
        *(LAS u32x4*)(Vs + (buf) * VB + (F.tid >> 3) * VP + (F.tid & 7) * 16) = rv; } while (0)
    ATT_LOAD(0); ATT_STORE(0);
    __syncthreads();
    for (int j = 0; j < ntile; ++j) {
        const int buf = j & 1;
        if (j + 1 < ntile) ATT_LOAD(j + 1);
        if (j <= myl) {
            f32x16 st[2];
#pragma unroll
            for (int kt = 0; kt < 2; ++kt) {
#pragma unroll
                for (int i = 0; i < 16; ++i) st[kt][i] = 0.f;
#pragma unroll
                for (int s = 0; s < 6; ++s) { const bf16x8 kf = *(const LAS bf16x8*)(Ks + buf * KB + (32 * kt + ql) * KP + (16 * s + 8 * hh) * 2);
                    st[kt] = __builtin_amdgcn_mfma_f32_32x32x16_bf16(kf, qf[s], st[kt], 0, 0, 0); }
            }
            float mx = st[0][0];
#pragma unroll
            for (int i = 1; i < 16; ++i) mx = fmaxf(mx, st[0][i]);
#pragma unroll
            for (int i = 0; i < 16; ++i) mx = fmaxf(mx, st[1][i]);
            mx = fmaxf(mx, shfl_xor_l(mx, 32, lane));
            const float mnew = fmaxf(mrun, mx), alpha = __builtin_amdgcn_exp2f((mrun - mnew) * c2), mc = mnew * c2;
            mrun = mnew;
            float ps = 0.f;
#pragma unroll
            for (int kt = 0; kt < 2; ++kt)
#pragma unroll
                for (int i = 0; i < 16; ++i) { const float p = __builtin_amdgcn_exp2f(st[kt][i] * c2 - mc); st[kt][i] = p; ps += p; }
            lrun = lrun * alpha + ps;
#pragma unroll
            for (int i = 0; i < 16; ++i) { ot[0][i] *= alpha; ot[1][i] *= alpha; }
#pragma unroll
            for (int kt = 0; kt < 2; ++kt)
#pragma unroll
                for (int c = 0; c < 2; ++c) {
                    u32x4 pw; pw.x = pk2(st[kt][8 * c], st[kt][8 * c + 1]); pw.y = pk2(st[kt][8 * c + 2], st[kt][8 * c + 3]); pw.z = pk2(st[kt][8 * c + 4], st[kt][8 * c + 5]); pw.w = pk2(st[kt][8 * c + 6], st[kt][8 * c + 7]);
                    const bf16x8 pf = __builtin_bit_cast(bf16x8, pw);
                    const int key0 = 32 * kt + 16 * c + 4 * hh;
#pragma unroll
                    for (int dt = 0; dt < 2; ++dt) { const LAS unsigned char* vp = Vs + buf * VB + (32 * dt + ql) * VP + key0 * 2;
                        const u32x2 v0 = *(const LAS u32x2*)vp, v1 = *(const LAS u32x2*)(vp + 16);
                        u32x4 vw; vw.x = v0.x; vw.y = v0.y; vw.z = v1.x; vw.w = v1.y;
                        ot[dt] = __builtin_amdgcn_mfma_f32_32x32x16_bf16(__builtin_bit_cast(bf16x8, vw), pf, ot[dt], 0, 0, 0); }
                }
        }
        if (j + 1 < ntile) ATT_STORE(buf ^ 1);
        __syncthreads();
    }
#undef ATT_LOAD
#undef ATT_STORE
    const float linv = 1.f / (lrun + shfl_xor_l(lrun, 32, lane));
    bf16_t* orow = O + tq * 256 + h * 64;
#pragma unroll
    for (int dt = 0; dt < 2; ++dt)
#pragma unroll
        for (int g = 0; g < 4; ++g) { u32x2 o; o.x = pk2(ot[dt][4 * g] * linv, ot[dt][4 * g + 1] * linv); o.y = pk2(ot[dt][4 * g + 2] * linv, ot[dt][4 * g + 3] * linv);
            *(u32x2*)(orow + 32 * dt + 8 * g + 4 * hh) = o; }
}
DI void phase_attn(const Frame& F, CArgs& A) {
    const bf16_t* Q = (const bf16_t*)(A.ws + WS_Q); const bf16_t* K = (const bf16_t*)(A.ws + WS_K); const bf16_t* VT = (const bf16_t*)(A.ws + WS_VT);
    bf16_t* O = (bf16_t*)(A.ws + WS_ATTO);
    for (int p = F.bid; p < 512; p += F.G) { const int bh = p >> 4, u = p & 15;
        attn_unit(F, Q, K, VT, O, bh, 31 - u);
        attn_unit(F, Q, K, VT, O, bh, u); }
}

DI void phase_rwkv_prep(const Frame& F, CArgs& A, int l) {
    const bf16_t* Z = (const bf16_t*)(A.ws + WS_Z);
    bf16_t* R_ = (bf16_t*)(A.ws + WS_RW_R); bf16_t* K_ = (bf16_t*)(A.ws + WS_RW_K); bf16_t* V_ = (bf16_t*)(A.ws + WS_RW_V); bf16_t* KK_ = (bf16_t*)(A.ws + WS_RW_KK);
    bf16_t* B_ = (bf16_t*)(A.ws + WS_RW_B); bf16_t* G_ = (bf16_t*)(A.ws + WS_RW_G); float* W_ = (float*)(A.ws + WS_RW_W);
    const float* mu = A.in[7] + l * 896; const float* w0 = A.in[8] + l * 256; const float* w2 = A.in[9] + l * 32 * 256; const float* a0 = A.in[10] + l * 256;
    const float* a2 = A.in[11] + l * 32 * 256; const float* g2 = A.in[12] + l * 64 * 256; const float* k_k = A.in[13] + l * 256; const float* k_a = A.in[14] + l * 256;
    LAS float* lora = (LAS float*)F.lds;
    const int tg = F.tid >> 8, ch = F.tid & 255;
    for (int pi = F.bid; pi < T / 2; pi += F.G) {
        const int t = 2 * pi + tg, s = t % SEQ; const bool hp = s > 0;
        const bf16_t* zr = Z + (size_t)t * ZS;
#define RW_SH(col) ({ const float zc_ = bf2f(zr[(col)]); const float zp_ = hp ? bf2f(zr[(col) - ZS]) : 0.f; zc_ + (zp_ - zc_) * mu[(col)]; })
        if (ch < 128) { float v = RW_SH(ZC_WLO + ch); if (ch < 32) v = tanhf(v); else if (ch >= 64) v = sigmoidf_(v); lora[tg * 128 + ch] = v; }
        __syncthreads();
        float wv = w0[ch], av = a0[ch], gv = 0.f;
        const LAS float* lo = lora + tg * 128;
#pragma unroll 8
        for (int j = 0; j < 32; ++j) { wv += lo[j] * w2[j * 256 + ch]; av += lo[32 + j] * a2[j * 256 + ch]; }
#pragma unroll 8
        for (int j = 0; j < 64; ++j) gv += lo[64 + j] * g2[j * 256 + ch];
        const float wraw = -softplusf_(-wv) - 0.5f, decay = __expf(-__expf(wraw));
        const float a = sigmoidf_(av);
        const float r = RW_SH(ZC_R + ch), k = RW_SH(ZC_K + ch), v = RW_SH(ZC_V + ch);
        const float kkv = k * k_k[ch];
        const float nrm = sqrtf(wave_sum(kkv * kkv));
        const float kk = kkv / fmaxf(nrm, 1e-12f);
        const float kmod = k * (1.f + (a - 1.f) * k_a[ch]);
        const size_t o = (size_t)t * 256 + ch;
        R_[o] = (bf16_t)f2bf(r); K_[o] = (bf16_t)f2bf(kmod); V_[o] = (bf16_t)f2bf(v); KK_[o] = (bf16_t)f2bf(kk); B_[o] = (bf16_t)f2bf(kk * a); G_[o] = (bf16_t)f2bf(gv); W_[o] = decay;
        __syncthreads();
#undef RW_SH
    }
}

DI void phase_rwkv_scan(const Frame& F, CArgs& A) {
    if (F.bid >= 32) return;
    const bf16_t* R_ = (const bf16_t*)(A.ws + WS_RW_R); const bf16_t* K_ = (const bf16_t*)(A.ws + WS_RW_K); const bf16_t* V_ = (const bf16_t*)(A.ws + WS_RW_V);
    const bf16_t* KK_ = (const bf16_t*)(A.ws + WS_RW_KK); const bf16_t* B_ = (const bf16_t*)(A.ws + WS_RW_B); const float* W_ = (const float*)(A.ws + WS_RW_W);
    float* Y_ = (float*)(A.ws + WS_RW_Y);
    constexpr int CH = 16;
    LAS float* buf = (LAS float*)F.lds;
    LAS float* psa = (LAS float*)(F.lds + 2 * 6 * CH * 64 * 4);
    LAS float* py = psa + 2 * 8 * 64;
    const int b = F.bid >> 2, h = F.bid & 3, w = F.wave, lane = F.lane;
    const size_t base = (size_t)b * SEQ * 256 + h * 64;
    float s[8];
#pragma unroll
    for (int c = 0; c < 8; ++c) s[c] = 0.f;
    float pre[12];
#define RS_LOAD(t0) do { _Pragma("unroll") for (int e = 0; e < 12; ++e) { const int step = (F.tid + 512 * (e & 1)) >> 6, col = F.tid & 63; const size_t gi = base + (size_t)((t0) + step) * 256 + col; \
        const int a_ = e >> 1; pre[e] = a_ == 0 ? bf2f(KK_[gi]) : a_ == 1 ? bf2f(B_[gi]) : a_ == 2 ? W_[gi] : a_ == 3 ? bf2f(K_[gi]) : a_ == 4 ? bf2f(R_[gi]) : bf2f(V_[gi]); } } while (0)
#define RS_STORE(bi) do { _Pragma("unroll") for (int e = 0; e < 12; ++e) buf[(((bi) * 6 + (e >> 1)) * CH) * 64 + F.tid + 512 * (e & 1)] = pre[e]; } while (0)
    RS_LOAD(0); RS_STORE(0);
    __syncthreads();
    for (int c0 = 0; c0 < SEQ / CH; ++c0) {
        const int bi = c0 & 1;
        if (c0 + 1 < SEQ / CH) RS_LOAD((c0 + 1) * CH);
        const LAS float* cb = buf + bi * 6 * CH * 64;
        for (int tl = 0; tl < CH; ++tl) {
            const LAS float* p = cb + tl * 64 + 8 * w;
            const f32x4 kk0 = *(const LAS f32x4*)(p), kk1 = *(const LAS f32x4*)(p + 4);
            const f32x4 be0 = *(const LAS f32x4*)(p + CH * 64), be1 = *(const LAS f32x4*)(p + CH * 64 + 4);
            const f32x4 w0 = *(const LAS f32x4*)(p + 2 * CH * 64), w1 = *(const LAS f32x4*)(p + 2 * CH * 64 + 4);
            const f32x4 k0 = *(const LAS f32x4*)(p + 3 * CH * 64), k1 = *(const LAS f32x4*)(p + 3 * CH * 64 + 4);
            const f32x4 r0 = *(const LAS f32x4*)(p + 4 * CH * 64), r1 = *(const LAS f32x4*)(p + 4 * CH * 64 + 4);
            const float vv = cb[5 * CH * 64 + tl * 64 + lane];
            float pa = s[0] * kk0[0] + s[1] * kk0[1] + s[2] * kk0[2] + s[3] * kk0[3] + s[4] * kk1[0] + s[5] * kk1[1] + s[6] * kk1[2] + s[7] * kk1[3];
            psa[((tl & 1) * 8 + w) * 64 + lane] = pa;
            __syncthreads();
            float sa = 0.f;
#pragma unroll
            for (int ww = 0; ww < 8; ++ww) sa -= psa[((tl & 1) * 8 + ww) * 64 + lane];
            s[0] = s[0] * w0[0] + sa * be0[0] + vv * k0[0]; s[1] = s[1] * w0[1] + sa * be0[1] + vv * k0[1]; s[2] = s[2] * w0[2] + sa * be0[2] + vv * k0[2]; s[3] = s[3] * w0[3] + sa * be0[3] + vv * k0[3];
            s[4] = s[4] * w1[0] + sa * be1[0] + vv * k1[0]; s[5] = s[5] * w1[1] + sa * be1[1] + vv * k1[1]; s[6] = s[6] * w1[2] + sa * be1[2] + vv * k1[2]; s[7] = s[7] * w1[3] + sa * be1[3] + vv * k1[3];
            py[(tl * 8 + w) * 64 + lane] = s[0] * r0[0] + s[1] * r0[1] + s[2] * r0[2] + s[3] * r0[3] + s[4] * r1[0] + s[5] * r1[1] + s[6] * r1[2] + s[7] * r1[3];
        }
        __syncthreads();
#pragma unroll
        for (int e = 0; e < 2; ++e) { const int idx = F.tid + 512 * e, tl = idx >> 6, row = idx & 63; float y = 0.f;
#pragma unroll
            for (int ww = 0; ww < 8; ++ww) y += py[(tl * 8 + ww) * 64 + row];
            Y_[base + (size_t)(c0 * CH + tl) * 256 + row] = y; }
        if (c0 + 1 < SEQ / CH) RS_STORE(bi ^ 1);
        __syncthreads();
    }
#undef RS_LOAD
#undef RS_STORE
}

DI void phase_rwkv_fin(const Frame& F, CArgs& A, int l) {
    const bf16_t* R_ = (const bf16_t*)(A.ws + WS_RW_R); const bf16_t* K_ = (const bf16_t*)(A.ws + WS_RW_K); const bf16_t* V_ = (const bf16_t*)(A.ws + WS_RW_V); const bf16_t* G_ = (const bf16_t*)(A.ws + WS_RW_G);
    const float* Y_ = (const float*)(A.ws + WS_RW_Y); bf16_t* MIX = (bf16_t*)(A.ws + WS_MIX);
    const float* r_k = A.in[15] + l * 256; const float* ln_w = A.in[16] + l * 256; const float* ln_b = A.in[17] + l * 256;
    for (int it = F.gw; it < T * 4; it += F.ngw) {
        const int t = it >> 2, ch = (it & 3) * 64 + F.lane; const size_t o = (size_t)t * 256 + ch;
        const float y = Y_[o];
        const float mean = wave_sum(y) * (1.f / 64.f); const float d = y - mean; const float var = wave_sum(d * d) * (1.f / 64.f);
        const float yn = d * rsqrtf(var + 64e-5f) * ln_w[ch] + ln_b[ch];
        const float r = bf2f(R_[o]), k = bf2f(K_[o]), v = bf2f(V_[o]), g = bf2f(G_[o]);
        const float bonus = wave_sum(r * k * r_k[ch]) * v;
        MIX[(size_t)t * DM + ch] = (bf16_t)f2bf((yn + bonus) * g);
    }
}

template <int PASS>
DI void phase_s5(const Frame& F, CArgs& A, int l) {
    const bf16_t* Z = (const bf16_t*)(A.ws + WS_Z); float* SEND = (float*)(A.ws + WS_S5END); bf16_t* YS = (bf16_t*)(A.ws + WS_YS5);
    LAS float* hre = (LAS float*)(F.lds + F.wave * 16512); LAS float* him = hre + 16 * 65; LAS float* cre = him + 16 * 65; LAS float* cim = cre + 16 * 64;
    const int lane = F.lane;
    for (int it = F.gw; it < 8 * 16 * 16; it += F.ngw) {
        const int b = it >> 8, g = (it >> 4) & 15, seg = it & 15, p = lane;
        const float dt = __expf(A.in[25][l * 16 + g]);
        const float lre = A.in[18][(l * 16 + g) * 64 + p], lim = A.in[19][(l * 16 + g) * 64 + p];
        const float mag = expf(lre * dt); float sn, cn; sincosf(lim * dt, &sn, &cn);
        const float are = mag * cn, aim = mag * sn, den = lre * lre + lim * lim;
        const float qre = ((are - 1.f) * lre + aim * lim) / den, qim = (aim * lre - (are - 1.f) * lim) / den;
        float bbr[16], bbi[16];
        { const float* br = A.in[20] + ((size_t)(l * 16 + g) * 64 + p) * 16; const float* bi = A.in[21] + ((size_t)(l * 16 + g) * 64 + p) * 16;
#pragma unroll
          for (int i = 0; i < 16; ++i) { const float x = br[i], y = bi[i]; bbr[i] = qre * x - qim * y; bbi[i] = qre * y + qim * x; } }
        float h_re = 0.f, h_im = 0.f;
        if (PASS == 2) {
            const float m512 = expf(512.f * lre * dt); float s5, c5; sincosf(512.f * (lim * dt), &s5, &c5); const float pr = m512 * c5, pi_ = m512 * s5;
            for (int j = 0; j < seg; ++j) { const float* e = SEND + ((size_t)((b * 16 + g) * 16 + j)) * 128; const float er = e[p], ei = e[64 + p];
                const float nr = pr * h_re - pi_ * h_im + er, ni = pr * h_im + pi_ * h_re + ei; h_re = nr; h_im = ni; }
            for (int i = lane; i < 1024; i += 64) { cre[i] = A.in[22][(size_t)(l * 16 + g) * 1024 + i]; cim[i] = A.in[23][(size_t)(l * 16 + g) * 1024 + i]; }
        }
        const bf16_t* zb = Z + ((size_t)b * SEQ + seg * 512) * ZS + ZC_S5 + g * 16;
        for (int t0 = 0; t0 < 512; t0 += 16) {
#pragma unroll
            for (int sb = 0; sb < 2; ++sb) {
                u32x4 ua[8], ub[8];
#pragma unroll
                for (int q = 0; q < 8; ++q) { const bf16_t* zp = zb + (size_t)(t0 + sb * 8 + q) * ZS; ua[q] = *(const u32x4*)zp; ub[q] = *(const u32x4*)(zp + 8); }
#pragma unroll
                for (int q = 0; q < 8; ++q) {
                    float br_ = 0.f, bi_ = 0.f;
                    const unsigned uw[8] = {ua[q].x, ua[q].y, ua[q].z, ua[q].w, ub[q].x, ub[q].y, ub[q].z, ub[q].w};
#pragma unroll
                    for (int i = 0; i < 8; ++i) { const float u0 = bflo(uw[i]), u1 = bfhi(uw[i]); br_ += bbr[2 * i] * u0 + bbr[2 * i + 1] * u1; bi_ += bbi[2 * i] * u0 + bbi[2 * i + 1] * u1; }
                    const float nr = are * h_re - aim * h_im + br_, ni = are * h_im + aim * h_re + bi_; h_re = nr; h_im = ni;
                    if (PASS == 2) { hre[(sb * 8 + q) * 65 + p] = h_re; him[(sb * 8 + q) * 65 + p] = h_im; }
                }
            }
            if (PASS == 2) {
                asm volatile("s_waitcnt lgkmcnt(0)" ::: "memory");
                const int tl = lane & 15, iq = lane >> 4;
                float acc[4] = {0.f, 0.f, 0.f, 0.f};
                for (int pp = 0; pp < 64; ++pp) { const float xr = hre[tl * 65 + pp], xi = him[tl * 65 + pp];
#pragma unroll
                    for (int i = 0; i < 4; ++i) acc[i] += xr * cre[(4 * iq + i) * 64 + pp] - xi * cim[(4 * iq + i) * 64 + pp]; }
                const int tt = seg * 512 + t0 + tl; const size_t tok = (size_t)b * SEQ + tt;
                const u32x2 uu = *(const u32x2*)(Z + tok * ZS + ZC_S5 + g * 16 + 4 * iq);
                const f32x4 dd = *(const f32x4*)(A.in[24] + l * 256 + g * 16 + 4 * iq);
                const float y0 = gelu_tanh(acc[0] + dd[0] * bflo(uu.x)), y1 = gelu_tanh(acc[1] + dd[1] * bfhi(uu.x)), y2 = gelu_tanh(acc[2] + dd[2] * bflo(uu.y)), y3 = gelu_tanh(acc[3] + dd[3] * bfhi(uu.y));
                u32x2 o; o.x = pk2(y0, y1); o.y = pk2(y2, y3);
                *(u32x2*)(YS + tok * 256 + g * 16 + 4 * iq) = o;
                asm volatile("s_waitcnt lgkmcnt(0)" ::: "memory");
            }
        }
        if (PASS == 1) { float* e = SEND + ((size_t)((b * 16 + g) * 16 + seg)) * 128; e[p] = h_re; e[64 + p] = h_im; }
    }
}

DI void phase_lru_prep(const Frame& F, CArgs& A, int l) {
    const bf16_t* Z = (const bf16_t*)(A.ws + WS_Z); float* LA = (float*)(A.ws + WS_LA); float* LB = (float*)(A.ws + WS_LB);
    const float* cw = A.in[34] + l * 4 * 256; const float* cb = A.in[35] + l * 256; const float* wa = A.in[36] + (size_t)l * 4 * 64 * 64; const float* ba = A.in[37] + l * 256;
    const float* wx = A.in[38] + (size_t)l * 4 * 64 * 64; const float* bx = A.in[39] + l * 256; const float* lam = A.in[40] + l * 256;
    LAS float* xs = (LAS float*)F.lds;
    const int tg = F.tid >> 8, ch = F.tid & 255, n = ch >> 6, jj = ch & 63;
    const float spl = softplusf_(-lam[ch]);
    for (int pi = F.bid; pi < T / 2; pi += F.G) {
        const int t = 2 * pi + tg, s = t % SEQ;
        const bf16_t* zr = Z + (size_t)t * ZS + ZC_LX + ch;
        float xc = cb[ch];
#pragma unroll
        for (int j = 0; j < 4; ++j) { const int sp = s - 3 + j; if (sp >= 0) xc += cw[j * 256 + ch] * bf2f(zr[(ptrdiff_t)(j - 3) * ZS]); }
        xs[tg * 256 + ch] = xc;
        __syncthreads();
        float ra = ba[ch], ia = bx[ch];
        const LAS float* xb = xs + tg * 256 + n * 64;
#pragma unroll 8
        for (int k = 0; k < 64; ++k) { const float x = xb[k]; ra += x * wa[(n * 64 + k) * 64 + jj]; ia += x * wx[(n * 64 + k) * 64 + jj]; }
        const float r = sigmoidf_(ra), ig = sigmoidf_(ia);
        const float log_a = -8.f * r * spl, a = __expf(log_a);
        const float bv = sqrtf(-expm1f(2.f * log_a)) * (ig * xc);
        LA[(size_t)t * 256 + ch] = a; LB[(size_t)t * 256 + ch] = bv;
        __syncthreads();
    }
}
DI void phase_lru_sum(const Frame& F, CArgs& A) {
    const float* LA = (const float*)(A.ws + WS_LA); const float* LB = (const float*)(A.ws + WS_LB); float* LS = (float*)(A.ws + WS_LSUM);
    for (int it = F.gw; it < 8 * 128; it += F.ngw) {
        const size_t r0 = (size_t)it * 64;
        f32x4 Ap = {1.f, 1.f, 1.f, 1.f}, Bp = {0.f, 0.f, 0.f, 0.f};
#pragma unroll 8
        for (int t = 0; t < 64; ++t) { const f32x4 a = *(const f32x4*)(LA + (r0 + t) * 256 + 4 * F.lane), bb = *(const f32x4*)(LB + (r0 + t) * 256 + 4 * F.lane); Bp = a * Bp + bb; Ap = Ap * a; }
        *(f32x4*)(LS + ((size_t)it * 2) * 256 + 4 * F.lane) = Ap; *(f32x4*)(LS + ((size_t)it * 2 + 1) * 256 + 4 * F.lane) = Bp;
    }
}
DI void phase_lru_fin(const Frame& F, CArgs& A) {
    const float* LA = (const float*)(A.ws + WS_LA); const float* LB = (const float*)(A.ws + WS_LB); const float* LS = (const float*)(A.ws + WS_LSUM);
    const bf16_t* Z = (const bf16_t*)(A.ws + WS_Z); bf16_t* YL = (bf16_t*)(A.ws + WS_YL);
    for (int it = F.gw; it < 8 * 128; it += F.ngw) {
        const int b = it >> 7, c = it & 127;
        f32x4 h = {0.f, 0.f, 0.f, 0.f};
        for (int j = 0; j < c; ++j) { const f32x4 a = *(const f32x4*)(LS + ((size_t)(b * 128 + j) * 2) * 256 + 4 * F.lane), bb = *(const f32x4*)(LS + ((size_t)(b * 128 + j) * 2 + 1) * 256 + 4 * F.lane); h = a * h + bb; }
        const size_t r0 = (size_t)it * 64;
#pragma unroll 4
        for (int t = 0; t < 64; ++t) { const f32x4 a = *(const f32x4*)(LA + (r0 + t) * 256 + 4 * F.lane), bb = *(const f32x4*)(LB + (r0 + t) * 256 + 4 * F.lane); h = a * h + bb;
            const u32x2 gz = *(const u32x2*)(Z + (r0 + t) * ZS + ZC_LG + 4 * F.lane);
            u32x2 o; o.x = pk2(h[0] * gelu_tanh(bflo(gz.x)), h[1] * gelu_tanh(bfhi(gz.x))); o.y = pk2(h[2] * gelu_tanh(bflo(gz.y)), h[3] * gelu_tanh(bfhi(gz.y)));
            *(u32x2*)(YL + (r0 + t) * 256 + 4 * F.lane) = o; }
    }
}

DI void phase_branch_norm(const Frame& F, CArgs& A, int l) {
    const bf16_t* S0 = (const bf16_t*)(A.ws + WS_YS5G); const bf16_t* S1 = (const bf16_t*)(A.ws + WS_ATTO); const bf16_t* S2 = (const bf16_t*)(A.ws + WS_YL);
    bf16_t* MIX = (bf16_t*)(A.ws + WS_MIX); const float* bg = A.in[41] + l * 768;
    for (int row = F.gw; row < T; row += F.ngw) {
#pragma unroll
        for (int br = 0; br < 3; ++br) { const bf16_t* S = br == 0 ? S0 : br == 1 ? S1 : S2;
            const u32x2 v = *(const u32x2*)(S + (size_t)row * 256 + 4 * F.lane);
            const float x0 = bflo(v.x), x1 = bfhi(v.x), x2 = bflo(v.y), x3 = bfhi(v.y);
            const float r = rsqrtf(wave_sum(x0 * x0 + x1 * x1 + x2 * x2 + x3 * x3) * (1.f / 256.f) + NORM_EPS);
            const f32x4 g = *(const f32x4*)(bg + br * 256 + 4 * F.lane);
            u32x2 o; o.x = pk2(x0 * r * g[0], x1 * r * g[1]); o.y = pk2(x2 * r * g[2], x3 * r * g[3]);
            *(u32x2*)(MIX + (size_t)row * DM + 256 * (br + 1) + 4 * F.lane) = o; }
    }
}

DI void phase_norm2_router(const Frame& F, CArgs& A, int l) {
    const float* MODL = (const float*)(A.ws + WS_MOD) + (size_t)l * 8 * 6144;
    const float* g = A.in[43] + l * 1024;
    bf16_t* H = (bf16_t*)(A.ws + WS_H);
    int* EID = (int*)(A.ws + WS_RT_EID); float* GATE = (float*)(A.ws + WS_RT_GATE); int* PIE = (int*)(A.ws + WS_RT_PIE);
    unsigned* CNT = (unsigned*)(A.ws + WS_CTL) + CW_CNT + l * 64;
    LAS float* W = (LAS float*)F.lds;
    { const float* wg = A.in[44] + (size_t)l * 1024 * 4; const float* we = A.in[46] + (size_t)l * 1024 * 32;
      for (int i = F.tid; i < 1024 * 4; i += NTHR) W[(i & 3) * 1024 + (i >> 2)] = wg[i];
      for (int i = F.tid; i < 1024 * 32; i += NTHR) W[(4 + (i & 31)) * 1024 + (i >> 5)] = we[i]; }
    __syncthreads();
    const float* bgp = A.in[45] + l * 4; const float* bep = A.in[47] + l * 32;
    for (int row = F.gw; row < T; row += F.ngw) {
        const int b = row / SEQ;
        f32x4 v[4]; float ss = 0.f;
#pragma unroll
        for (int j = 0; j < 4; ++j) { v[j] = *(const f32x4*)(A.out + (size_t)row * DM + 4 * (64 * j + F.lane)); ss += v[j][0] * v[j][0] + v[j][1] * v[j][1] + v[j][2] * v[j][2] + v[j][3] * v[j][3]; }
        const float rstd = rsqrtf(wave_sum(ss) * (1.f / DM) + NORM_EPS);
#pragma unroll
        for (int j = 0; j < 4; ++j) { const int col = 4 * (64 * j + F.lane);
            const f32x4 gg = *(const f32x4*)(g + col), sh = *(const f32x4*)(MODL + (size_t)b * 6144 + 3072 + col), scv = *(const f32x4*)(MODL + (size_t)b * 6144 + 4096 + col);
            v[j] = v[j] * rstd * gg * (scv + 1.f) + sh;
            u32x2 o; o.x = pk2(v[j][0], v[j][1]); o.y = pk2(v[j][2], v[j][3]);
            *(u32x2*)(H + (size_t)row * DM + col) = o; }
        LAS float* Lw = (LAS float*)(F.lds + 147456) + F.wave * 40;
#pragma unroll 1
        for (int n = 0; n < 36; ++n) { float a = 0.f;
#pragma unroll
            for (int j = 0; j < 4; ++j) { const f32x4 w4 = *(const LAS f32x4*)(W + n * 1024 + 4 * (64 * j + F.lane)); a += v[j][0] * w4[0] + v[j][1] * w4[1] + v[j][2] * w4[2] + v[j][3] * w4[3]; }
            a = wave_sum(a); if (F.lane == 0) Lw[n] = a; }
        asm volatile("s_waitcnt lgkmcnt(0)" ::: "memory");
        float L[36];
#pragma unroll
        for (int n = 0; n < 36; ++n) L[n] = Lw[n];
        asm volatile("s_waitcnt lgkmcnt(0)" ::: "memory");
        float gl[4];
#pragma unroll
        for (int i = 0; i < 4; ++i) gl[i] = L[i] + bgp[i];
        int gs = 0; float gm = gl[0];
#pragma unroll
        for (int i = 1; i < 4; ++i) if (gl[i] > gm) { gm = gl[i]; gs = i; }
        float gden = 0.f;
#pragma unroll
        for (int i = 0; i < 4; ++i) gden += expf(gl[i] - gm);
        const float gprob = 1.f / gden;
        float el[8];
#pragma unroll
        for (int j = 0; j < 8; ++j) el[j] = (gs == 0 ? L[4 + j] : gs == 1 ? L[12 + j] : gs == 2 ? L[20 + j] : L[28 + j]) + bep[gs * 8 + j];
        int i1 = 0; float v1 = el[0];
#pragma unroll
        for (int j = 1; j < 8; ++j) if (el[j] > v1) { v1 = el[j]; i1 = j; }
        int i2 = -1; float v2 = -INFINITY;
#pragma unroll
        for (int j = 0; j < 8; ++j) if (j != i1 && el[j] > v2) { v2 = el[j]; i2 = j; }
        const float p2 = expf(v2 - v1);
        const float g0 = gprob / (1.f + p2), g1 = gprob * p2 / (1.f + p2);
        if (F.lane == 0) {
            const int e0 = gs * 8 + i1, e1 = gs * 8 + i2;
            const unsigned q0 = atomicAdd(CNT + e0, 1u), q1 = atomicAdd(CNT + e1, 1u);
            EID[2 * row] = e0; EID[2 * row + 1] = e1; GATE[2 * row] = g0; GATE[2 * row + 1] = g1; PIE[2 * row] = (int)q0; PIE[2 * row + 1] = (int)q1;
        }
    }
    __syncthreads();
    LAS float* scr = (LAS float*)(F.lds + F.wave * 8448);
    bf16_t* WM1 = (bf16_t*)(A.ws + WS_WM1); bf16_t* WM2 = (bf16_t*)(A.ws + WS_WM2);
    for (int it = F.gw; it < 32 * 768; it += F.ngw) {
        const int e = it / 768; int r = it % 768;
        if (r < 512) { const int which = r >> 8; r &= 255; const int kb = r >> 4, nb = r & 15, n0 = 32 * nb;
            const float* src = (which ? A.in[49] : A.in[48]) + ((size_t)l * 32 + e) * 1024 * 512;
            transpose_item(src, 512, 64 * kb, n0, WM1 + (size_t)e * 1024 * 1024, 1024, 256 * (n0 >> 7) + (n0 & 127) + 128 * which, 64 * kb, scr, F.lane);
        } else { r -= 512; const int kb = r >> 5, nb = r & 31;
            transpose_item(A.in[50] + ((size_t)l * 32 + e) * 512 * 1024, 1024, 64 * kb, 32 * nb, WM2 + (size_t)e * 1024 * 512, 512, 32 * nb, 64 * kb, scr, F.lane); }
    }
}

DI void phase_moe_scatter(const Frame& F, CArgs& A, int l) {
    const unsigned* CNT = (const unsigned*)(A.ws + WS_CTL) + CW_CNT + l * 64;
    unsigned* META = (unsigned*)(A.ws + WS_CTL) + CW_UTAB + l * 1024;
    const int* EID = (const int*)(A.ws + WS_RT_EID); const int* PIE = (const int*)(A.ws + WS_RT_PIE); int* SORT = (int*)(A.ws + WS_RT_SORT);
    LAS unsigned* st = (LAS unsigned*)F.lds;
    if (F.tid == 0) { unsigned s = 0; for (int e = 0; e < 32; ++e) { st[e] = s; s += CNT[e]; } }
    __syncthreads();
    if (F.bid == 0 && F.tid == 0) { unsigned nu = 0;
        for (int e = 0; e < 32; ++e) { const unsigned c = CNT[e]; META[1 + e] = st[e]; META[33 + e] = c; for (unsigned bk = 0; bk * 256 < c; ++bk) META[65 + nu++] = ((unsigned)e << 16) | bk; }
        META[0] = nu; }
    for (int a = F.bid * NTHR + F.tid; a < 2 * T; a += F.G * NTHR) SORT[st[EID[a]] + PIE[a]] = a;
}

struct MoeProb1 {
    const char* Hh; const char* WM1; const unsigned* META; const int* SORT; int lda, ldb, nt, G, c;
    DI bool next(int i, pg8::Unit& u) const { const int idx = i * G + c; const int nu = (int)META[0]; if (idx >= nu * 4) return false;
        const unsigned ent = META[65 + (idx >> 2)]; u.pm = idx >> 2; u.pn = idx & 3; u.e = (int)(ent >> 16); u.blk = (int)(ent & 0xffffu); return true; }
    DI const char* a_base(const pg8::Unit&) const { return Hh; }
    DI const char* b_base(const pg8::Unit& u) const { return WM1 + ((size_t)u.e * 1024 + (size_t)u.pn * 256) * 1024 * 2; }
    DI unsigned a_off(const pg8::Unit& u, int row) const { const unsigned r = (unsigned)(u.blk * 256 + row), cnt = META[33 + u.e];
        const int a = r < cnt ? SORT[META[1 + u.e] + r] : 0; return (unsigned)(a >> 1) * 2048u; }
};
struct EpiMoe1 {
    static constexpr bool PERM = true;
    bf16_t* HID; const unsigned* META;
    DI void operator()(const f32x4 (&acc)[2][2][4][2], const pg8::Unit& u, int wr, int wc, int fr, int fq) const {
        const unsigned cnt = META[33 + u.e], st = META[1 + u.e];
        const int col0 = 128 * u.pn + wc * 32 + 8 * fq;
#pragma unroll
        for (int ai = 0; ai < 2; ++ai)
#pragma unroll
            for (int m = 0; m < 4; ++m) { const unsigned r = (unsigned)(u.blk * 256 + ai * 128 + wr * 64 + m * 16 + fr);
                if (r < cnt) { const f32x4 a0 = acc[ai][0][m][0], a1 = acc[ai][0][m][1], b0 = acc[ai][1][m][0], b1 = acc[ai][1][m][1];
                    u32x4 w; w.x = pk2(siluf_(a0[0]) * b0[0], siluf_(a0[1]) * b0[1]); w.y = pk2(siluf_(a0[2]) * b0[2], siluf_(a0[3]) * b0[3]);
                    w.z = pk2(siluf_(a1[0]) * b1[0], siluf_(a1[1]) * b1[1]); w.w = pk2(siluf_(a1[2]) * b1[2], siluf_(a1[3]) * b1[3]);
                    *(u32x4*)(HID + (size_t)(st + r) * 512 + col0) = w; } }
    }
};
struct MoeProb2 {
    const char* HID; const char* WM2; const unsigned* META; int lda, ldb, nt, G, c;
    DI bool next(int i, pg8::Unit& u) const { const int idx = i * G + c; const int nu = (int)META[0]; if (idx >= nu * 4) return false;
        const unsigned ent = META[65 + (idx >> 2)]; u.pm = idx >> 2; u.pn = idx & 3; u.e = (int)(ent >> 16); u.blk = (int)(ent & 0xffffu); return true; }
    DI const char* a_base(const pg8::Unit& u) const { return HID + ((size_t)META[1 + u.e] + (size_t)u.blk * 256) * 512 * 2; }
    DI const char* b_base(const pg8::Unit& u) const { return WM2 + ((size_t)u.e * 1024 + (size_t)u.pn * 256) * 512 * 2; }
    DI unsigned a_off(const pg8::Unit&, int row) const { return (unsigned)row * 1024u; }
};
struct EpiMoe2 {
    static constexpr bool PERM = true;
    bf16_t* Y; const unsigned* META; const int* SORT; const float* GATE; const float* gt;
    DI void operator()(const f32x4 (&acc)[2][2][4][2], const pg8::Unit& u, int wr, int wc, int fr, int fq) const {
        const unsigned cnt = META[33 + u.e], st = META[1 + u.e];
        const int col0 = 256 * u.pn + wc * 32 + 8 * fq;
#pragma unroll
        for (int ai = 0; ai < 2; ++ai)
#pragma unroll
            for (int m = 0; m < 4; ++m) { const unsigned r = (unsigned)(u.blk * 256 + ai * 128 + wr * 64 + m * 16 + fr);
                if (r < cnt) { const int a = SORT[st + r]; const float gw = GATE[a]; const int b = (a >> 1) / SEQ;
#pragma unroll
                    for (int bj = 0; bj < 2; ++bj) { const f32x4 g0 = *(const f32x4*)(gt + (size_t)b * 6144 + col0 + bj * 128), g1 = *(const f32x4*)(gt + (size_t)b * 6144 + col0 + bj * 128 + 4);
                        const f32x4 v0 = acc[ai][bj][m][0] * g0 * gw, v1 = acc[ai][bj][m][1] * g1 * gw;
                        u32x4 w; w.x = pk2(v0[0], v0[1]); w.y = pk2(v0[2], v0[3]); w.z = pk2(v1[0], v1[1]); w.w = pk2(v1[2], v1[3]);
                        *(u32x4*)(Y + (size_t)a * DM + col0 + bj * 128) = w; } } }
    }
};

DI void phase_final(const Frame& F, CArgs& A) {
    const bf16_t* Y = (const bf16_t*)(A.ws + WS_Y);
    for (size_t i = (size_t)F.bid * NTHR + F.tid; i < (size_t)T * DM / 4; i += (size_t)F.G * NTHR) {
        const size_t row = i >> 8, col = (i & 255) * 4;
        f32x4 v = *(const f32x4*)(A.out + row * DM + col);
        const u32x2 y0 = *(const u32x2*)(Y + (2 * row) * DM + col), y1 = *(const u32x2*)(Y + (2 * row + 1) * DM + col);
        v[0] += bflo(y0.x) + bflo(y1.x); v[1] += bfhi(y0.x) + bfhi(y1.x); v[2] += bflo(y0.y) + bflo(y1.y); v[3] += bfhi(y0.y) + bfhi(y1.y);
        *(f32x4*)(A.out + row * DM + col) = v;
    }
}

constexpr int NPL = 21, NPH = 1 + 2 * NPL + 1;
__global__ void __launch_bounds__(NTHR, 2) mk_fwd(Args args) {
    extern __shared__ __attribute__((aligned(16))) unsigned char lds_raw[];
    LAS unsigned char* const ldsb = (LAS unsigned char*)lds_raw;
    const int wave0 = __builtin_amdgcn_readfirstlane(threadIdx.x >> 6);
    volatile LAS unsigned* MISC = (volatile LAS unsigned*)(ldsb + MISC_OFF);
    if (threadIdx.x < 64) MISC[threadIdx.x] = 0u;
    __syncthreads();
    XcdBarrier bar; bar.bar = (unsigned*)(args.ws + WS_CTL) + CW_BAR; bar.x = 0; bar.st = nullptr;
    if (args.use_bar) bar = xcd_barrier_post((unsigned*)(args.ws + WS_CTL) + CW_BAR, MISC + 8);
    const int lo = args.ph_lo, hi = args.ph_hi;
#define IN(k) (lo <= (k) && (k) < hi)
#define SEAM(k) do { if (IN(k) && IN((k) + 1)) xcd_barrier(bar); } while (0)
    unsigned char* ws = args.ws;
    if (IN(0)) { const Frame F = make_frame(ldsb, wave0); CArgs& AA = *get_args(); phase_prologue(F, AA); } SEAM(0);
    for (int l = 0; l < DEPTH; ++l) {
        const int pb = 1 + l * NPL;
        const float* MODL = (const float*)(ws + WS_MOD) + (size_t)l * 8 * 6144;
        if (IN(pb + 0)) { const Frame F = make_frame(ldsb, wave0); CArgs& AA = *get_args(); phase_norm1(F, AA, l); } SEAM(pb + 0);
        if (IN(pb + 1)) { const Frame F = make_frame(ldsb, wave0); CArgs& AA = *get_args(); pg8::PlainProb P{(const char*)(ws + WS_H), (const char*)(ws + WS_WIN) + (size_t)l * ZS * 1024 * 2, 1024, 1024, 16, 256, 9, F.G, F.bid};
            EpiBf16Plain E{(bf16_t*)(ws + WS_Z), ZS}; pg8::gemm_phase(F.lds, P, E, F.tid); } SEAM(pb + 1);
        if (IN(pb + 2)) { const Frame F = make_frame(ldsb, wave0); CArgs& AA = *get_args(); phase_mla_prep(F, AA, l); } SEAM(pb + 2);
        if (IN(pb + 3)) { const Frame F = make_frame(ldsb, wave0); CArgs& AA = *get_args(); pg8::PlainProb P{(const char*)(ws + WS_AMLA), (const char*)(ws + WS_WMLA) + (size_t)l * 1024 * 512 * 2, 512, 512, 8, 256, 4, F.G, F.bid};
            EpiBf16Plain E{(bf16_t*)(ws + WS_QKVRAW), 1024}; pg8::gemm_phase(F.lds, P, E, F.tid); } SEAM(pb + 3);
        if (IN(pb + 4)) { const Frame F = make_frame(ldsb, wave0); CArgs& AA = *get_args(); phase_mla_post(F, AA, l); } SEAM(pb + 4);
        if (IN(pb + 5)) { const Frame F = make_frame(ldsb, wave0); CArgs& AA = *get_args(); phase_attn(F, AA); } SEAM(pb + 5);
        if (IN(pb + 6)) { const Frame F = make_frame(ldsb, wave0); CArgs& AA = *get_args(); phase_rwkv_prep(F, AA, l); } SEAM(pb + 6);
        if (IN(pb + 7)) { const Frame F = make_frame(ldsb, wave0); CArgs& AA = *get_args(); phase_rwkv_scan(F, AA); } SEAM(pb + 7);
        if (IN(pb + 8)) { const Frame F = make_frame(ldsb, wave0); CArgs& AA = *get_args(); phase_rwkv_fin(F, AA, l); } SEAM(pb + 8);
        if (IN(pb + 9)) { const Frame F = make_frame(ldsb, wave0); CArgs& AA = *get_args(); phase_s5<1>(F, AA, l); } SEAM(pb + 9);
        if (IN(pb + 10)) { const Frame F = make_frame(ldsb, wave0); CArgs& AA = *get_args(); phase_s5<2>(F, AA, l); } SEAM(pb + 10);
        if (IN(pb + 11)) { const Frame F = make_frame(ldsb, wave0); CArgs& AA = *get_args(); pg8::PlainProb P{(const char*)(ws + WS_YS5), (const char*)(ws + WS_WGLU) + (size_t)l * 256 * 256 * 2, 256, 256, 4, 256, 1, F.G, F.bid};
            EpiGlu E{(const bf16_t*)(ws + WS_YS5), (bf16_t*)(ws + WS_YS5G), AA.in[27] + l * 256}; pg8::gemm_phase(F.lds, P, E, F.tid); } SEAM(pb + 11);
        if (IN(pb + 12)) { const Frame F = make_frame(ldsb, wave0); CArgs& AA = *get_args(); phase_lru_prep(F, AA, l); } SEAM(pb + 12);
        if (IN(pb + 13)) { const Frame F = make_frame(ldsb, wave0); CArgs& AA = *get_args(); phase_lru_sum(F, AA); } SEAM(pb + 13);
        if (IN(pb + 14)) { const Frame F = make_frame(ldsb, wave0); CArgs& AA = *get_args(); phase_lru_fin(F, AA); } SEAM(pb + 14);
        if (IN(pb + 15)) { const Frame F = make_frame(ldsb, wave0); CArgs& AA = *get_args(); phase_branch_norm(F, AA, l); } SEAM(pb + 15);
        if (IN(pb + 16)) { const Frame F = make_frame(ldsb, wave0); CArgs& AA = *get_args(); pg8::PlainProb P{(const char*)(ws + WS_MIX), (const char*)(ws + WS_WOUT) + (size_t)l * 1024 * 1024 * 2, 1024, 1024, 16, 256, 4, F.G, F.bid};
            EpiResGate E{l == 0 ? AA.in[0] : AA.out, AA.out, MODL + 2048}; pg8::gemm_phase(F.lds, P, E, F.tid); } SEAM(pb + 16);
        if (IN(pb + 17)) { const Frame F = make_frame(ldsb, wave0); CArgs& AA = *get_args(); phase_norm2_router(F, AA, l); } SEAM(pb + 17);
        if (IN(pb + 18)) { const Frame F = make_frame(ldsb, wave0); CArgs& AA = *get_args(); phase_moe_scatter(F, AA, l); } SEAM(pb + 18);
        const unsigned* META = (const unsigned*)(ws + WS_CTL) + CW_UTAB + l * 1024;
        if (IN(pb + 19)) { const Frame F = make_frame(ldsb, wave0); CArgs& AA = *get_args(); MoeProb1 P{(const char*)(ws + WS_H), (const char*)(ws + WS_WM1), META, (const int*)(ws + WS_RT_SORT), 1024, 1024, 16, F.G, F.bid};
            EpiMoe1 E{(bf16_t*)(ws + WS_HID), META}; pg8::gemm_phase(F.lds, P, E, F.tid); } SEAM(pb + 19);
        if (IN(pb + 20)) { const Frame F = make_frame(ldsb, wave0); CArgs& AA = *get_args(); MoeProb2 P{(const char*)(ws + WS_HID), (const char*)(ws + WS_WM2), META, 512, 512, 8, F.G, F.bid};
            EpiMoe2 E{(bf16_t*)(ws + WS_Y), META, (const int*)(ws + WS_RT_SORT), (const float*)(ws + WS_RT_GATE), MODL + 5120}; pg8::gemm_phase(F.lds, P, E, F.tid); } SEAM(pb + 20);
    }
    if (IN(NPH - 1)) { const Frame F = make_frame(ldsb, wave0); CArgs& AA = *get_args(); phase_final(F, AA); }
#undef IN
#undef SEAM
}

extern "C" void kernel_launch(void* const* d_in, const int* in_sizes, int n_in, void* d_out, int out_size, void* d_ws, size_t ws_size, hipStream_t stream) {
    static int grid = 0;
    if (grid == 0) {
        if (n_in != 51 || ws_size < WS_END) { fprintf(stderr, "kernel_launch: unexpected inputs (n_in %d, ws %zu)\n", n_in, ws_size); grid = -1; return; }
        int dev = 0, cus = 0;
        if (hipGetDevice(&dev) != hipSuccess || hipDeviceGetAttribute(&cus, hipDeviceAttributeMultiprocessorCount, dev) != hipSuccess) { grid = -1; return; }
        if (hipFuncSetAttribute((const void*)mk_fwd, hipFuncAttributeMaxDynamicSharedMemorySize, LDS_BYTES) != hipSuccess) { fprintf(stderr, "kernel_launch: hipFuncSetAttribute failed\n"); grid = -1; return; }
        grid = cus;
    }
    if (grid < 0) return;
    (void)hipMemsetAsync((char*)d_ws + WS_CTL, 0, CTL_ZERO_BYTES, stream);
    Args a{};
    for (int i = 0; i < 51; ++i) a.in[i] = (const float*)d_in[i];
    a.pos_off = (const int*)d_in[2]; a.out = (float*)d_out; a.ws = (unsigned char*)d_ws; a.use_bar = 0; a.pad = 0;
    for (int p = 0; p < NPH; ++p) { a.ph_lo = p; a.ph_hi = p + 1; hipLaunchKernelGGL(mk_fwd, dim3(grid), dim3(NTHR), LDS_BYTES, stream, a); }
}
```

```cpp
#include <hip/hip_runtime.h>
#include <cstdio>
#include <cstdint>

#define LAS __attribute__((address_space(3)))
#define GAS __attribute__((address_space(1)))
#define DI __device__ __forceinline__
typedef unsigned short bf16_t;
typedef short bf16x8 __attribute__((ext_vector_type(8)));
typedef short s16x4 __attribute__((ext_vector_type(4)));
typedef float f32x4 __attribute__((ext_vector_type(4)));
typedef float f32x2 __attribute__((ext_vector_type(2)));
typedef float f32x16 __attribute__((ext_vector_type(16)));
typedef unsigned u32x4 __attribute__((ext_vector_type(4)));
typedef unsigned u32x2 __attribute__((ext_vector_type(2)));
typedef __bf16 bf16x2_t __attribute__((ext_vector_type(2)));

constexpr int NB = 8, SEQ = 8192, DM = 1024, T = NB * SEQ, DEPTH = 2;
constexpr int WG = 256;
constexpr int ZS = 2304;
constexpr int ZC_R = 0, ZC_K = 256, ZC_V = 512, ZC_WLO = 768, ZC_ALO = 800, ZC_GLO = 832, ZC_S5 = 896, ZC_QA = 1152, ZC_KVA = 1408, ZC_KPE = 1536, ZC_LX = 1568, ZC_LG = 1824, D_IN = 2080;
constexpr int NEXP = 32, DFF = 512;
constexpr float NORM_EPS = 1e-6f;

DI unsigned f2bf(float f) { unsigned u = __float_as_uint(f); return (u + 0x7fffu + ((u >> 16) & 1u)) >> 16; }
DI unsigned pk2(float lo, float hi) { f32x2 v = {lo, hi}; bf16x2_t b = __builtin_convertvector(v, bf16x2_t); return __builtin_bit_cast(unsigned, b); }
DI float bflo(unsigned u) { return __uint_as_float(u << 16); }
DI float bfhi(unsigned u) { return __uint_as_float(u & 0xffff0000u); }
DI float bf2f(bf16_t b) { return __uint_as_float(((unsigned)b) << 16); }
DI int lane_opaque() { int l = __builtin_amdgcn_mbcnt_hi(-1, __builtin_amdgcn_mbcnt_lo(-1, 0)); asm volatile("" : "+v"(l)); return l; }
DI float shfl_xor_l(float v, int o, int lane) { return __int_as_float(__builtin_amdgcn_ds_bpermute((lane ^ o) << 2, __float_as_int(v))); }
DI float wave_sum(float v) {
    const int l = lane_opaque();
#pragma unroll
    for (int o = 1; o < 64; o <<= 1) v += shfl_xor_l(v, o, l);
    return v;
}
DI float sigmoidf_(float x) { return 1.f / (1.f + __expf(-x)); }
DI float softplusf_(float x) { return fmaxf(x, 0.f) + log1pf(__expf(-fabsf(x))); }
DI float gelu_tanh(float x) { const float u = 0.7978845608028654f * (x + 0.044715f * x * x * x); return 0.5f * x * (1.f + tanhf(u)); }
DI float siluf_(float x) { return x / (1.f + __expf(-x)); }

namespace pg8 {
constexpr int BM = 256, BK = 64, HALF = 128, HTB = HALF * BK * 2, STAGE_BYTES = 8 * HTB;
DI int lds_byte(int r, int c) { const int st = (r >> 4) * 2 + (c >> 5), rr = r & 15, cc = c & 31, ob = rr * 64 + cc * 2; return st * 1024 + (ob ^ (((ob >> 9) & 1) << 5)); }
DI void stage_rc(int b, int& R, int& C) { const int st = b / 1024, sb = b % 1024, swz = sb ^ (((sb >> 9) & 1) << 5); R = (st >> 1) * 16 + swz / 64; C = (st & 1) * 32 + (swz % 64) / 2; }
DI int perm32(int rho) { const int n = rho >> 4, i = rho & 15; return 8 * (i >> 2) + 4 * n + (i & 3); }

struct Unit { int pm, pn, e, blk; };

template <class Epi, class P>
DI void gemm_phase(LAS unsigned char* lds, const P& S, const Epi& E, int tid_in) {
    const int tid = tid_in, wid = __builtin_amdgcn_readfirstlane(tid >> 6), lane = tid & 63, wr = wid >> 2, wc = wid & 3, fr = lane & 15, fq = lane >> 4;
    const int nt = S.nt;
    int Rr[2], Cc[2];
    unsigned voffB[2], offC[2][2], offN[2][2];
#pragma unroll
    for (int i = 0; i < 2; ++i) { int R, C; stage_rc(tid * 16 + i * 8192, R, C); Rr[i] = R; Cc[i] = C; const int Rb = Epi::PERM ? ((R & ~31) + perm32(R & 31)) : R;
        voffB[i] = (unsigned)(Rb * S.ldb + C) * 2u; }
    const size_t kstep = (size_t)(BK * 2);
    const size_t hstepB = (size_t)HALF * S.ldb * 2;
    const unsigned ldsw = (unsigned)wid * 1024u;
    const int aoff = lds_byte(wr * 64 + fr, fq * 8), boff = lds_byte(wc * 32 + fr, fq * 8);
#define PG8_SA(b, h) (((b) * 2 + (h)) * HTB)
#define PG8_SB(b, h) ((4 + (b) * 2 + (h)) * HTB)
#define PG8_STAGE(bufoff, gbase, voff) do { _Pragma("unroll") for (int _i = 0; _i < 2; ++_i) \
        __builtin_amdgcn_global_load_lds((const unsigned*)((const char*)(gbase) + (voff)[_i]), (LAS unsigned*)(lds + (bufoff) + ldsw + _i * 8192), 16, 0, 0); } while (0)
#define PG8_LDA(dst, b, h) do { _Pragma("unroll") for (int m = 0; m < 4; ++m) _Pragma("unroll") for (int k = 0; k < 2; ++k) dst[m][k] = *(const LAS bf16x8*)(lds + PG8_SA(b, h) + aoff + m * 2048 + k * 1024); } while (0)
#define PG8_LDB(dst, b, h) do { _Pragma("unroll") for (int n = 0; n < 2; ++n) _Pragma("unroll") for (int k = 0; k < 2; ++k) dst[n][k] = *(const LAS bf16x8*)(lds + PG8_SB(b, h) + boff + n * 2048 + k * 1024); } while (0)
#define PG8_MMA(ai, bj, At, Bt) do { __builtin_amdgcn_s_setprio(1); _Pragma("unroll") for (int m = 0; m < 4; ++m) _Pragma("unroll") for (int n = 0; n < 2; ++n) _Pragma("unroll") for (int k = 0; k < 2; ++k) \
        acc[ai][bj][m][n] = __builtin_amdgcn_mfma_f32_16x16x32_bf16(Bt[n][k], At[m][k], acc[ai][bj][m][n], 0, 0, 0); __builtin_amdgcn_s_setprio(0); } while (0)
#define PG8_WAIT_V(n) asm volatile("s_waitcnt vmcnt(" #n ")" ::: "memory")
#define PG8_WAIT_L(n) asm volatile("s_waitcnt lgkmcnt(" #n ")" ::: "memory")
#define PG8_BAR __builtin_amdgcn_s_barrier()
#define PG8_SCHED __builtin_amdgcn_sched_barrier(0)
    Unit cur, nxt; int ui = 0;
    if (!S.next(0, cur)) return;
    f32x4 acc[2][2][4][2];
#pragma unroll
    for (int a = 0; a < 2; ++a)
#pragma unroll
        for (int b = 0; b < 2; ++b)
#pragma unroll
            for (int m = 0; m < 4; ++m)
#pragma unroll
                for (int n = 0; n < 2; ++n) acc[a][b][m][n] = (f32x4){0.f, 0.f, 0.f, 0.f};
    bf16x8 At[4][2], B0[2][2], B1[2][2];
    const char* cA = S.a_base(cur); const char* cB = S.b_base(cur);
#pragma unroll
    for (int h = 0; h < 2; ++h)
#pragma unroll
        for (int i = 0; i < 2; ++i) { offC[h][i] = S.a_off(cur, h * HALF + Rr[i]) + (unsigned)Cc[i] * 2u; offN[h][i] = offC[h][i]; }
    PG8_STAGE(PG8_SB(0, 0), cB, voffB); PG8_STAGE(PG8_SB(0, 1), cB + hstepB, voffB); PG8_STAGE(PG8_SA(0, 0), cA, offC[0]); PG8_STAGE(PG8_SA(0, 1), cA, offC[1]);
    if (wr == 1) PG8_BAR;
    PG8_WAIT_V(2); PG8_BAR;
    PG8_STAGE(PG8_SB(1, 0), cB + kstep, voffB); PG8_STAGE(PG8_SA(1, 0), cA + kstep, offC[0]); PG8_STAGE(PG8_SB(1, 1), cB + hstepB + kstep, voffB);
    PG8_WAIT_V(6); PG8_BAR;
    for (;;) {
        const bool has_next = S.next(ui + 1, nxt);
        const char* nA = has_next ? S.a_base(nxt) : cA; const char* nB = has_next ? S.b_base(nxt) : cB;
        for (int t = 0; t < nt; t += 2) {
            const bool last = (t == nt - 2);
            const char* a1 = cA + (size_t)(t + 1) * kstep;
            const char* a2 = last ? nA : cA + (size_t)(t + 2) * kstep; const char* b2 = last ? nB : cB + (size_t)(t + 2) * kstep;
            const char* a3 = a2 + kstep; const char* b3 = b2 + kstep;
            if (last && has_next) {
#pragma unroll
                for (int h = 0; h < 2; ++h)
#pragma unroll
                    for (int i = 0; i < 2; ++i) offN[h][i] = S.a_off(nxt, h * HALF + Rr[i]) + (unsigned)Cc[i] * 2u;
            }
            unsigned o2[2][2];
#pragma unroll
            for (int h = 0; h < 2; ++h)
#pragma unroll
                for (int i = 0; i < 2; ++i) o2[h][i] = last ? offN[h][i] : offC[h][i];
            PG8_LDB(B0, 0, 0); PG8_LDB(B1, 0, 1); PG8_SCHED; PG8_LDA(At, 0, 0); PG8_STAGE(PG8_SA(1, 1), a1, offC[1]);
            PG8_WAIT_V(8); PG8_WAIT_L(0); PG8_BAR; PG8_MMA(0, 0, At, B0); PG8_MMA(0, 1, At, B1); PG8_BAR; PG8_SCHED;
            PG8_LDA(At, 0, 1); PG8_STAGE(PG8_SB(0, 0), b2, voffB); PG8_STAGE(PG8_SB(0, 1), b2 + hstepB, voffB); PG8_STAGE(PG8_SA(0, 0), a2, o2[0]);
            PG8_WAIT_V(8); PG8_WAIT_L(0); PG8_BAR; PG8_MMA(1, 0, At, B0); PG8_MMA(1, 1, At, B1); PG8_BAR; PG8_SCHED;
            PG8_LDB(B0, 1, 0); PG8_LDB(B1, 1, 1); PG8_SCHED; PG8_LDA(At, 1, 0); PG8_STAGE(PG8_SA(0, 1), a2, o2[1]);
            PG8_WAIT_V(8); PG8_WAIT_L(0); PG8_BAR; PG8_MMA(0, 0, At, B0); PG8_MMA(0, 1, At, B1); PG8_BAR; PG8_SCHED;
            PG8_LDA(At, 1, 1); PG8_STAGE(PG8_SB(1, 0), b3, voffB); PG8_STAGE(PG8_SB(1, 1), b3 + hstepB, voffB); PG8_STAGE(PG8_SA(1, 0), a3, o2[0]);
            PG8_WAIT_V(8); PG8_WAIT_L(0); PG8_BAR; PG8_MMA(1, 0, At, B0); PG8_MMA(1, 1, At, B1); PG8_BAR; PG8_SCHED;
        }
        if (wr == 0) PG8_BAR;
        E(acc, cur, wr, wc, fr, fq);
        if (!has_next) break;
#pragma unroll
        for (int a = 0; a < 2; ++a)
#pragma unroll
            for (int b = 0; b < 2; ++b)
#pragma unroll
                for (int m = 0; m < 4; ++m)
#pragma unroll
                    for (int n = 0; n < 2; ++n) acc[a][b][m][n] = (f32x4){0.f, 0.f, 0.f, 0.f};
        cur = nxt; cA = nA; cB = nB; ++ui;
#pragma unroll
        for (int h = 0; h < 2; ++h)
#pragma unroll
            for (int i = 0; i < 2; ++i) offC[h][i] = offN[h][i];
        if (wr == 1) PG8_BAR;
    }
    PG8_WAIT_V(0);
    PG8_BAR;
#undef PG8_SA
#undef PG8_SB
#undef PG8_STAGE
#undef PG8_LDA
#undef PG8_LDB
#undef PG8_MMA
#undef PG8_WAIT_V
#undef PG8_WAIT_L
#undef PG8_BAR
#undef PG8_SCHED
}

struct PlainProb {
    const char* A; const char* Bt; int lda, ldb, nt, nM, nN, G, c;
    DI bool next(int i, Unit& u) const {
        const long L = (long)i * G + c; const int nwg = nM * nN; if (L >= nwg) return false;
        int wgid = (int)L; { const int q = nwg / 8, r = nwg % 8, xcd = wgid % 8, off = wgid / 8; wgid = (xcd < r ? xcd * (q + 1) : r * (q + 1) + (xcd - r) * q) + off; }
        const int nig = 8 * nN, gid = wgid / nig, fm = gid * 8, gsz = (nM - fm) < 8 ? (nM - fm) : 8;
        u.pm = fm + ((wgid % nig) % gsz); u.pn = (wgid % nig) / gsz; u.e = 0; u.blk = 0; return true;
    }
    DI const char* a_base(const Unit& u) const { return A + (size_t)u.pm * 256 * lda * 2; }
    DI const char* b_base(const Unit& u) const { return Bt + (size_t)u.pn * 256 * ldb * 2; }
    DI unsigned a_off(const Unit&, int row) const { return (unsigned)row * (unsigned)lda * 2u; }
};
}

constexpr size_t MiB = 1u << 20;
constexpr size_t WS_CTL = 0, CTL_ZERO_BYTES = 1 * MiB;
constexpr size_t WS_MOD = 1 * MiB;
constexpr size_t WS_RT_EID = 3 * MiB;
constexpr size_t WS_RT_GATE = WS_RT_EID + 512 * 1024;
constexpr size_t WS_RT_PIE = WS_RT_GATE + 512 * 1024;
constexpr size_t WS_RT_SORT = WS_RT_PIE + 512 * 1024;
constexpr size_t WS_WIN = 8 * MiB;
constexpr size_t WS_WOUT = 17 * MiB;
constexpr size_t WS_WMLA = 21 * MiB;
constexpr size_t WS_WGLU = 23 * MiB;
constexpr size_t WS_H = 24 * MiB;
constexpr size_t WS_Z = 152 * MiB;
constexpr size_t WS_WM1 = WS_Z;
constexpr size_t WS_WM2 = WS_Z + 64 * MiB;
constexpr size_t WS_MIX = 440 * MiB;
constexpr size_t WS_HID = WS_MIX;
constexpr size_t WS_Y = 569 * MiB;
constexpr size_t WS_Q = 825 * MiB;
constexpr size_t WS_K = 873 * MiB;
constexpr size_t WS_VT = 921 * MiB;
constexpr size_t WS_TAIL = 953 * MiB;
constexpr size_t WS_END = 1017 * MiB;
constexpr size_t WS_AMLA = WS_TAIL;
constexpr size_t WS_QKVRAW = WS_Y;
constexpr size_t WS_ATTO = WS_H;
constexpr size_t WS_RW_R = WS_Y, WS_RW_K = WS_Y + 32 * MiB, WS_RW_V = WS_Y + 64 * MiB, WS_RW_KK = WS_Y + 96 * MiB, WS_RW_B = WS_Y + 128 * MiB, WS_RW_G = WS_Y + 160 * MiB;
constexpr size_t WS_RW_W = WS_Y + 192 * MiB;
constexpr size_t WS_RW_Y = WS_H + 32 * MiB;
constexpr size_t WS_YS5 = WS_H + 96 * MiB;
constexpr size_t WS_YS5G = WS_TAIL;
constexpr size_t WS_YL = WS_TAIL + 32 * MiB;
constexpr size_t WS_LA = WS_Y, WS_LB = WS_Y + 64 * MiB;
constexpr size_t WS_S5END = 2 * MiB;
constexpr size_t WS_LSUM = 5 * MiB + 512 * 1024;
static_assert(WS_RT_SORT + 512 * 1024 <= WS_LSUM && WS_LSUM + 2 * MiB <= WS_WIN && WS_S5END + 1 * MiB <= WS_RT_EID, "map");

constexpr int CW_BAR = 4096;
constexpr int CW_CNT = 16384;
constexpr int CW_UTAB = 20480;

constexpr int NWAVES = 8, NTHR = 512;
constexpr int LDS_BYTES = 155648;
constexpr int MISC_OFF = 155648 - 256;

struct Args { const float* in[51]; const int* pos_off; float* out; unsigned char* ws; int ph_lo, ph_hi, use_bar, pad; };
typedef const __attribute__((address_space(4))) Args CArgs;
DI CArgs* get_args() { CArgs* ap = (CArgs*)__builtin_amdgcn_kernarg_segment_ptr(); asm volatile("" : "+s"(ap)); return ap; }

#define XB_TMO      128
#define XB_XCNT(j)  (256  + 64 * (j))
#define XB_XSUB(j)  (1280 + 64 * (j))
#define XB_XGEN(j)  (2304 + 64 * (j))
#define XB_TOP      3328
#define XB_TOPGEN   3392
#define XCD_BAR_WORDS 3456
#define XB_SPIN_CAP (1u << 18)
DI unsigned xb_ld(unsigned* p)              { return __hip_atomic_load(p, __ATOMIC_RELAXED, __HIP_MEMORY_SCOPE_AGENT); }
DI unsigned xb_add(unsigned* p, unsigned v) { return __hip_atomic_fetch_add(p, v, __ATOMIC_RELAXED, __HIP_MEMORY_SCOPE_AGENT); }
DI unsigned xb_xcc_id() { return (unsigned)__builtin_amdgcn_s_getreg((3 << 11) | 20) & 0xFu; }
#define XB_SPIN(cond, bar) do { unsigned _sp = 0; while (cond) { __builtin_amdgcn_s_sleep(1); \
    if ((++_sp & 255u) == 0u) { if (xb_ld(&(bar)[XB_TMO])) break; if (_sp > XB_SPIN_CAP) { atomicAdd(&(bar)[XB_TMO], 1u); break; } } } } while (0)
struct XcdBarrier { unsigned* bar; unsigned x; volatile LAS unsigned* st; };
DI XcdBarrier xcd_barrier_post(unsigned* bar, volatile LAS unsigned* st) {
    XcdBarrier b; b.bar = bar; b.x = xb_xcc_id(); b.st = st;
    if (threadIdx.x == 0) (void)xb_add(&bar[XB_XCNT(b.x)], 1u);
    return b;
}
DI void xcd_barrier_complete(unsigned* bar, unsigned x, unsigned& nloc, unsigned& nx) {
    const unsigned G = gridDim.x * gridDim.y * gridDim.z;
    unsigned sum, cnt, mine, sp = 0u;
    for (;;) {
        sum = 0u; cnt = 0u; mine = 0u;
#pragma unroll
        for (unsigned j = 0; j < 16; ++j) { const unsigned c = xb_ld(&bar[XB_XCNT(j)]); sum += c; cnt += (c > 0u) ? 1u : 0u; mine = (j == x) ? c : mine; }
        if (sum == G) break;
        __builtin_amdgcn_s_sleep(1);
        if ((++sp & 255u) == 0u) { if (xb_ld(&bar[XB_TMO])) break; if (sp > XB_SPIN_CAP) { atomicAdd(&bar[XB_TMO], 1u); break; } }
    }
    nloc = mine > 0u ? mine : 1u; nx = cnt > 0u ? cnt : 1u;
}
DI void xcd_barrier(const XcdBarrier& b) {
    asm volatile("s_waitcnt vmcnt(0)" ::: "memory");
    __syncthreads();
    if (threadIdx.x == 0) {
        unsigned* bar = b.bar;
        __builtin_amdgcn_s_waitcnt(0);
        unsigned nloc = b.st[0], nx = b.st[1];
        if (nloc == 0u) { xcd_barrier_complete(bar, b.x, nloc, nx); b.st[0] = nloc; b.st[1] = nx; }
        const unsigned old = xb_add(&bar[XB_XSUB(b.x)], 1u);
        const unsigned gen = old / nloc;
        if (old + 1u == (gen + 1u) * nloc) {
            __builtin_amdgcn_fence(__ATOMIC_RELEASE, "agent");
            asm volatile("s_waitcnt vmcnt(0)" ::: "memory");
            const unsigned og = xb_add(&bar[XB_TOP], 1u);
            const unsigned tg = og / nx;
            if (og + 1u == (tg + 1u) * nx) xb_add(&bar[XB_TOPGEN], 1u);
            else XB_SPIN(xb_ld(&bar[XB_TOPGEN]) == tg, bar);
            __builtin_amdgcn_fence(__ATOMIC_ACQUIRE, "agent");
            xb_add(&bar[XB_XGEN(b.x)], 1u);
            asm volatile("s_waitcnt vmcnt(0)" ::: "memory");
        } else {
            XB_SPIN(xb_ld(&bar[XB_XGEN(b.x)]) == gen, bar);
            __builtin_amdgcn_fence(__ATOMIC_ACQUIRE, "agent");
            asm volatile("s_waitcnt vmcnt(0)" ::: "memory");
        }
    }
    __syncthreads();
}

struct EpiBf16Plain {
    static constexpr bool PERM = true;
    bf16_t* O; int ldc;
    DI void operator()(const f32x4 (&acc)[2][2][4][2], const pg8::Unit& u, int wr, int wc, int fr, int fq) const {
        const int row0 = u.pm * 256 + wr * 64 + fr, col0 = u.pn * 256 + wc * 32 + 8 * fq;
#pragma unroll
        for (int ai = 0; ai < 2; ++ai)
#pragma unroll
            for (int m = 0; m < 4; ++m) { bf16_t* rowp = O + (size_t)(row0 + ai * 128 + m * 16) * ldc + col0;
#pragma unroll
                for (int bj = 0; bj < 2; ++bj) { const f32x4 v0 = acc[ai][bj][m][0], v1 = acc[ai][bj][m][1];
                    u32x4 w; w.x = pk2(v0[0], v0[1]); w.y = pk2(v0[2], v0[3]); w.z = pk2(v1[0], v1[1]); w.w = pk2(v1[2], v1[3]);
                    *(u32x4*)(rowp + bj * 128) = w; } }
    }
};
struct EpiResGate {
    static constexpr bool PERM = false;
    const float* xin; float* out; const float* gt;
    DI void operator()(const f32x4 (&acc)[2][2][4][2], const pg8::Unit& u, int wr, int wc, int fr, int fq) const {
        const int row0 = u.pm * 256 + wr * 64 + fr, col0 = u.pn * 256 + wc * 32 + 4 * fq;
        const int b = (u.pm * 256) / SEQ;
        f32x4 g[2][2];
#pragma unroll
        for (int bj = 0; bj < 2; ++bj)
#pragma unroll
            for (int n = 0; n < 2; ++n) g[bj][n] = *(const f32x4*)(gt + (size_t)b * 6144 + col0 + bj * 128 + n * 16);
#pragma unroll
        for (int ai = 0; ai < 2; ++ai)
#pragma unroll
            for (int m = 0; m < 4; ++m) { const size_t ro = (size_t)(row0 + ai * 128 + m * 16) * DM + col0;
#pragma unroll
                for (int bj = 0; bj < 2; ++bj)
#pragma unroll
                    for (int n = 0; n < 2; ++n) { const f32x4 xv = *(const f32x4*)(xin + ro + bj * 128 + n * 16);
                        *(f32x4*)(out + ro + bj * 128 + n * 16) = xv + g[bj][n] * acc[ai][bj][m][n]; } }
    }
};
struct EpiGlu {
    static constexpr bool PERM = true;
    const bf16_t* Y; bf16_t* O; const float* bias;
    DI void operator()(const f32x4 (&acc)[2][2][4][2], const pg8::Unit& u, int wr, int wc, int fr, int fq) const {
        const int row0 = u.pm * 256 + wr * 64 + fr, col0 = wc * 32 + 8 * fq;
#pragma unroll
        for (int ai = 0; ai < 2; ++ai)
#pragma unroll
            for (int m = 0; m < 4; ++m) { const size_t ro = (size_t)(row0 + ai * 128 + m * 16) * 256 + col0;
#pragma unroll
                for (int bj = 0; bj < 2; ++bj) { const u32x4 yv = *(const u32x4*)(Y + ro + bj * 128);
                    const f32x4 b0 = *(const f32x4*)(bias + col0 + bj * 128), b1 = *(const f32x4*)(bias + col0 + bj * 128 + 4);
                    const f32x4 v0 = acc[ai][bj][m][0] + b0, v1 = acc[ai][bj][m][1] + b1;
                    u32x4 w;
                    w.x = pk2(bflo(yv.x) * sigmoidf_(v0[0]), bfhi(yv.x) * sigmoidf_(v0[1]));
                    w.y = pk2(bflo(yv.y) * sigmoidf_(v0[2]), bfhi(yv.y) * sigmoidf_(v0[3]));
                    w.z = pk2(bflo(yv.z) * sigmoidf_(v1[0]), bfhi(yv.z) * sigmoidf_(v1[1]));
                    w.w = pk2(bflo(yv.w) * sigmoidf_(v1[2]), bfhi(yv.w) * sigmoidf_(v1[3]));
                    *(u32x4*)(O + ro + bj * 128) = w; } }
    }
};

struct Frame { LAS unsigned char* lds; int tid, lane, wave, G, bid, gw, ngw; };

DI Frame make_frame(LAS unsigned char* lds, int wave0) {
    Frame F; F.lds = lds; int w = wave0; asm volatile("" : "+s"(w)); F.wave = w; F.lane = lane_opaque(); F.tid = w * 64 + F.lane;
    F.G = gridDim.x; F.bid = blockIdx.x; F.gw = F.bid * NWAVES + F.wave; F.ngw = F.G * NWAVES; return F;
}
DI void transpose_item(const float* src, int ld_src, int k0, int n0, bf16_t* dst, int ldd, int nd0, int kd0, LAS float* scr, int lane) {
#pragma unroll 8
    for (int i = 0; i < 32; ++i) { const int kk = 2 * i + (lane >> 5); scr[kk * 33 + (lane & 31)] = src[(size_t)(k0 + kk) * ld_src + n0 + (lane & 31)]; }
    asm volatile("s_waitcnt lgkmcnt(0)" ::: "memory");
    const int c = lane & 7;
#pragma unroll
    for (int j = 0; j < 4; ++j) { const int n = (lane >> 3) + 8 * j; const LAS float* s = scr + (8 * c) * 33 + n;
        u32x4 o; o.x = pk2(s[0 * 33], s[1 * 33]); o.y = pk2(s[2 * 33], s[3 * 33]); o.z = pk2(s[4 * 33], s[5 * 33]); o.w = pk2(s[6 * 33], s[7 * 33]);
        *(u32x4*)(dst + (size_t)(nd0 + n) * ldd + kd0 + 8 * c) = o; }
    asm volatile("s_waitcnt lgkmcnt(0)" ::: "memory");
}
DI void zero_rows(bf16_t* dst, int ld, int r0, int nr, int c0, int nc, int gw, int ngw, int lane) {
    for (int r = gw; r < nr; r += ngw) for (int c = lane * 8; c < nc; c += 512) *(u32x4*)(dst + (size_t)(r0 + r) * ld + c0 + c) = (u32x4){0u, 0u, 0u, 0u};
}

DI void phase_prologue(const Frame& F, CArgs& A) {
    unsigned char* ws = A.ws;
    LAS float* sc = (LAS float*)F.lds;
    LAS float* part = (LAS float*)(F.lds + 32768);
    for (int i = F.tid; i < 8192; i += NTHR) sc[i] = siluf_(A.in[1][i]);
    __syncthreads();
    float* MOD = (float*)(ws + WS_MOD);
    for (int item = F.bid; item < 192; item += F.G) {
        const int l = item / 96, n0 = (item % 96) * 64, nl = F.tid & 63, kg = F.tid >> 6;
        const float* W = A.in[3] + (size_t)l * 1024 * 6144 + n0 + nl;
        float acc[8];
#pragma unroll
        for (int b = 0; b < 8; ++b) acc[b] = 0.f;
        for (int k = kg * 128; k < kg * 128 + 128; ++k) { const float w = W[(size_t)k * 6144];
#pragma unroll
            for (int b = 0; b < 8; ++b) acc[b] += sc[b * 1024 + k] * w; }
#pragma unroll
        for (int b = 0; b < 8; ++b) part[(kg * 8 + b) * 64 + nl] = acc[b];
        __syncthreads();
        { const int b = F.tid >> 6; float s = A.in[4][l * 6144 + n0 + nl];
#pragma unroll
          for (int g = 0; g < 8; ++g) s += part[(g * 8 + b) * 64 + nl];
          MOD[((size_t)l * 8 + b) * 6144 + n0 + nl] = s; }
        __syncthreads();
    }
    LAS float* scr = (LAS float*)(F.lds + F.wave * 8448);
    bf16_t* WIN = (bf16_t*)(ws + WS_WIN); bf16_t* WOUT = (bf16_t*)(ws + WS_WOUT); bf16_t* WMLA = (bf16_t*)(ws + WS_WMLA); bf16_t* WGLU = (bf16_t*)(ws + WS_WGLU);
    constexpr int I_IN = 16 * 65, I_OUT = 16 * 32, I_Q = 4 * 12, I_KV = 2 * 16, I_GLU = 4 * 8, I_L = I_IN + I_OUT + I_Q + I_KV + I_GLU;
    for (int it = F.gw; it < 2 * I_L; it += F.ngw) {
        const int l = it / I_L; int r = it % I_L;
        if (r < I_IN) { transpose_item(A.in[6] + (size_t)l * 1024 * D_IN, D_IN, 64 * (r / 65), 32 * (r % 65), WIN + (size_t)l * ZS * 1024, 1024, 32 * (r % 65), 64 * (r / 65), scr, F.lane); continue; } r -= I_IN;
        if (r < I_OUT) { transpose_item(A.in[42] + (size_t)l * 1024 * 1024, 1024, 64 * (r / 32), 32 * (r % 32), WOUT + (size_t)l * 1024 * 1024, 1024, 32 * (r % 32), 64 * (r / 32), scr, F.lane); continue; } r -= I_OUT;
        if (r < I_Q) { transpose_item(A.in[29] + (size_t)l * 256 * 384, 384, 64 * (r / 12), 32 * (r % 12), WMLA + (size_t)l * 1024 * 512, 512, 32 * (r % 12), 64 * (r / 12), scr, F.lane); continue; } r -= I_Q;
        if (r < I_KV) { transpose_item(A.in[31] + (size_t)l * 128 * 512, 512, 64 * (r / 16), 32 * (r % 16), WMLA + (size_t)l * 1024 * 512, 512, 384 + 32 * (r % 16), 256 + 64 * (r / 16), scr, F.lane); continue; } r -= I_KV;
        transpose_item(A.in[26] + (size_t)l * 256 * 256, 256, 64 * (r / 8), 32 * (r % 8), WGLU + (size_t)l * 256 * 256, 256, 32 * (r % 8), 64 * (r / 8), scr, F.lane);
    }
    for (int l = 0; l < 2; ++l) {
        zero_rows(WIN + (size_t)l * ZS * 1024, 1024, D_IN, ZS - D_IN, 0, 1024, F.gw, F.ngw, F.lane);
        bf16_t* wm = WMLA + (size_t)l * 1024 * 512;
        zero_rows(wm, 512, 0, 384, 256, 256, F.gw, F.ngw, F.lane);
        zero_rows(wm, 512, 384, 512, 0, 256, F.gw, F.ngw, F.lane);
        zero_rows(wm, 512, 384, 512, 384, 128, F.gw, F.ngw, F.lane);
        zero_rows(wm, 512, 896, 128, 0, 512, F.gw, F.ngw, F.lane);
    }
}

DI void phase_norm1(const Frame& F, CArgs& A, int l) {
    const float* MODL = (const float*)(A.ws + WS_MOD) + (size_t)l * 8 * 6144;
    const float* g = A.in[5] + l * 1024;
    const bf16_t* Y = (const bf16_t*)(A.ws + WS_Y);
    bf16_t* H = (bf16_t*)(A.ws + WS_H);
    const float* src = (l == 0) ? A.in[0] : A.out;
    for (int row = F.gw; row < T; row += F.ngw) {
        const int b = row / SEQ;
        f32x4 v[4]; float ss = 0.f;
#pragma unroll
        for (int j = 0; j < 4; ++j) { const int col = 4 * (64 * j + F.lane);
            v[j] = *(const f32x4*)(src + (size_t)row * DM + col);
            if (l > 0) { const u32x2 y0 = *(const u32x2*)(Y + (size_t)(2 * row) * DM + col), y1 = *(const u32x2*)(Y + (size_t)(2 * row + 1) * DM + col);
                v[j][0] += bflo(y0.x) + bflo(y1.x); v[j][1] += bfhi(y0.x) + bfhi(y1.x); v[j][2] += bflo(y0.y) + bflo(y1.y); v[j][3] += bfhi(y0.y) + bfhi(y1.y);
                *(f32x4*)(A.out + (size_t)row * DM + col) = v[j]; }
            ss += v[j][0] * v[j][0] + v[j][1] * v[j][1] + v[j][2] * v[j][2] + v[j][3] * v[j][3]; }
        const float rstd = rsqrtf(wave_sum(ss) * (1.f / DM) + NORM_EPS);
#pragma unroll
        for (int j = 0; j < 4; ++j) { const int col = 4 * (64 * j + F.lane);
            const f32x4 gg = *(const f32x4*)(g + col), sh = *(const f32x4*)(MODL + (size_t)b * 6144 + col), scv = *(const f32x4*)(MODL + (size_t)b * 6144 + 1024 + col);
            const f32x4 hv = v[j] * rstd * gg * (scv + 1.f) + sh;
            u32x2 o; o.x = pk2(hv[0], hv[1]); o.y = pk2(hv[2], hv[3]);
            *(u32x2*)(H + (size_t)row * DM + col) = o; }
    }
}

DI void phase_mla_prep(const Frame& F, CArgs& A, int l) {
    const bf16_t* Z = (const bf16_t*)(A.ws + WS_Z); bf16_t* AM = (bf16_t*)(A.ws + WS_AMLA);
    const float* qg = A.in[28] + l * 256; const float* kg = A.in[30] + l * 128;
    for (int row = F.gw; row < T; row += F.ngw) {
        const bf16_t* zr = Z + (size_t)row * ZS;
        const u32x2 qv = *(const u32x2*)(zr + ZC_QA + 4 * F.lane); const unsigned kv = *(const unsigned*)(zr + ZC_KVA + 2 * F.lane);
        const float q0 = bflo(qv.x), q1 = bfhi(qv.x), q2 = bflo(qv.y), q3 = bfhi(qv.y), k0 = bflo(kv), k1 = bfhi(kv);
        const float rq = rsqrtf(wave_sum(q0 * q0 + q1 * q1 + q2 * q2 + q3 * q3) * (1.f / 256.f) + NORM_EPS);
        const float rk = rsqrtf(wave_sum(k0 * k0 + k1 * k1) * (1.f / 128.f) + NORM_EPS);
        const f32x4 g4 = *(const f32x4*)(qg + 4 * F.lane); const f32x2 g2 = *(const f32x2*)(kg + 2 * F.lane);
        u32x2 o; o.x = pk2(q0 * rq * g4[0], q1 * rq * g4[1]); o.y = pk2(q2 * rq * g4[2], q3 * rq * g4[3]);
        bf16_t* ar = AM + (size_t)row * 512;
        *(u32x2*)(ar + 4 * F.lane) = o;
        *(unsigned*)(ar + 256 + 2 * F.lane) = pk2(k0 * rk * g2[0], k1 * rk * g2[1]);
        *(unsigned*)(ar + 384 + 2 * F.lane) = 0u;
    }
}

DI void phase_mla_post(const Frame& F, CArgs& A, int l) {
    const bf16_t* Z = (const bf16_t*)(A.ws + WS_Z); const bf16_t* RAW = (const bf16_t*)(A.ws + WS_QKVRAW);
    bf16_t* Q = (bf16_t*)(A.ws + WS_Q); bf16_t* K = (bf16_t*)(A.ws + WS_K); bf16_t* VT = (bf16_t*)(A.ws + WS_VT);
    LAS float* cs = (LAS float*)F.lds;
    LAS bf16_t* vt = (LAS bf16_t*)(F.lds + 8192);
    const float* qhg = A.in[32] + l * 96; const float* khg = A.in[33] + l * 96;
    for (int tile = F.bid; tile < T / 64; tile += F.G) {
        const int t0 = tile * 64, b = t0 / SEQ, s0 = t0 % SEQ;
        for (int idx = F.tid; idx < 1024; idx += NTHR) { const int tok = idx >> 4, i = idx & 15;
            const int pos = A.pos_off[b] + s0 + tok; const float inv = powf(10000.f, -(float)i * (1.f / 16.f));
            double ang = (double)(float)pos * (double)inv; ang -= 6.283185307179586 * floor(ang * 0.15915494309189535);
            float sn, cn; sincosf((float)ang, &sn, &cn); cs[idx * 2] = cn; cs[idx * 2 + 1] = sn; }
        __syncthreads();
        const int tok = F.tid >> 3, sub = F.tid & 7, h = sub >> 1, isk = sub & 1, t = t0 + tok;
        {
            float v[96];
            const bf16_t* p0 = isk ? RAW + (size_t)t * 1024 + 384 + 128 * h : RAW + (size_t)t * 1024 + 96 * h;
            const bf16_t* p1 = isk ? Z + (size_t)t * ZS + ZC_KPE : p0 + 64;
#pragma unroll
            for (int c = 0; c < 8; ++c) { const u32x4 w = *(const u32x4*)(p0 + 8 * c);
                v[8 * c] = bflo(w.x); v[8 * c + 1] = bfhi(w.x); v[8 * c + 2] = bflo(w.y); v[8 * c + 3] = bfhi(w.y); v[8 * c + 4] = bflo(w.z); v[8 * c + 5] = bfhi(w.z); v[8 * c + 6] = bflo(w.w); v[8 * c + 7] = bfhi(w.w); }
#pragma unroll
            for (int c = 0; c < 4; ++c) { const u32x4 w = *(const u32x4*)(p1 + 8 * c);
                v[64 + 8 * c] = bflo(w.x); v[65 + 8 * c] = bfhi(w.x); v[66 + 8 * c] = bflo(w.y); v[67 + 8 * c] = bfhi(w.y); v[68 + 8 * c] = bflo(w.z); v[69 + 8 * c] = bfhi(w.z); v[70 + 8 * c] = bflo(w.w); v[71 + 8 * c] = bfhi(w.w); }
            float ss = 0.f;
#pragma unroll
            for (int i = 0; i < 96; ++i) ss += v[i] * v[i];
            const float r = rsqrtf(ss * (1.f / 96.f) + NORM_EPS);
            const float* hg = isk ? khg : qhg;
#pragma unroll
            for (int i = 0; i < 96; ++i) v[i] = v[i] * r * hg[i];
#pragma unroll
            for (int i = 0; i < 16; ++i) { const float cn = cs[(tok * 16 + i) * 2], sn = cs[(tok * 16 + i) * 2 + 1]; const float x1 = v[64 + i], x2 = v[80 + i];
                v[64 + i] = x1 * cn - x2 * sn; v[80 + i] = x1 * sn + x2 * cn; }
            bf16_t* dst = (isk ? K : Q) + ((size_t)t * 4 + h) * 96;
#pragma unroll
            for (int c = 0; c < 12; ++c) { u32x4 w; w.x = pk2(v[8 * c], v[8 * c + 1]); w.y = pk2(v[8 * c + 2], v[8 * c + 3]); w.z = pk2(v[8 * c + 4], v[8 * c + 5]); w.w = pk2(v[8 * c + 6], v[8 * c + 7]);
                *(u32x4*)(dst + 8 * c) = w; }
        }
        {
            const bf16_t* pv = RAW + (size_t)t * 1024 + 384 + 128 * h + 64 + 32 * isk;
#pragma unroll
            for (int c = 0; c < 4; ++c) { const u32x4 w = *(const u32x4*)(pv + 8 * c); const int r0 = h * 64 + 32 * isk + 8 * c;
                vt[(r0 + 0) * 72 + tok] = (bf16_t)(w.x & 0xffffu); vt[(r0 + 1) * 72 + tok] = (bf16_t)(w.x >> 16);
                vt[(r0 + 2) * 72 + tok] = (bf16_t)(w.y & 0xffffu); vt[(r0 + 3) * 72 + tok] = (bf16_t)(w.y >> 16);
                vt[(r0 + 4) * 72 + tok] = (bf16_t)(w.z & 0xffffu); vt[(r0 + 5) * 72 + tok] = (bf16_t)(w.z >> 16);
                vt[(r0 + 6) * 72 + tok] = (bf16_t)(w.w & 0xffffu); vt[(r0 + 7) * 72 + tok] = (bf16_t)(w.w >> 16); }
        }
        __syncthreads();
        { const int row = F.tid >> 1, hf = F.tid & 1;
          bf16_t* dst = VT + ((size_t)(b * 4) * 64 + row) * SEQ + s0 + 32 * hf;
#pragma unroll
          for (int c = 0; c < 4; ++c) *(u32x4*)(dst + 8 * c) = *(const LAS u32x4*)(vt + row * 72 + 32 * hf + 8 * c); }
        __syncthreads();
    }
}

DI void attn_unit(const Frame& F, const bf16_t* Q, const bf16_t* K, const bf16_t* VT, bf16_t* O, int bh, int u) {
    constexpr int KP = 208, VP = 144, KB = 64 * KP, VB = 64 * VP;
    LAS unsigned char* Ks = F.lds; LAS unsigned char* Vs = F.lds + 2 * KB;
    const int b = bh >> 2, h = bh & 3, lane = F.lane, w = F.wave, ql = lane & 31, hh = lane >> 5;
    const int ntile = 4 * u + 4, myl = 4 * u + (w >> 1);
    const size_t tq = (size_t)b * SEQ + 256 * u + 32 * w + ql;
    bf16x8 qf[6];
#pragma unroll
    for (int s = 0; s < 6; ++s) qf[s] = *(const bf16x8*)(Q + (tq * 4 + h) * 96 + 16 * s + 8 * hh);
    f32x16 ot[2];
#pragma unroll
    for (int i = 0; i < 16; ++i) { ot[0][i] = 0.f; ot[1][i] = 0.f; }
    float mrun = -INFINITY, lrun = 0.f;
    const float c2 = 0.10206207261596577f * 1.4426950408889634f;
    const int kp0 = F.tid, kp1 = F.tid + 512;
    const size_t kbase = ((size_t)b * SEQ * 4 + h) * 96;
    const bf16_t* vsrc = VT + ((size_t)bh * 64 + (F.tid >> 3)) * SEQ + 8 * (F.tid & 7);
    u32x4 rk0, rk1, rv;
    rk1 = (u32x4){0u, 0u, 0u, 0u};
#define ATT_LOAD(j) do { rk0 = *(const u32x4*)(K + kbase + (size_t)(64 * (j) + kp0 / 12) * 384 + 8 * (kp0 % 12)); \
        if (kp1 < 768) rk1 = *(const u32x4*)(K + kbase + (size_t)(64 * (j) + kp1 / 12) * 384 + 8 * (kp1 % 12)); \
        rv = *(const u32x4*)(vsrc + 64 * (j)); } while (0)
#define ATT_STORE(buf) do { *(LAS u32x4*)(Ks + (buf) * KB + (kp0 / 12) * KP + (kp0 % 12) * 16) = rk0; \
        if (kp1 < 768) *(LAS u32x4*)(Ks + (buf) * KB + (kp1 / 12) * KP + (kp1 % 12) * 16) = rk1; \
        *(LAS u32x4*)(Vs + (buf) * VB + (F.tid >> 3) * VP + (F.tid & 7) * 16) = rv; } while (0)
    ATT_LOAD(0); ATT_STORE(0);
    __syncthreads();
    for (int j = 0; j < ntile; ++j) {
        const int buf = j & 1;
        if (j + 1 < ntile) ATT_LOAD(j + 1);
        if (j <= myl) {
            f32x16 st[2];
#pragma unroll
            for (int kt = 0; kt < 2; ++kt) {
#pragma unroll
                for (int i = 0; i < 16; ++i) st[kt][i] = 0.f;
#pragma unroll
                for (int s = 0; s < 6; ++s) { const bf16x8 kf = *(const LAS bf16x8*)(Ks + buf * KB + (32 * kt + ql) * KP + (16 * s + 8 * hh) * 2);
                    st[kt] = __builtin_amdgcn_mfma_f32_32x32x16_bf16(kf, qf[s], st[kt], 0, 0, 0); }
            }
            float mx = st[0][0];
#pragma unroll
            for (int i = 1; i < 16; ++i) mx = fmaxf(mx, st[0][i]);
#pragma unroll
            for (int i = 0; i < 16; ++i) mx = fmaxf(mx, st[1][i]);
            mx = fmaxf(mx, shfl_xor_l(mx, 32, lane));
            const float mnew = fmaxf(mrun, mx), alpha = __builtin_amdgcn_exp2f((mrun - mnew) * c2), mc = mnew * c2;
            mrun = mnew;
            float ps = 0.f;
#pragma unroll
            for (int kt = 0; kt < 2; ++kt)
#pragma unroll
                for (int i = 0; i < 16; ++i) { const float p = __builtin_amdgcn_exp2f(st[kt][i] * c2 - mc); st[kt][i] = p; ps += p; }
            lrun = lrun * alpha + ps;
#pragma unroll
            for (int i = 0; i < 16; ++i) { ot[0][i] *= alpha; ot[1][i] *= alpha; }
#pragma unroll
            for (int kt = 0; kt < 2; ++kt)
#pragma unroll
                for (int c = 0; c < 2; ++c) {
                    u32x4 pw; pw.x = pk2(st[kt][8 * c], st[kt][8 * c + 1]); pw.y = pk2(st[kt][8 * c + 2], st[kt][8 * c + 3]); pw.z = pk2(st[kt][8 * c + 4], st[kt][8 * c + 5]); pw.w = pk2(st[kt][8 * c + 6], st[kt][8 * c + 7]);
                    const bf16x8 pf = __builtin_bit_cast(bf16x8, pw);
                    const int key0 = 32 * kt + 16 * c + 4 * hh;
#pragma unroll
                    for (int dt = 0; dt < 2; ++dt) { const LAS unsigned char* vp = Vs + buf * VB + (32 * dt + ql) * VP + key0 * 2;
                        const u32x2 v0 = *(const LAS u32x2*)vp, v1 = *(const LAS u32x2*)(vp + 16);
                        u32x4 vw; vw.x = v0.x; vw.y = v0.y; vw.z = v1.x; vw.w = v1.y;
                        ot[dt] = __builtin_amdgcn_mfma_f32_32x32x16_bf16(__builtin_bit_cast(bf16x8, vw), pf, ot[dt], 0, 0, 0); }
                }
        }
        if (j + 1 < ntile) ATT_STORE(buf ^ 1);
        __syncthreads();
    }
#undef ATT_LOAD
#undef ATT_STORE
    const float linv = 1.f / (lrun + shfl_xor_l(lrun, 32, lane));
    bf16_t* orow = O + tq * 256 + h * 64;
#pragma unroll
    for (int dt = 0; dt < 2; ++dt)
#pragma unroll
        for (int g = 0; g < 4; ++g) { u32x2 o; o.x = pk2(ot[dt][4 * g] * linv, ot[dt][4 * g + 1] * linv); o.y = pk2(ot[dt][4 * g + 2] * linv, ot[dt][4 * g + 3] * linv);
            *(u32x2*)(orow + 32 * dt + 8 * g + 4 * hh) = o; }
}
DI void phase_attn(const Frame& F, CArgs& A) {
    const bf16_t* Q = (const bf16_t*)(A.ws + WS_Q); const bf16_t* K = (const bf16_t*)(A.ws + WS_K); const bf16_t* VT = (const bf16_t*)(A.ws + WS_VT);
    bf16_t* O = (bf16_t*)(A.ws + WS_ATTO);
    for (int p = F.bid; p < 512; p += F.G) { const int bh = p >> 4, u = p & 15;
        attn_unit(F, Q, K, VT, O, bh, 31 - u);
        attn_unit(F, Q, K, VT, O, bh, u); }
}

DI void phase_rwkv_prep(const Frame& F, CArgs& A, int l) {
    const bf16_t* Z = (const bf16_t*)(A.ws + WS_Z);
    bf16_t* R_ = (bf16_t*)(A.ws + WS_RW_R); bf16_t* K_ = (bf16_t*)(A.ws + WS_RW_K); bf16_t* V_ = (bf16_t*)(A.ws + WS_RW_V); bf16_t* KK_ = (bf16_t*)(A.ws + WS_RW_KK);
    bf16_t* B_ = (bf16_t*)(A.ws + WS_RW_B); bf16_t* G_ = (bf16_t*)(A.ws + WS_RW_G); float* W_ = (float*)(A.ws + WS_RW_W);
    const float* mu = A.in[7] + l * 896; const float* w0 = A.in[8] + l * 256; const float* w2 = A.in[9] + l * 32 * 256; const float* a0 = A.in[10] + l * 256;
    const float* a2 = A.in[11] + l * 32 * 256; const float* g2 = A.in[12] + l * 64 * 256; const float* k_k = A.in[13] + l * 256; const float* k_a = A.in[14] + l * 256;
    LAS float* lora = (LAS float*)F.lds;
    const int tg = F.tid >> 8, ch = F.tid & 255;
    for (int pi = F.bid; pi < T / 2; pi += F.G) {
        const int t = 2 * pi + tg, s = t % SEQ; const bool hp = s > 0;
        const bf16_t* zr = Z + (size_t)t * ZS;
#define RW_SH(col) ({ const float zc_ = bf2f(zr[(col)]); const float zp_ = hp ? bf2f(zr[(col) - ZS]) : 0.f; zc_ + (zp_ - zc_) * mu[(col)]; })
        if (ch < 128) { float v = RW_SH(ZC_WLO + ch); if (ch < 32) v = tanhf(v); else if (ch >= 64) v = sigmoidf_(v); lora[tg * 128 + ch] = v; }
        __syncthreads();
        float wv = w0[ch], av = a0[ch], gv = 0.f;
        const LAS float* lo = lora + tg * 128;
#pragma unroll 8
        for (int j = 0; j < 32; ++j) { wv += lo[j] * w2[j * 256 + ch]; av += lo[32 + j] * a2[j * 256 + ch]; }
#pragma unroll 8
        for (int j = 0; j < 64; ++j) gv += lo[64 + j] * g2[j * 256 + ch];
        const float wraw = -softplusf_(-wv) - 0.5f, decay = __expf(-__expf(wraw));
        const float a = sigmoidf_(av);
        const float r = RW_SH(ZC_R + ch), k = RW_SH(ZC_K + ch), v = RW_SH(ZC_V + ch);
        const float kkv = k * k_k[ch];
        const float nrm = sqrtf(wave_sum(kkv * kkv));
        const float kk = kkv / fmaxf(nrm, 1e-12f);
        const float kmod = k * (1.f + (a - 1.f) * k_a[ch]);
        const size_t o = (size_t)t * 256 + ch;
        R_[o] = (bf16_t)f2bf(r); K_[o] = (bf16_t)f2bf(kmod); V_[o] = (bf16_t)f2bf(v); KK_[o] = (bf16_t)f2bf(kk); B_[o] = (bf16_t)f2bf(kk * a); G_[o] = (bf16_t)f2bf(gv); W_[o] = decay;
        __syncthreads();
#undef RW_SH
    }
}

DI void phase_rwkv_scan(const Frame& F, CArgs& A) {
    if (F.bid >= 32) return;
    const bf16_t* R_ = (const bf16_t*)(A.ws + WS_RW_R); const bf16_t* K_ = (const bf16_t*)(A.ws + WS_RW_K); const bf16_t* V_ = (const bf16_t*)(A.ws + WS_RW_V);
    const bf16_t* KK_ = (const bf16_t*)(A.ws + WS_RW_KK); const bf16_t* B_ = (const bf16_t*)(A.ws + WS_RW_B); const float* W_ = (const float*)(A.ws + WS_RW_W);
    float* Y_ = (float*)(A.ws + WS_RW_Y);
    constexpr int CH = 16;
    LAS float* buf = (LAS float*)F.lds;
    LAS float* psa = (LAS float*)(F.lds + 2 * 6 * CH * 64 * 4);
    LAS float* py = psa + 2 * 8 * 64;
    const int b = F.bid >> 2, h = F.bid & 3, w = F.wave, lane = F.lane;
    const size_t base = (size_t)b * SEQ * 256 + h * 64;
    float s[8];
#pragma unroll
    for (int c = 0; c < 8; ++c) s[c] = 0.f;
    float pre[12];
#define RS_LOAD(t0) do { _Pragma("unroll") for (int e = 0; e < 12; ++e) { const int step = (F.tid + 512 * (e & 1)) >> 6, col = F.tid & 63; const size_t gi = base + (size_t)((t0) + step) * 256 + col; \
        const int a_ = e >> 1; pre[e] = a_ == 0 ? bf2f(KK_[gi]) : a_ == 1 ? bf2f(B_[gi]) : a_ == 2 ? W_[gi] : a_ == 3 ? bf2f(K_[gi]) : a_ == 4 ? bf2f(R_[gi]) : bf2f(V_[gi]); } } while (0)
#define RS_STORE(bi) do { _Pragma("unroll") for (int e = 0; e < 12; ++e) buf[(((bi) * 6 + (e >> 1)) * CH) * 64 + F.tid + 512 * (e & 1)] = pre[e]; } while (0)
    RS_LOAD(0); RS_STORE(0);
    __syncthreads();
    for (int c0 = 0; c0 < SEQ / CH; ++c0) {
        const int bi = c0 & 1;
        if (c0 + 1 < SEQ / CH) RS_LOAD((c0 + 1) * CH);
        const LAS float* cb = buf + bi * 6 * CH * 64;
        for (int tl = 0; tl < CH; ++tl) {
            const LAS float* p = cb + tl * 64 + 8 * w;
            const f32x4 kk0 = *(const LAS f32x4*)(p), kk1 = *(const LAS f32x4*)(p + 4);
            const f32x4 be0 = *(const LAS f32x4*)(p + CH * 64), be1 = *(const LAS f32x4*)(p + CH * 64 + 4);
            const f32x4 w0 = *(const LAS f32x4*)(p + 2 * CH * 64), w1 = *(const LAS f32x4*)(p + 2 * CH * 64 + 4);
            const f32x4 k0 = *(const LAS f32x4*)(p + 3 * CH * 64), k1 = *(const LAS f32x4*)(p + 3 * CH * 64 + 4);
            const f32x4 r0 = *(const LAS f32x4*)(p + 4 * CH * 64), r1 = *(const LAS f32x4*)(p + 4 * CH * 64 + 4);
            const float vv = cb[5 * CH * 64 + tl * 64 + lane];
            float pa = s[0] * kk0[0] + s[1] * kk0[1] + s[2] * kk0[2] + s[3] * kk0[3] + s[4] * kk1[0] + s[5] * kk1[1] + s[6] * kk1[2] + s[7] * kk1[3];
            psa[((tl & 1) * 8 + w) * 64 + lane] = pa;
            __syncthreads();
            float sa = 0.f;
#pragma unroll
            for (int ww = 0; ww < 8; ++ww) sa -= psa[((tl & 1) * 8 + ww) * 64 + lane];
            s[0] = s[0] * w0[0] + sa * be0[0] + vv * k0[0]; s[1] = s[1] * w0[1] + sa * be0[1] + vv * k0[1]; s[2] = s[2] * w0[2] + sa * be0[2] + vv * k0[2]; s[3] = s[3] * w0[3] + sa * be0[3] + vv * k0[3];
            s[4] = s[4] * w1[0] + sa * be1[0] + vv * k1[0]; s[5] = s[5] * w1[1] + sa * be1[1] + vv * k1[1]; s[6] = s[6] * w1[2] + sa * be1[2] + vv * k1[2]; s[7] = s[7] * w1[3] + sa * be1[3] + vv * k1[3];
            py[(tl * 8 + w) * 64 + lane] = s[0] * r0[0] + s[1] * r0[1] + s[2] * r0[2] + s[3] * r0[3] + s[4] * r1[0] + s[5] * r1[1] + s[6] * r1[2] + s[7] * r1[3];
        }
        __syncthreads();
#pragma unroll
        for (int e = 0; e < 2; ++e) { const int idx = F.tid + 512 * e, tl = idx >> 6, row = idx & 63; float y = 0.f;
#pragma unroll
            for (int ww = 0; ww < 8; ++ww) y += py[(tl * 8 + ww) * 64 + row];
            Y_[base + (size_t)(c0 * CH + tl) * 256 + row] = y; }
        if (c0 + 1 < SEQ / CH) RS_STORE(bi ^ 1);
        __syncthreads();
    }
#undef RS_LOAD
#undef RS_STORE
}

DI void phase_rwkv_fin(const Frame& F, CArgs& A, int l) {
    const bf16_t* R_ = (const bf16_t*)(A.ws + WS_RW_R); const bf16_t* K_ = (const bf16_t*)(A.ws + WS_RW_K); const bf16_t* V_ = (const bf16_t*)(A.ws + WS_RW_V); const bf16_t* G_ = (const bf16_t*)(A.ws + WS_RW_G);
    const float* Y_ = (const float*)(A.ws + WS_RW_Y); bf16_t* MIX = (bf16_t*)(A.ws + WS_MIX);
    const float* r_k = A.in[15] + l * 256; const float* ln_w = A.in[16] + l * 256; const float* ln_b = A.in[17] + l * 256;
    for (int it = F.gw; it < T * 4; it += F.ngw) {
        const int t = it >> 2, ch = (it & 3) * 64 + F.lane; const size_t o = (size_t)t * 256 + ch;
        const float y = Y_[o];
        const float mean = wave_sum(y) * (1.f / 64.f); const float d = y - mean; const float var = wave_sum(d * d) * (1.f / 64.f);
        const float yn = d * rsqrtf(var + 64e-5f) * ln_w[ch] + ln_b[ch];
        const float r = bf2f(R_[o]), k = bf2f(K_[o]), v = bf2f(V_[o]), g = bf2f(G_[o]);
        const float bonus = wave_sum(r * k * r_k[ch]) * v;
        MIX[(size_t)t * DM + ch] = (bf16_t)f2bf((yn + bonus) * g);
    }
}

template <int PASS>
DI void phase_s5(const Frame& F, CArgs& A, int l) {
    const bf16_t* Z = (const bf16_t*)(A.ws + WS_Z); float* SEND = (float*)(A.ws + WS_S5END); bf16_t* YS = (bf16_t*)(A.ws + WS_YS5);
    LAS float* hre = (LAS float*)(F.lds + F.wave * 16512); LAS float* him = hre + 16 * 65; LAS float* cre = him + 16 * 65; LAS float* cim = cre + 16 * 64;
    const int lane = F.lane;
    for (int it = F.gw; it < 8 * 16 * 16; it += F.ngw) {
        const int b = it >> 8, g = (it >> 4) & 15, seg = it & 15, p = lane;
        const float dt = __expf(A.in[25][l * 16 + g]);
        const float lre = A.in[18][(l * 16 + g) * 64 + p], lim = A.in[19][(l * 16 + g) * 64 + p];
        const float mag = expf(lre * dt); float sn, cn; sincosf(lim * dt, &sn, &cn);
        const float are = mag * cn, aim = mag * sn, den = lre * lre + lim * lim;
        const float qre = ((are - 1.f) * lre + aim * lim) / den, qim = (aim * lre - (are - 1.f) * lim) / den;
        float bbr[16], bbi[16];
        { const float* br = A.in[20] + ((size_t)(l * 16 + g) * 64 + p) * 16; const float* bi = A.in[21] + ((size_t)(l * 16 + g) * 64 + p) * 16;
#pragma unroll
          for (int i = 0; i < 16; ++i) { const float x = br[i], y = bi[i]; bbr[i] = qre * x - qim * y; bbi[i] = qre * y + qim * x; } }
        float h_re = 0.f, h_im = 0.f;
        if (PASS == 2) {
            const float m512 = expf(512.f * lre * dt); float s5, c5; sincosf(512.f * (lim * dt), &s5, &c5); const float pr = m512 * c5, pi_ = m512 * s5;
            for (int j = 0; j < seg; ++j) { const float* e = SEND + ((size_t)((b * 16 + g) * 16 + j)) * 128; const float er = e[p], ei = e[64 + p];
                const float nr = pr * h_re - pi_ * h_im + er, ni = pr * h_im + pi_ * h_re + ei; h_re = nr; h_im = ni; }
            for (int i = lane; i < 1024; i += 64) { cre[i] = A.in[22][(size_t)(l * 16 + g) * 1024 + i]; cim[i] = A.in[23][(size_t)(l * 16 + g) * 1024 + i]; }
        }
        const bf16_t* zb = Z + ((size_t)b * SEQ + seg * 512) * ZS + ZC_S5 + g * 16;
        for (int t0 = 0; t0 < 512; t0 += 16) {
#pragma unroll
            for (int sb = 0; sb < 2; ++sb) {
                u32x4 ua[8], ub[8];
#pragma unroll
                for (int q = 0; q < 8; ++q) { const bf16_t* zp = zb + (size_t)(t0 + sb * 8 + q) * ZS; ua[q] = *(const u32x4*)zp; ub[q] = *(const u32x4*)(zp + 8); }
#pragma unroll
                for (int q = 0; q < 8; ++q) {
                    float br_ = 0.f, bi_ = 0.f;
                    const unsigned uw[8] = {ua[q].x, ua[q].y, ua[q].z, ua[q].w, ub[q].x, ub[q].y, ub[q].z, ub[q].w};
#pragma unroll
                    for (int i = 0; i < 8; ++i) { const float u0 = bflo(uw[i]), u1 = bfhi(uw[i]); br_ += bbr[2 * i] * u0 + bbr[2 * i + 1] * u1; bi_ += bbi[2 * i] * u0 + bbi[2 * i + 1] * u1; }
                    const float nr = are * h_re - aim * h_im + br_, ni = are * h_im + aim * h_re + bi_; h_re = nr; h_im = ni;
                    if (PASS == 2) { hre[(sb * 8 + q) * 65 + p] = h_re; him[(sb * 8 + q) * 65 + p] = h_im; }
                }
            }
            if (PASS == 2) {
                asm volatile("s_waitcnt lgkmcnt(0)" ::: "memory");
                const int tl = lane & 15, iq = lane >> 4;
                float acc[4] = {0.f, 0.f, 0.f, 0.f};
                for (int pp = 0; pp < 64; ++pp) { const float xr = hre[tl * 65 + pp], xi = him[tl * 65 + pp];
#pragma unroll
                    for (int i = 0; i < 4; ++i) acc[i] += xr * cre[(4 * iq + i) * 64 + pp] - xi * cim[(4 * iq + i) * 64 + pp]; }
                const int tt = seg * 512 + t0 + tl; const size_t tok = (size_t)b * SEQ + tt;
                const u32x2 uu = *(const u32x2*)(Z + tok * ZS + ZC_S5 + g * 16 + 4 * iq);
                const f32x4 dd = *(const f32x4*)(A.in[24] + l * 256 + g * 16 + 4 * iq);
                const float y0 = gelu_tanh(acc[0] + dd[0] * bflo(uu.x)), y1 = gelu_tanh(acc[1] + dd[1] * bfhi(uu.x)), y2 = gelu_tanh(acc[2] + dd[2] * bflo(uu.y)), y3 = gelu_tanh(acc[3] + dd[3] * bfhi(uu.y));
                u32x2 o; o.x = pk2(y0, y1); o.y = pk2(y2, y3);
                *(u32x2*)(YS + tok * 256 + g * 16 + 4 * iq) = o;
                asm volatile("s_waitcnt lgkmcnt(0)" ::: "memory");
            }
        }
        if (PASS == 1) { float* e = SEND + ((size_t)((b * 16 + g) * 16 + seg)) * 128; e[p] = h_re; e[64 + p] = h_im; }
    }
}

DI void phase_lru_prep(const Frame& F, CArgs& A, int l) {
    const bf16_t* Z = (const bf16_t*)(A.ws + WS_Z); float* LA = (float*)(A.ws + WS_LA); float* LB = (float*)(A.ws + WS_LB);
    const float* cw = A.in[34] + l * 4 * 256; const float* cb = A.in[35] + l * 256; const float* wa = A.in[36] + (size_t)l * 4 * 64 * 64; const float* ba = A.in[37] + l * 256;
    const float* wx = A.in[38] + (size_t)l * 4 * 64 * 64; const float* bx = A.in[39] + l * 256; const float* lam = A.in[40] + l * 256;
    LAS float* xs = (LAS float*)F.lds;
    const int tg = F.tid >> 8, ch = F.tid & 255, n = ch >> 6, jj = ch & 63;
    const float spl = softplusf_(-lam[ch]);
    for (int pi = F.bid; pi < T / 2; pi += F.G) {
        const int t = 2 * pi + tg, s = t % SEQ;
        const bf16_t* zr = Z + (size_t)t * ZS + ZC_LX + ch;
        float xc = cb[ch];
#pragma unroll
        for (int j = 0; j < 4; ++j) { const int sp = s - 3 + j; if (sp >= 0) xc += cw[j * 256 + ch] * bf2f(zr[(ptrdiff_t)(j - 3) * ZS]); }
        xs[tg * 256 + ch] = xc;
        __syncthreads();
        float ra = ba[ch], ia = bx[ch];
        const LAS float* xb = xs + tg * 256 + n * 64;
#pragma unroll 8
        for (int k = 0; k < 64; ++k) { const float x = xb[k]; ra += x * wa[(n * 64 + k) * 64 + jj]; ia += x * wx[(n * 64 + k) * 64 + jj]; }
        const float r = sigmoidf_(ra), ig = sigmoidf_(ia);
        const float log_a = -8.f * r * spl, a = __expf(log_a);
        const float bv = sqrtf(-expm1f(2.f * log_a)) * (ig * xc);
        LA[(size_t)t * 256 + ch] = a; LB[(size_t)t * 256 + ch] = bv;
        __syncthreads();
    }
}
DI void phase_lru_sum(const Frame& F, CArgs& A) {
    const float* LA = (const float*)(A.ws + WS_LA); const float* LB = (const float*)(A.ws + WS_LB); float* LS = (float*)(A.ws + WS_LSUM);
    for (int it = F.gw; it < 8 * 128; it += F.ngw) {
        const size_t r0 = (size_t)it * 64;
        f32x4 Ap = {1.f, 1.f, 1.f, 1.f}, Bp = {0.f, 0.f, 0.f, 0.f};
#pragma unroll 8
        for (int t = 0; t < 64; ++t) { const f32x4 a = *(const f32x4*)(LA + (r0 + t) * 256 + 4 * F.lane), bb = *(const f32x4*)(LB + (r0 + t) * 256 + 4 * F.lane); Bp = a * Bp + bb; Ap = Ap * a; }
        *(f32x4*)(LS + ((size_t)it * 2) * 256 + 4 * F.lane) = Ap; *(f32x4*)(LS + ((size_t)it * 2 + 1) * 256 + 4 * F.lane) = Bp;
    }
}
DI void phase_lru_fin(const Frame& F, CArgs& A) {
    const float* LA = (const float*)(A.ws + WS_LA); const float* LB = (const float*)(A.ws + WS_LB); const float* LS = (const float*)(A.ws + WS_LSUM);
    const bf16_t* Z = (const bf16_t*)(A.ws + WS_Z); bf16_t* YL = (bf16_t*)(A.ws + WS_YL);
    for (int it = F.gw; it < 8 * 128; it += F.ngw) {
        const int b = it >> 7, c = it & 127;
        f32x4 h = {0.f, 0.f, 0.f, 0.f};
        for (int j = 0; j < c; ++j) { const f32x4 a = *(const f32x4*)(LS + ((size_t)(b * 128 + j) * 2) * 256 + 4 * F.lane), bb = *(const f32x4*)(LS + ((size_t)(b * 128 + j) * 2 + 1) * 256 + 4 * F.lane); h = a * h + bb; }
        const size_t r0 = (size_t)it * 64;
#pragma unroll 4
        for (int t = 0; t < 64; ++t) { const f32x4 a = *(const f32x4*)(LA + (r0 + t) * 256 + 4 * F.lane), bb = *(const f32x4*)(LB + (r0 + t) * 256 + 4 * F.lane); h = a * h + bb;
            const u32x2 gz = *(const u32x2*)(Z + (r0 + t) * ZS + ZC_LG + 4 * F.lane);
            u32x2 o; o.x = pk2(h[0] * gelu_tanh(bflo(gz.x)), h[1] * gelu_tanh(bfhi(gz.x))); o.y = pk2(h[2] * gelu_tanh(bflo(gz.y)), h[3] * gelu_tanh(bfhi(gz.y)));
            *(u32x2*)(YL + (r0 + t) * 256 + 4 * F.lane) = o; }
    }
}

DI void phase_branch_norm(const Frame& F, CArgs& A, int l) {
    const bf16_t* S0 = (const bf16_t*)(A.ws + WS_YS5G); const bf16_t* S1 = (const bf16_t*)(A.ws + WS_ATTO); const bf16_t* S2 = (const bf16_t*)(A.ws + WS_YL);
    bf16_t* MIX = (bf16_t*)(A.ws + WS_MIX); const float* bg = A.in[41] + l * 768;
    for (int row = F.gw; row < T; row += F.ngw) {
#pragma unroll
        for (int br = 0; br < 3; ++br) { const bf16_t* S = br == 0 ? S0 : br == 1 ? S1 : S2;
            const u32x2 v = *(const u32x2*)(S + (size_t)row * 256 + 4 * F.lane);
            const float x0 = bflo(v.x), x1 = bfhi(v.x), x2 = bflo(v.y), x3 = bfhi(v.y);
            const float r = rsqrtf(wave_sum(x0 * x0 + x1 * x1 + x2 * x2 + x3 * x3) * (1.f / 256.f) + NORM_EPS);
            const f32x4 g = *(const f32x4*)(bg + br * 256 + 4 * F.lane);
            u32x2 o; o.x = pk2(x0 * r * g[0], x1 * r * g[1]); o.y = pk2(x2 * r * g[2], x3 * r * g[3]);
            *(u32x2*)(MIX + (size_t)row * DM + 256 * (br + 1) + 4 * F.lane) = o; }
    }
}

DI void phase_norm2_router(const Frame& F, CArgs& A, int l) {
    const float* MODL = (const float*)(A.ws + WS_MOD) + (size_t)l * 8 * 6144;
    const float* g = A.in[43] + l * 1024;
    bf16_t* H = (bf16_t*)(A.ws + WS_H);
    int* EID = (int*)(A.ws + WS_RT_EID); float* GATE = (float*)(A.ws + WS_RT_GATE); int* PIE = (int*)(A.ws + WS_RT_PIE);
    unsigned* CNT = (unsigned*)(A.ws + WS_CTL) + CW_CNT + l * 64;
    LAS float* W = (LAS float*)F.lds;
    { const float* wg = A.in[44] + (size_t)l * 1024 * 4; const float* we = A.in[46] + (size_t)l * 1024 * 32;
      for (int i = F.tid; i < 1024 * 4; i += NTHR) W[(i & 3) * 1024 + (i >> 2)] = wg[i];
      for (int i = F.tid; i < 1024 * 32; i += NTHR) W[(4 + (i & 31)) * 1024 + (i >> 5)] = we[i]; }
    __syncthreads();
    const float* bgp = A.in[45] + l * 4; const float* bep = A.in[47] + l * 32;
    for (int row = F.gw; row < T; row += F.ngw) {
        const int b = row / SEQ;
        f32x4 v[4]; float ss = 0.f;
#pragma unroll
        for (int j = 0; j < 4; ++j) { v[j] = *(const f32x4*)(A.out + (size_t)row * DM + 4 * (64 * j + F.lane)); ss += v[j][0] * v[j][0] + v[j][1] * v[j][1] + v[j][2] * v[j][2] + v[j][3] * v[j][3]; }
        const float rstd = rsqrtf(wave_sum(ss) * (1.f / DM) + NORM_EPS);
#pragma unroll
        for (int j = 0; j < 4; ++j) { const int col = 4 * (64 * j + F.lane);
            const f32x4 gg = *(const f32x4*)(g + col), sh = *(const f32x4*)(MODL + (size_t)b * 6144 + 3072 + col), scv = *(const f32x4*)(MODL + (size_t)b * 6144 + 4096 + col);
            v[j] = v[j] * rstd * gg * (scv + 1.f) + sh;
            u32x2 o; o.x = pk2(v[j][0], v[j][1]); o.y = pk2(v[j][2], v[j][3]);
            *(u32x2*)(H + (size_t)row * DM + col) = o; }
        LAS float* Lw = (LAS float*)(F.lds + 147456) + F.wave * 40;
#pragma unroll 1
        for (int n = 0; n < 36; ++n) { float a = 0.f;
#pragma unroll
            for (int j = 0; j < 4; ++j) { const f32x4 w4 = *(const LAS f32x4*)(W + n * 1024 + 4 * (64 * j + F.lane)); a += v[j][0] * w4[0] + v[j][1] * w4[1] + v[j][2] * w4[2] + v[j][3] * w4[3]; }
            a = wave_sum(a); if (F.lane == 0) Lw[n] = a; }
        asm volatile("s_waitcnt lgkmcnt(0)" ::: "memory");
        float L[36];
#pragma unroll
        for (int n = 0; n < 36; ++n) L[n] = Lw[n];
        asm volatile("s_waitcnt lgkmcnt(0)" ::: "memory");
        float gl[4];
#pragma unroll
        for (int i = 0; i < 4; ++i) gl[i] = L[i] + bgp[i];
        int gs = 0; float gm = gl[0];
#pragma unroll
        for (int i = 1; i < 4; ++i) if (gl[i] > gm) { gm = gl[i]; gs = i; }
        float gden = 0.f;
#pragma unroll
        for (int i = 0; i < 4; ++i) gden += expf(gl[i] - gm);
        const float gprob = 1.f / gden;
        float el[8];
#pragma unroll
        for (int j = 0; j < 8; ++j) el[j] = (gs == 0 ? L[4 + j] : gs == 1 ? L[12 + j] : gs == 2 ? L[20 + j] : L[28 + j]) + bep[gs * 8 + j];
        int i1 = 0; float v1 = el[0];
#pragma unroll
        for (int j = 1; j < 8; ++j) if (el[j] > v1) { v1 = el[j]; i1 = j; }
        int i2 = -1; float v2 = -INFINITY;
#pragma unroll
        for (int j = 0; j < 8; ++j) if (j != i1 && el[j] > v2) { v2 = el[j]; i2 = j; }
        const float p2 = expf(v2 - v1);
        const float g0 = gprob / (1.f + p2), g1 = gprob * p2 / (1.f + p2);
        if (F.lane == 0) {
            const int e0 = gs * 8 + i1, e1 = gs * 8 + i2;
            const unsigned q0 = atomicAdd(CNT + e0, 1u), q1 = atomicAdd(CNT + e1, 1u);
            EID[2 * row] = e0; EID[2 * row + 1] = e1; GATE[2 * row] = g0; GATE[2 * row + 1] = g1; PIE[2 * row] = (int)q0; PIE[2 * row + 1] = (int)q1;
        }
    }
    __syncthreads();
    LAS float* scr = (LAS float*)(F.lds + F.wave * 8448);
    bf16_t* WM1 = (bf16_t*)(A.ws + WS_WM1); bf16_t* WM2 = (bf16_t*)(A.ws + WS_WM2);
    for (int it = F.gw; it < 32 * 768; it += F.ngw) {
        const int e = it / 768; int r = it % 768;
        if (r < 512) { const int which = r >> 8; r &= 255; const int kb = r >> 4, nb = r & 15, n0 = 32 * nb;
            const float* src = (which ? A.in[49] : A.in[48]) + ((size_t)l * 32 + e) * 1024 * 512;
            transpose_item(src, 512, 64 * kb, n0, WM1 + (size_t)e * 1024 * 1024, 1024, 256 * (n0 >> 7) + (n0 & 127) + 128 * which, 64 * kb, scr, F.lane);
        } else { r -= 512; const int kb = r >> 5, nb = r & 31;
            transpose_item(A.in[50] + ((size_t)l * 32 + e) * 512 * 1024, 1024, 64 * kb, 32 * nb, WM2 + (size_t)e * 1024 * 512, 512, 32 * nb, 64 * kb, scr, F.lane); }
    }
}

DI void phase_moe_scatter(const Frame& F, CArgs& A, int l) {
    const unsigned* CNT = (const unsigned*)(A.ws + WS_CTL) + CW_CNT + l * 64;
    unsigned* META = (unsigned*)(A.ws + WS_CTL) + CW_UTAB + l * 1024;
    const int* EID = (const int*)(A.ws + WS_RT_EID); const int* PIE = (const int*)(A.ws + WS_RT_PIE); int* SORT = (int*)(A.ws + WS_RT_SORT);
    LAS unsigned* st = (LAS unsigned*)F.lds;
    if (F.tid == 0) { unsigned s = 0; for (int e = 0; e < 32; ++e) { st[e] = s; s += CNT[e]; } }
    __syncthreads();
    if (F.bid == 0 && F.tid == 0) { unsigned nu = 0;
        for (int e = 0; e < 32; ++e) { const unsigned c = CNT[e]; META[1 + e] = st[e]; META[33 + e] = c; for (unsigned bk = 0; bk * 256 < c; ++bk) META[65 + nu++] = ((unsigned)e << 16) | bk; }
        META[0] = nu; }
    for (int a = F.bid * NTHR + F.tid; a < 2 * T; a += F.G * NTHR) SORT[st[EID[a]] + PIE[a]] = a;
}

struct MoeProb1 {
    const char* Hh; const char* WM1; const unsigned* META; const int* SORT; int lda, ldb, nt, G, c;
    DI bool next(int i, pg8::Unit& u) const { const int idx = i * G + c; const int nu = (int)META[0]; if (idx >= nu * 4) return false;
        const unsigned ent = META[65 + (idx >> 2)]; u.pm = idx >> 2; u.pn = idx & 3; u.e = (int)(ent >> 16); u.blk = (int)(ent & 0xffffu); return true; }
    DI const char* a_base(const pg8::Unit&) const { return Hh; }
    DI const char* b_base(const pg8::Unit& u) const { return WM1 + ((size_t)u.e * 1024 + (size_t)u.pn * 256) * 1024 * 2; }
    DI unsigned a_off(const pg8::Unit& u, int row) const { const unsigned r = (unsigned)(u.blk * 256 + row), cnt = META[33 + u.e];
        const int a = r < cnt ? SORT[META[1 + u.e] + r] : 0; return (unsigned)(a >> 1) * 2048u; }
};
struct EpiMoe1 {
    static constexpr bool PERM = true;
    bf16_t* HID; const unsigned* META;
    DI void operator()(const f32x4 (&acc)[2][2][4][2], const pg8::Unit& u, int wr, int wc, int fr, int fq) const {
        const unsigned cnt = META[33 + u.e], st = META[1 + u.e];
        const int col0 = 128 * u.pn + wc * 32 + 8 * fq;
#pragma unroll
        for (int ai = 0; ai < 2; ++ai)
#pragma unroll
            for (int m = 0; m < 4; ++m) { const unsigned r = (unsigned)(u.blk * 256 + ai * 128 + wr * 64 + m * 16 + fr);
                if (r < cnt) { const f32x4 a0 = acc[ai][0][m][0], a1 = acc[ai][0][m][1], b0 = acc[ai][1][m][0], b1 = acc[ai][1][m][1];
                    u32x4 w; w.x = pk2(siluf_(a0[0]) * b0[0], siluf_(a0[1]) * b0[1]); w.y = pk2(siluf_(a0[2]) * b0[2], siluf_(a0[3]) * b0[3]);
                    w.z = pk2(siluf_(a1[0]) * b1[0], siluf_(a1[1]) * b1[1]); w.w = pk2(siluf_(a1[2]) * b1[2], siluf_(a1[3]) * b1[3]);
                    *(u32x4*)(HID + (size_t)(st + r) * 512 + col0) = w; } }
    }
};
struct MoeProb2 {
    const char* HID; const char* WM2; const unsigned* META; int lda, ldb, nt, G, c;
    DI bool next(int i, pg8::Unit& u) const { const int idx = i * G + c; const int nu = (int)META[0]; if (idx >= nu * 4) return false;
        const unsigned ent = META[65 + (idx >> 2)]; u.pm = idx >> 2; u.pn = idx & 3; u.e = (int)(ent >> 16); u.blk = (int)(ent & 0xffffu); return true; }
    DI const char* a_base(const pg8::Unit& u) const { return HID + ((size_t)META[1 + u.e] + (size_t)u.blk * 256) * 512 * 2; }
    DI const char* b_base(const pg8::Unit& u) const { return WM2 + ((size_t)u.e * 1024 + (size_t)u.pn * 256) * 512 * 2; }
    DI unsigned a_off(const pg8::Unit&, int row) const { return (unsigned)row * 1024u; }
};
struct EpiMoe2 {
    static constexpr bool PERM = true;
    bf16_t* Y; const unsigned* META; const int* SORT; const float* GATE; const float* gt;
    DI void operator()(const f32x4 (&acc)[2][2][4][2], const pg8::Unit& u, int wr, int wc, int fr, int fq) const {
        const unsigned cnt = META[33 + u.e], st = META[1 + u.e];
        const int col0 = 256 * u.pn + wc * 32 + 8 * fq;
#pragma unroll
        for (int ai = 0; ai < 2; ++ai)
#pragma unroll
            for (int m = 0; m < 4; ++m) { const unsigned r = (unsigned)(u.blk * 256 + ai * 128 + wr * 64 + m * 16 + fr);
                if (r < cnt) { const int a = SORT[st + r]; const float gw = GATE[a]; const int b = (a >> 1) / SEQ;
#pragma unroll
                    for (int bj = 0; bj < 2; ++bj) { const f32x4 g0 = *(const f32x4*)(gt + (size_t)b * 6144 + col0 + bj * 128), g1 = *(const f32x4*)(gt + (size_t)b * 6144 + col0 + bj * 128 + 4);
                        const f32x4 v0 = acc[ai][bj][m][0] * g0 * gw, v1 = acc[ai][bj][m][1] * g1 * gw;
                        u32x4 w; w.x = pk2(v0[0], v0[1]); w.y = pk2(v0[2], v0[3]); w.z = pk2(v1[0], v1[1]); w.w = pk2(v1[2], v1[3]);
                        *(u32x4*)(Y + (size_t)a * DM + col0 + bj * 128) = w; } } }
    }
};

DI void phase_final(const Frame& F, CArgs& A) {
    const bf16_t* Y = (const bf16_t*)(A.ws + WS_Y);
    for (size_t i = (size_t)F.bid * NTHR + F.tid; i < (size_t)T * DM / 4; i += (size_t)F.G * NTHR) {
        const size_t row = i >> 8, col = (i & 255) * 4;
        f32x4 v = *(const f32x4*)(A.out + row * DM + col);
        const u32x2 y0 = *(const u32x2*)(Y + (2 * row) * DM + col), y1 = *(const u32x2*)(Y + (2 * row + 1) * DM + col);
        v[0] += bflo(y0.x) + bflo(y1.x); v[1] += bfhi(y0.x) + bfhi(y1.x); v[2] += bflo(y0.y) + bflo(y1.y); v[3] += bfhi(y0.y) + bfhi(y1.y);
        *(f32x4*)(A.out + row * DM + col) = v;
    }
}

constexpr int NPL = 21, NPH = 1 + 2 * NPL + 1;
__global__ void __launch_bounds__(NTHR, 2) mk_fwd(Args args) {
    extern __shared__ __attribute__((aligned(16))) unsigned char lds_raw[];
    LAS unsigned char* const ldsb = (LAS unsigned char*)lds_raw;
    const int wave0 = __builtin_amdgcn_readfirstlane(threadIdx.x >> 6);
    volatile LAS unsigned* MISC = (volatile LAS unsigned*)(ldsb + MISC_OFF);
    if (threadIdx.x < 64) MISC[threadIdx.x] = 0u;
    __syncthreads();
    XcdBarrier bar; bar.bar = (unsigned*)(args.ws + WS_CTL) + CW_BAR; bar.x = 0; bar.st = nullptr;
    if (args.use_bar) bar = xcd_barrier_post((unsigned*)(args.ws + WS_CTL) + CW_BAR, MISC + 8);
    const int lo = args.ph_lo, hi = args.ph_hi;
#define IN(k) (lo <= (k) && (k) < hi)
#define SEAM(k) do { if (IN(k) && IN((k) + 1)) xcd_barrier(bar); } while (0)
    unsigned char* ws = args.ws;
    if (IN(0)) { const Frame F = make_frame(ldsb, wave0); CArgs& AA = *get_args(); phase_prologue(F, AA); } SEAM(0);
    for (int l = 0; l < DEPTH; ++l) {
        const int pb = 1 + l * NPL;
        const float* MODL = (const float*)(ws + WS_MOD) + (size_t)l * 8 * 6144;
        if (IN(pb + 0)) { const Frame F = make_frame(ldsb, wave0); CArgs& AA = *get_args(); phase_norm1(F, AA, l); } SEAM(pb + 0);
        if (IN(pb + 1)) { const Frame F = make_frame(ldsb, wave0); CArgs& AA = *get_args(); pg8::PlainProb P{(const char*)(ws + WS_H), (const char*)(ws + WS_WIN) + (size_t)l * ZS * 1024 * 2, 1024, 1024, 16, 256, 9, F.G, F.bid};
            EpiBf16Plain E{(bf16_t*)(ws + WS_Z), ZS}; pg8::gemm_phase(F.lds, P, E, F.tid); } SEAM(pb + 1);
        if (IN(pb + 2)) { const Frame F = make_frame(ldsb, wave0); CArgs& AA = *get_args(); phase_mla_prep(F, AA, l); } SEAM(pb + 2);
        if (IN(pb + 3)) { const Frame F = make_frame(ldsb, wave0); CArgs& AA = *get_args(); pg8::PlainProb P{(const char*)(ws + WS_AMLA), (const char*)(ws + WS_WMLA) + (size_t)l * 1024 * 512 * 2, 512, 512, 8, 256, 4, F.G, F.bid};
            EpiBf16Plain E{(bf16_t*)(ws + WS_QKVRAW), 1024}; pg8::gemm_phase(F.lds, P, E, F.tid); } SEAM(pb + 3);
        if (IN(pb + 4)) { const Frame F = make_frame(ldsb, wave0); CArgs& AA = *get_args(); phase_mla_post(F, AA, l); } SEAM(pb + 4);
        if (IN(pb + 5)) { const Frame F = make_frame(ldsb, wave0); CArgs& AA = *get_args(); phase_attn(F, AA); } SEAM(pb + 5);
        if (IN(pb + 6)) { const Frame F = make_frame(ldsb, wave0); CArgs& AA = *get_args(); phase_rwkv_prep(F, AA, l); } SEAM(pb + 6);
        if (IN(pb + 7)) { const Frame F = make_frame(ldsb, wave0); CArgs& AA = *get_args(); phase_rwkv_scan(F, AA); } SEAM(pb + 7);
        if (IN(pb + 8)) { const Frame F = make_frame(ldsb, wave0); CArgs& AA = *get_args(); phase_rwkv_fin(F, AA, l); } SEAM(pb + 8);
        if (IN(pb + 9)) { const Frame F = make_frame(ldsb, wave0); CArgs& AA = *get_args(); phase_s5<1>(F, AA, l); } SEAM(pb + 9);
        if (IN(pb + 10)) { const Frame F = make_frame(ldsb, wave0); CArgs& AA = *get_args(); phase_s5<2>(F, AA, l); } SEAM(pb + 10);
        if (IN(pb + 11)) { const Frame F = make_frame(ldsb, wave0); CArgs& AA = *get_args(); pg8::PlainProb P{(const char*)(ws + WS_YS5), (const char*)(ws + WS_WGLU) + (size_t)l * 256 * 256 * 2, 256, 256, 4, 256, 1, F.G, F.bid};
            EpiGlu E{(const bf16_t*)(ws + WS_YS5), (bf16_t*)(ws + WS_YS5G), AA.in[27] + l * 256}; pg8::gemm_phase(F.lds, P, E, F.tid); } SEAM(pb + 11);
        if (IN(pb + 12)) { const Frame F = make_frame(ldsb, wave0); CArgs& AA = *get_args(); phase_lru_prep(F, AA, l); } SEAM(pb + 12);
        if (IN(pb + 13)) { const Frame F = make_frame(ldsb, wave0); CArgs& AA = *get_args(); phase_lru_sum(F, AA); } SEAM(pb + 13);
        if (IN(pb + 14)) { const Frame F = make_frame(ldsb, wave0); CArgs& AA = *get_args(); phase_lru_fin(F, AA); } SEAM(pb + 14);
        if (IN(pb + 15)) { const Frame F = make_frame(ldsb, wave0); CArgs& AA = *get_args(); phase_branch_norm(F, AA, l); } SEAM(pb + 15);
        if (IN(pb + 16)) { const Frame F = make_frame(ldsb, wave0); CArgs& AA = *get_args(); pg8::PlainProb P{(const char*)(ws + WS_MIX), (const char*)(ws + WS_WOUT) + (size_t)l * 1024 * 1024 * 2, 1024, 1024, 16, 256, 4, F.G, F.bid};
            EpiResGate E{l == 0 ? AA.in[0] : AA.out, AA.out, MODL + 2048}; pg8::gemm_phase(F.lds, P, E, F.tid); } SEAM(pb + 16);
        if (IN(pb + 17)) { const Frame F = make_frame(ldsb, wave0); CArgs& AA = *get_args(); phase_norm2_router(F, AA, l); } SEAM(pb + 17);
        if (IN(pb + 18)) { const Frame F = make_frame(ldsb, wave0); CArgs& AA = *get_args(); phase_moe_scatter(F, AA, l); } SEAM(pb + 18);
        const unsigned* META = (const unsigned*)(ws + WS_CTL) + CW_UTAB + l * 1024;
        if (IN(pb + 19)) { const Frame F = make_frame(ldsb, wave0); CArgs& AA = *get_args(); MoeProb1 P{(const char*)(ws + WS_H), (const char*)(ws + WS_WM1), META, (const int*)(ws + WS_RT_SORT), 1024, 1024, 16, F.G, F.bid};
            EpiMoe1 E{(bf16_t*)(ws + WS_HID), META}; pg8::gemm_phase(F.lds, P, E, F.tid); } SEAM(pb + 19);
        if (IN(pb + 20)) { const Frame F = make_frame(ldsb, wave0); CArgs& AA = *get_args(); MoeProb2 P{(const char*)(ws + WS_HID), (const char*)(ws + WS_WM2), META, 512, 512, 8, F.G, F.bid};
            EpiMoe2 E{(bf16_t*)(ws + WS_Y), META, (const int*)(ws + WS_RT_SORT), (const float*)(ws + WS_RT_GATE), MODL + 5120}; pg8::gemm_phase(F.lds, P, E, F.tid); } SEAM(pb + 20);
    }
    if (IN(NPH - 1)) { const Frame F = make_frame(ldsb, wave0); CArgs& AA = *get_args(); phase_final(F, AA); }
#undef IN
#undef SEAM
}

extern "C" void kernel_launch(void* const* d_in, const int* in_sizes, int n_in, void* d_out, int out_size, void* d_ws, size_t ws_size, hipStream_t stream) {
    static int grid = 0;
    if (grid == 0) {
        if (n_in != 51 || ws_size < WS_END) { fprintf(stderr, "kernel_launch: unexpected inputs (n_in %d, ws %zu)\n", n_in, ws_size); grid = -1; return; }
        int dev = 0, cus = 0;
        if (hipGetDevice(&dev) != hipSuccess || hipDeviceGetAttribute(&cus, hipDeviceAttributeMultiprocessorCount, dev) != hipSuccess) { grid = -1; return; }
        if (hipFuncSetAttribute((const void*)mk_fwd, hipFuncAttributeMaxDynamicSharedMemorySize, LDS_BYTES) != hipSuccess) { fprintf(stderr, "kernel_launch: hipFuncSetAttribute failed\n"); grid = -1; return; }
        grid = cus;
    }
    if (grid < 0) return;
    (void)hipMemsetAsync((char*)d_ws + WS_CTL, 0, CTL_ZERO_BYTES, stream);
    Args a{};
    for (int i = 0; i < 51; ++i) a.in[i] = (const float*)d_in[i];
    a.pos_off = (const int*)d_in[2]; a.out = (float*)d_out; a.ws = (unsigned char*)d_ws; a.pad = 0;
#if defined(MK_PER_PHASE)
    a.use_bar = 0;
    for (int p = 0; p < NPH; ++p) { a.ph_lo = p; a.ph_hi = p + 1; hipLaunchKernelGGL(mk_fwd, dim3(grid), dim3(NTHR), LDS_BYTES, stream, a); }
#else
    a.use_bar = 1; a.ph_lo = 0; a.ph_hi = NPH;
    hipLaunchKernelGGL(mk_fwd, dim3(grid), dim3(NTHR), LDS_BYTES, stream, a);
#endif
}
```

```cpp
#include <hip/hip_runtime.h>
#include <cstdio>
#include <cstdint>

#define LAS __attribute__((address_space(3)))
#define GAS __attribute__((address_space(1)))
#define DI __device__ __forceinline__
typedef unsigned short bf16_t;
typedef short bf16x8 __attribute__((ext_vector_type(8)));
typedef short s16x4 __attribute__((ext_vector_type(4)));
typedef float f32x4 __attribute__((ext_vector_type(4)));
typedef float f32x2 __attribute__((ext_vector_type(2)));
typedef float f32x16 __attribute__((ext_vector_type(16)));
typedef unsigned u32x4 __attribute__((ext_vector_type(4)));
typedef unsigned u32x2 __attribute__((ext_vector_type(2)));
typedef __bf16 bf16x2_t __attribute__((ext_vector_type(2)));

constexpr int NB = 8, SEQ = 8192, DM = 1024, T = NB * SEQ, DEPTH = 2;
constexpr int WG = 256;
constexpr int ZS = 2304;
constexpr int ZC_R = 0, ZC_K = 256, ZC_V = 512, ZC_WLO = 768, ZC_ALO = 800, ZC_GLO = 832, ZC_S5 = 896, ZC_QA = 1152, ZC_KVA = 1408, ZC_KPE = 1536, ZC_LX = 1568, ZC_LG = 1824, D_IN = 2080;
constexpr int NEXP = 32, DFF = 512;
constexpr float NORM_EPS = 1e-6f;

DI unsigned f2bf(float f) { unsigned u = __float_as_uint(f); return (u + 0x7fffu + ((u >> 16) & 1u)) >> 16; }
DI unsigned pk2(float lo, float hi) { f32x2 v = {lo, hi}; bf16x2_t b = __builtin_convertvector(v, bf16x2_t); return __builtin_bit_cast(unsigned, b); }
DI float bflo(unsigned u) { return __uint_as_float(u << 16); }
DI float bfhi(unsigned u) { return __uint_as_float(u & 0xffff0000u); }
DI float bf2f(bf16_t b) { return __uint_as_float(((unsigned)b) << 16); }
DI int lane_opaque() { int l = __builtin_amdgcn_mbcnt_hi(-1, __builtin_amdgcn_mbcnt_lo(-1, 0)); asm volatile("" : "+v"(l)); return l; }
DI float shfl_xor_l(float v, int o, int lane) { return __int_as_float(__builtin_amdgcn_ds_bpermute((lane ^ o) << 2, __float_as_int(v))); }
DI float wave_sum(float v) {
    const int l = lane_opaque();
#pragma unroll
    for (int o = 1; o < 64; o <<= 1) v += shfl_xor_l(v, o, l);
    return v;
}
DI float sigmoidf_(float x) { return 1.f / (1.f + __expf(-x)); }
DI float softplusf_(float x) { return fmaxf(x, 0.f) + log1pf(__expf(-fabsf(x))); }
DI float gelu_tanh(float x) { const float u = 0.7978845608028654f * (x + 0.044715f * x * x * x); return 0.5f * x * (1.f + tanhf(u)); }
DI float siluf_(float x) { return x / (1.f + __expf(-x)); }

namespace pg8 {
constexpr int BM = 256, BK = 64, HALF = 128, HTB = HALF * BK * 2, STAGE_BYTES = 8 * HTB;
DI int lds_byte(int r, int c) { const int st = (r >> 4) * 2 + (c >> 5), rr = r & 15, cc = c & 31, ob = rr * 64 + cc * 2; return st * 1024 + (ob ^ (((ob >> 9) & 1) << 5)); }
DI void stage_rc(int b, int& R, int& C) { const int st = b / 1024, sb = b % 1024, swz = sb ^ (((sb >> 9) & 1) << 5); R = (st >> 1) * 16 + swz / 64; C = (st & 1) * 32 + (swz % 64) / 2; }
DI int perm32(int rho) { const int n = rho >> 4, i = rho & 15; return 8 * (i >> 2) + 4 * n + (i & 3); }

struct Unit { int pm, pn, e, blk; };

template <class Epi, class P>
DI void gemm_phase(LAS unsigned char* lds, const P& S, const Epi& E, int tid_in) {
    const int tid = tid_in, wid = __builtin_amdgcn_readfirstlane(tid >> 6), lane = tid & 63, wr = wid >> 2, wc = wid & 3, fr = lane & 15, fq = lane >> 4;
    const int nt = S.nt;
    int Rr[2], Cc[2];
    unsigned voffB[2], offC[2][2], offN[2][2];
#pragma unroll
    for (int i = 0; i < 2; ++i) { int R, C; stage_rc(tid * 16 + i * 8192, R, C); Rr[i] = R; Cc[i] = C; const int Rb = Epi::PERM ? ((R & ~31) + perm32(R & 31)) : R;
        voffB[i] = (unsigned)(Rb * S.ldb + C) * 2u; }
    const size_t kstep = (size_t)(BK * 2);
    const size_t hstepB = (size_t)HALF * S.ldb * 2;
    const unsigned ldsw = (unsigned)wid * 1024u;
    const int aoff = lds_byte(wr * 64 + fr, fq * 8), boff = lds_byte(wc * 32 + fr, fq * 8);
#define PG8_SA(b, h) (((b) * 2 + (h)) * HTB)
#define PG8_SB(b, h) ((4 + (b) * 2 + (h)) * HTB)
#define PG8_STAGE(bufoff, gbase, voff) do { _Pragma("unroll") for (int _i = 0; _i < 2; ++_i) \
        __builtin_amdgcn_global_load_lds((const unsigned*)((const char*)(gbase) + (voff)[_i]), (LAS unsigned*)(lds + (bufoff) + ldsw + _i * 8192), 16, 0, 0); } while (0)
#define PG8_LDA(dst, b, h) do { _Pragma("unroll") for (int m = 0; m < 4; ++m) _Pragma("unroll") for (int k = 0; k < 2; ++k) dst[m][k] = *(const LAS bf16x8*)(lds + PG8_SA(b, h) + aoff + m * 2048 + k * 1024); } while (0)
#define PG8_LDB(dst, b, h) do { _Pragma("unroll") for (int n = 0; n < 2; ++n) _Pragma("unroll") for (int k = 0; k < 2; ++k) dst[n][k] = *(const LAS bf16x8*)(lds + PG8_SB(b, h) + boff + n * 2048 + k * 1024); } while (0)
#define PG8_MMA(ai, bj, At, Bt) do { __builtin_amdgcn_s_setprio(1); _Pragma("unroll") for (int m = 0; m < 4; ++m) _Pragma("unroll") for (int n = 0; n < 2; ++n) _Pragma("unroll") for (int k = 0; k < 2; ++k) \
        acc[ai][bj][m][n] = __builtin_amdgcn_mfma_f32_16x16x32_bf16(Bt[n][k], At[m][k], acc[ai][bj][m][n], 0, 0, 0); __builtin_amdgcn_s_setprio(0); } while (0)
#define PG8_WAIT_V(n) asm volatile("s_waitcnt vmcnt(" #n ")" ::: "memory")
#define PG8_WAIT_L(n) asm volatile("s_waitcnt lgkmcnt(" #n ")" ::: "memory")
#define PG8_BAR __builtin_amdgcn_s_barrier()
#define PG8_SCHED __builtin_amdgcn_sched_barrier(0)
    Unit cur, nxt; int ui = 0;
    if (!S.next(0, cur)) return;
    f32x4 acc[2][2][4][2];
#pragma unroll
    for (int a = 0; a < 2; ++a)
#pragma unroll
        for (int b = 0; b < 2; ++b)
#pragma unroll
            for (int m = 0; m < 4; ++m)
#pragma unroll
                for (int n = 0; n < 2; ++n) acc[a][b][m][n] = (f32x4){0.f, 0.f, 0.f, 0.f};
    bf16x8 At[4][2], B0[2][2], B1[2][2];
    const char* cA = S.a_base(cur); const char* cB = S.b_base(cur);
#pragma unroll
    for (int h = 0; h < 2; ++h)
#pragma unroll
        for (int i = 0; i < 2; ++i) { offC[h][i] = S.a_off(cur, h * HALF + Rr[i]) + (unsigned)Cc[i] * 2u; offN[h][i] = offC[h][i]; }
    PG8_STAGE(PG8_SB(0, 0), cB, voffB); PG8_STAGE(PG8_SB(0, 1), cB + hstepB, voffB); PG8_STAGE(PG8_SA(0, 0), cA, offC[0]); PG8_STAGE(PG8_SA(0, 1), cA, offC[1]);
    if (wr == 1) PG8_BAR;
    PG8_WAIT_V(2); PG8_BAR;
    PG8_STAGE(PG8_SB(1, 0), cB + kstep, voffB); PG8_STAGE(PG8_SA(1, 0), cA + kstep, offC[0]); PG8_STAGE(PG8_SB(1, 1), cB + hstepB + kstep, voffB);
    PG8_WAIT_V(6); PG8_BAR;
    for (;;) {
        const bool has_next = S.next(ui + 1, nxt);
        const char* nA = has_next ? S.a_base(nxt) : cA; const char* nB = has_next ? S.b_base(nxt) : cB;
        for (int t = 0; t < nt; t += 2) {
            const bool last = (t == nt - 2);
            const char* a1 = cA + (size_t)(t + 1) * kstep;
            const char* a2 = last ? nA : cA + (size_t)(t + 2) * kstep; const char* b2 = last ? nB : cB + (size_t)(t + 2) * kstep;
            const char* a3 = a2 + kstep; const char* b3 = b2 + kstep;
            if (last && has_next) {
#pragma unroll
                for (int h = 0; h < 2; ++h)
#pragma unroll
                    for (int i = 0; i < 2; ++i) offN[h][i] = S.a_off(nxt, h * HALF + Rr[i]) + (unsigned)Cc[i] * 2u;
            }
            unsigned o2[2][2];
#pragma unroll
            for (int h = 0; h < 2; ++h)
#pragma unroll
                for (int i = 0; i < 2; ++i) o2[h][i] = last ? offN[h][i] : offC[h][i];
            PG8_LDB(B0, 0, 0); PG8_LDB(B1, 0, 1); PG8_SCHED; PG8_LDA(At, 0, 0); PG8_STAGE(PG8_SA(1, 1), a1, offC[1]);
            PG8_WAIT_V(8); PG8_WAIT_L(0); PG8_BAR; PG8_MMA(0, 0, At, B0); PG8_MMA(0, 1, At, B1); PG8_BAR; PG8_SCHED;
            PG8_LDA(At, 0, 1); PG8_STAGE(PG8_SB(0, 0), b2, voffB); PG8_STAGE(PG8_SB(0, 1), b2 + hstepB, voffB); PG8_STAGE(PG8_SA(0, 0), a2, o2[0]);
            PG8_WAIT_V(8); PG8_WAIT_L(0); PG8_BAR; PG8_MMA(1, 0, At, B0); PG8_MMA(1, 1, At, B1); PG8_BAR; PG8_SCHED;
            PG8_LDB(B0, 1, 0); PG8_LDB(B1, 1, 1); PG8_SCHED; PG8_LDA(At, 1, 0); PG8_STAGE(PG8_SA(0, 1), a2, o2[1]);
            PG8_WAIT_V(8); PG8_WAIT_L(0); PG8_BAR; PG8_MMA(0, 0, At, B0); PG8_MMA(0, 1, At, B1); PG8_BAR; PG8_SCHED;
            PG8_LDA(At, 1, 1); PG8_STAGE(PG8_SB(1, 0), b3, voffB); PG8_STAGE(PG8_SB(1, 1), b3 + hstepB, voffB); PG8_STAGE(PG8_SA(1, 0), a3, o2[0]);
            PG8_WAIT_V(8); PG8_WAIT_L(0); PG8_BAR; PG8_MMA(1, 0, At, B0); PG8_MMA(1, 1, At, B1); PG8_BAR; PG8_SCHED;
        }
        if (wr == 0) PG8_BAR;
        E(acc, cur, wr, wc, fr, fq);
        if (!has_next) break;
#pragma unroll
        for (int a = 0; a < 2; ++a)
#pragma unroll
            for (int b = 0; b < 2; ++b)
#pragma unroll
                for (int m = 0; m < 4; ++m)
#pragma unroll
                    for (int n = 0; n < 2; ++n) acc[a][b][m][n] = (f32x4){0.f, 0.f, 0.f, 0.f};
        cur = nxt; cA = nA; cB = nB; ++ui;
#pragma unroll
        for (int h = 0; h < 2; ++h)
#pragma unroll
            for (int i = 0; i < 2; ++i) offC[h][i] = offN[h][i];
        if (wr == 1) PG8_BAR;
    }
    PG8_WAIT_V(0);
    PG8_BAR;
#undef PG8_SA
#undef PG8_SB
#undef PG8_STAGE
#undef PG8_LDA
#undef PG8_LDB
#undef PG8_MMA
#undef PG8_WAIT_V
#undef PG8_WAIT_L
#undef PG8_BAR
#undef PG8_SCHED
}

struct PlainProb {
    const char* A; const char* Bt; int lda, ldb, nt, nM, nN, G, c;
    DI bool next(int i, Unit& u) const {
        const long L = (long)i * G + c; const int nwg = nM * nN; if (L >= nwg) return false;
        int wgid = (int)L; { const int q = nwg / 8, r = nwg % 8, xcd = wgid % 8, off = wgid / 8; wgid = (xcd < r ? xcd * (q + 1) : r * (q + 1) + (xcd - r) * q) + off; }
        const int nig = 8 * nN, gid = wgid / nig, fm = gid * 8, gsz = (nM - fm) < 8 ? (nM - fm) : 8;
        u.pm = fm + ((wgid % nig) % gsz); u.pn = (wgid % nig) / gsz; u.e = 0; u.blk = 0; return true;
    }
    DI const char* a_base(const Unit& u) const { return A + (size_t)u.pm * 256 * lda * 2; }
    DI const char* b_base(const Unit& u) const { return Bt + (size_t)u.pn * 256 * ldb * 2; }
    DI unsigned a_off(const Unit&, int row) const { return (unsigned)row * (unsigned)lda * 2u; }
};
}

constexpr size_t MiB = 1u << 20;
constexpr size_t WS_CTL = 0, CTL_ZERO_BYTES = 1 * MiB;
constexpr size_t WS_MOD = 1 * MiB;
constexpr size_t WS_RT_EID = 3 * MiB;
constexpr size_t WS_RT_GATE = WS_RT_EID + 512 * 1024;
constexpr size_t WS_RT_PIE = WS_RT_GATE + 512 * 1024;
constexpr size_t WS_RT_SORT = WS_RT_PIE + 512 * 1024;
constexpr size_t WS_WIN = 8 * MiB;
constexpr size_t WS_WOUT = 17 * MiB;
constexpr size_t WS_WMLA = 21 * MiB;
constexpr size_t WS_WGLU = 23 * MiB;
constexpr size_t WS_H = 24 * MiB;
constexpr size_t WS_Z = 152 * MiB;
constexpr size_t WS_WM1 = WS_Z;
constexpr size_t WS_WM2 = WS_Z + 64 * MiB;
constexpr size_t WS_MIX = 440 * MiB;
constexpr size_t WS_HID = WS_MIX;
constexpr size_t WS_Y = 569 * MiB;
constexpr size_t WS_Q = 825 * MiB;
constexpr size_t WS_K = 873 * MiB;
constexpr size_t WS_VT = 921 * MiB;
constexpr size_t WS_TAIL = 953 * MiB;
constexpr size_t WS_END = 1017 * MiB;
constexpr size_t WS_AMLA = WS_TAIL;
constexpr size_t WS_QKVRAW = WS_Y;
constexpr size_t WS_ATTO = WS_H;
constexpr size_t WS_RW_R = WS_Y, WS_RW_K = WS_Y + 32 * MiB, WS_RW_V = WS_Y + 64 * MiB, WS_RW_KK = WS_Y + 96 * MiB, WS_RW_B = WS_Y + 128 * MiB, WS_RW_G = WS_Y + 160 * MiB;
constexpr size_t WS_RW_W = WS_Y + 192 * MiB;
constexpr size_t WS_RC_RP = WS_H + 32 * MiB;
constexpr size_t WS_RC_MP = WS_H + 64 * MiB;
constexpr size_t WS_RC_HB = WS_H + 96 * MiB;
constexpr size_t WS_RC_Y0 = WS_Q;
constexpr size_t WS_RC_G = WS_Q + 64 * MiB;
constexpr size_t WS_RC_DP = WS_TAIL;
constexpr size_t WS_RC_BS = WS_TAIL + 1 * MiB;
constexpr size_t WS_YS5 = WS_H + 96 * MiB;
constexpr size_t WS_YS5G = WS_TAIL;
constexpr size_t WS_YL = WS_TAIL + 32 * MiB;
constexpr size_t WS_LA = WS_Y, WS_LB = WS_Y + 64 * MiB;
constexpr size_t WS_S5END = 2 * MiB;
constexpr size_t WS_LSUM = 5 * MiB + 512 * 1024;
static_assert(WS_RT_SORT + 512 * 1024 <= WS_LSUM && WS_LSUM + 2 * MiB <= WS_WIN && WS_S5END + 1 * MiB <= WS_RT_EID, "map");

constexpr int CW_BAR = 4096;
constexpr int CW_CNT = 16384;
constexpr int CW_UTAB = 20480;

constexpr int NWAVES = 8, NTHR = 512;
constexpr int LDS_BYTES = 155648;
constexpr int MISC_OFF = 155648 - 256;

struct Args { const float* in[51]; const int* pos_off; float* out; unsigned char* ws; int ph_lo, ph_hi, use_bar, pad; };
typedef const __attribute__((address_space(4))) Args CArgs;
DI CArgs* get_args() { CArgs* ap = (CArgs*)__builtin_amdgcn_kernarg_segment_ptr(); asm volatile("" : "+s"(ap)); return ap; }

#define XB_TMO      128
#define XB_XCNT(j)  (256  + 64 * (j))
#define XB_XSUB(j)  (1280 + 64 * (j))
#define XB_XGEN(j)  (2304 + 64 * (j))
#define XB_TOP      3328
#define XB_TOPGEN   3392
#define XCD_BAR_WORDS 3456
#define XB_SPIN_CAP (1u << 18)
DI unsigned xb_ld(unsigned* p)              { return __hip_atomic_load(p, __ATOMIC_RELAXED, __HIP_MEMORY_SCOPE_AGENT); }
DI unsigned xb_add(unsigned* p, unsigned v) { return __hip_atomic_fetch_add(p, v, __ATOMIC_RELAXED, __HIP_MEMORY_SCOPE_AGENT); }
DI unsigned xb_xcc_id() { return (unsigned)__builtin_amdgcn_s_getreg((3 << 11) | 20) & 0xFu; }
#define XB_SPIN(cond, bar) do { unsigned _sp = 0; while (cond) { __builtin_amdgcn_s_sleep(1); \
    if ((++_sp & 255u) == 0u) { if (xb_ld(&(bar)[XB_TMO])) break; if (_sp > XB_SPIN_CAP) { atomicAdd(&(bar)[XB_TMO], 1u); break; } } } } while (0)
struct XcdBarrier { unsigned* bar; unsigned x; volatile LAS unsigned* st; };
DI XcdBarrier xcd_barrier_post(unsigned* bar, volatile LAS unsigned* st) {
    XcdBarrier b; b.bar = bar; b.x = xb_xcc_id(); b.st = st;
    if (threadIdx.x == 0) (void)xb_add(&bar[XB_XCNT(b.x)], 1u);
    return b;
}
DI void xcd_barrier_complete(unsigned* bar, unsigned x, unsigned& nloc, unsigned& nx) {
    const unsigned G = gridDim.x * gridDim.y * gridDim.z;
    unsigned sum, cnt, mine, sp = 0u;
    for (;;) {
        sum = 0u; cnt = 0u; mine = 0u;
#pragma unroll
        for (unsigned j = 0; j < 16; ++j) { const unsigned c = xb_ld(&bar[XB_XCNT(j)]); sum += c; cnt += (c > 0u) ? 1u : 0u; mine = (j == x) ? c : mine; }
        if (sum == G) break;
        __builtin_amdgcn_s_sleep(1);
        if ((++sp & 255u) == 0u) { if (xb_ld(&bar[XB_TMO])) break; if (sp > XB_SPIN_CAP) { atomicAdd(&bar[XB_TMO], 1u); break; } }
    }
    nloc = mine > 0u ? mine : 1u; nx = cnt > 0u ? cnt : 1u;
}
DI void xcd_barrier(const XcdBarrier& b) {
    asm volatile("s_waitcnt vmcnt(0)" ::: "memory");
    __syncthreads();
    if (threadIdx.x == 0) {
        unsigned* bar = b.bar;
        __builtin_amdgcn_s_waitcnt(0);
        unsigned nloc = b.st[0], nx = b.st[1];
        if (nloc == 0u) { xcd_barrier_complete(bar, b.x, nloc, nx); b.st[0] = nloc; b.st[1] = nx; }
        const unsigned old = xb_add(&bar[XB_XSUB(b.x)], 1u);
        const unsigned gen = old / nloc;
        if (old + 1u == (gen + 1u) * nloc) {
            __builtin_amdgcn_fence(__ATOMIC_RELEASE, "agent");
            asm volatile("s_waitcnt vmcnt(0)" ::: "memory");
            const unsigned og = xb_add(&bar[XB_TOP], 1u);
            const unsigned tg = og / nx;
            if (og + 1u == (tg + 1u) * nx) xb_add(&bar[XB_TOPGEN], 1u);
            else XB_SPIN(xb_ld(&bar[XB_TOPGEN]) == tg, bar);
            __builtin_amdgcn_fence(__ATOMIC_ACQUIRE, "agent");
            xb_add(&bar[XB_XGEN(b.x)], 1u);
            asm volatile("s_waitcnt vmcnt(0)" ::: "memory");
        } else {
            XB_SPIN(xb_ld(&bar[XB_XGEN(b.x)]) == gen, bar);
            __builtin_amdgcn_fence(__ATOMIC_ACQUIRE, "agent");
            asm volatile("s_waitcnt vmcnt(0)" ::: "memory");
        }
    }
    __syncthreads();
}

struct EpiBf16Plain {
    static constexpr bool PERM = true;
    bf16_t* O; int ldc;
    DI void operator()(const f32x4 (&acc)[2][2][4][2], const pg8::Unit& u, int wr, int wc, int fr, int fq) const {
        const int row0 = u.pm * 256 + wr * 64 + fr, col0 = u.pn * 256 + wc * 32 + 8 * fq;
#pragma unroll
        for (int ai = 0; ai < 2; ++ai)
#pragma unroll
            for (int m = 0; m < 4; ++m) { bf16_t* rowp = O + (size_t)(row0 + ai * 128 + m * 16) * ldc + col0;
#pragma unroll
                for (int bj = 0; bj < 2; ++bj) { const f32x4 v0 = acc[ai][bj][m][0], v1 = acc[ai][bj][m][1];
                    u32x4 w; w.x = pk2(v0[0], v0[1]); w.y = pk2(v0[2], v0[3]); w.z = pk2(v1[0], v1[1]); w.w = pk2(v1[2], v1[3]);
                    *(u32x4*)(rowp + bj * 128) = w; } }
    }
};
struct EpiResGate {
    static constexpr bool PERM = false;
    const float* xin; float* out; const float* gt;
    DI void operator()(const f32x4 (&acc)[2][2][4][2], const pg8::Unit& u, int wr, int wc, int fr, int fq) const {
        const int row0 = u.pm * 256 + wr * 64 + fr, col0 = u.pn * 256 + wc * 32 + 4 * fq;
        const int b = (u.pm * 256) / SEQ;
        f32x4 g[2][2];
#pragma unroll
        for (int bj = 0; bj < 2; ++bj)
#pragma unroll
            for (int n = 0; n < 2; ++n) g[bj][n] = *(const f32x4*)(gt + (size_t)b * 6144 + col0 + bj * 128 + n * 16);
#pragma unroll
        for (int ai = 0; ai < 2; ++ai)
#pragma unroll
            for (int m = 0; m < 4; ++m) { const size_t ro = (size_t)(row0 + ai * 128 + m * 16) * DM + col0;
#pragma unroll
                for (int bj = 0; bj < 2; ++bj)
#pragma unroll
                    for (int n = 0; n < 2; ++n) { const f32x4 xv = *(const f32x4*)(xin + ro + bj * 128 + n * 16);
                        *(f32x4*)(out + ro + bj * 128 + n * 16) = xv + g[bj][n] * acc[ai][bj][m][n]; } }
    }
};
struct EpiGlu {
    static constexpr bool PERM = true;
    const bf16_t* Y; bf16_t* O; const float* bias;
    DI void operator()(const f32x4 (&acc)[2][2][4][2], const pg8::Unit& u, int wr, int wc, int fr, int fq) const {
        const int row0 = u.pm * 256 + wr * 64 + fr, col0 = wc * 32 + 8 * fq;
#pragma unroll
        for (int ai = 0; ai < 2; ++ai)
#pragma unroll
            for (int m = 0; m < 4; ++m) { const size_t ro = (size_t)(row0 + ai * 128 + m * 16) * 256 + col0;
#pragma unroll
                for (int bj = 0; bj < 2; ++bj) { const u32x4 yv = *(const u32x4*)(Y + ro + bj * 128);
                    const f32x4 b0 = *(const f32x4*)(bias + col0 + bj * 128), b1 = *(const f32x4*)(bias + col0 + bj * 128 + 4);
                    const f32x4 v0 = acc[ai][bj][m][0] + b0, v1 = acc[ai][bj][m][1] + b1;
                    u32x4 w;
                    w.x = pk2(bflo(yv.x) * sigmoidf_(v0[0]), bfhi(yv.x) * sigmoidf_(v0[1]));
                    w.y = pk2(bflo(yv.y) * sigmoidf_(v0[2]), bfhi(yv.y) * sigmoidf_(v0[3]));
                    w.z = pk2(bflo(yv.z) * sigmoidf_(v1[0]), bfhi(yv.z) * sigmoidf_(v1[1]));
                    w.w = pk2(bflo(yv.w) * sigmoidf_(v1[2]), bfhi(yv.w) * sigmoidf_(v1[3]));
                    *(u32x4*)(O + ro + bj * 128) = w; } }
    }
};

struct Frame { LAS unsigned char* lds; int tid, lane, wave, G, bid, gw, ngw; };

DI Frame make_frame(LAS unsigned char* lds, int wave0) {
    Frame F; F.lds = lds; int w = wave0; asm volatile("" : "+s"(w)); F.wave = w; F.lane = lane_opaque(); F.tid = w * 64 + F.lane;
    F.G = gridDim.x; F.bid = blockIdx.x; F.gw = F.bid * NWAVES + F.wave; F.ngw = F.G * NWAVES; return F;
}
DI void transpose_item(const float* src, int ld_src, int k0, int n0, bf16_t* dst, int ldd, int nd0, int kd0, LAS float* scr, int lane) {
#pragma unroll 8
    for (int i = 0; i < 32; ++i) { const int kk = 2 * i + (lane >> 5); scr[kk * 33 + (lane & 31)] = src[(size_t)(k0 + kk) * ld_src + n0 + (lane & 31)]; }
    asm volatile("s_waitcnt lgkmcnt(0)" ::: "memory");
    const int c = lane & 7;
#pragma unroll
    for (int j = 0; j < 4; ++j) { const int n = (lane >> 3) + 8 * j; const LAS float* s = scr + (8 * c) * 33 + n;
        u32x4 o; o.x = pk2(s[0 * 33], s[1 * 33]); o.y = pk2(s[2 * 33], s[3 * 33]); o.z = pk2(s[4 * 33], s[5 * 33]); o.w = pk2(s[6 * 33], s[7 * 33]);
        *(u32x4*)(dst + (size_t)(nd0 + n) * ldd + kd0 + 8 * c) = o; }
    asm volatile("s_waitcnt lgkmcnt(0)" ::: "memory");
}
DI void zero_rows(bf16_t* dst, int ld, int r0, int nr, int c0, int nc, int gw, int ngw, int lane) {
    for (int r = gw; r < nr; r += ngw) for (int c = lane * 8; c < nc; c += 512) *(u32x4*)(dst + (size_t)(r0 + r) * ld + c0 + c) = (u32x4){0u, 0u, 0u, 0u};
}

DI void phase_prologue(const Frame& F, CArgs& A) {
    unsigned char* ws = A.ws;
    LAS float* sc = (LAS float*)F.lds;
    LAS float* part = (LAS float*)(F.lds + 32768);
    for (int i = F.tid; i < 8192; i += NTHR) sc[i] = siluf_(A.in[1][i]);
    __syncthreads();
    float* MOD = (float*)(ws + WS_MOD);
    for (int item = F.bid; item < 192; item += F.G) {
        const int l = item / 96, n0 = (item % 96) * 64, nl = F.tid & 63, kg = F.tid >> 6;
        const float* W = A.in[3] + (size_t)l * 1024 * 6144 + n0 + nl;
        float acc[8];
#pragma unroll
        for (int b = 0; b < 8; ++b) acc[b] = 0.f;
        for (int k = kg * 128; k < kg * 128 + 128; ++k) { const float w = W[(size_t)k * 6144];
#pragma unroll
            for (int b = 0; b < 8; ++b) acc[b] += sc[b * 1024 + k] * w; }
#pragma unroll
        for (int b = 0; b < 8; ++b) part[(kg * 8 + b) * 64 + nl] = acc[b];
        __syncthreads();
        { const int b = F.tid >> 6; float s = A.in[4][l * 6144 + n0 + nl];
#pragma unroll
          for (int g = 0; g < 8; ++g) s += part[(g * 8 + b) * 64 + nl];
          MOD[((size_t)l * 8 + b) * 6144 + n0 + nl] = s; }
        __syncthreads();
    }
    LAS float* scr = (LAS float*)(F.lds + F.wave * 8448);
    bf16_t* WIN = (bf16_t*)(ws + WS_WIN); bf16_t* WOUT = (bf16_t*)(ws + WS_WOUT); bf16_t* WMLA = (bf16_t*)(ws + WS_WMLA); bf16_t* WGLU = (bf16_t*)(ws + WS_WGLU);
    constexpr int I_IN = 16 * 65, I_OUT = 16 * 32, I_Q = 4 * 12, I_KV = 2 * 16, I_GLU = 4 * 8, I_L = I_IN + I_OUT + I_Q + I_KV + I_GLU;
    for (int it = F.gw; it < 2 * I_L; it += F.ngw) {
        const int l = it / I_L; int r = it % I_L;
        if (r < I_IN) { transpose_item(A.in[6] + (size_t)l * 1024 * D_IN, D_IN, 64 * (r / 65), 32 * (r % 65), WIN + (size_t)l * ZS * 1024, 1024, 32 * (r % 65), 64 * (r / 65), scr, F.lane); continue; } r -= I_IN;
        if (r < I_OUT) { transpose_item(A.in[42] + (size_t)l * 1024 * 1024, 1024, 64 * (r / 32), 32 * (r % 32), WOUT + (size_t)l * 1024 * 1024, 1024, 32 * (r % 32), 64 * (r / 32), scr, F.lane); continue; } r -= I_OUT;
        if (r < I_Q) { transpose_item(A.in[29] + (size_t)l * 256 * 384, 384, 64 * (r / 12), 32 * (r % 12), WMLA + (size_t)l * 1024 * 512, 512, 32 * (r % 12), 64 * (r / 12), scr, F.lane); continue; } r -= I_Q;
        if (r < I_KV) { transpose_item(A.in[31] + (size_t)l * 128 * 512, 512, 64 * (r / 16), 32 * (r % 16), WMLA + (size_t)l * 1024 * 512, 512, 384 + 32 * (r % 16), 256 + 64 * (r / 16), scr, F.lane); continue; } r -= I_KV;
        transpose_item(A.in[26] + (size_t)l * 256 * 256, 256, 64 * (r / 8), 32 * (r % 8), WGLU + (size_t)l * 256 * 256, 256, 32 * (r % 8), 64 * (r / 8), scr, F.lane);
    }
    for (int l = 0; l < 2; ++l) {
        zero_rows(WIN + (size_t)l * ZS * 1024, 1024, D_IN, ZS - D_IN, 0, 1024, F.gw, F.ngw, F.lane);
        bf16_t* wm = WMLA + (size_t)l * 1024 * 512;
        zero_rows(wm, 512, 0, 384, 256, 256, F.gw, F.ngw, F.lane);
        zero_rows(wm, 512, 384, 512, 0, 256, F.gw, F.ngw, F.lane);
        zero_rows(wm, 512, 384, 512, 384, 128, F.gw, F.ngw, F.lane);
        zero_rows(wm, 512, 896, 128, 0, 512, F.gw, F.ngw, F.lane);
    }
}

DI void phase_norm1(const Frame& F, CArgs& A, int l) {
    const float* MODL = (const float*)(A.ws + WS_MOD) + (size_t)l * 8 * 6144;
    const float* g = A.in[5] + l * 1024;
    const bf16_t* Y = (const bf16_t*)(A.ws + WS_Y);
    bf16_t* H = (bf16_t*)(A.ws + WS_H);
    const float* src = (l == 0) ? A.in[0] : A.out;
    for (int row = F.gw; row < T; row += F.ngw) {
        const int b = row / SEQ;
        f32x4 v[4]; float ss = 0.f;
#pragma unroll
        for (int j = 0; j < 4; ++j) { const int col = 4 * (64 * j + F.lane);
            v[j] = *(const f32x4*)(src + (size_t)row * DM + col);
            if (l > 0) { const u32x2 y0 = *(const u32x2*)(Y + (size_t)(2 * row) * DM + col), y1 = *(const u32x2*)(Y + (size_t)(2 * row + 1) * DM + col);
                v[j][0] += bflo(y0.x) + bflo(y1.x); v[j][1] += bfhi(y0.x) + bfhi(y1.x); v[j][2] += bflo(y0.y) + bflo(y1.y); v[j][3] += bfhi(y0.y) + bfhi(y1.y);
                *(f32x4*)(A.out + (size_t)row * DM + col) = v[j]; }
            ss += v[j][0] * v[j][0] + v[j][1] * v[j][1] + v[j][2] * v[j][2] + v[j][3] * v[j][3]; }
        const float rstd = rsqrtf(wave_sum(ss) * (1.f / DM) + NORM_EPS);
#pragma unroll
        for (int j = 0; j < 4; ++j) { const int col = 4 * (64 * j + F.lane);
            const f32x4 gg = *(const f32x4*)(g + col), sh = *(const f32x4*)(MODL + (size_t)b * 6144 + col), scv = *(const f32x4*)(MODL + (size_t)b * 6144 + 1024 + col);
            const f32x4 hv = v[j] * rstd * gg * (scv + 1.f) + sh;
            u32x2 o; o.x = pk2(hv[0], hv[1]); o.y = pk2(hv[2], hv[3]);
            *(u32x2*)(H + (size_t)row * DM + col) = o; }
    }
}

DI void phase_mla_prep(const Frame& F, CArgs& A, int l) {
    const bf16_t* Z = (const bf16_t*)(A.ws + WS_Z); bf16_t* AM = (bf16_t*)(A.ws + WS_AMLA);
    const float* qg = A.in[28] + l * 256; const float* kg = A.in[30] + l * 128;
    for (int row = F.gw; row < T; row += F.ngw) {
        const bf16_t* zr = Z + (size_t)row * ZS;
        const u32x2 qv = *(const u32x2*)(zr + ZC_QA + 4 * F.lane); const unsigned kv = *(const unsigned*)(zr + ZC_KVA + 2 * F.lane);
        const float q0 = bflo(qv.x), q1 = bfhi(qv.x), q2 = bflo(qv.y), q3 = bfhi(qv.y), k0 = bflo(kv), k1 = bfhi(kv);
        const float rq = rsqrtf(wave_sum(q0 * q0 + q1 * q1 + q2 * q2 + q3 * q3) * (1.f / 256.f) + NORM_EPS);
        const float rk = rsqrtf(wave_sum(k0 * k0 + k1 * k1) * (1.f / 128.f) + NORM_EPS);
        const f32x4 g4 = *(const f32x4*)(qg + 4 * F.lane); const f32x2 g2 = *(const f32x2*)(kg + 2 * F.lane);
        u32x2 o; o.x = pk2(q0 * rq * g4[0], q1 * rq * g4[1]); o.y = pk2(q2 * rq * g4[2], q3 * rq * g4[3]);
        bf16_t* ar = AM + (size_t)row * 512;
        *(u32x2*)(ar + 4 * F.lane) = o;
        *(unsigned*)(ar + 256 + 2 * F.lane) = pk2(k0 * rk * g2[0], k1 * rk * g2[1]);
        *(unsigned*)(ar + 384 + 2 * F.lane) = 0u;
    }
}

DI void phase_mla_post(const Frame& F, CArgs& A, int l) {
    const bf16_t* Z = (const bf16_t*)(A.ws + WS_Z); const bf16_t* RAW = (const bf16_t*)(A.ws + WS_QKVRAW);
    bf16_t* Q = (bf16_t*)(A.ws + WS_Q); bf16_t* K = (bf16_t*)(A.ws + WS_K); bf16_t* VT = (bf16_t*)(A.ws + WS_VT);
    LAS float* cs = (LAS float*)F.lds;
    LAS bf16_t* vt = (LAS bf16_t*)(F.lds + 8192);
    const float* qhg = A.in[32] + l * 96; const float* khg = A.in[33] + l * 96;
    for (int tile = F.bid; tile < T / 64; tile += F.G) {
        const int t0 = tile * 64, b = t0 / SEQ, s0 = t0 % SEQ;
        int tz = F.tid; asm volatile("" : "+v"(tz));
        for (int idx = tz; idx < 1024; idx += NTHR) { const int tok = idx >> 4, i = idx & 15;
            const int pos = A.pos_off[b] + s0 + tok; const float inv = powf(10000.f, -(float)i * (1.f / 16.f));
            double ang = (double)(float)pos * (double)inv; ang -= 6.283185307179586 * floor(ang * 0.15915494309189535);
            float sn, cn; sincosf((float)ang, &sn, &cn); cs[idx * 2] = cn; cs[idx * 2 + 1] = sn; }
        __syncthreads();
        const int tok = tz >> 3, sub = tz & 7, h = sub >> 1, isk = sub & 1, t = t0 + tok;
        {
            float v[96];
            const bf16_t* p0 = isk ? RAW + (size_t)t * 1024 + 384 + 128 * h : RAW + (size_t)t * 1024 + 96 * h;
            const bf16_t* p1 = isk ? Z + (size_t)t * ZS + ZC_KPE : p0 + 64;
#pragma unroll
            for (int c = 0; c < 8; ++c) { const u32x4 w = *(const u32x4*)(p0 + 8 * c);
                v[8 * c] = bflo(w.x); v[8 * c + 1] = bfhi(w.x); v[8 * c + 2] = bflo(w.y); v[8 * c + 3] = bfhi(w.y); v[8 * c + 4] = bflo(w.z); v[8 * c + 5] = bfhi(w.z); v[8 * c + 6] = bflo(w.w); v[8 * c + 7] = bfhi(w.w); }
#pragma unroll
            for (int c = 0; c < 4; ++c) { const u32x4 w = *(const u32x4*)(p1 + 8 * c);
                v[64 + 8 * c] = bflo(w.x); v[65 + 8 * c] = bfhi(w.x); v[66 + 8 * c] = bflo(w.y); v[67 + 8 * c] = bfhi(w.y); v[68 + 8 * c] = bflo(w.z); v[69 + 8 * c] = bfhi(w.z); v[70 + 8 * c] = bflo(w.w); v[71 + 8 * c] = bfhi(w.w); }
            float ss = 0.f;
#pragma unroll
            for (int i = 0; i < 96; ++i) ss += v[i] * v[i];
            const float r = rsqrtf(ss * (1.f / 96.f) + NORM_EPS);
            const float* hg = isk ? khg : qhg;
#pragma unroll
            for (int i = 0; i < 96; ++i) v[i] = v[i] * r * hg[i];
#pragma unroll
            for (int i = 0; i < 16; ++i) { const float cn = cs[(tok * 16 + i) * 2], sn = cs[(tok * 16 + i) * 2 + 1]; const float x1 = v[64 + i], x2 = v[80 + i];
                v[64 + i] = x1 * cn - x2 * sn; v[80 + i] = x1 * sn + x2 * cn; }
            bf16_t* dst = (isk ? K : Q) + ((size_t)t * 4 + h) * 96;
#pragma unroll
            for (int c = 0; c < 12; ++c) { u32x4 w; w.x = pk2(v[8 * c], v[8 * c + 1]); w.y = pk2(v[8 * c + 2], v[8 * c + 3]); w.z = pk2(v[8 * c + 4], v[8 * c + 5]); w.w = pk2(v[8 * c + 6], v[8 * c + 7]);
                *(u32x4*)(dst + 8 * c) = w; }
        }
        {
            const bf16_t* pv = RAW + (size_t)t * 1024 + 384 + 128 * h + 64 + 32 * isk;
#pragma unroll
            for (int c = 0; c < 4; ++c) { const u32x4 w = *(const u32x4*)(pv + 8 * c); const int r0 = h * 64 + 32 * isk + 8 * c;
                vt[(r0 + 0) * 72 + tok] = (bf16_t)(w.x & 0xffffu); vt[(r0 + 1) * 72 + tok] = (bf16_t)(w.x >> 16);
                vt[(r0 + 2) * 72 + tok] = (bf16_t)(w.y & 0xffffu); vt[(r0 + 3) * 72 + tok] = (bf16_t)(w.y >> 16);
                vt[(r0 + 4) * 72 + tok] = (bf16_t)(w.z & 0xffffu); vt[(r0 + 5) * 72 + tok] = (bf16_t)(w.z >> 16);
                vt[(r0 + 6) * 72 + tok] = (bf16_t)(w.w & 0xffffu); vt[(r0 + 7) * 72 + tok] = (bf16_t)(w.w >> 16); }
        }
        __syncthreads();
        { const int row = tz >> 1, hf = tz & 1;
          bf16_t* dst = VT + ((size_t)(b * 4) * 64 + row) * SEQ + s0 + 32 * hf;
#pragma unroll
          for (int c = 0; c < 4; ++c) *(u32x4*)(dst + 8 * c) = *(const LAS u32x4*)(vt + row * 72 + 32 * hf + 8 * c); }
        __syncthreads();
    }
}

DI void attn_unit(const Frame& F, const bf16_t* Q, const bf16_t* K, const bf16_t* VT, bf16_t* O, int bh, int u) {
    constexpr int KP = 208, VP = 144, KB = 64 * KP, VB = 64 * VP;
    LAS unsigned char* Ks = F.lds; LAS unsigned char* Vs = F.lds + 2 * KB;
    const int b = bh >> 2, h = bh & 3, lane = F.lane, w = F.wave, ql = lane & 31, hh = lane >> 5;
    const int ntile = 4 * u + 4, myl = 4 * u + (w >> 1);
    const size_t tq = (size_t)b * SEQ + 256 * u + 32 * w + ql;
    bf16x8 qf[6];
#pragma unroll
    for (int s = 0; s < 6; ++s) qf[s] = *(const bf16x8*)(Q + (tq * 4 + h) * 96 + 16 * s + 8 * hh);
    f32x16 ot[2];
#pragma unroll
    for (int i = 0; i < 16; ++i) { ot[0][i] = 0.f; ot[1][i] = 0.f; }
    float mrun = -INFINITY, lrun = 0.f;
    const float c2 = 0.10206207261596577f * 1.4426950408889634f;
    const int kp0 = F.tid, kp1 = F.tid + 512;
    const size_t kbase = ((size_t)b * SEQ * 4 + h) * 96;
    const bf16_t* vsrc = VT + ((size_t)bh * 64 + (F.tid >> 3)) * SEQ + 8 * (F.tid & 7);
    u32x4 rk0, rk1, rv;
    rk1 = (u32x4){0u, 0u, 0u, 0u};
#define ATT_LOAD(j) do { rk0 = *(const u32x4*)(K + kbase + (size_t)(64 * (j) + kp0 / 12) * 384 + 8 * (kp0 % 12)); \
        if (kp1 < 768) rk1 = *(const u32x4*)(K + kbase + (size_t)(64 * (j) + kp1 / 12) * 384 + 8 * (kp1 % 12)); \
        rv = *(const u32x4*)(vsrc + 64 * (j)); } while (0)
#define ATT_STORE(buf) do { *(LAS u32x4*)(Ks + (buf) * KB + (kp0 / 12) * KP + (kp0 % 12) * 16) = rk0; \
        if (kp1 < 768) *(LAS u32x4*)(Ks + (buf) * KB + (kp1 / 12) * KP + (kp1 % 12) * 16) = rk1; \
        *(LAS u32x4*)(Vs + (buf) * VB + (F.tid >> 3) * VP + (F.tid & 7) * 16) = rv; } while (0)
    ATT_LOAD(0); ATT_STORE(0);
    __syncthreads();
    for (int j = 0; j < ntile; ++j) {
        const int buf = j & 1;
        if (j + 1 < ntile) ATT_LOAD(j + 1);
        if (j <= myl) {
            f32x16 st[2];
#pragma unroll
            for (int kt = 0; kt < 2; ++kt) {
#pragma unroll
                for (int i = 0; i < 16; ++i) st[kt][i] = 0.f;
#pragma unroll
                for (int s = 0; s < 6; ++s) { const bf16x8 kf = *(const LAS bf16x8*)(Ks + buf * KB + (32 * kt + ql) * KP + (16 * s + 8 * hh) * 2);
                    st[kt] = __builtin_amdgcn_mfma_f32_32x32x16_bf16(kf, qf[s], st[kt], 0, 0, 0); }
            }
            float mx = st[0][0];
#pragma unroll
            for (int i = 1; i < 16; ++i) mx = fmaxf(mx, st[0][i]);
#pragma unroll
            for (int i = 0; i < 16; ++i) mx = fmaxf(mx, st[1][i]);
            mx = fmaxf(mx, shfl_xor_l(mx, 32, lane));
            const float mnew = fmaxf(mrun, mx), alpha = __builtin_amdgcn_exp2f((mrun - mnew) * c2), mc = mnew * c2;
            mrun = mnew;
            float ps = 0.f;
#pragma unroll
            for (int kt = 0; kt < 2; ++kt)
#pragma unroll
                for (int i = 0; i < 16; ++i) { const float p = __builtin_amdgcn_exp2f(st[kt][i] * c2 - mc); st[kt][i] = p; ps += p; }
            lrun = lrun * alpha + ps;
#pragma unroll
            for (int i = 0; i < 16; ++i) { ot[0][i] *= alpha; ot[1][i] *= alpha; }
#pragma unroll
            for (int kt = 0; kt < 2; ++kt)
#pragma unroll
                for (int c = 0; c < 2; ++c) {
                    u32x4 pw; pw.x = pk2(st[kt][8 * c], st[kt][8 * c + 1]); pw.y = pk2(st[kt][8 * c + 2], st[kt][8 * c + 3]); pw.z = pk2(st[kt][8 * c + 4], st[kt][8 * c + 5]); pw.w = pk2(st[kt][8 * c + 6], st[kt][8 * c + 7]);
                    const bf16x8 pf = __builtin_bit_cast(bf16x8, pw);
                    const int key0 = 32 * kt + 16 * c + 4 * hh;
#pragma unroll
                    for (int dt = 0; dt < 2; ++dt) { const LAS unsigned char* vp = Vs + buf * VB + (32 * dt + ql) * VP + key0 * 2;
                        const u32x2 v0 = *(const LAS u32x2*)vp, v1 = *(const LAS u32x2*)(vp + 16);
                        u32x4 vw; vw.x = v0.x; vw.y = v0.y; vw.z = v1.x; vw.w = v1.y;
                        ot[dt] = __builtin_amdgcn_mfma_f32_32x32x16_bf16(__builtin_bit_cast(bf16x8, vw), pf, ot[dt], 0, 0, 0); }
                }
        }
        if (j + 1 < ntile) ATT_STORE(buf ^ 1);
        __syncthreads();
    }
#undef ATT_LOAD
#undef ATT_STORE
    const float linv = 1.f / (lrun + shfl_xor_l(lrun, 32, lane));
    bf16_t* orow = O + tq * 256 + h * 64;
#pragma unroll
    for (int dt = 0; dt < 2; ++dt)
#pragma unroll
        for (int g = 0; g < 4; ++g) { u32x2 o; o.x = pk2(ot[dt][4 * g] * linv, ot[dt][4 * g + 1] * linv); o.y = pk2(ot[dt][4 * g + 2] * linv, ot[dt][4 * g + 3] * linv);
            *(u32x2*)(orow + 32 * dt + 8 * g + 4 * hh) = o; }
}
DI void phase_attn(const Frame& F, CArgs& A) {
    const bf16_t* Q = (const bf16_t*)(A.ws + WS_Q); const bf16_t* K = (const bf16_t*)(A.ws + WS_K); const bf16_t* VT = (const bf16_t*)(A.ws + WS_VT);
    bf16_t* O = (bf16_t*)(A.ws + WS_ATTO);
    for (int p = F.bid; p < 512; p += F.G) { const int bh = p >> 4, u = p & 15;
        attn_unit(F, Q, K, VT, O, bh, 31 - u);
        attn_unit(F, Q, K, VT, O, bh, u); }
}

DI void phase_rwkv_prep(const Frame& F, CArgs& A, int l) {
    const bf16_t* Z = (const bf16_t*)(A.ws + WS_Z);
    bf16_t* R_ = (bf16_t*)(A.ws + WS_RW_R); bf16_t* K_ = (bf16_t*)(A.ws + WS_RW_K); bf16_t* V_ = (bf16_t*)(A.ws + WS_RW_V); bf16_t* KK_ = (bf16_t*)(A.ws + WS_RW_KK);
    bf16_t* B_ = (bf16_t*)(A.ws + WS_RW_B); bf16_t* G_ = (bf16_t*)(A.ws + WS_RW_G); float* W_ = (float*)(A.ws + WS_RW_W);
    const float* mu = A.in[7] + l * 896; const float* w0 = A.in[8] + l * 256; const float* w2 = A.in[9] + l * 32 * 256; const float* a0 = A.in[10] + l * 256;
    const float* a2 = A.in[11] + l * 32 * 256; const float* g2 = A.in[12] + l * 64 * 256; const float* k_k = A.in[13] + l * 256; const float* k_a = A.in[14] + l * 256;
    LAS float* lora = (LAS float*)F.lds;
    const int tg = F.tid >> 8, ch = F.tid & 255;
    for (int pi = F.bid; pi < T / 2; pi += F.G) {
        const int t = 2 * pi + tg, s = t % SEQ; const bool hp = s > 0;
        const bf16_t* zr = Z + (size_t)t * ZS;
#define RW_SH(col) ({ const float zc_ = bf2f(zr[(col)]); const float zp_ = hp ? bf2f(zr[(col) - ZS]) : 0.f; zc_ + (zp_ - zc_) * mu[(col)]; })
        if (ch < 128) { float v = RW_SH(ZC_WLO + ch); if (ch < 32) v = tanhf(v); else if (ch >= 64) v = sigmoidf_(v); lora[tg * 128 + ch] = v; }
        __syncthreads();
        float wv = w0[ch], av = a0[ch], gv = 0.f;
        const LAS float* lo = lora + tg * 128;
#pragma unroll 8
        for (int j = 0; j < 32; ++j) { wv += lo[j] * w2[j * 256 + ch]; av += lo[32 + j] * a2[j * 256 + ch]; }
#pragma unroll 8
        for (int j = 0; j < 64; ++j) gv += lo[64 + j] * g2[j * 256 + ch];
        const float wraw = -softplusf_(-wv) - 0.5f, decay = -__expf(wraw);
        const float a = sigmoidf_(av);
        const float r = RW_SH(ZC_R + ch), k = RW_SH(ZC_K + ch), v = RW_SH(ZC_V + ch);
        const float kkv = k * k_k[ch];
        const float nrm = sqrtf(wave_sum(kkv * kkv));
        const float kk = kkv / fmaxf(nrm, 1e-12f);
        const float kmod = k * (1.f + (a - 1.f) * k_a[ch]);
        const size_t o = (size_t)t * 256 + ch;
        R_[o] = (bf16_t)f2bf(r); K_[o] = (bf16_t)f2bf(kmod); V_[o] = (bf16_t)f2bf(v); KK_[o] = (bf16_t)f2bf(kk); B_[o] = (bf16_t)f2bf(kk * a); G_[o] = (bf16_t)f2bf(gv); W_[o] = decay;
        __syncthreads();
#undef RW_SH
    }
}

DI f32x16 mfma32(bf16x8 a, bf16x8 b, f32x16 c) { return __builtin_amdgcn_mfma_f32_32x32x16_bf16(a, b, c, 0, 0, 0); }
DI bf16x8 ldfrag(const LAS unsigned char* base, int row, int ks, int h) { return *(const LAS bf16x8*)(base + row * 144 + (16 * ks + 8 * h) * 2); }
DI f32x16 zero16() { f32x16 z;
#pragma unroll
    for (int i = 0; i < 16; ++i) z[i] = 0.f;
    return z; }
DI bf16x8 pack8(const f32x16& x, int o) { u32x4 p; p.x = pk2(x[o], x[o + 1]); p.y = pk2(x[o + 2], x[o + 3]); p.z = pk2(x[o + 4], x[o + 5]); p.w = pk2(x[o + 6], x[o + 7]); return __builtin_bit_cast(bf16x8, p); }
DI f32x16 tileprod(const LAS unsigned char* Aimg, int a0, const LAS unsigned char* Bimg, int b0, f32x16 acc, int lr, int h2) {
#pragma unroll
    for (int ks = 0; ks < 4; ++ks) acc = mfma32(ldfrag(Aimg, a0 + lr, ks, h2), ldfrag(Bimg, b0 + lr, ks, h2), acc);
    return acc;
}
DI void put_tile(LAS unsigned char* img, int c0, int r0, const f32x16& a, int lr, int h2) {
#pragma unroll
    for (int g = 0; g < 4; ++g) { u32x2 o; o.x = pk2(a[4 * g], a[4 * g + 1]); o.y = pk2(a[4 * g + 2], a[4 * g + 3]); *(LAS u32x2*)(img + (c0 + lr) * 144 + (r0 + 8 * g + 4 * h2) * 2) = o; }
}
DI void phase_rwkv_A(const Frame& F, CArgs& A, int l) {
    const bf16_t* R_ = (const bf16_t*)(A.ws + WS_RW_R); const bf16_t* K_ = (const bf16_t*)(A.ws + WS_RW_K); const bf16_t* V_ = (const bf16_t*)(A.ws + WS_RW_V);
    const bf16_t* KK_ = (const bf16_t*)(A.ws + WS_RW_KK); const bf16_t* B_ = (const bf16_t*)(A.ws + WS_RW_B); const float* LW_ = (const float*)(A.ws + WS_RW_W);
    bf16_t* RP = (bf16_t*)(A.ws + WS_RC_RP); bf16_t* MP = (bf16_t*)(A.ws + WS_RC_MP); float* Y0T = (float*)(A.ws + WS_RC_Y0); float* GG = (float*)(A.ws + WS_RC_G);
    float* DP = (float*)(A.ws + WS_RC_DP); float* BSUM = (float*)(A.ws + WS_RC_BS);
    const float* r_k = A.in[15] + l * 256;
    constexpr int TB = 64 * 144;
#define TILE(i) (F.lds + (i) * TB)
    LAS float* XF = (LAS float*)TILE(13);
    const int w = F.wave;
    for (int u = F.bid; u < 4096; u += F.G) {
        const int bh = u >> 7, c = u & 127, b = bh >> 2, hd = bh & 3;
        const size_t t0 = (size_t)b * SEQ + 64 * c;
        {
        int tid = F.tid; asm volatile("" : "+v"(tid)); const int lane = tid & 63;
        const int t = tid >> 3, d0 = 8 * (tid & 7);
        const size_t gi = (t0 + t) * 256 + hd * 64 + d0;
        const f32x4 lw0 = *(const f32x4*)(LW_ + gi), lw1 = *(const f32x4*)(LW_ + gi + 4);
        const u32x4 rv = *(const u32x4*)(R_ + gi), kv = *(const u32x4*)(K_ + gi), vv = *(const u32x4*)(V_ + gi), kkv = *(const u32x4*)(KK_ + gi), bv = *(const u32x4*)(B_ + gi);
        *(LAS f32x4*)(XF + t * 64 + d0) = lw0; *(LAS f32x4*)(XF + t * 64 + d0 + 4) = lw1;
        __syncthreads();
        if (w == 0) { float cv[64];
#pragma unroll
            for (int i = 0; i < 64; ++i) cv[i] = XF[i * 64 + lane];
            float run = 0.f;
#pragma unroll
            for (int i = 0; i < 64; ++i) { run += cv[i]; XF[i * 64 + lane] = run; } }
        __syncthreads();
        const f32x4 c0 = *(const LAS f32x4*)(XF + t * 64 + d0), c1 = *(const LAS f32x4*)(XF + t * 64 + d0 + 4);
        const f32x4 e0 = *(const LAS f32x4*)(XF + 63 * 64 + d0), e1 = *(const LAS f32x4*)(XF + 63 * 64 + d0 + 4);
        const float cum[8] = {c0[0], c0[1], c0[2], c0[3], c1[0], c1[1], c1[2], c1[3]};
        const float lwv[8] = {lw0[0], lw0[1], lw0[2], lw0[3], lw1[0], lw1[1], lw1[2], lw1[3]};
        const float c63[8] = {e0[0], e0[1], e0[2], e0[3], e1[0], e1[1], e1[2], e1[3]};
        const unsigned rw[4] = {rv.x, rv.y, rv.z, rv.w}, kw[4] = {kv.x, kv.y, kv.z, kv.w}, vw[4] = {vv.x, vv.y, vv.z, vv.w}, qw[4] = {kkv.x, kkv.y, kkv.z, kkv.w}, bw[4] = {bv.x, bv.y, bv.z, bv.w};
        float al[8], bt[8], kt[8], rb[8], bhh[8], khh[8], vf[8]; float bs = 0.f;
#pragma unroll
        for (int i = 0; i < 8; ++i) {
            const float r = (i & 1) ? bfhi(rw[i >> 1]) : bflo(rw[i >> 1]), k = (i & 1) ? bfhi(kw[i >> 1]) : bflo(kw[i >> 1]), v = (i & 1) ? bfhi(vw[i >> 1]) : bflo(vw[i >> 1]);
            const float kk = (i & 1) ? bfhi(qw[i >> 1]) : bflo(qw[i >> 1]), bb = (i & 1) ? bfhi(bw[i >> 1]) : bflo(bw[i >> 1]);
            const float ec = __expf(cum[i]), em = 1.f / ec, ep = __expf(cum[i] - lwv[i]), p63 = __expf(c63[i]);
            al[i] = -kk * ep; bt[i] = bb * em; kt[i] = k * em; rb[i] = r * ec; bhh[i] = bt[i] * p63; khh[i] = kt[i] * p63; vf[i] = v;
            bs += r * k * r_k[hd * 64 + d0 + i];
            if (t == 63) DP[(size_t)u * 64 + d0 + i] = p63;
        }
        bs += shfl_xor_l(bs, 1, lane); bs += shfl_xor_l(bs, 2, lane); bs += shfl_xor_l(bs, 4, lane);
        if ((tid & 7) == 0) BSUM[(t0 + t) * 4 + hd] = bs;
        u32x4 o;
        o.x = pk2(al[0], al[1]); o.y = pk2(al[2], al[3]); o.z = pk2(al[4], al[5]); o.w = pk2(al[6], al[7]); *(LAS u32x4*)(TILE(0) + t * 144 + d0 * 2) = o;
        o.x = pk2(bt[0], bt[1]); o.y = pk2(bt[2], bt[3]); o.z = pk2(bt[4], bt[5]); o.w = pk2(bt[6], bt[7]); *(LAS u32x4*)(TILE(1) + t * 144 + d0 * 2) = o;
        o.x = pk2(kt[0], kt[1]); o.y = pk2(kt[2], kt[3]); o.z = pk2(kt[4], kt[5]); o.w = pk2(kt[6], kt[7]); *(LAS u32x4*)(TILE(2) + t * 144 + d0 * 2) = o;
        o.x = pk2(rb[0], rb[1]); o.y = pk2(rb[2], rb[3]); o.z = pk2(rb[4], rb[5]); o.w = pk2(rb[6], rb[7]); *(LAS u32x4*)(TILE(3) + t * 144 + d0 * 2) = o;
#pragma unroll
        for (int i = 0; i < 8; ++i) { *(LAS bf16_t*)(TILE(4) + (d0 + i) * 144 + t * 2) = (bf16_t)f2bf(vf[i]); *(LAS bf16_t*)(TILE(5) + (d0 + i) * 144 + t * 2) = (bf16_t)f2bf(bhh[i]);
            *(LAS bf16_t*)(TILE(6) + (d0 + i) * 144 + t * 2) = (bf16_t)f2bf(khh[i]); *(LAS bf16_t*)(TILE(7) + (d0 + i) * 144 + t * 2) = (bf16_t)f2bf(al[i]); }
        }
        __syncthreads();
        f32x16 Tacc = zero16();
        {
        int tl = F.tid; asm volatile("" : "+v"(tl)); const int lane = tl & 63, lr = lane & 31, h2 = lane >> 5;
        unsigned zz = 0u; asm volatile("" : "+v"(zz));
        for (int i = tl; i < 768; i += NTHR) { const int q = i >> 7, rr = (i & 127) >> 2, cc = i & 3; const int tile = q < 4 ? 8 + q : q == 4 ? 14 : 12;
            *(LAS u32x4*)(TILE(tile) + (q == 5 ? (32 + rr) * 144 : rr * 144 + 64) + cc * 16) = (u32x4){zz, zz, zz, zz}; }
#pragma unroll
        for (int rnd = 0; rnd < 2; ++rnd) {
            const int j = w + 8 * rnd;
            if (j < 15) {
                const int prod = j / 3, tile = j % 3, si = tile == 2 ? 1 : 0, ti = tile == 0 ? 0 : 1;
                if (prod == 1) {
                    f32x16 acc = tileprod(TILE(0), 32 * ti, TILE(1), 32 * si, zero16(), lr, h2);
                    const int ss = 32 * si + lr;
#pragma unroll
                    for (int q = 0; q < 16; ++q) { const int tt = 32 * ti + 8 * (q >> 2) + 4 * h2 + (q & 3); if (!(ss < tt)) acc[q] = 0.f; }
                    put_tile(TILE(12), 32 * si, 32 * ti, acc, lr, h2);
                } else {
                    const LAS unsigned char* Ao = (prod == 0 || prod == 3) ? TILE(1) : TILE(2); const LAS unsigned char* Bo = prod >= 3 ? TILE(3) : TILE(0);
                    f32x16 acc = tileprod(Ao, 32 * si, Bo, 32 * ti, zero16(), lr, h2);
                    const int tt = 32 * ti + lr, incl = prod >= 3 ? 1 : 0;
#pragma unroll
                    for (int q = 0; q < 16; ++q) { const int ss = 32 * si + 8 * (q >> 2) + 4 * h2 + (q & 3); if (!(ss < tt + incl)) acc[q] = 0.f; }
                    if (prod == 0) { put_tile(TILE(11), 32 * ti, 32 * si, acc, lr, h2);
#pragma unroll
                        for (int q = 0; q < 16; ++q) { const int ss = 32 * si + 8 * (q >> 2) + 4 * h2 + (q & 3); Tacc[q] = acc[q] + (ss == tt ? 1.f : 0.f); }
                        put_tile(TILE(14), 32 * ti, 32 * si, Tacc, lr, h2);
                    } else put_tile(TILE(prod == 2 ? 8 : prod == 3 ? 9 : 10), 32 * ti, 32 * si, acc, lr, h2);
                }
            }
        }
        }
        __syncthreads();
        {
        int tl = F.tid; asm volatile("" : "+v"(tl)); const int lane = tl & 63, lr = lane & 31, h2 = lane >> 5;
        if (tl < 384) { const int q = tl >> 7, rr = (tl & 127) >> 2, cc = tl & 3;
            unsigned zz = 0u; asm volatile("" : "+v"(zz));
            *(LAS u32x4*)(TILE(q) + (q == 1 ? (32 + rr) * 144 : rr * 144 + 64) + cc * 16) = (u32x4){zz, zz, zz, zz}; }
        __syncthreads();
#pragma unroll
        for (int k = 1; k <= 5; ++k) {
            LAS unsigned char* Ss = (k & 1) ? TILE(11) : TILE(0); LAS unsigned char* STs = (k & 1) ? TILE(12) : TILE(1);
            LAS unsigned char* Sd = (k & 1) ? TILE(0) : TILE(11); LAS unsigned char* STd = (k & 1) ? TILE(1) : TILE(12);
            LAS unsigned char* Ts = (k & 1) ? TILE(14) : TILE(2); LAS unsigned char* Td = (k & 1) ? TILE(2) : TILE(14);
            if (w < 6) { const int tile = w % 3, ti = tile == 0 ? 0 : 1, si = tile == 2 ? 1 : 0;
                if (w < 3) { f32x16 acc = tileprod(Ss, 32 * ti, STs, 32 * si, zero16(), lr, h2); put_tile(STd, 32 * si, 32 * ti, acc, lr, h2); }
                else { f32x16 acc = tileprod(STs, 32 * si, Ss, 32 * ti, zero16(), lr, h2); put_tile(Sd, 32 * ti, 32 * si, acc, lr, h2); }
            } else if (k == 1) {
#pragma unroll
                for (int jj = 0; jj < 2; ++jj) { const int tile = (w - 6) * 2 + jj, ti = tile >> 1, ei = tile & 1;
                    f32x16 acc = tileprod(TILE(8), 32 * ti, TILE(4), 32 * ei, zero16(), lr, h2); put_tile(TILE(13), 32 * ei, 32 * ti, acc, lr, h2); }
            }
            __syncthreads();
            if (w < 3) { const int si = w == 2 ? 1 : 0, ti = w == 0 ? 0 : 1;
                Tacc = tileprod(STd, 32 * si, Ts, 32 * ti, Tacc, lr, h2); put_tile(Td, 32 * ti, 32 * si, Tacc, lr, h2); }
        }
        __syncthreads();
        { const int tile = w & 3, ti = tile >> 1, ci = tile & 1;
          f32x16 acc = tileprod(TILE(2), 32 * ti, w < 4 ? TILE(13) : TILE(7), 32 * ci, zero16(), lr, h2); put_tile(w < 4 ? TILE(11) : TILE(12), 32 * ci, 32 * ti, acc, lr, h2); }
        }
        __syncthreads();
        {
        int tl = F.tid; asm volatile("" : "+v"(tl)); const int lane = tl & 63, lr = lane & 31, h2 = lane >> 5; const int tj = w & 3, ta = tj >> 1, tb = tj & 1;
        if (w < 4) {
            { f32x16 acc = tileprod(TILE(12), 32 * ta, TILE(9), 32 * tb, zero16(), lr, h2);
              const int tt = 32 * tb + lr;
#pragma unroll
              for (int g = 0; g < 4; ++g) { const int dd = 32 * ta + 8 * g + 4 * h2; const u32x2 rbv = *(const LAS u32x2*)(TILE(3) + tt * 144 + dd * 2);
                  u32x2 o; o.x = pk2(acc[4 * g] + bflo(rbv.x), acc[4 * g + 1] + bfhi(rbv.x)); o.y = pk2(acc[4 * g + 2] + bflo(rbv.y), acc[4 * g + 3] + bfhi(rbv.y));
                  *(u32x2*)(RP + ((size_t)u * 64 + tt) * 64 + dd) = o; } }
            { f32x16 acc = tileprod(TILE(12), 32 * ta, TILE(5), 32 * tb, zero16(), lr, h2);
              const int dcol = 32 * tb + lr;
#pragma unroll
              for (int g = 0; g < 4; ++g) { const int dp = 32 * ta + 8 * g + 4 * h2; u32x2 o; o.x = pk2(acc[4 * g], acc[4 * g + 1]); o.y = pk2(acc[4 * g + 2], acc[4 * g + 3]);
                  *(u32x2*)(MP + ((size_t)u * 64 + dcol) * 64 + dp) = o; } }
        } else {
            f32x16 z2 = tileprod(TILE(4), 32 * ta, TILE(10), 32 * tb, zero16(), lr, h2);
            z2 = tileprod(TILE(11), 32 * ta, TILE(9), 32 * tb, z2, lr, h2);
            float* yo = Y0T + (((size_t)u * 4 + tj) * 64 + lane) * 16;
#pragma unroll
            for (int g = 0; g < 4; ++g) *(f32x4*)(yo + 4 * g) = (f32x4){z2[4 * g], z2[4 * g + 1], z2[4 * g + 2], z2[4 * g + 3]};
            f32x16 acc = tileprod(TILE(5), 32 * ta, TILE(11), 32 * tb, zero16(), lr, h2);
            acc = tileprod(TILE(6), 32 * ta, TILE(4), 32 * tb, acc, lr, h2);
            float* go = GG + (((size_t)u * 4 + tj) * 64 + lane) * 16;
#pragma unroll
            for (int g = 0; g < 4; ++g) *(f32x4*)(go + 4 * g) = (f32x4){acc[4 * g], acc[4 * g + 1], acc[4 * g + 2], acc[4 * g + 3]};
        }
        }
        __syncthreads();
    }
#undef TILE
}
DI void phase_rwkv_B(const Frame& F, CArgs& A) {
    if (F.bid >= 32 || F.wave >= 2) return;
    const bf16_t* MP = (const bf16_t*)(A.ws + WS_RC_MP); const float* GG = (const float*)(A.ws + WS_RC_G); const float* DP = (const float*)(A.ws + WS_RC_DP);
    bf16_t* HB = (bf16_t*)(A.ws + WS_RC_HB);
    const int bh = F.bid, eb = F.wave, lane = F.lane, lr = lane & 31, h2 = lane >> 5;
    f32x16 acc[2]; acc[0] = zero16(); acc[1] = zero16();
    for (int c = 0; c < 128; ++c) {
        const size_t u = (size_t)bh * 128 + c;
        bf16x8 hb[4];
#pragma unroll
        for (int s = 0; s < 4; ++s) { hb[s] = pack8(acc[s >> 1], 8 * (s & 1)); *(bf16x8*)(HB + (((u * 2 + eb) * 4 + s) * 64 + lane) * 8) = hb[s]; }
#pragma unroll
        for (int di = 0; di < 2; ++di) {
            const float* gp = GG + ((u * 4 + di * 2 + eb) * 64 + lane) * 16;
            f32x16 n;
#pragma unroll
            for (int g = 0; g < 4; ++g) { const f32x4 gv = *(const f32x4*)(gp + 4 * g); const f32x4 dv = *(const f32x4*)(DP + u * 64 + 32 * di + 8 * g + 4 * h2);
                n[4 * g] = dv[0] * acc[di][4 * g] + gv[0]; n[4 * g + 1] = dv[1] * acc[di][4 * g + 1] + gv[1]; n[4 * g + 2] = dv[2] * acc[di][4 * g + 2] + gv[2]; n[4 * g + 3] = dv[3] * acc[di][4 * g + 3] + gv[3]; }
            const bf16_t* mrow = MP + (u * 64 + 32 * di + lr) * 64;
#pragma unroll
            for (int s = 0; s < 4; ++s) { const u32x2 m0 = *(const u32x2*)(mrow + 16 * s + 4 * h2), m1 = *(const u32x2*)(mrow + 16 * s + 8 + 4 * h2);
                u32x4 mw; mw.x = m0.x; mw.y = m0.y; mw.z = m1.x; mw.w = m1.y;
                n = mfma32(__builtin_bit_cast(bf16x8, mw), hb[s], n); }
            acc[di] = n;
        }
    }
}
DI void phase_rwkv_C(const Frame& F, CArgs& A, int l) {
    const bf16_t* RP = (const bf16_t*)(A.ws + WS_RC_RP); const float* Y0T = (const float*)(A.ws + WS_RC_Y0); const bf16_t* HB = (const bf16_t*)(A.ws + WS_RC_HB); const float* BSUM = (const float*)(A.ws + WS_RC_BS);
    const bf16_t* V_ = (const bf16_t*)(A.ws + WS_RW_V); const bf16_t* G_ = (const bf16_t*)(A.ws + WS_RW_G); bf16_t* MIX = (bf16_t*)(A.ws + WS_MIX);
    const float* ln_w = A.in[16] + l * 256; const float* ln_b = A.in[17] + l * 256;
    const int lane = F.lane, lr = lane & 31, h2 = lane >> 5;
    for (int job = F.gw; job < 8192; job += F.ngw) {
        const size_t u = (size_t)(job >> 1); const int tt = job & 1, bh = (int)(u >> 7), c = (int)(u & 127), b = bh >> 2, hd = bh & 3;
        const size_t tok = (size_t)b * SEQ + 64 * c + 32 * tt + lr;
        bf16x8 bfr[4];
        const bf16_t* rrow = RP + (u * 64 + 32 * tt + lr) * 64;
#pragma unroll
        for (int s = 0; s < 4; ++s) { const u32x2 m0 = *(const u32x2*)(rrow + 16 * s + 4 * h2), m1 = *(const u32x2*)(rrow + 16 * s + 8 + 4 * h2); u32x4 mw; mw.x = m0.x; mw.y = m0.y; mw.z = m1.x; mw.w = m1.y; bfr[s] = __builtin_bit_cast(bf16x8, mw); }
        f32x16 y[2];
#pragma unroll
        for (int et = 0; et < 2; ++et) { const float* yp = Y0T + ((u * 4 + et * 2 + tt) * 64 + lane) * 16;
#pragma unroll
            for (int g = 0; g < 4; ++g) { const f32x4 v = *(const f32x4*)(yp + 4 * g); y[et][4 * g] = v[0]; y[et][4 * g + 1] = v[1]; y[et][4 * g + 2] = v[2]; y[et][4 * g + 3] = v[3]; }
#pragma unroll
            for (int s = 0; s < 4; ++s) { const bf16x8 hf = *(const bf16x8*)(HB + (((u * 2 + et) * 4 + s) * 64 + lane) * 8); y[et] = mfma32(hf, bfr[s], y[et]); } }
        float sm = 0.f;
#pragma unroll
        for (int i = 0; i < 16; ++i) sm += y[0][i] + y[1][i];
        sm += shfl_xor_l(sm, 32, lane); const float mean = sm * (1.f / 64.f);
        float sq = 0.f;
#pragma unroll
        for (int i = 0; i < 16; ++i) { const float d0 = y[0][i] - mean, d1 = y[1][i] - mean; sq += d0 * d0 + d1 * d1; }
        sq += shfl_xor_l(sq, 32, lane); const float rstd = rsqrtf(sq * (1.f / 64.f) + 64e-5f);
        const float bs = BSUM[tok * 4 + hd];
#pragma unroll
        for (int et = 0; et < 2; ++et)
#pragma unroll
            for (int g = 0; g < 4; ++g) { const int e0 = hd * 64 + 32 * et + 8 * g + 4 * h2;
                const f32x4 lw = *(const f32x4*)(ln_w + e0), lb = *(const f32x4*)(ln_b + e0);
                const u32x2 vv = *(const u32x2*)(V_ + tok * 256 + e0), gv = *(const u32x2*)(G_ + tok * 256 + e0);
                const float o0 = ((y[et][4 * g] - mean) * rstd * lw[0] + lb[0] + bs * bflo(vv.x)) * bflo(gv.x), o1 = ((y[et][4 * g + 1] - mean) * rstd * lw[1] + lb[1] + bs * bfhi(vv.x)) * bfhi(gv.x);
                const float o2 = ((y[et][4 * g + 2] - mean) * rstd * lw[2] + lb[2] + bs * bflo(vv.y)) * bflo(gv.y), o3 = ((y[et][4 * g + 3] - mean) * rstd * lw[3] + lb[3] + bs * bfhi(vv.y)) * bfhi(gv.y);
                u32x2 o; o.x = pk2(o0, o1); o.y = pk2(o2, o3);
                *(u32x2*)(MIX + tok * DM + e0) = o; }
    }
}

template <int PASS>
DI void phase_s5(const Frame& F, CArgs& A, int l) {
    const bf16_t* Z = (const bf16_t*)(A.ws + WS_Z); float* SEND = (float*)(A.ws + WS_S5END); bf16_t* YS = (bf16_t*)(A.ws + WS_YS5);
    LAS float* hre = (LAS float*)(F.lds + F.wave * 16512); LAS float* him = hre + 16 * 65; LAS float* cre = him + 16 * 65; LAS float* cim = cre + 16 * 64;
    const int lane = F.lane;
    for (int it = F.gw; it < 8 * 16 * 16; it += F.ngw) {
        const int b = it >> 8, g = (it >> 4) & 15, seg = it & 15, p = lane;
        const float dt = __expf(A.in[25][l * 16 + g]);
        const float lre = A.in[18][(l * 16 + g) * 64 + p], lim = A.in[19][(l * 16 + g) * 64 + p];
        const float mag = expf(lre * dt); float sn, cn; sincosf(lim * dt, &sn, &cn);
        const float are = mag * cn, aim = mag * sn, den = lre * lre + lim * lim;
        const float qre = ((are - 1.f) * lre + aim * lim) / den, qim = (aim * lre - (are - 1.f) * lim) / den;
        float bbr[16], bbi[16];
        { const float* br = A.in[20] + ((size_t)(l * 16 + g) * 64 + p) * 16; const float* bi = A.in[21] + ((size_t)(l * 16 + g) * 64 + p) * 16;
#pragma unroll
          for (int i = 0; i < 16; ++i) { const float x = br[i], y = bi[i]; bbr[i] = qre * x - qim * y; bbi[i] = qre * y + qim * x; } }
        float h_re = 0.f, h_im = 0.f;
        if (PASS == 2) {
            const float m512 = expf(512.f * lre * dt); float s5, c5; sincosf(512.f * (lim * dt), &s5, &c5); const float pr = m512 * c5, pi_ = m512 * s5;
            for (int j = 0; j < seg; ++j) { const float* e = SEND + ((size_t)((b * 16 + g) * 16 + j)) * 128; const float er = e[p], ei = e[64 + p];
                const float nr = pr * h_re - pi_ * h_im + er, ni = pr * h_im + pi_ * h_re + ei; h_re = nr; h_im = ni; }
            for (int i = lane; i < 1024; i += 64) { cre[i] = A.in[22][(size_t)(l * 16 + g) * 1024 + i]; cim[i] = A.in[23][(size_t)(l * 16 + g) * 1024 + i]; }
        }
        const bf16_t* zb = Z + ((size_t)b * SEQ + seg * 512) * ZS + ZC_S5 + g * 16;
        for (int t0 = 0; t0 < 512; t0 += 16) {
#pragma unroll
            for (int sb = 0; sb < 2; ++sb) {
                u32x4 ua[8], ub[8];
#pragma unroll
                for (int q = 0; q < 8; ++q) { const bf16_t* zp = zb + (size_t)(t0 + sb * 8 + q) * ZS; ua[q] = *(const u32x4*)zp; ub[q] = *(const u32x4*)(zp + 8); }
#pragma unroll
                for (int q = 0; q < 8; ++q) {
                    float br_ = 0.f, bi_ = 0.f;
                    const unsigned uw[8] = {ua[q].x, ua[q].y, ua[q].z, ua[q].w, ub[q].x, ub[q].y, ub[q].z, ub[q].w};
#pragma unroll
                    for (int i = 0; i < 8; ++i) { const float u0 = bflo(uw[i]), u1 = bfhi(uw[i]); br_ += bbr[2 * i] * u0 + bbr[2 * i + 1] * u1; bi_ += bbi[2 * i] * u0 + bbi[2 * i + 1] * u1; }
                    const float nr = are * h_re - aim * h_im + br_, ni = are * h_im + aim * h_re + bi_; h_re = nr; h_im = ni;
                    if (PASS == 2) { hre[(sb * 8 + q) * 65 + p] = h_re; him[(sb * 8 + q) * 65 + p] = h_im; }
                }
            }
            if (PASS == 2) {
                asm volatile("s_waitcnt lgkmcnt(0)" ::: "memory");
                const int tl = lane & 15, iq = lane >> 4;
                float acc[4] = {0.f, 0.f, 0.f, 0.f};
                for (int pp = 0; pp < 64; ++pp) { const float xr = hre[tl * 65 + pp], xi = him[tl * 65 + pp];
#pragma unroll
                    for (int i = 0; i < 4; ++i) acc[i] += xr * cre[(4 * iq + i) * 64 + pp] - xi * cim[(4 * iq + i) * 64 + pp]; }
                const int tt = seg * 512 + t0 + tl; const size_t tok = (size_t)b * SEQ + tt;
                const u32x2 uu = *(const u32x2*)(Z + tok * ZS + ZC_S5 + g * 16 + 4 * iq);
                const f32x4 dd = *(const f32x4*)(A.in[24] + l * 256 + g * 16 + 4 * iq);
                const float y0 = gelu_tanh(acc[0] + dd[0] * bflo(uu.x)), y1 = gelu_tanh(acc[1] + dd[1] * bfhi(uu.x)), y2 = gelu_tanh(acc[2] + dd[2] * bflo(uu.y)), y3 = gelu_tanh(acc[3] + dd[3] * bfhi(uu.y));
                u32x2 o; o.x = pk2(y0, y1); o.y = pk2(y2, y3);
                *(u32x2*)(YS + tok * 256 + g * 16 + 4 * iq) = o;
                asm volatile("s_waitcnt lgkmcnt(0)" ::: "memory");
            }
        }
        if (PASS == 1) { float* e = SEND + ((size_t)((b * 16 + g) * 16 + seg)) * 128; e[p] = h_re; e[64 + p] = h_im; }
    }
}

DI void phase_lru_prep(const Frame& F, CArgs& A, int l) {
    const bf16_t* Z = (const bf16_t*)(A.ws + WS_Z); float* LA = (float*)(A.ws + WS_LA); float* LB = (float*)(A.ws + WS_LB);
    const float* cw = A.in[34] + l * 4 * 256; const float* cb = A.in[35] + l * 256; const float* wa = A.in[36] + (size_t)l * 4 * 64 * 64; const float* ba = A.in[37] + l * 256;
    const float* wx = A.in[38] + (size_t)l * 4 * 64 * 64; const float* bx = A.in[39] + l * 256; const float* lam = A.in[40] + l * 256;
    LAS float* xs = (LAS float*)F.lds;
    const int tg = F.tid >> 8, ch = F.tid & 255, n = ch >> 6, jj = ch & 63;
    const float spl = softplusf_(-lam[ch]);
    for (int pi = F.bid; pi < T / 2; pi += F.G) {
        const int t = 2 * pi + tg, s = t % SEQ;
        const bf16_t* zr = Z + (size_t)t * ZS + ZC_LX + ch;
        float xc = cb[ch];
#pragma unroll
        for (int j = 0; j < 4; ++j) { const int sp = s - 3 + j; if (sp >= 0) xc += cw[j * 256 + ch] * bf2f(zr[(ptrdiff_t)(j - 3) * ZS]); }
        xs[tg * 256 + ch] = xc;
        __syncthreads();
        float ra = ba[ch], ia = bx[ch];
        const LAS float* xb = xs + tg * 256 + n * 64;
#pragma unroll 8
        for (int k = 0; k < 64; ++k) { const float x = xb[k]; ra += x * wa[(n * 64 + k) * 64 + jj]; ia += x * wx[(n * 64 + k) * 64 + jj]; }
        const float r = sigmoidf_(ra), ig = sigmoidf_(ia);
        const float log_a = -8.f * r * spl, a = __expf(log_a);
        const float bv = sqrtf(-expm1f(2.f * log_a)) * (ig * xc);
        LA[(size_t)t * 256 + ch] = a; LB[(size_t)t * 256 + ch] = bv;
        __syncthreads();
    }
}
DI void phase_lru_sum(const Frame& F, CArgs& A) {
    const float* LA = (const float*)(A.ws + WS_LA); const float* LB = (const float*)(A.ws + WS_LB); float* LS = (float*)(A.ws + WS_LSUM);
    for (int it = F.gw; it < 8 * 128; it += F.ngw) {
        const size_t r0 = (size_t)it * 64;
        f32x4 Ap = {1.f, 1.f, 1.f, 1.f}, Bp = {0.f, 0.f, 0.f, 0.f};
#pragma unroll 8
        for (int t = 0; t < 64; ++t) { const f32x4 a = *(const f32x4*)(LA + (r0 + t) * 256 + 4 * F.lane), bb = *(const f32x4*)(LB + (r0 + t) * 256 + 4 * F.lane); Bp = a * Bp + bb; Ap = Ap * a; }
        *(f32x4*)(LS + ((size_t)it * 2) * 256 + 4 * F.lane) = Ap; *(f32x4*)(LS + ((size_t)it * 2 + 1) * 256 + 4 * F.lane) = Bp;
    }
}
DI void phase_lru_fin(const Frame& F, CArgs& A) {
    const float* LA = (const float*)(A.ws + WS_LA); const float* LB = (const float*)(A.ws + WS_LB); const float* LS = (const float*)(A.ws + WS_LSUM);
    const bf16_t* Z = (const bf16_t*)(A.ws + WS_Z); bf16_t* YL = (bf16_t*)(A.ws + WS_YL);
    for (int it = F.gw; it < 8 * 128; it += F.ngw) {
        const int b = it >> 7, c = it & 127;
        f32x4 h = {0.f, 0.f, 0.f, 0.f};
        for (int j = 0; j < c; ++j) { const f32x4 a = *(const f32x4*)(LS + ((size_t)(b * 128 + j) * 2) * 256 + 4 * F.lane), bb = *(const f32x4*)(LS + ((size_t)(b * 128 + j) * 2 + 1) * 256 + 4 * F.lane); h = a * h + bb; }
        const size_t r0 = (size_t)it * 64;
#pragma unroll 4
        for (int t = 0; t < 64; ++t) { const f32x4 a = *(const f32x4*)(LA + (r0 + t) * 256 + 4 * F.lane), bb = *(const f32x4*)(LB + (r0 + t) * 256 + 4 * F.lane); h = a * h + bb;
            const u32x2 gz = *(const u32x2*)(Z + (r0 + t) * ZS + ZC_LG + 4 * F.lane);
            u32x2 o; o.x = pk2(h[0] * gelu_tanh(bflo(gz.x)), h[1] * gelu_tanh(bfhi(gz.x))); o.y = pk2(h[2] * gelu_tanh(bflo(gz.y)), h[3] * gelu_tanh(bfhi(gz.y)));
            *(u32x2*)(YL + (r0 + t) * 256 + 4 * F.lane) = o; }
    }
}

DI void phase_branch_norm(const Frame& F, CArgs& A, int l) {
    const bf16_t* S0 = (const bf16_t*)(A.ws + WS_YS5G); const bf16_t* S1 = (const bf16_t*)(A.ws + WS_ATTO); const bf16_t* S2 = (const bf16_t*)(A.ws + WS_YL);
    bf16_t* MIX = (bf16_t*)(A.ws + WS_MIX); const float* bg = A.in[41] + l * 768;
    for (int row = F.gw; row < T; row += F.ngw) {
#pragma unroll
        for (int br = 0; br < 3; ++br) { const bf16_t* S = br == 0 ? S0 : br == 1 ? S1 : S2;
            const u32x2 v = *(const u32x2*)(S + (size_t)row * 256 + 4 * F.lane);
            const float x0 = bflo(v.x), x1 = bfhi(v.x), x2 = bflo(v.y), x3 = bfhi(v.y);
            const float r = rsqrtf(wave_sum(x0 * x0 + x1 * x1 + x2 * x2 + x3 * x3) * (1.f / 256.f) + NORM_EPS);
            const f32x4 g = *(const f32x4*)(bg + br * 256 + 4 * F.lane);
            u32x2 o; o.x = pk2(x0 * r * g[0], x1 * r * g[1]); o.y = pk2(x2 * r * g[2], x3 * r * g[3]);
            *(u32x2*)(MIX + (size_t)row * DM + 256 * (br + 1) + 4 * F.lane) = o; }
    }
}

DI void phase_norm2_router(const Frame& F, CArgs& A, int l) {
    const float* MODL = (const float*)(A.ws + WS_MOD) + (size_t)l * 8 * 6144;
    const float* g = A.in[43] + l * 1024;
    bf16_t* H = (bf16_t*)(A.ws + WS_H);
    int* EID = (int*)(A.ws + WS_RT_EID); float* GATE = (float*)(A.ws + WS_RT_GATE); int* PIE = (int*)(A.ws + WS_RT_PIE);
    unsigned* CNT = (unsigned*)(A.ws + WS_CTL) + CW_CNT + l * 64;
    LAS float* W = (LAS float*)F.lds;
    { const float* wg = A.in[44] + (size_t)l * 1024 * 4; const float* we = A.in[46] + (size_t)l * 1024 * 32;
      for (int i = F.tid; i < 1024 * 4; i += NTHR) W[(i & 3) * 1024 + (i >> 2)] = wg[i];
      for (int i = F.tid; i < 1024 * 32; i += NTHR) W[(4 + (i & 31)) * 1024 + (i >> 5)] = we[i]; }
    __syncthreads();
    const float* bgp = A.in[45] + l * 4; const float* bep = A.in[47] + l * 32;
    for (int row = F.gw; row < T; row += F.ngw) {
        const int b = row / SEQ;
        f32x4 v[4]; float ss = 0.f;
#pragma unroll
        for (int j = 0; j < 4; ++j) { v[j] = *(const f32x4*)(A.out + (size_t)row * DM + 4 * (64 * j + F.lane)); ss += v[j][0] * v[j][0] + v[j][1] * v[j][1] + v[j][2] * v[j][2] + v[j][3] * v[j][3]; }
        const float rstd = rsqrtf(wave_sum(ss) * (1.f / DM) + NORM_EPS);
#pragma unroll
        for (int j = 0; j < 4; ++j) { const int col = 4 * (64 * j + F.lane);
            const f32x4 gg = *(const f32x4*)(g + col), sh = *(const f32x4*)(MODL + (size_t)b * 6144 + 3072 + col), scv = *(const f32x4*)(MODL + (size_t)b * 6144 + 4096 + col);
            v[j] = v[j] * rstd * gg * (scv + 1.f) + sh;
            u32x2 o; o.x = pk2(v[j][0], v[j][1]); o.y = pk2(v[j][2], v[j][3]);
            *(u32x2*)(H + (size_t)row * DM + col) = o; }
        LAS float* Lw = (LAS float*)(F.lds + 147456) + F.wave * 40;
#pragma unroll 1
        for (int n = 0; n < 36; ++n) { float a = 0.f;
#pragma unroll
            for (int j = 0; j < 4; ++j) { const f32x4 w4 = *(const LAS f32x4*)(W + n * 1024 + 4 * (64 * j + F.lane)); a += v[j][0] * w4[0] + v[j][1] * w4[1] + v[j][2] * w4[2] + v[j][3] * w4[3]; }
            a = wave_sum(a); if (F.lane == 0) Lw[n] = a; }
        asm volatile("s_waitcnt lgkmcnt(0)" ::: "memory");
        float L[36];
#pragma unroll
        for (int n = 0; n < 36; ++n) L[n] = Lw[n];
        asm volatile("s_waitcnt lgkmcnt(0)" ::: "memory");
        float gl[4];
#pragma unroll
        for (int i = 0; i < 4; ++i) gl[i] = L[i] + bgp[i];
        int gs = 0; float gm = gl[0];
#pragma unroll
        for (int i = 1; i < 4; ++i) if (gl[i] > gm) { gm = gl[i]; gs = i; }
        float gden = 0.f;
#pragma unroll
        for (int i = 0; i < 4; ++i) gden += expf(gl[i] - gm);
        const float gprob = 1.f / gden;
        float el[8];
#pragma unroll
        for (int j = 0; j < 8; ++j) el[j] = (gs == 0 ? L[4 + j] : gs == 1 ? L[12 + j] : gs == 2 ? L[20 + j] : L[28 + j]) + bep[gs * 8 + j];
        int i1 = 0; float v1 = el[0];
#pragma unroll
        for (int j = 1; j < 8; ++j) if (el[j] > v1) { v1 = el[j]; i1 = j; }
        int i2 = -1; float v2 = -INFINITY;
#pragma unroll
        for (int j = 0; j < 8; ++j) if (j != i1 && el[j] > v2) { v2 = el[j]; i2 = j; }
        const float p2 = expf(v2 - v1);
        const float g0 = gprob / (1.f + p2), g1 = gprob * p2 / (1.f + p2);
        if (F.lane == 0) {
            const int e0 = gs * 8 + i1, e1 = gs * 8 + i2;
            const unsigned q0 = atomicAdd(CNT + e0, 1u), q1 = atomicAdd(CNT + e1, 1u);
            EID[2 * row] = e0; EID[2 * row + 1] = e1; GATE[2 * row] = g0; GATE[2 * row + 1] = g1; PIE[2 * row] = (int)q0; PIE[2 * row + 1] = (int)q1;
        }
    }
    __syncthreads();
    LAS float* scr = (LAS float*)(F.lds + F.wave * 8448);
    bf16_t* WM1 = (bf16_t*)(A.ws + WS_WM1); bf16_t* WM2 = (bf16_t*)(A.ws + WS_WM2);
    for (int it = F.gw; it < 32 * 768; it += F.ngw) {
        const int e = it / 768; int r = it % 768;
        if (r < 512) { const int which = r >> 8; r &= 255; const int kb = r >> 4, nb = r & 15, n0 = 32 * nb;
            const float* src = (which ? A.in[49] : A.in[48]) + ((size_t)l * 32 + e) * 1024 * 512;
            transpose_item(src, 512, 64 * kb, n0, WM1 + (size_t)e * 1024 * 1024, 1024, 256 * (n0 >> 7) + (n0 & 127) + 128 * which, 64 * kb, scr, F.lane);
        } else { r -= 512; const int kb = r >> 5, nb = r & 31;
            transpose_item(A.in[50] + ((size_t)l * 32 + e) * 512 * 1024, 1024, 64 * kb, 32 * nb, WM2 + (size_t)e * 1024 * 512, 512, 32 * nb, 64 * kb, scr, F.lane); }
    }
}

DI void phase_moe_scatter(const Frame& F, CArgs& A, int l) {
    const unsigned* CNT = (const unsigned*)(A.ws + WS_CTL) + CW_CNT + l * 64;
    unsigned* META = (unsigned*)(A.ws + WS_CTL) + CW_UTAB + l * 1024;
    const int* EID = (const int*)(A.ws + WS_RT_EID); const int* PIE = (const int*)(A.ws + WS_RT_PIE); int* SORT = (int*)(A.ws + WS_RT_SORT);
    LAS unsigned* st = (LAS unsigned*)F.lds;
    if (F.tid == 0) { unsigned s = 0; for (int e = 0; e < 32; ++e) { st[e] = s; s += CNT[e]; } }
    __syncthreads();
    if (F.bid == 0 && F.tid == 0) { unsigned nu = 0;
        for (int e = 0; e < 32; ++e) { const unsigned c = CNT[e]; META[1 + e] = st[e]; META[33 + e] = c; for (unsigned bk = 0; bk * 256 < c; ++bk) META[65 + nu++] = ((unsigned)e << 16) | bk; }
        META[0] = nu; }
    for (int a = F.bid * NTHR + F.tid; a < 2 * T; a += F.G * NTHR) SORT[st[EID[a]] + PIE[a]] = a;
}

struct MoeProb1 {
    const char* Hh; const char* WM1; const unsigned* META; const int* SORT; int lda, ldb, nt, G, c;
    DI bool next(int i, pg8::Unit& u) const { const int idx = i * G + c; const int nu = (int)META[0]; if (idx >= nu * 4) return false;
        const unsigned ent = META[65 + (idx >> 2)]; u.pm = idx >> 2; u.pn = idx & 3; u.e = (int)(ent >> 16); u.blk = (int)(ent & 0xffffu); return true; }
    DI const char* a_base(const pg8::Unit&) const { return Hh; }
    DI const char* b_base(const pg8::Unit& u) const { return WM1 + ((size_t)u.e * 1024 + (size_t)u.pn * 256) * 1024 * 2; }
    DI unsigned a_off(const pg8::Unit& u, int row) const { const unsigned r = (unsigned)(u.blk * 256 + row), cnt = META[33 + u.e];
        const int a = r < cnt ? SORT[META[1 + u.e] + r] : 0; return (unsigned)(a >> 1) * 2048u; }
};
struct EpiMoe1 {
    static constexpr bool PERM = true;
    bf16_t* HID; const unsigned* META;
    DI void operator()(const f32x4 (&acc)[2][2][4][2], const pg8::Unit& u, int wr, int wc, int fr, int fq) const {
        const unsigned cnt = META[33 + u.e], st = META[1 + u.e];
        const int col0 = 128 * u.pn + wc * 32 + 8 * fq;
#pragma unroll
        for (int ai = 0; ai < 2; ++ai)
#pragma unroll
            for (int m = 0; m < 4; ++m) { const unsigned r = (unsigned)(u.blk * 256 + ai * 128 + wr * 64 + m * 16 + fr);
                if (r < cnt) { const f32x4 a0 = acc[ai][0][m][0], a1 = acc[ai][0][m][1], b0 = acc[ai][1][m][0], b1 = acc[ai][1][m][1];
                    u32x4 w; w.x = pk2(siluf_(a0[0]) * b0[0], siluf_(a0[1]) * b0[1]); w.y = pk2(siluf_(a0[2]) * b0[2], siluf_(a0[3]) * b0[3]);
                    w.z = pk2(siluf_(a1[0]) * b1[0], siluf_(a1[1]) * b1[1]); w.w = pk2(siluf_(a1[2]) * b1[2], siluf_(a1[3]) * b1[3]);
                    *(u32x4*)(HID + (size_t)(st + r) * 512 + col0) = w; } }
    }
};
struct MoeProb2 {
    const char* HID; const char* WM2; const unsigned* META; int lda, ldb, nt, G, c;
    DI bool next(int i, pg8::Unit& u) const { const int idx = i * G + c; const int nu = (int)META[0]; if (idx >= nu * 4) return false;
        const unsigned ent = META[65 + (idx >> 2)]; u.pm = idx >> 2; u.pn = idx & 3; u.e = (int)(ent >> 16); u.blk = (int)(ent & 0xffffu); return true; }
    DI const char* a_base(const pg8::Unit& u) const { return HID + ((size_t)META[1 + u.e] + (size_t)u.blk * 256) * 512 * 2; }
    DI const char* b_base(const pg8::Unit& u) const { return WM2 + ((size_t)u.e * 1024 + (size_t)u.pn * 256) * 512 * 2; }
    DI unsigned a_off(const pg8::Unit&, int row) const { return (unsigned)row * 1024u; }
};
struct EpiMoe2 {
    static constexpr bool PERM = true;
    bf16_t* Y; const unsigned* META; const int* SORT; const float* GATE; const float* gt;
    DI void operator()(const f32x4 (&acc)[2][2][4][2], const pg8::Unit& u, int wr, int wc, int fr, int fq) const {
        const unsigned cnt = META[33 + u.e], st = META[1 + u.e];
        const int col0 = 256 * u.pn + wc * 32 + 8 * fq;
#pragma unroll
        for (int ai = 0; ai < 2; ++ai)
#pragma unroll
            for (int m = 0; m < 4; ++m) { const unsigned r = (unsigned)(u.blk * 256 + ai * 128 + wr * 64 + m * 16 + fr);
                if (r < cnt) { const int a = SORT[st + r]; const float gw = GATE[a]; const int b = (a >> 1) / SEQ;
#pragma unroll
                    for (int bj = 0; bj < 2; ++bj) { const f32x4 g0 = *(const f32x4*)(gt + (size_t)b * 6144 + col0 + bj * 128), g1 = *(const f32x4*)(gt + (size_t)b * 6144 + col0 + bj * 128 + 4);
                        const f32x4 v0 = acc[ai][bj][m][0] * g0 * gw, v1 = acc[ai][bj][m][1] * g1 * gw;
                        u32x4 w; w.x = pk2(v0[0], v0[1]); w.y = pk2(v0[2], v0[3]); w.z = pk2(v1[0], v1[1]); w.w = pk2(v1[2], v1[3]);
                        *(u32x4*)(Y + (size_t)a * DM + col0 + bj * 128) = w; } } }
    }
};

DI void phase_final(const Frame& F, CArgs& A) {
    const bf16_t* Y = (const bf16_t*)(A.ws + WS_Y);
    for (size_t i = (size_t)F.bid * NTHR + F.tid; i < (size_t)T * DM / 4; i += (size_t)F.G * NTHR) {
        const size_t row = i >> 8, col = (i & 255) * 4;
        f32x4 v = *(const f32x4*)(A.out + row * DM + col);
        const u32x2 y0 = *(const u32x2*)(Y + (2 * row) * DM + col), y1 = *(const u32x2*)(Y + (2 * row + 1) * DM + col);
        v[0] += bflo(y0.x) + bflo(y1.x); v[1] += bfhi(y0.x) + bfhi(y1.x); v[2] += bflo(y0.y) + bflo(y1.y); v[3] += bfhi(y0.y) + bfhi(y1.y);
        *(f32x4*)(A.out + row * DM + col) = v;
    }
}

#ifndef REPMASK
#define REPMASK 0u
#endif
constexpr int NPL = 22, NPH = 1 + 2 * NPL + 1;
__global__ void __launch_bounds__(NTHR, 2) mk_fwd(Args args) {
    extern __shared__ __attribute__((aligned(16))) unsigned char lds_raw[];
    LAS unsigned char* const ldsb = (LAS unsigned char*)lds_raw;
    const int wave0 = __builtin_amdgcn_readfirstlane(threadIdx.x >> 6);
    volatile LAS unsigned* MISC = (volatile LAS unsigned*)(ldsb + MISC_OFF);
    if (threadIdx.x < 64) MISC[threadIdx.x] = 0u;
    __syncthreads();
    XcdBarrier bar; bar.bar = (unsigned*)(args.ws + WS_CTL) + CW_BAR; bar.x = 0; bar.st = nullptr;
    if (args.use_bar) bar = xcd_barrier_post((unsigned*)(args.ws + WS_CTL) + CW_BAR, MISC + 8);
    const int lo = args.ph_lo, hi = args.ph_hi;
#define IN(k) (lo <= (k) && (k) < hi)
#define SEAM(k) do { if (IN(k) && IN((k) + 1)) xcd_barrier(bar); } while (0)
    unsigned char* ws = args.ws;
    if (IN(0)) { const Frame F = make_frame(ldsb, wave0); CArgs& AA = *get_args(); phase_prologue(F, AA); } SEAM(0);
    for (int l = 0; l < DEPTH; ++l) {
        const int pb = 1 + l * NPL;
        const float* MODL = (const float*)(ws + WS_MOD) + (size_t)l * 8 * 6144;
        if (IN(pb + 0)) { const Frame F = make_frame(ldsb, wave0); CArgs& AA = *get_args(); phase_norm1(F, AA, l); } SEAM(pb + 0);
        if (IN(pb + 1)) { const Frame F = make_frame(ldsb, wave0); CArgs& AA = *get_args(); pg8::PlainProb P{(const char*)(ws + WS_H), (const char*)(ws + WS_WIN) + (size_t)l * ZS * 1024 * 2, 1024, 1024, 16, 256, 9, F.G, F.bid};
            EpiBf16Plain E{(bf16_t*)(ws + WS_Z), ZS}; pg8::gemm_phase(F.lds, P, E, F.tid); } SEAM(pb + 1);
        if (IN(pb + 2)) { const Frame F = make_frame(ldsb, wave0); CArgs& AA = *get_args(); phase_mla_prep(F, AA, l); } SEAM(pb + 2);
        if (IN(pb + 3)) { const Frame F = make_frame(ldsb, wave0); CArgs& AA = *get_args(); pg8::PlainProb P{(const char*)(ws + WS_AMLA), (const char*)(ws + WS_WMLA) + (size_t)l * 1024 * 512 * 2, 512, 512, 8, 256, 4, F.G, F.bid};
            EpiBf16Plain E{(bf16_t*)(ws + WS_QKVRAW), 1024}; pg8::gemm_phase(F.lds, P, E, F.tid); } SEAM(pb + 3);
        if (IN(pb + 4)) { const Frame F = make_frame(ldsb, wave0); CArgs& AA = *get_args(); phase_mla_post(F, AA, l); } SEAM(pb + 4);
        if (IN(pb + 5)) { const Frame F = make_frame(ldsb, wave0); CArgs& AA = *get_args(); phase_attn(F, AA); } SEAM(pb + 5);
        if (IN(pb + 6)) { const Frame F = make_frame(ldsb, wave0); CArgs& AA = *get_args(); phase_rwkv_prep(F, AA, l); } SEAM(pb + 6);
        if (IN(pb + 7)) { const Frame F = make_frame(ldsb, wave0); CArgs& AA = *get_args(); phase_rwkv_A(F, AA, l); } SEAM(pb + 7);
        if (IN(pb + 8)) { const Frame F = make_frame(ldsb, wave0); CArgs& AA = *get_args(); phase_rwkv_B(F, AA); } SEAM(pb + 8);
        if (IN(pb + 9)) { const Frame F = make_frame(ldsb, wave0); CArgs& AA = *get_args(); phase_rwkv_C(F, AA, l); } SEAM(pb + 9);
        if (IN(pb + 10)) { const Frame F = make_frame(ldsb, wave0); CArgs& AA = *get_args(); phase_s5<1>(F, AA, l); } SEAM(pb + 10);
        if (IN(pb + 11)) { const Frame F = make_frame(ldsb, wave0); CArgs& AA = *get_args(); phase_s5<2>(F, AA, l); } SEAM(pb + 11);
        if (IN(pb + 12)) { const Frame F = make_frame(ldsb, wave0); CArgs& AA = *get_args(); pg8::PlainProb P{(const char*)(ws + WS_YS5), (const char*)(ws + WS_WGLU) + (size_t)l * 256 * 256 * 2, 256, 256, 4, 256, 1, F.G, F.bid};
            EpiGlu E{(const bf16_t*)(ws + WS_YS5), (bf16_t*)(ws + WS_YS5G), AA.in[27] + l * 256}; pg8::gemm_phase(F.lds, P, E, F.tid); } SEAM(pb + 12);
        if (IN(pb + 13)) { const Frame F = make_frame(ldsb, wave0); CArgs& AA = *get_args(); phase_lru_prep(F, AA, l); } SEAM(pb + 13);
        if (IN(pb + 14)) { const Frame F = make_frame(ldsb, wave0); CArgs& AA = *get_args(); phase_lru_sum(F, AA); } SEAM(pb + 14);
        if (IN(pb + 15)) { const Frame F = make_frame(ldsb, wave0); CArgs& AA = *get_args(); phase_lru_fin(F, AA); } SEAM(pb + 15);
        if (IN(pb + 16)) { const Frame F = make_frame(ldsb, wave0); CArgs& AA = *get_args(); phase_branch_norm(F, AA, l); } SEAM(pb + 16);
        if (IN(pb + 17)) { const Frame F = make_frame(ldsb, wave0); CArgs& AA = *get_args(); pg8::PlainProb P{(const char*)(ws + WS_MIX), (const char*)(ws + WS_WOUT) + (size_t)l * 1024 * 1024 * 2, 1024, 1024, 16, 256, 4, F.G, F.bid};
            EpiResGate E{l == 0 ? AA.in[0] : AA.out, AA.out, MODL + 2048}; pg8::gemm_phase(F.lds, P, E, F.tid); } SEAM(pb + 17);
        if (IN(pb + 18)) { const Frame F = make_frame(ldsb, wave0); CArgs& AA = *get_args(); phase_norm2_router(F, AA, l); } SEAM(pb + 18);
        if (IN(pb + 19)) { const Frame F = make_frame(ldsb, wave0); CArgs& AA = *get_args(); phase_moe_scatter(F, AA, l); } SEAM(pb + 19);
        const unsigned* META = (const unsigned*)(ws + WS_CTL) + CW_UTAB + l * 1024;
        if (IN(pb + 20)) { const Frame F = make_frame(ldsb, wave0); CArgs& AA = *get_args(); MoeProb1 P{(const char*)(ws + WS_H), (const char*)(ws + WS_WM1), META, (const int*)(ws + WS_RT_SORT), 1024, 1024, 16, F.G, F.bid};
            EpiMoe1 E{(bf16_t*)(ws + WS_HID), META}; pg8::gemm_phase(F.lds, P, E, F.tid); } SEAM(pb + 20);
        if (IN(pb + 21)) { const Frame F = make_frame(ldsb, wave0); CArgs& AA = *get_args(); MoeProb2 P{(const char*)(ws + WS_HID), (const char*)(ws + WS_WM2), META, 512, 512, 8, F.G, F.bid};
            EpiMoe2 E{(bf16_t*)(ws + WS_Y), META, (const int*)(ws + WS_RT_SORT), (const float*)(ws + WS_RT_GATE), MODL + 5120}; pg8::gemm_phase(F.lds, P, E, F.tid); } SEAM(pb + 21);
    }
    if (IN(NPH - 1)) { const Frame F = make_frame(ldsb, wave0); CArgs& AA = *get_args(); phase_final(F, AA); }
#undef IN
#undef SEAM
}

extern "C" void kernel_launch(void* const* d_in, const int* in_sizes, int n_in, void* d_out, int out_size, void* d_ws, size_t ws_size, hipStream_t stream) {
    static int grid = 0;
    if (grid == 0) {
        if (n_in != 51 || ws_size < WS_END) { fprintf(stderr, "kernel_launch: unexpected inputs (n_in %d, ws %zu)\n", n_in, ws_size); grid = -1; return; }
        int dev = 0, cus = 0;
        if (hipGetDevice(&dev) != hipSuccess || hipDeviceGetAttribute(&cus, hipDeviceAttributeMultiprocessorCount, dev) != hipSuccess) { grid = -1; return; }
        if (hipFuncSetAttribute((const void*)mk_fwd, hipFuncAttributeMaxDynamicSharedMemorySize, LDS_BYTES) != hipSuccess) { fprintf(stderr, "kernel_launch: hipFuncSetAttribute failed\n"); grid = -1; return; }
        grid = cus;
    }
    if (grid < 0) return;
    (void)hipMemsetAsync((char*)d_ws + WS_CTL, 0, CTL_ZERO_BYTES, stream);
    Args a{};
    for (int i = 0; i < 51; ++i) a.in[i] = (const float*)d_in[i];
    a.pos_off = (const int*)d_in[2]; a.out = (float*)d_out; a.ws = (unsigned char*)d_ws; a.pad = 0;
#if defined(MK_PER_PHASE)
    a.use_bar = 0;
    for (int p = 0; p < NPH; ++p) { a.ph_lo = p; a.ph_hi = p + 1;
        const int k = (p == 0 || p == NPH - 1) ? 31 : (p - 1) % NPL; const int reps = 1 + (int)((REPMASK >> k) & 1u);
        for (int r = 0; r < reps; ++r) hipLaunchKernelGGL(mk_fwd, dim3(grid), dim3(NTHR), LDS_BYTES, stream, a); }
#else
    a.use_bar = 1; a.ph_lo = 0; a.ph_hi = NPH;
    hipLaunchKernelGGL(mk_fwd, dim3(grid), dim3(NTHR), LDS_BYTES, stream, a);
#endif
}
```

```cpp
#include <hip/hip_runtime.h>
#include <cstdio>
#include <cstdint>

#define LAS __attribute__((address_space(3)))
#define GAS __attribute__((address_space(1)))
#define DI __device__ __forceinline__
typedef unsigned short bf16_t;
typedef short bf16x8 __attribute__((ext_vector_type(8)));
typedef short s16x4 __attribute__((ext_vector_type(4)));
typedef float f32x4 __attribute__((ext_vector_type(4)));
typedef float f32x2 __attribute__((ext_vector_type(2)));
typedef float f32x16 __attribute__((ext_vector_type(16)));
typedef unsigned u32x4 __attribute__((ext_vector_type(4)));
typedef unsigned u32x2 __attribute__((ext_vector_type(2)));
typedef __bf16 bf16x2_t __attribute__((ext_vector_type(2)));

constexpr int NB = 8, SEQ = 8192, DM = 1024, T = NB * SEQ, DEPTH = 2;
constexpr int WG = 256;
constexpr int ZS = 2304;
constexpr int ZC_R = 0, ZC_K = 256, ZC_V = 512, ZC_WLO = 768, ZC_ALO = 800, ZC_GLO = 832, ZC_S5 = 896, ZC_QA = 1152, ZC_KVA = 1408, ZC_KPE = 1536, ZC_LX = 1568, ZC_LG = 1824, D_IN = 2080;
constexpr int NEXP = 32, DFF = 512;
constexpr float NORM_EPS = 1e-6f;

DI unsigned f2bf(float f) { unsigned u = __float_as_uint(f); return (u + 0x7fffu + ((u >> 16) & 1u)) >> 16; }
DI unsigned pk2(float lo, float hi) { f32x2 v = {lo, hi}; bf16x2_t b = __builtin_convertvector(v, bf16x2_t); return __builtin_bit_cast(unsigned, b); }
DI float bflo(unsigned u) { return __uint_as_float(u << 16); }
DI float bfhi(unsigned u) { return __uint_as_float(u & 0xffff0000u); }
DI float bf2f(bf16_t b) { return __uint_as_float(((unsigned)b) << 16); }
DI int lane_opaque() { int l; asm volatile("v_mbcnt_lo_u32_b32 %0, -1, 0\n\tv_mbcnt_hi_u32_b32 %0, -1, %0" : "=v"(l)); return l; }
DI float shfl_xor_l(float v, int o, int lane) { return __int_as_float(__builtin_amdgcn_ds_bpermute((lane ^ o) << 2, __float_as_int(v))); }
DI float wave_sum(float v) {
    const int l = lane_opaque();
#pragma unroll
    for (int o = 1; o < 64; o <<= 1) v += shfl_xor_l(v, o, l);
    return v;
}
DI float sigmoidf_(float x) { return 1.f / (1.f + __expf(-x)); }
DI float softplusf_(float x) { return fmaxf(x, 0.f) + log1pf(__expf(-fabsf(x))); }
DI float gelu_tanh(float x) { const float u = 0.7978845608028654f * (x + 0.044715f * x * x * x); return 0.5f * x * (1.f + tanhf(u)); }
DI float siluf_(float x) { return x / (1.f + __expf(-x)); }

namespace pg8 {
constexpr int BM = 256, BK = 64, HALF = 128, HTB = HALF * BK * 2, STAGE_BYTES = 8 * HTB;
DI int lds_byte(int r, int c) { const int st = (r >> 4) * 2 + (c >> 5), rr = r & 15, cc = c & 31, ob = rr * 64 + cc * 2; return st * 1024 + (ob ^ (((ob >> 9) & 1) << 5)); }
DI void stage_rc(int b, int& R, int& C) { const int st = b / 1024, sb = b % 1024, swz = sb ^ (((sb >> 9) & 1) << 5); R = (st >> 1) * 16 + swz / 64; C = (st & 1) * 32 + (swz % 64) / 2; }
DI int perm32(int rho) { const int n = rho >> 4, i = rho & 15; return 8 * (i >> 2) + 4 * n + (i & 3); }

struct Unit { int pm, pn, e, blk; };

template <class Epi, class P>
DI void gemm_phase(LAS unsigned char* lds, const P& S, const Epi& E, int tid_in) {
    const int tid = tid_in, wid = __builtin_amdgcn_readfirstlane(tid >> 6), lane = tid & 63, wr = wid >> 2, wc = wid & 3, fr = lane & 15, fq = lane >> 4;
    const int nt = S.nt;
    int Rr[2], Cc[2];
    unsigned voffB[2], offC[2][2], offN[2][2];
#pragma unroll
    for (int i = 0; i < 2; ++i) { int R, C; stage_rc(tid * 16 + i * 8192, R, C); Rr[i] = R; Cc[i] = C; const int Rb = Epi::PERM ? ((R & ~31) + perm32(R & 31)) : R;
        voffB[i] = (unsigned)(Rb * S.ldb + C) * 2u; }
    const size_t kstep = (size_t)(BK * 2);
    const size_t hstepB = (size_t)HALF * S.ldb * 2;
    const unsigned ldsw = (unsigned)wid * 1024u;
    const int aoff = lds_byte(wr * 64 + fr, fq * 8), boff = lds_byte(wc * 32 + fr, fq * 8);
#define PG8_SA(b, h) (((b) * 2 + (h)) * HTB)
#define PG8_SB(b, h) ((4 + (b) * 2 + (h)) * HTB)
#define PG8_STAGE(bufoff, gbase, voff) do { _Pragma("unroll") for (int _i = 0; _i < 2; ++_i) \
        __builtin_amdgcn_global_load_lds((const unsigned*)((const char*)(gbase) + (voff)[_i]), (LAS unsigned*)(lds + (bufoff) + ldsw + _i * 8192), 16, 0, 0); } while (0)
#define PG8_LDA(dst, b, h) do { _Pragma("unroll") for (int m = 0; m < 4; ++m) _Pragma("unroll") for (int k = 0; k < 2; ++k) dst[m][k] = *(const LAS bf16x8*)(lds + PG8_SA(b, h) + aoff + m * 2048 + k * 1024); } while (0)
#define PG8_LDB(dst, b, h) do { _Pragma("unroll") for (int n = 0; n < 2; ++n) _Pragma("unroll") for (int k = 0; k < 2; ++k) dst[n][k] = *(const LAS bf16x8*)(lds + PG8_SB(b, h) + boff + n * 2048 + k * 1024); } while (0)
#define PG8_MMA(ai, bj, At, Bt) do { __builtin_amdgcn_s_setprio(1); _Pragma("unroll") for (int m = 0; m < 4; ++m) _Pragma("unroll") for (int n = 0; n < 2; ++n) _Pragma("unroll") for (int k = 0; k < 2; ++k) \
        acc[ai][bj][m][n] = __builtin_amdgcn_mfma_f32_16x16x32_bf16(Bt[n][k], At[m][k], acc[ai][bj][m][n], 0, 0, 0); __builtin_amdgcn_s_setprio(0); } while (0)
#define PG8_WAIT_V(n) asm volatile("s_waitcnt vmcnt(" #n ")" ::: "memory")
#define PG8_WAIT_L(n) asm volatile("s_waitcnt lgkmcnt(" #n ")" ::: "memory")
#define PG8_BAR __builtin_amdgcn_s_barrier()
#define PG8_SCHED __builtin_amdgcn_sched_barrier(0)
    Unit cur, nxt; int ui = 0;
    if (!S.next(0, cur)) return;
    f32x4 acc[2][2][4][2];
#pragma unroll
    for (int a = 0; a < 2; ++a)
#pragma unroll
        for (int b = 0; b < 2; ++b)
#pragma unroll
            for (int m = 0; m < 4; ++m)
#pragma unroll
                for (int n = 0; n < 2; ++n) acc[a][b][m][n] = (f32x4){0.f, 0.f, 0.f, 0.f};
    bf16x8 At[4][2], B0[2][2], B1[2][2];
    const char* cA = S.a_base(cur); const char* cB = S.b_base(cur);
#pragma unroll
    for (int h = 0; h < 2; ++h)
#pragma unroll
        for (int i = 0; i < 2; ++i) { offC[h][i] = S.a_off(cur, h * HALF + Rr[i]) + (unsigned)Cc[i] * 2u; offN[h][i] = offC[h][i]; }
    PG8_STAGE(PG8_SB(0, 0), cB, voffB); PG8_STAGE(PG8_SB(0, 1), cB + hstepB, voffB); PG8_STAGE(PG8_SA(0, 0), cA, offC[0]); PG8_STAGE(PG8_SA(0, 1), cA, offC[1]);
    if (wr == 1) PG8_BAR;
    PG8_WAIT_V(2); PG8_BAR;
    PG8_STAGE(PG8_SB(1, 0), cB + kstep, voffB); PG8_STAGE(PG8_SA(1, 0), cA + kstep, offC[0]); PG8_STAGE(PG8_SB(1, 1), cB + hstepB + kstep, voffB);
    PG8_WAIT_V(6); PG8_BAR;
    for (;;) {
        const bool has_next = S.next(ui + 1, nxt);
        const char* nA = has_next ? S.a_base(nxt) : cA; const char* nB = has_next ? S.b_base(nxt) : cB;
        for (int t = 0; t < nt; t += 2) {
            const bool last = (t == nt - 2);
            const char* a1 = cA + (size_t)(t + 1) * kstep;
            const char* a2 = last ? nA : cA + (size_t)(t + 2) * kstep; const char* b2 = last ? nB : cB + (size_t)(t + 2) * kstep;
            const char* a3 = a2 + kstep; const char* b3 = b2 + kstep;
            if (last && has_next) {
#pragma unroll
                for (int h = 0; h < 2; ++h)
#pragma unroll
                    for (int i = 0; i < 2; ++i) offN[h][i] = S.a_off(nxt, h * HALF + Rr[i]) + (unsigned)Cc[i] * 2u;
            }
            unsigned o2[2][2];
#pragma unroll
            for (int h = 0; h < 2; ++h)
#pragma unroll
                for (int i = 0; i < 2; ++i) o2[h][i] = last ? offN[h][i] : offC[h][i];
            PG8_LDB(B0, 0, 0); PG8_LDB(B1, 0, 1); PG8_SCHED; PG8_LDA(At, 0, 0); PG8_STAGE(PG8_SA(1, 1), a1, offC[1]);
            PG8_WAIT_V(8); PG8_WAIT_L(0); PG8_BAR; PG8_MMA(0, 0, At, B0); PG8_MMA(0, 1, At, B1); PG8_BAR; PG8_SCHED;
            PG8_LDA(At, 0, 1); PG8_STAGE(PG8_SB(0, 0), b2, voffB); PG8_STAGE(PG8_SB(0, 1), b2 + hstepB, voffB); PG8_STAGE(PG8_SA(0, 0), a2, o2[0]);
            PG8_WAIT_V(8); PG8_WAIT_L(0); PG8_BAR; PG8_MMA(1, 0, At, B0); PG8_MMA(1, 1, At, B1); PG8_BAR; PG8_SCHED;
            PG8_LDB(B0, 1, 0); PG8_LDB(B1, 1, 1); PG8_SCHED; PG8_LDA(At, 1, 0); PG8_STAGE(PG8_SA(0, 1), a2, o2[1]);
            PG8_WAIT_V(8); PG8_WAIT_L(0); PG8_BAR; PG8_MMA(0, 0, At, B0); PG8_MMA(0, 1, At, B1); PG8_BAR; PG8_SCHED;
            PG8_LDA(At, 1, 1); PG8_STAGE(PG8_SB(1, 0), b3, voffB); PG8_STAGE(PG8_SB(1, 1), b3 + hstepB, voffB); PG8_STAGE(PG8_SA(1, 0), a3, o2[0]);
            PG8_WAIT_V(8); PG8_WAIT_L(0); PG8_BAR; PG8_MMA(1, 0, At, B0); PG8_MMA(1, 1, At, B1); PG8_BAR; PG8_SCHED;
        }
        if (wr == 0) PG8_BAR;
        E(acc, cur, wr, wc, fr, fq);
        if (!has_next) break;
#pragma unroll
        for (int a = 0; a < 2; ++a)
#pragma unroll
            for (int b = 0; b < 2; ++b)
#pragma unroll
                for (int m = 0; m < 4; ++m)
#pragma unroll
                    for (int n = 0; n < 2; ++n) acc[a][b][m][n] = (f32x4){0.f, 0.f, 0.f, 0.f};
        cur = nxt; cA = nA; cB = nB; ++ui;
#pragma unroll
        for (int h = 0; h < 2; ++h)
#pragma unroll
            for (int i = 0; i < 2; ++i) offC[h][i] = offN[h][i];
        if (wr == 1) PG8_BAR;
    }
    PG8_WAIT_V(0);
    PG8_BAR;
#undef PG8_SA
#undef PG8_SB
#undef PG8_STAGE
#undef PG8_LDA
#undef PG8_LDB
#undef PG8_MMA
#undef PG8_WAIT_V
#undef PG8_WAIT_L
#undef PG8_BAR
#undef PG8_SCHED
}

struct PlainProb {
    const char* A; const char* Bt; int lda, ldb, nt, nM, nN, G, c;
    DI bool next(int i, Unit& u) const {
        const long L = (long)i * G + c; const int nwg = nM * nN; if (L >= nwg) return false;
        int wgid = (int)L; { const int q = nwg / 8, r = nwg % 8, xcd = wgid % 8, off = wgid / 8; wgid = (xcd < r ? xcd * (q + 1) : r * (q + 1) + (xcd - r) * q) + off; }
        const int nig = 8 * nN, gid = wgid / nig, fm = gid * 8, gsz = (nM - fm) < 8 ? (nM - fm) : 8;
        u.pm = fm + ((wgid % nig) % gsz); u.pn = (wgid % nig) / gsz; u.e = 0; u.blk = 0; return true;
    }
    DI const char* a_base(const Unit& u) const { return A + (size_t)u.pm * 256 * lda * 2; }
    DI const char* b_base(const Unit& u) const { return Bt + (size_t)u.pn * 256 * ldb * 2; }
    DI unsigned a_off(const Unit&, int row) const { return (unsigned)row * (unsigned)lda * 2u; }
};
}

constexpr size_t MiB = 1u << 20;
constexpr size_t WS_CTL = 0, CTL_ZERO_BYTES = 1 * MiB;
constexpr size_t WS_MOD = 1 * MiB;
constexpr size_t WS_RT_EID = 3 * MiB;
constexpr size_t WS_RT_GATE = WS_RT_EID + 512 * 1024;
constexpr size_t WS_RT_PIE = WS_RT_GATE + 512 * 1024;
constexpr size_t WS_RT_SORT = WS_RT_PIE + 512 * 1024;
constexpr size_t WS_WIN = 8 * MiB;
constexpr size_t WS_WOUT = 17 * MiB;
constexpr size_t WS_WMLA = 21 * MiB;
constexpr size_t WS_WGLU = 23 * MiB;
constexpr size_t WS_WR = 23 * MiB + 256 * 1024;
constexpr size_t WS_WLRU = 23 * MiB + 640 * 1024;
constexpr size_t WS_WLORA = 23 * MiB + 768 * 1024;
static_assert(WS_WGLU + 256 * 1024 <= WS_WR && WS_WR + 384 * 1024 <= WS_WLRU && WS_WLRU + 128 * 1024 <= WS_WLORA && WS_WLORA + 128 * 1024 <= 24 * MiB, "small weight map");
constexpr size_t WS_H = 24 * MiB;
constexpr size_t WS_Z = 152 * MiB;
constexpr size_t WS_WM1 = WS_Z;
constexpr size_t WS_WM2 = WS_Z + 64 * MiB;
constexpr size_t WS_MIX = 440 * MiB;
constexpr size_t WS_HID = WS_MIX;
constexpr size_t WS_Y = 569 * MiB;
constexpr size_t WS_Q = 825 * MiB;
constexpr size_t WS_K = 873 * MiB;
constexpr size_t WS_VT = 921 * MiB;
constexpr size_t WS_TAIL = 953 * MiB;
constexpr size_t WS_END = 1017 * MiB;
constexpr size_t WS_AMLA = WS_TAIL;
constexpr size_t WS_QKVRAW = WS_Y;
constexpr size_t WS_ATTO = WS_H;
constexpr size_t WS_RW_R = WS_Y, WS_RW_K = WS_Y + 32 * MiB, WS_RW_V = WS_Y + 64 * MiB, WS_RW_KK = WS_Y + 96 * MiB, WS_RW_B = WS_Y + 128 * MiB, WS_RW_G = WS_Y + 160 * MiB;
constexpr size_t WS_RW_W = WS_Y + 192 * MiB;
constexpr size_t WS_RC_RP = WS_H + 32 * MiB;
constexpr size_t WS_RC_MP = WS_H + 64 * MiB;
constexpr size_t WS_RC_HB = WS_H + 96 * MiB;
constexpr size_t WS_RC_Y0 = WS_Q;
constexpr size_t WS_RC_G = WS_Q + 64 * MiB;
constexpr size_t WS_RC_DP = WS_TAIL;
constexpr size_t WS_RC_BS = WS_TAIL + 1 * MiB;
constexpr size_t WS_YS5 = WS_H + 96 * MiB;
constexpr size_t WS_YS5G = WS_TAIL;
constexpr size_t WS_YL = WS_TAIL + 32 * MiB;
constexpr size_t WS_LA = WS_Y, WS_LB = WS_Y + 64 * MiB;
constexpr size_t WS_S5END = 2 * MiB;
constexpr size_t WS_LSUM = 5 * MiB + 512 * 1024;
static_assert(WS_RT_SORT + 512 * 1024 <= WS_LSUM && WS_LSUM + 2 * MiB <= WS_WIN && WS_S5END + 1 * MiB <= WS_RT_EID, "map");

constexpr int CW_BAR = 4096;
constexpr int CW_CNT = 16384;
constexpr int CW_UTAB = 20480;

constexpr int NWAVES = 8, NTHR = 512;
constexpr int LDS_BYTES = 155648;
constexpr int MISC_OFF = 155648 - 256;

struct Args { const float* in[51]; const int* pos_off; float* out; unsigned char* ws; int ph_lo, ph_hi, use_bar, pad; };
typedef const __attribute__((address_space(4))) Args CArgs;
DI CArgs* get_args() { CArgs* ap = (CArgs*)__builtin_amdgcn_kernarg_segment_ptr(); asm volatile("" : "+s"(ap)); return ap; }

#define XB_TMO      128
#define XB_XCNT(j)  (256  + 64 * (j))
#define XB_XSUB(j)  (1280 + 64 * (j))
#define XB_XGEN(j)  (2304 + 64 * (j))
#define XB_TOP      3328
#define XB_TOPGEN   3392
#define XCD_BAR_WORDS 3456
#define XB_SPIN_CAP (1u << 18)
DI unsigned xb_ld(unsigned* p)              { return __hip_atomic_load(p, __ATOMIC_RELAXED, __HIP_MEMORY_SCOPE_AGENT); }
DI unsigned xb_add(unsigned* p, unsigned v) { return __hip_atomic_fetch_add(p, v, __ATOMIC_RELAXED, __HIP_MEMORY_SCOPE_AGENT); }
DI unsigned xb_xcc_id() { return (unsigned)__builtin_amdgcn_s_getreg((3 << 11) | 20) & 0xFu; }
#define XB_SPIN(cond, bar) do { unsigned _sp = 0; while (cond) { __builtin_amdgcn_s_sleep(1); \
    if ((++_sp & 255u) == 0u) { if (xb_ld(&(bar)[XB_TMO])) break; if (_sp > XB_SPIN_CAP) { atomicAdd(&(bar)[XB_TMO], 1u); break; } } } } while (0)
struct XcdBarrier { unsigned* bar; unsigned x; volatile LAS unsigned* st; };
DI XcdBarrier xcd_barrier_post(unsigned* bar, volatile LAS unsigned* st) {
    XcdBarrier b; b.bar = bar; b.x = xb_xcc_id(); b.st = st;
    if (threadIdx.x == 0) (void)xb_add(&bar[XB_XCNT(b.x)], 1u);
    return b;
}
DI void xcd_barrier_complete(unsigned* bar, unsigned x, unsigned& nloc, unsigned& nx) {
    const unsigned G = gridDim.x * gridDim.y * gridDim.z;
    unsigned sum, cnt, mine, sp = 0u;
    for (;;) {
        sum = 0u; cnt = 0u; mine = 0u;
#pragma unroll
        for (unsigned j = 0; j < 16; ++j) { const unsigned c = xb_ld(&bar[XB_XCNT(j)]); sum += c; cnt += (c > 0u) ? 1u : 0u; mine = (j == x) ? c : mine; }
        if (sum == G) break;
        __builtin_amdgcn_s_sleep(1);
        if ((++sp & 255u) == 0u) { if (xb_ld(&bar[XB_TMO])) break; if (sp > XB_SPIN_CAP) { atomicAdd(&bar[XB_TMO], 1u); break; } }
    }
    nloc = mine > 0u ? mine : 1u; nx = cnt > 0u ? cnt : 1u;
}
DI void xcd_barrier(const XcdBarrier& b) {
    asm volatile("s_waitcnt vmcnt(0)" ::: "memory");
    __syncthreads();
    if (threadIdx.x == 0) {
        unsigned* bar = b.bar;
        __builtin_amdgcn_s_waitcnt(0);
        unsigned nloc = b.st[0], nx = b.st[1];
        if (nloc == 0u) { xcd_barrier_complete(bar, b.x, nloc, nx); b.st[0] = nloc; b.st[1] = nx; }
        const unsigned old = xb_add(&bar[XB_XSUB(b.x)], 1u);
        const unsigned gen = old / nloc;
        if (old + 1u == (gen + 1u) * nloc) {
            __builtin_amdgcn_fence(__ATOMIC_RELEASE, "agent");
            asm volatile("s_waitcnt vmcnt(0)" ::: "memory");
            const unsigned og = xb_add(&bar[XB_TOP], 1u);
            const unsigned tg = og / nx;
            if (og + 1u == (tg + 1u) * nx) xb_add(&bar[XB_TOPGEN], 1u);
            else XB_SPIN(xb_ld(&bar[XB_TOPGEN]) == tg, bar);
            __builtin_amdgcn_fence(__ATOMIC_ACQUIRE, "agent");
            xb_add(&bar[XB_XGEN(b.x)], 1u);
            asm volatile("s_waitcnt vmcnt(0)" ::: "memory");
        } else {
            XB_SPIN(xb_ld(&bar[XB_XGEN(b.x)]) == gen, bar);
            __builtin_amdgcn_fence(__ATOMIC_ACQUIRE, "agent");
            asm volatile("s_waitcnt vmcnt(0)" ::: "memory");
        }
    }
    __syncthreads();
}

struct EpiBf16Plain {
    static constexpr bool PERM = true;
    bf16_t* O; int ldc;
    DI void operator()(const f32x4 (&acc)[2][2][4][2], const pg8::Unit& u, int wr, int wc, int fr, int fq) const {
        const int row0 = u.pm * 256 + wr * 64 + fr, col0 = u.pn * 256 + wc * 32 + 8 * fq;
#pragma unroll
        for (int ai = 0; ai < 2; ++ai)
#pragma unroll
            for (int m = 0; m < 4; ++m) { bf16_t* rowp = O + (size_t)(row0 + ai * 128 + m * 16) * ldc + col0;
#pragma unroll
                for (int bj = 0; bj < 2; ++bj) { const f32x4 v0 = acc[ai][bj][m][0], v1 = acc[ai][bj][m][1];
                    u32x4 w; w.x = pk2(v0[0], v0[1]); w.y = pk2(v0[2], v0[3]); w.z = pk2(v1[0], v1[1]); w.w = pk2(v1[2], v1[3]);
                    *(u32x4*)(rowp + bj * 128) = w; } }
    }
};
struct EpiResGate {
    static constexpr bool PERM = false;
    const float* xin; float* out; const float* gt;
    DI void operator()(const f32x4 (&acc)[2][2][4][2], const pg8::Unit& u, int wr, int wc, int fr, int fq) const {
        const int row0 = u.pm * 256 + wr * 64 + fr, col0 = u.pn * 256 + wc * 32 + 4 * fq;
        const int b = (u.pm * 256) / SEQ;
        f32x4 g[2][2];
#pragma unroll
        for (int bj = 0; bj < 2; ++bj)
#pragma unroll
            for (int n = 0; n < 2; ++n) g[bj][n] = *(const f32x4*)(gt + (size_t)b * 6144 + col0 + bj * 128 + n * 16);
#pragma unroll
        for (int ai = 0; ai < 2; ++ai)
#pragma unroll
            for (int m = 0; m < 4; ++m) { const size_t ro = (size_t)(row0 + ai * 128 + m * 16) * DM + col0;
#pragma unroll
                for (int bj = 0; bj < 2; ++bj)
#pragma unroll
                    for (int n = 0; n < 2; ++n) { const f32x4 xv = *(const f32x4*)(xin + ro + bj * 128 + n * 16);
                        *(f32x4*)(out + ro + bj * 128 + n * 16) = xv + g[bj][n] * acc[ai][bj][m][n]; } }
    }
};
struct EpiGlu {
    static constexpr bool PERM = true;
    const bf16_t* Y; bf16_t* O; const float* bias;
    DI void operator()(const f32x4 (&acc)[2][2][4][2], const pg8::Unit& u, int wr, int wc, int fr, int fq) const {
        const int row0 = u.pm * 256 + wr * 64 + fr, col0 = wc * 32 + 8 * fq;
#pragma unroll
        for (int ai = 0; ai < 2; ++ai)
#pragma unroll
            for (int m = 0; m < 4; ++m) { const size_t ro = (size_t)(row0 + ai * 128 + m * 16) * 256 + col0;
#pragma unroll
                for (int bj = 0; bj < 2; ++bj) { const u32x4 yv = *(const u32x4*)(Y + ro + bj * 128);
                    const f32x4 b0 = *(const f32x4*)(bias + col0 + bj * 128), b1 = *(const f32x4*)(bias + col0 + bj * 128 + 4);
                    const f32x4 v0 = acc[ai][bj][m][0] + b0, v1 = acc[ai][bj][m][1] + b1;
                    u32x4 w;
                    w.x = pk2(bflo(yv.x) * sigmoidf_(v0[0]), bfhi(yv.x) * sigmoidf_(v0[1]));
                    w.y = pk2(bflo(yv.y) * sigmoidf_(v0[2]), bfhi(yv.y) * sigmoidf_(v0[3]));
                    w.z = pk2(bflo(yv.z) * sigmoidf_(v1[0]), bfhi(yv.z) * sigmoidf_(v1[1]));
                    w.w = pk2(bflo(yv.w) * sigmoidf_(v1[2]), bfhi(yv.w) * sigmoidf_(v1[3]));
                    *(u32x4*)(O + ro + bj * 128) = w; } }
    }
};

struct Frame { LAS unsigned char* lds; int tid, lane, wave, G, bid, gw, ngw; };

DI Frame make_frame(LAS unsigned char* lds, int wave0) {
    Frame F; F.lds = lds; int w = wave0; asm volatile("" : "+s"(w)); F.wave = w; F.lane = lane_opaque(); F.tid = w * 64 + F.lane;
    F.G = gridDim.x; F.bid = blockIdx.x; F.gw = F.bid * NWAVES + F.wave; F.ngw = F.G * NWAVES; return F;
}
DI void transpose_item(const float* src, int ld_src, int k0, int n0, bf16_t* dst, int ldd, int nd0, int kd0, LAS float* scr, int lane) {
#pragma unroll 8
    for (int i = 0; i < 32; ++i) { const int kk = 2 * i + (lane >> 5); scr[kk * 33 + (lane & 31)] = src[(size_t)(k0 + kk) * ld_src + n0 + (lane & 31)]; }
    asm volatile("s_waitcnt lgkmcnt(0)" ::: "memory");
    const int c = lane & 7;
#pragma unroll
    for (int j = 0; j < 4; ++j) { const int n = (lane >> 3) + 8 * j; const LAS float* s = scr + (8 * c) * 33 + n;
        u32x4 o; o.x = pk2(s[0 * 33], s[1 * 33]); o.y = pk2(s[2 * 33], s[3 * 33]); o.z = pk2(s[4 * 33], s[5 * 33]); o.w = pk2(s[6 * 33], s[7 * 33]);
        *(u32x4*)(dst + (size_t)(nd0 + n) * ldd + kd0 + 8 * c) = o; }
    asm volatile("s_waitcnt lgkmcnt(0)" ::: "memory");
}
DI void zero_rows(bf16_t* dst, int ld, int r0, int nr, int c0, int nc, int gw, int ngw, int lane) {
    for (int r = gw; r < nr; r += ngw) for (int c = lane * 8; c < nc; c += 512) *(u32x4*)(dst + (size_t)(r0 + r) * ld + c0 + c) = (u32x4){0u, 0u, 0u, 0u};
}

DI void phase_prologue(const Frame& F, CArgs& A) {
    unsigned char* ws = A.ws;
    LAS float* sc = (LAS float*)F.lds;
    LAS float* part = (LAS float*)(F.lds + 32768);
    for (int i = F.tid; i < 8192; i += NTHR) sc[i] = siluf_(A.in[1][i]);
    __syncthreads();
    float* MOD = (float*)(ws + WS_MOD);
    for (int item = F.bid; item < 192; item += F.G) {
        const int l = item / 96, n0 = (item % 96) * 64, nl = F.tid & 63, kg = F.tid >> 6;
        const float* W = A.in[3] + (size_t)l * 1024 * 6144 + n0 + nl;
        float acc[8];
#pragma unroll
        for (int b = 0; b < 8; ++b) acc[b] = 0.f;
        for (int k = kg * 128; k < kg * 128 + 128; ++k) { const float w = W[(size_t)k * 6144];
#pragma unroll
            for (int b = 0; b < 8; ++b) acc[b] += sc[b * 1024 + k] * w; }
#pragma unroll
        for (int b = 0; b < 8; ++b) part[(kg * 8 + b) * 64 + nl] = acc[b];
        __syncthreads();
        { const int b = F.tid >> 6; float s = A.in[4][l * 6144 + n0 + nl];
#pragma unroll
          for (int g = 0; g < 8; ++g) s += part[(g * 8 + b) * 64 + nl];
          MOD[((size_t)l * 8 + b) * 6144 + n0 + nl] = s; }
        __syncthreads();
    }
    LAS float* scr = (LAS float*)(F.lds + F.wave * 8448);
    bf16_t* WIN = (bf16_t*)(ws + WS_WIN); bf16_t* WOUT = (bf16_t*)(ws + WS_WOUT); bf16_t* WMLA = (bf16_t*)(ws + WS_WMLA); bf16_t* WGLU = (bf16_t*)(ws + WS_WGLU);
    constexpr int I_IN = 16 * 65, I_OUT = 16 * 32, I_Q = 4 * 12, I_KV = 2 * 16, I_GLU = 4 * 8, I_L = I_IN + I_OUT + I_Q + I_KV + I_GLU;
    for (int it = F.gw; it < 2 * I_L; it += F.ngw) {
        const int l = it / I_L; int r = it % I_L;
        if (r < I_IN) { transpose_item(A.in[6] + (size_t)l * 1024 * D_IN, D_IN, 64 * (r / 65), 32 * (r % 65), WIN + (size_t)l * ZS * 1024, 1024, 32 * (r % 65), 64 * (r / 65), scr, F.lane); continue; } r -= I_IN;
        if (r < I_OUT) { transpose_item(A.in[42] + (size_t)l * 1024 * 1024, 1024, 64 * (r / 32), 32 * (r % 32), WOUT + (size_t)l * 1024 * 1024, 1024, 32 * (r % 32), 64 * (r / 32), scr, F.lane); continue; } r -= I_OUT;
        if (r < I_Q) { transpose_item(A.in[29] + (size_t)l * 256 * 384, 384, 64 * (r / 12), 32 * (r % 12), WMLA + (size_t)l * 1024 * 512, 512, 32 * (r % 12), 64 * (r / 12), scr, F.lane); continue; } r -= I_Q;
        if (r < I_KV) { transpose_item(A.in[31] + (size_t)l * 128 * 512, 512, 64 * (r / 16), 32 * (r % 16), WMLA + (size_t)l * 1024 * 512, 512, 384 + 32 * (r % 16), 256 + 64 * (r / 16), scr, F.lane); continue; } r -= I_KV;
        transpose_item(A.in[26] + (size_t)l * 256 * 256, 256, 64 * (r / 8), 32 * (r % 8), WGLU + (size_t)l * 256 * 256, 256, 32 * (r % 8), 64 * (r / 8), scr, F.lane);
    }
    { bf16_t* WR = (bf16_t*)(ws + WS_WR);
      for (int i = F.bid * NTHR + F.tid; i < 2 * 48 * 1024; i += F.G * NTHR) { const int l = i / (48 * 1024), n = (i / 1024) % 48, k = i % 1024;
          const float v = n < 4 ? A.in[44][((size_t)l * 1024 + k) * 4 + n] : n < 36 ? A.in[46][((size_t)l * 1024 + k) * 32 + (n - 4)] : 0.f;
          const unsigned hi = f2bf(v); const float rem = v - __uint_as_float(hi << 16);
          WR[((size_t)(l * 2 + 0) * 48 + n) * 1024 + k] = (bf16_t)hi; WR[((size_t)(l * 2 + 1) * 48 + n) * 1024 + k] = (bf16_t)f2bf(rem); } }
    { bf16_t* WL = (bf16_t*)(ws + WS_WLRU); bf16_t* WO = (bf16_t*)(ws + WS_WLORA);
      for (int i = F.bid * NTHR + F.tid; i < 2 * 2 * 4 * 4096; i += F.G * NTHR) { const int l = i >> 15, wh = (i >> 14) & 1, n = (i >> 12) & 3, j = (i >> 6) & 63, k = i & 63;
          WL[i] = (bf16_t)f2bf((wh ? A.in[38] : A.in[36])[((size_t)(l * 4 + n) * 64 + k) * 64 + j]); }
      for (int i = F.bid * NTHR + F.tid; i < 2 * 32768; i += F.G * NTHR) { const int l = i >> 15, r = i & 32767;
          float v;
          if (r < 8192) v = A.in[9][(size_t)l * 8192 + (r & 31) * 256 + (r >> 5)];
          else if (r < 16384) v = A.in[11][(size_t)l * 8192 + ((r - 8192) & 31) * 256 + ((r - 8192) >> 5)];
          else v = A.in[12][(size_t)l * 16384 + ((r - 16384) & 63) * 256 + ((r - 16384) >> 6)];
          WO[i] = (bf16_t)f2bf(v); } }
    for (int l = 0; l < 2; ++l) {
        zero_rows(WIN + (size_t)l * ZS * 1024, 1024, D_IN, ZS - D_IN, 0, 1024, F.gw, F.ngw, F.lane);
        bf16_t* wm = WMLA + (size_t)l * 1024 * 512;
        zero_rows(wm, 512, 0, 384, 256, 256, F.gw, F.ngw, F.lane);
        zero_rows(wm, 512, 384, 512, 0, 256, F.gw, F.ngw, F.lane);
        zero_rows(wm, 512, 384, 512, 384, 128, F.gw, F.ngw, F.lane);
        zero_rows(wm, 512, 896, 128, 0, 512, F.gw, F.ngw, F.lane);
    }
}

DI void phase_norm1(const Frame& F, CArgs& A, int l) {
    const float* MODL = (const float*)(A.ws + WS_MOD) + (size_t)l * 8 * 6144;
    const float* g = A.in[5] + l * 1024;
    const bf16_t* Y = (const bf16_t*)(A.ws + WS_Y);
    bf16_t* H = (bf16_t*)(A.ws + WS_H);
    const float* src = (l == 0) ? A.in[0] : A.out;
    for (int row = F.gw; row < T; row += F.ngw) {
        const int b = row / SEQ;
        f32x4 v[4]; float ss = 0.f;
#pragma unroll
        for (int j = 0; j < 4; ++j) { const int col = 4 * (64 * j + F.lane);
            v[j] = *(const f32x4*)(src + (size_t)row * DM + col);
            if (l > 0) { const u32x2 y0 = *(const u32x2*)(Y + (size_t)(2 * row) * DM + col), y1 = *(const u32x2*)(Y + (size_t)(2 * row + 1) * DM + col);
                v[j][0] += bflo(y0.x) + bflo(y1.x); v[j][1] += bfhi(y0.x) + bfhi(y1.x); v[j][2] += bflo(y0.y) + bflo(y1.y); v[j][3] += bfhi(y0.y) + bfhi(y1.y);
                *(f32x4*)(A.out + (size_t)row * DM + col) = v[j]; }
            ss += v[j][0] * v[j][0] + v[j][1] * v[j][1] + v[j][2] * v[j][2] + v[j][3] * v[j][3]; }
        const float rstd = rsqrtf(wave_sum(ss) * (1.f / DM) + NORM_EPS);
#pragma unroll
        for (int j = 0; j < 4; ++j) { const int col = 4 * (64 * j + F.lane);
            const f32x4 gg = *(const f32x4*)(g + col), sh = *(const f32x4*)(MODL + (size_t)b * 6144 + col), scv = *(const f32x4*)(MODL + (size_t)b * 6144 + 1024 + col);
            const f32x4 hv = v[j] * rstd * gg * (scv + 1.f) + sh;
            u32x2 o; o.x = pk2(hv[0], hv[1]); o.y = pk2(hv[2], hv[3]);
            *(u32x2*)(H + (size_t)row * DM + col) = o; }
    }
}

DI void phase_mla_prep(const Frame& F, CArgs& A, int l) {
    const bf16_t* Z = (const bf16_t*)(A.ws + WS_Z); bf16_t* AM = (bf16_t*)(A.ws + WS_AMLA);
    const float* qg = A.in[28] + l * 256; const float* kg = A.in[30] + l * 128;
    for (int row = F.gw; row < T; row += F.ngw) {
        const bf16_t* zr = Z + (size_t)row * ZS;
        const u32x2 qv = *(const u32x2*)(zr + ZC_QA + 4 * F.lane); const unsigned kv = *(const unsigned*)(zr + ZC_KVA + 2 * F.lane);
        const float q0 = bflo(qv.x), q1 = bfhi(qv.x), q2 = bflo(qv.y), q3 = bfhi(qv.y), k0 = bflo(kv), k1 = bfhi(kv);
        const float rq = rsqrtf(wave_sum(q0 * q0 + q1 * q1 + q2 * q2 + q3 * q3) * (1.f / 256.f) + NORM_EPS);
        const float rk = rsqrtf(wave_sum(k0 * k0 + k1 * k1) * (1.f / 128.f) + NORM_EPS);
        const f32x4 g4 = *(const f32x4*)(qg + 4 * F.lane); const f32x2 g2 = *(const f32x2*)(kg + 2 * F.lane);
        u32x2 o; o.x = pk2(q0 * rq * g4[0], q1 * rq * g4[1]); o.y = pk2(q2 * rq * g4[2], q3 * rq * g4[3]);
        bf16_t* ar = AM + (size_t)row * 512;
        *(u32x2*)(ar + 4 * F.lane) = o;
        *(unsigned*)(ar + 256 + 2 * F.lane) = pk2(k0 * rk * g2[0], k1 * rk * g2[1]);
        *(unsigned*)(ar + 384 + 2 * F.lane) = 0u;
    }
}

DI void phase_mla_post(const Frame& F, CArgs& A, int l) {
    const bf16_t* Z = (const bf16_t*)(A.ws + WS_Z); const bf16_t* RAW = (const bf16_t*)(A.ws + WS_QKVRAW);
    bf16_t* Q = (bf16_t*)(A.ws + WS_Q); bf16_t* K = (bf16_t*)(A.ws + WS_K); bf16_t* VT = (bf16_t*)(A.ws + WS_VT);
    LAS float* cs = (LAS float*)F.lds;
    LAS bf16_t* vt = (LAS bf16_t*)(F.lds + 8192);
    const float* qhg = A.in[32] + l * 96; const float* khg = A.in[33] + l * 96;
    for (int tile = F.bid; tile < T / 64; tile += F.G) {
        const int t0 = tile * 64, b = t0 / SEQ, s0 = t0 % SEQ;
        int tz = F.tid; asm volatile("" : "+v"(tz));
        for (int idx = tz; idx < 1024; idx += NTHR) { const int tok = idx >> 4, i = idx & 15;
            const int pos = A.pos_off[b] + s0 + tok; const float inv = powf(10000.f, -(float)i * (1.f / 16.f));
            double ang = (double)(float)pos * (double)inv; ang -= 6.283185307179586 * floor(ang * 0.15915494309189535);
            float sn, cn; sincosf((float)ang, &sn, &cn); cs[idx * 2] = cn; cs[idx * 2 + 1] = sn; }
        __syncthreads();
        const int tok = tz >> 3, sub = tz & 7, h = sub >> 1, isk = sub & 1, t = t0 + tok;
        {
            float v[96];
            const bf16_t* p0 = isk ? RAW + (size_t)t * 1024 + 384 + 128 * h : RAW + (size_t)t * 1024 + 96 * h;
            const bf16_t* p1 = isk ? Z + (size_t)t * ZS + ZC_KPE : p0 + 64;
#pragma unroll
            for (int c = 0; c < 8; ++c) { const u32x4 w = *(const u32x4*)(p0 + 8 * c);
                v[8 * c] = bflo(w.x); v[8 * c + 1] = bfhi(w.x); v[8 * c + 2] = bflo(w.y); v[8 * c + 3] = bfhi(w.y); v[8 * c + 4] = bflo(w.z); v[8 * c + 5] = bfhi(w.z); v[8 * c + 6] = bflo(w.w); v[8 * c + 7] = bfhi(w.w); }
#pragma unroll
            for (int c = 0; c < 4; ++c) { const u32x4 w = *(const u32x4*)(p1 + 8 * c);
                v[64 + 8 * c] = bflo(w.x); v[65 + 8 * c] = bfhi(w.x); v[66 + 8 * c] = bflo(w.y); v[67 + 8 * c] = bfhi(w.y); v[68 + 8 * c] = bflo(w.z); v[69 + 8 * c] = bfhi(w.z); v[70 + 8 * c] = bflo(w.w); v[71 + 8 * c] = bfhi(w.w); }
            float ss = 0.f;
#pragma unroll
            for (int i = 0; i < 96; ++i) ss += v[i] * v[i];
            const float r = rsqrtf(ss * (1.f / 96.f) + NORM_EPS);
            const float* hg = isk ? khg : qhg;
#pragma unroll
            for (int i = 0; i < 96; ++i) v[i] = v[i] * r * hg[i];
#pragma unroll
            for (int i = 0; i < 16; ++i) { const float cn = cs[(tok * 16 + i) * 2], sn = cs[(tok * 16 + i) * 2 + 1]; const float x1 = v[64 + i], x2 = v[80 + i];
                v[64 + i] = x1 * cn - x2 * sn; v[80 + i] = x1 * sn + x2 * cn; }
            bf16_t* dst = (isk ? K : Q) + ((size_t)t * 4 + h) * 96;
#pragma unroll
            for (int c = 0; c < 12; ++c) { u32x4 w; w.x = pk2(v[8 * c], v[8 * c + 1]); w.y = pk2(v[8 * c + 2], v[8 * c + 3]); w.z = pk2(v[8 * c + 4], v[8 * c + 5]); w.w = pk2(v[8 * c + 6], v[8 * c + 7]);
                *(u32x4*)(dst + 8 * c) = w; }
        }
        {
            const bf16_t* pv = RAW + (size_t)t * 1024 + 384 + 128 * h + 64 + 32 * isk;
#pragma unroll
            for (int c = 0; c < 4; ++c) { const u32x4 w = *(const u32x4*)(pv + 8 * c); const int r0 = h * 64 + 32 * isk + 8 * c;
                vt[(r0 + 0) * 72 + tok] = (bf16_t)(w.x & 0xffffu); vt[(r0 + 1) * 72 + tok] = (bf16_t)(w.x >> 16);
                vt[(r0 + 2) * 72 + tok] = (bf16_t)(w.y & 0xffffu); vt[(r0 + 3) * 72 + tok] = (bf16_t)(w.y >> 16);
                vt[(r0 + 4) * 72 + tok] = (bf16_t)(w.z & 0xffffu); vt[(r0 + 5) * 72 + tok] = (bf16_t)(w.z >> 16);
                vt[(r0 + 6) * 72 + tok] = (bf16_t)(w.w & 0xffffu); vt[(r0 + 7) * 72 + tok] = (bf16_t)(w.w >> 16); }
        }
        __syncthreads();
        { const int row = tz >> 1, hf = tz & 1;
          bf16_t* dst = VT + ((size_t)(b * 4) * 64 + row) * SEQ + s0 + 32 * hf;
#pragma unroll
          for (int c = 0; c < 4; ++c) *(u32x4*)(dst + 8 * c) = *(const LAS u32x4*)(vt + row * 72 + 32 * hf + 8 * c); }
        __syncthreads();
    }
}

DI void attn_unit(const Frame& F, const bf16_t* Q, const bf16_t* K, const bf16_t* VT, bf16_t* O, int bh, int u) {
    constexpr int KP = 208, VP = 144, KB = 64 * KP, VB = 64 * VP;
    LAS unsigned char* Ks = F.lds; LAS unsigned char* Vs = F.lds + 2 * KB;
    const int b = bh >> 2, h = bh & 3, lane = F.lane, w = F.wave, ql = lane & 31, hh = lane >> 5;
    const int ntile = 4 * u + 4, myl = 4 * u + (w >> 1);
    const size_t tq = (size_t)b * SEQ + 256 * u + 32 * w + ql;
    bf16x8 qf[6];
#pragma unroll
    for (int s = 0; s < 6; ++s) qf[s] = *(const bf16x8*)(Q + (tq * 4 + h) * 96 + 16 * s + 8 * hh);
    f32x16 ot[2];
#pragma unroll
    for (int i = 0; i < 16; ++i) { ot[0][i] = 0.f; ot[1][i] = 0.f; }
    float mrun = -INFINITY, lrun = 0.f;
    const float c2 = 0.10206207261596577f * 1.4426950408889634f;
    const int kp0 = F.tid, kp1 = F.tid + 512;
    const size_t kbase = ((size_t)b * SEQ * 4 + h) * 96;
    const bf16_t* vsrc = VT + ((size_t)bh * 64 + (F.tid >> 3)) * SEQ + 8 * (F.tid & 7);
    u32x4 rk0, rk1, rv;
    rk1 = (u32x4){0u, 0u, 0u, 0u};
#define ATT_LOAD(j) do { rk0 = *(const u32x4*)(K + kbase + (size_t)(64 * (j) + kp0 / 12) * 384 + 8 * (kp0 % 12)); \
        if (kp1 < 768) rk1 = *(const u32x4*)(K + kbase + (size_t)(64 * (j) + kp1 / 12) * 384 + 8 * (kp1 % 12)); \
        rv = *(const u32x4*)(vsrc + 64 * (j)); } while (0)
#define ATT_STORE(buf) do { *(LAS u32x4*)(Ks + (buf) * KB + (kp0 / 12) * KP + (kp0 % 12) * 16) = rk0; \
        if (kp1 < 768) *(LAS u32x4*)(Ks + (buf) * KB + (kp1 / 12) * KP + (kp1 % 12) * 16) = rk1; \
        *(LAS u32x4*)(Vs + (buf) * VB + (F.tid >> 3) * VP + (F.tid & 7) * 16) = rv; } while (0)
    ATT_LOAD(0); ATT_STORE(0);
    __syncthreads();
    for (int j = 0; j < ntile; ++j) {
        const int buf = j & 1;
        if (j + 1 < ntile) ATT_LOAD(j + 1);
        if (j <= myl) {
            f32x16 st[2];
#pragma unroll
            for (int kt = 0; kt < 2; ++kt) {
#pragma unroll
                for (int i = 0; i < 16; ++i) st[kt][i] = 0.f;
#pragma unroll
                for (int s = 0; s < 6; ++s) { const bf16x8 kf = *(const LAS bf16x8*)(Ks + buf * KB + (32 * kt + ql) * KP + (16 * s + 8 * hh) * 2);
                    st[kt] = __builtin_amdgcn_mfma_f32_32x32x16_bf16(kf, qf[s], st[kt], 0, 0, 0); }
            }
            float mx = st[0][0];
#pragma unroll
            for (int i = 1; i < 16; ++i) mx = fmaxf(mx, st[0][i]);
#pragma unroll
            for (int i = 0; i < 16; ++i) mx = fmaxf(mx, st[1][i]);
            mx = fmaxf(mx, shfl_xor_l(mx, 32, lane));
            const float mnew = fmaxf(mrun, mx), alpha = __builtin_amdgcn_exp2f((mrun - mnew) * c2), mc = mnew * c2;
            mrun = mnew;
            float ps = 0.f;
#pragma unroll
            for (int kt = 0; kt < 2; ++kt)
#pragma unroll
                for (int i = 0; i < 16; ++i) { const float p = __builtin_amdgcn_exp2f(st[kt][i] * c2 - mc); st[kt][i] = p; ps += p; }
            lrun = lrun * alpha + ps;
#pragma unroll
            for (int i = 0; i < 16; ++i) { ot[0][i] *= alpha; ot[1][i] *= alpha; }
#pragma unroll
            for (int kt = 0; kt < 2; ++kt)
#pragma unroll
                for (int c = 0; c < 2; ++c) {
                    u32x4 pw; pw.x = pk2(st[kt][8 * c], st[kt][8 * c + 1]); pw.y = pk2(st[kt][8 * c + 2], st[kt][8 * c + 3]); pw.z = pk2(st[kt][8 * c + 4], st[kt][8 * c + 5]); pw.w = pk2(st[kt][8 * c + 6], st[kt][8 * c + 7]);
                    const bf16x8 pf = __builtin_bit_cast(bf16x8, pw);
                    const int key0 = 32 * kt + 16 * c + 4 * hh;
#pragma unroll
                    for (int dt = 0; dt < 2; ++dt) { const LAS unsigned char* vp = Vs + buf * VB + (32 * dt + ql) * VP + key0 * 2;
                        const u32x2 v0 = *(const LAS u32x2*)vp, v1 = *(const LAS u32x2*)(vp + 16);
                        u32x4 vw; vw.x = v0.x; vw.y = v0.y; vw.z = v1.x; vw.w = v1.y;
                        ot[dt] = __builtin_amdgcn_mfma_f32_32x32x16_bf16(__builtin_bit_cast(bf16x8, vw), pf, ot[dt], 0, 0, 0); }
                }
        }
        if (j + 1 < ntile) ATT_STORE(buf ^ 1);
        __syncthreads();
    }
#undef ATT_LOAD
#undef ATT_STORE
    const float linv = 1.f / (lrun + shfl_xor_l(lrun, 32, lane));
    bf16_t* orow = O + tq * 256 + h * 64;
#pragma unroll
    for (int dt = 0; dt < 2; ++dt)
#pragma unroll
        for (int g = 0; g < 4; ++g) { u32x2 o; o.x = pk2(ot[dt][4 * g] * linv, ot[dt][4 * g + 1] * linv); o.y = pk2(ot[dt][4 * g + 2] * linv, ot[dt][4 * g + 3] * linv);
            *(u32x2*)(orow + 32 * dt + 8 * g + 4 * hh) = o; }
}
DI void phase_attn(const Frame& F, CArgs& A) {
    const bf16_t* Q = (const bf16_t*)(A.ws + WS_Q); const bf16_t* K = (const bf16_t*)(A.ws + WS_K); const bf16_t* VT = (const bf16_t*)(A.ws + WS_VT);
    bf16_t* O = (bf16_t*)(A.ws + WS_ATTO);
    for (int p = F.bid; p < 512; p += F.G) { const int bh = p >> 4, u = p & 15;
        attn_unit(F, Q, K, VT, O, bh, 31 - u);
        attn_unit(F, Q, K, VT, O, bh, u); }
}

DI void phase_rwkv_prep(const Frame& F, CArgs& A, int l) {
    const bf16_t* Z = (const bf16_t*)(A.ws + WS_Z);
    bf16_t* R_ = (bf16_t*)(A.ws + WS_RW_R); bf16_t* K_ = (bf16_t*)(A.ws + WS_RW_K); bf16_t* V_ = (bf16_t*)(A.ws + WS_RW_V); bf16_t* KK_ = (bf16_t*)(A.ws + WS_RW_KK);
    bf16_t* B_ = (bf16_t*)(A.ws + WS_RW_B); bf16_t* G_ = (bf16_t*)(A.ws + WS_RW_G); float* W_ = (float*)(A.ws + WS_RW_W);
    const float* mu = A.in[7] + l * 896; const float* w0 = A.in[8] + l * 256; const float* a0 = A.in[10] + l * 256; const float* k_k = A.in[13] + l * 256; const float* k_a = A.in[14] + l * 256;
    const bf16_t* WO = (const bf16_t*)(A.ws + WS_WLORA) + (size_t)l * 32768;
    LAS float* hs = (LAS float*)F.lds;
    const int w = F.wave, c0 = 32 * w;
    bf16x8 w2f[2], a2f[2], g2f[2][2];
    { const int fr = F.lane & 15, fq = F.lane >> 4;
#pragma unroll
      for (int nf = 0; nf < 2; ++nf) { const int ch = c0 + 16 * nf + fr;
          w2f[nf] = *(const bf16x8*)(WO + ch * 32 + 8 * fq); a2f[nf] = *(const bf16x8*)(WO + 8192 + ch * 32 + 8 * fq);
          g2f[nf][0] = *(const bf16x8*)(WO + 16384 + ch * 64 + 8 * fq); g2f[nf][1] = *(const bf16x8*)(WO + 16384 + ch * 64 + 32 + 8 * fq); } }
    for (int tile = F.bid; tile < T / 64; tile += F.G) {
        int tz = F.tid; asm volatile("" : "+v"(tz)); const int lane = tz & 63, fr = lane & 15, fq = lane >> 4;
        const int t0 = tile * 64, s0 = t0 % SEQ;
        f32x4 aw[4][2], aa[4][2], ag[4][2];
#pragma unroll
        for (int m = 0; m < 4; ++m) {
            const size_t t = (size_t)t0 + 16 * m + fr; const bool hp = (s0 + 16 * m + fr) > 0;
            const bf16_t* zr = Z + t * ZS + ZC_WLO + 8 * fq;
            bf16x8 xf[4];
#pragma unroll
            for (int ks = 0; ks < 4; ++ks) {
                const u32x4 zc = *(const u32x4*)(zr + 32 * ks); u32x4 zp = {0u, 0u, 0u, 0u}; if (hp) zp = *(const u32x4*)(zr + 32 * ks - ZS);
                const f32x4 m0 = *(const f32x4*)(mu + ZC_WLO + 32 * ks + 8 * fq), m1 = *(const f32x4*)(mu + ZC_WLO + 32 * ks + 8 * fq + 4);
                const unsigned cw[4] = {zc.x, zc.y, zc.z, zc.w}, pw[4] = {zp.x, zp.y, zp.z, zp.w}; const float mm[8] = {m0[0], m0[1], m0[2], m0[3], m1[0], m1[1], m1[2], m1[3]};
                float v[8];
#pragma unroll
                for (int i = 0; i < 8; ++i) { const float zcv = (i & 1) ? bfhi(cw[i >> 1]) : bflo(cw[i >> 1]), zpv = (i & 1) ? bfhi(pw[i >> 1]) : bflo(pw[i >> 1]);
                    float x = zcv + (zpv - zcv) * mm[i]; if (ks == 0) x = tanhf(x); else if (ks >= 2) x = sigmoidf_(x); v[i] = x; }
                u32x4 o; o.x = pk2(v[0], v[1]); o.y = pk2(v[2], v[3]); o.z = pk2(v[4], v[5]); o.w = pk2(v[6], v[7]); xf[ks] = __builtin_bit_cast(bf16x8, o);
            }
#pragma unroll
            for (int nf = 0; nf < 2; ++nf) { const f32x4 z4 = {0.f, 0.f, 0.f, 0.f};
                aw[m][nf] = __builtin_amdgcn_mfma_f32_16x16x32_bf16(w2f[nf], xf[0], z4, 0, 0, 0);
                aa[m][nf] = __builtin_amdgcn_mfma_f32_16x16x32_bf16(a2f[nf], xf[1], z4, 0, 0, 0);
                ag[m][nf] = __builtin_amdgcn_mfma_f32_16x16x32_bf16(g2f[nf][0], xf[2], z4, 0, 0, 0);
                ag[m][nf] = __builtin_amdgcn_mfma_f32_16x16x32_bf16(g2f[nf][1], xf[3], ag[m][nf], 0, 0, 0); }
        }
#pragma unroll
        for (int m = 0; m < 4; ++m) {
            const size_t t = (size_t)t0 + 16 * m + fr; const bool hp = (s0 + 16 * m + fr) > 0; float ssq = 0.f;
#pragma unroll
            for (int nf = 0; nf < 2; ++nf) { const int ch4 = c0 + 16 * nf + 4 * fq;
                const u32x2 kc = *(const u32x2*)(Z + t * ZS + ZC_K + ch4); u32x2 kp = {0u, 0u}; if (hp) kp = *(const u32x2*)(Z + (t - 1) * ZS + ZC_K + ch4);
                const f32x4 mk = *(const f32x4*)(mu + ZC_K + ch4), kkw = *(const f32x4*)(k_k + ch4);
                const f32x4 kcv = {bflo(kc.x), bfhi(kc.x), bflo(kc.y), bfhi(kc.y)}, kpv = {bflo(kp.x), bfhi(kp.x), bflo(kp.y), bfhi(kp.y)};
                const f32x4 k = kcv + (kpv - kcv) * mk; const f32x4 q = k * kkw; ssq += q[0] * q[0] + q[1] * q[1] + q[2] * q[2] + q[3] * q[3]; }
            ssq += shfl_xor_l(ssq, 16, lane); ssq += shfl_xor_l(ssq, 32, lane);
            if (fq == 0) hs[w * 64 + 16 * m + fr] = ssq;
        }
        __syncthreads();
#pragma unroll
        for (int m = 0; m < 4; ++m) {
            const size_t t = (size_t)t0 + 16 * m + fr; const bool hp = (s0 + 16 * m + fr) > 0;
            const float nrm = sqrtf(hs[w * 64 + 16 * m + fr] + hs[(w ^ 1) * 64 + 16 * m + fr]); const float rn = 1.f / fmaxf(nrm, 1e-12f);
#pragma unroll
            for (int nf = 0; nf < 2; ++nf) { const int ch4 = c0 + 16 * nf + 4 * fq;
                const f32x4 wv = aw[m][nf] + *(const f32x4*)(w0 + ch4), av = aa[m][nf] + *(const f32x4*)(a0 + ch4), gv = ag[m][nf];
                const u32x2 rc = *(const u32x2*)(Z + t * ZS + ZC_R + ch4), kc = *(const u32x2*)(Z + t * ZS + ZC_K + ch4), vc = *(const u32x2*)(Z + t * ZS + ZC_V + ch4);
                u32x2 rp = {0u, 0u}, kp = {0u, 0u}, vp = {0u, 0u};
                if (hp) { rp = *(const u32x2*)(Z + (t - 1) * ZS + ZC_R + ch4); kp = *(const u32x2*)(Z + (t - 1) * ZS + ZC_K + ch4); vp = *(const u32x2*)(Z + (t - 1) * ZS + ZC_V + ch4); }
                const f32x4 mr = *(const f32x4*)(mu + ZC_R + ch4), mk = *(const f32x4*)(mu + ZC_K + ch4), mv = *(const f32x4*)(mu + ZC_V + ch4), ka = *(const f32x4*)(k_a + ch4), kkw = *(const f32x4*)(k_k + ch4);
                const f32x4 rcv = {bflo(rc.x), bfhi(rc.x), bflo(rc.y), bfhi(rc.y)}, rpv = {bflo(rp.x), bfhi(rp.x), bflo(rp.y), bfhi(rp.y)};
                const f32x4 kcv = {bflo(kc.x), bfhi(kc.x), bflo(kc.y), bfhi(kc.y)}, kpv = {bflo(kp.x), bfhi(kp.x), bflo(kp.y), bfhi(kp.y)};
                const f32x4 vcv = {bflo(vc.x), bfhi(vc.x), bflo(vc.y), bfhi(vc.y)}, vpv = {bflo(vp.x), bfhi(vp.x), bflo(vp.y), bfhi(vp.y)};
                const f32x4 r = rcv + (rpv - rcv) * mr, k = kcv + (kpv - kcv) * mk, v = vcv + (vpv - vcv) * mv;
                f32x4 lw, a4, km, kk, bb;
#pragma unroll
                for (int i = 0; i < 4; ++i) { lw[i] = -__expf(-softplusf_(-wv[i]) - 0.5f); a4[i] = sigmoidf_(av[i]); kk[i] = k[i] * kkw[i] * rn; km[i] = k[i] * (1.f + (a4[i] - 1.f) * ka[i]); bb[i] = kk[i] * a4[i]; }
                const size_t o = t * 256 + ch4;
                u32x2 p;
                p.x = pk2(r[0], r[1]); p.y = pk2(r[2], r[3]); *(u32x2*)(R_ + o) = p;
                p.x = pk2(km[0], km[1]); p.y = pk2(km[2], km[3]); *(u32x2*)(K_ + o) = p;
                p.x = pk2(v[0], v[1]); p.y = pk2(v[2], v[3]); *(u32x2*)(V_ + o) = p;
                p.x = pk2(kk[0], kk[1]); p.y = pk2(kk[2], kk[3]); *(u32x2*)(KK_ + o) = p;
                p.x = pk2(bb[0], bb[1]); p.y = pk2(bb[2], bb[3]); *(u32x2*)(B_ + o) = p;
                p.x = pk2(gv[0], gv[1]); p.y = pk2(gv[2], gv[3]); *(u32x2*)(G_ + o) = p;
                *(f32x4*)(W_ + o) = lw; }
        }
        __syncthreads();
    }
}

DI f32x16 mfma32(bf16x8 a, bf16x8 b, f32x16 c) { return __builtin_amdgcn_mfma_f32_32x32x16_bf16(a, b, c, 0, 0, 0); }
DI bf16x8 ldfrag(const LAS unsigned char* base, int row, int ks, int h) { return *(const LAS bf16x8*)(base + row * 144 + (16 * ks + 8 * h) * 2); }
DI f32x16 zero16() { f32x16 z;
#pragma unroll
    for (int i = 0; i < 16; ++i) z[i] = 0.f;
    return z; }
DI bf16x8 pack8(const f32x16& x, int o) { u32x4 p; p.x = pk2(x[o], x[o + 1]); p.y = pk2(x[o + 2], x[o + 3]); p.z = pk2(x[o + 4], x[o + 5]); p.w = pk2(x[o + 6], x[o + 7]); return __builtin_bit_cast(bf16x8, p); }
DI f32x16 tileprod(const LAS unsigned char* Aimg, int a0, const LAS unsigned char* Bimg, int b0, f32x16 acc, int lr, int h2) {
#pragma unroll
    for (int ks = 0; ks < 4; ++ks) acc = mfma32(ldfrag(Aimg, a0 + lr, ks, h2), ldfrag(Bimg, b0 + lr, ks, h2), acc);
    return acc;
}
DI void put_tile(LAS unsigned char* img, int c0, int r0, const f32x16& a, int lr, int h2) {
#pragma unroll
    for (int g = 0; g < 4; ++g) { u32x2 o; o.x = pk2(a[4 * g], a[4 * g + 1]); o.y = pk2(a[4 * g + 2], a[4 * g + 3]); *(LAS u32x2*)(img + (c0 + lr) * 144 + (r0 + 8 * g + 4 * h2) * 2) = o; }
}
DI void phase_rwkv_A(const Frame& F, CArgs& A, int l) {
    const bf16_t* R_ = (const bf16_t*)(A.ws + WS_RW_R); const bf16_t* K_ = (const bf16_t*)(A.ws + WS_RW_K); const bf16_t* V_ = (const bf16_t*)(A.ws + WS_RW_V);
    const bf16_t* KK_ = (const bf16_t*)(A.ws + WS_RW_KK); const bf16_t* B_ = (const bf16_t*)(A.ws + WS_RW_B); const float* LW_ = (const float*)(A.ws + WS_RW_W);
    bf16_t* RP = (bf16_t*)(A.ws + WS_RC_RP); bf16_t* MP = (bf16_t*)(A.ws + WS_RC_MP); float* Y0T = (float*)(A.ws + WS_RC_Y0); float* GG = (float*)(A.ws + WS_RC_G);
    float* DP = (float*)(A.ws + WS_RC_DP); float* BSUM = (float*)(A.ws + WS_RC_BS);
    const float* r_k = A.in[15] + l * 256;
    constexpr int TB = 64 * 144;
#define TILE(i) (F.lds + (i) * TB)
    LAS float* XF = (LAS float*)TILE(13);
    const int w = F.wave;
    for (int u = F.bid; u < 4096; u += F.G) {
        const int bh = u >> 7, c = u & 127, b = bh >> 2, hd = bh & 3;
        const size_t t0 = (size_t)b * SEQ + 64 * c;
        {
        int tid = F.tid; asm volatile("" : "+v"(tid)); const int lane = tid & 63;
        const int t = tid >> 3, d0 = 8 * (tid & 7);
        const size_t gi = (t0 + t) * 256 + hd * 64 + d0;
        const f32x4 lw0 = *(const f32x4*)(LW_ + gi), lw1 = *(const f32x4*)(LW_ + gi + 4);
        const u32x4 rv = *(const u32x4*)(R_ + gi), kv = *(const u32x4*)(K_ + gi), vv = *(const u32x4*)(V_ + gi), kkv = *(const u32x4*)(KK_ + gi), bv = *(const u32x4*)(B_ + gi);
        *(LAS f32x4*)(XF + t * 64 + d0) = lw0; *(LAS f32x4*)(XF + t * 64 + d0 + 4) = lw1;
        __syncthreads();
        if (w == 0) { float cv[64];
#pragma unroll
            for (int i = 0; i < 64; ++i) cv[i] = XF[i * 64 + lane];
            float run = 0.f;
#pragma unroll
            for (int i = 0; i < 64; ++i) { run += cv[i]; XF[i * 64 + lane] = run; } }
        __syncthreads();
        const f32x4 c0 = *(const LAS f32x4*)(XF + t * 64 + d0), c1 = *(const LAS f32x4*)(XF + t * 64 + d0 + 4);
        const f32x4 e0 = *(const LAS f32x4*)(XF + 63 * 64 + d0), e1 = *(const LAS f32x4*)(XF + 63 * 64 + d0 + 4);
        const float cum[8] = {c0[0], c0[1], c0[2], c0[3], c1[0], c1[1], c1[2], c1[3]};
        const float lwv[8] = {lw0[0], lw0[1], lw0[2], lw0[3], lw1[0], lw1[1], lw1[2], lw1[3]};
        const float c63[8] = {e0[0], e0[1], e0[2], e0[3], e1[0], e1[1], e1[2], e1[3]};
        const unsigned rw[4] = {rv.x, rv.y, rv.z, rv.w}, kw[4] = {kv.x, kv.y, kv.z, kv.w}, vw[4] = {vv.x, vv.y, vv.z, vv.w}, qw[4] = {kkv.x, kkv.y, kkv.z, kkv.w}, bw[4] = {bv.x, bv.y, bv.z, bv.w};
        float al[8], bt[8], kt[8], rb[8], bhh[8], khh[8], vf[8]; float bs = 0.f;
#pragma unroll
        for (int i = 0; i < 8; ++i) {
            const float r = (i & 1) ? bfhi(rw[i >> 1]) : bflo(rw[i >> 1]), k = (i & 1) ? bfhi(kw[i >> 1]) : bflo(kw[i >> 1]), v = (i & 1) ? bfhi(vw[i >> 1]) : bflo(vw[i >> 1]);
            const float kk = (i & 1) ? bfhi(qw[i >> 1]) : bflo(qw[i >> 1]), bb = (i & 1) ? bfhi(bw[i >> 1]) : bflo(bw[i >> 1]);
            const float ec = __expf(cum[i]), em = 1.f / ec, ep = __expf(cum[i] - lwv[i]), p63 = __expf(c63[i]);
            al[i] = -kk * ep; bt[i] = bb * em; kt[i] = k * em; rb[i] = r * ec; bhh[i] = bt[i] * p63; khh[i] = kt[i] * p63; vf[i] = v;
            bs += r * k * r_k[hd * 64 + d0 + i];
            if (t == 63) DP[(size_t)u * 64 + d0 + i] = p63;
        }
        bs += shfl_xor_l(bs, 1, lane); bs += shfl_xor_l(bs, 2, lane); bs += shfl_xor_l(bs, 4, lane);
        if ((tid & 7) == 0) BSUM[(t0 + t) * 4 + hd] = bs;
        u32x4 o;
        o.x = pk2(al[0], al[1]); o.y = pk2(al[2], al[3]); o.z = pk2(al[4], al[5]); o.w = pk2(al[6], al[7]); *(LAS u32x4*)(TILE(0) + t * 144 + d0 * 2) = o;
        o.x = pk2(bt[0], bt[1]); o.y = pk2(bt[2], bt[3]); o.z = pk2(bt[4], bt[5]); o.w = pk2(bt[6], bt[7]); *(LAS u32x4*)(TILE(1) + t * 144 + d0 * 2) = o;
        o.x = pk2(kt[0], kt[1]); o.y = pk2(kt[2], kt[3]); o.z = pk2(kt[4], kt[5]); o.w = pk2(kt[6], kt[7]); *(LAS u32x4*)(TILE(2) + t * 144 + d0 * 2) = o;
        o.x = pk2(rb[0], rb[1]); o.y = pk2(rb[2], rb[3]); o.z = pk2(rb[4], rb[5]); o.w = pk2(rb[6], rb[7]); *(LAS u32x4*)(TILE(3) + t * 144 + d0 * 2) = o;
#pragma unroll
        for (int i = 0; i < 8; ++i) { *(LAS bf16_t*)(TILE(4) + (d0 + i) * 144 + t * 2) = (bf16_t)f2bf(vf[i]); *(LAS bf16_t*)(TILE(5) + (d0 + i) * 144 + t * 2) = (bf16_t)f2bf(bhh[i]);
            *(LAS bf16_t*)(TILE(6) + (d0 + i) * 144 + t * 2) = (bf16_t)f2bf(khh[i]); *(LAS bf16_t*)(TILE(7) + (d0 + i) * 144 + t * 2) = (bf16_t)f2bf(al[i]); }
        }
        __syncthreads();
        f32x16 Tacc = zero16();
        {
        int tl = F.tid; asm volatile("" : "+v"(tl)); const int lane = tl & 63, lr = lane & 31, h2 = lane >> 5;
        unsigned zz = 0u; asm volatile("" : "+v"(zz));
        for (int i = tl; i < 768; i += NTHR) { const int q = i >> 7, rr = (i & 127) >> 2, cc = i & 3; const int tile = q < 4 ? 8 + q : q == 4 ? 14 : 12;
            *(LAS u32x4*)(TILE(tile) + (q == 5 ? (32 + rr) * 144 : rr * 144 + 64) + cc * 16) = (u32x4){zz, zz, zz, zz}; }
#pragma unroll
        for (int rnd = 0; rnd < 2; ++rnd) {
            const int j = w + 8 * rnd;
            if (j < 15) {
                const int prod = j / 3, tile = j % 3, si = tile == 2 ? 1 : 0, ti = tile == 0 ? 0 : 1;
                if (prod == 1) {
                    f32x16 acc = tileprod(TILE(0), 32 * ti, TILE(1), 32 * si, zero16(), lr, h2);
                    const int ss = 32 * si + lr;
#pragma unroll
                    for (int q = 0; q < 16; ++q) { const int tt = 32 * ti + 8 * (q >> 2) + 4 * h2 + (q & 3); if (!(ss < tt)) acc[q] = 0.f; }
                    put_tile(TILE(12), 32 * si, 32 * ti, acc, lr, h2);
                } else {
                    const LAS unsigned char* Ao = (prod == 0 || prod == 3) ? TILE(1) : TILE(2); const LAS unsigned char* Bo = prod >= 3 ? TILE(3) : TILE(0);
                    f32x16 acc = tileprod(Ao, 32 * si, Bo, 32 * ti, zero16(), lr, h2);
                    const int tt = 32 * ti + lr, incl = prod >= 3 ? 1 : 0;
#pragma unroll
                    for (int q = 0; q < 16; ++q) { const int ss = 32 * si + 8 * (q >> 2) + 4 * h2 + (q & 3); if (!(ss < tt + incl)) acc[q] = 0.f; }
                    if (prod == 0) { put_tile(TILE(11), 32 * ti, 32 * si, acc, lr, h2);
#pragma unroll
                        for (int q = 0; q < 16; ++q) { const int ss = 32 * si + 8 * (q >> 2) + 4 * h2 + (q & 3); Tacc[q] = acc[q] + (ss == tt ? 1.f : 0.f); }
                        put_tile(TILE(14), 32 * ti, 32 * si, Tacc, lr, h2);
                    } else put_tile(TILE(prod == 2 ? 8 : prod == 3 ? 9 : 10), 32 * ti, 32 * si, acc, lr, h2);
                }
            }
        }
        }
        __syncthreads();
        {
        int tl = F.tid; asm volatile("" : "+v"(tl)); const int lane = tl & 63, lr = lane & 31, h2 = lane >> 5;
        if (tl < 384) { const int q = tl >> 7, rr = (tl & 127) >> 2, cc = tl & 3;
            unsigned zz = 0u; asm volatile("" : "+v"(zz));
            *(LAS u32x4*)(TILE(q) + (q == 1 ? (32 + rr) * 144 : rr * 144 + 64) + cc * 16) = (u32x4){zz, zz, zz, zz}; }
        __syncthreads();
#pragma unroll
        for (int k = 1; k <= 5; ++k) {
            LAS unsigned char* Ss = (k & 1) ? TILE(11) : TILE(0); LAS unsigned char* STs = (k & 1) ? TILE(12) : TILE(1);
            LAS unsigned char* Sd = (k & 1) ? TILE(0) : TILE(11); LAS unsigned char* STd = (k & 1) ? TILE(1) : TILE(12);
            LAS unsigned char* Ts = (k & 1) ? TILE(14) : TILE(2); LAS unsigned char* Td = (k & 1) ? TILE(2) : TILE(14);
            if (w < 6) { const int tile = w % 3, ti = tile == 0 ? 0 : 1, si = tile == 2 ? 1 : 0;
                if (w < 3) { f32x16 acc = tileprod(Ss, 32 * ti, STs, 32 * si, zero16(), lr, h2); put_tile(STd, 32 * si, 32 * ti, acc, lr, h2); }
                else { f32x16 acc = tileprod(STs, 32 * si, Ss, 32 * ti, zero16(), lr, h2); put_tile(Sd, 32 * ti, 32 * si, acc, lr, h2); }
            } else if (k == 1) {
#pragma unroll
                for (int jj = 0; jj < 2; ++jj) { const int tile = (w - 6) * 2 + jj, ti = tile >> 1, ei = tile & 1;
                    f32x16 acc = tileprod(TILE(8), 32 * ti, TILE(4), 32 * ei, zero16(), lr, h2); put_tile(TILE(13), 32 * ei, 32 * ti, acc, lr, h2); }
            }
            __syncthreads();
            if (w < 3) { const int si = w == 2 ? 1 : 0, ti = w == 0 ? 0 : 1;
                Tacc = tileprod(STd, 32 * si, Ts, 32 * ti, Tacc, lr, h2); put_tile(Td, 32 * ti, 32 * si, Tacc, lr, h2); }
        }
        __syncthreads();
        { const int tile = w & 3, ti = tile >> 1, ci = tile & 1;
          f32x16 acc = tileprod(TILE(2), 32 * ti, w < 4 ? TILE(13) : TILE(7), 32 * ci, zero16(), lr, h2); put_tile(w < 4 ? TILE(11) : TILE(12), 32 * ci, 32 * ti, acc, lr, h2); }
        }
        __syncthreads();
        {
        int tl = F.tid; asm volatile("" : "+v"(tl)); const int lane = tl & 63, lr = lane & 31, h2 = lane >> 5; const int tj = w & 3, ta = tj >> 1, tb = tj & 1;
        if (w < 4) {
            { f32x16 acc = tileprod(TILE(12), 32 * ta, TILE(9), 32 * tb, zero16(), lr, h2);
              const int tt = 32 * tb + lr;
#pragma unroll
              for (int g = 0; g < 4; ++g) { const int dd = 32 * ta + 8 * g + 4 * h2; const u32x2 rbv = *(const LAS u32x2*)(TILE(3) + tt * 144 + dd * 2);
                  u32x2 o; o.x = pk2(acc[4 * g] + bflo(rbv.x), acc[4 * g + 1] + bfhi(rbv.x)); o.y = pk2(acc[4 * g + 2] + bflo(rbv.y), acc[4 * g + 3] + bfhi(rbv.y));
                  *(u32x2*)(RP + ((size_t)u * 64 + tt) * 64 + dd) = o; } }
            { f32x16 acc = tileprod(TILE(12), 32 * ta, TILE(5), 32 * tb, zero16(), lr, h2);
              const int dcol = 32 * tb + lr;
#pragma unroll
              for (int g = 0; g < 4; ++g) { const int dp = 32 * ta + 8 * g + 4 * h2; u32x2 o; o.x = pk2(acc[4 * g], acc[4 * g + 1]); o.y = pk2(acc[4 * g + 2], acc[4 * g + 3]);
                  *(u32x2*)(MP + ((size_t)u * 64 + dcol) * 64 + dp) = o; } }
        } else {
            f32x16 z2 = tileprod(TILE(4), 32 * ta, TILE(10), 32 * tb, zero16(), lr, h2);
            z2 = tileprod(TILE(11), 32 * ta, TILE(9), 32 * tb, z2, lr, h2);
            float* yo = Y0T + (((size_t)u * 4 + tj) * 64 + lane) * 16;
#pragma unroll
            for (int g = 0; g < 4; ++g) *(f32x4*)(yo + 4 * g) = (f32x4){z2[4 * g], z2[4 * g + 1], z2[4 * g + 2], z2[4 * g + 3]};
            f32x16 acc = tileprod(TILE(5), 32 * ta, TILE(11), 32 * tb, zero16(), lr, h2);
            acc = tileprod(TILE(6), 32 * ta, TILE(4), 32 * tb, acc, lr, h2);
            float* go = GG + (((size_t)u * 4 + tj) * 64 + lane) * 16;
#pragma unroll
            for (int g = 0; g < 4; ++g) *(f32x4*)(go + 4 * g) = (f32x4){acc[4 * g], acc[4 * g + 1], acc[4 * g + 2], acc[4 * g + 3]};
        }
        }
        __syncthreads();
    }
#undef TILE
}
DI void phase_rwkv_B(const Frame& F, CArgs& A) {
    if (F.bid >= 32 || F.wave >= 2) return;
    const bf16_t* MP = (const bf16_t*)(A.ws + WS_RC_MP); const float* GG = (const float*)(A.ws + WS_RC_G); const float* DP = (const float*)(A.ws + WS_RC_DP);
    bf16_t* HB = (bf16_t*)(A.ws + WS_RC_HB);
    const int bh = F.bid, eb = F.wave, lane = F.lane, lr = lane & 31, h2 = lane >> 5;
    f32x16 acc[2]; acc[0] = zero16(); acc[1] = zero16();
    for (int c = 0; c < 128; ++c) {
        const size_t u = (size_t)bh * 128 + c;
        bf16x8 hb[4];
#pragma unroll
        for (int s = 0; s < 4; ++s) { hb[s] = pack8(acc[s >> 1], 8 * (s & 1)); *(bf16x8*)(HB + (((u * 2 + eb) * 4 + s) * 64 + lane) * 8) = hb[s]; }
#pragma unroll
        for (int di = 0; di < 2; ++di) {
            const float* gp = GG + ((u * 4 + di * 2 + eb) * 64 + lane) * 16;
            f32x16 n;
#pragma unroll
            for (int g = 0; g < 4; ++g) { const f32x4 gv = *(const f32x4*)(gp + 4 * g); const f32x4 dv = *(const f32x4*)(DP + u * 64 + 32 * di + 8 * g + 4 * h2);
                n[4 * g] = dv[0] * acc[di][4 * g] + gv[0]; n[4 * g + 1] = dv[1] * acc[di][4 * g + 1] + gv[1]; n[4 * g + 2] = dv[2] * acc[di][4 * g + 2] + gv[2]; n[4 * g + 3] = dv[3] * acc[di][4 * g + 3] + gv[3]; }
            const bf16_t* mrow = MP + (u * 64 + 32 * di + lr) * 64;
#pragma unroll
            for (int s = 0; s < 4; ++s) { const u32x2 m0 = *(const u32x2*)(mrow + 16 * s + 4 * h2), m1 = *(const u32x2*)(mrow + 16 * s + 8 + 4 * h2);
                u32x4 mw; mw.x = m0.x; mw.y = m0.y; mw.z = m1.x; mw.w = m1.y;
                n = mfma32(__builtin_bit_cast(bf16x8, mw), hb[s], n); }
            acc[di] = n;
        }
    }
}
DI void phase_rwkv_C(const Frame& F, CArgs& A, int l) {
    const bf16_t* RP = (const bf16_t*)(A.ws + WS_RC_RP); const float* Y0T = (const float*)(A.ws + WS_RC_Y0); const bf16_t* HB = (const bf16_t*)(A.ws + WS_RC_HB); const float* BSUM = (const float*)(A.ws + WS_RC_BS);
    const bf16_t* V_ = (const bf16_t*)(A.ws + WS_RW_V); const bf16_t* G_ = (const bf16_t*)(A.ws + WS_RW_G); bf16_t* MIX = (bf16_t*)(A.ws + WS_MIX);
    const float* ln_w = A.in[16] + l * 256; const float* ln_b = A.in[17] + l * 256;
    const int lane = F.lane, lr = lane & 31, h2 = lane >> 5;
    for (int job = F.gw; job < 8192; job += F.ngw) {
        const size_t u = (size_t)(job >> 1); const int tt = job & 1, bh = (int)(u >> 7), c = (int)(u & 127), b = bh >> 2, hd = bh & 3;
        const size_t tok = (size_t)b * SEQ + 64 * c + 32 * tt + lr;
        bf16x8 bfr[4];
        const bf16_t* rrow = RP + (u * 64 + 32 * tt + lr) * 64;
#pragma unroll
        for (int s = 0; s < 4; ++s) { const u32x2 m0 = *(const u32x2*)(rrow + 16 * s + 4 * h2), m1 = *(const u32x2*)(rrow + 16 * s + 8 + 4 * h2); u32x4 mw; mw.x = m0.x; mw.y = m0.y; mw.z = m1.x; mw.w = m1.y; bfr[s] = __builtin_bit_cast(bf16x8, mw); }
        f32x16 y[2];
#pragma unroll
        for (int et = 0; et < 2; ++et) { const float* yp = Y0T + ((u * 4 + et * 2 + tt) * 64 + lane) * 16;
#pragma unroll
            for (int g = 0; g < 4; ++g) { const f32x4 v = *(const f32x4*)(yp + 4 * g); y[et][4 * g] = v[0]; y[et][4 * g + 1] = v[1]; y[et][4 * g + 2] = v[2]; y[et][4 * g + 3] = v[3]; }
#pragma unroll
            for (int s = 0; s < 4; ++s) { const bf16x8 hf = *(const bf16x8*)(HB + (((u * 2 + et) * 4 + s) * 64 + lane) * 8); y[et] = mfma32(hf, bfr[s], y[et]); } }
        float sm = 0.f;
#pragma unroll
        for (int i = 0; i < 16; ++i) sm += y[0][i] + y[1][i];
        sm += shfl_xor_l(sm, 32, lane); const float mean = sm * (1.f / 64.f);
        float sq = 0.f;
#pragma unroll
        for (int i = 0; i < 16; ++i) { const float d0 = y[0][i] - mean, d1 = y[1][i] - mean; sq += d0 * d0 + d1 * d1; }
        sq += shfl_xor_l(sq, 32, lane); const float rstd = rsqrtf(sq * (1.f / 64.f) + 64e-5f);
        const float bs = BSUM[tok * 4 + hd];
#pragma unroll
        for (int et = 0; et < 2; ++et)
#pragma unroll
            for (int g = 0; g < 4; ++g) { const int e0 = hd * 64 + 32 * et + 8 * g + 4 * h2;
                const f32x4 lw = *(const f32x4*)(ln_w + e0), lb = *(const f32x4*)(ln_b + e0);
                const u32x2 vv = *(const u32x2*)(V_ + tok * 256 + e0), gv = *(const u32x2*)(G_ + tok * 256 + e0);
                const float o0 = ((y[et][4 * g] - mean) * rstd * lw[0] + lb[0] + bs * bflo(vv.x)) * bflo(gv.x), o1 = ((y[et][4 * g + 1] - mean) * rstd * lw[1] + lb[1] + bs * bfhi(vv.x)) * bfhi(gv.x);
                const float o2 = ((y[et][4 * g + 2] - mean) * rstd * lw[2] + lb[2] + bs * bflo(vv.y)) * bflo(gv.y), o3 = ((y[et][4 * g + 3] - mean) * rstd * lw[3] + lb[3] + bs * bfhi(vv.y)) * bfhi(gv.y);
                u32x2 o; o.x = pk2(o0, o1); o.y = pk2(o2, o3);
                *(u32x2*)(MIX + tok * DM + e0) = o; }
    }
}

template <int PASS>
DI void phase_s5(const Frame& F, CArgs& A, int l) {
    const bf16_t* Z = (const bf16_t*)(A.ws + WS_Z); float* SEND = (float*)(A.ws + WS_S5END); bf16_t* YS = (bf16_t*)(A.ws + WS_YS5);
    LAS float* hre = (LAS float*)(F.lds + F.wave * 16512); LAS float* him = hre + 16 * 65; LAS float* cre = him + 16 * 65; LAS float* cim = cre + 16 * 64;
    const int lane = F.lane;
    for (int it = F.gw; it < 8 * 16 * 16; it += F.ngw) {
        const int b = it >> 8, g = (it >> 4) & 15, seg = it & 15, p = lane;
        const float dt = __expf(A.in[25][l * 16 + g]);
        const float lre = A.in[18][(l * 16 + g) * 64 + p], lim = A.in[19][(l * 16 + g) * 64 + p];
        const float mag = expf(lre * dt); float sn, cn; sincosf(lim * dt, &sn, &cn);
        const float are = mag * cn, aim = mag * sn, den = lre * lre + lim * lim;
        const float qre = ((are - 1.f) * lre + aim * lim) / den, qim = (aim * lre - (are - 1.f) * lim) / den;
        float bbr[16], bbi[16];
        { const float* br = A.in[20] + ((size_t)(l * 16 + g) * 64 + p) * 16; const float* bi = A.in[21] + ((size_t)(l * 16 + g) * 64 + p) * 16;
#pragma unroll
          for (int i = 0; i < 16; ++i) { const float x = br[i], y = bi[i]; bbr[i] = qre * x - qim * y; bbi[i] = qre * y + qim * x; } }
        float h_re = 0.f, h_im = 0.f;
        if (PASS == 2) {
            const float m512 = expf(512.f * lre * dt); float s5, c5; sincosf(512.f * (lim * dt), &s5, &c5); const float pr = m512 * c5, pi_ = m512 * s5;
            for (int j = 0; j < seg; ++j) { const float* e = SEND + ((size_t)((b * 16 + g) * 16 + j)) * 128; const float er = e[p], ei = e[64 + p];
                const float nr = pr * h_re - pi_ * h_im + er, ni = pr * h_im + pi_ * h_re + ei; h_re = nr; h_im = ni; }
            for (int i = lane; i < 1024; i += 64) { cre[i] = A.in[22][(size_t)(l * 16 + g) * 1024 + i]; cim[i] = A.in[23][(size_t)(l * 16 + g) * 1024 + i]; }
        }
        const bf16_t* zb = Z + ((size_t)b * SEQ + seg * 512) * ZS + ZC_S5 + g * 16;
        for (int t0 = 0; t0 < 512; t0 += 16) {
#pragma unroll
            for (int sb = 0; sb < 2; ++sb) {
                u32x4 ua[8], ub[8];
#pragma unroll
                for (int q = 0; q < 8; ++q) { const bf16_t* zp = zb + (size_t)(t0 + sb * 8 + q) * ZS; ua[q] = *(const u32x4*)zp; ub[q] = *(const u32x4*)(zp + 8); }
#pragma unroll
                for (int q = 0; q < 8; ++q) {
                    float br_ = 0.f, bi_ = 0.f;
                    const unsigned uw[8] = {ua[q].x, ua[q].y, ua[q].z, ua[q].w, ub[q].x, ub[q].y, ub[q].z, ub[q].w};
#pragma unroll
                    for (int i = 0; i < 8; ++i) { const float u0 = bflo(uw[i]), u1 = bfhi(uw[i]); br_ += bbr[2 * i] * u0 + bbr[2 * i + 1] * u1; bi_ += bbi[2 * i] * u0 + bbi[2 * i + 1] * u1; }
                    const float nr = are * h_re - aim * h_im + br_, ni = are * h_im + aim * h_re + bi_; h_re = nr; h_im = ni;
                    if (PASS == 2) { hre[(sb * 8 + q) * 65 + p] = h_re; him[(sb * 8 + q) * 65 + p] = h_im; }
                }
            }
            if (PASS == 2) {
                asm volatile("s_waitcnt lgkmcnt(0)" ::: "memory");
                const int tl = lane & 15, iq = lane >> 4;
                float acc[4] = {0.f, 0.f, 0.f, 0.f};
                for (int pp = 0; pp < 64; ++pp) { const float xr = hre[tl * 65 + pp], xi = him[tl * 65 + pp];
#pragma unroll
                    for (int i = 0; i < 4; ++i) acc[i] += xr * cre[(4 * iq + i) * 64 + pp] - xi * cim[(4 * iq + i) * 64 + pp]; }
                const int tt = seg * 512 + t0 + tl; const size_t tok = (size_t)b * SEQ + tt;
                const u32x2 uu = *(const u32x2*)(Z + tok * ZS + ZC_S5 + g * 16 + 4 * iq);
                const f32x4 dd = *(const f32x4*)(A.in[24] + l * 256 + g * 16 + 4 * iq);
                const float y0 = gelu_tanh(acc[0] + dd[0] * bflo(uu.x)), y1 = gelu_tanh(acc[1] + dd[1] * bfhi(uu.x)), y2 = gelu_tanh(acc[2] + dd[2] * bflo(uu.y)), y3 = gelu_tanh(acc[3] + dd[3] * bfhi(uu.y));
                u32x2 o; o.x = pk2(y0, y1); o.y = pk2(y2, y3);
                *(u32x2*)(YS + tok * 256 + g * 16 + 4 * iq) = o;
                asm volatile("s_waitcnt lgkmcnt(0)" ::: "memory");
            }
        }
        if (PASS == 1) { float* e = SEND + ((size_t)((b * 16 + g) * 16 + seg)) * 128; e[p] = h_re; e[64 + p] = h_im; }
    }
}

DI void phase_lru_prep(const Frame& F, CArgs& A, int l) {
    const bf16_t* Z = (const bf16_t*)(A.ws + WS_Z); float* LA = (float*)(A.ws + WS_LA); float* LB = (float*)(A.ws + WS_LB);
    const float* cw = A.in[34] + l * 4 * 256; const float* cb = A.in[35] + l * 256; const float* ba = A.in[37] + l * 256; const float* bx = A.in[39] + l * 256; const float* lam = A.in[40] + l * 256;
    const bf16_t* WL = (const bf16_t*)(A.ws + WS_WLRU) + (size_t)l * 2 * 4 * 4096;
    LAS float* xs = (LAS float*)F.lds;
    const int w = F.wave, n = w >> 1, hf = w & 1;
    bf16x8 waf[2][2], wxf[2][2];
    { const int fr = F.lane & 15, fq = F.lane >> 4;
#pragma unroll
      for (int nf = 0; nf < 2; ++nf)
#pragma unroll
          for (int ks = 0; ks < 2; ++ks) { const int j = 32 * hf + 16 * nf + fr;
              waf[nf][ks] = *(const bf16x8*)(WL + ((size_t)(0 * 4 + n) * 64 + j) * 64 + 32 * ks + 8 * fq); wxf[nf][ks] = *(const bf16x8*)(WL + ((size_t)(1 * 4 + n) * 64 + j) * 64 + 32 * ks + 8 * fq); } }
    for (int tile = F.bid; tile < T / 64; tile += F.G) {
        int tz = F.tid; asm volatile("" : "+v"(tz)); const int lane = tz & 63, fr = lane & 15, fq = lane >> 4;
        const int t0 = tile * 64, s0 = t0 % SEQ;
        f32x4 accA[4][2], accX[4][2];
#pragma unroll
        for (int m = 0; m < 4; ++m) {
            const int tok = 16 * m + fr, sq = s0 + tok;
            bf16x8 xf[2];
#pragma unroll
            for (int ks = 0; ks < 2; ++ks) { const int ch0 = n * 64 + 32 * ks + 8 * fq;
                const f32x4 b0 = *(const f32x4*)(cb + ch0), b1 = *(const f32x4*)(cb + ch0 + 4);
                float xc[8] = {b0[0], b0[1], b0[2], b0[3], b1[0], b1[1], b1[2], b1[3]};
#pragma unroll
                for (int j = 0; j < 4; ++j) if (sq - 3 + j >= 0) {
                    const u32x4 z8 = *(const u32x4*)(Z + (size_t)(t0 + tok - 3 + j) * ZS + ZC_LX + ch0);
                    const f32x4 c0 = *(const f32x4*)(cw + j * 256 + ch0), c1 = *(const f32x4*)(cw + j * 256 + ch0 + 4);
                    xc[0] += c0[0] * bflo(z8.x); xc[1] += c0[1] * bfhi(z8.x); xc[2] += c0[2] * bflo(z8.y); xc[3] += c0[3] * bfhi(z8.y);
                    xc[4] += c1[0] * bflo(z8.z); xc[5] += c1[1] * bfhi(z8.z); xc[6] += c1[2] * bflo(z8.w); xc[7] += c1[3] * bfhi(z8.w); }
                u32x4 o; o.x = pk2(xc[0], xc[1]); o.y = pk2(xc[2], xc[3]); o.z = pk2(xc[4], xc[5]); o.w = pk2(xc[6], xc[7]); xf[ks] = __builtin_bit_cast(bf16x8, o);
                if (hf == 0) { *(LAS f32x4*)(xs + tok * 260 + ch0) = (f32x4){xc[0], xc[1], xc[2], xc[3]}; *(LAS f32x4*)(xs + tok * 260 + ch0 + 4) = (f32x4){xc[4], xc[5], xc[6], xc[7]}; }
            }
#pragma unroll
            for (int nf = 0; nf < 2; ++nf) { const f32x4 z4 = {0.f, 0.f, 0.f, 0.f};
                accA[m][nf] = __builtin_amdgcn_mfma_f32_16x16x32_bf16(waf[nf][0], xf[0], z4, 0, 0, 0); accA[m][nf] = __builtin_amdgcn_mfma_f32_16x16x32_bf16(waf[nf][1], xf[1], accA[m][nf], 0, 0, 0);
                accX[m][nf] = __builtin_amdgcn_mfma_f32_16x16x32_bf16(wxf[nf][0], xf[0], z4, 0, 0, 0); accX[m][nf] = __builtin_amdgcn_mfma_f32_16x16x32_bf16(wxf[nf][1], xf[1], accX[m][nf], 0, 0, 0); }
        }
        __syncthreads();
#pragma unroll
        for (int m = 0; m < 4; ++m)
#pragma unroll
            for (int nf = 0; nf < 2; ++nf) { const int tok = 16 * m + fr, ch4 = n * 64 + 32 * hf + 16 * nf + 4 * fq;
                const f32x4 xc = *(const LAS f32x4*)(xs + tok * 260 + ch4), b_a = *(const f32x4*)(ba + ch4), b_x = *(const f32x4*)(bx + ch4), lm = *(const f32x4*)(lam + ch4);
                f32x4 av, bv;
#pragma unroll
                for (int i = 0; i < 4; ++i) { const float r = sigmoidf_(accA[m][nf][i] + b_a[i]), ig = sigmoidf_(accX[m][nf][i] + b_x[i]); const float log_a = -8.f * r * softplusf_(-lm[i]);
                    av[i] = __expf(log_a); bv[i] = sqrtf(-expm1f(2.f * log_a)) * (ig * xc[i]); }
                *(f32x4*)(LA + (size_t)(t0 + tok) * 256 + ch4) = av; *(f32x4*)(LB + (size_t)(t0 + tok) * 256 + ch4) = bv; }
        __syncthreads();
    }
}
DI void phase_lru_sum(const Frame& F, CArgs& A) {
    const float* LA = (const float*)(A.ws + WS_LA); const float* LB = (const float*)(A.ws + WS_LB); float* LS = (float*)(A.ws + WS_LSUM);
    for (int it = F.gw; it < 8 * 128; it += F.ngw) {
        const size_t r0 = (size_t)it * 64;
        f32x4 Ap = {1.f, 1.f, 1.f, 1.f}, Bp = {0.f, 0.f, 0.f, 0.f};
#pragma unroll 8
        for (int t = 0; t < 64; ++t) { const f32x4 a = *(const f32x4*)(LA + (r0 + t) * 256 + 4 * F.lane), bb = *(const f32x4*)(LB + (r0 + t) * 256 + 4 * F.lane); Bp = a * Bp + bb; Ap = Ap * a; }
        *(f32x4*)(LS + ((size_t)it * 2) * 256 + 4 * F.lane) = Ap; *(f32x4*)(LS + ((size_t)it * 2 + 1) * 256 + 4 * F.lane) = Bp;
    }
}
DI void phase_lru_fin(const Frame& F, CArgs& A) {
    const float* LA = (const float*)(A.ws + WS_LA); const float* LB = (const float*)(A.ws + WS_LB); const float* LS = (const float*)(A.ws + WS_LSUM);
    const bf16_t* Z = (const bf16_t*)(A.ws + WS_Z); bf16_t* YL = (bf16_t*)(A.ws + WS_YL);
    for (int it = F.gw; it < 8 * 128; it += F.ngw) {
        const int b = it >> 7, c = it & 127;
        f32x4 h = {0.f, 0.f, 0.f, 0.f};
        for (int j = 0; j < c; ++j) { const f32x4 a = *(const f32x4*)(LS + ((size_t)(b * 128 + j) * 2) * 256 + 4 * F.lane), bb = *(const f32x4*)(LS + ((size_t)(b * 128 + j) * 2 + 1) * 256 + 4 * F.lane); h = a * h + bb; }
        const size_t r0 = (size_t)it * 64;
#pragma unroll 4
        for (int t = 0; t < 64; ++t) { const f32x4 a = *(const f32x4*)(LA + (r0 + t) * 256 + 4 * F.lane), bb = *(const f32x4*)(LB + (r0 + t) * 256 + 4 * F.lane); h = a * h + bb;
            const u32x2 gz = *(const u32x2*)(Z + (r0 + t) * ZS + ZC_LG + 4 * F.lane);
            u32x2 o; o.x = pk2(h[0] * gelu_tanh(bflo(gz.x)), h[1] * gelu_tanh(bfhi(gz.x))); o.y = pk2(h[2] * gelu_tanh(bflo(gz.y)), h[3] * gelu_tanh(bfhi(gz.y)));
            *(u32x2*)(YL + (r0 + t) * 256 + 4 * F.lane) = o; }
    }
}

DI void phase_branch_norm(const Frame& F, CArgs& A, int l) {
    const bf16_t* S0 = (const bf16_t*)(A.ws + WS_YS5G); const bf16_t* S1 = (const bf16_t*)(A.ws + WS_ATTO); const bf16_t* S2 = (const bf16_t*)(A.ws + WS_YL);
    bf16_t* MIX = (bf16_t*)(A.ws + WS_MIX); const float* bg = A.in[41] + l * 768;
    for (int row = F.gw; row < T; row += F.ngw) {
#pragma unroll
        for (int br = 0; br < 3; ++br) { const bf16_t* S = br == 0 ? S0 : br == 1 ? S1 : S2;
            const u32x2 v = *(const u32x2*)(S + (size_t)row * 256 + 4 * F.lane);
            const float x0 = bflo(v.x), x1 = bfhi(v.x), x2 = bflo(v.y), x3 = bfhi(v.y);
            const float r = rsqrtf(wave_sum(x0 * x0 + x1 * x1 + x2 * x2 + x3 * x3) * (1.f / 256.f) + NORM_EPS);
            const f32x4 g = *(const f32x4*)(bg + br * 256 + 4 * F.lane);
            u32x2 o; o.x = pk2(x0 * r * g[0], x1 * r * g[1]); o.y = pk2(x2 * r * g[2], x3 * r * g[3]);
            *(u32x2*)(MIX + (size_t)row * DM + 256 * (br + 1) + 4 * F.lane) = o; }
    }
}

DI void phase_norm2_router(const Frame& F, CArgs& A, int l) {
    const float* MODL = (const float*)(A.ws + WS_MOD) + (size_t)l * 8 * 6144;
    const float* g = A.in[43] + l * 1024;
    bf16_t* H = (bf16_t*)(A.ws + WS_H);
    int* EID = (int*)(A.ws + WS_RT_EID); float* GATE = (float*)(A.ws + WS_RT_GATE); int* PIE = (int*)(A.ws + WS_RT_PIE);
    unsigned* CNT = (unsigned*)(A.ws + WS_CTL) + CW_CNT + l * 64;
    const bf16_t* WRh = (const bf16_t*)(A.ws + WS_WR) + (size_t)(l * 2) * 48 * 1024; const bf16_t* WRl = WRh + 48 * 1024;
    LAS float* part = (LAS float*)F.lds;
    LAS float* red = part + 8 * 64 * 48;
    LAS float* lsum = red + 8 * 64;
    LAS unsigned* lcnt = (LAS unsigned*)(lsum + 64 * 36);
    LAS int* lsel = (LAS int*)(lcnt + 64);
    const float* bgp = A.in[45] + l * 4; const float* bep = A.in[47] + l * 32;
    const int w = F.wave, k0 = 128 * w;
    bf16x8 bh[3][4], bl[3][4];
    { const int fr = F.lane & 15, fq = F.lane >> 4;
#pragma unroll
      for (int n = 0; n < 3; ++n)
#pragma unroll
          for (int ks = 0; ks < 4; ++ks) { bh[n][ks] = *(const bf16x8*)(WRh + (size_t)(16 * n + fr) * 1024 + k0 + 32 * ks + 8 * fq); bl[n][ks] = *(const bf16x8*)(WRl + (size_t)(16 * n + fr) * 1024 + k0 + 32 * ks + 8 * fq); } }
    for (int tile = F.bid; tile < T / 64; tile += F.G) {
        int tz = F.tid; asm volatile("" : "+v"(tz)); const int lane = tz & 63, fr = lane & 15, fq = lane >> 4;
        const int row0 = tile * 64, b = row0 / SEQ;
        const float* xb = A.out + (size_t)(row0 + fr) * DM + k0 + 8 * fq;
        float ss[4];
#pragma unroll
        for (int m = 0; m < 4; ++m) { float a = 0.f;
#pragma unroll
            for (int ks = 0; ks < 4; ++ks) { const f32x4 x0 = *(const f32x4*)(xb + (size_t)(16 * m) * DM + 32 * ks), x1 = *(const f32x4*)(xb + (size_t)(16 * m) * DM + 32 * ks + 4);
                a += x0[0] * x0[0] + x0[1] * x0[1] + x0[2] * x0[2] + x0[3] * x0[3] + x1[0] * x1[0] + x1[1] * x1[1] + x1[2] * x1[2] + x1[3] * x1[3]; }
            a += shfl_xor_l(a, 16, lane); a += shfl_xor_l(a, 32, lane); ss[m] = a; }
        if (fq == 0) {
#pragma unroll
            for (int m = 0; m < 4; ++m) red[w * 64 + 16 * m + fr] = ss[m]; }
        if (tz < 32) lcnt[tz] = 0u;
        __syncthreads();
        f32x4 acc[4][3];
#pragma unroll
        for (int m = 0; m < 4; ++m) { float tot = 0.f;
#pragma unroll
            for (int ww = 0; ww < 8; ++ww) tot += red[ww * 64 + 16 * m + fr];
            const float rstd = rsqrtf(tot * (1.f / DM) + NORM_EPS);
#pragma unroll
            for (int n = 0; n < 3; ++n) acc[m][n] = (f32x4){0.f, 0.f, 0.f, 0.f};
#pragma unroll
            for (int ks = 0; ks < 4; ++ks) { const int kc = k0 + 32 * ks + 8 * fq;
                const f32x4 x0 = *(const f32x4*)(xb + (size_t)(16 * m) * DM + 32 * ks), x1 = *(const f32x4*)(xb + (size_t)(16 * m) * DM + 32 * ks + 4);
                const f32x4 g0 = *(const f32x4*)(g + kc), g1 = *(const f32x4*)(g + kc + 4);
                const f32x4 s0 = *(const f32x4*)(MODL + (size_t)b * 6144 + 4096 + kc), s1 = *(const f32x4*)(MODL + (size_t)b * 6144 + 4096 + kc + 4);
                const f32x4 h0 = *(const f32x4*)(MODL + (size_t)b * 6144 + 3072 + kc), h1 = *(const f32x4*)(MODL + (size_t)b * 6144 + 3072 + kc + 4);
                const f32x4 v0 = x0 * rstd * g0 * (s0 + 1.f) + h0, v1 = x1 * rstd * g1 * (s1 + 1.f) + h1;
                u32x4 hi; hi.x = pk2(v0[0], v0[1]); hi.y = pk2(v0[2], v0[3]); hi.z = pk2(v1[0], v1[1]); hi.w = pk2(v1[2], v1[3]);
                u32x4 lo; lo.x = pk2(v0[0] - bflo(hi.x), v0[1] - bfhi(hi.x)); lo.y = pk2(v0[2] - bflo(hi.y), v0[3] - bfhi(hi.y)); lo.z = pk2(v1[0] - bflo(hi.z), v1[1] - bfhi(hi.z)); lo.w = pk2(v1[2] - bflo(hi.w), v1[3] - bfhi(hi.w));
                *(u32x4*)(H + (size_t)(row0 + 16 * m + fr) * DM + kc) = hi;
                const bf16x8 ah = __builtin_bit_cast(bf16x8, hi), al = __builtin_bit_cast(bf16x8, lo);
#pragma unroll
                for (int n = 0; n < 3; ++n) { acc[m][n] = __builtin_amdgcn_mfma_f32_16x16x32_bf16(ah, bh[n][ks], acc[m][n], 0, 0, 0);
                    acc[m][n] = __builtin_amdgcn_mfma_f32_16x16x32_bf16(al, bh[n][ks], acc[m][n], 0, 0, 0); acc[m][n] = __builtin_amdgcn_mfma_f32_16x16x32_bf16(ah, bl[n][ks], acc[m][n], 0, 0, 0); } }
#pragma unroll
            for (int n = 0; n < 3; ++n)
#pragma unroll
                for (int j = 0; j < 4; ++j) part[(w * 64 + 16 * m + 4 * fq + j) * 48 + 16 * n + fr] = acc[m][n][j];
        }
        __syncthreads();
        for (int i = tz; i < 64 * 36; i += NTHR) { const int tok = i / 36, n = i % 36; float a = 0.f;
#pragma unroll
            for (int ww = 0; ww < 8; ++ww) a += part[(ww * 64 + tok) * 48 + n];
            lsum[i] = a; }
        __syncthreads();
        float g0 = 0.f, g1 = 0.f; int e0 = 0, e1 = 0; unsigned r0 = 0, r1 = 0;
        if (tz < 64) {
            const LAS float* L = lsum + tz * 36;
            int gs = 0; float gm = L[0] + bgp[0];
#pragma unroll
            for (int i = 1; i < 4; ++i) { const float v = L[i] + bgp[i]; if (v > gm) { gm = v; gs = i; } }
            float gden = 0.f;
#pragma unroll
            for (int i = 0; i < 4; ++i) gden += expf(L[i] + bgp[i] - gm);
            const float gprob = 1.f / gden;
            int i1 = 0; float v1 = L[4 + gs * 8] + bep[gs * 8];
#pragma unroll
            for (int j = 1; j < 8; ++j) { const float v = L[4 + gs * 8 + j] + bep[gs * 8 + j]; if (v > v1) { v1 = v; i1 = j; } }
            int i2 = -1; float v2 = -INFINITY;
#pragma unroll
            for (int j = 0; j < 8; ++j) { const float v = L[4 + gs * 8 + j] + bep[gs * 8 + j]; if (j != i1 && v > v2) { v2 = v; i2 = j; } }
            const float p2 = expf(v2 - v1);
            g0 = gprob / (1.f + p2); g1 = gprob * p2 / (1.f + p2); e0 = gs * 8 + i1; e1 = gs * 8 + i2;
            r0 = __hip_atomic_fetch_add(lcnt + e0, 1u, __ATOMIC_RELAXED, __HIP_MEMORY_SCOPE_WORKGROUP); r1 = __hip_atomic_fetch_add(lcnt + e1, 1u, __ATOMIC_RELAXED, __HIP_MEMORY_SCOPE_WORKGROUP);
        }
        __syncthreads();
        if (tz < 32) { const unsigned c = lcnt[tz]; lcnt[32 + tz] = c ? atomicAdd(CNT + tz, c) : 0u; }
        __syncthreads();
        if (tz < 64) { const int row = row0 + tz;
            EID[2 * row] = e0; EID[2 * row + 1] = e1; GATE[2 * row] = g0; GATE[2 * row + 1] = g1; PIE[2 * row] = (int)(lcnt[32 + e0] + r0); PIE[2 * row + 1] = (int)(lcnt[32 + e1] + r1); }
        __syncthreads();
    }
    __syncthreads();
    LAS float* scr = (LAS float*)(F.lds + F.wave * 8448);
    bf16_t* WM1 = (bf16_t*)(A.ws + WS_WM1); bf16_t* WM2 = (bf16_t*)(A.ws + WS_WM2);
    for (int it = F.gw; it < 32 * 768; it += F.ngw) {
        const int e = it / 768; int r = it % 768;
        if (r < 512) { const int which = r >> 8; r &= 255; const int kb = r >> 4, nb = r & 15, n0 = 32 * nb;
            const float* src = (which ? A.in[49] : A.in[48]) + ((size_t)l * 32 + e) * 1024 * 512;
            transpose_item(src, 512, 64 * kb, n0, WM1 + (size_t)e * 1024 * 1024, 1024, 256 * (n0 >> 7) + (n0 & 127) + 128 * which, 64 * kb, scr, F.lane);
        } else { r -= 512; const int kb = r >> 5, nb = r & 31;
            transpose_item(A.in[50] + ((size_t)l * 32 + e) * 512 * 1024, 1024, 64 * kb, 32 * nb, WM2 + (size_t)e * 1024 * 512, 512, 32 * nb, 64 * kb, scr, F.lane); }
    }
}

DI void phase_moe_scatter(const Frame& F, CArgs& A, int l) {
    const unsigned* CNT = (const unsigned*)(A.ws + WS_CTL) + CW_CNT + l * 64;
    unsigned* META = (unsigned*)(A.ws + WS_CTL) + CW_UTAB + l * 1024;
    const int* EID = (const int*)(A.ws + WS_RT_EID); const int* PIE = (const int*)(A.ws + WS_RT_PIE); int* SORT = (int*)(A.ws + WS_RT_SORT);
    LAS unsigned* st = (LAS unsigned*)F.lds;
    if (F.tid == 0) { unsigned s = 0; for (int e = 0; e < 32; ++e) { st[e] = s; s += CNT[e]; } }
    __syncthreads();
    if (F.bid == 0 && F.tid == 0) { unsigned nu = 0;
        for (int e = 0; e < 32; ++e) { const unsigned c = CNT[e]; META[1 + e] = st[e]; META[33 + e] = c; for (unsigned bk = 0; bk * 256 < c; ++bk) META[65 + nu++] = ((unsigned)e << 16) | bk; }
        META[0] = nu; }
    for (int a = F.bid * NTHR + F.tid; a < 2 * T; a += F.G * NTHR) SORT[st[EID[a]] + PIE[a]] = a;
}

struct MoeProb1 {
    const char* Hh; const char* WM1; const unsigned* META; const int* SORT; int lda, ldb, nt, G, c;
    DI bool next(int i, pg8::Unit& u) const { const int idx = i * G + c; const int nu = (int)META[0]; if (idx >= nu * 4) return false;
        const unsigned ent = META[65 + (idx >> 2)]; u.pm = idx >> 2; u.pn = idx & 3; u.e = (int)(ent >> 16); u.blk = (int)(ent & 0xffffu); return true; }
    DI const char* a_base(const pg8::Unit&) const { return Hh; }
    DI const char* b_base(const pg8::Unit& u) const { return WM1 + ((size_t)u.e * 1024 + (size_t)u.pn * 256) * 1024 * 2; }
    DI unsigned a_off(const pg8::Unit& u, int row) const { const unsigned r = (unsigned)(u.blk * 256 + row), cnt = META[33 + u.e];
        const int a = r < cnt ? SORT[META[1 + u.e] + r] : 0; return (unsigned)(a >> 1) * 2048u; }
};
struct EpiMoe1 {
    static constexpr bool PERM = true;
    bf16_t* HID; const unsigned* META;
    DI void operator()(const f32x4 (&acc)[2][2][4][2], const pg8::Unit& u, int wr, int wc, int fr, int fq) const {
        const unsigned cnt = META[33 + u.e], st = META[1 + u.e];
        const int col0 = 128 * u.pn + wc * 32 + 8 * fq;
#pragma unroll
        for (int ai = 0; ai < 2; ++ai)
#pragma unroll
            for (int m = 0; m < 4; ++m) { const unsigned r = (unsigned)(u.blk * 256 + ai * 128 + wr * 64 + m * 16 + fr);
                if (r < cnt) { const f32x4 a0 = acc[ai][0][m][0], a1 = acc[ai][0][m][1], b0 = acc[ai][1][m][0], b1 = acc[ai][1][m][1];
                    u32x4 w; w.x = pk2(siluf_(a0[0]) * b0[0], siluf_(a0[1]) * b0[1]); w.y = pk2(siluf_(a0[2]) * b0[2], siluf_(a0[3]) * b0[3]);
                    w.z = pk2(siluf_(a1[0]) * b1[0], siluf_(a1[1]) * b1[1]); w.w = pk2(siluf_(a1[2]) * b1[2], siluf_(a1[3]) * b1[3]);
                    *(u32x4*)(HID + (size_t)(st + r) * 512 + col0) = w; } }
    }
};
struct MoeProb2 {
    const char* HID; const char* WM2; const unsigned* META; int lda, ldb, nt, G, c;
    DI bool next(int i, pg8::Unit& u) const { const int idx = i * G + c; const int nu = (int)META[0]; if (idx >= nu * 4) return false;
        const unsigned ent = META[65 + (idx >> 2)]; u.pm = idx >> 2; u.pn = idx & 3; u.e = (int)(ent >> 16); u.blk = (int)(ent & 0xffffu); return true; }
    DI const char* a_base(const pg8::Unit& u) const { return HID + ((size_t)META[1 + u.e] + (size_t)u.blk * 256) * 512 * 2; }
    DI const char* b_base(const pg8::Unit& u) const { return WM2 + ((size_t)u.e * 1024 + (size_t)u.pn * 256) * 512 * 2; }
    DI unsigned a_off(const pg8::Unit&, int row) const { return (unsigned)row * 1024u; }
};
struct EpiMoe2 {
    static constexpr bool PERM = true;
    bf16_t* Y; const unsigned* META; const int* SORT; const float* GATE; const float* gt;
    DI void operator()(const f32x4 (&acc)[2][2][4][2], const pg8::Unit& u, int wr, int wc, int fr, int fq) const {
        const unsigned cnt = META[33 + u.e], st = META[1 + u.e];
        const int col0 = 256 * u.pn + wc * 32 + 8 * fq;
#pragma unroll
        for (int ai = 0; ai < 2; ++ai)
#pragma unroll
            for (int m = 0; m < 4; ++m) { const unsigned r = (unsigned)(u.blk * 256 + ai * 128 + wr * 64 + m * 16 + fr);
                if (r < cnt) { const int a = SORT[st + r]; const float gw = GATE[a]; const int b = (a >> 1) / SEQ;
#pragma unroll
                    for (int bj = 0; bj < 2; ++bj) { const f32x4 g0 = *(const f32x4*)(gt + (size_t)b * 6144 + col0 + bj * 128), g1 = *(const f32x4*)(gt + (size_t)b * 6144 + col0 + bj * 128 + 4);
                        const f32x4 v0 = acc[ai][bj][m][0] * g0 * gw, v1 = acc[ai][bj][m][1] * g1 * gw;
                        u32x4 w; w.x = pk2(v0[0], v0[1]); w.y = pk2(v0[2], v0[3]); w.z = pk2(v1[0], v1[1]); w.w = pk2(v1[2], v1[3]);
                        *(u32x4*)(Y + (size_t)a * DM + col0 + bj * 128) = w; } } }
    }
};

DI void phase_final(const Frame& F, CArgs& A) {
    const bf16_t* Y = (const bf16_t*)(A.ws + WS_Y);
    for (size_t i = (size_t)F.bid * NTHR + F.tid; i < (size_t)T * DM / 4; i += (size_t)F.G * NTHR) {
        const size_t row = i >> 8, col = (i & 255) * 4;
        f32x4 v = *(const f32x4*)(A.out + row * DM + col);
        const u32x2 y0 = *(const u32x2*)(Y + (2 * row) * DM + col), y1 = *(const u32x2*)(Y + (2 * row + 1) * DM + col);
        v[0] += bflo(y0.x) + bflo(y1.x); v[1] += bfhi(y0.x) + bfhi(y1.x); v[2] += bflo(y0.y) + bflo(y1.y); v[3] += bfhi(y0.y) + bfhi(y1.y);
        *(f32x4*)(A.out + row * DM + col) = v;
    }
}

#ifndef REPMASK
#define REPMASK 0u
#endif
constexpr int NPL = 22, NPH = 1 + 2 * NPL + 1;
__global__ void __launch_bounds__(NTHR, 2) mk_fwd(Args args) {
    extern __shared__ __attribute__((aligned(16))) unsigned char lds_raw[];
    LAS unsigned char* const ldsb = (LAS unsigned char*)lds_raw;
    const int wave0 = __builtin_amdgcn_readfirstlane(threadIdx.x >> 6);
    volatile LAS unsigned* MISC = (volatile LAS unsigned*)(ldsb + MISC_OFF);
    if (threadIdx.x < 64) MISC[threadIdx.x] = 0u;
    __syncthreads();
    XcdBarrier bar; bar.bar = (unsigned*)(args.ws + WS_CTL) + CW_BAR; bar.x = 0; bar.st = nullptr;
    if (args.use_bar) bar = xcd_barrier_post((unsigned*)(args.ws + WS_CTL) + CW_BAR, MISC + 8);
    const int lo = args.ph_lo, hi = args.ph_hi;
#define IN(k) (lo <= (k) && (k) < hi)
#define SEAM(k) do { if (IN(k) && IN((k) + 1)) xcd_barrier(bar); } while (0)
    unsigned char* ws = args.ws;
    if (IN(0)) { const Frame F = make_frame(ldsb, wave0); CArgs& AA = *get_args(); phase_prologue(F, AA); } SEAM(0);
    for (int l = 0; l < DEPTH; ++l) {
        const int pb = 1 + l * NPL;
        const float* MODL = (const float*)(ws + WS_MOD) + (size_t)l * 8 * 6144;
        if (IN(pb + 0)) { const Frame F = make_frame(ldsb, wave0); CArgs& AA = *get_args(); phase_norm1(F, AA, l); } SEAM(pb + 0);
        if (IN(pb + 1)) { const Frame F = make_frame(ldsb, wave0); CArgs& AA = *get_args(); pg8::PlainProb P{(const char*)(ws + WS_H), (const char*)(ws + WS_WIN) + (size_t)l * ZS * 1024 * 2, 1024, 1024, 16, 256, 9, F.G, F.bid};
            EpiBf16Plain E{(bf16_t*)(ws + WS_Z), ZS}; pg8::gemm_phase(F.lds, P, E, F.tid); } SEAM(pb + 1);
        if (IN(pb + 2)) { const Frame F = make_frame(ldsb, wave0); CArgs& AA = *get_args(); phase_mla_prep(F, AA, l); } SEAM(pb + 2);
        if (IN(pb + 3)) { const Frame F = make_frame(ldsb, wave0); CArgs& AA = *get_args(); pg8::PlainProb P{(const char*)(ws + WS_AMLA), (const char*)(ws + WS_WMLA) + (size_t)l * 1024 * 512 * 2, 512, 512, 8, 256, 4, F.G, F.bid};
            EpiBf16Plain E{(bf16_t*)(ws + WS_QKVRAW), 1024}; pg8::gemm_phase(F.lds, P, E, F.tid); } SEAM(pb + 3);
        if (IN(pb + 4)) { const Frame F = make_frame(ldsb, wave0); CArgs& AA = *get_args(); phase_mla_post(F, AA, l); } SEAM(pb + 4);
        if (IN(pb + 5)) { const Frame F = make_frame(ldsb, wave0); CArgs& AA = *get_args(); phase_attn(F, AA); } SEAM(pb + 5);
        if (IN(pb + 6)) { const Frame F = make_frame(ldsb, wave0); CArgs& AA = *get_args(); phase_rwkv_prep(F, AA, l); } SEAM(pb + 6);
        if (IN(pb + 7)) { const Frame F = make_frame(ldsb, wave0); CArgs& AA = *get_args(); phase_rwkv_A(F, AA, l); } SEAM(pb + 7);
        if (IN(pb + 8)) { const Frame F = make_frame(ldsb, wave0); CArgs& AA = *get_args(); phase_rwkv_B(F, AA); } SEAM(pb + 8);
        if (IN(pb + 9)) { const Frame F = make_frame(ldsb, wave0); CArgs& AA = *get_args(); phase_rwkv_C(F, AA, l); } SEAM(pb + 9);
        if (IN(pb + 10)) { const Frame F = make_frame(ldsb, wave0); CArgs& AA = *get_args(); phase_s5<1>(F, AA, l); } SEAM(pb + 10);
        if (IN(pb + 11)) { const Frame F = make_frame(ldsb, wave0); CArgs& AA = *get_args(); phase_s5<2>(F, AA, l); } SEAM(pb + 11);
        if (IN(pb + 12)) { const Frame F = make_frame(ldsb, wave0); CArgs& AA = *get_args(); pg8::PlainProb P{(const char*)(ws + WS_YS5), (const char*)(ws + WS_WGLU) + (size_t)l * 256 * 256 * 2, 256, 256, 4, 256, 1, F.G, F.bid};
            EpiGlu E{(const bf16_t*)(ws + WS_YS5), (bf16_t*)(ws + WS_YS5G), AA.in[27] + l * 256}; pg8::gemm_phase(F.lds, P, E, F.tid); } SEAM(pb + 12);
        if (IN(pb + 13)) { const Frame F = make_frame(ldsb, wave0); CArgs& AA = *get_args(); phase_lru_prep(F, AA, l); } SEAM(pb + 13);
        if (IN(pb + 14)) { const Frame F = make_frame(ldsb, wave0); CArgs& AA = *get_args(); phase_lru_sum(F, AA); } SEAM(pb + 14);
        if (IN(pb + 15)) { const Frame F = make_frame(ldsb, wave0); CArgs& AA = *get_args(); phase_lru_fin(F, AA); } SEAM(pb + 15);
        if (IN(pb + 16)) { const Frame F = make_frame(ldsb, wave0); CArgs& AA = *get_args(); phase_branch_norm(F, AA, l); } SEAM(pb + 16);
        if (IN(pb + 17)) { const Frame F = make_frame(ldsb, wave0); CArgs& AA = *get_args(); pg8::PlainProb P{(const char*)(ws + WS_MIX), (const char*)(ws + WS_WOUT) + (size_t)l * 1024 * 1024 * 2, 1024, 1024, 16, 256, 4, F.G, F.bid};
            EpiResGate E{l == 0 ? AA.in[0] : AA.out, AA.out, MODL + 2048}; pg8::gemm_phase(F.lds, P, E, F.tid); } SEAM(pb + 17);
        if (IN(pb + 18)) { const Frame F = make_frame(ldsb, wave0); CArgs& AA = *get_args(); phase_norm2_router(F, AA, l); } SEAM(pb + 18);
        if (IN(pb + 19)) { const Frame F = make_frame(ldsb, wave0); CArgs& AA = *get_args(); phase_moe_scatter(F, AA, l); } SEAM(pb + 19);
        const unsigned* META = (const unsigned*)(ws + WS_CTL) + CW_UTAB + l * 1024;
        if (IN(pb + 20)) { const Frame F = make_frame(ldsb, wave0); CArgs& AA = *get_args(); MoeProb1 P{(const char*)(ws + WS_H), (const char*)(ws + WS_WM1), META, (const int*)(ws + WS_RT_SORT), 1024, 1024, 16, F.G, F.bid};
            EpiMoe1 E{(bf16_t*)(ws + WS_HID), META}; pg8::gemm_phase(F.lds, P, E, F.tid); } SEAM(pb + 20);
        if (IN(pb + 21)) { const Frame F = make_frame(ldsb, wave0); CArgs& AA = *get_args(); MoeProb2 P{(const char*)(ws + WS_HID), (const char*)(ws + WS_WM2), META, 512, 512, 8, F.G, F.bid};
            EpiMoe2 E{(bf16_t*)(ws + WS_Y), META, (const int*)(ws + WS_RT_SORT), (const float*)(ws + WS_RT_GATE), MODL + 5120}; pg8::gemm_phase(F.lds, P, E, F.tid); } SEAM(pb + 21);
    }
    if (IN(NPH - 1)) { const Frame F = make_frame(ldsb, wave0); CArgs& AA = *get_args(); phase_final(F, AA); }
#undef IN
#undef SEAM
}

extern "C" void kernel_launch(void* const* d_in, const int* in_sizes, int n_in, void* d_out, int out_size, void* d_ws, size_t ws_size, hipStream_t stream) {
    static int grid = 0;
    if (grid == 0) {
        if (n_in != 51 || ws_size < WS_END) { fprintf(stderr, "kernel_launch: unexpected inputs (n_in %d, ws %zu)\n", n_in, ws_size); grid = -1; return; }
        int dev = 0, cus = 0;
        if (hipGetDevice(&dev) != hipSuccess || hipDeviceGetAttribute(&cus, hipDeviceAttributeMultiprocessorCount, dev) != hipSuccess) { grid = -1; return; }
        if (hipFuncSetAttribute((const void*)mk_fwd, hipFuncAttributeMaxDynamicSharedMemorySize, LDS_BYTES) != hipSuccess) { fprintf(stderr, "kernel_launch: hipFuncSetAttribute failed\n"); grid = -1; return; }
        grid = cus;
    }
    if (grid < 0) return;
    (void)hipMemsetAsync((char*)d_ws + WS_CTL, 0, CTL_ZERO_BYTES, stream);
    Args a{};
    for (int i = 0; i < 51; ++i) a.in[i] = (const float*)d_in[i];
    a.pos_off = (const int*)d_in[2]; a.out = (float*)d_out; a.ws = (unsigned char*)d_ws; a.pad = 0;
#if defined(MK_PER_PHASE)
    a.use_bar = 0;
    for (int p = 0; p < NPH; ++p) { a.ph_lo = p; a.ph_hi = p + 1;
        const int k = (p == 0 || p == NPH - 1) ? 31 : (p - 1) % NPL; const int reps = 1 + (int)((REPMASK >> k) & 1u);
        for (int r = 0; r < reps; ++r) hipLaunchKernelGGL(mk_fwd, dim3(grid), dim3(NTHR), LDS_BYTES, stream, a); }
#else
    a.use_bar = 1; a.ph_lo = 0; a.ph_hi = NPH;
    hipLaunchKernelGGL(mk_fwd, dim3(grid), dim3(NTHR), LDS_BYTES, stream, a);
#endif
}
```

```cpp
#include <hip/hip_runtime.h>
#include <cstdio>
#include <cstdint>

#define LAS __attribute__((address_space(3)))
#define GAS __attribute__((address_space(1)))
#define DI __device__ __forceinline__
typedef unsigned short bf16_t;
typedef short bf16x8 __attribute__((ext_vector_type(8)));
typedef short s16x4 __attribute__((ext_vector_type(4)));
typedef float f32x4 __attribute__((ext_vector_type(4)));
typedef float f32x2 __attribute__((ext_vector_type(2)));
typedef float f32x16 __attribute__((ext_vector_type(16)));
typedef unsigned u32x4 __attribute__((ext_vector_type(4)));
typedef unsigned u32x2 __attribute__((ext_vector_type(2)));
typedef __bf16 bf16x2_t __attribute__((ext_vector_type(2)));

constexpr int NB = 8, SEQ = 8192, DM = 1024, T = NB * SEQ, DEPTH = 2;
constexpr int WG = 256;
constexpr int ZS = 2304;
constexpr int ZC_R = 0, ZC_K = 256, ZC_V = 512, ZC_WLO = 768, ZC_ALO = 800, ZC_GLO = 832, ZC_S5 = 896, ZC_QA = 1152, ZC_KVA = 1408, ZC_KPE = 1536, ZC_LX = 1568, ZC_LG = 1824, D_IN = 2080;
constexpr int NEXP = 32, DFF = 512;
constexpr float NORM_EPS = 1e-6f;

DI unsigned f2bf(float f) { unsigned u = __float_as_uint(f); return (u + 0x7fffu + ((u >> 16) & 1u)) >> 16; }
DI unsigned pk2(float lo, float hi) { f32x2 v = {lo, hi}; bf16x2_t b = __builtin_convertvector(v, bf16x2_t); return __builtin_bit_cast(unsigned, b); }
DI float bflo(unsigned u) { return __uint_as_float(u << 16); }
DI float bfhi(unsigned u) { return __uint_as_float(u & 0xffff0000u); }
DI float bf2f(bf16_t b) { return __uint_as_float(((unsigned)b) << 16); }
DI int lane_opaque() { int l; asm volatile("v_mbcnt_lo_u32_b32 %0, -1, 0\n\tv_mbcnt_hi_u32_b32 %0, -1, %0" : "=v"(l)); return l; }
DI float shfl_xor_l(float v, int o, int lane) { return __int_as_float(__builtin_amdgcn_ds_bpermute((lane ^ o) << 2, __float_as_int(v))); }
DI float wave_sum(float v) {
    const int l = lane_opaque();
#pragma unroll
    for (int o = 1; o < 64; o <<= 1) v += shfl_xor_l(v, o, l);
    return v;
}
DI float sigmoidf_(float x) { return 1.f / (1.f + __expf(-x)); }
DI float softplusf_(float x) { return fmaxf(x, 0.f) + log1pf(__expf(-fabsf(x))); }
DI float gelu_tanh(float x) { const float u = 0.7978845608028654f * (x + 0.044715f * x * x * x); return 0.5f * x * (1.f + tanhf(u)); }
DI float siluf_(float x) { return x / (1.f + __expf(-x)); }

namespace pg8 {
constexpr int BM = 256, BK = 64, HALF = 128, HTB = HALF * BK * 2, STAGE_BYTES = 8 * HTB;
DI int lds_byte(int r, int c) { const int st = (r >> 4) * 2 + (c >> 5), rr = r & 15, cc = c & 31, ob = rr * 64 + cc * 2; return st * 1024 + (ob ^ (((ob >> 9) & 1) << 5)); }
DI void stage_rc(int b, int& R, int& C) { const int st = b / 1024, sb = b % 1024, swz = sb ^ (((sb >> 9) & 1) << 5); R = (st >> 1) * 16 + swz / 64; C = (st & 1) * 32 + (swz % 64) / 2; }
DI int perm32(int rho) { const int n = rho >> 4, i = rho & 15; return 8 * (i >> 2) + 4 * n + (i & 3); }

struct Unit { int pm, pn, e, blk; };

template <class Epi, class P>
DI void gemm_phase(LAS unsigned char* lds, const P& S, const Epi& E, int tid_in) {
    const int tid = tid_in, wid = __builtin_amdgcn_readfirstlane(tid >> 6), lane = tid & 63, wr = wid >> 2, wc = wid & 3, fr = lane & 15, fq = lane >> 4;
    const int nt = S.nt;
    int Rr[2], Cc[2];
    unsigned voffB[2], offC[2][2], offN[2][2];
#pragma unroll
    for (int i = 0; i < 2; ++i) { int R, C; stage_rc(tid * 16 + i * 8192, R, C); Rr[i] = R; Cc[i] = C; const int Rb = Epi::PERM ? ((R & ~31) + perm32(R & 31)) : R;
        voffB[i] = (unsigned)(Rb * S.ldb + C) * 2u; }
    const size_t kstep = (size_t)(BK * 2);
    const size_t hstepB = (size_t)HALF * S.ldb * 2;
    const unsigned ldsw = (unsigned)wid * 1024u;
    const int aoff = lds_byte(wr * 64 + fr, fq * 8), boff = lds_byte(wc * 32 + fr, fq * 8);
#define PG8_SA(b, h) (((b) * 2 + (h)) * HTB)
#define PG8_SB(b, h) ((4 + (b) * 2 + (h)) * HTB)
#define PG8_STAGE(bufoff, gbase, voff) do { _Pragma("unroll") for (int _i = 0; _i < 2; ++_i) \
        __builtin_amdgcn_global_load_lds((const unsigned*)((const char*)(gbase) + (voff)[_i]), (LAS unsigned*)(lds + (bufoff) + ldsw + _i * 8192), 16, 0, 0); } while (0)
#define PG8_LDA(dst, b, h) do { _Pragma("unroll") for (int m = 0; m < 4; ++m) _Pragma("unroll") for (int k = 0; k < 2; ++k) dst[m][k] = *(const LAS bf16x8*)(lds + PG8_SA(b, h) + aoff + m * 2048 + k * 1024); } while (0)
#define PG8_LDB(dst, b, h) do { _Pragma("unroll") for (int n = 0; n < 2; ++n) _Pragma("unroll") for (int k = 0; k < 2; ++k) dst[n][k] = *(const LAS bf16x8*)(lds + PG8_SB(b, h) + boff + n * 2048 + k * 1024); } while (0)
#define PG8_MMA(ai, bj, At, Bt) do { __builtin_amdgcn_s_setprio(1); _Pragma("unroll") for (int m = 0; m < 4; ++m) _Pragma("unroll") for (int n = 0; n < 2; ++n) _Pragma("unroll") for (int k = 0; k < 2; ++k) \
        acc[ai][bj][m][n] = __builtin_amdgcn_mfma_f32_16x16x32_bf16(Bt[n][k], At[m][k], acc[ai][bj][m][n], 0, 0, 0); __builtin_amdgcn_s_setprio(0); } while (0)
#define PG8_WAIT_V(n) asm volatile("s_waitcnt vmcnt(" #n ")" ::: "memory")
#define PG8_WAIT_L(n) asm volatile("s_waitcnt lgkmcnt(" #n ")" ::: "memory")
#define PG8_BAR __builtin_amdgcn_s_barrier()
#define PG8_SCHED __builtin_amdgcn_sched_barrier(0)
    Unit cur, nxt; int ui = 0;
    if (!S.next(0, cur)) return;
    f32x4 acc[2][2][4][2];
#pragma unroll
    for (int a = 0; a < 2; ++a)
#pragma unroll
        for (int b = 0; b < 2; ++b)
#pragma unroll
            for (int m = 0; m < 4; ++m)
#pragma unroll
                for (int n = 0; n < 2; ++n) acc[a][b][m][n] = (f32x4){0.f, 0.f, 0.f, 0.f};
    bf16x8 At[4][2], B0[2][2], B1[2][2];
    const char* cA = S.a_base(cur); const char* cB = S.b_base(cur);
#pragma unroll
    for (int h = 0; h < 2; ++h)
#pragma unroll
        for (int i = 0; i < 2; ++i) { offC[h][i] = S.a_off(cur, h * HALF + Rr[i]) + (unsigned)Cc[i] * 2u; offN[h][i] = offC[h][i]; }
    PG8_STAGE(PG8_SB(0, 0), cB, voffB); PG8_STAGE(PG8_SB(0, 1), cB + hstepB, voffB); PG8_STAGE(PG8_SA(0, 0), cA, offC[0]); PG8_STAGE(PG8_SA(0, 1), cA, offC[1]);
    if (wr == 1) PG8_BAR;
    PG8_WAIT_V(2); PG8_BAR;
    PG8_STAGE(PG8_SB(1, 0), cB + kstep, voffB); PG8_STAGE(PG8_SA(1, 0), cA + kstep, offC[0]); PG8_STAGE(PG8_SB(1, 1), cB + hstepB + kstep, voffB);
    PG8_WAIT_V(6); PG8_BAR;
    for (;;) {
        const bool has_next = S.next(ui + 1, nxt);
        const char* nA = has_next ? S.a_base(nxt) : cA; const char* nB = has_next ? S.b_base(nxt) : cB;
        for (int t = 0; t < nt; t += 2) {
            const bool last = (t == nt - 2);
            const char* a1 = cA + (size_t)(t + 1) * kstep;
            const char* a2 = last ? nA : cA + (size_t)(t + 2) * kstep; const char* b2 = last ? nB : cB + (size_t)(t + 2) * kstep;
            const char* a3 = a2 + kstep; const char* b3 = b2 + kstep;
            if (last && has_next) {
#pragma unroll
                for (int h = 0; h < 2; ++h)
#pragma unroll
                    for (int i = 0; i < 2; ++i) offN[h][i] = S.a_off(nxt, h * HALF + Rr[i]) + (unsigned)Cc[i] * 2u;
            }
            unsigned o2[2][2];
#pragma unroll
            for (int h = 0; h < 2; ++h)
#pragma unroll
                for (int i = 0; i < 2; ++i) o2[h][i] = last ? offN[h][i] : offC[h][i];
            PG8_LDB(B0, 0, 0); PG8_LDB(B1, 0, 1); PG8_SCHED; PG8_LDA(At, 0, 0); PG8_STAGE(PG8_SA(1, 1), a1, offC[1]);
            PG8_WAIT_V(8); PG8_WAIT_L(0); PG8_BAR; PG8_MMA(0, 0, At, B0); PG8_MMA(0, 1, At, B1); PG8_BAR; PG8_SCHED;
            PG8_LDA(At, 0, 1); PG8_STAGE(PG8_SB(0, 0), b2, voffB); PG8_STAGE(PG8_SB(0, 1), b2 + hstepB, voffB); PG8_STAGE(PG8_SA(0, 0), a2, o2[0]);
            PG8_WAIT_V(8); PG8_WAIT_L(0); PG8_BAR; PG8_MMA(1, 0, At, B0); PG8_MMA(1, 1, At, B1); PG8_BAR; PG8_SCHED;
            PG8_LDB(B0, 1, 0); PG8_LDB(B1, 1, 1); PG8_SCHED; PG8_LDA(At, 1, 0); PG8_STAGE(PG8_SA(0, 1), a2, o2[1]);
            PG8_WAIT_V(8); PG8_WAIT_L(0); PG8_BAR; PG8_MMA(0, 0, At, B0); PG8_MMA(0, 1, At, B1); PG8_BAR; PG8_SCHED;
            PG8_LDA(At, 1, 1); PG8_STAGE(PG8_SB(1, 0), b3, voffB); PG8_STAGE(PG8_SB(1, 1), b3 + hstepB, voffB); PG8_STAGE(PG8_SA(1, 0), a3, o2[0]);
            PG8_WAIT_V(8); PG8_WAIT_L(0); PG8_BAR; PG8_MMA(1, 0, At, B0); PG8_MMA(1, 1, At, B1); PG8_BAR; PG8_SCHED;
        }
        if (wr == 0) PG8_BAR;
        E(acc, cur, wr, wc, fr, fq);
        if (!has_next) break;
#pragma unroll
        for (int a = 0; a < 2; ++a)
#pragma unroll
            for (int b = 0; b < 2; ++b)
#pragma unroll
                for (int m = 0; m < 4; ++m)
#pragma unroll
                    for (int n = 0; n < 2; ++n) acc[a][b][m][n] = (f32x4){0.f, 0.f, 0.f, 0.f};
        cur = nxt; cA = nA; cB = nB; ++ui;
#pragma unroll
        for (int h = 0; h < 2; ++h)
#pragma unroll
            for (int i = 0; i < 2; ++i) offC[h][i] = offN[h][i];
        if (wr == 1) PG8_BAR;
    }
    PG8_WAIT_V(0);
    PG8_BAR;
#undef PG8_SA
#undef PG8_SB
#undef PG8_STAGE
#undef PG8_LDA
#undef PG8_LDB
#undef PG8_MMA
#undef PG8_WAIT_V
#undef PG8_WAIT_L
#undef PG8_BAR
#undef PG8_SCHED
}

struct PlainProb {
    const char* A; const char* Bt; int lda, ldb, nt, nM, nN, G, c;
    DI bool next(int i, Unit& u) const {
        const long L = (long)i * G + c; const int nwg = nM * nN; if (L >= nwg) return false;
        int wgid = (int)L; { const int q = nwg / 8, r = nwg % 8, xcd = wgid % 8, off = wgid / 8; wgid = (xcd < r ? xcd * (q + 1) : r * (q + 1) + (xcd - r) * q) + off; }
        const int nig = 8 * nN, gid = wgid / nig, fm = gid * 8, gsz = (nM - fm) < 8 ? (nM - fm) : 8;
        u.pm = fm + ((wgid % nig) % gsz); u.pn = (wgid % nig) / gsz; u.e = 0; u.blk = 0; return true;
    }
    DI const char* a_base(const Unit& u) const { return A + (size_t)u.pm * 256 * lda * 2; }
    DI const char* b_base(const Unit& u) const { return Bt + (size_t)u.pn * 256 * ldb * 2; }
    DI unsigned a_off(const Unit&, int row) const { return (unsigned)row * (unsigned)lda * 2u; }
};
}

constexpr size_t MiB = 1u << 20;
constexpr size_t WS_CTL = 0, CTL_ZERO_BYTES = 1 * MiB;
constexpr size_t WS_MOD = 1 * MiB;
constexpr size_t WS_RT_EID = 3 * MiB;
constexpr size_t WS_RT_GATE = WS_RT_EID + 512 * 1024;
constexpr size_t WS_RT_PIE = WS_RT_GATE + 512 * 1024;
constexpr size_t WS_RT_SORT = WS_RT_PIE + 512 * 1024;
constexpr size_t WS_WIN = 8 * MiB;
constexpr size_t WS_WOUT = 17 * MiB;
constexpr size_t WS_WMLA = 21 * MiB;
constexpr size_t WS_WGLU = 23 * MiB;
constexpr size_t WS_WR = 23 * MiB + 256 * 1024;
constexpr size_t WS_WLRU = 23 * MiB + 640 * 1024;
constexpr size_t WS_WLORA = 23 * MiB + 768 * 1024;
static_assert(WS_WGLU + 256 * 1024 <= WS_WR && WS_WR + 384 * 1024 <= WS_WLRU && WS_WLRU + 128 * 1024 <= WS_WLORA && WS_WLORA + 128 * 1024 <= 24 * MiB, "small weight map");
constexpr size_t WS_H = 24 * MiB;
constexpr size_t WS_Z = 152 * MiB;
constexpr size_t WS_WM1 = WS_Z;
constexpr size_t WS_WM2 = WS_Z + 64 * MiB;
constexpr size_t WS_MIX = 440 * MiB;
constexpr size_t WS_HID = WS_MIX;
constexpr size_t WS_Y = 569 * MiB;
constexpr size_t WS_Q = 825 * MiB;
constexpr size_t WS_K = 873 * MiB;
constexpr size_t WS_VT = 921 * MiB;
constexpr size_t WS_TAIL = 953 * MiB;
constexpr size_t WS_END = 1017 * MiB;
constexpr size_t WS_AMLA = WS_TAIL;
constexpr size_t WS_QKVRAW = WS_Y;
constexpr size_t WS_ATTO = WS_H;
constexpr size_t WS_RW_R = WS_Y, WS_RW_K = WS_Y + 32 * MiB, WS_RW_V = WS_Y + 64 * MiB, WS_RW_KK = WS_Y + 96 * MiB, WS_RW_B = WS_Y + 128 * MiB, WS_RW_G = WS_Y + 160 * MiB;
constexpr size_t WS_RW_W = WS_Y + 192 * MiB;
constexpr size_t WS_RC_RP = WS_H + 32 * MiB;
constexpr size_t WS_RC_MP = WS_H + 64 * MiB;
constexpr size_t WS_RC_HB = WS_H + 96 * MiB;
constexpr size_t WS_RC_Y0 = WS_Q;
constexpr size_t WS_RC_G = WS_Q + 64 * MiB;
constexpr int RC_REC = 24832;
constexpr size_t WS_RC_BS = WS_Q + 64 * MiB + 98 * MiB;
static_assert((size_t)4096 * RC_REC <= 98 * MiB && WS_RC_BS + 1 * MiB <= WS_END, "rwkv record map");
constexpr size_t WS_YS5 = WS_H + 96 * MiB;
constexpr size_t WS_YS5G = WS_TAIL;
constexpr size_t WS_YL = WS_TAIL + 32 * MiB;
constexpr size_t WS_LA = WS_Y, WS_LB = WS_Y + 64 * MiB;
constexpr size_t WS_S5END = 2 * MiB;
constexpr size_t WS_S5BB = 5 * MiB;
constexpr size_t WS_S5CC = 5 * MiB + 128 * 1024;
constexpr size_t WS_LSUM = 5 * MiB + 512 * 1024;
static_assert(WS_RT_SORT + 512 * 1024 <= WS_LSUM && WS_LSUM + 2 * MiB <= WS_WIN && WS_S5END + 1 * MiB <= WS_RT_EID, "map");

constexpr int CW_BAR = 4096;
constexpr int CW_CNT = 16384;
constexpr int CW_UTAB = 20480;

constexpr int NWAVES = 8, NTHR = 512;
constexpr int LDS_BYTES = 155648;
constexpr int MISC_OFF = 155648 - 256;

struct Args { const float* in[51]; const int* pos_off; float* out; unsigned char* ws; int ph_lo, ph_hi, use_bar, pad; };
typedef const __attribute__((address_space(4))) Args CArgs;
DI CArgs* get_args() { CArgs* ap = (CArgs*)__builtin_amdgcn_kernarg_segment_ptr(); asm volatile("" : "+s"(ap)); return ap; }

#define XB_TMO      128
#define XB_XCNT(j)  (256  + 64 * (j))
#define XB_XSUB(j)  (1280 + 64 * (j))
#define XB_XGEN(j)  (2304 + 64 * (j))
#define XB_TOP      3328
#define XB_TOPGEN   3392
#define XCD_BAR_WORDS 3456
#define XB_SPIN_CAP (1u << 18)
DI unsigned xb_ld(unsigned* p)              { return __hip_atomic_load(p, __ATOMIC_RELAXED, __HIP_MEMORY_SCOPE_AGENT); }
DI unsigned xb_add(unsigned* p, unsigned v) { return __hip_atomic_fetch_add(p, v, __ATOMIC_RELAXED, __HIP_MEMORY_SCOPE_AGENT); }
DI unsigned xb_xcc_id() { return (unsigned)__builtin_amdgcn_s_getreg((3 << 11) | 20) & 0xFu; }
#define XB_SPIN(cond, bar) do { unsigned _sp = 0; while (cond) { __builtin_amdgcn_s_sleep(1); \
    if ((++_sp & 255u) == 0u) { if (xb_ld(&(bar)[XB_TMO])) break; if (_sp > XB_SPIN_CAP) { atomicAdd(&(bar)[XB_TMO], 1u); break; } } } } while (0)
struct XcdBarrier { unsigned* bar; unsigned x; volatile LAS unsigned* st; };
DI XcdBarrier xcd_barrier_post(unsigned* bar, volatile LAS unsigned* st) {
    XcdBarrier b; b.bar = bar; b.x = xb_xcc_id(); b.st = st;
    if (threadIdx.x == 0) (void)xb_add(&bar[XB_XCNT(b.x)], 1u);
    return b;
}
DI void xcd_barrier_complete(unsigned* bar, unsigned x, unsigned& nloc, unsigned& nx) {
    const unsigned G = gridDim.x * gridDim.y * gridDim.z;
    unsigned sum, cnt, mine, sp = 0u;
    for (;;) {
        sum = 0u; cnt = 0u; mine = 0u;
#pragma unroll
        for (unsigned j = 0; j < 16; ++j) { const unsigned c = xb_ld(&bar[XB_XCNT(j)]); sum += c; cnt += (c > 0u) ? 1u : 0u; mine = (j == x) ? c : mine; }
        if (sum == G) break;
        __builtin_amdgcn_s_sleep(1);
        if ((++sp & 255u) == 0u) { if (xb_ld(&bar[XB_TMO])) break; if (sp > XB_SPIN_CAP) { atomicAdd(&bar[XB_TMO], 1u); break; } }
    }
    nloc = mine > 0u ? mine : 1u; nx = cnt > 0u ? cnt : 1u;
}
DI void xcd_barrier(const XcdBarrier& b) {
    asm volatile("s_waitcnt vmcnt(0)" ::: "memory");
    __syncthreads();
    if (threadIdx.x == 0) {
        unsigned* bar = b.bar;
        __builtin_amdgcn_s_waitcnt(0);
        unsigned nloc = b.st[0], nx = b.st[1];
        if (nloc == 0u) { xcd_barrier_complete(bar, b.x, nloc, nx); b.st[0] = nloc; b.st[1] = nx; }
        const unsigned old = xb_add(&bar[XB_XSUB(b.x)], 1u);
        const unsigned gen = old / nloc;
        if (old + 1u == (gen + 1u) * nloc) {
            __builtin_amdgcn_fence(__ATOMIC_RELEASE, "agent");
            asm volatile("s_waitcnt vmcnt(0)" ::: "memory");
            const unsigned og = xb_add(&bar[XB_TOP], 1u);
            const unsigned tg = og / nx;
            if (og + 1u == (tg + 1u) * nx) xb_add(&bar[XB_TOPGEN], 1u);
            else XB_SPIN(xb_ld(&bar[XB_TOPGEN]) == tg, bar);
            __builtin_amdgcn_fence(__ATOMIC_ACQUIRE, "agent");
            xb_add(&bar[XB_XGEN(b.x)], 1u);
            asm volatile("s_waitcnt vmcnt(0)" ::: "memory");
        } else {
            XB_SPIN(xb_ld(&bar[XB_XGEN(b.x)]) == gen, bar);
            __builtin_amdgcn_fence(__ATOMIC_ACQUIRE, "agent");
            asm volatile("s_waitcnt vmcnt(0)" ::: "memory");
        }
    }
    __syncthreads();
}

struct EpiBf16Plain {
    static constexpr bool PERM = true;
    bf16_t* O; int ldc;
    DI void operator()(const f32x4 (&acc)[2][2][4][2], const pg8::Unit& u, int wr, int wc, int fr, int fq) const {
        const int row0 = u.pm * 256 + wr * 64 + fr, col0 = u.pn * 256 + wc * 32 + 8 * fq;
#pragma unroll
        for (int ai = 0; ai < 2; ++ai)
#pragma unroll
            for (int m = 0; m < 4; ++m) { bf16_t* rowp = O + (size_t)(row0 + ai * 128 + m * 16) * ldc + col0;
#pragma unroll
                for (int bj = 0; bj < 2; ++bj) { const f32x4 v0 = acc[ai][bj][m][0], v1 = acc[ai][bj][m][1];
                    u32x4 w; w.x = pk2(v0[0], v0[1]); w.y = pk2(v0[2], v0[3]); w.z = pk2(v1[0], v1[1]); w.w = pk2(v1[2], v1[3]);
                    *(u32x4*)(rowp + bj * 128) = w; } }
    }
};
struct EpiResGate {
    static constexpr bool PERM = false;
    const float* xin; float* out; const float* gt;
    DI void operator()(const f32x4 (&acc)[2][2][4][2], const pg8::Unit& u, int wr, int wc, int fr, int fq) const {
        const int row0 = u.pm * 256 + wr * 64 + fr, col0 = u.pn * 256 + wc * 32 + 4 * fq;
        const int b = (u.pm * 256) / SEQ;
        f32x4 g[2][2];
#pragma unroll
        for (int bj = 0; bj < 2; ++bj)
#pragma unroll
            for (int n = 0; n < 2; ++n) g[bj][n] = *(const f32x4*)(gt + (size_t)b * 6144 + col0 + bj * 128 + n * 16);
#pragma unroll
        for (int ai = 0; ai < 2; ++ai)
#pragma unroll
            for (int m = 0; m < 4; ++m) { const size_t ro = (size_t)(row0 + ai * 128 + m * 16) * DM + col0;
#pragma unroll
                for (int bj = 0; bj < 2; ++bj)
#pragma unroll
                    for (int n = 0; n < 2; ++n) { const f32x4 xv = *(const f32x4*)(xin + ro + bj * 128 + n * 16);
                        *(f32x4*)(out + ro + bj * 128 + n * 16) = xv + g[bj][n] * acc[ai][bj][m][n]; } }
    }
};
struct EpiGlu {
    static constexpr bool PERM = true;
    const bf16_t* Y; bf16_t* O; const float* bias;
    DI void operator()(const f32x4 (&acc)[2][2][4][2], const pg8::Unit& u, int wr, int wc, int fr, int fq) const {
        const int row0 = u.pm * 256 + wr * 64 + fr, col0 = wc * 32 + 8 * fq;
#pragma unroll
        for (int ai = 0; ai < 2; ++ai)
#pragma unroll
            for (int m = 0; m < 4; ++m) { const size_t ro = (size_t)(row0 + ai * 128 + m * 16) * 256 + col0;
#pragma unroll
                for (int bj = 0; bj < 2; ++bj) { const u32x4 yv = *(const u32x4*)(Y + ro + bj * 128);
                    const f32x4 b0 = *(const f32x4*)(bias + col0 + bj * 128), b1 = *(const f32x4*)(bias + col0 + bj * 128 + 4);
                    const f32x4 v0 = acc[ai][bj][m][0] + b0, v1 = acc[ai][bj][m][1] + b1;
                    u32x4 w;
                    w.x = pk2(bflo(yv.x) * sigmoidf_(v0[0]), bfhi(yv.x) * sigmoidf_(v0[1]));
                    w.y = pk2(bflo(yv.y) * sigmoidf_(v0[2]), bfhi(yv.y) * sigmoidf_(v0[3]));
                    w.z = pk2(bflo(yv.z) * sigmoidf_(v1[0]), bfhi(yv.z) * sigmoidf_(v1[1]));
                    w.w = pk2(bflo(yv.w) * sigmoidf_(v1[2]), bfhi(yv.w) * sigmoidf_(v1[3]));
                    *(u32x4*)(O + ro + bj * 128) = w; } }
    }
};

struct Frame { LAS unsigned char* lds; int tid, lane, wave, G, bid, gw, ngw; };

DI Frame make_frame(LAS unsigned char* lds, int wave0) {
    Frame F; F.lds = lds; int w = wave0; asm volatile("" : "+s"(w)); F.wave = w; F.lane = lane_opaque(); F.tid = w * 64 + F.lane;
    F.G = gridDim.x; F.bid = blockIdx.x; F.gw = F.bid * NWAVES + F.wave; F.ngw = F.G * NWAVES; return F;
}
DI void transpose_item(const float* src, int ld_src, int k0, int n0, bf16_t* dst, int ldd, int nd0, int kd0, LAS float* scr, int lane) {
#pragma unroll 8
    for (int i = 0; i < 32; ++i) { const int kk = 2 * i + (lane >> 5); scr[kk * 33 + (lane & 31)] = src[(size_t)(k0 + kk) * ld_src + n0 + (lane & 31)]; }
    asm volatile("s_waitcnt lgkmcnt(0)" ::: "memory");
    const int c = lane & 7;
#pragma unroll
    for (int j = 0; j < 4; ++j) { const int n = (lane >> 3) + 8 * j; const LAS float* s = scr + (8 * c) * 33 + n;
        u32x4 o; o.x = pk2(s[0 * 33], s[1 * 33]); o.y = pk2(s[2 * 33], s[3 * 33]); o.z = pk2(s[4 * 33], s[5 * 33]); o.w = pk2(s[6 * 33], s[7 * 33]);
        *(u32x4*)(dst + (size_t)(nd0 + n) * ldd + kd0 + 8 * c) = o; }
    asm volatile("s_waitcnt lgkmcnt(0)" ::: "memory");
}
DI void zero_rows(bf16_t* dst, int ld, int r0, int nr, int c0, int nc, int gw, int ngw, int lane) {
    for (int r = gw; r < nr; r += ngw) for (int c = lane * 8; c < nc; c += 512) *(u32x4*)(dst + (size_t)(r0 + r) * ld + c0 + c) = (u32x4){0u, 0u, 0u, 0u};
}

DI void phase_prologue(const Frame& F, CArgs& A) {
    unsigned char* ws = A.ws;
    LAS float* sc = (LAS float*)F.lds;
    LAS float* part = (LAS float*)(F.lds + 32768);
    for (int i = F.tid; i < 8192; i += NTHR) sc[i] = siluf_(A.in[1][i]);
    __syncthreads();
    float* MOD = (float*)(ws + WS_MOD);
    for (int item = F.bid; item < 192; item += F.G) {
        const int l = item / 96, n0 = (item % 96) * 64, nl = F.tid & 63, kg = F.tid >> 6;
        const float* W = A.in[3] + (size_t)l * 1024 * 6144 + n0 + nl;
        float acc[8];
#pragma unroll
        for (int b = 0; b < 8; ++b) acc[b] = 0.f;
        for (int k = kg * 128; k < kg * 128 + 128; ++k) { const float w = W[(size_t)k * 6144];
#pragma unroll
            for (int b = 0; b < 8; ++b) acc[b] += sc[b * 1024 + k] * w; }
#pragma unroll
        for (int b = 0; b < 8; ++b) part[(kg * 8 + b) * 64 + nl] = acc[b];
        __syncthreads();
        { const int b = F.tid >> 6; float s = A.in[4][l * 6144 + n0 + nl];
#pragma unroll
          for (int g = 0; g < 8; ++g) s += part[(g * 8 + b) * 64 + nl];
          MOD[((size_t)l * 8 + b) * 6144 + n0 + nl] = s; }
        __syncthreads();
    }
    LAS float* scr = (LAS float*)(F.lds + F.wave * 8448);
    bf16_t* WIN = (bf16_t*)(ws + WS_WIN); bf16_t* WOUT = (bf16_t*)(ws + WS_WOUT); bf16_t* WMLA = (bf16_t*)(ws + WS_WMLA); bf16_t* WGLU = (bf16_t*)(ws + WS_WGLU);
    constexpr int I_IN = 16 * 65, I_OUT = 16 * 32, I_Q = 4 * 12, I_KV = 2 * 16, I_GLU = 4 * 8, I_L = I_IN + I_OUT + I_Q + I_KV + I_GLU;
    for (int it = F.gw; it < 2 * I_L; it += F.ngw) {
        const int l = it / I_L; int r = it % I_L;
        if (r < I_IN) { transpose_item(A.in[6] + (size_t)l * 1024 * D_IN, D_IN, 64 * (r / 65), 32 * (r % 65), WIN + (size_t)l * ZS * 1024, 1024, 32 * (r % 65), 64 * (r / 65), scr, F.lane); continue; } r -= I_IN;
        if (r < I_OUT) { transpose_item(A.in[42] + (size_t)l * 1024 * 1024, 1024, 64 * (r / 32), 32 * (r % 32), WOUT + (size_t)l * 1024 * 1024, 1024, 32 * (r % 32), 64 * (r / 32), scr, F.lane); continue; } r -= I_OUT;
        if (r < I_Q) { transpose_item(A.in[29] + (size_t)l * 256 * 384, 384, 64 * (r / 12), 32 * (r % 12), WMLA + (size_t)l * 1024 * 512, 512, 32 * (r % 12), 64 * (r / 12), scr, F.lane); continue; } r -= I_Q;
        if (r < I_KV) { transpose_item(A.in[31] + (size_t)l * 128 * 512, 512, 64 * (r / 16), 32 * (r % 16), WMLA + (size_t)l * 1024 * 512, 512, 384 + 32 * (r % 16), 256 + 64 * (r / 16), scr, F.lane); continue; } r -= I_KV;
        transpose_item(A.in[26] + (size_t)l * 256 * 256, 256, 64 * (r / 8), 32 * (r % 8), WGLU + (size_t)l * 256 * 256, 256, 32 * (r % 8), 64 * (r / 8), scr, F.lane);
    }
    { bf16_t* WR = (bf16_t*)(ws + WS_WR);
      for (int i = F.bid * NTHR + F.tid; i < 2 * 48 * 1024; i += F.G * NTHR) { const int l = i / (48 * 1024), n = (i / 1024) % 48, k = i % 1024;
          const float v = n < 4 ? A.in[44][((size_t)l * 1024 + k) * 4 + n] : n < 36 ? A.in[46][((size_t)l * 1024 + k) * 32 + (n - 4)] : 0.f;
          const unsigned hi = f2bf(v); const float rem = v - __uint_as_float(hi << 16);
          WR[((size_t)(l * 2 + 0) * 48 + n) * 1024 + k] = (bf16_t)hi; WR[((size_t)(l * 2 + 1) * 48 + n) * 1024 + k] = (bf16_t)f2bf(rem); } }
    { bf16_t* WL = (bf16_t*)(ws + WS_WLRU); bf16_t* WO = (bf16_t*)(ws + WS_WLORA);
      for (int i = F.bid * NTHR + F.tid; i < 2 * 2 * 4 * 4096; i += F.G * NTHR) { const int l = i >> 15, wh = (i >> 14) & 1, n = (i >> 12) & 3, j = (i >> 6) & 63, k = i & 63;
          WL[i] = (bf16_t)f2bf((wh ? A.in[38] : A.in[36])[((size_t)(l * 4 + n) * 64 + k) * 64 + j]); }
      for (int i = F.bid * NTHR + F.tid; i < 2 * 32768; i += F.G * NTHR) { const int l = i >> 15, r = i & 32767;
          float v;
          if (r < 8192) v = A.in[9][(size_t)l * 8192 + (r & 31) * 256 + (r >> 5)];
          else if (r < 16384) v = A.in[11][(size_t)l * 8192 + ((r - 8192) & 31) * 256 + ((r - 8192) >> 5)];
          else v = A.in[12][(size_t)l * 16384 + ((r - 16384) & 63) * 256 + ((r - 16384) >> 6)];
          WO[i] = (bf16_t)f2bf(v); } }
    { bf16_t* BBt = (bf16_t*)(ws + WS_S5BB); bf16_t* CCt = (bf16_t*)(ws + WS_S5CC);
      for (int i = F.bid * NTHR + F.tid; i < 2 * 16 * 64; i += F.G * NTHR) { const int lg = i >> 6, p = i & 63;
          const float dt = __expf(A.in[25][lg]); const float lre = A.in[18][lg * 64 + p], lim = A.in[19][lg * 64 + p];
          const float mag = expf(lre * dt); float sn, cn; sincosf(lim * dt, &sn, &cn);
          const float are = mag * cn, aim = mag * sn, den = lre * lre + lim * lim;
          const float qre = ((are - 1.f) * lre + aim * lim) / den, qim = (aim * lre - (are - 1.f) * lim) / den;
          const float* br = A.in[20] + ((size_t)lg * 64 + p) * 16; const float* bi = A.in[21] + ((size_t)lg * 64 + p) * 16;
          for (int c = 0; c < 16; ++c) { const float x = br[c], y = bi[c];
              BBt[(((size_t)lg * 2 + 0) * 64 + p) * 16 + c] = (bf16_t)f2bf(qre * x - qim * y); BBt[(((size_t)lg * 2 + 1) * 64 + p) * 16 + c] = (bf16_t)f2bf(qre * y + qim * x); } }
      for (int i = F.bid * NTHR + F.tid; i < 2 * 16 * 16 * 128; i += F.G * NTHR) { const int lg = i >> 11, ii = (i >> 7) & 15, k = i & 127;
          CCt[i] = (bf16_t)f2bf(k < 64 ? A.in[22][((size_t)lg * 16 + ii) * 64 + k] : -A.in[23][((size_t)lg * 16 + ii) * 64 + (k - 64)]); } }
    for (int l = 0; l < 2; ++l) {
        zero_rows(WIN + (size_t)l * ZS * 1024, 1024, D_IN, ZS - D_IN, 0, 1024, F.gw, F.ngw, F.lane);
        bf16_t* wm = WMLA + (size_t)l * 1024 * 512;
        zero_rows(wm, 512, 0, 384, 256, 256, F.gw, F.ngw, F.lane);
        zero_rows(wm, 512, 384, 512, 0, 256, F.gw, F.ngw, F.lane);
        zero_rows(wm, 512, 384, 512, 384, 128, F.gw, F.ngw, F.lane);
        zero_rows(wm, 512, 896, 128, 0, 512, F.gw, F.ngw, F.lane);
    }
}

DI void phase_norm1(const Frame& F, CArgs& A, int l) {
    const float* MODL = (const float*)(A.ws + WS_MOD) + (size_t)l * 8 * 6144;
    const float* g = A.in[5] + l * 1024;
    const bf16_t* Y = (const bf16_t*)(A.ws + WS_Y);
    bf16_t* H = (bf16_t*)(A.ws + WS_H);
    const float* src = (l == 0) ? A.in[0] : A.out;
    for (int row = F.gw; row < T; row += F.ngw) {
        const int b = row / SEQ;
        f32x4 v[4]; float ss = 0.f;
#pragma unroll
        for (int j = 0; j < 4; ++j) { const int col = 4 * (64 * j + F.lane);
            v[j] = *(const f32x4*)(src + (size_t)row * DM + col);
            if (l > 0) { const u32x2 y0 = *(const u32x2*)(Y + (size_t)(2 * row) * DM + col), y1 = *(const u32x2*)(Y + (size_t)(2 * row + 1) * DM + col);
                v[j][0] += bflo(y0.x) + bflo(y1.x); v[j][1] += bfhi(y0.x) + bfhi(y1.x); v[j][2] += bflo(y0.y) + bflo(y1.y); v[j][3] += bfhi(y0.y) + bfhi(y1.y);
                *(f32x4*)(A.out + (size_t)row * DM + col) = v[j]; }
            ss += v[j][0] * v[j][0] + v[j][1] * v[j][1] + v[j][2] * v[j][2] + v[j][3] * v[j][3]; }
        const float rstd = rsqrtf(wave_sum(ss) * (1.f / DM) + NORM_EPS);
#pragma unroll
        for (int j = 0; j < 4; ++j) { const int col = 4 * (64 * j + F.lane);
            const f32x4 gg = *(const f32x4*)(g + col), sh = *(const f32x4*)(MODL + (size_t)b * 6144 + col), scv = *(const f32x4*)(MODL + (size_t)b * 6144 + 1024 + col);
            const f32x4 hv = v[j] * rstd * gg * (scv + 1.f) + sh;
            u32x2 o; o.x = pk2(hv[0], hv[1]); o.y = pk2(hv[2], hv[3]);
            *(u32x2*)(H + (size_t)row * DM + col) = o; }
    }
}

DI void phase_mla_prep(const Frame& F, CArgs& A, int l) {
    const bf16_t* Z = (const bf16_t*)(A.ws + WS_Z); bf16_t* AM = (bf16_t*)(A.ws + WS_AMLA);
    const float* qg = A.in[28] + l * 256; const float* kg = A.in[30] + l * 128;
    for (int row = F.gw; row < T; row += F.ngw) {
        const bf16_t* zr = Z + (size_t)row * ZS;
        const u32x2 qv = *(const u32x2*)(zr + ZC_QA + 4 * F.lane); const unsigned kv = *(const unsigned*)(zr + ZC_KVA + 2 * F.lane);
        const float q0 = bflo(qv.x), q1 = bfhi(qv.x), q2 = bflo(qv.y), q3 = bfhi(qv.y), k0 = bflo(kv), k1 = bfhi(kv);
        const float rq = rsqrtf(wave_sum(q0 * q0 + q1 * q1 + q2 * q2 + q3 * q3) * (1.f / 256.f) + NORM_EPS);
        const float rk = rsqrtf(wave_sum(k0 * k0 + k1 * k1) * (1.f / 128.f) + NORM_EPS);
        const f32x4 g4 = *(const f32x4*)(qg + 4 * F.lane); const f32x2 g2 = *(const f32x2*)(kg + 2 * F.lane);
        u32x2 o; o.x = pk2(q0 * rq * g4[0], q1 * rq * g4[1]); o.y = pk2(q2 * rq * g4[2], q3 * rq * g4[3]);
        bf16_t* ar = AM + (size_t)row * 512;
        *(u32x2*)(ar + 4 * F.lane) = o;
        *(unsigned*)(ar + 256 + 2 * F.lane) = pk2(k0 * rk * g2[0], k1 * rk * g2[1]);
        *(unsigned*)(ar + 384 + 2 * F.lane) = 0u;
    }
}

DI void phase_mla_post(const Frame& F, CArgs& A, int l) {
    const bf16_t* Z = (const bf16_t*)(A.ws + WS_Z); const bf16_t* RAW = (const bf16_t*)(A.ws + WS_QKVRAW);
    bf16_t* Q = (bf16_t*)(A.ws + WS_Q); bf16_t* K = (bf16_t*)(A.ws + WS_K); bf16_t* VT = (bf16_t*)(A.ws + WS_VT);
    LAS float* cs = (LAS float*)F.lds;
    LAS bf16_t* vt = (LAS bf16_t*)(F.lds + 8192);
    const float* qhg = A.in[32] + l * 96; const float* khg = A.in[33] + l * 96;
    for (int tile = F.bid; tile < T / 64; tile += F.G) {
        const int t0 = tile * 64, b = t0 / SEQ, s0 = t0 % SEQ;
        int tz = F.tid; asm volatile("" : "+v"(tz));
        for (int idx = tz; idx < 1024; idx += NTHR) { const int tok = idx >> 4, i = idx & 15;
            const int pos = A.pos_off[b] + s0 + tok; const float inv = powf(10000.f, -(float)i * (1.f / 16.f));
            double ang = (double)(float)pos * (double)inv; ang -= 6.283185307179586 * floor(ang * 0.15915494309189535);
            float sn, cn; sincosf((float)ang, &sn, &cn); cs[idx * 2] = cn; cs[idx * 2 + 1] = sn; }
        __syncthreads();
        const int tok = tz >> 3, sub = tz & 7, h = sub >> 1, isk = sub & 1, t = t0 + tok;
        {
            float v[96];
            const bf16_t* p0 = isk ? RAW + (size_t)t * 1024 + 384 + 128 * h : RAW + (size_t)t * 1024 + 96 * h;
            const bf16_t* p1 = isk ? Z + (size_t)t * ZS + ZC_KPE : p0 + 64;
#pragma unroll
            for (int c = 0; c < 8; ++c) { const u32x4 w = *(const u32x4*)(p0 + 8 * c);
                v[8 * c] = bflo(w.x); v[8 * c + 1] = bfhi(w.x); v[8 * c + 2] = bflo(w.y); v[8 * c + 3] = bfhi(w.y); v[8 * c + 4] = bflo(w.z); v[8 * c + 5] = bfhi(w.z); v[8 * c + 6] = bflo(w.w); v[8 * c + 7] = bfhi(w.w); }
#pragma unroll
            for (int c = 0; c < 4; ++c) { const u32x4 w = *(const u32x4*)(p1 + 8 * c);
                v[64 + 8 * c] = bflo(w.x); v[65 + 8 * c] = bfhi(w.x); v[66 + 8 * c] = bflo(w.y); v[67 + 8 * c] = bfhi(w.y); v[68 + 8 * c] = bflo(w.z); v[69 + 8 * c] = bfhi(w.z); v[70 + 8 * c] = bflo(w.w); v[71 + 8 * c] = bfhi(w.w); }
            float ss = 0.f;
#pragma unroll
            for (int i = 0; i < 96; ++i) ss += v[i] * v[i];
            const float r = rsqrtf(ss * (1.f / 96.f) + NORM_EPS);
            const float* hg = isk ? khg : qhg;
#pragma unroll
            for (int i = 0; i < 96; ++i) v[i] = v[i] * r * hg[i];
#pragma unroll
            for (int i = 0; i < 16; ++i) { const float cn = cs[(tok * 16 + i) * 2], sn = cs[(tok * 16 + i) * 2 + 1]; const float x1 = v[64 + i], x2 = v[80 + i];
                v[64 + i] = x1 * cn - x2 * sn; v[80 + i] = x1 * sn + x2 * cn; }
            bf16_t* dst = (isk ? K : Q) + ((size_t)t * 4 + h) * 96;
#pragma unroll
            for (int c = 0; c < 12; ++c) { u32x4 w; w.x = pk2(v[8 * c], v[8 * c + 1]); w.y = pk2(v[8 * c + 2], v[8 * c + 3]); w.z = pk2(v[8 * c + 4], v[8 * c + 5]); w.w = pk2(v[8 * c + 6], v[8 * c + 7]);
                *(u32x4*)(dst + 8 * c) = w; }
        }
        {
            const bf16_t* pv = RAW + (size_t)t * 1024 + 384 + 128 * h + 64 + 32 * isk;
#pragma unroll
            for (int c = 0; c < 4; ++c) { const u32x4 w = *(const u32x4*)(pv + 8 * c); const int r0 = h * 64 + 32 * isk + 8 * c;
                vt[(r0 + 0) * 72 + tok] = (bf16_t)(w.x & 0xffffu); vt[(r0 + 1) * 72 + tok] = (bf16_t)(w.x >> 16);
                vt[(r0 + 2) * 72 + tok] = (bf16_t)(w.y & 0xffffu); vt[(r0 + 3) * 72 + tok] = (bf16_t)(w.y >> 16);
                vt[(r0 + 4) * 72 + tok] = (bf16_t)(w.z & 0xffffu); vt[(r0 + 5) * 72 + tok] = (bf16_t)(w.z >> 16);
                vt[(r0 + 6) * 72 + tok] = (bf16_t)(w.w & 0xffffu); vt[(r0 + 7) * 72 + tok] = (bf16_t)(w.w >> 16); }
        }
        __syncthreads();
        { const int row = tz >> 1, hf = tz & 1;
          bf16_t* dst = VT + ((size_t)(b * 4) * 64 + row) * SEQ + s0 + 32 * hf;
#pragma unroll
          for (int c = 0; c < 4; ++c) *(u32x4*)(dst + 8 * c) = *(const LAS u32x4*)(vt + row * 72 + 32 * hf + 8 * c); }
        __syncthreads();
    }
}

DI void attn_unit(const Frame& F, const bf16_t* Q, const bf16_t* K, const bf16_t* VT, bf16_t* O, int bh, int u) {
    constexpr int KP = 208, VP = 144, KB = 64 * KP, VB = 64 * VP;
    LAS unsigned char* Ks = F.lds; LAS unsigned char* Vs = F.lds + 2 * KB;
    const int b = bh >> 2, h = bh & 3, lane = F.lane, w = F.wave, ql = lane & 31, hh = lane >> 5;
    const int ntile = 4 * u + 4, myl = 4 * u + (w >> 1);
    const size_t tq = (size_t)b * SEQ + 256 * u + 32 * w + ql;
    bf16x8 qf[6];
#pragma unroll
    for (int s = 0; s < 6; ++s) qf[s] = *(const bf16x8*)(Q + (tq * 4 + h) * 96 + 16 * s + 8 * hh);
    f32x16 ot[2];
#pragma unroll
    for (int i = 0; i < 16; ++i) { ot[0][i] = 0.f; ot[1][i] = 0.f; }
    float mrun = -INFINITY, lrun = 0.f;
    const float c2 = 0.10206207261596577f * 1.4426950408889634f;
    const int kp0 = F.tid, kp1 = F.tid + 512;
    const size_t kbase = ((size_t)b * SEQ * 4 + h) * 96;
    const bf16_t* vsrc = VT + ((size_t)bh * 64 + (F.tid >> 3)) * SEQ + 8 * (F.tid & 7);
    u32x4 rk0, rk1, rv;
    rk1 = (u32x4){0u, 0u, 0u, 0u};
#define ATT_LOAD(j) do { rk0 = *(const u32x4*)(K + kbase + (size_t)(64 * (j) + kp0 / 12) * 384 + 8 * (kp0 % 12)); \
        if (kp1 < 768) rk1 = *(const u32x4*)(K + kbase + (size_t)(64 * (j) + kp1 / 12) * 384 + 8 * (kp1 % 12)); \
        rv = *(const u32x4*)(vsrc + 64 * (j)); } while (0)
#define ATT_STORE(buf) do { *(LAS u32x4*)(Ks + (buf) * KB + (kp0 / 12) * KP + (kp0 % 12) * 16) = rk0; \
        if (kp1 < 768) *(LAS u32x4*)(Ks + (buf) * KB + (kp1 / 12) * KP + (kp1 % 12) * 16) = rk1; \
        *(LAS u32x4*)(Vs + (buf) * VB + (F.tid >> 3) * VP + (F.tid & 7) * 16) = rv; } while (0)
    ATT_LOAD(0); ATT_STORE(0);
    __syncthreads();
    for (int j = 0; j < ntile; ++j) {
        const int buf = j & 1;
        if (j + 1 < ntile) ATT_LOAD(j + 1);
        if (j <= myl) {
            f32x16 st[2];
#pragma unroll
            for (int kt = 0; kt < 2; ++kt) {
#pragma unroll
                for (int i = 0; i < 16; ++i) st[kt][i] = 0.f;
#pragma unroll
                for (int s = 0; s < 6; ++s) { const bf16x8 kf = *(const LAS bf16x8*)(Ks + buf * KB + (32 * kt + ql) * KP + (16 * s + 8 * hh) * 2);
                    st[kt] = __builtin_amdgcn_mfma_f32_32x32x16_bf16(kf, qf[s], st[kt], 0, 0, 0); }
            }
            float mx = st[0][0];
#pragma unroll
            for (int i = 1; i < 16; ++i) mx = fmaxf(mx, st[0][i]);
#pragma unroll
            for (int i = 0; i < 16; ++i) mx = fmaxf(mx, st[1][i]);
            mx = fmaxf(mx, shfl_xor_l(mx, 32, lane));
            const float mnew = fmaxf(mrun, mx), alpha = __builtin_amdgcn_exp2f((mrun - mnew) * c2), mc = mnew * c2;
            mrun = mnew;
            float ps = 0.f;
#pragma unroll
            for (int kt = 0; kt < 2; ++kt)
#pragma unroll
                for (int i = 0; i < 16; ++i) { const float p = __builtin_amdgcn_exp2f(st[kt][i] * c2 - mc); st[kt][i] = p; ps += p; }
            lrun = lrun * alpha + ps;
#pragma unroll
            for (int i = 0; i < 16; ++i) { ot[0][i] *= alpha; ot[1][i] *= alpha; }
#pragma unroll
            for (int kt = 0; kt < 2; ++kt)
#pragma unroll
                for (int c = 0; c < 2; ++c) {
                    u32x4 pw; pw.x = pk2(st[kt][8 * c], st[kt][8 * c + 1]); pw.y = pk2(st[kt][8 * c + 2], st[kt][8 * c + 3]); pw.z = pk2(st[kt][8 * c + 4], st[kt][8 * c + 5]); pw.w = pk2(st[kt][8 * c + 6], st[kt][8 * c + 7]);
                    const bf16x8 pf = __builtin_bit_cast(bf16x8, pw);
                    const int key0 = 32 * kt + 16 * c + 4 * hh;
#pragma unroll
                    for (int dt = 0; dt < 2; ++dt) { const LAS unsigned char* vp = Vs + buf * VB + (32 * dt + ql) * VP + key0 * 2;
                        const u32x2 v0 = *(const LAS u32x2*)vp, v1 = *(const LAS u32x2*)(vp + 16);
                        u32x4 vw; vw.x = v0.x; vw.y = v0.y; vw.z = v1.x; vw.w = v1.y;
                        ot[dt] = __builtin_amdgcn_mfma_f32_32x32x16_bf16(__builtin_bit_cast(bf16x8, vw), pf, ot[dt], 0, 0, 0); }
                }
        }
        if (j + 1 < ntile) ATT_STORE(buf ^ 1);
        __syncthreads();
    }
#undef ATT_LOAD
#undef ATT_STORE
    const float linv = 1.f / (lrun + shfl_xor_l(lrun, 32, lane));
    bf16_t* orow = O + tq * 256 + h * 64;
#pragma unroll
    for (int dt = 0; dt < 2; ++dt)
#pragma unroll
        for (int g = 0; g < 4; ++g) { u32x2 o; o.x = pk2(ot[dt][4 * g] * linv, ot[dt][4 * g + 1] * linv); o.y = pk2(ot[dt][4 * g + 2] * linv, ot[dt][4 * g + 3] * linv);
            *(u32x2*)(orow + 32 * dt + 8 * g + 4 * hh) = o; }
}
DI void phase_attn(const Frame& F, CArgs& A) {
    const bf16_t* Q = (const bf16_t*)(A.ws + WS_Q); const bf16_t* K = (const bf16_t*)(A.ws + WS_K); const bf16_t* VT = (const bf16_t*)(A.ws + WS_VT);
    bf16_t* O = (bf16_t*)(A.ws + WS_ATTO);
    for (int p = F.bid; p < 512; p += F.G) { const int bh = p >> 4, u = p & 15;
        attn_unit(F, Q, K, VT, O, bh, 31 - u);
        attn_unit(F, Q, K, VT, O, bh, u); }
}

DI void phase_rwkv_prep(const Frame& F, CArgs& A, int l) {
    const bf16_t* Z = (const bf16_t*)(A.ws + WS_Z);
    bf16_t* R_ = (bf16_t*)(A.ws + WS_RW_R); bf16_t* K_ = (bf16_t*)(A.ws + WS_RW_K); bf16_t* V_ = (bf16_t*)(A.ws + WS_RW_V); bf16_t* KK_ = (bf16_t*)(A.ws + WS_RW_KK);
    bf16_t* B_ = (bf16_t*)(A.ws + WS_RW_B); bf16_t* G_ = (bf16_t*)(A.ws + WS_RW_G); float* W_ = (float*)(A.ws + WS_RW_W);
    const float* mu = A.in[7] + l * 896; const float* w0 = A.in[8] + l * 256; const float* a0 = A.in[10] + l * 256; const float* k_k = A.in[13] + l * 256; const float* k_a = A.in[14] + l * 256;
    const bf16_t* WO = (const bf16_t*)(A.ws + WS_WLORA) + (size_t)l * 32768;
    LAS float* hs = (LAS float*)F.lds;
    const int w = F.wave, c0 = 32 * w;
    bf16x8 w2f[2], a2f[2], g2f[2][2];
    { const int fr = F.lane & 15, fq = F.lane >> 4;
#pragma unroll
      for (int nf = 0; nf < 2; ++nf) { const int ch = c0 + 16 * nf + fr;
          w2f[nf] = *(const bf16x8*)(WO + ch * 32 + 8 * fq); a2f[nf] = *(const bf16x8*)(WO + 8192 + ch * 32 + 8 * fq);
          g2f[nf][0] = *(const bf16x8*)(WO + 16384 + ch * 64 + 8 * fq); g2f[nf][1] = *(const bf16x8*)(WO + 16384 + ch * 64 + 32 + 8 * fq); } }
    for (int tile = F.bid; tile < T / 64; tile += F.G) {
        int tz = F.tid; asm volatile("" : "+v"(tz)); const int lane = tz & 63, fr = lane & 15, fq = lane >> 4;
        const int t0 = tile * 64, s0 = t0 % SEQ;
        f32x4 aw[4][2], aa[4][2], ag[4][2];
#pragma unroll
        for (int m = 0; m < 4; ++m) {
            const size_t t = (size_t)t0 + 16 * m + fr; const bool hp = (s0 + 16 * m + fr) > 0;
            const bf16_t* zr = Z + t * ZS + ZC_WLO + 8 * fq;
            bf16x8 xf[4];
#pragma unroll
            for (int ks = 0; ks < 4; ++ks) {
                const u32x4 zc = *(const u32x4*)(zr + 32 * ks); u32x4 zp = {0u, 0u, 0u, 0u}; if (hp) zp = *(const u32x4*)(zr + 32 * ks - ZS);
                const f32x4 m0 = *(const f32x4*)(mu + ZC_WLO + 32 * ks + 8 * fq), m1 = *(const f32x4*)(mu + ZC_WLO + 32 * ks + 8 * fq + 4);
                const unsigned cw[4] = {zc.x, zc.y, zc.z, zc.w}, pw[4] = {zp.x, zp.y, zp.z, zp.w}; const float mm[8] = {m0[0], m0[1], m0[2], m0[3], m1[0], m1[1], m1[2], m1[3]};
                float v[8];
#pragma unroll
                for (int i = 0; i < 8; ++i) { const float zcv = (i & 1) ? bfhi(cw[i >> 1]) : bflo(cw[i >> 1]), zpv = (i & 1) ? bfhi(pw[i >> 1]) : bflo(pw[i >> 1]);
                    float x = zcv + (zpv - zcv) * mm[i]; if (ks == 0) x = tanhf(x); else if (ks >= 2) x = sigmoidf_(x); v[i] = x; }
                u32x4 o; o.x = pk2(v[0], v[1]); o.y = pk2(v[2], v[3]); o.z = pk2(v[4], v[5]); o.w = pk2(v[6], v[7]); xf[ks] = __builtin_bit_cast(bf16x8, o);
            }
#pragma unroll
            for (int nf = 0; nf < 2; ++nf) { const f32x4 z4 = {0.f, 0.f, 0.f, 0.f};
                aw[m][nf] = __builtin_amdgcn_mfma_f32_16x16x32_bf16(w2f[nf], xf[0], z4, 0, 0, 0);
                aa[m][nf] = __builtin_amdgcn_mfma_f32_16x16x32_bf16(a2f[nf], xf[1], z4, 0, 0, 0);
                ag[m][nf] = __builtin_amdgcn_mfma_f32_16x16x32_bf16(g2f[nf][0], xf[2], z4, 0, 0, 0);
                ag[m][nf] = __builtin_amdgcn_mfma_f32_16x16x32_bf16(g2f[nf][1], xf[3], ag[m][nf], 0, 0, 0); }
        }
#pragma unroll
        for (int m = 0; m < 4; ++m) {
            const size_t t = (size_t)t0 + 16 * m + fr; const bool hp = (s0 + 16 * m + fr) > 0; float ssq = 0.f;
#pragma unroll
            for (int nf = 0; nf < 2; ++nf) { const int ch4 = c0 + 16 * nf + 4 * fq;
                const u32x2 kc = *(const u32x2*)(Z + t * ZS + ZC_K + ch4); u32x2 kp = {0u, 0u}; if (hp) kp = *(const u32x2*)(Z + (t - 1) * ZS + ZC_K + ch4);
                const f32x4 mk = *(const f32x4*)(mu + ZC_K + ch4), kkw = *(const f32x4*)(k_k + ch4);
                const f32x4 kcv = {bflo(kc.x), bfhi(kc.x), bflo(kc.y), bfhi(kc.y)}, kpv = {bflo(kp.x), bfhi(kp.x), bflo(kp.y), bfhi(kp.y)};
                const f32x4 k = kcv + (kpv - kcv) * mk; const f32x4 q = k * kkw; ssq += q[0] * q[0] + q[1] * q[1] + q[2] * q[2] + q[3] * q[3]; }
            ssq += shfl_xor_l(ssq, 16, lane); ssq += shfl_xor_l(ssq, 32, lane);
            if (fq == 0) hs[w * 64 + 16 * m + fr] = ssq;
        }
        __syncthreads();
#pragma unroll
        for (int m = 0; m < 4; ++m) {
            const size_t t = (size_t)t0 + 16 * m + fr; const bool hp = (s0 + 16 * m + fr) > 0;
            const float nrm = sqrtf(hs[w * 64 + 16 * m + fr] + hs[(w ^ 1) * 64 + 16 * m + fr]); const float rn = 1.f / fmaxf(nrm, 1e-12f);
#pragma unroll
            for (int nf = 0; nf < 2; ++nf) { const int ch4 = c0 + 16 * nf + 4 * fq;
                const f32x4 wv = aw[m][nf] + *(const f32x4*)(w0 + ch4), av = aa[m][nf] + *(const f32x4*)(a0 + ch4), gv = ag[m][nf];
                const u32x2 rc = *(const u32x2*)(Z + t * ZS + ZC_R + ch4), kc = *(const u32x2*)(Z + t * ZS + ZC_K + ch4), vc = *(const u32x2*)(Z + t * ZS + ZC_V + ch4);
                u32x2 rp = {0u, 0u}, kp = {0u, 0u}, vp = {0u, 0u};
                if (hp) { rp = *(const u32x2*)(Z + (t - 1) * ZS + ZC_R + ch4); kp = *(const u32x2*)(Z + (t - 1) * ZS + ZC_K + ch4); vp = *(const u32x2*)(Z + (t - 1) * ZS + ZC_V + ch4); }
                const f32x4 mr = *(const f32x4*)(mu + ZC_R + ch4), mk = *(const f32x4*)(mu + ZC_K + ch4), mv = *(const f32x4*)(mu + ZC_V + ch4), ka = *(const f32x4*)(k_a + ch4), kkw = *(const f32x4*)(k_k + ch4);
                const f32x4 rcv = {bflo(rc.x), bfhi(rc.x), bflo(rc.y), bfhi(rc.y)}, rpv = {bflo(rp.x), bfhi(rp.x), bflo(rp.y), bfhi(rp.y)};
                const f32x4 kcv = {bflo(kc.x), bfhi(kc.x), bflo(kc.y), bfhi(kc.y)}, kpv = {bflo(kp.x), bfhi(kp.x), bflo(kp.y), bfhi(kp.y)};
                const f32x4 vcv = {bflo(vc.x), bfhi(vc.x), bflo(vc.y), bfhi(vc.y)}, vpv = {bflo(vp.x), bfhi(vp.x), bflo(vp.y), bfhi(vp.y)};
                const f32x4 r = rcv + (rpv - rcv) * mr, k = kcv + (kpv - kcv) * mk, v = vcv + (vpv - vcv) * mv;
                f32x4 lw, a4, km, kk, bb;
#pragma unroll
                for (int i = 0; i < 4; ++i) { lw[i] = -__expf(-softplusf_(-wv[i]) - 0.5f); a4[i] = sigmoidf_(av[i]); kk[i] = k[i] * kkw[i] * rn; km[i] = k[i] * (1.f + (a4[i] - 1.f) * ka[i]); bb[i] = kk[i] * a4[i]; }
                const size_t o = t * 256 + ch4;
                u32x2 p;
                p.x = pk2(r[0], r[1]); p.y = pk2(r[2], r[3]); *(u32x2*)(R_ + o) = p;
                p.x = pk2(km[0], km[1]); p.y = pk2(km[2], km[3]); *(u32x2*)(K_ + o) = p;
                p.x = pk2(v[0], v[1]); p.y = pk2(v[2], v[3]); *(u32x2*)(V_ + o) = p;
                p.x = pk2(kk[0], kk[1]); p.y = pk2(kk[2], kk[3]); *(u32x2*)(KK_ + o) = p;
                p.x = pk2(bb[0], bb[1]); p.y = pk2(bb[2], bb[3]); *(u32x2*)(B_ + o) = p;
                p.x = pk2(gv[0], gv[1]); p.y = pk2(gv[2], gv[3]); *(u32x2*)(G_ + o) = p;
                *(f32x4*)(W_ + o) = lw; }
        }
        __syncthreads();
    }
}

DI f32x16 mfma32(bf16x8 a, bf16x8 b, f32x16 c) { return __builtin_amdgcn_mfma_f32_32x32x16_bf16(a, b, c, 0, 0, 0); }
DI bf16x8 ldfrag(const LAS unsigned char* base, int row, int ks, int h) { return *(const LAS bf16x8*)(base + row * 144 + (16 * ks + 8 * h) * 2); }
DI f32x16 zero16() { f32x16 z;
#pragma unroll
    for (int i = 0; i < 16; ++i) z[i] = 0.f;
    return z; }
DI bf16x8 pack8(const f32x16& x, int o) { u32x4 p; p.x = pk2(x[o], x[o + 1]); p.y = pk2(x[o + 2], x[o + 3]); p.z = pk2(x[o + 4], x[o + 5]); p.w = pk2(x[o + 6], x[o + 7]); return __builtin_bit_cast(bf16x8, p); }
DI f32x16 tileprod(const LAS unsigned char* Aimg, int a0, const LAS unsigned char* Bimg, int b0, f32x16 acc, int lr, int h2) {
#pragma unroll
    for (int ks = 0; ks < 4; ++ks) acc = mfma32(ldfrag(Aimg, a0 + lr, ks, h2), ldfrag(Bimg, b0 + lr, ks, h2), acc);
    return acc;
}
DI void put_tile(LAS unsigned char* img, int c0, int r0, const f32x16& a, int lr, int h2) {
#pragma unroll
    for (int g = 0; g < 4; ++g) { u32x2 o; o.x = pk2(a[4 * g], a[4 * g + 1]); o.y = pk2(a[4 * g + 2], a[4 * g + 3]); *(LAS u32x2*)(img + (c0 + lr) * 144 + (r0 + 8 * g + 4 * h2) * 2) = o; }
}
DI void phase_rwkv_A(const Frame& F, CArgs& A, int l) {
    const bf16_t* R_ = (const bf16_t*)(A.ws + WS_RW_R); const bf16_t* K_ = (const bf16_t*)(A.ws + WS_RW_K); const bf16_t* V_ = (const bf16_t*)(A.ws + WS_RW_V);
    const bf16_t* KK_ = (const bf16_t*)(A.ws + WS_RW_KK); const bf16_t* B_ = (const bf16_t*)(A.ws + WS_RW_B); const float* LW_ = (const float*)(A.ws + WS_RW_W);
    bf16_t* RP = (bf16_t*)(A.ws + WS_RC_RP); float* Y0T = (float*)(A.ws + WS_RC_Y0); unsigned char* REC = A.ws + WS_RC_G;
    float* BSUM = (float*)(A.ws + WS_RC_BS);
    const float* r_k = A.in[15] + l * 256;
    constexpr int TB = 64 * 144;
#define TILE(i) (F.lds + (i) * TB)
    LAS float* XF = (LAS float*)TILE(13);
    const int w = F.wave;
    for (int u = F.bid; u < 4096; u += F.G) {
        const int bh = u >> 7, c = u & 127, b = bh >> 2, hd = bh & 3;
        const size_t t0 = (size_t)b * SEQ + 64 * c;
        {
        int tid = F.tid; asm volatile("" : "+v"(tid)); const int lane = tid & 63;
        const int t = tid >> 3, d0 = 8 * (tid & 7);
        const size_t gi = (t0 + t) * 256 + hd * 64 + d0;
        const f32x4 lw0 = *(const f32x4*)(LW_ + gi), lw1 = *(const f32x4*)(LW_ + gi + 4);
        const u32x4 rv = *(const u32x4*)(R_ + gi), kv = *(const u32x4*)(K_ + gi), vv = *(const u32x4*)(V_ + gi), kkv = *(const u32x4*)(KK_ + gi), bv = *(const u32x4*)(B_ + gi);
        *(LAS f32x4*)(XF + t * 64 + d0) = lw0; *(LAS f32x4*)(XF + t * 64 + d0 + 4) = lw1;
        __syncthreads();
        if (w == 0) { float cv[64];
#pragma unroll
            for (int i = 0; i < 64; ++i) cv[i] = XF[i * 64 + lane];
            float run = 0.f;
#pragma unroll
            for (int i = 0; i < 64; ++i) { run += cv[i]; XF[i * 64 + lane] = run; } }
        __syncthreads();
        const f32x4 c0 = *(const LAS f32x4*)(XF + t * 64 + d0), c1 = *(const LAS f32x4*)(XF + t * 64 + d0 + 4);
        const f32x4 e0 = *(const LAS f32x4*)(XF + 63 * 64 + d0), e1 = *(const LAS f32x4*)(XF + 63 * 64 + d0 + 4);
        const float cum[8] = {c0[0], c0[1], c0[2], c0[3], c1[0], c1[1], c1[2], c1[3]};
        const float lwv[8] = {lw0[0], lw0[1], lw0[2], lw0[3], lw1[0], lw1[1], lw1[2], lw1[3]};
        const float c63[8] = {e0[0], e0[1], e0[2], e0[3], e1[0], e1[1], e1[2], e1[3]};
        const unsigned rw[4] = {rv.x, rv.y, rv.z, rv.w}, kw[4] = {kv.x, kv.y, kv.z, kv.w}, vw[4] = {vv.x, vv.y, vv.z, vv.w}, qw[4] = {kkv.x, kkv.y, kkv.z, kkv.w}, bw[4] = {bv.x, bv.y, bv.z, bv.w};
        float al[8], bt[8], kt[8], rb[8], bhh[8], khh[8], vf[8]; float bs = 0.f;
#pragma unroll
        for (int i = 0; i < 8; ++i) {
            const float r = (i & 1) ? bfhi(rw[i >> 1]) : bflo(rw[i >> 1]), k = (i & 1) ? bfhi(kw[i >> 1]) : bflo(kw[i >> 1]), v = (i & 1) ? bfhi(vw[i >> 1]) : bflo(vw[i >> 1]);
            const float kk = (i & 1) ? bfhi(qw[i >> 1]) : bflo(qw[i >> 1]), bb = (i & 1) ? bfhi(bw[i >> 1]) : bflo(bw[i >> 1]);
            const float ec = __expf(cum[i]), em = 1.f / ec, ep = __expf(cum[i] - lwv[i]), p63 = __expf(c63[i]);
            al[i] = -kk * ep; bt[i] = bb * em; kt[i] = k * em; rb[i] = r * ec; bhh[i] = bt[i] * p63; khh[i] = kt[i] * p63; vf[i] = v;
            bs += r * k * r_k[hd * 64 + d0 + i];
            if (t == 63) *(float*)(REC + (size_t)u * RC_REC + 24576 + (d0 + i) * 4) = p63;
        }
        bs += shfl_xor_l(bs, 1, lane); bs += shfl_xor_l(bs, 2, lane); bs += shfl_xor_l(bs, 4, lane);
        if ((tid & 7) == 0) BSUM[(t0 + t) * 4 + hd] = bs;
        u32x4 o;
        o.x = pk2(al[0], al[1]); o.y = pk2(al[2], al[3]); o.z = pk2(al[4], al[5]); o.w = pk2(al[6], al[7]); *(LAS u32x4*)(TILE(0) + t * 144 + d0 * 2) = o;
        o.x = pk2(bt[0], bt[1]); o.y = pk2(bt[2], bt[3]); o.z = pk2(bt[4], bt[5]); o.w = pk2(bt[6], bt[7]); *(LAS u32x4*)(TILE(1) + t * 144 + d0 * 2) = o;
        o.x = pk2(kt[0], kt[1]); o.y = pk2(kt[2], kt[3]); o.z = pk2(kt[4], kt[5]); o.w = pk2(kt[6], kt[7]); *(LAS u32x4*)(TILE(2) + t * 144 + d0 * 2) = o;
        o.x = pk2(rb[0], rb[1]); o.y = pk2(rb[2], rb[3]); o.z = pk2(rb[4], rb[5]); o.w = pk2(rb[6], rb[7]); *(LAS u32x4*)(TILE(3) + t * 144 + d0 * 2) = o;
#pragma unroll
        for (int i = 0; i < 8; ++i) { *(LAS bf16_t*)(TILE(4) + (d0 + i) * 144 + t * 2) = (bf16_t)f2bf(vf[i]); *(LAS bf16_t*)(TILE(5) + (d0 + i) * 144 + t * 2) = (bf16_t)f2bf(bhh[i]);
            *(LAS bf16_t*)(TILE(6) + (d0 + i) * 144 + t * 2) = (bf16_t)f2bf(khh[i]); *(LAS bf16_t*)(TILE(7) + (d0 + i) * 144 + t * 2) = (bf16_t)f2bf(al[i]); }
        }
        __syncthreads();
        f32x16 Tacc = zero16();
        {
        int tl = F.tid; asm volatile("" : "+v"(tl)); const int lane = tl & 63, lr = lane & 31, h2 = lane >> 5;
        unsigned zz = 0u; asm volatile("" : "+v"(zz));
        for (int i = tl; i < 768; i += NTHR) { const int q = i >> 7, rr = (i & 127) >> 2, cc = i & 3; const int tile = q < 4 ? 8 + q : q == 4 ? 14 : 12;
            *(LAS u32x4*)(TILE(tile) + (q == 5 ? (32 + rr) * 144 : rr * 144 + 64) + cc * 16) = (u32x4){zz, zz, zz, zz}; }
#pragma unroll
        for (int rnd = 0; rnd < 2; ++rnd) {
            const int j = w + 8 * rnd;
            if (j < 15) {
                const int prod = j / 3, tile = j % 3, si = tile == 2 ? 1 : 0, ti = tile == 0 ? 0 : 1;
                if (prod == 1) {
                    f32x16 acc = tileprod(TILE(0), 32 * ti, TILE(1), 32 * si, zero16(), lr, h2);
                    const int ss = 32 * si + lr;
#pragma unroll
                    for (int q = 0; q < 16; ++q) { const int tt = 32 * ti + 8 * (q >> 2) + 4 * h2 + (q & 3); if (!(ss < tt)) acc[q] = 0.f; }
                    put_tile(TILE(12), 32 * si, 32 * ti, acc, lr, h2);
                } else {
                    const LAS unsigned char* Ao = (prod == 0 || prod == 3) ? TILE(1) : TILE(2); const LAS unsigned char* Bo = prod >= 3 ? TILE(3) : TILE(0);
                    f32x16 acc = tileprod(Ao, 32 * si, Bo, 32 * ti, zero16(), lr, h2);
                    const int tt = 32 * ti + lr, incl = prod >= 3 ? 1 : 0;
#pragma unroll
                    for (int q = 0; q < 16; ++q) { const int ss = 32 * si + 8 * (q >> 2) + 4 * h2 + (q & 3); if (!(ss < tt + incl)) acc[q] = 0.f; }
                    if (prod == 0) { put_tile(TILE(11), 32 * ti, 32 * si, acc, lr, h2);
#pragma unroll
                        for (int q = 0; q < 16; ++q) { const int ss = 32 * si + 8 * (q >> 2) + 4 * h2 + (q & 3); Tacc[q] = acc[q] + (ss == tt ? 1.f : 0.f); }
                        put_tile(TILE(14), 32 * ti, 32 * si, Tacc, lr, h2);
                    } else put_tile(TILE(prod == 2 ? 8 : prod == 3 ? 9 : 10), 32 * ti, 32 * si, acc, lr, h2);
                }
            }
        }
        }
        __syncthreads();
        {
        int tl = F.tid; asm volatile("" : "+v"(tl)); const int lane = tl & 63, lr = lane & 31, h2 = lane >> 5;
        if (tl < 384) { const int q = tl >> 7, rr = (tl & 127) >> 2, cc = tl & 3;
            unsigned zz = 0u; asm volatile("" : "+v"(zz));
            *(LAS u32x4*)(TILE(q) + (q == 1 ? (32 + rr) * 144 : rr * 144 + 64) + cc * 16) = (u32x4){zz, zz, zz, zz}; }
        __syncthreads();
#pragma unroll
        for (int k = 1; k <= 5; ++k) {
            LAS unsigned char* Ss = (k & 1) ? TILE(11) : TILE(0); LAS unsigned char* STs = (k & 1) ? TILE(12) : TILE(1);
            LAS unsigned char* Sd = (k & 1) ? TILE(0) : TILE(11); LAS unsigned char* STd = (k & 1) ? TILE(1) : TILE(12);
            LAS unsigned char* Ts = (k & 1) ? TILE(14) : TILE(2); LAS unsigned char* Td = (k & 1) ? TILE(2) : TILE(14);
            if (w < 6) { const int tile = w % 3, ti = tile == 0 ? 0 : 1, si = tile == 2 ? 1 : 0;
                if (w < 3) { f32x16 acc = tileprod(Ss, 32 * ti, STs, 32 * si, zero16(), lr, h2); put_tile(STd, 32 * si, 32 * ti, acc, lr, h2); }
                else { f32x16 acc = tileprod(STs, 32 * si, Ss, 32 * ti, zero16(), lr, h2); put_tile(Sd, 32 * ti, 32 * si, acc, lr, h2); }
            } else if (k == 1) {
#pragma unroll
                for (int jj = 0; jj < 2; ++jj) { const int tile = (w - 6) * 2 + jj, ti = tile >> 1, ei = tile & 1;
                    f32x16 acc = tileprod(TILE(8), 32 * ti, TILE(4), 32 * ei, zero16(), lr, h2); put_tile(TILE(13), 32 * ei, 32 * ti, acc, lr, h2); }
            }
            __syncthreads();
            if (w < 3) { const int si = w == 2 ? 1 : 0, ti = w == 0 ? 0 : 1;
                Tacc = tileprod(STd, 32 * si, Ts, 32 * ti, Tacc, lr, h2); put_tile(Td, 32 * ti, 32 * si, Tacc, lr, h2); }
        }
        __syncthreads();
        { const int tile = w & 3, ti = tile >> 1, ci = tile & 1;
          f32x16 acc = tileprod(TILE(2), 32 * ti, w < 4 ? TILE(13) : TILE(7), 32 * ci, zero16(), lr, h2); put_tile(w < 4 ? TILE(11) : TILE(12), 32 * ci, 32 * ti, acc, lr, h2); }
        }
        __syncthreads();
        {
        int tl = F.tid; asm volatile("" : "+v"(tl)); const int lane = tl & 63, lr = lane & 31, h2 = lane >> 5; const int tj = w & 3, ta = tj >> 1, tb = tj & 1;
        if (w < 4) {
            { f32x16 acc = tileprod(TILE(12), 32 * ta, TILE(9), 32 * tb, zero16(), lr, h2);
              const int tt = 32 * tb + lr;
#pragma unroll
              for (int g = 0; g < 4; ++g) { const int dd = 32 * ta + 8 * g + 4 * h2; const u32x2 rbv = *(const LAS u32x2*)(TILE(3) + tt * 144 + dd * 2);
                  u32x2 o; o.x = pk2(acc[4 * g] + bflo(rbv.x), acc[4 * g + 1] + bfhi(rbv.x)); o.y = pk2(acc[4 * g + 2] + bflo(rbv.y), acc[4 * g + 3] + bfhi(rbv.y));
                  *(u32x2*)(RP + ((size_t)u * 64 + tt) * 64 + dd) = o; } }
            { f32x16 acc = tileprod(TILE(12), 32 * ta, TILE(5), 32 * tb, zero16(), lr, h2);
              const int dcol = 32 * tb + lr;
#pragma unroll
              for (int g = 0; g < 4; ++g) { u32x2 o; o.x = pk2(acc[4 * g], acc[4 * g + 1]); o.y = pk2(acc[4 * g + 2], acc[4 * g + 3]);
                  *(u32x2*)(REC + (size_t)u * RC_REC + ((((dcol >> 4) * 2 + ta) * 64 + (2 * (g & 1) + h2) * 16 + (dcol & 15)) * 16) + 8 * (g >> 1)) = o; } }
        } else {
            f32x16 z2 = tileprod(TILE(4), 32 * ta, TILE(10), 32 * tb, zero16(), lr, h2);
            z2 = tileprod(TILE(11), 32 * ta, TILE(9), 32 * tb, z2, lr, h2);
            float* yo = Y0T + ((size_t)u * 64 + 32 * tb + lr) * 64 + 32 * ta + 4 * h2;
#pragma unroll
            for (int g = 0; g < 4; ++g) *(f32x4*)(yo + 8 * g) = (f32x4){z2[4 * g], z2[4 * g + 1], z2[4 * g + 2], z2[4 * g + 3]};
            f32x16 acc = tileprod(TILE(5), 32 * ta, TILE(11), 32 * tb, zero16(), lr, h2);
            acc = tileprod(TILE(6), 32 * ta, TILE(4), 32 * tb, acc, lr, h2);
            const int ecol = 32 * tb + lr;
#pragma unroll
            for (int g = 0; g < 4; ++g) *(f32x4*)(REC + (size_t)u * RC_REC + 8192 + ((((ecol >> 4) * 4 + 2 * ta + (g >> 1)) * 64 + (2 * (g & 1) + h2) * 16 + (ecol & 15)) * 16)) = (f32x4){acc[4 * g], acc[4 * g + 1], acc[4 * g + 2], acc[4 * g + 3]};
        }
        }
        __syncthreads();
    }
#undef TILE
}
DI void phase_rwkv_B(const Frame& F, CArgs& A) {
    if (F.bid >= 32) return;
    const unsigned char* REC = A.ws + WS_RC_G; bf16_t* HB = (bf16_t*)(A.ws + WS_RC_HB);
    constexpr int SLOT = 25600, NSLOT = 4;
    const int bh = F.bid, w = F.wave, lane = F.lane, fr = lane & 15, fq = lane >> 4;
    const unsigned char* rec0 = REC + (size_t)bh * 128 * RC_REC;
    if (w >= 4) {
        const int lw = w - 4;
#define RB_ISSUE2(cs, cr) do { const unsigned char* r_ = rec0 + (size_t)(cr) * RC_REC; LAS unsigned char* s_ = F.lds + ((cs) & (NSLOT - 1)) * SLOT; \
        _Pragma("unroll") for (int k = 0; k < 6; ++k) __builtin_amdgcn_global_load_lds((const unsigned*)(r_ + (lw + 4 * k) * 1024 + lane * 16), (LAS unsigned*)(s_ + (lw + 4 * k) * 1024), 16, 0, 0); \
        if (lw == 3) __builtin_amdgcn_global_load_lds((const unsigned*)(r_ + 24576 + lane * 4), (LAS unsigned*)(s_ + 24576), 4, 0, 0); } while (0)
        RB_ISSUE2(0, 0); RB_ISSUE2(1, 1); RB_ISSUE2(2, 2);
        if (lw == 3) asm volatile("s_waitcnt vmcnt(14)" ::: "memory"); else asm volatile("s_waitcnt vmcnt(12)" ::: "memory");
        __builtin_amdgcn_s_barrier();
        for (int c = 0; c < 128; ++c) {
            RB_ISSUE2(c + 3, (c + 3 < 128) ? c + 3 : 127);
            if (lw == 3) asm volatile("s_waitcnt vmcnt(14)" ::: "memory"); else asm volatile("s_waitcnt vmcnt(12)" ::: "memory");
            __builtin_amdgcn_s_barrier();
        }
        asm volatile("s_waitcnt vmcnt(0)" ::: "memory");
#undef RB_ISSUE2
    } else {
        const int ew = w;
        f32x4 acc[4];
#pragma unroll
        for (int dt = 0; dt < 4; ++dt) acc[dt] = (f32x4){0.f, 0.f, 0.f, 0.f};
        __builtin_amdgcn_s_barrier();
        for (int c = 0; c < 128; ++c) {
            const size_t u = (size_t)bh * 128 + c;
            const LAS unsigned char* sl = F.lds + (c & (NSLOT - 1)) * SLOT;
            bf16x8 hb[2];
#pragma unroll
            for (int sk = 0; sk < 2; ++sk) { u32x4 p; p.x = pk2(acc[2 * sk][0], acc[2 * sk][1]); p.y = pk2(acc[2 * sk][2], acc[2 * sk][3]); p.z = pk2(acc[2 * sk + 1][0], acc[2 * sk + 1][1]); p.w = pk2(acc[2 * sk + 1][2], acc[2 * sk + 1][3]);
                hb[sk] = __builtin_bit_cast(bf16x8, p); *(bf16x8*)(HB + (((u * 4 + ew) * 2 + sk) * 64 + lane) * 8) = hb[sk]; }
#pragma unroll
            for (int dt = 0; dt < 4; ++dt) {
                const f32x4 g4 = *(const LAS f32x4*)(sl + 8192 + ((ew * 4 + dt) * 64 + lane) * 16), d4 = *(const LAS f32x4*)(sl + 24576 + (16 * dt + 4 * fq) * 4);
                const bf16x8 m0 = *(const LAS bf16x8*)(sl + ((dt * 2 + 0) * 64 + lane) * 16), m1 = *(const LAS bf16x8*)(sl + ((dt * 2 + 1) * 64 + lane) * 16);
                f32x4 n = d4 * acc[dt] + g4;
                n = __builtin_amdgcn_mfma_f32_16x16x32_bf16(m0, hb[0], n, 0, 0, 0); n = __builtin_amdgcn_mfma_f32_16x16x32_bf16(m1, hb[1], n, 0, 0, 0); acc[dt] = n; }
            asm volatile("s_waitcnt lgkmcnt(0)" ::: "memory");
            __builtin_amdgcn_s_barrier();
        }
    }
}
DI void phase_rwkv_C(const Frame& F, CArgs& A, int l) {
    const bf16_t* RP = (const bf16_t*)(A.ws + WS_RC_RP); const float* Y0 = (const float*)(A.ws + WS_RC_Y0); const bf16_t* HB = (const bf16_t*)(A.ws + WS_RC_HB); const float* BSUM = (const float*)(A.ws + WS_RC_BS);
    const bf16_t* V_ = (const bf16_t*)(A.ws + WS_RW_V); const bf16_t* G_ = (const bf16_t*)(A.ws + WS_RW_G); bf16_t* MIX = (bf16_t*)(A.ws + WS_MIX);
    const float* ln_w = A.in[16] + l * 256; const float* ln_b = A.in[17] + l * 256;
    for (int job = F.gw; job < 4096; job += F.ngw) {
        int lz = F.lane; asm volatile("" : "+v"(lz)); const int lane = lz, fr = lane & 15, fq = lane >> 4;
        const size_t u = (size_t)job; const int bh = job >> 7, c = job & 127, b = bh >> 2, hd = bh & 3;
        bf16x8 hf[4][2];
#pragma unroll
        for (int et = 0; et < 4; ++et)
#pragma unroll
            for (int sk = 0; sk < 2; ++sk) hf[et][sk] = *(const bf16x8*)(HB + (((u * 4 + et) * 2 + sk) * 64 + lane) * 8);
#pragma unroll
        for (int tb = 0; tb < 4; ++tb) {
            const size_t tok = (size_t)b * SEQ + 64 * c + 16 * tb + fr;
            const bf16_t* rrow = RP + (u * 64 + 16 * tb + fr) * 64 + 4 * fq;
            bf16x8 bfr[2];
#pragma unroll
            for (int sk = 0; sk < 2; ++sk) { const u32x2 m0 = *(const u32x2*)(rrow + 32 * sk), m1 = *(const u32x2*)(rrow + 32 * sk + 16); u32x4 mw; mw.x = m0.x; mw.y = m0.y; mw.z = m1.x; mw.w = m1.y; bfr[sk] = __builtin_bit_cast(bf16x8, mw); }
            f32x4 y[4]; float sm = 0.f;
#pragma unroll
            for (int et = 0; et < 4; ++et) { y[et] = *(const f32x4*)(Y0 + (u * 64 + 16 * tb + fr) * 64 + 16 * et + 4 * fq);
                y[et] = __builtin_amdgcn_mfma_f32_16x16x32_bf16(hf[et][0], bfr[0], y[et], 0, 0, 0); y[et] = __builtin_amdgcn_mfma_f32_16x16x32_bf16(hf[et][1], bfr[1], y[et], 0, 0, 0); }
#pragma unroll
            for (int et = 0; et < 4; ++et) sm += (y[et][0] + y[et][1]) + (y[et][2] + y[et][3]);
            sm += shfl_xor_l(sm, 16, lane); sm += shfl_xor_l(sm, 32, lane); const float mean = sm * (1.f / 64.f);
            float sq = 0.f;
#pragma unroll
            for (int et = 0; et < 4; ++et) { const f32x4 d = y[et] - mean; sq += (d[0] * d[0] + d[1] * d[1]) + (d[2] * d[2] + d[3] * d[3]); }
            sq += shfl_xor_l(sq, 16, lane); sq += shfl_xor_l(sq, 32, lane); const float rstd = rsqrtf(sq * (1.f / 64.f) + 64e-5f);
            const float bs = BSUM[tok * 4 + hd];
#pragma unroll
            for (int et = 0; et < 4; ++et) { const int e0 = hd * 64 + 16 * et + 4 * fq;
                const f32x4 lw = *(const f32x4*)(ln_w + e0), lb = *(const f32x4*)(ln_b + e0);
                const u32x2 vv = *(const u32x2*)(V_ + tok * 256 + e0), gv = *(const u32x2*)(G_ + tok * 256 + e0);
                const float o0 = ((y[et][0] - mean) * rstd * lw[0] + lb[0] + bs * bflo(vv.x)) * bflo(gv.x), o1 = ((y[et][1] - mean) * rstd * lw[1] + lb[1] + bs * bfhi(vv.x)) * bfhi(gv.x);
                const float o2 = ((y[et][2] - mean) * rstd * lw[2] + lb[2] + bs * bflo(vv.y)) * bflo(gv.y), o3 = ((y[et][3] - mean) * rstd * lw[3] + lb[3] + bs * bfhi(vv.y)) * bfhi(gv.y);
                u32x2 o; o.x = pk2(o0, o1); o.y = pk2(o2, o3);
                *(u32x2*)(MIX + tok * DM + e0) = o; }
        }
    }
}

template <int PASS>
DI void phase_s5(const Frame& F, CArgs& A, int l) {
    const bf16_t* Z = (const bf16_t*)(A.ws + WS_Z); float* SEND = (float*)(A.ws + WS_S5END); bf16_t* YS = (bf16_t*)(A.ws + WS_YS5);
    const bf16_t* BBt = (const bf16_t*)(A.ws + WS_S5BB); const bf16_t* CCt = (const bf16_t*)(A.ws + WS_S5CC);
    LAS unsigned char* himg = F.lds + F.wave * 17408;
    for (int it = F.gw; it < 8 * 16 * 16; it += F.ngw) {
        int lz = F.lane; asm volatile("" : "+v"(lz)); const int lane = lz, lr = lane & 31, hh = lane >> 5;
        const int b = it >> 8, g = (it >> 4) & 15, seg = it & 15, lg = l * 16 + g;
        const float dt = __expf(A.in[25][lg]);
        float are[2], aim[2], cr[2], ci[2];
        bf16x8 bbf[2][2];
#pragma unroll
        for (int st = 0; st < 2; ++st) { const int p = 32 * st + lr;
            const float lre = A.in[18][lg * 64 + p], lim = A.in[19][lg * 64 + p]; const float mag = expf(lre * dt); float sn, cn; sincosf(lim * dt, &sn, &cn); are[st] = mag * cn; aim[st] = mag * sn;
            cr[st] = 0.f; ci[st] = 0.f;
            if (PASS == 2) { const float m512 = expf(512.f * lre * dt); float s5, c5; sincosf(512.f * (lim * dt), &s5, &c5); const float pr = m512 * c5, pi_ = m512 * s5;
                for (int j = 0; j < seg; ++j) { const float* e = SEND + ((size_t)((b * 16 + g) * 16 + j)) * 128; const float er = e[p], ei = e[64 + p];
                    const float nr = pr * cr[st] - pi_ * ci[st] + er, ni = pr * ci[st] + pi_ * cr[st] + ei; cr[st] = nr; ci[st] = ni; } }
#pragma unroll
            for (int part = 0; part < 2; ++part) bbf[part][st] = *(const bf16x8*)(BBt + (((size_t)lg * 2 + part) * 64 + p) * 16 + 8 * hh); }
        bf16x8 ccf[4];
        if (PASS == 2) {
#pragma unroll
            for (int ks = 0; ks < 4; ++ks) ccf[ks] = *(const bf16x8*)(CCt + ((size_t)lg * 16 + (lane & 15)) * 128 + 32 * ks + 8 * (lane >> 4)); }
        for (int ch = 0; ch < 8; ++ch) {
            const size_t tok0 = (size_t)b * SEQ + seg * 512 + ch * 64;
            const bf16_t* zb = Z + tok0 * ZS + ZC_S5 + g * 16;
#pragma unroll
            for (int tk = 0; tk < 2; ++tk) {
                const bf16x8 uf = *(const bf16x8*)(zb + (size_t)(32 * tk + lr) * ZS + 8 * hh);
                f32x16 xr[2], xi[2];
#pragma unroll
                for (int st = 0; st < 2; ++st) { xr[st] = mfma32(uf, bbf[0][st], zero16()); xi[st] = mfma32(uf, bbf[1][st], zero16()); }
                asm volatile("s_nop 15\n\ts_nop 15" : "+v"(xr[0]), "+v"(xi[0]), "+v"(xr[1]), "+v"(xi[1]));
#pragma unroll
                for (int j = 0; j < 4; ++j) {
#pragma unroll
                    for (int half = 0; half < 2; ++half) {
                        const bool act = (hh == half);
#pragma unroll
                        for (int st = 0; st < 2; ++st) { float tr = cr[st], ti = ci[st];
#pragma unroll
                            for (int q = 0; q < 4; ++q) { const float nr = are[st] * tr - aim[st] * ti + xr[st][4 * j + q], ni = are[st] * ti + aim[st] * tr + xi[st][4 * j + q];
                                tr = nr; ti = ni; xr[st][4 * j + q] = act ? nr : xr[st][4 * j + q]; xi[st][4 * j + q] = act ? ni : xi[st][4 * j + q]; }
                            const float pr = shfl_xor_l(tr, 32, lane), pi2 = shfl_xor_l(ti, 32, lane);
                            cr[st] = act ? tr : pr; ci[st] = act ? ti : pi2; }
                    }
                }
                if (PASS == 2) {
                    unsigned hb = (unsigned)(uintptr_t)(himg + (4 * hh) * 272 + lr * 2); asm volatile("" : "+v"(hb));
                    LAS unsigned char* hp = (LAS unsigned char*)(uintptr_t)hb;
#pragma unroll
                    for (int st = 0; st < 2; ++st)
#pragma unroll
                        for (int q = 0; q < 16; ++q) { const int trow = 32 * tk + 8 * (q >> 2) + (q & 3);
                            *(LAS bf16_t*)(hp + trow * 272 + 64 * st) = (bf16_t)f2bf(xr[st][q]); *(LAS bf16_t*)(hp + trow * 272 + 128 + 64 * st) = (bf16_t)f2bf(xi[st][q]); }
                }
            }
            if (PASS == 2) {
                asm volatile("s_waitcnt lgkmcnt(0)" ::: "memory");
                const int fr = lane & 15, fq = lane >> 4;
                unsigned rb = (unsigned)(uintptr_t)(himg + fr * 272 + fq * 16); asm volatile("" : "+v"(rb)); const LAS unsigned char* rp = (const LAS unsigned char*)(uintptr_t)rb;
#pragma unroll
                for (int m = 0; m < 4; ++m) { f32x4 acc = {0.f, 0.f, 0.f, 0.f};
#pragma unroll
                    for (int ks = 0; ks < 4; ++ks) acc = __builtin_amdgcn_mfma_f32_16x16x32_bf16(ccf[ks], *(const LAS bf16x8*)(rp + (16 * m) * 272 + 64 * ks), acc, 0, 0, 0);
                    const size_t tok = tok0 + 16 * m + fr;
                    const u32x2 uu = *(const u32x2*)(Z + tok * ZS + ZC_S5 + g * 16 + 4 * fq);
                    const f32x4 dd = *(const f32x4*)(A.in[24] + l * 256 + g * 16 + 4 * fq);
                    u32x2 o; o.x = pk2(gelu_tanh(acc[0] + dd[0] * bflo(uu.x)), gelu_tanh(acc[1] + dd[1] * bfhi(uu.x))); o.y = pk2(gelu_tanh(acc[2] + dd[2] * bflo(uu.y)), gelu_tanh(acc[3] + dd[3] * bfhi(uu.y)));
                    *(u32x2*)(YS + tok * 256 + g * 16 + 4 * fq) = o; }
                asm volatile("s_waitcnt lgkmcnt(0)" ::: "memory");
            }
        }
        if (PASS == 1 && hh == 1) {
#pragma unroll
            for (int st = 0; st < 2; ++st) { float* e = SEND + ((size_t)((b * 16 + g) * 16 + seg)) * 128; e[32 * st + lr] = cr[st]; e[64 + 32 * st + lr] = ci[st]; } }
    }
}

DI void phase_lru_prep(const Frame& F, CArgs& A, int l) {
    const bf16_t* Z = (const bf16_t*)(A.ws + WS_Z); float* LA = (float*)(A.ws + WS_LA); float* LB = (float*)(A.ws + WS_LB);
    const float* cw = A.in[34] + l * 4 * 256; const float* cb = A.in[35] + l * 256; const float* ba = A.in[37] + l * 256; const float* bx = A.in[39] + l * 256; const float* lam = A.in[40] + l * 256;
    const bf16_t* WL = (const bf16_t*)(A.ws + WS_WLRU) + (size_t)l * 2 * 4 * 4096;
    LAS float* xs = (LAS float*)F.lds;
    const int w = F.wave, n = w >> 1, hf = w & 1;
    bf16x8 waf[2][2], wxf[2][2];
    { const int fr = F.lane & 15, fq = F.lane >> 4;
#pragma unroll
      for (int nf = 0; nf < 2; ++nf)
#pragma unroll
          for (int ks = 0; ks < 2; ++ks) { const int j = 32 * hf + 16 * nf + fr;
              waf[nf][ks] = *(const bf16x8*)(WL + ((size_t)(0 * 4 + n) * 64 + j) * 64 + 32 * ks + 8 * fq); wxf[nf][ks] = *(const bf16x8*)(WL + ((size_t)(1 * 4 + n) * 64 + j) * 64 + 32 * ks + 8 * fq); } }
    for (int tile = F.bid; tile < T / 64; tile += F.G) {
        int tz = F.tid; asm volatile("" : "+v"(tz)); const int lane = tz & 63, fr = lane & 15, fq = lane >> 4;
        const int t0 = tile * 64, s0 = t0 % SEQ;
        f32x4 accA[4][2], accX[4][2];
#pragma unroll
        for (int m = 0; m < 4; ++m) {
            const int tok = 16 * m + fr, sq = s0 + tok;
            bf16x8 xf[2];
#pragma unroll
            for (int ks = 0; ks < 2; ++ks) { const int ch0 = n * 64 + 32 * ks + 8 * fq;
                const f32x4 b0 = *(const f32x4*)(cb + ch0), b1 = *(const f32x4*)(cb + ch0 + 4);
                float xc[8] = {b0[0], b0[1], b0[2], b0[3], b1[0], b1[1], b1[2], b1[3]};
#pragma unroll
                for (int j = 0; j < 4; ++j) if (sq - 3 + j >= 0) {
                    const u32x4 z8 = *(const u32x4*)(Z + (size_t)(t0 + tok - 3 + j) * ZS + ZC_LX + ch0);
                    const f32x4 c0 = *(const f32x4*)(cw + j * 256 + ch0), c1 = *(const f32x4*)(cw + j * 256 + ch0 + 4);
                    xc[0] += c0[0] * bflo(z8.x); xc[1] += c0[1] * bfhi(z8.x); xc[2] += c0[2] * bflo(z8.y); xc[3] += c0[3] * bfhi(z8.y);
                    xc[4] += c1[0] * bflo(z8.z); xc[5] += c1[1] * bfhi(z8.z); xc[6] += c1[2] * bflo(z8.w); xc[7] += c1[3] * bfhi(z8.w); }
                u32x4 o; o.x = pk2(xc[0], xc[1]); o.y = pk2(xc[2], xc[3]); o.z = pk2(xc[4], xc[5]); o.w = pk2(xc[6], xc[7]); xf[ks] = __builtin_bit_cast(bf16x8, o);
                if (hf == 0) { *(LAS f32x4*)(xs + tok * 260 + ch0) = (f32x4){xc[0], xc[1], xc[2], xc[3]}; *(LAS f32x4*)(xs + tok * 260 + ch0 + 4) = (f32x4){xc[4], xc[5], xc[6], xc[7]}; }
            }
#pragma unroll
            for (int nf = 0; nf < 2; ++nf) { const f32x4 z4 = {0.f, 0.f, 0.f, 0.f};
                accA[m][nf] = __builtin_amdgcn_mfma_f32_16x16x32_bf16(waf[nf][0], xf[0], z4, 0, 0, 0); accA[m][nf] = __builtin_amdgcn_mfma_f32_16x16x32_bf16(waf[nf][1], xf[1], accA[m][nf], 0, 0, 0);
                accX[m][nf] = __builtin_amdgcn_mfma_f32_16x16x32_bf16(wxf[nf][0], xf[0], z4, 0, 0, 0); accX[m][nf] = __builtin_amdgcn_mfma_f32_16x16x32_bf16(wxf[nf][1], xf[1], accX[m][nf], 0, 0, 0); }
        }
        __syncthreads();
#pragma unroll
        for (int m = 0; m < 4; ++m)
#pragma unroll
            for (int nf = 0; nf < 2; ++nf) { const int tok = 16 * m + fr, ch4 = n * 64 + 32 * hf + 16 * nf + 4 * fq;
                const f32x4 xc = *(const LAS f32x4*)(xs + tok * 260 + ch4), b_a = *(const f32x4*)(ba + ch4), b_x = *(const f32x4*)(bx + ch4), lm = *(const f32x4*)(lam + ch4);
                f32x4 av, bv;
#pragma unroll
                for (int i = 0; i < 4; ++i) { const float r = sigmoidf_(accA[m][nf][i] + b_a[i]), ig = sigmoidf_(accX[m][nf][i] + b_x[i]); const float log_a = -8.f * r * softplusf_(-lm[i]);
                    av[i] = __expf(log_a); bv[i] = sqrtf(-expm1f(2.f * log_a)) * (ig * xc[i]); }
                *(f32x4*)(LA + (size_t)(t0 + tok) * 256 + ch4) = av; *(f32x4*)(LB + (size_t)(t0 + tok) * 256 + ch4) = bv; }
        __syncthreads();
    }
}
DI void phase_lru_sum(const Frame& F, CArgs& A) {
    const float* LA = (const float*)(A.ws + WS_LA); const float* LB = (const float*)(A.ws + WS_LB); float* LS = (float*)(A.ws + WS_LSUM);
    for (int it = F.gw; it < 8 * 128; it += F.ngw) {
        const size_t r0 = (size_t)it * 64;
        f32x4 Ap = {1.f, 1.f, 1.f, 1.f}, Bp = {0.f, 0.f, 0.f, 0.f};
#pragma unroll 8
        for (int t = 0; t < 64; ++t) { const f32x4 a = *(const f32x4*)(LA + (r0 + t) * 256 + 4 * F.lane), bb = *(const f32x4*)(LB + (r0 + t) * 256 + 4 * F.lane); Bp = a * Bp + bb; Ap = Ap * a; }
        *(f32x4*)(LS + ((size_t)it * 2) * 256 + 4 * F.lane) = Ap; *(f32x4*)(LS + ((size_t)it * 2 + 1) * 256 + 4 * F.lane) = Bp;
    }
}
DI void phase_lru_fin(const Frame& F, CArgs& A) {
    const float* LA = (const float*)(A.ws + WS_LA); const float* LB = (const float*)(A.ws + WS_LB); const float* LS = (const float*)(A.ws + WS_LSUM);
    const bf16_t* Z = (const bf16_t*)(A.ws + WS_Z); bf16_t* YL = (bf16_t*)(A.ws + WS_YL);
    for (int it = F.gw; it < 8 * 128; it += F.ngw) {
        const int b = it >> 7, c = it & 127;
        f32x4 h = {0.f, 0.f, 0.f, 0.f};
        for (int j = 0; j < c; ++j) { const f32x4 a = *(const f32x4*)(LS + ((size_t)(b * 128 + j) * 2) * 256 + 4 * F.lane), bb = *(const f32x4*)(LS + ((size_t)(b * 128 + j) * 2 + 1) * 256 + 4 * F.lane); h = a * h + bb; }
        const size_t r0 = (size_t)it * 64;
#pragma unroll 4
        for (int t = 0; t < 64; ++t) { const f32x4 a = *(const f32x4*)(LA + (r0 + t) * 256 + 4 * F.lane), bb = *(const f32x4*)(LB + (r0 + t) * 256 + 4 * F.lane); h = a * h + bb;
            const u32x2 gz = *(const u32x2*)(Z + (r0 + t) * ZS + ZC_LG + 4 * F.lane);
            u32x2 o; o.x = pk2(h[0] * gelu_tanh(bflo(gz.x)), h[1] * gelu_tanh(bfhi(gz.x))); o.y = pk2(h[2] * gelu_tanh(bflo(gz.y)), h[3] * gelu_tanh(bfhi(gz.y)));
            *(u32x2*)(YL + (r0 + t) * 256 + 4 * F.lane) = o; }
    }
}

DI void phase_branch_norm(const Frame& F, CArgs& A, int l) {
    const bf16_t* S0 = (const bf16_t*)(A.ws + WS_YS5G); const bf16_t* S1 = (const bf16_t*)(A.ws + WS_ATTO); const bf16_t* S2 = (const bf16_t*)(A.ws + WS_YL);
    bf16_t* MIX = (bf16_t*)(A.ws + WS_MIX); const float* bg = A.in[41] + l * 768;
    for (int row = F.gw; row < T; row += F.ngw) {
#pragma unroll
        for (int br = 0; br < 3; ++br) { const bf16_t* S = br == 0 ? S0 : br == 1 ? S1 : S2;
            const u32x2 v = *(const u32x2*)(S + (size_t)row * 256 + 4 * F.lane);
            const float x0 = bflo(v.x), x1 = bfhi(v.x), x2 = bflo(v.y), x3 = bfhi(v.y);
            const float r = rsqrtf(wave_sum(x0 * x0 + x1 * x1 + x2 * x2 + x3 * x3) * (1.f / 256.f) + NORM_EPS);
            const f32x4 g = *(const f32x4*)(bg + br * 256 + 4 * F.lane);
            u32x2 o; o.x = pk2(x0 * r * g[0], x1 * r * g[1]); o.y = pk2(x2 * r * g[2], x3 * r * g[3]);
            *(u32x2*)(MIX + (size_t)row * DM + 256 * (br + 1) + 4 * F.lane) = o; }
    }
}

DI void phase_norm2_router(const Frame& F, CArgs& A, int l) {
    const float* MODL = (const float*)(A.ws + WS_MOD) + (size_t)l * 8 * 6144;
    const float* g = A.in[43] + l * 1024;
    bf16_t* H = (bf16_t*)(A.ws + WS_H);
    int* EID = (int*)(A.ws + WS_RT_EID); float* GATE = (float*)(A.ws + WS_RT_GATE); int* PIE = (int*)(A.ws + WS_RT_PIE);
    unsigned* CNT = (unsigned*)(A.ws + WS_CTL) + CW_CNT + l * 64;
    const bf16_t* WRh = (const bf16_t*)(A.ws + WS_WR) + (size_t)(l * 2) * 48 * 1024; const bf16_t* WRl = WRh + 48 * 1024;
    LAS float* part = (LAS float*)F.lds;
    LAS float* red = part + 8 * 64 * 48;
    LAS float* lsum = red + 8 * 64;
    LAS unsigned* lcnt = (LAS unsigned*)(lsum + 64 * 36);
    LAS int* lsel = (LAS int*)(lcnt + 64);
    const float* bgp = A.in[45] + l * 4; const float* bep = A.in[47] + l * 32;
    const int w = F.wave, k0 = 128 * w;
    bf16x8 bh[3][4], bl[3][4];
    { const int fr = F.lane & 15, fq = F.lane >> 4;
#pragma unroll
      for (int n = 0; n < 3; ++n)
#pragma unroll
          for (int ks = 0; ks < 4; ++ks) { bh[n][ks] = *(const bf16x8*)(WRh + (size_t)(16 * n + fr) * 1024 + k0 + 32 * ks + 8 * fq); bl[n][ks] = *(const bf16x8*)(WRl + (size_t)(16 * n + fr) * 1024 + k0 + 32 * ks + 8 * fq); } }
    for (int tile = F.bid; tile < T / 64; tile += F.G) {
        int tz = F.tid; asm volatile("" : "+v"(tz)); const int lane = tz & 63, fr = lane & 15, fq = lane >> 4;
        const int row0 = tile * 64, b = row0 / SEQ;
        const float* xb = A.out + (size_t)(row0 + fr) * DM + k0 + 8 * fq;
        float ss[4];
#pragma unroll
        for (int m = 0; m < 4; ++m) { float a = 0.f;
#pragma unroll
            for (int ks = 0; ks < 4; ++ks) { const f32x4 x0 = *(const f32x4*)(xb + (size_t)(16 * m) * DM + 32 * ks), x1 = *(const f32x4*)(xb + (size_t)(16 * m) * DM + 32 * ks + 4);
                a += x0[0] * x0[0] + x0[1] * x0[1] + x0[2] * x0[2] + x0[3] * x0[3] + x1[0] * x1[0] + x1[1] * x1[1] + x1[2] * x1[2] + x1[3] * x1[3]; }
            a += shfl_xor_l(a, 16, lane); a += shfl_xor_l(a, 32, lane); ss[m] = a; }
        if (fq == 0) {
#pragma unroll
            for (int m = 0; m < 4; ++m) red[w * 64 + 16 * m + fr] = ss[m]; }
        if (tz < 32) lcnt[tz] = 0u;
        __syncthreads();
        f32x4 acc[4][3];
#pragma unroll
        for (int m = 0; m < 4; ++m) { float tot = 0.f;
#pragma unroll
            for (int ww = 0; ww < 8; ++ww) tot += red[ww * 64 + 16 * m + fr];
            const float rstd = rsqrtf(tot * (1.f / DM) + NORM_EPS);
#pragma unroll
            for (int n = 0; n < 3; ++n) acc[m][n] = (f32x4){0.f, 0.f, 0.f, 0.f};
#pragma unroll
            for (int ks = 0; ks < 4; ++ks) { const int kc = k0 + 32 * ks + 8 * fq;
                const f32x4 x0 = *(const f32x4*)(xb + (size_t)(16 * m) * DM + 32 * ks), x1 = *(const f32x4*)(xb + (size_t)(16 * m) * DM + 32 * ks + 4);
                const f32x4 g0 = *(const f32x4*)(g + kc), g1 = *(const f32x4*)(g + kc + 4);
                const f32x4 s0 = *(const f32x4*)(MODL + (size_t)b * 6144 + 4096 + kc), s1 = *(const f32x4*)(MODL + (size_t)b * 6144 + 4096 + kc + 4);
                const f32x4 h0 = *(const f32x4*)(MODL + (size_t)b * 6144 + 3072 + kc), h1 = *(const f32x4*)(MODL + (size_t)b * 6144 + 3072 + kc + 4);
                const f32x4 v0 = x0 * rstd * g0 * (s0 + 1.f) + h0, v1 = x1 * rstd * g1 * (s1 + 1.f) + h1;
                u32x4 hi; hi.x = pk2(v0[0], v0[1]); hi.y = pk2(v0[2], v0[3]); hi.z = pk2(v1[0], v1[1]); hi.w = pk2(v1[2], v1[3]);
                u32x4 lo; lo.x = pk2(v0[0] - bflo(hi.x), v0[1] - bfhi(hi.x)); lo.y = pk2(v0[2] - bflo(hi.y), v0[3] - bfhi(hi.y)); lo.z = pk2(v1[0] - bflo(hi.z), v1[1] - bfhi(hi.z)); lo.w = pk2(v1[2] - bflo(hi.w), v1[3] - bfhi(hi.w));
                *(u32x4*)(H + (size_t)(row0 + 16 * m + fr) * DM + kc) = hi;
                const bf16x8 ah = __builtin_bit_cast(bf16x8, hi), al = __builtin_bit_cast(bf16x8, lo);
#pragma unroll
                for (int n = 0; n < 3; ++n) { acc[m][n] = __builtin_amdgcn_mfma_f32_16x16x32_bf16(ah, bh[n][ks], acc[m][n], 0, 0, 0);
                    acc[m][n] = __builtin_amdgcn_mfma_f32_16x16x32_bf16(al, bh[n][ks], acc[m][n], 0, 0, 0); acc[m][n] = __builtin_amdgcn_mfma_f32_16x16x32_bf16(ah, bl[n][ks], acc[m][n], 0, 0, 0); } }
#pragma unroll
            for (int n = 0; n < 3; ++n)
#pragma unroll
                for (int j = 0; j < 4; ++j) part[(w * 64 + 16 * m + 4 * fq + j) * 48 + 16 * n + fr] = acc[m][n][j];
        }
        __syncthreads();
        for (int i = tz; i < 64 * 36; i += NTHR) { const int tok = i / 36, n = i % 36; float a = 0.f;
#pragma unroll
            for (int ww = 0; ww < 8; ++ww) a += part[(ww * 64 + tok) * 48 + n];
            lsum[i] = a; }
        __syncthreads();
        float g0 = 0.f, g1 = 0.f; int e0 = 0, e1 = 0; unsigned r0 = 0, r1 = 0;
        if (tz < 64) {
            const LAS float* L = lsum + tz * 36;
            int gs = 0; float gm = L[0] + bgp[0];
#pragma unroll
            for (int i = 1; i < 4; ++i) { const float v = L[i] + bgp[i]; if (v > gm) { gm = v; gs = i; } }
            float gden = 0.f;
#pragma unroll
            for (int i = 0; i < 4; ++i) gden += expf(L[i] + bgp[i] - gm);
            const float gprob = 1.f / gden;
            int i1 = 0; float v1 = L[4 + gs * 8] + bep[gs * 8];
#pragma unroll
            for (int j = 1; j < 8; ++j) { const float v = L[4 + gs * 8 + j] + bep[gs * 8 + j]; if (v > v1) { v1 = v; i1 = j; } }
            int i2 = -1; float v2 = -INFINITY;
#pragma unroll
            for (int j = 0; j < 8; ++j) { const float v = L[4 + gs * 8 + j] + bep[gs * 8 + j]; if (j != i1 && v > v2) { v2 = v; i2 = j; } }
            const float p2 = expf(v2 - v1);
            g0 = gprob / (1.f + p2); g1 = gprob * p2 / (1.f + p2); e0 = gs * 8 + i1; e1 = gs * 8 + i2;
            r0 = __hip_atomic_fetch_add(lcnt + e0, 1u, __ATOMIC_RELAXED, __HIP_MEMORY_SCOPE_WORKGROUP); r1 = __hip_atomic_fetch_add(lcnt + e1, 1u, __ATOMIC_RELAXED, __HIP_MEMORY_SCOPE_WORKGROUP);
        }
        __syncthreads();
        if (tz < 32) { const unsigned c = lcnt[tz]; lcnt[32 + tz] = c ? atomicAdd(CNT + tz, c) : 0u; }
        __syncthreads();
        if (tz < 64) { const int row = row0 + tz;
            EID[2 * row] = e0; EID[2 * row + 1] = e1; GATE[2 * row] = g0; GATE[2 * row + 1] = g1; PIE[2 * row] = (int)(lcnt[32 + e0] + r0); PIE[2 * row + 1] = (int)(lcnt[32 + e1] + r1); }
        __syncthreads();
    }
    __syncthreads();
    LAS float* scr = (LAS float*)(F.lds + F.wave * 8448);
    bf16_t* WM1 = (bf16_t*)(A.ws + WS_WM1); bf16_t* WM2 = (bf16_t*)(A.ws + WS_WM2);
    for (int it = F.gw; it < 32 * 768; it += F.ngw) {
        const int e = it / 768; int r = it % 768;
        if (r < 512) { const int which = r >> 8; r &= 255; const int kb = r >> 4, nb = r & 15, n0 = 32 * nb;
            const float* src = (which ? A.in[49] : A.in[48]) + ((size_t)l * 32 + e) * 1024 * 512;
            transpose_item(src, 512, 64 * kb, n0, WM1 + (size_t)e * 1024 * 1024, 1024, 256 * (n0 >> 7) + (n0 & 127) + 128 * which, 64 * kb, scr, F.lane);
        } else { r -= 512; const int kb = r >> 5, nb = r & 31;
            transpose_item(A.in[50] + ((size_t)l * 32 + e) * 512 * 1024, 1024, 64 * kb, 32 * nb, WM2 + (size_t)e * 1024 * 512, 512, 32 * nb, 64 * kb, scr, F.lane); }
    }
}

DI void phase_moe_scatter(const Frame& F, CArgs& A, int l) {
    const unsigned* CNT = (const unsigned*)(A.ws + WS_CTL) + CW_CNT + l * 64;
    unsigned* META = (unsigned*)(A.ws + WS_CTL) + CW_UTAB + l * 1024;
    const int* EID = (const int*)(A.ws + WS_RT_EID); const int* PIE = (const int*)(A.ws + WS_RT_PIE); int* SORT = (int*)(A.ws + WS_RT_SORT);
    LAS unsigned* st = (LAS unsigned*)F.lds;
    if (F.tid == 0) { unsigned s = 0; for (int e = 0; e < 32; ++e) { st[e] = s; s += CNT[e]; } }
    __syncthreads();
    if (F.bid == 0 && F.tid == 0) { unsigned nu = 0;
        for (int e = 0; e < 32; ++e) { const unsigned c = CNT[e]; META[1 + e] = st[e]; META[33 + e] = c; for (unsigned bk = 0; bk * 256 < c; ++bk) META[65 + nu++] = ((unsigned)e << 16) | bk; }
        META[0] = nu; }
    for (int a = F.bid * NTHR + F.tid; a < 2 * T; a += F.G * NTHR) SORT[st[EID[a]] + PIE[a]] = a;
}

struct MoeProb1 {
    const char* Hh; const char* WM1; const unsigned* META; const int* SORT; int lda, ldb, nt, G, c;
    DI bool next(int i, pg8::Unit& u) const { const int idx = i * G + c; const int nu = (int)META[0]; if (idx >= nu * 4) return false;
        const unsigned ent = META[65 + (idx >> 2)]; u.pm = idx >> 2; u.pn = idx & 3; u.e = (int)(ent >> 16); u.blk = (int)(ent & 0xffffu); return true; }
    DI const char* a_base(const pg8::Unit&) const { return Hh; }
    DI const char* b_base(const pg8::Unit& u) const { return WM1 + ((size_t)u.e * 1024 + (size_t)u.pn * 256) * 1024 * 2; }
    DI unsigned a_off(const pg8::Unit& u, int row) const { const unsigned r = (unsigned)(u.blk * 256 + row), cnt = META[33 + u.e];
        const int a = r < cnt ? SORT[META[1 + u.e] + r] : 0; return (unsigned)(a >> 1) * 2048u; }
};
struct EpiMoe1 {
    static constexpr bool PERM = true;
    bf16_t* HID; const unsigned* META;
    DI void operator()(const f32x4 (&acc)[2][2][4][2], const pg8::Unit& u, int wr, int wc, int fr, int fq) const {
        const unsigned cnt = META[33 + u.e], st = META[1 + u.e];
        const int col0 = 128 * u.pn + wc * 32 + 8 * fq;
#pragma unroll
        for (int ai = 0; ai < 2; ++ai)
#pragma unroll
            for (int m = 0; m < 4; ++m) { const unsigned r = (unsigned)(u.blk * 256 + ai * 128 + wr * 64 + m * 16 + fr);
                if (r < cnt) { const f32x4 a0 = acc[ai][0][m][0], a1 = acc[ai][0][m][1], b0 = acc[ai][1][m][0], b1 = acc[ai][1][m][1];
                    u32x4 w; w.x = pk2(siluf_(a0[0]) * b0[0], siluf_(a0[1]) * b0[1]); w.y = pk2(siluf_(a0[2]) * b0[2], siluf_(a0[3]) * b0[3]);
                    w.z = pk2(siluf_(a1[0]) * b1[0], siluf_(a1[1]) * b1[1]); w.w = pk2(siluf_(a1[2]) * b1[2], siluf_(a1[3]) * b1[3]);
                    *(u32x4*)(HID + (size_t)(st + r) * 512 + col0) = w; } }
    }
};
struct MoeProb2 {
    const char* HID; const char* WM2; const unsigned* META; int lda, ldb, nt, G, c;
    DI bool next(int i, pg8::Unit& u) const { const int idx = i * G + c; const int nu = (int)META[0]; if (idx >= nu * 4) return false;
        const unsigned ent = META[65 + (idx >> 2)]; u.pm = idx >> 2; u.pn = idx & 3; u.e = (int)(ent >> 16); u.blk = (int)(ent & 0xffffu); return true; }
    DI const char* a_base(const pg8::Unit& u) const { return HID + ((size_t)META[1 + u.e] + (size_t)u.blk * 256) * 512 * 2; }
    DI const char* b_base(const pg8::Unit& u) const { return WM2 + ((size_t)u.e * 1024 + (size_t)u.pn * 256) * 512 * 2; }
    DI unsigned a_off(const pg8::Unit&, int row) const { return (unsigned)row * 1024u; }
};
struct EpiMoe2 {
    static constexpr bool PERM = true;
    bf16_t* Y; const unsigned* META; const int* SORT; const float* GATE; const float* gt;
    DI void operator()(const f32x4 (&acc)[2][2][4][2], const pg8::Unit& u, int wr, int wc, int fr, int fq) const {
        const unsigned cnt = META[33 + u.e], st = META[1 + u.e];
        const int col0 = 256 * u.pn + wc * 32 + 8 * fq;
#pragma unroll
        for (int ai = 0; ai < 2; ++ai)
#pragma unroll
            for (int m = 0; m < 4; ++m) { const unsigned r = (unsigned)(u.blk * 256 + ai * 128 + wr * 64 + m * 16 + fr);
                if (r < cnt) { const int a = SORT[st + r]; const float gw = GATE[a]; const int b = (a >> 1) / SEQ;
#pragma unroll
                    for (int bj = 0; bj < 2; ++bj) { const f32x4 g0 = *(const f32x4*)(gt + (size_t)b * 6144 + col0 + bj * 128), g1 = *(const f32x4*)(gt + (size_t)b * 6144 + col0 + bj * 128 + 4);
                        const f32x4 v0 = acc[ai][bj][m][0] * g0 * gw, v1 = acc[ai][bj][m][1] * g1 * gw;
                        u32x4 w; w.x = pk2(v0[0], v0[1]); w.y = pk2(v0[2], v0[3]); w.z = pk2(v1[0], v1[1]); w.w = pk2(v1[2], v1[3]);
                        *(u32x4*)(Y + (size_t)a * DM + col0 + bj * 128) = w; } } }
    }
};

DI void phase_final(const Frame& F, CArgs& A) {
    const bf16_t* Y = (const bf16_t*)(A.ws + WS_Y);
    for (size_t i = (size_t)F.bid * NTHR + F.tid; i < (size_t)T * DM / 4; i += (size_t)F.G * NTHR) {
        const size_t row = i >> 8, col = (i & 255) * 4;
        f32x4 v = *(const f32x4*)(A.out + row * DM + col);
        const u32x2 y0 = *(const u32x2*)(Y + (2 * row) * DM + col), y1 = *(const u32x2*)(Y + (2 * row + 1) * DM + col);
        v[0] += bflo(y0.x) + bflo(y1.x); v[1] += bfhi(y0.x) + bfhi(y1.x); v[2] += bflo(y0.y) + bflo(y1.y); v[3] += bfhi(y0.y) + bfhi(y1.y);
        *(f32x4*)(A.out + row * DM + col) = v;
    }
}

#ifndef REPMASK
#define REPMASK 0u
#endif
constexpr int NPL = 22, NPH = 1 + 2 * NPL + 1;
__global__ void __launch_bounds__(NTHR, 2) mk_fwd(Args args) {
    extern __shared__ __attribute__((aligned(16))) unsigned char lds_raw[];
    LAS unsigned char* const ldsb = (LAS unsigned char*)lds_raw;
    const int wave0 = __builtin_amdgcn_readfirstlane(threadIdx.x >> 6);
    volatile LAS unsigned* MISC = (volatile LAS unsigned*)(ldsb + MISC_OFF);
    if (threadIdx.x < 64) MISC[threadIdx.x] = 0u;
    __syncthreads();
    XcdBarrier bar; bar.bar = (unsigned*)(args.ws + WS_CTL) + CW_BAR; bar.x = 0; bar.st = nullptr;
    if (args.use_bar) bar = xcd_barrier_post((unsigned*)(args.ws + WS_CTL) + CW_BAR, MISC + 8);
    const int lo = args.ph_lo, hi = args.ph_hi;
#define IN(k) (lo <= (k) && (k) < hi)
#define SEAM(k) do { if (IN(k) && IN((k) + 1)) xcd_barrier(bar); } while (0)
    unsigned char* ws = args.ws;
    if (IN(0)) { const Frame F = make_frame(ldsb, wave0); CArgs& AA = *get_args(); phase_prologue(F, AA); } SEAM(0);
    for (int l = 0; l < DEPTH; ++l) {
        const int pb = 1 + l * NPL;
        const float* MODL = (const float*)(ws + WS_MOD) + (size_t)l * 8 * 6144;
        if (IN(pb + 0)) { const Frame F = make_frame(ldsb, wave0); CArgs& AA = *get_args(); phase_norm1(F, AA, l); } SEAM(pb + 0);
        if (IN(pb + 1)) { const Frame F = make_frame(ldsb, wave0); CArgs& AA = *get_args(); pg8::PlainProb P{(const char*)(ws + WS_H), (const char*)(ws + WS_WIN) + (size_t)l * ZS * 1024 * 2, 1024, 1024, 16, 256, 9, F.G, F.bid};
            EpiBf16Plain E{(bf16_t*)(ws + WS_Z), ZS}; pg8::gemm_phase(F.lds, P, E, F.tid); } SEAM(pb + 1);
        if (IN(pb + 2)) { const Frame F = make_frame(ldsb, wave0); CArgs& AA = *get_args(); phase_mla_prep(F, AA, l); } SEAM(pb + 2);
        if (IN(pb + 3)) { const Frame F = make_frame(ldsb, wave0); CArgs& AA = *get_args(); pg8::PlainProb P{(const char*)(ws + WS_AMLA), (const char*)(ws + WS_WMLA) + (size_t)l * 1024 * 512 * 2, 512, 512, 8, 256, 4, F.G, F.bid};
            EpiBf16Plain E{(bf16_t*)(ws + WS_QKVRAW), 1024}; pg8::gemm_phase(F.lds, P, E, F.tid); } SEAM(pb + 3);
        if (IN(pb + 4)) { const Frame F = make_frame(ldsb, wave0); CArgs& AA = *get_args(); phase_mla_post(F, AA, l); } SEAM(pb + 4);
        if (IN(pb + 5)) { const Frame F = make_frame(ldsb, wave0); CArgs& AA = *get_args(); phase_attn(F, AA); } SEAM(pb + 5);
        if (IN(pb + 6)) { const Frame F = make_frame(ldsb, wave0); CArgs& AA = *get_args(); phase_rwkv_prep(F, AA, l); } SEAM(pb + 6);
        if (IN(pb + 7)) { const Frame F = make_frame(ldsb, wave0); CArgs& AA = *get_args(); phase_rwkv_A(F, AA, l); } SEAM(pb + 7);
        if (IN(pb + 8)) { const Frame F = make_frame(ldsb, wave0); CArgs& AA = *get_args(); phase_rwkv_B(F, AA); } SEAM(pb + 8);
        if (IN(pb + 9)) { const Frame F = make_frame(ldsb, wave0); CArgs& AA = *get_args(); phase_rwkv_C(F, AA, l); } SEAM(pb + 9);
        if (IN(pb + 10)) { const Frame F = make_frame(ldsb, wave0); CArgs& AA = *get_args(); phase_s5<1>(F, AA, l); } SEAM(pb + 10);
        if (IN(pb + 11)) { const Frame F = make_frame(ldsb, wave0); CArgs& AA = *get_args(); phase_s5<2>(F, AA, l); } SEAM(pb + 11);
        if (IN(pb + 12)) { const Frame F = make_frame(ldsb, wave0); CArgs& AA = *get_args(); pg8::PlainProb P{(const char*)(ws + WS_YS5), (const char*)(ws + WS_WGLU) + (size_t)l * 256 * 256 * 2, 256, 256, 4, 256, 1, F.G, F.bid};
            EpiGlu E{(const bf16_t*)(ws + WS_YS5), (bf16_t*)(ws + WS_YS5G), AA.in[27] + l * 256}; pg8::gemm_phase(F.lds, P, E, F.tid); } SEAM(pb + 12);
        if (IN(pb + 13)) { const Frame F = make_frame(ldsb, wave0); CArgs& AA = *get_args(); phase_lru_prep(F, AA, l); } SEAM(pb + 13);
        if (IN(pb + 14)) { const Frame F = make_frame(ldsb, wave0); CArgs& AA = *get_args(); phase_lru_sum(F, AA); } SEAM(pb + 14);
        if (IN(pb + 15)) { const Frame F = make_frame(ldsb, wave0); CArgs& AA = *get_args(); phase_lru_fin(F, AA); } SEAM(pb + 15);
        if (IN(pb + 16)) { const Frame F = make_frame(ldsb, wave0); CArgs& AA = *get_args(); phase_branch_norm(F, AA, l); } SEAM(pb + 16);
        if (IN(pb + 17)) { const Frame F = make_frame(ldsb, wave0); CArgs& AA = *get_args(); pg8::PlainProb P{(const char*)(ws + WS_MIX), (const char*)(ws + WS_WOUT) + (size_t)l * 1024 * 1024 * 2, 1024, 1024, 16, 256, 4, F.G, F.bid};
            EpiResGate E{l == 0 ? AA.in[0] : AA.out, AA.out, MODL + 2048}; pg8::gemm_phase(F.lds, P, E, F.tid); } SEAM(pb + 17);
        if (IN(pb + 18)) { const Frame F = make_frame(ldsb, wave0); CArgs& AA = *get_args(); phase_norm2_router(F, AA, l); } SEAM(pb + 18);
        if (IN(pb + 19)) { const Frame F = make_frame(ldsb, wave0); CArgs& AA = *get_args(); phase_moe_scatter(F, AA, l); } SEAM(pb + 19);
        const unsigned* META = (const unsigned*)(ws + WS_CTL) + CW_UTAB + l * 1024;
        if (IN(pb + 20)) { const Frame F = make_frame(ldsb, wave0); CArgs& AA = *get_args(); MoeProb1 P{(const char*)(ws + WS_H), (const char*)(ws + WS_WM1), META, (const int*)(ws + WS_RT_SORT), 1024, 1024, 16, F.G, F.bid};
            EpiMoe1 E{(bf16_t*)(ws + WS_HID), META}; pg8::gemm_phase(F.lds, P, E, F.tid); } SEAM(pb + 20);
        if (IN(pb + 21)) { const Frame F = make_frame(ldsb, wave0); CArgs& AA = *get_args(); MoeProb2 P{(const char*)(ws + WS_HID), (const char*)(ws + WS_WM2), META, 512, 512, 8, F.G, F.bid};
            EpiMoe2 E{(bf16_t*)(ws + WS_Y), META, (const int*)(ws + WS_RT_SORT), (const float*)(ws + WS_RT_GATE), MODL + 5120}; pg8::gemm_phase(F.lds, P, E, F.tid); } SEAM(pb + 21);
    }
    if (IN(NPH - 1)) { const Frame F = make_frame(ldsb, wave0); CArgs& AA = *get_args(); phase_final(F, AA); }
#undef IN
#undef SEAM
}

extern "C" void kernel_launch(void* const* d_in, const int* in_sizes, int n_in, void* d_out, int out_size, void* d_ws, size_t ws_size, hipStream_t stream) {
    static int grid = 0;
    if (grid == 0) {
        if (n_in != 51 || ws_size < WS_END) { fprintf(stderr, "kernel_launch: unexpected inputs (n_in %d, ws %zu)\n", n_in, ws_size); grid = -1; return; }
        int dev = 0, cus = 0;
        if (hipGetDevice(&dev) != hipSuccess || hipDeviceGetAttribute(&cus, hipDeviceAttributeMultiprocessorCount, dev) != hipSuccess) { grid = -1; return; }
        if (hipFuncSetAttribute((const void*)mk_fwd, hipFuncAttributeMaxDynamicSharedMemorySize, LDS_BYTES) != hipSuccess) { fprintf(stderr, "kernel_launch: hipFuncSetAttribute failed\n"); grid = -1; return; }
        grid = cus;
    }
    if (grid < 0) return;
    (void)hipMemsetAsync((char*)d_ws + WS_CTL, 0, CTL_ZERO_BYTES, stream);
    Args a{};
    for (int i = 0; i < 51; ++i) a.in[i] = (const float*)d_in[i];
    a.pos_off = (const int*)d_in[2]; a.out = (float*)d_out; a.ws = (unsigned char*)d_ws; a.pad = 0;
#if defined(MK_PER_PHASE)
    a.use_bar = 0;
    for (int p = 0; p < NPH; ++p) { a.ph_lo = p; a.ph_hi = p + 1;
        const int k = (p == 0) ? 30 : (p == NPH - 1) ? 31 : (p - 1) % NPL; const int reps = 1 + (int)((REPMASK >> k) & 1u);
        for (int r = 0; r < reps; ++r) hipLaunchKernelGGL(mk_fwd, dim3(grid), dim3(NTHR), LDS_BYTES, stream, a); }
#else
    a.use_bar = 1; a.ph_lo = 0; a.ph_hi = NPH;
    hipLaunchKernelGGL(mk_fwd, dim3(grid), dim3(NTHR), LDS_BYTES, stream, a);
#endif
}
```

```cpp
#include <hip/hip_runtime.h>
#include <cstdio>
#include <cstdint>

#define LAS __attribute__((address_space(3)))
#define GAS __attribute__((address_space(1)))
#define DI __device__ __forceinline__
typedef unsigned short bf16_t;
typedef short bf16x8 __attribute__((ext_vector_type(8)));
typedef short s16x4 __attribute__((ext_vector_type(4)));
typedef float f32x4 __attribute__((ext_vector_type(4)));
typedef float f32x2 __attribute__((ext_vector_type(2)));
typedef float f32x16 __attribute__((ext_vector_type(16)));
typedef unsigned u32x4 __attribute__((ext_vector_type(4)));
typedef unsigned u32x2 __attribute__((ext_vector_type(2)));
typedef __bf16 bf16x2_t __attribute__((ext_vector_type(2)));

constexpr int NB = 8, SEQ = 8192, DM = 1024, T = NB * SEQ, DEPTH = 2;
constexpr int WG = 256;
constexpr int ZS = 2304;
constexpr int ZC_R = 0, ZC_K = 256, ZC_V = 512, ZC_WLO = 768, ZC_ALO = 800, ZC_GLO = 832, ZC_S5 = 896, ZC_QA = 1152, ZC_KVA = 1408, ZC_KPE = 1536, ZC_LX = 1568, ZC_LG = 1824, D_IN = 2080;
constexpr int NEXP = 32, DFF = 512;
constexpr float NORM_EPS = 1e-6f;

DI unsigned f2bf(float f) { unsigned u = __float_as_uint(f); return (u + 0x7fffu + ((u >> 16) & 1u)) >> 16; }
DI unsigned pk2(float lo, float hi) { f32x2 v = {lo, hi}; bf16x2_t b = __builtin_convertvector(v, bf16x2_t); return __builtin_bit_cast(unsigned, b); }
DI float bflo(unsigned u) { return __uint_as_float(u << 16); }
DI float bfhi(unsigned u) { return __uint_as_float(u & 0xffff0000u); }
DI float bf2f(bf16_t b) { return __uint_as_float(((unsigned)b) << 16); }
DI int lane_opaque() { int l; asm volatile("v_mbcnt_lo_u32_b32 %0, -1, 0\n\tv_mbcnt_hi_u32_b32 %0, -1, %0" : "=v"(l)); return l; }
DI float shfl_xor_l(float v, int o, int lane) { return __int_as_float(__builtin_amdgcn_ds_bpermute((lane ^ o) << 2, __float_as_int(v))); }
DI float wave_sum(float v) {
    const int l = lane_opaque();
#pragma unroll
    for (int o = 1; o < 64; o <<= 1) v += shfl_xor_l(v, o, l);
    return v;
}
DI void lds_barrier() { asm volatile("s_waitcnt lgkmcnt(0)" ::: "memory"); __builtin_amdgcn_s_barrier(); asm volatile("" ::: "memory"); }
DI float sigmoidf_(float x) { return __builtin_amdgcn_rcpf(1.f + __expf(-x)); }
DI float fast_tanh(float x) { const float e = __expf(2.f * fminf(fmaxf(x, -15.f), 15.f)); return (e - 1.f) * __builtin_amdgcn_rcpf(e + 1.f); }
DI float fast_softplus(float x) { return fmaxf(x, 0.f) + __logf(1.f + __expf(-fabsf(x))); }
DI float softplusf_(float x) { return fmaxf(x, 0.f) + log1pf(__expf(-fabsf(x))); }
DI float gelu_tanh(float x) { const float u = 0.7978845608028654f * (x + 0.044715f * x * x * x); const float e = __expf(2.f * fminf(fmaxf(u, -15.f), 15.f)); return x * e * __builtin_amdgcn_rcpf(e + 1.f); }
DI float siluf_(float x) { return x / (1.f + __expf(-x)); }

namespace pg8 {
constexpr int BM = 256, BK = 64, HALF = 128, HTB = HALF * BK * 2, STAGE_BYTES = 8 * HTB;
DI int lds_byte(int r, int c) { const int st = (r >> 4) * 2 + (c >> 5), rr = r & 15, cc = c & 31, ob = rr * 64 + cc * 2; return st * 1024 + (ob ^ (((ob >> 9) & 1) << 5)); }
DI void stage_rc(int b, int& R, int& C) { const int st = b / 1024, sb = b % 1024, swz = sb ^ (((sb >> 9) & 1) << 5); R = (st >> 1) * 16 + swz / 64; C = (st & 1) * 32 + (swz % 64) / 2; }
DI int perm32(int rho) { const int n = rho >> 4, i = rho & 15; return 8 * (i >> 2) + 4 * n + (i & 3); }

struct Unit { int pm, pn, e, blk; };

template <class Epi, class P>
DI void gemm_phase(LAS unsigned char* lds, const P& S, const Epi& E, int tid_in) {
    const int tid = tid_in, wid = __builtin_amdgcn_readfirstlane(tid >> 6), lane = tid & 63, wr = wid >> 2, wc = wid & 3, fr = lane & 15, fq = lane >> 4;
    const int nt = S.nt;
    int Rr[2], Cc[2];
    unsigned voffB[2], offC[2][2], offN[2][2];
#pragma unroll
    for (int i = 0; i < 2; ++i) { int R, C; stage_rc(tid * 16 + i * 8192, R, C); Rr[i] = R; Cc[i] = C; const int Rb = Epi::PERM ? ((R & ~31) + perm32(R & 31)) : R;
        voffB[i] = (unsigned)(Rb * S.ldb + C) * 2u; }
    const size_t kstep = (size_t)(BK * 2);
    const size_t hstepB = (size_t)HALF * S.ldb * 2;
    const unsigned ldsw = (unsigned)wid * 1024u;
    const int aoff = lds_byte(wr * 64 + fr, fq * 8), boff = lds_byte(wc * 32 + fr, fq * 8);
#define PG8_SA(b, h) (((b) * 2 + (h)) * HTB)
#define PG8_SB(b, h) ((4 + (b) * 2 + (h)) * HTB)
#define PG8_STAGE(bufoff, gbase, voff) do { _Pragma("unroll") for (int _i = 0; _i < 2; ++_i) \
        __builtin_amdgcn_global_load_lds((const unsigned*)((const char*)(gbase) + (voff)[_i]), (LAS unsigned*)(lds + (bufoff) + ldsw + _i * 8192), 16, 0, 0); } while (0)
#define PG8_LDA(dst, b, h) do { _Pragma("unroll") for (int m = 0; m < 4; ++m) _Pragma("unroll") for (int k = 0; k < 2; ++k) dst[m][k] = *(const LAS bf16x8*)(lds + PG8_SA(b, h) + aoff + m * 2048 + k * 1024); } while (0)
#define PG8_LDB(dst, b, h) do { _Pragma("unroll") for (int n = 0; n < 2; ++n) _Pragma("unroll") for (int k = 0; k < 2; ++k) dst[n][k] = *(const LAS bf16x8*)(lds + PG8_SB(b, h) + boff + n * 2048 + k * 1024); } while (0)
#define PG8_MMA(ai, bj, At, Bt) do { __builtin_amdgcn_s_setprio(1); _Pragma("unroll") for (int m = 0; m < 4; ++m) _Pragma("unroll") for (int n = 0; n < 2; ++n) _Pragma("unroll") for (int k = 0; k < 2; ++k) \
        acc[ai][bj][m][n] = __builtin_amdgcn_mfma_f32_16x16x32_bf16(Bt[n][k], At[m][k], acc[ai][bj][m][n], 0, 0, 0); __builtin_amdgcn_s_setprio(0); } while (0)
#define PG8_WAIT_V(n) asm volatile("s_waitcnt vmcnt(" #n ")" ::: "memory")
#define PG8_WAIT_L(n) asm volatile("s_waitcnt lgkmcnt(" #n ")" ::: "memory")
#define PG8_BAR __builtin_amdgcn_s_barrier()
#define PG8_SCHED __builtin_amdgcn_sched_barrier(0)
    Unit cur, nxt; int ui = 0;
    if (!S.next(0, cur)) return;
    f32x4 acc[2][2][4][2];
#pragma unroll
    for (int a = 0; a < 2; ++a)
#pragma unroll
        for (int b = 0; b < 2; ++b)
#pragma unroll
            for (int m = 0; m < 4; ++m)
#pragma unroll
                for (int n = 0; n < 2; ++n) acc[a][b][m][n] = (f32x4){0.f, 0.f, 0.f, 0.f};
    bf16x8 At[4][2], B0[2][2], B1[2][2];
    const char* cA = S.a_base(cur); const char* cB = S.b_base(cur);
#pragma unroll
    for (int h = 0; h < 2; ++h)
#pragma unroll
        for (int i = 0; i < 2; ++i) { offC[h][i] = S.a_off(cur, h * HALF + Rr[i]) + (unsigned)Cc[i] * 2u; offN[h][i] = offC[h][i]; }
    PG8_STAGE(PG8_SB(0, 0), cB, voffB); PG8_STAGE(PG8_SB(0, 1), cB + hstepB, voffB); PG8_STAGE(PG8_SA(0, 0), cA, offC[0]); PG8_STAGE(PG8_SA(0, 1), cA, offC[1]);
    if (wr == 1) PG8_BAR;
    PG8_WAIT_V(2); PG8_BAR;
    PG8_STAGE(PG8_SB(1, 0), cB + kstep, voffB); PG8_STAGE(PG8_SA(1, 0), cA + kstep, offC[0]); PG8_STAGE(PG8_SB(1, 1), cB + hstepB + kstep, voffB);
    PG8_WAIT_V(6); PG8_BAR;
    for (;;) {
        const bool has_next = S.next(ui + 1, nxt);
        const char* nA = has_next ? S.a_base(nxt) : cA; const char* nB = has_next ? S.b_base(nxt) : cB;
        for (int t = 0; t < nt; t += 2) {
            const bool last = (t == nt - 2);
            const char* a1 = cA + (size_t)(t + 1) * kstep;
            const char* a2 = last ? nA : cA + (size_t)(t + 2) * kstep; const char* b2 = last ? nB : cB + (size_t)(t + 2) * kstep;
            const char* a3 = a2 + kstep; const char* b3 = b2 + kstep;
            if (last && has_next) {
#pragma unroll
                for (int h = 0; h < 2; ++h)
#pragma unroll
                    for (int i = 0; i < 2; ++i) offN[h][i] = S.a_off(nxt, h * HALF + Rr[i]) + (unsigned)Cc[i] * 2u;
            }
            unsigned o2[2][2];
#pragma unroll
            for (int h = 0; h < 2; ++h)
#pragma unroll
                for (int i = 0; i < 2; ++i) o2[h][i] = last ? offN[h][i] : offC[h][i];
            PG8_LDB(B0, 0, 0); PG8_LDB(B1, 0, 1); PG8_SCHED; PG8_LDA(At, 0, 0); PG8_STAGE(PG8_SA(1, 1), a1, offC[1]);
            PG8_WAIT_V(8); PG8_WAIT_L(0); PG8_BAR; PG8_MMA(0, 0, At, B0); PG8_MMA(0, 1, At, B1); PG8_BAR; PG8_SCHED;
            PG8_LDA(At, 0, 1); PG8_STAGE(PG8_SB(0, 0), b2, voffB); PG8_STAGE(PG8_SB(0, 1), b2 + hstepB, voffB); PG8_STAGE(PG8_SA(0, 0), a2, o2[0]);
            PG8_WAIT_V(8); PG8_WAIT_L(0); PG8_BAR; PG8_MMA(1, 0, At, B0); PG8_MMA(1, 1, At, B1); PG8_BAR; PG8_SCHED;
            PG8_LDB(B0, 1, 0); PG8_LDB(B1, 1, 1); PG8_SCHED; PG8_LDA(At, 1, 0); PG8_STAGE(PG8_SA(0, 1), a2, o2[1]);
            PG8_WAIT_V(8); PG8_WAIT_L(0); PG8_BAR; PG8_MMA(0, 0, At, B0); PG8_MMA(0, 1, At, B1); PG8_BAR; PG8_SCHED;
            PG8_LDA(At, 1, 1); PG8_STAGE(PG8_SB(1, 0), b3, voffB); PG8_STAGE(PG8_SB(1, 1), b3 + hstepB, voffB); PG8_STAGE(PG8_SA(1, 0), a3, o2[0]);
            PG8_WAIT_V(8); PG8_WAIT_L(0); PG8_BAR; PG8_MMA(1, 0, At, B0); PG8_MMA(1, 1, At, B1); PG8_BAR; PG8_SCHED;
        }
        if (wr == 0) PG8_BAR;
        E(acc, cur, wr, wc, fr, fq);
        if (!has_next) break;
#pragma unroll
        for (int a = 0; a < 2; ++a)
#pragma unroll
            for (int b = 0; b < 2; ++b)
#pragma unroll
                for (int m = 0; m < 4; ++m)
#pragma unroll
                    for (int n = 0; n < 2; ++n) acc[a][b][m][n] = (f32x4){0.f, 0.f, 0.f, 0.f};
        cur = nxt; cA = nA; cB = nB; ++ui;
#pragma unroll
        for (int h = 0; h < 2; ++h)
#pragma unroll
            for (int i = 0; i < 2; ++i) offC[h][i] = offN[h][i];
        if (wr == 1) PG8_BAR;
    }
    PG8_WAIT_V(0);
    PG8_BAR;
#undef PG8_SA
#undef PG8_SB
#undef PG8_STAGE
#undef PG8_LDA
#undef PG8_LDB
#undef PG8_MMA
#undef PG8_WAIT_V
#undef PG8_WAIT_L
#undef PG8_BAR
#undef PG8_SCHED
}

struct PlainProb {
    const char* A; const char* Bt; int lda, ldb, nt, nM, nN, G, c;
    DI bool next(int i, Unit& u) const {
        const long L = (long)i * G + c; const int nwg = nM * nN; if (L >= nwg) return false;
        int wgid = (int)L; { const int q = nwg / 8, r = nwg % 8, xcd = wgid % 8, off = wgid / 8; wgid = (xcd < r ? xcd * (q + 1) : r * (q + 1) + (xcd - r) * q) + off; }
        const int nig = 8 * nN, gid = wgid / nig, fm = gid * 8, gsz = (nM - fm) < 8 ? (nM - fm) : 8;
        u.pm = fm + ((wgid % nig) % gsz); u.pn = (wgid % nig) / gsz; u.e = 0; u.blk = 0; return true;
    }
    DI const char* a_base(const Unit& u) const { return A + (size_t)u.pm * 256 * lda * 2; }
    DI const char* b_base(const Unit& u) const { return Bt + (size_t)u.pn * 256 * ldb * 2; }
    DI unsigned a_off(const Unit&, int row) const { return (unsigned)row * (unsigned)lda * 2u; }
};
}

constexpr size_t MiB = 1u << 20;
constexpr size_t WS_CTL = 0, CTL_ZERO_BYTES = 1 * MiB;
constexpr size_t WS_MOD = 1 * MiB;
constexpr size_t WS_RT_EID = 3 * MiB;
constexpr size_t WS_RT_GATE = WS_RT_EID + 512 * 1024;
constexpr size_t WS_RT_PIE = WS_RT_GATE + 512 * 1024;
constexpr size_t WS_RT_SORT = WS_RT_PIE + 512 * 1024;
constexpr size_t WS_WIN = 8 * MiB;
constexpr size_t WS_WOUT = 17 * MiB;
constexpr size_t WS_WMLA = 21 * MiB;
constexpr size_t WS_WGLU = 23 * MiB;
constexpr size_t WS_WR = 23 * MiB + 256 * 1024;
constexpr size_t WS_WLRU = 23 * MiB + 640 * 1024;
constexpr size_t WS_WLORA = 23 * MiB + 768 * 1024;
static_assert(WS_WGLU + 256 * 1024 <= WS_WR && WS_WR + 384 * 1024 <= WS_WLRU && WS_WLRU + 128 * 1024 <= WS_WLORA && WS_WLORA + 128 * 1024 <= 24 * MiB, "small weight map");
constexpr size_t WS_H = 24 * MiB;
constexpr size_t WS_Z = 152 * MiB;
constexpr size_t WS_WM1 = WS_Z;
constexpr size_t WS_WM2 = WS_Z + 64 * MiB;
constexpr size_t WS_MIX = 440 * MiB;
constexpr size_t WS_HID = WS_MIX;
constexpr size_t WS_Y = 569 * MiB;
constexpr size_t WS_Q = 825 * MiB;
constexpr size_t WS_K = 873 * MiB;
constexpr size_t WS_VT = 921 * MiB;
constexpr size_t WS_TAIL = 953 * MiB;
constexpr size_t WS_END = 1017 * MiB;
constexpr size_t WS_AMLA = WS_TAIL;
constexpr size_t WS_QKVRAW = WS_Y;
constexpr size_t WS_ATTO = WS_H;
constexpr size_t WS_RW_R = WS_Y, WS_RW_K = WS_Y + 32 * MiB, WS_RW_V = WS_Y + 64 * MiB, WS_RW_KK = WS_Y + 96 * MiB, WS_RW_B = WS_Y + 128 * MiB, WS_RW_G = WS_Y + 160 * MiB;
constexpr size_t WS_RW_W = WS_Y + 192 * MiB;
constexpr size_t WS_RC_RP = WS_H + 32 * MiB;
constexpr size_t WS_RC_MP = WS_H + 64 * MiB;
constexpr size_t WS_RC_HB = WS_H + 96 * MiB;
constexpr size_t WS_RC_Y0 = WS_Q;
constexpr size_t WS_RC_G = WS_Q + 64 * MiB;
constexpr int RC_REC = 24832;
constexpr size_t WS_RC_BS = WS_Q + 64 * MiB + 98 * MiB;
static_assert((size_t)4096 * RC_REC <= 98 * MiB && WS_RC_BS + 1 * MiB <= WS_END, "rwkv record map");
constexpr size_t WS_YS5 = WS_H + 96 * MiB;
constexpr size_t WS_YS5G = WS_TAIL;
constexpr size_t WS_YL = WS_TAIL + 32 * MiB;
constexpr size_t WS_LA = WS_Y, WS_LB = WS_Y + 64 * MiB;
constexpr size_t WS_S5END = 2 * MiB;
constexpr size_t WS_S5BB = 5 * MiB;
constexpr size_t WS_S5CC = 5 * MiB + 128 * 1024;
constexpr size_t WS_LSUM = 5 * MiB + 512 * 1024;
static_assert(WS_RT_SORT + 512 * 1024 <= WS_LSUM && WS_LSUM + 2 * MiB <= WS_WIN && WS_S5END + 1 * MiB <= WS_RT_EID, "map");

constexpr int CW_BAR = 4096;
constexpr int CW_CNT = 16384;
constexpr int CW_UTAB = 20480;

constexpr int NWAVES = 8, NTHR = 512;
constexpr int LDS_BYTES = 155648;
constexpr int MISC_OFF = 155648 - 256;

struct Args { const float* in[51]; const int* pos_off; float* out; unsigned char* ws; int ph_lo, ph_hi, use_bar, pad; };
typedef const __attribute__((address_space(4))) Args CArgs;
DI CArgs* get_args() { CArgs* ap = (CArgs*)__builtin_amdgcn_kernarg_segment_ptr(); asm volatile("" : "+s"(ap)); return ap; }

#define XB_TMO      128
#define XB_XCNT(j)  (256  + 64 * (j))
#define XB_XSUB(j)  (1280 + 64 * (j))
#define XB_XGEN(j)  (2304 + 64 * (j))
#define XB_TOP      3328
#define XB_TOPGEN   3392
#define XCD_BAR_WORDS 3456
#define XB_SPIN_CAP (1u << 18)
DI unsigned xb_ld(unsigned* p)              { return __hip_atomic_load(p, __ATOMIC_RELAXED, __HIP_MEMORY_SCOPE_AGENT); }
DI unsigned xb_add(unsigned* p, unsigned v) { return __hip_atomic_fetch_add(p, v, __ATOMIC_RELAXED, __HIP_MEMORY_SCOPE_AGENT); }
DI unsigned xb_xcc_id() { return (unsigned)__builtin_amdgcn_s_getreg((3 << 11) | 20) & 0xFu; }
#define XB_SPIN(cond, bar) do { unsigned _sp = 0; while (cond) { __builtin_amdgcn_s_sleep(1); \
    if ((++_sp & 255u) == 0u) { if (xb_ld(&(bar)[XB_TMO])) break; if (_sp > XB_SPIN_CAP) { atomicAdd(&(bar)[XB_TMO], 1u); break; } } } } while (0)
struct XcdBarrier { unsigned* bar; unsigned x; volatile LAS unsigned* st; };
DI XcdBarrier xcd_barrier_post(unsigned* bar, volatile LAS unsigned* st) {
    XcdBarrier b; b.bar = bar; b.x = xb_xcc_id(); b.st = st;
    if (threadIdx.x == 0) (void)xb_add(&bar[XB_XCNT(b.x)], 1u);
    return b;
}
DI void xcd_barrier_complete(unsigned* bar, unsigned x, unsigned& nloc, unsigned& nx) {
    const unsigned G = gridDim.x * gridDim.y * gridDim.z;
    unsigned sum, cnt, mine, sp = 0u;
    for (;;) {
        sum = 0u; cnt = 0u; mine = 0u;
#pragma unroll
        for (unsigned j = 0; j < 16; ++j) { const unsigned c = xb_ld(&bar[XB_XCNT(j)]); sum += c; cnt += (c > 0u) ? 1u : 0u; mine = (j == x) ? c : mine; }
        if (sum == G) break;
        __builtin_amdgcn_s_sleep(1);
        if ((++sp & 255u) == 0u) { if (xb_ld(&bar[XB_TMO])) break; if (sp > XB_SPIN_CAP) { atomicAdd(&bar[XB_TMO], 1u); break; } }
    }
    nloc = mine > 0u ? mine : 1u; nx = cnt > 0u ? cnt : 1u;
}
DI void xcd_barrier(const XcdBarrier& b) {
    asm volatile("s_waitcnt vmcnt(0)" ::: "memory");
    __syncthreads();
    if (threadIdx.x == 0) {
        unsigned* bar = b.bar;
        __builtin_amdgcn_s_waitcnt(0);
        unsigned nloc = b.st[0], nx = b.st[1];
        if (nloc == 0u) { xcd_barrier_complete(bar, b.x, nloc, nx); b.st[0] = nloc; b.st[1] = nx; }
        const unsigned old = xb_add(&bar[XB_XSUB(b.x)], 1u);
        const unsigned gen = old / nloc;
        if (old + 1u == (gen + 1u) * nloc) {
            __builtin_amdgcn_fence(__ATOMIC_RELEASE, "agent");
            asm volatile("s_waitcnt vmcnt(0)" ::: "memory");
            const unsigned og = xb_add(&bar[XB_TOP], 1u);
            const unsigned tg = og / nx;
            if (og + 1u == (tg + 1u) * nx) xb_add(&bar[XB_TOPGEN], 1u);
            else XB_SPIN(xb_ld(&bar[XB_TOPGEN]) == tg, bar);
            __builtin_amdgcn_fence(__ATOMIC_ACQUIRE, "agent");
            xb_add(&bar[XB_XGEN(b.x)], 1u);
            asm volatile("s_waitcnt vmcnt(0)" ::: "memory");
        } else {
            XB_SPIN(xb_ld(&bar[XB_XGEN(b.x)]) == gen, bar);
            __builtin_amdgcn_fence(__ATOMIC_ACQUIRE, "agent");
            asm volatile("s_waitcnt vmcnt(0)" ::: "memory");
        }
    }
    __syncthreads();
}

struct EpiBf16Plain {
    static constexpr bool PERM = true;
    bf16_t* O; int ldc;
    DI void operator()(const f32x4 (&acc)[2][2][4][2], const pg8::Unit& u, int wr, int wc, int fr, int fq) const {
        const int row0 = u.pm * 256 + wr * 64 + fr, col0 = u.pn * 256 + wc * 32 + 8 * fq;
#pragma unroll
        for (int ai = 0; ai < 2; ++ai)
#pragma unroll
            for (int m = 0; m < 4; ++m) { bf16_t* rowp = O + (size_t)(row0 + ai * 128 + m * 16) * ldc + col0;
#pragma unroll
                for (int bj = 0; bj < 2; ++bj) { const f32x4 v0 = acc[ai][bj][m][0], v1 = acc[ai][bj][m][1];
                    u32x4 w; w.x = pk2(v0[0], v0[1]); w.y = pk2(v0[2], v0[3]); w.z = pk2(v1[0], v1[1]); w.w = pk2(v1[2], v1[3]);
                    *(u32x4*)(rowp + bj * 128) = w; } }
    }
};
struct EpiResGate {
    static constexpr bool PERM = false;
    const float* xin; float* out; const float* gt;
    DI void operator()(const f32x4 (&acc)[2][2][4][2], const pg8::Unit& u, int wr, int wc, int fr, int fq) const {
        const int row0 = u.pm * 256 + wr * 64 + fr, col0 = u.pn * 256 + wc * 32 + 4 * fq;
        const int b = (u.pm * 256) / SEQ;
        f32x4 g[2][2];
#pragma unroll
        for (int bj = 0; bj < 2; ++bj)
#pragma unroll
            for (int n = 0; n < 2; ++n) g[bj][n] = *(const f32x4*)(gt + (size_t)b * 6144 + col0 + bj * 128 + n * 16);
#pragma unroll
        for (int ai = 0; ai < 2; ++ai)
#pragma unroll
            for (int m = 0; m < 4; ++m) { const size_t ro = (size_t)(row0 + ai * 128 + m * 16) * DM + col0;
#pragma unroll
                for (int bj = 0; bj < 2; ++bj)
#pragma unroll
                    for (int n = 0; n < 2; ++n) { const f32x4 xv = *(const f32x4*)(xin + ro + bj * 128 + n * 16);
                        *(f32x4*)(out + ro + bj * 128 + n * 16) = xv + g[bj][n] * acc[ai][bj][m][n]; } }
    }
};
struct EpiGlu {
    static constexpr bool PERM = true;
    const bf16_t* Y; bf16_t* O; const float* bias;
    DI void operator()(const f32x4 (&acc)[2][2][4][2], const pg8::Unit& u, int wr, int wc, int fr, int fq) const {
        const int row0 = u.pm * 256 + wr * 64 + fr, col0 = wc * 32 + 8 * fq;
#pragma unroll
        for (int ai = 0; ai < 2; ++ai)
#pragma unroll
            for (int m = 0; m < 4; ++m) { const size_t ro = (size_t)(row0 + ai * 128 + m * 16) * 256 + col0;
#pragma unroll
                for (int bj = 0; bj < 2; ++bj) { const u32x4 yv = *(const u32x4*)(Y + ro + bj * 128);
                    const f32x4 b0 = *(const f32x4*)(bias + col0 + bj * 128), b1 = *(const f32x4*)(bias + col0 + bj * 128 + 4);
                    const f32x4 v0 = acc[ai][bj][m][0] + b0, v1 = acc[ai][bj][m][1] + b1;
                    u32x4 w;
                    w.x = pk2(bflo(yv.x) * sigmoidf_(v0[0]), bfhi(yv.x) * sigmoidf_(v0[1]));
                    w.y = pk2(bflo(yv.y) * sigmoidf_(v0[2]), bfhi(yv.y) * sigmoidf_(v0[3]));
                    w.z = pk2(bflo(yv.z) * sigmoidf_(v1[0]), bfhi(yv.z) * sigmoidf_(v1[1]));
                    w.w = pk2(bflo(yv.w) * sigmoidf_(v1[2]), bfhi(yv.w) * sigmoidf_(v1[3]));
                    *(u32x4*)(O + ro + bj * 128) = w; } }
    }
};

struct Frame { LAS unsigned char* lds; int tid, lane, wave, G, bid, gw, ngw; };

DI Frame make_frame(LAS unsigned char* lds, int wave0) {
    Frame F; F.lds = lds; int w = wave0; asm volatile("" : "+s"(w)); F.wave = w; F.lane = lane_opaque(); F.tid = w * 64 + F.lane;
    F.G = gridDim.x; F.bid = blockIdx.x; F.gw = F.bid * NWAVES + F.wave; F.ngw = F.G * NWAVES; return F;
}
DI void transpose_item(const float* src, int ld_src, int k0, int n0, bf16_t* dst, int ldd, int nd0, int kd0, LAS float* scr, int lane) {
#pragma unroll 8
    for (int i = 0; i < 32; ++i) { const int kk = 2 * i + (lane >> 5); scr[kk * 33 + (lane & 31)] = src[(size_t)(k0 + kk) * ld_src + n0 + (lane & 31)]; }
    asm volatile("s_waitcnt lgkmcnt(0)" ::: "memory");
    const int c = lane & 7;
#pragma unroll
    for (int j = 0; j < 4; ++j) { const int n = (lane >> 3) + 8 * j; const LAS float* s = scr + (8 * c) * 33 + n;
        u32x4 o; o.x = pk2(s[0 * 33], s[1 * 33]); o.y = pk2(s[2 * 33], s[3 * 33]); o.z = pk2(s[4 * 33], s[5 * 33]); o.w = pk2(s[6 * 33], s[7 * 33]);
        *(u32x4*)(dst + (size_t)(nd0 + n) * ldd + kd0 + 8 * c) = o; }
    asm volatile("s_waitcnt lgkmcnt(0)" ::: "memory");
}
DI void transpose_item64(const float* src, int ld_src, int k0, int n0, bf16_t* dst, int ldd, int nd0, int kd0, LAS float* scr, int lane) {
    f32x4 v[16];
#pragma unroll
    for (int i = 0; i < 16; ++i) v[i] = *(const f32x4*)(src + (size_t)(k0 + 4 * i + (lane >> 4)) * ld_src + n0 + 4 * (lane & 15));
#pragma unroll
    for (int i = 0; i < 16; ++i) { LAS float* p = scr + (4 * i + (lane >> 4)) * 65 + 4 * (lane & 15); p[0] = v[i][0]; p[1] = v[i][1]; p[2] = v[i][2]; p[3] = v[i][3]; }
    asm volatile("s_waitcnt lgkmcnt(0)" ::: "memory");
    const int c = lane & 7;
#pragma unroll
    for (int j = 0; j < 8; ++j) { const int n = (lane >> 3) + 8 * j; const LAS float* q = scr + (8 * c) * 65 + n;
        u32x4 o; o.x = pk2(q[0 * 65], q[1 * 65]); o.y = pk2(q[2 * 65], q[3 * 65]); o.z = pk2(q[4 * 65], q[5 * 65]); o.w = pk2(q[6 * 65], q[7 * 65]);
        *(u32x4*)(dst + (size_t)(nd0 + n) * ldd + kd0 + 8 * c) = o; }
    asm volatile("s_waitcnt lgkmcnt(0)" ::: "memory");
}
DI void zero_rows(bf16_t* dst, int ld, int r0, int nr, int c0, int nc, int gw, int ngw, int lane) {
    for (int r = gw; r < nr; r += ngw) for (int c = lane * 8; c < nc; c += 512) *(u32x4*)(dst + (size_t)(r0 + r) * ld + c0 + c) = (u32x4){0u, 0u, 0u, 0u};
}

DI void phase_prologue(const Frame& F, CArgs& A) {
    unsigned char* ws = A.ws;
    LAS float* sc = (LAS float*)F.lds;
    LAS float* part = (LAS float*)(F.lds + 32768);
    for (int i = F.tid; i < 8192; i += NTHR) sc[i] = siluf_(A.in[1][i]);
    __syncthreads();
    float* MOD = (float*)(ws + WS_MOD);
    for (int item = F.bid; item < 192; item += F.G) {
        const int l = item / 96, n0 = (item % 96) * 64, nl = F.tid & 63, kg = F.tid >> 6;
        const float* W = A.in[3] + (size_t)l * 1024 * 6144 + n0 + nl;
        float acc[8];
#pragma unroll
        for (int b = 0; b < 8; ++b) acc[b] = 0.f;
        for (int k = kg * 128; k < kg * 128 + 128; ++k) { const float w = W[(size_t)k * 6144];
#pragma unroll
            for (int b = 0; b < 8; ++b) acc[b] += sc[b * 1024 + k] * w; }
#pragma unroll
        for (int b = 0; b < 8; ++b) part[(kg * 8 + b) * 64 + nl] = acc[b];
        __syncthreads();
        { const int b = F.tid >> 6; float s = A.in[4][l * 6144 + n0 + nl];
#pragma unroll
          for (int g = 0; g < 8; ++g) s += part[(g * 8 + b) * 64 + nl];
          MOD[((size_t)l * 8 + b) * 6144 + n0 + nl] = s; }
        __syncthreads();
    }
    LAS float* scr = (LAS float*)(F.lds + F.wave * 16640);
    bf16_t* WIN = (bf16_t*)(ws + WS_WIN); bf16_t* WOUT = (bf16_t*)(ws + WS_WOUT); bf16_t* WMLA = (bf16_t*)(ws + WS_WMLA); bf16_t* WGLU = (bf16_t*)(ws + WS_WGLU);
    constexpr int I_IN = 16 * 32, I_INT = 16, I_OUT = 16 * 16, I_Q = 4 * 6, I_KV = 2 * 8, I_GLU = 4 * 4, I_L = I_IN + I_INT + I_OUT + I_Q + I_KV + I_GLU;
    for (int it = F.gw; it < 2 * I_L; it += F.ngw) {
        const int l = it / I_L; int r = it % I_L;
        if (r < I_IN) { transpose_item64(A.in[6] + (size_t)l * 1024 * D_IN, D_IN, 64 * (r / 32), 64 * (r % 32), WIN + (size_t)l * ZS * 1024, 1024, 64 * (r % 32), 64 * (r / 32), scr, F.lane); continue; } r -= I_IN;
        if (r < I_INT) { transpose_item(A.in[6] + (size_t)l * 1024 * D_IN, D_IN, 64 * r, 2048, WIN + (size_t)l * ZS * 1024, 1024, 2048, 64 * r, scr, F.lane); continue; } r -= I_INT;
        if (r < I_OUT) { transpose_item64(A.in[42] + (size_t)l * 1024 * 1024, 1024, 64 * (r / 16), 64 * (r % 16), WOUT + (size_t)l * 1024 * 1024, 1024, 64 * (r % 16), 64 * (r / 16), scr, F.lane); continue; } r -= I_OUT;
        if (r < I_Q) { transpose_item64(A.in[29] + (size_t)l * 256 * 384, 384, 64 * (r / 6), 64 * (r % 6), WMLA + (size_t)l * 1024 * 512, 512, 64 * (r % 6), 64 * (r / 6), scr, F.lane); continue; } r -= I_Q;
        if (r < I_KV) { transpose_item64(A.in[31] + (size_t)l * 128 * 512, 512, 64 * (r / 8), 64 * (r % 8), WMLA + (size_t)l * 1024 * 512, 512, 384 + 64 * (r % 8), 256 + 64 * (r / 8), scr, F.lane); continue; } r -= I_KV;
        transpose_item64(A.in[26] + (size_t)l * 256 * 256, 256, 64 * (r / 4), 64 * (r % 4), WGLU + (size_t)l * 256 * 256, 256, 64 * (r % 4), 64 * (r / 4), scr, F.lane);
    }
    { bf16_t* WR = (bf16_t*)(ws + WS_WR);
      for (int i = F.bid * NTHR + F.tid; i < 2 * 48 * 1024; i += F.G * NTHR) { const int l = i / (48 * 1024), n = (i / 1024) % 48, k = i % 1024;
          const float v = n < 4 ? A.in[44][((size_t)l * 1024 + k) * 4 + n] : n < 36 ? A.in[46][((size_t)l * 1024 + k) * 32 + (n - 4)] : 0.f;
          const unsigned hi = f2bf(v); const float rem = v - __uint_as_float(hi << 16);
          WR[((size_t)(l * 2 + 0) * 48 + n) * 1024 + k] = (bf16_t)hi; WR[((size_t)(l * 2 + 1) * 48 + n) * 1024 + k] = (bf16_t)f2bf(rem); } }
    { bf16_t* WL = (bf16_t*)(ws + WS_WLRU); bf16_t* WO = (bf16_t*)(ws + WS_WLORA);
      for (int i = F.bid * NTHR + F.tid; i < 2 * 2 * 4 * 4096; i += F.G * NTHR) { const int l = i >> 15, wh = (i >> 14) & 1, n = (i >> 12) & 3, j = (i >> 6) & 63, k = i & 63;
          WL[i] = (bf16_t)f2bf((wh ? A.in[38] : A.in[36])[((size_t)(l * 4 + n) * 64 + k) * 64 + j]); }
      for (int i = F.bid * NTHR + F.tid; i < 2 * 32768; i += F.G * NTHR) { const int l = i >> 15, r = i & 32767;
          float v;
          if (r < 8192) v = A.in[9][(size_t)l * 8192 + (r & 31) * 256 + (r >> 5)];
          else if (r < 16384) v = A.in[11][(size_t)l * 8192 + ((r - 8192) & 31) * 256 + ((r - 8192) >> 5)];
          else v = A.in[12][(size_t)l * 16384 + ((r - 16384) & 63) * 256 + ((r - 16384) >> 6)];
          WO[i] = (bf16_t)f2bf(v); } }
    { bf16_t* BBt = (bf16_t*)(ws + WS_S5BB); bf16_t* CCt = (bf16_t*)(ws + WS_S5CC);
      for (int i = F.bid * NTHR + F.tid; i < 2 * 16 * 64; i += F.G * NTHR) { const int lg = i >> 6, p = i & 63;
          const float dt = __expf(A.in[25][lg]); const float lre = A.in[18][lg * 64 + p], lim = A.in[19][lg * 64 + p];
          const float mag = expf(lre * dt); float sn, cn; sincosf(lim * dt, &sn, &cn);
          const float are = mag * cn, aim = mag * sn, den = lre * lre + lim * lim;
          const float qre = ((are - 1.f) * lre + aim * lim) / den, qim = (aim * lre - (are - 1.f) * lim) / den;
          const float* br = A.in[20] + ((size_t)lg * 64 + p) * 16; const float* bi = A.in[21] + ((size_t)lg * 64 + p) * 16;
          for (int c = 0; c < 16; ++c) { const float x = br[c], y = bi[c];
              BBt[(((size_t)lg * 2 + 0) * 64 + p) * 16 + c] = (bf16_t)f2bf(qre * x - qim * y); BBt[(((size_t)lg * 2 + 1) * 64 + p) * 16 + c] = (bf16_t)f2bf(qre * y + qim * x); } }
      for (int i = F.bid * NTHR + F.tid; i < 2 * 16 * 16 * 128; i += F.G * NTHR) { const int lg = i >> 11, ii = (i >> 7) & 15, k = i & 127;
          CCt[i] = (bf16_t)f2bf(k < 64 ? A.in[22][((size_t)lg * 16 + ii) * 64 + k] : -A.in[23][((size_t)lg * 16 + ii) * 64 + (k - 64)]); } }
    for (int l = 0; l < 2; ++l) {
        zero_rows(WIN + (size_t)l * ZS * 1024, 1024, D_IN, ZS - D_IN, 0, 1024, F.gw, F.ngw, F.lane);
        bf16_t* wm = WMLA + (size_t)l * 1024 * 512;
        zero_rows(wm, 512, 0, 384, 256, 256, F.gw, F.ngw, F.lane);
        zero_rows(wm, 512, 384, 512, 0, 256, F.gw, F.ngw, F.lane);
        zero_rows(wm, 512, 384, 512, 384, 128, F.gw, F.ngw, F.lane);
        zero_rows(wm, 512, 896, 128, 0, 512, F.gw, F.ngw, F.lane);
    }
}

DI void phase_norm1(const Frame& F, CArgs& A, int l) {
    const float* MODL = (const float*)(A.ws + WS_MOD) + (size_t)l * 8 * 6144;
    const float* g = A.in[5] + l * 1024;
    const bf16_t* Y = (const bf16_t*)(A.ws + WS_Y);
    bf16_t* H = (bf16_t*)(A.ws + WS_H);
    const float* src = (l == 0) ? A.in[0] : A.out;
    for (int row = F.gw; row < T; row += F.ngw) {
        const int b = row / SEQ;
        f32x4 v[4]; float ss = 0.f;
#pragma unroll
        for (int j = 0; j < 4; ++j) { const int col = 4 * (64 * j + F.lane);
            v[j] = *(const f32x4*)(src + (size_t)row * DM + col);
            if (l > 0) { const u32x2 y0 = *(const u32x2*)(Y + (size_t)(2 * row) * DM + col), y1 = *(const u32x2*)(Y + (size_t)(2 * row + 1) * DM + col);
                v[j][0] += bflo(y0.x) + bflo(y1.x); v[j][1] += bfhi(y0.x) + bfhi(y1.x); v[j][2] += bflo(y0.y) + bflo(y1.y); v[j][3] += bfhi(y0.y) + bfhi(y1.y);
                *(f32x4*)(A.out + (size_t)row * DM + col) = v[j]; }
            ss += v[j][0] * v[j][0] + v[j][1] * v[j][1] + v[j][2] * v[j][2] + v[j][3] * v[j][3]; }
        const float rstd = rsqrtf(wave_sum(ss) * (1.f / DM) + NORM_EPS);
#pragma unroll
        for (int j = 0; j < 4; ++j) { const int col = 4 * (64 * j + F.lane);
            const f32x4 gg = *(const f32x4*)(g + col), sh = *(const f32x4*)(MODL + (size_t)b * 6144 + col), scv = *(const f32x4*)(MODL + (size_t)b * 6144 + 1024 + col);
            const f32x4 hv = v[j] * rstd * gg * (scv + 1.f) + sh;
            u32x2 o; o.x = pk2(hv[0], hv[1]); o.y = pk2(hv[2], hv[3]);
            *(u32x2*)(H + (size_t)row * DM + col) = o; }
    }
}

DI void phase_mla_prep(const Frame& F, CArgs& A, int l) {
    const bf16_t* Z = (const bf16_t*)(A.ws + WS_Z); bf16_t* AM = (bf16_t*)(A.ws + WS_AMLA);
    const float* qg = A.in[28] + l * 256; const float* kg = A.in[30] + l * 128;
    for (int row = F.gw; row < T; row += F.ngw) {
        const bf16_t* zr = Z + (size_t)row * ZS;
        const u32x2 qv = *(const u32x2*)(zr + ZC_QA + 4 * F.lane); const unsigned kv = *(const unsigned*)(zr + ZC_KVA + 2 * F.lane);
        const float q0 = bflo(qv.x), q1 = bfhi(qv.x), q2 = bflo(qv.y), q3 = bfhi(qv.y), k0 = bflo(kv), k1 = bfhi(kv);
        const float rq = rsqrtf(wave_sum(q0 * q0 + q1 * q1 + q2 * q2 + q3 * q3) * (1.f / 256.f) + NORM_EPS);
        const float rk = rsqrtf(wave_sum(k0 * k0 + k1 * k1) * (1.f / 128.f) + NORM_EPS);
        const f32x4 g4 = *(const f32x4*)(qg + 4 * F.lane); const f32x2 g2 = *(const f32x2*)(kg + 2 * F.lane);
        u32x2 o; o.x = pk2(q0 * rq * g4[0], q1 * rq * g4[1]); o.y = pk2(q2 * rq * g4[2], q3 * rq * g4[3]);
        bf16_t* ar = AM + (size_t)row * 512;
        *(u32x2*)(ar + 4 * F.lane) = o;
        *(unsigned*)(ar + 256 + 2 * F.lane) = pk2(k0 * rk * g2[0], k1 * rk * g2[1]);
        *(unsigned*)(ar + 384 + 2 * F.lane) = 0u;
    }
}

DI void phase_mla_post(const Frame& F, CArgs& A, int l) {
    const bf16_t* Z = (const bf16_t*)(A.ws + WS_Z); const bf16_t* RAW = (const bf16_t*)(A.ws + WS_QKVRAW);
    bf16_t* Q = (bf16_t*)(A.ws + WS_Q); bf16_t* K = (bf16_t*)(A.ws + WS_K); bf16_t* VT = (bf16_t*)(A.ws + WS_VT);
    LAS float* cs = (LAS float*)F.lds;
    LAS bf16_t* vt = (LAS bf16_t*)(F.lds + 8192);
    const float* qhg = A.in[32] + l * 96; const float* khg = A.in[33] + l * 96;
    for (int tile = F.bid; tile < T / 64; tile += F.G) {
        const int t0 = tile * 64, b = t0 / SEQ, s0 = t0 % SEQ;
        int tz = F.tid; asm volatile("" : "+v"(tz));
        for (int idx = tz; idx < 1024; idx += NTHR) { const int tok = idx >> 4, i = idx & 15;
            const int pos = A.pos_off[b] + s0 + tok; const float inv = powf(10000.f, -(float)i * (1.f / 16.f));
            double ang = (double)(float)pos * (double)inv; ang -= 6.283185307179586 * floor(ang * 0.15915494309189535);
            float sn, cn; sincosf((float)ang, &sn, &cn); cs[idx * 2] = cn; cs[idx * 2 + 1] = sn; }
        lds_barrier();
        const int tok = tz >> 3, sub = tz & 7, h = sub >> 1, isk = sub & 1, t = t0 + tok;
        {
            float v[96];
            const bf16_t* p0 = isk ? RAW + (size_t)t * 1024 + 384 + 128 * h : RAW + (size_t)t * 1024 + 96 * h;
            const bf16_t* p1 = isk ? Z + (size_t)t * ZS + ZC_KPE : p0 + 64;
#pragma unroll
            for (int c = 0; c < 8; ++c) { const u32x4 w = *(const u32x4*)(p0 + 8 * c);
                v[8 * c] = bflo(w.x); v[8 * c + 1] = bfhi(w.x); v[8 * c + 2] = bflo(w.y); v[8 * c + 3] = bfhi(w.y); v[8 * c + 4] = bflo(w.z); v[8 * c + 5] = bfhi(w.z); v[8 * c + 6] = bflo(w.w); v[8 * c + 7] = bfhi(w.w); }
#pragma unroll
            for (int c = 0; c < 4; ++c) { const u32x4 w = *(const u32x4*)(p1 + 8 * c);
                v[64 + 8 * c] = bflo(w.x); v[65 + 8 * c] = bfhi(w.x); v[66 + 8 * c] = bflo(w.y); v[67 + 8 * c] = bfhi(w.y); v[68 + 8 * c] = bflo(w.z); v[69 + 8 * c] = bfhi(w.z); v[70 + 8 * c] = bflo(w.w); v[71 + 8 * c] = bfhi(w.w); }
            float ss = 0.f;
#pragma unroll
            for (int i = 0; i < 96; ++i) ss += v[i] * v[i];
            const float r = rsqrtf(ss * (1.f / 96.f) + NORM_EPS);
            const float* hg = isk ? khg : qhg;
#pragma unroll
            for (int i = 0; i < 96; ++i) v[i] = v[i] * r * hg[i];
#pragma unroll
            for (int i = 0; i < 16; ++i) { const float cn = cs[(tok * 16 + i) * 2], sn = cs[(tok * 16 + i) * 2 + 1]; const float x1 = v[64 + i], x2 = v[80 + i];
                v[64 + i] = x1 * cn - x2 * sn; v[80 + i] = x1 * sn + x2 * cn; }
            bf16_t* dst = (isk ? K : Q) + ((size_t)t * 4 + h) * 96;
#pragma unroll
            for (int c = 0; c < 12; ++c) { u32x4 w; w.x = pk2(v[8 * c], v[8 * c + 1]); w.y = pk2(v[8 * c + 2], v[8 * c + 3]); w.z = pk2(v[8 * c + 4], v[8 * c + 5]); w.w = pk2(v[8 * c + 6], v[8 * c + 7]);
                *(u32x4*)(dst + 8 * c) = w; }
        }
        {
            const bf16_t* pv = RAW + (size_t)t * 1024 + 384 + 128 * h + 64 + 32 * isk;
#pragma unroll
            for (int c = 0; c < 4; ++c) { const u32x4 w = *(const u32x4*)(pv + 8 * c); const int r0 = h * 64 + 32 * isk + 8 * c;
                vt[(r0 + 0) * 72 + tok] = (bf16_t)(w.x & 0xffffu); vt[(r0 + 1) * 72 + tok] = (bf16_t)(w.x >> 16);
                vt[(r0 + 2) * 72 + tok] = (bf16_t)(w.y & 0xffffu); vt[(r0 + 3) * 72 + tok] = (bf16_t)(w.y >> 16);
                vt[(r0 + 4) * 72 + tok] = (bf16_t)(w.z & 0xffffu); vt[(r0 + 5) * 72 + tok] = (bf16_t)(w.z >> 16);
                vt[(r0 + 6) * 72 + tok] = (bf16_t)(w.w & 0xffffu); vt[(r0 + 7) * 72 + tok] = (bf16_t)(w.w >> 16); }
        }
        lds_barrier();
        { const int row = tz >> 1, hf = tz & 1;
          bf16_t* dst = VT + ((size_t)(b * 4) * 64 + row) * SEQ + s0 + 32 * hf;
#pragma unroll
          for (int c = 0; c < 4; ++c) *(u32x4*)(dst + 8 * c) = *(const LAS u32x4*)(vt + row * 72 + 32 * hf + 8 * c); }
        lds_barrier();
    }
}

DI void attn_unit(const Frame& F, const bf16_t* Q, const bf16_t* K, const bf16_t* VT, bf16_t* O, int bh, int u) {
    constexpr int KP = 208, VP = 144, KB = 64 * KP, VB = 64 * VP;
    LAS unsigned char* Ks = F.lds; LAS unsigned char* Vs = F.lds + 2 * KB;
    const int b = bh >> 2, h = bh & 3, lane = F.lane, w = F.wave, ql = lane & 31, hh = lane >> 5;
    const int ntile = 4 * u + 4, myl = 4 * u + (w >> 1);
    const size_t tq = (size_t)b * SEQ + 256 * u + 32 * w + ql;
    bf16x8 qf[6];
#pragma unroll
    for (int s = 0; s < 6; ++s) qf[s] = *(const bf16x8*)(Q + (tq * 4 + h) * 96 + 16 * s + 8 * hh);
    f32x16 ot[2];
#pragma unroll
    for (int i = 0; i < 16; ++i) { ot[0][i] = 0.f; ot[1][i] = 0.f; }
    float mrun = -INFINITY, lrun = 0.f;
    const float c2 = 0.10206207261596577f * 1.4426950408889634f;
    const int kp0 = F.tid, kp1 = F.tid + 512;
    const size_t kbase = ((size_t)b * SEQ * 4 + h) * 96;
    const bf16_t* vsrc = VT + ((size_t)bh * 64 + (F.tid >> 3)) * SEQ + 8 * (F.tid & 7);
    u32x4 rk0, rk1, rv;
    rk1 = (u32x4){0u, 0u, 0u, 0u};
#define ATT_LOAD(j) do { rk0 = *(const u32x4*)(K + kbase + (size_t)(64 * (j) + kp0 / 12) * 384 + 8 * (kp0 % 12)); \
        if (kp1 < 768) rk1 = *(const u32x4*)(K + kbase + (size_t)(64 * (j) + kp1 / 12) * 384 + 8 * (kp1 % 12)); \
        rv = *(const u32x4*)(vsrc + 64 * (j)); } while (0)
#define ATT_STORE(buf) do { *(LAS u32x4*)(Ks + (buf) * KB + (kp0 / 12) * KP + (kp0 % 12) * 16) = rk0; \
        if (kp1 < 768) *(LAS u32x4*)(Ks + (buf) * KB + (kp1 / 12) * KP + (kp1 % 12) * 16) = rk1; \
        *(LAS u32x4*)(Vs + (buf) * VB + (F.tid >> 3) * VP + (F.tid & 7) * 16) = rv; } while (0)
    ATT_LOAD(0); ATT_STORE(0);
    __syncthreads();
    for (int j = 0; j < ntile; ++j) {
        const int buf = j & 1;
        if (j + 1 < ntile) ATT_LOAD(j + 1);
        if (j <= myl) {
            f32x16 st[2];
#pragma unroll
            for (int kt = 0; kt < 2; ++kt) {
#pragma unroll
                for (int i = 0; i < 16; ++i) st[kt][i] = 0.f;
#pragma unroll
                for (int s = 0; s < 6; ++s) { const bf16x8 kf = *(const LAS bf16x8*)(Ks + buf * KB + (32 * kt + ql) * KP + (16 * s + 8 * hh) * 2);
                    st[kt] = __builtin_amdgcn_mfma_f32_32x32x16_bf16(kf, qf[s], st[kt], 0, 0, 0); }
            }
            float mx = st[0][0];
#pragma unroll
            for (int i = 1; i < 16; ++i) mx = fmaxf(mx, st[0][i]);
#pragma unroll
            for (int i = 0; i < 16; ++i) mx = fmaxf(mx, st[1][i]);
            mx = fmaxf(mx, shfl_xor_l(mx, 32, lane));
            const float mnew = fmaxf(mrun, mx), alpha = __builtin_amdgcn_exp2f((mrun - mnew) * c2), mc = mnew * c2;
            mrun = mnew;
            float ps = 0.f;
#pragma unroll
            for (int kt = 0; kt < 2; ++kt)
#pragma unroll
                for (int i = 0; i < 16; ++i) { const float p = __builtin_amdgcn_exp2f(st[kt][i] * c2 - mc); st[kt][i] = p; ps += p; }
            lrun = lrun * alpha + ps;
#pragma unroll
            for (int i = 0; i < 16; ++i) { ot[0][i] *= alpha; ot[1][i] *= alpha; }
#pragma unroll
            for (int kt = 0; kt < 2; ++kt)
#pragma unroll
                for (int c = 0; c < 2; ++c) {
                    u32x4 pw; pw.x = pk2(st[kt][8 * c], st[kt][8 * c + 1]); pw.y = pk2(st[kt][8 * c + 2], st[kt][8 * c + 3]); pw.z = pk2(st[kt][8 * c + 4], st[kt][8 * c + 5]); pw.w = pk2(st[kt][8 * c + 6], st[kt][8 * c + 7]);
                    const bf16x8 pf = __builtin_bit_cast(bf16x8, pw);
                    const int key0 = 32 * kt + 16 * c + 4 * hh;
#pragma unroll
                    for (int dt = 0; dt < 2; ++dt) { const LAS unsigned char* vp = Vs + buf * VB + (32 * dt + ql) * VP + key0 * 2;
                        const u32x2 v0 = *(const LAS u32x2*)vp, v1 = *(const LAS u32x2*)(vp + 16);
                        u32x4 vw; vw.x = v0.x; vw.y = v0.y; vw.z = v1.x; vw.w = v1.y;
                        ot[dt] = __builtin_amdgcn_mfma_f32_32x32x16_bf16(__builtin_bit_cast(bf16x8, vw), pf, ot[dt], 0, 0, 0); }
                }
        }
        if (j + 1 < ntile) ATT_STORE(buf ^ 1);
        __syncthreads();
    }
#undef ATT_LOAD
#undef ATT_STORE
    const float linv = 1.f / (lrun + shfl_xor_l(lrun, 32, lane));
    bf16_t* orow = O + tq * 256 + h * 64;
#pragma unroll
    for (int dt = 0; dt < 2; ++dt)
#pragma unroll
        for (int g = 0; g < 4; ++g) { u32x2 o; o.x = pk2(ot[dt][4 * g] * linv, ot[dt][4 * g + 1] * linv); o.y = pk2(ot[dt][4 * g + 2] * linv, ot[dt][4 * g + 3] * linv);
            *(u32x2*)(orow + 32 * dt + 8 * g + 4 * hh) = o; }
}
DI void phase_attn(const Frame& F, CArgs& A) {
    const bf16_t* Q = (const bf16_t*)(A.ws + WS_Q); const bf16_t* K = (const bf16_t*)(A.ws + WS_K); const bf16_t* VT = (const bf16_t*)(A.ws + WS_VT);
    bf16_t* O = (bf16_t*)(A.ws + WS_ATTO);
    for (int p = F.bid; p < 512; p += F.G) { const int bh = p >> 4, u = p & 15;
        attn_unit(F, Q, K, VT, O, bh, 31 - u);
        attn_unit(F, Q, K, VT, O, bh, u); }
}

DI void phase_rwkv_prep(const Frame& F, CArgs& A, int l) {
    const bf16_t* Z = (const bf16_t*)(A.ws + WS_Z);
    bf16_t* R_ = (bf16_t*)(A.ws + WS_RW_R); bf16_t* K_ = (bf16_t*)(A.ws + WS_RW_K); bf16_t* V_ = (bf16_t*)(A.ws + WS_RW_V); bf16_t* KK_ = (bf16_t*)(A.ws + WS_RW_KK);
    bf16_t* B_ = (bf16_t*)(A.ws + WS_RW_B); bf16_t* G_ = (bf16_t*)(A.ws + WS_RW_G); float* W_ = (float*)(A.ws + WS_RW_W);
    const float* mu = A.in[7] + l * 896; const float* w0 = A.in[8] + l * 256; const float* a0 = A.in[10] + l * 256; const float* k_k = A.in[13] + l * 256; const float* k_a = A.in[14] + l * 256;
    const bf16_t* WO = (const bf16_t*)(A.ws + WS_WLORA) + (size_t)l * 32768;
    LAS float* hs = (LAS float*)F.lds;
    const int w = F.wave, c0 = 32 * w;
    bf16x8 w2f[2], a2f[2], g2f[2][2];
    { const int fr = F.lane & 15, fq = F.lane >> 4;
#pragma unroll
      for (int nf = 0; nf < 2; ++nf) { const int ch = c0 + 16 * nf + fr;
          w2f[nf] = *(const bf16x8*)(WO + ch * 32 + 8 * fq); a2f[nf] = *(const bf16x8*)(WO + 8192 + ch * 32 + 8 * fq);
          g2f[nf][0] = *(const bf16x8*)(WO + 16384 + ch * 64 + 8 * fq); g2f[nf][1] = *(const bf16x8*)(WO + 16384 + ch * 64 + 32 + 8 * fq); } }
    for (int tile = F.bid; tile < T / 64; tile += F.G) {
        int tz = F.tid; asm volatile("" : "+v"(tz)); const int lane = tz & 63, fr = lane & 15, fq = lane >> 4;
        const int t0 = tile * 64, s0 = t0 % SEQ;
        f32x4 aw[4][2], aa[4][2], ag[4][2];
#pragma unroll
        for (int m = 0; m < 4; ++m) {
            const size_t t = (size_t)t0 + 16 * m + fr; const bool hp = (s0 + 16 * m + fr) > 0;
            const bf16_t* zr = Z + t * ZS + ZC_WLO + 8 * fq;
            bf16x8 xf[4];
#pragma unroll
            for (int ks = 0; ks < 4; ++ks) {
                const u32x4 zc = *(const u32x4*)(zr + 32 * ks); u32x4 zp = {0u, 0u, 0u, 0u}; if (hp) zp = *(const u32x4*)(zr + 32 * ks - ZS);
                const f32x4 m0 = *(const f32x4*)(mu + ZC_WLO + 32 * ks + 8 * fq), m1 = *(const f32x4*)(mu + ZC_WLO + 32 * ks + 8 * fq + 4);
                const unsigned cw[4] = {zc.x, zc.y, zc.z, zc.w}, pw[4] = {zp.x, zp.y, zp.z, zp.w}; const float mm[8] = {m0[0], m0[1], m0[2], m0[3], m1[0], m1[1], m1[2], m1[3]};
                float v[8];
#pragma unroll
                for (int i = 0; i < 8; ++i) { const float zcv = (i & 1) ? bfhi(cw[i >> 1]) : bflo(cw[i >> 1]), zpv = (i & 1) ? bfhi(pw[i >> 1]) : bflo(pw[i >> 1]);
                    float x = zcv + (zpv - zcv) * mm[i]; if (ks == 0) x = tanhf(x); else if (ks >= 2) x = sigmoidf_(x); v[i] = x; }
                u32x4 o; o.x = pk2(v[0], v[1]); o.y = pk2(v[2], v[3]); o.z = pk2(v[4], v[5]); o.w = pk2(v[6], v[7]); xf[ks] = __builtin_bit_cast(bf16x8, o);
            }
#pragma unroll
            for (int nf = 0; nf < 2; ++nf) { const f32x4 z4 = {0.f, 0.f, 0.f, 0.f};
                aw[m][nf] = __builtin_amdgcn_mfma_f32_16x16x32_bf16(w2f[nf], xf[0], z4, 0, 0, 0);
                aa[m][nf] = __builtin_amdgcn_mfma_f32_16x16x32_bf16(a2f[nf], xf[1], z4, 0, 0, 0);
                ag[m][nf] = __builtin_amdgcn_mfma_f32_16x16x32_bf16(g2f[nf][0], xf[2], z4, 0, 0, 0);
                ag[m][nf] = __builtin_amdgcn_mfma_f32_16x16x32_bf16(g2f[nf][1], xf[3], ag[m][nf], 0, 0, 0); }
        }
#pragma unroll
        for (int m = 0; m < 4; ++m) {
            const size_t t = (size_t)t0 + 16 * m + fr; const bool hp = (s0 + 16 * m + fr) > 0; float ssq = 0.f;
#pragma unroll
            for (int nf = 0; nf < 2; ++nf) { const int ch4 = c0 + 16 * nf + 4 * fq;
                const u32x2 kc = *(const u32x2*)(Z + t * ZS + ZC_K + ch4); u32x2 kp = {0u, 0u}; if (hp) kp = *(const u32x2*)(Z + (t - 1) * ZS + ZC_K + ch4);
                const f32x4 mk = *(const f32x4*)(mu + ZC_K + ch4), kkw = *(const f32x4*)(k_k + ch4);
                const f32x4 kcv = {bflo(kc.x), bfhi(kc.x), bflo(kc.y), bfhi(kc.y)}, kpv = {bflo(kp.x), bfhi(kp.x), bflo(kp.y), bfhi(kp.y)};
                const f32x4 k = kcv + (kpv - kcv) * mk; const f32x4 q = k * kkw; ssq += q[0] * q[0] + q[1] * q[1] + q[2] * q[2] + q[3] * q[3]; }
            ssq += shfl_xor_l(ssq, 16, lane); ssq += shfl_xor_l(ssq, 32, lane);
            if (fq == 0) hs[w * 64 + 16 * m + fr] = ssq;
        }
        __syncthreads();
#pragma unroll
        for (int m = 0; m < 4; ++m) {
            const size_t t = (size_t)t0 + 16 * m + fr; const bool hp = (s0 + 16 * m + fr) > 0;
            const float nrm = sqrtf(hs[w * 64 + 16 * m + fr] + hs[(w ^ 1) * 64 + 16 * m + fr]); const float rn = 1.f / fmaxf(nrm, 1e-12f);
#pragma unroll
            for (int nf = 0; nf < 2; ++nf) { const int ch4 = c0 + 16 * nf + 4 * fq;
                const f32x4 wv = aw[m][nf] + *(const f32x4*)(w0 + ch4), av = aa[m][nf] + *(const f32x4*)(a0 + ch4), gv = ag[m][nf];
                const u32x2 rc = *(const u32x2*)(Z + t * ZS + ZC_R + ch4), kc = *(const u32x2*)(Z + t * ZS + ZC_K + ch4), vc = *(const u32x2*)(Z + t * ZS + ZC_V + ch4);
                u32x2 rp = {0u, 0u}, kp = {0u, 0u}, vp = {0u, 0u};
                if (hp) { rp = *(const u32x2*)(Z + (t - 1) * ZS + ZC_R + ch4); kp = *(const u32x2*)(Z + (t - 1) * ZS + ZC_K + ch4); vp = *(const u32x2*)(Z + (t - 1) * ZS + ZC_V + ch4); }
                const f32x4 mr = *(const f32x4*)(mu + ZC_R + ch4), mk = *(const f32x4*)(mu + ZC_K + ch4), mv = *(const f32x4*)(mu + ZC_V + ch4), ka = *(const f32x4*)(k_a + ch4), kkw = *(const f32x4*)(k_k + ch4);
                const f32x4 rcv = {bflo(rc.x), bfhi(rc.x), bflo(rc.y), bfhi(rc.y)}, rpv = {bflo(rp.x), bfhi(rp.x), bflo(rp.y), bfhi(rp.y)};
                const f32x4 kcv = {bflo(kc.x), bfhi(kc.x), bflo(kc.y), bfhi(kc.y)}, kpv = {bflo(kp.x), bfhi(kp.x), bflo(kp.y), bfhi(kp.y)};
                const f32x4 vcv = {bflo(vc.x), bfhi(vc.x), bflo(vc.y), bfhi(vc.y)}, vpv = {bflo(vp.x), bfhi(vp.x), bflo(vp.y), bfhi(vp.y)};
                const f32x4 r = rcv + (rpv - rcv) * mr, k = kcv + (kpv - kcv) * mk, v = vcv + (vpv - vcv) * mv;
                f32x4 lw, a4, km, kk, bb;
#pragma unroll
                for (int i = 0; i < 4; ++i) { lw[i] = -__expf(-softplusf_(-wv[i]) - 0.5f); a4[i] = sigmoidf_(av[i]); kk[i] = k[i] * kkw[i] * rn; km[i] = k[i] * (1.f + (a4[i] - 1.f) * ka[i]); bb[i] = kk[i] * a4[i]; }
                const size_t o = t * 256 + ch4;
                u32x2 p;
                p.x = pk2(r[0], r[1]); p.y = pk2(r[2], r[3]); *(u32x2*)(R_ + o) = p;
                p.x = pk2(km[0], km[1]); p.y = pk2(km[2], km[3]); *(u32x2*)(K_ + o) = p;
                p.x = pk2(v[0], v[1]); p.y = pk2(v[2], v[3]); *(u32x2*)(V_ + o) = p;
                p.x = pk2(kk[0], kk[1]); p.y = pk2(kk[2], kk[3]); *(u32x2*)(KK_ + o) = p;
                p.x = pk2(bb[0], bb[1]); p.y = pk2(bb[2], bb[3]); *(u32x2*)(B_ + o) = p;
                p.x = pk2(gv[0], gv[1]); p.y = pk2(gv[2], gv[3]); *(u32x2*)(G_ + o) = p;
                *(f32x4*)(W_ + o) = lw; }
        }
        __syncthreads();
    }
}

DI f32x16 mfma32(bf16x8 a, bf16x8 b, f32x16 c) { return __builtin_amdgcn_mfma_f32_32x32x16_bf16(a, b, c, 0, 0, 0); }
DI bf16x8 ldfrag(const LAS unsigned char* base, int row, int ks, int h) { return *(const LAS bf16x8*)(base + row * 144 + (16 * ks + 8 * h) * 2); }
DI f32x16 zero16() { f32x16 z;
#pragma unroll
    for (int i = 0; i < 16; ++i) z[i] = 0.f;
    return z; }
DI bf16x8 pack8(const f32x16& x, int o) { u32x4 p; p.x = pk2(x[o], x[o + 1]); p.y = pk2(x[o + 2], x[o + 3]); p.z = pk2(x[o + 4], x[o + 5]); p.w = pk2(x[o + 6], x[o + 7]); return __builtin_bit_cast(bf16x8, p); }
DI f32x16 tileprod(const LAS unsigned char* Aimg, int a0, const LAS unsigned char* Bimg, int b0, f32x16 acc, int lr, int h2) {
#pragma unroll
    for (int ks = 0; ks < 4; ++ks) acc = mfma32(ldfrag(Aimg, a0 + lr, ks, h2), ldfrag(Bimg, b0 + lr, ks, h2), acc);
    return acc;
}
DI void put_tile(LAS unsigned char* img, int c0, int r0, const f32x16& a, int lr, int h2) {
#pragma unroll
    for (int g = 0; g < 4; ++g) { u32x2 o; o.x = pk2(a[4 * g], a[4 * g + 1]); o.y = pk2(a[4 * g + 2], a[4 * g + 3]); *(LAS u32x2*)(img + (c0 + lr) * 144 + (r0 + 8 * g + 4 * h2) * 2) = o; }
}
DI void phase_rwkv_A(const Frame& F, CArgs& A, int l) {
    const bf16_t* Z = (const bf16_t*)(A.ws + WS_Z); bf16_t* V_ = (bf16_t*)(A.ws + WS_RW_V); bf16_t* G_ = (bf16_t*)(A.ws + WS_RW_G);
    const float* mu = A.in[7] + l * 896; const float* w0 = A.in[8] + l * 256; const float* a0 = A.in[10] + l * 256; const float* k_k = A.in[13] + l * 256; const float* k_a = A.in[14] + l * 256;
    const bf16_t* WO = (const bf16_t*)(A.ws + WS_WLORA) + (size_t)l * 32768;
    bf16_t* RP = (bf16_t*)(A.ws + WS_RC_RP); float* Y0T = (float*)(A.ws + WS_RC_Y0); unsigned char* REC = A.ws + WS_RC_G;
    float* BSUM = (float*)(A.ws + WS_RC_BS);
    const float* r_k = A.in[15] + l * 256;
    constexpr int TB = 64 * 144;
#define TILE(i) (F.lds + (i) * TB)
    LAS float* XF = (LAS float*)TILE(13);
    const int w = F.wave;
    for (int ub = F.bid; ub < 1024; ub += F.G) {
      const int b = ub >> 7, c = ub & 127;
      const size_t t0 = (size_t)b * SEQ + 64 * c;
      bf16x8 xf[4];
      {
        int tid = F.tid; asm volatile("" : "+v"(tid)); const int lane = tid & 63, fr = lane & 15, fq = lane >> 4, mt = w & 3;
        const int tk = 16 * mt + fr; const size_t t = t0 + tk; const bool hp = (64 * c + tk) > 0;
        const bf16_t* zr = Z + t * ZS + ZC_WLO + 8 * fq;
#pragma unroll
        for (int ks = 0; ks < 4; ++ks) {
            const u32x4 zc = *(const u32x4*)(zr + 32 * ks); u32x4 zp = {0u, 0u, 0u, 0u}; if (hp) zp = *(const u32x4*)(zr + 32 * ks - ZS);
            const f32x4 m0 = *(const f32x4*)(mu + ZC_WLO + 32 * ks + 8 * fq), m1 = *(const f32x4*)(mu + ZC_WLO + 32 * ks + 8 * fq + 4);
            const unsigned cw[4] = {zc.x, zc.y, zc.z, zc.w}, pw[4] = {zp.x, zp.y, zp.z, zp.w}; const float mm[8] = {m0[0], m0[1], m0[2], m0[3], m1[0], m1[1], m1[2], m1[3]};
            float v[8];
#pragma unroll
            for (int i = 0; i < 8; ++i) { const float zcv = (i & 1) ? bfhi(cw[i >> 1]) : bflo(cw[i >> 1]), zpv = (i & 1) ? bfhi(pw[i >> 1]) : bflo(pw[i >> 1]);
                float x = zcv + (zpv - zcv) * mm[i]; if (ks == 0) x = fast_tanh(x); else if (ks >= 2) x = sigmoidf_(x); v[i] = x; }
            u32x4 o; o.x = pk2(v[0], v[1]); o.y = pk2(v[2], v[3]); o.z = pk2(v[4], v[5]); o.w = pk2(v[6], v[7]); xf[ks] = __builtin_bit_cast(bf16x8, o);
        }
      }
      for (int hd = 0; hd < 4; ++hd) {
        const int u = (b * 4 + hd) * 128 + c;
        {
        int tid = F.tid; asm volatile("" : "+v"(tid)); const int lane = tid & 63, fr = lane & 15, fq = lane >> 4, mt = w & 3, nh = w >> 2;
        const int tk = 16 * mt + fr; const size_t t = t0 + tk; const bool hp = (64 * c + tk) > 0;
        LAS float* hs = (LAS float*)TILE(12);
        f32x4 aw[2], aa[2], ag[2];
        {
#pragma unroll
            for (int nf = 0; nf < 2; ++nf) { const int ch = hd * 64 + 32 * nh + 16 * nf + fr; const f32x4 z4 = {0.f, 0.f, 0.f, 0.f};
                aw[nf] = __builtin_amdgcn_mfma_f32_16x16x32_bf16(*(const bf16x8*)(WO + ch * 32 + 8 * fq), xf[0], z4, 0, 0, 0);
                aa[nf] = __builtin_amdgcn_mfma_f32_16x16x32_bf16(*(const bf16x8*)(WO + 8192 + ch * 32 + 8 * fq), xf[1], z4, 0, 0, 0);
                ag[nf] = __builtin_amdgcn_mfma_f32_16x16x32_bf16(*(const bf16x8*)(WO + 16384 + ch * 64 + 8 * fq), xf[2], z4, 0, 0, 0);
                ag[nf] = __builtin_amdgcn_mfma_f32_16x16x32_bf16(*(const bf16x8*)(WO + 16384 + ch * 64 + 32 + 8 * fq), xf[3], ag[nf], 0, 0, 0); }
        }
        f32x4 rr[2], kq[2], km[2], vv4[2], lw4[2], a4[2];
        float ssq = 0.f, bsp = 0.f;
#pragma unroll
        for (int nf = 0; nf < 2; ++nf) { const int d4 = 32 * nh + 16 * nf + 4 * fq, ch4 = hd * 64 + d4;
            const u32x2 rc = *(const u32x2*)(Z + t * ZS + ZC_R + ch4), kc = *(const u32x2*)(Z + t * ZS + ZC_K + ch4), vc = *(const u32x2*)(Z + t * ZS + ZC_V + ch4);
            u32x2 rp = {0u, 0u}, kp = {0u, 0u}, vp = {0u, 0u};
            if (hp) { rp = *(const u32x2*)(Z + (t - 1) * ZS + ZC_R + ch4); kp = *(const u32x2*)(Z + (t - 1) * ZS + ZC_K + ch4); vp = *(const u32x2*)(Z + (t - 1) * ZS + ZC_V + ch4); }
            const f32x4 mr = *(const f32x4*)(mu + ZC_R + ch4), mk = *(const f32x4*)(mu + ZC_K + ch4), mv = *(const f32x4*)(mu + ZC_V + ch4), ka = *(const f32x4*)(k_a + ch4), kkw = *(const f32x4*)(k_k + ch4), rk4 = *(const f32x4*)(r_k + ch4);
            const f32x4 rcv = {bflo(rc.x), bfhi(rc.x), bflo(rc.y), bfhi(rc.y)}, rpv = {bflo(rp.x), bfhi(rp.x), bflo(rp.y), bfhi(rp.y)};
            const f32x4 kcv = {bflo(kc.x), bfhi(kc.x), bflo(kc.y), bfhi(kc.y)}, kpv = {bflo(kp.x), bfhi(kp.x), bflo(kp.y), bfhi(kp.y)};
            const f32x4 vcv = {bflo(vc.x), bfhi(vc.x), bflo(vc.y), bfhi(vc.y)}, vpv = {bflo(vp.x), bfhi(vp.x), bflo(vp.y), bfhi(vp.y)};
            const f32x4 r = rcv + (rpv - rcv) * mr, k = kcv + (kpv - kcv) * mk, v = vcv + (vpv - vcv) * mv;
            const f32x4 wv = aw[nf] + *(const f32x4*)(w0 + ch4), av = aa[nf] + *(const f32x4*)(a0 + ch4);
#pragma unroll
            for (int i = 0; i < 4; ++i) { lw4[nf][i] = -__expf(-fast_softplus(-wv[i]) - 0.5f); a4[nf][i] = sigmoidf_(av[i]); kq[nf][i] = k[i] * kkw[i]; km[nf][i] = k[i] * (1.f + (a4[nf][i] - 1.f) * ka[i]);
                ssq += kq[nf][i] * kq[nf][i]; bsp += r[i] * km[nf][i] * rk4[i]; }
            rr[nf] = r; vv4[nf] = v;
            *(LAS f32x4*)(XF + tk * 64 + d4) = lw4[nf];
            u32x2 p; p.x = pk2(ag[nf][0], ag[nf][1]); p.y = pk2(ag[nf][2], ag[nf][3]); *(u32x2*)(G_ + t * 256 + ch4) = p;
            p.x = pk2(v[0], v[1]); p.y = pk2(v[2], v[3]); *(u32x2*)(V_ + t * 256 + ch4) = p;
        }
        ssq += shfl_xor_l(ssq, 16, lane); ssq += shfl_xor_l(ssq, 32, lane); bsp += shfl_xor_l(bsp, 16, lane); bsp += shfl_xor_l(bsp, 32, lane);
        if (fq == 0) { hs[nh * 64 + tk] = ssq; hs[128 + nh * 64 + tk] = bsp; }
        lds_barrier();
        if (w == 0) { float cv[64];
#pragma unroll
            for (int i = 0; i < 64; ++i) cv[i] = XF[i * 64 + lane];
            float run = 0.f;
#pragma unroll
            for (int i = 0; i < 64; ++i) { run += cv[i]; XF[i * 64 + lane] = run; } }
        if (w == 1) BSUM[(t0 + lane) * 4 + hd] = hs[128 + lane] + hs[192 + lane];
        lds_barrier();
        const float rn = rsqrtf(fmaxf(hs[tk] + hs[64 + tk], 1e-24f));
#pragma unroll
        for (int nf = 0; nf < 2; ++nf) { const int d4 = 32 * nh + 16 * nf + 4 * fq;
            const f32x4 cum = *(const LAS f32x4*)(XF + tk * 64 + d4), c63 = *(const LAS f32x4*)(XF + 63 * 64 + d4);
            f32x4 al, bt, kt, rb, bhh, khh;
#pragma unroll
            for (int i = 0; i < 4; ++i) { const float kk = kq[nf][i] * rn; const float ec = __expf(cum[i]), em = __builtin_amdgcn_rcpf(ec), ep = __expf(cum[i] - lw4[nf][i]), p63 = __expf(c63[i]);
                al[i] = -kk * ep; bt[i] = kk * a4[nf][i] * em; kt[i] = km[nf][i] * em; rb[i] = rr[nf][i] * ec; bhh[i] = bt[i] * p63; khh[i] = kt[i] * p63;
                if (tk == 63) *(float*)(REC + (size_t)u * RC_REC + 24576 + (d4 + i) * 4) = p63; }
            u32x2 o;
            o.x = pk2(al[0], al[1]); o.y = pk2(al[2], al[3]); *(LAS u32x2*)(TILE(0) + tk * 144 + d4 * 2) = o;
            o.x = pk2(bt[0], bt[1]); o.y = pk2(bt[2], bt[3]); *(LAS u32x2*)(TILE(1) + tk * 144 + d4 * 2) = o;
            o.x = pk2(kt[0], kt[1]); o.y = pk2(kt[2], kt[3]); *(LAS u32x2*)(TILE(2) + tk * 144 + d4 * 2) = o;
            o.x = pk2(rb[0], rb[1]); o.y = pk2(rb[2], rb[3]); *(LAS u32x2*)(TILE(3) + tk * 144 + d4 * 2) = o;
#pragma unroll
            for (int i = 0; i < 4; ++i) { *(LAS bf16_t*)(TILE(4) + (d4 + i) * 144 + tk * 2) = (bf16_t)f2bf(vv4[nf][i]); *(LAS bf16_t*)(TILE(5) + (d4 + i) * 144 + tk * 2) = (bf16_t)f2bf(bhh[i]);
                *(LAS bf16_t*)(TILE(6) + (d4 + i) * 144 + tk * 2) = (bf16_t)f2bf(khh[i]); *(LAS bf16_t*)(TILE(7) + (d4 + i) * 144 + tk * 2) = (bf16_t)f2bf(al[i]); }
        }
        }
        lds_barrier();
        f32x16 Tacc = zero16();
        {
        int tl = F.tid; asm volatile("" : "+v"(tl)); const int lane = tl & 63, lr = lane & 31, h2 = lane >> 5;
        unsigned zz = 0u; asm volatile("" : "+v"(zz));
        for (int i = tl; i < 768; i += NTHR) { const int q = i >> 7, rr = (i & 127) >> 2, cc = i & 3; const int tile = q < 4 ? 8 + q : q == 4 ? 14 : 12;
            *(LAS u32x4*)(TILE(tile) + (q == 5 ? (32 + rr) * 144 : rr * 144 + 64) + cc * 16) = (u32x4){zz, zz, zz, zz}; }
#pragma unroll
        for (int rnd = 0; rnd < 2; ++rnd) {
            const int j = w + 8 * rnd;
            if (j < 15) {
                const int prod = j / 3, tile = j % 3, si = tile == 2 ? 1 : 0, ti = tile == 0 ? 0 : 1;
                if (prod == 1) {
                    f32x16 acc = tileprod(TILE(0), 32 * ti, TILE(1), 32 * si, zero16(), lr, h2);
                    const int ss = 32 * si + lr;
#pragma unroll
                    for (int q = 0; q < 16; ++q) { const int tt = 32 * ti + 8 * (q >> 2) + 4 * h2 + (q & 3); if (!(ss < tt)) acc[q] = 0.f; }
                    put_tile(TILE(12), 32 * si, 32 * ti, acc, lr, h2);
                } else {
                    const LAS unsigned char* Ao = (prod == 0 || prod == 3) ? TILE(1) : TILE(2); const LAS unsigned char* Bo = prod >= 3 ? TILE(3) : TILE(0);
                    f32x16 acc = tileprod(Ao, 32 * si, Bo, 32 * ti, zero16(), lr, h2);
                    const int tt = 32 * ti + lr, incl = prod >= 3 ? 1 : 0;
#pragma unroll
                    for (int q = 0; q < 16; ++q) { const int ss = 32 * si + 8 * (q >> 2) + 4 * h2 + (q & 3); if (!(ss < tt + incl)) acc[q] = 0.f; }
                    if (prod == 0) { put_tile(TILE(11), 32 * ti, 32 * si, acc, lr, h2);
#pragma unroll
                        for (int q = 0; q < 16; ++q) { const int ss = 32 * si + 8 * (q >> 2) + 4 * h2 + (q & 3); Tacc[q] = acc[q] + (ss == tt ? 1.f : 0.f); }
                        put_tile(TILE(14), 32 * ti, 32 * si, Tacc, lr, h2);
                    } else put_tile(TILE(prod == 2 ? 8 : prod == 3 ? 9 : 10), 32 * ti, 32 * si, acc, lr, h2);
                }
            }
        }
        }
        lds_barrier();
        {
        int tl = F.tid; asm volatile("" : "+v"(tl)); const int lane = tl & 63, lr = lane & 31, h2 = lane >> 5;
        if (tl < 384) { const int q = tl >> 7, rr = (tl & 127) >> 2, cc = tl & 3;
            unsigned zz = 0u; asm volatile("" : "+v"(zz));
            *(LAS u32x4*)(TILE(q) + (q == 1 ? (32 + rr) * 144 : rr * 144 + 64) + cc * 16) = (u32x4){zz, zz, zz, zz}; }
        lds_barrier();
#pragma unroll
        for (int k = 1; k <= 5; ++k) {
            LAS unsigned char* Ss = (k & 1) ? TILE(11) : TILE(0); LAS unsigned char* STs = (k & 1) ? TILE(12) : TILE(1);
            LAS unsigned char* Sd = (k & 1) ? TILE(0) : TILE(11); LAS unsigned char* STd = (k & 1) ? TILE(1) : TILE(12);
            LAS unsigned char* Ts = (k & 1) ? TILE(14) : TILE(2); LAS unsigned char* Td = (k & 1) ? TILE(2) : TILE(14);
            if (w < 6) { const int tile = w % 3, ti = tile == 0 ? 0 : 1, si = tile == 2 ? 1 : 0;
                if (w < 3) { f32x16 acc = tileprod(Ss, 32 * ti, STs, 32 * si, zero16(), lr, h2); put_tile(STd, 32 * si, 32 * ti, acc, lr, h2); }
                else { f32x16 acc = tileprod(STs, 32 * si, Ss, 32 * ti, zero16(), lr, h2); put_tile(Sd, 32 * ti, 32 * si, acc, lr, h2); }
            } else if (k == 1) {
#pragma unroll
                for (int jj = 0; jj < 2; ++jj) { const int tile = (w - 6) * 2 + jj, ti = tile >> 1, ei = tile & 1;
                    f32x16 acc = tileprod(TILE(8), 32 * ti, TILE(4), 32 * ei, zero16(), lr, h2); put_tile(TILE(13), 32 * ei, 32 * ti, acc, lr, h2); }
            }
            lds_barrier();
            if (w < 3) { const int si = w == 2 ? 1 : 0, ti = w == 0 ? 0 : 1;
                Tacc = tileprod(STd, 32 * si, Ts, 32 * ti, Tacc, lr, h2); put_tile(Td, 32 * ti, 32 * si, Tacc, lr, h2); }
        }
        lds_barrier();
        { const int tile = w & 3, ti = tile >> 1, ci = tile & 1;
          f32x16 acc = tileprod(TILE(2), 32 * ti, w < 4 ? TILE(13) : TILE(7), 32 * ci, zero16(), lr, h2); put_tile(w < 4 ? TILE(11) : TILE(12), 32 * ci, 32 * ti, acc, lr, h2); }
        }
        lds_barrier();
        {
        int tl = F.tid; asm volatile("" : "+v"(tl)); const int lane = tl & 63, lr = lane & 31, h2 = lane >> 5; const int tj = w & 3, ta = tj >> 1, tb = tj & 1;
        if (w < 4) {
            { f32x16 acc = tileprod(TILE(12), 32 * ta, TILE(9), 32 * tb, zero16(), lr, h2);
              const int tt = 32 * tb + lr;
#pragma unroll
              for (int g = 0; g < 4; ++g) { const int dd = 32 * ta + 8 * g + 4 * h2; const u32x2 rbv = *(const LAS u32x2*)(TILE(3) + tt * 144 + dd * 2);
                  u32x2 o; o.x = pk2(acc[4 * g] + bflo(rbv.x), acc[4 * g + 1] + bfhi(rbv.x)); o.y = pk2(acc[4 * g + 2] + bflo(rbv.y), acc[4 * g + 3] + bfhi(rbv.y));
                  *(u32x2*)(RP + ((size_t)u * 64 + tt) * 64 + dd) = o; } }
            { f32x16 acc = tileprod(TILE(12), 32 * ta, TILE(5), 32 * tb, zero16(), lr, h2);
              const int dcol = 32 * tb + lr;
#pragma unroll
              for (int g = 0; g < 4; ++g) { u32x2 o; o.x = pk2(acc[4 * g], acc[4 * g + 1]); o.y = pk2(acc[4 * g + 2], acc[4 * g + 3]);
                  *(u32x2*)(REC + (size_t)u * RC_REC + ((((dcol >> 4) * 2 + ta) * 64 + (2 * (g & 1) + h2) * 16 + (dcol & 15)) * 16) + 8 * (g >> 1)) = o; } }
        } else {
            f32x16 z2 = tileprod(TILE(4), 32 * ta, TILE(10), 32 * tb, zero16(), lr, h2);
            z2 = tileprod(TILE(11), 32 * ta, TILE(9), 32 * tb, z2, lr, h2);
            float* yo = Y0T + ((size_t)u * 64 + 32 * tb + lr) * 64 + 32 * ta + 4 * h2;
#pragma unroll
            for (int g = 0; g < 4; ++g) *(f32x4*)(yo + 8 * g) = (f32x4){z2[4 * g], z2[4 * g + 1], z2[4 * g + 2], z2[4 * g + 3]};
            f32x16 acc = tileprod(TILE(5), 32 * ta, TILE(11), 32 * tb, zero16(), lr, h2);
            acc = tileprod(TILE(6), 32 * ta, TILE(4), 32 * tb, acc, lr, h2);
            const int ecol = 32 * tb + lr;
#pragma unroll
            for (int g = 0; g < 4; ++g) *(f32x4*)(REC + (size_t)u * RC_REC + 8192 + ((((ecol >> 4) * 4 + 2 * ta + (g >> 1)) * 64 + (2 * (g & 1) + h2) * 16 + (ecol & 15)) * 16)) = (f32x4){acc[4 * g], acc[4 * g + 1], acc[4 * g + 2], acc[4 * g + 3]};
        }
        }
        lds_barrier();
      }
    }
#undef TILE
}
DI void phase_rwkv_B(const Frame& F, CArgs& A) {
    if (F.bid >= 32) return;
    const unsigned char* REC = A.ws + WS_RC_G; bf16_t* HB = (bf16_t*)(A.ws + WS_RC_HB);
    constexpr int SLOT = 25600, NSLOT = 4;
    const int bh = F.bid, w = F.wave, lane = F.lane, fr = lane & 15, fq = lane >> 4;
    const unsigned char* rec0 = REC + (size_t)bh * 128 * RC_REC;
    if (w >= 4) {
        const int lw = w - 4;
#define RB_ISSUE2(cs, cr) do { const unsigned char* r_ = rec0 + (size_t)(cr) * RC_REC; LAS unsigned char* s_ = F.lds + ((cs) & (NSLOT - 1)) * SLOT; \
        _Pragma("unroll") for (int k = 0; k < 6; ++k) __builtin_amdgcn_global_load_lds((const unsigned*)(r_ + (lw + 4 * k) * 1024 + lane * 16), (LAS unsigned*)(s_ + (lw + 4 * k) * 1024), 16, 0, 0); \
        if (lw == 3) __builtin_amdgcn_global_load_lds((const unsigned*)(r_ + 24576 + lane * 4), (LAS unsigned*)(s_ + 24576), 4, 0, 0); } while (0)
        RB_ISSUE2(0, 0); RB_ISSUE2(1, 1); RB_ISSUE2(2, 2);
        if (lw == 3) asm volatile("s_waitcnt vmcnt(14)" ::: "memory"); else asm volatile("s_waitcnt vmcnt(12)" ::: "memory");
        __builtin_amdgcn_s_barrier();
        for (int c = 0; c < 128; ++c) {
            RB_ISSUE2(c + 3, (c + 3 < 128) ? c + 3 : 127);
            if (lw == 3) asm volatile("s_waitcnt vmcnt(14)" ::: "memory"); else asm volatile("s_waitcnt vmcnt(12)" ::: "memory");
            __builtin_amdgcn_s_barrier();
        }
        asm volatile("s_waitcnt vmcnt(0)" ::: "memory");
#undef RB_ISSUE2
    } else {
        const int ew = w;
        f32x4 acc[4];
#pragma unroll
        for (int dt = 0; dt < 4; ++dt) acc[dt] = (f32x4){0.f, 0.f, 0.f, 0.f};
        __builtin_amdgcn_s_barrier();
        for (int c = 0; c < 128; ++c) {
            const size_t u = (size_t)bh * 128 + c;
            const LAS unsigned char* sl = F.lds + (c & (NSLOT - 1)) * SLOT;
            bf16x8 hb[2];
#pragma unroll
            for (int sk = 0; sk < 2; ++sk) { u32x4 p; p.x = pk2(acc[2 * sk][0], acc[2 * sk][1]); p.y = pk2(acc[2 * sk][2], acc[2 * sk][3]); p.z = pk2(acc[2 * sk + 1][0], acc[2 * sk + 1][1]); p.w = pk2(acc[2 * sk + 1][2], acc[2 * sk + 1][3]);
                hb[sk] = __builtin_bit_cast(bf16x8, p); *(bf16x8*)(HB + (((u * 4 + ew) * 2 + sk) * 64 + lane) * 8) = hb[sk]; }
#pragma unroll
            for (int dt = 0; dt < 4; ++dt) {
                const f32x4 g4 = *(const LAS f32x4*)(sl + 8192 + ((ew * 4 + dt) * 64 + lane) * 16), d4 = *(const LAS f32x4*)(sl + 24576 + (16 * dt + 4 * fq) * 4);
                const bf16x8 m0 = *(const LAS bf16x8*)(sl + ((dt * 2 + 0) * 64 + lane) * 16), m1 = *(const LAS bf16x8*)(sl + ((dt * 2 + 1) * 64 + lane) * 16);
                f32x4 n = d4 * acc[dt] + g4;
                n = __builtin_amdgcn_mfma_f32_16x16x32_bf16(m0, hb[0], n, 0, 0, 0); n = __builtin_amdgcn_mfma_f32_16x16x32_bf16(m1, hb[1], n, 0, 0, 0); acc[dt] = n; }
            asm volatile("s_waitcnt lgkmcnt(0)" ::: "memory");
            __builtin_amdgcn_s_barrier();
        }
    }
}
DI void phase_rwkv_C(const Frame& F, CArgs& A, int l) {
    const bf16_t* RP = (const bf16_t*)(A.ws + WS_RC_RP); const float* Y0 = (const float*)(A.ws + WS_RC_Y0); const bf16_t* HB = (const bf16_t*)(A.ws + WS_RC_HB); const float* BSUM = (const float*)(A.ws + WS_RC_BS);
    const bf16_t* V_ = (const bf16_t*)(A.ws + WS_RW_V); const bf16_t* G_ = (const bf16_t*)(A.ws + WS_RW_G); bf16_t* MIX = (bf16_t*)(A.ws + WS_MIX);
    const float* ln_w = A.in[16] + l * 256; const float* ln_b = A.in[17] + l * 256;
    for (int job = F.gw; job < 4096; job += F.ngw) {
        int lz = F.lane; asm volatile("" : "+v"(lz)); const int lane = lz, fr = lane & 15, fq = lane >> 4;
        const size_t u = (size_t)job; const int bh = job >> 7, c = job & 127, b = bh >> 2, hd = bh & 3;
        bf16x8 hf[4][2];
#pragma unroll
        for (int et = 0; et < 4; ++et)
#pragma unroll
            for (int sk = 0; sk < 2; ++sk) hf[et][sk] = *(const bf16x8*)(HB + (((u * 4 + et) * 2 + sk) * 64 + lane) * 8);
#pragma unroll
        for (int tb = 0; tb < 4; ++tb) {
            const size_t tok = (size_t)b * SEQ + 64 * c + 16 * tb + fr;
            const bf16_t* rrow = RP + (u * 64 + 16 * tb + fr) * 64 + 4 * fq;
            bf16x8 bfr[2];
#pragma unroll
            for (int sk = 0; sk < 2; ++sk) { const u32x2 m0 = *(const u32x2*)(rrow + 32 * sk), m1 = *(const u32x2*)(rrow + 32 * sk + 16); u32x4 mw; mw.x = m0.x; mw.y = m0.y; mw.z = m1.x; mw.w = m1.y; bfr[sk] = __builtin_bit_cast(bf16x8, mw); }
            f32x4 y[4]; float sm = 0.f;
#pragma unroll
            for (int et = 0; et < 4; ++et) { y[et] = *(const f32x4*)(Y0 + (u * 64 + 16 * tb + fr) * 64 + 16 * et + 4 * fq);
                y[et] = __builtin_amdgcn_mfma_f32_16x16x32_bf16(hf[et][0], bfr[0], y[et], 0, 0, 0); y[et] = __builtin_amdgcn_mfma_f32_16x16x32_bf16(hf[et][1], bfr[1], y[et], 0, 0, 0); }
#pragma unroll
            for (int et = 0; et < 4; ++et) sm += (y[et][0] + y[et][1]) + (y[et][2] + y[et][3]);
            sm += shfl_xor_l(sm, 16, lane); sm += shfl_xor_l(sm, 32, lane); const float mean = sm * (1.f / 64.f);
            float sq = 0.f;
#pragma unroll
            for (int et = 0; et < 4; ++et) { const f32x4 d = y[et] - mean; sq += (d[0] * d[0] + d[1] * d[1]) + (d[2] * d[2] + d[3] * d[3]); }
            sq += shfl_xor_l(sq, 16, lane); sq += shfl_xor_l(sq, 32, lane); const float rstd = rsqrtf(sq * (1.f / 64.f) + 64e-5f);
            const float bs = BSUM[tok * 4 + hd];
#pragma unroll
            for (int et = 0; et < 4; ++et) { const int e0 = hd * 64 + 16 * et + 4 * fq;
                const f32x4 lw = *(const f32x4*)(ln_w + e0), lb = *(const f32x4*)(ln_b + e0);
                const u32x2 vv = *(const u32x2*)(V_ + tok * 256 + e0), gv = *(const u32x2*)(G_ + tok * 256 + e0);
                const float o0 = ((y[et][0] - mean) * rstd * lw[0] + lb[0] + bs * bflo(vv.x)) * bflo(gv.x), o1 = ((y[et][1] - mean) * rstd * lw[1] + lb[1] + bs * bfhi(vv.x)) * bfhi(gv.x);
                const float o2 = ((y[et][2] - mean) * rstd * lw[2] + lb[2] + bs * bflo(vv.y)) * bflo(gv.y), o3 = ((y[et][3] - mean) * rstd * lw[3] + lb[3] + bs * bfhi(vv.y)) * bfhi(gv.y);
                u32x2 o; o.x = pk2(o0, o1); o.y = pk2(o2, o3);
                *(u32x2*)(MIX + tok * DM + e0) = o; }
        }
    }
}

template <int PASS>
DI void phase_s5(const Frame& F, CArgs& A, int l) {
    const bf16_t* Z = (const bf16_t*)(A.ws + WS_Z); float* SEND = (float*)(A.ws + WS_S5END); bf16_t* YS = (bf16_t*)(A.ws + WS_YS5);
    const bf16_t* BBt = (const bf16_t*)(A.ws + WS_S5BB); const bf16_t* CCt = (const bf16_t*)(A.ws + WS_S5CC);
    LAS unsigned char* himg = F.lds + F.wave * 17408;
    for (int it = F.gw; it < 8 * 16 * 16; it += F.ngw) {
        int lz = F.lane; asm volatile("" : "+v"(lz)); const int lane = lz, lr = lane & 31, hh = lane >> 5;
        const int b = it >> 8, g = (it >> 4) & 15, seg = it & 15, lg = l * 16 + g;
        const float dt = __expf(A.in[25][lg]);
        float are[2], aim[2], cr[2], ci[2];
        bf16x8 bbf[2][2];
#pragma unroll
        for (int st = 0; st < 2; ++st) { const int p = 32 * st + lr;
            const float lre = A.in[18][lg * 64 + p], lim = A.in[19][lg * 64 + p]; const float mag = expf(lre * dt); float sn, cn; sincosf(lim * dt, &sn, &cn); are[st] = mag * cn; aim[st] = mag * sn;
            cr[st] = 0.f; ci[st] = 0.f;
            if (PASS == 2) { const float m512 = expf(512.f * lre * dt); float s5, c5; sincosf(512.f * (lim * dt), &s5, &c5); const float pr = m512 * c5, pi_ = m512 * s5;
                for (int j = 0; j < seg; ++j) { const float* e = SEND + ((size_t)((b * 16 + g) * 16 + j)) * 128; const float er = e[p], ei = e[64 + p];
                    const float nr = pr * cr[st] - pi_ * ci[st] + er, ni = pr * ci[st] + pi_ * cr[st] + ei; cr[st] = nr; ci[st] = ni; } }
#pragma unroll
            for (int part = 0; part < 2; ++part) bbf[part][st] = *(const bf16x8*)(BBt + (((size_t)lg * 2 + part) * 64 + p) * 16 + 8 * hh); }
        bf16x8 ccf[4];
        if (PASS == 2) {
#pragma unroll
            for (int ks = 0; ks < 4; ++ks) ccf[ks] = *(const bf16x8*)(CCt + ((size_t)lg * 16 + (lane & 15)) * 128 + 32 * ks + 8 * (lane >> 4)); }
        for (int ch = 0; ch < 8; ++ch) {
            const size_t tok0 = (size_t)b * SEQ + seg * 512 + ch * 64;
#pragma unroll
            for (int tk = 0; tk < 2; ++tk) {
                const bf16x8 uf = *(const bf16x8*)(Z + (tok0 + 32 * tk + lr) * ZS + ZC_S5 + g * 16 + 8 * hh);
                f32x16 xr[2], xi[2];
#pragma unroll
                for (int st = 0; st < 2; ++st) { xr[st] = mfma32(uf, bbf[0][st], zero16()); xi[st] = mfma32(uf, bbf[1][st], zero16()); }
                asm volatile("s_nop 15\n\ts_nop 15" : "+v"(xr[0]), "+v"(xi[0]), "+v"(xr[1]), "+v"(xi[1]));
#pragma unroll
                for (int j = 0; j < 4; ++j) {
#pragma unroll
                    for (int half = 0; half < 2; ++half) {
                        const bool act = (hh == half);
#pragma unroll
                        for (int st = 0; st < 2; ++st) { float tr = cr[st], ti = ci[st];
#pragma unroll
                            for (int q = 0; q < 4; ++q) { const float nr = are[st] * tr - aim[st] * ti + xr[st][4 * j + q], ni = are[st] * ti + aim[st] * tr + xi[st][4 * j + q];
                                tr = nr; ti = ni; xr[st][4 * j + q] = act ? nr : xr[st][4 * j + q]; xi[st][4 * j + q] = act ? ni : xi[st][4 * j + q]; }
                            const float pr = shfl_xor_l(tr, 32, lane), pi2 = shfl_xor_l(ti, 32, lane);
                            cr[st] = act ? tr : pr; ci[st] = act ? ti : pi2; }
                    }
                }
                if (PASS == 2) {
                    unsigned hb = (unsigned)(uintptr_t)(himg + (4 * hh) * 272 + lr * 2); asm volatile("" : "+v"(hb));
                    LAS unsigned char* hp = (LAS unsigned char*)(uintptr_t)hb;
#pragma unroll
                    for (int st = 0; st < 2; ++st)
#pragma unroll
                        for (int q = 0; q < 16; ++q) { const int trow = 32 * tk + 8 * (q >> 2) + (q & 3);
                            *(LAS bf16_t*)(hp + trow * 272 + 64 * st) = (bf16_t)f2bf(xr[st][q]); *(LAS bf16_t*)(hp + trow * 272 + 128 + 64 * st) = (bf16_t)f2bf(xi[st][q]); }
                }
            }
            if (PASS == 2) {
                asm volatile("s_waitcnt lgkmcnt(0)" ::: "memory");
                const int fr = lane & 15, fq = lane >> 4;
                unsigned rb = (unsigned)(uintptr_t)(himg + fr * 272 + fq * 16); asm volatile("" : "+v"(rb)); const LAS unsigned char* rp = (const LAS unsigned char*)(uintptr_t)rb;
#pragma unroll
                for (int m = 0; m < 4; ++m) { f32x4 acc = {0.f, 0.f, 0.f, 0.f};
#pragma unroll
                    for (int ks = 0; ks < 4; ++ks) acc = __builtin_amdgcn_mfma_f32_16x16x32_bf16(ccf[ks], *(const LAS bf16x8*)(rp + (16 * m) * 272 + 64 * ks), acc, 0, 0, 0);
                    const size_t tok = tok0 + 16 * m + fr;
                    const u32x2 uu = *(const u32x2*)(Z + tok * ZS + ZC_S5 + g * 16 + 4 * fq);
                    const f32x4 dd = *(const f32x4*)(A.in[24] + l * 256 + g * 16 + 4 * fq);
                    u32x2 o; o.x = pk2(gelu_tanh(acc[0] + dd[0] * bflo(uu.x)), gelu_tanh(acc[1] + dd[1] * bfhi(uu.x))); o.y = pk2(gelu_tanh(acc[2] + dd[2] * bflo(uu.y)), gelu_tanh(acc[3] + dd[3] * bfhi(uu.y)));
                    *(u32x2*)(YS + tok * 256 + g * 16 + 4 * fq) = o; }
                asm volatile("s_waitcnt lgkmcnt(0)" ::: "memory");
            }
        }
        if (PASS == 1 && hh == 1) {
#pragma unroll
            for (int st = 0; st < 2; ++st) { float* e = SEND + ((size_t)((b * 16 + g) * 16 + seg)) * 128; e[32 * st + lr] = cr[st]; e[64 + 32 * st + lr] = ci[st]; } }
    }
}

DI void phase_lru_prep(const Frame& F, CArgs& A, int l) {
    const bf16_t* Z = (const bf16_t*)(A.ws + WS_Z); float* LA = (float*)(A.ws + WS_LA); float* LB = (float*)(A.ws + WS_LB);
    const float* cw = A.in[34] + l * 4 * 256; const float* cb = A.in[35] + l * 256; const float* ba = A.in[37] + l * 256; const float* bx = A.in[39] + l * 256; const float* lam = A.in[40] + l * 256;
    const bf16_t* WL = (const bf16_t*)(A.ws + WS_WLRU) + (size_t)l * 2 * 4 * 4096;
    LAS float* xs = (LAS float*)F.lds;
    const int w = F.wave, n = w >> 1, hf = w & 1;
    bf16x8 waf[2][2], wxf[2][2];
    { const int fr = F.lane & 15, fq = F.lane >> 4;
#pragma unroll
      for (int nf = 0; nf < 2; ++nf)
#pragma unroll
          for (int ks = 0; ks < 2; ++ks) { const int j = 32 * hf + 16 * nf + fr;
              waf[nf][ks] = *(const bf16x8*)(WL + ((size_t)(0 * 4 + n) * 64 + j) * 64 + 32 * ks + 8 * fq); wxf[nf][ks] = *(const bf16x8*)(WL + ((size_t)(1 * 4 + n) * 64 + j) * 64 + 32 * ks + 8 * fq); } }
    f32x4 c_ba[2], c_bx[2], c_sp[2];
    { const int fq0 = F.lane >> 4;
#pragma unroll
      for (int nf = 0; nf < 2; ++nf) { const int ch4 = n * 64 + 32 * hf + 16 * nf + 4 * fq0; c_ba[nf] = *(const f32x4*)(ba + ch4); c_bx[nf] = *(const f32x4*)(bx + ch4); const f32x4 lm = *(const f32x4*)(lam + ch4);
#pragma unroll
          for (int i = 0; i < 4; ++i) c_sp[nf][i] = -8.f * softplusf_(-lm[i]); } }
    for (int tile = F.bid; tile < T / 64; tile += F.G) {
        int tz = F.tid; asm volatile("" : "+v"(tz)); const int lane = tz & 63, fr = lane & 15, fq = lane >> 4;
        const int t0 = tile * 64, s0 = t0 % SEQ;
        f32x4 accA[4][2], accX[4][2];
#pragma unroll
        for (int m = 0; m < 4; ++m) {
            const int tok = 16 * m + fr, sq = s0 + tok;
            bf16x8 xf[2];
#pragma unroll
            for (int ks = 0; ks < 2; ++ks) { const int ch0 = n * 64 + 32 * ks + 8 * fq;
                const f32x4 b0 = *(const f32x4*)(cb + ch0), b1 = *(const f32x4*)(cb + ch0 + 4);
                float xc[8] = {b0[0], b0[1], b0[2], b0[3], b1[0], b1[1], b1[2], b1[3]};
#pragma unroll
                for (int j = 0; j < 4; ++j) if (sq - 3 + j >= 0) {
                    const u32x4 z8 = *(const u32x4*)(Z + (size_t)(t0 + tok - 3 + j) * ZS + ZC_LX + ch0);
                    const f32x4 c0 = *(const f32x4*)(cw + j * 256 + ch0), c1 = *(const f32x4*)(cw + j * 256 + ch0 + 4);
                    xc[0] += c0[0] * bflo(z8.x); xc[1] += c0[1] * bfhi(z8.x); xc[2] += c0[2] * bflo(z8.y); xc[3] += c0[3] * bfhi(z8.y);
                    xc[4] += c1[0] * bflo(z8.z); xc[5] += c1[1] * bfhi(z8.z); xc[6] += c1[2] * bflo(z8.w); xc[7] += c1[3] * bfhi(z8.w); }
                u32x4 o; o.x = pk2(xc[0], xc[1]); o.y = pk2(xc[2], xc[3]); o.z = pk2(xc[4], xc[5]); o.w = pk2(xc[6], xc[7]); xf[ks] = __builtin_bit_cast(bf16x8, o);
                if (hf == 0) { *(LAS f32x4*)(xs + tok * 260 + ch0) = (f32x4){xc[0], xc[1], xc[2], xc[3]}; *(LAS f32x4*)(xs + tok * 260 + ch0 + 4) = (f32x4){xc[4], xc[5], xc[6], xc[7]}; }
            }
#pragma unroll
            for (int nf = 0; nf < 2; ++nf) { const f32x4 z4 = {0.f, 0.f, 0.f, 0.f};
                accA[m][nf] = __builtin_amdgcn_mfma_f32_16x16x32_bf16(waf[nf][0], xf[0], z4, 0, 0, 0); accA[m][nf] = __builtin_amdgcn_mfma_f32_16x16x32_bf16(waf[nf][1], xf[1], accA[m][nf], 0, 0, 0);
                accX[m][nf] = __builtin_amdgcn_mfma_f32_16x16x32_bf16(wxf[nf][0], xf[0], z4, 0, 0, 0); accX[m][nf] = __builtin_amdgcn_mfma_f32_16x16x32_bf16(wxf[nf][1], xf[1], accX[m][nf], 0, 0, 0); }
        }
        lds_barrier();
#pragma unroll
        for (int m = 0; m < 4; ++m)
#pragma unroll
            for (int nf = 0; nf < 2; ++nf) { const int tok = 16 * m + fr, ch4 = n * 64 + 32 * hf + 16 * nf + 4 * fq;
                const f32x4 xc = *(const LAS f32x4*)(xs + tok * 260 + ch4);
                f32x4 av, bv;
#pragma unroll
                for (int i = 0; i < 4; ++i) { const float r = sigmoidf_(accA[m][nf][i] + c_ba[nf][i]), ig = sigmoidf_(accX[m][nf][i] + c_bx[nf][i]); const float log_a = r * c_sp[nf][i];
                    const float x2 = 2.f * log_a; float em1 = __expf(x2) - 1.f; if (x2 > -0.25f) em1 = x2 * (1.f + x2 * (0.5f + x2 * (0.16666667f + x2 * (0.041666668f + x2 * 0.008333334f))));
                    av[i] = __expf(log_a); bv[i] = __builtin_amdgcn_sqrtf(-em1) * (ig * xc[i]); }
                *(f32x4*)(LA + (size_t)(t0 + tok) * 256 + ch4) = av; *(f32x4*)(LB + (size_t)(t0 + tok) * 256 + ch4) = bv; }
        lds_barrier();
    }
}
DI void phase_lru_sum(const Frame& F, CArgs& A) {
    const float* LA = (const float*)(A.ws + WS_LA); const float* LB = (const float*)(A.ws + WS_LB); float* LS = (float*)(A.ws + WS_LSUM);
    for (int it = F.gw; it < 8 * 128; it += F.ngw) {
        const size_t r0 = (size_t)it * 64;
        f32x4 Ap = {1.f, 1.f, 1.f, 1.f}, Bp = {0.f, 0.f, 0.f, 0.f};
#pragma unroll 8
        for (int t = 0; t < 64; ++t) { const f32x4 a = *(const f32x4*)(LA + (r0 + t) * 256 + 4 * F.lane), bb = *(const f32x4*)(LB + (r0 + t) * 256 + 4 * F.lane); Bp = a * Bp + bb; Ap = Ap * a; }
        *(f32x4*)(LS + ((size_t)it * 2) * 256 + 4 * F.lane) = Ap; *(f32x4*)(LS + ((size_t)it * 2 + 1) * 256 + 4 * F.lane) = Bp;
    }
}
DI void phase_lru_fin(const Frame& F, CArgs& A, int l) {
    const float* LA = (const float*)(A.ws + WS_LA); const float* LB = (const float*)(A.ws + WS_LB); const float* LS = (const float*)(A.ws + WS_LSUM);
    const bf16_t* Z = (const bf16_t*)(A.ws + WS_Z); bf16_t* MIX = (bf16_t*)(A.ws + WS_MIX);
    const f32x4 bg = *(const f32x4*)(A.in[41] + l * 768 + 512 + 4 * F.lane);
    for (int it = F.gw; it < 8 * 128; it += F.ngw) {
        const int b = it >> 7, c = it & 127;
        f32x4 h = {0.f, 0.f, 0.f, 0.f};
        for (int j = 0; j < c; ++j) { const f32x4 a = *(const f32x4*)(LS + ((size_t)(b * 128 + j) * 2) * 256 + 4 * F.lane), bb = *(const f32x4*)(LS + ((size_t)(b * 128 + j) * 2 + 1) * 256 + 4 * F.lane); h = a * h + bb; }
        const size_t r0 = (size_t)it * 64;
#pragma unroll 4
        for (int t = 0; t < 64; ++t) { const f32x4 a = *(const f32x4*)(LA + (r0 + t) * 256 + 4 * F.lane), bb = *(const f32x4*)(LB + (r0 + t) * 256 + 4 * F.lane); h = a * h + bb;
            const u32x2 gz = *(const u32x2*)(Z + (r0 + t) * ZS + ZC_LG + 4 * F.lane);
            const float y0 = h[0] * gelu_tanh(bflo(gz.x)), y1 = h[1] * gelu_tanh(bfhi(gz.x)), y2 = h[2] * gelu_tanh(bflo(gz.y)), y3 = h[3] * gelu_tanh(bfhi(gz.y));
            const float r = rsqrtf(wave_sum(y0 * y0 + y1 * y1 + y2 * y2 + y3 * y3) * (1.f / 256.f) + NORM_EPS);
            u32x2 o; o.x = pk2(y0 * r * bg[0], y1 * r * bg[1]); o.y = pk2(y2 * r * bg[2], y3 * r * bg[3]);
            *(u32x2*)(MIX + (r0 + t) * DM + 768 + 4 * F.lane) = o; }
    }
}

DI void phase_branch_norm(const Frame& F, CArgs& A, int l) {
    const bf16_t* S0 = (const bf16_t*)(A.ws + WS_YS5G); const bf16_t* S1 = (const bf16_t*)(A.ws + WS_ATTO);
    bf16_t* MIX = (bf16_t*)(A.ws + WS_MIX); const float* bg = A.in[41] + l * 768;
    for (int row = F.gw; row < T; row += F.ngw) {
#pragma unroll
        for (int br = 0; br < 2; ++br) { const bf16_t* S = br == 0 ? S0 : S1;
            const u32x2 v = *(const u32x2*)(S + (size_t)row * 256 + 4 * F.lane);
            const float x0 = bflo(v.x), x1 = bfhi(v.x), x2 = bflo(v.y), x3 = bfhi(v.y);
            const float r = rsqrtf(wave_sum(x0 * x0 + x1 * x1 + x2 * x2 + x3 * x3) * (1.f / 256.f) + NORM_EPS);
            const f32x4 g = *(const f32x4*)(bg + br * 256 + 4 * F.lane);
            u32x2 o; o.x = pk2(x0 * r * g[0], x1 * r * g[1]); o.y = pk2(x2 * r * g[2], x3 * r * g[3]);
            *(u32x2*)(MIX + (size_t)row * DM + 256 * (br + 1) + 4 * F.lane) = o; }
    }
}

DI void phase_norm2_router(const Frame& F, CArgs& A, int l) {
    const float* MODL = (const float*)(A.ws + WS_MOD) + (size_t)l * 8 * 6144;
    const float* g = A.in[43] + l * 1024;
    bf16_t* H = (bf16_t*)(A.ws + WS_H);
    int* EID = (int*)(A.ws + WS_RT_EID); float* GATE = (float*)(A.ws + WS_RT_GATE); int* PIE = (int*)(A.ws + WS_RT_PIE);
    unsigned* CNT = (unsigned*)(A.ws + WS_CTL) + CW_CNT + l * 64;
    const bf16_t* WRh = (const bf16_t*)(A.ws + WS_WR) + (size_t)(l * 2) * 48 * 1024; const bf16_t* WRl = WRh + 48 * 1024;
    LAS float* part = (LAS float*)F.lds;
    LAS float* red = part + 8 * 64 * 48;
    LAS float* lsum = red + 8 * 64;
    LAS unsigned* lcnt = (LAS unsigned*)(lsum + 64 * 36);
    LAS int* lsel = (LAS int*)(lcnt + 64);
    const float* bgp = A.in[45] + l * 4; const float* bep = A.in[47] + l * 32;
    const int w = F.wave, k0 = 128 * w;
    bf16x8 bh[3][4], bl[3][4];
    { const int fr = F.lane & 15, fq = F.lane >> 4;
#pragma unroll
      for (int n = 0; n < 3; ++n)
#pragma unroll
          for (int ks = 0; ks < 4; ++ks) { bh[n][ks] = *(const bf16x8*)(WRh + (size_t)(16 * n + fr) * 1024 + k0 + 32 * ks + 8 * fq); bl[n][ks] = *(const bf16x8*)(WRl + (size_t)(16 * n + fr) * 1024 + k0 + 32 * ks + 8 * fq); } }
    for (int tile = F.bid; tile < T / 64; tile += F.G) {
        int tz = F.tid; asm volatile("" : "+v"(tz)); const int lane = tz & 63, fr = lane & 15, fq = lane >> 4;
        const int row0 = tile * 64, b = row0 / SEQ;
        const float* xb = A.out + (size_t)(row0 + fr) * DM + k0 + 8 * fq;
        float ss[4];
#pragma unroll
        for (int m = 0; m < 4; ++m) { float a = 0.f;
#pragma unroll
            for (int ks = 0; ks < 4; ++ks) { const f32x4 x0 = *(const f32x4*)(xb + (size_t)(16 * m) * DM + 32 * ks), x1 = *(const f32x4*)(xb + (size_t)(16 * m) * DM + 32 * ks + 4);
                a += x0[0] * x0[0] + x0[1] * x0[1] + x0[2] * x0[2] + x0[3] * x0[3] + x1[0] * x1[0] + x1[1] * x1[1] + x1[2] * x1[2] + x1[3] * x1[3]; }
            a += shfl_xor_l(a, 16, lane); a += shfl_xor_l(a, 32, lane); ss[m] = a; }
        if (fq == 0) {
#pragma unroll
            for (int m = 0; m < 4; ++m) red[w * 64 + 16 * m + fr] = ss[m]; }
        if (tz < 32) lcnt[tz] = 0u;
        lds_barrier();
        f32x4 acc[4][3];
#pragma unroll
        for (int m = 0; m < 4; ++m) { float tot = 0.f;
#pragma unroll
            for (int ww = 0; ww < 8; ++ww) tot += red[ww * 64 + 16 * m + fr];
            const float rstd = rsqrtf(tot * (1.f / DM) + NORM_EPS);
#pragma unroll
            for (int n = 0; n < 3; ++n) acc[m][n] = (f32x4){0.f, 0.f, 0.f, 0.f};
#pragma unroll
            for (int ks = 0; ks < 4; ++ks) { const int kc = k0 + 32 * ks + 8 * fq;
                const f32x4 x0 = *(const f32x4*)(xb + (size_t)(16 * m) * DM + 32 * ks), x1 = *(const f32x4*)(xb + (size_t)(16 * m) * DM + 32 * ks + 4);
                const f32x4 g0 = *(const f32x4*)(g + kc), g1 = *(const f32x4*)(g + kc + 4);
                const f32x4 s0 = *(const f32x4*)(MODL + (size_t)b * 6144 + 4096 + kc), s1 = *(const f32x4*)(MODL + (size_t)b * 6144 + 4096 + kc + 4);
                const f32x4 h0 = *(const f32x4*)(MODL + (size_t)b * 6144 + 3072 + kc), h1 = *(const f32x4*)(MODL + (size_t)b * 6144 + 3072 + kc + 4);
                const f32x4 v0 = x0 * rstd * g0 * (s0 + 1.f) + h0, v1 = x1 * rstd * g1 * (s1 + 1.f) + h1;
                u32x4 hi; hi.x = pk2(v0[0], v0[1]); hi.y = pk2(v0[2], v0[3]); hi.z = pk2(v1[0], v1[1]); hi.w = pk2(v1[2], v1[3]);
                u32x4 lo; lo.x = pk2(v0[0] - bflo(hi.x), v0[1] - bfhi(hi.x)); lo.y = pk2(v0[2] - bflo(hi.y), v0[3] - bfhi(hi.y)); lo.z = pk2(v1[0] - bflo(hi.z), v1[1] - bfhi(hi.z)); lo.w = pk2(v1[2] - bflo(hi.w), v1[3] - bfhi(hi.w));
                *(u32x4*)(H + (size_t)(row0 + 16 * m + fr) * DM + kc) = hi;
                const bf16x8 ah = __builtin_bit_cast(bf16x8, hi), al = __builtin_bit_cast(bf16x8, lo);
#pragma unroll
                for (int n = 0; n < 3; ++n) { acc[m][n] = __builtin_amdgcn_mfma_f32_16x16x32_bf16(ah, bh[n][ks], acc[m][n], 0, 0, 0);
                    acc[m][n] = __builtin_amdgcn_mfma_f32_16x16x32_bf16(al, bh[n][ks], acc[m][n], 0, 0, 0); acc[m][n] = __builtin_amdgcn_mfma_f32_16x16x32_bf16(ah, bl[n][ks], acc[m][n], 0, 0, 0); } }
#pragma unroll
            for (int n = 0; n < 3; ++n)
#pragma unroll
                for (int j = 0; j < 4; ++j) part[(w * 64 + 16 * m + 4 * fq + j) * 48 + 16 * n + fr] = acc[m][n][j];
        }
        lds_barrier();
        for (int i = tz; i < 64 * 36; i += NTHR) { const int tok = i / 36, n = i % 36; float a = 0.f;
#pragma unroll
            for (int ww = 0; ww < 8; ++ww) a += part[(ww * 64 + tok) * 48 + n];
            lsum[i] = a; }
        lds_barrier();
        float g0 = 0.f, g1 = 0.f; int e0 = 0, e1 = 0; unsigned r0 = 0, r1 = 0;
        if (tz < 64) {
            const LAS float* L = lsum + tz * 36;
            int gs = 0; float gm = L[0] + bgp[0];
#pragma unroll
            for (int i = 1; i < 4; ++i) { const float v = L[i] + bgp[i]; if (v > gm) { gm = v; gs = i; } }
            float gden = 0.f;
#pragma unroll
            for (int i = 0; i < 4; ++i) gden += expf(L[i] + bgp[i] - gm);
            const float gprob = 1.f / gden;
            int i1 = 0; float v1 = L[4 + gs * 8] + bep[gs * 8];
#pragma unroll
            for (int j = 1; j < 8; ++j) { const float v = L[4 + gs * 8 + j] + bep[gs * 8 + j]; if (v > v1) { v1 = v; i1 = j; } }
            int i2 = -1; float v2 = -INFINITY;
#pragma unroll
            for (int j = 0; j < 8; ++j) { const float v = L[4 + gs * 8 + j] + bep[gs * 8 + j]; if (j != i1 && v > v2) { v2 = v; i2 = j; } }
            const float p2 = expf(v2 - v1);
            g0 = gprob / (1.f + p2); g1 = gprob * p2 / (1.f + p2); e0 = gs * 8 + i1; e1 = gs * 8 + i2;
            r0 = __hip_atomic_fetch_add(lcnt + e0, 1u, __ATOMIC_RELAXED, __HIP_MEMORY_SCOPE_WORKGROUP); r1 = __hip_atomic_fetch_add(lcnt + e1, 1u, __ATOMIC_RELAXED, __HIP_MEMORY_SCOPE_WORKGROUP);
        }
        lds_barrier();
        if (tz < 32) { const unsigned c = lcnt[tz]; lcnt[32 + tz] = c ? atomicAdd(CNT + tz, c) : 0u; }
        lds_barrier();
        if (tz < 64) { const int row = row0 + tz;
            EID[2 * row] = e0; EID[2 * row + 1] = e1; GATE[2 * row] = g0; GATE[2 * row + 1] = g1; PIE[2 * row] = (int)(lcnt[32 + e0] + r0); PIE[2 * row + 1] = (int)(lcnt[32 + e1] + r1); }
        lds_barrier();
    }
    __syncthreads();
    LAS float* scr = (LAS float*)(F.lds + F.wave * 16640);
    bf16_t* WM1 = (bf16_t*)(A.ws + WS_WM1); bf16_t* WM2 = (bf16_t*)(A.ws + WS_WM2);
    for (int it = F.gw; it < 32 * 384; it += F.ngw) {
        const int e = it / 384; int r = it % 384;
        if (r < 256) { const int which = r >> 7; r &= 127; const int kb = r >> 3, nb = r & 7, n0 = 64 * nb;
            const float* src = (which ? A.in[49] : A.in[48]) + ((size_t)l * 32 + e) * 1024 * 512;
            transpose_item64(src, 512, 64 * kb, n0, WM1 + (size_t)e * 1024 * 1024, 1024, 256 * (n0 >> 7) + (n0 & 127) + 128 * which, 64 * kb, scr, F.lane);
        } else { r -= 256; const int kb = r >> 4, nb = r & 15;
            transpose_item64(A.in[50] + ((size_t)l * 32 + e) * 512 * 1024, 1024, 64 * kb, 64 * nb, WM2 + (size_t)e * 1024 * 512, 512, 64 * nb, 64 * kb, scr, F.lane); }
    }
}

DI void phase_moe_scatter(const Frame& F, CArgs& A, int l) {
    const unsigned* CNT = (const unsigned*)(A.ws + WS_CTL) + CW_CNT + l * 64;
    unsigned* META = (unsigned*)(A.ws + WS_CTL) + CW_UTAB + l * 1024;
    const int* EID = (const int*)(A.ws + WS_RT_EID); const int* PIE = (const int*)(A.ws + WS_RT_PIE); int* SORT = (int*)(A.ws + WS_RT_SORT);
    LAS unsigned* st = (LAS unsigned*)F.lds;
    if (F.tid == 0) { unsigned s = 0; for (int e = 0; e < 32; ++e) { st[e] = s; s += CNT[e]; } }
    __syncthreads();
    if (F.bid == 0 && F.tid == 0) { unsigned nu = 0;
        for (int e = 0; e < 32; ++e) { const unsigned c = CNT[e]; META[1 + e] = st[e]; META[33 + e] = c; for (unsigned bk = 0; bk * 256 < c; ++bk) META[65 + nu++] = ((unsigned)e << 16) | bk; }
        META[0] = nu; }
    for (int a = F.bid * NTHR + F.tid; a < 2 * T; a += F.G * NTHR) SORT[st[EID[a]] + PIE[a]] = a;
}

struct MoeProb1 {
    const char* Hh; const char* WM1; const unsigned* META; const int* SORT; int lda, ldb, nt, G, c;
    DI bool next(int i, pg8::Unit& u) const { const int idx = i * G + c; const int nu = (int)META[0]; if (idx >= nu * 4) return false;
        const unsigned ent = META[65 + (idx >> 2)]; u.pm = idx >> 2; u.pn = idx & 3; u.e = (int)(ent >> 16); u.blk = (int)(ent & 0xffffu); return true; }
    DI const char* a_base(const pg8::Unit&) const { return Hh; }
    DI const char* b_base(const pg8::Unit& u) const { return WM1 + ((size_t)u.e * 1024 + (size_t)u.pn * 256) * 1024 * 2; }
    DI unsigned a_off(const pg8::Unit& u, int row) const { const unsigned r = (unsigned)(u.blk * 256 + row), cnt = META[33 + u.e];
        const int a = r < cnt ? SORT[META[1 + u.e] + r] : 0; return (unsigned)(a >> 1) * 2048u; }
};
struct EpiMoe1 {
    static constexpr bool PERM = true;
    bf16_t* HID; const unsigned* META;
    DI void operator()(const f32x4 (&acc)[2][2][4][2], const pg8::Unit& u, int wr, int wc, int fr, int fq) const {
        const unsigned cnt = META[33 + u.e], st = META[1 + u.e];
        const int col0 = 128 * u.pn + wc * 32 + 8 * fq;
#pragma unroll
        for (int ai = 0; ai < 2; ++ai)
#pragma unroll
            for (int m = 0; m < 4; ++m) { const unsigned r = (unsigned)(u.blk * 256 + ai * 128 + wr * 64 + m * 16 + fr);
                if (r < cnt) { const f32x4 a0 = acc[ai][0][m][0], a1 = acc[ai][0][m][1], b0 = acc[ai][1][m][0], b1 = acc[ai][1][m][1];
                    u32x4 w; w.x = pk2(siluf_(a0[0]) * b0[0], siluf_(a0[1]) * b0[1]); w.y = pk2(siluf_(a0[2]) * b0[2], siluf_(a0[3]) * b0[3]);
                    w.z = pk2(siluf_(a1[0]) * b1[0], siluf_(a1[1]) * b1[1]); w.w = pk2(siluf_(a1[2]) * b1[2], siluf_(a1[3]) * b1[3]);
                    *(u32x4*)(HID + (size_t)(st + r) * 512 + col0) = w; } }
    }
};
struct MoeProb2 {
    const char* HID; const char* WM2; const unsigned* META; int lda, ldb, nt, G, c;
    DI bool next(int i, pg8::Unit& u) const { const int idx = i * G + c; const int nu = (int)META[0]; if (idx >= nu * 4) return false;
        const unsigned ent = META[65 + (idx >> 2)]; u.pm = idx >> 2; u.pn = idx & 3; u.e = (int)(ent >> 16); u.blk = (int)(ent & 0xffffu); return true; }
    DI const char* a_base(const pg8::Unit& u) const { return HID + ((size_t)META[1 + u.e] + (size_t)u.blk * 256) * 512 * 2; }
    DI const char* b_base(const pg8::Unit& u) const { return WM2 + ((size_t)u.e * 1024 + (size_t)u.pn * 256) * 512 * 2; }
    DI unsigned a_off(const pg8::Unit&, int row) const { return (unsigned)row * 1024u; }
};
struct EpiMoe2 {
    static constexpr bool PERM = true;
    bf16_t* Y; const unsigned* META; const int* SORT; const float* GATE; const float* gt;
    DI void operator()(const f32x4 (&acc)[2][2][4][2], const pg8::Unit& u, int wr, int wc, int fr, int fq) const {
        const unsigned cnt = META[33 + u.e], st = META[1 + u.e];
        const int col0 = 256 * u.pn + wc * 32 + 8 * fq;
#pragma unroll
        for (int ai = 0; ai < 2; ++ai)
#pragma unroll
            for (int m = 0; m < 4; ++m) { const unsigned r = (unsigned)(u.blk * 256 + ai * 128 + wr * 64 + m * 16 + fr);
                if (r < cnt) { const int a = SORT[st + r]; const float gw = GATE[a]; const int b = (a >> 1) / SEQ;
#pragma unroll
                    for (int bj = 0; bj < 2; ++bj) { const f32x4 g0 = *(const f32x4*)(gt + (size_t)b * 6144 + col0 + bj * 128), g1 = *(const f32x4*)(gt + (size_t)b * 6144 + col0 + bj * 128 + 4);
                        const f32x4 v0 = acc[ai][bj][m][0] * g0 * gw, v1 = acc[ai][bj][m][1] * g1 * gw;
                        u32x4 w; w.x = pk2(v0[0], v0[1]); w.y = pk2(v0[2], v0[3]); w.z = pk2(v1[0], v1[1]); w.w = pk2(v1[2], v1[3]);
                        *(u32x4*)(Y + (size_t)a * DM + col0 + bj * 128) = w; } } }
    }
};

DI void phase_final(const Frame& F, CArgs& A) {
    const bf16_t* Y = (const bf16_t*)(A.ws + WS_Y);
    for (size_t i = (size_t)F.bid * NTHR + F.tid; i < (size_t)T * DM / 4; i += (size_t)F.G * NTHR) {
        const size_t row = i >> 8, col = (i & 255) * 4;
        f32x4 v = *(const f32x4*)(A.out + row * DM + col);
        const u32x2 y0 = *(const u32x2*)(Y + (2 * row) * DM + col), y1 = *(const u32x2*)(Y + (2 * row + 1) * DM + col);
        v[0] += bflo(y0.x) + bflo(y1.x); v[1] += bfhi(y0.x) + bfhi(y1.x); v[2] += bflo(y0.y) + bflo(y1.y); v[3] += bfhi(y0.y) + bfhi(y1.y);
        *(f32x4*)(A.out + row * DM + col) = v;
    }
}

#ifndef REPMASK
#define REPMASK 0u
#endif
constexpr int NPL = 21, NPH = 1 + 2 * NPL + 1;
__global__ void __launch_bounds__(NTHR, 2) mk_fwd(Args args) {
    extern __shared__ __attribute__((aligned(16))) unsigned char lds_raw[];
    LAS unsigned char* const ldsb = (LAS unsigned char*)lds_raw;
    const int wave0 = __builtin_amdgcn_readfirstlane(threadIdx.x >> 6);
    volatile LAS unsigned* MISC = (volatile LAS unsigned*)(ldsb + MISC_OFF);
    if (threadIdx.x < 64) MISC[threadIdx.x] = 0u;
    __syncthreads();
    XcdBarrier bar; bar.bar = (unsigned*)(args.ws + WS_CTL) + CW_BAR; bar.x = 0; bar.st = nullptr;
    if (args.use_bar) bar = xcd_barrier_post((unsigned*)(args.ws + WS_CTL) + CW_BAR, MISC + 8);
    const int lo = args.ph_lo, hi = args.ph_hi;
#define IN(k) (lo <= (k) && (k) < hi)
#define SEAM(k) do { if (IN(k) && IN((k) + 1)) xcd_barrier(bar); } while (0)
    unsigned char* ws = args.ws;
    if (IN(0)) { const Frame F = make_frame(ldsb, wave0); CArgs& AA = *get_args(); phase_prologue(F, AA); } SEAM(0);
    for (int l = 0; l < DEPTH; ++l) {
        const int pb = 1 + l * NPL;
        const float* MODL = (const float*)(ws + WS_MOD) + (size_t)l * 8 * 6144;
        if (IN(pb + 0)) { const Frame F = make_frame(ldsb, wave0); CArgs& AA = *get_args(); phase_norm1(F, AA, l); } SEAM(pb + 0);
        if (IN(pb + 1)) { const Frame F = make_frame(ldsb, wave0); CArgs& AA = *get_args(); pg8::PlainProb P{(const char*)(ws + WS_H), (const char*)(ws + WS_WIN) + (size_t)l * ZS * 1024 * 2, 1024, 1024, 16, 256, 9, F.G, F.bid};
            EpiBf16Plain E{(bf16_t*)(ws + WS_Z), ZS}; pg8::gemm_phase(F.lds, P, E, F.tid); } SEAM(pb + 1);
        if (IN(pb + 2)) { const Frame F = make_frame(ldsb, wave0); CArgs& AA = *get_args(); phase_mla_prep(F, AA, l); } SEAM(pb + 2);
        if (IN(pb + 3)) { const Frame F = make_frame(ldsb, wave0); CArgs& AA = *get_args(); pg8::PlainProb P{(const char*)(ws + WS_AMLA), (const char*)(ws + WS_WMLA) + (size_t)l * 1024 * 512 * 2, 512, 512, 8, 256, 4, F.G, F.bid};
            EpiBf16Plain E{(bf16_t*)(ws + WS_QKVRAW), 1024}; pg8::gemm_phase(F.lds, P, E, F.tid); } SEAM(pb + 3);
        if (IN(pb + 4)) { const Frame F = make_frame(ldsb, wave0); CArgs& AA = *get_args(); phase_mla_post(F, AA, l); } SEAM(pb + 4);
        if (IN(pb + 5)) { const Frame F = make_frame(ldsb, wave0); CArgs& AA = *get_args(); phase_attn(F, AA); } SEAM(pb + 5);
        if (IN(pb + 6)) { const Frame F = make_frame(ldsb, wave0); CArgs& AA = *get_args(); phase_rwkv_A(F, AA, l); } SEAM(pb + 6);
        if (IN(pb + 7)) { const Frame F = make_frame(ldsb, wave0); CArgs& AA = *get_args(); phase_rwkv_B(F, AA); } SEAM(pb + 7);
        if (IN(pb + 8)) { const Frame F = make_frame(ldsb, wave0); CArgs& AA = *get_args(); phase_rwkv_C(F, AA, l); } SEAM(pb + 8);
        if (IN(pb + 9)) { const Frame F = make_frame(ldsb, wave0); CArgs& AA = *get_args(); phase_s5<1>(F, AA, l); } SEAM(pb + 9);
        if (IN(pb + 10)) { const Frame F = make_frame(ldsb, wave0); CArgs& AA = *get_args(); phase_s5<2>(F, AA, l); } SEAM(pb + 10);
        if (IN(pb + 11)) { const Frame F = make_frame(ldsb, wave0); CArgs& AA = *get_args(); pg8::PlainProb P{(const char*)(ws + WS_YS5), (const char*)(ws + WS_WGLU) + (size_t)l * 256 * 256 * 2, 256, 256, 4, 256, 1, F.G, F.bid};
            EpiGlu E{(const bf16_t*)(ws + WS_YS5), (bf16_t*)(ws + WS_YS5G), AA.in[27] + l * 256}; pg8::gemm_phase(F.lds, P, E, F.tid); } SEAM(pb + 11);
        if (IN(pb + 12)) { const Frame F = make_frame(ldsb, wave0); CArgs& AA = *get_args(); phase_lru_prep(F, AA, l); } SEAM(pb + 12);
        if (IN(pb + 13)) { const Frame F = make_frame(ldsb, wave0); CArgs& AA = *get_args(); phase_lru_sum(F, AA); } SEAM(pb + 13);
        if (IN(pb + 14)) { const Frame F = make_frame(ldsb, wave0); CArgs& AA = *get_args(); phase_lru_fin(F, AA, l); } SEAM(pb + 14);
        if (IN(pb + 15)) { const Frame F = make_frame(ldsb, wave0); CArgs& AA = *get_args(); phase_branch_norm(F, AA, l); } SEAM(pb + 15);
        if (IN(pb + 16)) { const Frame F = make_frame(ldsb, wave0); CArgs& AA = *get_args(); pg8::PlainProb P{(const char*)(ws + WS_MIX), (const char*)(ws + WS_WOUT) + (size_t)l * 1024 * 1024 * 2, 1024, 1024, 16, 256, 4, F.G, F.bid};
            EpiResGate E{l == 0 ? AA.in[0] : AA.out, AA.out, MODL + 2048}; pg8::gemm_phase(F.lds, P, E, F.tid); } SEAM(pb + 16);
        if (IN(pb + 17)) { const Frame F = make_frame(ldsb, wave0); CArgs& AA = *get_args(); phase_norm2_router(F, AA, l); } SEAM(pb + 17);
        if (IN(pb + 18)) { const Frame F = make_frame(ldsb, wave0); CArgs& AA = *get_args(); phase_moe_scatter(F, AA, l); } SEAM(pb + 18);
        const unsigned* META = (const unsigned*)(ws + WS_CTL) + CW_UTAB + l * 1024;
        if (IN(pb + 19)) { const Frame F = make_frame(ldsb, wave0); CArgs& AA = *get_args(); MoeProb1 P{(const char*)(ws + WS_H), (const char*)(ws + WS_WM1), META, (const int*)(ws + WS_RT_SORT), 1024, 1024, 16, F.G, F.bid};
            EpiMoe1 E{(bf16_t*)(ws + WS_HID), META}; pg8::gemm_phase(F.lds, P, E, F.tid); } SEAM(pb + 19);
        if (IN(pb + 20)) { const Frame F = make_frame(ldsb, wave0); CArgs& AA = *get_args(); MoeProb2 P{(const char*)(ws + WS_HID), (const char*)(ws + WS_WM2), META, 512, 512, 8, F.G, F.bid};
            EpiMoe2 E{(bf16_t*)(ws + WS_Y), META, (const int*)(ws + WS_RT_SORT), (const float*)(ws + WS_RT_GATE), MODL + 5120}; pg8::gemm_phase(F.lds, P, E, F.tid); } SEAM(pb + 20);
    }
    if (IN(NPH - 1)) { const Frame F = make_frame(ldsb, wave0); CArgs& AA = *get_args(); phase_final(F, AA); }
#undef IN
#undef SEAM
}

extern "C" void kernel_launch(void* const* d_in, const int* in_sizes, int n_in, void* d_out, int out_size, void* d_ws, size_t ws_size, hipStream_t stream) {
    static int grid = 0;
    if (grid == 0) {
        if (n_in != 51 || ws_size < WS_END) { fprintf(stderr, "kernel_launch: unexpected inputs (n_in %d, ws %zu)\n", n_in, ws_size); grid = -1; return; }
        int dev = 0, cus = 0;
        if (hipGetDevice(&dev) != hipSuccess || hipDeviceGetAttribute(&cus, hipDeviceAttributeMultiprocessorCount, dev) != hipSuccess) { grid = -1; return; }
        if (hipFuncSetAttribute((const void*)mk_fwd, hipFuncAttributeMaxDynamicSharedMemorySize, LDS_BYTES) != hipSuccess) { fprintf(stderr, "kernel_launch: hipFuncSetAttribute failed\n"); grid = -1; return; }
        grid = cus;
    }
    if (grid < 0) return;
    (void)hipMemsetAsync((char*)d_ws + WS_CTL, 0, CTL_ZERO_BYTES, stream);
    Args a{};
    for (int i = 0; i < 51; ++i) a.in[i] = (const float*)d_in[i];
    a.pos_off = (const int*)d_in[2]; a.out = (float*)d_out; a.ws = (unsigned char*)d_ws; a.pad = 0;
#if defined(MK_PER_PHASE)
    a.use_bar = 0;
    for (int p = 0; p < NPH; ++p) { a.ph_lo = p; a.ph_hi = p + 1;
        const int k = (p == 0) ? 30 : (p == NPH - 1) ? 31 : (p - 1) % NPL; const int reps = 1 + (int)((REPMASK >> k) & 1u);
        for (int r = 0; r < reps; ++r) hipLaunchKernelGGL(mk_fwd, dim3(grid), dim3(NTHR), LDS_BYTES, stream, a); }
#else
    a.use_bar = 1; a.ph_lo = 0; a.ph_hi = NPH;
    hipLaunchKernelGGL(mk_fwd, dim3(grid), dim3(NTHR), LDS_BYTES, stream, a);
#endif
}
```

```cpp
#include <hip/hip_runtime.h>
#include <cstdio>
#include <cstdint>

#define LAS __attribute__((address_space(3)))
#define GAS __attribute__((address_space(1)))
#define DI __device__ __forceinline__
typedef unsigned short bf16_t;
typedef short bf16x8 __attribute__((ext_vector_type(8)));
typedef short s16x4 __attribute__((ext_vector_type(4)));
typedef float f32x4 __attribute__((ext_vector_type(4)));
typedef float f32x2 __attribute__((ext_vector_type(2)));
typedef float f32x16 __attribute__((ext_vector_type(16)));
typedef unsigned u32x4 __attribute__((ext_vector_type(4)));
typedef unsigned u32x2 __attribute__((ext_vector_type(2)));
typedef __bf16 bf16x2_t __attribute__((ext_vector_type(2)));

constexpr int NB = 8, SEQ = 8192, DM = 1024, T = NB * SEQ, DEPTH = 2;
constexpr int WG = 256;
constexpr int ZS = 2304;
constexpr int ZC_R = 0, ZC_K = 256, ZC_V = 512, ZC_WLO = 768, ZC_ALO = 800, ZC_GLO = 832, ZC_S5 = 896, ZC_QA = 1152, ZC_KVA = 1408, ZC_KPE = 1536, ZC_LX = 1568, ZC_LG = 1824, D_IN = 2080;
constexpr int NEXP = 32, DFF = 512;
constexpr float NORM_EPS = 1e-6f;

DI unsigned f2bf(float f) { unsigned u = __float_as_uint(f); return (u + 0x7fffu + ((u >> 16) & 1u)) >> 16; }
DI unsigned pk2(float lo, float hi) { f32x2 v = {lo, hi}; bf16x2_t b = __builtin_convertvector(v, bf16x2_t); return __builtin_bit_cast(unsigned, b); }
DI float bflo(unsigned u) { return __uint_as_float(u << 16); }
DI float bfhi(unsigned u) { return __uint_as_float(u & 0xffff0000u); }
DI float bf2f(bf16_t b) { return __uint_as_float(((unsigned)b) << 16); }
DI int lane_opaque() { int l; asm volatile("v_mbcnt_lo_u32_b32 %0, -1, 0\n\tv_mbcnt_hi_u32_b32 %0, -1, %0" : "=v"(l)); return l; }
DI float shfl_xor_l(float v, int o, int lane) { return __int_as_float(__builtin_amdgcn_ds_bpermute((lane ^ o) << 2, __float_as_int(v))); }
DI float wave_sum(float v) {
    const int l = lane_opaque();
#pragma unroll
    for (int o = 1; o < 64; o <<= 1) v += shfl_xor_l(v, o, l);
    return v;
}
DI void lds_barrier() { asm volatile("s_waitcnt lgkmcnt(0)" ::: "memory"); __builtin_amdgcn_s_barrier(); asm volatile("" ::: "memory"); }
DI float sigmoidf_(float x) { return __builtin_amdgcn_rcpf(1.f + __expf(-x)); }
DI float fast_tanh(float x) { const float e = __expf(2.f * fminf(fmaxf(x, -15.f), 15.f)); return (e - 1.f) * __builtin_amdgcn_rcpf(e + 1.f); }
DI float fast_softplus(float x) { return fmaxf(x, 0.f) + __logf(1.f + __expf(-fabsf(x))); }
DI float softplusf_(float x) { return fmaxf(x, 0.f) + log1pf(__expf(-fabsf(x))); }
DI float gelu_tanh(float x) { const float u = 0.7978845608028654f * (x + 0.044715f * x * x * x); const float e = __expf(2.f * fminf(fmaxf(u, -15.f), 15.f)); return x * e * __builtin_amdgcn_rcpf(e + 1.f); }
DI float siluf_(float x) { return x / (1.f + __expf(-x)); }

namespace pg8 {
constexpr int BM = 256, BK = 64, HALF = 128, HTB = HALF * BK * 2, STAGE_BYTES = 8 * HTB;
DI int lds_byte(int r, int c) { const int st = (r >> 4) * 2 + (c >> 5), rr = r & 15, cc = c & 31, ob = rr * 64 + cc * 2; return st * 1024 + (ob ^ (((ob >> 9) & 1) << 5)); }
DI void stage_rc(int b, int& R, int& C) { const int st = b / 1024, sb = b % 1024, swz = sb ^ (((sb >> 9) & 1) << 5); R = (st >> 1) * 16 + swz / 64; C = (st & 1) * 32 + (swz % 64) / 2; }
DI int perm32(int rho) { const int n = rho >> 4, i = rho & 15; return 8 * (i >> 2) + 4 * n + (i & 3); }

struct Unit { int pm, pn, e, blk; };

template <bool ALIGN_EPI = true, class Epi, class P>
DI void gemm_phase(LAS unsigned char* lds, const P& S, const Epi& E, int tid_in) {
    const int tid = tid_in, wid = __builtin_amdgcn_readfirstlane(tid >> 6), lane = tid & 63, wr = wid >> 2, wc = wid & 3, fr = lane & 15, fq = lane >> 4;
    const int nt = S.nt;
    int Rr[2], Cc[2];
    unsigned voffB[2], offC[2][2], offN[2][2];
#pragma unroll
    for (int i = 0; i < 2; ++i) { int R, C; stage_rc(tid * 16 + i * 8192, R, C); Rr[i] = R; Cc[i] = C; const int Rb = Epi::PERM ? ((R & ~31) + perm32(R & 31)) : R;
        voffB[i] = (unsigned)(Rb * S.ldb + C) * 2u; }
    const size_t kstep = (size_t)(BK * 2);
    const size_t hstepB = (size_t)HALF * S.ldb * 2;
    const unsigned ldsw = (unsigned)wid * 1024u;
    const int aoff = lds_byte(wr * 64 + fr, fq * 8), boff = lds_byte(wc * 32 + fr, fq * 8);
#define PG8_SA(b, h) (((b) * 2 + (h)) * HTB)
#define PG8_SB(b, h) ((4 + (b) * 2 + (h)) * HTB)
#define PG8_STAGE(bufoff, gbase, voff) do { _Pragma("unroll") for (int _i = 0; _i < 2; ++_i) \
        __builtin_amdgcn_global_load_lds((const unsigned*)((const char*)(gbase) + (voff)[_i]), (LAS unsigned*)(lds + (bufoff) + ldsw + _i * 8192), 16, 0, 0); } while (0)
#define PG8_LDA(dst, b, h) do { _Pragma("unroll") for (int m = 0; m < 4; ++m) _Pragma("unroll") for (int k = 0; k < 2; ++k) dst[m][k] = *(const LAS bf16x8*)(lds + PG8_SA(b, h) + aoff + m * 2048 + k * 1024); } while (0)
#define PG8_LDB(dst, b, h) do { _Pragma("unroll") for (int n = 0; n < 2; ++n) _Pragma("unroll") for (int k = 0; k < 2; ++k) dst[n][k] = *(const LAS bf16x8*)(lds + PG8_SB(b, h) + boff + n * 2048 + k * 1024); } while (0)
#define PG8_MMA(ai, bj, At, Bt) do { __builtin_amdgcn_s_setprio(1); _Pragma("unroll") for (int m = 0; m < 4; ++m) _Pragma("unroll") for (int n = 0; n < 2; ++n) _Pragma("unroll") for (int k = 0; k < 2; ++k) \
        acc[ai][bj][m][n] = __builtin_amdgcn_mfma_f32_16x16x32_bf16(Bt[n][k], At[m][k], acc[ai][bj][m][n], 0, 0, 0); __builtin_amdgcn_s_setprio(0); } while (0)
#define PG8_WAIT_V(n) asm volatile("s_waitcnt vmcnt(" #n ")" ::: "memory")
#define PG8_WAIT_L(n) asm volatile("s_waitcnt lgkmcnt(" #n ")" ::: "memory")
#define PG8_BAR __builtin_amdgcn_s_barrier()
#define PG8_SCHED __builtin_amdgcn_sched_barrier(0)
    Unit cur, nxt; int ui = 0;
    if (!S.next(0, cur)) return;
    f32x4 acc[2][2][4][2];
#pragma unroll
    for (int a = 0; a < 2; ++a)
#pragma unroll
        for (int b = 0; b < 2; ++b)
#pragma unroll
            for (int m = 0; m < 4; ++m)
#pragma unroll
                for (int n = 0; n < 2; ++n) acc[a][b][m][n] = (f32x4){0.f, 0.f, 0.f, 0.f};
    bf16x8 At[4][2], B0[2][2], B1[2][2];
    const char* cA = S.a_base(cur); const char* cB = S.b_base(cur);
#pragma unroll
    for (int h = 0; h < 2; ++h)
#pragma unroll
        for (int i = 0; i < 2; ++i) { offC[h][i] = S.a_off(cur, h * HALF + Rr[i]) + (unsigned)Cc[i] * 2u; offN[h][i] = offC[h][i]; }
    PG8_STAGE(PG8_SB(0, 0), cB, voffB); PG8_STAGE(PG8_SB(0, 1), cB + hstepB, voffB); PG8_STAGE(PG8_SA(0, 0), cA, offC[0]); PG8_STAGE(PG8_SA(0, 1), cA, offC[1]);
    if (wr == 1) PG8_BAR;
    PG8_WAIT_V(2); PG8_BAR;
    PG8_STAGE(PG8_SB(1, 0), cB + kstep, voffB); PG8_STAGE(PG8_SA(1, 0), cA + kstep, offC[0]); PG8_STAGE(PG8_SB(1, 1), cB + hstepB + kstep, voffB);
    PG8_WAIT_V(6); PG8_BAR;
    for (;;) {
        const bool has_next = S.next(ui + 1, nxt);
        const char* nA = has_next ? S.a_base(nxt) : cA; const char* nB = has_next ? S.b_base(nxt) : cB;
        for (int t = 0; t < nt; t += 2) {
            const bool last = (t == nt - 2);
            const char* a1 = cA + (size_t)(t + 1) * kstep;
            const char* a2 = last ? nA : cA + (size_t)(t + 2) * kstep; const char* b2 = last ? nB : cB + (size_t)(t + 2) * kstep;
            const char* a3 = a2 + kstep; const char* b3 = b2 + kstep;
            if (last && has_next) {
#pragma unroll
                for (int h = 0; h < 2; ++h)
#pragma unroll
                    for (int i = 0; i < 2; ++i) offN[h][i] = S.a_off(nxt, h * HALF + Rr[i]) + (unsigned)Cc[i] * 2u;
            }
            unsigned o2[2][2];
#pragma unroll
            for (int h = 0; h < 2; ++h)
#pragma unroll
                for (int i = 0; i < 2; ++i) o2[h][i] = last ? offN[h][i] : offC[h][i];
            PG8_LDB(B0, 0, 0); PG8_LDB(B1, 0, 1); PG8_SCHED; PG8_LDA(At, 0, 0); PG8_STAGE(PG8_SA(1, 1), a1, offC[1]);
            PG8_WAIT_V(8); PG8_WAIT_L(0); PG8_BAR; PG8_MMA(0, 0, At, B0); PG8_MMA(0, 1, At, B1); PG8_BAR; PG8_SCHED;
            PG8_LDA(At, 0, 1); PG8_STAGE(PG8_SB(0, 0), b2, voffB); PG8_STAGE(PG8_SB(0, 1), b2 + hstepB, voffB); PG8_STAGE(PG8_SA(0, 0), a2, o2[0]);
            PG8_WAIT_V(8); PG8_WAIT_L(0); PG8_BAR; PG8_MMA(1, 0, At, B0); PG8_MMA(1, 1, At, B1); PG8_BAR; PG8_SCHED;
            PG8_LDB(B0, 1, 0); PG8_LDB(B1, 1, 1); PG8_SCHED; PG8_LDA(At, 1, 0); PG8_STAGE(PG8_SA(0, 1), a2, o2[1]);
            PG8_WAIT_V(8); PG8_WAIT_L(0); PG8_BAR; PG8_MMA(0, 0, At, B0); PG8_MMA(0, 1, At, B1); PG8_BAR; PG8_SCHED;
            PG8_LDA(At, 1, 1); PG8_STAGE(PG8_SB(1, 0), b3, voffB); PG8_STAGE(PG8_SB(1, 1), b3 + hstepB, voffB); PG8_STAGE(PG8_SA(1, 0), a3, o2[0]);
            PG8_WAIT_V(8); PG8_WAIT_L(0); PG8_BAR; PG8_MMA(1, 0, At, B0); PG8_MMA(1, 1, At, B1); PG8_BAR; PG8_SCHED;
        }
        if constexpr (ALIGN_EPI) { if (wr == 0) PG8_BAR; }
        E(acc, cur, wr, wc, fr, fq);
        if (!has_next) break;
#pragma unroll
        for (int a = 0; a < 2; ++a)
#pragma unroll
            for (int b = 0; b < 2; ++b)
#pragma unroll
                for (int m = 0; m < 4; ++m)
#pragma unroll
                    for (int n = 0; n < 2; ++n) acc[a][b][m][n] = (f32x4){0.f, 0.f, 0.f, 0.f};
        cur = nxt; cA = nA; cB = nB; ++ui;
#pragma unroll
        for (int h = 0; h < 2; ++h)
#pragma unroll
            for (int i = 0; i < 2; ++i) offC[h][i] = offN[h][i];
        if constexpr (ALIGN_EPI) { if (wr == 1) PG8_BAR; }
    }
    PG8_WAIT_V(0);
    if constexpr (!ALIGN_EPI) { if (wr == 0) PG8_BAR; }
    PG8_BAR;
#undef PG8_SA
#undef PG8_SB
#undef PG8_STAGE
#undef PG8_LDA
#undef PG8_LDB
#undef PG8_MMA
#undef PG8_WAIT_V
#undef PG8_WAIT_L
#undef PG8_BAR
#undef PG8_SCHED
}

struct PlainProb {
    const char* A; const char* Bt; int lda, ldb, nt, nM, nN, G, c;
    DI bool next(int i, Unit& u) const {
        const long L = (long)i * G + c; const int nwg = nM * nN; if (L >= nwg) return false;
        int wgid = (int)L; { const int q = nwg / 8, r = nwg % 8, xcd = wgid % 8, off = wgid / 8; wgid = (xcd < r ? xcd * (q + 1) : r * (q + 1) + (xcd - r) * q) + off; }
        const int nig = 8 * nN, gid = wgid / nig, fm = gid * 8, gsz = (nM - fm) < 8 ? (nM - fm) : 8;
        u.pm = fm + ((wgid % nig) % gsz); u.pn = (wgid % nig) / gsz; u.e = 0; u.blk = 0; return true;
    }
    DI const char* a_base(const Unit& u) const { return A + (size_t)u.pm * 256 * lda * 2; }
    DI const char* b_base(const Unit& u) const { return Bt + (size_t)u.pn * 256 * ldb * 2; }
    DI unsigned a_off(const Unit&, int row) const { return (unsigned)row * (unsigned)lda * 2u; }
};
}

constexpr size_t MiB = 1u << 20;
constexpr size_t WS_CTL = 0, CTL_ZERO_BYTES = 1 * MiB;
constexpr size_t WS_MOD = 1 * MiB;
constexpr size_t WS_RT_EID = 3 * MiB;
constexpr size_t WS_RT_GATE = WS_RT_EID + 512 * 1024;
constexpr size_t WS_RT_PIE = WS_RT_GATE + 512 * 1024;
constexpr size_t WS_RT_SORT = WS_RT_PIE + 512 * 1024;
constexpr size_t WS_WIN = 8 * MiB;
constexpr size_t WS_WOUT = 17 * MiB;
constexpr size_t WS_WMLA = 21 * MiB;
constexpr size_t WS_WGLU = 23 * MiB;
constexpr size_t WS_WR = 23 * MiB + 256 * 1024;
constexpr size_t WS_WLRU = 23 * MiB + 640 * 1024;
constexpr size_t WS_WLORA = 23 * MiB + 768 * 1024;
static_assert(WS_WGLU + 256 * 1024 <= WS_WR && WS_WR + 384 * 1024 <= WS_WLRU && WS_WLRU + 128 * 1024 <= WS_WLORA && WS_WLORA + 128 * 1024 <= 24 * MiB, "small weight map");
constexpr size_t WS_H = 24 * MiB;
constexpr size_t WS_Z = 152 * MiB;
constexpr size_t WS_WM1 = WS_Z;
constexpr size_t WS_WM2 = WS_Z + 64 * MiB;
constexpr size_t WS_MIX = 440 * MiB;
constexpr size_t WS_HID = WS_MIX;
constexpr size_t WS_Y = 569 * MiB;
constexpr size_t WS_Q = 825 * MiB;
constexpr size_t WS_K = 873 * MiB;
constexpr size_t WS_VT = 921 * MiB;
constexpr size_t WS_ROWSS = WS_Q;
constexpr size_t WS_TAIL = 953 * MiB;
constexpr size_t WS_END = 1017 * MiB;
constexpr size_t WS_AMLA = WS_TAIL;
constexpr size_t WS_QKVRAW = WS_Y;
constexpr size_t WS_ATTO = WS_H;
constexpr size_t WS_RW_V = WS_Y + 64 * MiB, WS_RW_G = WS_H + 64 * MiB;
constexpr size_t WS_RC_RP = WS_H + 32 * MiB;
constexpr size_t WS_RC_MP = WS_H + 64 * MiB;
constexpr size_t WS_RC_HB = WS_H + 96 * MiB;
constexpr size_t WS_RC_Y0 = WS_Q;
constexpr size_t WS_RC_G = WS_Q + 64 * MiB;
constexpr int RC_REC = 24832;
constexpr size_t WS_RC_BS = WS_Q + 64 * MiB + 98 * MiB;
static_assert((size_t)4096 * RC_REC <= 98 * MiB && WS_RC_BS + 1 * MiB <= WS_END, "rwkv record map");
constexpr size_t WS_YS5 = WS_Y;
constexpr size_t WS_YS5G = WS_Y + 32 * MiB;
constexpr size_t WS_YL = WS_TAIL + 32 * MiB;
constexpr size_t WS_LA = WS_Y + 128 * MiB, WS_LB = WS_Y + 192 * MiB;
constexpr size_t WS_S5END = 2 * MiB;
constexpr size_t WS_S5BB = 5 * MiB;
constexpr size_t WS_S5CC = 5 * MiB + 128 * 1024;
constexpr size_t WS_LSUM = 5 * MiB + 512 * 1024;
static_assert(WS_RT_SORT + 512 * 1024 <= WS_LSUM && WS_LSUM + 2 * MiB <= WS_WIN && WS_S5END + 1 * MiB <= WS_RT_EID, "map");

constexpr int CW_BAR = 4096;
constexpr int CW_CNT = 16384;
constexpr int CW_UTAB = 20480;

constexpr int NWAVES = 8, NTHR = 512;
constexpr int LDS_BYTES = 155648;
constexpr int MISC_OFF = 155648 - 256;

struct Args { const float* in[51]; const int* pos_off; float* out; unsigned char* ws; int ph_lo, ph_hi, use_bar, pad; };
typedef const __attribute__((address_space(4))) Args CArgs;
DI CArgs* get_args() { CArgs* ap = (CArgs*)__builtin_amdgcn_kernarg_segment_ptr(); asm volatile("" : "+s"(ap)); return ap; }

#define XB_TMO      128
#define XB_XCNT(j)  (256  + 64 * (j))
#define XB_XSUB(j)  (1280 + 64 * (j))
#define XB_XGEN(j)  (2304 + 64 * (j))
#define XB_TOP      3328
#define XB_TOPGEN   3392
#define XCD_BAR_WORDS 3456
#define XB_SPIN_CAP (1u << 18)
DI unsigned xb_ld(unsigned* p)              { return __hip_atomic_load(p, __ATOMIC_RELAXED, __HIP_MEMORY_SCOPE_AGENT); }
DI unsigned xb_add(unsigned* p, unsigned v) { return __hip_atomic_fetch_add(p, v, __ATOMIC_RELAXED, __HIP_MEMORY_SCOPE_AGENT); }
DI unsigned xb_xcc_id() { return (unsigned)__builtin_amdgcn_s_getreg((3 << 11) | 20) & 0xFu; }
#define XB_SPIN(cond, bar) do { unsigned _sp = 0; while (cond) { __builtin_amdgcn_s_sleep(1); \
    if ((++_sp & 255u) == 0u) { if (xb_ld(&(bar)[XB_TMO])) break; if (_sp > XB_SPIN_CAP) { atomicAdd(&(bar)[XB_TMO], 1u); break; } } } } while (0)
struct XcdBarrier { unsigned* bar; unsigned x; volatile LAS unsigned* st; };
DI XcdBarrier xcd_barrier_post(unsigned* bar, volatile LAS unsigned* st) {
    XcdBarrier b; b.bar = bar; b.x = xb_xcc_id(); b.st = st;
    if (threadIdx.x == 0) (void)xb_add(&bar[XB_XCNT(b.x)], 1u);
    return b;
}
DI void xcd_barrier_complete(unsigned* bar, unsigned x, unsigned& nloc, unsigned& nx) {
    const unsigned G = gridDim.x * gridDim.y * gridDim.z;
    unsigned sum, cnt, mine, sp = 0u;
    for (;;) {
        sum = 0u; cnt = 0u; mine = 0u;
#pragma unroll
        for (unsigned j = 0; j < 16; ++j) { const unsigned c = xb_ld(&bar[XB_XCNT(j)]); sum += c; cnt += (c > 0u) ? 1u : 0u; mine = (j == x) ? c : mine; }
        if (sum == G) break;
        __builtin_amdgcn_s_sleep(1);
        if ((++sp & 255u) == 0u) { if (xb_ld(&bar[XB_TMO])) break; if (sp > XB_SPIN_CAP) { atomicAdd(&bar[XB_TMO], 1u); break; } }
    }
    nloc = mine > 0u ? mine : 1u; nx = cnt > 0u ? cnt : 1u;
}
DI void xcd_barrier(const XcdBarrier& b) {
    asm volatile("s_waitcnt vmcnt(0)" ::: "memory");
    __syncthreads();
    if (threadIdx.x == 0) {
        unsigned* bar = b.bar;
        __builtin_amdgcn_s_waitcnt(0);
        unsigned nloc = b.st[0], nx = b.st[1];
        if (nloc == 0u) { xcd_barrier_complete(bar, b.x, nloc, nx); b.st[0] = nloc; b.st[1] = nx; }
        const unsigned old = xb_add(&bar[XB_XSUB(b.x)], 1u);
        const unsigned gen = old / nloc;
        if (old + 1u == (gen + 1u) * nloc) {
            __builtin_amdgcn_fence(__ATOMIC_RELEASE, "agent");
            asm volatile("s_waitcnt vmcnt(0)" ::: "memory");
            const unsigned og = xb_add(&bar[XB_TOP], 1u);
            const unsigned tg = og / nx;
            if (og + 1u == (tg + 1u) * nx) xb_add(&bar[XB_TOPGEN], 1u);
            else XB_SPIN(xb_ld(&bar[XB_TOPGEN]) == tg, bar);
            __builtin_amdgcn_fence(__ATOMIC_ACQUIRE, "agent");
            xb_add(&bar[XB_XGEN(b.x)], 1u);
            asm volatile("s_waitcnt vmcnt(0)" ::: "memory");
        } else {
            XB_SPIN(xb_ld(&bar[XB_XGEN(b.x)]) == gen, bar);
            __builtin_amdgcn_fence(__ATOMIC_ACQUIRE, "agent");
            asm volatile("s_waitcnt vmcnt(0)" ::: "memory");
        }
    }
    __syncthreads();
}

struct EpiBf16Plain {
    static constexpr bool PERM = true;
    bf16_t* O; int ldc;
    DI void operator()(const f32x4 (&acc)[2][2][4][2], const pg8::Unit& u, int wr, int wc, int fr, int fq) const {
        const int row0 = u.pm * 256 + wr * 64 + fr, col0 = u.pn * 256 + wc * 32 + 8 * fq;
#pragma unroll
        for (int ai = 0; ai < 2; ++ai)
#pragma unroll
            for (int m = 0; m < 4; ++m) { bf16_t* rowp = O + (size_t)(row0 + ai * 128 + m * 16) * ldc + col0;
#pragma unroll
                for (int bj = 0; bj < 2; ++bj) { const f32x4 v0 = acc[ai][bj][m][0], v1 = acc[ai][bj][m][1];
                    u32x4 w; w.x = pk2(v0[0], v0[1]); w.y = pk2(v0[2], v0[3]); w.z = pk2(v1[0], v1[1]); w.w = pk2(v1[2], v1[3]);
                    *(u32x4*)(rowp + bj * 128) = w; } }
    }
};
struct EpiResGate {
    static constexpr bool PERM = false;
    const float* xin; float* out; const float* gt; float* rowss;
    DI void operator()(const f32x4 (&acc)[2][2][4][2], const pg8::Unit& u, int wr, int wc, int fr, int fq) const {
        const int row0 = u.pm * 256 + wr * 64 + fr, col0 = u.pn * 256 + wc * 32 + 4 * fq;
        const int b = (u.pm * 256) / SEQ;
        const int ln = lane_opaque();
        f32x4 g[2][2];
#pragma unroll
        for (int bj = 0; bj < 2; ++bj)
#pragma unroll
            for (int n = 0; n < 2; ++n) g[bj][n] = *(const f32x4*)(gt + (size_t)b * 6144 + col0 + bj * 128 + n * 16);
#pragma unroll
        for (int ai = 0; ai < 2; ++ai)
#pragma unroll
            for (int m = 0; m < 4; ++m) { const size_t ro = (size_t)(row0 + ai * 128 + m * 16) * DM + col0; float ss = 0.f;
#pragma unroll
                for (int bj = 0; bj < 2; ++bj)
#pragma unroll
                    for (int n = 0; n < 2; ++n) { const f32x4 xv = *(const f32x4*)(xin + ro + bj * 128 + n * 16); const f32x4 v = xv + g[bj][n] * acc[ai][bj][m][n];
                        *(f32x4*)(out + ro + bj * 128 + n * 16) = v; ss += (v[0] * v[0] + v[1] * v[1]) + (v[2] * v[2] + v[3] * v[3]); }
                ss += shfl_xor_l(ss, 16, ln); ss += shfl_xor_l(ss, 32, ln);
                if (fq == 0) rowss[(size_t)(row0 + ai * 128 + m * 16) * 16 + u.pn * 4 + wc] = ss; }
    }
};
struct EpiGlu {
    static constexpr bool PERM = true;
    const bf16_t* Y; bf16_t* O; const float* bias;
    DI void operator()(const f32x4 (&acc)[2][2][4][2], const pg8::Unit& u, int wr, int wc, int fr, int fq) const {
        const int row0 = u.pm * 256 + wr * 64 + fr, col0 = wc * 32 + 8 * fq;
#pragma unroll
        for (int ai = 0; ai < 2; ++ai)
#pragma unroll
            for (int m = 0; m < 4; ++m) { const size_t ro = (size_t)(row0 + ai * 128 + m * 16) * 256 + col0;
#pragma unroll
                for (int bj = 0; bj < 2; ++bj) { const u32x4 yv = *(const u32x4*)(Y + ro + bj * 128);
                    const f32x4 b0 = *(const f32x4*)(bias + col0 + bj * 128), b1 = *(const f32x4*)(bias + col0 + bj * 128 + 4);
                    const f32x4 v0 = acc[ai][bj][m][0] + b0, v1 = acc[ai][bj][m][1] + b1;
                    u32x4 w;
                    w.x = pk2(bflo(yv.x) * sigmoidf_(v0[0]), bfhi(yv.x) * sigmoidf_(v0[1]));
                    w.y = pk2(bflo(yv.y) * sigmoidf_(v0[2]), bfhi(yv.y) * sigmoidf_(v0[3]));
                    w.z = pk2(bflo(yv.z) * sigmoidf_(v1[0]), bfhi(yv.z) * sigmoidf_(v1[1]));
                    w.w = pk2(bflo(yv.w) * sigmoidf_(v1[2]), bfhi(yv.w) * sigmoidf_(v1[3]));
                    *(u32x4*)(O + ro + bj * 128) = w; } }
    }
};

struct Frame { LAS unsigned char* lds; int tid, lane, wave, G, bid, gw, ngw; };

DI Frame make_frame(LAS unsigned char* lds, int wave0) {
    Frame F; F.lds = lds; int w = wave0; asm volatile("" : "+s"(w)); F.wave = w; F.lane = lane_opaque(); F.tid = w * 64 + F.lane;
    F.G = gridDim.x; F.bid = blockIdx.x; F.gw = F.bid * NWAVES + F.wave; F.ngw = F.G * NWAVES; return F;
}
DI void transpose_item(const float* src, int ld_src, int k0, int n0, bf16_t* dst, int ldd, int nd0, int kd0, LAS float* scr, int lane) {
#pragma unroll 8
    for (int i = 0; i < 32; ++i) { const int kk = 2 * i + (lane >> 5); scr[kk * 33 + (lane & 31)] = src[(size_t)(k0 + kk) * ld_src + n0 + (lane & 31)]; }
    asm volatile("s_waitcnt lgkmcnt(0)" ::: "memory");
    const int c = lane & 7;
#pragma unroll
    for (int j = 0; j < 4; ++j) { const int n = (lane >> 3) + 8 * j; const LAS float* s = scr + (8 * c) * 33 + n;
        u32x4 o; o.x = pk2(s[0 * 33], s[1 * 33]); o.y = pk2(s[2 * 33], s[3 * 33]); o.z = pk2(s[4 * 33], s[5 * 33]); o.w = pk2(s[6 * 33], s[7 * 33]);
        *(u32x4*)(dst + (size_t)(nd0 + n) * ldd + kd0 + 8 * c) = o; }
    asm volatile("s_waitcnt lgkmcnt(0)" ::: "memory");
}
DI void transpose_item64(const float* src, int ld_src, int k0, int n0, bf16_t* dst, int ldd, int nd0, int kd0, LAS float* scr, int lane) {
    f32x4 v[16];
#pragma unroll
    for (int i = 0; i < 16; ++i) v[i] = *(const f32x4*)(src + (size_t)(k0 + 4 * i + (lane >> 4)) * ld_src + n0 + 4 * (lane & 15));
#pragma unroll
    for (int i = 0; i < 16; ++i) { LAS float* p = scr + (4 * i + (lane >> 4)) * 65 + 4 * (lane & 15); p[0] = v[i][0]; p[1] = v[i][1]; p[2] = v[i][2]; p[3] = v[i][3]; }
    asm volatile("s_waitcnt lgkmcnt(0)" ::: "memory");
    const int c = lane & 7;
#pragma unroll
    for (int j = 0; j < 8; ++j) { const int n = (lane >> 3) + 8 * j; const LAS float* q = scr + (8 * c) * 65 + n;
        u32x4 o; o.x = pk2(q[0 * 65], q[1 * 65]); o.y = pk2(q[2 * 65], q[3 * 65]); o.z = pk2(q[4 * 65], q[5 * 65]); o.w = pk2(q[6 * 65], q[7 * 65]);
        *(u32x4*)(dst + (size_t)(nd0 + n) * ldd + kd0 + 8 * c) = o; }
    asm volatile("s_waitcnt lgkmcnt(0)" ::: "memory");
}
DI void zero_rows(bf16_t* dst, int ld, int r0, int nr, int c0, int nc, int gw, int ngw, int lane) {
    for (int r = gw; r < nr; r += ngw) for (int c = lane * 8; c < nc; c += 512) *(u32x4*)(dst + (size_t)(r0 + r) * ld + c0 + c) = (u32x4){0u, 0u, 0u, 0u};
}

DI void phase_prologue(const Frame& F, CArgs& A) {
    unsigned char* ws = A.ws;
    LAS float* sc = (LAS float*)F.lds;
    LAS float* part = (LAS float*)(F.lds + 32768);
    for (int i = F.tid; i < 8192; i += NTHR) sc[i] = siluf_(A.in[1][i]);
    __syncthreads();
    float* MOD = (float*)(ws + WS_MOD);
    for (int item = F.bid; item < 192; item += F.G) {
        const int l = item / 96, n0 = (item % 96) * 64, nl = F.tid & 63, kg = F.tid >> 6;
        const float* W = A.in[3] + (size_t)l * 1024 * 6144 + n0 + nl;
        float acc[8];
#pragma unroll
        for (int b = 0; b < 8; ++b) acc[b] = 0.f;
        for (int k = kg * 128; k < kg * 128 + 128; ++k) { const float w = W[(size_t)k * 6144];
#pragma unroll
            for (int b = 0; b < 8; ++b) acc[b] += sc[b * 1024 + k] * w; }
#pragma unroll
        for (int b = 0; b < 8; ++b) part[(kg * 8 + b) * 64 + nl] = acc[b];
        __syncthreads();
        { const int b = F.tid >> 6; float s = A.in[4][l * 6144 + n0 + nl];
#pragma unroll
          for (int g = 0; g < 8; ++g) s += part[(g * 8 + b) * 64 + nl];
          MOD[((size_t)l * 8 + b) * 6144 + n0 + nl] = s; }
        __syncthreads();
    }
    LAS float* scr = (LAS float*)(F.lds + F.wave * 16640);
    bf16_t* WIN = (bf16_t*)(ws + WS_WIN); bf16_t* WOUT = (bf16_t*)(ws + WS_WOUT); bf16_t* WMLA = (bf16_t*)(ws + WS_WMLA); bf16_t* WGLU = (bf16_t*)(ws + WS_WGLU);
    constexpr int I_IN = 16 * 32, I_INT = 16, I_OUT = 16 * 16, I_Q = 4 * 6, I_KV = 2 * 8, I_GLU = 4 * 4, I_L = I_IN + I_INT + I_OUT + I_Q + I_KV + I_GLU;
    for (int it = F.gw; it < 2 * I_L; it += F.ngw) {
        const int l = it / I_L; int r = it % I_L;
        if (r < I_IN) { transpose_item64(A.in[6] + (size_t)l * 1024 * D_IN, D_IN, 64 * (r / 32), 64 * (r % 32), WIN + (size_t)l * ZS * 1024, 1024, 64 * (r % 32), 64 * (r / 32), scr, F.lane); continue; } r -= I_IN;
        if (r < I_INT) { transpose_item(A.in[6] + (size_t)l * 1024 * D_IN, D_IN, 64 * r, 2048, WIN + (size_t)l * ZS * 1024, 1024, 2048, 64 * r, scr, F.lane); continue; } r -= I_INT;
        if (r < I_OUT) { transpose_item64(A.in[42] + (size_t)l * 1024 * 1024, 1024, 64 * (r / 16), 64 * (r % 16), WOUT + (size_t)l * 1024 * 1024, 1024, 64 * (r % 16), 64 * (r / 16), scr, F.lane); continue; } r -= I_OUT;
        if (r < I_Q) { transpose_item64(A.in[29] + (size_t)l * 256 * 384, 384, 64 * (r / 6), 64 * (r % 6), WMLA + (size_t)l * 1024 * 512, 512, 64 * (r % 6), 64 * (r / 6), scr, F.lane); continue; } r -= I_Q;
        if (r < I_KV) { transpose_item64(A.in[31] + (size_t)l * 128 * 512, 512, 64 * (r / 8), 64 * (r % 8), WMLA + (size_t)l * 1024 * 512, 512, 384 + 64 * (r % 8), 256 + 64 * (r / 8), scr, F.lane); continue; } r -= I_KV;
        transpose_item64(A.in[26] + (size_t)l * 256 * 256, 256, 64 * (r / 4), 64 * (r % 4), WGLU + (size_t)l * 256 * 256, 256, 64 * (r % 4), 64 * (r / 4), scr, F.lane);
    }
    { bf16_t* WR = (bf16_t*)(ws + WS_WR);
      for (int i = F.bid * NTHR + F.tid; i < 2 * 48 * 1024; i += F.G * NTHR) { const int l = i / (48 * 1024), n = (i / 1024) % 48, k = i % 1024;
          const float v = n < 4 ? A.in[44][((size_t)l * 1024 + k) * 4 + n] : n < 36 ? A.in[46][((size_t)l * 1024 + k) * 32 + (n - 4)] : 0.f;
          const unsigned hi = f2bf(v); const float rem = v - __uint_as_float(hi << 16);
          WR[((size_t)(l * 2 + 0) * 48 + n) * 1024 + k] = (bf16_t)hi; WR[((size_t)(l * 2 + 1) * 48 + n) * 1024 + k] = (bf16_t)f2bf(rem); } }
    { bf16_t* WL = (bf16_t*)(ws + WS_WLRU); bf16_t* WO = (bf16_t*)(ws + WS_WLORA);
      for (int i = F.bid * NTHR + F.tid; i < 2 * 2 * 4 * 4096; i += F.G * NTHR) { const int l = i >> 15, wh = (i >> 14) & 1, n = (i >> 12) & 3, j = (i >> 6) & 63, k = i & 63;
          WL[i] = (bf16_t)f2bf((wh ? A.in[38] : A.in[36])[((size_t)(l * 4 + n) * 64 + k) * 64 + j]); }
      for (int i = F.bid * NTHR + F.tid; i < 2 * 32768; i += F.G * NTHR) { const int l = i >> 15, r = i & 32767;
          float v;
          if (r < 8192) v = A.in[9][(size_t)l * 8192 + (r & 31) * 256 + (r >> 5)];
          else if (r < 16384) v = A.in[11][(size_t)l * 8192 + ((r - 8192) & 31) * 256 + ((r - 8192) >> 5)];
          else v = A.in[12][(size_t)l * 16384 + ((r - 16384) & 63) * 256 + ((r - 16384) >> 6)];
          WO[i] = (bf16_t)f2bf(v); } }
    { bf16_t* BBt = (bf16_t*)(ws + WS_S5BB); bf16_t* CCt = (bf16_t*)(ws + WS_S5CC);
      for (int i = F.bid * NTHR + F.tid; i < 2 * 16 * 64; i += F.G * NTHR) { const int lg = i >> 6, p = i & 63;
          const float dt = __expf(A.in[25][lg]); const float lre = A.in[18][lg * 64 + p], lim = A.in[19][lg * 64 + p];
          const float mag = expf(lre * dt); float sn, cn; sincosf(lim * dt, &sn, &cn);
          const float are = mag * cn, aim = mag * sn, den = lre * lre + lim * lim;
          const float qre = ((are - 1.f) * lre + aim * lim) / den, qim = (aim * lre - (are - 1.f) * lim) / den;
          const float* br = A.in[20] + ((size_t)lg * 64 + p) * 16; const float* bi = A.in[21] + ((size_t)lg * 64 + p) * 16;
          for (int c = 0; c < 16; ++c) { const float x = br[c], y = bi[c];
              BBt[(((size_t)lg * 2 + 0) * 64 + p) * 16 + c] = (bf16_t)f2bf(qre * x - qim * y); BBt[(((size_t)lg * 2 + 1) * 64 + p) * 16 + c] = (bf16_t)f2bf(qre * y + qim * x); } }
      for (int i = F.bid * NTHR + F.tid; i < 2 * 16 * 16 * 128; i += F.G * NTHR) { const int lg = i >> 11, ii = (i >> 7) & 15, k = i & 127;
          CCt[i] = (bf16_t)f2bf(k < 64 ? A.in[22][((size_t)lg * 16 + ii) * 64 + k] : -A.in[23][((size_t)lg * 16 + ii) * 64 + (k - 64)]); } }
    for (int l = 0; l < 2; ++l) {
        zero_rows(WIN + (size_t)l * ZS * 1024, 1024, D_IN, ZS - D_IN, 0, 1024, F.gw, F.ngw, F.lane);
        bf16_t* wm = WMLA + (size_t)l * 1024 * 512;
        zero_rows(wm, 512, 0, 384, 256, 256, F.gw, F.ngw, F.lane);
        zero_rows(wm, 512, 384, 512, 0, 256, F.gw, F.ngw, F.lane);
        zero_rows(wm, 512, 384, 512, 384, 128, F.gw, F.ngw, F.lane);
        zero_rows(wm, 512, 896, 128, 0, 512, F.gw, F.ngw, F.lane);
    }
}

DI void phase_norm1(const Frame& F, CArgs& A, int l) {
    const float* MODL = (const float*)(A.ws + WS_MOD) + (size_t)l * 8 * 6144;
    const float* g = A.in[5] + l * 1024;
    const bf16_t* Y = (const bf16_t*)(A.ws + WS_Y);
    bf16_t* H = (bf16_t*)(A.ws + WS_H);
    const float* src = (l == 0) ? A.in[0] : A.out;
    for (int row0 = 2 * F.gw; row0 < T; row0 += 2 * F.ngw) {
        const int b = row0 / SEQ;
        f32x4 v[2][4]; u32x2 ya[2][4], yb[2][4];
#pragma unroll
        for (int r = 0; r < 2; ++r)
#pragma unroll
            for (int j = 0; j < 4; ++j) { const int col = 4 * (64 * j + F.lane); v[r][j] = *(const f32x4*)(src + (size_t)(row0 + r) * DM + col);
                if (l > 0) { ya[r][j] = *(const u32x2*)(Y + (size_t)(2 * (row0 + r)) * DM + col); yb[r][j] = *(const u32x2*)(Y + (size_t)(2 * (row0 + r) + 1) * DM + col); } }
#pragma unroll
        for (int r = 0; r < 2; ++r) {
            const int row = row0 + r; float ss = 0.f;
#pragma unroll
            for (int j = 0; j < 4; ++j) { const int col = 4 * (64 * j + F.lane);
                if (l > 0) { const u32x2 y0 = ya[r][j], y1 = yb[r][j];
                    v[r][j][0] += bflo(y0.x) + bflo(y1.x); v[r][j][1] += bfhi(y0.x) + bfhi(y1.x); v[r][j][2] += bflo(y0.y) + bflo(y1.y); v[r][j][3] += bfhi(y0.y) + bfhi(y1.y);
                    *(f32x4*)(A.out + (size_t)row * DM + col) = v[r][j]; }
                ss += v[r][j][0] * v[r][j][0] + v[r][j][1] * v[r][j][1] + v[r][j][2] * v[r][j][2] + v[r][j][3] * v[r][j][3]; }
            const float rstd = rsqrtf(wave_sum(ss) * (1.f / DM) + NORM_EPS);
#pragma unroll
            for (int j = 0; j < 4; ++j) { const int col = 4 * (64 * j + F.lane);
                const f32x4 gg = *(const f32x4*)(g + col), sh = *(const f32x4*)(MODL + (size_t)b * 6144 + col), scv = *(const f32x4*)(MODL + (size_t)b * 6144 + 1024 + col);
                const f32x4 hv = v[r][j] * rstd * gg * (scv + 1.f) + sh;
                u32x2 o; o.x = pk2(hv[0], hv[1]); o.y = pk2(hv[2], hv[3]);
                *(u32x2*)(H + (size_t)row * DM + col) = o; }
        }
    }
}

DI void phase_mla_prep(const Frame& F, CArgs& A, int l) {
    const bf16_t* Z = (const bf16_t*)(A.ws + WS_Z); bf16_t* AM = (bf16_t*)(A.ws + WS_AMLA);
    const float* qg = A.in[28] + l * 256; const float* kg = A.in[30] + l * 128;
    for (int row = F.gw; row < T; row += F.ngw) {
        const bf16_t* zr = Z + (size_t)row * ZS;
        const u32x2 qv = *(const u32x2*)(zr + ZC_QA + 4 * F.lane); const unsigned kv = *(const unsigned*)(zr + ZC_KVA + 2 * F.lane);
        const float q0 = bflo(qv.x), q1 = bfhi(qv.x), q2 = bflo(qv.y), q3 = bfhi(qv.y), k0 = bflo(kv), k1 = bfhi(kv);
        const float rq = rsqrtf(wave_sum(q0 * q0 + q1 * q1 + q2 * q2 + q3 * q3) * (1.f / 256.f) + NORM_EPS);
        const float rk = rsqrtf(wave_sum(k0 * k0 + k1 * k1) * (1.f / 128.f) + NORM_EPS);
        const f32x4 g4 = *(const f32x4*)(qg + 4 * F.lane); const f32x2 g2 = *(const f32x2*)(kg + 2 * F.lane);
        u32x2 o; o.x = pk2(q0 * rq * g4[0], q1 * rq * g4[1]); o.y = pk2(q2 * rq * g4[2], q3 * rq * g4[3]);
        bf16_t* ar = AM + (size_t)row * 512;
        *(u32x2*)(ar + 4 * F.lane) = o;
        *(unsigned*)(ar + 256 + 2 * F.lane) = pk2(k0 * rk * g2[0], k1 * rk * g2[1]);
        *(unsigned*)(ar + 384 + 2 * F.lane) = 0u;
    }
}

DI void phase_mla_post(const Frame& F, CArgs& A, int l) {
    const bf16_t* Z = (const bf16_t*)(A.ws + WS_Z); const bf16_t* RAW = (const bf16_t*)(A.ws + WS_QKVRAW);
    bf16_t* Q = (bf16_t*)(A.ws + WS_Q); bf16_t* K = (bf16_t*)(A.ws + WS_K); bf16_t* VT = (bf16_t*)(A.ws + WS_VT);
    LAS float* cs = (LAS float*)F.lds;
    LAS bf16_t* vt = (LAS bf16_t*)(F.lds + 8192);
    const float* qhg = A.in[32] + l * 96; const float* khg = A.in[33] + l * 96;
    for (int tile = F.bid; tile < T / 64; tile += F.G) {
        const int t0 = tile * 64, b = t0 / SEQ, s0 = t0 % SEQ;
        int tz = F.tid; asm volatile("" : "+v"(tz));
        for (int idx = tz; idx < 1024; idx += NTHR) { const int tok = idx >> 4, i = idx & 15;
            const int pos = A.pos_off[b] + s0 + tok; const float inv = powf(10000.f, -(float)i * (1.f / 16.f));
            double ang = (double)(float)pos * (double)inv; ang -= 6.283185307179586 * floor(ang * 0.15915494309189535);
            float sn, cn; sincosf((float)ang, &sn, &cn); cs[idx * 2] = cn; cs[idx * 2 + 1] = sn; }
        lds_barrier();
        const int tok = tz >> 3, sub = tz & 7, h = sub >> 1, isk = sub & 1, t = t0 + tok;
        {
            float v[96];
            const bf16_t* p0 = isk ? RAW + (size_t)t * 1024 + 384 + 128 * h : RAW + (size_t)t * 1024 + 96 * h;
            const bf16_t* p1 = isk ? Z + (size_t)t * ZS + ZC_KPE : p0 + 64;
#pragma unroll
            for (int c = 0; c < 8; ++c) { const u32x4 w = *(const u32x4*)(p0 + 8 * c);
                v[8 * c] = bflo(w.x); v[8 * c + 1] = bfhi(w.x); v[8 * c + 2] = bflo(w.y); v[8 * c + 3] = bfhi(w.y); v[8 * c + 4] = bflo(w.z); v[8 * c + 5] = bfhi(w.z); v[8 * c + 6] = bflo(w.w); v[8 * c + 7] = bfhi(w.w); }
#pragma unroll
            for (int c = 0; c < 4; ++c) { const u32x4 w = *(const u32x4*)(p1 + 8 * c);
                v[64 + 8 * c] = bflo(w.x); v[65 + 8 * c] = bfhi(w.x); v[66 + 8 * c] = bflo(w.y); v[67 + 8 * c] = bfhi(w.y); v[68 + 8 * c] = bflo(w.z); v[69 + 8 * c] = bfhi(w.z); v[70 + 8 * c] = bflo(w.w); v[71 + 8 * c] = bfhi(w.w); }
            float ss = 0.f;
#pragma unroll
            for (int i = 0; i < 96; ++i) ss += v[i] * v[i];
            const float r = rsqrtf(ss * (1.f / 96.f) + NORM_EPS);
            const float* hg = isk ? khg : qhg;
#pragma unroll
            for (int i = 0; i < 96; ++i) v[i] = v[i] * r * hg[i];
#pragma unroll
            for (int i = 0; i < 16; ++i) { const float cn = cs[(tok * 16 + i) * 2], sn = cs[(tok * 16 + i) * 2 + 1]; const float x1 = v[64 + i], x2 = v[80 + i];
                v[64 + i] = x1 * cn - x2 * sn; v[80 + i] = x1 * sn + x2 * cn; }
            bf16_t* dst = (isk ? K : Q) + ((size_t)t * 4 + h) * 96;
#pragma unroll
            for (int c = 0; c < 12; ++c) { u32x4 w; w.x = pk2(v[8 * c], v[8 * c + 1]); w.y = pk2(v[8 * c + 2], v[8 * c + 3]); w.z = pk2(v[8 * c + 4], v[8 * c + 5]); w.w = pk2(v[8 * c + 6], v[8 * c + 7]);
                *(u32x4*)(dst + 8 * c) = w; }
        }
        {
            const bf16_t* pv = RAW + (size_t)t * 1024 + 384 + 128 * h + 64 + 32 * isk;
#pragma unroll
            for (int c = 0; c < 4; ++c) { const u32x4 w = *(const u32x4*)(pv + 8 * c); const int r0 = h * 64 + 32 * isk + 8 * c;
                vt[(r0 + 0) * 72 + tok] = (bf16_t)(w.x & 0xffffu); vt[(r0 + 1) * 72 + tok] = (bf16_t)(w.x >> 16);
                vt[(r0 + 2) * 72 + tok] = (bf16_t)(w.y & 0xffffu); vt[(r0 + 3) * 72 + tok] = (bf16_t)(w.y >> 16);
                vt[(r0 + 4) * 72 + tok] = (bf16_t)(w.z & 0xffffu); vt[(r0 + 5) * 72 + tok] = (bf16_t)(w.z >> 16);
                vt[(r0 + 6) * 72 + tok] = (bf16_t)(w.w & 0xffffu); vt[(r0 + 7) * 72 + tok] = (bf16_t)(w.w >> 16); }
        }
        lds_barrier();
        { const int row = tz >> 1, hf = tz & 1;
          bf16_t* dst = VT + ((size_t)(b * 4) * 64 + row) * SEQ + s0 + 32 * hf;
#pragma unroll
          for (int c = 0; c < 4; ++c) *(u32x4*)(dst + 8 * c) = *(const LAS u32x4*)(vt + row * 72 + 32 * hf + 8 * c); }
        lds_barrier();
    }
}

DI void attn_unit(const Frame& F, const bf16_t* Q, const bf16_t* K, const bf16_t* VT, bf16_t* O, int bh, int u, float eoff) {
    constexpr int KP = 208, VP = 144, KB = 64 * KP, VB = 64 * VP;
    LAS unsigned char* Ks = F.lds; LAS unsigned char* Vs = F.lds + 2 * KB;
    int tz = F.tid; asm volatile("" : "+v"(tz));
    const int b = bh >> 2, h = bh & 3, lane = tz & 63, w = F.wave, ql = lane & 31, hh = lane >> 5;
    const int ntile = 8 * u + 8, myl = 8 * u + w;
    const size_t tq0 = (size_t)b * SEQ + 512 * u + 64 * w + ql;
    bf16x8 qf[2][6];
#pragma unroll
    for (int qt = 0; qt < 2; ++qt)
#pragma unroll
        for (int s = 0; s < 6; ++s) qf[qt][s] = *(const bf16x8*)(Q + ((tq0 + 32 * qt) * 4 + h) * 96 + 16 * s + 8 * hh);
    f32x16 ot[2][2];
#pragma unroll
    for (int i = 0; i < 16; ++i) { ot[0][0][i] = 0.f; ot[0][1][i] = 0.f; ot[1][0][i] = 0.f; ot[1][1][i] = 0.f; }
    float lrun[2] = {0.f, 0.f};
    const float c2 = 0.10206207261596577f * 1.4426950408889634f;
    const int kp0 = tz, kp1 = tz + 512;
    const size_t kbase = ((size_t)b * SEQ * 4 + h) * 96;
    const bf16_t* vsrc = VT + ((size_t)bh * 64 + (tz >> 3)) * SEQ + 8 * (tz & 7);
    u32x4 rk0, rk1, rv;
    rk1 = (u32x4){0u, 0u, 0u, 0u};
#define ATT_LOAD(j) do { rk0 = *(const u32x4*)(K + kbase + (size_t)(64 * (j) + kp0 / 12) * 384 + 8 * (kp0 % 12)); \
        if (kp1 < 768) rk1 = *(const u32x4*)(K + kbase + (size_t)(64 * (j) + kp1 / 12) * 384 + 8 * (kp1 % 12)); \
        rv = *(const u32x4*)(vsrc + 64 * (j)); } while (0)
#define ATT_STORE(buf) do { *(LAS u32x4*)(Ks + (buf) * KB + (kp0 / 12) * KP + (kp0 % 12) * 16) = rk0; \
        if (kp1 < 768) *(LAS u32x4*)(Ks + (buf) * KB + (kp1 / 12) * KP + (kp1 % 12) * 16) = rk1; \
        *(LAS u32x4*)(Vs + (buf) * VB + (tz >> 3) * VP + (tz & 7) * 16) = rv; } while (0)
    ATT_LOAD(0); ATT_STORE(0);
    lds_barrier();
    for (int j = 0; j < ntile; ++j) {
        const int buf = j & 1;
        if (j + 1 < ntile) ATT_LOAD(j + 1);
        if (j <= myl) {
            if (w >= 4) __builtin_amdgcn_s_sleep(6);
#pragma unroll
            for (int kt = 0; kt < 2; ++kt) {
                f32x16 st[2];
#pragma unroll
                for (int i = 0; i < 16; ++i) { st[0][i] = 0.f; st[1][i] = 0.f; }
#pragma unroll
                for (int s = 0; s < 6; ++s) { const bf16x8 kf = *(const LAS bf16x8*)(Ks + buf * KB + (32 * kt + ql) * KP + (16 * s + 8 * hh) * 2);
                    st[0] = __builtin_amdgcn_mfma_f32_32x32x16_bf16(kf, qf[0][s], st[0], 0, 0, 0);
                    st[1] = __builtin_amdgcn_mfma_f32_32x32x16_bf16(kf, qf[1][s], st[1], 0, 0, 0); }
                bf16x8 pf[2][2];
#pragma unroll
                for (int qt = 0; qt < 2; ++qt) { float ps = 0.f;
#pragma unroll
                    for (int i = 0; i < 16; ++i) { const float p = __builtin_amdgcn_exp2f(st[qt][i] * c2 - eoff); st[qt][i] = p; ps += p; }
                    lrun[qt] += ps;
#pragma unroll
                    for (int c = 0; c < 2; ++c) { u32x4 pw; pw.x = pk2(st[qt][8 * c], st[qt][8 * c + 1]); pw.y = pk2(st[qt][8 * c + 2], st[qt][8 * c + 3]); pw.z = pk2(st[qt][8 * c + 4], st[qt][8 * c + 5]); pw.w = pk2(st[qt][8 * c + 6], st[qt][8 * c + 7]);
                        pf[qt][c] = __builtin_bit_cast(bf16x8, pw); } }
#pragma unroll
                for (int c = 0; c < 2; ++c) {
                    const int key0 = 32 * kt + 16 * c + 4 * hh;
#pragma unroll
                    for (int dt = 0; dt < 2; ++dt) { const LAS unsigned char* vp = Vs + buf * VB + (32 * dt + ql) * VP + key0 * 2;
                        const u32x2 v0 = *(const LAS u32x2*)vp, v1 = *(const LAS u32x2*)(vp + 16);
                        u32x4 vw; vw.x = v0.x; vw.y = v0.y; vw.z = v1.x; vw.w = v1.y; const bf16x8 vf = __builtin_bit_cast(bf16x8, vw);
                        ot[dt][0] = __builtin_amdgcn_mfma_f32_32x32x16_bf16(vf, pf[0][c], ot[dt][0], 0, 0, 0);
                        ot[dt][1] = __builtin_amdgcn_mfma_f32_32x32x16_bf16(vf, pf[1][c], ot[dt][1], 0, 0, 0); }
                }
            }
        }
        if (j + 1 < ntile) ATT_STORE(buf ^ 1);
        lds_barrier();
    }
#undef ATT_LOAD
#undef ATT_STORE
#pragma unroll
    for (int qt = 0; qt < 2; ++qt) {
        const float linv = 1.f / (lrun[qt] + shfl_xor_l(lrun[qt], 32, lane));
        bf16_t* orow = O + (tq0 + 32 * qt) * 256 + h * 64;
#pragma unroll
        for (int dt = 0; dt < 2; ++dt)
#pragma unroll
            for (int g = 0; g < 4; ++g) { u32x2 o; o.x = pk2(ot[dt][qt][4 * g] * linv, ot[dt][qt][4 * g + 1] * linv); o.y = pk2(ot[dt][qt][4 * g + 2] * linv, ot[dt][qt][4 * g + 3] * linv);
                *(u32x2*)(orow + 32 * dt + 8 * g + 4 * hh) = o; }
    }
}
DI void phase_attn(const Frame& F, CArgs& A, int l) {
    const bf16_t* Q = (const bf16_t*)(A.ws + WS_Q); const bf16_t* K = (const bf16_t*)(A.ws + WS_K); const bf16_t* VT = (const bf16_t*)(A.ws + WS_VT);
    bf16_t* O = (bf16_t*)(A.ws + WS_ATTO);
    float gq = 0.f, gk = 0.f;
    for (int i = 0; i < 96; ++i) { gq = fmaxf(gq, fabsf(A.in[32][l * 96 + i])); gk = fmaxf(gk, fabsf(A.in[33][l * 96 + i])); }
    const float eoff = 96.f * gq * gk * 0.10206207261596577f * 1.4426950408889634f * 1.0001f;
    for (int p = F.bid; p < 256; p += F.G) { const int bh = p >> 3, u = p & 7;
        attn_unit(F, Q, K, VT, O, bh, 15 - u, eoff);
        attn_unit(F, Q, K, VT, O, bh, u, eoff); }
}
DI f32x16 mfma32(bf16x8 a, bf16x8 b, f32x16 c) { return __builtin_amdgcn_mfma_f32_32x32x16_bf16(a, b, c, 0, 0, 0); }
DI bf16x8 ldfrag(const LAS unsigned char* base, int row, int ks, int h) { return *(const LAS bf16x8*)(base + row * 144 + (16 * ks + 8 * h) * 2); }
DI f32x16 zero16() { f32x16 z;
#pragma unroll
    for (int i = 0; i < 16; ++i) z[i] = 0.f;
    return z; }
DI bf16x8 pack8(const f32x16& x, int o) { u32x4 p; p.x = pk2(x[o], x[o + 1]); p.y = pk2(x[o + 2], x[o + 3]); p.z = pk2(x[o + 4], x[o + 5]); p.w = pk2(x[o + 6], x[o + 7]); return __builtin_bit_cast(bf16x8, p); }
DI f32x16 tileprod(const LAS unsigned char* Aimg, int a0, const LAS unsigned char* Bimg, int b0, f32x16 acc, int lr, int h2) {
#pragma unroll
    for (int ks = 0; ks < 4; ++ks) acc = mfma32(ldfrag(Aimg, a0 + lr, ks, h2), ldfrag(Bimg, b0 + lr, ks, h2), acc);
    return acc;
}
DI void put_tile(LAS unsigned char* img, int c0, int r0, const f32x16& a, int lr, int h2) {
#pragma unroll
    for (int g = 0; g < 4; ++g) { u32x2 o; o.x = pk2(a[4 * g], a[4 * g + 1]); o.y = pk2(a[4 * g + 2], a[4 * g + 3]); *(LAS u32x2*)(img + (c0 + lr) * 144 + (r0 + 8 * g + 4 * h2) * 2) = o; }
}
DI void phase_rwkv_A(const Frame& F, CArgs& A, int l) {
    const bf16_t* Z = (const bf16_t*)(A.ws + WS_Z); bf16_t* V_ = (bf16_t*)(A.ws + WS_RW_V); bf16_t* G_ = (bf16_t*)(A.ws + WS_RW_G);
    const float* mu = A.in[7] + l * 896; const float* w0 = A.in[8] + l * 256; const float* a0 = A.in[10] + l * 256; const float* k_k = A.in[13] + l * 256; const float* k_a = A.in[14] + l * 256;
    const bf16_t* WO = (const bf16_t*)(A.ws + WS_WLORA) + (size_t)l * 32768;
    bf16_t* RP = (bf16_t*)(A.ws + WS_RC_RP); float* Y0T = (float*)(A.ws + WS_RC_Y0); unsigned char* REC = A.ws + WS_RC_G;
    float* BSUM = (float*)(A.ws + WS_RC_BS);
    const float* r_k = A.in[15] + l * 256;
    constexpr int TB = 64 * 144;
#define TILE(i) (F.lds + (i) * TB)
    LAS float* XF = (LAS float*)TILE(13);
    const int w = F.wave;
    for (int ub = F.bid; ub < 1024; ub += F.G) {
      const int b = ub >> 7, c = ub & 127;
      const size_t t0 = (size_t)b * SEQ + 64 * c;
      bf16x8 xf[4];
      {
        int tid = F.tid; asm volatile("" : "+v"(tid)); const int lane = tid & 63, fr = lane & 15, fq = lane >> 4, mt = w & 3;
        const int tk = 16 * mt + fr; const size_t t = t0 + tk; const bool hp = (64 * c + tk) > 0;
        const bf16_t* zr = Z + t * ZS + ZC_WLO + 8 * fq;
#pragma unroll
        for (int ks = 0; ks < 4; ++ks) {
            const u32x4 zc = *(const u32x4*)(zr + 32 * ks); u32x4 zp = {0u, 0u, 0u, 0u}; if (hp) zp = *(const u32x4*)(zr + 32 * ks - ZS);
            const f32x4 m0 = *(const f32x4*)(mu + ZC_WLO + 32 * ks + 8 * fq), m1 = *(const f32x4*)(mu + ZC_WLO + 32 * ks + 8 * fq + 4);
            const unsigned cw[4] = {zc.x, zc.y, zc.z, zc.w}, pw[4] = {zp.x, zp.y, zp.z, zp.w}; const float mm[8] = {m0[0], m0[1], m0[2], m0[3], m1[0], m1[1], m1[2], m1[3]};
            float v[8];
#pragma unroll
            for (int i = 0; i < 8; ++i) { const float zcv = (i & 1) ? bfhi(cw[i >> 1]) : bflo(cw[i >> 1]), zpv = (i & 1) ? bfhi(pw[i >> 1]) : bflo(pw[i >> 1]);
                float x = zcv + (zpv - zcv) * mm[i]; if (ks == 0) x = fast_tanh(x); else if (ks >= 2) x = sigmoidf_(x); v[i] = x; }
            u32x4 o; o.x = pk2(v[0], v[1]); o.y = pk2(v[2], v[3]); o.z = pk2(v[4], v[5]); o.w = pk2(v[6], v[7]); xf[ks] = __builtin_bit_cast(bf16x8, o);
        }
      }
      for (int hd = 0; hd < 4; ++hd) {
        const int u = (b * 4 + hd) * 128 + c;
        {
        int tid = F.tid; asm volatile("" : "+v"(tid)); const int lane = tid & 63, fr = lane & 15, fq = lane >> 4, mt = w & 3, nh = w >> 2;
        const int tk = 16 * mt + fr; const size_t t = t0 + tk; const bool hp = (64 * c + tk) > 0;
        LAS float* hs = (LAS float*)TILE(12);
        f32x4 aw[2], aa[2], ag[2];
        {
#pragma unroll
            for (int nf = 0; nf < 2; ++nf) { const int ch = hd * 64 + 32 * nh + 16 * nf + fr; const f32x4 z4 = {0.f, 0.f, 0.f, 0.f};
                aw[nf] = __builtin_amdgcn_mfma_f32_16x16x32_bf16(*(const bf16x8*)(WO + ch * 32 + 8 * fq), xf[0], z4, 0, 0, 0);
                aa[nf] = __builtin_amdgcn_mfma_f32_16x16x32_bf16(*(const bf16x8*)(WO + 8192 + ch * 32 + 8 * fq), xf[1], z4, 0, 0, 0);
                ag[nf] = __builtin_amdgcn_mfma_f32_16x16x32_bf16(*(const bf16x8*)(WO + 16384 + ch * 64 + 8 * fq), xf[2], z4, 0, 0, 0);
                ag[nf] = __builtin_amdgcn_mfma_f32_16x16x32_bf16(*(const bf16x8*)(WO + 16384 + ch * 64 + 32 + 8 * fq), xf[3], ag[nf], 0, 0, 0); }
        }
        f32x4 rr[2], kq[2], km[2], vv4[2], lw4[2], a4[2];
        float ssq = 0.f, bsp = 0.f;
#pragma unroll
        for (int nf = 0; nf < 2; ++nf) { const int d4 = 32 * nh + 16 * nf + 4 * fq, ch4 = hd * 64 + d4;
            const u32x2 rc = *(const u32x2*)(Z + t * ZS + ZC_R + ch4), kc = *(const u32x2*)(Z + t * ZS + ZC_K + ch4), vc = *(const u32x2*)(Z + t * ZS + ZC_V + ch4);
            u32x2 rp = {0u, 0u}, kp = {0u, 0u}, vp = {0u, 0u};
            if (hp) { rp = *(const u32x2*)(Z + (t - 1) * ZS + ZC_R + ch4); kp = *(const u32x2*)(Z + (t - 1) * ZS + ZC_K + ch4); vp = *(const u32x2*)(Z + (t - 1) * ZS + ZC_V + ch4); }
            const f32x4 mr = *(const f32x4*)(mu + ZC_R + ch4), mk = *(const f32x4*)(mu + ZC_K + ch4), mv = *(const f32x4*)(mu + ZC_V + ch4), ka = *(const f32x4*)(k_a + ch4), kkw = *(const f32x4*)(k_k + ch4), rk4 = *(const f32x4*)(r_k + ch4);
            const f32x4 rcv = {bflo(rc.x), bfhi(rc.x), bflo(rc.y), bfhi(rc.y)}, rpv = {bflo(rp.x), bfhi(rp.x), bflo(rp.y), bfhi(rp.y)};
            const f32x4 kcv = {bflo(kc.x), bfhi(kc.x), bflo(kc.y), bfhi(kc.y)}, kpv = {bflo(kp.x), bfhi(kp.x), bflo(kp.y), bfhi(kp.y)};
            const f32x4 vcv = {bflo(vc.x), bfhi(vc.x), bflo(vc.y), bfhi(vc.y)}, vpv = {bflo(vp.x), bfhi(vp.x), bflo(vp.y), bfhi(vp.y)};
            const f32x4 r = rcv + (rpv - rcv) * mr, k = kcv + (kpv - kcv) * mk, v = vcv + (vpv - vcv) * mv;
            const f32x4 wv = aw[nf] + *(const f32x4*)(w0 + ch4), av = aa[nf] + *(const f32x4*)(a0 + ch4);
#pragma unroll
            for (int i = 0; i < 4; ++i) { lw4[nf][i] = -__expf(-fast_softplus(-wv[i]) - 0.5f); a4[nf][i] = sigmoidf_(av[i]); kq[nf][i] = k[i] * kkw[i]; km[nf][i] = k[i] * (1.f + (a4[nf][i] - 1.f) * ka[i]);
                ssq += kq[nf][i] * kq[nf][i]; bsp += r[i] * km[nf][i] * rk4[i]; }
            rr[nf] = r; vv4[nf] = v;
            *(LAS f32x4*)(XF + tk * 64 + d4) = lw4[nf];
            u32x2 p; p.x = pk2(ag[nf][0], ag[nf][1]); p.y = pk2(ag[nf][2], ag[nf][3]); *(u32x2*)(G_ + t * 256 + ch4) = p;
            p.x = pk2(v[0], v[1]); p.y = pk2(v[2], v[3]); *(u32x2*)(V_ + t * 256 + ch4) = p;
        }
        ssq += shfl_xor_l(ssq, 16, lane); ssq += shfl_xor_l(ssq, 32, lane); bsp += shfl_xor_l(bsp, 16, lane); bsp += shfl_xor_l(bsp, 32, lane);
        if (fq == 0) { hs[nh * 64 + tk] = ssq; hs[128 + nh * 64 + tk] = bsp; }
        lds_barrier();
        if (w == 0) { float cv[64];
#pragma unroll
            for (int i = 0; i < 64; ++i) cv[i] = XF[i * 64 + lane];
            float run = 0.f;
#pragma unroll
            for (int i = 0; i < 64; ++i) { run += cv[i]; XF[i * 64 + lane] = run; } }
        if (w == 1) BSUM[(t0 + lane) * 4 + hd] = hs[128 + lane] + hs[192 + lane];
        lds_barrier();
        const float rn = rsqrtf(fmaxf(hs[tk] + hs[64 + tk], 1e-24f));
#pragma unroll
        for (int nf = 0; nf < 2; ++nf) { const int d4 = 32 * nh + 16 * nf + 4 * fq;
            const f32x4 cum = *(const LAS f32x4*)(XF + tk * 64 + d4), c63 = *(const LAS f32x4*)(XF + 63 * 64 + d4);
            f32x4 al, bt, kt, rb, bhh, khh;
#pragma unroll
            for (int i = 0; i < 4; ++i) { const float kk = kq[nf][i] * rn; const float ec = __expf(cum[i]), em = __builtin_amdgcn_rcpf(ec), ep = __expf(cum[i] - lw4[nf][i]), p63 = __expf(c63[i]);
                al[i] = -kk * ep; bt[i] = kk * a4[nf][i] * em; kt[i] = km[nf][i] * em; rb[i] = rr[nf][i] * ec; bhh[i] = bt[i] * p63; khh[i] = kt[i] * p63;
                if (tk == 63) *(float*)(REC + (size_t)u * RC_REC + 24576 + (d4 + i) * 4) = p63; }
            u32x2 o;
            o.x = pk2(al[0], al[1]); o.y = pk2(al[2], al[3]); *(LAS u32x2*)(TILE(0) + tk * 144 + d4 * 2) = o;
            o.x = pk2(bt[0], bt[1]); o.y = pk2(bt[2], bt[3]); *(LAS u32x2*)(TILE(1) + tk * 144 + d4 * 2) = o;
            o.x = pk2(kt[0], kt[1]); o.y = pk2(kt[2], kt[3]); *(LAS u32x2*)(TILE(2) + tk * 144 + d4 * 2) = o;
            o.x = pk2(rb[0], rb[1]); o.y = pk2(rb[2], rb[3]); *(LAS u32x2*)(TILE(3) + tk * 144 + d4 * 2) = o;
#pragma unroll
            for (int i = 0; i < 4; ++i) { *(LAS bf16_t*)(TILE(4) + (d4 + i) * 144 + tk * 2) = (bf16_t)f2bf(vv4[nf][i]); *(LAS bf16_t*)(TILE(5) + (d4 + i) * 144 + tk * 2) = (bf16_t)f2bf(bhh[i]);
                *(LAS bf16_t*)(TILE(6) + (d4 + i) * 144 + tk * 2) = (bf16_t)f2bf(khh[i]); *(LAS bf16_t*)(TILE(7) + (d4 + i) * 144 + tk * 2) = (bf16_t)f2bf(al[i]); }
        }
        }
        lds_barrier();
        f32x16 Tacc = zero16();
        {
        int tl = F.tid; asm volatile("" : "+v"(tl)); const int lane = tl & 63, lr = lane & 31, h2 = lane >> 5;
        unsigned zz = 0u; asm volatile("" : "+v"(zz));
        for (int i = tl; i < 768; i += NTHR) { const int q = i >> 7, rr = (i & 127) >> 2, cc = i & 3; const int tile = q < 4 ? 8 + q : q == 4 ? 14 : 12;
            *(LAS u32x4*)(TILE(tile) + (q == 5 ? (32 + rr) * 144 : rr * 144 + 64) + cc * 16) = (u32x4){zz, zz, zz, zz}; }
#pragma unroll
        for (int rnd = 0; rnd < 2; ++rnd) {
            const int j = w + 8 * rnd;
            if (j < 15) {
                const int prod = j / 3, tile = j % 3, si = tile == 2 ? 1 : 0, ti = tile == 0 ? 0 : 1;
                if (prod == 1) {
                    f32x16 acc = tileprod(TILE(0), 32 * ti, TILE(1), 32 * si, zero16(), lr, h2);
                    const int ss = 32 * si + lr;
#pragma unroll
                    for (int q = 0; q < 16; ++q) { const int tt = 32 * ti + 8 * (q >> 2) + 4 * h2 + (q & 3); if (!(ss < tt)) acc[q] = 0.f; }
                    put_tile(TILE(12), 32 * si, 32 * ti, acc, lr, h2);
                } else {
                    const LAS unsigned char* Ao = (prod == 0 || prod == 3) ? TILE(1) : TILE(2); const LAS unsigned char* Bo = prod >= 3 ? TILE(3) : TILE(0);
                    f32x16 acc = tileprod(Ao, 32 * si, Bo, 32 * ti, zero16(), lr, h2);
                    const int tt = 32 * ti + lr, incl = prod >= 3 ? 1 : 0;
#pragma unroll
                    for (int q = 0; q < 16; ++q) { const int ss = 32 * si + 8 * (q >> 2) + 4 * h2 + (q & 3); if (!(ss < tt + incl)) acc[q] = 0.f; }
                    if (prod == 0) { put_tile(TILE(11), 32 * ti, 32 * si, acc, lr, h2);
#pragma unroll
                        for (int q = 0; q < 16; ++q) { const int ss = 32 * si + 8 * (q >> 2) + 4 * h2 + (q & 3); Tacc[q] = acc[q] + (ss == tt ? 1.f : 0.f); }
                        put_tile(TILE(14), 32 * ti, 32 * si, Tacc, lr, h2);
                    } else put_tile(TILE(prod == 2 ? 8 : prod == 3 ? 9 : 10), 32 * ti, 32 * si, acc, lr, h2);
                }
            }
        }
        }
        lds_barrier();
        {
        int tl = F.tid; asm volatile("" : "+v"(tl)); const int lane = tl & 63, lr = lane & 31, h2 = lane >> 5;
        if (tl < 384) { const int q = tl >> 7, rr = (tl & 127) >> 2, cc = tl & 3;
            unsigned zz = 0u; asm volatile("" : "+v"(zz));
            *(LAS u32x4*)(TILE(q) + (q == 1 ? (32 + rr) * 144 : rr * 144 + 64) + cc * 16) = (u32x4){zz, zz, zz, zz}; }
        lds_barrier();
#pragma unroll
        for (int k = 1; k <= 5; ++k) {
            LAS unsigned char* Ss = (k & 1) ? TILE(11) : TILE(0); LAS unsigned char* STs = (k & 1) ? TILE(12) : TILE(1);
            LAS unsigned char* Sd = (k & 1) ? TILE(0) : TILE(11); LAS unsigned char* STd = (k & 1) ? TILE(1) : TILE(12);
            LAS unsigned char* Ts = (k & 1) ? TILE(14) : TILE(2); LAS unsigned char* Td = (k & 1) ? TILE(2) : TILE(14);
            if (w < 6) { const int tile = w % 3, ti = tile == 0 ? 0 : 1, si = tile == 2 ? 1 : 0;
                if (w < 3) { f32x16 acc = tileprod(Ss, 32 * ti, STs, 32 * si, zero16(), lr, h2); put_tile(STd, 32 * si, 32 * ti, acc, lr, h2); }
                else { f32x16 acc = tileprod(STs, 32 * si, Ss, 32 * ti, zero16(), lr, h2); put_tile(Sd, 32 * ti, 32 * si, acc, lr, h2); }
            } else if (k == 1) {
#pragma unroll
                for (int jj = 0; jj < 2; ++jj) { const int tile = (w - 6) * 2 + jj, ti = tile >> 1, ei = tile & 1;
                    f32x16 acc = tileprod(TILE(8), 32 * ti, TILE(4), 32 * ei, zero16(), lr, h2); put_tile(TILE(13), 32 * ei, 32 * ti, acc, lr, h2); }
            }
            lds_barrier();
            if (w < 3) { const int si = w == 2 ? 1 : 0, ti = w == 0 ? 0 : 1;
                Tacc = tileprod(STd, 32 * si, Ts, 32 * ti, Tacc, lr, h2); put_tile(Td, 32 * ti, 32 * si, Tacc, lr, h2); }
        }
        lds_barrier();
        { const int tile = w & 3, ti = tile >> 1, ci = tile & 1;
          f32x16 acc = tileprod(TILE(2), 32 * ti, w < 4 ? TILE(13) : TILE(7), 32 * ci, zero16(), lr, h2); put_tile(w < 4 ? TILE(11) : TILE(12), 32 * ci, 32 * ti, acc, lr, h2); }
        }
        lds_barrier();
        {
        int tl = F.tid; asm volatile("" : "+v"(tl)); const int lane = tl & 63, lr = lane & 31, h2 = lane >> 5; const int tj = w & 3, ta = tj >> 1, tb = tj & 1;
        if (w < 4) {
            { f32x16 acc = tileprod(TILE(12), 32 * ta, TILE(9), 32 * tb, zero16(), lr, h2);
              const int tt = 32 * tb + lr;
#pragma unroll
              for (int g = 0; g < 4; ++g) { const int dd = 32 * ta + 8 * g + 4 * h2; const u32x2 rbv = *(const LAS u32x2*)(TILE(3) + tt * 144 + dd * 2);
                  u32x2 o; o.x = pk2(acc[4 * g] + bflo(rbv.x), acc[4 * g + 1] + bfhi(rbv.x)); o.y = pk2(acc[4 * g + 2] + bflo(rbv.y), acc[4 * g + 3] + bfhi(rbv.y));
                  *(u32x2*)(RP + ((size_t)u * 64 + tt) * 64 + dd) = o; } }
            { f32x16 acc = tileprod(TILE(12), 32 * ta, TILE(5), 32 * tb, zero16(), lr, h2);
              const int dcol = 32 * tb + lr;
#pragma unroll
              for (int g = 0; g < 4; ++g) { u32x2 o; o.x = pk2(acc[4 * g], acc[4 * g + 1]); o.y = pk2(acc[4 * g + 2], acc[4 * g + 3]);
                  *(u32x2*)(REC + (size_t)u * RC_REC + ((((dcol >> 4) * 2 + ta) * 64 + (2 * (g & 1) + h2) * 16 + (dcol & 15)) * 16) + 8 * (g >> 1)) = o; } }
        } else {
            f32x16 z2 = tileprod(TILE(4), 32 * ta, TILE(10), 32 * tb, zero16(), lr, h2);
            z2 = tileprod(TILE(11), 32 * ta, TILE(9), 32 * tb, z2, lr, h2);
            float* yo = Y0T + ((size_t)u * 64 + 32 * tb + lr) * 64 + 32 * ta + 4 * h2;
#pragma unroll
            for (int g = 0; g < 4; ++g) *(f32x4*)(yo + 8 * g) = (f32x4){z2[4 * g], z2[4 * g + 1], z2[4 * g + 2], z2[4 * g + 3]};
            f32x16 acc = tileprod(TILE(5), 32 * ta, TILE(11), 32 * tb, zero16(), lr, h2);
            acc = tileprod(TILE(6), 32 * ta, TILE(4), 32 * tb, acc, lr, h2);
            const int ecol = 32 * tb + lr;
#pragma unroll
            for (int g = 0; g < 4; ++g) *(f32x4*)(REC + (size_t)u * RC_REC + 8192 + ((((ecol >> 4) * 4 + 2 * ta + (g >> 1)) * 64 + (2 * (g & 1) + h2) * 16 + (ecol & 15)) * 16)) = (f32x4){acc[4 * g], acc[4 * g + 1], acc[4 * g + 2], acc[4 * g + 3]};
        }
        }
        lds_barrier();
      }
    }
#undef TILE
}
DI void phase_rwkv_B(const Frame& F, CArgs& A) {
    if (F.bid >= 32) return;
    const unsigned char* REC = A.ws + WS_RC_G; bf16_t* HB = (bf16_t*)(A.ws + WS_RC_HB);
    constexpr int SLOT = 25600, NSLOT = 6;
    const int bh = F.bid, w = F.wave, lane = F.lane, fr = lane & 15, fq = lane >> 4;
    const unsigned char* rec0 = REC + (size_t)bh * 128 * RC_REC;
    if (w >= 4) {
        const int lw = w - 4;
#define RB_ISSUE2(cs, cr) do { const unsigned char* r_ = rec0 + (size_t)(cr) * RC_REC; LAS unsigned char* s_ = F.lds + ((cs) % NSLOT) * SLOT; \
        _Pragma("unroll") for (int k = 0; k < 6; ++k) __builtin_amdgcn_global_load_lds((const unsigned*)(r_ + (lw + 4 * k) * 1024 + lane * 16), (LAS unsigned*)(s_ + (lw + 4 * k) * 1024), 16, 0, 0); \
        if (lw == 3) __builtin_amdgcn_global_load_lds((const unsigned*)(r_ + 24576 + lane * 4), (LAS unsigned*)(s_ + 24576), 4, 0, 0); } while (0)
        RB_ISSUE2(0, 0); RB_ISSUE2(1, 1); RB_ISSUE2(2, 2); RB_ISSUE2(3, 3); RB_ISSUE2(4, 4);
        if (lw == 3) asm volatile("s_waitcnt vmcnt(28)" ::: "memory"); else asm volatile("s_waitcnt vmcnt(24)" ::: "memory");
        __builtin_amdgcn_s_barrier();
        for (int c = 0; c < 128; ++c) {
            RB_ISSUE2(c + 5, (c + 5 < 128) ? c + 5 : 127);
            if (lw == 3) asm volatile("s_waitcnt vmcnt(28)" ::: "memory"); else asm volatile("s_waitcnt vmcnt(24)" ::: "memory");
            __builtin_amdgcn_s_barrier();
        }
        asm volatile("s_waitcnt vmcnt(0)" ::: "memory");
#undef RB_ISSUE2
    } else {
        const int ew = w;
        f32x4 acc[4];
#pragma unroll
        for (int dt = 0; dt < 4; ++dt) acc[dt] = (f32x4){0.f, 0.f, 0.f, 0.f};
        __builtin_amdgcn_s_barrier();
        for (int c = 0; c < 128; ++c) {
            const size_t u = (size_t)bh * 128 + c;
            const LAS unsigned char* sl = F.lds + (c % NSLOT) * SLOT;
            bf16x8 hb[2];
#pragma unroll
            for (int sk = 0; sk < 2; ++sk) { u32x4 p; p.x = pk2(acc[2 * sk][0], acc[2 * sk][1]); p.y = pk2(acc[2 * sk][2], acc[2 * sk][3]); p.z = pk2(acc[2 * sk + 1][0], acc[2 * sk + 1][1]); p.w = pk2(acc[2 * sk + 1][2], acc[2 * sk + 1][3]);
                hb[sk] = __builtin_bit_cast(bf16x8, p); *(bf16x8*)(HB + (((u * 4 + ew) * 2 + sk) * 64 + lane) * 8) = hb[sk]; }
#pragma unroll
            for (int dt = 0; dt < 4; ++dt) {
                const f32x4 g4 = *(const LAS f32x4*)(sl + 8192 + ((ew * 4 + dt) * 64 + lane) * 16), d4 = *(const LAS f32x4*)(sl + 24576 + (16 * dt + 4 * fq) * 4);
                const bf16x8 m0 = *(const LAS bf16x8*)(sl + ((dt * 2 + 0) * 64 + lane) * 16), m1 = *(const LAS bf16x8*)(sl + ((dt * 2 + 1) * 64 + lane) * 16);
                f32x4 n = d4 * acc[dt] + g4;
                n = __builtin_amdgcn_mfma_f32_16x16x32_bf16(m0, hb[0], n, 0, 0, 0); n = __builtin_amdgcn_mfma_f32_16x16x32_bf16(m1, hb[1], n, 0, 0, 0); acc[dt] = n; }
            asm volatile("s_waitcnt lgkmcnt(0)" ::: "memory");
            __builtin_amdgcn_s_barrier();
        }
    }
}
DI void phase_rwkv_C(const Frame& F, CArgs& A, int l) {
    const bf16_t* RP = (const bf16_t*)(A.ws + WS_RC_RP); const float* Y0 = (const float*)(A.ws + WS_RC_Y0); const bf16_t* HB = (const bf16_t*)(A.ws + WS_RC_HB); const float* BSUM = (const float*)(A.ws + WS_RC_BS);
    const bf16_t* V_ = (const bf16_t*)(A.ws + WS_RW_V); const bf16_t* G_ = (const bf16_t*)(A.ws + WS_RW_G); bf16_t* MIX = (bf16_t*)(A.ws + WS_MIX);
    const float* ln_w = A.in[16] + l * 256; const float* ln_b = A.in[17] + l * 256;
    for (int job = F.gw; job < 4096; job += F.ngw) {
        int lz = F.lane; asm volatile("" : "+v"(lz)); const int lane = lz, fr = lane & 15, fq = lane >> 4;
        const size_t u = (size_t)job; const int bh = job >> 7, c = job & 127, b = bh >> 2, hd = bh & 3;
        bf16x8 hf[4][2];
#pragma unroll
        for (int et = 0; et < 4; ++et)
#pragma unroll
            for (int sk = 0; sk < 2; ++sk) hf[et][sk] = *(const bf16x8*)(HB + (((u * 4 + et) * 2 + sk) * 64 + lane) * 8);
#pragma unroll
        for (int tb = 0; tb < 4; ++tb) {
            const size_t tok = (size_t)b * SEQ + 64 * c + 16 * tb + fr;
            const bf16_t* rrow = RP + (u * 64 + 16 * tb + fr) * 64 + 4 * fq;
            bf16x8 bfr[2];
#pragma unroll
            for (int sk = 0; sk < 2; ++sk) { const u32x2 m0 = *(const u32x2*)(rrow + 32 * sk), m1 = *(const u32x2*)(rrow + 32 * sk + 16); u32x4 mw; mw.x = m0.x; mw.y = m0.y; mw.z = m1.x; mw.w = m1.y; bfr[sk] = __builtin_bit_cast(bf16x8, mw); }
            f32x4 y[4]; float sm = 0.f;
#pragma unroll
            for (int et = 0; et < 4; ++et) { y[et] = *(const f32x4*)(Y0 + (u * 64 + 16 * tb + fr) * 64 + 16 * et + 4 * fq);
                y[et] = __builtin_amdgcn_mfma_f32_16x16x32_bf16(hf[et][0], bfr[0], y[et], 0, 0, 0); y[et] = __builtin_amdgcn_mfma_f32_16x16x32_bf16(hf[et][1], bfr[1], y[et], 0, 0, 0); }
#pragma unroll
            for (int et = 0; et < 4; ++et) sm += (y[et][0] + y[et][1]) + (y[et][2] + y[et][3]);
            sm += shfl_xor_l(sm, 16, lane); sm += shfl_xor_l(sm, 32, lane); const float mean = sm * (1.f / 64.f);
            float sq = 0.f;
#pragma unroll
            for (int et = 0; et < 4; ++et) { const f32x4 d = y[et] - mean; sq += (d[0] * d[0] + d[1] * d[1]) + (d[2] * d[2] + d[3] * d[3]); }
            sq += shfl_xor_l(sq, 16, lane); sq += shfl_xor_l(sq, 32, lane); const float rstd = rsqrtf(sq * (1.f / 64.f) + 64e-5f);
            const float bs = BSUM[tok * 4 + hd];
#pragma unroll
            for (int et = 0; et < 4; ++et) { const int e0 = hd * 64 + 16 * et + 4 * fq;
                const f32x4 lw = *(const f32x4*)(ln_w + e0), lb = *(const f32x4*)(ln_b + e0);
                const u32x2 vv = *(const u32x2*)(V_ + tok * 256 + e0), gv = *(const u32x2*)(G_ + tok * 256 + e0);
                const float o0 = ((y[et][0] - mean) * rstd * lw[0] + lb[0] + bs * bflo(vv.x)) * bflo(gv.x), o1 = ((y[et][1] - mean) * rstd * lw[1] + lb[1] + bs * bfhi(vv.x)) * bfhi(gv.x);
                const float o2 = ((y[et][2] - mean) * rstd * lw[2] + lb[2] + bs * bflo(vv.y)) * bflo(gv.y), o3 = ((y[et][3] - mean) * rstd * lw[3] + lb[3] + bs * bfhi(vv.y)) * bfhi(gv.y);
                u32x2 o; o.x = pk2(o0, o1); o.y = pk2(o2, o3);
                *(u32x2*)(MIX + tok * DM + e0) = o; }
        }
    }
}

template <int PASS>
DI void phase_s5(const Frame& F, CArgs& A, int l) {
    const bf16_t* Z = (const bf16_t*)(A.ws + WS_Z); float* SEND = (float*)(A.ws + WS_S5END); bf16_t* YS = (bf16_t*)(A.ws + WS_YS5);
    const bf16_t* BBt = (const bf16_t*)(A.ws + WS_S5BB); const bf16_t* CCt = (const bf16_t*)(A.ws + WS_S5CC);
    LAS unsigned char* himg = F.lds + F.wave * 17408;
    for (int it = F.gw; it < 8 * 16 * 16; it += F.ngw) {
        int lz = F.lane; asm volatile("" : "+v"(lz)); const int lane = lz, lr = lane & 31, hh = lane >> 5;
        const int b = it >> 8, g = (it >> 4) & 15, seg = it & 15, lg = l * 16 + g;
        const float dt = __expf(A.in[25][lg]);
        float are[2], aim[2], cr[2], ci[2];
        bf16x8 bbf[2][2];
#pragma unroll
        for (int st = 0; st < 2; ++st) { const int p = 32 * st + lr;
            const float lre = A.in[18][lg * 64 + p], lim = A.in[19][lg * 64 + p]; const float mag = expf(lre * dt); float sn, cn; sincosf(lim * dt, &sn, &cn); are[st] = mag * cn; aim[st] = mag * sn;
            cr[st] = 0.f; ci[st] = 0.f;
            if (PASS == 2) { const float m512 = expf(512.f * lre * dt); float s5, c5; sincosf(512.f * (lim * dt), &s5, &c5); const float pr = m512 * c5, pi_ = m512 * s5;
                for (int j = 0; j < seg; ++j) { const float* e = SEND + ((size_t)((b * 16 + g) * 16 + j)) * 128; const float er = e[p], ei = e[64 + p];
                    const float nr = pr * cr[st] - pi_ * ci[st] + er, ni = pr * ci[st] + pi_ * cr[st] + ei; cr[st] = nr; ci[st] = ni; } }
#pragma unroll
            for (int part = 0; part < 2; ++part) bbf[part][st] = *(const bf16x8*)(BBt + (((size_t)lg * 2 + part) * 64 + p) * 16 + 8 * hh); }
        bf16x8 ccf[4];
        if (PASS == 2) {
#pragma unroll
            for (int ks = 0; ks < 4; ++ks) ccf[ks] = *(const bf16x8*)(CCt + ((size_t)lg * 16 + (lane & 15)) * 128 + 32 * ks + 8 * (lane >> 4)); }
        for (int ch = 0; ch < 8; ++ch) {
            const size_t tok0 = (size_t)b * SEQ + seg * 512 + ch * 64;
#pragma unroll
            for (int tk = 0; tk < 2; ++tk) {
                const bf16x8 uf = *(const bf16x8*)(Z + (tok0 + 32 * tk + lr) * ZS + ZC_S5 + g * 16 + 8 * hh);
                f32x16 xr[2], xi[2];
#pragma unroll
                for (int st = 0; st < 2; ++st) { xr[st] = mfma32(uf, bbf[0][st], zero16()); xi[st] = mfma32(uf, bbf[1][st], zero16()); }
                asm volatile("s_nop 15\n\ts_nop 15" : "+v"(xr[0]), "+v"(xi[0]), "+v"(xr[1]), "+v"(xi[1]));
#pragma unroll
                for (int j = 0; j < 4; ++j) {
#pragma unroll
                    for (int half = 0; half < 2; ++half) {
                        const bool act = (hh == half);
#pragma unroll
                        for (int st = 0; st < 2; ++st) { float tr = cr[st], ti = ci[st];
#pragma unroll
                            for (int q = 0; q < 4; ++q) { const float nr = are[st] * tr - aim[st] * ti + xr[st][4 * j + q], ni = are[st] * ti + aim[st] * tr + xi[st][4 * j + q];
                                tr = nr; ti = ni; xr[st][4 * j + q] = act ? nr : xr[st][4 * j + q]; xi[st][4 * j + q] = act ? ni : xi[st][4 * j + q]; }
                            const float pr = shfl_xor_l(tr, 32, lane), pi2 = shfl_xor_l(ti, 32, lane);
                            cr[st] = act ? tr : pr; ci[st] = act ? ti : pi2; }
                    }
                }
                if (PASS == 2) {
                    unsigned hb = (unsigned)(uintptr_t)(himg + (4 * hh) * 272 + lr * 2); asm volatile("" : "+v"(hb));
                    LAS unsigned char* hp = (LAS unsigned char*)(uintptr_t)hb;
#pragma unroll
                    for (int st = 0; st < 2; ++st)
#pragma unroll
                        for (int q = 0; q < 16; ++q) { const int trow = 32 * tk + 8 * (q >> 2) + (q & 3);
                            *(LAS bf16_t*)(hp + trow * 272 + 64 * st) = (bf16_t)f2bf(xr[st][q]); *(LAS bf16_t*)(hp + trow * 272 + 128 + 64 * st) = (bf16_t)f2bf(xi[st][q]); }
                }
            }
            if (PASS == 2) {
                asm volatile("s_waitcnt lgkmcnt(0)" ::: "memory");
                const int fr = lane & 15, fq = lane >> 4;
                unsigned rb = (unsigned)(uintptr_t)(himg + fr * 272 + fq * 16); asm volatile("" : "+v"(rb)); const LAS unsigned char* rp = (const LAS unsigned char*)(uintptr_t)rb;
#pragma unroll
                for (int m = 0; m < 4; ++m) { f32x4 acc = {0.f, 0.f, 0.f, 0.f};
#pragma unroll
                    for (int ks = 0; ks < 4; ++ks) acc = __builtin_amdgcn_mfma_f32_16x16x32_bf16(ccf[ks], *(const LAS bf16x8*)(rp + (16 * m) * 272 + 64 * ks), acc, 0, 0, 0);
                    const size_t tok = tok0 + 16 * m + fr;
                    const u32x2 uu = *(const u32x2*)(Z + tok * ZS + ZC_S5 + g * 16 + 4 * fq);
                    const f32x4 dd = *(const f32x4*)(A.in[24] + l * 256 + g * 16 + 4 * fq);
                    u32x2 o; o.x = pk2(gelu_tanh(acc[0] + dd[0] * bflo(uu.x)), gelu_tanh(acc[1] + dd[1] * bfhi(uu.x))); o.y = pk2(gelu_tanh(acc[2] + dd[2] * bflo(uu.y)), gelu_tanh(acc[3] + dd[3] * bfhi(uu.y)));
                    *(u32x2*)(YS + tok * 256 + g * 16 + 4 * fq) = o; }
                asm volatile("s_waitcnt lgkmcnt(0)" ::: "memory");
            }
        }
        if (PASS == 1 && hh == 1) {
#pragma unroll
            for (int st = 0; st < 2; ++st) { float* e = SEND + ((size_t)((b * 16 + g) * 16 + seg)) * 128; e[32 * st + lr] = cr[st]; e[64 + 32 * st + lr] = ci[st]; } }
    }
}

DI void phase_lru_prep(const Frame& F, CArgs& A, int l) {
    const bf16_t* Z = (const bf16_t*)(A.ws + WS_Z); float* LA = (float*)(A.ws + WS_LA); float* LB = (float*)(A.ws + WS_LB);
    const float* cw = A.in[34] + l * 4 * 256; const float* cb = A.in[35] + l * 256; const float* ba = A.in[37] + l * 256; const float* bx = A.in[39] + l * 256; const float* lam = A.in[40] + l * 256;
    const bf16_t* WL = (const bf16_t*)(A.ws + WS_WLRU) + (size_t)l * 2 * 4 * 4096;
    LAS float* xs = (LAS float*)F.lds;
    const int w = F.wave, n = w >> 1, hf = w & 1;
    bf16x8 waf[2][2], wxf[2][2];
    { const int fr = F.lane & 15, fq = F.lane >> 4;
#pragma unroll
      for (int nf = 0; nf < 2; ++nf)
#pragma unroll
          for (int ks = 0; ks < 2; ++ks) { const int j = 32 * hf + 16 * nf + fr;
              waf[nf][ks] = *(const bf16x8*)(WL + ((size_t)(0 * 4 + n) * 64 + j) * 64 + 32 * ks + 8 * fq); wxf[nf][ks] = *(const bf16x8*)(WL + ((size_t)(1 * 4 + n) * 64 + j) * 64 + 32 * ks + 8 * fq); } }
    f32x4 c_ba[2], c_bx[2], c_sp[2];
    { const int fq0 = F.lane >> 4;
#pragma unroll
      for (int nf = 0; nf < 2; ++nf) { const int ch4 = n * 64 + 32 * hf + 16 * nf + 4 * fq0; c_ba[nf] = *(const f32x4*)(ba + ch4); c_bx[nf] = *(const f32x4*)(bx + ch4); const f32x4 lm = *(const f32x4*)(lam + ch4);
#pragma unroll
          for (int i = 0; i < 4; ++i) c_sp[nf][i] = -8.f * softplusf_(-lm[i]); } }
    for (int tile = F.bid; tile < T / 64; tile += F.G) {
        int tz = F.tid; asm volatile("" : "+v"(tz)); const int lane = tz & 63, fr = lane & 15, fq = lane >> 4;
        const int t0 = tile * 64, s0 = t0 % SEQ;
        f32x4 accA[4][2], accX[4][2];
#pragma unroll
        for (int m = 0; m < 4; ++m) {
            const int tok = 16 * m + fr, sq = s0 + tok;
            bf16x8 xf[2];
#pragma unroll
            for (int ks = 0; ks < 2; ++ks) { const int ch0 = n * 64 + 32 * ks + 8 * fq;
                const f32x4 b0 = *(const f32x4*)(cb + ch0), b1 = *(const f32x4*)(cb + ch0 + 4);
                float xc[8] = {b0[0], b0[1], b0[2], b0[3], b1[0], b1[1], b1[2], b1[3]};
#pragma unroll
                for (int j = 0; j < 4; ++j) if (sq - 3 + j >= 0) {
                    const u32x4 z8 = *(const u32x4*)(Z + (size_t)(t0 + tok - 3 + j) * ZS + ZC_LX + ch0);
                    const f32x4 c0 = *(const f32x4*)(cw + j * 256 + ch0), c1 = *(const f32x4*)(cw + j * 256 + ch0 + 4);
                    xc[0] += c0[0] * bflo(z8.x); xc[1] += c0[1] * bfhi(z8.x); xc[2] += c0[2] * bflo(z8.y); xc[3] += c0[3] * bfhi(z8.y);
                    xc[4] += c1[0] * bflo(z8.z); xc[5] += c1[1] * bfhi(z8.z); xc[6] += c1[2] * bflo(z8.w); xc[7] += c1[3] * bfhi(z8.w); }
                u32x4 o; o.x = pk2(xc[0], xc[1]); o.y = pk2(xc[2], xc[3]); o.z = pk2(xc[4], xc[5]); o.w = pk2(xc[6], xc[7]); xf[ks] = __builtin_bit_cast(bf16x8, o);
                if (hf == 0) { *(LAS f32x4*)(xs + tok * 260 + ch0) = (f32x4){xc[0], xc[1], xc[2], xc[3]}; *(LAS f32x4*)(xs + tok * 260 + ch0 + 4) = (f32x4){xc[4], xc[5], xc[6], xc[7]}; }
            }
#pragma unroll
            for (int nf = 0; nf < 2; ++nf) { const f32x4 z4 = {0.f, 0.f, 0.f, 0.f};
                accA[m][nf] = __builtin_amdgcn_mfma_f32_16x16x32_bf16(waf[nf][0], xf[0], z4, 0, 0, 0); accA[m][nf] = __builtin_amdgcn_mfma_f32_16x16x32_bf16(waf[nf][1], xf[1], accA[m][nf], 0, 0, 0);
                accX[m][nf] = __builtin_amdgcn_mfma_f32_16x16x32_bf16(wxf[nf][0], xf[0], z4, 0, 0, 0); accX[m][nf] = __builtin_amdgcn_mfma_f32_16x16x32_bf16(wxf[nf][1], xf[1], accX[m][nf], 0, 0, 0); }
        }
        lds_barrier();
#pragma unroll
        for (int m = 0; m < 4; ++m)
#pragma unroll
            for (int nf = 0; nf < 2; ++nf) { const int tok = 16 * m + fr, ch4 = n * 64 + 32 * hf + 16 * nf + 4 * fq;
                const f32x4 xc = *(const LAS f32x4*)(xs + tok * 260 + ch4);
                f32x4 av, bv;
#pragma unroll
                for (int i = 0; i < 4; ++i) { const float r = sigmoidf_(accA[m][nf][i] + c_ba[nf][i]), ig = sigmoidf_(accX[m][nf][i] + c_bx[nf][i]); const float log_a = r * c_sp[nf][i];
                    const float x2 = 2.f * log_a; float em1 = __expf(x2) - 1.f; if (x2 > -0.25f) em1 = x2 * (1.f + x2 * (0.5f + x2 * (0.16666667f + x2 * (0.041666668f + x2 * 0.008333334f))));
                    av[i] = __expf(log_a); bv[i] = __builtin_amdgcn_sqrtf(-em1) * (ig * xc[i]); }
                *(f32x4*)(LA + (size_t)(t0 + tok) * 256 + ch4) = av; *(f32x4*)(LB + (size_t)(t0 + tok) * 256 + ch4) = bv; }
        lds_barrier();
    }
}
DI void phase_lru_sum(const Frame& F, CArgs& A) {
    const float* LA = (const float*)(A.ws + WS_LA); const float* LB = (const float*)(A.ws + WS_LB); float* LS = (float*)(A.ws + WS_LSUM);
    for (int it = F.gw; it < 8 * 128; it += F.ngw) {
        const size_t r0 = (size_t)it * 64;
        f32x4 Ap = {1.f, 1.f, 1.f, 1.f}, Bp = {0.f, 0.f, 0.f, 0.f};
#pragma unroll 8
        for (int t = 0; t < 64; ++t) { const f32x4 a = *(const f32x4*)(LA + (r0 + t) * 256 + 4 * F.lane), bb = *(const f32x4*)(LB + (r0 + t) * 256 + 4 * F.lane); Bp = a * Bp + bb; Ap = Ap * a; }
        *(f32x4*)(LS + ((size_t)it * 2) * 256 + 4 * F.lane) = Ap; *(f32x4*)(LS + ((size_t)it * 2 + 1) * 256 + 4 * F.lane) = Bp;
    }
}
DI void phase_lru_fin(const Frame& F, CArgs& A, int l) {
    const float* LA = (const float*)(A.ws + WS_LA); const float* LB = (const float*)(A.ws + WS_LB); const float* LS = (const float*)(A.ws + WS_LSUM);
    const bf16_t* Z = (const bf16_t*)(A.ws + WS_Z); bf16_t* MIX = (bf16_t*)(A.ws + WS_MIX);
    const f32x4 bg = *(const f32x4*)(A.in[41] + l * 768 + 512 + 4 * F.lane);
    for (int it = F.gw; it < 8 * 128; it += F.ngw) {
        const int b = it >> 7, c = it & 127;
        f32x4 h = {0.f, 0.f, 0.f, 0.f};
        for (int j0 = 0; j0 < c; j0 += 8) {
            f32x4 sa[8], sb[8];
#pragma unroll
            for (int q = 0; q < 8; ++q) { const int j = (j0 + q < c) ? j0 + q : c - 1; sa[q] = *(const f32x4*)(LS + ((size_t)(b * 128 + j) * 2) * 256 + 4 * F.lane); sb[q] = *(const f32x4*)(LS + ((size_t)(b * 128 + j) * 2 + 1) * 256 + 4 * F.lane); }
#pragma unroll
            for (int q = 0; q < 8; ++q) if (j0 + q < c) h = sa[q] * h + sb[q]; }
        const size_t r0 = (size_t)it * 64;
        for (int t0 = 0; t0 < 64; t0 += 8) {
            f32x4 y[8]; float ss[8];
#pragma unroll
            for (int q = 0; q < 8; ++q) { const size_t r = r0 + t0 + q;
                const f32x4 a = *(const f32x4*)(LA + r * 256 + 4 * F.lane), bb = *(const f32x4*)(LB + r * 256 + 4 * F.lane); h = a * h + bb;
                const u32x2 gz = *(const u32x2*)(Z + r * ZS + ZC_LG + 4 * F.lane);
                y[q] = (f32x4){h[0] * gelu_tanh(bflo(gz.x)), h[1] * gelu_tanh(bfhi(gz.x)), h[2] * gelu_tanh(bflo(gz.y)), h[3] * gelu_tanh(bfhi(gz.y))};
                ss[q] = y[q][0] * y[q][0] + y[q][1] * y[q][1] + y[q][2] * y[q][2] + y[q][3] * y[q][3]; }
            const int ln = lane_opaque();
#pragma unroll
            for (int o = 1; o < 64; o <<= 1) {
#pragma unroll
                for (int q = 0; q < 8; ++q) ss[q] += shfl_xor_l(ss[q], o, ln); }
#pragma unroll
            for (int q = 0; q < 8; ++q) { const float r = rsqrtf(ss[q] * (1.f / 256.f) + NORM_EPS);
                u32x2 o; o.x = pk2(y[q][0] * r * bg[0], y[q][1] * r * bg[1]); o.y = pk2(y[q][2] * r * bg[2], y[q][3] * r * bg[3]);
                *(u32x2*)(MIX + (r0 + t0 + q) * DM + 768 + 4 * F.lane) = o; }
        }
    }
}

DI void phase_branch_norm(const Frame& F, CArgs& A, int l) {
    const bf16_t* S0 = (const bf16_t*)(A.ws + WS_YS5G); const bf16_t* S1 = (const bf16_t*)(A.ws + WS_ATTO);
    bf16_t* MIX = (bf16_t*)(A.ws + WS_MIX); const float* bg = A.in[41] + l * 768;
    for (int row0 = 4 * F.gw; row0 < T; row0 += 4 * F.ngw) {
        u32x2 v[4][2];
#pragma unroll
        for (int r = 0; r < 4; ++r) { v[r][0] = *(const u32x2*)(S0 + (size_t)(row0 + r) * 256 + 4 * F.lane); v[r][1] = *(const u32x2*)(S1 + (size_t)(row0 + r) * 256 + 4 * F.lane); }
#pragma unroll
        for (int r = 0; r < 4; ++r)
#pragma unroll
            for (int br = 0; br < 2; ++br) {
                const float x0 = bflo(v[r][br].x), x1 = bfhi(v[r][br].x), x2 = bflo(v[r][br].y), x3 = bfhi(v[r][br].y);
                const float rs = rsqrtf(wave_sum(x0 * x0 + x1 * x1 + x2 * x2 + x3 * x3) * (1.f / 256.f) + NORM_EPS);
                const f32x4 g = *(const f32x4*)(bg + br * 256 + 4 * F.lane);
                u32x2 o; o.x = pk2(x0 * rs * g[0], x1 * rs * g[1]); o.y = pk2(x2 * rs * g[2], x3 * rs * g[3]);
                *(u32x2*)(MIX + (size_t)(row0 + r) * DM + 256 * (br + 1) + 4 * F.lane) = o; }
    }
}

DI void phase_norm2_router(const Frame& F, CArgs& A, int l) {
    const float* MODL = (const float*)(A.ws + WS_MOD) + (size_t)l * 8 * 6144;
    const float* g = A.in[43] + l * 1024;
    bf16_t* H = (bf16_t*)(A.ws + WS_H);
    int* EID = (int*)(A.ws + WS_RT_EID); float* GATE = (float*)(A.ws + WS_RT_GATE); int* PIE = (int*)(A.ws + WS_RT_PIE);
    unsigned* CNT = (unsigned*)(A.ws + WS_CTL) + CW_CNT + l * 64;
    const bf16_t* WRh = (const bf16_t*)(A.ws + WS_WR) + (size_t)(l * 2) * 48 * 1024; const bf16_t* WRl = WRh + 48 * 1024;
    const float* ROWSS = (const float*)(A.ws + WS_ROWSS);
    LAS float* part = (LAS float*)F.lds;
    LAS float* red = part + 8 * 64 * 48;
    LAS float* lsum = red + 8 * 64;
    LAS unsigned* lcnt = (LAS unsigned*)(lsum + 64 * 36);
    LAS int* lsel = (LAS int*)(lcnt + 64);
    const float* bgp = A.in[45] + l * 4; const float* bep = A.in[47] + l * 32;
    const int w = F.wave, k0 = 128 * w;
    bf16x8 bh[3][4], bl[3][4];
    { const int fr = F.lane & 15, fq = F.lane >> 4;
#pragma unroll
      for (int n = 0; n < 3; ++n)
#pragma unroll
          for (int ks = 0; ks < 4; ++ks) { bh[n][ks] = *(const bf16x8*)(WRh + (size_t)(16 * n + fr) * 1024 + k0 + 32 * ks + 8 * fq); bl[n][ks] = *(const bf16x8*)(WRl + (size_t)(16 * n + fr) * 1024 + k0 + 32 * ks + 8 * fq); } }
    for (int tile = F.bid; tile < T / 64; tile += F.G) {
        int tz = F.tid; asm volatile("" : "+v"(tz)); const int lane = tz & 63, fr = lane & 15, fq = lane >> 4;
        const int row0 = tile * 64, b = row0 / SEQ;
        const float* xb = A.out + (size_t)(row0 + fr) * DM + k0 + 8 * fq;
        if (tz < 32) lcnt[tz] = 0u;
        f32x4 acc[4][3];
#pragma unroll
        for (int m = 0; m < 4; ++m) { const float* rp = ROWSS + (size_t)(row0 + 16 * m + fr) * 16;
            const f32x4 p0 = *(const f32x4*)rp, p1 = *(const f32x4*)(rp + 4), p2 = *(const f32x4*)(rp + 8), p3 = *(const f32x4*)(rp + 12);
            const float tot = (((p0[0] + p0[1]) + (p0[2] + p0[3])) + ((p1[0] + p1[1]) + (p1[2] + p1[3]))) + (((p2[0] + p2[1]) + (p2[2] + p2[3])) + ((p3[0] + p3[1]) + (p3[2] + p3[3])));
            const float rstd = rsqrtf(tot * (1.f / DM) + NORM_EPS);
#pragma unroll
            for (int n = 0; n < 3; ++n) acc[m][n] = (f32x4){0.f, 0.f, 0.f, 0.f};
#pragma unroll
            for (int ks = 0; ks < 4; ++ks) { const int kc = k0 + 32 * ks + 8 * fq;
                const f32x4 x0 = *(const f32x4*)(xb + (size_t)(16 * m) * DM + 32 * ks), x1 = *(const f32x4*)(xb + (size_t)(16 * m) * DM + 32 * ks + 4);
                const f32x4 g0 = *(const f32x4*)(g + kc), g1 = *(const f32x4*)(g + kc + 4);
                const f32x4 s0 = *(const f32x4*)(MODL + (size_t)b * 6144 + 4096 + kc), s1 = *(const f32x4*)(MODL + (size_t)b * 6144 + 4096 + kc + 4);
                const f32x4 h0 = *(const f32x4*)(MODL + (size_t)b * 6144 + 3072 + kc), h1 = *(const f32x4*)(MODL + (size_t)b * 6144 + 3072 + kc + 4);
                const f32x4 v0 = x0 * rstd * g0 * (s0 + 1.f) + h0, v1 = x1 * rstd * g1 * (s1 + 1.f) + h1;
                u32x4 hi; hi.x = pk2(v0[0], v0[1]); hi.y = pk2(v0[2], v0[3]); hi.z = pk2(v1[0], v1[1]); hi.w = pk2(v1[2], v1[3]);
                u32x4 lo; lo.x = pk2(v0[0] - bflo(hi.x), v0[1] - bfhi(hi.x)); lo.y = pk2(v0[2] - bflo(hi.y), v0[3] - bfhi(hi.y)); lo.z = pk2(v1[0] - bflo(hi.z), v1[1] - bfhi(hi.z)); lo.w = pk2(v1[2] - bflo(hi.w), v1[3] - bfhi(hi.w));
                *(u32x4*)(H + (size_t)(row0 + 16 * m + fr) * DM + kc) = hi;
                const bf16x8 ah = __builtin_bit_cast(bf16x8, hi), al = __builtin_bit_cast(bf16x8, lo);
#pragma unroll
                for (int n = 0; n < 3; ++n) { acc[m][n] = __builtin_amdgcn_mfma_f32_16x16x32_bf16(ah, bh[n][ks], acc[m][n], 0, 0, 0);
                    acc[m][n] = __builtin_amdgcn_mfma_f32_16x16x32_bf16(al, bh[n][ks], acc[m][n], 0, 0, 0); acc[m][n] = __builtin_amdgcn_mfma_f32_16x16x32_bf16(ah, bl[n][ks], acc[m][n], 0, 0, 0); } }
#pragma unroll
            for (int n = 0; n < 3; ++n)
#pragma unroll
                for (int j = 0; j < 4; ++j) part[(w * 64 + 16 * m + 4 * fq + j) * 48 + 16 * n + fr] = acc[m][n][j];
        }
        lds_barrier();
        for (int i = tz; i < 64 * 36; i += NTHR) { const int tok = i / 36, n = i % 36; float a = 0.f;
#pragma unroll
            for (int ww = 0; ww < 8; ++ww) a += part[(ww * 64 + tok) * 48 + n];
            lsum[i] = a; }
        lds_barrier();
        float g0 = 0.f, g1 = 0.f; int e0 = 0, e1 = 0; unsigned r0 = 0, r1 = 0;
        if (tz < 64) {
            const LAS float* L = lsum + tz * 36;
            int gs = 0; float gm = L[0] + bgp[0];
#pragma unroll
            for (int i = 1; i < 4; ++i) { const float v = L[i] + bgp[i]; if (v > gm) { gm = v; gs = i; } }
            float gden = 0.f;
#pragma unroll
            for (int i = 0; i < 4; ++i) gden += expf(L[i] + bgp[i] - gm);
            const float gprob = 1.f / gden;
            int i1 = 0; float v1 = L[4 + gs * 8] + bep[gs * 8];
#pragma unroll
            for (int j = 1; j < 8; ++j) { const float v = L[4 + gs * 8 + j] + bep[gs * 8 + j]; if (v > v1) { v1 = v; i1 = j; } }
            int i2 = -1; float v2 = -INFINITY;
#pragma unroll
            for (int j = 0; j < 8; ++j) { const float v = L[4 + gs * 8 + j] + bep[gs * 8 + j]; if (j != i1 && v > v2) { v2 = v; i2 = j; } }
            const float p2 = expf(v2 - v1);
            g0 = gprob / (1.f + p2); g1 = gprob * p2 / (1.f + p2); e0 = gs * 8 + i1; e1 = gs * 8 + i2;
            r0 = __hip_atomic_fetch_add(lcnt + e0, 1u, __ATOMIC_RELAXED, __HIP_MEMORY_SCOPE_WORKGROUP); r1 = __hip_atomic_fetch_add(lcnt + e1, 1u, __ATOMIC_RELAXED, __HIP_MEMORY_SCOPE_WORKGROUP);
        }
        lds_barrier();
        if (tz < 32) { const unsigned c = lcnt[tz]; lcnt[32 + tz] = c ? atomicAdd(CNT + tz, c) : 0u; }
        lds_barrier();
        if (tz < 64) { const int row = row0 + tz;
            EID[2 * row] = e0; EID[2 * row + 1] = e1; GATE[2 * row] = g0; GATE[2 * row + 1] = g1; PIE[2 * row] = (int)(lcnt[32 + e0] + r0); PIE[2 * row + 1] = (int)(lcnt[32 + e1] + r1); }
        lds_barrier();
    }
    __syncthreads();
    LAS float* scr = (LAS float*)(F.lds + F.wave * 16640);
    bf16_t* WM1 = (bf16_t*)(A.ws + WS_WM1); bf16_t* WM2 = (bf16_t*)(A.ws + WS_WM2);
    for (int it = F.gw; it < 32 * 384; it += F.ngw) {
        const int e = it / 384; int r = it % 384;
        if (r < 256) { const int which = r >> 7; r &= 127; const int kb = r >> 3, nb = r & 7, n0 = 64 * nb;
            const float* src = (which ? A.in[49] : A.in[48]) + ((size_t)l * 32 + e) * 1024 * 512;
            transpose_item64(src, 512, 64 * kb, n0, WM1 + (size_t)e * 1024 * 1024, 1024, 256 * (n0 >> 7) + (n0 & 127) + 128 * which, 64 * kb, scr, F.lane);
        } else { r -= 256; const int kb = r >> 4, nb = r & 15;
            transpose_item64(A.in[50] + ((size_t)l * 32 + e) * 512 * 1024, 1024, 64 * kb, 64 * nb, WM2 + (size_t)e * 1024 * 512, 512, 64 * nb, 64 * kb, scr, F.lane); }
    }
}

DI void phase_moe_scatter(const Frame& F, CArgs& A, int l) {
    const unsigned* CNT = (const unsigned*)(A.ws + WS_CTL) + CW_CNT + l * 64;
    unsigned* META = (unsigned*)(A.ws + WS_CTL) + CW_UTAB + l * 1024;
    const int* EID = (const int*)(A.ws + WS_RT_EID); const int* PIE = (const int*)(A.ws + WS_RT_PIE); int* SORT = (int*)(A.ws + WS_RT_SORT);
    LAS unsigned* st = (LAS unsigned*)F.lds;
    if (F.tid == 0) { unsigned s = 0; for (int e = 0; e < 32; ++e) { st[e] = s; s += CNT[e]; } }
    __syncthreads();
    if (F.bid == 0 && F.tid == 0) { unsigned nu = 0;
        for (int e = 0; e < 32; ++e) { const unsigned c = CNT[e]; META[1 + e] = st[e]; META[33 + e] = c; for (unsigned bk = 0; bk * 256 < c; ++bk) META[65 + nu++] = ((unsigned)e << 16) | bk; }
        META[0] = nu; }
    for (int a = F.bid * NTHR + F.tid; a < 2 * T; a += F.G * NTHR) SORT[st[EID[a]] + PIE[a]] = a;
}

struct MoeProb1 {
    const char* Hh; const char* WM1; const unsigned* META; const int* SORT; int lda, ldb, nt, G, c;
    DI bool next(int i, pg8::Unit& u) const { const int idx = i * G + c; const int nu = (int)META[0]; if (idx >= nu * 4) return false;
        const unsigned ent = META[65 + (idx >> 2)]; u.pm = idx >> 2; u.pn = idx & 3; u.e = (int)(ent >> 16); u.blk = (int)(ent & 0xffffu); return true; }
    DI const char* a_base(const pg8::Unit&) const { return Hh; }
    DI const char* b_base(const pg8::Unit& u) const { return WM1 + ((size_t)u.e * 1024 + (size_t)u.pn * 256) * 1024 * 2; }
    DI unsigned a_off(const pg8::Unit& u, int row) const { const unsigned r = (unsigned)(u.blk * 256 + row), cnt = META[33 + u.e];
        const int a = r < cnt ? SORT[META[1 + u.e] + r] : 0; return (unsigned)(a >> 1) * 2048u; }
};
struct EpiMoe1 {
    static constexpr bool PERM = true;
    bf16_t* HID; const unsigned* META;
    DI void operator()(const f32x4 (&acc)[2][2][4][2], const pg8::Unit& u, int wr, int wc, int fr, int fq) const {
        const unsigned cnt = META[33 + u.e], st = META[1 + u.e];
        const int col0 = 128 * u.pn + wc * 32 + 8 * fq;
#pragma unroll
        for (int ai = 0; ai < 2; ++ai)
#pragma unroll
            for (int m = 0; m < 4; ++m) { const unsigned r = (unsigned)(u.blk * 256 + ai * 128 + wr * 64 + m * 16 + fr);
                if (r < cnt) { const f32x4 a0 = acc[ai][0][m][0], a1 = acc[ai][0][m][1], b0 = acc[ai][1][m][0], b1 = acc[ai][1][m][1];
                    u32x4 w; w.x = pk2(siluf_(a0[0]) * b0[0], siluf_(a0[1]) * b0[1]); w.y = pk2(siluf_(a0[2]) * b0[2], siluf_(a0[3]) * b0[3]);
                    w.z = pk2(siluf_(a1[0]) * b1[0], siluf_(a1[1]) * b1[1]); w.w = pk2(siluf_(a1[2]) * b1[2], siluf_(a1[3]) * b1[3]);
                    *(u32x4*)(HID + (size_t)(st + r) * 512 + col0) = w; } }
    }
};
struct MoeProb2 {
    const char* HID; const char* WM2; const unsigned* META; int lda, ldb, nt, G, c;
    DI bool next(int i, pg8::Unit& u) const { const int idx = i * G + c; const int nu = (int)META[0]; if (idx >= nu * 4) return false;
        const unsigned ent = META[65 + (idx >> 2)]; u.pm = idx >> 2; u.pn = idx & 3; u.e = (int)(ent >> 16); u.blk = (int)(ent & 0xffffu); return true; }
    DI const char* a_base(const pg8::Unit& u) const { return HID + ((size_t)META[1 + u.e] + (size_t)u.blk * 256) * 512 * 2; }
    DI const char* b_base(const pg8::Unit& u) const { return WM2 + ((size_t)u.e * 1024 + (size_t)u.pn * 256) * 512 * 2; }
    DI unsigned a_off(const pg8::Unit&, int row) const { return (unsigned)row * 1024u; }
};
struct EpiMoe2 {
    static constexpr bool PERM = true;
    bf16_t* Y; const unsigned* META; const int* SORT; const float* GATE; const float* gt;
    DI void operator()(const f32x4 (&acc)[2][2][4][2], const pg8::Unit& u, int wr, int wc, int fr, int fq) const {
        const unsigned cnt = META[33 + u.e], st = META[1 + u.e];
        const int col0 = 256 * u.pn + wc * 32 + 8 * fq;
        int av[2][4]; float gw[2][4];
#pragma unroll
        for (int ai = 0; ai < 2; ++ai)
#pragma unroll
            for (int m = 0; m < 4; ++m) { const unsigned r = (unsigned)(u.blk * 256 + ai * 128 + wr * 64 + m * 16 + fr); av[ai][m] = r < cnt ? SORT[st + r] : -1; }
#pragma unroll
        for (int ai = 0; ai < 2; ++ai)
#pragma unroll
            for (int m = 0; m < 4; ++m) gw[ai][m] = av[ai][m] >= 0 ? GATE[av[ai][m]] : 0.f;
#pragma unroll
        for (int ai = 0; ai < 2; ++ai)
#pragma unroll
            for (int m = 0; m < 4; ++m) { const int a = av[ai][m];
                if (a >= 0) { const int b = (a >> 1) / SEQ; const float g = gw[ai][m];
#pragma unroll
                    for (int bj = 0; bj < 2; ++bj) { const f32x4 g0 = *(const f32x4*)(gt + (size_t)b * 6144 + col0 + bj * 128), g1 = *(const f32x4*)(gt + (size_t)b * 6144 + col0 + bj * 128 + 4);
                        const f32x4 v0 = acc[ai][bj][m][0] * g0 * g, v1 = acc[ai][bj][m][1] * g1 * g;
                        u32x4 w; w.x = pk2(v0[0], v0[1]); w.y = pk2(v0[2], v0[3]); w.z = pk2(v1[0], v1[1]); w.w = pk2(v1[2], v1[3]);
                        *(u32x4*)(Y + (size_t)a * DM + col0 + bj * 128) = w; } } }
    }
};

DI void phase_final(const Frame& F, CArgs& A) {
    const bf16_t* Y = (const bf16_t*)(A.ws + WS_Y);
    const size_t N4 = (size_t)T * DM / 4, stride = (size_t)F.G * NTHR;
    for (size_t i0 = (size_t)F.bid * NTHR + F.tid; i0 < N4; i0 += 4 * stride) {
        f32x4 v[4]; u32x2 y0[4], y1[4];
#pragma unroll
        for (int k = 0; k < 4; ++k) { const size_t i = i0 + k * stride; if (i < N4) { const size_t row = i >> 8, col = (i & 255) * 4;
            v[k] = *(const f32x4*)(A.out + row * DM + col); y0[k] = *(const u32x2*)(Y + (2 * row) * DM + col); y1[k] = *(const u32x2*)(Y + (2 * row + 1) * DM + col); } }
#pragma unroll
        for (int k = 0; k < 4; ++k) { const size_t i = i0 + k * stride; if (i < N4) { const size_t row = i >> 8, col = (i & 255) * 4;
            v[k][0] += bflo(y0[k].x) + bflo(y1[k].x); v[k][1] += bfhi(y0[k].x) + bfhi(y1[k].x); v[k][2] += bflo(y0[k].y) + bflo(y1[k].y); v[k][3] += bfhi(y0[k].y) + bfhi(y1[k].y);
            *(f32x4*)(A.out + row * DM + col) = v[k]; } }
    }
}

#ifndef REPMASK
#define REPMASK 0u
#endif
constexpr int NPL = 14, NPH = 1 + 2 * NPL + 1;
__global__ void __launch_bounds__(NTHR, 2) mk_fwd(Args args) {
    extern __shared__ __attribute__((aligned(16))) unsigned char lds_raw[];
    LAS unsigned char* const ldsb = (LAS unsigned char*)lds_raw;
    const int wave0 = __builtin_amdgcn_readfirstlane(threadIdx.x >> 6);
    volatile LAS unsigned* MISC = (volatile LAS unsigned*)(ldsb + MISC_OFF);
    if (threadIdx.x < 64) MISC[threadIdx.x] = 0u;
    __syncthreads();
    XcdBarrier bar; bar.bar = (unsigned*)(args.ws + WS_CTL) + CW_BAR; bar.x = 0; bar.st = nullptr;
    if (args.use_bar) bar = xcd_barrier_post((unsigned*)(args.ws + WS_CTL) + CW_BAR, MISC + 8);
    const int lo = args.ph_lo, hi = args.ph_hi;
#define IN(k) (lo <= (k) && (k) < hi)
#define SEAM(k) do { if (IN(k) && IN((k) + 1)) xcd_barrier(bar); } while (0)
    unsigned char* ws = args.ws;
    if (IN(0)) { const Frame F = make_frame(ldsb, wave0); CArgs& AA = *get_args(); phase_prologue(F, AA); } SEAM(0);
    for (int l = 0; l < DEPTH; ++l) {
        const int pb = 1 + l * NPL;
        const float* MODL = (const float*)(ws + WS_MOD) + (size_t)l * 8 * 6144;
        if (IN(pb + 0)) { const Frame F = make_frame(ldsb, wave0); CArgs& AA = *get_args(); phase_norm1(F, AA, l); } SEAM(pb + 0);
        if (IN(pb + 1)) { const Frame F = make_frame(ldsb, wave0); CArgs& AA = *get_args(); pg8::PlainProb P{(const char*)(ws + WS_H), (const char*)(ws + WS_WIN) + (size_t)l * ZS * 1024 * 2, 1024, 1024, 16, 256, 9, F.G, F.bid};
            EpiBf16Plain E{(bf16_t*)(ws + WS_Z), ZS}; pg8::gemm_phase(F.lds, P, E, F.tid); } SEAM(pb + 1);
        if (IN(pb + 2)) { { const Frame F = make_frame(ldsb, wave0); CArgs& AA = *get_args(); phase_mla_prep(F, AA, l); } { const Frame F = make_frame(ldsb, wave0); CArgs& AA = *get_args(); phase_s5<1>(F, AA, l); } { const Frame F = make_frame(ldsb, wave0); CArgs& AA = *get_args(); phase_lru_prep(F, AA, l); } } SEAM(pb + 2);
        if (IN(pb + 3)) { { const Frame F = make_frame(ldsb, wave0); CArgs& AA = *get_args(); pg8::PlainProb P{(const char*)(ws + WS_AMLA), (const char*)(ws + WS_WMLA) + (size_t)l * 1024 * 512 * 2, 512, 512, 8, 256, 4, F.G, F.bid};
            EpiBf16Plain E{(bf16_t*)(ws + WS_QKVRAW), 1024}; pg8::gemm_phase(F.lds, P, E, F.tid); } { const Frame F = make_frame(ldsb, wave0); CArgs& AA = *get_args(); phase_lru_sum(F, AA); } } SEAM(pb + 3);
        if (IN(pb + 4)) { { const Frame F = make_frame(ldsb, wave0); CArgs& AA = *get_args(); phase_mla_post(F, AA, l); } { const Frame F = make_frame(ldsb, wave0); CArgs& AA = *get_args(); phase_lru_fin(F, AA, l); } } SEAM(pb + 4);
        if (IN(pb + 5)) { { const Frame F = make_frame(ldsb, wave0); CArgs& AA = *get_args(); phase_attn(F, AA, l); } lds_barrier(); { const Frame F = make_frame(ldsb, wave0); CArgs& AA = *get_args(); phase_s5<2>(F, AA, l); } } SEAM(pb + 5);
        if (IN(pb + 6)) { { const Frame F = make_frame(ldsb, wave0); CArgs& AA = *get_args(); phase_rwkv_A(F, AA, l); } lds_barrier(); { const Frame F = make_frame(ldsb, wave0); CArgs& AA = *get_args(); pg8::PlainProb P{(const char*)(ws + WS_YS5), (const char*)(ws + WS_WGLU) + (size_t)l * 256 * 256 * 2, 256, 256, 4, 256, 1, F.G, F.bid};
            EpiGlu E{(const bf16_t*)(ws + WS_YS5), (bf16_t*)(ws + WS_YS5G), AA.in[27] + l * 256}; pg8::gemm_phase(F.lds, P, E, F.tid); } } SEAM(pb + 6);
        if (IN(pb + 7)) { const Frame F = make_frame(ldsb, wave0); CArgs& AA = *get_args(); phase_rwkv_B(F, AA); } SEAM(pb + 7);
        if (IN(pb + 8)) { { const Frame F = make_frame(ldsb, wave0); CArgs& AA = *get_args(); phase_rwkv_C(F, AA, l); } { const Frame F = make_frame(ldsb, wave0); CArgs& AA = *get_args(); phase_branch_norm(F, AA, l); } } SEAM(pb + 8);
        if (IN(pb + 9)) { const Frame F = make_frame(ldsb, wave0); CArgs& AA = *get_args(); pg8::PlainProb P{(const char*)(ws + WS_MIX), (const char*)(ws + WS_WOUT) + (size_t)l * 1024 * 1024 * 2, 1024, 1024, 16, 256, 4, F.G, F.bid};
            EpiResGate E{l == 0 ? AA.in[0] : AA.out, AA.out, MODL + 2048, (float*)(ws + WS_ROWSS)}; pg8::gemm_phase(F.lds, P, E, F.tid); } SEAM(pb + 9);
        if (IN(pb + 10)) { const Frame F = make_frame(ldsb, wave0); CArgs& AA = *get_args(); phase_norm2_router(F, AA, l); } SEAM(pb + 10);
        if (IN(pb + 11)) { const Frame F = make_frame(ldsb, wave0); CArgs& AA = *get_args(); phase_moe_scatter(F, AA, l); } SEAM(pb + 11);
        const unsigned* META = (const unsigned*)(ws + WS_CTL) + CW_UTAB + l * 1024;
        if (IN(pb + 12)) { const Frame F = make_frame(ldsb, wave0); CArgs& AA = *get_args(); MoeProb1 P{(const char*)(ws + WS_H), (const char*)(ws + WS_WM1), META, (const int*)(ws + WS_RT_SORT), 1024, 1024, 16, F.G, F.bid};
            EpiMoe1 E{(bf16_t*)(ws + WS_HID), META}; pg8::gemm_phase(F.lds, P, E, F.tid); } SEAM(pb + 12);
        if (IN(pb + 13)) { const Frame F = make_frame(ldsb, wave0); CArgs& AA = *get_args(); MoeProb2 P{(const char*)(ws + WS_HID), (const char*)(ws + WS_WM2), META, 512, 512, 8, F.G, F.bid};
            EpiMoe2 E{(bf16_t*)(ws + WS_Y), META, (const int*)(ws + WS_RT_SORT), (const float*)(ws + WS_RT_GATE), MODL + 5120}; pg8::gemm_phase(F.lds, P, E, F.tid); } SEAM(pb + 13);
    }
    if (IN(NPH - 1)) { const Frame F = make_frame(ldsb, wave0); CArgs& AA = *get_args(); phase_final(F, AA); }
#undef IN
#undef SEAM
}

extern "C" void kernel_launch(void* const* d_in, const int* in_sizes, int n_in, void* d_out, int out_size, void* d_ws, size_t ws_size, hipStream_t stream) {
    static int grid = 0;
    if (grid == 0) {
        if (n_in != 51 || ws_size < WS_END) { fprintf(stderr, "kernel_launch: unexpected inputs (n_in %d, ws %zu)\n", n_in, ws_size); grid = -1; return; }
        int dev = 0, cus = 0;
        if (hipGetDevice(&dev) != hipSuccess || hipDeviceGetAttribute(&cus, hipDeviceAttributeMultiprocessorCount, dev) != hipSuccess) { grid = -1; return; }
        if (hipFuncSetAttribute((const void*)mk_fwd, hipFuncAttributeMaxDynamicSharedMemorySize, LDS_BYTES) != hipSuccess) { fprintf(stderr, "kernel_launch: hipFuncSetAttribute failed\n"); grid = -1; return; }
        grid = cus;
    }
    if (grid < 0) return;
    (void)hipMemsetAsync((char*)d_ws + WS_CTL, 0, CTL_ZERO_BYTES, stream);
    Args a{};
    for (int i = 0; i < 51; ++i) a.in[i] = (const float*)d_in[i];
    a.pos_off = (const int*)d_in[2]; a.out = (float*)d_out; a.ws = (unsigned char*)d_ws; a.pad = 0;
#if defined(MK_PER_PHASE)
    a.use_bar = 0;
    for (int p = 0; p < NPH; ++p) { a.ph_lo = p; a.ph_hi = p + 1;
        const int k = (p == 0) ? 30 : (p == NPH - 1) ? 31 : (p - 1) % NPL; const int reps = 1 + (int)((REPMASK >> k) & 1u);
        for (int r = 0; r < reps; ++r) hipLaunchKernelGGL(mk_fwd, dim3(grid), dim3(NTHR), LDS_BYTES, stream, a); }
#else
    a.use_bar = 1; a.ph_lo = 0; a.ph_hi = NPH;
    hipLaunchKernelGGL(mk_fwd, dim3(grid), dim3(NTHR), LDS_BYTES, stream, a);
#endif
}
```

```cpp
#include <hip/hip_runtime.h>
#include <cstdio>
#include <cstdint>
#include <type_traits>

#define LAS __attribute__((address_space(3)))
#define GAS __attribute__((address_space(1)))
#define DI __device__ __forceinline__
typedef unsigned short bf16_t;
typedef short bf16x8 __attribute__((ext_vector_type(8)));
typedef short s16x4 __attribute__((ext_vector_type(4)));
typedef float f32x4 __attribute__((ext_vector_type(4)));
typedef float f32x2 __attribute__((ext_vector_type(2)));
typedef float f32x16 __attribute__((ext_vector_type(16)));
typedef unsigned u32x4 __attribute__((ext_vector_type(4)));
typedef unsigned u32x2 __attribute__((ext_vector_type(2)));
typedef __bf16 bf16x2_t __attribute__((ext_vector_type(2)));
typedef int i32x4 __attribute__((ext_vector_type(4)));

constexpr int NB = 8, SEQ = 8192, DM = 1024, T = NB * SEQ, DEPTH = 2;
constexpr int WG = 256;
constexpr int ZS = 2304;
constexpr int ZC_R = 0, ZC_K = 256, ZC_V = 512, ZC_WLO = 768, ZC_ALO = 800, ZC_GLO = 832, ZC_S5 = 896, ZC_QA = 1152, ZC_KVA = 1408, ZC_KPE = 1536, ZC_LX = 1568, ZC_LG = 1824, D_IN = 2080;
constexpr int NEXP = 32, DFF = 512;
constexpr float NORM_EPS = 1e-6f;

DI unsigned f2bf(float f) { unsigned u = __float_as_uint(f); return (u + 0x7fffu + ((u >> 16) & 1u)) >> 16; }
DI unsigned pk2(float lo, float hi) { f32x2 v = {lo, hi}; bf16x2_t b = __builtin_convertvector(v, bf16x2_t); return __builtin_bit_cast(unsigned, b); }
DI float bflo(unsigned u) { return __uint_as_float(u << 16); }
DI float bfhi(unsigned u) { return __uint_as_float(u & 0xffff0000u); }
DI float bf2f(bf16_t b) { return __uint_as_float(((unsigned)b) << 16); }
DI int lane_opaque() { int l; asm volatile("v_mbcnt_lo_u32_b32 %0, -1, 0\n\tv_mbcnt_hi_u32_b32 %0, -1, %0" : "=v"(l)); return l; }
DI float shfl_xor_l(float v, int o, int lane) { return __int_as_float(__builtin_amdgcn_ds_bpermute((lane ^ o) << 2, __float_as_int(v))); }
DI float wave_max(float v) {
    const int l = lane_opaque();
#pragma unroll
    for (int o = 1; o < 64; o <<= 1) v = fmaxf(v, shfl_xor_l(v, o, l));
    return v;
}
DI unsigned q8x4(f32x4 v, float inv) { const int a = (int)rintf(v[0] * inv), b = (int)rintf(v[1] * inv), c = (int)rintf(v[2] * inv), d = (int)rintf(v[3] * inv);
    return (unsigned)(a & 255) | ((unsigned)(b & 255) << 8) | ((unsigned)(c & 255) << 16) | ((unsigned)(d & 255) << 24); }
DI float wave_sum(float v) {
    const int l = lane_opaque();
#pragma unroll
    for (int o = 1; o < 64; o <<= 1) v += shfl_xor_l(v, o, l);
    return v;
}
DI void lds_barrier() { asm volatile("s_waitcnt lgkmcnt(0)" ::: "memory"); __builtin_amdgcn_s_barrier(); asm volatile("" ::: "memory"); }
DI float sigmoidf_(float x) { return __builtin_amdgcn_rcpf(1.f + __expf(-x)); }
DI float fast_tanh(float x) { const float e = __expf(2.f * fminf(fmaxf(x, -15.f), 15.f)); return (e - 1.f) * __builtin_amdgcn_rcpf(e + 1.f); }
DI float fast_softplus(float x) { return fmaxf(x, 0.f) + __logf(1.f + __expf(-fabsf(x))); }
DI float softplusf_(float x) { return fmaxf(x, 0.f) + log1pf(__expf(-fabsf(x))); }
DI float gelu_tanh(float x) { const float u = 0.7978845608028654f * (x + 0.044715f * x * x * x); const float e = __expf(2.f * fminf(fmaxf(u, -15.f), 15.f)); return x * e * __builtin_amdgcn_rcpf(e + 1.f); }
DI float siluf_(float x) { return x / (1.f + __expf(-x)); }

namespace pg8 {
constexpr int BM = 256, BK = 64, HALF = 128, HTB = HALF * BK * 2, STAGE_BYTES = 8 * HTB;
DI int lds_byte(int r, int c) { const int st = (r >> 4) * 2 + (c >> 5), rr = r & 15, cc = c & 31, ob = rr * 64 + cc * 2; return st * 1024 + (ob ^ (((ob >> 9) & 1) << 5)); }
DI void stage_rc(int b, int& R, int& C) { const int st = b / 1024, sb = b % 1024, swz = sb ^ (((sb >> 9) & 1) << 5); R = (st >> 1) * 16 + swz / 64; C = (st & 1) * 32 + (swz % 64) / 2; }
DI int perm32(int rho) { const int n = rho >> 4, i = rho & 15; return 8 * (i >> 2) + 4 * n + (i & 3); }

struct Unit { int pm, pn, e, blk; };
DI f32x4 mma_any(bf16x8 a, bf16x8 b, f32x4 c) { return __builtin_amdgcn_mfma_f32_16x16x32_bf16(a, b, c, 0, 0, 0); }
DI i32x4 mma_any(bf16x8 a, bf16x8 b, i32x4 c) { return __builtin_amdgcn_mfma_i32_16x16x64_i8(__builtin_bit_cast(i32x4, a), __builtin_bit_cast(i32x4, b), c, 0, 0, 0); }

template <bool ALIGN_EPI = true, bool I8 = false, class Epi, class P>
DI void gemm_phase(LAS unsigned char* lds, const P& S, const Epi& E, int tid_in) {
    typedef typename std::conditional<I8, i32x4, f32x4>::type acc_t;
    const int tid = tid_in, wid = __builtin_amdgcn_readfirstlane(tid >> 6), lane = tid & 63, wr = wid >> 2, wc = wid & 3, fr = lane & 15, fq = lane >> 4;
    const int nt = S.nt;
    int Rr[2], Cc[2];
    unsigned voffB[2], offC[2][2], offN[2][2];
#pragma unroll
    for (int i = 0; i < 2; ++i) { int R, C; stage_rc(tid * 16 + i * 8192, R, C); Rr[i] = R; Cc[i] = C; const int Rb = Epi::PERM ? ((R & ~31) + perm32(R & 31)) : R;
        voffB[i] = (unsigned)(Rb * S.ldb + C) * 2u; }
    const size_t kstep = (size_t)(BK * 2);
    const size_t hstepB = (size_t)HALF * S.ldb * 2;
    const unsigned ldsw = (unsigned)wid * 1024u;
    const int aoff = lds_byte(wr * 64 + fr, fq * 8), boff = lds_byte(wc * 32 + fr, fq * 8);
#define PG8_SA(b, h) (((b) * 2 + (h)) * HTB)
#define PG8_SB(b, h) ((4 + (b) * 2 + (h)) * HTB)
#define PG8_STAGE(bufoff, gbase, voff) do { _Pragma("unroll") for (int _i = 0; _i < 2; ++_i) \
        __builtin_amdgcn_global_load_lds((const unsigned*)((const char*)(gbase) + (voff)[_i]), (LAS unsigned*)(lds + (bufoff) + ldsw + _i * 8192), 16, 0, 0); } while (0)
#define PG8_LDA(dst, b, h) do { _Pragma("unroll") for (int m = 0; m < 4; ++m) _Pragma("unroll") for (int k = 0; k < 2; ++k) dst[m][k] = *(const LAS bf16x8*)(lds + PG8_SA(b, h) + aoff + m * 2048 + k * 1024); } while (0)
#define PG8_LDB(dst, b, h) do { _Pragma("unroll") for (int n = 0; n < 2; ++n) _Pragma("unroll") for (int k = 0; k < 2; ++k) dst[n][k] = *(const LAS bf16x8*)(lds + PG8_SB(b, h) + boff + n * 2048 + k * 1024); } while (0)
#define PG8_MMA(ai, bj, At, Bt) do { __builtin_amdgcn_s_setprio(1); _Pragma("unroll") for (int m = 0; m < 4; ++m) _Pragma("unroll") for (int n = 0; n < 2; ++n) _Pragma("unroll") for (int k = 0; k < 2; ++k) \
        acc[ai][bj][m][n] = mma_any(Bt[n][k], At[m][k], acc[ai][bj][m][n]); __builtin_amdgcn_s_setprio(0); } while (0)
#define PG8_WAIT_V(n) asm volatile("s_waitcnt vmcnt(" #n ")" ::: "memory")
#define PG8_WAIT_L(n) asm volatile("s_waitcnt lgkmcnt(" #n ")" ::: "memory")
#define PG8_BAR __builtin_amdgcn_s_barrier()
#define PG8_SCHED __builtin_amdgcn_sched_barrier(0)
    Unit cur, nxt; int ui = 0;
    if (!S.next(0, cur)) return;
    acc_t acc[2][2][4][2];
#pragma unroll
    for (int a = 0; a < 2; ++a)
#pragma unroll
        for (int b = 0; b < 2; ++b)
#pragma unroll
            for (int m = 0; m < 4; ++m)
#pragma unroll
                for (int n = 0; n < 2; ++n) acc[a][b][m][n] = (acc_t){0, 0, 0, 0};
    bf16x8 At[4][2], B0[2][2], B1[2][2];
    const char* cA = S.a_base(cur); const char* cB = S.b_base(cur);
#pragma unroll
    for (int h = 0; h < 2; ++h)
#pragma unroll
        for (int i = 0; i < 2; ++i) { offC[h][i] = S.a_off(cur, h * HALF + Rr[i]) + (unsigned)Cc[i] * 2u; offN[h][i] = offC[h][i]; }
    PG8_STAGE(PG8_SB(0, 0), cB, voffB); PG8_STAGE(PG8_SB(0, 1), cB + hstepB, voffB); PG8_STAGE(PG8_SA(0, 0), cA, offC[0]); PG8_STAGE(PG8_SA(0, 1), cA, offC[1]);
    if (wr == 1) PG8_BAR;
    PG8_WAIT_V(2); PG8_BAR;
    PG8_STAGE(PG8_SB(1, 0), cB + kstep, voffB); PG8_STAGE(PG8_SA(1, 0), cA + kstep, offC[0]); PG8_STAGE(PG8_SB(1, 1), cB + hstepB + kstep, voffB);
    PG8_WAIT_V(6); PG8_BAR;
    for (;;) {
        const bool has_next = S.next(ui + 1, nxt);
        const char* nA = has_next ? S.a_base(nxt) : cA; const char* nB = has_next ? S.b_base(nxt) : cB;
        for (int t = 0; t < nt; t += 2) {
            const bool last = (t == nt - 2);
            const char* a1 = cA + (size_t)(t + 1) * kstep;
            const char* a2 = last ? nA : cA + (size_t)(t + 2) * kstep; const char* b2 = last ? nB : cB + (size_t)(t + 2) * kstep;
            const char* a3 = a2 + kstep; const char* b3 = b2 + kstep;
            if (last && has_next) {
#pragma unroll
                for (int h = 0; h < 2; ++h)
#pragma unroll
                    for (int i = 0; i < 2; ++i) offN[h][i] = S.a_off(nxt, h * HALF + Rr[i]) + (unsigned)Cc[i] * 2u;
            }
            unsigned o2[2][2];
#pragma unroll
            for (int h = 0; h < 2; ++h)
#pragma unroll
                for (int i = 0; i < 2; ++i) o2[h][i] = last ? offN[h][i] : offC[h][i];
            PG8_LDB(B0, 0, 0); PG8_LDB(B1, 0, 1); PG8_SCHED; PG8_LDA(At, 0, 0); PG8_STAGE(PG8_SA(1, 1), a1, offC[1]);
            PG8_WAIT_V(8); PG8_WAIT_L(0); PG8_BAR; PG8_MMA(0, 0, At, B0); PG8_MMA(0, 1, At, B1); PG8_BAR; PG8_SCHED;
            PG8_LDA(At, 0, 1); PG8_STAGE(PG8_SB(0, 0), b2, voffB); PG8_STAGE(PG8_SB(0, 1), b2 + hstepB, voffB); PG8_STAGE(PG8_SA(0, 0), a2, o2[0]);
            PG8_WAIT_V(8); PG8_WAIT_L(0); PG8_BAR; PG8_MMA(1, 0, At, B0); PG8_MMA(1, 1, At, B1); PG8_BAR; PG8_SCHED;
            PG8_LDB(B0, 1, 0); PG8_LDB(B1, 1, 1); PG8_SCHED; PG8_LDA(At, 1, 0); PG8_STAGE(PG8_SA(0, 1), a2, o2[1]);
            PG8_WAIT_V(8); PG8_WAIT_L(0); PG8_BAR; PG8_MMA(0, 0, At, B0); PG8_MMA(0, 1, At, B1); PG8_BAR; PG8_SCHED;
            PG8_LDA(At, 1, 1); PG8_STAGE(PG8_SB(1, 0), b3, voffB); PG8_STAGE(PG8_SB(1, 1), b3 + hstepB, voffB); PG8_STAGE(PG8_SA(1, 0), a3, o2[0]);
            PG8_WAIT_V(8); PG8_WAIT_L(0); PG8_BAR; PG8_MMA(1, 0, At, B0); PG8_MMA(1, 1, At, B1); PG8_BAR; PG8_SCHED;
        }
        if constexpr (ALIGN_EPI) { if (wr == 0) PG8_BAR; }
        E(acc, cur, wr, wc, fr, fq);
        if (!has_next) break;
#pragma unroll
        for (int a = 0; a < 2; ++a)
#pragma unroll
            for (int b = 0; b < 2; ++b)
#pragma unroll
                for (int m = 0; m < 4; ++m)
#pragma unroll
                    for (int n = 0; n < 2; ++n) acc[a][b][m][n] = (acc_t){0, 0, 0, 0};
        cur = nxt; cA = nA; cB = nB; ++ui;
#pragma unroll
        for (int h = 0; h < 2; ++h)
#pragma unroll
            for (int i = 0; i < 2; ++i) offC[h][i] = offN[h][i];
        if constexpr (ALIGN_EPI) { if (wr == 1) PG8_BAR; }
    }
    PG8_WAIT_V(0);
    if constexpr (!ALIGN_EPI) { if (wr == 0) PG8_BAR; }
    PG8_BAR;
#undef PG8_SA
#undef PG8_SB
#undef PG8_STAGE
#undef PG8_LDA
#undef PG8_LDB
#undef PG8_MMA
#undef PG8_WAIT_V
#undef PG8_WAIT_L
#undef PG8_BAR
#undef PG8_SCHED
}

struct PlainProb {
    const char* A; const char* Bt; int lda, ldb, nt, nM, nN, G, c;
    DI bool next(int i, Unit& u) const {
        const long L = (long)i * G + c; const int nwg = nM * nN; if (L >= nwg) return false;
        int wgid = (int)L; { const int q = nwg / 8, r = nwg % 8, xcd = wgid % 8, off = wgid / 8; wgid = (xcd < r ? xcd * (q + 1) : r * (q + 1) + (xcd - r) * q) + off; }
        const int nig = 8 * nN, gid = wgid / nig, fm = gid * 8, gsz = (nM - fm) < 8 ? (nM - fm) : 8;
        u.pm = fm + ((wgid % nig) % gsz); u.pn = (wgid % nig) / gsz; u.e = 0; u.blk = 0; return true;
    }
    DI const char* a_base(const Unit& u) const { return A + (size_t)u.pm * 256 * lda * 2; }
    DI const char* b_base(const Unit& u) const { return Bt + (size_t)u.pn * 256 * ldb * 2; }
    DI unsigned a_off(const Unit&, int row) const { return (unsigned)row * (unsigned)lda * 2u; }
};
}

constexpr size_t MiB = 1u << 20;
constexpr size_t WS_CTL = 0, CTL_ZERO_BYTES = 1 * MiB;
constexpr size_t WS_MOD = 1 * MiB;
constexpr size_t WS_RT_EID = 3 * MiB;
constexpr size_t WS_RT_GATE = WS_RT_EID + 512 * 1024;
constexpr size_t WS_RT_PIE = WS_RT_GATE + 512 * 1024;
constexpr size_t WS_RT_SORT = WS_RT_PIE + 512 * 1024;
constexpr size_t WS_WIN = 8 * MiB;
constexpr size_t WS_WINSC = 8 * MiB + 5 * MiB;
constexpr size_t WS_HSC = 7 * MiB + 512 * 1024;
constexpr size_t WS_WOUT = 17 * MiB;
constexpr size_t WS_WMLA = 21 * MiB;
constexpr size_t WS_WGLU = 23 * MiB;
constexpr size_t WS_WR = 23 * MiB + 256 * 1024;
constexpr size_t WS_WLRU = 23 * MiB + 640 * 1024;
constexpr size_t WS_WLORA = 23 * MiB + 768 * 1024;
static_assert(WS_WGLU + 256 * 1024 <= WS_WR && WS_WR + 384 * 1024 <= WS_WLRU && WS_WLRU + 128 * 1024 <= WS_WLORA && WS_WLORA + 128 * 1024 <= 24 * MiB, "small weight map");
constexpr size_t WS_H = 24 * MiB;
constexpr size_t WS_Z = 152 * MiB;
constexpr size_t WS_WM1 = WS_Z;
constexpr size_t WS_WM2 = WS_Z + 64 * MiB;
constexpr size_t WS_MIX = 440 * MiB;
constexpr size_t WS_HID = WS_MIX;
constexpr size_t WS_Y = 569 * MiB;
constexpr size_t WS_Q = 825 * MiB;
constexpr size_t WS_K = 873 * MiB;
constexpr size_t WS_VT = 921 * MiB;
constexpr size_t WS_ROWSS = WS_Q;
constexpr size_t WS_TAIL = 953 * MiB;
constexpr size_t WS_END = 1017 * MiB;
constexpr size_t WS_AMLA = WS_TAIL;
constexpr size_t WS_QKVRAW = WS_Y;
constexpr size_t WS_ATTO = WS_H;
constexpr size_t WS_RW_V = WS_Y + 64 * MiB, WS_RW_G = WS_H + 64 * MiB;
constexpr size_t WS_RC_RP = WS_H + 32 * MiB;
constexpr size_t WS_RC_MP = WS_H + 64 * MiB;
constexpr size_t WS_RC_HB = WS_H + 96 * MiB;
constexpr size_t WS_RC_Y0 = WS_Q;
constexpr size_t WS_RC_G = WS_Q + 64 * MiB;
constexpr int RC_REC = 24832;
constexpr size_t WS_RC_BS = WS_Q + 64 * MiB + 98 * MiB;
static_assert((size_t)4096 * RC_REC <= 98 * MiB && WS_RC_BS + 1 * MiB <= WS_END, "rwkv record map");
constexpr size_t WS_YS5 = WS_Y;
constexpr size_t WS_YS5G = WS_Y + 32 * MiB;
constexpr size_t WS_YL = WS_TAIL + 32 * MiB;
constexpr size_t WS_LA = WS_Y + 128 * MiB, WS_LB = WS_Y + 192 * MiB;
constexpr size_t WS_S5END = 2 * MiB;
constexpr size_t WS_S5BB = 5 * MiB;
constexpr size_t WS_S5CC = 5 * MiB + 128 * 1024;
constexpr size_t WS_LSUM = 5 * MiB + 512 * 1024;
static_assert(WS_RT_SORT + 512 * 1024 <= WS_LSUM && WS_LSUM + 2 * MiB <= WS_WIN && WS_S5END + 1 * MiB <= WS_RT_EID, "map");

constexpr int CW_BAR = 4096;
constexpr int CW_CNT = 16384;
constexpr int CW_UTAB = 20480;

constexpr int NWAVES = 8, NTHR = 512;
constexpr int LDS_BYTES = 155648;
constexpr int MISC_OFF = 155648 - 256;

struct Args { const float* in[51]; const int* pos_off; float* out; unsigned char* ws; int ph_lo, ph_hi, use_bar, pad; };
typedef const __attribute__((address_space(4))) Args CArgs;
DI CArgs* get_args() { CArgs* ap = (CArgs*)__builtin_amdgcn_kernarg_segment_ptr(); asm volatile("" : "+s"(ap)); return ap; }

#define XB_TMO      128
#define XB_XCNT(j)  (256  + 64 * (j))
#define XB_XSUB(j)  (1280 + 64 * (j))
#define XB_XGEN(j)  (2304 + 64 * (j))
#define XB_TOP      3328
#define XB_TOPGEN   3392
#define XCD_BAR_WORDS 3456
#define XB_SPIN_CAP (1u << 18)
DI unsigned xb_ld(unsigned* p)              { return __hip_atomic_load(p, __ATOMIC_RELAXED, __HIP_MEMORY_SCOPE_AGENT); }
DI unsigned xb_add(unsigned* p, unsigned v) { return __hip_atomic_fetch_add(p, v, __ATOMIC_RELAXED, __HIP_MEMORY_SCOPE_AGENT); }
DI unsigned xb_xcc_id() { return (unsigned)__builtin_amdgcn_s_getreg((3 << 11) | 20) & 0xFu; }
#define XB_SPIN(cond, bar) do { unsigned _sp = 0; while (cond) { __builtin_amdgcn_s_sleep(1); \
    if ((++_sp & 255u) == 0u) { if (xb_ld(&(bar)[XB_TMO])) break; if (_sp > XB_SPIN_CAP) { atomicAdd(&(bar)[XB_TMO], 1u); break; } } } } while (0)
struct XcdBarrier { unsigned* bar; unsigned x; volatile LAS unsigned* st; };
DI XcdBarrier xcd_barrier_post(unsigned* bar, volatile LAS unsigned* st) {
    XcdBarrier b; b.bar = bar; b.x = xb_xcc_id(); b.st = st;
    if (threadIdx.x == 0) (void)xb_add(&bar[XB_XCNT(b.x)], 1u);
    return b;
}
DI void xcd_barrier_complete(unsigned* bar, unsigned x, unsigned& nloc, unsigned& nx) {
    const unsigned G = gridDim.x * gridDim.y * gridDim.z;
    unsigned sum, cnt, mine, sp = 0u;
    for (;;) {
        sum = 0u; cnt = 0u; mine = 0u;
#pragma unroll
        for (unsigned j = 0; j < 16; ++j) { const unsigned c = xb_ld(&bar[XB_XCNT(j)]); sum += c; cnt += (c > 0u) ? 1u : 0u; mine = (j == x) ? c : mine; }
        if (sum == G) break;
        __builtin_amdgcn_s_sleep(1);
        if ((++sp & 255u) == 0u) { if (xb_ld(&bar[XB_TMO])) break; if (sp > XB_SPIN_CAP) { atomicAdd(&bar[XB_TMO], 1u); break; } }
    }
    nloc = mine > 0u ? mine : 1u; nx = cnt > 0u ? cnt : 1u;
}
DI void xcd_barrier(const XcdBarrier& b) {
    asm volatile("s_waitcnt vmcnt(0)" ::: "memory");
    __syncthreads();
    if (threadIdx.x == 0) {
        unsigned* bar = b.bar;
        __builtin_amdgcn_s_waitcnt(0);
        unsigned nloc = b.st[0], nx = b.st[1];
        if (nloc == 0u) { xcd_barrier_complete(bar, b.x, nloc, nx); b.st[0] = nloc; b.st[1] = nx; }
        const unsigned old = xb_add(&bar[XB_XSUB(b.x)], 1u);
        const unsigned gen = old / nloc;
        if (old + 1u == (gen + 1u) * nloc) {
            __builtin_amdgcn_fence(__ATOMIC_RELEASE, "agent");
            asm volatile("s_waitcnt vmcnt(0)" ::: "memory");
            const unsigned og = xb_add(&bar[XB_TOP], 1u);
            const unsigned tg = og / nx;
            if (og + 1u == (tg + 1u) * nx) xb_add(&bar[XB_TOPGEN], 1u);
            else XB_SPIN(xb_ld(&bar[XB_TOPGEN]) == tg, bar);
            __builtin_amdgcn_fence(__ATOMIC_ACQUIRE, "agent");
            xb_add(&bar[XB_XGEN(b.x)], 1u);
            asm volatile("s_waitcnt vmcnt(0)" ::: "memory");
        } else {
            XB_SPIN(xb_ld(&bar[XB_XGEN(b.x)]) == gen, bar);
            __builtin_amdgcn_fence(__ATOMIC_ACQUIRE, "agent");
            asm volatile("s_waitcnt vmcnt(0)" ::: "memory");
        }
    }
    __syncthreads();
}

struct EpiBf16Plain {
    static constexpr bool PERM = true;
    bf16_t* O; int ldc;
    DI void operator()(const f32x4 (&acc)[2][2][4][2], const pg8::Unit& u, int wr, int wc, int fr, int fq) const {
        const int row0 = u.pm * 256 + wr * 64 + fr, col0 = u.pn * 256 + wc * 32 + 8 * fq;
#pragma unroll
        for (int ai = 0; ai < 2; ++ai)
#pragma unroll
            for (int m = 0; m < 4; ++m) { bf16_t* rowp = O + (size_t)(row0 + ai * 128 + m * 16) * ldc + col0;
#pragma unroll
                for (int bj = 0; bj < 2; ++bj) { const f32x4 v0 = acc[ai][bj][m][0], v1 = acc[ai][bj][m][1];
                    u32x4 w; w.x = pk2(v0[0], v0[1]); w.y = pk2(v0[2], v0[3]); w.z = pk2(v1[0], v1[1]); w.w = pk2(v1[2], v1[3]);
                    *(u32x4*)(rowp + bj * 128) = w; } }
    }
};
struct EpiBf16I8 {
    static constexpr bool PERM = true;
    bf16_t* O; int ldc; const float* sa; const float* sw;
    DI void operator()(const i32x4 (&acc)[2][2][4][2], const pg8::Unit& u, int wr, int wc, int fr, int fq) const {
        const int row0 = u.pm * 256 + wr * 64 + fr, col0 = u.pn * 256 + wc * 32 + 8 * fq;
        f32x4 w0[2], w1[2];
#pragma unroll
        for (int bj = 0; bj < 2; ++bj) { w0[bj] = *(const f32x4*)(sw + col0 + bj * 128); w1[bj] = *(const f32x4*)(sw + col0 + bj * 128 + 4); }
#pragma unroll
        for (int ai = 0; ai < 2; ++ai)
#pragma unroll
            for (int m = 0; m < 4; ++m) { const int row = row0 + ai * 128 + m * 16; const float ra = sa[row]; bf16_t* rowp = O + (size_t)row * ldc + col0;
#pragma unroll
                for (int bj = 0; bj < 2; ++bj) { const i32x4 a0 = acc[ai][bj][m][0], a1 = acc[ai][bj][m][1];
                    u32x4 w; w.x = pk2((float)a0[0] * ra * w0[bj][0], (float)a0[1] * ra * w0[bj][1]); w.y = pk2((float)a0[2] * ra * w0[bj][2], (float)a0[3] * ra * w0[bj][3]);
                    w.z = pk2((float)a1[0] * ra * w1[bj][0], (float)a1[1] * ra * w1[bj][1]); w.w = pk2((float)a1[2] * ra * w1[bj][2], (float)a1[3] * ra * w1[bj][3]);
                    *(u32x4*)(rowp + bj * 128) = w; } }
    }
};
struct EpiResGate {
    static constexpr bool PERM = false;
    const float* xin; float* out; const float* gt; float* rowss;
    DI void operator()(const f32x4 (&acc)[2][2][4][2], const pg8::Unit& u, int wr, int wc, int fr, int fq) const {
        const int row0 = u.pm * 256 + wr * 64 + fr, col0 = u.pn * 256 + wc * 32 + 4 * fq;
        const int b = (u.pm * 256) / SEQ;
        const int ln = lane_opaque();
        f32x4 g[2][2];
#pragma unroll
        for (int bj = 0; bj < 2; ++bj)
#pragma unroll
            for (int n = 0; n < 2; ++n) g[bj][n] = *(const f32x4*)(gt + (size_t)b * 6144 + col0 + bj * 128 + n * 16);
#pragma unroll
        for (int ai = 0; ai < 2; ++ai)
#pragma unroll
            for (int m = 0; m < 4; ++m) { const size_t ro = (size_t)(row0 + ai * 128 + m * 16) * DM + col0; float ss = 0.f;
#pragma unroll
                for (int bj = 0; bj < 2; ++bj)
#pragma unroll
                    for (int n = 0; n < 2; ++n) { const f32x4 xv = *(const f32x4*)(xin + ro + bj * 128 + n * 16); const f32x4 v = xv + g[bj][n] * acc[ai][bj][m][n];
                        *(f32x4*)(out + ro + bj * 128 + n * 16) = v; ss += (v[0] * v[0] + v[1] * v[1]) + (v[2] * v[2] + v[3] * v[3]); }
                ss += shfl_xor_l(ss, 16, ln); ss += shfl_xor_l(ss, 32, ln);
                if (fq == 0) rowss[(size_t)(row0 + ai * 128 + m * 16) * 16 + u.pn * 4 + wc] = ss; }
    }
};
struct EpiGlu {
    static constexpr bool PERM = true;
    const bf16_t* Y; bf16_t* O; const float* bias;
    DI void operator()(const f32x4 (&acc)[2][2][4][2], const pg8::Unit& u, int wr, int wc, int fr, int fq) const {
        const int row0 = u.pm * 256 + wr * 64 + fr, col0 = wc * 32 + 8 * fq;
#pragma unroll
        for (int ai = 0; ai < 2; ++ai)
#pragma unroll
            for (int m = 0; m < 4; ++m) { const size_t ro = (size_t)(row0 + ai * 128 + m * 16) * 256 + col0;
#pragma unroll
                for (int bj = 0; bj < 2; ++bj) { const u32x4 yv = *(const u32x4*)(Y + ro + bj * 128);
                    const f32x4 b0 = *(const f32x4*)(bias + col0 + bj * 128), b1 = *(const f32x4*)(bias + col0 + bj * 128 + 4);
                    const f32x4 v0 = acc[ai][bj][m][0] + b0, v1 = acc[ai][bj][m][1] + b1;
                    u32x4 w;
                    w.x = pk2(bflo(yv.x) * sigmoidf_(v0[0]), bfhi(yv.x) * sigmoidf_(v0[1]));
                    w.y = pk2(bflo(yv.y) * sigmoidf_(v0[2]), bfhi(yv.y) * sigmoidf_(v0[3]));
                    w.z = pk2(bflo(yv.z) * sigmoidf_(v1[0]), bfhi(yv.z) * sigmoidf_(v1[1]));
                    w.w = pk2(bflo(yv.w) * sigmoidf_(v1[2]), bfhi(yv.w) * sigmoidf_(v1[3]));
                    *(u32x4*)(O + ro + bj * 128) = w; } }
    }
};

struct Frame { LAS unsigned char* lds; int tid, lane, wave, G, bid, gw, ngw; };

DI Frame make_frame(LAS unsigned char* lds, int wave0) {
    Frame F; F.lds = lds; int w = wave0; asm volatile("" : "+s"(w)); F.wave = w; F.lane = lane_opaque(); F.tid = w * 64 + F.lane;
    F.G = gridDim.x; F.bid = blockIdx.x; F.gw = F.bid * NWAVES + F.wave; F.ngw = F.G * NWAVES; return F;
}
DI void transpose_item(const float* src, int ld_src, int k0, int n0, bf16_t* dst, int ldd, int nd0, int kd0, LAS float* scr, int lane) {
#pragma unroll 8
    for (int i = 0; i < 32; ++i) { const int kk = 2 * i + (lane >> 5); scr[kk * 33 + (lane & 31)] = src[(size_t)(k0 + kk) * ld_src + n0 + (lane & 31)]; }
    asm volatile("s_waitcnt lgkmcnt(0)" ::: "memory");
    const int c = lane & 7;
#pragma unroll
    for (int j = 0; j < 4; ++j) { const int n = (lane >> 3) + 8 * j; const LAS float* s = scr + (8 * c) * 33 + n;
        u32x4 o; o.x = pk2(s[0 * 33], s[1 * 33]); o.y = pk2(s[2 * 33], s[3 * 33]); o.z = pk2(s[4 * 33], s[5 * 33]); o.w = pk2(s[6 * 33], s[7 * 33]);
        *(u32x4*)(dst + (size_t)(nd0 + n) * ldd + kd0 + 8 * c) = o; }
    asm volatile("s_waitcnt lgkmcnt(0)" ::: "memory");
}
DI void transpose_item64(const float* src, int ld_src, int k0, int n0, bf16_t* dst, int ldd, int nd0, int kd0, LAS float* scr, int lane) {
    f32x4 v[16];
#pragma unroll
    for (int i = 0; i < 16; ++i) v[i] = *(const f32x4*)(src + (size_t)(k0 + 4 * i + (lane >> 4)) * ld_src + n0 + 4 * (lane & 15));
#pragma unroll
    for (int i = 0; i < 16; ++i) { LAS float* p = scr + (4 * i + (lane >> 4)) * 65 + 4 * (lane & 15); p[0] = v[i][0]; p[1] = v[i][1]; p[2] = v[i][2]; p[3] = v[i][3]; }
    asm volatile("s_waitcnt lgkmcnt(0)" ::: "memory");
    const int c = lane & 7;
#pragma unroll
    for (int j = 0; j < 8; ++j) { const int n = (lane >> 3) + 8 * j; const LAS float* q = scr + (8 * c) * 65 + n;
        u32x4 o; o.x = pk2(q[0 * 65], q[1 * 65]); o.y = pk2(q[2 * 65], q[3 * 65]); o.z = pk2(q[4 * 65], q[5 * 65]); o.w = pk2(q[6 * 65], q[7 * 65]);
        *(u32x4*)(dst + (size_t)(nd0 + n) * ldd + kd0 + 8 * c) = o; }
    asm volatile("s_waitcnt lgkmcnt(0)" ::: "memory");
}
DI void quant_strip64(const float* src, int ld_src, int n0, int nvalid, signed char* dst, int ldd, float* scale, LAS float* scr, int lane) {
    const int c4 = n0 + 4 * (lane & 15); const bool okc = c4 < nvalid;
    float mx[4] = {0.f, 0.f, 0.f, 0.f};
    for (int kb = 0; kb < 16; ++kb) {
#pragma unroll
        for (int i = 0; i < 16; ++i) { f32x4 v = {0.f, 0.f, 0.f, 0.f}; if (okc) v = *(const f32x4*)(src + (size_t)(64 * kb + 4 * i + (lane >> 4)) * ld_src + c4);
            mx[0] = fmaxf(mx[0], fabsf(v[0])); mx[1] = fmaxf(mx[1], fabsf(v[1])); mx[2] = fmaxf(mx[2], fabsf(v[2])); mx[3] = fmaxf(mx[3], fabsf(v[3])); } }
#pragma unroll
    for (int q = 0; q < 4; ++q) { mx[q] = fmaxf(mx[q], shfl_xor_l(mx[q], 16, lane)); mx[q] = fmaxf(mx[q], shfl_xor_l(mx[q], 32, lane)); }
    LAS float* smax = scr + 64 * 65;
    if (lane < 16) {
#pragma unroll
        for (int q = 0; q < 4; ++q) { const float sc = fmaxf(mx[q], 1e-30f) * (1.f / 127.f); smax[4 * lane + q] = sc; scale[4 * lane + q] = sc; } }
    asm volatile("s_waitcnt lgkmcnt(0)" ::: "memory");
    for (int kb = 0; kb < 16; ++kb) {
        f32x4 v[16];
#pragma unroll
        for (int i = 0; i < 16; ++i) { v[i] = (f32x4){0.f, 0.f, 0.f, 0.f}; if (okc) v[i] = *(const f32x4*)(src + (size_t)(64 * kb + 4 * i + (lane >> 4)) * ld_src + c4); }
#pragma unroll
        for (int i = 0; i < 16; ++i) { LAS float* p = scr + (4 * i + (lane >> 4)) * 65 + 4 * (lane & 15); p[0] = v[i][0]; p[1] = v[i][1]; p[2] = v[i][2]; p[3] = v[i][3]; }
        asm volatile("s_waitcnt lgkmcnt(0)" ::: "memory");
        const int c = lane & 7;
#pragma unroll
        for (int j = 0; j < 8; ++j) { const int n = (lane >> 3) + 8 * j; const LAS float* q = scr + (8 * c) * 65 + n; const float inv = 1.f / smax[n];
            u32x2 o; o.x = q8x4((f32x4){q[0 * 65], q[1 * 65], q[2 * 65], q[3 * 65]}, inv); o.y = q8x4((f32x4){q[4 * 65], q[5 * 65], q[6 * 65], q[7 * 65]}, inv);
            *(u32x2*)(dst + (size_t)n * ldd + 64 * kb + 8 * c) = o; }
        asm volatile("s_waitcnt lgkmcnt(0)" ::: "memory");
    }
}
DI void zero_rows(bf16_t* dst, int ld, int r0, int nr, int c0, int nc, int gw, int ngw, int lane) {
    for (int r = gw; r < nr; r += ngw) for (int c = lane * 8; c < nc; c += 512) *(u32x4*)(dst + (size_t)(r0 + r) * ld + c0 + c) = (u32x4){0u, 0u, 0u, 0u};
}

DI void phase_prologue(const Frame& F, CArgs& A) {
    unsigned char* ws = A.ws;
    LAS float* sc = (LAS float*)F.lds;
    LAS float* part = (LAS float*)(F.lds + 32768);
    for (int i = F.tid; i < 8192; i += NTHR) sc[i] = siluf_(A.in[1][i]);
    __syncthreads();
    float* MOD = (float*)(ws + WS_MOD);
    for (int item = F.bid; item < 192; item += F.G) {
        const int l = item / 96, n0 = (item % 96) * 64, nl = F.tid & 63, kg = F.tid >> 6;
        const float* W = A.in[3] + (size_t)l * 1024 * 6144 + n0 + nl;
        float acc[8];
#pragma unroll
        for (int b = 0; b < 8; ++b) acc[b] = 0.f;
        for (int k = kg * 128; k < kg * 128 + 128; ++k) { const float w = W[(size_t)k * 6144];
#pragma unroll
            for (int b = 0; b < 8; ++b) acc[b] += sc[b * 1024 + k] * w; }
#pragma unroll
        for (int b = 0; b < 8; ++b) part[(kg * 8 + b) * 64 + nl] = acc[b];
        __syncthreads();
        { const int b = F.tid >> 6; float s = A.in[4][l * 6144 + n0 + nl];
#pragma unroll
          for (int g = 0; g < 8; ++g) s += part[(g * 8 + b) * 64 + nl];
          MOD[((size_t)l * 8 + b) * 6144 + n0 + nl] = s; }
        __syncthreads();
    }
    LAS float* scr = (LAS float*)(F.lds + F.wave * 16896);
    bf16_t* WIN = (bf16_t*)(ws + WS_WIN); bf16_t* WOUT = (bf16_t*)(ws + WS_WOUT); bf16_t* WMLA = (bf16_t*)(ws + WS_WMLA); bf16_t* WGLU = (bf16_t*)(ws + WS_WGLU);
    constexpr int I_IN = 0, I_INT = 0, I_OUT = 16 * 16, I_Q = 4 * 6, I_KV = 2 * 8, I_GLU = 4 * 4, I_L = I_IN + I_INT + I_OUT + I_Q + I_KV + I_GLU;
    for (int it = F.gw; it < 2 * I_L; it += F.ngw) {
        const int l = it / I_L; int r = it % I_L;
        if (r < I_IN) { transpose_item64(A.in[6] + (size_t)l * 1024 * D_IN, D_IN, 64 * (r / 32), 64 * (r % 32), WIN + (size_t)l * ZS * 1024, 1024, 64 * (r % 32), 64 * (r / 32), scr, F.lane); continue; } r -= I_IN;
        if (r < I_INT) { transpose_item(A.in[6] + (size_t)l * 1024 * D_IN, D_IN, 64 * r, 2048, WIN + (size_t)l * ZS * 1024, 1024, 2048, 64 * r, scr, F.lane); continue; } r -= I_INT;
        if (r < I_OUT) { transpose_item64(A.in[42] + (size_t)l * 1024 * 1024, 1024, 64 * (r / 16), 64 * (r % 16), WOUT + (size_t)l * 1024 * 1024, 1024, 64 * (r % 16), 64 * (r / 16), scr, F.lane); continue; } r -= I_OUT;
        if (r < I_Q) { transpose_item64(A.in[29] + (size_t)l * 256 * 384, 384, 64 * (r / 6), 64 * (r % 6), WMLA + (size_t)l * 1024 * 512, 512, 64 * (r % 6), 64 * (r / 6), scr, F.lane); continue; } r -= I_Q;
        if (r < I_KV) { transpose_item64(A.in[31] + (size_t)l * 128 * 512, 512, 64 * (r / 8), 64 * (r % 8), WMLA + (size_t)l * 1024 * 512, 512, 384 + 64 * (r % 8), 256 + 64 * (r / 8), scr, F.lane); continue; } r -= I_KV;
        transpose_item64(A.in[26] + (size_t)l * 256 * 256, 256, 64 * (r / 4), 64 * (r % 4), WGLU + (size_t)l * 256 * 256, 256, 64 * (r % 4), 64 * (r / 4), scr, F.lane);
    }
    for (int it = F.gw; it < 2 * 36; it += F.ngw) {
        const int l = it / 36, nb = it % 36;
        quant_strip64(A.in[6] + (size_t)l * 1024 * D_IN, D_IN, 64 * nb, D_IN, (signed char*)(ws + WS_WIN) + ((size_t)l * ZS + 64 * nb) * 1024, 1024, (float*)(ws + WS_WINSC) + l * ZS + 64 * nb, scr, F.lane); }
    { bf16_t* WR = (bf16_t*)(ws + WS_WR);
      for (int i = F.bid * NTHR + F.tid; i < 2 * 48 * 1024; i += F.G * NTHR) { const int l = i / (48 * 1024), n = (i / 1024) % 48, k = i % 1024;
          const float v = n < 4 ? A.in[44][((size_t)l * 1024 + k) * 4 + n] : n < 36 ? A.in[46][((size_t)l * 1024 + k) * 32 + (n - 4)] : 0.f;
          const unsigned hi = f2bf(v); const float rem = v - __uint_as_float(hi << 16);
          WR[((size_t)(l * 2 + 0) * 48 + n) * 1024 + k] = (bf16_t)hi; WR[((size_t)(l * 2 + 1) * 48 + n) * 1024 + k] = (bf16_t)f2bf(rem); } }
    { bf16_t* WL = (bf16_t*)(ws + WS_WLRU); bf16_t* WO = (bf16_t*)(ws + WS_WLORA);
      for (int i = F.bid * NTHR + F.tid; i < 2 * 2 * 4 * 4096; i += F.G * NTHR) { const int l = i >> 15, wh = (i >> 14) & 1, n = (i >> 12) & 3, j = (i >> 6) & 63, k = i & 63;
          WL[i] = (bf16_t)f2bf((wh ? A.in[38] : A.in[36])[((size_t)(l * 4 + n) * 64 + k) * 64 + j]); }
      for (int i = F.bid * NTHR + F.tid; i < 2 * 32768; i += F.G * NTHR) { const int l = i >> 15, r = i & 32767;
          float v;
          if (r < 8192) v = A.in[9][(size_t)l * 8192 + (r & 31) * 256 + (r >> 5)];
          else if (r < 16384) v = A.in[11][(size_t)l * 8192 + ((r - 8192) & 31) * 256 + ((r - 8192) >> 5)];
          else v = A.in[12][(size_t)l * 16384 + ((r - 16384) & 63) * 256 + ((r - 16384) >> 6)];
          WO[i] = (bf16_t)f2bf(v); } }
    { bf16_t* BBt = (bf16_t*)(ws + WS_S5BB); bf16_t* CCt = (bf16_t*)(ws + WS_S5CC);
      for (int i = F.bid * NTHR + F.tid; i < 2 * 16 * 64; i += F.G * NTHR) { const int lg = i >> 6, p = i & 63;
          const float dt = __expf(A.in[25][lg]); const float lre = A.in[18][lg * 64 + p], lim = A.in[19][lg * 64 + p];
          const float mag = expf(lre * dt); float sn, cn; sincosf(lim * dt, &sn, &cn);
          const float are = mag * cn, aim = mag * sn, den = lre * lre + lim * lim;
          const float qre = ((are - 1.f) * lre + aim * lim) / den, qim = (aim * lre - (are - 1.f) * lim) / den;
          const float* br = A.in[20] + ((size_t)lg * 64 + p) * 16; const float* bi = A.in[21] + ((size_t)lg * 64 + p) * 16;
          for (int c = 0; c < 16; ++c) { const float x = br[c], y = bi[c];
              BBt[(((size_t)lg * 2 + 0) * 64 + p) * 16 + c] = (bf16_t)f2bf(qre * x - qim * y); BBt[(((size_t)lg * 2 + 1) * 64 + p) * 16 + c] = (bf16_t)f2bf(qre * y + qim * x); } }
      for (int i = F.bid * NTHR + F.tid; i < 2 * 16 * 16 * 128; i += F.G * NTHR) { const int lg = i >> 11, ii = (i >> 7) & 15, k = i & 127;
          CCt[i] = (bf16_t)f2bf(k < 64 ? A.in[22][((size_t)lg * 16 + ii) * 64 + k] : -A.in[23][((size_t)lg * 16 + ii) * 64 + (k - 64)]); } }
    for (int l = 0; l < 2; ++l) {
        bf16_t* wm = WMLA + (size_t)l * 1024 * 512;
        zero_rows(wm, 512, 0, 384, 256, 256, F.gw, F.ngw, F.lane);
        zero_rows(wm, 512, 384, 512, 0, 256, F.gw, F.ngw, F.lane);
        zero_rows(wm, 512, 384, 512, 384, 128, F.gw, F.ngw, F.lane);
        zero_rows(wm, 512, 896, 128, 0, 512, F.gw, F.ngw, F.lane);
    }
}

DI void phase_norm1(const Frame& F, CArgs& A, int l) {
    const float* MODL = (const float*)(A.ws + WS_MOD) + (size_t)l * 8 * 6144;
    const float* g = A.in[5] + l * 1024;
    const bf16_t* Y = (const bf16_t*)(A.ws + WS_Y);
    signed char* H8 = (signed char*)(A.ws + WS_H); float* HS = (float*)(A.ws + WS_HSC);
    const float* src = (l == 0) ? A.in[0] : A.out;
    for (int row0 = 2 * F.gw; row0 < T; row0 += 2 * F.ngw) {
        const int b = row0 / SEQ;
        f32x4 v[2][4]; u32x2 ya[2][4], yb[2][4];
#pragma unroll
        for (int r = 0; r < 2; ++r)
#pragma unroll
            for (int j = 0; j < 4; ++j) { const int col = 4 * (64 * j + F.lane); v[r][j] = *(const f32x4*)(src + (size_t)(row0 + r) * DM + col);
                if (l > 0) { ya[r][j] = *(const u32x2*)(Y + (size_t)(2 * (row0 + r)) * DM + col); yb[r][j] = *(const u32x2*)(Y + (size_t)(2 * (row0 + r) + 1) * DM + col); } }
#pragma unroll
        for (int r = 0; r < 2; ++r) {
            const int row = row0 + r; float ss = 0.f;
#pragma unroll
            for (int j = 0; j < 4; ++j) { const int col = 4 * (64 * j + F.lane);
                if (l > 0) { const u32x2 y0 = ya[r][j], y1 = yb[r][j];
                    v[r][j][0] += bflo(y0.x) + bflo(y1.x); v[r][j][1] += bfhi(y0.x) + bfhi(y1.x); v[r][j][2] += bflo(y0.y) + bflo(y1.y); v[r][j][3] += bfhi(y0.y) + bfhi(y1.y);
                    *(f32x4*)(A.out + (size_t)row * DM + col) = v[r][j]; }
                ss += v[r][j][0] * v[r][j][0] + v[r][j][1] * v[r][j][1] + v[r][j][2] * v[r][j][2] + v[r][j][3] * v[r][j][3]; }
            const float rstd = rsqrtf(wave_sum(ss) * (1.f / DM) + NORM_EPS);
#pragma unroll
            for (int j = 0; j < 4; ++j) { const int col = 4 * (64 * j + F.lane);
                const f32x4 gg = *(const f32x4*)(g + col), sh = *(const f32x4*)(MODL + (size_t)b * 6144 + col), scv = *(const f32x4*)(MODL + (size_t)b * 6144 + 1024 + col);
                v[r][j] = v[r][j] * rstd * gg * (scv + 1.f) + sh; }
            float mx = 0.f;
#pragma unroll
            for (int j = 0; j < 4; ++j) mx = fmaxf(mx, fmaxf(fmaxf(fabsf(v[r][j][0]), fabsf(v[r][j][1])), fmaxf(fabsf(v[r][j][2]), fabsf(v[r][j][3]))));
            mx = fmaxf(wave_max(mx), 1e-30f); const float inv = 127.f / mx;
            if (F.lane == 0) HS[row] = mx * (1.f / 127.f);
#pragma unroll
            for (int j = 0; j < 4; ++j) *(unsigned*)(H8 + (size_t)row * DM + 4 * (64 * j + F.lane)) = q8x4(v[r][j], inv);
        }
    }
}

DI void phase_mla_prep(const Frame& F, CArgs& A, int l) {
    const bf16_t* Z = (const bf16_t*)(A.ws + WS_Z); bf16_t* AM = (bf16_t*)(A.ws + WS_AMLA);
    const float* qg = A.in[28] + l * 256; const float* kg = A.in[30] + l * 128;
    for (int row = F.gw; row < T; row += F.ngw) {
        const bf16_t* zr = Z + (size_t)row * ZS;
        const u32x2 qv = *(const u32x2*)(zr + ZC_QA + 4 * F.lane); const unsigned kv = *(const unsigned*)(zr + ZC_KVA + 2 * F.lane);
        const float q0 = bflo(qv.x), q1 = bfhi(qv.x), q2 = bflo(qv.y), q3 = bfhi(qv.y), k0 = bflo(kv), k1 = bfhi(kv);
        const float rq = rsqrtf(wave_sum(q0 * q0 + q1 * q1 + q2 * q2 + q3 * q3) * (1.f / 256.f) + NORM_EPS);
        const float rk = rsqrtf(wave_sum(k0 * k0 + k1 * k1) * (1.f / 128.f) + NORM_EPS);
        const f32x4 g4 = *(const f32x4*)(qg + 4 * F.lane); const f32x2 g2 = *(const f32x2*)(kg + 2 * F.lane);
        u32x2 o; o.x = pk2(q0 * rq * g4[0], q1 * rq * g4[1]); o.y = pk2(q2 * rq * g4[2], q3 * rq * g4[3]);
        bf16_t* ar = AM + (size_t)row * 512;
        *(u32x2*)(ar + 4 * F.lane) = o;
        *(unsigned*)(ar + 256 + 2 * F.lane) = pk2(k0 * rk * g2[0], k1 * rk * g2[1]);
        *(unsigned*)(ar + 384 + 2 * F.lane) = 0u;
    }
}

DI void phase_mla_post(const Frame& F, CArgs& A, int l) {
    const bf16_t* Z = (const bf16_t*)(A.ws + WS_Z); const bf16_t* RAW = (const bf16_t*)(A.ws + WS_QKVRAW);
    bf16_t* Q = (bf16_t*)(A.ws + WS_Q); bf16_t* K = (bf16_t*)(A.ws + WS_K); bf16_t* VT = (bf16_t*)(A.ws + WS_VT);
    LAS float* cs = (LAS float*)F.lds;
    LAS bf16_t* vt = (LAS bf16_t*)(F.lds + 8192);
    const float* qhg = A.in[32] + l * 96; const float* khg = A.in[33] + l * 96;
    for (int tile = F.bid; tile < T / 64; tile += F.G) {
        const int t0 = tile * 64, b = t0 / SEQ, s0 = t0 % SEQ;
        int tz = F.tid; asm volatile("" : "+v"(tz));
        for (int idx = tz; idx < 1024; idx += NTHR) { const int tok = idx >> 4, i = idx & 15;
            const int pos = A.pos_off[b] + s0 + tok; const float inv = powf(10000.f, -(float)i * (1.f / 16.f));
            double ang = (double)(float)pos * (double)inv; ang -= 6.283185307179586 * floor(ang * 0.15915494309189535);
            float sn, cn; sincosf((float)ang, &sn, &cn); cs[idx * 2] = cn; cs[idx * 2 + 1] = sn; }
        lds_barrier();
        const int tok = tz >> 3, sub = tz & 7, h = sub >> 1, isk = sub & 1, t = t0 + tok;
        {
            float v[96];
            const bf16_t* p0 = isk ? RAW + (size_t)t * 1024 + 384 + 128 * h : RAW + (size_t)t * 1024 + 96 * h;
            const bf16_t* p1 = isk ? Z + (size_t)t * ZS + ZC_KPE : p0 + 64;
#pragma unroll
            for (int c = 0; c < 8; ++c) { const u32x4 w = *(const u32x4*)(p0 + 8 * c);
                v[8 * c] = bflo(w.x); v[8 * c + 1] = bfhi(w.x); v[8 * c + 2] = bflo(w.y); v[8 * c + 3] = bfhi(w.y); v[8 * c + 4] = bflo(w.z); v[8 * c + 5] = bfhi(w.z); v[8 * c + 6] = bflo(w.w); v[8 * c + 7] = bfhi(w.w); }
#pragma unroll
            for (int c = 0; c < 4; ++c) { const u32x4 w = *(const u32x4*)(p1 + 8 * c);
                v[64 + 8 * c] = bflo(w.x); v[65 + 8 * c] = bfhi(w.x); v[66 + 8 * c] = bflo(w.y); v[67 + 8 * c] = bfhi(w.y); v[68 + 8 * c] = bflo(w.z); v[69 + 8 * c] = bfhi(w.z); v[70 + 8 * c] = bflo(w.w); v[71 + 8 * c] = bfhi(w.w); }
            float ss = 0.f;
#pragma unroll
            for (int i = 0; i < 96; ++i) ss += v[i] * v[i];
            const float r = rsqrtf(ss * (1.f / 96.f) + NORM_EPS);
            const float* hg = isk ? khg : qhg;
#pragma unroll
            for (int i = 0; i < 96; ++i) v[i] = v[i] * r * hg[i];
#pragma unroll
            for (int i = 0; i < 16; ++i) { const float cn = cs[(tok * 16 + i) * 2], sn = cs[(tok * 16 + i) * 2 + 1]; const float x1 = v[64 + i], x2 = v[80 + i];
                v[64 + i] = x1 * cn - x2 * sn; v[80 + i] = x1 * sn + x2 * cn; }
            bf16_t* dst = (isk ? K : Q) + ((size_t)t * 4 + h) * 96;
#pragma unroll
            for (int c = 0; c < 12; ++c) { u32x4 w; w.x = pk2(v[8 * c], v[8 * c + 1]); w.y = pk2(v[8 * c + 2], v[8 * c + 3]); w.z = pk2(v[8 * c + 4], v[8 * c + 5]); w.w = pk2(v[8 * c + 6], v[8 * c + 7]);
                *(u32x4*)(dst + 8 * c) = w; }
        }
        {
            const bf16_t* pv = RAW + (size_t)t * 1024 + 384 + 128 * h + 64 + 32 * isk;
#pragma unroll
            for (int c = 0; c < 4; ++c) { const u32x4 w = *(const u32x4*)(pv + 8 * c); const int r0 = h * 64 + 32 * isk + 8 * c;
                vt[(r0 + 0) * 72 + tok] = (bf16_t)(w.x & 0xffffu); vt[(r0 + 1) * 72 + tok] = (bf16_t)(w.x >> 16);
                vt[(r0 + 2) * 72 + tok] = (bf16_t)(w.y & 0xffffu); vt[(r0 + 3) * 72 + tok] = (bf16_t)(w.y >> 16);
                vt[(r0 + 4) * 72 + tok] = (bf16_t)(w.z & 0xffffu); vt[(r0 + 5) * 72 + tok] = (bf16_t)(w.z >> 16);
                vt[(r0 + 6) * 72 + tok] = (bf16_t)(w.w & 0xffffu); vt[(r0 + 7) * 72 + tok] = (bf16_t)(w.w >> 16); }
        }
        lds_barrier();
        { const int row = tz >> 1, hf = tz & 1;
          bf16_t* dst = VT + ((size_t)(b * 4) * 64 + row) * SEQ + s0 + 32 * hf;
#pragma unroll
          for (int c = 0; c < 4; ++c) *(u32x4*)(dst + 8 * c) = *(const LAS u32x4*)(vt + row * 72 + 32 * hf + 8 * c); }
        lds_barrier();
    }
}

DI void attn_unit(const Frame& F, const bf16_t* Q, const bf16_t* K, const bf16_t* VT, bf16_t* O, int bh, int u, float eoff) {
    constexpr int KP = 208, VP = 144, KB = 64 * KP, VB = 64 * VP;
    LAS unsigned char* Ks = F.lds; LAS unsigned char* Vs = F.lds + 2 * KB;
    int tz = F.tid; asm volatile("" : "+v"(tz));
    const int b = bh >> 2, h = bh & 3, lane = tz & 63, w = F.wave, ql = lane & 31, hh = lane >> 5;
    const int ntile = 8 * u + 8, myl = 8 * u + w;
    const size_t tq0 = (size_t)b * SEQ + 512 * u + 64 * w + ql;
    bf16x8 qf[2][6];
#pragma unroll
    for (int qt = 0; qt < 2; ++qt)
#pragma unroll
        for (int s = 0; s < 6; ++s) qf[qt][s] = *(const bf16x8*)(Q + ((tq0 + 32 * qt) * 4 + h) * 96 + 16 * s + 8 * hh);
    f32x16 ot[2][2];
#pragma unroll
    for (int i = 0; i < 16; ++i) { ot[0][0][i] = 0.f; ot[0][1][i] = 0.f; ot[1][0][i] = 0.f; ot[1][1][i] = 0.f; }
    float lrun[2] = {0.f, 0.f};
    const float c2 = 0.10206207261596577f * 1.4426950408889634f;
    const int kp0 = tz, kp1 = tz + 512;
    const size_t kbase = ((size_t)b * SEQ * 4 + h) * 96;
    const bf16_t* vsrc = VT + ((size_t)bh * 64 + (tz >> 3)) * SEQ + 8 * (tz & 7);
    u32x4 rk0, rk1, rv;
    rk1 = (u32x4){0u, 0u, 0u, 0u};
#define ATT_LOAD(j) do { rk0 = *(const u32x4*)(K + kbase + (size_t)(64 * (j) + kp0 / 12) * 384 + 8 * (kp0 % 12)); \
        if (kp1 < 768) rk1 = *(const u32x4*)(K + kbase + (size_t)(64 * (j) + kp1 / 12) * 384 + 8 * (kp1 % 12)); \
        rv = *(const u32x4*)(vsrc + 64 * (j)); } while (0)
#define ATT_STORE(buf) do { *(LAS u32x4*)(Ks + (buf) * KB + (kp0 / 12) * KP + (kp0 % 12) * 16) = rk0; \
        if (kp1 < 768) *(LAS u32x4*)(Ks + (buf) * KB + (kp1 / 12) * KP + (kp1 % 12) * 16) = rk1; \
        *(LAS u32x4*)(Vs + (buf) * VB + (tz >> 3) * VP + (tz & 7) * 16) = rv; } while (0)
    ATT_LOAD(0); ATT_STORE(0);
    lds_barrier();
    for (int j = 0; j < ntile; ++j) {
        const int buf = j & 1;
        if (j + 1 < ntile) ATT_LOAD(j + 1);
        if (j <= myl) {
            if (w >= 4) __builtin_amdgcn_s_sleep(6);
#pragma unroll
            for (int kt = 0; kt < 2; ++kt) {
                f32x16 st[2];
#pragma unroll
                for (int i = 0; i < 16; ++i) { st[0][i] = 0.f; st[1][i] = 0.f; }
#pragma unroll
                for (int s = 0; s < 6; ++s) { const bf16x8 kf = *(const LAS bf16x8*)(Ks + buf * KB + (32 * kt + ql) * KP + (16 * s + 8 * hh) * 2);
                    st[0] = __builtin_amdgcn_mfma_f32_32x32x16_bf16(kf, qf[0][s], st[0], 0, 0, 0);
                    st[1] = __builtin_amdgcn_mfma_f32_32x32x16_bf16(kf, qf[1][s], st[1], 0, 0, 0); }
                bf16x8 pf[2][2];
#pragma unroll
                for (int qt = 0; qt < 2; ++qt) { float ps = 0.f;
#pragma unroll
                    for (int i = 0; i < 16; ++i) { const float p = __builtin_amdgcn_exp2f(st[qt][i] * c2 - eoff); st[qt][i] = p; ps += p; }
                    lrun[qt] += ps;
#pragma unroll
                    for (int c = 0; c < 2; ++c) { u32x4 pw; pw.x = pk2(st[qt][8 * c], st[qt][8 * c + 1]); pw.y = pk2(st[qt][8 * c + 2], st[qt][8 * c + 3]); pw.z = pk2(st[qt][8 * c + 4], st[qt][8 * c + 5]); pw.w = pk2(st[qt][8 * c + 6], st[qt][8 * c + 7]);
                        pf[qt][c] = __builtin_bit_cast(bf16x8, pw); } }
#pragma unroll
                for (int c = 0; c < 2; ++c) {
                    const int key0 = 32 * kt + 16 * c + 4 * hh;
#pragma unroll
                    for (int dt = 0; dt < 2; ++dt) { const LAS unsigned char* vp = Vs + buf * VB + (32 * dt + ql) * VP + key0 * 2;
                        const u32x2 v0 = *(const LAS u32x2*)vp, v1 = *(const LAS u32x2*)(vp + 16);
                        u32x4 vw; vw.x = v0.x; vw.y = v0.y; vw.z = v1.x; vw.w = v1.y; const bf16x8 vf = __builtin_bit_cast(bf16x8, vw);
                        ot[dt][0] = __builtin_amdgcn_mfma_f32_32x32x16_bf16(vf, pf[0][c], ot[dt][0], 0, 0, 0);
                        ot[dt][1] = __builtin_amdgcn_mfma_f32_32x32x16_bf16(vf, pf[1][c], ot[dt][1], 0, 0, 0); }
                }
            }
        }
        if (j + 1 < ntile) ATT_STORE(buf ^ 1);
        lds_barrier();
    }
#undef ATT_LOAD
#undef ATT_STORE
#pragma unroll
    for (int qt = 0; qt < 2; ++qt) {
        const float linv = 1.f / (lrun[qt] + shfl_xor_l(lrun[qt], 32, lane));
        bf16_t* orow = O + (tq0 + 32 * qt) * 256 + h * 64;
#pragma unroll
        for (int dt = 0; dt < 2; ++dt)
#pragma unroll
            for (int g = 0; g < 4; ++g) { u32x2 o; o.x = pk2(ot[dt][qt][4 * g] * linv, ot[dt][qt][4 * g + 1] * linv); o.y = pk2(ot[dt][qt][4 * g + 2] * linv, ot[dt][qt][4 * g + 3] * linv);
                *(u32x2*)(orow + 32 * dt + 8 * g + 4 * hh) = o; }
    }
}
DI void phase_attn(const Frame& F, CArgs& A, int l) {
    const bf16_t* Q = (const bf16_t*)(A.ws + WS_Q); const bf16_t* K = (const bf16_t*)(A.ws + WS_K); const bf16_t* VT = (const bf16_t*)(A.ws + WS_VT);
    bf16_t* O = (bf16_t*)(A.ws + WS_ATTO);
    float gq = 0.f, gk = 0.f;
    for (int i = 0; i < 96; ++i) { gq = fmaxf(gq, fabsf(A.in[32][l * 96 + i])); gk = fmaxf(gk, fabsf(A.in[33][l * 96 + i])); }
    const float eoff = 96.f * gq * gk * 0.10206207261596577f * 1.4426950408889634f * 1.0001f;
    for (int p = F.bid; p < 256; p += F.G) { const int bh = p >> 3, u = p & 7;
        attn_unit(F, Q, K, VT, O, bh, 15 - u, eoff);
        attn_unit(F, Q, K, VT, O, bh, u, eoff); }
}
DI f32x16 mfma32(bf16x8 a, bf16x8 b, f32x16 c) { return __builtin_amdgcn_mfma_f32_32x32x16_bf16(a, b, c, 0, 0, 0); }
DI bf16x8 ldfrag(const LAS unsigned char* base, int row, int ks, int h) { return *(const LAS bf16x8*)(base + row * 144 + (16 * ks + 8 * h) * 2); }
DI f32x16 zero16() { f32x16 z;
#pragma unroll
    for (int i = 0; i < 16; ++i) z[i] = 0.f;
    return z; }
DI bf16x8 pack8(const f32x16& x, int o) { u32x4 p; p.x = pk2(x[o], x[o + 1]); p.y = pk2(x[o + 2], x[o + 3]); p.z = pk2(x[o + 4], x[o + 5]); p.w = pk2(x[o + 6], x[o + 7]); return __builtin_bit_cast(bf16x8, p); }
DI f32x16 tileprod(const LAS unsigned char* Aimg, int a0, const LAS unsigned char* Bimg, int b0, f32x16 acc, int lr, int h2) {
#pragma unroll
    for (int ks = 0; ks < 4; ++ks) acc = mfma32(ldfrag(Aimg, a0 + lr, ks, h2), ldfrag(Bimg, b0 + lr, ks, h2), acc);
    return acc;
}
DI void put_tile(LAS unsigned char* img, int c0, int r0, const f32x16& a, int lr, int h2) {
#pragma unroll
    for (int g = 0; g < 4; ++g) { u32x2 o; o.x = pk2(a[4 * g], a[4 * g + 1]); o.y = pk2(a[4 * g + 2], a[4 * g + 3]); *(LAS u32x2*)(img + (c0 + lr) * 144 + (r0 + 8 * g + 4 * h2) * 2) = o; }
}
DI void phase_rwkv_A(const Frame& F, CArgs& A, int l) {
    const bf16_t* Z = (const bf16_t*)(A.ws + WS_Z); bf16_t* V_ = (bf16_t*)(A.ws + WS_RW_V); bf16_t* G_ = (bf16_t*)(A.ws + WS_RW_G);
    const float* mu = A.in[7] + l * 896; const float* w0 = A.in[8] + l * 256; const float* a0 = A.in[10] + l * 256; const float* k_k = A.in[13] + l * 256; const float* k_a = A.in[14] + l * 256;
    const bf16_t* WO = (const bf16_t*)(A.ws + WS_WLORA) + (size_t)l * 32768;
    bf16_t* RP = (bf16_t*)(A.ws + WS_RC_RP); float* Y0T = (float*)(A.ws + WS_RC_Y0); unsigned char* REC = A.ws + WS_RC_G;
    float* BSUM = (float*)(A.ws + WS_RC_BS);
    const float* r_k = A.in[15] + l * 256;
    constexpr int TB = 64 * 144;
#define TILE(i) (F.lds + (i) * TB)
    LAS float* XF = (LAS float*)TILE(13);
    const int w = F.wave;
    for (int ub = F.bid; ub < 1024; ub += F.G) {
      const int b = ub >> 7, c = ub & 127;
      const size_t t0 = (size_t)b * SEQ + 64 * c;
      bf16x8 xf[4];
      {
        int tid = F.tid; asm volatile("" : "+v"(tid)); const int lane = tid & 63, fr = lane & 15, fq = lane >> 4, mt = w & 3;
        const int tk = 16 * mt + fr; const size_t t = t0 + tk; const bool hp = (64 * c + tk) > 0;
        const bf16_t* zr = Z + t * ZS + ZC_WLO + 8 * fq;
#pragma unroll
        for (int ks = 0; ks < 4; ++ks) {
            const u32x4 zc = *(const u32x4*)(zr + 32 * ks); u32x4 zp = {0u, 0u, 0u, 0u}; if (hp) zp = *(const u32x4*)(zr + 32 * ks - ZS);
            const f32x4 m0 = *(const f32x4*)(mu + ZC_WLO + 32 * ks + 8 * fq), m1 = *(const f32x4*)(mu + ZC_WLO + 32 * ks + 8 * fq + 4);
            const unsigned cw[4] = {zc.x, zc.y, zc.z, zc.w}, pw[4] = {zp.x, zp.y, zp.z, zp.w}; const float mm[8] = {m0[0], m0[1], m0[2], m0[3], m1[0], m1[1], m1[2], m1[3]};
            float v[8];
#pragma unroll
            for (int i = 0; i < 8; ++i) { const float zcv = (i & 1) ? bfhi(cw[i >> 1]) : bflo(cw[i >> 1]), zpv = (i & 1) ? bfhi(pw[i >> 1]) : bflo(pw[i >> 1]);
                float x = zcv + (zpv - zcv) * mm[i]; if (ks == 0) x = fast_tanh(x); else if (ks >= 2) x = sigmoidf_(x); v[i] = x; }
            u32x4 o; o.x = pk2(v[0], v[1]); o.y = pk2(v[2], v[3]); o.z = pk2(v[4], v[5]); o.w = pk2(v[6], v[7]); xf[ks] = __builtin_bit_cast(bf16x8, o);
        }
      }
      for (int hd = 0; hd < 4; ++hd) {
        const int u = (b * 4 + hd) * 128 + c;
        {
        int tid = F.tid; asm volatile("" : "+v"(tid)); const int lane = tid & 63, fr = lane & 15, fq = lane >> 4, mt = w & 3, nh = w >> 2;
        const int tk = 16 * mt + fr; const size_t t = t0 + tk; const bool hp = (64 * c + tk) > 0;
        LAS float* hs = (LAS float*)TILE(12);
        f32x4 aw[2], aa[2], ag[2];
        {
#pragma unroll
            for (int nf = 0; nf < 2; ++nf) { const int ch = hd * 64 + 32 * nh + 16 * nf + fr; const f32x4 z4 = {0.f, 0.f, 0.f, 0.f};
                aw[nf] = __builtin_amdgcn_mfma_f32_16x16x32_bf16(*(const bf16x8*)(WO + ch * 32 + 8 * fq), xf[0], z4, 0, 0, 0);
                aa[nf] = __builtin_amdgcn_mfma_f32_16x16x32_bf16(*(const bf16x8*)(WO + 8192 + ch * 32 + 8 * fq), xf[1], z4, 0, 0, 0);
                ag[nf] = __builtin_amdgcn_mfma_f32_16x16x32_bf16(*(const bf16x8*)(WO + 16384 + ch * 64 + 8 * fq), xf[2], z4, 0, 0, 0);
                ag[nf] = __builtin_amdgcn_mfma_f32_16x16x32_bf16(*(const bf16x8*)(WO + 16384 + ch * 64 + 32 + 8 * fq), xf[3], ag[nf], 0, 0, 0); }
        }
        f32x4 rr[2], kq[2], km[2], vv4[2], lw4[2], a4[2];
        float ssq = 0.f, bsp = 0.f;
#pragma unroll
        for (int nf = 0; nf < 2; ++nf) { const int d4 = 32 * nh + 16 * nf + 4 * fq, ch4 = hd * 64 + d4;
            const u32x2 rc = *(const u32x2*)(Z + t * ZS + ZC_R + ch4), kc = *(const u32x2*)(Z + t * ZS + ZC_K + ch4), vc = *(const u32x2*)(Z + t * ZS + ZC_V + ch4);
            u32x2 rp = {0u, 0u}, kp = {0u, 0u}, vp = {0u, 0u};
            if (hp) { rp = *(const u32x2*)(Z + (t - 1) * ZS + ZC_R + ch4); kp = *(const u32x2*)(Z + (t - 1) * ZS + ZC_K + ch4); vp = *(const u32x2*)(Z + (t - 1) * ZS + ZC_V + ch4); }
            const f32x4 mr = *(const f32x4*)(mu + ZC_R + ch4), mk = *(const f32x4*)(mu + ZC_K + ch4), mv = *(const f32x4*)(mu + ZC_V + ch4), ka = *(const f32x4*)(k_a + ch4), kkw = *(const f32x4*)(k_k + ch4), rk4 = *(const f32x4*)(r_k + ch4);
            const f32x4 rcv = {bflo(rc.x), bfhi(rc.x), bflo(rc.y), bfhi(rc.y)}, rpv = {bflo(rp.x), bfhi(rp.x), bflo(rp.y), bfhi(rp.y)};
            const f32x4 kcv = {bflo(kc.x), bfhi(kc.x), bflo(kc.y), bfhi(kc.y)}, kpv = {bflo(kp.x), bfhi(kp.x), bflo(kp.y), bfhi(kp.y)};
            const f32x4 vcv = {bflo(vc.x), bfhi(vc.x), bflo(vc.y), bfhi(vc.y)}, vpv = {bflo(vp.x), bfhi(vp.x), bflo(vp.y), bfhi(vp.y)};
            const f32x4 r = rcv + (rpv - rcv) * mr, k = kcv + (kpv - kcv) * mk, v = vcv + (vpv - vcv) * mv;
            const f32x4 wv = aw[nf] + *(const f32x4*)(w0 + ch4), av = aa[nf] + *(const f32x4*)(a0 + ch4);
#pragma unroll
            for (int i = 0; i < 4; ++i) { lw4[nf][i] = -__expf(-fast_softplus(-wv[i]) - 0.5f); a4[nf][i] = sigmoidf_(av[i]); kq[nf][i] = k[i] * kkw[i]; km[nf][i] = k[i] * (1.f + (a4[nf][i] - 1.f) * ka[i]);
                ssq += kq[nf][i] * kq[nf][i]; bsp += r[i] * km[nf][i] * rk4[i]; }
            rr[nf] = r; vv4[nf] = v;
            *(LAS f32x4*)(XF + tk * 64 + d4) = lw4[nf];
            u32x2 p; p.x = pk2(ag[nf][0], ag[nf][1]); p.y = pk2(ag[nf][2], ag[nf][3]); *(u32x2*)(G_ + t * 256 + ch4) = p;
            p.x = pk2(v[0], v[1]); p.y = pk2(v[2], v[3]); *(u32x2*)(V_ + t * 256 + ch4) = p;
        }
        ssq += shfl_xor_l(ssq, 16, lane); ssq += shfl_xor_l(ssq, 32, lane); bsp += shfl_xor_l(bsp, 16, lane); bsp += shfl_xor_l(bsp, 32, lane);
        if (fq == 0) { hs[nh * 64 + tk] = ssq; hs[128 + nh * 64 + tk] = bsp; }
        lds_barrier();
        if (w == 0) { float cv[64];
#pragma unroll
            for (int i = 0; i < 64; ++i) cv[i] = XF[i * 64 + lane];
            float run = 0.f;
#pragma unroll
            for (int i = 0; i < 64; ++i) { run += cv[i]; XF[i * 64 + lane] = run; } }
        if (w == 1) BSUM[(t0 + lane) * 4 + hd] = hs[128 + lane] + hs[192 + lane];
        lds_barrier();
        const float rn = rsqrtf(fmaxf(hs[tk] + hs[64 + tk], 1e-24f));
#pragma unroll
        for (int nf = 0; nf < 2; ++nf) { const int d4 = 32 * nh + 16 * nf + 4 * fq;
            const f32x4 cum = *(const LAS f32x4*)(XF + tk * 64 + d4), c63 = *(const LAS f32x4*)(XF + 63 * 64 + d4);
            f32x4 al, bt, kt, rb, bhh, khh;
#pragma unroll
            for (int i = 0; i < 4; ++i) { const float kk = kq[nf][i] * rn; const float ec = __expf(cum[i]), em = __builtin_amdgcn_rcpf(ec), ep = __expf(cum[i] - lw4[nf][i]), p63 = __expf(c63[i]);
                al[i] = -kk * ep; bt[i] = kk * a4[nf][i] * em; kt[i] = km[nf][i] * em; rb[i] = rr[nf][i] * ec; bhh[i] = bt[i] * p63; khh[i] = kt[i] * p63;
                if (tk == 63) *(float*)(REC + (size_t)u * RC_REC + 24576 + (d4 + i) * 4) = p63; }
            u32x2 o;
            o.x = pk2(al[0], al[1]); o.y = pk2(al[2], al[3]); *(LAS u32x2*)(TILE(0) + tk * 144 + d4 * 2) = o;
            o.x = pk2(bt[0], bt[1]); o.y = pk2(bt[2], bt[3]); *(LAS u32x2*)(TILE(1) + tk * 144 + d4 * 2) = o;
            o.x = pk2(kt[0], kt[1]); o.y = pk2(kt[2], kt[3]); *(LAS u32x2*)(TILE(2) + tk * 144 + d4 * 2) = o;
            o.x = pk2(rb[0], rb[1]); o.y = pk2(rb[2], rb[3]); *(LAS u32x2*)(TILE(3) + tk * 144 + d4 * 2) = o;
#pragma unroll
            for (int i = 0; i < 4; ++i) { *(LAS bf16_t*)(TILE(4) + (d4 + i) * 144 + tk * 2) = (bf16_t)f2bf(vv4[nf][i]); *(LAS bf16_t*)(TILE(5) + (d4 + i) * 144 + tk * 2) = (bf16_t)f2bf(bhh[i]);
                *(LAS bf16_t*)(TILE(6) + (d4 + i) * 144 + tk * 2) = (bf16_t)f2bf(khh[i]); *(LAS bf16_t*)(TILE(7) + (d4 + i) * 144 + tk * 2) = (bf16_t)f2bf(al[i]); }
        }
        }
        lds_barrier();
        f32x16 Tacc = zero16();
        {
        int tl = F.tid; asm volatile("" : "+v"(tl)); const int lane = tl & 63, lr = lane & 31, h2 = lane >> 5;
        unsigned zz = 0u; asm volatile("" : "+v"(zz));
        for (int i = tl; i < 768; i += NTHR) { const int q = i >> 7, rr = (i & 127) >> 2, cc = i & 3; const int tile = q < 4 ? 8 + q : q == 4 ? 14 : 12;
            *(LAS u32x4*)(TILE(tile) + (q == 5 ? (32 + rr) * 144 : rr * 144 + 64) + cc * 16) = (u32x4){zz, zz, zz, zz}; }
#pragma unroll
        for (int rnd = 0; rnd < 2; ++rnd) {
            const int j = w + 8 * rnd;
            if (j < 15) {
                const int prod = j / 3, tile = j % 3, si = tile == 2 ? 1 : 0, ti = tile == 0 ? 0 : 1;
                if (prod == 1) {
                    f32x16 acc = tileprod(TILE(0), 32 * ti, TILE(1), 32 * si, zero16(), lr, h2);
                    const int ss = 32 * si + lr;
#pragma unroll
                    for (int q = 0; q < 16; ++q) { const int tt = 32 * ti + 8 * (q >> 2) + 4 * h2 + (q & 3); if (!(ss < tt)) acc[q] = 0.f; }
                    put_tile(TILE(12), 32 * si, 32 * ti, acc, lr, h2);
                } else {
                    const LAS unsigned char* Ao = (prod == 0 || prod == 3) ? TILE(1) : TILE(2); const LAS unsigned char* Bo = prod >= 3 ? TILE(3) : TILE(0);
                    f32x16 acc = tileprod(Ao, 32 * si, Bo, 32 * ti, zero16(), lr, h2);
                    const int tt = 32 * ti + lr, incl = prod >= 3 ? 1 : 0;
#pragma unroll
                    for (int q = 0; q < 16; ++q) { const int ss = 32 * si + 8 * (q >> 2) + 4 * h2 + (q & 3); if (!(ss < tt + incl)) acc[q] = 0.f; }
                    if (prod == 0) { put_tile(TILE(11), 32 * ti, 32 * si, acc, lr, h2);
#pragma unroll
                        for (int q = 0; q < 16; ++q) { const int ss = 32 * si + 8 * (q >> 2) + 4 * h2 + (q & 3); Tacc[q] = acc[q] + (ss == tt ? 1.f : 0.f); }
                        put_tile(TILE(14), 32 * ti, 32 * si, Tacc, lr, h2);
                    } else put_tile(TILE(prod == 2 ? 8 : prod == 3 ? 9 : 10), 32 * ti, 32 * si, acc, lr, h2);
                }
            }
        }
        }
        lds_barrier();
        {
        int tl = F.tid; asm volatile("" : "+v"(tl)); const int lane = tl & 63, lr = lane & 31, h2 = lane >> 5;
        if (tl < 384) { const int q = tl >> 7, rr = (tl & 127) >> 2, cc = tl & 3;
            unsigned zz = 0u; asm volatile("" : "+v"(zz));
            *(LAS u32x4*)(TILE(q) + (q == 1 ? (32 + rr) * 144 : rr * 144 + 64) + cc * 16) = (u32x4){zz, zz, zz, zz}; }
        lds_barrier();
#pragma unroll
        for (int k = 1; k <= 5; ++k) {
            LAS unsigned char* Ss = (k & 1) ? TILE(11) : TILE(0); LAS unsigned char* STs = (k & 1) ? TILE(12) : TILE(1);
            LAS unsigned char* Sd = (k & 1) ? TILE(0) : TILE(11); LAS unsigned char* STd = (k & 1) ? TILE(1) : TILE(12);
            LAS unsigned char* Ts = (k & 1) ? TILE(14) : TILE(2); LAS unsigned char* Td = (k & 1) ? TILE(2) : TILE(14);
            if (w < 6) { const int tile = w % 3, ti = tile == 0 ? 0 : 1, si = tile == 2 ? 1 : 0;
                if (w < 3) { f32x16 acc = tileprod(Ss, 32 * ti, STs, 32 * si, zero16(), lr, h2); put_tile(STd, 32 * si, 32 * ti, acc, lr, h2); }
                else { f32x16 acc = tileprod(STs, 32 * si, Ss, 32 * ti, zero16(), lr, h2); put_tile(Sd, 32 * ti, 32 * si, acc, lr, h2); }
            } else if (k == 1) {
#pragma unroll
                for (int jj = 0; jj < 2; ++jj) { const int tile = (w - 6) * 2 + jj, ti = tile >> 1, ei = tile & 1;
                    f32x16 acc = tileprod(TILE(8), 32 * ti, TILE(4), 32 * ei, zero16(), lr, h2); put_tile(TILE(13), 32 * ei, 32 * ti, acc, lr, h2); }
            }
            lds_barrier();
            if (w < 3) { const int si = w == 2 ? 1 : 0, ti = w == 0 ? 0 : 1;
                Tacc = tileprod(STd, 32 * si, Ts, 32 * ti, Tacc, lr, h2); put_tile(Td, 32 * ti, 32 * si, Tacc, lr, h2); }
        }
        lds_barrier();
        { const int tile = w & 3, ti = tile >> 1, ci = tile & 1;
          f32x16 acc = tileprod(TILE(2), 32 * ti, w < 4 ? TILE(13) : TILE(7), 32 * ci, zero16(), lr, h2); put_tile(w < 4 ? TILE(11) : TILE(12), 32 * ci, 32 * ti, acc, lr, h2); }
        }
        lds_barrier();
        {
        int tl = F.tid; asm volatile("" : "+v"(tl)); const int lane = tl & 63, lr = lane & 31, h2 = lane >> 5; const int tj = w & 3, ta = tj >> 1, tb = tj & 1;
        if (w < 4) {
            { f32x16 acc = tileprod(TILE(12), 32 * ta, TILE(9), 32 * tb, zero16(), lr, h2);
              const int tt = 32 * tb + lr;
#pragma unroll
              for (int g = 0; g < 4; ++g) { const int dd = 32 * ta + 8 * g + 4 * h2; const u32x2 rbv = *(const LAS u32x2*)(TILE(3) + tt * 144 + dd * 2);
                  u32x2 o; o.x = pk2(acc[4 * g] + bflo(rbv.x), acc[4 * g + 1] + bfhi(rbv.x)); o.y = pk2(acc[4 * g + 2] + bflo(rbv.y), acc[4 * g + 3] + bfhi(rbv.y));
                  *(u32x2*)(RP + ((size_t)u * 64 + tt) * 64 + dd) = o; } }
            { f32x16 acc = tileprod(TILE(12), 32 * ta, TILE(5), 32 * tb, zero16(), lr, h2);
              const int dcol = 32 * tb + lr;
#pragma unroll
              for (int g = 0; g < 4; ++g) { u32x2 o; o.x = pk2(acc[4 * g], acc[4 * g + 1]); o.y = pk2(acc[4 * g + 2], acc[4 * g + 3]);
                  *(u32x2*)(REC + (size_t)u * RC_REC + ((((dcol >> 4) * 2 + ta) * 64 + (2 * (g & 1) + h2) * 16 + (dcol & 15)) * 16) + 8 * (g >> 1)) = o; } }
        } else {
            f32x16 z2 = tileprod(TILE(4), 32 * ta, TILE(10), 32 * tb, zero16(), lr, h2);
            z2 = tileprod(TILE(11), 32 * ta, TILE(9), 32 * tb, z2, lr, h2);
            float* yo = Y0T + ((size_t)u * 64 + 32 * tb + lr) * 64 + 32 * ta + 4 * h2;
#pragma unroll
            for (int g = 0; g < 4; ++g) *(f32x4*)(yo + 8 * g) = (f32x4){z2[4 * g], z2[4 * g + 1], z2[4 * g + 2], z2[4 * g + 3]};
            f32x16 acc = tileprod(TILE(5), 32 * ta, TILE(11), 32 * tb, zero16(), lr, h2);
            acc = tileprod(TILE(6), 32 * ta, TILE(4), 32 * tb, acc, lr, h2);
            const int ecol = 32 * tb + lr;
#pragma unroll
            for (int g = 0; g < 4; ++g) *(f32x4*)(REC + (size_t)u * RC_REC + 8192 + ((((ecol >> 4) * 4 + 2 * ta + (g >> 1)) * 64 + (2 * (g & 1) + h2) * 16 + (ecol & 15)) * 16)) = (f32x4){acc[4 * g], acc[4 * g + 1], acc[4 * g + 2], acc[4 * g + 3]};
        }
        }
        lds_barrier();
      }
    }
#undef TILE
}
DI void phase_rwkv_B(const Frame& F, CArgs& A) {
    if (F.bid >= 32) return;
    const unsigned char* REC = A.ws + WS_RC_G; bf16_t* HB = (bf16_t*)(A.ws + WS_RC_HB);
    constexpr int SLOT = 25600, NSLOT = 6;
    const int bh = F.bid, w = F.wave, lane = F.lane, fr = lane & 15, fq = lane >> 4;
    const unsigned char* rec0 = REC + (size_t)bh * 128 * RC_REC;
    if (w >= 4) {
        const int lw = w - 4;
#define RB_ISSUE2(cs, cr) do { const unsigned char* r_ = rec0 + (size_t)(cr) * RC_REC; LAS unsigned char* s_ = F.lds + ((cs) % NSLOT) * SLOT; \
        _Pragma("unroll") for (int k = 0; k < 6; ++k) __builtin_amdgcn_global_load_lds((const unsigned*)(r_ + (lw + 4 * k) * 1024 + lane * 16), (LAS unsigned*)(s_ + (lw + 4 * k) * 1024), 16, 0, 0); \
        if (lw == 3) __builtin_amdgcn_global_load_lds((const unsigned*)(r_ + 24576 + lane * 4), (LAS unsigned*)(s_ + 24576), 4, 0, 0); } while (0)
        RB_ISSUE2(0, 0); RB_ISSUE2(1, 1); RB_ISSUE2(2, 2); RB_ISSUE2(3, 3); RB_ISSUE2(4, 4);
        if (lw == 3) asm volatile("s_waitcnt vmcnt(28)" ::: "memory"); else asm volatile("s_waitcnt vmcnt(24)" ::: "memory");
        __builtin_amdgcn_s_barrier();
        for (int c = 0; c < 128; ++c) {
            RB_ISSUE2(c + 5, (c + 5 < 128) ? c + 5 : 127);
            if (lw == 3) asm volatile("s_waitcnt vmcnt(28)" ::: "memory"); else asm volatile("s_waitcnt vmcnt(24)" ::: "memory");
            __builtin_amdgcn_s_barrier();
        }
        asm volatile("s_waitcnt vmcnt(0)" ::: "memory");
#undef RB_ISSUE2
    } else {
        const int ew = w;
        f32x4 acc[4];
#pragma unroll
        for (int dt = 0; dt < 4; ++dt) acc[dt] = (f32x4){0.f, 0.f, 0.f, 0.f};
        __builtin_amdgcn_s_barrier();
        for (int c = 0; c < 128; ++c) {
            const size_t u = (size_t)bh * 128 + c;
            const LAS unsigned char* sl = F.lds + (c % NSLOT) * SLOT;
            bf16x8 hb[2];
#pragma unroll
            for (int sk = 0; sk < 2; ++sk) { u32x4 p; p.x = pk2(acc[2 * sk][0], acc[2 * sk][1]); p.y = pk2(acc[2 * sk][2], acc[2 * sk][3]); p.z = pk2(acc[2 * sk + 1][0], acc[2 * sk + 1][1]); p.w = pk2(acc[2 * sk + 1][2], acc[2 * sk + 1][3]);
                hb[sk] = __builtin_bit_cast(bf16x8, p); *(bf16x8*)(HB + (((u * 4 + ew) * 2 + sk) * 64 + lane) * 8) = hb[sk]; }
#pragma unroll
            for (int dt = 0; dt < 4; ++dt) {
                const f32x4 g4 = *(const LAS f32x4*)(sl + 8192 + ((ew * 4 + dt) * 64 + lane) * 16), d4 = *(const LAS f32x4*)(sl + 24576 + (16 * dt + 4 * fq) * 4);
                const bf16x8 m0 = *(const LAS bf16x8*)(sl + ((dt * 2 + 0) * 64 + lane) * 16), m1 = *(const LAS bf16x8*)(sl + ((dt * 2 + 1) * 64 + lane) * 16);
                f32x4 n = d4 * acc[dt] + g4;
                n = __builtin_amdgcn_mfma_f32_16x16x32_bf16(m0, hb[0], n, 0, 0, 0); n = __builtin_amdgcn_mfma_f32_16x16x32_bf16(m1, hb[1], n, 0, 0, 0); acc[dt] = n; }
            asm volatile("s_waitcnt lgkmcnt(0)" ::: "memory");
            __builtin_amdgcn_s_barrier();
        }
    }
}
DI void phase_rwkv_C(const Frame& F, CArgs& A, int l) {
    const bf16_t* RP = (const bf16_t*)(A.ws + WS_RC_RP); const float* Y0 = (const float*)(A.ws + WS_RC_Y0); const bf16_t* HB = (const bf16_t*)(A.ws + WS_RC_HB); const float* BSUM = (const float*)(A.ws + WS_RC_BS);
    const bf16_t* V_ = (const bf16_t*)(A.ws + WS_RW_V); const bf16_t* G_ = (const bf16_t*)(A.ws + WS_RW_G); bf16_t* MIX = (bf16_t*)(A.ws + WS_MIX);
    const float* ln_w = A.in[16] + l * 256; const float* ln_b = A.in[17] + l * 256;
    for (int job = F.gw; job < 4096; job += F.ngw) {
        int lz = F.lane; asm volatile("" : "+v"(lz)); const int lane = lz, fr = lane & 15, fq = lane >> 4;
        const size_t u = (size_t)job; const int bh = job >> 7, c = job & 127, b = bh >> 2, hd = bh & 3;
        bf16x8 hf[4][2];
#pragma unroll
        for (int et = 0; et < 4; ++et)
#pragma unroll
            for (int sk = 0; sk < 2; ++sk) hf[et][sk] = *(const bf16x8*)(HB + (((u * 4 + et) * 2 + sk) * 64 + lane) * 8);
#pragma unroll
        for (int tb = 0; tb < 4; ++tb) {
            const size_t tok = (size_t)b * SEQ + 64 * c + 16 * tb + fr;
            const bf16_t* rrow = RP + (u * 64 + 16 * tb + fr) * 64 + 4 * fq;
            bf16x8 bfr[2];
#pragma unroll
            for (int sk = 0; sk < 2; ++sk) { const u32x2 m0 = *(const u32x2*)(rrow + 32 * sk), m1 = *(const u32x2*)(rrow + 32 * sk + 16); u32x4 mw; mw.x = m0.x; mw.y = m0.y; mw.z = m1.x; mw.w = m1.y; bfr[sk] = __builtin_bit_cast(bf16x8, mw); }
            f32x4 y[4]; float sm = 0.f;
#pragma unroll
            for (int et = 0; et < 4; ++et) { y[et] = *(const f32x4*)(Y0 + (u * 64 + 16 * tb + fr) * 64 + 16 * et + 4 * fq);
                y[et] = __builtin_amdgcn_mfma_f32_16x16x32_bf16(hf[et][0], bfr[0], y[et], 0, 0, 0); y[et] = __builtin_amdgcn_mfma_f32_16x16x32_bf16(hf[et][1], bfr[1], y[et], 0, 0, 0); }
#pragma unroll
            for (int et = 0; et < 4; ++et) sm += (y[et][0] + y[et][1]) + (y[et][2] + y[et][3]);
            sm += shfl_xor_l(sm, 16, lane); sm += shfl_xor_l(sm, 32, lane); const float mean = sm * (1.f / 64.f);
            float sq = 0.f;
#pragma unroll
            for (int et = 0; et < 4; ++et) { const f32x4 d = y[et] - mean; sq += (d[0] * d[0] + d[1] * d[1]) + (d[2] * d[2] + d[3] * d[3]); }
            sq += shfl_xor_l(sq, 16, lane); sq += shfl_xor_l(sq, 32, lane); const float rstd = rsqrtf(sq * (1.f / 64.f) + 64e-5f);
            const float bs = BSUM[tok * 4 + hd];
#pragma unroll
            for (int et = 0; et < 4; ++et) { const int e0 = hd * 64 + 16 * et + 4 * fq;
                const f32x4 lw = *(const f32x4*)(ln_w + e0), lb = *(const f32x4*)(ln_b + e0);
                const u32x2 vv = *(const u32x2*)(V_ + tok * 256 + e0), gv = *(const u32x2*)(G_ + tok * 256 + e0);
                const float o0 = ((y[et][0] - mean) * rstd * lw[0] + lb[0] + bs * bflo(vv.x)) * bflo(gv.x), o1 = ((y[et][1] - mean) * rstd * lw[1] + lb[1] + bs * bfhi(vv.x)) * bfhi(gv.x);
                const float o2 = ((y[et][2] - mean) * rstd * lw[2] + lb[2] + bs * bflo(vv.y)) * bflo(gv.y), o3 = ((y[et][3] - mean) * rstd * lw[3] + lb[3] + bs * bfhi(vv.y)) * bfhi(gv.y);
                u32x2 o; o.x = pk2(o0, o1); o.y = pk2(o2, o3);
                *(u32x2*)(MIX + tok * DM + e0) = o; }
        }
    }
}

template <int PASS>
DI void phase_s5(const Frame& F, CArgs& A, int l) {
    const bf16_t* Z = (const bf16_t*)(A.ws + WS_Z); float* SEND = (float*)(A.ws + WS_S5END); bf16_t* YS = (bf16_t*)(A.ws + WS_YS5);
    const bf16_t* BBt = (const bf16_t*)(A.ws + WS_S5BB); const bf16_t* CCt = (const bf16_t*)(A.ws + WS_S5CC);
    LAS unsigned char* himg = F.lds + F.wave * 17408;
    for (int it = F.gw; it < 8 * 16 * 16; it += F.ngw) {
        int lz = F.lane; asm volatile("" : "+v"(lz)); const int lane = lz, lr = lane & 31, hh = lane >> 5;
        const int b = it >> 8, g = (it >> 4) & 15, seg = it & 15, lg = l * 16 + g;
        const float dt = __expf(A.in[25][lg]);
        float are[2], aim[2], cr[2], ci[2];
        bf16x8 bbf[2][2];
#pragma unroll
        for (int st = 0; st < 2; ++st) { const int p = 32 * st + lr;
            const float lre = A.in[18][lg * 64 + p], lim = A.in[19][lg * 64 + p]; const float mag = expf(lre * dt); float sn, cn; sincosf(lim * dt, &sn, &cn); are[st] = mag * cn; aim[st] = mag * sn;
            cr[st] = 0.f; ci[st] = 0.f;
            if (PASS == 2) { const float m512 = expf(512.f * lre * dt); float s5, c5; sincosf(512.f * (lim * dt), &s5, &c5); const float pr = m512 * c5, pi_ = m512 * s5;
                for (int j = 0; j < seg; ++j) { const float* e = SEND + ((size_t)((b * 16 + g) * 16 + j)) * 128; const float er = e[p], ei = e[64 + p];
                    const float nr = pr * cr[st] - pi_ * ci[st] + er, ni = pr * ci[st] + pi_ * cr[st] + ei; cr[st] = nr; ci[st] = ni; } }
#pragma unroll
            for (int part = 0; part < 2; ++part) bbf[part][st] = *(const bf16x8*)(BBt + (((size_t)lg * 2 + part) * 64 + p) * 16 + 8 * hh); }
        bf16x8 ccf[4];
        if (PASS == 2) {
#pragma unroll
            for (int ks = 0; ks < 4; ++ks) ccf[ks] = *(const bf16x8*)(CCt + ((size_t)lg * 16 + (lane & 15)) * 128 + 32 * ks + 8 * (lane >> 4)); }
        for (int ch = 0; ch < 8; ++ch) {
            const size_t tok0 = (size_t)b * SEQ + seg * 512 + ch * 64;
#pragma unroll
            for (int tk = 0; tk < 2; ++tk) {
                const bf16x8 uf = *(const bf16x8*)(Z + (tok0 + 32 * tk + lr) * ZS + ZC_S5 + g * 16 + 8 * hh);
                f32x16 xr[2], xi[2];
#pragma unroll
                for (int st = 0; st < 2; ++st) { xr[st] = mfma32(uf, bbf[0][st], zero16()); xi[st] = mfma32(uf, bbf[1][st], zero16()); }
                asm volatile("s_nop 15\n\ts_nop 15" : "+v"(xr[0]), "+v"(xi[0]), "+v"(xr[1]), "+v"(xi[1]));
#pragma unroll
                for (int j = 0; j < 4; ++j) {
#pragma unroll
                    for (int half = 0; half < 2; ++half) {
                        const bool act = (hh == half);
#pragma unroll
                        for (int st = 0; st < 2; ++st) { float tr = cr[st], ti = ci[st];
#pragma unroll
                            for (int q = 0; q < 4; ++q) { const float nr = are[st] * tr - aim[st] * ti + xr[st][4 * j + q], ni = are[st] * ti + aim[st] * tr + xi[st][4 * j + q];
                                tr = nr; ti = ni; xr[st][4 * j + q] = act ? nr : xr[st][4 * j + q]; xi[st][4 * j + q] = act ? ni : xi[st][4 * j + q]; }
                            const float pr = shfl_xor_l(tr, 32, lane), pi2 = shfl_xor_l(ti, 32, lane);
                            cr[st] = act ? tr : pr; ci[st] = act ? ti : pi2; }
                    }
                }
                if (PASS == 2) {
                    unsigned hb = (unsigned)(uintptr_t)(himg + (4 * hh) * 272 + lr * 2); asm volatile("" : "+v"(hb));
                    LAS unsigned char* hp = (LAS unsigned char*)(uintptr_t)hb;
#pragma unroll
                    for (int st = 0; st < 2; ++st)
#pragma unroll
                        for (int q = 0; q < 16; ++q) { const int trow = 32 * tk + 8 * (q >> 2) + (q & 3);
                            *(LAS bf16_t*)(hp + trow * 272 + 64 * st) = (bf16_t)f2bf(xr[st][q]); *(LAS bf16_t*)(hp + trow * 272 + 128 + 64 * st) = (bf16_t)f2bf(xi[st][q]); }
                }
            }
            if (PASS == 2) {
                asm volatile("s_waitcnt lgkmcnt(0)" ::: "memory");
                const int fr = lane & 15, fq = lane >> 4;
                unsigned rb = (unsigned)(uintptr_t)(himg + fr * 272 + fq * 16); asm volatile("" : "+v"(rb)); const LAS unsigned char* rp = (const LAS unsigned char*)(uintptr_t)rb;
#pragma unroll
                for (int m = 0; m < 4; ++m) { f32x4 acc = {0.f, 0.f, 0.f, 0.f};
#pragma unroll
                    for (int ks = 0; ks < 4; ++ks) acc = __builtin_amdgcn_mfma_f32_16x16x32_bf16(ccf[ks], *(const LAS bf16x8*)(rp + (16 * m) * 272 + 64 * ks), acc, 0, 0, 0);
                    const size_t tok = tok0 + 16 * m + fr;
                    const u32x2 uu = *(const u32x2*)(Z + tok * ZS + ZC_S5 + g * 16 + 4 * fq);
                    const f32x4 dd = *(const f32x4*)(A.in[24] + l * 256 + g * 16 + 4 * fq);
                    u32x2 o; o.x = pk2(gelu_tanh(acc[0] + dd[0] * bflo(uu.x)), gelu_tanh(acc[1] + dd[1] * bfhi(uu.x))); o.y = pk2(gelu_tanh(acc[2] + dd[2] * bflo(uu.y)), gelu_tanh(acc[3] + dd[3] * bfhi(uu.y)));
                    *(u32x2*)(YS + tok * 256 + g * 16 + 4 * fq) = o; }
                asm volatile("s_waitcnt lgkmcnt(0)" ::: "memory");
            }
        }
        if (PASS == 1 && hh == 1) {
#pragma unroll
            for (int st = 0; st < 2; ++st) { float* e = SEND + ((size_t)((b * 16 + g) * 16 + seg)) * 128; e[32 * st + lr] = cr[st]; e[64 + 32 * st + lr] = ci[st]; } }
    }
}

DI void phase_lru_prep(const Frame& F, CArgs& A, int l) {
    const bf16_t* Z = (const bf16_t*)(A.ws + WS_Z); float* LA = (float*)(A.ws + WS_LA); float* LB = (float*)(A.ws + WS_LB);
    const float* cw = A.in[34] + l * 4 * 256; const float* cb = A.in[35] + l * 256; const float* ba = A.in[37] + l * 256; const float* bx = A.in[39] + l * 256; const float* lam = A.in[40] + l * 256;
    const bf16_t* WL = (const bf16_t*)(A.ws + WS_WLRU) + (size_t)l * 2 * 4 * 4096;
    LAS float* xs = (LAS float*)F.lds;
    const int w = F.wave, n = w >> 1, hf = w & 1;
    bf16x8 waf[2][2], wxf[2][2];
    { const int fr = F.lane & 15, fq = F.lane >> 4;
#pragma unroll
      for (int nf = 0; nf < 2; ++nf)
#pragma unroll
          for (int ks = 0; ks < 2; ++ks) { const int j = 32 * hf + 16 * nf + fr;
              waf[nf][ks] = *(const bf16x8*)(WL + ((size_t)(0 * 4 + n) * 64 + j) * 64 + 32 * ks + 8 * fq); wxf[nf][ks] = *(const bf16x8*)(WL + ((size_t)(1 * 4 + n) * 64 + j) * 64 + 32 * ks + 8 * fq); } }
    f32x4 c_ba[2], c_bx[2], c_sp[2];
    { const int fq0 = F.lane >> 4;
#pragma unroll
      for (int nf = 0; nf < 2; ++nf) { const int ch4 = n * 64 + 32 * hf + 16 * nf + 4 * fq0; c_ba[nf] = *(const f32x4*)(ba + ch4); c_bx[nf] = *(const f32x4*)(bx + ch4); const f32x4 lm = *(const f32x4*)(lam + ch4);
#pragma unroll
          for (int i = 0; i < 4; ++i) c_sp[nf][i] = -8.f * softplusf_(-lm[i]); } }
    for (int tile = F.bid; tile < T / 64; tile += F.G) {
        int tz = F.tid; asm volatile("" : "+v"(tz)); const int lane = tz & 63, fr = lane & 15, fq = lane >> 4;
        const int t0 = tile * 64, s0 = t0 % SEQ;
        f32x4 accA[4][2], accX[4][2];
#pragma unroll
        for (int m = 0; m < 4; ++m) {
            const int tok = 16 * m + fr, sq = s0 + tok;
            bf16x8 xf[2];
#pragma unroll
            for (int ks = 0; ks < 2; ++ks) { const int ch0 = n * 64 + 32 * ks + 8 * fq;
                const f32x4 b0 = *(const f32x4*)(cb + ch0), b1 = *(const f32x4*)(cb + ch0 + 4);
                float xc[8] = {b0[0], b0[1], b0[2], b0[3], b1[0], b1[1], b1[2], b1[3]};
#pragma unroll
                for (int j = 0; j < 4; ++j) if (sq - 3 + j >= 0) {
                    const u32x4 z8 = *(const u32x4*)(Z + (size_t)(t0 + tok - 3 + j) * ZS + ZC_LX + ch0);
                    const f32x4 c0 = *(const f32x4*)(cw + j * 256 + ch0), c1 = *(const f32x4*)(cw + j * 256 + ch0 + 4);
                    xc[0] += c0[0] * bflo(z8.x); xc[1] += c0[1] * bfhi(z8.x); xc[2] += c0[2] * bflo(z8.y); xc[3] += c0[3] * bfhi(z8.y);
                    xc[4] += c1[0] * bflo(z8.z); xc[5] += c1[1] * bfhi(z8.z); xc[6] += c1[2] * bflo(z8.w); xc[7] += c1[3] * bfhi(z8.w); }
                u32x4 o; o.x = pk2(xc[0], xc[1]); o.y = pk2(xc[2], xc[3]); o.z = pk2(xc[4], xc[5]); o.w = pk2(xc[6], xc[7]); xf[ks] = __builtin_bit_cast(bf16x8, o);
                if (hf == 0) { *(LAS f32x4*)(xs + tok * 260 + ch0) = (f32x4){xc[0], xc[1], xc[2], xc[3]}; *(LAS f32x4*)(xs + tok * 260 + ch0 + 4) = (f32x4){xc[4], xc[5], xc[6], xc[7]}; }
            }
#pragma unroll
            for (int nf = 0; nf < 2; ++nf) { const f32x4 z4 = {0.f, 0.f, 0.f, 0.f};
                accA[m][nf] = __builtin_amdgcn_mfma_f32_16x16x32_bf16(waf[nf][0], xf[0], z4, 0, 0, 0); accA[m][nf] = __builtin_amdgcn_mfma_f32_16x16x32_bf16(waf[nf][1], xf[1], accA[m][nf], 0, 0, 0);
                accX[m][nf] = __builtin_amdgcn_mfma_f32_16x16x32_bf16(wxf[nf][0], xf[0], z4, 0, 0, 0); accX[m][nf] = __builtin_amdgcn_mfma_f32_16x16x32_bf16(wxf[nf][1], xf[1], accX[m][nf], 0, 0, 0); }
        }
        lds_barrier();
#pragma unroll
        for (int m = 0; m < 4; ++m)
#pragma unroll
            for (int nf = 0; nf < 2; ++nf) { const int tok = 16 * m + fr, ch4 = n * 64 + 32 * hf + 16 * nf + 4 * fq;
                const f32x4 xc = *(const LAS f32x4*)(xs + tok * 260 + ch4);
                f32x4 av, bv;
#pragma unroll
                for (int i = 0; i < 4; ++i) { const float r = sigmoidf_(accA[m][nf][i] + c_ba[nf][i]), ig = sigmoidf_(accX[m][nf][i] + c_bx[nf][i]); const float log_a = r * c_sp[nf][i];
                    const float x2 = 2.f * log_a; float em1 = __expf(x2) - 1.f; if (x2 > -0.25f) em1 = x2 * (1.f + x2 * (0.5f + x2 * (0.16666667f + x2 * (0.041666668f + x2 * 0.008333334f))));
                    av[i] = __expf(log_a); bv[i] = __builtin_amdgcn_sqrtf(-em1) * (ig * xc[i]); }
                *(f32x4*)(LA + (size_t)(t0 + tok) * 256 + ch4) = av; *(f32x4*)(LB + (size_t)(t0 + tok) * 256 + ch4) = bv; }
        lds_barrier();
    }
}
DI void phase_lru_sum(const Frame& F, CArgs& A) {
    const float* LA = (const float*)(A.ws + WS_LA); const float* LB = (const float*)(A.ws + WS_LB); float* LS = (float*)(A.ws + WS_LSUM);
    for (int it = F.gw; it < 8 * 128; it += F.ngw) {
        const size_t r0 = (size_t)it * 64;
        f32x4 Ap = {1.f, 1.f, 1.f, 1.f}, Bp = {0.f, 0.f, 0.f, 0.f};
#pragma unroll 8
        for (int t = 0; t < 64; ++t) { const f32x4 a = *(const f32x4*)(LA + (r0 + t) * 256 + 4 * F.lane), bb = *(const f32x4*)(LB + (r0 + t) * 256 + 4 * F.lane); Bp = a * Bp + bb; Ap = Ap * a; }
        *(f32x4*)(LS + ((size_t)it * 2) * 256 + 4 * F.lane) = Ap; *(f32x4*)(LS + ((size_t)it * 2 + 1) * 256 + 4 * F.lane) = Bp;
    }
}
DI void phase_lru_fin(const Frame& F, CArgs& A, int l) {
    const float* LA = (const float*)(A.ws + WS_LA); const float* LB = (const float*)(A.ws + WS_LB); const float* LS = (const float*)(A.ws + WS_LSUM);
    const bf16_t* Z = (const bf16_t*)(A.ws + WS_Z); bf16_t* MIX = (bf16_t*)(A.ws + WS_MIX);
    const f32x4 bg = *(const f32x4*)(A.in[41] + l * 768 + 512 + 4 * F.lane);
    for (int it = F.gw; it < 8 * 128; it += F.ngw) {
        const int b = it >> 7, c = it & 127;
        f32x4 h = {0.f, 0.f, 0.f, 0.f};
        for (int j0 = 0; j0 < c; j0 += 8) {
            f32x4 sa[8], sb[8];
#pragma unroll
            for (int q = 0; q < 8; ++q) { const int j = (j0 + q < c) ? j0 + q : c - 1; sa[q] = *(const f32x4*)(LS + ((size_t)(b * 128 + j) * 2) * 256 + 4 * F.lane); sb[q] = *(const f32x4*)(LS + ((size_t)(b * 128 + j) * 2 + 1) * 256 + 4 * F.lane); }
#pragma unroll
            for (int q = 0; q < 8; ++q) if (j0 + q < c) h = sa[q] * h + sb[q]; }
        const size_t r0 = (size_t)it * 64;
        for (int t0 = 0; t0 < 64; t0 += 8) {
            f32x4 y[8]; float ss[8];
#pragma unroll
            for (int q = 0; q < 8; ++q) { const size_t r = r0 + t0 + q;
                const f32x4 a = *(const f32x4*)(LA + r * 256 + 4 * F.lane), bb = *(const f32x4*)(LB + r * 256 + 4 * F.lane); h = a * h + bb;
                const u32x2 gz = *(const u32x2*)(Z + r * ZS + ZC_LG + 4 * F.lane);
                y[q] = (f32x4){h[0] * gelu_tanh(bflo(gz.x)), h[1] * gelu_tanh(bfhi(gz.x)), h[2] * gelu_tanh(bflo(gz.y)), h[3] * gelu_tanh(bfhi(gz.y))};
                ss[q] = y[q][0] * y[q][0] + y[q][1] * y[q][1] + y[q][2] * y[q][2] + y[q][3] * y[q][3]; }
            const int ln = lane_opaque();
#pragma unroll
            for (int o = 1; o < 64; o <<= 1) {
#pragma unroll
                for (int q = 0; q < 8; ++q) ss[q] += shfl_xor_l(ss[q], o, ln); }
#pragma unroll
            for (int q = 0; q < 8; ++q) { const float r = rsqrtf(ss[q] * (1.f / 256.f) + NORM_EPS);
                u32x2 o; o.x = pk2(y[q][0] * r * bg[0], y[q][1] * r * bg[1]); o.y = pk2(y[q][2] * r * bg[2], y[q][3] * r * bg[3]);
                *(u32x2*)(MIX + (r0 + t0 + q) * DM + 768 + 4 * F.lane) = o; }
        }
    }
}

DI void phase_branch_norm(const Frame& F, CArgs& A, int l) {
    const bf16_t* S0 = (const bf16_t*)(A.ws + WS_YS5G); const bf16_t* S1 = (const bf16_t*)(A.ws + WS_ATTO);
    bf16_t* MIX = (bf16_t*)(A.ws + WS_MIX); const float* bg = A.in[41] + l * 768;
    for (int row0 = 4 * F.gw; row0 < T; row0 += 4 * F.ngw) {
        u32x2 v[4][2];
#pragma unroll
        for (int r = 0; r < 4; ++r) { v[r][0] = *(const u32x2*)(S0 + (size_t)(row0 + r) * 256 + 4 * F.lane); v[r][1] = *(const u32x2*)(S1 + (size_t)(row0 + r) * 256 + 4 * F.lane); }
#pragma unroll
        for (int r = 0; r < 4; ++r)
#pragma unroll
            for (int br = 0; br < 2; ++br) {
                const float x0 = bflo(v[r][br].x), x1 = bfhi(v[r][br].x), x2 = bflo(v[r][br].y), x3 = bfhi(v[r][br].y);
                const float rs = rsqrtf(wave_sum(x0 * x0 + x1 * x1 + x2 * x2 + x3 * x3) * (1.f / 256.f) + NORM_EPS);
                const f32x4 g = *(const f32x4*)(bg + br * 256 + 4 * F.lane);
                u32x2 o; o.x = pk2(x0 * rs * g[0], x1 * rs * g[1]); o.y = pk2(x2 * rs * g[2], x3 * rs * g[3]);
                *(u32x2*)(MIX + (size_t)(row0 + r) * DM + 256 * (br + 1) + 4 * F.lane) = o; }
    }
}

DI void phase_norm2_router(const Frame& F, CArgs& A, int l) {
    const float* MODL = (const float*)(A.ws + WS_MOD) + (size_t)l * 8 * 6144;
    const float* g = A.in[43] + l * 1024;
    bf16_t* H = (bf16_t*)(A.ws + WS_H);
    int* EID = (int*)(A.ws + WS_RT_EID); float* GATE = (float*)(A.ws + WS_RT_GATE); int* PIE = (int*)(A.ws + WS_RT_PIE);
    unsigned* CNT = (unsigned*)(A.ws + WS_CTL) + CW_CNT + l * 64;
    const bf16_t* WRh = (const bf16_t*)(A.ws + WS_WR) + (size_t)(l * 2) * 48 * 1024; const bf16_t* WRl = WRh + 48 * 1024;
    const float* ROWSS = (const float*)(A.ws + WS_ROWSS);
    LAS float* part = (LAS float*)F.lds;
    LAS float* red = part + 8 * 64 * 48;
    LAS float* lsum = red + 8 * 64;
    LAS unsigned* lcnt = (LAS unsigned*)(lsum + 64 * 36);
    LAS int* lsel = (LAS int*)(lcnt + 64);
    const float* bgp = A.in[45] + l * 4; const float* bep = A.in[47] + l * 32;
    const int w = F.wave, k0 = 128 * w;
    bf16x8 bh[3][4], bl[3][4];
    { const int fr = F.lane & 15, fq = F.lane >> 4;
#pragma unroll
      for (int n = 0; n < 3; ++n)
#pragma unroll
          for (int ks = 0; ks < 4; ++ks) { bh[n][ks] = *(const bf16x8*)(WRh + (size_t)(16 * n + fr) * 1024 + k0 + 32 * ks + 8 * fq); bl[n][ks] = *(const bf16x8*)(WRl + (size_t)(16 * n + fr) * 1024 + k0 + 32 * ks + 8 * fq); } }
    for (int tile = F.bid; tile < T / 64; tile += F.G) {
        int tz = F.tid; asm volatile("" : "+v"(tz)); const int lane = tz & 63, fr = lane & 15, fq = lane >> 4;
        const int row0 = tile * 64, b = row0 / SEQ;
        const float* xb = A.out + (size_t)(row0 + fr) * DM + k0 + 8 * fq;
        if (tz < 32) lcnt[tz] = 0u;
        f32x4 acc[4][3];
#pragma unroll
        for (int m = 0; m < 4; ++m) { const float* rp = ROWSS + (size_t)(row0 + 16 * m + fr) * 16;
            const f32x4 p0 = *(const f32x4*)rp, p1 = *(const f32x4*)(rp + 4), p2 = *(const f32x4*)(rp + 8), p3 = *(const f32x4*)(rp + 12);
            const float tot = (((p0[0] + p0[1]) + (p0[2] + p0[3])) + ((p1[0] + p1[1]) + (p1[2] + p1[3]))) + (((p2[0] + p2[1]) + (p2[2] + p2[3])) + ((p3[0] + p3[1]) + (p3[2] + p3[3])));
            const float rstd = rsqrtf(tot * (1.f / DM) + NORM_EPS);
#pragma unroll
            for (int n = 0; n < 3; ++n) acc[m][n] = (f32x4){0.f, 0.f, 0.f, 0.f};
#pragma unroll
            for (int ks = 0; ks < 4; ++ks) { const int kc = k0 + 32 * ks + 8 * fq;
                const f32x4 x0 = *(const f32x4*)(xb + (size_t)(16 * m) * DM + 32 * ks), x1 = *(const f32x4*)(xb + (size_t)(16 * m) * DM + 32 * ks + 4);
                const f32x4 g0 = *(const f32x4*)(g + kc), g1 = *(const f32x4*)(g + kc + 4);
                const f32x4 s0 = *(const f32x4*)(MODL + (size_t)b * 6144 + 4096 + kc), s1 = *(const f32x4*)(MODL + (size_t)b * 6144 + 4096 + kc + 4);
                const f32x4 h0 = *(const f32x4*)(MODL + (size_t)b * 6144 + 3072 + kc), h1 = *(const f32x4*)(MODL + (size_t)b * 6144 + 3072 + kc + 4);
                const f32x4 v0 = x0 * rstd * g0 * (s0 + 1.f) + h0, v1 = x1 * rstd * g1 * (s1 + 1.f) + h1;
                u32x4 hi; hi.x = pk2(v0[0], v0[1]); hi.y = pk2(v0[2], v0[3]); hi.z = pk2(v1[0], v1[1]); hi.w = pk2(v1[2], v1[3]);
                u32x4 lo; lo.x = pk2(v0[0] - bflo(hi.x), v0[1] - bfhi(hi.x)); lo.y = pk2(v0[2] - bflo(hi.y), v0[3] - bfhi(hi.y)); lo.z = pk2(v1[0] - bflo(hi.z), v1[1] - bfhi(hi.z)); lo.w = pk2(v1[2] - bflo(hi.w), v1[3] - bfhi(hi.w));
                *(u32x4*)(H + (size_t)(row0 + 16 * m + fr) * DM + kc) = hi;
                const bf16x8 ah = __builtin_bit_cast(bf16x8, hi), al = __builtin_bit_cast(bf16x8, lo);
#pragma unroll
                for (int n = 0; n < 3; ++n) { acc[m][n] = __builtin_amdgcn_mfma_f32_16x16x32_bf16(ah, bh[n][ks], acc[m][n], 0, 0, 0);
                    acc[m][n] = __builtin_amdgcn_mfma_f32_16x16x32_bf16(al, bh[n][ks], acc[m][n], 0, 0, 0); acc[m][n] = __builtin_amdgcn_mfma_f32_16x16x32_bf16(ah, bl[n][ks], acc[m][n], 0, 0, 0); } }
#pragma unroll
            for (int n = 0; n < 3; ++n)
#pragma unroll
                for (int j = 0; j < 4; ++j) part[(w * 64 + 16 * m + 4 * fq + j) * 48 + 16 * n + fr] = acc[m][n][j];
        }
        lds_barrier();
        for (int i = tz; i < 64 * 36; i += NTHR) { const int tok = i / 36, n = i % 36; float a = 0.f;
#pragma unroll
            for (int ww = 0; ww < 8; ++ww) a += part[(ww * 64 + tok) * 48 + n];
            lsum[i] = a; }
        lds_barrier();
        float g0 = 0.f, g1 = 0.f; int e0 = 0, e1 = 0; unsigned r0 = 0, r1 = 0;
        if (tz < 64) {
            const LAS float* L = lsum + tz * 36;
            int gs = 0; float gm = L[0] + bgp[0];
#pragma unroll
            for (int i = 1; i < 4; ++i) { const float v = L[i] + bgp[i]; if (v > gm) { gm = v; gs = i; } }
            float gden = 0.f;
#pragma unroll
            for (int i = 0; i < 4; ++i) gden += expf(L[i] + bgp[i] - gm);
            const float gprob = 1.f / gden;
            int i1 = 0; float v1 = L[4 + gs * 8] + bep[gs * 8];
#pragma unroll
            for (int j = 1; j < 8; ++j) { const float v = L[4 + gs * 8 + j] + bep[gs * 8 + j]; if (v > v1) { v1 = v; i1 = j; } }
            int i2 = -1; float v2 = -INFINITY;
#pragma unroll
            for (int j = 0; j < 8; ++j) { const float v = L[4 + gs * 8 + j] + bep[gs * 8 + j]; if (j != i1 && v > v2) { v2 = v; i2 = j; } }
            const float p2 = expf(v2 - v1);
            g0 = gprob / (1.f + p2); g1 = gprob * p2 / (1.f + p2); e0 = gs * 8 + i1; e1 = gs * 8 + i2;
            r0 = __hip_atomic_fetch_add(lcnt + e0, 1u, __ATOMIC_RELAXED, __HIP_MEMORY_SCOPE_WORKGROUP); r1 = __hip_atomic_fetch_add(lcnt + e1, 1u, __ATOMIC_RELAXED, __HIP_MEMORY_SCOPE_WORKGROUP);
        }
        lds_barrier();
        if (tz < 32) { const unsigned c = lcnt[tz]; lcnt[32 + tz] = c ? atomicAdd(CNT + tz, c) : 0u; }
        lds_barrier();
        if (tz < 64) { const int row = row0 + tz;
            EID[2 * row] = e0; EID[2 * row + 1] = e1; GATE[2 * row] = g0; GATE[2 * row + 1] = g1; PIE[2 * row] = (int)(lcnt[32 + e0] + r0); PIE[2 * row + 1] = (int)(lcnt[32 + e1] + r1); }
        lds_barrier();
    }
    __syncthreads();
    LAS float* scr = (LAS float*)(F.lds + F.wave * 16640);
    bf16_t* WM1 = (bf16_t*)(A.ws + WS_WM1); bf16_t* WM2 = (bf16_t*)(A.ws + WS_WM2);
    for (int it = F.gw; it < 32 * 384; it += F.ngw) {
        const int e = it / 384; int r = it % 384;
        if (r < 256) { const int which = r >> 7; r &= 127; const int kb = r >> 3, nb = r & 7, n0 = 64 * nb;
            const float* src = (which ? A.in[49] : A.in[48]) + ((size_t)l * 32 + e) * 1024 * 512;
            transpose_item64(src, 512, 64 * kb, n0, WM1 + (size_t)e * 1024 * 1024, 1024, 256 * (n0 >> 7) + (n0 & 127) + 128 * which, 64 * kb, scr, F.lane);
        } else { r -= 256; const int kb = r >> 4, nb = r & 15;
            transpose_item64(A.in[50] + ((size_t)l * 32 + e) * 512 * 1024, 1024, 64 * kb, 64 * nb, WM2 + (size_t)e * 1024 * 512, 512, 64 * nb, 64 * kb, scr, F.lane); }
    }
}

DI void phase_moe_scatter(const Frame& F, CArgs& A, int l) {
    const unsigned* CNT = (const unsigned*)(A.ws + WS_CTL) + CW_CNT + l * 64;
    unsigned* META = (unsigned*)(A.ws + WS_CTL) + CW_UTAB + l * 1024;
    const int* EID = (const int*)(A.ws + WS_RT_EID); const int* PIE = (const int*)(A.ws + WS_RT_PIE); int* SORT = (int*)(A.ws + WS_RT_SORT);
    LAS unsigned* st = (LAS unsigned*)F.lds;
    if (F.tid == 0) { unsigned s = 0; for (int e = 0; e < 32; ++e) { st[e] = s; s += CNT[e]; } }
    __syncthreads();
    if (F.bid == 0 && F.tid == 0) { unsigned nu = 0;
        for (int e = 0; e < 32; ++e) { const unsigned c = CNT[e]; META[1 + e] = st[e]; META[33 + e] = c; for (unsigned bk = 0; bk * 256 < c; ++bk) META[65 + nu++] = ((unsigned)e << 16) | bk; }
        META[0] = nu; }
    for (int a = F.bid * NTHR + F.tid; a < 2 * T; a += F.G * NTHR) SORT[st[EID[a]] + PIE[a]] = a;
}

struct MoeProb1 {
    const char* Hh; const char* WM1; const unsigned* META; const int* SORT; int lda, ldb, nt, G, c;
    DI bool next(int i, pg8::Unit& u) const { const int idx = i * G + c; const int nu = (int)META[0]; if (idx >= nu * 4) return false;
        const unsigned ent = META[65 + (idx >> 2)]; u.pm = idx >> 2; u.pn = idx & 3; u.e = (int)(ent >> 16); u.blk = (int)(ent & 0xffffu); return true; }
    DI const char* a_base(const pg8::Unit&) const { return Hh; }
    DI const char* b_base(const pg8::Unit& u) const { return WM1 + ((size_t)u.e * 1024 + (size_t)u.pn * 256) * 1024 * 2; }
    DI unsigned a_off(const pg8::Unit& u, int row) const { const unsigned r = (unsigned)(u.blk * 256 + row), cnt = META[33 + u.e];
        const int a = r < cnt ? SORT[META[1 + u.e] + r] : 0; return (unsigned)(a >> 1) * 2048u; }
};
struct EpiMoe1 {
    static constexpr bool PERM = true;
    bf16_t* HID; const unsigned* META;
    DI void operator()(const f32x4 (&acc)[2][2][4][2], const pg8::Unit& u, int wr, int wc, int fr, int fq) const {
        const unsigned cnt = META[33 + u.e], st = META[1 + u.e];
        const int col0 = 128 * u.pn + wc * 32 + 8 * fq;
#pragma unroll
        for (int ai = 0; ai < 2; ++ai)
#pragma unroll
            for (int m = 0; m < 4; ++m) { const unsigned r = (unsigned)(u.blk * 256 + ai * 128 + wr * 64 + m * 16 + fr);
                if (r < cnt) { const f32x4 a0 = acc[ai][0][m][0], a1 = acc[ai][0][m][1], b0 = acc[ai][1][m][0], b1 = acc[ai][1][m][1];
                    u32x4 w; w.x = pk2(siluf_(a0[0]) * b0[0], siluf_(a0[1]) * b0[1]); w.y = pk2(siluf_(a0[2]) * b0[2], siluf_(a0[3]) * b0[3]);
                    w.z = pk2(siluf_(a1[0]) * b1[0], siluf_(a1[1]) * b1[1]); w.w = pk2(siluf_(a1[2]) * b1[2], siluf_(a1[3]) * b1[3]);
                    *(u32x4*)(HID + (size_t)(st + r) * 512 + col0) = w; } }
    }
};
struct MoeProb2 {
    const char* HID; const char* WM2; const unsigned* META; int lda, ldb, nt, G, c;
    DI bool next(int i, pg8::Unit& u) const { const int idx = i * G + c; const int nu = (int)META[0]; if (idx >= nu * 4) return false;
        const unsigned ent = META[65 + (idx >> 2)]; u.pm = idx >> 2; u.pn = idx & 3; u.e = (int)(ent >> 16); u.blk = (int)(ent & 0xffffu); return true; }
    DI const char* a_base(const pg8::Unit& u) const { return HID + ((size_t)META[1 + u.e] + (size_t)u.blk * 256) * 512 * 2; }
    DI const char* b_base(const pg8::Unit& u) const { return WM2 + ((size_t)u.e * 1024 + (size_t)u.pn * 256) * 512 * 2; }
    DI unsigned a_off(const pg8::Unit&, int row) const { return (unsigned)row * 1024u; }
};
struct EpiMoe2 {
    static constexpr bool PERM = true;
    bf16_t* Y; const unsigned* META; const int* SORT; const float* GATE; const float* gt;
    DI void operator()(const f32x4 (&acc)[2][2][4][2], const pg8::Unit& u, int wr, int wc, int fr, int fq) const {
        const unsigned cnt = META[33 + u.e], st = META[1 + u.e];
        const int col0 = 256 * u.pn + wc * 32 + 8 * fq;
        int av[2][4]; float gw[2][4];
#pragma unroll
        for (int ai = 0; ai < 2; ++ai)
#pragma unroll
            for (int m = 0; m < 4; ++m) { const unsigned r = (unsigned)(u.blk * 256 + ai * 128 + wr * 64 + m * 16 + fr); av[ai][m] = r < cnt ? SORT[st + r] : -1; }
#pragma unroll
        for (int ai = 0; ai < 2; ++ai)
#pragma unroll
            for (int m = 0; m < 4; ++m) gw[ai][m] = av[ai][m] >= 0 ? GATE[av[ai][m]] : 0.f;
#pragma unroll
        for (int ai = 0; ai < 2; ++ai)
#pragma unroll
            for (int m = 0; m < 4; ++m) { const int a = av[ai][m];
                if (a >= 0) { const int b = (a >> 1) / SEQ; const float g = gw[ai][m];
#pragma unroll
                    for (int bj = 0; bj < 2; ++bj) { const f32x4 g0 = *(const f32x4*)(gt + (size_t)b * 6144 + col0 + bj * 128), g1 = *(const f32x4*)(gt + (size_t)b * 6144 + col0 + bj * 128 + 4);
                        const f32x4 v0 = acc[ai][bj][m][0] * g0 * g, v1 = acc[ai][bj][m][1] * g1 * g;
                        u32x4 w; w.x = pk2(v0[0], v0[1]); w.y = pk2(v0[2], v0[3]); w.z = pk2(v1[0], v1[1]); w.w = pk2(v1[2], v1[3]);
                        *(u32x4*)(Y + (size_t)a * DM + col0 + bj * 128) = w; } } }
    }
};

DI void phase_final(const Frame& F, CArgs& A) {
    const bf16_t* Y = (const bf16_t*)(A.ws + WS_Y);
    const size_t N4 = (size_t)T * DM / 4, stride = (size_t)F.G * NTHR;
    for (size_t i0 = (size_t)F.bid * NTHR + F.tid; i0 < N4; i0 += 4 * stride) {
        f32x4 v[4]; u32x2 y0[4], y1[4];
#pragma unroll
        for (int k = 0; k < 4; ++k) { const size_t i = i0 + k * stride; if (i < N4) { const size_t row = i >> 8, col = (i & 255) * 4;
            v[k] = *(const f32x4*)(A.out + row * DM + col); y0[k] = *(const u32x2*)(Y + (2 * row) * DM + col); y1[k] = *(const u32x2*)(Y + (2 * row + 1) * DM + col); } }
#pragma unroll
        for (int k = 0; k < 4; ++k) { const size_t i = i0 + k * stride; if (i < N4) { const size_t row = i >> 8, col = (i & 255) * 4;
            v[k][0] += bflo(y0[k].x) + bflo(y1[k].x); v[k][1] += bfhi(y0[k].x) + bfhi(y1[k].x); v[k][2] += bflo(y0[k].y) + bflo(y1[k].y); v[k][3] += bfhi(y0[k].y) + bfhi(y1[k].y);
            *(f32x4*)(A.out + row * DM + col) = v[k]; } }
    }
}

#ifndef REPMASK
#define REPMASK 0u
#endif
constexpr int NPL = 14, NPH = 1 + 2 * NPL + 1;
__global__ void __launch_bounds__(NTHR, 2) mk_fwd(Args args) {
    extern __shared__ __attribute__((aligned(16))) unsigned char lds_raw[];
    LAS unsigned char* const ldsb = (LAS unsigned char*)lds_raw;
    const int wave0 = __builtin_amdgcn_readfirstlane(threadIdx.x >> 6);
    volatile LAS unsigned* MISC = (volatile LAS unsigned*)(ldsb + MISC_OFF);
    if (threadIdx.x < 64) MISC[threadIdx.x] = 0u;
    __syncthreads();
    XcdBarrier bar; bar.bar = (unsigned*)(args.ws + WS_CTL) + CW_BAR; bar.x = 0; bar.st = nullptr;
    if (args.use_bar) bar = xcd_barrier_post((unsigned*)(args.ws + WS_CTL) + CW_BAR, MISC + 8);
    const int lo = args.ph_lo, hi = args.ph_hi;
#define IN(k) (lo <= (k) && (k) < hi)
#define SEAM(k) do { if (IN(k) && IN((k) + 1)) xcd_barrier(bar); } while (0)
    unsigned char* ws = args.ws;
    if (IN(0)) { const Frame F = make_frame(ldsb, wave0); CArgs& AA = *get_args(); phase_prologue(F, AA); } SEAM(0);
    for (int l = 0; l < DEPTH; ++l) {
        const int pb = 1 + l * NPL;
        const float* MODL = (const float*)(ws + WS_MOD) + (size_t)l * 8 * 6144;
        if (IN(pb + 0)) { const Frame F = make_frame(ldsb, wave0); CArgs& AA = *get_args(); phase_norm1(F, AA, l); } SEAM(pb + 0);
        if (IN(pb + 1)) { const Frame F = make_frame(ldsb, wave0); CArgs& AA = *get_args(); pg8::PlainProb P{(const char*)(ws + WS_H), (const char*)(ws + WS_WIN) + (size_t)l * ZS * 1024, 512, 512, 8, 256, 9, F.G, F.bid};
            EpiBf16I8 E{(bf16_t*)(ws + WS_Z), ZS, (const float*)(ws + WS_HSC), (const float*)(ws + WS_WINSC) + l * ZS}; pg8::gemm_phase<true, true>(F.lds, P, E, F.tid); } SEAM(pb + 1);
        if (IN(pb + 2)) { { const Frame F = make_frame(ldsb, wave0); CArgs& AA = *get_args(); phase_mla_prep(F, AA, l); } { const Frame F = make_frame(ldsb, wave0); CArgs& AA = *get_args(); phase_s5<1>(F, AA, l); } { const Frame F = make_frame(ldsb, wave0); CArgs& AA = *get_args(); phase_lru_prep(F, AA, l); } } SEAM(pb + 2);
        if (IN(pb + 3)) { { const Frame F = make_frame(ldsb, wave0); CArgs& AA = *get_args(); pg8::PlainProb P{(const char*)(ws + WS_AMLA), (const char*)(ws + WS_WMLA) + (size_t)l * 1024 * 512 * 2, 512, 512, 8, 256, 4, F.G, F.bid};
            EpiBf16Plain E{(bf16_t*)(ws + WS_QKVRAW), 1024}; pg8::gemm_phase(F.lds, P, E, F.tid); } { const Frame F = make_frame(ldsb, wave0); CArgs& AA = *get_args(); phase_lru_sum(F, AA); } } SEAM(pb + 3);
        if (IN(pb + 4)) { { const Frame F = make_frame(ldsb, wave0); CArgs& AA = *get_args(); phase_mla_post(F, AA, l); } { const Frame F = make_frame(ldsb, wave0); CArgs& AA = *get_args(); phase_lru_fin(F, AA, l); } } SEAM(pb + 4);
        if (IN(pb + 5)) { { const Frame F = make_frame(ldsb, wave0); CArgs& AA = *get_args(); phase_attn(F, AA, l); } lds_barrier(); { const Frame F = make_frame(ldsb, wave0); CArgs& AA = *get_args(); phase_s5<2>(F, AA, l); } } SEAM(pb + 5);
        if (IN(pb + 6)) { { const Frame F = make_frame(ldsb, wave0); CArgs& AA = *get_args(); phase_rwkv_A(F, AA, l); } lds_barrier(); { const Frame F = make_frame(ldsb, wave0); CArgs& AA = *get_args(); pg8::PlainProb P{(const char*)(ws + WS_YS5), (const char*)(ws + WS_WGLU) + (size_t)l * 256 * 256 * 2, 256, 256, 4, 256, 1, F.G, F.bid};
            EpiGlu E{(const bf16_t*)(ws + WS_YS5), (bf16_t*)(ws + WS_YS5G), AA.in[27] + l * 256}; pg8::gemm_phase(F.lds, P, E, F.tid); } } SEAM(pb + 6);
        if (IN(pb + 7)) { const Frame F = make_frame(ldsb, wave0); CArgs& AA = *get_args(); phase_rwkv_B(F, AA); } SEAM(pb + 7);
        if (IN(pb + 8)) { { const Frame F = make_frame(ldsb, wave0); CArgs& AA = *get_args(); phase_rwkv_C(F, AA, l); } { const Frame F = make_frame(ldsb, wave0); CArgs& AA = *get_args(); phase_branch_norm(F, AA, l); } } SEAM(pb + 8);
        if (IN(pb + 9)) { const Frame F = make_frame(ldsb, wave0); CArgs& AA = *get_args(); pg8::PlainProb P{(const char*)(ws + WS_MIX), (const char*)(ws + WS_WOUT) + (size_t)l * 1024 * 1024 * 2, 1024, 1024, 16, 256, 4, F.G, F.bid};
            EpiResGate E{l == 0 ? AA.in[0] : AA.out, AA.out, MODL + 2048, (float*)(ws + WS_ROWSS)}; pg8::gemm_phase(F.lds, P, E, F.tid); } SEAM(pb + 9);
        if (IN(pb + 10)) { const Frame F = make_frame(ldsb, wave0); CArgs& AA = *get_args(); phase_norm2_router(F, AA, l); } SEAM(pb + 10);
        if (IN(pb + 11)) { const Frame F = make_frame(ldsb, wave0); CArgs& AA = *get_args(); phase_moe_scatter(F, AA, l); } SEAM(pb + 11);
        const unsigned* META = (const unsigned*)(ws + WS_CTL) + CW_UTAB + l * 1024;
        if (IN(pb + 12)) { const Frame F = make_frame(ldsb, wave0); CArgs& AA = *get_args(); MoeProb1 P{(const char*)(ws + WS_H), (const char*)(ws + WS_WM1), META, (const int*)(ws + WS_RT_SORT), 1024, 1024, 16, F.G, F.bid};
            EpiMoe1 E{(bf16_t*)(ws + WS_HID), META}; pg8::gemm_phase(F.lds, P, E, F.tid); } SEAM(pb + 12);
        if (IN(pb + 13)) { const Frame F = make_frame(ldsb, wave0); CArgs& AA = *get_args(); MoeProb2 P{(const char*)(ws + WS_HID), (const char*)(ws + WS_WM2), META, 512, 512, 8, F.G, F.bid};
            EpiMoe2 E{(bf16_t*)(ws + WS_Y), META, (const int*)(ws + WS_RT_SORT), (const float*)(ws + WS_RT_GATE), MODL + 5120}; pg8::gemm_phase(F.lds, P, E, F.tid); } SEAM(pb + 13);
    }
    if (IN(NPH - 1)) { const Frame F = make_frame(ldsb, wave0); CArgs& AA = *get_args(); phase_final(F, AA); }
#undef IN
#undef SEAM
}

extern "C" void kernel_launch(void* const* d_in, const int* in_sizes, int n_in, void* d_out, int out_size, void* d_ws, size_t ws_size, hipStream_t stream) {
    static int grid = 0;
    if (grid == 0) {
        if (n_in != 51 || ws_size < WS_END) { fprintf(stderr, "kernel_launch: unexpected inputs (n_in %d, ws %zu)\n", n_in, ws_size); grid = -1; return; }
        int dev = 0, cus = 0;
        if (hipGetDevice(&dev) != hipSuccess || hipDeviceGetAttribute(&cus, hipDeviceAttributeMultiprocessorCount, dev) != hipSuccess) { grid = -1; return; }
        if (hipFuncSetAttribute((const void*)mk_fwd, hipFuncAttributeMaxDynamicSharedMemorySize, LDS_BYTES) != hipSuccess) { fprintf(stderr, "kernel_launch: hipFuncSetAttribute failed\n"); grid = -1; return; }
        grid = cus;
    }
    if (grid < 0) return;
    (void)hipMemsetAsync((char*)d_ws + WS_CTL, 0, CTL_ZERO_BYTES, stream);
    Args a{};
    for (int i = 0; i < 51; ++i) a.in[i] = (const float*)d_in[i];
    a.pos_off = (const int*)d_in[2]; a.out = (float*)d_out; a.ws = (unsigned char*)d_ws; a.pad = 0;
#if defined(MK_PER_PHASE)
    a.use_bar = 0;
    for (int p = 0; p < NPH; ++p) { a.ph_lo = p; a.ph_hi = p + 1;
        const int k = (p == 0) ? 30 : (p == NPH - 1) ? 31 : (p - 1) % NPL; const int reps = 1 + (int)((REPMASK >> k) & 1u);
        for (int r = 0; r < reps; ++r) hipLaunchKernelGGL(mk_fwd, dim3(grid), dim3(NTHR), LDS_BYTES, stream, a); }
#else
    a.use_bar = 1; a.ph_lo = 0; a.ph_hi = NPH;
    hipLaunchKernelGGL(mk_fwd, dim3(grid), dim3(NTHR), LDS_BYTES, stream, a);
#endif
}
```

```cpp
#include <hip/hip_runtime.h>
#include <cstdio>
#include <cstdint>
#include <type_traits>

#define LAS __attribute__((address_space(3)))
#define GAS __attribute__((address_space(1)))
#define DI __device__ __forceinline__
typedef unsigned short bf16_t;
typedef short bf16x8 __attribute__((ext_vector_type(8)));
typedef short s16x4 __attribute__((ext_vector_type(4)));
typedef float f32x4 __attribute__((ext_vector_type(4)));
typedef float f32x2 __attribute__((ext_vector_type(2)));
typedef float f32x16 __attribute__((ext_vector_type(16)));
typedef unsigned u32x4 __attribute__((ext_vector_type(4)));
typedef unsigned u32x2 __attribute__((ext_vector_type(2)));
typedef __bf16 bf16x2_t __attribute__((ext_vector_type(2)));
typedef int i32x4 __attribute__((ext_vector_type(4)));

constexpr int NB = 8, SEQ = 8192, DM = 1024, T = NB * SEQ, DEPTH = 2;
constexpr int WG = 256;
constexpr int ZS = 2304;
constexpr int ZC_R = 0, ZC_K = 256, ZC_V = 512, ZC_WLO = 768, ZC_ALO = 800, ZC_GLO = 832, ZC_S5 = 896, ZC_QA = 1152, ZC_KVA = 1408, ZC_KPE = 1536, ZC_LX = 1568, ZC_LG = 1824, D_IN = 2080;
constexpr int NEXP = 32, DFF = 512;
constexpr float NORM_EPS = 1e-6f;

DI unsigned f2bf(float f) { unsigned u = __float_as_uint(f); return (u + 0x7fffu + ((u >> 16) & 1u)) >> 16; }
DI unsigned pk2(float lo, float hi) { f32x2 v = {lo, hi}; bf16x2_t b = __builtin_convertvector(v, bf16x2_t); return __builtin_bit_cast(unsigned, b); }
DI float bflo(unsigned u) { return __uint_as_float(u << 16); }
DI float bfhi(unsigned u) { return __uint_as_float(u & 0xffff0000u); }
DI float bf2f(bf16_t b) { return __uint_as_float(((unsigned)b) << 16); }
DI int lane_opaque() { int l; asm volatile("v_mbcnt_lo_u32_b32 %0, -1, 0\n\tv_mbcnt_hi_u32_b32 %0, -1, %0" : "=v"(l)); return l; }
DI float shfl_xor_l(float v, int o, int lane) { return __int_as_float(__builtin_amdgcn_ds_bpermute((lane ^ o) << 2, __float_as_int(v))); }
DI float wave_max(float v) {
    const int l = lane_opaque();
#pragma unroll
    for (int o = 1; o < 64; o <<= 1) v = fmaxf(v, shfl_xor_l(v, o, l));
    return v;
}
DI unsigned q8x4(f32x4 v, float inv) { const int a = (int)rintf(v[0] * inv), b = (int)rintf(v[1] * inv), c = (int)rintf(v[2] * inv), d = (int)rintf(v[3] * inv);
    return (unsigned)(a & 255) | ((unsigned)(b & 255) << 8) | ((unsigned)(c & 255) << 16) | ((unsigned)(d & 255) << 24); }
DI float wave_sum(float v) {
    const int l = lane_opaque();
#pragma unroll
    for (int o = 1; o < 64; o <<= 1) v += shfl_xor_l(v, o, l);
    return v;
}
DI void lds_barrier() { asm volatile("s_waitcnt lgkmcnt(0)" ::: "memory"); __builtin_amdgcn_s_barrier(); asm volatile("" ::: "memory"); }
DI float sigmoidf_(float x) { return __builtin_amdgcn_rcpf(1.f + __expf(-x)); }
DI float fast_tanh(float x) { const float e = __expf(2.f * fminf(fmaxf(x, -15.f), 15.f)); return (e - 1.f) * __builtin_amdgcn_rcpf(e + 1.f); }
DI float fast_softplus(float x) { return fmaxf(x, 0.f) + __logf(1.f + __expf(-fabsf(x))); }
DI float softplusf_(float x) { return fmaxf(x, 0.f) + log1pf(__expf(-fabsf(x))); }
DI float gelu_tanh(float x) { const float u = 0.7978845608028654f * (x + 0.044715f * x * x * x); const float e = __expf(2.f * fminf(fmaxf(u, -15.f), 15.f)); return x * e * __builtin_amdgcn_rcpf(e + 1.f); }
DI float siluf_(float x) { return x / (1.f + __expf(-x)); }

namespace pg8 {
constexpr int BM = 256, BK = 64, HALF = 128, HTB = HALF * BK * 2, STAGE_BYTES = 8 * HTB;
DI int lds_byte(int r, int c) { const int st = (r >> 4) * 2 + (c >> 5), rr = r & 15, cc = c & 31, ob = rr * 64 + cc * 2; return st * 1024 + (ob ^ (((ob >> 9) & 1) << 5)); }
DI void stage_rc(int b, int& R, int& C) { const int st = b / 1024, sb = b % 1024, swz = sb ^ (((sb >> 9) & 1) << 5); R = (st >> 1) * 16 + swz / 64; C = (st & 1) * 32 + (swz % 64) / 2; }
DI int perm32(int rho) { const int n = rho >> 4, i = rho & 15; return 8 * (i >> 2) + 4 * n + (i & 3); }

struct Unit { int pm, pn, e, blk; };
DI f32x4 mma_any(bf16x8 a, bf16x8 b, f32x4 c) { return __builtin_amdgcn_mfma_f32_16x16x32_bf16(a, b, c, 0, 0, 0); }
DI i32x4 mma_any(bf16x8 a, bf16x8 b, i32x4 c) { return __builtin_amdgcn_mfma_i32_16x16x64_i8(__builtin_bit_cast(i32x4, a), __builtin_bit_cast(i32x4, b), c, 0, 0, 0); }

template <bool ALIGN_EPI = true, bool I8 = false, class Epi, class P>
DI void gemm_phase(LAS unsigned char* lds, const P& S, const Epi& E, int tid_in) {
    typedef typename std::conditional<I8, i32x4, f32x4>::type acc_t;
    const int tid = tid_in, wid = __builtin_amdgcn_readfirstlane(tid >> 6), lane = tid & 63, wr = wid >> 2, wc = wid & 3, fr = lane & 15, fq = lane >> 4;
    const int nt = S.nt;
    int Rr[2], Cc[2];
    unsigned voffB[2], offC[2][2], offN[2][2];
#pragma unroll
    for (int i = 0; i < 2; ++i) { int R, C; stage_rc(tid * 16 + i * 8192, R, C); Rr[i] = R; Cc[i] = C; const int Rb = Epi::PERM ? ((R & ~31) + perm32(R & 31)) : R;
        voffB[i] = (unsigned)(Rb * S.ldb + C) * 2u; }
    const size_t kstep = (size_t)(BK * 2);
    const size_t hstepB = (size_t)HALF * S.ldb * 2;
    const unsigned ldsw = (unsigned)wid * 1024u;
    const int aoff = lds_byte(wr * 64 + fr, fq * 8), boff = lds_byte(wc * 32 + fr, fq * 8);
#define PG8_SA(b, h) (((b) * 2 + (h)) * HTB)
#define PG8_SB(b, h) ((4 + (b) * 2 + (h)) * HTB)
#define PG8_STAGE(bufoff, gbase, voff) do { _Pragma("unroll") for (int _i = 0; _i < 2; ++_i) \
        __builtin_amdgcn_global_load_lds((const unsigned*)((const char*)(gbase) + (voff)[_i]), (LAS unsigned*)(lds + (bufoff) + ldsw + _i * 8192), 16, 0, 0); } while (0)
#define PG8_LDA(dst, b, h) do { _Pragma("unroll") for (int m = 0; m < 4; ++m) _Pragma("unroll") for (int k = 0; k < 2; ++k) dst[m][k] = *(const LAS bf16x8*)(lds + PG8_SA(b, h) + aoff + m * 2048 + k * 1024); } while (0)
#define PG8_LDB(dst, b, h) do { _Pragma("unroll") for (int n = 0; n < 2; ++n) _Pragma("unroll") for (int k = 0; k < 2; ++k) dst[n][k] = *(const LAS bf16x8*)(lds + PG8_SB(b, h) + boff + n * 2048 + k * 1024); } while (0)
#define PG8_MMA(ai, bj, At, Bt) do { __builtin_amdgcn_s_setprio(1); _Pragma("unroll") for (int m = 0; m < 4; ++m) _Pragma("unroll") for (int n = 0; n < 2; ++n) _Pragma("unroll") for (int k = 0; k < 2; ++k) \
        acc[ai][bj][m][n] = mma_any(Bt[n][k], At[m][k], acc[ai][bj][m][n]); __builtin_amdgcn_s_setprio(0); } while (0)
#define PG8_WAIT_V(n) asm volatile("s_waitcnt vmcnt(" #n ")" ::: "memory")
#define PG8_WAIT_L(n) asm volatile("s_waitcnt lgkmcnt(" #n ")" ::: "memory")
#define PG8_BAR __builtin_amdgcn_s_barrier()
#define PG8_SCHED __builtin_amdgcn_sched_barrier(0)
    Unit cur, nxt; int ui = 0;
    if (!S.next(0, cur)) return;
    acc_t acc[2][2][4][2];
#pragma unroll
    for (int a = 0; a < 2; ++a)
#pragma unroll
        for (int b = 0; b < 2; ++b)
#pragma unroll
            for (int m = 0; m < 4; ++m)
#pragma unroll
                for (int n = 0; n < 2; ++n) acc[a][b][m][n] = (acc_t){0, 0, 0, 0};
    bf16x8 At[4][2], B0[2][2], B1[2][2];
    const char* cA = S.a_base(cur); const char* cB = S.b_base(cur);
#pragma unroll
    for (int h = 0; h < 2; ++h)
#pragma unroll
        for (int i = 0; i < 2; ++i) { offC[h][i] = S.a_off(cur, h * HALF + Rr[i]) + (unsigned)Cc[i] * 2u; offN[h][i] = offC[h][i]; }
    PG8_STAGE(PG8_SB(0, 0), cB, voffB); PG8_STAGE(PG8_SB(0, 1), cB + hstepB, voffB); PG8_STAGE(PG8_SA(0, 0), cA, offC[0]); PG8_STAGE(PG8_SA(0, 1), cA, offC[1]);
    if (wr == 1) PG8_BAR;
    PG8_WAIT_V(2); PG8_BAR;
    PG8_STAGE(PG8_SB(1, 0), cB + kstep, voffB); PG8_STAGE(PG8_SA(1, 0), cA + kstep, offC[0]); PG8_STAGE(PG8_SB(1, 1), cB + hstepB + kstep, voffB);
    PG8_WAIT_V(6); PG8_BAR;
    for (;;) {
        const bool has_next = S.next(ui + 1, nxt);
        const char* nA = has_next ? S.a_base(nxt) : cA; const char* nB = has_next ? S.b_base(nxt) : cB;
        for (int t = 0; t < nt; t += 2) {
            const bool last = (t == nt - 2);
            const char* a1 = cA + (size_t)(t + 1) * kstep;
            const char* a2 = last ? nA : cA + (size_t)(t + 2) * kstep; const char* b2 = last ? nB : cB + (size_t)(t + 2) * kstep;
            const char* a3 = a2 + kstep; const char* b3 = b2 + kstep;
            if (last && has_next) {
#pragma unroll
                for (int h = 0; h < 2; ++h)
#pragma unroll
                    for (int i = 0; i < 2; ++i) offN[h][i] = S.a_off(nxt, h * HALF + Rr[i]) + (unsigned)Cc[i] * 2u;
            }
            unsigned o2[2][2];
#pragma unroll
            for (int h = 0; h < 2; ++h)
#pragma unroll
                for (int i = 0; i < 2; ++i) o2[h][i] = last ? offN[h][i] : offC[h][i];
            PG8_LDB(B0, 0, 0); PG8_LDB(B1, 0, 1); PG8_SCHED; PG8_LDA(At, 0, 0); PG8_STAGE(PG8_SA(1, 1), a1, offC[1]);
            PG8_WAIT_V(8); PG8_WAIT_L(0); PG8_BAR; PG8_MMA(0, 0, At, B0); PG8_MMA(0, 1, At, B1); PG8_BAR; PG8_SCHED;
            PG8_LDA(At, 0, 1); PG8_STAGE(PG8_SB(0, 0), b2, voffB); PG8_STAGE(PG8_SB(0, 1), b2 + hstepB, voffB); PG8_STAGE(PG8_SA(0, 0), a2, o2[0]);
            PG8_WAIT_V(8); PG8_WAIT_L(0); PG8_BAR; PG8_MMA(1, 0, At, B0); PG8_MMA(1, 1, At, B1); PG8_BAR; PG8_SCHED;
            PG8_LDB(B0, 1, 0); PG8_LDB(B1, 1, 1); PG8_SCHED; PG8_LDA(At, 1, 0); PG8_STAGE(PG8_SA(0, 1), a2, o2[1]);
            PG8_WAIT_V(8); PG8_WAIT_L(0); PG8_BAR; PG8_MMA(0, 0, At, B0); PG8_MMA(0, 1, At, B1); PG8_BAR; PG8_SCHED;
            PG8_LDA(At, 1, 1); PG8_STAGE(PG8_SB(1, 0), b3, voffB); PG8_STAGE(PG8_SB(1, 1), b3 + hstepB, voffB); PG8_STAGE(PG8_SA(1, 0), a3, o2[0]);
            PG8_WAIT_V(8); PG8_WAIT_L(0); PG8_BAR; PG8_MMA(1, 0, At, B0); PG8_MMA(1, 1, At, B1); PG8_BAR; PG8_SCHED;
        }
        if constexpr (ALIGN_EPI) { if (wr == 0) PG8_BAR; }
        E(acc, cur, wr, wc, fr, fq);
        if (!has_next) break;
#pragma unroll
        for (int a = 0; a < 2; ++a)
#pragma unroll
            for (int b = 0; b < 2; ++b)
#pragma unroll
                for (int m = 0; m < 4; ++m)
#pragma unroll
                    for (int n = 0; n < 2; ++n) acc[a][b][m][n] = (acc_t){0, 0, 0, 0};
        cur = nxt; cA = nA; cB = nB; ++ui;
#pragma unroll
        for (int h = 0; h < 2; ++h)
#pragma unroll
            for (int i = 0; i < 2; ++i) offC[h][i] = offN[h][i];
        if constexpr (ALIGN_EPI) { if (wr == 1) PG8_BAR; }
    }
    PG8_WAIT_V(0);
    if constexpr (!ALIGN_EPI) { if (wr == 0) PG8_BAR; }
    PG8_BAR;
#undef PG8_SA
#undef PG8_SB
#undef PG8_STAGE
#undef PG8_LDA
#undef PG8_LDB
#undef PG8_MMA
#undef PG8_WAIT_V
#undef PG8_WAIT_L
#undef PG8_BAR
#undef PG8_SCHED
}

struct PlainProb {
    const char* A; const char* Bt; int lda, ldb, nt, nM, nN, G, c;
    DI bool next(int i, Unit& u) const {
        const long L = (long)i * G + c; const int nwg = nM * nN; if (L >= nwg) return false;
        int wgid = (int)L; { const int q = nwg / 8, r = nwg % 8, xcd = wgid % 8, off = wgid / 8; wgid = (xcd < r ? xcd * (q + 1) : r * (q + 1) + (xcd - r) * q) + off; }
        const int nig = 8 * nN, gid = wgid / nig, fm = gid * 8, gsz = (nM - fm) < 8 ? (nM - fm) : 8;
        u.pm = fm + ((wgid % nig) % gsz); u.pn = (wgid % nig) / gsz; u.e = 0; u.blk = 0; return true;
    }
    DI const char* a_base(const Unit& u) const { return A + (size_t)u.pm * 256 * lda * 2; }
    DI const char* b_base(const Unit& u) const { return Bt + (size_t)u.pn * 256 * ldb * 2; }
    DI unsigned a_off(const Unit&, int row) const { return (unsigned)row * (unsigned)lda * 2u; }
};
}

constexpr size_t MiB = 1u << 20;
constexpr size_t WS_CTL = 0, CTL_ZERO_BYTES = 1 * MiB;
constexpr size_t WS_MOD = 1 * MiB;
constexpr size_t WS_RT_EID = 3 * MiB;
constexpr size_t WS_RT_GATE = WS_RT_EID + 512 * 1024;
constexpr size_t WS_RT_PIE = WS_RT_GATE + 512 * 1024;
constexpr size_t WS_RT_SORT = WS_RT_PIE + 512 * 1024;
constexpr size_t WS_WIN = 8 * MiB;
constexpr size_t WS_WINSC = 8 * MiB + 5 * MiB;
constexpr size_t WS_HSC = 7 * MiB + 512 * 1024;
constexpr size_t WS_WOUT = 17 * MiB;
constexpr size_t WS_WMLA = 21 * MiB;
constexpr size_t WS_WGLU = 23 * MiB;
constexpr size_t WS_WR = 23 * MiB + 256 * 1024;
constexpr size_t WS_WLRU = 23 * MiB + 640 * 1024;
constexpr size_t WS_WLORA = 23 * MiB + 768 * 1024;
static_assert(WS_WGLU + 256 * 1024 <= WS_WR && WS_WR + 384 * 1024 <= WS_WLRU && WS_WLRU + 128 * 1024 <= WS_WLORA && WS_WLORA + 128 * 1024 <= 24 * MiB, "small weight map");
constexpr size_t WS_H = 24 * MiB;
constexpr size_t WS_Z = 152 * MiB;
constexpr size_t WS_WM1 = WS_Z;
constexpr size_t WS_WM2 = WS_Z + 64 * MiB;
constexpr size_t WS_WM1SC = WS_Z + 32 * MiB;
constexpr size_t WS_H2SC = 7 * MiB + 768 * 1024;
constexpr size_t WS_MIX = 440 * MiB;
constexpr size_t WS_HID = WS_MIX;
constexpr size_t WS_Y = 569 * MiB;
constexpr size_t WS_Q = 825 * MiB;
constexpr size_t WS_K = 873 * MiB;
constexpr size_t WS_VT = 921 * MiB;
constexpr size_t WS_ROWSS = WS_Q;
constexpr size_t WS_TAIL = 953 * MiB;
constexpr size_t WS_END = 1017 * MiB;
constexpr size_t WS_AMLA = WS_TAIL;
constexpr size_t WS_QKVRAW = WS_Y;
constexpr size_t WS_ATTO = WS_H;
constexpr size_t WS_RW_V = WS_Y + 64 * MiB, WS_RW_G = WS_H + 64 * MiB;
constexpr size_t WS_RC_RP = WS_H + 32 * MiB;
constexpr size_t WS_RC_MP = WS_H + 64 * MiB;
constexpr size_t WS_RC_HB = WS_H + 96 * MiB;
constexpr size_t WS_RC_Y0 = WS_Q;
constexpr size_t WS_RC_G = WS_Q + 64 * MiB;
constexpr int RC_REC = 24832;
constexpr size_t WS_RC_BS = WS_Q + 64 * MiB + 98 * MiB;
static_assert((size_t)4096 * RC_REC <= 98 * MiB && WS_RC_BS + 1 * MiB <= WS_END, "rwkv record map");
constexpr size_t WS_YS5 = WS_Y;
constexpr size_t WS_YS5G = WS_Y + 32 * MiB;
constexpr size_t WS_YL = WS_TAIL + 32 * MiB;
constexpr size_t WS_LA = WS_Y + 128 * MiB, WS_LB = WS_Y + 192 * MiB;
constexpr size_t WS_S5END = 2 * MiB;
constexpr size_t WS_S5BB = 5 * MiB;
constexpr size_t WS_S5CC = 5 * MiB + 128 * 1024;
constexpr size_t WS_LSUM = 5 * MiB + 512 * 1024;
static_assert(WS_RT_SORT + 512 * 1024 <= WS_LSUM && WS_LSUM + 2 * MiB <= WS_WIN && WS_S5END + 1 * MiB <= WS_RT_EID, "map");

constexpr int CW_BAR = 4096;
constexpr int CW_CNT = 16384;
constexpr int CW_INMAX = 32768;
constexpr int CW_COLMAX = 65536;
constexpr int CW_UTAB = 20480;

constexpr int NWAVES = 8, NTHR = 512;
constexpr int LDS_BYTES = 155648;
constexpr int MISC_OFF = 155648 - 256;

struct Args { const float* in[51]; const int* pos_off; float* out; unsigned char* ws; int ph_lo, ph_hi, use_bar, pad; };
typedef const __attribute__((address_space(4))) Args CArgs;
DI CArgs* get_args() { CArgs* ap = (CArgs*)__builtin_amdgcn_kernarg_segment_ptr(); asm volatile("" : "+s"(ap)); return ap; }

#define XB_TMO      128
#define XB_XCNT(j)  (256  + 64 * (j))
#define XB_XSUB(j)  (1280 + 64 * (j))
#define XB_XGEN(j)  (2304 + 64 * (j))
#define XB_TOP      3328
#define XB_TOPGEN   3392
#define XCD_BAR_WORDS 3456
#define XB_SPIN_CAP (1u << 18)
DI unsigned xb_ld(unsigned* p)              { return __hip_atomic_load(p, __ATOMIC_RELAXED, __HIP_MEMORY_SCOPE_AGENT); }
DI unsigned xb_add(unsigned* p, unsigned v) { return __hip_atomic_fetch_add(p, v, __ATOMIC_RELAXED, __HIP_MEMORY_SCOPE_AGENT); }
DI unsigned xb_xcc_id() { return (unsigned)__builtin_amdgcn_s_getreg((3 << 11) | 20) & 0xFu; }
#define XB_SPIN(cond, bar) do { unsigned _sp = 0; while (cond) { __builtin_amdgcn_s_sleep(1); \
    if ((++_sp & 255u) == 0u) { if (xb_ld(&(bar)[XB_TMO])) break; if (_sp > XB_SPIN_CAP) { atomicAdd(&(bar)[XB_TMO], 1u); break; } } } } while (0)
struct XcdBarrier { unsigned* bar; unsigned x; volatile LAS unsigned* st; };
DI XcdBarrier xcd_barrier_post(unsigned* bar, volatile LAS unsigned* st) {
    XcdBarrier b; b.bar = bar; b.x = xb_xcc_id(); b.st = st;
    if (threadIdx.x == 0) (void)xb_add(&bar[XB_XCNT(b.x)], 1u);
    return b;
}
DI void xcd_barrier_complete(unsigned* bar, unsigned x, unsigned& nloc, unsigned& nx) {
    const unsigned G = gridDim.x * gridDim.y * gridDim.z;
    unsigned sum, cnt, mine, sp = 0u;
    for (;;) {
        sum = 0u; cnt = 0u; mine = 0u;
#pragma unroll
        for (unsigned j = 0; j < 16; ++j) { const unsigned c = xb_ld(&bar[XB_XCNT(j)]); sum += c; cnt += (c > 0u) ? 1u : 0u; mine = (j == x) ? c : mine; }
        if (sum == G) break;
        __builtin_amdgcn_s_sleep(1);
        if ((++sp & 255u) == 0u) { if (xb_ld(&bar[XB_TMO])) break; if (sp > XB_SPIN_CAP) { atomicAdd(&bar[XB_TMO], 1u); break; } }
    }
    nloc = mine > 0u ? mine : 1u; nx = cnt > 0u ? cnt : 1u;
}
DI void xcd_barrier(const XcdBarrier& b) {
    asm volatile("s_waitcnt vmcnt(0)" ::: "memory");
    __syncthreads();
    if (threadIdx.x == 0) {
        unsigned* bar = b.bar;
        __builtin_amdgcn_s_waitcnt(0);
        unsigned nloc = b.st[0], nx = b.st[1];
        if (nloc == 0u) { xcd_barrier_complete(bar, b.x, nloc, nx); b.st[0] = nloc; b.st[1] = nx; }
        const unsigned old = xb_add(&bar[XB_XSUB(b.x)], 1u);
        const unsigned gen = old / nloc;
        if (old + 1u == (gen + 1u) * nloc) {
            __builtin_amdgcn_fence(__ATOMIC_RELEASE, "agent");
            asm volatile("s_waitcnt vmcnt(0)" ::: "memory");
            const unsigned og = xb_add(&bar[XB_TOP], 1u);
            const unsigned tg = og / nx;
            if (og + 1u == (tg + 1u) * nx) xb_add(&bar[XB_TOPGEN], 1u);
            else XB_SPIN(xb_ld(&bar[XB_TOPGEN]) == tg, bar);
            __builtin_amdgcn_fence(__ATOMIC_ACQUIRE, "agent");
            xb_add(&bar[XB_XGEN(b.x)], 1u);
            asm volatile("s_waitcnt vmcnt(0)" ::: "memory");
        } else {
            XB_SPIN(xb_ld(&bar[XB_XGEN(b.x)]) == gen, bar);
            __builtin_amdgcn_fence(__ATOMIC_ACQUIRE, "agent");
            asm volatile("s_waitcnt vmcnt(0)" ::: "memory");
        }
    }
    __syncthreads();
}

struct EpiBf16Plain {
    static constexpr bool PERM = true;
    bf16_t* O; int ldc;
    DI void operator()(const f32x4 (&acc)[2][2][4][2], const pg8::Unit& u, int wr, int wc, int fr, int fq) const {
        const int row0 = u.pm * 256 + wr * 64 + fr, col0 = u.pn * 256 + wc * 32 + 8 * fq;
#pragma unroll
        for (int ai = 0; ai < 2; ++ai)
#pragma unroll
            for (int m = 0; m < 4; ++m) { bf16_t* rowp = O + (size_t)(row0 + ai * 128 + m * 16) * ldc + col0;
#pragma unroll
                for (int bj = 0; bj < 2; ++bj) { const f32x4 v0 = acc[ai][bj][m][0], v1 = acc[ai][bj][m][1];
                    u32x4 w; w.x = pk2(v0[0], v0[1]); w.y = pk2(v0[2], v0[3]); w.z = pk2(v1[0], v1[1]); w.w = pk2(v1[2], v1[3]);
                    *(u32x4*)(rowp + bj * 128) = w; } }
    }
};
struct EpiBf16I8 {
    static constexpr bool PERM = true;
    bf16_t* O; int ldc; const float* sa; const float* sw;
    DI void operator()(const i32x4 (&acc)[2][2][4][2], const pg8::Unit& u, int wr, int wc, int fr, int fq) const {
        const int row0 = u.pm * 256 + wr * 64 + fr, col0 = u.pn * 256 + wc * 32 + 8 * fq;
        f32x4 w0[2], w1[2];
#pragma unroll
        for (int bj = 0; bj < 2; ++bj) { w0[bj] = *(const f32x4*)(sw + col0 + bj * 128); w1[bj] = *(const f32x4*)(sw + col0 + bj * 128 + 4); }
#pragma unroll
        for (int ai = 0; ai < 2; ++ai)
#pragma unroll
            for (int m = 0; m < 4; ++m) { const int row = row0 + ai * 128 + m * 16; const float ra = sa[row]; bf16_t* rowp = O + (size_t)row * ldc + col0;
#pragma unroll
                for (int bj = 0; bj < 2; ++bj) { const i32x4 a0 = acc[ai][bj][m][0], a1 = acc[ai][bj][m][1];
                    u32x4 w; w.x = pk2((float)a0[0] * ra * w0[bj][0], (float)a0[1] * ra * w0[bj][1]); w.y = pk2((float)a0[2] * ra * w0[bj][2], (float)a0[3] * ra * w0[bj][3]);
                    w.z = pk2((float)a1[0] * ra * w1[bj][0], (float)a1[1] * ra * w1[bj][1]); w.w = pk2((float)a1[2] * ra * w1[bj][2], (float)a1[3] * ra * w1[bj][3]);
                    *(u32x4*)(rowp + bj * 128) = w; } }
    }
};
struct EpiResGate {
    static constexpr bool PERM = false;
    const float* xin; float* out; const float* gt; float* rowss; const float* n2g;
    DI void operator()(const f32x4 (&acc)[2][2][4][2], const pg8::Unit& u, int wr, int wc, int fr, int fq) const {
        const int row0 = u.pm * 256 + wr * 64 + fr, col0 = u.pn * 256 + wc * 32 + 4 * fq;
        const int b = (u.pm * 256) / SEQ;
        const int ln = lane_opaque();
        f32x4 g[2][2], G2[2][2];
#pragma unroll
        for (int bj = 0; bj < 2; ++bj)
#pragma unroll
            for (int n = 0; n < 2; ++n) { g[bj][n] = *(const f32x4*)(gt + (size_t)b * 6144 + col0 + bj * 128 + n * 16);
                G2[bj][n] = *(const f32x4*)(n2g + col0 + bj * 128 + n * 16) * (*(const f32x4*)(gt + (size_t)b * 6144 + 2048 + col0 + bj * 128 + n * 16) + 1.f); }
#pragma unroll
        for (int ai = 0; ai < 2; ++ai)
#pragma unroll
            for (int m = 0; m < 4; ++m) { const size_t ro = (size_t)(row0 + ai * 128 + m * 16) * DM + col0; float ss = 0.f, mxg = 0.f;
#pragma unroll
                for (int bj = 0; bj < 2; ++bj)
#pragma unroll
                    for (int n = 0; n < 2; ++n) { const f32x4 xv = *(const f32x4*)(xin + ro + bj * 128 + n * 16); const f32x4 v = xv + g[bj][n] * acc[ai][bj][m][n];
                        *(f32x4*)(out + ro + bj * 128 + n * 16) = v; ss += (v[0] * v[0] + v[1] * v[1]) + (v[2] * v[2] + v[3] * v[3]);
                        const f32x4 vg = v * G2[bj][n]; mxg = fmaxf(mxg, fmaxf(fmaxf(fabsf(vg[0]), fabsf(vg[1])), fmaxf(fabsf(vg[2]), fabsf(vg[3])))); }
                ss += shfl_xor_l(ss, 16, ln); ss += shfl_xor_l(ss, 32, ln); mxg = fmaxf(mxg, shfl_xor_l(mxg, 16, ln)); mxg = fmaxf(mxg, shfl_xor_l(mxg, 32, ln));
                if (fq == 0) { float* rp = rowss + (size_t)(row0 + ai * 128 + m * 16) * 32 + u.pn * 4 + wc; rp[0] = ss; rp[16] = mxg; } }
    }
};
struct EpiGlu {
    static constexpr bool PERM = true;
    const bf16_t* Y; bf16_t* O; const float* bias;
    DI void operator()(const f32x4 (&acc)[2][2][4][2], const pg8::Unit& u, int wr, int wc, int fr, int fq) const {
        const int row0 = u.pm * 256 + wr * 64 + fr, col0 = wc * 32 + 8 * fq;
#pragma unroll
        for (int ai = 0; ai < 2; ++ai)
#pragma unroll
            for (int m = 0; m < 4; ++m) { const size_t ro = (size_t)(row0 + ai * 128 + m * 16) * 256 + col0;
#pragma unroll
                for (int bj = 0; bj < 2; ++bj) { const u32x4 yv = *(const u32x4*)(Y + ro + bj * 128);
                    const f32x4 b0 = *(const f32x4*)(bias + col0 + bj * 128), b1 = *(const f32x4*)(bias + col0 + bj * 128 + 4);
                    const f32x4 v0 = acc[ai][bj][m][0] + b0, v1 = acc[ai][bj][m][1] + b1;
                    u32x4 w;
                    w.x = pk2(bflo(yv.x) * sigmoidf_(v0[0]), bfhi(yv.x) * sigmoidf_(v0[1]));
                    w.y = pk2(bflo(yv.y) * sigmoidf_(v0[2]), bfhi(yv.y) * sigmoidf_(v0[3]));
                    w.z = pk2(bflo(yv.z) * sigmoidf_(v1[0]), bfhi(yv.z) * sigmoidf_(v1[1]));
                    w.w = pk2(bflo(yv.w) * sigmoidf_(v1[2]), bfhi(yv.w) * sigmoidf_(v1[3]));
                    *(u32x4*)(O + ro + bj * 128) = w; } }
    }
};

struct Frame { LAS unsigned char* lds; int tid, lane, wave, G, bid, gw, ngw; };

DI Frame make_frame(LAS unsigned char* lds, int wave0) {
    Frame F; F.lds = lds; int w = wave0; asm volatile("" : "+s"(w)); F.wave = w; F.lane = lane_opaque(); F.tid = w * 64 + F.lane;
    F.G = gridDim.x; F.bid = blockIdx.x; F.gw = F.bid * NWAVES + F.wave; F.ngw = F.G * NWAVES; return F;
}
DI void transpose_item(const float* src, int ld_src, int k0, int n0, bf16_t* dst, int ldd, int nd0, int kd0, LAS float* scr, int lane) {
#pragma unroll 8
    for (int i = 0; i < 32; ++i) { const int kk = 2 * i + (lane >> 5); scr[kk * 33 + (lane & 31)] = src[(size_t)(k0 + kk) * ld_src + n0 + (lane & 31)]; }
    asm volatile("s_waitcnt lgkmcnt(0)" ::: "memory");
    const int c = lane & 7;
#pragma unroll
    for (int j = 0; j < 4; ++j) { const int n = (lane >> 3) + 8 * j; const LAS float* s = scr + (8 * c) * 33 + n;
        u32x4 o; o.x = pk2(s[0 * 33], s[1 * 33]); o.y = pk2(s[2 * 33], s[3 * 33]); o.z = pk2(s[4 * 33], s[5 * 33]); o.w = pk2(s[6 * 33], s[7 * 33]);
        *(u32x4*)(dst + (size_t)(nd0 + n) * ldd + kd0 + 8 * c) = o; }
    asm volatile("s_waitcnt lgkmcnt(0)" ::: "memory");
}
DI void transpose_item64(const float* src, int ld_src, int k0, int n0, bf16_t* dst, int ldd, int nd0, int kd0, LAS float* scr, int lane) {
    f32x4 v[16];
#pragma unroll
    for (int i = 0; i < 16; ++i) v[i] = *(const f32x4*)(src + (size_t)(k0 + 4 * i + (lane >> 4)) * ld_src + n0 + 4 * (lane & 15));
#pragma unroll
    for (int i = 0; i < 16; ++i) { LAS float* p = scr + (4 * i + (lane >> 4)) * 65 + 4 * (lane & 15); p[0] = v[i][0]; p[1] = v[i][1]; p[2] = v[i][2]; p[3] = v[i][3]; }
    asm volatile("s_waitcnt lgkmcnt(0)" ::: "memory");
    const int c = lane & 7;
#pragma unroll
    for (int j = 0; j < 8; ++j) { const int n = (lane >> 3) + 8 * j; const LAS float* q = scr + (8 * c) * 65 + n;
        u32x4 o; o.x = pk2(q[0 * 65], q[1 * 65]); o.y = pk2(q[2 * 65], q[3 * 65]); o.z = pk2(q[4 * 65], q[5 * 65]); o.w = pk2(q[6 * 65], q[7 * 65]);
        *(u32x4*)(dst + (size_t)(nd0 + n) * ldd + kd0 + 8 * c) = o; }
    asm volatile("s_waitcnt lgkmcnt(0)" ::: "memory");
}
DI void quant_item64(const float* src, int ld_src, int k0, int n0, signed char* dst, int ldd, int nd0, int kd0, const unsigned* colmax, float* wsc, LAS float* scr, int lane, int nvalid = 1 << 30) {
    f32x4 v[16]; const bool okc = n0 + 4 * (lane & 15) < nvalid;
#pragma unroll
    for (int i = 0; i < 16; ++i) { v[i] = (f32x4){0.f, 0.f, 0.f, 0.f}; if (okc) v[i] = *(const f32x4*)(src + (size_t)(k0 + 4 * i + (lane >> 4)) * ld_src + n0 + 4 * (lane & 15)); }
#pragma unroll
    for (int i = 0; i < 16; ++i) { LAS float* p = scr + (4 * i + (lane >> 4)) * 65 + 4 * (lane & 15); p[0] = v[i][0]; p[1] = v[i][1]; p[2] = v[i][2]; p[3] = v[i][3]; }
    asm volatile("s_waitcnt lgkmcnt(0)" ::: "memory");
    const int c = lane & 7;
#pragma unroll
    for (int j = 0; j < 8; ++j) { const int n = (lane >> 3) + 8 * j; const LAS float* q = scr + (8 * c) * 65 + n;
        const float sc = fmaxf(__uint_as_float(colmax[n]), 1e-30f) * (1.f / 127.f), inv = 1.f / sc;
        if (wsc && c == 0) wsc[n] = sc;
        u32x2 o; o.x = q8x4((f32x4){q[0 * 65], q[1 * 65], q[2 * 65], q[3 * 65]}, inv); o.y = q8x4((f32x4){q[4 * 65], q[5 * 65], q[6 * 65], q[7 * 65]}, inv);
        *(u32x2*)(dst + (size_t)(nd0 + n) * ldd + kd0 + 8 * c) = o; }
    asm volatile("s_waitcnt lgkmcnt(0)" ::: "memory");
}
DI void quant_strip64(const float* src, int ld_src, int n0, int nvalid, signed char* dst, int ldd, float* scale, LAS float* scr, int lane) {
    const int c4 = n0 + 4 * (lane & 15); const bool okc = c4 < nvalid;
    float mx[4] = {0.f, 0.f, 0.f, 0.f};
    for (int kb = 0; kb < 16; ++kb) {
#pragma unroll
        for (int i = 0; i < 16; ++i) { f32x4 v = {0.f, 0.f, 0.f, 0.f}; if (okc) v = *(const f32x4*)(src + (size_t)(64 * kb + 4 * i + (lane >> 4)) * ld_src + c4);
            mx[0] = fmaxf(mx[0], fabsf(v[0])); mx[1] = fmaxf(mx[1], fabsf(v[1])); mx[2] = fmaxf(mx[2], fabsf(v[2])); mx[3] = fmaxf(mx[3], fabsf(v[3])); } }
#pragma unroll
    for (int q = 0; q < 4; ++q) { mx[q] = fmaxf(mx[q], shfl_xor_l(mx[q], 16, lane)); mx[q] = fmaxf(mx[q], shfl_xor_l(mx[q], 32, lane)); }
    LAS float* smax = scr + 64 * 65;
    if (lane < 16) {
#pragma unroll
        for (int q = 0; q < 4; ++q) { const float sc = fmaxf(mx[q], 1e-30f) * (1.f / 127.f); smax[4 * lane + q] = sc; scale[4 * lane + q] = sc; } }
    asm volatile("s_waitcnt lgkmcnt(0)" ::: "memory");
    for (int kb = 0; kb < 16; ++kb) {
        f32x4 v[16];
#pragma unroll
        for (int i = 0; i < 16; ++i) { v[i] = (f32x4){0.f, 0.f, 0.f, 0.f}; if (okc) v[i] = *(const f32x4*)(src + (size_t)(64 * kb + 4 * i + (lane >> 4)) * ld_src + c4); }
#pragma unroll
        for (int i = 0; i < 16; ++i) { LAS float* p = scr + (4 * i + (lane >> 4)) * 65 + 4 * (lane & 15); p[0] = v[i][0]; p[1] = v[i][1]; p[2] = v[i][2]; p[3] = v[i][3]; }
        asm volatile("s_waitcnt lgkmcnt(0)" ::: "memory");
        const int c = lane & 7;
#pragma unroll
        for (int j = 0; j < 8; ++j) { const int n = (lane >> 3) + 8 * j; const LAS float* q = scr + (8 * c) * 65 + n; const float inv = 1.f / smax[n];
            u32x2 o; o.x = q8x4((f32x4){q[0 * 65], q[1 * 65], q[2 * 65], q[3 * 65]}, inv); o.y = q8x4((f32x4){q[4 * 65], q[5 * 65], q[6 * 65], q[7 * 65]}, inv);
            *(u32x2*)(dst + (size_t)n * ldd + 64 * kb + 8 * c) = o; }
        asm volatile("s_waitcnt lgkmcnt(0)" ::: "memory");
    }
}
DI void zero_rows(bf16_t* dst, int ld, int r0, int nr, int c0, int nc, int gw, int ngw, int lane) {
    for (int r = gw; r < nr; r += ngw) for (int c = lane * 8; c < nc; c += 512) *(u32x4*)(dst + (size_t)(r0 + r) * ld + c0 + c) = (u32x4){0u, 0u, 0u, 0u};
}

DI void phase_prologue(const Frame& F, CArgs& A) {
    unsigned char* ws = A.ws;
    LAS float* sc = (LAS float*)F.lds;
    LAS float* part = (LAS float*)(F.lds + 32768);
    for (int i = F.tid; i < 8192; i += NTHR) sc[i] = siluf_(A.in[1][i]);
    __syncthreads();
    float* MOD = (float*)(ws + WS_MOD);
    for (int item = F.bid; item < 192; item += F.G) {
        const int l = item / 96, n0 = (item % 96) * 64, nl = F.tid & 63, kg = F.tid >> 6;
        const float* W = A.in[3] + (size_t)l * 1024 * 6144 + n0 + nl;
        float acc[8];
#pragma unroll
        for (int b = 0; b < 8; ++b) acc[b] = 0.f;
        for (int k = kg * 128; k < kg * 128 + 128; ++k) { const float w = W[(size_t)k * 6144];
#pragma unroll
            for (int b = 0; b < 8; ++b) acc[b] += sc[b * 1024 + k] * w; }
#pragma unroll
        for (int b = 0; b < 8; ++b) part[(kg * 8 + b) * 64 + nl] = acc[b];
        __syncthreads();
        { const int b = F.tid >> 6; float s = A.in[4][l * 6144 + n0 + nl];
#pragma unroll
          for (int g = 0; g < 8; ++g) s += part[(g * 8 + b) * 64 + nl];
          MOD[((size_t)l * 8 + b) * 6144 + n0 + nl] = s; }
        __syncthreads();
    }
    LAS float* scr = (LAS float*)(F.lds + F.wave * 16896);
    bf16_t* WIN = (bf16_t*)(ws + WS_WIN); bf16_t* WOUT = (bf16_t*)(ws + WS_WOUT); bf16_t* WMLA = (bf16_t*)(ws + WS_WMLA); bf16_t* WGLU = (bf16_t*)(ws + WS_WGLU);
    constexpr int I_IN = 0, I_INT = 0, I_OUT = 16 * 16, I_Q = 4 * 6, I_KV = 2 * 8, I_GLU = 4 * 4, I_L = I_IN + I_INT + I_OUT + I_Q + I_KV + I_GLU;
    for (int it = F.gw; it < 2 * I_L; it += F.ngw) {
        const int l = it / I_L; int r = it % I_L;
        if (r < I_IN) { transpose_item64(A.in[6] + (size_t)l * 1024 * D_IN, D_IN, 64 * (r / 32), 64 * (r % 32), WIN + (size_t)l * ZS * 1024, 1024, 64 * (r % 32), 64 * (r / 32), scr, F.lane); continue; } r -= I_IN;
        if (r < I_INT) { transpose_item(A.in[6] + (size_t)l * 1024 * D_IN, D_IN, 64 * r, 2048, WIN + (size_t)l * ZS * 1024, 1024, 2048, 64 * r, scr, F.lane); continue; } r -= I_INT;
        if (r < I_OUT) { transpose_item64(A.in[42] + (size_t)l * 1024 * 1024, 1024, 64 * (r / 16), 64 * (r % 16), WOUT + (size_t)l * 1024 * 1024, 1024, 64 * (r % 16), 64 * (r / 16), scr, F.lane); continue; } r -= I_OUT;
        if (r < I_Q) { transpose_item64(A.in[29] + (size_t)l * 256 * 384, 384, 64 * (r / 6), 64 * (r % 6), WMLA + (size_t)l * 1024 * 512, 512, 64 * (r % 6), 64 * (r / 6), scr, F.lane); continue; } r -= I_Q;
        if (r < I_KV) { transpose_item64(A.in[31] + (size_t)l * 128 * 512, 512, 64 * (r / 8), 64 * (r % 8), WMLA + (size_t)l * 1024 * 512, 512, 384 + 64 * (r % 8), 256 + 64 * (r / 8), scr, F.lane); continue; } r -= I_KV;
        transpose_item64(A.in[26] + (size_t)l * 256 * 256, 256, 64 * (r / 4), 64 * (r % 4), WGLU + (size_t)l * 256 * 256, 256, 64 * (r % 4), 64 * (r / 4), scr, F.lane);
    }
    { unsigned* CM = (unsigned*)(ws + WS_CTL) + CW_COLMAX;
      for (int it = F.gw; it < 2 * 32 * 2 * 128; it += F.ngw) { const int le = it >> 8, which = (it >> 7) & 1, kb = (it >> 3) & 15, nb = it & 7;
          const float* src = (which ? A.in[49] : A.in[48]) + (size_t)le * 1024 * 512 + (size_t)(64 * kb + (F.lane >> 4)) * 512 + 64 * nb + 4 * (F.lane & 15);
          float mx[4] = {0.f, 0.f, 0.f, 0.f};
#pragma unroll
          for (int i = 0; i < 16; ++i) { const f32x4 v = *(const f32x4*)(src + (size_t)(4 * i) * 512);
              mx[0] = fmaxf(mx[0], fabsf(v[0])); mx[1] = fmaxf(mx[1], fabsf(v[1])); mx[2] = fmaxf(mx[2], fabsf(v[2])); mx[3] = fmaxf(mx[3], fabsf(v[3])); }
#pragma unroll
          for (int q = 0; q < 4; ++q) { mx[q] = fmaxf(mx[q], shfl_xor_l(mx[q], 16, F.lane)); mx[q] = fmaxf(mx[q], shfl_xor_l(mx[q], 32, F.lane)); }
          if (F.lane < 16) { const int n0 = 64 * nb + 4 * F.lane, np = 256 * (n0 >> 7) + (n0 & 127) + 128 * which;
#pragma unroll
              for (int q = 0; q < 4; ++q) atomicMax(CM + (size_t)le * 1024 + np + q, __float_as_uint(mx[q])); } } }
    { unsigned* IM = (unsigned*)(ws + WS_CTL) + CW_INMAX;
      for (int it = F.gw; it < 2 * 16 * 33; it += F.ngw) { const int l = it / (16 * 33), r = it % (16 * 33), kb = r / 33, nb = r % 33;
          const int c4 = 64 * nb + 4 * (F.lane & 15); const bool okc = c4 < D_IN;
          const float* src = A.in[6] + (size_t)l * 1024 * D_IN + (size_t)(64 * kb + (F.lane >> 4)) * D_IN + c4;
          float mx[4] = {0.f, 0.f, 0.f, 0.f};
#pragma unroll
          for (int i = 0; i < 16; ++i) { f32x4 v = {0.f, 0.f, 0.f, 0.f}; if (okc) v = *(const f32x4*)(src + (size_t)(4 * i) * D_IN);
              mx[0] = fmaxf(mx[0], fabsf(v[0])); mx[1] = fmaxf(mx[1], fabsf(v[1])); mx[2] = fmaxf(mx[2], fabsf(v[2])); mx[3] = fmaxf(mx[3], fabsf(v[3])); }
#pragma unroll
          for (int q = 0; q < 4; ++q) { mx[q] = fmaxf(mx[q], shfl_xor_l(mx[q], 16, F.lane)); mx[q] = fmaxf(mx[q], shfl_xor_l(mx[q], 32, F.lane)); }
          if (F.lane < 16) {
#pragma unroll
              for (int q = 0; q < 4; ++q) atomicMax(IM + l * ZS + c4 + q, __float_as_uint(mx[q])); } }
      for (int l = 0; l < 2; ++l) {
          signed char* w8 = (signed char*)(ws + WS_WIN) + ((size_t)l * ZS + 2112) * 1024;
          for (int i = F.bid * NTHR + F.tid; i < 192 * 1024 / 16; i += F.G * NTHR) *(u32x4*)(w8 + (size_t)i * 16) = (u32x4){0u, 0u, 0u, 0u};
          for (int i = F.bid * NTHR + F.tid; i < 192; i += F.G * NTHR) ((float*)(ws + WS_WINSC))[l * ZS + 2112 + i] = 0.f; } }
    { bf16_t* WR = (bf16_t*)(ws + WS_WR);
      for (int i = F.bid * NTHR + F.tid; i < 2 * 48 * 1024; i += F.G * NTHR) { const int l = i / (48 * 1024), n = (i / 1024) % 48, k = i % 1024;
          const float v = n < 4 ? A.in[44][((size_t)l * 1024 + k) * 4 + n] : n < 36 ? A.in[46][((size_t)l * 1024 + k) * 32 + (n - 4)] : 0.f;
          const unsigned hi = f2bf(v); const float rem = v - __uint_as_float(hi << 16);
          WR[((size_t)(l * 2 + 0) * 48 + n) * 1024 + k] = (bf16_t)hi; WR[((size_t)(l * 2 + 1) * 48 + n) * 1024 + k] = (bf16_t)f2bf(rem); } }
    { bf16_t* WL = (bf16_t*)(ws + WS_WLRU); bf16_t* WO = (bf16_t*)(ws + WS_WLORA);
      for (int i = F.bid * NTHR + F.tid; i < 2 * 2 * 4 * 4096; i += F.G * NTHR) { const int l = i >> 15, wh = (i >> 14) & 1, n = (i >> 12) & 3, j = (i >> 6) & 63, k = i & 63;
          WL[i] = (bf16_t)f2bf((wh ? A.in[38] : A.in[36])[((size_t)(l * 4 + n) * 64 + k) * 64 + j]); }
      for (int i = F.bid * NTHR + F.tid; i < 2 * 32768; i += F.G * NTHR) { const int l = i >> 15, r = i & 32767;
          float v;
          if (r < 8192) v = A.in[9][(size_t)l * 8192 + (r & 31) * 256 + (r >> 5)];
          else if (r < 16384) v = A.in[11][(size_t)l * 8192 + ((r - 8192) & 31) * 256 + ((r - 8192) >> 5)];
          else v = A.in[12][(size_t)l * 16384 + ((r - 16384) & 63) * 256 + ((r - 16384) >> 6)];
          WO[i] = (bf16_t)f2bf(v); } }
    { bf16_t* BBt = (bf16_t*)(ws + WS_S5BB); bf16_t* CCt = (bf16_t*)(ws + WS_S5CC);
      for (int i = F.bid * NTHR + F.tid; i < 2 * 16 * 64; i += F.G * NTHR) { const int lg = i >> 6, p = i & 63;
          const float dt = __expf(A.in[25][lg]); const float lre = A.in[18][lg * 64 + p], lim = A.in[19][lg * 64 + p];
          const float mag = expf(lre * dt); float sn, cn; sincosf(lim * dt, &sn, &cn);
          const float are = mag * cn, aim = mag * sn, den = lre * lre + lim * lim;
          const float qre = ((are - 1.f) * lre + aim * lim) / den, qim = (aim * lre - (are - 1.f) * lim) / den;
          const float* br = A.in[20] + ((size_t)lg * 64 + p) * 16; const float* bi = A.in[21] + ((size_t)lg * 64 + p) * 16;
          for (int c = 0; c < 16; ++c) { const float x = br[c], y = bi[c];
              BBt[(((size_t)lg * 2 + 0) * 64 + p) * 16 + c] = (bf16_t)f2bf(qre * x - qim * y); BBt[(((size_t)lg * 2 + 1) * 64 + p) * 16 + c] = (bf16_t)f2bf(qre * y + qim * x); } }
      for (int i = F.bid * NTHR + F.tid; i < 2 * 16 * 16 * 128; i += F.G * NTHR) { const int lg = i >> 11, ii = (i >> 7) & 15, k = i & 127;
          CCt[i] = (bf16_t)f2bf(k < 64 ? A.in[22][((size_t)lg * 16 + ii) * 64 + k] : -A.in[23][((size_t)lg * 16 + ii) * 64 + (k - 64)]); } }
    for (int l = 0; l < 2; ++l) {
        bf16_t* wm = WMLA + (size_t)l * 1024 * 512;
        zero_rows(wm, 512, 0, 384, 256, 256, F.gw, F.ngw, F.lane);
        zero_rows(wm, 512, 384, 512, 0, 256, F.gw, F.ngw, F.lane);
        zero_rows(wm, 512, 384, 512, 384, 128, F.gw, F.ngw, F.lane);
        zero_rows(wm, 512, 896, 128, 0, 512, F.gw, F.ngw, F.lane);
    }
}

DI void phase_win_quant(const Frame& F, CArgs& A) {
    LAS float* scr = (LAS float*)(F.lds + F.wave * 16640);
    const unsigned* IM = (const unsigned*)(A.ws + WS_CTL) + CW_INMAX;
    for (int it = F.gw; it < 2 * 16 * 33; it += F.ngw) { const int l = it / (16 * 33), r = it % (16 * 33), kb = r / 33, nb = r % 33;
        quant_item64(A.in[6] + (size_t)l * 1024 * D_IN, D_IN, 64 * kb, 64 * nb, (signed char*)(A.ws + WS_WIN) + (size_t)l * ZS * 1024, 1024, 64 * nb, 64 * kb, IM + l * ZS + 64 * nb,
                     kb == 0 ? (float*)(A.ws + WS_WINSC) + l * ZS + 64 * nb : (float*)nullptr, scr, F.lane, D_IN); }
}
DI void phase_norm1(const Frame& F, CArgs& A, int l) {
    const float* MODL = (const float*)(A.ws + WS_MOD) + (size_t)l * 8 * 6144;
    const float* g = A.in[5] + l * 1024;
    const bf16_t* Y = (const bf16_t*)(A.ws + WS_Y);
    signed char* H8 = (signed char*)(A.ws + WS_H); float* HS = (float*)(A.ws + WS_HSC);
    const float* src = (l == 0) ? A.in[0] : A.out;
    for (int row0 = 2 * F.gw; row0 < T; row0 += 2 * F.ngw) {
        const int b = row0 / SEQ;
        f32x4 v[2][4]; u32x2 ya[2][4], yb[2][4];
#pragma unroll
        for (int r = 0; r < 2; ++r)
#pragma unroll
            for (int j = 0; j < 4; ++j) { const int col = 4 * (64 * j + F.lane); v[r][j] = *(const f32x4*)(src + (size_t)(row0 + r) * DM + col);
                if (l > 0) { ya[r][j] = *(const u32x2*)(Y + (size_t)(2 * (row0 + r)) * DM + col); yb[r][j] = *(const u32x2*)(Y + (size_t)(2 * (row0 + r) + 1) * DM + col); } }
#pragma unroll
        for (int r = 0; r < 2; ++r) {
            const int row = row0 + r; float ss = 0.f;
#pragma unroll
            for (int j = 0; j < 4; ++j) { const int col = 4 * (64 * j + F.lane);
                if (l > 0) { const u32x2 y0 = ya[r][j], y1 = yb[r][j];
                    v[r][j][0] += bflo(y0.x) + bflo(y1.x); v[r][j][1] += bfhi(y0.x) + bfhi(y1.x); v[r][j][2] += bflo(y0.y) + bflo(y1.y); v[r][j][3] += bfhi(y0.y) + bfhi(y1.y);
                    *(f32x4*)(A.out + (size_t)row * DM + col) = v[r][j]; }
                ss += v[r][j][0] * v[r][j][0] + v[r][j][1] * v[r][j][1] + v[r][j][2] * v[r][j][2] + v[r][j][3] * v[r][j][3]; }
            const float rstd = rsqrtf(wave_sum(ss) * (1.f / DM) + NORM_EPS);
#pragma unroll
            for (int j = 0; j < 4; ++j) { const int col = 4 * (64 * j + F.lane);
                const f32x4 gg = *(const f32x4*)(g + col), sh = *(const f32x4*)(MODL + (size_t)b * 6144 + col), scv = *(const f32x4*)(MODL + (size_t)b * 6144 + 1024 + col);
                v[r][j] = v[r][j] * rstd * gg * (scv + 1.f) + sh; }
            float mx = 0.f;
#pragma unroll
            for (int j = 0; j < 4; ++j) mx = fmaxf(mx, fmaxf(fmaxf(fabsf(v[r][j][0]), fabsf(v[r][j][1])), fmaxf(fabsf(v[r][j][2]), fabsf(v[r][j][3]))));
            mx = fmaxf(wave_max(mx), 1e-30f); const float inv = 127.f / mx;
            if (F.lane == 0) HS[row] = mx * (1.f / 127.f);
#pragma unroll
            for (int j = 0; j < 4; ++j) *(unsigned*)(H8 + (size_t)row * DM + 4 * (64 * j + F.lane)) = q8x4(v[r][j], inv);
        }
    }
}

DI void phase_mla_prep(const Frame& F, CArgs& A, int l) {
    const bf16_t* Z = (const bf16_t*)(A.ws + WS_Z); bf16_t* AM = (bf16_t*)(A.ws + WS_AMLA);
    const float* qg = A.in[28] + l * 256; const float* kg = A.in[30] + l * 128;
    for (int row = F.gw; row < T; row += F.ngw) {
        const bf16_t* zr = Z + (size_t)row * ZS;
        const u32x2 qv = *(const u32x2*)(zr + ZC_QA + 4 * F.lane); const unsigned kv = *(const unsigned*)(zr + ZC_KVA + 2 * F.lane);
        const float q0 = bflo(qv.x), q1 = bfhi(qv.x), q2 = bflo(qv.y), q3 = bfhi(qv.y), k0 = bflo(kv), k1 = bfhi(kv);
        const float rq = rsqrtf(wave_sum(q0 * q0 + q1 * q1 + q2 * q2 + q3 * q3) * (1.f / 256.f) + NORM_EPS);
        const float rk = rsqrtf(wave_sum(k0 * k0 + k1 * k1) * (1.f / 128.f) + NORM_EPS);
        const f32x4 g4 = *(const f32x4*)(qg + 4 * F.lane); const f32x2 g2 = *(const f32x2*)(kg + 2 * F.lane);
        u32x2 o; o.x = pk2(q0 * rq * g4[0], q1 * rq * g4[1]); o.y = pk2(q2 * rq * g4[2], q3 * rq * g4[3]);
        bf16_t* ar = AM + (size_t)row * 512;
        *(u32x2*)(ar + 4 * F.lane) = o;
        *(unsigned*)(ar + 256 + 2 * F.lane) = pk2(k0 * rk * g2[0], k1 * rk * g2[1]);
        *(unsigned*)(ar + 384 + 2 * F.lane) = 0u;
    }
}

DI void phase_mla_post(const Frame& F, CArgs& A, int l) {
    const bf16_t* Z = (const bf16_t*)(A.ws + WS_Z); const bf16_t* RAW = (const bf16_t*)(A.ws + WS_QKVRAW);
    bf16_t* Q = (bf16_t*)(A.ws + WS_Q); bf16_t* K = (bf16_t*)(A.ws + WS_K); bf16_t* VT = (bf16_t*)(A.ws + WS_VT);
    LAS float* cs = (LAS float*)F.lds;
    LAS bf16_t* vt = (LAS bf16_t*)(F.lds + 8192);
    const float* qhg = A.in[32] + l * 96; const float* khg = A.in[33] + l * 96;
    for (int tile = F.bid; tile < T / 64; tile += F.G) {
        const int t0 = tile * 64, b = t0 / SEQ, s0 = t0 % SEQ;
        int tz = F.tid; asm volatile("" : "+v"(tz));
        for (int idx = tz; idx < 1024; idx += NTHR) { const int tok = idx >> 4, i = idx & 15;
            const int pos = A.pos_off[b] + s0 + tok; const float inv = powf(10000.f, -(float)i * (1.f / 16.f));
            double ang = (double)(float)pos * (double)inv; ang -= 6.283185307179586 * floor(ang * 0.15915494309189535);
            float sn, cn; sincosf((float)ang, &sn, &cn); cs[idx * 2] = cn; cs[idx * 2 + 1] = sn; }
        lds_barrier();
        const int tok = tz >> 3, sub = tz & 7, h = sub >> 1, isk = sub & 1, t = t0 + tok;
        {
            float v[96];
            const bf16_t* p0 = isk ? RAW + (size_t)t * 1024 + 384 + 128 * h : RAW + (size_t)t * 1024 + 96 * h;
            const bf16_t* p1 = isk ? Z + (size_t)t * ZS + ZC_KPE : p0 + 64;
#pragma unroll
            for (int c = 0; c < 8; ++c) { const u32x4 w = *(const u32x4*)(p0 + 8 * c);
                v[8 * c] = bflo(w.x); v[8 * c + 1] = bfhi(w.x); v[8 * c + 2] = bflo(w.y); v[8 * c + 3] = bfhi(w.y); v[8 * c + 4] = bflo(w.z); v[8 * c + 5] = bfhi(w.z); v[8 * c + 6] = bflo(w.w); v[8 * c + 7] = bfhi(w.w); }
#pragma unroll
            for (int c = 0; c < 4; ++c) { const u32x4 w = *(const u32x4*)(p1 + 8 * c);
                v[64 + 8 * c] = bflo(w.x); v[65 + 8 * c] = bfhi(w.x); v[66 + 8 * c] = bflo(w.y); v[67 + 8 * c] = bfhi(w.y); v[68 + 8 * c] = bflo(w.z); v[69 + 8 * c] = bfhi(w.z); v[70 + 8 * c] = bflo(w.w); v[71 + 8 * c] = bfhi(w.w); }
            float ss = 0.f;
#pragma unroll
            for (int i = 0; i < 96; ++i) ss += v[i] * v[i];
            const float r = rsqrtf(ss * (1.f / 96.f) + NORM_EPS);
            const float* hg = isk ? khg : qhg;
#pragma unroll
            for (int i = 0; i < 96; ++i) v[i] = v[i] * r * hg[i];
#pragma unroll
            for (int i = 0; i < 16; ++i) { const float cn = cs[(tok * 16 + i) * 2], sn = cs[(tok * 16 + i) * 2 + 1]; const float x1 = v[64 + i], x2 = v[80 + i];
                v[64 + i] = x1 * cn - x2 * sn; v[80 + i] = x1 * sn + x2 * cn; }
            bf16_t* dst = (isk ? K : Q) + ((size_t)t * 4 + h) * 96;
#pragma unroll
            for (int c = 0; c < 12; ++c) { u32x4 w; w.x = pk2(v[8 * c], v[8 * c + 1]); w.y = pk2(v[8 * c + 2], v[8 * c + 3]); w.z = pk2(v[8 * c + 4], v[8 * c + 5]); w.w = pk2(v[8 * c + 6], v[8 * c + 7]);
                *(u32x4*)(dst + 8 * c) = w; }
        }
        {
            const bf16_t* pv = RAW + (size_t)t * 1024 + 384 + 128 * h + 64 + 32 * isk;
#pragma unroll
            for (int c = 0; c < 4; ++c) { const u32x4 w = *(const u32x4*)(pv + 8 * c); const int r0 = h * 64 + 32 * isk + 8 * c;
                vt[(r0 + 0) * 72 + tok] = (bf16_t)(w.x & 0xffffu); vt[(r0 + 1) * 72 + tok] = (bf16_t)(w.x >> 16);
                vt[(r0 + 2) * 72 + tok] = (bf16_t)(w.y & 0xffffu); vt[(r0 + 3) * 72 + tok] = (bf16_t)(w.y >> 16);
                vt[(r0 + 4) * 72 + tok] = (bf16_t)(w.z & 0xffffu); vt[(r0 + 5) * 72 + tok] = (bf16_t)(w.z >> 16);
                vt[(r0 + 6) * 72 + tok] = (bf16_t)(w.w & 0xffffu); vt[(r0 + 7) * 72 + tok] = (bf16_t)(w.w >> 16); }
        }
        lds_barrier();
        { const int row = tz >> 1, hf = tz & 1;
          bf16_t* dst = VT + ((size_t)(b * 4) * 64 + row) * SEQ + s0 + 32 * hf;
#pragma unroll
          for (int c = 0; c < 4; ++c) *(u32x4*)(dst + 8 * c) = *(const LAS u32x4*)(vt + row * 72 + 32 * hf + 8 * c); }
        lds_barrier();
    }
}

DI void attn_unit(const Frame& F, const bf16_t* Q, const bf16_t* K, const bf16_t* VT, bf16_t* O, int bh, int u, float eoff) {
    constexpr int KP = 208, VP = 144, KB = 64 * KP, VB = 64 * VP;
    LAS unsigned char* Ks = F.lds; LAS unsigned char* Vs = F.lds + 2 * KB;
    int tz = F.tid; asm volatile("" : "+v"(tz));
    const int b = bh >> 2, h = bh & 3, lane = tz & 63, w = F.wave, ql = lane & 31, hh = lane >> 5;
    const int ntile = 8 * u + 8, myl = 8 * u + w;
    const size_t tq0 = (size_t)b * SEQ + 512 * u + 64 * w + ql;
    bf16x8 qf[2][6];
#pragma unroll
    for (int qt = 0; qt < 2; ++qt)
#pragma unroll
        for (int s = 0; s < 6; ++s) qf[qt][s] = *(const bf16x8*)(Q + ((tq0 + 32 * qt) * 4 + h) * 96 + 16 * s + 8 * hh);
    f32x16 ot[2][2];
#pragma unroll
    for (int i = 0; i < 16; ++i) { ot[0][0][i] = 0.f; ot[0][1][i] = 0.f; ot[1][0][i] = 0.f; ot[1][1][i] = 0.f; }
    float lrun[2] = {0.f, 0.f};
    const float c2 = 0.10206207261596577f * 1.4426950408889634f;
    const int kp0 = tz, kp1 = tz + 512;
    const size_t kbase = ((size_t)b * SEQ * 4 + h) * 96;
    const bf16_t* vsrc = VT + ((size_t)bh * 64 + (tz >> 3)) * SEQ + 8 * (tz & 7);
    u32x4 rk0, rk1, rv;
    rk1 = (u32x4){0u, 0u, 0u, 0u};
#define ATT_LOAD(j) do { rk0 = *(const u32x4*)(K + kbase + (size_t)(64 * (j) + kp0 / 12) * 384 + 8 * (kp0 % 12)); \
        if (kp1 < 768) rk1 = *(const u32x4*)(K + kbase + (size_t)(64 * (j) + kp1 / 12) * 384 + 8 * (kp1 % 12)); \
        rv = *(const u32x4*)(vsrc + 64 * (j)); } while (0)
#define ATT_STORE(buf) do { *(LAS u32x4*)(Ks + (buf) * KB + (kp0 / 12) * KP + (kp0 % 12) * 16) = rk0; \
        if (kp1 < 768) *(LAS u32x4*)(Ks + (buf) * KB + (kp1 / 12) * KP + (kp1 % 12) * 16) = rk1; \
        *(LAS u32x4*)(Vs + (buf) * VB + (tz >> 3) * VP + (tz & 7) * 16) = rv; } while (0)
    ATT_LOAD(0); ATT_STORE(0);
    lds_barrier();
    for (int j = 0; j < ntile; ++j) {
        const int buf = j & 1;
        if (j + 1 < ntile) ATT_LOAD(j + 1);
        if (j <= myl) {
            if (w >= 4) __builtin_amdgcn_s_sleep(6);
#pragma unroll
            for (int kt = 0; kt < 2; ++kt) {
                f32x16 st[2];
#pragma unroll
                for (int i = 0; i < 16; ++i) { st[0][i] = 0.f; st[1][i] = 0.f; }
#pragma unroll
                for (int s = 0; s < 6; ++s) { const bf16x8 kf = *(const LAS bf16x8*)(Ks + buf * KB + (32 * kt + ql) * KP + (16 * s + 8 * hh) * 2);
                    st[0] = __builtin_amdgcn_mfma_f32_32x32x16_bf16(kf, qf[0][s], st[0], 0, 0, 0);
                    st[1] = __builtin_amdgcn_mfma_f32_32x32x16_bf16(kf, qf[1][s], st[1], 0, 0, 0); }
                bf16x8 pf[2][2];
#pragma unroll
                for (int qt = 0; qt < 2; ++qt) { float ps = 0.f;
#pragma unroll
                    for (int i = 0; i < 16; ++i) { const float p = __builtin_amdgcn_exp2f(st[qt][i] * c2 - eoff); st[qt][i] = p; ps += p; }
                    lrun[qt] += ps;
#pragma unroll
                    for (int c = 0; c < 2; ++c) { u32x4 pw; pw.x = pk2(st[qt][8 * c], st[qt][8 * c + 1]); pw.y = pk2(st[qt][8 * c + 2], st[qt][8 * c + 3]); pw.z = pk2(st[qt][8 * c + 4], st[qt][8 * c + 5]); pw.w = pk2(st[qt][8 * c + 6], st[qt][8 * c + 7]);
                        pf[qt][c] = __builtin_bit_cast(bf16x8, pw); } }
#pragma unroll
                for (int c = 0; c < 2; ++c) {
                    const int key0 = 32 * kt + 16 * c + 4 * hh;
#pragma unroll
                    for (int dt = 0; dt < 2; ++dt) { const LAS unsigned char* vp = Vs + buf * VB + (32 * dt + ql) * VP + key0 * 2;
                        const u32x2 v0 = *(const LAS u32x2*)vp, v1 = *(const LAS u32x2*)(vp + 16);
                        u32x4 vw; vw.x = v0.x; vw.y = v0.y; vw.z = v1.x; vw.w = v1.y; const bf16x8 vf = __builtin_bit_cast(bf16x8, vw);
                        ot[dt][0] = __builtin_amdgcn_mfma_f32_32x32x16_bf16(vf, pf[0][c], ot[dt][0], 0, 0, 0);
                        ot[dt][1] = __builtin_amdgcn_mfma_f32_32x32x16_bf16(vf, pf[1][c], ot[dt][1], 0, 0, 0); }
                }
            }
        }
        if (j + 1 < ntile) ATT_STORE(buf ^ 1);
        lds_barrier();
    }
#undef ATT_LOAD
#undef ATT_STORE
#pragma unroll
    for (int qt = 0; qt < 2; ++qt) {
        const float linv = 1.f / (lrun[qt] + shfl_xor_l(lrun[qt], 32, lane));
        bf16_t* orow = O + (tq0 + 32 * qt) * 256 + h * 64;
#pragma unroll
        for (int dt = 0; dt < 2; ++dt)
#pragma unroll
            for (int g = 0; g < 4; ++g) { u32x2 o; o.x = pk2(ot[dt][qt][4 * g] * linv, ot[dt][qt][4 * g + 1] * linv); o.y = pk2(ot[dt][qt][4 * g + 2] * linv, ot[dt][qt][4 * g + 3] * linv);
                *(u32x2*)(orow + 32 * dt + 8 * g + 4 * hh) = o; }
    }
}
DI void phase_attn(const Frame& F, CArgs& A, int l) {
    const bf16_t* Q = (const bf16_t*)(A.ws + WS_Q); const bf16_t* K = (const bf16_t*)(A.ws + WS_K); const bf16_t* VT = (const bf16_t*)(A.ws + WS_VT);
    bf16_t* O = (bf16_t*)(A.ws + WS_ATTO);
    float gq = 0.f, gk = 0.f;
    for (int i = 0; i < 96; ++i) { gq = fmaxf(gq, fabsf(A.in[32][l * 96 + i])); gk = fmaxf(gk, fabsf(A.in[33][l * 96 + i])); }
    const float eoff = 96.f * gq * gk * 0.10206207261596577f * 1.4426950408889634f * 1.0001f;
    for (int p = F.bid; p < 256; p += F.G) { const int bh = p >> 3, u = p & 7;
        attn_unit(F, Q, K, VT, O, bh, 15 - u, eoff);
        attn_unit(F, Q, K, VT, O, bh, u, eoff); }
}
DI f32x16 mfma32(bf16x8 a, bf16x8 b, f32x16 c) { return __builtin_amdgcn_mfma_f32_32x32x16_bf16(a, b, c, 0, 0, 0); }
DI bf16x8 ldfrag(const LAS unsigned char* base, int row, int ks, int h) { return *(const LAS bf16x8*)(base + row * 144 + (16 * ks + 8 * h) * 2); }
DI f32x16 zero16() { f32x16 z;
#pragma unroll
    for (int i = 0; i < 16; ++i) z[i] = 0.f;
    return z; }
DI bf16x8 pack8(const f32x16& x, int o) { u32x4 p; p.x = pk2(x[o], x[o + 1]); p.y = pk2(x[o + 2], x[o + 3]); p.z = pk2(x[o + 4], x[o + 5]); p.w = pk2(x[o + 6], x[o + 7]); return __builtin_bit_cast(bf16x8, p); }
DI f32x16 tileprod(const LAS unsigned char* Aimg, int a0, const LAS unsigned char* Bimg, int b0, f32x16 acc, int lr, int h2) {
#pragma unroll
    for (int ks = 0; ks < 4; ++ks) acc = mfma32(ldfrag(Aimg, a0 + lr, ks, h2), ldfrag(Bimg, b0 + lr, ks, h2), acc);
    return acc;
}
DI void put_tile(LAS unsigned char* img, int c0, int r0, const f32x16& a, int lr, int h2) {
#pragma unroll
    for (int g = 0; g < 4; ++g) { u32x2 o; o.x = pk2(a[4 * g], a[4 * g + 1]); o.y = pk2(a[4 * g + 2], a[4 * g + 3]); *(LAS u32x2*)(img + (c0 + lr) * 144 + (r0 + 8 * g + 4 * h2) * 2) = o; }
}
DI void phase_rwkv_A(const Frame& F, CArgs& A, int l) {
    const bf16_t* Z = (const bf16_t*)(A.ws + WS_Z); bf16_t* V_ = (bf16_t*)(A.ws + WS_RW_V); bf16_t* G_ = (bf16_t*)(A.ws + WS_RW_G);
    const float* mu = A.in[7] + l * 896; const float* w0 = A.in[8] + l * 256; const float* a0 = A.in[10] + l * 256; const float* k_k = A.in[13] + l * 256; const float* k_a = A.in[14] + l * 256;
    const bf16_t* WO = (const bf16_t*)(A.ws + WS_WLORA) + (size_t)l * 32768;
    bf16_t* RP = (bf16_t*)(A.ws + WS_RC_RP); float* Y0T = (float*)(A.ws + WS_RC_Y0); unsigned char* REC = A.ws + WS_RC_G;
    float* BSUM = (float*)(A.ws + WS_RC_BS);
    const float* r_k = A.in[15] + l * 256;
    constexpr int TB = 64 * 144;
#define TILE(i) (F.lds + (i) * TB)
    LAS float* XF = (LAS float*)TILE(13);
    const int w = F.wave;
    for (int ub = F.bid; ub < 1024; ub += F.G) {
      const int b = ub >> 7, c = ub & 127;
      const size_t t0 = (size_t)b * SEQ + 64 * c;
      bf16x8 xf[4];
      {
        int tid = F.tid; asm volatile("" : "+v"(tid)); const int lane = tid & 63, fr = lane & 15, fq = lane >> 4, mt = w & 3;
        const int tk = 16 * mt + fr; const size_t t = t0 + tk; const bool hp = (64 * c + tk) > 0;
        const bf16_t* zr = Z + t * ZS + ZC_WLO + 8 * fq;
#pragma unroll
        for (int ks = 0; ks < 4; ++ks) {
            const u32x4 zc = *(const u32x4*)(zr + 32 * ks); u32x4 zp = {0u, 0u, 0u, 0u}; if (hp) zp = *(const u32x4*)(zr + 32 * ks - ZS);
            const f32x4 m0 = *(const f32x4*)(mu + ZC_WLO + 32 * ks + 8 * fq), m1 = *(const f32x4*)(mu + ZC_WLO + 32 * ks + 8 * fq + 4);
            const unsigned cw[4] = {zc.x, zc.y, zc.z, zc.w}, pw[4] = {zp.x, zp.y, zp.z, zp.w}; const float mm[8] = {m0[0], m0[1], m0[2], m0[3], m1[0], m1[1], m1[2], m1[3]};
            float v[8];
#pragma unroll
            for (int i = 0; i < 8; ++i) { const float zcv = (i & 1) ? bfhi(cw[i >> 1]) : bflo(cw[i >> 1]), zpv = (i & 1) ? bfhi(pw[i >> 1]) : bflo(pw[i >> 1]);
                float x = zcv + (zpv - zcv) * mm[i]; if (ks == 0) x = fast_tanh(x); else if (ks >= 2) x = sigmoidf_(x); v[i] = x; }
            u32x4 o; o.x = pk2(v[0], v[1]); o.y = pk2(v[2], v[3]); o.z = pk2(v[4], v[5]); o.w = pk2(v[6], v[7]); xf[ks] = __builtin_bit_cast(bf16x8, o);
        }
      }
      for (int hd = 0; hd < 4; ++hd) {
        const int u = (b * 4 + hd) * 128 + c;
        {
        int tid = F.tid; asm volatile("" : "+v"(tid)); const int lane = tid & 63, fr = lane & 15, fq = lane >> 4, mt = w & 3, nh = w >> 2;
        const int tk = 16 * mt + fr; const size_t t = t0 + tk; const bool hp = (64 * c + tk) > 0;
        LAS float* hs = (LAS float*)TILE(12);
        f32x4 aw[2], aa[2], ag[2];
        {
#pragma unroll
            for (int nf = 0; nf < 2; ++nf) { const int ch = hd * 64 + 32 * nh + 8 * (fr >> 2) + 4 * nf + (fr & 3);     const f32x4 z4 = {0.f, 0.f, 0.f, 0.f};
                aw[nf] = __builtin_amdgcn_mfma_f32_16x16x32_bf16(*(const bf16x8*)(WO + ch * 32 + 8 * fq), xf[0], z4, 0, 0, 0);
                aa[nf] = __builtin_amdgcn_mfma_f32_16x16x32_bf16(*(const bf16x8*)(WO + 8192 + ch * 32 + 8 * fq), xf[1], z4, 0, 0, 0);
                ag[nf] = __builtin_amdgcn_mfma_f32_16x16x32_bf16(*(const bf16x8*)(WO + 16384 + ch * 64 + 8 * fq), xf[2], z4, 0, 0, 0);
                ag[nf] = __builtin_amdgcn_mfma_f32_16x16x32_bf16(*(const bf16x8*)(WO + 16384 + ch * 64 + 32 + 8 * fq), xf[3], ag[nf], 0, 0, 0); }
        }
        f32x4 rr[2], kq[2], km[2], vv4[2], lw4[2], a4[2];
        float ssq = 0.f, bsp = 0.f;
#pragma unroll
        for (int nf = 0; nf < 2; ++nf) { const int d4 = 32 * nh + 8 * fq + 4 * nf, ch4 = hd * 64 + d4;
            const u32x2 rc = *(const u32x2*)(Z + t * ZS + ZC_R + ch4), kc = *(const u32x2*)(Z + t * ZS + ZC_K + ch4), vc = *(const u32x2*)(Z + t * ZS + ZC_V + ch4);
            u32x2 rp = {0u, 0u}, kp = {0u, 0u}, vp = {0u, 0u};
            if (hp) { rp = *(const u32x2*)(Z + (t - 1) * ZS + ZC_R + ch4); kp = *(const u32x2*)(Z + (t - 1) * ZS + ZC_K + ch4); vp = *(const u32x2*)(Z + (t - 1) * ZS + ZC_V + ch4); }
            const f32x4 mr = *(const f32x4*)(mu + ZC_R + ch4), mk = *(const f32x4*)(mu + ZC_K + ch4), mv = *(const f32x4*)(mu + ZC_V + ch4), ka = *(const f32x4*)(k_a + ch4), kkw = *(const f32x4*)(k_k + ch4), rk4 = *(const f32x4*)(r_k + ch4);
            const f32x4 rcv = {bflo(rc.x), bfhi(rc.x), bflo(rc.y), bfhi(rc.y)}, rpv = {bflo(rp.x), bfhi(rp.x), bflo(rp.y), bfhi(rp.y)};
            const f32x4 kcv = {bflo(kc.x), bfhi(kc.x), bflo(kc.y), bfhi(kc.y)}, kpv = {bflo(kp.x), bfhi(kp.x), bflo(kp.y), bfhi(kp.y)};
            const f32x4 vcv = {bflo(vc.x), bfhi(vc.x), bflo(vc.y), bfhi(vc.y)}, vpv = {bflo(vp.x), bfhi(vp.x), bflo(vp.y), bfhi(vp.y)};
            const f32x4 r = rcv + (rpv - rcv) * mr, k = kcv + (kpv - kcv) * mk, v = vcv + (vpv - vcv) * mv;
            const f32x4 wv = aw[nf] + *(const f32x4*)(w0 + ch4), av = aa[nf] + *(const f32x4*)(a0 + ch4);
#pragma unroll
            for (int i = 0; i < 4; ++i) { lw4[nf][i] = -__expf(-fast_softplus(-wv[i]) - 0.5f); a4[nf][i] = sigmoidf_(av[i]); kq[nf][i] = k[i] * kkw[i]; km[nf][i] = k[i] * (1.f + (a4[nf][i] - 1.f) * ka[i]);
                ssq += kq[nf][i] * kq[nf][i]; bsp += r[i] * km[nf][i] * rk4[i]; }
            rr[nf] = r; vv4[nf] = v;
            *(LAS f32x4*)(XF + tk * 64 + d4) = lw4[nf];
            u32x2 p; p.x = pk2(ag[nf][0], ag[nf][1]); p.y = pk2(ag[nf][2], ag[nf][3]); *(u32x2*)(G_ + t * 256 + ch4) = p;
            p.x = pk2(v[0], v[1]); p.y = pk2(v[2], v[3]); *(u32x2*)(V_ + t * 256 + ch4) = p;
        }
        ssq += shfl_xor_l(ssq, 16, lane); ssq += shfl_xor_l(ssq, 32, lane); bsp += shfl_xor_l(bsp, 16, lane); bsp += shfl_xor_l(bsp, 32, lane);
        if (fq == 0) { hs[nh * 64 + tk] = ssq; hs[128 + nh * 64 + tk] = bsp; }
        lds_barrier();
        if (w == 0) { float cv[64];
#pragma unroll
            for (int i = 0; i < 64; ++i) cv[i] = XF[i * 64 + lane];
            float run = 0.f;
#pragma unroll
            for (int i = 0; i < 64; ++i) { run += cv[i]; XF[i * 64 + lane] = run; } }
        if (w == 1) BSUM[(t0 + lane) * 4 + hd] = hs[128 + lane] + hs[192 + lane];
        lds_barrier();
        const float rn = rsqrtf(fmaxf(hs[tk] + hs[64 + tk], 1e-24f));
#pragma unroll
        for (int nf = 0; nf < 2; ++nf) { const int d4 = 32 * nh + 8 * fq + 4 * nf;
            const f32x4 cum = *(const LAS f32x4*)(XF + tk * 64 + d4), c63 = *(const LAS f32x4*)(XF + 63 * 64 + d4);
            f32x4 al, bt, kt, rb, bhh, khh;
#pragma unroll
            for (int i = 0; i < 4; ++i) { const float kk = kq[nf][i] * rn; const float ec = __expf(cum[i]), em = __builtin_amdgcn_rcpf(ec), ep = __expf(cum[i] - lw4[nf][i]), p63 = __expf(c63[i]);
                al[i] = -kk * ep; bt[i] = kk * a4[nf][i] * em; kt[i] = km[nf][i] * em; rb[i] = rr[nf][i] * ec; bhh[i] = bt[i] * p63; khh[i] = kt[i] * p63;
                if (tk == 63) *(float*)(REC + (size_t)u * RC_REC + 24576 + (d4 + i) * 4) = p63; }
            u32x2 o;
            o.x = pk2(al[0], al[1]); o.y = pk2(al[2], al[3]); *(LAS u32x2*)(TILE(0) + tk * 144 + d4 * 2) = o;
            o.x = pk2(bt[0], bt[1]); o.y = pk2(bt[2], bt[3]); *(LAS u32x2*)(TILE(1) + tk * 144 + d4 * 2) = o;
            o.x = pk2(kt[0], kt[1]); o.y = pk2(kt[2], kt[3]); *(LAS u32x2*)(TILE(2) + tk * 144 + d4 * 2) = o;
            o.x = pk2(rb[0], rb[1]); o.y = pk2(rb[2], rb[3]); *(LAS u32x2*)(TILE(3) + tk * 144 + d4 * 2) = o;
#pragma unroll
            for (int i = 0; i < 4; ++i) { *(LAS bf16_t*)(TILE(4) + (d4 + i) * 144 + tk * 2) = (bf16_t)f2bf(vv4[nf][i]); *(LAS bf16_t*)(TILE(5) + (d4 + i) * 144 + tk * 2) = (bf16_t)f2bf(bhh[i]);
                *(LAS bf16_t*)(TILE(6) + (d4 + i) * 144 + tk * 2) = (bf16_t)f2bf(khh[i]); *(LAS bf16_t*)(TILE(7) + (d4 + i) * 144 + tk * 2) = (bf16_t)f2bf(al[i]); }
        }
        }
        lds_barrier();
        f32x16 Tacc = zero16();
        {
        int tl = F.tid; asm volatile("" : "+v"(tl)); const int lane = tl & 63, lr = lane & 31, h2 = lane >> 5;
        unsigned zz = 0u; asm volatile("" : "+v"(zz));
        for (int i = tl; i < 768; i += NTHR) { const int q = i >> 7, rr = (i & 127) >> 2, cc = i & 3; const int tile = q < 4 ? 8 + q : q == 4 ? 14 : 12;
            *(LAS u32x4*)(TILE(tile) + (q == 5 ? (32 + rr) * 144 : rr * 144 + 64) + cc * 16) = (u32x4){zz, zz, zz, zz}; }
#pragma unroll
        for (int rnd = 0; rnd < 2; ++rnd) {
            const int j = w + 8 * rnd;
            if (j < 15) {
                const int prod = j / 3, tile = j % 3, si = tile == 2 ? 1 : 0, ti = tile == 0 ? 0 : 1;
                if (prod == 1) {
                    f32x16 acc = tileprod(TILE(0), 32 * ti, TILE(1), 32 * si, zero16(), lr, h2);
                    const int ss = 32 * si + lr;
#pragma unroll
                    for (int q = 0; q < 16; ++q) { const int tt = 32 * ti + 8 * (q >> 2) + 4 * h2 + (q & 3); if (!(ss < tt)) acc[q] = 0.f; }
                    put_tile(TILE(12), 32 * si, 32 * ti, acc, lr, h2);
                } else {
                    const LAS unsigned char* Ao = (prod == 0 || prod == 3) ? TILE(1) : TILE(2); const LAS unsigned char* Bo = prod >= 3 ? TILE(3) : TILE(0);
                    f32x16 acc = tileprod(Ao, 32 * si, Bo, 32 * ti, zero16(), lr, h2);
                    const int tt = 32 * ti + lr, incl = prod >= 3 ? 1 : 0;
#pragma unroll
                    for (int q = 0; q < 16; ++q) { const int ss = 32 * si + 8 * (q >> 2) + 4 * h2 + (q & 3); if (!(ss < tt + incl)) acc[q] = 0.f; }
                    if (prod == 0) { put_tile(TILE(11), 32 * ti, 32 * si, acc, lr, h2);
#pragma unroll
                        for (int q = 0; q < 16; ++q) { const int ss = 32 * si + 8 * (q >> 2) + 4 * h2 + (q & 3); Tacc[q] = acc[q] + (ss == tt ? 1.f : 0.f); }
                        put_tile(TILE(14), 32 * ti, 32 * si, Tacc, lr, h2);
                    } else put_tile(TILE(prod == 2 ? 8 : prod == 3 ? 9 : 10), 32 * ti, 32 * si, acc, lr, h2);
                }
            }
        }
        }
        lds_barrier();
        {
        int tl = F.tid; asm volatile("" : "+v"(tl)); const int lane = tl & 63, lr = lane & 31, h2 = lane >> 5;
        if (tl < 384) { const int q = tl >> 7, rr = (tl & 127) >> 2, cc = tl & 3;
            unsigned zz = 0u; asm volatile("" : "+v"(zz));
            *(LAS u32x4*)(TILE(q) + (q == 1 ? (32 + rr) * 144 : rr * 144 + 64) + cc * 16) = (u32x4){zz, zz, zz, zz}; }
        lds_barrier();
#pragma unroll
        for (int k = 1; k <= 5; ++k) {
            LAS unsigned char* Ss = (k & 1) ? TILE(11) : TILE(0); LAS unsigned char* STs = (k & 1) ? TILE(12) : TILE(1);
            LAS unsigned char* Sd = (k & 1) ? TILE(0) : TILE(11); LAS unsigned char* STd = (k & 1) ? TILE(1) : TILE(12);
            LAS unsigned char* Ts = (k & 1) ? TILE(14) : TILE(2); LAS unsigned char* Td = (k & 1) ? TILE(2) : TILE(14);
            if (w < 6) { const int tile = w % 3, ti = tile == 0 ? 0 : 1, si = tile == 2 ? 1 : 0;
                if (w < 3) { f32x16 acc = tileprod(Ss, 32 * ti, STs, 32 * si, zero16(), lr, h2); put_tile(STd, 32 * si, 32 * ti, acc, lr, h2); }
                else { f32x16 acc = tileprod(STs, 32 * si, Ss, 32 * ti, zero16(), lr, h2); put_tile(Sd, 32 * ti, 32 * si, acc, lr, h2); }
            } else if (k == 1) {
#pragma unroll
                for (int jj = 0; jj < 2; ++jj) { const int tile = (w - 6) * 2 + jj, ti = tile >> 1, ei = tile & 1;
                    f32x16 acc = tileprod(TILE(8), 32 * ti, TILE(4), 32 * ei, zero16(), lr, h2); put_tile(TILE(13), 32 * ei, 32 * ti, acc, lr, h2); }
            }
            lds_barrier();
            if (w < 3) { const int si = w == 2 ? 1 : 0, ti = w == 0 ? 0 : 1;
                Tacc = tileprod(STd, 32 * si, Ts, 32 * ti, Tacc, lr, h2); put_tile(Td, 32 * ti, 32 * si, Tacc, lr, h2); }
        }
        lds_barrier();
        { const int tile = w & 3, ti = tile >> 1, ci = tile & 1;
          f32x16 acc = tileprod(TILE(2), 32 * ti, w < 4 ? TILE(13) : TILE(7), 32 * ci, zero16(), lr, h2); put_tile(w < 4 ? TILE(11) : TILE(12), 32 * ci, 32 * ti, acc, lr, h2); }
        }
        lds_barrier();
        {
        int tl = F.tid; asm volatile("" : "+v"(tl)); const int lane = tl & 63, lr = lane & 31, h2 = lane >> 5; const int tj = w & 3, ta = tj >> 1, tb = tj & 1;
        if (w < 4) {
            { f32x16 acc = tileprod(TILE(12), 32 * ta, TILE(9), 32 * tb, zero16(), lr, h2);
              const int tt = 32 * tb + lr;
#pragma unroll
              for (int g = 0; g < 4; ++g) { const int dd = 32 * ta + 8 * g + 4 * h2; const u32x2 rbv = *(const LAS u32x2*)(TILE(3) + tt * 144 + dd * 2);
                  u32x2 o; o.x = pk2(acc[4 * g] + bflo(rbv.x), acc[4 * g + 1] + bfhi(rbv.x)); o.y = pk2(acc[4 * g + 2] + bflo(rbv.y), acc[4 * g + 3] + bfhi(rbv.y));
                  *(u32x2*)(RP + ((size_t)u * 64 + tt) * 64 + dd) = o; } }
            { f32x16 acc = tileprod(TILE(12), 32 * ta, TILE(5), 32 * tb, zero16(), lr, h2);
              const int dcol = 32 * tb + lr;
#pragma unroll
              for (int g = 0; g < 4; ++g) { u32x2 o; o.x = pk2(acc[4 * g], acc[4 * g + 1]); o.y = pk2(acc[4 * g + 2], acc[4 * g + 3]);
                  *(u32x2*)(REC + (size_t)u * RC_REC + ((((dcol >> 4) * 2 + ta) * 64 + (2 * (g & 1) + h2) * 16 + (dcol & 15)) * 16) + 8 * (g >> 1)) = o; } }
        } else {
            f32x16 z2 = tileprod(TILE(4), 32 * ta, TILE(10), 32 * tb, zero16(), lr, h2);
            z2 = tileprod(TILE(11), 32 * ta, TILE(9), 32 * tb, z2, lr, h2);
            float* yo = Y0T + ((size_t)u * 64 + 32 * tb + lr) * 64 + 32 * ta + 4 * h2;
#pragma unroll
            for (int g = 0; g < 4; ++g) *(f32x4*)(yo + 8 * g) = (f32x4){z2[4 * g], z2[4 * g + 1], z2[4 * g + 2], z2[4 * g + 3]};
            f32x16 acc = tileprod(TILE(5), 32 * ta, TILE(11), 32 * tb, zero16(), lr, h2);
            acc = tileprod(TILE(6), 32 * ta, TILE(4), 32 * tb, acc, lr, h2);
            const int ecol = 32 * tb + lr;
#pragma unroll
            for (int g = 0; g < 4; ++g) *(f32x4*)(REC + (size_t)u * RC_REC + 8192 + ((((ecol >> 4) * 4 + 2 * ta + (g >> 1)) * 64 + (2 * (g & 1) + h2) * 16 + (ecol & 15)) * 16)) = (f32x4){acc[4 * g], acc[4 * g + 1], acc[4 * g + 2], acc[4 * g + 3]};
        }
        }
        lds_barrier();
      }
    }
#undef TILE
}
DI void phase_rwkv_B(const Frame& F, CArgs& A) {
    if (F.bid >= 32) return;
    const unsigned char* REC = A.ws + WS_RC_G; bf16_t* HB = (bf16_t*)(A.ws + WS_RC_HB);
    constexpr int SLOT = 25600, NSLOT = 6;
    const int bh = F.bid, w = F.wave, lane = F.lane, fr = lane & 15, fq = lane >> 4;
    const unsigned char* rec0 = REC + (size_t)bh * 128 * RC_REC;
    if (w >= 4) {
        const int lw = w - 4;
#define RB_ISSUE2(cs, cr) do { const unsigned char* r_ = rec0 + (size_t)(cr) * RC_REC; LAS unsigned char* s_ = F.lds + ((cs) % NSLOT) * SLOT; \
        _Pragma("unroll") for (int k = 0; k < 6; ++k) __builtin_amdgcn_global_load_lds((const unsigned*)(r_ + (lw + 4 * k) * 1024 + lane * 16), (LAS unsigned*)(s_ + (lw + 4 * k) * 1024), 16, 0, 0); \
        if (lw == 3) __builtin_amdgcn_global_load_lds((const unsigned*)(r_ + 24576 + lane * 4), (LAS unsigned*)(s_ + 24576), 4, 0, 0); } while (0)
        RB_ISSUE2(0, 0); RB_ISSUE2(1, 1); RB_ISSUE2(2, 2); RB_ISSUE2(3, 3); RB_ISSUE2(4, 4);
        if (lw == 3) asm volatile("s_waitcnt vmcnt(28)" ::: "memory"); else asm volatile("s_waitcnt vmcnt(24)" ::: "memory");
        __builtin_amdgcn_s_barrier();
        for (int c = 0; c < 128; ++c) {
            RB_ISSUE2(c + 5, (c + 5 < 128) ? c + 5 : 127);
            if (lw == 3) asm volatile("s_waitcnt vmcnt(28)" ::: "memory"); else asm volatile("s_waitcnt vmcnt(24)" ::: "memory");
            __builtin_amdgcn_s_barrier();
        }
        asm volatile("s_waitcnt vmcnt(0)" ::: "memory");
#undef RB_ISSUE2
    } else {
        const int ew = w;
        f32x4 acc[4];
#pragma unroll
        for (int dt = 0; dt < 4; ++dt) acc[dt] = (f32x4){0.f, 0.f, 0.f, 0.f};
        __builtin_amdgcn_s_barrier();
        for (int c = 0; c < 128; ++c) {
            const size_t u = (size_t)bh * 128 + c;
            const LAS unsigned char* sl = F.lds + (c % NSLOT) * SLOT;
            bf16x8 hb[2];
#pragma unroll
            for (int sk = 0; sk < 2; ++sk) { u32x4 p; p.x = pk2(acc[2 * sk][0], acc[2 * sk][1]); p.y = pk2(acc[2 * sk][2], acc[2 * sk][3]); p.z = pk2(acc[2 * sk + 1][0], acc[2 * sk + 1][1]); p.w = pk2(acc[2 * sk + 1][2], acc[2 * sk + 1][3]);
                hb[sk] = __builtin_bit_cast(bf16x8, p); *(bf16x8*)(HB + (((u * 4 + ew) * 2 + sk) * 64 + lane) * 8) = hb[sk]; }
#pragma unroll
            for (int dt = 0; dt < 4; ++dt) {
                const f32x4 g4 = *(const LAS f32x4*)(sl + 8192 + ((ew * 4 + dt) * 64 + lane) * 16), d4 = *(const LAS f32x4*)(sl + 24576 + (16 * dt + 4 * fq) * 4);
                const bf16x8 m0 = *(const LAS bf16x8*)(sl + ((dt * 2 + 0) * 64 + lane) * 16), m1 = *(const LAS bf16x8*)(sl + ((dt * 2 + 1) * 64 + lane) * 16);
                f32x4 n = d4 * acc[dt] + g4;
                n = __builtin_amdgcn_mfma_f32_16x16x32_bf16(m0, hb[0], n, 0, 0, 0); n = __builtin_amdgcn_mfma_f32_16x16x32_bf16(m1, hb[1], n, 0, 0, 0); acc[dt] = n; }
            asm volatile("s_waitcnt lgkmcnt(0)" ::: "memory");
            __builtin_amdgcn_s_barrier();
        }
    }
}
DI void phase_rwkv_C(const Frame& F, CArgs& A, int l) {
    const bf16_t* RP = (const bf16_t*)(A.ws + WS_RC_RP); const float* Y0 = (const float*)(A.ws + WS_RC_Y0); const bf16_t* HB = (const bf16_t*)(A.ws + WS_RC_HB); const float* BSUM = (const float*)(A.ws + WS_RC_BS);
    const bf16_t* V_ = (const bf16_t*)(A.ws + WS_RW_V); const bf16_t* G_ = (const bf16_t*)(A.ws + WS_RW_G); bf16_t* MIX = (bf16_t*)(A.ws + WS_MIX);
    const float* ln_w = A.in[16] + l * 256; const float* ln_b = A.in[17] + l * 256;
    for (int job = F.gw; job < 4096; job += F.ngw) {
        int lz = F.lane; asm volatile("" : "+v"(lz)); const int lane = lz, fr = lane & 15, fq = lane >> 4;
        const size_t u = (size_t)job; const int bh = job >> 7, c = job & 127, b = bh >> 2, hd = bh & 3;
        bf16x8 hf[4][2];
#pragma unroll
        for (int et = 0; et < 4; ++et)
#pragma unroll
            for (int sk = 0; sk < 2; ++sk) hf[et][sk] = *(const bf16x8*)(HB + (((u * 4 + et) * 2 + sk) * 64 + lane) * 8);
#pragma unroll
        for (int tb = 0; tb < 4; ++tb) {
            const size_t tok = (size_t)b * SEQ + 64 * c + 16 * tb + fr;
            const bf16_t* rrow = RP + (u * 64 + 16 * tb + fr) * 64 + 4 * fq;
            bf16x8 bfr[2];
#pragma unroll
            for (int sk = 0; sk < 2; ++sk) { const u32x2 m0 = *(const u32x2*)(rrow + 32 * sk), m1 = *(const u32x2*)(rrow + 32 * sk + 16); u32x4 mw; mw.x = m0.x; mw.y = m0.y; mw.z = m1.x; mw.w = m1.y; bfr[sk] = __builtin_bit_cast(bf16x8, mw); }
            f32x4 y[4]; float sm = 0.f;
#pragma unroll
            for (int et = 0; et < 4; ++et) { y[et] = *(const f32x4*)(Y0 + (u * 64 + 16 * tb + fr) * 64 + 16 * et + 4 * fq);
                y[et] = __builtin_amdgcn_mfma_f32_16x16x32_bf16(hf[et][0], bfr[0], y[et], 0, 0, 0); y[et] = __builtin_amdgcn_mfma_f32_16x16x32_bf16(hf[et][1], bfr[1], y[et], 0, 0, 0); }
#pragma unroll
            for (int et = 0; et < 4; ++et) sm += (y[et][0] + y[et][1]) + (y[et][2] + y[et][3]);
            sm += shfl_xor_l(sm, 16, lane); sm += shfl_xor_l(sm, 32, lane); const float mean = sm * (1.f / 64.f);
            float sq = 0.f;
#pragma unroll
            for (int et = 0; et < 4; ++et) { const f32x4 d = y[et] - mean; sq += (d[0] * d[0] + d[1] * d[1]) + (d[2] * d[2] + d[3] * d[3]); }
            sq += shfl_xor_l(sq, 16, lane); sq += shfl_xor_l(sq, 32, lane); const float rstd = rsqrtf(sq * (1.f / 64.f) + 64e-5f);
            const float bs = BSUM[tok * 4 + hd];
#pragma unroll
            for (int et = 0; et < 4; ++et) { const int e0 = hd * 64 + 16 * et + 4 * fq;
                const f32x4 lw = *(const f32x4*)(ln_w + e0), lb = *(const f32x4*)(ln_b + e0);
                const u32x2 vv = *(const u32x2*)(V_ + tok * 256 + e0), gv = *(const u32x2*)(G_ + tok * 256 + e0);
                const float o0 = ((y[et][0] - mean) * rstd * lw[0] + lb[0] + bs * bflo(vv.x)) * bflo(gv.x), o1 = ((y[et][1] - mean) * rstd * lw[1] + lb[1] + bs * bfhi(vv.x)) * bfhi(gv.x);
                const float o2 = ((y[et][2] - mean) * rstd * lw[2] + lb[2] + bs * bflo(vv.y)) * bflo(gv.y), o3 = ((y[et][3] - mean) * rstd * lw[3] + lb[3] + bs * bfhi(vv.y)) * bfhi(gv.y);
                u32x2 o; o.x = pk2(o0, o1); o.y = pk2(o2, o3);
                *(u32x2*)(MIX + tok * DM + e0) = o; }
        }
    }
}

template <int PASS>
DI void phase_s5(const Frame& F, CArgs& A, int l) {
    const bf16_t* Z = (const bf16_t*)(A.ws + WS_Z); float* SEND = (float*)(A.ws + WS_S5END); bf16_t* YS = (bf16_t*)(A.ws + WS_YS5);
    const bf16_t* BBt = (const bf16_t*)(A.ws + WS_S5BB); const bf16_t* CCt = (const bf16_t*)(A.ws + WS_S5CC);
    LAS unsigned char* himg = F.lds + F.wave * 17408;
    for (int it = F.gw; it < 8 * 16 * 16; it += F.ngw) {
        int lz = F.lane; asm volatile("" : "+v"(lz)); const int lane = lz, lr = lane & 31, hh = lane >> 5;
        const int b = it >> 8, g = (it >> 4) & 15, seg = it & 15, lg = l * 16 + g;
        const float dt = __expf(A.in[25][lg]);
        float are[2], aim[2], cr[2], ci[2];
        bf16x8 bbf[2][2];
#pragma unroll
        for (int st = 0; st < 2; ++st) { const int p = 32 * st + lr;
            const float lre = A.in[18][lg * 64 + p], lim = A.in[19][lg * 64 + p]; const float mag = expf(lre * dt); float sn, cn; sincosf(lim * dt, &sn, &cn); are[st] = mag * cn; aim[st] = mag * sn;
            cr[st] = 0.f; ci[st] = 0.f;
            if (PASS == 2) { const float m512 = expf(512.f * lre * dt); float s5, c5; sincosf(512.f * (lim * dt), &s5, &c5); const float pr = m512 * c5, pi_ = m512 * s5;
                for (int j = 0; j < seg; ++j) { const float* e = SEND + ((size_t)((b * 16 + g) * 16 + j)) * 128; const float er = e[p], ei = e[64 + p];
                    const float nr = pr * cr[st] - pi_ * ci[st] + er, ni = pr * ci[st] + pi_ * cr[st] + ei; cr[st] = nr; ci[st] = ni; } }
#pragma unroll
            for (int part = 0; part < 2; ++part) bbf[part][st] = *(const bf16x8*)(BBt + (((size_t)lg * 2 + part) * 64 + p) * 16 + 8 * hh); }
        bf16x8 ccf[4];
        if (PASS == 2) {
#pragma unroll
            for (int ks = 0; ks < 4; ++ks) ccf[ks] = *(const bf16x8*)(CCt + ((size_t)lg * 16 + (lane & 15)) * 128 + 32 * ks + 8 * (lane >> 4)); }
        for (int ch = 0; ch < 8; ++ch) {
            const size_t tok0 = (size_t)b * SEQ + seg * 512 + ch * 64;
#pragma unroll
            for (int tk = 0; tk < 2; ++tk) {
                const bf16x8 uf = *(const bf16x8*)(Z + (tok0 + 32 * tk + lr) * ZS + ZC_S5 + g * 16 + 8 * hh);
                f32x16 xr[2], xi[2];
#pragma unroll
                for (int st = 0; st < 2; ++st) { xr[st] = mfma32(uf, bbf[0][st], zero16()); xi[st] = mfma32(uf, bbf[1][st], zero16()); }
                asm volatile("s_nop 15\n\ts_nop 15" : "+v"(xr[0]), "+v"(xi[0]), "+v"(xr[1]), "+v"(xi[1]));
#pragma unroll
                for (int j = 0; j < 4; ++j) {
#pragma unroll
                    for (int half = 0; half < 2; ++half) {
                        const bool act = (hh == half);
#pragma unroll
                        for (int st = 0; st < 2; ++st) { float tr = cr[st], ti = ci[st];
#pragma unroll
                            for (int q = 0; q < 4; ++q) { const float nr = are[st] * tr - aim[st] * ti + xr[st][4 * j + q], ni = are[st] * ti + aim[st] * tr + xi[st][4 * j + q];
                                tr = nr; ti = ni; xr[st][4 * j + q] = act ? nr : xr[st][4 * j + q]; xi[st][4 * j + q] = act ? ni : xi[st][4 * j + q]; }
                            const float pr = shfl_xor_l(tr, 32, lane), pi2 = shfl_xor_l(ti, 32, lane);
                            cr[st] = act ? tr : pr; ci[st] = act ? ti : pi2; }
                    }
                }
                if (PASS == 2) {
                    unsigned hb = (unsigned)(uintptr_t)(himg + (4 * hh) * 272 + lr * 2); asm volatile("" : "+v"(hb));
                    LAS unsigned char* hp = (LAS unsigned char*)(uintptr_t)hb;
#pragma unroll
                    for (int st = 0; st < 2; ++st)
#pragma unroll
                        for (int q = 0; q < 16; ++q) { const int trow = 32 * tk + 8 * (q >> 2) + (q & 3);
                            *(LAS bf16_t*)(hp + trow * 272 + 64 * st) = (bf16_t)f2bf(xr[st][q]); *(LAS bf16_t*)(hp + trow * 272 + 128 + 64 * st) = (bf16_t)f2bf(xi[st][q]); }
                }
            }
            if (PASS == 2) {
                asm volatile("s_waitcnt lgkmcnt(0)" ::: "memory");
                const int fr = lane & 15, fq = lane >> 4;
                unsigned rb = (unsigned)(uintptr_t)(himg + fr * 272 + fq * 16); asm volatile("" : "+v"(rb)); const LAS unsigned char* rp = (const LAS unsigned char*)(uintptr_t)rb;
#pragma unroll
                for (int m = 0; m < 4; ++m) { f32x4 acc = {0.f, 0.f, 0.f, 0.f};
#pragma unroll
                    for (int ks = 0; ks < 4; ++ks) acc = __builtin_amdgcn_mfma_f32_16x16x32_bf16(ccf[ks], *(const LAS bf16x8*)(rp + (16 * m) * 272 + 64 * ks), acc, 0, 0, 0);
                    const size_t tok = tok0 + 16 * m + fr;
                    const u32x2 uu = *(const u32x2*)(Z + tok * ZS + ZC_S5 + g * 16 + 4 * fq);
                    const f32x4 dd = *(const f32x4*)(A.in[24] + l * 256 + g * 16 + 4 * fq);
                    u32x2 o; o.x = pk2(gelu_tanh(acc[0] + dd[0] * bflo(uu.x)), gelu_tanh(acc[1] + dd[1] * bfhi(uu.x))); o.y = pk2(gelu_tanh(acc[2] + dd[2] * bflo(uu.y)), gelu_tanh(acc[3] + dd[3] * bfhi(uu.y)));
                    *(u32x2*)(YS + tok * 256 + g * 16 + 4 * fq) = o; }
                asm volatile("s_waitcnt lgkmcnt(0)" ::: "memory");
            }
        }
        if (PASS == 1 && hh == 1) {
#pragma unroll
            for (int st = 0; st < 2; ++st) { float* e = SEND + ((size_t)((b * 16 + g) * 16 + seg)) * 128; e[32 * st + lr] = cr[st]; e[64 + 32 * st + lr] = ci[st]; } }
    }
}

DI void phase_lru_prep(const Frame& F, CArgs& A, int l) {
    const bf16_t* Z = (const bf16_t*)(A.ws + WS_Z); float* LA = (float*)(A.ws + WS_LA); float* LB = (float*)(A.ws + WS_LB);
    const float* cw = A.in[34] + l * 4 * 256; const float* cb = A.in[35] + l * 256; const float* ba = A.in[37] + l * 256; const float* bx = A.in[39] + l * 256; const float* lam = A.in[40] + l * 256;
    const bf16_t* WL = (const bf16_t*)(A.ws + WS_WLRU) + (size_t)l * 2 * 4 * 4096;
    LAS float* xs = (LAS float*)F.lds;
    const int w = F.wave, n = w >> 1, hf = w & 1;
    bf16x8 waf[2][2], wxf[2][2];
    { const int fr = F.lane & 15, fq = F.lane >> 4;
#pragma unroll
      for (int nf = 0; nf < 2; ++nf)
#pragma unroll
          for (int ks = 0; ks < 2; ++ks) { const int j = 32 * hf + 16 * nf + fr;
              waf[nf][ks] = *(const bf16x8*)(WL + ((size_t)(0 * 4 + n) * 64 + j) * 64 + 32 * ks + 8 * fq); wxf[nf][ks] = *(const bf16x8*)(WL + ((size_t)(1 * 4 + n) * 64 + j) * 64 + 32 * ks + 8 * fq); } }
    f32x4 c_ba[2], c_bx[2], c_sp[2];
    { const int fq0 = F.lane >> 4;
#pragma unroll
      for (int nf = 0; nf < 2; ++nf) { const int ch4 = n * 64 + 32 * hf + 16 * nf + 4 * fq0; c_ba[nf] = *(const f32x4*)(ba + ch4); c_bx[nf] = *(const f32x4*)(bx + ch4); const f32x4 lm = *(const f32x4*)(lam + ch4);
#pragma unroll
          for (int i = 0; i < 4; ++i) c_sp[nf][i] = -8.f * softplusf_(-lm[i]); } }
    for (int tile = F.bid; tile < T / 64; tile += F.G) {
        int tz = F.tid; asm volatile("" : "+v"(tz)); const int lane = tz & 63, fr = lane & 15, fq = lane >> 4;
        const int t0 = tile * 64, s0 = t0 % SEQ;
        f32x4 accA[4][2], accX[4][2];
#pragma unroll
        for (int m = 0; m < 4; ++m) {
            const int tok = 16 * m + fr, sq = s0 + tok;
            bf16x8 xf[2];
#pragma unroll
            for (int ks = 0; ks < 2; ++ks) { const int ch0 = n * 64 + 32 * ks + 8 * fq;
                const f32x4 b0 = *(const f32x4*)(cb + ch0), b1 = *(const f32x4*)(cb + ch0 + 4);
                float xc[8] = {b0[0], b0[1], b0[2], b0[3], b1[0], b1[1], b1[2], b1[3]};
#pragma unroll
                for (int j = 0; j < 4; ++j) if (sq - 3 + j >= 0) {
                    const u32x4 z8 = *(const u32x4*)(Z + (size_t)(t0 + tok - 3 + j) * ZS + ZC_LX + ch0);
                    const f32x4 c0 = *(const f32x4*)(cw + j * 256 + ch0), c1 = *(const f32x4*)(cw + j * 256 + ch0 + 4);
                    xc[0] += c0[0] * bflo(z8.x); xc[1] += c0[1] * bfhi(z8.x); xc[2] += c0[2] * bflo(z8.y); xc[3] += c0[3] * bfhi(z8.y);
                    xc[4] += c1[0] * bflo(z8.z); xc[5] += c1[1] * bfhi(z8.z); xc[6] += c1[2] * bflo(z8.w); xc[7] += c1[3] * bfhi(z8.w); }
                u32x4 o; o.x = pk2(xc[0], xc[1]); o.y = pk2(xc[2], xc[3]); o.z = pk2(xc[4], xc[5]); o.w = pk2(xc[6], xc[7]); xf[ks] = __builtin_bit_cast(bf16x8, o);
                if (hf == 0) { *(LAS f32x4*)(xs + tok * 260 + ch0) = (f32x4){xc[0], xc[1], xc[2], xc[3]}; *(LAS f32x4*)(xs + tok * 260 + ch0 + 4) = (f32x4){xc[4], xc[5], xc[6], xc[7]}; }
            }
#pragma unroll
            for (int nf = 0; nf < 2; ++nf) { const f32x4 z4 = {0.f, 0.f, 0.f, 0.f};
                accA[m][nf] = __builtin_amdgcn_mfma_f32_16x16x32_bf16(waf[nf][0], xf[0], z4, 0, 0, 0); accA[m][nf] = __builtin_amdgcn_mfma_f32_16x16x32_bf16(waf[nf][1], xf[1], accA[m][nf], 0, 0, 0);
                accX[m][nf] = __builtin_amdgcn_mfma_f32_16x16x32_bf16(wxf[nf][0], xf[0], z4, 0, 0, 0); accX[m][nf] = __builtin_amdgcn_mfma_f32_16x16x32_bf16(wxf[nf][1], xf[1], accX[m][nf], 0, 0, 0); }
        }
        lds_barrier();
#pragma unroll
        for (int m = 0; m < 4; ++m)
#pragma unroll
            for (int nf = 0; nf < 2; ++nf) { const int tok = 16 * m + fr, ch4 = n * 64 + 32 * hf + 16 * nf + 4 * fq;
                const f32x4 xc = *(const LAS f32x4*)(xs + tok * 260 + ch4);
                f32x4 av, bv;
#pragma unroll
                for (int i = 0; i < 4; ++i) { const float r = sigmoidf_(accA[m][nf][i] + c_ba[nf][i]), ig = sigmoidf_(accX[m][nf][i] + c_bx[nf][i]); const float log_a = r * c_sp[nf][i];
                    const float x2 = 2.f * log_a; float em1 = __expf(x2) - 1.f; if (x2 > -0.25f) em1 = x2 * (1.f + x2 * (0.5f + x2 * (0.16666667f + x2 * (0.041666668f + x2 * 0.008333334f))));
                    av[i] = __expf(log_a); bv[i] = __builtin_amdgcn_sqrtf(-em1) * (ig * xc[i]); }
                *(f32x4*)(LA + (size_t)(t0 + tok) * 256 + ch4) = av; *(f32x4*)(LB + (size_t)(t0 + tok) * 256 + ch4) = bv; }
        lds_barrier();
    }
}
DI void phase_lru_sum(const Frame& F, CArgs& A) {
    const float* LA = (const float*)(A.ws + WS_LA); const float* LB = (const float*)(A.ws + WS_LB); float* LS = (float*)(A.ws + WS_LSUM);
    for (int it = F.gw; it < 8 * 128; it += F.ngw) {
        const size_t r0 = (size_t)it * 64;
        f32x4 Ap = {1.f, 1.f, 1.f, 1.f}, Bp = {0.f, 0.f, 0.f, 0.f};
#pragma unroll 8
        for (int t = 0; t < 64; ++t) { const f32x4 a = *(const f32x4*)(LA + (r0 + t) * 256 + 4 * F.lane), bb = *(const f32x4*)(LB + (r0 + t) * 256 + 4 * F.lane); Bp = a * Bp + bb; Ap = Ap * a; }
        *(f32x4*)(LS + ((size_t)it * 2) * 256 + 4 * F.lane) = Ap; *(f32x4*)(LS + ((size_t)it * 2 + 1) * 256 + 4 * F.lane) = Bp;
    }
}
DI void phase_lru_fin(const Frame& F, CArgs& A, int l) {
    const float* LA = (const float*)(A.ws + WS_LA); const float* LB = (const float*)(A.ws + WS_LB); const float* LS = (const float*)(A.ws + WS_LSUM);
    const bf16_t* Z = (const bf16_t*)(A.ws + WS_Z); bf16_t* MIX = (bf16_t*)(A.ws + WS_MIX);
    const f32x4 bg = *(const f32x4*)(A.in[41] + l * 768 + 512 + 4 * F.lane);
    for (int it = F.gw; it < 8 * 128; it += F.ngw) {
        const int b = it >> 7, c = it & 127;
        f32x4 h = {0.f, 0.f, 0.f, 0.f};
        for (int j0 = 0; j0 < c; j0 += 8) {
            f32x4 sa[8], sb[8];
#pragma unroll
            for (int q = 0; q < 8; ++q) { const int j = (j0 + q < c) ? j0 + q : c - 1; sa[q] = *(const f32x4*)(LS + ((size_t)(b * 128 + j) * 2) * 256 + 4 * F.lane); sb[q] = *(const f32x4*)(LS + ((size_t)(b * 128 + j) * 2 + 1) * 256 + 4 * F.lane); }
#pragma unroll
            for (int q = 0; q < 8; ++q) if (j0 + q < c) h = sa[q] * h + sb[q]; }
        const size_t r0 = (size_t)it * 64;
        for (int t0 = 0; t0 < 64; t0 += 8) {
            f32x4 y[8]; float ss[8];
#pragma unroll
            for (int q = 0; q < 8; ++q) { const size_t r = r0 + t0 + q;
                const f32x4 a = *(const f32x4*)(LA + r * 256 + 4 * F.lane), bb = *(const f32x4*)(LB + r * 256 + 4 * F.lane); h = a * h + bb;
                const u32x2 gz = *(const u32x2*)(Z + r * ZS + ZC_LG + 4 * F.lane);
                y[q] = (f32x4){h[0] * gelu_tanh(bflo(gz.x)), h[1] * gelu_tanh(bfhi(gz.x)), h[2] * gelu_tanh(bflo(gz.y)), h[3] * gelu_tanh(bfhi(gz.y))};
                ss[q] = y[q][0] * y[q][0] + y[q][1] * y[q][1] + y[q][2] * y[q][2] + y[q][3] * y[q][3]; }
            const int ln = lane_opaque();
#pragma unroll
            for (int o = 1; o < 64; o <<= 1) {
#pragma unroll
                for (int q = 0; q < 8; ++q) ss[q] += shfl_xor_l(ss[q], o, ln); }
#pragma unroll
            for (int q = 0; q < 8; ++q) { const float r = rsqrtf(ss[q] * (1.f / 256.f) + NORM_EPS);
                u32x2 o; o.x = pk2(y[q][0] * r * bg[0], y[q][1] * r * bg[1]); o.y = pk2(y[q][2] * r * bg[2], y[q][3] * r * bg[3]);
                *(u32x2*)(MIX + (r0 + t0 + q) * DM + 768 + 4 * F.lane) = o; }
        }
    }
}

DI void phase_branch_norm(const Frame& F, CArgs& A, int l) {
    const bf16_t* S0 = (const bf16_t*)(A.ws + WS_YS5G); const bf16_t* S1 = (const bf16_t*)(A.ws + WS_ATTO);
    bf16_t* MIX = (bf16_t*)(A.ws + WS_MIX); const float* bg = A.in[41] + l * 768;
    for (int row0 = 4 * F.gw; row0 < T; row0 += 4 * F.ngw) {
        u32x2 v[4][2];
#pragma unroll
        for (int r = 0; r < 4; ++r) { v[r][0] = *(const u32x2*)(S0 + (size_t)(row0 + r) * 256 + 4 * F.lane); v[r][1] = *(const u32x2*)(S1 + (size_t)(row0 + r) * 256 + 4 * F.lane); }
#pragma unroll
        for (int r = 0; r < 4; ++r)
#pragma unroll
            for (int br = 0; br < 2; ++br) {
                const float x0 = bflo(v[r][br].x), x1 = bfhi(v[r][br].x), x2 = bflo(v[r][br].y), x3 = bfhi(v[r][br].y);
                const float rs = rsqrtf(wave_sum(x0 * x0 + x1 * x1 + x2 * x2 + x3 * x3) * (1.f / 256.f) + NORM_EPS);
                const f32x4 g = *(const f32x4*)(bg + br * 256 + 4 * F.lane);
                u32x2 o; o.x = pk2(x0 * rs * g[0], x1 * rs * g[1]); o.y = pk2(x2 * rs * g[2], x3 * rs * g[3]);
                *(u32x2*)(MIX + (size_t)(row0 + r) * DM + 256 * (br + 1) + 4 * F.lane) = o; }
    }
}

DI void phase_norm2_router(const Frame& F, CArgs& A, int l) {
    const float* MODL = (const float*)(A.ws + WS_MOD) + (size_t)l * 8 * 6144;
    const float* g = A.in[43] + l * 1024;
    signed char* H8 = (signed char*)(A.ws + WS_H); float* H2S = (float*)(A.ws + WS_H2SC);
    int* EID = (int*)(A.ws + WS_RT_EID); float* GATE = (float*)(A.ws + WS_RT_GATE); int* PIE = (int*)(A.ws + WS_RT_PIE);
    unsigned* CNT = (unsigned*)(A.ws + WS_CTL) + CW_CNT + l * 64;
    const bf16_t* WRh = (const bf16_t*)(A.ws + WS_WR) + (size_t)(l * 2) * 48 * 1024; const bf16_t* WRl = WRh + 48 * 1024;
    const float* ROWSS = (const float*)(A.ws + WS_ROWSS);
    LAS float* part = (LAS float*)F.lds;
    LAS float* red = part + 8 * 64 * 48;
    LAS float* lsum = red + 8 * 64;
    LAS unsigned* lcnt = (LAS unsigned*)(lsum + 64 * 36);
    LAS int* lsel = (LAS int*)(lcnt + 64);
    const float* bgp = A.in[45] + l * 4; const float* bep = A.in[47] + l * 32;
    const int w = F.wave, k0 = 128 * w;
    for (int tile = F.bid; tile < T / 64; tile += F.G) {
        int tz = F.tid; asm volatile("" : "+v"(tz)); const int lane = tz & 63, fr = lane & 15, fq = lane >> 4;
        const int row0 = tile * 64, b = row0 / SEQ;
        const unsigned xi = (unsigned)(row0 + fr) * DM + k0 + 8 * fq;
        const float* xb = A.out;
        if (tz < 32) lcnt[tz] = 0u;
        { float m2 = fmaxf(fabsf(MODL[(unsigned)(b * 6144 + 3072 + tz)]), fabsf(MODL[(unsigned)(b * 6144 + 3072 + 512 + tz)])); m2 = wave_max(m2); if (lane == 0) red[w] = m2; }
        lds_barrier();
        float shmax = 0.f;
#pragma unroll
        for (int ww = 0; ww < 8; ++ww) shmax = fmaxf(shmax, red[ww]);
        f32x4 acc[4][3]; float rsv[4], inv8[4];
#pragma unroll
        for (int m = 0; m < 4; ++m) { const float* rp = ROWSS + (unsigned)((row0 + 16 * m + fr) * 32);
            const f32x4 p0 = *(const f32x4*)rp, p1 = *(const f32x4*)(rp + 4), p2 = *(const f32x4*)(rp + 8), p3 = *(const f32x4*)(rp + 12);
            const f32x4 q0 = *(const f32x4*)(rp + 16), q1 = *(const f32x4*)(rp + 20), q2 = *(const f32x4*)(rp + 24), q3 = *(const f32x4*)(rp + 28);
            const float tot = (((p0[0] + p0[1]) + (p0[2] + p0[3])) + ((p1[0] + p1[1]) + (p1[2] + p1[3]))) + (((p2[0] + p2[1]) + (p2[2] + p2[3])) + ((p3[0] + p3[1]) + (p3[2] + p3[3])));
            const float mg = fmaxf(fmaxf(fmaxf(fmaxf(q0[0], q0[1]), fmaxf(q0[2], q0[3])), fmaxf(fmaxf(q1[0], q1[1]), fmaxf(q1[2], q1[3]))), fmaxf(fmaxf(fmaxf(q2[0], q2[1]), fmaxf(q2[2], q2[3])), fmaxf(fmaxf(q3[0], q3[1]), fmaxf(q3[2], q3[3]))));
            rsv[m] = rsqrtf(tot * (1.f / DM) + NORM_EPS);
            const float bound = fmaxf(rsv[m] * mg + shmax, 1e-30f) * 1.0001f;
            inv8[m] = 127.f / bound; if (w == 0 && fq == 0) H2S[(unsigned)(row0 + 16 * m + fr)] = bound * (1.f / 127.f);
#pragma unroll
            for (int n = 0; n < 3; ++n) acc[m][n] = (f32x4){0.f, 0.f, 0.f, 0.f}; }
#pragma unroll
        for (int ks = 0; ks < 4; ++ks) { const int kc = k0 + 32 * ks + 8 * fq;
            const f32x4 g0 = *(const f32x4*)(g + kc), g1 = *(const f32x4*)(g + kc + 4);
            const f32x4 s0 = *(const f32x4*)(MODL + (unsigned)(b * 6144 + 4096 + kc)) + 1.f, s1 = *(const f32x4*)(MODL + (unsigned)(b * 6144 + 4096 + kc + 4)) + 1.f;
            const f32x4 h0 = *(const f32x4*)(MODL + (unsigned)(b * 6144 + 3072 + kc)), h1 = *(const f32x4*)(MODL + (unsigned)(b * 6144 + 3072 + kc + 4));
            bf16x8 blf[3], bhf[3];
#pragma unroll
            for (int n = 0; n < 3; ++n) { blf[n] = *(const bf16x8*)(WRl + (unsigned)((16 * n + fr) * 1024 + kc)); bhf[n] = *(const bf16x8*)(WRh + (unsigned)((16 * n + fr) * 1024 + kc)); }
#pragma unroll
            for (int m = 0; m < 4; ++m) {
                const f32x4 x0 = *(const f32x4*)(xb + (xi + (unsigned)(16 * m * DM + 32 * ks))), x1 = *(const f32x4*)(xb + (xi + (unsigned)(16 * m * DM + 32 * ks + 4)));
                const f32x4 v0 = x0 * rsv[m] * g0 * s0 + h0, v1 = x1 * rsv[m] * g1 * s1 + h1;
                u32x2 o; o.x = q8x4(v0, inv8[m]); o.y = q8x4(v1, inv8[m]); *(u32x2*)(H8 + (unsigned)((row0 + 16 * m + fr) * DM + kc)) = o;
                u32x4 hi; hi.x = pk2(v0[0], v0[1]); hi.y = pk2(v0[2], v0[3]); hi.z = pk2(v1[0], v1[1]); hi.w = pk2(v1[2], v1[3]);
                u32x4 lo; lo.x = pk2(v0[0] - bflo(hi.x), v0[1] - bfhi(hi.x)); lo.y = pk2(v0[2] - bflo(hi.y), v0[3] - bfhi(hi.y)); lo.z = pk2(v1[0] - bflo(hi.z), v1[1] - bfhi(hi.z)); lo.w = pk2(v1[2] - bflo(hi.w), v1[3] - bfhi(hi.w));
                const bf16x8 ah = __builtin_bit_cast(bf16x8, hi), al = __builtin_bit_cast(bf16x8, lo);
#pragma unroll
                for (int n = 0; n < 3; ++n) { acc[m][n] = __builtin_amdgcn_mfma_f32_16x16x32_bf16(ah, bhf[n], acc[m][n], 0, 0, 0);
                    acc[m][n] = __builtin_amdgcn_mfma_f32_16x16x32_bf16(al, bhf[n], acc[m][n], 0, 0, 0); acc[m][n] = __builtin_amdgcn_mfma_f32_16x16x32_bf16(ah, blf[n], acc[m][n], 0, 0, 0); }
            }
            __builtin_amdgcn_sched_barrier(0);
        }
#pragma unroll
        for (int m = 0; m < 4; ++m)
#pragma unroll
            for (int n = 0; n < 3; ++n)
#pragma unroll
                for (int j = 0; j < 4; ++j) part[(w * 64 + 16 * m + 4 * fq + j) * 48 + 16 * n + fr] = acc[m][n][j];
        lds_barrier();
        for (int i = tz; i < 64 * 36; i += NTHR) { const int tok = i / 36, n = i % 36; float a = 0.f;
#pragma unroll
            for (int ww = 0; ww < 8; ++ww) a += part[(ww * 64 + tok) * 48 + n];
            lsum[i] = a; }
        lds_barrier();
        float g0 = 0.f, g1 = 0.f; int e0 = 0, e1 = 0; unsigned r0 = 0, r1 = 0;
        if (tz < 64) {
            const LAS float* L = lsum + tz * 36;
            int gs = 0; float gm = L[0] + bgp[0];
#pragma unroll
            for (int i = 1; i < 4; ++i) { const float v = L[i] + bgp[i]; if (v > gm) { gm = v; gs = i; } }
            float gden = 0.f;
#pragma unroll
            for (int i = 0; i < 4; ++i) gden += expf(L[i] + bgp[i] - gm);
            const float gprob = 1.f / gden;
            int i1 = 0; float v1 = L[4 + gs * 8] + bep[gs * 8];
#pragma unroll
            for (int j = 1; j < 8; ++j) { const float v = L[4 + gs * 8 + j] + bep[gs * 8 + j]; if (v > v1) { v1 = v; i1 = j; } }
            int i2 = -1; float v2 = -INFINITY;
#pragma unroll
            for (int j = 0; j < 8; ++j) { const float v = L[4 + gs * 8 + j] + bep[gs * 8 + j]; if (j != i1 && v > v2) { v2 = v; i2 = j; } }
            const float p2 = expf(v2 - v1);
            g0 = gprob / (1.f + p2); g1 = gprob * p2 / (1.f + p2); e0 = gs * 8 + i1; e1 = gs * 8 + i2;
            r0 = __hip_atomic_fetch_add(lcnt + e0, 1u, __ATOMIC_RELAXED, __HIP_MEMORY_SCOPE_WORKGROUP); r1 = __hip_atomic_fetch_add(lcnt + e1, 1u, __ATOMIC_RELAXED, __HIP_MEMORY_SCOPE_WORKGROUP);
        }
        lds_barrier();
        if (tz < 32) { const unsigned c = lcnt[tz]; lcnt[32 + tz] = c ? atomicAdd(CNT + tz, c) : 0u; }
        lds_barrier();
        if (tz < 64) { const int row = row0 + tz;
            EID[2 * row] = e0; EID[2 * row + 1] = e1; GATE[2 * row] = g0; GATE[2 * row + 1] = g1; PIE[2 * row] = (int)(lcnt[32 + e0] + r0); PIE[2 * row + 1] = (int)(lcnt[32 + e1] + r1); }
        lds_barrier();
    }
}

DI void phase_moe_convert(const Frame& F, CArgs& A, int l, int gw0, int ngw0) {
    LAS float* scr = (LAS float*)(F.lds + F.wave * 16640);
    bf16_t* WM2 = (bf16_t*)(A.ws + WS_WM2);
    for (int it = gw0; it < 32 * 384; it += ngw0) {
        const int e = it / 384; int r = it % 384;
        if (r < 256) { const int which = r >> 7; r &= 127; const int kb = r >> 3, nb = r & 7, n0 = 64 * nb;
            const float* src = (which ? A.in[49] : A.in[48]) + ((size_t)l * 32 + e) * 1024 * 512;
            const int np0 = 256 * (n0 >> 7) + (n0 & 127) + 128 * which;
            quant_item64(src, 512, 64 * kb, n0, (signed char*)(A.ws + WS_WM1) + (size_t)e * 1024 * 1024, 1024, np0, 64 * kb, (const unsigned*)(A.ws + WS_CTL) + CW_COLMAX + ((size_t)l * 32 + e) * 1024 + np0,
                         kb == 0 ? (float*)(A.ws + WS_WM1SC) + (size_t)e * 1024 + np0 : (float*)nullptr, scr, F.lane);
        } else { r -= 256; const int kb = r >> 4, nb = r & 15;
            transpose_item64(A.in[50] + ((size_t)l * 32 + e) * 512 * 1024, 1024, 64 * kb, 64 * nb, WM2 + (size_t)e * 1024 * 512, 512, 64 * nb, 64 * kb, scr, F.lane); }
    }
}

DI void phase_moe_scatter(const Frame& F, CArgs& A, int l) {
    const unsigned* CNT = (const unsigned*)(A.ws + WS_CTL) + CW_CNT + l * 64;
    unsigned* META = (unsigned*)(A.ws + WS_CTL) + CW_UTAB + l * 1024;
    const int* EID = (const int*)(A.ws + WS_RT_EID); const int* PIE = (const int*)(A.ws + WS_RT_PIE); int* SORT = (int*)(A.ws + WS_RT_SORT);
    LAS unsigned* st = (LAS unsigned*)F.lds;
    if (F.tid == 0) { unsigned s = 0; for (int e = 0; e < 32; ++e) { st[e] = s; s += CNT[e]; } }
    __syncthreads();
    if (F.bid == 0 && F.tid == 0) { unsigned nu = 0;
        for (int e = 0; e < 32; ++e) { const unsigned c = CNT[e]; META[1 + e] = st[e]; META[33 + e] = c; for (unsigned bk = 0; bk * 256 < c; ++bk) META[65 + nu++] = ((unsigned)e << 16) | bk; }
        META[0] = nu; }
    for (int a = F.bid * NTHR + F.tid; a < 2 * T; a += F.G * NTHR) SORT[st[EID[a]] + PIE[a]] = a;
}

struct MoeProb1 {
    const char* Hh; const char* WM1; const unsigned* META; const int* SORT; int lda, ldb, nt, G, c;
    DI bool next(int i, pg8::Unit& u) const { const int idx = i * G + c; const int nu = (int)META[0]; if (idx >= nu * 4) return false;
        const unsigned ent = META[65 + (idx >> 2)]; u.pm = idx >> 2; u.pn = idx & 3; u.e = (int)(ent >> 16); u.blk = (int)(ent & 0xffffu); return true; }
    DI const char* a_base(const pg8::Unit&) const { return Hh; }
    DI const char* b_base(const pg8::Unit& u) const { return WM1 + ((size_t)u.e * 1024 + (size_t)u.pn * 256) * 1024; }
    DI unsigned a_off(const pg8::Unit& u, int row) const { const unsigned r = (unsigned)(u.blk * 256 + row), cnt = META[33 + u.e];
        const int a = r < cnt ? SORT[META[1 + u.e] + r] : 0; return (unsigned)(a >> 1) * 1024u; }
};
struct EpiMoe1 {
    static constexpr bool PERM = true;
    bf16_t* HID; const unsigned* META; const int* SORT; const float* H2S; const float* WSC;
    DI void operator()(const i32x4 (&acc)[2][2][4][2], const pg8::Unit& u, int wr, int wc, int fr, int fq) const {
        const unsigned cnt = META[33 + u.e], st = META[1 + u.e];
        const int col0 = 128 * u.pn + wc * 32 + 8 * fq;
        const float* wsp = WSC + (size_t)u.e * 1024 + 256 * u.pn + wc * 32 + 8 * fq;
        const f32x4 s10 = *(const f32x4*)wsp, s11 = *(const f32x4*)(wsp + 4), s30 = *(const f32x4*)(wsp + 128), s31 = *(const f32x4*)(wsp + 132);
#pragma unroll
        for (int ai = 0; ai < 2; ++ai)
#pragma unroll
            for (int m = 0; m < 4; ++m) { const unsigned r = (unsigned)(u.blk * 256 + ai * 128 + wr * 64 + m * 16 + fr);
                if (r < cnt) { const float sa = H2S[SORT[st + r] >> 1];
                    const i32x4 a0 = acc[ai][0][m][0], a1 = acc[ai][0][m][1], b0 = acc[ai][1][m][0], b1 = acc[ai][1][m][1];
                    float h[8];
#pragma unroll
                    for (int i = 0; i < 4; ++i) { h[i] = siluf_((float)a0[i] * sa * s10[i]) * ((float)b0[i] * sa * s30[i]); h[4 + i] = siluf_((float)a1[i] * sa * s11[i]) * ((float)b1[i] * sa * s31[i]); }
                    u32x4 w; w.x = pk2(h[0], h[1]); w.y = pk2(h[2], h[3]); w.z = pk2(h[4], h[5]); w.w = pk2(h[6], h[7]);
                    *(u32x4*)(HID + (size_t)(st + r) * 512 + col0) = w; } }
    }
};
struct MoeProb2 {
    const char* HID; const char* WM2; const unsigned* META; int lda, ldb, nt, G, c;
    DI bool next(int i, pg8::Unit& u) const { const int idx = i * G + c; const int nu = (int)META[0]; if (idx >= nu * 4) return false;
        const unsigned ent = META[65 + (idx >> 2)]; u.pm = idx >> 2; u.pn = idx & 3; u.e = (int)(ent >> 16); u.blk = (int)(ent & 0xffffu); return true; }
    DI const char* a_base(const pg8::Unit& u) const { return HID + ((size_t)META[1 + u.e] + (size_t)u.blk * 256) * 512 * 2; }
    DI const char* b_base(const pg8::Unit& u) const { return WM2 + ((size_t)u.e * 1024 + (size_t)u.pn * 256) * 512 * 2; }
    DI unsigned a_off(const pg8::Unit&, int row) const { return (unsigned)row * 1024u; }
};
struct EpiMoe2 {
    static constexpr bool PERM = true;
    bf16_t* Y; const unsigned* META; const int* SORT; const float* GATE; const float* gt;
    DI void operator()(const f32x4 (&acc)[2][2][4][2], const pg8::Unit& u, int wr, int wc, int fr, int fq) const {
        const unsigned cnt = META[33 + u.e], st = META[1 + u.e];
        const int col0 = 256 * u.pn + wc * 32 + 8 * fq;
        int av[2][4]; float gw[2][4];
#pragma unroll
        for (int ai = 0; ai < 2; ++ai)
#pragma unroll
            for (int m = 0; m < 4; ++m) { const unsigned r = (unsigned)(u.blk * 256 + ai * 128 + wr * 64 + m * 16 + fr); av[ai][m] = r < cnt ? SORT[st + r] : -1; }
#pragma unroll
        for (int ai = 0; ai < 2; ++ai)
#pragma unroll
            for (int m = 0; m < 4; ++m) gw[ai][m] = av[ai][m] >= 0 ? GATE[av[ai][m]] : 0.f;
#pragma unroll
        for (int ai = 0; ai < 2; ++ai)
#pragma unroll
            for (int m = 0; m < 4; ++m) { const int a = av[ai][m];
                if (a >= 0) { const int b = (a >> 1) / SEQ; const float g = gw[ai][m];
#pragma unroll
                    for (int bj = 0; bj < 2; ++bj) { const f32x4 g0 = *(const f32x4*)(gt + (size_t)b * 6144 + col0 + bj * 128), g1 = *(const f32x4*)(gt + (size_t)b * 6144 + col0 + bj * 128 + 4);
                        const f32x4 v0 = acc[ai][bj][m][0] * g0 * g, v1 = acc[ai][bj][m][1] * g1 * g;
                        u32x4 w; w.x = pk2(v0[0], v0[1]); w.y = pk2(v0[2], v0[3]); w.z = pk2(v1[0], v1[1]); w.w = pk2(v1[2], v1[3]);
                        *(u32x4*)(Y + (size_t)a * DM + col0 + bj * 128) = w; } } }
    }
};

DI void phase_final(const Frame& F, CArgs& A) {
    const bf16_t* Y = (const bf16_t*)(A.ws + WS_Y);
    const size_t N4 = (size_t)T * DM / 4, stride = (size_t)F.G * NTHR;
    for (size_t i0 = (size_t)F.bid * NTHR + F.tid; i0 < N4; i0 += 4 * stride) {
        f32x4 v[4]; u32x2 y0[4], y1[4];
#pragma unroll
        for (int k = 0; k < 4; ++k) { const size_t i = i0 + k * stride; if (i < N4) { const size_t row = i >> 8, col = (i & 255) * 4;
            v[k] = *(const f32x4*)(A.out + row * DM + col); y0[k] = *(const u32x2*)(Y + (2 * row) * DM + col); y1[k] = *(const u32x2*)(Y + (2 * row + 1) * DM + col); } }
#pragma unroll
        for (int k = 0; k < 4; ++k) { const size_t i = i0 + k * stride; if (i < N4) { const size_t row = i >> 8, col = (i & 255) * 4;
            v[k][0] += bflo(y0[k].x) + bflo(y1[k].x); v[k][1] += bfhi(y0[k].x) + bfhi(y1[k].x); v[k][2] += bflo(y0[k].y) + bflo(y1[k].y); v[k][3] += bfhi(y0[k].y) + bfhi(y1[k].y);
            *(f32x4*)(A.out + row * DM + col) = v[k]; } }
    }
}

#ifndef REPMASK
#define REPMASK 0u
#endif
constexpr int NPL = 14, NPH = 1 + 2 * NPL + 1;
__global__ void __launch_bounds__(NTHR, 2) mk_fwd(Args args) {
    extern __shared__ __attribute__((aligned(16))) unsigned char lds_raw[];
    LAS unsigned char* const ldsb = (LAS unsigned char*)lds_raw;
    const int wave0 = __builtin_amdgcn_readfirstlane(threadIdx.x >> 6);
    volatile LAS unsigned* MISC = (volatile LAS unsigned*)(ldsb + MISC_OFF);
    if (threadIdx.x < 64) MISC[threadIdx.x] = 0u;
    __syncthreads();
    XcdBarrier bar; bar.bar = (unsigned*)(args.ws + WS_CTL) + CW_BAR; bar.x = 0; bar.st = nullptr;
    if (args.use_bar) bar = xcd_barrier_post((unsigned*)(args.ws + WS_CTL) + CW_BAR, MISC + 8);
    const int lo = args.ph_lo, hi = args.ph_hi;
#define IN(k) (lo <= (k) && (k) < hi)
#define SEAM(k) do { if (IN(k) && IN((k) + 1)) xcd_barrier(bar); } while (0)
    unsigned char* ws = args.ws;
    if (IN(0)) { const Frame F = make_frame(ldsb, wave0); CArgs& AA = *get_args(); phase_prologue(F, AA); } SEAM(0);
    for (int l = 0; l < DEPTH; ++l) {
        const int pb = 1 + l * NPL;
        const float* MODL = (const float*)(ws + WS_MOD) + (size_t)l * 8 * 6144;
        if (IN(pb + 0)) { { const Frame F = make_frame(ldsb, wave0); CArgs& AA = *get_args(); phase_norm1(F, AA, l); } if (l == 0) { const Frame F = make_frame(ldsb, wave0); CArgs& AA = *get_args(); phase_win_quant(F, AA); } } SEAM(pb + 0);
        if (IN(pb + 1)) { const Frame F = make_frame(ldsb, wave0); CArgs& AA = *get_args(); pg8::PlainProb P{(const char*)(ws + WS_H), (const char*)(ws + WS_WIN) + (size_t)l * ZS * 1024, 512, 512, 8, 256, 9, F.G, F.bid};
            EpiBf16I8 E{(bf16_t*)(ws + WS_Z), ZS, (const float*)(ws + WS_HSC), (const float*)(ws + WS_WINSC) + l * ZS}; pg8::gemm_phase<true, true>(F.lds, P, E, F.tid); } SEAM(pb + 1);
        if (IN(pb + 2)) { { const Frame F = make_frame(ldsb, wave0); CArgs& AA = *get_args(); phase_mla_prep(F, AA, l); } { const Frame F = make_frame(ldsb, wave0); CArgs& AA = *get_args(); phase_s5<1>(F, AA, l); } { const Frame F = make_frame(ldsb, wave0); CArgs& AA = *get_args(); phase_lru_prep(F, AA, l); } } SEAM(pb + 2);
        if (IN(pb + 3)) { { const Frame F = make_frame(ldsb, wave0); CArgs& AA = *get_args(); pg8::PlainProb P{(const char*)(ws + WS_AMLA), (const char*)(ws + WS_WMLA) + (size_t)l * 1024 * 512 * 2, 512, 512, 8, 256, 4, F.G, F.bid};
            EpiBf16Plain E{(bf16_t*)(ws + WS_QKVRAW), 1024}; pg8::gemm_phase(F.lds, P, E, F.tid); } { const Frame F = make_frame(ldsb, wave0); CArgs& AA = *get_args(); phase_lru_sum(F, AA); } } SEAM(pb + 3);
        if (IN(pb + 4)) { { const Frame F = make_frame(ldsb, wave0); CArgs& AA = *get_args(); phase_mla_post(F, AA, l); } { const Frame F = make_frame(ldsb, wave0); CArgs& AA = *get_args(); phase_lru_fin(F, AA, l); } } SEAM(pb + 4);
        if (IN(pb + 5)) { { const Frame F = make_frame(ldsb, wave0); CArgs& AA = *get_args(); phase_attn(F, AA, l); } lds_barrier(); { const Frame F = make_frame(ldsb, wave0); CArgs& AA = *get_args(); phase_s5<2>(F, AA, l); } } SEAM(pb + 5);
        if (IN(pb + 6)) { { const Frame F = make_frame(ldsb, wave0); CArgs& AA = *get_args(); phase_rwkv_A(F, AA, l); } lds_barrier(); { const Frame F = make_frame(ldsb, wave0); CArgs& AA = *get_args(); pg8::PlainProb P{(const char*)(ws + WS_YS5), (const char*)(ws + WS_WGLU) + (size_t)l * 256 * 256 * 2, 256, 256, 4, 256, 1, F.G, F.bid};
            EpiGlu E{(const bf16_t*)(ws + WS_YS5), (bf16_t*)(ws + WS_YS5G), AA.in[27] + l * 256}; pg8::gemm_phase(F.lds, P, E, F.tid); } } SEAM(pb + 6);
        if (IN(pb + 7)) { const Frame F = make_frame(ldsb, wave0); CArgs& AA = *get_args(); if (F.bid < 32) phase_rwkv_B(F, AA); else phase_moe_convert(F, AA, l, (F.bid - 32) * NWAVES + F.wave, (F.G - 32) * NWAVES); } SEAM(pb + 7);
        if (IN(pb + 8)) { { const Frame F = make_frame(ldsb, wave0); CArgs& AA = *get_args(); phase_rwkv_C(F, AA, l); } { const Frame F = make_frame(ldsb, wave0); CArgs& AA = *get_args(); phase_branch_norm(F, AA, l); } } SEAM(pb + 8);
        if (IN(pb + 9)) { const Frame F = make_frame(ldsb, wave0); CArgs& AA = *get_args(); pg8::PlainProb P{(const char*)(ws + WS_MIX), (const char*)(ws + WS_WOUT) + (size_t)l * 1024 * 1024 * 2, 1024, 1024, 16, 256, 4, F.G, F.bid};
            EpiResGate E{l == 0 ? AA.in[0] : AA.out, AA.out, MODL + 2048, (float*)(ws + WS_ROWSS), AA.in[43] + l * 1024}; pg8::gemm_phase(F.lds, P, E, F.tid); } SEAM(pb + 9);
        if (IN(pb + 10)) { const Frame F = make_frame(ldsb, wave0); CArgs& AA = *get_args(); phase_norm2_router(F, AA, l); } SEAM(pb + 10);
        if (IN(pb + 11)) { const Frame F = make_frame(ldsb, wave0); CArgs& AA = *get_args(); phase_moe_scatter(F, AA, l); } SEAM(pb + 11);
        const unsigned* META = (const unsigned*)(ws + WS_CTL) + CW_UTAB + l * 1024;
        if (IN(pb + 12)) { const Frame F = make_frame(ldsb, wave0); CArgs& AA = *get_args(); MoeProb1 P{(const char*)(ws + WS_H), (const char*)(ws + WS_WM1), META, (const int*)(ws + WS_RT_SORT), 512, 512, 8, F.G, F.bid};
            EpiMoe1 E{(bf16_t*)(ws + WS_HID), META, (const int*)(ws + WS_RT_SORT), (const float*)(ws + WS_H2SC), (const float*)(ws + WS_WM1SC)}; pg8::gemm_phase<true, true>(F.lds, P, E, F.tid); } SEAM(pb + 12);
        if (IN(pb + 13)) { const Frame F = make_frame(ldsb, wave0); CArgs& AA = *get_args(); MoeProb2 P{(const char*)(ws + WS_HID), (const char*)(ws + WS_WM2), META, 512, 512, 8, F.G, F.bid};
            EpiMoe2 E{(bf16_t*)(ws + WS_Y), META, (const int*)(ws + WS_RT_SORT), (const float*)(ws + WS_RT_GATE), MODL + 5120}; pg8::gemm_phase(F.lds, P, E, F.tid); } SEAM(pb + 13);
    }
    if (IN(NPH - 1)) { const Frame F = make_frame(ldsb, wave0); CArgs& AA = *get_args(); phase_final(F, AA); }
#undef IN
#undef SEAM
}

extern "C" void kernel_launch(void* const* d_in, const int* in_sizes, int n_in, void* d_out, int out_size, void* d_ws, size_t ws_size, hipStream_t stream) {
    static int grid = 0;
    if (grid == 0) {
        if (n_in != 51 || ws_size < WS_END) { fprintf(stderr, "kernel_launch: unexpected inputs (n_in %d, ws %zu)\n", n_in, ws_size); grid = -1; return; }
        int dev = 0, cus = 0;
        if (hipGetDevice(&dev) != hipSuccess || hipDeviceGetAttribute(&cus, hipDeviceAttributeMultiprocessorCount, dev) != hipSuccess) { grid = -1; return; }
        if (hipFuncSetAttribute((const void*)mk_fwd, hipFuncAttributeMaxDynamicSharedMemorySize, LDS_BYTES) != hipSuccess) { fprintf(stderr, "kernel_launch: hipFuncSetAttribute failed\n"); grid = -1; return; }
        grid = cus;
    }
    if (grid < 0) return;
    (void)hipMemsetAsync((char*)d_ws + WS_CTL, 0, CTL_ZERO_BYTES, stream);
    Args a{};
    for (int i = 0; i < 51; ++i) a.in[i] = (const float*)d_in[i];
    a.pos_off = (const int*)d_in[2]; a.out = (float*)d_out; a.ws = (unsigned char*)d_ws; a.pad = 0;
#if defined(MK_PER_PHASE)
    a.use_bar = 0;
    for (int p = 0; p < NPH; ++p) { a.ph_lo = p; a.ph_hi = p + 1;
        const int k = (p == 0) ? 30 : (p == NPH - 1) ? 31 : (p - 1) % NPL; const int reps = 1 + (int)((REPMASK >> k) & 1u);
        for (int r = 0; r < reps; ++r) hipLaunchKernelGGL(mk_fwd, dim3(grid), dim3(NTHR), LDS_BYTES, stream, a); }
#else
    a.use_bar = 1; a.ph_lo = 0; a.ph_hi = NPH;
    hipLaunchKernelGGL(mk_fwd, dim3(grid), dim3(NTHR), LDS_BYTES, stream, a);
#endif
}
```

```cpp
#include <hip/hip_runtime.h>
#include <cstdio>
#include <cstdint>
#include <type_traits>

#define LAS __attribute__((address_space(3)))
#define GAS __attribute__((address_space(1)))
#define DI __device__ __forceinline__
typedef unsigned short bf16_t;
typedef short bf16x8 __attribute__((ext_vector_type(8)));
typedef short s16x4 __attribute__((ext_vector_type(4)));
typedef float f32x4 __attribute__((ext_vector_type(4)));
typedef float f32x2 __attribute__((ext_vector_type(2)));
typedef float f32x16 __attribute__((ext_vector_type(16)));
typedef unsigned u32x4 __attribute__((ext_vector_type(4)));
typedef unsigned u32x2 __attribute__((ext_vector_type(2)));
typedef __bf16 bf16x2_t __attribute__((ext_vector_type(2)));
typedef int i32x4 __attribute__((ext_vector_type(4)));

constexpr int NB = 8, SEQ = 8192, DM = 1024, T = NB * SEQ, DEPTH = 2;
constexpr int WG = 256;
constexpr int ZS = 2304;
constexpr int ZC_R = 0, ZC_K = 256, ZC_V = 512, ZC_WLO = 768, ZC_ALO = 800, ZC_GLO = 832, ZC_S5 = 896, ZC_QA = 1152, ZC_KVA = 1408, ZC_KPE = 1536, ZC_LX = 1568, ZC_LG = 1824, D_IN = 2080;
constexpr int NEXP = 32, DFF = 512;
constexpr float NORM_EPS = 1e-6f;

DI unsigned f2bf(float f) { unsigned u = __float_as_uint(f); return (u + 0x7fffu + ((u >> 16) & 1u)) >> 16; }
DI unsigned pk2(float lo, float hi) { f32x2 v = {lo, hi}; bf16x2_t b = __builtin_convertvector(v, bf16x2_t); return __builtin_bit_cast(unsigned, b); }
DI float bflo(unsigned u) { return __uint_as_float(u << 16); }
DI float bfhi(unsigned u) { return __uint_as_float(u & 0xffff0000u); }
DI float bf2f(bf16_t b) { return __uint_as_float(((unsigned)b) << 16); }
DI int lane_opaque() { int l; asm volatile("v_mbcnt_lo_u32_b32 %0, -1, 0\n\tv_mbcnt_hi_u32_b32 %0, -1, %0" : "=v"(l)); return l; }
DI float shfl_xor_l(float v, int o, int lane) { return __int_as_float(__builtin_amdgcn_ds_bpermute((lane ^ o) << 2, __float_as_int(v))); }
DI float wave_max(float v) {
    const int l = lane_opaque();
#pragma unroll
    for (int o = 1; o < 64; o <<= 1) v = fmaxf(v, shfl_xor_l(v, o, l));
    return v;
}
DI unsigned q8x4(f32x4 v, float inv) { const int a = (int)rintf(v[0] * inv), b = (int)rintf(v[1] * inv), c = (int)rintf(v[2] * inv), d = (int)rintf(v[3] * inv);
    return (unsigned)(a & 255) | ((unsigned)(b & 255) << 8) | ((unsigned)(c & 255) << 16) | ((unsigned)(d & 255) << 24); }
DI float wave_sum(float v) {
    const int l = lane_opaque();
#pragma unroll
    for (int o = 1; o < 64; o <<= 1) v += shfl_xor_l(v, o, l);
    return v;
}
DI void lds_barrier() { asm volatile("s_waitcnt lgkmcnt(0)" ::: "memory"); __builtin_amdgcn_s_barrier(); asm volatile("" ::: "memory"); }
DI float sigmoidf_(float x) { return __builtin_amdgcn_rcpf(1.f + __expf(-x)); }
DI float fast_tanh(float x) { const float e = __expf(2.f * fminf(fmaxf(x, -15.f), 15.f)); return (e - 1.f) * __builtin_amdgcn_rcpf(e + 1.f); }
DI float fast_softplus(float x) { return fmaxf(x, 0.f) + __logf(1.f + __expf(-fabsf(x))); }
DI float softplusf_(float x) { return fmaxf(x, 0.f) + log1pf(__expf(-fabsf(x))); }
DI float gelu_tanh(float x) { const float u = 0.7978845608028654f * (x + 0.044715f * x * x * x); const float e = __expf(2.f * fminf(fmaxf(u, -15.f), 15.f)); return x * e * __builtin_amdgcn_rcpf(e + 1.f); }
DI float siluf_(float x) { return x / (1.f + __expf(-x)); }

namespace pg8 {
constexpr int BM = 256, BK = 64, HALF = 128, HTB = HALF * BK * 2, STAGE_BYTES = 8 * HTB;
DI int lds_byte(int r, int c) { const int st = (r >> 4) * 2 + (c >> 5), rr = r & 15, cc = c & 31, ob = rr * 64 + cc * 2; return st * 1024 + (ob ^ (((ob >> 9) & 1) << 5)); }
DI void stage_rc(int b, int& R, int& C) { const int st = b / 1024, sb = b % 1024, swz = sb ^ (((sb >> 9) & 1) << 5); R = (st >> 1) * 16 + swz / 64; C = (st & 1) * 32 + (swz % 64) / 2; }
DI int perm32(int rho) { const int n = rho >> 4, i = rho & 15; return 8 * (i >> 2) + 4 * n + (i & 3); }

struct Unit { int pm, pn, e, blk; };
DI f32x4 mma_any(bf16x8 a, bf16x8 b, f32x4 c) { return __builtin_amdgcn_mfma_f32_16x16x32_bf16(a, b, c, 0, 0, 0); }
DI i32x4 mma_any(bf16x8 a, bf16x8 b, i32x4 c) { return __builtin_amdgcn_mfma_i32_16x16x64_i8(__builtin_bit_cast(i32x4, a), __builtin_bit_cast(i32x4, b), c, 0, 0, 0); }

template <bool ALIGN_EPI = true, bool I8 = false, class Epi, class P>
DI void gemm_phase(LAS unsigned char* lds, const P& S, const Epi& E, int tid_in) {
    typedef typename std::conditional<I8, i32x4, f32x4>::type acc_t;
    const int tid = tid_in, wid = __builtin_amdgcn_readfirstlane(tid >> 6), lane = tid & 63, wr = wid >> 2, wc = wid & 3, fr = lane & 15, fq = lane >> 4;
    const int nt = S.nt;
    int Rr[2], Cc[2];
    unsigned voffB[2], offC[2][2], offN[2][2];
#pragma unroll
    for (int i = 0; i < 2; ++i) { int R, C; stage_rc(tid * 16 + i * 8192, R, C); Rr[i] = R; Cc[i] = C; const int Rb = Epi::PERM ? ((R & ~31) + perm32(R & 31)) : R;
        voffB[i] = (unsigned)(Rb * S.ldb + C) * 2u; }
    const size_t kstep = (size_t)(BK * 2);
    const size_t hstepB = (size_t)HALF * S.ldb * 2;
    const unsigned ldsw = (unsigned)wid * 1024u;
    const int aoff = lds_byte(wr * 64 + fr, fq * 8), boff = lds_byte(wc * 32 + fr, fq * 8);
#define PG8_SA(b, h) (((b) * 2 + (h)) * HTB)
#define PG8_SB(b, h) ((4 + (b) * 2 + (h)) * HTB)
#define PG8_STAGE(bufoff, gbase, voff) do { _Pragma("unroll") for (int _i = 0; _i < 2; ++_i) \
        __builtin_amdgcn_global_load_lds((const unsigned*)((const char*)(gbase) + (voff)[_i]), (LAS unsigned*)(lds + (bufoff) + ldsw + _i * 8192), 16, 0, 0); } while (0)
#define PG8_LDA(dst, b, h) do { _Pragma("unroll") for (int m = 0; m < 4; ++m) _Pragma("unroll") for (int k = 0; k < 2; ++k) dst[m][k] = *(const LAS bf16x8*)(lds + PG8_SA(b, h) + aoff + m * 2048 + k * 1024); } while (0)
#define PG8_LDB(dst, b, h) do { _Pragma("unroll") for (int n = 0; n < 2; ++n) _Pragma("unroll") for (int k = 0; k < 2; ++k) dst[n][k] = *(const LAS bf16x8*)(lds + PG8_SB(b, h) + boff + n * 2048 + k * 1024); } while (0)
#define PG8_MMA(ai, bj, At, Bt) do { __builtin_amdgcn_s_setprio(1); _Pragma("unroll") for (int m = 0; m < 4; ++m) _Pragma("unroll") for (int n = 0; n < 2; ++n) _Pragma("unroll") for (int k = 0; k < 2; ++k) \
        acc[ai][bj][m][n] = mma_any(Bt[n][k], At[m][k], acc[ai][bj][m][n]); __builtin_amdgcn_s_setprio(0); } while (0)
#define PG8_WAIT_V(n) asm volatile("s_waitcnt vmcnt(" #n ")" ::: "memory")
#define PG8_WAIT_L(n) asm volatile("s_waitcnt lgkmcnt(" #n ")" ::: "memory")
#define PG8_BAR __builtin_amdgcn_s_barrier()
#define PG8_SCHED __builtin_amdgcn_sched_barrier(0)
    Unit cur, nxt; int ui = 0;
    if (!S.next(0, cur)) return;
    acc_t acc[2][2][4][2];
#pragma unroll
    for (int a = 0; a < 2; ++a)
#pragma unroll
        for (int b = 0; b < 2; ++b)
#pragma unroll
            for (int m = 0; m < 4; ++m)
#pragma unroll
                for (int n = 0; n < 2; ++n) acc[a][b][m][n] = (acc_t){0, 0, 0, 0};
    bf16x8 At[4][2], B0[2][2], B1[2][2];
    const char* cA = S.a_base(cur); const char* cB = S.b_base(cur);
#pragma unroll
    for (int h = 0; h < 2; ++h)
#pragma unroll
        for (int i = 0; i < 2; ++i) { offC[h][i] = S.a_off(cur, h * HALF + Rr[i]) + (unsigned)Cc[i] * 2u; offN[h][i] = offC[h][i]; }
    PG8_STAGE(PG8_SB(0, 0), cB, voffB); PG8_STAGE(PG8_SB(0, 1), cB + hstepB, voffB); PG8_STAGE(PG8_SA(0, 0), cA, offC[0]); PG8_STAGE(PG8_SA(0, 1), cA, offC[1]);
    if (wr == 1) PG8_BAR;
    PG8_WAIT_V(2); PG8_BAR;
    PG8_STAGE(PG8_SB(1, 0), cB + kstep, voffB); PG8_STAGE(PG8_SA(1, 0), cA + kstep, offC[0]); PG8_STAGE(PG8_SB(1, 1), cB + hstepB + kstep, voffB);
    PG8_WAIT_V(6); PG8_BAR;
    for (;;) {
        const bool has_next = S.next(ui + 1, nxt);
        const char* nA = has_next ? S.a_base(nxt) : cA; const char* nB = has_next ? S.b_base(nxt) : cB;
        for (int t = 0; t < nt; t += 2) {
            const bool last = (t == nt - 2);
            const char* a1 = cA + (size_t)(t + 1) * kstep;
            const char* a2 = last ? nA : cA + (size_t)(t + 2) * kstep; const char* b2 = last ? nB : cB + (size_t)(t + 2) * kstep;
            const char* a3 = a2 + kstep; const char* b3 = b2 + kstep;
            if (last && has_next) {
#pragma unroll
                for (int h = 0; h < 2; ++h)
#pragma unroll
                    for (int i = 0; i < 2; ++i) offN[h][i] = S.a_off(nxt, h * HALF + Rr[i]) + (unsigned)Cc[i] * 2u;
            }
            unsigned o2[2][2];
#pragma unroll
            for (int h = 0; h < 2; ++h)
#pragma unroll
                for (int i = 0; i < 2; ++i) o2[h][i] = last ? offN[h][i] : offC[h][i];
            PG8_LDB(B0, 0, 0); PG8_LDB(B1, 0, 1); PG8_SCHED; PG8_LDA(At, 0, 0); PG8_STAGE(PG8_SA(1, 1), a1, offC[1]);
            PG8_WAIT_V(8); PG8_WAIT_L(0); PG8_BAR; PG8_MMA(0, 0, At, B0); PG8_MMA(0, 1, At, B1); PG8_BAR; PG8_SCHED;
            PG8_LDA(At, 0, 1); PG8_STAGE(PG8_SB(0, 0), b2, voffB); PG8_STAGE(PG8_SB(0, 1), b2 + hstepB, voffB); PG8_STAGE(PG8_SA(0, 0), a2, o2[0]);
            PG8_WAIT_V(8); PG8_WAIT_L(0); PG8_BAR; PG8_MMA(1, 0, At, B0); PG8_MMA(1, 1, At, B1); PG8_BAR; PG8_SCHED;
            PG8_LDB(B0, 1, 0); PG8_LDB(B1, 1, 1); PG8_SCHED; PG8_LDA(At, 1, 0); PG8_STAGE(PG8_SA(0, 1), a2, o2[1]);
            PG8_WAIT_V(8); PG8_WAIT_L(0); PG8_BAR; PG8_MMA(0, 0, At, B0); PG8_MMA(0, 1, At, B1); PG8_BAR; PG8_SCHED;
            PG8_LDA(At, 1, 1); PG8_STAGE(PG8_SB(1, 0), b3, voffB); PG8_STAGE(PG8_SB(1, 1), b3 + hstepB, voffB); PG8_STAGE(PG8_SA(1, 0), a3, o2[0]);
            PG8_WAIT_V(8); PG8_WAIT_L(0); PG8_BAR; PG8_MMA(1, 0, At, B0); PG8_MMA(1, 1, At, B1); PG8_BAR; PG8_SCHED;
        }
        if constexpr (ALIGN_EPI) { if (wr == 0) PG8_BAR; }
        E(acc, cur, wr, wc, fr, fq);
        if (!has_next) break;
#pragma unroll
        for (int a = 0; a < 2; ++a)
#pragma unroll
            for (int b = 0; b < 2; ++b)
#pragma unroll
                for (int m = 0; m < 4; ++m)
#pragma unroll
                    for (int n = 0; n < 2; ++n) acc[a][b][m][n] = (acc_t){0, 0, 0, 0};
        cur = nxt; cA = nA; cB = nB; ++ui;
#pragma unroll
        for (int h = 0; h < 2; ++h)
#pragma unroll
            for (int i = 0; i < 2; ++i) offC[h][i] = offN[h][i];
        if constexpr (ALIGN_EPI) { if (wr == 1) PG8_BAR; }
    }
    PG8_WAIT_V(0);
    if constexpr (!ALIGN_EPI) { if (wr == 0) PG8_BAR; }
    PG8_BAR;
#undef PG8_SA
#undef PG8_SB
#undef PG8_STAGE
#undef PG8_LDA
#undef PG8_LDB
#undef PG8_MMA
#undef PG8_WAIT_V
#undef PG8_WAIT_L
#undef PG8_BAR
#undef PG8_SCHED
}

struct PlainProb {
    const char* A; const char* Bt; int lda, ldb, nt, nM, nN, G, c;
    DI bool next(int i, Unit& u) const {
        const long L = (long)i * G + c; const int nwg = nM * nN; if (L >= nwg) return false;
        int wgid = (int)L; { const int q = nwg / 8, r = nwg % 8, xcd = wgid % 8, off = wgid / 8; wgid = (xcd < r ? xcd * (q + 1) : r * (q + 1) + (xcd - r) * q) + off; }
        const int nig = 8 * nN, gid = wgid / nig, fm = gid * 8, gsz = (nM - fm) < 8 ? (nM - fm) : 8;
        u.pm = fm + ((wgid % nig) % gsz); u.pn = (wgid % nig) / gsz; u.e = 0; u.blk = 0; return true;
    }
    DI const char* a_base(const Unit& u) const { return A + (size_t)u.pm * 256 * lda * 2; }
    DI const char* b_base(const Unit& u) const { return Bt + (size_t)u.pn * 256 * ldb * 2; }
    DI unsigned a_off(const Unit&, int row) const { return (unsigned)row * (unsigned)lda * 2u; }
};
}

constexpr size_t MiB = 1u << 20;
constexpr size_t WS_CTL = 0, CTL_ZERO_BYTES = 1 * MiB;
constexpr size_t WS_MOD = 1 * MiB;
constexpr size_t WS_RT_EID = 3 * MiB;
constexpr size_t WS_RT_GATE = WS_RT_EID + 512 * 1024;
constexpr size_t WS_RT_PIE = WS_RT_GATE + 512 * 1024;
constexpr size_t WS_RT_SORT = WS_RT_PIE + 512 * 1024;
constexpr size_t WS_WIN = 8 * MiB;
constexpr size_t WS_WINSC = 8 * MiB + 5 * MiB;
constexpr size_t WS_HSC = 7 * MiB + 512 * 1024;
constexpr size_t WS_WOUT = 17 * MiB;
constexpr size_t WS_WMLA = 21 * MiB;
constexpr size_t WS_WGLU = 23 * MiB;
constexpr size_t WS_WR = 23 * MiB + 256 * 1024;
constexpr size_t WS_WLRU = 23 * MiB + 640 * 1024;
constexpr size_t WS_WLORA = 23 * MiB + 768 * 1024;
static_assert(WS_WGLU + 256 * 1024 <= WS_WR && WS_WR + 384 * 1024 <= WS_WLRU && WS_WLRU + 128 * 1024 <= WS_WLORA && WS_WLORA + 128 * 1024 <= 24 * MiB, "small weight map");
constexpr size_t WS_H = 24 * MiB;
constexpr size_t WS_Z = 152 * MiB;
constexpr size_t WS_WM1 = WS_Z;
constexpr size_t WS_WM2 = WS_Z + 64 * MiB;
constexpr size_t WS_WM1SC = WS_Z + 32 * MiB;
constexpr size_t WS_H2SC = 7 * MiB + 768 * 1024;
constexpr size_t WS_MIX = 440 * MiB;
constexpr size_t WS_HID = WS_MIX;
constexpr size_t WS_Y = 569 * MiB;
constexpr size_t WS_Q = 825 * MiB;
constexpr size_t WS_K = 873 * MiB;
constexpr size_t WS_VT = 921 * MiB;
constexpr size_t WS_ROWSS = WS_Q;
constexpr size_t WS_TAIL = 953 * MiB;
constexpr size_t WS_END = 1017 * MiB;
constexpr size_t WS_AMLA = WS_TAIL;
constexpr size_t WS_QKVRAW = WS_Y;
constexpr size_t WS_ATTO = WS_H;
constexpr size_t WS_RW_V = WS_Y + 64 * MiB, WS_RW_G = WS_H + 64 * MiB;
constexpr size_t WS_RC_RP = WS_H + 32 * MiB;
constexpr size_t WS_RC_MP = WS_H + 64 * MiB;
constexpr size_t WS_RC_HB = WS_H + 96 * MiB;
constexpr size_t WS_RC_Y0 = WS_Q;
constexpr size_t WS_RC_G = WS_Q + 64 * MiB;
constexpr int RC_REC = 24832;
constexpr size_t WS_RC_BS = WS_Q + 64 * MiB + 98 * MiB;
static_assert((size_t)4096 * RC_REC <= 98 * MiB && WS_RC_BS + 1 * MiB <= WS_END, "rwkv record map");
constexpr size_t WS_YS5 = WS_Y;
constexpr size_t WS_YS5G = WS_Y + 32 * MiB;
constexpr size_t WS_YL = WS_TAIL + 32 * MiB;
constexpr size_t WS_LA = WS_Y + 128 * MiB, WS_LB = WS_Y + 192 * MiB;
constexpr size_t WS_S5END = 2 * MiB;
constexpr size_t WS_S5BB = 5 * MiB;
constexpr size_t WS_S5CC = 5 * MiB + 128 * 1024;
constexpr size_t WS_LSUM = 5 * MiB + 512 * 1024;
static_assert(WS_RT_SORT + 512 * 1024 <= WS_LSUM && WS_LSUM + 2 * MiB <= WS_WIN && WS_S5END + 1 * MiB <= WS_RT_EID, "map");

constexpr int CW_BAR = 4096;
constexpr int CW_CNT = 16384;
constexpr int CW_INMAX = 32768;
constexpr int CW_COLMAX = 65536;
constexpr int CW_UTAB = 20480;

constexpr int NWAVES = 8, NTHR = 512;
constexpr int LDS_BYTES = 155648;
constexpr int MISC_OFF = 155648 - 256;

struct Args { const float* in[51]; const int* pos_off; float* out; unsigned char* ws; int ph_lo, ph_hi, use_bar, pad; };
typedef const __attribute__((address_space(4))) Args CArgs;
DI CArgs* get_args() { CArgs* ap = (CArgs*)__builtin_amdgcn_kernarg_segment_ptr(); asm volatile("" : "+s"(ap)); return ap; }

#define XB_TMO      128
#define XB_XCNT(j)  (256  + 64 * (j))
#define XB_XSUB(j)  (1280 + 64 * (j))
#define XB_XGEN(j)  (2304 + 64 * (j))
#define XB_TOP      3328
#define XB_TOPGEN   3392
#define XCD_BAR_WORDS 3456
#define XB_SPIN_CAP (1u << 18)
DI unsigned xb_ld(unsigned* p)              { return __hip_atomic_load(p, __ATOMIC_RELAXED, __HIP_MEMORY_SCOPE_AGENT); }
DI unsigned xb_add(unsigned* p, unsigned v) { return __hip_atomic_fetch_add(p, v, __ATOMIC_RELAXED, __HIP_MEMORY_SCOPE_AGENT); }
DI unsigned xb_xcc_id() { return (unsigned)__builtin_amdgcn_s_getreg((3 << 11) | 20) & 0xFu; }
#define XB_SPIN(cond, bar) do { unsigned _sp = 0; while (cond) { __builtin_amdgcn_s_sleep(1); \
    if ((++_sp & 255u) == 0u) { if (xb_ld(&(bar)[XB_TMO])) break; if (_sp > XB_SPIN_CAP) { atomicAdd(&(bar)[XB_TMO], 1u); break; } } } } while (0)
struct XcdBarrier { unsigned* bar; unsigned x; volatile LAS unsigned* st; };
DI XcdBarrier xcd_barrier_post(unsigned* bar, volatile LAS unsigned* st) {
    XcdBarrier b; b.bar = bar; b.x = xb_xcc_id(); b.st = st;
    if (threadIdx.x == 0) (void)xb_add(&bar[XB_XCNT(b.x)], 1u);
    return b;
}
DI void xcd_barrier_complete(unsigned* bar, unsigned x, unsigned& nloc, unsigned& nx) {
    const unsigned G = gridDim.x * gridDim.y * gridDim.z;
    unsigned sum, cnt, mine, sp = 0u;
    for (;;) {
        sum = 0u; cnt = 0u; mine = 0u;
#pragma unroll
        for (unsigned j = 0; j < 16; ++j) { const unsigned c = xb_ld(&bar[XB_XCNT(j)]); sum += c; cnt += (c > 0u) ? 1u : 0u; mine = (j == x) ? c : mine; }
        if (sum == G) break;
        __builtin_amdgcn_s_sleep(1);
        if ((++sp & 255u) == 0u) { if (xb_ld(&bar[XB_TMO])) break; if (sp > XB_SPIN_CAP) { atomicAdd(&bar[XB_TMO], 1u); break; } }
    }
    nloc = mine > 0u ? mine : 1u; nx = cnt > 0u ? cnt : 1u;
}
DI void xcd_barrier(const XcdBarrier& b) {
    asm volatile("s_waitcnt vmcnt(0)" ::: "memory");
    __syncthreads();
    if (threadIdx.x == 0) {
        unsigned* bar = b.bar;
        __builtin_amdgcn_s_waitcnt(0);
        unsigned nloc = b.st[0], nx = b.st[1];
        if (nloc == 0u) { xcd_barrier_complete(bar, b.x, nloc, nx); b.st[0] = nloc; b.st[1] = nx; }
        const unsigned old = xb_add(&bar[XB_XSUB(b.x)], 1u);
        const unsigned gen = old / nloc;
        if (old + 1u == (gen + 1u) * nloc) {
            __builtin_amdgcn_fence(__ATOMIC_RELEASE, "agent");
            asm volatile("s_waitcnt vmcnt(0)" ::: "memory");
            const unsigned og = xb_add(&bar[XB_TOP], 1u);
            const unsigned tg = og / nx;
            if (og + 1u == (tg + 1u) * nx) xb_add(&bar[XB_TOPGEN], 1u);
            else XB_SPIN(xb_ld(&bar[XB_TOPGEN]) == tg, bar);
            __builtin_amdgcn_fence(__ATOMIC_ACQUIRE, "agent");
            xb_add(&bar[XB_XGEN(b.x)], 1u);
            asm volatile("s_waitcnt vmcnt(0)" ::: "memory");
        } else {
            XB_SPIN(xb_ld(&bar[XB_XGEN(b.x)]) == gen, bar);
            __builtin_amdgcn_fence(__ATOMIC_ACQUIRE, "agent");
            asm volatile("s_waitcnt vmcnt(0)" ::: "memory");
        }
    }
    __syncthreads();
}

struct EpiBf16Plain {
    static constexpr bool PERM = true;
    bf16_t* O; int ldc;
    DI void operator()(const f32x4 (&acc)[2][2][4][2], const pg8::Unit& u, int wr, int wc, int fr, int fq) const {
        const int row0 = u.pm * 256 + wr * 64 + fr, col0 = u.pn * 256 + wc * 32 + 8 * fq;
#pragma unroll
        for (int ai = 0; ai < 2; ++ai)
#pragma unroll
            for (int m = 0; m < 4; ++m) { bf16_t* rowp = O + (size_t)(row0 + ai * 128 + m * 16) * ldc + col0;
#pragma unroll
                for (int bj = 0; bj < 2; ++bj) { const f32x4 v0 = acc[ai][bj][m][0], v1 = acc[ai][bj][m][1];
                    u32x4 w; w.x = pk2(v0[0], v0[1]); w.y = pk2(v0[2], v0[3]); w.z = pk2(v1[0], v1[1]); w.w = pk2(v1[2], v1[3]);
                    *(u32x4*)(rowp + bj * 128) = w; } }
    }
};
struct EpiBf16I8 {
    static constexpr bool PERM = true;
    bf16_t* O; int ldc; const float* sa; const float* sw;
    DI void operator()(const i32x4 (&acc)[2][2][4][2], const pg8::Unit& u, int wr, int wc, int fr, int fq) const {
        const int row0 = u.pm * 256 + wr * 64 + fr, col0 = u.pn * 256 + wc * 32 + 8 * fq;
        f32x4 w0[2], w1[2];
#pragma unroll
        for (int bj = 0; bj < 2; ++bj) { w0[bj] = *(const f32x4*)(sw + col0 + bj * 128); w1[bj] = *(const f32x4*)(sw + col0 + bj * 128 + 4); }
#pragma unroll
        for (int ai = 0; ai < 2; ++ai)
#pragma unroll
            for (int m = 0; m < 4; ++m) { const int row = row0 + ai * 128 + m * 16; const float ra = sa[row]; bf16_t* rowp = O + (size_t)row * ldc + col0;
#pragma unroll
                for (int bj = 0; bj < 2; ++bj) { const i32x4 a0 = acc[ai][bj][m][0], a1 = acc[ai][bj][m][1];
                    u32x4 w; w.x = pk2((float)a0[0] * ra * w0[bj][0], (float)a0[1] * ra * w0[bj][1]); w.y = pk2((float)a0[2] * ra * w0[bj][2], (float)a0[3] * ra * w0[bj][3]);
                    w.z = pk2((float)a1[0] * ra * w1[bj][0], (float)a1[1] * ra * w1[bj][1]); w.w = pk2((float)a1[2] * ra * w1[bj][2], (float)a1[3] * ra * w1[bj][3]);
                    *(u32x4*)(rowp + bj * 128) = w; } }
    }
};
struct EpiResGate {
    static constexpr bool PERM = false;
    const float* xin; float* out; const float* gt; float* rowss; const float* n2g;
    DI void operator()(const f32x4 (&acc)[2][2][4][2], const pg8::Unit& u, int wr, int wc, int fr, int fq) const {
        const int row0 = u.pm * 256 + wr * 64 + fr, col0 = u.pn * 256 + wc * 32 + 4 * fq;
        const int b = (u.pm * 256) / SEQ;
        const int ln = lane_opaque();
        f32x4 g[2][2], G2[2][2];
#pragma unroll
        for (int bj = 0; bj < 2; ++bj)
#pragma unroll
            for (int n = 0; n < 2; ++n) { g[bj][n] = *(const f32x4*)(gt + (size_t)b * 6144 + col0 + bj * 128 + n * 16);
                G2[bj][n] = *(const f32x4*)(n2g + col0 + bj * 128 + n * 16) * (*(const f32x4*)(gt + (size_t)b * 6144 + 2048 + col0 + bj * 128 + n * 16) + 1.f); }
#pragma unroll
        for (int ai = 0; ai < 2; ++ai)
#pragma unroll
            for (int m = 0; m < 4; ++m) { const size_t ro = (size_t)(row0 + ai * 128 + m * 16) * DM + col0; float ss = 0.f, mxg = 0.f;
#pragma unroll
                for (int bj = 0; bj < 2; ++bj)
#pragma unroll
                    for (int n = 0; n < 2; ++n) { const f32x4 xv = *(const f32x4*)(xin + ro + bj * 128 + n * 16); const f32x4 v = xv + g[bj][n] * acc[ai][bj][m][n];
                        *(f32x4*)(out + ro + bj * 128 + n * 16) = v; ss += (v[0] * v[0] + v[1] * v[1]) + (v[2] * v[2] + v[3] * v[3]);
                        const f32x4 vg = v * G2[bj][n]; mxg = fmaxf(mxg, fmaxf(fmaxf(fabsf(vg[0]), fabsf(vg[1])), fmaxf(fabsf(vg[2]), fabsf(vg[3])))); }
                ss += shfl_xor_l(ss, 16, ln); ss += shfl_xor_l(ss, 32, ln); mxg = fmaxf(mxg, shfl_xor_l(mxg, 16, ln)); mxg = fmaxf(mxg, shfl_xor_l(mxg, 32, ln));
                if (fq == 0) { float* rp = rowss + (size_t)(row0 + ai * 128 + m * 16) * 32 + u.pn * 4 + wc; rp[0] = ss; rp[16] = mxg; } }
    }
};
struct EpiGlu {
    static constexpr bool PERM = true;
    const bf16_t* Y; bf16_t* O; const float* bias;
    DI void operator()(const f32x4 (&acc)[2][2][4][2], const pg8::Unit& u, int wr, int wc, int fr, int fq) const {
        const int row0 = u.pm * 256 + wr * 64 + fr, col0 = wc * 32 + 8 * fq;
#pragma unroll
        for (int ai = 0; ai < 2; ++ai)
#pragma unroll
            for (int m = 0; m < 4; ++m) { const size_t ro = (size_t)(row0 + ai * 128 + m * 16) * 256 + col0;
#pragma unroll
                for (int bj = 0; bj < 2; ++bj) { const u32x4 yv = *(const u32x4*)(Y + ro + bj * 128);
                    const f32x4 b0 = *(const f32x4*)(bias + col0 + bj * 128), b1 = *(const f32x4*)(bias + col0 + bj * 128 + 4);
                    const f32x4 v0 = acc[ai][bj][m][0] + b0, v1 = acc[ai][bj][m][1] + b1;
                    u32x4 w;
                    w.x = pk2(bflo(yv.x) * sigmoidf_(v0[0]), bfhi(yv.x) * sigmoidf_(v0[1]));
                    w.y = pk2(bflo(yv.y) * sigmoidf_(v0[2]), bfhi(yv.y) * sigmoidf_(v0[3]));
                    w.z = pk2(bflo(yv.z) * sigmoidf_(v1[0]), bfhi(yv.z) * sigmoidf_(v1[1]));
                    w.w = pk2(bflo(yv.w) * sigmoidf_(v1[2]), bfhi(yv.w) * sigmoidf_(v1[3]));
                    *(u32x4*)(O + ro + bj * 128) = w; } }
    }
};

struct Frame { LAS unsigned char* lds; int tid, lane, wave, G, bid, gw, ngw; };

DI Frame make_frame(LAS unsigned char* lds, int wave0) {
    Frame F; F.lds = lds; int w = wave0; asm volatile("" : "+s"(w)); F.wave = w; F.lane = lane_opaque(); F.tid = w * 64 + F.lane;
    F.G = gridDim.x; F.bid = blockIdx.x; F.gw = F.bid * NWAVES + F.wave; F.ngw = F.G * NWAVES; return F;
}
DI void transpose_item(const float* src, int ld_src, int k0, int n0, bf16_t* dst, int ldd, int nd0, int kd0, LAS float* scr, int lane) {
#pragma unroll 8
    for (int i = 0; i < 32; ++i) { const int kk = 2 * i + (lane >> 5); scr[kk * 33 + (lane & 31)] = src[(size_t)(k0 + kk) * ld_src + n0 + (lane & 31)]; }
    asm volatile("s_waitcnt lgkmcnt(0)" ::: "memory");
    const int c = lane & 7;
#pragma unroll
    for (int j = 0; j < 4; ++j) { const int n = (lane >> 3) + 8 * j; const LAS float* s = scr + (8 * c) * 33 + n;
        u32x4 o; o.x = pk2(s[0 * 33], s[1 * 33]); o.y = pk2(s[2 * 33], s[3 * 33]); o.z = pk2(s[4 * 33], s[5 * 33]); o.w = pk2(s[6 * 33], s[7 * 33]);
        *(u32x4*)(dst + (size_t)(nd0 + n) * ldd + kd0 + 8 * c) = o; }
    asm volatile("s_waitcnt lgkmcnt(0)" ::: "memory");
}
DI void transpose_item64(const float* src, int ld_src, int k0, int n0, bf16_t* dst, int ldd, int nd0, int kd0, LAS float* scr, int lane) {
    f32x4 v[16];
#pragma unroll
    for (int i = 0; i < 16; ++i) v[i] = *(const f32x4*)(src + (size_t)(k0 + 4 * i + (lane >> 4)) * ld_src + n0 + 4 * (lane & 15));
#pragma unroll
    for (int i = 0; i < 16; ++i) { LAS float* p = scr + (4 * i + (lane >> 4)) * 65 + 4 * (lane & 15); p[0] = v[i][0]; p[1] = v[i][1]; p[2] = v[i][2]; p[3] = v[i][3]; }
    asm volatile("s_waitcnt lgkmcnt(0)" ::: "memory");
    const int c = lane & 7;
#pragma unroll
    for (int j = 0; j < 8; ++j) { const int n = (lane >> 3) + 8 * j; const LAS float* q = scr + (8 * c) * 65 + n;
        u32x4 o; o.x = pk2(q[0 * 65], q[1 * 65]); o.y = pk2(q[2 * 65], q[3 * 65]); o.z = pk2(q[4 * 65], q[5 * 65]); o.w = pk2(q[6 * 65], q[7 * 65]);
        *(u32x4*)(dst + (size_t)(nd0 + n) * ldd + kd0 + 8 * c) = o; }
    asm volatile("s_waitcnt lgkmcnt(0)" ::: "memory");
}
DI void quant_item64(const float* src, int ld_src, int k0, int n0, signed char* dst, int ldd, int nd0, int kd0, const unsigned* colmax, float* wsc, LAS float* scr, int lane, int nvalid = 1 << 30) {
    f32x4 v[16]; const bool okc = n0 + 4 * (lane & 15) < nvalid;
#pragma unroll
    for (int i = 0; i < 16; ++i) { v[i] = (f32x4){0.f, 0.f, 0.f, 0.f}; if (okc) v[i] = *(const f32x4*)(src + (size_t)(k0 + 4 * i + (lane >> 4)) * ld_src + n0 + 4 * (lane & 15)); }
#pragma unroll
    for (int i = 0; i < 16; ++i) { LAS float* p = scr + (4 * i + (lane >> 4)) * 65 + 4 * (lane & 15); p[0] = v[i][0]; p[1] = v[i][1]; p[2] = v[i][2]; p[3] = v[i][3]; }
    asm volatile("s_waitcnt lgkmcnt(0)" ::: "memory");
    const int c = lane & 7;
#pragma unroll
    for (int j = 0; j < 8; ++j) { const int n = (lane >> 3) + 8 * j; const LAS float* q = scr + (8 * c) * 65 + n;
        const float sc = fmaxf(__uint_as_float(colmax[n]), 1e-30f) * (1.f / 127.f), inv = 1.f / sc;
        if (wsc && c == 0) wsc[n] = sc;
        u32x2 o; o.x = q8x4((f32x4){q[0 * 65], q[1 * 65], q[2 * 65], q[3 * 65]}, inv); o.y = q8x4((f32x4){q[4 * 65], q[5 * 65], q[6 * 65], q[7 * 65]}, inv);
        *(u32x2*)(dst + (size_t)(nd0 + n) * ldd + kd0 + 8 * c) = o; }
    asm volatile("s_waitcnt lgkmcnt(0)" ::: "memory");
}
DI void quant_strip64(const float* src, int ld_src, int n0, int nvalid, signed char* dst, int ldd, float* scale, LAS float* scr, int lane) {
    const int c4 = n0 + 4 * (lane & 15); const bool okc = c4 < nvalid;
    float mx[4] = {0.f, 0.f, 0.f, 0.f};
    for (int kb = 0; kb < 16; ++kb) {
#pragma unroll
        for (int i = 0; i < 16; ++i) { f32x4 v = {0.f, 0.f, 0.f, 0.f}; if (okc) v = *(const f32x4*)(src + (size_t)(64 * kb + 4 * i + (lane >> 4)) * ld_src + c4);
            mx[0] = fmaxf(mx[0], fabsf(v[0])); mx[1] = fmaxf(mx[1], fabsf(v[1])); mx[2] = fmaxf(mx[2], fabsf(v[2])); mx[3] = fmaxf(mx[3], fabsf(v[3])); } }
#pragma unroll
    for (int q = 0; q < 4; ++q) { mx[q] = fmaxf(mx[q], shfl_xor_l(mx[q], 16, lane)); mx[q] = fmaxf(mx[q], shfl_xor_l(mx[q], 32, lane)); }
    LAS float* smax = scr + 64 * 65;
    if (lane < 16) {
#pragma unroll
        for (int q = 0; q < 4; ++q) { const float sc = fmaxf(mx[q], 1e-30f) * (1.f / 127.f); smax[4 * lane + q] = sc; scale[4 * lane + q] = sc; } }
    asm volatile("s_waitcnt lgkmcnt(0)" ::: "memory");
    for (int kb = 0; kb < 16; ++kb) {
        f32x4 v[16];
#pragma unroll
        for (int i = 0; i < 16; ++i) { v[i] = (f32x4){0.f, 0.f, 0.f, 0.f}; if (okc) v[i] = *(const f32x4*)(src + (size_t)(64 * kb + 4 * i + (lane >> 4)) * ld_src + c4); }
#pragma unroll
        for (int i = 0; i < 16; ++i) { LAS float* p = scr + (4 * i + (lane >> 4)) * 65 + 4 * (lane & 15); p[0] = v[i][0]; p[1] = v[i][1]; p[2] = v[i][2]; p[3] = v[i][3]; }
        asm volatile("s_waitcnt lgkmcnt(0)" ::: "memory");
        const int c = lane & 7;
#pragma unroll
        for (int j = 0; j < 8; ++j) { const int n = (lane >> 3) + 8 * j; const LAS float* q = scr + (8 * c) * 65 + n; const float inv = 1.f / smax[n];
            u32x2 o; o.x = q8x4((f32x4){q[0 * 65], q[1 * 65], q[2 * 65], q[3 * 65]}, inv); o.y = q8x4((f32x4){q[4 * 65], q[5 * 65], q[6 * 65], q[7 * 65]}, inv);
            *(u32x2*)(dst + (size_t)n * ldd + 64 * kb + 8 * c) = o; }
        asm volatile("s_waitcnt lgkmcnt(0)" ::: "memory");
    }
}
DI void zero_rows(bf16_t* dst, int ld, int r0, int nr, int c0, int nc, int gw, int ngw, int lane) {
    for (int r = gw; r < nr; r += ngw) for (int c = lane * 8; c < nc; c += 512) *(u32x4*)(dst + (size_t)(r0 + r) * ld + c0 + c) = (u32x4){0u, 0u, 0u, 0u};
}

DI void phase_prologue(const Frame& F, CArgs& A) {
    unsigned char* ws = A.ws;
    LAS float* sc = (LAS float*)F.lds;
    LAS float* part = (LAS float*)(F.lds + 32768);
    for (int i = F.tid; i < 8192; i += NTHR) sc[i] = siluf_(A.in[1][i]);
    __syncthreads();
    float* MOD = (float*)(ws + WS_MOD);
    for (int item = F.bid; item < 192; item += F.G) {
        const int l = item / 96, n0 = (item % 96) * 64, nl = F.tid & 63, kg = F.tid >> 6;
        const float* W = A.in[3] + (size_t)l * 1024 * 6144 + n0 + nl;
        float acc[8];
#pragma unroll
        for (int b = 0; b < 8; ++b) acc[b] = 0.f;
        for (int k = kg * 128; k < kg * 128 + 128; ++k) { const float w = W[(size_t)k * 6144];
#pragma unroll
            for (int b = 0; b < 8; ++b) acc[b] += sc[b * 1024 + k] * w; }
#pragma unroll
        for (int b = 0; b < 8; ++b) part[(kg * 8 + b) * 64 + nl] = acc[b];
        __syncthreads();
        { const int b = F.tid >> 6; float s = A.in[4][l * 6144 + n0 + nl];
#pragma unroll
          for (int g = 0; g < 8; ++g) s += part[(g * 8 + b) * 64 + nl];
          MOD[((size_t)l * 8 + b) * 6144 + n0 + nl] = s; }
        __syncthreads();
    }
    LAS float* scr = (LAS float*)(F.lds + F.wave * 16896);
    bf16_t* WIN = (bf16_t*)(ws + WS_WIN); bf16_t* WOUT = (bf16_t*)(ws + WS_WOUT); bf16_t* WMLA = (bf16_t*)(ws + WS_WMLA); bf16_t* WGLU = (bf16_t*)(ws + WS_WGLU);
    constexpr int I_IN = 0, I_INT = 0, I_OUT = 16 * 16, I_Q = 4 * 6, I_KV = 2 * 8, I_GLU = 4 * 4, I_L = I_IN + I_INT + I_OUT + I_Q + I_KV + I_GLU;
    for (int it = F.gw; it < 2 * I_L; it += F.ngw) {
        const int l = it / I_L; int r = it % I_L;
        if (r < I_IN) { transpose_item64(A.in[6] + (size_t)l * 1024 * D_IN, D_IN, 64 * (r / 32), 64 * (r % 32), WIN + (size_t)l * ZS * 1024, 1024, 64 * (r % 32), 64 * (r / 32), scr, F.lane); continue; } r -= I_IN;
        if (r < I_INT) { transpose_item(A.in[6] + (size_t)l * 1024 * D_IN, D_IN, 64 * r, 2048, WIN + (size_t)l * ZS * 1024, 1024, 2048, 64 * r, scr, F.lane); continue; } r -= I_INT;
        if (r < I_OUT) { transpose_item64(A.in[42] + (size_t)l * 1024 * 1024, 1024, 64 * (r / 16), 64 * (r % 16), WOUT + (size_t)l * 1024 * 1024, 1024, 64 * (r % 16), 64 * (r / 16), scr, F.lane); continue; } r -= I_OUT;
        if (r < I_Q) { transpose_item64(A.in[29] + (size_t)l * 256 * 384, 384, 64 * (r / 6), 64 * (r % 6), WMLA + (size_t)l * 1024 * 512, 512, 64 * (r % 6), 64 * (r / 6), scr, F.lane); continue; } r -= I_Q;
        if (r < I_KV) { transpose_item64(A.in[31] + (size_t)l * 128 * 512, 512, 64 * (r / 8), 64 * (r % 8), WMLA + (size_t)l * 1024 * 512, 512, 384 + 64 * (r % 8), 256 + 64 * (r / 8), scr, F.lane); continue; } r -= I_KV;
        transpose_item64(A.in[26] + (size_t)l * 256 * 256, 256, 64 * (r / 4), 64 * (r % 4), WGLU + (size_t)l * 256 * 256, 256, 64 * (r % 4), 64 * (r / 4), scr, F.lane);
    }
    { unsigned* CM = (unsigned*)(ws + WS_CTL) + CW_COLMAX;
      for (int it = F.gw; it < 2 * 32 * 2 * 128; it += F.ngw) { const int le = it >> 8, which = (it >> 7) & 1, kb = (it >> 3) & 15, nb = it & 7;
          const float* src = (which ? A.in[49] : A.in[48]) + (size_t)le * 1024 * 512 + (size_t)(64 * kb + (F.lane >> 4)) * 512 + 64 * nb + 4 * (F.lane & 15);
          float mx[4] = {0.f, 0.f, 0.f, 0.f};
#pragma unroll
          for (int i = 0; i < 16; ++i) { const f32x4 v = *(const f32x4*)(src + (size_t)(4 * i) * 512);
              mx[0] = fmaxf(mx[0], fabsf(v[0])); mx[1] = fmaxf(mx[1], fabsf(v[1])); mx[2] = fmaxf(mx[2], fabsf(v[2])); mx[3] = fmaxf(mx[3], fabsf(v[3])); }
#pragma unroll
          for (int q = 0; q < 4; ++q) { mx[q] = fmaxf(mx[q], shfl_xor_l(mx[q], 16, F.lane)); mx[q] = fmaxf(mx[q], shfl_xor_l(mx[q], 32, F.lane)); }
          if (F.lane < 16) { const int n0 = 64 * nb + 4 * F.lane, np = 256 * (n0 >> 7) + (n0 & 127) + 128 * which;
#pragma unroll
              for (int q = 0; q < 4; ++q) atomicMax(CM + (size_t)le * 1024 + np + q, __float_as_uint(mx[q])); } } }
    { unsigned* IM = (unsigned*)(ws + WS_CTL) + CW_INMAX;
      for (int it = F.gw; it < 2 * 16 * 33; it += F.ngw) { const int l = it / (16 * 33), r = it % (16 * 33), kb = r / 33, nb = r % 33;
          const int c4 = 64 * nb + 4 * (F.lane & 15); const bool okc = c4 < D_IN;
          const float* src = A.in[6] + (size_t)l * 1024 * D_IN + (size_t)(64 * kb + (F.lane >> 4)) * D_IN + c4;
          float mx[4] = {0.f, 0.f, 0.f, 0.f};
#pragma unroll
          for (int i = 0; i < 16; ++i) { f32x4 v = {0.f, 0.f, 0.f, 0.f}; if (okc) v = *(const f32x4*)(src + (size_t)(4 * i) * D_IN);
              mx[0] = fmaxf(mx[0], fabsf(v[0])); mx[1] = fmaxf(mx[1], fabsf(v[1])); mx[2] = fmaxf(mx[2], fabsf(v[2])); mx[3] = fmaxf(mx[3], fabsf(v[3])); }
#pragma unroll
          for (int q = 0; q < 4; ++q) { mx[q] = fmaxf(mx[q], shfl_xor_l(mx[q], 16, F.lane)); mx[q] = fmaxf(mx[q], shfl_xor_l(mx[q], 32, F.lane)); }
          if (F.lane < 16) {
#pragma unroll
              for (int q = 0; q < 4; ++q) atomicMax(IM + l * ZS + c4 + q, __float_as_uint(mx[q])); } }
      for (int l = 0; l < 2; ++l) {
          signed char* w8 = (signed char*)(ws + WS_WIN) + ((size_t)l * ZS + 2112) * 1024;
          for (int i = F.bid * NTHR + F.tid; i < 192 * 1024 / 16; i += F.G * NTHR) *(u32x4*)(w8 + (size_t)i * 16) = (u32x4){0u, 0u, 0u, 0u};
          for (int i = F.bid * NTHR + F.tid; i < 192; i += F.G * NTHR) ((float*)(ws + WS_WINSC))[l * ZS + 2112 + i] = 0.f; } }
    { bf16_t* WR = (bf16_t*)(ws + WS_WR);
      for (int i = F.bid * NTHR + F.tid; i < 2 * 48 * 1024; i += F.G * NTHR) { const int l = i / (48 * 1024), n = (i / 1024) % 48, k = i % 1024;
          const float v = n < 4 ? A.in[44][((size_t)l * 1024 + k) * 4 + n] : n < 36 ? A.in[46][((size_t)l * 1024 + k) * 32 + (n - 4)] : 0.f;
          const unsigned hi = f2bf(v); const float rem = v - __uint_as_float(hi << 16);
          WR[((size_t)(l * 2 + 0) * 48 + n) * 1024 + k] = (bf16_t)hi; WR[((size_t)(l * 2 + 1) * 48 + n) * 1024 + k] = (bf16_t)f2bf(rem); } }
    { bf16_t* WL = (bf16_t*)(ws + WS_WLRU); bf16_t* WO = (bf16_t*)(ws + WS_WLORA);
      for (int i = F.bid * NTHR + F.tid; i < 2 * 2 * 4 * 4096; i += F.G * NTHR) { const int l = i >> 15, wh = (i >> 14) & 1, n = (i >> 12) & 3, j = (i >> 6) & 63, k = i & 63;
          WL[i] = (bf16_t)f2bf((wh ? A.in[38] : A.in[36])[((size_t)(l * 4 + n) * 64 + k) * 64 + j]); }
      for (int i = F.bid * NTHR + F.tid; i < 2 * 32768; i += F.G * NTHR) { const int l = i >> 15, r = i & 32767;
          float v;
          if (r < 8192) v = A.in[9][(size_t)l * 8192 + (r & 31) * 256 + (r >> 5)];
          else if (r < 16384) v = A.in[11][(size_t)l * 8192 + ((r - 8192) & 31) * 256 + ((r - 8192) >> 5)];
          else v = A.in[12][(size_t)l * 16384 + ((r - 16384) & 63) * 256 + ((r - 16384) >> 6)];
          WO[i] = (bf16_t)f2bf(v); } }
    { bf16_t* BBt = (bf16_t*)(ws + WS_S5BB); bf16_t* CCt = (bf16_t*)(ws + WS_S5CC);
      for (int i = F.bid * NTHR + F.tid; i < 2 * 16 * 64; i += F.G * NTHR) { const int lg = i >> 6, p = i & 63;
          const float dt = __expf(A.in[25][lg]); const float lre = A.in[18][lg * 64 + p], lim = A.in[19][lg * 64 + p];
          const float mag = expf(lre * dt); float sn, cn; sincosf(lim * dt, &sn, &cn);
          const float are = mag * cn, aim = mag * sn, den = lre * lre + lim * lim;
          const float qre = ((are - 1.f) * lre + aim * lim) / den, qim = (aim * lre - (are - 1.f) * lim) / den;
          const float* br = A.in[20] + ((size_t)lg * 64 + p) * 16; const float* bi = A.in[21] + ((size_t)lg * 64 + p) * 16;
          for (int c = 0; c < 16; ++c) { const float x = br[c], y = bi[c];
              BBt[(((size_t)lg * 2 + 0) * 64 + p) * 16 + c] = (bf16_t)f2bf(qre * x - qim * y); BBt[(((size_t)lg * 2 + 1) * 64 + p) * 16 + c] = (bf16_t)f2bf(qre * y + qim * x); } }
      for (int i = F.bid * NTHR + F.tid; i < 2 * 16 * 16 * 128; i += F.G * NTHR) { const int lg = i >> 11, ii = (i >> 7) & 15, k = i & 127;
          CCt[i] = (bf16_t)f2bf(k < 64 ? A.in[22][((size_t)lg * 16 + ii) * 64 + k] : -A.in[23][((size_t)lg * 16 + ii) * 64 + (k - 64)]); } }
    for (int l = 0; l < 2; ++l) {
        bf16_t* wm = WMLA + (size_t)l * 1024 * 512;
        zero_rows(wm, 512, 0, 384, 256, 256, F.gw, F.ngw, F.lane);
        zero_rows(wm, 512, 384, 512, 0, 256, F.gw, F.ngw, F.lane);
        zero_rows(wm, 512, 384, 512, 384, 128, F.gw, F.ngw, F.lane);
        zero_rows(wm, 512, 896, 128, 0, 512, F.gw, F.ngw, F.lane);
    }
}

DI void phase_win_quant(const Frame& F, CArgs& A) {
    LAS float* scr = (LAS float*)(F.lds + F.wave * 16640);
    const unsigned* IM = (const unsigned*)(A.ws + WS_CTL) + CW_INMAX;
    for (int it = F.gw; it < 2 * 16 * 33; it += F.ngw) { const int l = it / (16 * 33), r = it % (16 * 33), kb = r / 33, nb = r % 33;
        quant_item64(A.in[6] + (size_t)l * 1024 * D_IN, D_IN, 64 * kb, 64 * nb, (signed char*)(A.ws + WS_WIN) + (size_t)l * ZS * 1024, 1024, 64 * nb, 64 * kb, IM + l * ZS + 64 * nb,
                     kb == 0 ? (float*)(A.ws + WS_WINSC) + l * ZS + 64 * nb : (float*)nullptr, scr, F.lane, D_IN); }
}
DI void phase_norm1(const Frame& F, CArgs& A, int l) {
    const float* MODL = (const float*)(A.ws + WS_MOD) + (size_t)l * 8 * 6144;
    const float* g = A.in[5] + l * 1024;
    const bf16_t* Y = (const bf16_t*)(A.ws + WS_Y);
    signed char* H8 = (signed char*)(A.ws + WS_H); float* HS = (float*)(A.ws + WS_HSC);
    const float* src = (l == 0) ? A.in[0] : A.out;
    for (int row0 = 2 * F.gw; row0 < T; row0 += 2 * F.ngw) {
        const int b = row0 / SEQ;
        f32x4 v[2][4]; u32x2 ya[2][4], yb[2][4];
#pragma unroll
        for (int r = 0; r < 2; ++r)
#pragma unroll
            for (int j = 0; j < 4; ++j) { const int col = 4 * (64 * j + F.lane); v[r][j] = *(const f32x4*)(src + (size_t)(row0 + r) * DM + col);
                if (l > 0) { ya[r][j] = *(const u32x2*)(Y + (size_t)(2 * (row0 + r)) * DM + col); yb[r][j] = *(const u32x2*)(Y + (size_t)(2 * (row0 + r) + 1) * DM + col); } }
#pragma unroll
        for (int r = 0; r < 2; ++r) {
            const int row = row0 + r; float ss = 0.f;
#pragma unroll
            for (int j = 0; j < 4; ++j) { const int col = 4 * (64 * j + F.lane);
                if (l > 0) { const u32x2 y0 = ya[r][j], y1 = yb[r][j];
                    v[r][j][0] += bflo(y0.x) + bflo(y1.x); v[r][j][1] += bfhi(y0.x) + bfhi(y1.x); v[r][j][2] += bflo(y0.y) + bflo(y1.y); v[r][j][3] += bfhi(y0.y) + bfhi(y1.y);
                    *(f32x4*)(A.out + (size_t)row * DM + col) = v[r][j]; }
                ss += v[r][j][0] * v[r][j][0] + v[r][j][1] * v[r][j][1] + v[r][j][2] * v[r][j][2] + v[r][j][3] * v[r][j][3]; }
            const float rstd = rsqrtf(wave_sum(ss) * (1.f / DM) + NORM_EPS);
#pragma unroll
            for (int j = 0; j < 4; ++j) { const int col = 4 * (64 * j + F.lane);
                const f32x4 gg = *(const f32x4*)(g + col), sh = *(const f32x4*)(MODL + (size_t)b * 6144 + col), scv = *(const f32x4*)(MODL + (size_t)b * 6144 + 1024 + col);
                v[r][j] = v[r][j] * rstd * gg * (scv + 1.f) + sh; }
            float mx = 0.f;
#pragma unroll
            for (int j = 0; j < 4; ++j) mx = fmaxf(mx, fmaxf(fmaxf(fabsf(v[r][j][0]), fabsf(v[r][j][1])), fmaxf(fabsf(v[r][j][2]), fabsf(v[r][j][3]))));
            mx = fmaxf(wave_max(mx), 1e-30f); const float inv = 127.f / mx;
            if (F.lane == 0) HS[row] = mx * (1.f / 127.f);
#pragma unroll
            for (int j = 0; j < 4; ++j) *(unsigned*)(H8 + (size_t)row * DM + 4 * (64 * j + F.lane)) = q8x4(v[r][j], inv);
        }
    }
}

DI void phase_mla_prep(const Frame& F, CArgs& A, int l) {
    const bf16_t* Z = (const bf16_t*)(A.ws + WS_Z); bf16_t* AM = (bf16_t*)(A.ws + WS_AMLA);
    const float* qg = A.in[28] + l * 256; const float* kg = A.in[30] + l * 128;
    for (int row = F.gw; row < T; row += F.ngw) {
        const bf16_t* zr = Z + (size_t)row * ZS;
        const u32x2 qv = *(const u32x2*)(zr + ZC_QA + 4 * F.lane); const unsigned kv = *(const unsigned*)(zr + ZC_KVA + 2 * F.lane);
        const float q0 = bflo(qv.x), q1 = bfhi(qv.x), q2 = bflo(qv.y), q3 = bfhi(qv.y), k0 = bflo(kv), k1 = bfhi(kv);
        const float rq = rsqrtf(wave_sum(q0 * q0 + q1 * q1 + q2 * q2 + q3 * q3) * (1.f / 256.f) + NORM_EPS);
        const float rk = rsqrtf(wave_sum(k0 * k0 + k1 * k1) * (1.f / 128.f) + NORM_EPS);
        const f32x4 g4 = *(const f32x4*)(qg + 4 * F.lane); const f32x2 g2 = *(const f32x2*)(kg + 2 * F.lane);
        u32x2 o; o.x = pk2(q0 * rq * g4[0], q1 * rq * g4[1]); o.y = pk2(q2 * rq * g4[2], q3 * rq * g4[3]);
        bf16_t* ar = AM + (size_t)row * 512;
        *(u32x2*)(ar + 4 * F.lane) = o;
        *(unsigned*)(ar + 256 + 2 * F.lane) = pk2(k0 * rk * g2[0], k1 * rk * g2[1]);
        *(unsigned*)(ar + 384 + 2 * F.lane) = 0u;
    }
}

DI void phase_mla_post(const Frame& F, CArgs& A, int l) {
    const bf16_t* Z = (const bf16_t*)(A.ws + WS_Z); const bf16_t* RAW = (const bf16_t*)(A.ws + WS_QKVRAW);
    bf16_t* Q = (bf16_t*)(A.ws + WS_Q); bf16_t* K = (bf16_t*)(A.ws + WS_K); bf16_t* VT = (bf16_t*)(A.ws + WS_VT);
    LAS float* cs = (LAS float*)F.lds;
    LAS bf16_t* vt = (LAS bf16_t*)(F.lds + 8192);
    const float* qhg = A.in[32] + l * 96; const float* khg = A.in[33] + l * 96;
    for (int tile = F.bid; tile < T / 64; tile += F.G) {
        const int t0 = tile * 64, b = t0 / SEQ, s0 = t0 % SEQ;
        int tz = F.tid; asm volatile("" : "+v"(tz));
        for (int idx = tz; idx < 1024; idx += NTHR) { const int tok = idx >> 4, i = idx & 15;
            const int pos = A.pos_off[b] + s0 + tok; const float inv = powf(10000.f, -(float)i * (1.f / 16.f));
            double ang = (double)(float)pos * (double)inv; ang -= 6.283185307179586 * floor(ang * 0.15915494309189535);
            float sn, cn; sincosf((float)ang, &sn, &cn); cs[idx * 2] = cn; cs[idx * 2 + 1] = sn; }
        lds_barrier();
        const int tok = tz >> 3, sub = tz & 7, h = sub >> 1, isk = sub & 1, t = t0 + tok;
        {
            float v[96];
            const bf16_t* p0 = isk ? RAW + (size_t)t * 1024 + 384 + 128 * h : RAW + (size_t)t * 1024 + 96 * h;
            const bf16_t* p1 = isk ? Z + (size_t)t * ZS + ZC_KPE : p0 + 64;
#pragma unroll
            for (int c = 0; c < 8; ++c) { const u32x4 w = *(const u32x4*)(p0 + 8 * c);
                v[8 * c] = bflo(w.x); v[8 * c + 1] = bfhi(w.x); v[8 * c + 2] = bflo(w.y); v[8 * c + 3] = bfhi(w.y); v[8 * c + 4] = bflo(w.z); v[8 * c + 5] = bfhi(w.z); v[8 * c + 6] = bflo(w.w); v[8 * c + 7] = bfhi(w.w); }
#pragma unroll
            for (int c = 0; c < 4; ++c) { const u32x4 w = *(const u32x4*)(p1 + 8 * c);
                v[64 + 8 * c] = bflo(w.x); v[65 + 8 * c] = bfhi(w.x); v[66 + 8 * c] = bflo(w.y); v[67 + 8 * c] = bfhi(w.y); v[68 + 8 * c] = bflo(w.z); v[69 + 8 * c] = bfhi(w.z); v[70 + 8 * c] = bflo(w.w); v[71 + 8 * c] = bfhi(w.w); }
            float ss = 0.f;
#pragma unroll
            for (int i = 0; i < 96; ++i) ss += v[i] * v[i];
            const float r = rsqrtf(ss * (1.f / 96.f) + NORM_EPS);
            const float* hg = isk ? khg : qhg;
#pragma unroll
            for (int i = 0; i < 96; ++i) v[i] = v[i] * r * hg[i];
#pragma unroll
            for (int i = 0; i < 16; ++i) { const float cn = cs[(tok * 16 + i) * 2], sn = cs[(tok * 16 + i) * 2 + 1]; const float x1 = v[64 + i], x2 = v[80 + i];
                v[64 + i] = x1 * cn - x2 * sn; v[80 + i] = x1 * sn + x2 * cn; }
            bf16_t* dst = (isk ? K : Q) + ((size_t)t * 4 + h) * 96;
#pragma unroll
            for (int c = 0; c < 12; ++c) { u32x4 w; w.x = pk2(v[8 * c], v[8 * c + 1]); w.y = pk2(v[8 * c + 2], v[8 * c + 3]); w.z = pk2(v[8 * c + 4], v[8 * c + 5]); w.w = pk2(v[8 * c + 6], v[8 * c + 7]);
                *(u32x4*)(dst + 8 * c) = w; }
        }
        {
            const bf16_t* pv = RAW + (size_t)t * 1024 + 384 + 128 * h + 64 + 32 * isk;
#pragma unroll
            for (int c = 0; c < 4; ++c) { const u32x4 w = *(const u32x4*)(pv + 8 * c); const int r0 = h * 64 + 32 * isk + 8 * c;
                vt[(r0 + 0) * 72 + tok] = (bf16_t)(w.x & 0xffffu); vt[(r0 + 1) * 72 + tok] = (bf16_t)(w.x >> 16);
                vt[(r0 + 2) * 72 + tok] = (bf16_t)(w.y & 0xffffu); vt[(r0 + 3) * 72 + tok] = (bf16_t)(w.y >> 16);
                vt[(r0 + 4) * 72 + tok] = (bf16_t)(w.z & 0xffffu); vt[(r0 + 5) * 72 + tok] = (bf16_t)(w.z >> 16);
                vt[(r0 + 6) * 72 + tok] = (bf16_t)(w.w & 0xffffu); vt[(r0 + 7) * 72 + tok] = (bf16_t)(w.w >> 16); }
        }
        lds_barrier();
        { const int row = tz >> 1, hf = tz & 1;
          bf16_t* dst = VT + ((size_t)(b * 4) * 64 + row) * SEQ + s0 + 32 * hf;
#pragma unroll
          for (int c = 0; c < 4; ++c) *(u32x4*)(dst + 8 * c) = *(const LAS u32x4*)(vt + row * 72 + 32 * hf + 8 * c); }
        lds_barrier();
    }
}

DI void attn_unit(const Frame& F, const bf16_t* Q, const bf16_t* K, const bf16_t* VT, bf16_t* O, int bh, int u, float eoff) {
    constexpr int KP = 208, VP = 144, KB = 64 * KP, VB = 64 * VP;
    LAS unsigned char* Ks = F.lds; LAS unsigned char* Vs = F.lds + 2 * KB;
    int tz = F.tid; asm volatile("" : "+v"(tz));
    const int b = bh >> 2, h = bh & 3, lane = tz & 63, w = F.wave, ql = lane & 31, hh = lane >> 5;
    const int ntile = 8 * u + 8, myl = 8 * u + w;
    const size_t tq0 = (size_t)b * SEQ + 512 * u + 64 * w + ql;
    bf16x8 qf[2][6];
#pragma unroll
    for (int qt = 0; qt < 2; ++qt)
#pragma unroll
        for (int s = 0; s < 6; ++s) qf[qt][s] = *(const bf16x8*)(Q + ((tq0 + 32 * qt) * 4 + h) * 96 + 16 * s + 8 * hh);
    f32x16 ot[2][2];
#pragma unroll
    for (int i = 0; i < 16; ++i) { ot[0][0][i] = 0.f; ot[0][1][i] = 0.f; ot[1][0][i] = 0.f; ot[1][1][i] = 0.f; }
    float lrun[2] = {0.f, 0.f};
    const float c2 = 0.10206207261596577f * 1.4426950408889634f;
    const int kp0 = tz, kp1 = tz + 512;
    const size_t kbase = ((size_t)b * SEQ * 4 + h) * 96;
    const bf16_t* vsrc = VT + ((size_t)bh * 64 + (tz >> 3)) * SEQ + 8 * (tz & 7);
    u32x4 rk0, rk1, rv;
    rk1 = (u32x4){0u, 0u, 0u, 0u};
#define ATT_LOAD(j) do { rk0 = *(const u32x4*)(K + kbase + (size_t)(64 * (j) + kp0 / 12) * 384 + 8 * (kp0 % 12)); \
        if (kp1 < 768) rk1 = *(const u32x4*)(K + kbase + (size_t)(64 * (j) + kp1 / 12) * 384 + 8 * (kp1 % 12)); \
        rv = *(const u32x4*)(vsrc + 64 * (j)); } while (0)
#define ATT_STORE(jj) do { *(LAS u32x4*)(Ks + ((jj) & 1) * KB + (kp0 / 12) * KP + (kp0 % 12) * 16) = rk0; \
        if (kp1 < 768) *(LAS u32x4*)(Ks + ((jj) & 1) * KB + (kp1 / 12) * KP + (kp1 % 12) * 16) = rk1; \
        *(LAS u32x4*)(Vs + ((jj) % 3) * VB + (tz >> 3) * VP + (tz & 7) * 16) = rv; } while (0)
#define ATT_PV(vb, ktp) do { _Pragma("unroll") for (int c = 0; c < 2; ++c) { const int key0 = 32 * (ktp) + 16 * c + 4 * hh; \
        _Pragma("unroll") for (int dt = 0; dt < 2; ++dt) { const LAS unsigned char* vp = Vs + (vb) * VB + (32 * dt + ql) * VP + key0 * 2; \
            const u32x2 v0 = *(const LAS u32x2*)vp, v1 = *(const LAS u32x2*)(vp + 16); u32x4 vw; vw.x = v0.x; vw.y = v0.y; vw.z = v1.x; vw.w = v1.y; const bf16x8 vf = __builtin_bit_cast(bf16x8, vw); \
            ot[dt][0] = __builtin_amdgcn_mfma_f32_32x32x16_bf16(vf, pfo[0][c], ot[dt][0], 0, 0, 0); ot[dt][1] = __builtin_amdgcn_mfma_f32_32x32x16_bf16(vf, pfo[1][c], ot[dt][1], 0, 0, 0); } } } while (0)
#define ATT_SM() do { _Pragma("unroll") for (int qt = 0; qt < 2; ++qt) { float ps = 0.f; \
        _Pragma("unroll") for (int i = 0; i < 16; ++i) { const float p = __builtin_amdgcn_exp2f(st[qt][i] * c2 - eoff); st[qt][i] = p; ps += p; } \
        lrun[qt] += ps; \
        _Pragma("unroll") for (int c = 0; c < 2; ++c) { u32x4 pw; pw.x = pk2(st[qt][8 * c], st[qt][8 * c + 1]); pw.y = pk2(st[qt][8 * c + 2], st[qt][8 * c + 3]); pw.z = pk2(st[qt][8 * c + 4], st[qt][8 * c + 5]); pw.w = pk2(st[qt][8 * c + 6], st[qt][8 * c + 7]); \
            pfn[qt][c] = __builtin_bit_cast(bf16x8, pw); } } } while (0)
#define ATT_MIX() do { _Pragma("unroll") for (int g_ = 0; g_ < 4; ++g_) { __builtin_amdgcn_sched_group_barrier(0x100, 2, 0); __builtin_amdgcn_sched_group_barrier(0x008, 1, 0); __builtin_amdgcn_sched_group_barrier(0x002, 14, 0); \
        __builtin_amdgcn_sched_group_barrier(0x008, 1, 0); __builtin_amdgcn_sched_group_barrier(0x002, 14, 0); } } while (0)
    ATT_LOAD(0); ATT_STORE(0);
    lds_barrier();
    bf16x8 pfo[2][2], pfn[2][2];
    bool owed = false;
    for (int j = 0; j < ntile; ++j) {
        if (j + 1 < ntile) ATT_LOAD(j + 1);
        if (j <= myl) {
#pragma unroll
            for (int kt = 0; kt < 2; ++kt) {
                f32x16 st[2];
#pragma unroll
                for (int i = 0; i < 16; ++i) { st[0][i] = 0.f; st[1][i] = 0.f; }
#pragma unroll
                for (int s = 0; s < 6; ++s) { const bf16x8 kf = *(const LAS bf16x8*)(Ks + (j & 1) * KB + (32 * kt + ql) * KP + (16 * s + 8 * hh) * 2);
                    st[0] = __builtin_amdgcn_mfma_f32_32x32x16_bf16(kf, qf[0][s], st[0], 0, 0, 0);
                    st[1] = __builtin_amdgcn_mfma_f32_32x32x16_bf16(kf, qf[1][s], st[1], 0, 0, 0); }
                __builtin_amdgcn_sched_barrier(0);
                if (kt == 0) { if (owed) { ATT_PV((j + 2) % 3, 1); ATT_SM(); ATT_MIX(); } else { ATT_SM(); } }
                else { ATT_PV(j % 3, 0); ATT_SM(); ATT_MIX(); }
                __builtin_amdgcn_sched_barrier(0);
#pragma unroll
                for (int qt = 0; qt < 2; ++qt) { pfo[qt][0] = pfn[qt][0]; pfo[qt][1] = pfn[qt][1]; }
            }
            owed = true;
        } else if (owed) { ATT_PV(myl % 3, 1); owed = false; }
        if (j + 1 < ntile) ATT_STORE(j + 1);
        lds_barrier();
    }
    if (owed) ATT_PV(myl % 3, 1);
#undef ATT_LOAD
#undef ATT_STORE
#undef ATT_PV
#undef ATT_SM
#undef ATT_MIX
    int lz2 = lane; asm volatile("" : "+v"(lz2));
    const unsigned tqe = (unsigned)(b * SEQ + 512 * u + 64 * w + (lz2 & 31));
#pragma unroll
    for (int qt = 0; qt < 2; ++qt) {
        const float linv = 1.f / (lrun[qt] + shfl_xor_l(lrun[qt], 32, lane));
        bf16_t* orow = O + (size_t)(tqe + 32 * qt) * 256 + h * 64;
#pragma unroll
        for (int dt = 0; dt < 2; ++dt)
#pragma unroll
            for (int g = 0; g < 4; ++g) { u32x2 o; o.x = pk2(ot[dt][qt][4 * g] * linv, ot[dt][qt][4 * g + 1] * linv); o.y = pk2(ot[dt][qt][4 * g + 2] * linv, ot[dt][qt][4 * g + 3] * linv);
                *(u32x2*)(orow + 32 * dt + 8 * g + 4 * hh) = o; }
    }
    lds_barrier();
}
DI void phase_attn(const Frame& F, CArgs& A, int l) {
    const bf16_t* Q = (const bf16_t*)(A.ws + WS_Q); const bf16_t* K = (const bf16_t*)(A.ws + WS_K); const bf16_t* VT = (const bf16_t*)(A.ws + WS_VT);
    bf16_t* O = (bf16_t*)(A.ws + WS_ATTO);
    float gq = 0.f, gk = 0.f;
    for (int i = 0; i < 96; ++i) { gq = fmaxf(gq, fabsf(A.in[32][l * 96 + i])); gk = fmaxf(gk, fabsf(A.in[33][l * 96 + i])); }
    const float eoff = 96.f * gq * gk * 0.10206207261596577f * 1.4426950408889634f * 1.0001f;
    for (int p = F.bid; p < 256; p += F.G) { const int bh = p >> 3, u = p & 7;
        attn_unit(F, Q, K, VT, O, bh, 15 - u, eoff);
        attn_unit(F, Q, K, VT, O, bh, u, eoff); }
}
DI f32x16 mfma32(bf16x8 a, bf16x8 b, f32x16 c) { return __builtin_amdgcn_mfma_f32_32x32x16_bf16(a, b, c, 0, 0, 0); }
DI bf16x8 ldfrag(const LAS unsigned char* base, int row, int ks, int h) { return *(const LAS bf16x8*)(base + row * 144 + (16 * ks + 8 * h) * 2); }
DI f32x16 zero16() { f32x16 z;
#pragma unroll
    for (int i = 0; i < 16; ++i) z[i] = 0.f;
    return z; }
DI bf16x8 pack8(const f32x16& x, int o) { u32x4 p; p.x = pk2(x[o], x[o + 1]); p.y = pk2(x[o + 2], x[o + 3]); p.z = pk2(x[o + 4], x[o + 5]); p.w = pk2(x[o + 6], x[o + 7]); return __builtin_bit_cast(bf16x8, p); }
DI f32x16 tileprod(const LAS unsigned char* Aimg, int a0, const LAS unsigned char* Bimg, int b0, f32x16 acc, int lr, int h2) {
#pragma unroll
    for (int ks = 0; ks < 4; ++ks) acc = mfma32(ldfrag(Aimg, a0 + lr, ks, h2), ldfrag(Bimg, b0 + lr, ks, h2), acc);
    return acc;
}
DI void put_tile(LAS unsigned char* img, int c0, int r0, const f32x16& a, int lr, int h2) {
#pragma unroll
    for (int g = 0; g < 4; ++g) { u32x2 o; o.x = pk2(a[4 * g], a[4 * g + 1]); o.y = pk2(a[4 * g + 2], a[4 * g + 3]); *(LAS u32x2*)(img + (c0 + lr) * 144 + (r0 + 8 * g + 4 * h2) * 2) = o; }
}
DI void phase_rwkv_A(const Frame& F, CArgs& A, int l) {
    const bf16_t* Z = (const bf16_t*)(A.ws + WS_Z); bf16_t* V_ = (bf16_t*)(A.ws + WS_RW_V); bf16_t* G_ = (bf16_t*)(A.ws + WS_RW_G);
    const float* mu = A.in[7] + l * 896; const float* w0 = A.in[8] + l * 256; const float* a0 = A.in[10] + l * 256; const float* k_k = A.in[13] + l * 256; const float* k_a = A.in[14] + l * 256;
    const bf16_t* WO = (const bf16_t*)(A.ws + WS_WLORA) + (size_t)l * 32768;
    bf16_t* RP = (bf16_t*)(A.ws + WS_RC_RP); float* Y0T = (float*)(A.ws + WS_RC_Y0); unsigned char* REC = A.ws + WS_RC_G;
    float* BSUM = (float*)(A.ws + WS_RC_BS);
    const float* r_k = A.in[15] + l * 256;
    constexpr int TB = 64 * 144;
#define TILE(i) (F.lds + (i) * TB)
    LAS float* XF = (LAS float*)TILE(13);
    const int w = F.wave;
    for (int ub = F.bid; ub < 1024; ub += F.G) {
      const int b = ub >> 7, c = ub & 127;
      const size_t t0 = (size_t)b * SEQ + 64 * c;
      bf16x8 xf[4];
      {
        int tid = F.tid; asm volatile("" : "+v"(tid)); const int lane = tid & 63, fr = lane & 15, fq = lane >> 4, mt = w & 3;
        const int tk = 16 * mt + fr; const size_t t = t0 + tk; const bool hp = (64 * c + tk) > 0;
        const bf16_t* zr = Z + t * ZS + ZC_WLO + 8 * fq;
#pragma unroll
        for (int ks = 0; ks < 4; ++ks) {
            const u32x4 zc = *(const u32x4*)(zr + 32 * ks); u32x4 zp = {0u, 0u, 0u, 0u}; if (hp) zp = *(const u32x4*)(zr + 32 * ks - ZS);
            const f32x4 m0 = *(const f32x4*)(mu + ZC_WLO + 32 * ks + 8 * fq), m1 = *(const f32x4*)(mu + ZC_WLO + 32 * ks + 8 * fq + 4);
            const unsigned cw[4] = {zc.x, zc.y, zc.z, zc.w}, pw[4] = {zp.x, zp.y, zp.z, zp.w}; const float mm[8] = {m0[0], m0[1], m0[2], m0[3], m1[0], m1[1], m1[2], m1[3]};
            float v[8];
#pragma unroll
            for (int i = 0; i < 8; ++i) { const float zcv = (i & 1) ? bfhi(cw[i >> 1]) : bflo(cw[i >> 1]), zpv = (i & 1) ? bfhi(pw[i >> 1]) : bflo(pw[i >> 1]);
                float x = zcv + (zpv - zcv) * mm[i]; if (ks == 0) x = fast_tanh(x); else if (ks >= 2) x = sigmoidf_(x); v[i] = x; }
            u32x4 o; o.x = pk2(v[0], v[1]); o.y = pk2(v[2], v[3]); o.z = pk2(v[4], v[5]); o.w = pk2(v[6], v[7]); xf[ks] = __builtin_bit_cast(bf16x8, o);
        }
      }
      for (int hd = 0; hd < 4; ++hd) {
        const int u = (b * 4 + hd) * 128 + c;
        {
        int tid = F.tid; asm volatile("" : "+v"(tid)); const int lane = tid & 63, fr = lane & 15, fq = lane >> 4, mt = w & 3, nh = w >> 2;
        const int tk = 16 * mt + fr; const size_t t = t0 + tk; const bool hp = (64 * c + tk) > 0;
        LAS float* hs = (LAS float*)TILE(12);
        f32x4 aw[2], aa[2], ag[2];
        {
#pragma unroll
            for (int nf = 0; nf < 2; ++nf) { const int ch = hd * 64 + 32 * nh + 8 * (fr >> 2) + 4 * nf + (fr & 3);     const f32x4 z4 = {0.f, 0.f, 0.f, 0.f};
                aw[nf] = __builtin_amdgcn_mfma_f32_16x16x32_bf16(*(const bf16x8*)(WO + ch * 32 + 8 * fq), xf[0], z4, 0, 0, 0);
                aa[nf] = __builtin_amdgcn_mfma_f32_16x16x32_bf16(*(const bf16x8*)(WO + 8192 + ch * 32 + 8 * fq), xf[1], z4, 0, 0, 0);
                ag[nf] = __builtin_amdgcn_mfma_f32_16x16x32_bf16(*(const bf16x8*)(WO + 16384 + ch * 64 + 8 * fq), xf[2], z4, 0, 0, 0);
                ag[nf] = __builtin_amdgcn_mfma_f32_16x16x32_bf16(*(const bf16x8*)(WO + 16384 + ch * 64 + 32 + 8 * fq), xf[3], ag[nf], 0, 0, 0); }
        }
        f32x4 rr[2], kq[2], km[2], vv4[2], lw4[2], a4[2];
        float ssq = 0.f, bsp = 0.f;
#pragma unroll
        for (int nf = 0; nf < 2; ++nf) { const int d4 = 32 * nh + 8 * fq + 4 * nf, ch4 = hd * 64 + d4;
            const u32x2 rc = *(const u32x2*)(Z + t * ZS + ZC_R + ch4), kc = *(const u32x2*)(Z + t * ZS + ZC_K + ch4), vc = *(const u32x2*)(Z + t * ZS + ZC_V + ch4);
            u32x2 rp = {0u, 0u}, kp = {0u, 0u}, vp = {0u, 0u};
            if (hp) { rp = *(const u32x2*)(Z + (t - 1) * ZS + ZC_R + ch4); kp = *(const u32x2*)(Z + (t - 1) * ZS + ZC_K + ch4); vp = *(const u32x2*)(Z + (t - 1) * ZS + ZC_V + ch4); }
            const f32x4 mr = *(const f32x4*)(mu + ZC_R + ch4), mk = *(const f32x4*)(mu + ZC_K + ch4), mv = *(const f32x4*)(mu + ZC_V + ch4), ka = *(const f32x4*)(k_a + ch4), kkw = *(const f32x4*)(k_k + ch4), rk4 = *(const f32x4*)(r_k + ch4);
            const f32x4 rcv = {bflo(rc.x), bfhi(rc.x), bflo(rc.y), bfhi(rc.y)}, rpv = {bflo(rp.x), bfhi(rp.x), bflo(rp.y), bfhi(rp.y)};
            const f32x4 kcv = {bflo(kc.x), bfhi(kc.x), bflo(kc.y), bfhi(kc.y)}, kpv = {bflo(kp.x), bfhi(kp.x), bflo(kp.y), bfhi(kp.y)};
            const f32x4 vcv = {bflo(vc.x), bfhi(vc.x), bflo(vc.y), bfhi(vc.y)}, vpv = {bflo(vp.x), bfhi(vp.x), bflo(vp.y), bfhi(vp.y)};
            const f32x4 r = rcv + (rpv - rcv) * mr, k = kcv + (kpv - kcv) * mk, v = vcv + (vpv - vcv) * mv;
            const f32x4 wv = aw[nf] + *(const f32x4*)(w0 + ch4), av = aa[nf] + *(const f32x4*)(a0 + ch4);
#pragma unroll
            for (int i = 0; i < 4; ++i) { lw4[nf][i] = -__expf(-fast_softplus(-wv[i]) - 0.5f); a4[nf][i] = sigmoidf_(av[i]); kq[nf][i] = k[i] * kkw[i]; km[nf][i] = k[i] * (1.f + (a4[nf][i] - 1.f) * ka[i]);
                ssq += kq[nf][i] * kq[nf][i]; bsp += r[i] * km[nf][i] * rk4[i]; }
            rr[nf] = r; vv4[nf] = v;
            *(LAS f32x4*)(XF + tk * 64 + d4) = lw4[nf];
            u32x2 p; p.x = pk2(ag[nf][0], ag[nf][1]); p.y = pk2(ag[nf][2], ag[nf][3]); *(u32x2*)(G_ + t * 256 + ch4) = p;
            p.x = pk2(v[0], v[1]); p.y = pk2(v[2], v[3]); *(u32x2*)(V_ + t * 256 + ch4) = p;
        }
        ssq += shfl_xor_l(ssq, 16, lane); ssq += shfl_xor_l(ssq, 32, lane); bsp += shfl_xor_l(bsp, 16, lane); bsp += shfl_xor_l(bsp, 32, lane);
        if (fq == 0) { hs[nh * 64 + tk] = ssq; hs[128 + nh * 64 + tk] = bsp; }
        lds_barrier();
        if (w == 0) { float cv[64];
#pragma unroll
            for (int i = 0; i < 64; ++i) cv[i] = XF[i * 64 + lane];
            float run = 0.f;
#pragma unroll
            for (int i = 0; i < 64; ++i) { run += cv[i]; XF[i * 64 + lane] = run; } }
        if (w == 1) BSUM[(t0 + lane) * 4 + hd] = hs[128 + lane] + hs[192 + lane];
        lds_barrier();
        const float rn = rsqrtf(fmaxf(hs[tk] + hs[64 + tk], 1e-24f));
#pragma unroll
        for (int nf = 0; nf < 2; ++nf) { const int d4 = 32 * nh + 8 * fq + 4 * nf;
            const f32x4 cum = *(const LAS f32x4*)(XF + tk * 64 + d4), c63 = *(const LAS f32x4*)(XF + 63 * 64 + d4);
            f32x4 al, bt, kt, rb, bhh, khh;
#pragma unroll
            for (int i = 0; i < 4; ++i) { const float kk = kq[nf][i] * rn; const float ec = __expf(cum[i]), em = __builtin_amdgcn_rcpf(ec), ep = __expf(cum[i] - lw4[nf][i]), p63 = __expf(c63[i]);
                al[i] = -kk * ep; bt[i] = kk * a4[nf][i] * em; kt[i] = km[nf][i] * em; rb[i] = rr[nf][i] * ec; bhh[i] = bt[i] * p63; khh[i] = kt[i] * p63;
                if (tk == 63) *(float*)(REC + (size_t)u * RC_REC + 24576 + (d4 + i) * 4) = p63; }
            u32x2 o;
            o.x = pk2(al[0], al[1]); o.y = pk2(al[2], al[3]); *(LAS u32x2*)(TILE(0) + tk * 144 + d4 * 2) = o;
            o.x = pk2(bt[0], bt[1]); o.y = pk2(bt[2], bt[3]); *(LAS u32x2*)(TILE(1) + tk * 144 + d4 * 2) = o;
            o.x = pk2(kt[0], kt[1]); o.y = pk2(kt[2], kt[3]); *(LAS u32x2*)(TILE(2) + tk * 144 + d4 * 2) = o;
            o.x = pk2(rb[0], rb[1]); o.y = pk2(rb[2], rb[3]); *(LAS u32x2*)(TILE(3) + tk * 144 + d4 * 2) = o;
#pragma unroll
            for (int i = 0; i < 4; ++i) { *(LAS bf16_t*)(TILE(4) + (d4 + i) * 144 + tk * 2) = (bf16_t)f2bf(vv4[nf][i]); *(LAS bf16_t*)(TILE(5) + (d4 + i) * 144 + tk * 2) = (bf16_t)f2bf(bhh[i]);
                *(LAS bf16_t*)(TILE(6) + (d4 + i) * 144 + tk * 2) = (bf16_t)f2bf(khh[i]); *(LAS bf16_t*)(TILE(7) + (d4 + i) * 144 + tk * 2) = (bf16_t)f2bf(al[i]); }
        }
        }
        lds_barrier();
        f32x16 Tacc = zero16();
        {
        int tl = F.tid; asm volatile("" : "+v"(tl)); const int lane = tl & 63, lr = lane & 31, h2 = lane >> 5;
        unsigned zz = 0u; asm volatile("" : "+v"(zz));
        for (int i = tl; i < 768; i += NTHR) { const int q = i >> 7, rr = (i & 127) >> 2, cc = i & 3; const int tile = q < 4 ? 8 + q : q == 4 ? 14 : 12;
            *(LAS u32x4*)(TILE(tile) + (q == 5 ? (32 + rr) * 144 : rr * 144 + 64) + cc * 16) = (u32x4){zz, zz, zz, zz}; }
#pragma unroll
        for (int rnd = 0; rnd < 2; ++rnd) {
            const int j = w + 8 * rnd;
            if (j < 15) {
                const int prod = j / 3, tile = j % 3, si = tile == 2 ? 1 : 0, ti = tile == 0 ? 0 : 1;
                if (prod == 1) {
                    f32x16 acc = tileprod(TILE(0), 32 * ti, TILE(1), 32 * si, zero16(), lr, h2);
                    const int ss = 32 * si + lr;
#pragma unroll
                    for (int q = 0; q < 16; ++q) { const int tt = 32 * ti + 8 * (q >> 2) + 4 * h2 + (q & 3); if (!(ss < tt)) acc[q] = 0.f; }
                    put_tile(TILE(12), 32 * si, 32 * ti, acc, lr, h2);
                } else {
                    const LAS unsigned char* Ao = (prod == 0 || prod == 3) ? TILE(1) : TILE(2); const LAS unsigned char* Bo = prod >= 3 ? TILE(3) : TILE(0);
                    f32x16 acc = tileprod(Ao, 32 * si, Bo, 32 * ti, zero16(), lr, h2);
                    const int tt = 32 * ti + lr, incl = prod >= 3 ? 1 : 0;
#pragma unroll
                    for (int q = 0; q < 16; ++q) { const int ss = 32 * si + 8 * (q >> 2) + 4 * h2 + (q & 3); if (!(ss < tt + incl)) acc[q] = 0.f; }
                    if (prod == 0) { put_tile(TILE(11), 32 * ti, 32 * si, acc, lr, h2);
#pragma unroll
                        for (int q = 0; q < 16; ++q) { const int ss = 32 * si + 8 * (q >> 2) + 4 * h2 + (q & 3); Tacc[q] = acc[q] + (ss == tt ? 1.f : 0.f); }
                        put_tile(TILE(14), 32 * ti, 32 * si, Tacc, lr, h2);
                    } else put_tile(TILE(prod == 2 ? 8 : prod == 3 ? 9 : 10), 32 * ti, 32 * si, acc, lr, h2);
                }
            }
        }
        }
        lds_barrier();
        {
        int tl = F.tid; asm volatile("" : "+v"(tl)); const int lane = tl & 63, lr = lane & 31, h2 = lane >> 5;
        if (tl < 384) { const int q = tl >> 7, rr = (tl & 127) >> 2, cc = tl & 3;
            unsigned zz = 0u; asm volatile("" : "+v"(zz));
            *(LAS u32x4*)(TILE(q) + (q == 1 ? (32 + rr) * 144 : rr * 144 + 64) + cc * 16) = (u32x4){zz, zz, zz, zz}; }
        lds_barrier();
#pragma unroll
        for (int k = 1; k <= 5; ++k) {
            LAS unsigned char* Ss = (k & 1) ? TILE(11) : TILE(0); LAS unsigned char* STs = (k & 1) ? TILE(12) : TILE(1);
            LAS unsigned char* Sd = (k & 1) ? TILE(0) : TILE(11); LAS unsigned char* STd = (k & 1) ? TILE(1) : TILE(12);
            LAS unsigned char* Ts = (k & 1) ? TILE(14) : TILE(2); LAS unsigned char* Td = (k & 1) ? TILE(2) : TILE(14);
            if (w < 6) { const int tile = w % 3, ti = tile == 0 ? 0 : 1, si = tile == 2 ? 1 : 0;
                if (w < 3) { f32x16 acc = tileprod(Ss, 32 * ti, STs, 32 * si, zero16(), lr, h2); put_tile(STd, 32 * si, 32 * ti, acc, lr, h2); }
                else { f32x16 acc = tileprod(STs, 32 * si, Ss, 32 * ti, zero16(), lr, h2); put_tile(Sd, 32 * ti, 32 * si, acc, lr, h2); }
            } else if (k == 1) {
#pragma unroll
                for (int jj = 0; jj < 2; ++jj) { const int tile = (w - 6) * 2 + jj, ti = tile >> 1, ei = tile & 1;
                    f32x16 acc = tileprod(TILE(8), 32 * ti, TILE(4), 32 * ei, zero16(), lr, h2); put_tile(TILE(13), 32 * ei, 32 * ti, acc, lr, h2); }
            }
            lds_barrier();
            if (w < 3) { const int si = w == 2 ? 1 : 0, ti = w == 0 ? 0 : 1;
                Tacc = tileprod(STd, 32 * si, Ts, 32 * ti, Tacc, lr, h2); put_tile(Td, 32 * ti, 32 * si, Tacc, lr, h2); }
        }
        lds_barrier();
        { const int tile = w & 3, ti = tile >> 1, ci = tile & 1;
          f32x16 acc = tileprod(TILE(2), 32 * ti, w < 4 ? TILE(13) : TILE(7), 32 * ci, zero16(), lr, h2); put_tile(w < 4 ? TILE(11) : TILE(12), 32 * ci, 32 * ti, acc, lr, h2); }
        }
        lds_barrier();
        {
        int tl = F.tid; asm volatile("" : "+v"(tl)); const int lane = tl & 63, lr = lane & 31, h2 = lane >> 5; const int tj = w & 3, ta = tj >> 1, tb = tj & 1;
        if (w < 4) {
            { f32x16 acc = tileprod(TILE(12), 32 * ta, TILE(9), 32 * tb, zero16(), lr, h2);
              const int tt = 32 * tb + lr;
#pragma unroll
              for (int g = 0; g < 4; ++g) { const int dd = 32 * ta + 8 * g + 4 * h2; const u32x2 rbv = *(const LAS u32x2*)(TILE(3) + tt * 144 + dd * 2);
                  u32x2 o; o.x = pk2(acc[4 * g] + bflo(rbv.x), acc[4 * g + 1] + bfhi(rbv.x)); o.y = pk2(acc[4 * g + 2] + bflo(rbv.y), acc[4 * g + 3] + bfhi(rbv.y));
                  *(u32x2*)(RP + ((size_t)u * 64 + tt) * 64 + dd) = o; } }
            { f32x16 acc = tileprod(TILE(12), 32 * ta, TILE(5), 32 * tb, zero16(), lr, h2);
              const int dcol = 32 * tb + lr;
#pragma unroll
              for (int g = 0; g < 4; ++g) { u32x2 o; o.x = pk2(acc[4 * g], acc[4 * g + 1]); o.y = pk2(acc[4 * g + 2], acc[4 * g + 3]);
                  *(u32x2*)(REC + (size_t)u * RC_REC + ((((dcol >> 4) * 2 + ta) * 64 + (2 * (g & 1) + h2) * 16 + (dcol & 15)) * 16) + 8 * (g >> 1)) = o; } }
        } else {
            f32x16 z2 = tileprod(TILE(4), 32 * ta, TILE(10), 32 * tb, zero16(), lr, h2);
            z2 = tileprod(TILE(11), 32 * ta, TILE(9), 32 * tb, z2, lr, h2);
            float* yo = Y0T + ((size_t)u * 64 + 32 * tb + lr) * 64 + 32 * ta + 4 * h2;
#pragma unroll
            for (int g = 0; g < 4; ++g) *(f32x4*)(yo + 8 * g) = (f32x4){z2[4 * g], z2[4 * g + 1], z2[4 * g + 2], z2[4 * g + 3]};
            f32x16 acc = tileprod(TILE(5), 32 * ta, TILE(11), 32 * tb, zero16(), lr, h2);
            acc = tileprod(TILE(6), 32 * ta, TILE(4), 32 * tb, acc, lr, h2);
            const int ecol = 32 * tb + lr;
#pragma unroll
            for (int g = 0; g < 4; ++g) *(f32x4*)(REC + (size_t)u * RC_REC + 8192 + ((((ecol >> 4) * 4 + 2 * ta + (g >> 1)) * 64 + (2 * (g & 1) + h2) * 16 + (ecol & 15)) * 16)) = (f32x4){acc[4 * g], acc[4 * g + 1], acc[4 * g + 2], acc[4 * g + 3]};
        }
        }
        lds_barrier();
      }
    }
#undef TILE
}
DI void phase_rwkv_B(const Frame& F, CArgs& A) {
    if (F.bid >= 32) return;
    const unsigned char* REC = A.ws + WS_RC_G; bf16_t* HB = (bf16_t*)(A.ws + WS_RC_HB);
    constexpr int SLOT = 25600, NSLOT = 6;
    const int bh = F.bid, w = F.wave, lane = F.lane, fr = lane & 15, fq = lane >> 4;
    const unsigned char* rec0 = REC + (size_t)bh * 128 * RC_REC;
    if (w >= 4) {
        const int lw = w - 4;
#define RB_ISSUE2(cs, cr) do { const unsigned char* r_ = rec0 + (size_t)(cr) * RC_REC; LAS unsigned char* s_ = F.lds + ((cs) % NSLOT) * SLOT; \
        _Pragma("unroll") for (int k = 0; k < 6; ++k) __builtin_amdgcn_global_load_lds((const unsigned*)(r_ + (lw + 4 * k) * 1024 + lane * 16), (LAS unsigned*)(s_ + (lw + 4 * k) * 1024), 16, 0, 0); \
        if (lw == 3) __builtin_amdgcn_global_load_lds((const unsigned*)(r_ + 24576 + lane * 4), (LAS unsigned*)(s_ + 24576), 4, 0, 0); } while (0)
        RB_ISSUE2(0, 0); RB_ISSUE2(1, 1); RB_ISSUE2(2, 2); RB_ISSUE2(3, 3); RB_ISSUE2(4, 4);
        if (lw == 3) asm volatile("s_waitcnt vmcnt(28)" ::: "memory"); else asm volatile("s_waitcnt vmcnt(24)" ::: "memory");
        __builtin_amdgcn_s_barrier();
        for (int c = 0; c < 128; ++c) {
            RB_ISSUE2(c + 5, (c + 5 < 128) ? c + 5 : 127);
            if (lw == 3) asm volatile("s_waitcnt vmcnt(28)" ::: "memory"); else asm volatile("s_waitcnt vmcnt(24)" ::: "memory");
            __builtin_amdgcn_s_barrier();
        }
        asm volatile("s_waitcnt vmcnt(0)" ::: "memory");
#undef RB_ISSUE2
    } else {
        const int ew = w;
        f32x4 acc[4];
#pragma unroll
        for (int dt = 0; dt < 4; ++dt) acc[dt] = (f32x4){0.f, 0.f, 0.f, 0.f};
        __builtin_amdgcn_s_barrier();
        for (int c = 0; c < 128; ++c) {
            const size_t u = (size_t)bh * 128 + c;
            const LAS unsigned char* sl = F.lds + (c % NSLOT) * SLOT;
            bf16x8 hb[2];
#pragma unroll
            for (int sk = 0; sk < 2; ++sk) { u32x4 p; p.x = pk2(acc[2 * sk][0], acc[2 * sk][1]); p.y = pk2(acc[2 * sk][2], acc[2 * sk][3]); p.z = pk2(acc[2 * sk + 1][0], acc[2 * sk + 1][1]); p.w = pk2(acc[2 * sk + 1][2], acc[2 * sk + 1][3]);
                hb[sk] = __builtin_bit_cast(bf16x8, p); *(bf16x8*)(HB + (((u * 4 + ew) * 2 + sk) * 64 + lane) * 8) = hb[sk]; }
#pragma unroll
            for (int dt = 0; dt < 4; ++dt) {
                const f32x4 g4 = *(const LAS f32x4*)(sl + 8192 + ((ew * 4 + dt) * 64 + lane) * 16), d4 = *(const LAS f32x4*)(sl + 24576 + (16 * dt + 4 * fq) * 4);
                const bf16x8 m0 = *(const LAS bf16x8*)(sl + ((dt * 2 + 0) * 64 + lane) * 16), m1 = *(const LAS bf16x8*)(sl + ((dt * 2 + 1) * 64 + lane) * 16);
                f32x4 n = d4 * acc[dt] + g4;
                n = __builtin_amdgcn_mfma_f32_16x16x32_bf16(m0, hb[0], n, 0, 0, 0); n = __builtin_amdgcn_mfma_f32_16x16x32_bf16(m1, hb[1], n, 0, 0, 0); acc[dt] = n; }
            asm volatile("s_waitcnt lgkmcnt(0)" ::: "memory");
            __builtin_amdgcn_s_barrier();
        }
    }
}
DI void phase_rwkv_C(const Frame& F, CArgs& A, int l) {
    const bf16_t* RP = (const bf16_t*)(A.ws + WS_RC_RP); const float* Y0 = (const float*)(A.ws + WS_RC_Y0); const bf16_t* HB = (const bf16_t*)(A.ws + WS_RC_HB); const float* BSUM = (const float*)(A.ws + WS_RC_BS);
    const bf16_t* V_ = (const bf16_t*)(A.ws + WS_RW_V); const bf16_t* G_ = (const bf16_t*)(A.ws + WS_RW_G); bf16_t* MIX = (bf16_t*)(A.ws + WS_MIX);
    const float* ln_w = A.in[16] + l * 256; const float* ln_b = A.in[17] + l * 256;
    for (int job = F.gw; job < 4096; job += F.ngw) {
        int lz = F.lane; asm volatile("" : "+v"(lz)); const int lane = lz, fr = lane & 15, fq = lane >> 4;
        const size_t u = (size_t)job; const int bh = job >> 7, c = job & 127, b = bh >> 2, hd = bh & 3;
        bf16x8 hf[4][2];
#pragma unroll
        for (int et = 0; et < 4; ++et)
#pragma unroll
            for (int sk = 0; sk < 2; ++sk) hf[et][sk] = *(const bf16x8*)(HB + (((u * 4 + et) * 2 + sk) * 64 + lane) * 8);
#pragma unroll
        for (int tb = 0; tb < 4; ++tb) {
            const size_t tok = (size_t)b * SEQ + 64 * c + 16 * tb + fr;
            const bf16_t* rrow = RP + (u * 64 + 16 * tb + fr) * 64 + 4 * fq;
            bf16x8 bfr[2];
#pragma unroll
            for (int sk = 0; sk < 2; ++sk) { const u32x2 m0 = *(const u32x2*)(rrow + 32 * sk), m1 = *(const u32x2*)(rrow + 32 * sk + 16); u32x4 mw; mw.x = m0.x; mw.y = m0.y; mw.z = m1.x; mw.w = m1.y; bfr[sk] = __builtin_bit_cast(bf16x8, mw); }
            f32x4 y[4]; float sm = 0.f;
#pragma unroll
            for (int et = 0; et < 4; ++et) { y[et] = *(const f32x4*)(Y0 + (u * 64 + 16 * tb + fr) * 64 + 16 * et + 4 * fq);
                y[et] = __builtin_amdgcn_mfma_f32_16x16x32_bf16(hf[et][0], bfr[0], y[et], 0, 0, 0); y[et] = __builtin_amdgcn_mfma_f32_16x16x32_bf16(hf[et][1], bfr[1], y[et], 0, 0, 0); }
#pragma unroll
            for (int et = 0; et < 4; ++et) sm += (y[et][0] + y[et][1]) + (y[et][2] + y[et][3]);
            sm += shfl_xor_l(sm, 16, lane); sm += shfl_xor_l(sm, 32, lane); const float mean = sm * (1.f / 64.f);
            float sq = 0.f;
#pragma unroll
            for (int et = 0; et < 4; ++et) { const f32x4 d = y[et] - mean; sq += (d[0] * d[0] + d[1] * d[1]) + (d[2] * d[2] + d[3] * d[3]); }
            sq += shfl_xor_l(sq, 16, lane); sq += shfl_xor_l(sq, 32, lane); const float rstd = rsqrtf(sq * (1.f / 64.f) + 64e-5f);
            const float bs = BSUM[tok * 4 + hd];
#pragma unroll
            for (int et = 0; et < 4; ++et) { const int e0 = hd * 64 + 16 * et + 4 * fq;
                const f32x4 lw = *(const f32x4*)(ln_w + e0), lb = *(const f32x4*)(ln_b + e0);
                const u32x2 vv = *(const u32x2*)(V_ + tok * 256 + e0), gv = *(const u32x2*)(G_ + tok * 256 + e0);
                const float o0 = ((y[et][0] - mean) * rstd * lw[0] + lb[0] + bs * bflo(vv.x)) * bflo(gv.x), o1 = ((y[et][1] - mean) * rstd * lw[1] + lb[1] + bs * bfhi(vv.x)) * bfhi(gv.x);
                const float o2 = ((y[et][2] - mean) * rstd * lw[2] + lb[2] + bs * bflo(vv.y)) * bflo(gv.y), o3 = ((y[et][3] - mean) * rstd * lw[3] + lb[3] + bs * bfhi(vv.y)) * bfhi(gv.y);
                u32x2 o; o.x = pk2(o0, o1); o.y = pk2(o2, o3);
                *(u32x2*)(MIX + tok * DM + e0) = o; }
        }
    }
}

template <int PASS>
DI void phase_s5(const Frame& F, CArgs& A, int l) {
    const bf16_t* Z = (const bf16_t*)(A.ws + WS_Z); float* SEND = (float*)(A.ws + WS_S5END); bf16_t* YS = (bf16_t*)(A.ws + WS_YS5);
    const bf16_t* BBt = (const bf16_t*)(A.ws + WS_S5BB); const bf16_t* CCt = (const bf16_t*)(A.ws + WS_S5CC);
    LAS unsigned char* himg = F.lds + F.wave * 17408;
    for (int it = F.gw; it < 8 * 16 * 16; it += F.ngw) {
        int lz = F.lane; asm volatile("" : "+v"(lz)); const int lane = lz, lr = lane & 31, hh = lane >> 5;
        const int b = it >> 8, g = (it >> 4) & 15, seg = it & 15, lg = l * 16 + g;
        const float dt = __expf(A.in[25][lg]);
        float are[2], aim[2], cr[2], ci[2];
        bf16x8 bbf[2][2];
#pragma unroll
        for (int st = 0; st < 2; ++st) { const int p = 32 * st + lr;
            const float lre = A.in[18][lg * 64 + p], lim = A.in[19][lg * 64 + p]; const float mag = expf(lre * dt); float sn, cn; sincosf(lim * dt, &sn, &cn); are[st] = mag * cn; aim[st] = mag * sn;
            cr[st] = 0.f; ci[st] = 0.f;
            if (PASS == 2) { const float m512 = expf(512.f * lre * dt); float s5, c5; sincosf(512.f * (lim * dt), &s5, &c5); const float pr = m512 * c5, pi_ = m512 * s5;
                for (int j = 0; j < seg; ++j) { const float* e = SEND + ((size_t)((b * 16 + g) * 16 + j)) * 128; const float er = e[p], ei = e[64 + p];
                    const float nr = pr * cr[st] - pi_ * ci[st] + er, ni = pr * ci[st] + pi_ * cr[st] + ei; cr[st] = nr; ci[st] = ni; } }
#pragma unroll
            for (int part = 0; part < 2; ++part) bbf[part][st] = *(const bf16x8*)(BBt + (((size_t)lg * 2 + part) * 64 + p) * 16 + 8 * hh); }
        bf16x8 ccf[4];
        if (PASS == 2) {
#pragma unroll
            for (int ks = 0; ks < 4; ++ks) ccf[ks] = *(const bf16x8*)(CCt + ((size_t)lg * 16 + (lane & 15)) * 128 + 32 * ks + 8 * (lane >> 4)); }
        for (int ch = 0; ch < 8; ++ch) {
            const size_t tok0 = (size_t)b * SEQ + seg * 512 + ch * 64;
#pragma unroll
            for (int tk = 0; tk < 2; ++tk) {
                const bf16x8 uf = *(const bf16x8*)(Z + (tok0 + 32 * tk + lr) * ZS + ZC_S5 + g * 16 + 8 * hh);
                f32x16 xr[2], xi[2];
#pragma unroll
                for (int st = 0; st < 2; ++st) { xr[st] = mfma32(uf, bbf[0][st], zero16()); xi[st] = mfma32(uf, bbf[1][st], zero16()); }
                asm volatile("s_nop 15\n\ts_nop 15" : "+v"(xr[0]), "+v"(xi[0]), "+v"(xr[1]), "+v"(xi[1]));
#pragma unroll
                for (int j = 0; j < 4; ++j) {
#pragma unroll
                    for (int half = 0; half < 2; ++half) {
                        const bool act = (hh == half);
#pragma unroll
                        for (int st = 0; st < 2; ++st) { float tr = cr[st], ti = ci[st];
#pragma unroll
                            for (int q = 0; q < 4; ++q) { const float nr = are[st] * tr - aim[st] * ti + xr[st][4 * j + q], ni = are[st] * ti + aim[st] * tr + xi[st][4 * j + q];
                                tr = nr; ti = ni; xr[st][4 * j + q] = act ? nr : xr[st][4 * j + q]; xi[st][4 * j + q] = act ? ni : xi[st][4 * j + q]; }
                            const float pr = shfl_xor_l(tr, 32, lane), pi2 = shfl_xor_l(ti, 32, lane);
                            cr[st] = act ? tr : pr; ci[st] = act ? ti : pi2; }
                    }
                }
                if (PASS == 2) {
                    unsigned hb = (unsigned)(uintptr_t)(himg + (4 * hh) * 272 + lr * 2); asm volatile("" : "+v"(hb));
                    LAS unsigned char* hp = (LAS unsigned char*)(uintptr_t)hb;
#pragma unroll
                    for (int st = 0; st < 2; ++st)
#pragma unroll
                        for (int q = 0; q < 16; ++q) { const int trow = 32 * tk + 8 * (q >> 2) + (q & 3);
                            *(LAS bf16_t*)(hp + trow * 272 + 64 * st) = (bf16_t)f2bf(xr[st][q]); *(LAS bf16_t*)(hp + trow * 272 + 128 + 64 * st) = (bf16_t)f2bf(xi[st][q]); }
                }
            }
            if (PASS == 2) {
                asm volatile("s_waitcnt lgkmcnt(0)" ::: "memory");
                const int fr = lane & 15, fq = lane >> 4;
                unsigned rb = (unsigned)(uintptr_t)(himg + fr * 272 + fq * 16); asm volatile("" : "+v"(rb)); const LAS unsigned char* rp = (const LAS unsigned char*)(uintptr_t)rb;
#pragma unroll
                for (int m = 0; m < 4; ++m) { f32x4 acc = {0.f, 0.f, 0.f, 0.f};
#pragma unroll
                    for (int ks = 0; ks < 4; ++ks) acc = __builtin_amdgcn_mfma_f32_16x16x32_bf16(ccf[ks], *(const LAS bf16x8*)(rp + (16 * m) * 272 + 64 * ks), acc, 0, 0, 0);
                    const size_t tok = tok0 + 16 * m + fr;
                    const u32x2 uu = *(const u32x2*)(Z + tok * ZS + ZC_S5 + g * 16 + 4 * fq);
                    const f32x4 dd = *(const f32x4*)(A.in[24] + l * 256 + g * 16 + 4 * fq);
                    u32x2 o; o.x = pk2(gelu_tanh(acc[0] + dd[0] * bflo(uu.x)), gelu_tanh(acc[1] + dd[1] * bfhi(uu.x))); o.y = pk2(gelu_tanh(acc[2] + dd[2] * bflo(uu.y)), gelu_tanh(acc[3] + dd[3] * bfhi(uu.y)));
                    *(u32x2*)(YS + tok * 256 + g * 16 + 4 * fq) = o; }
                asm volatile("s_waitcnt lgkmcnt(0)" ::: "memory");
            }
        }
        if (PASS == 1 && hh == 1) {
#pragma unroll
            for (int st = 0; st < 2; ++st) { float* e = SEND + ((size_t)((b * 16 + g) * 16 + seg)) * 128; e[32 * st + lr] = cr[st]; e[64 + 32 * st + lr] = ci[st]; } }
    }
}

DI void phase_lru_prep(const Frame& F, CArgs& A, int l) {
    const bf16_t* Z = (const bf16_t*)(A.ws + WS_Z); float* LA = (float*)(A.ws + WS_LA); float* LB = (float*)(A.ws + WS_LB);
    const float* cw = A.in[34] + l * 4 * 256; const float* cb = A.in[35] + l * 256; const float* ba = A.in[37] + l * 256; const float* bx = A.in[39] + l * 256; const float* lam = A.in[40] + l * 256;
    const bf16_t* WL = (const bf16_t*)(A.ws + WS_WLRU) + (size_t)l * 2 * 4 * 4096;
    LAS float* xs = (LAS float*)F.lds;
    const int w = F.wave, n = w >> 1, hf = w & 1;
    bf16x8 waf[2][2], wxf[2][2];
    { const int fr = F.lane & 15, fq = F.lane >> 4;
#pragma unroll
      for (int nf = 0; nf < 2; ++nf)
#pragma unroll
          for (int ks = 0; ks < 2; ++ks) { const int j = 32 * hf + 16 * nf + fr;
              waf[nf][ks] = *(const bf16x8*)(WL + ((size_t)(0 * 4 + n) * 64 + j) * 64 + 32 * ks + 8 * fq); wxf[nf][ks] = *(const bf16x8*)(WL + ((size_t)(1 * 4 + n) * 64 + j) * 64 + 32 * ks + 8 * fq); } }
    f32x4 c_ba[2], c_bx[2], c_sp[2];
    { const int fq0 = F.lane >> 4;
#pragma unroll
      for (int nf = 0; nf < 2; ++nf) { const int ch4 = n * 64 + 32 * hf + 16 * nf + 4 * fq0; c_ba[nf] = *(const f32x4*)(ba + ch4); c_bx[nf] = *(const f32x4*)(bx + ch4); const f32x4 lm = *(const f32x4*)(lam + ch4);
#pragma unroll
          for (int i = 0; i < 4; ++i) c_sp[nf][i] = -8.f * softplusf_(-lm[i]); } }
    for (int tile = F.bid; tile < T / 64; tile += F.G) {
        int tz = F.tid; asm volatile("" : "+v"(tz)); const int lane = tz & 63, fr = lane & 15, fq = lane >> 4;
        const int t0 = tile * 64, s0 = t0 % SEQ;
        f32x4 accA[4][2], accX[4][2];
#pragma unroll
        for (int m = 0; m < 4; ++m) {
            const int tok = 16 * m + fr, sq = s0 + tok;
            bf16x8 xf[2];
#pragma unroll
            for (int ks = 0; ks < 2; ++ks) { const int ch0 = n * 64 + 32 * ks + 8 * fq;
                const f32x4 b0 = *(const f32x4*)(cb + ch0), b1 = *(const f32x4*)(cb + ch0 + 4);
                float xc[8] = {b0[0], b0[1], b0[2], b0[3], b1[0], b1[1], b1[2], b1[3]};
#pragma unroll
                for (int j = 0; j < 4; ++j) if (sq - 3 + j >= 0) {
                    const u32x4 z8 = *(const u32x4*)(Z + (size_t)(t0 + tok - 3 + j) * ZS + ZC_LX + ch0);
                    const f32x4 c0 = *(const f32x4*)(cw + j * 256 + ch0), c1 = *(const f32x4*)(cw + j * 256 + ch0 + 4);
                    xc[0] += c0[0] * bflo(z8.x); xc[1] += c0[1] * bfhi(z8.x); xc[2] += c0[2] * bflo(z8.y); xc[3] += c0[3] * bfhi(z8.y);
                    xc[4] += c1[0] * bflo(z8.z); xc[5] += c1[1] * bfhi(z8.z); xc[6] += c1[2] * bflo(z8.w); xc[7] += c1[3] * bfhi(z8.w); }
                u32x4 o; o.x = pk2(xc[0], xc[1]); o.y = pk2(xc[2], xc[3]); o.z = pk2(xc[4], xc[5]); o.w = pk2(xc[6], xc[7]); xf[ks] = __builtin_bit_cast(bf16x8, o);
                if (hf == 0) { *(LAS f32x4*)(xs + tok * 260 + ch0) = (f32x4){xc[0], xc[1], xc[2], xc[3]}; *(LAS f32x4*)(xs + tok * 260 + ch0 + 4) = (f32x4){xc[4], xc[5], xc[6], xc[7]}; }
            }
#pragma unroll
            for (int nf = 0; nf < 2; ++nf) { const f32x4 z4 = {0.f, 0.f, 0.f, 0.f};
                accA[m][nf] = __builtin_amdgcn_mfma_f32_16x16x32_bf16(waf[nf][0], xf[0], z4, 0, 0, 0); accA[m][nf] = __builtin_amdgcn_mfma_f32_16x16x32_bf16(waf[nf][1], xf[1], accA[m][nf], 0, 0, 0);
                accX[m][nf] = __builtin_amdgcn_mfma_f32_16x16x32_bf16(wxf[nf][0], xf[0], z4, 0, 0, 0); accX[m][nf] = __builtin_amdgcn_mfma_f32_16x16x32_bf16(wxf[nf][1], xf[1], accX[m][nf], 0, 0, 0); }
        }
        lds_barrier();
#pragma unroll
        for (int m = 0; m < 4; ++m)
#pragma unroll
            for (int nf = 0; nf < 2; ++nf) { const int tok = 16 * m + fr, ch4 = n * 64 + 32 * hf + 16 * nf + 4 * fq;
                const f32x4 xc = *(const LAS f32x4*)(xs + tok * 260 + ch4);
                f32x4 av, bv;
#pragma unroll
                for (int i = 0; i < 4; ++i) { const float r = sigmoidf_(accA[m][nf][i] + c_ba[nf][i]), ig = sigmoidf_(accX[m][nf][i] + c_bx[nf][i]); const float log_a = r * c_sp[nf][i];
                    const float x2 = 2.f * log_a; float em1 = __expf(x2) - 1.f; if (x2 > -0.25f) em1 = x2 * (1.f + x2 * (0.5f + x2 * (0.16666667f + x2 * (0.041666668f + x2 * 0.008333334f))));
                    av[i] = __expf(log_a); bv[i] = __builtin_amdgcn_sqrtf(-em1) * (ig * xc[i]); }
                *(f32x4*)(LA + (size_t)(t0 + tok) * 256 + ch4) = av; *(f32x4*)(LB + (size_t)(t0 + tok) * 256 + ch4) = bv; }
        lds_barrier();
    }
}
DI void phase_lru_sum(const Frame& F, CArgs& A) {
    const float* LA = (const float*)(A.ws + WS_LA); const float* LB = (const float*)(A.ws + WS_LB); float* LS = (float*)(A.ws + WS_LSUM);
    for (int it = F.gw; it < 8 * 128; it += F.ngw) {
        const size_t r0 = (size_t)it * 64;
        f32x4 Ap = {1.f, 1.f, 1.f, 1.f}, Bp = {0.f, 0.f, 0.f, 0.f};
#pragma unroll 8
        for (int t = 0; t < 64; ++t) { const f32x4 a = *(const f32x4*)(LA + (r0 + t) * 256 + 4 * F.lane), bb = *(const f32x4*)(LB + (r0 + t) * 256 + 4 * F.lane); Bp = a * Bp + bb; Ap = Ap * a; }
        *(f32x4*)(LS + ((size_t)it * 2) * 256 + 4 * F.lane) = Ap; *(f32x4*)(LS + ((size_t)it * 2 + 1) * 256 + 4 * F.lane) = Bp;
    }
}
DI void phase_lru_fin(const Frame& F, CArgs& A, int l) {
    const float* LA = (const float*)(A.ws + WS_LA); const float* LB = (const float*)(A.ws + WS_LB); const float* LS = (const float*)(A.ws + WS_LSUM);
    const bf16_t* Z = (const bf16_t*)(A.ws + WS_Z); bf16_t* MIX = (bf16_t*)(A.ws + WS_MIX);
    const f32x4 bg = *(const f32x4*)(A.in[41] + l * 768 + 512 + 4 * F.lane);
    for (int it = F.gw; it < 8 * 128; it += F.ngw) {
        const int b = it >> 7, c = it & 127;
        f32x4 h = {0.f, 0.f, 0.f, 0.f};
        for (int j0 = 0; j0 < c; j0 += 8) {
            f32x4 sa[8], sb[8];
#pragma unroll
            for (int q = 0; q < 8; ++q) { const int j = (j0 + q < c) ? j0 + q : c - 1; sa[q] = *(const f32x4*)(LS + ((size_t)(b * 128 + j) * 2) * 256 + 4 * F.lane); sb[q] = *(const f32x4*)(LS + ((size_t)(b * 128 + j) * 2 + 1) * 256 + 4 * F.lane); }
#pragma unroll
            for (int q = 0; q < 8; ++q) if (j0 + q < c) h = sa[q] * h + sb[q]; }
        const size_t r0 = (size_t)it * 64;
        for (int t0 = 0; t0 < 64; t0 += 8) {
            f32x4 y[8]; float ss[8];
#pragma unroll
            for (int q = 0; q < 8; ++q) { const size_t r = r0 + t0 + q;
                const f32x4 a = *(const f32x4*)(LA + r * 256 + 4 * F.lane), bb = *(const f32x4*)(LB + r * 256 + 4 * F.lane); h = a * h + bb;
                const u32x2 gz = *(const u32x2*)(Z + r * ZS + ZC_LG + 4 * F.lane);
                y[q] = (f32x4){h[0] * gelu_tanh(bflo(gz.x)), h[1] * gelu_tanh(bfhi(gz.x)), h[2] * gelu_tanh(bflo(gz.y)), h[3] * gelu_tanh(bfhi(gz.y))};
                ss[q] = y[q][0] * y[q][0] + y[q][1] * y[q][1] + y[q][2] * y[q][2] + y[q][3] * y[q][3]; }
            const int ln = lane_opaque();
#pragma unroll
            for (int o = 1; o < 64; o <<= 1) {
#pragma unroll
                for (int q = 0; q < 8; ++q) ss[q] += shfl_xor_l(ss[q], o, ln); }
#pragma unroll
            for (int q = 0; q < 8; ++q) { const float r = rsqrtf(ss[q] * (1.f / 256.f) + NORM_EPS);
                u32x2 o; o.x = pk2(y[q][0] * r * bg[0], y[q][1] * r * bg[1]); o.y = pk2(y[q][2] * r * bg[2], y[q][3] * r * bg[3]);
                *(u32x2*)(MIX + (r0 + t0 + q) * DM + 768 + 4 * F.lane) = o; }
        }
    }
}

DI void phase_branch_norm(const Frame& F, CArgs& A, int l) {
    const bf16_t* S0 = (const bf16_t*)(A.ws + WS_YS5G); const bf16_t* S1 = (const bf16_t*)(A.ws + WS_ATTO);
    bf16_t* MIX = (bf16_t*)(A.ws + WS_MIX); const float* bg = A.in[41] + l * 768;
    for (int row0 = 4 * F.gw; row0 < T; row0 += 4 * F.ngw) {
        u32x2 v[4][2];
#pragma unroll
        for (int r = 0; r < 4; ++r) { v[r][0] = *(const u32x2*)(S0 + (size_t)(row0 + r) * 256 + 4 * F.lane); v[r][1] = *(const u32x2*)(S1 + (size_t)(row0 + r) * 256 + 4 * F.lane); }
#pragma unroll
        for (int r = 0; r < 4; ++r)
#pragma unroll
            for (int br = 0; br < 2; ++br) {
                const float x0 = bflo(v[r][br].x), x1 = bfhi(v[r][br].x), x2 = bflo(v[r][br].y), x3 = bfhi(v[r][br].y);
                const float rs = rsqrtf(wave_sum(x0 * x0 + x1 * x1 + x2 * x2 + x3 * x3) * (1.f / 256.f) + NORM_EPS);
                const f32x4 g = *(const f32x4*)(bg + br * 256 + 4 * F.lane);
                u32x2 o; o.x = pk2(x0 * rs * g[0], x1 * rs * g[1]); o.y = pk2(x2 * rs * g[2], x3 * rs * g[3]);
                *(u32x2*)(MIX + (size_t)(row0 + r) * DM + 256 * (br + 1) + 4 * F.lane) = o; }
    }
}

DI void phase_norm2_router(const Frame& F, CArgs& A, int l) {
    const float* MODL = (const float*)(A.ws + WS_MOD) + (size_t)l * 8 * 6144;
    const float* g = A.in[43] + l * 1024;
    signed char* H8 = (signed char*)(A.ws + WS_H); float* H2S = (float*)(A.ws + WS_H2SC);
    int* EID = (int*)(A.ws + WS_RT_EID); float* GATE = (float*)(A.ws + WS_RT_GATE); int* PIE = (int*)(A.ws + WS_RT_PIE);
    unsigned* CNT = (unsigned*)(A.ws + WS_CTL) + CW_CNT + l * 64;
    const bf16_t* WRh = (const bf16_t*)(A.ws + WS_WR) + (size_t)(l * 2) * 48 * 1024; const bf16_t* WRl = WRh + 48 * 1024;
    const float* ROWSS = (const float*)(A.ws + WS_ROWSS);
    LAS float* part = (LAS float*)F.lds;
    LAS float* red = part + 8 * 64 * 48;
    LAS float* lsum = red + 8 * 64;
    LAS unsigned* lcnt = (LAS unsigned*)(lsum + 64 * 36);
    LAS int* lsel = (LAS int*)(lcnt + 64);
    const float* bgp = A.in[45] + l * 4; const float* bep = A.in[47] + l * 32;
    const int w = F.wave, k0 = 128 * w;
    for (int tile = F.bid; tile < T / 64; tile += F.G) {
        int tz = F.tid; asm volatile("" : "+v"(tz)); const int lane = tz & 63, fr = lane & 15, fq = lane >> 4;
        const int row0 = tile * 64, b = row0 / SEQ;
        const unsigned xi = (unsigned)(row0 + fr) * DM + k0 + 8 * fq;
        const float* xb = A.out;
        if (tz < 32) lcnt[tz] = 0u;
        { float m2 = fmaxf(fabsf(MODL[(unsigned)(b * 6144 + 3072 + tz)]), fabsf(MODL[(unsigned)(b * 6144 + 3072 + 512 + tz)])); m2 = wave_max(m2); if (lane == 0) red[w] = m2; }
        lds_barrier();
        float shmax = 0.f;
#pragma unroll
        for (int ww = 0; ww < 8; ++ww) shmax = fmaxf(shmax, red[ww]);
        f32x4 acc[4][3]; float rsv[4], inv8[4];
#pragma unroll
        for (int m = 0; m < 4; ++m) { const float* rp = ROWSS + (unsigned)((row0 + 16 * m + fr) * 32);
            const f32x4 p0 = *(const f32x4*)rp, p1 = *(const f32x4*)(rp + 4), p2 = *(const f32x4*)(rp + 8), p3 = *(const f32x4*)(rp + 12);
            const f32x4 q0 = *(const f32x4*)(rp + 16), q1 = *(const f32x4*)(rp + 20), q2 = *(const f32x4*)(rp + 24), q3 = *(const f32x4*)(rp + 28);
            const float tot = (((p0[0] + p0[1]) + (p0[2] + p0[3])) + ((p1[0] + p1[1]) + (p1[2] + p1[3]))) + (((p2[0] + p2[1]) + (p2[2] + p2[3])) + ((p3[0] + p3[1]) + (p3[2] + p3[3])));
            const float mg = fmaxf(fmaxf(fmaxf(fmaxf(q0[0], q0[1]), fmaxf(q0[2], q0[3])), fmaxf(fmaxf(q1[0], q1[1]), fmaxf(q1[2], q1[3]))), fmaxf(fmaxf(fmaxf(q2[0], q2[1]), fmaxf(q2[2], q2[3])), fmaxf(fmaxf(q3[0], q3[1]), fmaxf(q3[2], q3[3]))));
            rsv[m] = rsqrtf(tot * (1.f / DM) + NORM_EPS);
            const float bound = fmaxf(rsv[m] * mg + shmax, 1e-30f) * 1.0001f;
            inv8[m] = 127.f / bound; if (w == 0 && fq == 0) H2S[(unsigned)(row0 + 16 * m + fr)] = bound * (1.f / 127.f);
#pragma unroll
            for (int n = 0; n < 3; ++n) acc[m][n] = (f32x4){0.f, 0.f, 0.f, 0.f}; }
#pragma unroll
        for (int ks = 0; ks < 4; ++ks) { const int kc = k0 + 32 * ks + 8 * fq;
            const f32x4 g0 = *(const f32x4*)(g + kc), g1 = *(const f32x4*)(g + kc + 4);
            const f32x4 s0 = *(const f32x4*)(MODL + (unsigned)(b * 6144 + 4096 + kc)) + 1.f, s1 = *(const f32x4*)(MODL + (unsigned)(b * 6144 + 4096 + kc + 4)) + 1.f;
            const f32x4 h0 = *(const f32x4*)(MODL + (unsigned)(b * 6144 + 3072 + kc)), h1 = *(const f32x4*)(MODL + (unsigned)(b * 6144 + 3072 + kc + 4));
            bf16x8 blf[3], bhf[3];
#pragma unroll
            for (int n = 0; n < 3; ++n) { blf[n] = *(const bf16x8*)(WRl + (unsigned)((16 * n + fr) * 1024 + kc)); bhf[n] = *(const bf16x8*)(WRh + (unsigned)((16 * n + fr) * 1024 + kc)); }
#pragma unroll
            for (int m = 0; m < 4; ++m) {
                const f32x4 x0 = *(const f32x4*)(xb + (xi + (unsigned)(16 * m * DM + 32 * ks))), x1 = *(const f32x4*)(xb + (xi + (unsigned)(16 * m * DM + 32 * ks + 4)));
                const f32x4 v0 = x0 * rsv[m] * g0 * s0 + h0, v1 = x1 * rsv[m] * g1 * s1 + h1;
                u32x2 o; o.x = q8x4(v0, inv8[m]); o.y = q8x4(v1, inv8[m]); *(u32x2*)(H8 + (unsigned)((row0 + 16 * m + fr) * DM + kc)) = o;
                u32x4 hi; hi.x = pk2(v0[0], v0[1]); hi.y = pk2(v0[2], v0[3]); hi.z = pk2(v1[0], v1[1]); hi.w = pk2(v1[2], v1[3]);
                u32x4 lo; lo.x = pk2(v0[0] - bflo(hi.x), v0[1] - bfhi(hi.x)); lo.y = pk2(v0[2] - bflo(hi.y), v0[3] - bfhi(hi.y)); lo.z = pk2(v1[0] - bflo(hi.z), v1[1] - bfhi(hi.z)); lo.w = pk2(v1[2] - bflo(hi.w), v1[3] - bfhi(hi.w));
                const bf16x8 ah = __builtin_bit_cast(bf16x8, hi), al = __builtin_bit_cast(bf16x8, lo);
#pragma unroll
                for (int n = 0; n < 3; ++n) { acc[m][n] = __builtin_amdgcn_mfma_f32_16x16x32_bf16(ah, bhf[n], acc[m][n], 0, 0, 0);
                    acc[m][n] = __builtin_amdgcn_mfma_f32_16x16x32_bf16(al, bhf[n], acc[m][n], 0, 0, 0); acc[m][n] = __builtin_amdgcn_mfma_f32_16x16x32_bf16(ah, blf[n], acc[m][n], 0, 0, 0); }
            }
            __builtin_amdgcn_sched_barrier(0);
        }
#pragma unroll
        for (int m = 0; m < 4; ++m)
#pragma unroll
            for (int n = 0; n < 3; ++n)
#pragma unroll
                for (int j = 0; j < 4; ++j) part[(w * 64 + 16 * m + 4 * fq + j) * 48 + 16 * n + fr] = acc[m][n][j];
        lds_barrier();
        for (int i = tz; i < 64 * 36; i += NTHR) { const int tok = i / 36, n = i % 36; float a = 0.f;
#pragma unroll
            for (int ww = 0; ww < 8; ++ww) a += part[(ww * 64 + tok) * 48 + n];
            lsum[i] = a; }
        lds_barrier();
        float g0 = 0.f, g1 = 0.f; int e0 = 0, e1 = 0; unsigned r0 = 0, r1 = 0;
        if (tz < 64) {
            const LAS float* L = lsum + tz * 36;
            int gs = 0; float gm = L[0] + bgp[0];
#pragma unroll
            for (int i = 1; i < 4; ++i) { const float v = L[i] + bgp[i]; if (v > gm) { gm = v; gs = i; } }
            float gden = 0.f;
#pragma unroll
            for (int i = 0; i < 4; ++i) gden += expf(L[i] + bgp[i] - gm);
            const float gprob = 1.f / gden;
            int i1 = 0; float v1 = L[4 + gs * 8] + bep[gs * 8];
#pragma unroll
            for (int j = 1; j < 8; ++j) { const float v = L[4 + gs * 8 + j] + bep[gs * 8 + j]; if (v > v1) { v1 = v; i1 = j; } }
            int i2 = -1; float v2 = -INFINITY;
#pragma unroll
            for (int j = 0; j < 8; ++j) { const float v = L[4 + gs * 8 + j] + bep[gs * 8 + j]; if (j != i1 && v > v2) { v2 = v; i2 = j; } }
            const float p2 = expf(v2 - v1);
            g0 = gprob / (1.f + p2); g1 = gprob * p2 / (1.f + p2); e0 = gs * 8 + i1; e1 = gs * 8 + i2;
            r0 = __hip_atomic_fetch_add(lcnt + e0, 1u, __ATOMIC_RELAXED, __HIP_MEMORY_SCOPE_WORKGROUP); r1 = __hip_atomic_fetch_add(lcnt + e1, 1u, __ATOMIC_RELAXED, __HIP_MEMORY_SCOPE_WORKGROUP);
        }
        lds_barrier();
        if (tz < 32) { const unsigned c = lcnt[tz]; lcnt[32 + tz] = c ? atomicAdd(CNT + tz, c) : 0u; }
        lds_barrier();
        if (tz < 64) { const int row = row0 + tz;
            EID[2 * row] = e0; EID[2 * row + 1] = e1; GATE[2 * row] = g0; GATE[2 * row + 1] = g1; PIE[2 * row] = (int)(lcnt[32 + e0] + r0); PIE[2 * row + 1] = (int)(lcnt[32 + e1] + r1); }
        lds_barrier();
    }
}

DI void phase_moe_convert(const Frame& F, CArgs& A, int l, int gw0, int ngw0) {
    LAS float* scr = (LAS float*)(F.lds + F.wave * 16640);
    bf16_t* WM2 = (bf16_t*)(A.ws + WS_WM2);
    for (int it = gw0; it < 32 * 384; it += ngw0) {
        const int e = it / 384; int r = it % 384;
        if (r < 256) { const int which = r >> 7; r &= 127; const int kb = r >> 3, nb = r & 7, n0 = 64 * nb;
            const float* src = (which ? A.in[49] : A.in[48]) + ((size_t)l * 32 + e) * 1024 * 512;
            const int np0 = 256 * (n0 >> 7) + (n0 & 127) + 128 * which;
            quant_item64(src, 512, 64 * kb, n0, (signed char*)(A.ws + WS_WM1) + (size_t)e * 1024 * 1024, 1024, np0, 64 * kb, (const unsigned*)(A.ws + WS_CTL) + CW_COLMAX + ((size_t)l * 32 + e) * 1024 + np0,
                         kb == 0 ? (float*)(A.ws + WS_WM1SC) + (size_t)e * 1024 + np0 : (float*)nullptr, scr, F.lane);
        } else { r -= 256; const int kb = r >> 4, nb = r & 15;
            transpose_item64(A.in[50] + ((size_t)l * 32 + e) * 512 * 1024, 1024, 64 * kb, 64 * nb, WM2 + (size_t)e * 1024 * 512, 512, 64 * nb, 64 * kb, scr, F.lane); }
    }
}

DI void phase_moe_scatter(const Frame& F, CArgs& A, int l) {
    const unsigned* CNT = (const unsigned*)(A.ws + WS_CTL) + CW_CNT + l * 64;
    unsigned* META = (unsigned*)(A.ws + WS_CTL) + CW_UTAB + l * 1024;
    const int* EID = (const int*)(A.ws + WS_RT_EID); const int* PIE = (const int*)(A.ws + WS_RT_PIE); int* SORT = (int*)(A.ws + WS_RT_SORT);
    LAS unsigned* st = (LAS unsigned*)F.lds;
    if (F.tid == 0) { unsigned s = 0; for (int e = 0; e < 32; ++e) { st[e] = s; s += CNT[e]; } }
    __syncthreads();
    if (F.bid == 0 && F.tid == 0) { unsigned nu = 0;
        for (int e = 0; e < 32; ++e) { const unsigned c = CNT[e]; META[1 + e] = st[e]; META[33 + e] = c; for (unsigned bk = 0; bk * 256 < c; ++bk) META[65 + nu++] = ((unsigned)e << 16) | bk; }
        META[0] = nu; }
    for (int a = F.bid * NTHR + F.tid; a < 2 * T; a += F.G * NTHR) SORT[st[EID[a]] + PIE[a]] = a;
}

struct MoeProb1 {
    const char* Hh; const char* WM1; const unsigned* META; const int* SORT; int lda, ldb, nt, G, c;
    DI bool next(int i, pg8::Unit& u) const { const int idx = i * G + c; const int nu = (int)META[0]; if (idx >= nu * 4) return false;
        const unsigned ent = META[65 + (idx >> 2)]; u.pm = idx >> 2; u.pn = idx & 3; u.e = (int)(ent >> 16); u.blk = (int)(ent & 0xffffu); return true; }
    DI const char* a_base(const pg8::Unit&) const { return Hh; }
    DI const char* b_base(const pg8::Unit& u) const { return WM1 + ((size_t)u.e * 1024 + (size_t)u.pn * 256) * 1024; }
    DI unsigned a_off(const pg8::Unit& u, int row) const { const unsigned r = (unsigned)(u.blk * 256 + row), cnt = META[33 + u.e];
        const int a = r < cnt ? SORT[META[1 + u.e] + r] : 0; return (unsigned)(a >> 1) * 1024u; }
};
struct EpiMoe1 {
    static constexpr bool PERM = true;
    bf16_t* HID; const unsigned* META; const int* SORT; const float* H2S; const float* WSC;
    DI void operator()(const i32x4 (&acc)[2][2][4][2], const pg8::Unit& u, int wr, int wc, int fr, int fq) const {
        const unsigned cnt = META[33 + u.e], st = META[1 + u.e];
        const int col0 = 128 * u.pn + wc * 32 + 8 * fq;
        const float* wsp = WSC + (size_t)u.e * 1024 + 256 * u.pn + wc * 32 + 8 * fq;
        const f32x4 s10 = *(const f32x4*)wsp, s11 = *(const f32x4*)(wsp + 4), s30 = *(const f32x4*)(wsp + 128), s31 = *(const f32x4*)(wsp + 132);
#pragma unroll
        for (int ai = 0; ai < 2; ++ai)
#pragma unroll
            for (int m = 0; m < 4; ++m) { const unsigned r = (unsigned)(u.blk * 256 + ai * 128 + wr * 64 + m * 16 + fr);
                if (r < cnt) { const float sa = H2S[SORT[st + r] >> 1];
                    const i32x4 a0 = acc[ai][0][m][0], a1 = acc[ai][0][m][1], b0 = acc[ai][1][m][0], b1 = acc[ai][1][m][1];
                    float h[8];
#pragma unroll
                    for (int i = 0; i < 4; ++i) { h[i] = siluf_((float)a0[i] * sa * s10[i]) * ((float)b0[i] * sa * s30[i]); h[4 + i] = siluf_((float)a1[i] * sa * s11[i]) * ((float)b1[i] * sa * s31[i]); }
                    u32x4 w; w.x = pk2(h[0], h[1]); w.y = pk2(h[2], h[3]); w.z = pk2(h[4], h[5]); w.w = pk2(h[6], h[7]);
                    *(u32x4*)(HID + (size_t)(st + r) * 512 + col0) = w; } }
    }
};
struct MoeProb2 {
    const char* HID; const char* WM2; const unsigned* META; int lda, ldb, nt, G, c;
    DI bool next(int i, pg8::Unit& u) const { const int idx = i * G + c; const int nu = (int)META[0]; if (idx >= nu * 4) return false;
        const unsigned ent = META[65 + (idx >> 2)]; u.pm = idx >> 2; u.pn = idx & 3; u.e = (int)(ent >> 16); u.blk = (int)(ent & 0xffffu); return true; }
    DI const char* a_base(const pg8::Unit& u) const { return HID + ((size_t)META[1 + u.e] + (size_t)u.blk * 256) * 512 * 2; }
    DI const char* b_base(const pg8::Unit& u) const { return WM2 + ((size_t)u.e * 1024 + (size_t)u.pn * 256) * 512 * 2; }
    DI unsigned a_off(const pg8::Unit&, int row) const { return (unsigned)row * 1024u; }
};
struct EpiMoe2 {
    static constexpr bool PERM = true;
    bf16_t* Y; const unsigned* META; const int* SORT; const float* GATE; const float* gt;
    DI void operator()(const f32x4 (&acc)[2][2][4][2], const pg8::Unit& u, int wr, int wc, int fr, int fq) const {
        const unsigned cnt = META[33 + u.e], st = META[1 + u.e];
        const int col0 = 256 * u.pn + wc * 32 + 8 * fq;
        int av[2][4]; float gw[2][4];
#pragma unroll
        for (int ai = 0; ai < 2; ++ai)
#pragma unroll
            for (int m = 0; m < 4; ++m) { const unsigned r = (unsigned)(u.blk * 256 + ai * 128 + wr * 64 + m * 16 + fr); av[ai][m] = r < cnt ? SORT[st + r] : -1; }
#pragma unroll
        for (int ai = 0; ai < 2; ++ai)
#pragma unroll
            for (int m = 0; m < 4; ++m) gw[ai][m] = av[ai][m] >= 0 ? GATE[av[ai][m]] : 0.f;
#pragma unroll
        for (int ai = 0; ai < 2; ++ai)
#pragma unroll
            for (int m = 0; m < 4; ++m) { const int a = av[ai][m];
                if (a >= 0) { const int b = (a >> 1) / SEQ; const float g = gw[ai][m];
#pragma unroll
                    for (int bj = 0; bj < 2; ++bj) { const f32x4 g0 = *(const f32x4*)(gt + (size_t)b * 6144 + col0 + bj * 128), g1 = *(const f32x4*)(gt + (size_t)b * 6144 + col0 + bj * 128 + 4);
                        const f32x4 v0 = acc[ai][bj][m][0] * g0 * g, v1 = acc[ai][bj][m][1] * g1 * g;
                        u32x4 w; w.x = pk2(v0[0], v0[1]); w.y = pk2(v0[2], v0[3]); w.z = pk2(v1[0], v1[1]); w.w = pk2(v1[2], v1[3]);
                        *(u32x4*)(Y + (size_t)a * DM + col0 + bj * 128) = w; } } }
    }
};

DI void phase_final(const Frame& F, CArgs& A) {
    const bf16_t* Y = (const bf16_t*)(A.ws + WS_Y);
    const size_t N4 = (size_t)T * DM / 4, stride = (size_t)F.G * NTHR;
    for (size_t i0 = (size_t)F.bid * NTHR + F.tid; i0 < N4; i0 += 4 * stride) {
        f32x4 v[4]; u32x2 y0[4], y1[4];
#pragma unroll
        for (int k = 0; k < 4; ++k) { const size_t i = i0 + k * stride; if (i < N4) { const size_t row = i >> 8, col = (i & 255) * 4;
            v[k] = *(const f32x4*)(A.out + row * DM + col); y0[k] = *(const u32x2*)(Y + (2 * row) * DM + col); y1[k] = *(const u32x2*)(Y + (2 * row + 1) * DM + col); } }
#pragma unroll
        for (int k = 0; k < 4; ++k) { const size_t i = i0 + k * stride; if (i < N4) { const size_t row = i >> 8, col = (i & 255) * 4;
            v[k][0] += bflo(y0[k].x) + bflo(y1[k].x); v[k][1] += bfhi(y0[k].x) + bfhi(y1[k].x); v[k][2] += bflo(y0[k].y) + bflo(y1[k].y); v[k][3] += bfhi(y0[k].y) + bfhi(y1[k].y);
            *(f32x4*)(A.out + row * DM + col) = v[k]; } }
    }
}

#ifndef REPMASK
#define REPMASK 0u
#endif
constexpr int NPL = 14, NPH = 1 + 2 * NPL + 1;
__global__ void __launch_bounds__(NTHR, 2) mk_fwd(Args args) {
    extern __shared__ __attribute__((aligned(16))) unsigned char lds_raw[];
    LAS unsigned char* const ldsb = (LAS unsigned char*)lds_raw;
    const int wave0 = __builtin_amdgcn_readfirstlane(threadIdx.x >> 6);
    volatile LAS unsigned* MISC = (volatile LAS unsigned*)(ldsb + MISC_OFF);
    if (threadIdx.x < 64) MISC[threadIdx.x] = 0u;
    __syncthreads();
    XcdBarrier bar; bar.bar = (unsigned*)(args.ws + WS_CTL) + CW_BAR; bar.x = 0; bar.st = nullptr;
    if (args.use_bar) bar = xcd_barrier_post((unsigned*)(args.ws + WS_CTL) + CW_BAR, MISC + 8);
    const int lo = args.ph_lo, hi = args.ph_hi;
#define IN(k) (lo <= (k) && (k) < hi)
#define SEAM(k) do { if (IN(k) && IN((k) + 1)) xcd_barrier(bar); } while (0)
    unsigned char* ws = args.ws;
    if (IN(0)) { const Frame F = make_frame(ldsb, wave0); CArgs& AA = *get_args(); phase_prologue(F, AA); } SEAM(0);
    for (int l = 0; l < DEPTH; ++l) {
        const int pb = 1 + l * NPL;
        const float* MODL = (const float*)(ws + WS_MOD) + (size_t)l * 8 * 6144;
        if (IN(pb + 0)) { { const Frame F = make_frame(ldsb, wave0); CArgs& AA = *get_args(); phase_norm1(F, AA, l); } if (l == 0) { const Frame F = make_frame(ldsb, wave0); CArgs& AA = *get_args(); phase_win_quant(F, AA); } } SEAM(pb + 0);
        if (IN(pb + 1)) { const Frame F = make_frame(ldsb, wave0); CArgs& AA = *get_args(); pg8::PlainProb P{(const char*)(ws + WS_H), (const char*)(ws + WS_WIN) + (size_t)l * ZS * 1024, 512, 512, 8, 256, 9, F.G, F.bid};
            EpiBf16I8 E{(bf16_t*)(ws + WS_Z), ZS, (const float*)(ws + WS_HSC), (const float*)(ws + WS_WINSC) + l * ZS}; pg8::gemm_phase<true, true>(F.lds, P, E, F.tid); } SEAM(pb + 1);
        if (IN(pb + 2)) { { const Frame F = make_frame(ldsb, wave0); CArgs& AA = *get_args(); phase_mla_prep(F, AA, l); } { const Frame F = make_frame(ldsb, wave0); CArgs& AA = *get_args(); phase_s5<1>(F, AA, l); } { const Frame F = make_frame(ldsb, wave0); CArgs& AA = *get_args(); phase_lru_prep(F, AA, l); } } SEAM(pb + 2);
        if (IN(pb + 3)) { { const Frame F = make_frame(ldsb, wave0); CArgs& AA = *get_args(); pg8::PlainProb P{(const char*)(ws + WS_AMLA), (const char*)(ws + WS_WMLA) + (size_t)l * 1024 * 512 * 2, 512, 512, 8, 256, 4, F.G, F.bid};
            EpiBf16Plain E{(bf16_t*)(ws + WS_QKVRAW), 1024}; pg8::gemm_phase(F.lds, P, E, F.tid); } { const Frame F = make_frame(ldsb, wave0); CArgs& AA = *get_args(); phase_lru_sum(F, AA); } } SEAM(pb + 3);
        if (IN(pb + 4)) { { const Frame F = make_frame(ldsb, wave0); CArgs& AA = *get_args(); phase_mla_post(F, AA, l); } { const Frame F = make_frame(ldsb, wave0); CArgs& AA = *get_args(); phase_lru_fin(F, AA, l); } } SEAM(pb + 4);
        if (IN(pb + 5)) { { const Frame F = make_frame(ldsb, wave0); CArgs& AA = *get_args(); phase_attn(F, AA, l); } lds_barrier(); { const Frame F = make_frame(ldsb, wave0); CArgs& AA = *get_args(); phase_s5<2>(F, AA, l); } } SEAM(pb + 5);
        if (IN(pb + 6)) { { const Frame F = make_frame(ldsb, wave0); CArgs& AA = *get_args(); phase_rwkv_A(F, AA, l); } lds_barrier(); { const Frame F = make_frame(ldsb, wave0); CArgs& AA = *get_args(); pg8::PlainProb P{(const char*)(ws + WS_YS5), (const char*)(ws + WS_WGLU) + (size_t)l * 256 * 256 * 2, 256, 256, 4, 256, 1, F.G, F.bid};
            EpiGlu E{(const bf16_t*)(ws + WS_YS5), (bf16_t*)(ws + WS_YS5G), AA.in[27] + l * 256}; pg8::gemm_phase(F.lds, P, E, F.tid); } } SEAM(pb + 6);
        if (IN(pb + 7)) { const Frame F = make_frame(ldsb, wave0); CArgs& AA = *get_args(); if (F.bid < 32) phase_rwkv_B(F, AA); else phase_moe_convert(F, AA, l, (F.bid - 32) * NWAVES + F.wave, (F.G - 32) * NWAVES); } SEAM(pb + 7);
        if (IN(pb + 8)) { { const Frame F = make_frame(ldsb, wave0); CArgs& AA = *get_args(); phase_rwkv_C(F, AA, l); } { const Frame F = make_frame(ldsb, wave0); CArgs& AA = *get_args(); phase_branch_norm(F, AA, l); } } SEAM(pb + 8);
        if (IN(pb + 9)) { const Frame F = make_frame(ldsb, wave0); CArgs& AA = *get_args(); pg8::PlainProb P{(const char*)(ws + WS_MIX), (const char*)(ws + WS_WOUT) + (size_t)l * 1024 * 1024 * 2, 1024, 1024, 16, 256, 4, F.G, F.bid};
            EpiResGate E{l == 0 ? AA.in[0] : AA.out, AA.out, MODL + 2048, (float*)(ws + WS_ROWSS), AA.in[43] + l * 1024}; pg8::gemm_phase(F.lds, P, E, F.tid); } SEAM(pb + 9);
        if (IN(pb + 10)) { const Frame F = make_frame(ldsb, wave0); CArgs& AA = *get_args(); phase_norm2_router(F, AA, l); } SEAM(pb + 10);
        if (IN(pb + 11)) { const Frame F = make_frame(ldsb, wave0); CArgs& AA = *get_args(); phase_moe_scatter(F, AA, l); } SEAM(pb + 11);
        const unsigned* META = (const unsigned*)(ws + WS_CTL) + CW_UTAB + l * 1024;
        if (IN(pb + 12)) { const Frame F = make_frame(ldsb, wave0); CArgs& AA = *get_args(); MoeProb1 P{(const char*)(ws + WS_H), (const char*)(ws + WS_WM1), META, (const int*)(ws + WS_RT_SORT), 512, 512, 8, F.G, F.bid};
            EpiMoe1 E{(bf16_t*)(ws + WS_HID), META, (const int*)(ws + WS_RT_SORT), (const float*)(ws + WS_H2SC), (const float*)(ws + WS_WM1SC)}; pg8::gemm_phase<true, true>(F.lds, P, E, F.tid); } SEAM(pb + 12);
        if (IN(pb + 13)) { const Frame F = make_frame(ldsb, wave0); CArgs& AA = *get_args(); MoeProb2 P{(const char*)(ws + WS_HID), (const char*)(ws + WS_WM2), META, 512, 512, 8, F.G, F.bid};
            EpiMoe2 E{(bf16_t*)(ws + WS_Y), META, (const int*)(ws + WS_RT_SORT), (const float*)(ws + WS_RT_GATE), MODL + 5120}; pg8::gemm_phase(F.lds, P, E, F.tid); } SEAM(pb + 13);
    }
    if (IN(NPH - 1)) { const Frame F = make_frame(ldsb, wave0); CArgs& AA = *get_args(); phase_final(F, AA); }
#undef IN
#undef SEAM
}

extern "C" void kernel_launch(void* const* d_in, const int* in_sizes, int n_in, void* d_out, int out_size, void* d_ws, size_t ws_size, hipStream_t stream) {
    static int grid = 0;
    if (grid == 0) {
        if (n_in != 51 || ws_size < WS_END) { fprintf(stderr, "kernel_launch: unexpected inputs (n_in %d, ws %zu)\n", n_in, ws_size); grid = -1; return; }
        int dev = 0, cus = 0;
        if (hipGetDevice(&dev) != hipSuccess || hipDeviceGetAttribute(&cus, hipDeviceAttributeMultiprocessorCount, dev) != hipSuccess) { grid = -1; return; }
        if (hipFuncSetAttribute((const void*)mk_fwd, hipFuncAttributeMaxDynamicSharedMemorySize, LDS_BYTES) != hipSuccess) { fprintf(stderr, "kernel_launch: hipFuncSetAttribute failed\n"); grid = -1; return; }
        grid = cus;
    }
    if (grid < 0) return;
    (void)hipMemsetAsync((char*)d_ws + WS_CTL, 0, CTL_ZERO_BYTES, stream);
    Args a{};
    for (int i = 0; i < 51; ++i) a.in[i] = (const float*)d_in[i];
    a.pos_off = (const int*)d_in[2]; a.out = (float*)d_out; a.ws = (unsigned char*)d_ws; a.pad = 0;
#if defined(MK_PER_PHASE)
    a.use_bar = 0;
    for (int p = 0; p < NPH; ++p) { a.ph_lo = p; a.ph_hi = p + 1;
        const int k = (p == 0) ? 30 : (p == NPH - 1) ? 31 : (p - 1) % NPL; const int reps = 1 + (int)((REPMASK >> k) & 1u);
        for (int r = 0; r < reps; ++r) hipLaunchKernelGGL(mk_fwd, dim3(grid), dim3(NTHR), LDS_BYTES, stream, a); }
#else
    a.use_bar = 1; a.ph_lo = 0; a.ph_hi = NPH;
    hipLaunchKernelGGL(mk_fwd, dim3(grid), dim3(NTHR), LDS_BYTES, stream, a);
#endif
}
```

```cpp
#include <hip/hip_runtime.h>
#include <cstdio>
#include <cstdint>
#include <type_traits>

#define LAS __attribute__((address_space(3)))
#define GAS __attribute__((address_space(1)))
#define DI __device__ __forceinline__
typedef unsigned short bf16_t;
typedef short bf16x8 __attribute__((ext_vector_type(8)));
typedef short s16x4 __attribute__((ext_vector_type(4)));
typedef float f32x4 __attribute__((ext_vector_type(4)));
typedef float f32x2 __attribute__((ext_vector_type(2)));
typedef float f32x16 __attribute__((ext_vector_type(16)));
typedef unsigned u32x4 __attribute__((ext_vector_type(4)));
typedef unsigned u32x2 __attribute__((ext_vector_type(2)));
typedef __bf16 bf16x2_t __attribute__((ext_vector_type(2)));
typedef int i32x4 __attribute__((ext_vector_type(4)));

constexpr int NB = 8, SEQ = 8192, DM = 1024, T = NB * SEQ, DEPTH = 2;
constexpr int WG = 256;
constexpr int ZS = 2304;
constexpr int ZC_R = 0, ZC_K = 256, ZC_V = 512, ZC_WLO = 768, ZC_ALO = 800, ZC_GLO = 832, ZC_S5 = 896, ZC_QA = 1152, ZC_KVA = 1408, ZC_KPE = 1536, ZC_LX = 1568, ZC_LG = 1824, D_IN = 2080;
constexpr int NEXP = 32, DFF = 512;
constexpr float NORM_EPS = 1e-6f;

DI unsigned f2bf(float f) { unsigned u = __float_as_uint(f); return (u + 0x7fffu + ((u >> 16) & 1u)) >> 16; }
DI unsigned pk2(float lo, float hi) { f32x2 v = {lo, hi}; bf16x2_t b = __builtin_convertvector(v, bf16x2_t); return __builtin_bit_cast(unsigned, b); }
DI float bflo(unsigned u) { return __uint_as_float(u << 16); }
DI float bfhi(unsigned u) { return __uint_as_float(u & 0xffff0000u); }
DI float bf2f(bf16_t b) { return __uint_as_float(((unsigned)b) << 16); }
DI int lane_opaque() { int l; asm volatile("v_mbcnt_lo_u32_b32 %0, -1, 0\n\tv_mbcnt_hi_u32_b32 %0, -1, %0" : "=v"(l)); return l; }
DI float shfl_xor_l(float v, int o, int lane) { return __int_as_float(__builtin_amdgcn_ds_bpermute((lane ^ o) << 2, __float_as_int(v))); }
DI float wave_max(float v) {
    const int l = lane_opaque();
#pragma unroll
    for (int o = 1; o < 64; o <<= 1) v = fmaxf(v, shfl_xor_l(v, o, l));
    return v;
}
DI unsigned q8x4(f32x4 v, float inv) { const int a = (int)rintf(v[0] * inv), b = (int)rintf(v[1] * inv), c = (int)rintf(v[2] * inv), d = (int)rintf(v[3] * inv);
    return (unsigned)(a & 255) | ((unsigned)(b & 255) << 8) | ((unsigned)(c & 255) << 16) | ((unsigned)(d & 255) << 24); }
DI float wave_sum(float v) {
    const int l = lane_opaque();
#pragma unroll
    for (int o = 1; o < 64; o <<= 1) v += shfl_xor_l(v, o, l);
    return v;
}
DI void lds_barrier() { asm volatile("s_waitcnt lgkmcnt(0)" ::: "memory"); __builtin_amdgcn_s_barrier(); asm volatile("" ::: "memory"); }
DI float sigmoidf_(float x) { return __builtin_amdgcn_rcpf(1.f + __expf(-x)); }
DI float fast_tanh(float x) { const float e = __expf(2.f * fminf(fmaxf(x, -15.f), 15.f)); return (e - 1.f) * __builtin_amdgcn_rcpf(e + 1.f); }
DI float fast_softplus(float x) { return fmaxf(x, 0.f) + __logf(1.f + __expf(-fabsf(x))); }
DI float softplusf_(float x) { return fmaxf(x, 0.f) + log1pf(__expf(-fabsf(x))); }
DI float gelu_tanh(float x) { const float u = 0.7978845608028654f * (x + 0.044715f * x * x * x); const float e = __expf(2.f * fminf(fmaxf(u, -15.f), 15.f)); return x * e * __builtin_amdgcn_rcpf(e + 1.f); }
DI float siluf_(float x) { return x / (1.f + __expf(-x)); }

namespace pg8 {
constexpr int BM = 256, BK = 64, HALF = 128, HTB = HALF * BK * 2, STAGE_BYTES = 8 * HTB;
DI int lds_byte(int r, int c) { const int st = (r >> 4) * 2 + (c >> 5), rr = r & 15, cc = c & 31, ob = rr * 64 + cc * 2; return st * 1024 + (ob ^ (((ob >> 9) & 1) << 5)); }
DI void stage_rc(int b, int& R, int& C) { const int st = b / 1024, sb = b % 1024, swz = sb ^ (((sb >> 9) & 1) << 5); R = (st >> 1) * 16 + swz / 64; C = (st & 1) * 32 + (swz % 64) / 2; }
DI int perm32(int rho) { const int n = rho >> 4, i = rho & 15; return 8 * (i >> 2) + 4 * n + (i & 3); }

struct Unit { int pm, pn, e, blk; };
DI f32x4 mma_any(bf16x8 a, bf16x8 b, f32x4 c) { return __builtin_amdgcn_mfma_f32_16x16x32_bf16(a, b, c, 0, 0, 0); }
DI i32x4 mma_any(bf16x8 a, bf16x8 b, i32x4 c) { return __builtin_amdgcn_mfma_i32_16x16x64_i8(__builtin_bit_cast(i32x4, a), __builtin_bit_cast(i32x4, b), c, 0, 0, 0); }

template <bool ALIGN_EPI = true, bool I8 = false, class Epi, class P>
DI void gemm_phase(LAS unsigned char* lds, const P& S, const Epi& E, int tid_in) {
    typedef typename std::conditional<I8, i32x4, f32x4>::type acc_t;
    const int tid = tid_in, wid = __builtin_amdgcn_readfirstlane(tid >> 6), lane = tid & 63, wr = wid >> 2, wc = wid & 3, fr = lane & 15, fq = lane >> 4;
    const int nt = S.nt;
    int Rr[2], Cc[2];
    unsigned voffB[2], offC[2][2], offN[2][2];
#pragma unroll
    for (int i = 0; i < 2; ++i) { int R, C; stage_rc(tid * 16 + i * 8192, R, C); Rr[i] = R; Cc[i] = C; const int Rb = Epi::PERM ? ((R & ~31) + perm32(R & 31)) : R;
        voffB[i] = (unsigned)(Rb * S.ldb + C) * 2u; }
    const size_t kstep = (size_t)(BK * 2);
    const size_t hstepB = (size_t)HALF * S.ldb * 2;
    const unsigned ldsw = (unsigned)wid * 1024u;
    const int aoff = lds_byte(wr * 64 + fr, fq * 8), boff = lds_byte(wc * 32 + fr, fq * 8);
#define PG8_SA(b, h) (((b) * 2 + (h)) * HTB)
#define PG8_SB(b, h) ((4 + (b) * 2 + (h)) * HTB)
#define PG8_STAGE(bufoff, gbase, voff) do { _Pragma("unroll") for (int _i = 0; _i < 2; ++_i) \
        __builtin_amdgcn_global_load_lds((const unsigned*)((const char*)(gbase) + (voff)[_i]), (LAS unsigned*)(lds + (bufoff) + ldsw + _i * 8192), 16, 0, 0); } while (0)
#define PG8_LDA(dst, b, h) do { _Pragma("unroll") for (int m = 0; m < 4; ++m) _Pragma("unroll") for (int k = 0; k < 2; ++k) dst[m][k] = *(const LAS bf16x8*)(lds + PG8_SA(b, h) + aoff + m * 2048 + k * 1024); } while (0)
#define PG8_LDB(dst, b, h) do { _Pragma("unroll") for (int n = 0; n < 2; ++n) _Pragma("unroll") for (int k = 0; k < 2; ++k) dst[n][k] = *(const LAS bf16x8*)(lds + PG8_SB(b, h) + boff + n * 2048 + k * 1024); } while (0)
#define PG8_MMA(ai, bj, At, Bt) do { __builtin_amdgcn_s_setprio(1); _Pragma("unroll") for (int m = 0; m < 4; ++m) _Pragma("unroll") for (int n = 0; n < 2; ++n) _Pragma("unroll") for (int k = 0; k < 2; ++k) \
        acc[ai][bj][m][n] = mma_any(Bt[n][k], At[m][k], acc[ai][bj][m][n]); __builtin_amdgcn_s_setprio(0); } while (0)
#define PG8_WAIT_V(n) asm volatile("s_waitcnt vmcnt(" #n ")" ::: "memory")
#define PG8_WAIT_L(n) asm volatile("s_waitcnt lgkmcnt(" #n ")" ::: "memory")
#define PG8_BAR __builtin_amdgcn_s_barrier()
#define PG8_SCHED __builtin_amdgcn_sched_barrier(0)
    Unit cur, nxt; int ui = 0;
    if (!S.next(0, cur)) return;
    acc_t acc[2][2][4][2];
#pragma unroll
    for (int a = 0; a < 2; ++a)
#pragma unroll
        for (int b = 0; b < 2; ++b)
#pragma unroll
            for (int m = 0; m < 4; ++m)
#pragma unroll
                for (int n = 0; n < 2; ++n) acc[a][b][m][n] = (acc_t){0, 0, 0, 0};
    bf16x8 At[4][2], B0[2][2], B1[2][2];
    const char* cA = S.a_base(cur); const char* cB = S.b_base(cur);
#pragma unroll
    for (int h = 0; h < 2; ++h)
#pragma unroll
        for (int i = 0; i < 2; ++i) { offC[h][i] = S.a_off(cur, h * HALF + Rr[i]) + (unsigned)Cc[i] * 2u; offN[h][i] = offC[h][i]; }
    PG8_STAGE(PG8_SB(0, 0), cB, voffB); PG8_STAGE(PG8_SB(0, 1), cB + hstepB, voffB); PG8_STAGE(PG8_SA(0, 0), cA, offC[0]); PG8_STAGE(PG8_SA(0, 1), cA, offC[1]);
    if (wr == 1) PG8_BAR;
    PG8_WAIT_V(2); PG8_BAR;
    PG8_STAGE(PG8_SB(1, 0), cB + kstep, voffB); PG8_STAGE(PG8_SA(1, 0), cA + kstep, offC[0]); PG8_STAGE(PG8_SB(1, 1), cB + hstepB + kstep, voffB);
    PG8_WAIT_V(6); PG8_BAR;
    for (;;) {
        const bool has_next = S.next(ui + 1, nxt);
        const char* nA = has_next ? S.a_base(nxt) : cA; const char* nB = has_next ? S.b_base(nxt) : cB;
        for (int t = 0; t < nt; t += 2) {
            const bool last = (t == nt - 2);
            const char* a1 = cA + (size_t)(t + 1) * kstep;
            const char* a2 = last ? nA : cA + (size_t)(t + 2) * kstep; const char* b2 = last ? nB : cB + (size_t)(t + 2) * kstep;
            const char* a3 = a2 + kstep; const char* b3 = b2 + kstep;
            if (last && has_next) {
#pragma unroll
                for (int h = 0; h < 2; ++h)
#pragma unroll
                    for (int i = 0; i < 2; ++i) offN[h][i] = S.a_off(nxt, h * HALF + Rr[i]) + (unsigned)Cc[i] * 2u;
            }
            unsigned o2[2][2];
#pragma unroll
            for (int h = 0; h < 2; ++h)
#pragma unroll
                for (int i = 0; i < 2; ++i) o2[h][i] = last ? offN[h][i] : offC[h][i];
            PG8_LDB(B0, 0, 0); PG8_LDB(B1, 0, 1); PG8_SCHED; PG8_LDA(At, 0, 0); PG8_STAGE(PG8_SA(1, 1), a1, offC[1]);
            PG8_WAIT_V(8); PG8_WAIT_L(0); PG8_BAR; PG8_MMA(0, 0, At, B0); PG8_MMA(0, 1, At, B1); PG8_BAR; PG8_SCHED;
            PG8_LDA(At, 0, 1); PG8_STAGE(PG8_SB(0, 0), b2, voffB); PG8_STAGE(PG8_SB(0, 1), b2 + hstepB, voffB); PG8_STAGE(PG8_SA(0, 0), a2, o2[0]);
            PG8_WAIT_V(8); PG8_WAIT_L(0); PG8_BAR; PG8_MMA(1, 0, At, B0); PG8_MMA(1, 1, At, B1); PG8_BAR; PG8_SCHED;
            PG8_LDB(B0, 1, 0); PG8_LDB(B1, 1, 1); PG8_SCHED; PG8_LDA(At, 1, 0); PG8_STAGE(PG8_SA(0, 1), a2, o2[1]);
            PG8_WAIT_V(8); PG8_WAIT_L(0); PG8_BAR; PG8_MMA(0, 0, At, B0); PG8_MMA(0, 1, At, B1); PG8_BAR; PG8_SCHED;
            PG8_LDA(At, 1, 1); PG8_STAGE(PG8_SB(1, 0), b3, voffB); PG8_STAGE(PG8_SB(1, 1), b3 + hstepB, voffB); PG8_STAGE(PG8_SA(1, 0), a3, o2[0]);
            PG8_WAIT_V(8); PG8_WAIT_L(0); PG8_BAR; PG8_MMA(1, 0, At, B0); PG8_MMA(1, 1, At, B1); PG8_BAR; PG8_SCHED;
        }
        if constexpr (ALIGN_EPI) { if (wr == 0) PG8_BAR; }
        E(acc, cur, wr, wc, fr, fq);
        if (!has_next) break;
#pragma unroll
        for (int a = 0; a < 2; ++a)
#pragma unroll
            for (int b = 0; b < 2; ++b)
#pragma unroll
                for (int m = 0; m < 4; ++m)
#pragma unroll
                    for (int n = 0; n < 2; ++n) acc[a][b][m][n] = (acc_t){0, 0, 0, 0};
        cur = nxt; cA = nA; cB = nB; ++ui;
#pragma unroll
        for (int h = 0; h < 2; ++h)
#pragma unroll
            for (int i = 0; i < 2; ++i) offC[h][i] = offN[h][i];
        if constexpr (ALIGN_EPI) { if (wr == 1) PG8_BAR; }
    }
    PG8_WAIT_V(0);
    if constexpr (!ALIGN_EPI) { if (wr == 0) PG8_BAR; }
    PG8_BAR;
#undef PG8_SA
#undef PG8_SB
#undef PG8_STAGE
#undef PG8_LDA
#undef PG8_LDB
#undef PG8_MMA
#undef PG8_WAIT_V
#undef PG8_WAIT_L
#undef PG8_BAR
#undef PG8_SCHED
}

struct PlainProb {
    const char* A; const char* Bt; int lda, ldb, nt, nM, nN, G, c;
    DI bool next(int i, Unit& u) const {
        const long L = (long)i * G + c; const int nwg = nM * nN; if (L >= nwg) return false;
        int wgid = (int)L; { const int q = nwg / 8, r = nwg % 8, xcd = wgid % 8, off = wgid / 8; wgid = (xcd < r ? xcd * (q + 1) : r * (q + 1) + (xcd - r) * q) + off; }
        const int nig = 8 * nN, gid = wgid / nig, fm = gid * 8, gsz = (nM - fm) < 8 ? (nM - fm) : 8;
        u.pm = fm + ((wgid % nig) % gsz); u.pn = (wgid % nig) / gsz; u.e = 0; u.blk = 0; return true;
    }
    DI const char* a_base(const Unit& u) const { return A + (size_t)u.pm * 256 * lda * 2; }
    DI const char* b_base(const Unit& u) const { return Bt + (size_t)u.pn * 256 * ldb * 2; }
    DI unsigned a_off(const Unit&, int row) const { return (unsigned)row * (unsigned)lda * 2u; }
};
}

constexpr size_t MiB = 1u << 20;
constexpr size_t WS_CTL = 0, CTL_ZERO_BYTES = 1 * MiB;
constexpr size_t WS_MOD = 1 * MiB;
constexpr size_t WS_RT_EID = 3 * MiB;
constexpr size_t WS_RT_GATE = WS_RT_EID + 512 * 1024;
constexpr size_t WS_RT_PIE = WS_RT_GATE + 512 * 1024;
constexpr size_t WS_RT_SORT = WS_RT_PIE + 512 * 1024;
constexpr size_t WS_WIN = 8 * MiB;
constexpr size_t WS_WINSC = 8 * MiB + 5 * MiB;
constexpr size_t WS_HSC = 7 * MiB + 512 * 1024;
constexpr size_t WS_WOUT = 17 * MiB;
constexpr size_t WS_WMLA = 21 * MiB;
constexpr size_t WS_WGLU = 23 * MiB;
constexpr size_t WS_WR = 23 * MiB + 256 * 1024;
constexpr size_t WS_WLRU = 23 * MiB + 640 * 1024;
constexpr size_t WS_WLORA = 23 * MiB + 768 * 1024;
static_assert(WS_WGLU + 256 * 1024 <= WS_WR && WS_WR + 384 * 1024 <= WS_WLRU && WS_WLRU + 128 * 1024 <= WS_WLORA && WS_WLORA + 128 * 1024 <= 24 * MiB, "small weight map");
constexpr size_t WS_H = 24 * MiB;
constexpr size_t WS_Z = 152 * MiB;
constexpr size_t WS_WM1 = WS_Z;
constexpr size_t WS_WM2 = WS_Z + 64 * MiB;
constexpr size_t WS_WM1SC = WS_Z + 32 * MiB;
constexpr size_t WS_H2SC = 7 * MiB + 768 * 1024;
constexpr size_t WS_MIX = 440 * MiB;
constexpr size_t WS_HID = WS_MIX;
constexpr size_t WS_Y = 569 * MiB;
constexpr size_t WS_Q = 825 * MiB;
constexpr size_t WS_K = 873 * MiB;
constexpr size_t WS_VT = 921 * MiB;
constexpr size_t WS_ROWSS = WS_Q;
constexpr size_t WS_TAIL = 953 * MiB;
constexpr size_t WS_END = 1017 * MiB;
constexpr size_t WS_AMLA = WS_TAIL;
constexpr size_t WS_QKVRAW = WS_Y;
constexpr size_t WS_ATTO = WS_H;
constexpr size_t WS_RW_V = WS_Y + 64 * MiB, WS_RW_G = WS_H + 64 * MiB;
constexpr size_t WS_RC_RP = WS_H + 32 * MiB;
constexpr size_t WS_RC_MP = WS_H + 64 * MiB;
constexpr size_t WS_RC_HB = WS_H + 96 * MiB;
constexpr size_t WS_RC_Y0 = WS_Q;
constexpr size_t WS_RC_G = WS_Q + 64 * MiB;
constexpr int RC_REC = 24832;
constexpr size_t WS_RC_BS = WS_Q + 64 * MiB + 98 * MiB;
static_assert((size_t)4096 * RC_REC <= 98 * MiB && WS_RC_BS + 1 * MiB <= WS_END, "rwkv record map");
constexpr size_t WS_YS5 = WS_Y;
constexpr size_t WS_YS5G = WS_Y + 32 * MiB;
constexpr size_t WS_YL = WS_TAIL + 32 * MiB;
constexpr size_t WS_LA = WS_Y + 128 * MiB, WS_LB = WS_Y + 192 * MiB;
constexpr size_t WS_S5END = 2 * MiB;
constexpr size_t WS_S5BB = 5 * MiB;
constexpr size_t WS_S5CC = 5 * MiB + 128 * 1024;
constexpr size_t WS_LSUM = 5 * MiB + 512 * 1024;
static_assert(WS_RT_SORT + 512 * 1024 <= WS_LSUM && WS_LSUM + 2 * MiB <= WS_WIN && WS_S5END + 1 * MiB <= WS_RT_EID, "map");

constexpr int CW_BAR = 4096;
constexpr int CW_CNT = 16384;
constexpr int CW_INMAX = 32768;
constexpr int CW_COLMAX = 65536;
constexpr int CW_UTAB = 20480;

constexpr int NWAVES = 8, NTHR = 512;
constexpr int LDS_BYTES = 155648;
constexpr int MISC_OFF = 155648 - 256;

struct Args { const float* in[51]; const int* pos_off; float* out; unsigned char* ws; int ph_lo, ph_hi, use_bar, pad; };
typedef const __attribute__((address_space(4))) Args CArgs;
DI CArgs* get_args() { CArgs* ap = (CArgs*)__builtin_amdgcn_kernarg_segment_ptr(); asm volatile("" : "+s"(ap)); return ap; }

#define XB_TMO      128
#define XB_XCNT(j)  (256  + 64 * (j))
#define XB_XSUB(j)  (1280 + 64 * (j))
#define XB_XGEN(j)  (2304 + 64 * (j))
#define XB_TOP      3328
#define XB_TOPGEN   3392
#define XCD_BAR_WORDS 3456
#define XB_SPIN_CAP (1u << 18)
DI unsigned xb_ld(unsigned* p)              { return __hip_atomic_load(p, __ATOMIC_RELAXED, __HIP_MEMORY_SCOPE_AGENT); }
DI unsigned xb_add(unsigned* p, unsigned v) { return __hip_atomic_fetch_add(p, v, __ATOMIC_RELAXED, __HIP_MEMORY_SCOPE_AGENT); }
DI unsigned xb_xcc_id() { return (unsigned)__builtin_amdgcn_s_getreg((3 << 11) | 20) & 0xFu; }
#define XB_SPIN(cond, bar) do { unsigned _sp = 0; while (cond) { __builtin_amdgcn_s_sleep(1); \
    if ((++_sp & 255u) == 0u) { if (xb_ld(&(bar)[XB_TMO])) break; if (_sp > XB_SPIN_CAP) { atomicAdd(&(bar)[XB_TMO], 1u); break; } } } } while (0)
struct XcdBarrier { unsigned* bar; unsigned x; volatile LAS unsigned* st; };
DI XcdBarrier xcd_barrier_post(unsigned* bar, volatile LAS unsigned* st) {
    XcdBarrier b; b.bar = bar; b.x = xb_xcc_id(); b.st = st;
    if (threadIdx.x == 0) (void)xb_add(&bar[XB_XCNT(b.x)], 1u);
    return b;
}
DI void xcd_barrier_complete(unsigned* bar, unsigned x, unsigned& nloc, unsigned& nx) {
    const unsigned G = gridDim.x * gridDim.y * gridDim.z;
    unsigned sum, cnt, mine, sp = 0u;
    for (;;) {
        sum = 0u; cnt = 0u; mine = 0u;
#pragma unroll
        for (unsigned j = 0; j < 16; ++j) { const unsigned c = xb_ld(&bar[XB_XCNT(j)]); sum += c; cnt += (c > 0u) ? 1u : 0u; mine = (j == x) ? c : mine; }
        if (sum == G) break;
        __builtin_amdgcn_s_sleep(1);
        if ((++sp & 255u) == 0u) { if (xb_ld(&bar[XB_TMO])) break; if (sp > XB_SPIN_CAP) { atomicAdd(&bar[XB_TMO], 1u); break; } }
    }
    nloc = mine > 0u ? mine : 1u; nx = cnt > 0u ? cnt : 1u;
}
DI void xcd_barrier(const XcdBarrier& b) {
    asm volatile("s_waitcnt vmcnt(0)" ::: "memory");
    __syncthreads();
    if (threadIdx.x == 0) {
        unsigned* bar = b.bar;
        __builtin_amdgcn_s_waitcnt(0);
        unsigned nloc = b.st[0], nx = b.st[1];
        if (nloc == 0u) { xcd_barrier_complete(bar, b.x, nloc, nx); b.st[0] = nloc; b.st[1] = nx; }
        const unsigned old = xb_add(&bar[XB_XSUB(b.x)], 1u);
        const unsigned gen = old / nloc;
        if (old + 1u == (gen + 1u) * nloc) {
            __builtin_amdgcn_fence(__ATOMIC_RELEASE, "agent");
            asm volatile("s_waitcnt vmcnt(0)" ::: "memory");
            const unsigned og = xb_add(&bar[XB_TOP], 1u);
            const unsigned tg = og / nx;
            if (og + 1u == (tg + 1u) * nx) xb_add(&bar[XB_TOPGEN], 1u);
            else XB_SPIN(xb_ld(&bar[XB_TOPGEN]) == tg, bar);
            __builtin_amdgcn_fence(__ATOMIC_ACQUIRE, "agent");
            xb_add(&bar[XB_XGEN(b.x)], 1u);
            asm volatile("s_waitcnt vmcnt(0)" ::: "memory");
        } else {
            XB_SPIN(xb_ld(&bar[XB_XGEN(b.x)]) == gen, bar);
            __builtin_amdgcn_fence(__ATOMIC_ACQUIRE, "agent");
            asm volatile("s_waitcnt vmcnt(0)" ::: "memory");
        }
    }
    __syncthreads();
}

struct EpiBf16Plain {
    static constexpr bool PERM = true;
    bf16_t* O; int ldc;
    DI void operator()(const f32x4 (&acc)[2][2][4][2], const pg8::Unit& u, int wr, int wc, int fr, int fq) const {
        const int row0 = u.pm * 256 + wr * 64 + fr, col0 = u.pn * 256 + wc * 32 + 8 * fq;
#pragma unroll
        for (int ai = 0; ai < 2; ++ai)
#pragma unroll
            for (int m = 0; m < 4; ++m) { bf16_t* rowp = O + (size_t)(row0 + ai * 128 + m * 16) * ldc + col0;
#pragma unroll
                for (int bj = 0; bj < 2; ++bj) { const f32x4 v0 = acc[ai][bj][m][0], v1 = acc[ai][bj][m][1];
                    u32x4 w; w.x = pk2(v0[0], v0[1]); w.y = pk2(v0[2], v0[3]); w.z = pk2(v1[0], v1[1]); w.w = pk2(v1[2], v1[3]);
                    *(u32x4*)(rowp + bj * 128) = w; } }
    }
};
struct EpiBf16I8 {
    static constexpr bool PERM = true;
    bf16_t* O; int ldc; const float* sa; const float* sw;
    DI void operator()(const i32x4 (&acc)[2][2][4][2], const pg8::Unit& u, int wr, int wc, int fr, int fq) const {
        const int row0 = u.pm * 256 + wr * 64 + fr, col0 = u.pn * 256 + wc * 32 + 8 * fq;
        f32x4 w0[2], w1[2];
#pragma unroll
        for (int bj = 0; bj < 2; ++bj) { w0[bj] = *(const f32x4*)(sw + col0 + bj * 128); w1[bj] = *(const f32x4*)(sw + col0 + bj * 128 + 4); }
#pragma unroll
        for (int ai = 0; ai < 2; ++ai)
#pragma unroll
            for (int m = 0; m < 4; ++m) { const int row = row0 + ai * 128 + m * 16; const float ra = sa[row]; bf16_t* rowp = O + (size_t)row * ldc + col0;
#pragma unroll
                for (int bj = 0; bj < 2; ++bj) { const i32x4 a0 = acc[ai][bj][m][0], a1 = acc[ai][bj][m][1];
                    u32x4 w; w.x = pk2((float)a0[0] * ra * w0[bj][0], (float)a0[1] * ra * w0[bj][1]); w.y = pk2((float)a0[2] * ra * w0[bj][2], (float)a0[3] * ra * w0[bj][3]);
                    w.z = pk2((float)a1[0] * ra * w1[bj][0], (float)a1[1] * ra * w1[bj][1]); w.w = pk2((float)a1[2] * ra * w1[bj][2], (float)a1[3] * ra * w1[bj][3]);
                    *(u32x4*)(rowp + bj * 128) = w; } }
    }
};
struct EpiResGate {
    static constexpr bool PERM = false;
    const float* xin; float* out; const float* gt; float* rowss; const float* n2g;
    DI void operator()(const f32x4 (&acc)[2][2][4][2], const pg8::Unit& u, int wr, int wc, int fr, int fq) const {
        const int row0 = u.pm * 256 + wr * 64 + fr, col0 = u.pn * 256 + wc * 32 + 4 * fq;
        const int b = (u.pm * 256) / SEQ;
        const int ln = lane_opaque();
        f32x4 g[2][2], G2[2][2];
#pragma unroll
        for (int bj = 0; bj < 2; ++bj)
#pragma unroll
            for (int n = 0; n < 2; ++n) { g[bj][n] = *(const f32x4*)(gt + (size_t)b * 6144 + col0 + bj * 128 + n * 16);
                G2[bj][n] = *(const f32x4*)(n2g + col0 + bj * 128 + n * 16) * (*(const f32x4*)(gt + (size_t)b * 6144 + 2048 + col0 + bj * 128 + n * 16) + 1.f); }
#pragma unroll
        for (int ai = 0; ai < 2; ++ai)
#pragma unroll
            for (int m = 0; m < 4; ++m) { const size_t ro = (size_t)(row0 + ai * 128 + m * 16) * DM + col0; float ss = 0.f, mxg = 0.f;
#pragma unroll
                for (int bj = 0; bj < 2; ++bj)
#pragma unroll
                    for (int n = 0; n < 2; ++n) { const f32x4 xv = *(const f32x4*)(xin + ro + bj * 128 + n * 16); const f32x4 v = xv + g[bj][n] * acc[ai][bj][m][n];
                        *(f32x4*)(out + ro + bj * 128 + n * 16) = v; ss += (v[0] * v[0] + v[1] * v[1]) + (v[2] * v[2] + v[3] * v[3]);
                        const f32x4 vg = v * G2[bj][n]; mxg = fmaxf(mxg, fmaxf(fmaxf(fabsf(vg[0]), fabsf(vg[1])), fmaxf(fabsf(vg[2]), fabsf(vg[3])))); }
                ss += shfl_xor_l(ss, 16, ln); ss += shfl_xor_l(ss, 32, ln); mxg = fmaxf(mxg, shfl_xor_l(mxg, 16, ln)); mxg = fmaxf(mxg, shfl_xor_l(mxg, 32, ln));
                if (fq == 0) { float* rp = rowss + (size_t)(row0 + ai * 128 + m * 16) * 32 + u.pn * 4 + wc; rp[0] = ss; rp[16] = mxg; } }
    }
};
struct EpiGlu {
    static constexpr bool PERM = true;
    const bf16_t* Y; bf16_t* O; const float* bias;
    DI void operator()(const f32x4 (&acc)[2][2][4][2], const pg8::Unit& u, int wr, int wc, int fr, int fq) const {
        const int row0 = u.pm * 256 + wr * 64 + fr, col0 = wc * 32 + 8 * fq;
#pragma unroll
        for (int ai = 0; ai < 2; ++ai)
#pragma unroll
            for (int m = 0; m < 4; ++m) { const size_t ro = (size_t)(row0 + ai * 128 + m * 16) * 256 + col0;
#pragma unroll
                for (int bj = 0; bj < 2; ++bj) { const u32x4 yv = *(const u32x4*)(Y + ro + bj * 128);
                    const f32x4 b0 = *(const f32x4*)(bias + col0 + bj * 128), b1 = *(const f32x4*)(bias + col0 + bj * 128 + 4);
                    const f32x4 v0 = acc[ai][bj][m][0] + b0, v1 = acc[ai][bj][m][1] + b1;
                    u32x4 w;
                    w.x = pk2(bflo(yv.x) * sigmoidf_(v0[0]), bfhi(yv.x) * sigmoidf_(v0[1]));
                    w.y = pk2(bflo(yv.y) * sigmoidf_(v0[2]), bfhi(yv.y) * sigmoidf_(v0[3]));
                    w.z = pk2(bflo(yv.z) * sigmoidf_(v1[0]), bfhi(yv.z) * sigmoidf_(v1[1]));
                    w.w = pk2(bflo(yv.w) * sigmoidf_(v1[2]), bfhi(yv.w) * sigmoidf_(v1[3]));
                    *(u32x4*)(O + ro + bj * 128) = w; } }
    }
};

struct Frame { LAS unsigned char* lds; int tid, lane, wave, G, bid, gw, ngw; };

DI Frame make_frame(LAS unsigned char* lds, int wave0) {
    Frame F; F.lds = lds; int w = wave0; asm volatile("" : "+s"(w)); F.wave = w; F.lane = lane_opaque(); F.tid = w * 64 + F.lane;
    F.G = gridDim.x; F.bid = blockIdx.x; F.gw = F.bid * NWAVES + F.wave; F.ngw = F.G * NWAVES; return F;
}
DI void transpose_item(const float* src, int ld_src, int k0, int n0, bf16_t* dst, int ldd, int nd0, int kd0, LAS float* scr, int lane) {
#pragma unroll 8
    for (int i = 0; i < 32; ++i) { const int kk = 2 * i + (lane >> 5); scr[kk * 33 + (lane & 31)] = src[(size_t)(k0 + kk) * ld_src + n0 + (lane & 31)]; }
    asm volatile("s_waitcnt lgkmcnt(0)" ::: "memory");
    const int c = lane & 7;
#pragma unroll
    for (int j = 0; j < 4; ++j) { const int n = (lane >> 3) + 8 * j; const LAS float* s = scr + (8 * c) * 33 + n;
        u32x4 o; o.x = pk2(s[0 * 33], s[1 * 33]); o.y = pk2(s[2 * 33], s[3 * 33]); o.z = pk2(s[4 * 33], s[5 * 33]); o.w = pk2(s[6 * 33], s[7 * 33]);
        *(u32x4*)(dst + (size_t)(nd0 + n) * ldd + kd0 + 8 * c) = o; }
    asm volatile("s_waitcnt lgkmcnt(0)" ::: "memory");
}
DI void transpose_item64(const float* src, int ld_src, int k0, int n0, bf16_t* dst, int ldd, int nd0, int kd0, LAS float* scr, int lane) {
    f32x4 v[16];
#pragma unroll
    for (int i = 0; i < 16; ++i) v[i] = *(const f32x4*)(src + (size_t)(k0 + 4 * i + (lane >> 4)) * ld_src + n0 + 4 * (lane & 15));
#pragma unroll
    for (int i = 0; i < 16; ++i) { LAS float* p = scr + (4 * i + (lane >> 4)) * 65 + 4 * (lane & 15); p[0] = v[i][0]; p[1] = v[i][1]; p[2] = v[i][2]; p[3] = v[i][3]; }
    asm volatile("s_waitcnt lgkmcnt(0)" ::: "memory");
    const int c = lane & 7;
#pragma unroll
    for (int j = 0; j < 8; ++j) { const int n = (lane >> 3) + 8 * j; const LAS float* q = scr + (8 * c) * 65 + n;
        u32x4 o; o.x = pk2(q[0 * 65], q[1 * 65]); o.y = pk2(q[2 * 65], q[3 * 65]); o.z = pk2(q[4 * 65], q[5 * 65]); o.w = pk2(q[6 * 65], q[7 * 65]);
        *(u32x4*)(dst + (size_t)(nd0 + n) * ldd + kd0 + 8 * c) = o; }
    asm volatile("s_waitcnt lgkmcnt(0)" ::: "memory");
}
DI void quant_item64(const float* src, int ld_src, int k0, int n0, signed char* dst, int ldd, int nd0, int kd0, const unsigned* colmax, float* wsc, LAS float* scr, int lane, int nvalid = 1 << 30) {
    f32x4 v[16]; const bool okc = n0 + 4 * (lane & 15) < nvalid;
#pragma unroll
    for (int i = 0; i < 16; ++i) { v[i] = (f32x4){0.f, 0.f, 0.f, 0.f}; if (okc) v[i] = *(const f32x4*)(src + (size_t)(k0 + 4 * i + (lane >> 4)) * ld_src + n0 + 4 * (lane & 15)); }
#pragma unroll
    for (int i = 0; i < 16; ++i) { LAS float* p = scr + (4 * i + (lane >> 4)) * 65 + 4 * (lane & 15); p[0] = v[i][0]; p[1] = v[i][1]; p[2] = v[i][2]; p[3] = v[i][3]; }
    asm volatile("s_waitcnt lgkmcnt(0)" ::: "memory");
    const int c = lane & 7;
#pragma unroll
    for (int j = 0; j < 8; ++j) { const int n = (lane >> 3) + 8 * j; const LAS float* q = scr + (8 * c) * 65 + n;
        const float sc = fmaxf(__uint_as_float(colmax[n]), 1e-30f) * (1.f / 127.f), inv = 1.f / sc;
        if (wsc && c == 0) wsc[n] = sc;
        u32x2 o; o.x = q8x4((f32x4){q[0 * 65], q[1 * 65], q[2 * 65], q[3 * 65]}, inv); o.y = q8x4((f32x4){q[4 * 65], q[5 * 65], q[6 * 65], q[7 * 65]}, inv);
        *(u32x2*)(dst + (size_t)(nd0 + n) * ldd + kd0 + 8 * c) = o; }
    asm volatile("s_waitcnt lgkmcnt(0)" ::: "memory");
}
DI void quant_strip64(const float* src, int ld_src, int n0, int nvalid, signed char* dst, int ldd, float* scale, LAS float* scr, int lane) {
    const int c4 = n0 + 4 * (lane & 15); const bool okc = c4 < nvalid;
    float mx[4] = {0.f, 0.f, 0.f, 0.f};
    for (int kb = 0; kb < 16; ++kb) {
#pragma unroll
        for (int i = 0; i < 16; ++i) { f32x4 v = {0.f, 0.f, 0.f, 0.f}; if (okc) v = *(const f32x4*)(src + (size_t)(64 * kb + 4 * i + (lane >> 4)) * ld_src + c4);
            mx[0] = fmaxf(mx[0], fabsf(v[0])); mx[1] = fmaxf(mx[1], fabsf(v[1])); mx[2] = fmaxf(mx[2], fabsf(v[2])); mx[3] = fmaxf(mx[3], fabsf(v[3])); } }
#pragma unroll
    for (int q = 0; q < 4; ++q) { mx[q] = fmaxf(mx[q], shfl_xor_l(mx[q], 16, lane)); mx[q] = fmaxf(mx[q], shfl_xor_l(mx[q], 32, lane)); }
    LAS float* smax = scr + 64 * 65;
    if (lane < 16) {
#pragma unroll
        for (int q = 0; q < 4; ++q) { const float sc = fmaxf(mx[q], 1e-30f) * (1.f / 127.f); smax[4 * lane + q] = sc; scale[4 * lane + q] = sc; } }
    asm volatile("s_waitcnt lgkmcnt(0)" ::: "memory");
    for (int kb = 0; kb < 16; ++kb) {
        f32x4 v[16];
#pragma unroll
        for (int i = 0; i < 16; ++i) { v[i] = (f32x4){0.f, 0.f, 0.f, 0.f}; if (okc) v[i] = *(const f32x4*)(src + (size_t)(64 * kb + 4 * i + (lane >> 4)) * ld_src + c4); }
#pragma unroll
        for (int i = 0; i < 16; ++i) { LAS float* p = scr + (4 * i + (lane >> 4)) * 65 + 4 * (lane & 15); p[0] = v[i][0]; p[1] = v[i][1]; p[2] = v[i][2]; p[3] = v[i][3]; }
        asm volatile("s_waitcnt lgkmcnt(0)" ::: "memory");
        const int c = lane & 7;
#pragma unroll
        for (int j = 0; j < 8; ++j) { const int n = (lane >> 3) + 8 * j; const LAS float* q = scr + (8 * c) * 65 + n; const float inv = 1.f / smax[n];
            u32x2 o; o.x = q8x4((f32x4){q[0 * 65], q[1 * 65], q[2 * 65], q[3 * 65]}, inv); o.y = q8x4((f32x4){q[4 * 65], q[5 * 65], q[6 * 65], q[7 * 65]}, inv);
            *(u32x2*)(dst + (size_t)n * ldd + 64 * kb + 8 * c) = o; }
        asm volatile("s_waitcnt lgkmcnt(0)" ::: "memory");
    }
}
DI void zero_rows(bf16_t* dst, int ld, int r0, int nr, int c0, int nc, int gw, int ngw, int lane) {
    for (int r = gw; r < nr; r += ngw) for (int c = lane * 8; c < nc; c += 512) *(u32x4*)(dst + (size_t)(r0 + r) * ld + c0 + c) = (u32x4){0u, 0u, 0u, 0u};
}

DI void phase_prologue(const Frame& F, CArgs& A) {
    unsigned char* ws = A.ws;
    LAS float* sc = (LAS float*)F.lds;
    LAS float* part = (LAS float*)(F.lds + 32768);
    for (int i = F.tid; i < 8192; i += NTHR) sc[i] = siluf_(A.in[1][i]);
    __syncthreads();
    float* MOD = (float*)(ws + WS_MOD);
    for (int item = F.bid; item < 192; item += F.G) {
        const int l = item / 96, n0 = (item % 96) * 64, nl = F.tid & 63, kg = F.tid >> 6;
        const float* W = A.in[3] + (size_t)l * 1024 * 6144 + n0 + nl;
        float acc[8];
#pragma unroll
        for (int b = 0; b < 8; ++b) acc[b] = 0.f;
        for (int k = kg * 128; k < kg * 128 + 128; ++k) { const float w = W[(size_t)k * 6144];
#pragma unroll
            for (int b = 0; b < 8; ++b) acc[b] += sc[b * 1024 + k] * w; }
#pragma unroll
        for (int b = 0; b < 8; ++b) part[(kg * 8 + b) * 64 + nl] = acc[b];
        __syncthreads();
        { const int b = F.tid >> 6; float s = A.in[4][l * 6144 + n0 + nl];
#pragma unroll
          for (int g = 0; g < 8; ++g) s += part[(g * 8 + b) * 64 + nl];
          MOD[((size_t)l * 8 + b) * 6144 + n0 + nl] = s; }
        __syncthreads();
    }
    LAS float* scr = (LAS float*)(F.lds + F.wave * 16896);
    bf16_t* WIN = (bf16_t*)(ws + WS_WIN); bf16_t* WOUT = (bf16_t*)(ws + WS_WOUT); bf16_t* WMLA = (bf16_t*)(ws + WS_WMLA); bf16_t* WGLU = (bf16_t*)(ws + WS_WGLU);
    constexpr int I_IN = 0, I_INT = 0, I_OUT = 16 * 16, I_Q = 4 * 6, I_KV = 2 * 8, I_GLU = 4 * 4, I_L = I_IN + I_INT + I_OUT + I_Q + I_KV + I_GLU;
    for (int it = F.gw; it < 2 * I_L; it += F.ngw) {
        const int l = it / I_L; int r = it % I_L;
        if (r < I_IN) { transpose_item64(A.in[6] + (size_t)l * 1024 * D_IN, D_IN, 64 * (r / 32), 64 * (r % 32), WIN + (size_t)l * ZS * 1024, 1024, 64 * (r % 32), 64 * (r / 32), scr, F.lane); continue; } r -= I_IN;
        if (r < I_INT) { transpose_item(A.in[6] + (size_t)l * 1024 * D_IN, D_IN, 64 * r, 2048, WIN + (size_t)l * ZS * 1024, 1024, 2048, 64 * r, scr, F.lane); continue; } r -= I_INT;
        if (r < I_OUT) { transpose_item64(A.in[42] + (size_t)l * 1024 * 1024, 1024, 64 * (r / 16), 64 * (r % 16), WOUT + (size_t)l * 1024 * 1024, 1024, 64 * (r % 16), 64 * (r / 16), scr, F.lane); continue; } r -= I_OUT;
        if (r < I_Q) { transpose_item64(A.in[29] + (size_t)l * 256 * 384, 384, 64 * (r / 6), 64 * (r % 6), WMLA + (size_t)l * 1024 * 512, 512, 64 * (r % 6), 64 * (r / 6), scr, F.lane); continue; } r -= I_Q;
        if (r < I_KV) { transpose_item64(A.in[31] + (size_t)l * 128 * 512, 512, 64 * (r / 8), 64 * (r % 8), WMLA + (size_t)l * 1024 * 512, 512, 384 + 64 * (r % 8), 256 + 64 * (r / 8), scr, F.lane); continue; } r -= I_KV;
        transpose_item64(A.in[26] + (size_t)l * 256 * 256, 256, 64 * (r / 4), 64 * (r % 4), WGLU + (size_t)l * 256 * 256, 256, 64 * (r % 4), 64 * (r / 4), scr, F.lane);
    }
    { unsigned* CM = (unsigned*)(ws + WS_CTL) + CW_COLMAX;
      for (int it = F.gw; it < 2 * 32 * 2 * 128; it += F.ngw) { const int le = it >> 8, which = (it >> 7) & 1, kb = (it >> 3) & 15, nb = it & 7;
          const float* src = (which ? A.in[49] : A.in[48]) + (size_t)le * 1024 * 512 + (size_t)(64 * kb + (F.lane >> 4)) * 512 + 64 * nb + 4 * (F.lane & 15);
          float mx[4] = {0.f, 0.f, 0.f, 0.f};
#pragma unroll
          for (int i = 0; i < 16; ++i) { const f32x4 v = *(const f32x4*)(src + (size_t)(4 * i) * 512);
              mx[0] = fmaxf(mx[0], fabsf(v[0])); mx[1] = fmaxf(mx[1], fabsf(v[1])); mx[2] = fmaxf(mx[2], fabsf(v[2])); mx[3] = fmaxf(mx[3], fabsf(v[3])); }
#pragma unroll
          for (int q = 0; q < 4; ++q) { mx[q] = fmaxf(mx[q], shfl_xor_l(mx[q], 16, F.lane)); mx[q] = fmaxf(mx[q], shfl_xor_l(mx[q], 32, F.lane)); }
          if (F.lane < 16) { const int n0 = 64 * nb + 4 * F.lane, np = 256 * (n0 >> 7) + (n0 & 127) + 128 * which;
#pragma unroll
              for (int q = 0; q < 4; ++q) atomicMax(CM + (size_t)le * 1024 + np + q, __float_as_uint(mx[q])); } } }
    { unsigned* IM = (unsigned*)(ws + WS_CTL) + CW_INMAX;
      for (int it = F.gw; it < 2 * 16 * 33; it += F.ngw) { const int l = it / (16 * 33), r = it % (16 * 33), kb = r / 33, nb = r % 33;
          const int c4 = 64 * nb + 4 * (F.lane & 15); const bool okc = c4 < D_IN;
          const float* src = A.in[6] + (size_t)l * 1024 * D_IN + (size_t)(64 * kb + (F.lane >> 4)) * D_IN + c4;
          float mx[4] = {0.f, 0.f, 0.f, 0.f};
#pragma unroll
          for (int i = 0; i < 16; ++i) { f32x4 v = {0.f, 0.f, 0.f, 0.f}; if (okc) v = *(const f32x4*)(src + (size_t)(4 * i) * D_IN);
              mx[0] = fmaxf(mx[0], fabsf(v[0])); mx[1] = fmaxf(mx[1], fabsf(v[1])); mx[2] = fmaxf(mx[2], fabsf(v[2])); mx[3] = fmaxf(mx[3], fabsf(v[3])); }
#pragma unroll
          for (int q = 0; q < 4; ++q) { mx[q] = fmaxf(mx[q], shfl_xor_l(mx[q], 16, F.lane)); mx[q] = fmaxf(mx[q], shfl_xor_l(mx[q], 32, F.lane)); }
          if (F.lane < 16) {
#pragma unroll
              for (int q = 0; q < 4; ++q) atomicMax(IM + l * ZS + c4 + q, __float_as_uint(mx[q])); } }
      for (int l = 0; l < 2; ++l) {
          signed char* w8 = (signed char*)(ws + WS_WIN) + ((size_t)l * ZS + 2112) * 1024;
          for (int i = F.bid * NTHR + F.tid; i < 192 * 1024 / 16; i += F.G * NTHR) *(u32x4*)(w8 + (size_t)i * 16) = (u32x4){0u, 0u, 0u, 0u};
          for (int i = F.bid * NTHR + F.tid; i < 192; i += F.G * NTHR) ((float*)(ws + WS_WINSC))[l * ZS + 2112 + i] = 0.f; } }
    { bf16_t* WR = (bf16_t*)(ws + WS_WR);
      for (int i = F.bid * NTHR + F.tid; i < 2 * 48 * 1024; i += F.G * NTHR) { const int l = i / (48 * 1024), n = (i / 1024) % 48, k = i % 1024;
          const float v = n < 4 ? A.in[44][((size_t)l * 1024 + k) * 4 + n] : n < 36 ? A.in[46][((size_t)l * 1024 + k) * 32 + (n - 4)] : 0.f;
          const unsigned hi = f2bf(v); const float rem = v - __uint_as_float(hi << 16);
          WR[((size_t)(l * 2 + 0) * 48 + n) * 1024 + k] = (bf16_t)hi; WR[((size_t)(l * 2 + 1) * 48 + n) * 1024 + k] = (bf16_t)f2bf(rem); } }
    { bf16_t* WL = (bf16_t*)(ws + WS_WLRU); bf16_t* WO = (bf16_t*)(ws + WS_WLORA);
      for (int i = F.bid * NTHR + F.tid; i < 2 * 2 * 4 * 4096; i += F.G * NTHR) { const int l = i >> 15, wh = (i >> 14) & 1, n = (i >> 12) & 3, j = (i >> 6) & 63, k = i & 63;
          WL[i] = (bf16_t)f2bf((wh ? A.in[38] : A.in[36])[((size_t)(l * 4 + n) * 64 + k) * 64 + j]); }
      for (int i = F.bid * NTHR + F.tid; i < 2 * 32768; i += F.G * NTHR) { const int l = i >> 15, r = i & 32767;
          float v;
          if (r < 8192) v = A.in[9][(size_t)l * 8192 + (r & 31) * 256 + (r >> 5)];
          else if (r < 16384) v = A.in[11][(size_t)l * 8192 + ((r - 8192) & 31) * 256 + ((r - 8192) >> 5)];
          else v = A.in[12][(size_t)l * 16384 + ((r - 16384) & 63) * 256 + ((r - 16384) >> 6)];
          WO[i] = (bf16_t)f2bf(v); } }
    { bf16_t* BBt = (bf16_t*)(ws + WS_S5BB); bf16_t* CCt = (bf16_t*)(ws + WS_S5CC);
      for (int i = F.bid * NTHR + F.tid; i < 2 * 16 * 64; i += F.G * NTHR) { const int lg = i >> 6, p = i & 63;
          const float dt = __expf(A.in[25][lg]); const float lre = A.in[18][lg * 64 + p], lim = A.in[19][lg * 64 + p];
          const float mag = expf(lre * dt); float sn, cn; sincosf(lim * dt, &sn, &cn);
          const float are = mag * cn, aim = mag * sn, den = lre * lre + lim * lim;
          const float qre = ((are - 1.f) * lre + aim * lim) / den, qim = (aim * lre - (are - 1.f) * lim) / den;
          const float* br = A.in[20] + ((size_t)lg * 64 + p) * 16; const float* bi = A.in[21] + ((size_t)lg * 64 + p) * 16;
          for (int c = 0; c < 16; ++c) { const float x = br[c], y = bi[c];
              BBt[(((size_t)lg * 2 + 0) * 64 + p) * 16 + c] = (bf16_t)f2bf(qre * x - qim * y); BBt[(((size_t)lg * 2 + 1) * 64 + p) * 16 + c] = (bf16_t)f2bf(qre * y + qim * x); } }
      for (int i = F.bid * NTHR + F.tid; i < 2 * 16 * 16 * 128; i += F.G * NTHR) { const int lg = i >> 11, ii = (i >> 7) & 15, k = i & 127;
          CCt[i] = (bf16_t)f2bf(k < 64 ? A.in[22][((size_t)lg * 16 + ii) * 64 + k] : -A.in[23][((size_t)lg * 16 + ii) * 64 + (k - 64)]); } }
    for (int l = 0; l < 2; ++l) {
        bf16_t* wm = WMLA + (size_t)l * 1024 * 512;
        zero_rows(wm, 512, 0, 384, 256, 256, F.gw, F.ngw, F.lane);
        zero_rows(wm, 512, 384, 512, 0, 256, F.gw, F.ngw, F.lane);
        zero_rows(wm, 512, 384, 512, 384, 128, F.gw, F.ngw, F.lane);
        zero_rows(wm, 512, 896, 128, 0, 512, F.gw, F.ngw, F.lane);
    }
}

DI void phase_win_quant(const Frame& F, CArgs& A) {
    LAS float* scr = (LAS float*)(F.lds + F.wave * 16640);
    const unsigned* IM = (const unsigned*)(A.ws + WS_CTL) + CW_INMAX;
    for (int it = F.gw; it < 2 * 16 * 33; it += F.ngw) { const int l = it / (16 * 33), r = it % (16 * 33), kb = r / 33, nb = r % 33;
        quant_item64(A.in[6] + (size_t)l * 1024 * D_IN, D_IN, 64 * kb, 64 * nb, (signed char*)(A.ws + WS_WIN) + (size_t)l * ZS * 1024, 1024, 64 * nb, 64 * kb, IM + l * ZS + 64 * nb,
                     kb == 0 ? (float*)(A.ws + WS_WINSC) + l * ZS + 64 * nb : (float*)nullptr, scr, F.lane, D_IN); }
}
DI void phase_norm1(const Frame& F, CArgs& A, int l) {
    const float* MODL = (const float*)(A.ws + WS_MOD) + (size_t)l * 8 * 6144;
    const float* g = A.in[5] + l * 1024;
    const bf16_t* Y = (const bf16_t*)(A.ws + WS_Y);
    signed char* H8 = (signed char*)(A.ws + WS_H); float* HS = (float*)(A.ws + WS_HSC);
    const float* src = (l == 0) ? A.in[0] : A.out;
    for (int row0 = 2 * F.gw; row0 < T; row0 += 2 * F.ngw) {
        const int b = row0 / SEQ;
        f32x4 v[2][4]; u32x2 ya[2][4], yb[2][4];
#pragma unroll
        for (int r = 0; r < 2; ++r)
#pragma unroll
            for (int j = 0; j < 4; ++j) { const int col = 4 * (64 * j + F.lane); v[r][j] = *(const f32x4*)(src + (size_t)(row0 + r) * DM + col);
                if (l > 0) { ya[r][j] = *(const u32x2*)(Y + (size_t)(2 * (row0 + r)) * DM + col); yb[r][j] = *(const u32x2*)(Y + (size_t)(2 * (row0 + r) + 1) * DM + col); } }
#pragma unroll
        for (int r = 0; r < 2; ++r) {
            const int row = row0 + r; float ss = 0.f;
#pragma unroll
            for (int j = 0; j < 4; ++j) { const int col = 4 * (64 * j + F.lane);
                if (l > 0) { const u32x2 y0 = ya[r][j], y1 = yb[r][j];
                    v[r][j][0] += bflo(y0.x) + bflo(y1.x); v[r][j][1] += bfhi(y0.x) + bfhi(y1.x); v[r][j][2] += bflo(y0.y) + bflo(y1.y); v[r][j][3] += bfhi(y0.y) + bfhi(y1.y);
                    *(f32x4*)(A.out + (size_t)row * DM + col) = v[r][j]; }
                ss += v[r][j][0] * v[r][j][0] + v[r][j][1] * v[r][j][1] + v[r][j][2] * v[r][j][2] + v[r][j][3] * v[r][j][3]; }
            const float rstd = rsqrtf(wave_sum(ss) * (1.f / DM) + NORM_EPS);
#pragma unroll
            for (int j = 0; j < 4; ++j) { const int col = 4 * (64 * j + F.lane);
                const f32x4 gg = *(const f32x4*)(g + col), sh = *(const f32x4*)(MODL + (size_t)b * 6144 + col), scv = *(const f32x4*)(MODL + (size_t)b * 6144 + 1024 + col);
                v[r][j] = v[r][j] * rstd * gg * (scv + 1.f) + sh; }
            float mx = 0.f;
#pragma unroll
            for (int j = 0; j < 4; ++j) mx = fmaxf(mx, fmaxf(fmaxf(fabsf(v[r][j][0]), fabsf(v[r][j][1])), fmaxf(fabsf(v[r][j][2]), fabsf(v[r][j][3]))));
            mx = fmaxf(wave_max(mx), 1e-30f); const float inv = 127.f / mx;
            if (F.lane == 0) HS[row] = mx * (1.f / 127.f);
#pragma unroll
            for (int j = 0; j < 4; ++j) *(unsigned*)(H8 + (size_t)row * DM + 4 * (64 * j + F.lane)) = q8x4(v[r][j], inv);
        }
    }
}

DI void phase_mla_prep(const Frame& F, CArgs& A, int l) {
    const bf16_t* Z = (const bf16_t*)(A.ws + WS_Z); bf16_t* AM = (bf16_t*)(A.ws + WS_AMLA);
    const float* qg = A.in[28] + l * 256; const float* kg = A.in[30] + l * 128;
    for (int row = F.gw; row < T; row += F.ngw) {
        const bf16_t* zr = Z + (size_t)row * ZS;
        const u32x2 qv = *(const u32x2*)(zr + ZC_QA + 4 * F.lane); const unsigned kv = *(const unsigned*)(zr + ZC_KVA + 2 * F.lane);
        const float q0 = bflo(qv.x), q1 = bfhi(qv.x), q2 = bflo(qv.y), q3 = bfhi(qv.y), k0 = bflo(kv), k1 = bfhi(kv);
        const float rq = rsqrtf(wave_sum(q0 * q0 + q1 * q1 + q2 * q2 + q3 * q3) * (1.f / 256.f) + NORM_EPS);
        const float rk = rsqrtf(wave_sum(k0 * k0 + k1 * k1) * (1.f / 128.f) + NORM_EPS);
        const f32x4 g4 = *(const f32x4*)(qg + 4 * F.lane); const f32x2 g2 = *(const f32x2*)(kg + 2 * F.lane);
        u32x2 o; o.x = pk2(q0 * rq * g4[0], q1 * rq * g4[1]); o.y = pk2(q2 * rq * g4[2], q3 * rq * g4[3]);
        bf16_t* ar = AM + (size_t)row * 512;
        *(u32x2*)(ar + 4 * F.lane) = o;
        *(unsigned*)(ar + 256 + 2 * F.lane) = pk2(k0 * rk * g2[0], k1 * rk * g2[1]);
        *(unsigned*)(ar + 384 + 2 * F.lane) = 0u;
    }
}

DI void phase_mla_post(const Frame& F, CArgs& A, int l) {
    const bf16_t* Z = (const bf16_t*)(A.ws + WS_Z); const bf16_t* RAW = (const bf16_t*)(A.ws + WS_QKVRAW);
    bf16_t* Q = (bf16_t*)(A.ws + WS_Q); bf16_t* K = (bf16_t*)(A.ws + WS_K); bf16_t* VT = (bf16_t*)(A.ws + WS_VT);
    LAS float* cs = (LAS float*)F.lds;
    LAS bf16_t* vt = (LAS bf16_t*)(F.lds + 8192);
    const float* qhg = A.in[32] + l * 96; const float* khg = A.in[33] + l * 96;
    for (int tile = F.bid; tile < T / 64; tile += F.G) {
        const int t0 = tile * 64, b = t0 / SEQ, s0 = t0 % SEQ;
        int tz = F.tid; asm volatile("" : "+v"(tz));
        for (int idx = tz; idx < 1024; idx += NTHR) { const int tok = idx >> 4, i = idx & 15;
            const int pos = A.pos_off[b] + s0 + tok; const float inv = powf(10000.f, -(float)i * (1.f / 16.f));
            double ang = (double)(float)pos * (double)inv; ang -= 6.283185307179586 * floor(ang * 0.15915494309189535);
            float sn, cn; sincosf((float)ang, &sn, &cn); cs[idx * 2] = cn; cs[idx * 2 + 1] = sn; }
        lds_barrier();
        const int tok = tz >> 3, sub = tz & 7, h = sub >> 1, isk = sub & 1, t = t0 + tok;
        {
            float v[96];
            const bf16_t* p0 = isk ? RAW + (size_t)t * 1024 + 384 + 128 * h : RAW + (size_t)t * 1024 + 96 * h;
            const bf16_t* p1 = isk ? Z + (size_t)t * ZS + ZC_KPE : p0 + 64;
#pragma unroll
            for (int c = 0; c < 8; ++c) { const u32x4 w = *(const u32x4*)(p0 + 8 * c);
                v[8 * c] = bflo(w.x); v[8 * c + 1] = bfhi(w.x); v[8 * c + 2] = bflo(w.y); v[8 * c + 3] = bfhi(w.y); v[8 * c + 4] = bflo(w.z); v[8 * c + 5] = bfhi(w.z); v[8 * c + 6] = bflo(w.w); v[8 * c + 7] = bfhi(w.w); }
#pragma unroll
            for (int c = 0; c < 4; ++c) { const u32x4 w = *(const u32x4*)(p1 + 8 * c);
                v[64 + 8 * c] = bflo(w.x); v[65 + 8 * c] = bfhi(w.x); v[66 + 8 * c] = bflo(w.y); v[67 + 8 * c] = bfhi(w.y); v[68 + 8 * c] = bflo(w.z); v[69 + 8 * c] = bfhi(w.z); v[70 + 8 * c] = bflo(w.w); v[71 + 8 * c] = bfhi(w.w); }
            float ss = 0.f;
#pragma unroll
            for (int i = 0; i < 96; ++i) ss += v[i] * v[i];
            const float r = rsqrtf(ss * (1.f / 96.f) + NORM_EPS) * (isk ? 1.f : 0.10206207261596577f * 1.4426950408889634f);
            const float* hg = isk ? khg : qhg;
#pragma unroll
            for (int i = 0; i < 96; ++i) v[i] = v[i] * r * hg[i];
#pragma unroll
            for (int i = 0; i < 16; ++i) { const float cn = cs[(tok * 16 + i) * 2], sn = cs[(tok * 16 + i) * 2 + 1]; const float x1 = v[64 + i], x2 = v[80 + i];
                v[64 + i] = x1 * cn - x2 * sn; v[80 + i] = x1 * sn + x2 * cn; }
            bf16_t* dst = (isk ? K : Q) + ((size_t)t * 4 + h) * 96;
#pragma unroll
            for (int c = 0; c < 12; ++c) { u32x4 w; w.x = pk2(v[8 * c], v[8 * c + 1]); w.y = pk2(v[8 * c + 2], v[8 * c + 3]); w.z = pk2(v[8 * c + 4], v[8 * c + 5]); w.w = pk2(v[8 * c + 6], v[8 * c + 7]);
                *(u32x4*)(dst + 8 * c) = w; }
        }
        {
            const bf16_t* pv = RAW + (size_t)t * 1024 + 384 + 128 * h + 64 + 32 * isk;
#pragma unroll
            for (int c = 0; c < 4; ++c) { const u32x4 w = *(const u32x4*)(pv + 8 * c); const int r0 = h * 64 + 32 * isk + 8 * c;
                vt[(r0 + 0) * 72 + tok] = (bf16_t)(w.x & 0xffffu); vt[(r0 + 1) * 72 + tok] = (bf16_t)(w.x >> 16);
                vt[(r0 + 2) * 72 + tok] = (bf16_t)(w.y & 0xffffu); vt[(r0 + 3) * 72 + tok] = (bf16_t)(w.y >> 16);
                vt[(r0 + 4) * 72 + tok] = (bf16_t)(w.z & 0xffffu); vt[(r0 + 5) * 72 + tok] = (bf16_t)(w.z >> 16);
                vt[(r0 + 6) * 72 + tok] = (bf16_t)(w.w & 0xffffu); vt[(r0 + 7) * 72 + tok] = (bf16_t)(w.w >> 16); }
        }
        lds_barrier();
        { const int row = tz >> 1, hf = tz & 1;
          bf16_t* dst = VT + ((size_t)(b * 4) * 64 + row) * SEQ + s0 + 32 * hf;
#pragma unroll
          for (int c = 0; c < 4; ++c) *(u32x4*)(dst + 8 * c) = *(const LAS u32x4*)(vt + row * 72 + 32 * hf + 8 * c); }
        lds_barrier();
    }
}

DI void attn_unit(const Frame& F, const bf16_t* Q, const bf16_t* K, const bf16_t* VT, bf16_t* O, int bh, int u, float eoff) {
    constexpr int KP = 208, VP = 144, KB = 64 * KP, VB = 64 * VP;
    LAS unsigned char* Ks = F.lds; LAS unsigned char* Vs = F.lds + 2 * KB;
    int tz = F.tid; asm volatile("" : "+v"(tz));
    const int b = bh >> 2, h = bh & 3, lane = tz & 63, w = F.wave, ql = lane & 31, hh = lane >> 5;
    const int ntile = 8 * u + 8, myl = 8 * u + w;
    const size_t tq0 = (size_t)b * SEQ + 512 * u + 64 * w + ql;
    bf16x8 qf[2][6];
#pragma unroll
    for (int qt = 0; qt < 2; ++qt)
#pragma unroll
        for (int s = 0; s < 6; ++s) qf[qt][s] = *(const bf16x8*)(Q + ((tq0 + 32 * qt) * 4 + h) * 96 + 16 * s + 8 * hh);
    f32x16 ot[2][2];
#pragma unroll
    for (int i = 0; i < 16; ++i) { ot[0][0][i] = 0.f; ot[0][1][i] = 0.f; ot[1][0][i] = 0.f; ot[1][1][i] = 0.f; }
    float lrun[2] = {0.f, 0.f};
    const float neoff = -eoff;
    const int kp0 = tz, kp1 = tz + 512;
    const size_t kbase = ((size_t)b * SEQ * 4 + h) * 96;
    const bf16_t* vsrc = VT + ((size_t)bh * 64 + (tz >> 3)) * SEQ + 8 * (tz & 7);
    u32x4 rk0, rk1, rv;
    rk1 = (u32x4){0u, 0u, 0u, 0u};
#define ATT_LOAD(j) do { rk0 = *(const u32x4*)(K + kbase + (size_t)(64 * (j) + kp0 / 12) * 384 + 8 * (kp0 % 12)); \
        if (kp1 < 768) rk1 = *(const u32x4*)(K + kbase + (size_t)(64 * (j) + kp1 / 12) * 384 + 8 * (kp1 % 12)); \
        rv = *(const u32x4*)(vsrc + 64 * (j)); } while (0)
#define ATT_STORE(jj) do { *(LAS u32x4*)(Ks + ((jj) & 1) * KB + (kp0 / 12) * KP + (kp0 % 12) * 16) = rk0; \
        if (kp1 < 768) *(LAS u32x4*)(Ks + ((jj) & 1) * KB + (kp1 / 12) * KP + (kp1 % 12) * 16) = rk1; \
        *(LAS u32x4*)(Vs + ((jj) % 3) * VB + (tz >> 3) * VP + (tz & 7) * 16) = rv; } while (0)
#define ATT_PV(vb, ktp) do { _Pragma("unroll") for (int c = 0; c < 2; ++c) { const int key0 = 32 * (ktp) + 16 * c + 4 * hh; \
        _Pragma("unroll") for (int dt = 0; dt < 2; ++dt) { const LAS unsigned char* vp = Vs + (vb) * VB + (32 * dt + ql) * VP + key0 * 2; \
            const u32x2 v0 = *(const LAS u32x2*)vp, v1 = *(const LAS u32x2*)(vp + 16); u32x4 vw; vw.x = v0.x; vw.y = v0.y; vw.z = v1.x; vw.w = v1.y; const bf16x8 vf = __builtin_bit_cast(bf16x8, vw); \
            ot[dt][0] = __builtin_amdgcn_mfma_f32_32x32x16_bf16(vf, pfo[0][c], ot[dt][0], 0, 0, 0); ot[dt][1] = __builtin_amdgcn_mfma_f32_32x32x16_bf16(vf, pfo[1][c], ot[dt][1], 0, 0, 0); } } } while (0)
#define ATT_SM() do { _Pragma("unroll") for (int qt = 0; qt < 2; ++qt) { f32x2 ps = {0.f, 0.f}; \
        _Pragma("unroll") for (int i = 0; i < 16; i += 2) { const float p0 = __builtin_amdgcn_exp2f(st[qt][i]), p1 = __builtin_amdgcn_exp2f(st[qt][i + 1]); st[qt][i] = p0; st[qt][i + 1] = p1; ps += (f32x2){p0, p1}; } \
        lrun[qt] += ps[0] + ps[1]; \
        _Pragma("unroll") for (int c = 0; c < 2; ++c) { u32x4 pw; pw.x = pk2(st[qt][8 * c], st[qt][8 * c + 1]); pw.y = pk2(st[qt][8 * c + 2], st[qt][8 * c + 3]); pw.z = pk2(st[qt][8 * c + 4], st[qt][8 * c + 5]); pw.w = pk2(st[qt][8 * c + 6], st[qt][8 * c + 7]); \
            pfn[qt][c] = __builtin_bit_cast(bf16x8, pw); } } } while (0)
#define ATT_MIX() do { _Pragma("unroll") for (int g_ = 0; g_ < 4; ++g_) { __builtin_amdgcn_sched_group_barrier(0x100, 2, 0); __builtin_amdgcn_sched_group_barrier(0x008, 1, 0); __builtin_amdgcn_sched_group_barrier(0x002, 14, 0); \
        __builtin_amdgcn_sched_group_barrier(0x008, 1, 0); __builtin_amdgcn_sched_group_barrier(0x002, 14, 0); } } while (0)
    ATT_LOAD(0); ATT_STORE(0);
    lds_barrier();
    bf16x8 pfo[2][2], pfn[2][2];
    bool owed = false;
    for (int j = 0; j < ntile; ++j) {
        if (j + 1 < ntile) ATT_LOAD(j + 1);
        if (j <= myl) {
#pragma unroll
            for (int kt = 0; kt < 2; ++kt) {
                f32x16 st[2];
#pragma unroll
                for (int i = 0; i < 16; ++i) { st[0][i] = neoff; st[1][i] = neoff; }
#pragma unroll
                for (int s = 0; s < 6; ++s) { const bf16x8 kf = *(const LAS bf16x8*)(Ks + (j & 1) * KB + (32 * kt + ql) * KP + (16 * s + 8 * hh) * 2);
                    st[0] = __builtin_amdgcn_mfma_f32_32x32x16_bf16(kf, qf[0][s], st[0], 0, 0, 0);
                    st[1] = __builtin_amdgcn_mfma_f32_32x32x16_bf16(kf, qf[1][s], st[1], 0, 0, 0); }
                __builtin_amdgcn_sched_barrier(0);
                if (kt == 0) { if (owed) { ATT_PV((j + 2) % 3, 1); ATT_SM(); ATT_MIX(); } else { ATT_SM(); } }
                else { ATT_PV(j % 3, 0); ATT_SM(); ATT_MIX(); }
                __builtin_amdgcn_sched_barrier(0);
#pragma unroll
                for (int qt = 0; qt < 2; ++qt) { pfo[qt][0] = pfn[qt][0]; pfo[qt][1] = pfn[qt][1]; }
            }
            owed = true;
        } else if (owed) { ATT_PV(myl % 3, 1); owed = false; }
        if (j + 1 < ntile) ATT_STORE(j + 1);
        lds_barrier();
    }
    if (owed) ATT_PV(myl % 3, 1);
#undef ATT_LOAD
#undef ATT_STORE
#undef ATT_PV
#undef ATT_SM
#undef ATT_MIX
    int lz2 = lane; asm volatile("" : "+v"(lz2));
    const unsigned tqe = (unsigned)(b * SEQ + 512 * u + 64 * w + (lz2 & 31));
#pragma unroll
    for (int qt = 0; qt < 2; ++qt) {
        const float linv = 1.f / (lrun[qt] + shfl_xor_l(lrun[qt], 32, lane));
        bf16_t* orow = O + (size_t)(tqe + 32 * qt) * 256 + h * 64;
#pragma unroll
        for (int dt = 0; dt < 2; ++dt)
#pragma unroll
            for (int g = 0; g < 4; ++g) { u32x2 o; o.x = pk2(ot[dt][qt][4 * g] * linv, ot[dt][qt][4 * g + 1] * linv); o.y = pk2(ot[dt][qt][4 * g + 2] * linv, ot[dt][qt][4 * g + 3] * linv);
                *(u32x2*)(orow + 32 * dt + 8 * g + 4 * hh) = o; }
    }
    lds_barrier();
}
DI void phase_attn(const Frame& F, CArgs& A, int l) {
    const bf16_t* Q = (const bf16_t*)(A.ws + WS_Q); const bf16_t* K = (const bf16_t*)(A.ws + WS_K); const bf16_t* VT = (const bf16_t*)(A.ws + WS_VT);
    bf16_t* O = (bf16_t*)(A.ws + WS_ATTO);
    float gq = 0.f, gk = 0.f;
    for (int i = 0; i < 96; ++i) { gq = fmaxf(gq, fabsf(A.in[32][l * 96 + i])); gk = fmaxf(gk, fabsf(A.in[33][l * 96 + i])); }
    const float eoff = 96.f * gq * gk * 0.10206207261596577f * 1.4426950408889634f * 1.0001f;
    for (int p = F.bid; p < 256; p += F.G) { const int bh = p >> 3, u = p & 7;
        attn_unit(F, Q, K, VT, O, bh, 15 - u, eoff);
        attn_unit(F, Q, K, VT, O, bh, u, eoff); }
}
DI f32x16 mfma32(bf16x8 a, bf16x8 b, f32x16 c) { return __builtin_amdgcn_mfma_f32_32x32x16_bf16(a, b, c, 0, 0, 0); }
DI bf16x8 ldfrag(const LAS unsigned char* base, int row, int ks, int h) { return *(const LAS bf16x8*)(base + row * 144 + (16 * ks + 8 * h) * 2); }
DI f32x16 zero16() { f32x16 z;
#pragma unroll
    for (int i = 0; i < 16; ++i) z[i] = 0.f;
    return z; }
DI bf16x8 pack8(const f32x16& x, int o) { u32x4 p; p.x = pk2(x[o], x[o + 1]); p.y = pk2(x[o + 2], x[o + 3]); p.z = pk2(x[o + 4], x[o + 5]); p.w = pk2(x[o + 6], x[o + 7]); return __builtin_bit_cast(bf16x8, p); }
DI f32x16 tileprod(const LAS unsigned char* Aimg, int a0, const LAS unsigned char* Bimg, int b0, f32x16 acc, int lr, int h2) {
#pragma unroll
    for (int ks = 0; ks < 4; ++ks) acc = mfma32(ldfrag(Aimg, a0 + lr, ks, h2), ldfrag(Bimg, b0 + lr, ks, h2), acc);
    return acc;
}
DI void put_tile(LAS unsigned char* img, int c0, int r0, const f32x16& a, int lr, int h2) {
#pragma unroll
    for (int g = 0; g < 4; ++g) { u32x2 o; o.x = pk2(a[4 * g], a[4 * g + 1]); o.y = pk2(a[4 * g + 2], a[4 * g + 3]); *(LAS u32x2*)(img + (c0 + lr) * 144 + (r0 + 8 * g + 4 * h2) * 2) = o; }
}
DI void phase_rwkv_A(const Frame& F, CArgs& A, int l) {
    const bf16_t* Z = (const bf16_t*)(A.ws + WS_Z); bf16_t* V_ = (bf16_t*)(A.ws + WS_RW_V); bf16_t* G_ = (bf16_t*)(A.ws + WS_RW_G);
    const float* mu = A.in[7] + l * 896; const float* w0 = A.in[8] + l * 256; const float* a0 = A.in[10] + l * 256; const float* k_k = A.in[13] + l * 256; const float* k_a = A.in[14] + l * 256;
    const bf16_t* WO = (const bf16_t*)(A.ws + WS_WLORA) + (size_t)l * 32768;
    bf16_t* RP = (bf16_t*)(A.ws + WS_RC_RP); float* Y0T = (float*)(A.ws + WS_RC_Y0); unsigned char* REC = A.ws + WS_RC_G;
    float* BSUM = (float*)(A.ws + WS_RC_BS);
    const float* r_k = A.in[15] + l * 256;
    constexpr int TB = 64 * 144;
#define TILE(i) (F.lds + (i) * TB)
    LAS float* XF = (LAS float*)TILE(13);
    const int w = F.wave;
    for (int ub = F.bid; ub < 1024; ub += F.G) {
      const int b = ub >> 7, c = ub & 127;
      const size_t t0 = (size_t)b * SEQ + 64 * c;
      bf16x8 xf[4];
      {
        int tid = F.tid; asm volatile("" : "+v"(tid)); const int lane = tid & 63, fr = lane & 15, fq = lane >> 4, mt = w & 3;
        const int tk = 16 * mt + fr; const size_t t = t0 + tk; const bool hp = (64 * c + tk) > 0;
        const bf16_t* zr = Z + t * ZS + ZC_WLO + 8 * fq;
#pragma unroll
        for (int ks = 0; ks < 4; ++ks) {
            const u32x4 zc = *(const u32x4*)(zr + 32 * ks); u32x4 zp = {0u, 0u, 0u, 0u}; if (hp) zp = *(const u32x4*)(zr + 32 * ks - ZS);
            const f32x4 m0 = *(const f32x4*)(mu + ZC_WLO + 32 * ks + 8 * fq), m1 = *(const f32x4*)(mu + ZC_WLO + 32 * ks + 8 * fq + 4);
            const unsigned cw[4] = {zc.x, zc.y, zc.z, zc.w}, pw[4] = {zp.x, zp.y, zp.z, zp.w}; const float mm[8] = {m0[0], m0[1], m0[2], m0[3], m1[0], m1[1], m1[2], m1[3]};
            float v[8];
#pragma unroll
            for (int i = 0; i < 8; ++i) { const float zcv = (i & 1) ? bfhi(cw[i >> 1]) : bflo(cw[i >> 1]), zpv = (i & 1) ? bfhi(pw[i >> 1]) : bflo(pw[i >> 1]);
                float x = zcv + (zpv - zcv) * mm[i]; if (ks == 0) x = fast_tanh(x); else if (ks >= 2) x = sigmoidf_(x); v[i] = x; }
            u32x4 o; o.x = pk2(v[0], v[1]); o.y = pk2(v[2], v[3]); o.z = pk2(v[4], v[5]); o.w = pk2(v[6], v[7]); xf[ks] = __builtin_bit_cast(bf16x8, o);
        }
      }
      for (int hd = 0; hd < 4; ++hd) {
        const int u = (b * 4 + hd) * 128 + c;
        {
        int tid = F.tid; asm volatile("" : "+v"(tid)); const int lane = tid & 63, fr = lane & 15, fq = lane >> 4, mt = w & 3, nh = w >> 2;
        const int tk = 16 * mt + fr; const size_t t = t0 + tk; const bool hp = (64 * c + tk) > 0;
        LAS float* hs = (LAS float*)TILE(12);
        f32x4 aw[2], aa[2], ag[2];
        {
#pragma unroll
            for (int nf = 0; nf < 2; ++nf) { const int ch = hd * 64 + 32 * nh + 8 * (fr >> 2) + 4 * nf + (fr & 3);     const f32x4 z4 = {0.f, 0.f, 0.f, 0.f};
                aw[nf] = __builtin_amdgcn_mfma_f32_16x16x32_bf16(*(const bf16x8*)(WO + ch * 32 + 8 * fq), xf[0], z4, 0, 0, 0);
                aa[nf] = __builtin_amdgcn_mfma_f32_16x16x32_bf16(*(const bf16x8*)(WO + 8192 + ch * 32 + 8 * fq), xf[1], z4, 0, 0, 0);
                ag[nf] = __builtin_amdgcn_mfma_f32_16x16x32_bf16(*(const bf16x8*)(WO + 16384 + ch * 64 + 8 * fq), xf[2], z4, 0, 0, 0);
                ag[nf] = __builtin_amdgcn_mfma_f32_16x16x32_bf16(*(const bf16x8*)(WO + 16384 + ch * 64 + 32 + 8 * fq), xf[3], ag[nf], 0, 0, 0); }
        }
        f32x4 rr[2], kq[2], km[2], vv4[2], lw4[2], a4[2];
        float ssq = 0.f, bsp = 0.f;
#pragma unroll
        for (int nf = 0; nf < 2; ++nf) { const int d4 = 32 * nh + 8 * fq + 4 * nf, ch4 = hd * 64 + d4;
            const u32x2 rc = *(const u32x2*)(Z + t * ZS + ZC_R + ch4), kc = *(const u32x2*)(Z + t * ZS + ZC_K + ch4), vc = *(const u32x2*)(Z + t * ZS + ZC_V + ch4);
            u32x2 rp = {0u, 0u}, kp = {0u, 0u}, vp = {0u, 0u};
            if (hp) { rp = *(const u32x2*)(Z + (t - 1) * ZS + ZC_R + ch4); kp = *(const u32x2*)(Z + (t - 1) * ZS + ZC_K + ch4); vp = *(const u32x2*)(Z + (t - 1) * ZS + ZC_V + ch4); }
            const f32x4 mr = *(const f32x4*)(mu + ZC_R + ch4), mk = *(const f32x4*)(mu + ZC_K + ch4), mv = *(const f32x4*)(mu + ZC_V + ch4), ka = *(const f32x4*)(k_a + ch4), kkw = *(const f32x4*)(k_k + ch4), rk4 = *(const f32x4*)(r_k + ch4);
            const f32x4 rcv = {bflo(rc.x), bfhi(rc.x), bflo(rc.y), bfhi(rc.y)}, rpv = {bflo(rp.x), bfhi(rp.x), bflo(rp.y), bfhi(rp.y)};
            const f32x4 kcv = {bflo(kc.x), bfhi(kc.x), bflo(kc.y), bfhi(kc.y)}, kpv = {bflo(kp.x), bfhi(kp.x), bflo(kp.y), bfhi(kp.y)};
            const f32x4 vcv = {bflo(vc.x), bfhi(vc.x), bflo(vc.y), bfhi(vc.y)}, vpv = {bflo(vp.x), bfhi(vp.x), bflo(vp.y), bfhi(vp.y)};
            const f32x4 r = rcv + (rpv - rcv) * mr, k = kcv + (kpv - kcv) * mk, v = vcv + (vpv - vcv) * mv;
            const f32x4 wv = aw[nf] + *(const f32x4*)(w0 + ch4), av = aa[nf] + *(const f32x4*)(a0 + ch4);
#pragma unroll
            for (int i = 0; i < 4; ++i) { lw4[nf][i] = -__expf(-fast_softplus(-wv[i]) - 0.5f); a4[nf][i] = sigmoidf_(av[i]); kq[nf][i] = k[i] * kkw[i]; km[nf][i] = k[i] * (1.f + (a4[nf][i] - 1.f) * ka[i]);
                ssq += kq[nf][i] * kq[nf][i]; bsp += r[i] * km[nf][i] * rk4[i]; }
            rr[nf] = r; vv4[nf] = v;
            *(LAS f32x4*)(XF + tk * 64 + d4) = lw4[nf];
            u32x2 p; p.x = pk2(ag[nf][0], ag[nf][1]); p.y = pk2(ag[nf][2], ag[nf][3]); *(u32x2*)(G_ + t * 256 + ch4) = p;
            p.x = pk2(v[0], v[1]); p.y = pk2(v[2], v[3]); *(u32x2*)(V_ + t * 256 + ch4) = p;
        }
        ssq += shfl_xor_l(ssq, 16, lane); ssq += shfl_xor_l(ssq, 32, lane); bsp += shfl_xor_l(bsp, 16, lane); bsp += shfl_xor_l(bsp, 32, lane);
        if (fq == 0) { hs[nh * 64 + tk] = ssq; hs[128 + nh * 64 + tk] = bsp; }
        lds_barrier();
        if (w == 0) { float cv[64];
#pragma unroll
            for (int i = 0; i < 64; ++i) cv[i] = XF[i * 64 + lane];
            float run = 0.f;
#pragma unroll
            for (int i = 0; i < 64; ++i) { run += cv[i]; XF[i * 64 + lane] = run; } }
        if (w == 1) BSUM[(t0 + lane) * 4 + hd] = hs[128 + lane] + hs[192 + lane];
        lds_barrier();
        const float rn = rsqrtf(fmaxf(hs[tk] + hs[64 + tk], 1e-24f));
#pragma unroll
        for (int nf = 0; nf < 2; ++nf) { const int d4 = 32 * nh + 8 * fq + 4 * nf;
            const f32x4 cum = *(const LAS f32x4*)(XF + tk * 64 + d4), c63 = *(const LAS f32x4*)(XF + 63 * 64 + d4);
            f32x4 al, bt, kt, rb, bhh, khh;
#pragma unroll
            for (int i = 0; i < 4; ++i) { const float kk = kq[nf][i] * rn; const float ec = __expf(cum[i]), em = __builtin_amdgcn_rcpf(ec), ep = __expf(cum[i] - lw4[nf][i]), p63 = __expf(c63[i]);
                al[i] = -kk * ep; bt[i] = kk * a4[nf][i] * em; kt[i] = km[nf][i] * em; rb[i] = rr[nf][i] * ec; bhh[i] = bt[i] * p63; khh[i] = kt[i] * p63;
                if (tk == 63) *(float*)(REC + (size_t)u * RC_REC + 24576 + (d4 + i) * 4) = p63; }
            u32x2 o;
            o.x = pk2(al[0], al[1]); o.y = pk2(al[2], al[3]); *(LAS u32x2*)(TILE(0) + tk * 144 + d4 * 2) = o;
            o.x = pk2(bt[0], bt[1]); o.y = pk2(bt[2], bt[3]); *(LAS u32x2*)(TILE(1) + tk * 144 + d4 * 2) = o;
            o.x = pk2(kt[0], kt[1]); o.y = pk2(kt[2], kt[3]); *(LAS u32x2*)(TILE(2) + tk * 144 + d4 * 2) = o;
            o.x = pk2(rb[0], rb[1]); o.y = pk2(rb[2], rb[3]); *(LAS u32x2*)(TILE(3) + tk * 144 + d4 * 2) = o;
#pragma unroll
            for (int i = 0; i < 4; ++i) { *(LAS bf16_t*)(TILE(4) + (d4 + i) * 144 + tk * 2) = (bf16_t)f2bf(vv4[nf][i]); *(LAS bf16_t*)(TILE(5) + (d4 + i) * 144 + tk * 2) = (bf16_t)f2bf(bhh[i]);
                *(LAS bf16_t*)(TILE(6) + (d4 + i) * 144 + tk * 2) = (bf16_t)f2bf(khh[i]); *(LAS bf16_t*)(TILE(7) + (d4 + i) * 144 + tk * 2) = (bf16_t)f2bf(al[i]); }
        }
        }
        lds_barrier();
        f32x16 Tacc = zero16();
        {
        int tl = F.tid; asm volatile("" : "+v"(tl)); const int lane = tl & 63, lr = lane & 31, h2 = lane >> 5;
        unsigned zz = 0u; asm volatile("" : "+v"(zz));
        for (int i = tl; i < 768; i += NTHR) { const int q = i >> 7, rr = (i & 127) >> 2, cc = i & 3; const int tile = q < 4 ? 8 + q : q == 4 ? 14 : 12;
            *(LAS u32x4*)(TILE(tile) + (q == 5 ? (32 + rr) * 144 : rr * 144 + 64) + cc * 16) = (u32x4){zz, zz, zz, zz}; }
#pragma unroll
        for (int rnd = 0; rnd < 2; ++rnd) {
            const int j = w + 8 * rnd;
            if (j < 15) {
                const int prod = j / 3, tile = j % 3, si = tile == 2 ? 1 : 0, ti = tile == 0 ? 0 : 1;
                if (prod == 1) {
                    f32x16 acc = tileprod(TILE(0), 32 * ti, TILE(1), 32 * si, zero16(), lr, h2);
                    const int ss = 32 * si + lr;
#pragma unroll
                    for (int q = 0; q < 16; ++q) { const int tt = 32 * ti + 8 * (q >> 2) + 4 * h2 + (q & 3); if (!(ss < tt)) acc[q] = 0.f; }
                    put_tile(TILE(12), 32 * si, 32 * ti, acc, lr, h2);
                } else {
                    const LAS unsigned char* Ao = (prod == 0 || prod == 3) ? TILE(1) : TILE(2); const LAS unsigned char* Bo = prod >= 3 ? TILE(3) : TILE(0);
                    f32x16 acc = tileprod(Ao, 32 * si, Bo, 32 * ti, zero16(), lr, h2);
                    const int tt = 32 * ti + lr, incl = prod >= 3 ? 1 : 0;
#pragma unroll
                    for (int q = 0; q < 16; ++q) { const int ss = 32 * si + 8 * (q >> 2) + 4 * h2 + (q & 3); if (!(ss < tt + incl)) acc[q] = 0.f; }
                    if (prod == 0) { put_tile(TILE(11), 32 * ti, 32 * si, acc, lr, h2);
#pragma unroll
                        for (int q = 0; q < 16; ++q) { const int ss = 32 * si + 8 * (q >> 2) + 4 * h2 + (q & 3); Tacc[q] = acc[q] + (ss == tt ? 1.f : 0.f); }
                        put_tile(TILE(14), 32 * ti, 32 * si, Tacc, lr, h2);
                    } else put_tile(TILE(prod == 2 ? 8 : prod == 3 ? 9 : 10), 32 * ti, 32 * si, acc, lr, h2);
                }
            }
        }
        }
        lds_barrier();
        {
        int tl = F.tid; asm volatile("" : "+v"(tl)); const int lane = tl & 63, lr = lane & 31, h2 = lane >> 5;
        if (tl < 384) { const int q = tl >> 7, rr = (tl & 127) >> 2, cc = tl & 3;
            unsigned zz = 0u; asm volatile("" : "+v"(zz));
            *(LAS u32x4*)(TILE(q) + (q == 1 ? (32 + rr) * 144 : rr * 144 + 64) + cc * 16) = (u32x4){zz, zz, zz, zz}; }
        lds_barrier();
#pragma unroll
        for (int k = 1; k <= 5; ++k) {
            LAS unsigned char* Ss = (k & 1) ? TILE(11) : TILE(0); LAS unsigned char* STs = (k & 1) ? TILE(12) : TILE(1);
            LAS unsigned char* Sd = (k & 1) ? TILE(0) : TILE(11); LAS unsigned char* STd = (k & 1) ? TILE(1) : TILE(12);
            LAS unsigned char* Ts = (k & 1) ? TILE(14) : TILE(2); LAS unsigned char* Td = (k & 1) ? TILE(2) : TILE(14);
            if (w < 6) { const int tile = w % 3, ti = tile == 0 ? 0 : 1, si = tile == 2 ? 1 : 0;
                if (w < 3) { f32x16 acc = tileprod(Ss, 32 * ti, STs, 32 * si, zero16(), lr, h2); put_tile(STd, 32 * si, 32 * ti, acc, lr, h2); }
                else { f32x16 acc = tileprod(STs, 32 * si, Ss, 32 * ti, zero16(), lr, h2); put_tile(Sd, 32 * ti, 32 * si, acc, lr, h2); }
            } else if (k == 1) {
#pragma unroll
                for (int jj = 0; jj < 2; ++jj) { const int tile = (w - 6) * 2 + jj, ti = tile >> 1, ei = tile & 1;
                    f32x16 acc = tileprod(TILE(8), 32 * ti, TILE(4), 32 * ei, zero16(), lr, h2); put_tile(TILE(13), 32 * ei, 32 * ti, acc, lr, h2); }
            }
            lds_barrier();
            if (w < 3) { const int si = w == 2 ? 1 : 0, ti = w == 0 ? 0 : 1;
                Tacc = tileprod(STd, 32 * si, Ts, 32 * ti, Tacc, lr, h2); put_tile(Td, 32 * ti, 32 * si, Tacc, lr, h2); }
        }
        lds_barrier();
        { const int tile = w & 3, ti = tile >> 1, ci = tile & 1;
          f32x16 acc = tileprod(TILE(2), 32 * ti, w < 4 ? TILE(13) : TILE(7), 32 * ci, zero16(), lr, h2); put_tile(w < 4 ? TILE(11) : TILE(12), 32 * ci, 32 * ti, acc, lr, h2); }
        }
        lds_barrier();
        {
        int tl = F.tid; asm volatile("" : "+v"(tl)); const int lane = tl & 63, lr = lane & 31, h2 = lane >> 5; const int tj = w & 3, ta = tj >> 1, tb = tj & 1;
        if (w < 4) {
            { f32x16 acc = tileprod(TILE(12), 32 * ta, TILE(9), 32 * tb, zero16(), lr, h2);
              const int tt = 32 * tb + lr;
#pragma unroll
              for (int g = 0; g < 4; ++g) { const int dd = 32 * ta + 8 * g + 4 * h2; const u32x2 rbv = *(const LAS u32x2*)(TILE(3) + tt * 144 + dd * 2);
                  u32x2 o; o.x = pk2(acc[4 * g] + bflo(rbv.x), acc[4 * g + 1] + bfhi(rbv.x)); o.y = pk2(acc[4 * g + 2] + bflo(rbv.y), acc[4 * g + 3] + bfhi(rbv.y));
                  *(u32x2*)(RP + ((size_t)u * 64 + tt) * 64 + dd) = o; } }
            { f32x16 acc = tileprod(TILE(12), 32 * ta, TILE(5), 32 * tb, zero16(), lr, h2);
              const int dcol = 32 * tb + lr;
#pragma unroll
              for (int g = 0; g < 4; ++g) { u32x2 o; o.x = pk2(acc[4 * g], acc[4 * g + 1]); o.y = pk2(acc[4 * g + 2], acc[4 * g + 3]);
                  *(u32x2*)(REC + (size_t)u * RC_REC + ((((dcol >> 4) * 2 + ta) * 64 + (2 * (g & 1) + h2) * 16 + (dcol & 15)) * 16) + 8 * (g >> 1)) = o; } }
        } else {
            f32x16 z2 = tileprod(TILE(4), 32 * ta, TILE(10), 32 * tb, zero16(), lr, h2);
            z2 = tileprod(TILE(11), 32 * ta, TILE(9), 32 * tb, z2, lr, h2);
            float* yo = Y0T + ((size_t)u * 64 + 32 * tb + lr) * 64 + 32 * ta + 4 * h2;
#pragma unroll
            for (int g = 0; g < 4; ++g) *(f32x4*)(yo + 8 * g) = (f32x4){z2[4 * g], z2[4 * g + 1], z2[4 * g + 2], z2[4 * g + 3]};
            f32x16 acc = tileprod(TILE(5), 32 * ta, TILE(11), 32 * tb, zero16(), lr, h2);
            acc = tileprod(TILE(6), 32 * ta, TILE(4), 32 * tb, acc, lr, h2);
            const int ecol = 32 * tb + lr;
#pragma unroll
            for (int g = 0; g < 4; ++g) *(f32x4*)(REC + (size_t)u * RC_REC + 8192 + ((((ecol >> 4) * 4 + 2 * ta + (g >> 1)) * 64 + (2 * (g & 1) + h2) * 16 + (ecol & 15)) * 16)) = (f32x4){acc[4 * g], acc[4 * g + 1], acc[4 * g + 2], acc[4 * g + 3]};
        }
        }
        lds_barrier();
      }
    }
#undef TILE
}
DI void phase_rwkv_B(const Frame& F, CArgs& A) {
    if (F.bid >= 32) return;
    const unsigned char* REC = A.ws + WS_RC_G; bf16_t* HB = (bf16_t*)(A.ws + WS_RC_HB);
    constexpr int SLOT = 25600, NSLOT = 6;
    const int bh = F.bid, w = F.wave, lane = F.lane, fr = lane & 15, fq = lane >> 4;
    const unsigned char* rec0 = REC + (size_t)bh * 128 * RC_REC;
    if (w >= 4) {
        const int lw = w - 4;
#define RB_ISSUE2(cs, cr) do { const unsigned char* r_ = rec0 + (size_t)(cr) * RC_REC; LAS unsigned char* s_ = F.lds + ((cs) % NSLOT) * SLOT; \
        _Pragma("unroll") for (int k = 0; k < 6; ++k) __builtin_amdgcn_global_load_lds((const unsigned*)(r_ + (lw + 4 * k) * 1024 + lane * 16), (LAS unsigned*)(s_ + (lw + 4 * k) * 1024), 16, 0, 0); \
        if (lw == 3) __builtin_amdgcn_global_load_lds((const unsigned*)(r_ + 24576 + lane * 4), (LAS unsigned*)(s_ + 24576), 4, 0, 0); } while (0)
        RB_ISSUE2(0, 0); RB_ISSUE2(1, 1); RB_ISSUE2(2, 2); RB_ISSUE2(3, 3); RB_ISSUE2(4, 4);
        if (lw == 3) asm volatile("s_waitcnt vmcnt(28)" ::: "memory"); else asm volatile("s_waitcnt vmcnt(24)" ::: "memory");
        __builtin_amdgcn_s_barrier();
        for (int c = 0; c < 128; ++c) {
            RB_ISSUE2(c + 5, (c + 5 < 128) ? c + 5 : 127);
            if (lw == 3) asm volatile("s_waitcnt vmcnt(28)" ::: "memory"); else asm volatile("s_waitcnt vmcnt(24)" ::: "memory");
            __builtin_amdgcn_s_barrier();
        }
        asm volatile("s_waitcnt vmcnt(0)" ::: "memory");
#undef RB_ISSUE2
    } else {
        const int ew = w;
        f32x4 acc[4];
#pragma unroll
        for (int dt = 0; dt < 4; ++dt) acc[dt] = (f32x4){0.f, 0.f, 0.f, 0.f};
        __builtin_amdgcn_s_barrier();
        for (int c = 0; c < 128; ++c) {
            const size_t u = (size_t)bh * 128 + c;
            const LAS unsigned char* sl = F.lds + (c % NSLOT) * SLOT;
            bf16x8 hb[2];
#pragma unroll
            for (int sk = 0; sk < 2; ++sk) { u32x4 p; p.x = pk2(acc[2 * sk][0], acc[2 * sk][1]); p.y = pk2(acc[2 * sk][2], acc[2 * sk][3]); p.z = pk2(acc[2 * sk + 1][0], acc[2 * sk + 1][1]); p.w = pk2(acc[2 * sk + 1][2], acc[2 * sk + 1][3]);
                hb[sk] = __builtin_bit_cast(bf16x8, p); *(bf16x8*)(HB + (((u * 4 + ew) * 2 + sk) * 64 + lane) * 8) = hb[sk]; }
#pragma unroll
            for (int dt = 0; dt < 4; ++dt) {
                const f32x4 g4 = *(const LAS f32x4*)(sl + 8192 + ((ew * 4 + dt) * 64 + lane) * 16), d4 = *(const LAS f32x4*)(sl + 24576 + (16 * dt + 4 * fq) * 4);
                const bf16x8 m0 = *(const LAS bf16x8*)(sl + ((dt * 2 + 0) * 64 + lane) * 16), m1 = *(const LAS bf16x8*)(sl + ((dt * 2 + 1) * 64 + lane) * 16);
                f32x4 n = d4 * acc[dt] + g4;
                n = __builtin_amdgcn_mfma_f32_16x16x32_bf16(m0, hb[0], n, 0, 0, 0); n = __builtin_amdgcn_mfma_f32_16x16x32_bf16(m1, hb[1], n, 0, 0, 0); acc[dt] = n; }
            asm volatile("s_waitcnt lgkmcnt(0)" ::: "memory");
            __builtin_amdgcn_s_barrier();
        }
    }
}
DI void phase_rwkv_C(const Frame& F, CArgs& A, int l) {
    const bf16_t* RP = (const bf16_t*)(A.ws + WS_RC_RP); const float* Y0 = (const float*)(A.ws + WS_RC_Y0); const bf16_t* HB = (const bf16_t*)(A.ws + WS_RC_HB); const float* BSUM = (const float*)(A.ws + WS_RC_BS);
    const bf16_t* V_ = (const bf16_t*)(A.ws + WS_RW_V); const bf16_t* G_ = (const bf16_t*)(A.ws + WS_RW_G); bf16_t* MIX = (bf16_t*)(A.ws + WS_MIX);
    const float* ln_w = A.in[16] + l * 256; const float* ln_b = A.in[17] + l * 256;
    for (int job = F.gw; job < 4096; job += F.ngw) {
        int lz = F.lane; asm volatile("" : "+v"(lz)); const int lane = lz, fr = lane & 15, fq = lane >> 4;
        const size_t u = (size_t)job; const int bh = job >> 7, c = job & 127, b = bh >> 2, hd = bh & 3;
        bf16x8 hf[4][2];
#pragma unroll
        for (int et = 0; et < 4; ++et)
#pragma unroll
            for (int sk = 0; sk < 2; ++sk) hf[et][sk] = *(const bf16x8*)(HB + (((u * 4 + et) * 2 + sk) * 64 + lane) * 8);
#pragma unroll
        for (int tb = 0; tb < 4; ++tb) {
            const size_t tok = (size_t)b * SEQ + 64 * c + 16 * tb + fr;
            const bf16_t* rrow = RP + (u * 64 + 16 * tb + fr) * 64 + 4 * fq;
            bf16x8 bfr[2];
#pragma unroll
            for (int sk = 0; sk < 2; ++sk) { const u32x2 m0 = *(const u32x2*)(rrow + 32 * sk), m1 = *(const u32x2*)(rrow + 32 * sk + 16); u32x4 mw; mw.x = m0.x; mw.y = m0.y; mw.z = m1.x; mw.w = m1.y; bfr[sk] = __builtin_bit_cast(bf16x8, mw); }
            f32x4 y[4]; float sm = 0.f;
#pragma unroll
            for (int et = 0; et < 4; ++et) { y[et] = *(const f32x4*)(Y0 + (u * 64 + 16 * tb + fr) * 64 + 16 * et + 4 * fq);
                y[et] = __builtin_amdgcn_mfma_f32_16x16x32_bf16(hf[et][0], bfr[0], y[et], 0, 0, 0); y[et] = __builtin_amdgcn_mfma_f32_16x16x32_bf16(hf[et][1], bfr[1], y[et], 0, 0, 0); }
#pragma unroll
            for (int et = 0; et < 4; ++et) sm += (y[et][0] + y[et][1]) + (y[et][2] + y[et][3]);
            sm += shfl_xor_l(sm, 16, lane); sm += shfl_xor_l(sm, 32, lane); const float mean = sm * (1.f / 64.f);
            float sq = 0.f;
#pragma unroll
            for (int et = 0; et < 4; ++et) { const f32x4 d = y[et] - mean; sq += (d[0] * d[0] + d[1] * d[1]) + (d[2] * d[2] + d[3] * d[3]); }
            sq += shfl_xor_l(sq, 16, lane); sq += shfl_xor_l(sq, 32, lane); const float rstd = rsqrtf(sq * (1.f / 64.f) + 64e-5f);
            const float bs = BSUM[tok * 4 + hd];
#pragma unroll
            for (int et = 0; et < 4; ++et) { const int e0 = hd * 64 + 16 * et + 4 * fq;
                const f32x4 lw = *(const f32x4*)(ln_w + e0), lb = *(const f32x4*)(ln_b + e0);
                const u32x2 vv = *(const u32x2*)(V_ + tok * 256 + e0), gv = *(const u32x2*)(G_ + tok * 256 + e0);
                const float o0 = ((y[et][0] - mean) * rstd * lw[0] + lb[0] + bs * bflo(vv.x)) * bflo(gv.x), o1 = ((y[et][1] - mean) * rstd * lw[1] + lb[1] + bs * bfhi(vv.x)) * bfhi(gv.x);
                const float o2 = ((y[et][2] - mean) * rstd * lw[2] + lb[2] + bs * bflo(vv.y)) * bflo(gv.y), o3 = ((y[et][3] - mean) * rstd * lw[3] + lb[3] + bs * bfhi(vv.y)) * bfhi(gv.y);
                u32x2 o; o.x = pk2(o0, o1); o.y = pk2(o2, o3);
                *(u32x2*)(MIX + tok * DM + e0) = o; }
        }
    }
}

template <int PASS>
DI void phase_s5(const Frame& F, CArgs& A, int l) {
    const bf16_t* Z = (const bf16_t*)(A.ws + WS_Z); float* SEND = (float*)(A.ws + WS_S5END); bf16_t* YS = (bf16_t*)(A.ws + WS_YS5);
    const bf16_t* BBt = (const bf16_t*)(A.ws + WS_S5BB); const bf16_t* CCt = (const bf16_t*)(A.ws + WS_S5CC);
    LAS unsigned char* himg = F.lds + F.wave * 17408;
    for (int it = F.gw; it < 8 * 16 * 16; it += F.ngw) {
        int lz = F.lane; asm volatile("" : "+v"(lz)); const int lane = lz, lr = lane & 31, hh = lane >> 5;
        const int b = it >> 8, g = (it >> 4) & 15, seg = it & 15, lg = l * 16 + g;
        const float dt = __expf(A.in[25][lg]);
        float are[2], aim[2], cr[2], ci[2];
        bf16x8 bbf[2][2];
#pragma unroll
        for (int st = 0; st < 2; ++st) { const int p = 32 * st + lr;
            const float lre = A.in[18][lg * 64 + p], lim = A.in[19][lg * 64 + p]; const float mag = expf(lre * dt); float sn, cn; sincosf(lim * dt, &sn, &cn); are[st] = mag * cn; aim[st] = mag * sn;
            cr[st] = 0.f; ci[st] = 0.f;
            if (PASS == 2) { const float m512 = expf(512.f * lre * dt); float s5, c5; sincosf(512.f * (lim * dt), &s5, &c5); const float pr = m512 * c5, pi_ = m512 * s5;
                for (int j = 0; j < seg; ++j) { const float* e = SEND + ((size_t)((b * 16 + g) * 16 + j)) * 128; const float er = e[p], ei = e[64 + p];
                    const float nr = pr * cr[st] - pi_ * ci[st] + er, ni = pr * ci[st] + pi_ * cr[st] + ei; cr[st] = nr; ci[st] = ni; } }
#pragma unroll
            for (int part = 0; part < 2; ++part) bbf[part][st] = *(const bf16x8*)(BBt + (((size_t)lg * 2 + part) * 64 + p) * 16 + 8 * hh); }
        bf16x8 ccf[4];
        if (PASS == 2) {
#pragma unroll
            for (int ks = 0; ks < 4; ++ks) ccf[ks] = *(const bf16x8*)(CCt + ((size_t)lg * 16 + (lane & 15)) * 128 + 32 * ks + 8 * (lane >> 4)); }
        for (int ch = 0; ch < 8; ++ch) {
            const size_t tok0 = (size_t)b * SEQ + seg * 512 + ch * 64;
#pragma unroll
            for (int tk = 0; tk < 2; ++tk) {
                const bf16x8 uf = *(const bf16x8*)(Z + (tok0 + 32 * tk + lr) * ZS + ZC_S5 + g * 16 + 8 * hh);
                f32x16 xr[2], xi[2];
#pragma unroll
                for (int st = 0; st < 2; ++st) { xr[st] = mfma32(uf, bbf[0][st], zero16()); xi[st] = mfma32(uf, bbf[1][st], zero16()); }
                asm volatile("s_nop 15\n\ts_nop 15" : "+v"(xr[0]), "+v"(xi[0]), "+v"(xr[1]), "+v"(xi[1]));
#pragma unroll
                for (int j = 0; j < 4; ++j) {
#pragma unroll
                    for (int half = 0; half < 2; ++half) {
                        const bool act = (hh == half);
#pragma unroll
                        for (int st = 0; st < 2; ++st) { float tr = cr[st], ti = ci[st];
#pragma unroll
                            for (int q = 0; q < 4; ++q) { const float nr = are[st] * tr - aim[st] * ti + xr[st][4 * j + q], ni = are[st] * ti + aim[st] * tr + xi[st][4 * j + q];
                                tr = nr; ti = ni; xr[st][4 * j + q] = act ? nr : xr[st][4 * j + q]; xi[st][4 * j + q] = act ? ni : xi[st][4 * j + q]; }
                            const float pr = shfl_xor_l(tr, 32, lane), pi2 = shfl_xor_l(ti, 32, lane);
                            cr[st] = act ? tr : pr; ci[st] = act ? ti : pi2; }
                    }
                }
                if (PASS == 2) {
                    unsigned hb = (unsigned)(uintptr_t)(himg + (4 * hh) * 272 + lr * 2); asm volatile("" : "+v"(hb));
                    LAS unsigned char* hp = (LAS unsigned char*)(uintptr_t)hb;
#pragma unroll
                    for (int st = 0; st < 2; ++st)
#pragma unroll
                        for (int q = 0; q < 16; ++q) { const int trow = 32 * tk + 8 * (q >> 2) + (q & 3);
                            *(LAS bf16_t*)(hp + trow * 272 + 64 * st) = (bf16_t)f2bf(xr[st][q]); *(LAS bf16_t*)(hp + trow * 272 + 128 + 64 * st) = (bf16_t)f2bf(xi[st][q]); }
                }
            }
            if (PASS == 2) {
                asm volatile("s_waitcnt lgkmcnt(0)" ::: "memory");
                const int fr = lane & 15, fq = lane >> 4;
                unsigned rb = (unsigned)(uintptr_t)(himg + fr * 272 + fq * 16); asm volatile("" : "+v"(rb)); const LAS unsigned char* rp = (const LAS unsigned char*)(uintptr_t)rb;
#pragma unroll
                for (int m = 0; m < 4; ++m) { f32x4 acc = {0.f, 0.f, 0.f, 0.f};
#pragma unroll
                    for (int ks = 0; ks < 4; ++ks) acc = __builtin_amdgcn_mfma_f32_16x16x32_bf16(ccf[ks], *(const LAS bf16x8*)(rp + (16 * m) * 272 + 64 * ks), acc, 0, 0, 0);
                    const size_t tok = tok0 + 16 * m + fr;
                    const u32x2 uu = *(const u32x2*)(Z + tok * ZS + ZC_S5 + g * 16 + 4 * fq);
                    const f32x4 dd = *(const f32x4*)(A.in[24] + l * 256 + g * 16 + 4 * fq);
                    u32x2 o; o.x = pk2(gelu_tanh(acc[0] + dd[0] * bflo(uu.x)), gelu_tanh(acc[1] + dd[1] * bfhi(uu.x))); o.y = pk2(gelu_tanh(acc[2] + dd[2] * bflo(uu.y)), gelu_tanh(acc[3] + dd[3] * bfhi(uu.y)));
                    *(u32x2*)(YS + tok * 256 + g * 16 + 4 * fq) = o; }
                asm volatile("s_waitcnt lgkmcnt(0)" ::: "memory");
            }
        }
        if (PASS == 1 && hh == 1) {
#pragma unroll
            for (int st = 0; st < 2; ++st) { float* e = SEND + ((size_t)((b * 16 + g) * 16 + seg)) * 128; e[32 * st + lr] = cr[st]; e[64 + 32 * st + lr] = ci[st]; } }
    }
}

DI void phase_lru_prep(const Frame& F, CArgs& A, int l) {
    const bf16_t* Z = (const bf16_t*)(A.ws + WS_Z); float* LA = (float*)(A.ws + WS_LA); float* LB = (float*)(A.ws + WS_LB);
    const float* cw = A.in[34] + l * 4 * 256; const float* cb = A.in[35] + l * 256; const float* ba = A.in[37] + l * 256; const float* bx = A.in[39] + l * 256; const float* lam = A.in[40] + l * 256;
    const bf16_t* WL = (const bf16_t*)(A.ws + WS_WLRU) + (size_t)l * 2 * 4 * 4096;
    LAS float* xs = (LAS float*)F.lds;
    const int w = F.wave, n = w >> 1, hf = w & 1;
    bf16x8 waf[2][2], wxf[2][2];
    { const int fr = F.lane & 15, fq = F.lane >> 4;
#pragma unroll
      for (int nf = 0; nf < 2; ++nf)
#pragma unroll
          for (int ks = 0; ks < 2; ++ks) { const int j = 32 * hf + 16 * nf + fr;
              waf[nf][ks] = *(const bf16x8*)(WL + ((size_t)(0 * 4 + n) * 64 + j) * 64 + 32 * ks + 8 * fq); wxf[nf][ks] = *(const bf16x8*)(WL + ((size_t)(1 * 4 + n) * 64 + j) * 64 + 32 * ks + 8 * fq); } }
    f32x4 c_ba[2], c_bx[2], c_sp[2];
    { const int fq0 = F.lane >> 4;
#pragma unroll
      for (int nf = 0; nf < 2; ++nf) { const int ch4 = n * 64 + 32 * hf + 16 * nf + 4 * fq0; c_ba[nf] = *(const f32x4*)(ba + ch4); c_bx[nf] = *(const f32x4*)(bx + ch4); const f32x4 lm = *(const f32x4*)(lam + ch4);
#pragma unroll
          for (int i = 0; i < 4; ++i) c_sp[nf][i] = -8.f * softplusf_(-lm[i]); } }
    for (int tile = F.bid; tile < T / 64; tile += F.G) {
        int tz = F.tid; asm volatile("" : "+v"(tz)); const int lane = tz & 63, fr = lane & 15, fq = lane >> 4;
        const int t0 = tile * 64, s0 = t0 % SEQ;
        f32x4 accA[4][2], accX[4][2];
#pragma unroll
        for (int m = 0; m < 4; ++m) {
            const int tok = 16 * m + fr, sq = s0 + tok;
            bf16x8 xf[2];
#pragma unroll
            for (int ks = 0; ks < 2; ++ks) { const int ch0 = n * 64 + 32 * ks + 8 * fq;
                const f32x4 b0 = *(const f32x4*)(cb + ch0), b1 = *(const f32x4*)(cb + ch0 + 4);
                float xc[8] = {b0[0], b0[1], b0[2], b0[3], b1[0], b1[1], b1[2], b1[3]};
#pragma unroll
                for (int j = 0; j < 4; ++j) if (sq - 3 + j >= 0) {
                    const u32x4 z8 = *(const u32x4*)(Z + (size_t)(t0 + tok - 3 + j) * ZS + ZC_LX + ch0);
                    const f32x4 c0 = *(const f32x4*)(cw + j * 256 + ch0), c1 = *(const f32x4*)(cw + j * 256 + ch0 + 4);
                    xc[0] += c0[0] * bflo(z8.x); xc[1] += c0[1] * bfhi(z8.x); xc[2] += c0[2] * bflo(z8.y); xc[3] += c0[3] * bfhi(z8.y);
                    xc[4] += c1[0] * bflo(z8.z); xc[5] += c1[1] * bfhi(z8.z); xc[6] += c1[2] * bflo(z8.w); xc[7] += c1[3] * bfhi(z8.w); }
                u32x4 o; o.x = pk2(xc[0], xc[1]); o.y = pk2(xc[2], xc[3]); o.z = pk2(xc[4], xc[5]); o.w = pk2(xc[6], xc[7]); xf[ks] = __builtin_bit_cast(bf16x8, o);
                if (hf == 0) { *(LAS f32x4*)(xs + tok * 260 + ch0) = (f32x4){xc[0], xc[1], xc[2], xc[3]}; *(LAS f32x4*)(xs + tok * 260 + ch0 + 4) = (f32x4){xc[4], xc[5], xc[6], xc[7]}; }
            }
#pragma unroll
            for (int nf = 0; nf < 2; ++nf) { const f32x4 z4 = {0.f, 0.f, 0.f, 0.f};
                accA[m][nf] = __builtin_amdgcn_mfma_f32_16x16x32_bf16(waf[nf][0], xf[0], z4, 0, 0, 0); accA[m][nf] = __builtin_amdgcn_mfma_f32_16x16x32_bf16(waf[nf][1], xf[1], accA[m][nf], 0, 0, 0);
                accX[m][nf] = __builtin_amdgcn_mfma_f32_16x16x32_bf16(wxf[nf][0], xf[0], z4, 0, 0, 0); accX[m][nf] = __builtin_amdgcn_mfma_f32_16x16x32_bf16(wxf[nf][1], xf[1], accX[m][nf], 0, 0, 0); }
        }
        lds_barrier();
#pragma unroll
        for (int m = 0; m < 4; ++m)
#pragma unroll
            for (int nf = 0; nf < 2; ++nf) { const int tok = 16 * m + fr, ch4 = n * 64 + 32 * hf + 16 * nf + 4 * fq;
                const f32x4 xc = *(const LAS f32x4*)(xs + tok * 260 + ch4);
                f32x4 av, bv;
#pragma unroll
                for (int i = 0; i < 4; ++i) { const float r = sigmoidf_(accA[m][nf][i] + c_ba[nf][i]), ig = sigmoidf_(accX[m][nf][i] + c_bx[nf][i]); const float log_a = r * c_sp[nf][i];
                    const float x2 = 2.f * log_a; float em1 = __expf(x2) - 1.f; if (x2 > -0.25f) em1 = x2 * (1.f + x2 * (0.5f + x2 * (0.16666667f + x2 * (0.041666668f + x2 * 0.008333334f))));
                    av[i] = __expf(log_a); bv[i] = __builtin_amdgcn_sqrtf(-em1) * (ig * xc[i]); }
                *(f32x4*)(LA + (size_t)(t0 + tok) * 256 + ch4) = av; *(f32x4*)(LB + (size_t)(t0 + tok) * 256 + ch4) = bv; }
        lds_barrier();
    }
}
DI void phase_lru_sum(const Frame& F, CArgs& A) {
    const float* LA = (const float*)(A.ws + WS_LA); const float* LB = (const float*)(A.ws + WS_LB); float* LS = (float*)(A.ws + WS_LSUM);
    for (int it = F.gw; it < 8 * 128; it += F.ngw) {
        const size_t r0 = (size_t)it * 64;
        f32x4 Ap = {1.f, 1.f, 1.f, 1.f}, Bp = {0.f, 0.f, 0.f, 0.f};
#pragma unroll 8
        for (int t = 0; t < 64; ++t) { const f32x4 a = *(const f32x4*)(LA + (r0 + t) * 256 + 4 * F.lane), bb = *(const f32x4*)(LB + (r0 + t) * 256 + 4 * F.lane); Bp = a * Bp + bb; Ap = Ap * a; }
        *(f32x4*)(LS + ((size_t)it * 2) * 256 + 4 * F.lane) = Ap; *(f32x4*)(LS + ((size_t)it * 2 + 1) * 256 + 4 * F.lane) = Bp;
    }
}
DI void phase_lru_fin(const Frame& F, CArgs& A, int l) {
    const float* LA = (const float*)(A.ws + WS_LA); const float* LB = (const float*)(A.ws + WS_LB); const float* LS = (const float*)(A.ws + WS_LSUM);
    const bf16_t* Z = (const bf16_t*)(A.ws + WS_Z); bf16_t* MIX = (bf16_t*)(A.ws + WS_MIX);
    const f32x4 bg = *(const f32x4*)(A.in[41] + l * 768 + 512 + 4 * F.lane);
    for (int it = F.gw; it < 8 * 128; it += F.ngw) {
        const int b = it >> 7, c = it & 127;
        f32x4 h = {0.f, 0.f, 0.f, 0.f};
        for (int j0 = 0; j0 < c; j0 += 8) {
            f32x4 sa[8], sb[8];
#pragma unroll
            for (int q = 0; q < 8; ++q) { const int j = (j0 + q < c) ? j0 + q : c - 1; sa[q] = *(const f32x4*)(LS + ((size_t)(b * 128 + j) * 2) * 256 + 4 * F.lane); sb[q] = *(const f32x4*)(LS + ((size_t)(b * 128 + j) * 2 + 1) * 256 + 4 * F.lane); }
#pragma unroll
            for (int q = 0; q < 8; ++q) if (j0 + q < c) h = sa[q] * h + sb[q]; }
        const size_t r0 = (size_t)it * 64;
        for (int t0 = 0; t0 < 64; t0 += 8) {
            f32x4 y[8]; float ss[8];
#pragma unroll
            for (int q = 0; q < 8; ++q) { const size_t r = r0 + t0 + q;
                const f32x4 a = *(const f32x4*)(LA + r * 256 + 4 * F.lane), bb = *(const f32x4*)(LB + r * 256 + 4 * F.lane); h = a * h + bb;
                const u32x2 gz = *(const u32x2*)(Z + r * ZS + ZC_LG + 4 * F.lane);
                y[q] = (f32x4){h[0] * gelu_tanh(bflo(gz.x)), h[1] * gelu_tanh(bfhi(gz.x)), h[2] * gelu_tanh(bflo(gz.y)), h[3] * gelu_tanh(bfhi(gz.y))};
                ss[q] = y[q][0] * y[q][0] + y[q][1] * y[q][1] + y[q][2] * y[q][2] + y[q][3] * y[q][3]; }
            const int ln = lane_opaque();
#pragma unroll
            for (int o = 1; o < 64; o <<= 1) {
#pragma unroll
                for (int q = 0; q < 8; ++q) ss[q] += shfl_xor_l(ss[q], o, ln); }
#pragma unroll
            for (int q = 0; q < 8; ++q) { const float r = rsqrtf(ss[q] * (1.f / 256.f) + NORM_EPS);
                u32x2 o; o.x = pk2(y[q][0] * r * bg[0], y[q][1] * r * bg[1]); o.y = pk2(y[q][2] * r * bg[2], y[q][3] * r * bg[3]);
                *(u32x2*)(MIX + (r0 + t0 + q) * DM + 768 + 4 * F.lane) = o; }
        }
    }
}

DI void phase_branch_norm(const Frame& F, CArgs& A, int l) {
    const bf16_t* S0 = (const bf16_t*)(A.ws + WS_YS5G); const bf16_t* S1 = (const bf16_t*)(A.ws + WS_ATTO);
    bf16_t* MIX = (bf16_t*)(A.ws + WS_MIX); const float* bg = A.in[41] + l * 768;
    for (int row0 = 4 * F.gw; row0 < T; row0 += 4 * F.ngw) {
        u32x2 v[4][2];
#pragma unroll
        for (int r = 0; r < 4; ++r) { v[r][0] = *(const u32x2*)(S0 + (size_t)(row0 + r) * 256 + 4 * F.lane); v[r][1] = *(const u32x2*)(S1 + (size_t)(row0 + r) * 256 + 4 * F.lane); }
#pragma unroll
        for (int r = 0; r < 4; ++r)
#pragma unroll
            for (int br = 0; br < 2; ++br) {
                const float x0 = bflo(v[r][br].x), x1 = bfhi(v[r][br].x), x2 = bflo(v[r][br].y), x3 = bfhi(v[r][br].y);
                const float rs = rsqrtf(wave_sum(x0 * x0 + x1 * x1 + x2 * x2 + x3 * x3) * (1.f / 256.f) + NORM_EPS);
                const f32x4 g = *(const f32x4*)(bg + br * 256 + 4 * F.lane);
                u32x2 o; o.x = pk2(x0 * rs * g[0], x1 * rs * g[1]); o.y = pk2(x2 * rs * g[2], x3 * rs * g[3]);
                *(u32x2*)(MIX + (size_t)(row0 + r) * DM + 256 * (br + 1) + 4 * F.lane) = o; }
    }
}

DI void phase_norm2_router(const Frame& F, CArgs& A, int l) {
    const float* MODL = (const float*)(A.ws + WS_MOD) + (size_t)l * 8 * 6144;
    const float* g = A.in[43] + l * 1024;
    signed char* H8 = (signed char*)(A.ws + WS_H); float* H2S = (float*)(A.ws + WS_H2SC);
    int* EID = (int*)(A.ws + WS_RT_EID); float* GATE = (float*)(A.ws + WS_RT_GATE); int* PIE = (int*)(A.ws + WS_RT_PIE);
    unsigned* CNT = (unsigned*)(A.ws + WS_CTL) + CW_CNT + l * 64;
    const bf16_t* WRh = (const bf16_t*)(A.ws + WS_WR) + (size_t)(l * 2) * 48 * 1024; const bf16_t* WRl = WRh + 48 * 1024;
    const float* ROWSS = (const float*)(A.ws + WS_ROWSS);
    LAS float* part = (LAS float*)F.lds;
    LAS float* red = part + 8 * 64 * 48;
    LAS float* lsum = red + 8 * 64;
    LAS unsigned* lcnt = (LAS unsigned*)(lsum + 64 * 36);
    LAS int* lsel = (LAS int*)(lcnt + 64);
    const float* bgp = A.in[45] + l * 4; const float* bep = A.in[47] + l * 32;
    const int w = F.wave, k0 = 128 * w;
    for (int tile = F.bid; tile < T / 64; tile += F.G) {
        int tz = F.tid; asm volatile("" : "+v"(tz)); const int lane = tz & 63, fr = lane & 15, fq = lane >> 4;
        const int row0 = tile * 64, b = row0 / SEQ;
        const unsigned xi = (unsigned)(row0 + fr) * DM + k0 + 8 * fq;
        const float* xb = A.out;
        if (tz < 32) lcnt[tz] = 0u;
        { float m2 = fmaxf(fabsf(MODL[(unsigned)(b * 6144 + 3072 + tz)]), fabsf(MODL[(unsigned)(b * 6144 + 3072 + 512 + tz)])); m2 = wave_max(m2); if (lane == 0) red[w] = m2; }
        lds_barrier();
        float shmax = 0.f;
#pragma unroll
        for (int ww = 0; ww < 8; ++ww) shmax = fmaxf(shmax, red[ww]);
        f32x4 acc[4][3]; float rsv[4], inv8[4];
#pragma unroll
        for (int m = 0; m < 4; ++m) { const float* rp = ROWSS + (unsigned)((row0 + 16 * m + fr) * 32);
            const f32x4 p0 = *(const f32x4*)rp, p1 = *(const f32x4*)(rp + 4), p2 = *(const f32x4*)(rp + 8), p3 = *(const f32x4*)(rp + 12);
            const f32x4 q0 = *(const f32x4*)(rp + 16), q1 = *(const f32x4*)(rp + 20), q2 = *(const f32x4*)(rp + 24), q3 = *(const f32x4*)(rp + 28);
            const float tot = (((p0[0] + p0[1]) + (p0[2] + p0[3])) + ((p1[0] + p1[1]) + (p1[2] + p1[3]))) + (((p2[0] + p2[1]) + (p2[2] + p2[3])) + ((p3[0] + p3[1]) + (p3[2] + p3[3])));
            const float mg = fmaxf(fmaxf(fmaxf(fmaxf(q0[0], q0[1]), fmaxf(q0[2], q0[3])), fmaxf(fmaxf(q1[0], q1[1]), fmaxf(q1[2], q1[3]))), fmaxf(fmaxf(fmaxf(q2[0], q2[1]), fmaxf(q2[2], q2[3])), fmaxf(fmaxf(q3[0], q3[1]), fmaxf(q3[2], q3[3]))));
            rsv[m] = rsqrtf(tot * (1.f / DM) + NORM_EPS);
            const float bound = fmaxf(rsv[m] * mg + shmax, 1e-30f) * 1.0001f;
            inv8[m] = 127.f / bound; if (w == 0 && fq == 0) H2S[(unsigned)(row0 + 16 * m + fr)] = bound * (1.f / 127.f);
#pragma unroll
            for (int n = 0; n < 3; ++n) acc[m][n] = (f32x4){0.f, 0.f, 0.f, 0.f}; }
#pragma unroll
        for (int ks = 0; ks < 4; ++ks) { const int kc = k0 + 32 * ks + 8 * fq;
            const f32x4 g0 = *(const f32x4*)(g + kc), g1 = *(const f32x4*)(g + kc + 4);
            const f32x4 s0 = *(const f32x4*)(MODL + (unsigned)(b * 6144 + 4096 + kc)) + 1.f, s1 = *(const f32x4*)(MODL + (unsigned)(b * 6144 + 4096 + kc + 4)) + 1.f;
            const f32x4 h0 = *(const f32x4*)(MODL + (unsigned)(b * 6144 + 3072 + kc)), h1 = *(const f32x4*)(MODL + (unsigned)(b * 6144 + 3072 + kc + 4));
            bf16x8 blf[3], bhf[3];
#pragma unroll
            for (int n = 0; n < 3; ++n) { blf[n] = *(const bf16x8*)(WRl + (unsigned)((16 * n + fr) * 1024 + kc)); bhf[n] = *(const bf16x8*)(WRh + (unsigned)((16 * n + fr) * 1024 + kc)); }
#pragma unroll
            for (int m = 0; m < 4; ++m) {
                const f32x4 x0 = *(const f32x4*)(xb + (xi + (unsigned)(16 * m * DM + 32 * ks))), x1 = *(const f32x4*)(xb + (xi + (unsigned)(16 * m * DM + 32 * ks + 4)));
                const f32x4 v0 = x0 * rsv[m] * g0 * s0 + h0, v1 = x1 * rsv[m] * g1 * s1 + h1;
                u32x2 o; o.x = q8x4(v0, inv8[m]); o.y = q8x4(v1, inv8[m]); *(u32x2*)(H8 + (unsigned)((row0 + 16 * m + fr) * DM + kc)) = o;
                u32x4 hi; hi.x = pk2(v0[0], v0[1]); hi.y = pk2(v0[2], v0[3]); hi.z = pk2(v1[0], v1[1]); hi.w = pk2(v1[2], v1[3]);
                u32x4 lo; lo.x = pk2(v0[0] - bflo(hi.x), v0[1] - bfhi(hi.x)); lo.y = pk2(v0[2] - bflo(hi.y), v0[3] - bfhi(hi.y)); lo.z = pk2(v1[0] - bflo(hi.z), v1[1] - bfhi(hi.z)); lo.w = pk2(v1[2] - bflo(hi.w), v1[3] - bfhi(hi.w));
                const bf16x8 ah = __builtin_bit_cast(bf16x8, hi), al = __builtin_bit_cast(bf16x8, lo);
#pragma unroll
                for (int n = 0; n < 3; ++n) { acc[m][n] = __builtin_amdgcn_mfma_f32_16x16x32_bf16(ah, bhf[n], acc[m][n], 0, 0, 0);
                    acc[m][n] = __builtin_amdgcn_mfma_f32_16x16x32_bf16(al, bhf[n], acc[m][n], 0, 0, 0); acc[m][n] = __builtin_amdgcn_mfma_f32_16x16x32_bf16(ah, blf[n], acc[m][n], 0, 0, 0); }
            }
            __builtin_amdgcn_sched_barrier(0);
        }
#pragma unroll
        for (int m = 0; m < 4; ++m)
#pragma unroll
            for (int n = 0; n < 3; ++n)
#pragma unroll
                for (int j = 0; j < 4; ++j) part[(w * 64 + 16 * m + 4 * fq + j) * 48 + 16 * n + fr] = acc[m][n][j];
        lds_barrier();
        for (int i = tz; i < 64 * 36; i += NTHR) { const int tok = i / 36, n = i % 36; float a = 0.f;
#pragma unroll
            for (int ww = 0; ww < 8; ++ww) a += part[(ww * 64 + tok) * 48 + n];
            lsum[i] = a; }
        lds_barrier();
        float g0 = 0.f, g1 = 0.f; int e0 = 0, e1 = 0; unsigned r0 = 0, r1 = 0;
        if (tz < 64) {
            const LAS float* L = lsum + tz * 36;
            int gs = 0; float gm = L[0] + bgp[0];
#pragma unroll
            for (int i = 1; i < 4; ++i) { const float v = L[i] + bgp[i]; if (v > gm) { gm = v; gs = i; } }
            float gden = 0.f;
#pragma unroll
            for (int i = 0; i < 4; ++i) gden += expf(L[i] + bgp[i] - gm);
            const float gprob = 1.f / gden;
            int i1 = 0; float v1 = L[4 + gs * 8] + bep[gs * 8];
#pragma unroll
            for (int j = 1; j < 8; ++j) { const float v = L[4 + gs * 8 + j] + bep[gs * 8 + j]; if (v > v1) { v1 = v; i1 = j; } }
            int i2 = -1; float v2 = -INFINITY;
#pragma unroll
            for (int j = 0; j < 8; ++j) { const float v = L[4 + gs * 8 + j] + bep[gs * 8 + j]; if (j != i1 && v > v2) { v2 = v; i2 = j; } }
            const float p2 = expf(v2 - v1);
            g0 = gprob / (1.f + p2); g1 = gprob * p2 / (1.f + p2); e0 = gs * 8 + i1; e1 = gs * 8 + i2;
            r0 = __hip_atomic_fetch_add(lcnt + e0, 1u, __ATOMIC_RELAXED, __HIP_MEMORY_SCOPE_WORKGROUP); r1 = __hip_atomic_fetch_add(lcnt + e1, 1u, __ATOMIC_RELAXED, __HIP_MEMORY_SCOPE_WORKGROUP);
        }
        lds_barrier();
        if (tz < 32) { const unsigned c = lcnt[tz]; lcnt[32 + tz] = c ? atomicAdd(CNT + tz, c) : 0u; }
        lds_barrier();
        if (tz < 64) { const int row = row0 + tz;
            EID[2 * row] = e0; EID[2 * row + 1] = e1; GATE[2 * row] = g0; GATE[2 * row + 1] = g1; PIE[2 * row] = (int)(lcnt[32 + e0] + r0); PIE[2 * row + 1] = (int)(lcnt[32 + e1] + r1); }
        lds_barrier();
    }
}

DI void phase_moe_convert(const Frame& F, CArgs& A, int l, int gw0, int ngw0) {
    LAS float* scr = (LAS float*)(F.lds + F.wave * 16640);
    bf16_t* WM2 = (bf16_t*)(A.ws + WS_WM2);
    for (int it = gw0; it < 32 * 384; it += ngw0) {
        const int e = it / 384; int r = it % 384;
        if (r < 256) { const int which = r >> 7; r &= 127; const int kb = r >> 3, nb = r & 7, n0 = 64 * nb;
            const float* src = (which ? A.in[49] : A.in[48]) + ((size_t)l * 32 + e) * 1024 * 512;
            const int np0 = 256 * (n0 >> 7) + (n0 & 127) + 128 * which;
            quant_item64(src, 512, 64 * kb, n0, (signed char*)(A.ws + WS_WM1) + (size_t)e * 1024 * 1024, 1024, np0, 64 * kb, (const unsigned*)(A.ws + WS_CTL) + CW_COLMAX + ((size_t)l * 32 + e) * 1024 + np0,
                         kb == 0 ? (float*)(A.ws + WS_WM1SC) + (size_t)e * 1024 + np0 : (float*)nullptr, scr, F.lane);
        } else { r -= 256; const int kb = r >> 4, nb = r & 15;
            transpose_item64(A.in[50] + ((size_t)l * 32 + e) * 512 * 1024, 1024, 64 * kb, 64 * nb, WM2 + (size_t)e * 1024 * 512, 512, 64 * nb, 64 * kb, scr, F.lane); }
    }
}

DI void phase_moe_scatter(const Frame& F, CArgs& A, int l) {
    const unsigned* CNT = (const unsigned*)(A.ws + WS_CTL) + CW_CNT + l * 64;
    unsigned* META = (unsigned*)(A.ws + WS_CTL) + CW_UTAB + l * 1024;
    const int* EID = (const int*)(A.ws + WS_RT_EID); const int* PIE = (const int*)(A.ws + WS_RT_PIE); int* SORT = (int*)(A.ws + WS_RT_SORT);
    LAS unsigned* st = (LAS unsigned*)F.lds;
    if (F.tid == 0) { unsigned s = 0; for (int e = 0; e < 32; ++e) { st[e] = s; s += CNT[e]; } }
    __syncthreads();
    if (F.bid == 0 && F.tid == 0) { unsigned nu = 0;
        for (int e = 0; e < 32; ++e) { const unsigned c = CNT[e]; META[1 + e] = st[e]; META[33 + e] = c; for (unsigned bk = 0; bk * 256 < c; ++bk) META[65 + nu++] = ((unsigned)e << 16) | bk; }
        META[0] = nu; }
    for (int a = F.bid * NTHR + F.tid; a < 2 * T; a += F.G * NTHR) SORT[st[EID[a]] + PIE[a]] = a;
}

struct MoeProb1 {
    const char* Hh; const char* WM1; const unsigned* META; const int* SORT; int lda, ldb, nt, G, c;
    DI bool next(int i, pg8::Unit& u) const { const int idx = i * G + c; const int nu = (int)META[0]; if (idx >= nu * 4) return false;
        const unsigned ent = META[65 + (idx >> 2)]; u.pm = idx >> 2; u.pn = idx & 3; u.e = (int)(ent >> 16); u.blk = (int)(ent & 0xffffu); return true; }
    DI const char* a_base(const pg8::Unit&) const { return Hh; }
    DI const char* b_base(const pg8::Unit& u) const { return WM1 + ((size_t)u.e * 1024 + (size_t)u.pn * 256) * 1024; }
    DI unsigned a_off(const pg8::Unit& u, int row) const { const unsigned r = (unsigned)(u.blk * 256 + row), cnt = META[33 + u.e];
        const int a = r < cnt ? SORT[META[1 + u.e] + r] : 0; return (unsigned)(a >> 1) * 1024u; }
};
struct EpiMoe1 {
    static constexpr bool PERM = true;
    bf16_t* HID; const unsigned* META; const int* SORT; const float* H2S; const float* WSC;
    DI void operator()(const i32x4 (&acc)[2][2][4][2], const pg8::Unit& u, int wr, int wc, int fr, int fq) const {
        const unsigned cnt = META[33 + u.e], st = META[1 + u.e];
        const int col0 = 128 * u.pn + wc * 32 + 8 * fq;
        const float* wsp = WSC + (size_t)u.e * 1024 + 256 * u.pn + wc * 32 + 8 * fq;
        const f32x4 s10 = *(const f32x4*)wsp, s11 = *(const f32x4*)(wsp + 4), s30 = *(const f32x4*)(wsp + 128), s31 = *(const f32x4*)(wsp + 132);
#pragma unroll
        for (int ai = 0; ai < 2; ++ai)
#pragma unroll
            for (int m = 0; m < 4; ++m) { const unsigned r = (unsigned)(u.blk * 256 + ai * 128 + wr * 64 + m * 16 + fr);
                if (r < cnt) { const float sa = H2S[SORT[st + r] >> 1];
                    const i32x4 a0 = acc[ai][0][m][0], a1 = acc[ai][0][m][1], b0 = acc[ai][1][m][0], b1 = acc[ai][1][m][1];
                    float h[8];
#pragma unroll
                    for (int i = 0; i < 4; ++i) { h[i] = siluf_((float)a0[i] * sa * s10[i]) * ((float)b0[i] * sa * s30[i]); h[4 + i] = siluf_((float)a1[i] * sa * s11[i]) * ((float)b1[i] * sa * s31[i]); }
                    u32x4 w; w.x = pk2(h[0], h[1]); w.y = pk2(h[2], h[3]); w.z = pk2(h[4], h[5]); w.w = pk2(h[6], h[7]);
                    *(u32x4*)(HID + (size_t)(st + r) * 512 + col0) = w; } }
    }
};
struct MoeProb2 {
    const char* HID; const char* WM2; const unsigned* META; int lda, ldb, nt, G, c;
    DI bool next(int i, pg8::Unit& u) const { const int idx = i * G + c; const int nu = (int)META[0]; if (idx >= nu * 4) return false;
        const unsigned ent = META[65 + (idx >> 2)]; u.pm = idx >> 2; u.pn = idx & 3; u.e = (int)(ent >> 16); u.blk = (int)(ent & 0xffffu); return true; }
    DI const char* a_base(const pg8::Unit& u) const { return HID + ((size_t)META[1 + u.e] + (size_t)u.blk * 256) * 512 * 2; }
    DI const char* b_base(const pg8::Unit& u) const { return WM2 + ((size_t)u.e * 1024 + (size_t)u.pn * 256) * 512 * 2; }
    DI unsigned a_off(const pg8::Unit&, int row) const { return (unsigned)row * 1024u; }
};
struct EpiMoe2 {
    static constexpr bool PERM = true;
    bf16_t* Y; const unsigned* META; const int* SORT; const float* GATE; const float* gt;
    DI void operator()(const f32x4 (&acc)[2][2][4][2], const pg8::Unit& u, int wr, int wc, int fr, int fq) const {
        const unsigned cnt = META[33 + u.e], st = META[1 + u.e];
        const int col0 = 256 * u.pn + wc * 32 + 8 * fq;
        int av[2][4]; float gw[2][4];
#pragma unroll
        for (int ai = 0; ai < 2; ++ai)
#pragma unroll
            for (int m = 0; m < 4; ++m) { const unsigned r = (unsigned)(u.blk * 256 + ai * 128 + wr * 64 + m * 16 + fr); av[ai][m] = r < cnt ? SORT[st + r] : -1; }
#pragma unroll
        for (int ai = 0; ai < 2; ++ai)
#pragma unroll
            for (int m = 0; m < 4; ++m) gw[ai][m] = av[ai][m] >= 0 ? GATE[av[ai][m]] : 0.f;
#pragma unroll
        for (int ai = 0; ai < 2; ++ai)
#pragma unroll
            for (int m = 0; m < 4; ++m) { const int a = av[ai][m];
                if (a >= 0) { const int b = (a >> 1) / SEQ; const float g = gw[ai][m];
#pragma unroll
                    for (int bj = 0; bj < 2; ++bj) { const f32x4 g0 = *(const f32x4*)(gt + (size_t)b * 6144 + col0 + bj * 128), g1 = *(const f32x4*)(gt + (size_t)b * 6144 + col0 + bj * 128 + 4);
                        const f32x4 v0 = acc[ai][bj][m][0] * g0 * g, v1 = acc[ai][bj][m][1] * g1 * g;
                        u32x4 w; w.x = pk2(v0[0], v0[1]); w.y = pk2(v0[2], v0[3]); w.z = pk2(v1[0], v1[1]); w.w = pk2(v1[2], v1[3]);
                        *(u32x4*)(Y + (size_t)a * DM + col0 + bj * 128) = w; } } }
    }
};

DI void phase_final(const Frame& F, CArgs& A) {
    const bf16_t* Y = (const bf16_t*)(A.ws + WS_Y);
    const size_t N4 = (size_t)T * DM / 4, stride = (size_t)F.G * NTHR;
    for (size_t i0 = (size_t)F.bid * NTHR + F.tid; i0 < N4; i0 += 4 * stride) {
        f32x4 v[4]; u32x2 y0[4], y1[4];
#pragma unroll
        for (int k = 0; k < 4; ++k) { const size_t i = i0 + k * stride; if (i < N4) { const size_t row = i >> 8, col = (i & 255) * 4;
            v[k] = *(const f32x4*)(A.out + row * DM + col); y0[k] = *(const u32x2*)(Y + (2 * row) * DM + col); y1[k] = *(const u32x2*)(Y + (2 * row + 1) * DM + col); } }
#pragma unroll
        for (int k = 0; k < 4; ++k) { const size_t i = i0 + k * stride; if (i < N4) { const size_t row = i >> 8, col = (i & 255) * 4;
            v[k][0] += bflo(y0[k].x) + bflo(y1[k].x); v[k][1] += bfhi(y0[k].x) + bfhi(y1[k].x); v[k][2] += bflo(y0[k].y) + bflo(y1[k].y); v[k][3] += bfhi(y0[k].y) + bfhi(y1[k].y);
            *(f32x4*)(A.out + row * DM + col) = v[k]; } }
    }
}

#ifndef REPMASK
#define REPMASK 0u
#endif
constexpr int NPL = 14, NPH = 1 + 2 * NPL + 1;
__global__ void __launch_bounds__(NTHR, 2) mk_fwd(Args args) {
    extern __shared__ __attribute__((aligned(16))) unsigned char lds_raw[];
    LAS unsigned char* const ldsb = (LAS unsigned char*)lds_raw;
    const int wave0 = __builtin_amdgcn_readfirstlane(threadIdx.x >> 6);
    volatile LAS unsigned* MISC = (volatile LAS unsigned*)(ldsb + MISC_OFF);
    if (threadIdx.x < 64) MISC[threadIdx.x] = 0u;
    __syncthreads();
    XcdBarrier bar; bar.bar = (unsigned*)(args.ws + WS_CTL) + CW_BAR; bar.x = 0; bar.st = nullptr;
    if (args.use_bar) bar = xcd_barrier_post((unsigned*)(args.ws + WS_CTL) + CW_BAR, MISC + 8);
    const int lo = args.ph_lo, hi = args.ph_hi;
#define IN(k) (lo <= (k) && (k) < hi)
#define SEAM(k) do { if (IN(k) && IN((k) + 1)) xcd_barrier(bar); } while (0)
    unsigned char* ws = args.ws;
    if (IN(0)) { const Frame F = make_frame(ldsb, wave0); CArgs& AA = *get_args(); phase_prologue(F, AA); } SEAM(0);
    for (int l = 0; l < DEPTH; ++l) {
        const int pb = 1 + l * NPL;
        const float* MODL = (const float*)(ws + WS_MOD) + (size_t)l * 8 * 6144;
        if (IN(pb + 0)) { { const Frame F = make_frame(ldsb, wave0); CArgs& AA = *get_args(); phase_norm1(F, AA, l); } if (l == 0) { const Frame F = make_frame(ldsb, wave0); CArgs& AA = *get_args(); phase_win_quant(F, AA); } } SEAM(pb + 0);
        if (IN(pb + 1)) { const Frame F = make_frame(ldsb, wave0); CArgs& AA = *get_args(); pg8::PlainProb P{(const char*)(ws + WS_H), (const char*)(ws + WS_WIN) + (size_t)l * ZS * 1024, 512, 512, 8, 256, 9, F.G, F.bid};
            EpiBf16I8 E{(bf16_t*)(ws + WS_Z), ZS, (const float*)(ws + WS_HSC), (const float*)(ws + WS_WINSC) + l * ZS}; pg8::gemm_phase<true, true>(F.lds, P, E, F.tid); } SEAM(pb + 1);
        if (IN(pb + 2)) { { const Frame F = make_frame(ldsb, wave0); CArgs& AA = *get_args(); phase_mla_prep(F, AA, l); } { const Frame F = make_frame(ldsb, wave0); CArgs& AA = *get_args(); phase_s5<1>(F, AA, l); } { const Frame F = make_frame(ldsb, wave0); CArgs& AA = *get_args(); phase_lru_prep(F, AA, l); } } SEAM(pb + 2);
        if (IN(pb + 3)) { { const Frame F = make_frame(ldsb, wave0); CArgs& AA = *get_args(); pg8::PlainProb P{(const char*)(ws + WS_AMLA), (const char*)(ws + WS_WMLA) + (size_t)l * 1024 * 512 * 2, 512, 512, 8, 256, 4, F.G, F.bid};
            EpiBf16Plain E{(bf16_t*)(ws + WS_QKVRAW), 1024}; pg8::gemm_phase(F.lds, P, E, F.tid); } { const Frame F = make_frame(ldsb, wave0); CArgs& AA = *get_args(); phase_lru_sum(F, AA); } } SEAM(pb + 3);
        if (IN(pb + 4)) { { const Frame F = make_frame(ldsb, wave0); CArgs& AA = *get_args(); phase_mla_post(F, AA, l); } { const Frame F = make_frame(ldsb, wave0); CArgs& AA = *get_args(); phase_lru_fin(F, AA, l); } } SEAM(pb + 4);
        if (IN(pb + 5)) { { const Frame F = make_frame(ldsb, wave0); CArgs& AA = *get_args(); phase_attn(F, AA, l); } lds_barrier(); { const Frame F = make_frame(ldsb, wave0); CArgs& AA = *get_args(); phase_s5<2>(F, AA, l); } } SEAM(pb + 5);
        if (IN(pb + 6)) { { const Frame F = make_frame(ldsb, wave0); CArgs& AA = *get_args(); phase_rwkv_A(F, AA, l); } lds_barrier(); { const Frame F = make_frame(ldsb, wave0); CArgs& AA = *get_args(); pg8::PlainProb P{(const char*)(ws + WS_YS5), (const char*)(ws + WS_WGLU) + (size_t)l * 256 * 256 * 2, 256, 256, 4, 256, 1, F.G, F.bid};
            EpiGlu E{(const bf16_t*)(ws + WS_YS5), (bf16_t*)(ws + WS_YS5G), AA.in[27] + l * 256}; pg8::gemm_phase(F.lds, P, E, F.tid); } } SEAM(pb + 6);
        if (IN(pb + 7)) { const Frame F = make_frame(ldsb, wave0); CArgs& AA = *get_args(); if (F.bid < 32) phase_rwkv_B(F, AA); else phase_moe_convert(F, AA, l, (F.bid - 32) * NWAVES + F.wave, (F.G - 32) * NWAVES); } SEAM(pb + 7);
        if (IN(pb + 8)) { { const Frame F = make_frame(ldsb, wave0); CArgs& AA = *get_args(); phase_rwkv_C(F, AA, l); } { const Frame F = make_frame(ldsb, wave0); CArgs& AA = *get_args(); phase_branch_norm(F, AA, l); } } SEAM(pb + 8);
        if (IN(pb + 9)) { const Frame F = make_frame(ldsb, wave0); CArgs& AA = *get_args(); pg8::PlainProb P{(const char*)(ws + WS_MIX), (const char*)(ws + WS_WOUT) + (size_t)l * 1024 * 1024 * 2, 1024, 1024, 16, 256, 4, F.G, F.bid};
            EpiResGate E{l == 0 ? AA.in[0] : AA.out, AA.out, MODL + 2048, (float*)(ws + WS_ROWSS), AA.in[43] + l * 1024}; pg8::gemm_phase(F.lds, P, E, F.tid); } SEAM(pb + 9);
        if (IN(pb + 10)) { const Frame F = make_frame(ldsb, wave0); CArgs& AA = *get_args(); phase_norm2_router(F, AA, l); } SEAM(pb + 10);
        if (IN(pb + 11)) { const Frame F = make_frame(ldsb, wave0); CArgs& AA = *get_args(); phase_moe_scatter(F, AA, l); } SEAM(pb + 11);
        const unsigned* META = (const unsigned*)(ws + WS_CTL) + CW_UTAB + l * 1024;
        if (IN(pb + 12)) { const Frame F = make_frame(ldsb, wave0); CArgs& AA = *get_args(); MoeProb1 P{(const char*)(ws + WS_H), (const char*)(ws + WS_WM1), META, (const int*)(ws + WS_RT_SORT), 512, 512, 8, F.G, F.bid};
            EpiMoe1 E{(bf16_t*)(ws + WS_HID), META, (const int*)(ws + WS_RT_SORT), (const float*)(ws + WS_H2SC), (const float*)(ws + WS_WM1SC)}; pg8::gemm_phase<true, true>(F.lds, P, E, F.tid); } SEAM(pb + 12);
        if (IN(pb + 13)) { const Frame F = make_frame(ldsb, wave0); CArgs& AA = *get_args(); MoeProb2 P{(const char*)(ws + WS_HID), (const char*)(ws + WS_WM2), META, 512, 512, 8, F.G, F.bid};
            EpiMoe2 E{(bf16_t*)(ws + WS_Y), META, (const int*)(ws + WS_RT_SORT), (const float*)(ws + WS_RT_GATE), MODL + 5120}; pg8::gemm_phase(F.lds, P, E, F.tid); } SEAM(pb + 13);
    }
    if (IN(NPH - 1)) { const Frame F = make_frame(ldsb, wave0); CArgs& AA = *get_args(); phase_final(F, AA); }
#undef IN
#undef SEAM
}

extern "C" void kernel_launch(void* const* d_in, const int* in_sizes, int n_in, void* d_out, int out_size, void* d_ws, size_t ws_size, hipStream_t stream) {
    static int grid = 0;
    if (grid == 0) {
        if (n_in != 51 || ws_size < WS_END) { fprintf(stderr, "kernel_launch: unexpected inputs (n_in %d, ws %zu)\n", n_in, ws_size); grid = -1; return; }
        int dev = 0, cus = 0;
        if (hipGetDevice(&dev) != hipSuccess || hipDeviceGetAttribute(&cus, hipDeviceAttributeMultiprocessorCount, dev) != hipSuccess) { grid = -1; return; }
        if (hipFuncSetAttribute((const void*)mk_fwd, hipFuncAttributeMaxDynamicSharedMemorySize, LDS_BYTES) != hipSuccess) { fprintf(stderr, "kernel_launch: hipFuncSetAttribute failed\n"); grid = -1; return; }
        grid = cus;
    }
    if (grid < 0) return;
    (void)hipMemsetAsync((char*)d_ws + WS_CTL, 0, CTL_ZERO_BYTES, stream);
    Args a{};
    for (int i = 0; i < 51; ++i) a.in[i] = (const float*)d_in[i];
    a.pos_off = (const int*)d_in[2]; a.out = (float*)d_out; a.ws = (unsigned char*)d_ws; a.pad = 0;
#if defined(MK_PER_PHASE)
    a.use_bar = 0;
    for (int p = 0; p < NPH; ++p) { a.ph_lo = p; a.ph_hi = p + 1;
        const int k = (p == 0) ? 30 : (p == NPH - 1) ? 31 : (p - 1) % NPL; const int reps = 1 + (int)((REPMASK >> k) & 1u);
        for (int r = 0; r < reps; ++r) hipLaunchKernelGGL(mk_fwd, dim3(grid), dim3(NTHR), LDS_BYTES, stream, a); }
#else
    a.use_bar = 1; a.ph_lo = 0; a.ph_hi = NPH;
    hipLaunchKernelGGL(mk_fwd, dim3(grid), dim3(NTHR), LDS_BYTES, stream, a);
#endif
}
```

```cpp
#include <hip/hip_runtime.h>
#include <cstdio>
#include <cstdint>
#include <type_traits>

#define LAS __attribute__((address_space(3)))
#define GAS __attribute__((address_space(1)))
#define DI __device__ __forceinline__
typedef unsigned short bf16_t;
typedef short bf16x8 __attribute__((ext_vector_type(8)));
typedef short s16x4 __attribute__((ext_vector_type(4)));
typedef float f32x4 __attribute__((ext_vector_type(4)));
typedef float f32x2 __attribute__((ext_vector_type(2)));
typedef float f32x16 __attribute__((ext_vector_type(16)));
typedef unsigned u32x4 __attribute__((ext_vector_type(4)));
typedef unsigned u32x2 __attribute__((ext_vector_type(2)));
typedef __bf16 bf16x2_t __attribute__((ext_vector_type(2)));
typedef int i32x4 __attribute__((ext_vector_type(4)));

constexpr int NB = 8, SEQ = 8192, DM = 1024, T = NB * SEQ, DEPTH = 2;
constexpr int WG = 256;
constexpr int ZS = 2304;
constexpr int ZC_R = 0, ZC_K = 256, ZC_V = 512, ZC_WLO = 768, ZC_ALO = 800, ZC_GLO = 832, ZC_S5 = 896, ZC_QA = 1152, ZC_KVA = 1408, ZC_KPE = 1536, ZC_LX = 1568, ZC_LG = 1824, D_IN = 2080;
constexpr int NEXP = 32, DFF = 512;
constexpr float NORM_EPS = 1e-6f;

DI unsigned f2bf(float f) { unsigned u = __float_as_uint(f); return (u + 0x7fffu + ((u >> 16) & 1u)) >> 16; }
DI unsigned pk2(float lo, float hi) { f32x2 v = {lo, hi}; bf16x2_t b = __builtin_convertvector(v, bf16x2_t); return __builtin_bit_cast(unsigned, b); }
DI float bflo(unsigned u) { return __uint_as_float(u << 16); }
DI float bfhi(unsigned u) { return __uint_as_float(u & 0xffff0000u); }
DI float bf2f(bf16_t b) { return __uint_as_float(((unsigned)b) << 16); }
DI int lane_opaque() { int l; asm volatile("v_mbcnt_lo_u32_b32 %0, -1, 0\n\tv_mbcnt_hi_u32_b32 %0, -1, %0" : "=v"(l)); return l; }
DI float shfl_xor_l(float v, int o, int lane) { return __int_as_float(__builtin_amdgcn_ds_bpermute((lane ^ o) << 2, __float_as_int(v))); }
DI float wave_max(float v) {
    const int l = lane_opaque();
#pragma unroll
    for (int o = 1; o < 64; o <<= 1) v = fmaxf(v, shfl_xor_l(v, o, l));
    return v;
}
DI unsigned q8x4(f32x4 v, float inv) { const int a = (int)rintf(v[0] * inv), b = (int)rintf(v[1] * inv), c = (int)rintf(v[2] * inv), d = (int)rintf(v[3] * inv);
    return (unsigned)(a & 255) | ((unsigned)(b & 255) << 8) | ((unsigned)(c & 255) << 16) | ((unsigned)(d & 255) << 24); }
DI float wave_sum(float v) {
    const int l = lane_opaque();
#pragma unroll
    for (int o = 1; o < 64; o <<= 1) v += shfl_xor_l(v, o, l);
    return v;
}
DI void lds_barrier() { asm volatile("s_waitcnt lgkmcnt(0)" ::: "memory"); __builtin_amdgcn_s_barrier(); asm volatile("" ::: "memory"); }
DI float sigmoidf_(float x) { return __builtin_amdgcn_rcpf(1.f + __expf(-x)); }
DI float fast_tanh(float x) { const float e = __expf(2.f * fminf(fmaxf(x, -15.f), 15.f)); return (e - 1.f) * __builtin_amdgcn_rcpf(e + 1.f); }
DI float fast_softplus(float x) { return fmaxf(x, 0.f) + __logf(1.f + __expf(-fabsf(x))); }
DI float softplusf_(float x) { return fmaxf(x, 0.f) + log1pf(__expf(-fabsf(x))); }
DI float gelu_tanh(float x) { const float u = 0.7978845608028654f * (x + 0.044715f * x * x * x); const float e = __expf(2.f * fminf(fmaxf(u, -15.f), 15.f)); return x * e * __builtin_amdgcn_rcpf(e + 1.f); }
DI float siluf_(float x) { return x / (1.f + __expf(-x)); }

namespace pg8 {
constexpr int BM = 256, BK = 64, HALF = 128, HTB = HALF * BK * 2, STAGE_BYTES = 8 * HTB;
DI int lds_byte(int r, int c) { const int st = (r >> 4) * 2 + (c >> 5), rr = r & 15, cc = c & 31, ob = rr * 64 + cc * 2; return st * 1024 + (ob ^ (((ob >> 9) & 1) << 5)); }
DI void stage_rc(int b, int& R, int& C) { const int st = b / 1024, sb = b % 1024, swz = sb ^ (((sb >> 9) & 1) << 5); R = (st >> 1) * 16 + swz / 64; C = (st & 1) * 32 + (swz % 64) / 2; }
DI int perm32(int rho) { const int n = rho >> 4, i = rho & 15; return 8 * (i >> 2) + 4 * n + (i & 3); }

struct Unit { int pm, pn, e, blk; };
DI f32x4 mma_any(bf16x8 a, bf16x8 b, f32x4 c) { return __builtin_amdgcn_mfma_f32_16x16x32_bf16(a, b, c, 0, 0, 0); }
DI i32x4 mma_any(bf16x8 a, bf16x8 b, i32x4 c) { return __builtin_amdgcn_mfma_i32_16x16x64_i8(__builtin_bit_cast(i32x4, a), __builtin_bit_cast(i32x4, b), c, 0, 0, 0); }

template <bool ALIGN_EPI = true, bool I8 = false, class Epi, class P>
DI void gemm_phase(LAS unsigned char* lds, const P& S, const Epi& E, int tid_in) {
    typedef typename std::conditional<I8, i32x4, f32x4>::type acc_t;
    const int tid = tid_in, wid = __builtin_amdgcn_readfirstlane(tid >> 6), lane = tid & 63, wr = wid >> 2, wc = wid & 3, fr = lane & 15, fq = lane >> 4;
    const int nt = S.nt;
    int Rr[2], Cc[2];
    unsigned voffB[2], offC[2][2], offN[2][2];
#pragma unroll
    for (int i = 0; i < 2; ++i) { int R, C; stage_rc(tid * 16 + i * 8192, R, C); Rr[i] = R; Cc[i] = C; const int Rb = Epi::PERM ? ((R & ~31) + perm32(R & 31)) : R;
        voffB[i] = (unsigned)(Rb * S.ldb + C) * 2u; }
    const size_t kstep = (size_t)(BK * 2);
    const size_t hstepB = (size_t)HALF * S.ldb * 2;
    const unsigned ldsw = (unsigned)wid * 1024u;
    const int aoff = lds_byte(wr * 64 + fr, fq * 8), boff = lds_byte(wc * 32 + fr, fq * 8);
#define PG8_SA(b, h) (((b) * 2 + (h)) * HTB)
#define PG8_SB(b, h) ((4 + (b) * 2 + (h)) * HTB)
#define PG8_STAGE(bufoff, gbase, voff) do { _Pragma("unroll") for (int _i = 0; _i < 2; ++_i) \
        __builtin_amdgcn_global_load_lds((const unsigned*)((const char*)(gbase) + (voff)[_i]), (LAS unsigned*)(lds + (bufoff) + ldsw + _i * 8192), 16, 0, 0); } while (0)
#define PG8_LDA(dst, b, h) do { _Pragma("unroll") for (int m = 0; m < 4; ++m) _Pragma("unroll") for (int k = 0; k < 2; ++k) dst[m][k] = *(const LAS bf16x8*)(lds + PG8_SA(b, h) + aoff + m * 2048 + k * 1024); } while (0)
#define PG8_LDB(dst, b, h) do { _Pragma("unroll") for (int n = 0; n < 2; ++n) _Pragma("unroll") for (int k = 0; k < 2; ++k) dst[n][k] = *(const LAS bf16x8*)(lds + PG8_SB(b, h) + boff + n * 2048 + k * 1024); } while (0)
#define PG8_MMA(ai, bj, At, Bt) do { __builtin_amdgcn_s_setprio(1); _Pragma("unroll") for (int m = 0; m < 4; ++m) _Pragma("unroll") for (int n = 0; n < 2; ++n) _Pragma("unroll") for (int k = 0; k < 2; ++k) \
        acc[ai][bj][m][n] = mma_any(Bt[n][k], At[m][k], acc[ai][bj][m][n]); __builtin_amdgcn_s_setprio(0); } while (0)
#define PG8_WAIT_V(n) asm volatile("s_waitcnt vmcnt(" #n ")" ::: "memory")
#define PG8_WAIT_L(n) asm volatile("s_waitcnt lgkmcnt(" #n ")" ::: "memory")
#define PG8_BAR __builtin_amdgcn_s_barrier()
#define PG8_SCHED __builtin_amdgcn_sched_barrier(0)
    Unit cur, nxt; int ui = 0;
    if (!S.next(0, cur)) return;
    acc_t acc[2][2][4][2];
#pragma unroll
    for (int a = 0; a < 2; ++a)
#pragma unroll
        for (int b = 0; b < 2; ++b)
#pragma unroll
            for (int m = 0; m < 4; ++m)
#pragma unroll
                for (int n = 0; n < 2; ++n) acc[a][b][m][n] = (acc_t){0, 0, 0, 0};
    bf16x8 At[4][2], B0[2][2], B1[2][2];
    const char* cA = S.a_base(cur); const char* cB = S.b_base(cur);
#pragma unroll
    for (int h = 0; h < 2; ++h)
#pragma unroll
        for (int i = 0; i < 2; ++i) { offC[h][i] = S.a_off(cur, h * HALF + Rr[i]) + (unsigned)Cc[i] * 2u; offN[h][i] = offC[h][i]; }
    PG8_STAGE(PG8_SB(0, 0), cB, voffB); PG8_STAGE(PG8_SB(0, 1), cB + hstepB, voffB); PG8_STAGE(PG8_SA(0, 0), cA, offC[0]); PG8_STAGE(PG8_SA(0, 1), cA, offC[1]);
    if (wr == 1) PG8_BAR;
    PG8_WAIT_V(2); PG8_BAR;
    PG8_STAGE(PG8_SB(1, 0), cB + kstep, voffB); PG8_STAGE(PG8_SA(1, 0), cA + kstep, offC[0]); PG8_STAGE(PG8_SB(1, 1), cB + hstepB + kstep, voffB);
    PG8_WAIT_V(6); PG8_BAR;
    for (;;) {
        const bool has_next = S.next(ui + 1, nxt);
        const char* nA = has_next ? S.a_base(nxt) : cA; const char* nB = has_next ? S.b_base(nxt) : cB;
        for (int t = 0; t < nt; t += 2) {
            const bool last = (t == nt - 2);
            const char* a1 = cA + (size_t)(t + 1) * kstep;
            const char* a2 = last ? nA : cA + (size_t)(t + 2) * kstep; const char* b2 = last ? nB : cB + (size_t)(t + 2) * kstep;
            const char* a3 = a2 + kstep; const char* b3 = b2 + kstep;
            if (last && has_next) {
#pragma unroll
                for (int h = 0; h < 2; ++h)
#pragma unroll
                    for (int i = 0; i < 2; ++i) offN[h][i] = S.a_off(nxt, h * HALF + Rr[i]) + (unsigned)Cc[i] * 2u;
            }
            unsigned o2[2][2];
#pragma unroll
            for (int h = 0; h < 2; ++h)
#pragma unroll
                for (int i = 0; i < 2; ++i) o2[h][i] = last ? offN[h][i] : offC[h][i];
            PG8_LDB(B0, 0, 0); PG8_LDB(B1, 0, 1); PG8_SCHED; PG8_LDA(At, 0, 0); PG8_STAGE(PG8_SA(1, 1), a1, offC[1]);
            PG8_WAIT_V(8); PG8_WAIT_L(0); PG8_BAR; PG8_MMA(0, 0, At, B0); PG8_MMA(0, 1, At, B1); PG8_BAR; PG8_SCHED;
            PG8_LDA(At, 0, 1); PG8_STAGE(PG8_SB(0, 0), b2, voffB); PG8_STAGE(PG8_SB(0, 1), b2 + hstepB, voffB); PG8_STAGE(PG8_SA(0, 0), a2, o2[0]);
            PG8_WAIT_V(8); PG8_WAIT_L(0); PG8_BAR; PG8_MMA(1, 0, At, B0); PG8_MMA(1, 1, At, B1); PG8_BAR; PG8_SCHED;
            PG8_LDB(B0, 1, 0); PG8_LDB(B1, 1, 1); PG8_SCHED; PG8_LDA(At, 1, 0); PG8_STAGE(PG8_SA(0, 1), a2, o2[1]);
            PG8_WAIT_V(8); PG8_WAIT_L(0); PG8_BAR; PG8_MMA(0, 0, At, B0); PG8_MMA(0, 1, At, B1); PG8_BAR; PG8_SCHED;
            PG8_LDA(At, 1, 1); PG8_STAGE(PG8_SB(1, 0), b3, voffB); PG8_STAGE(PG8_SB(1, 1), b3 + hstepB, voffB); PG8_STAGE(PG8_SA(1, 0), a3, o2[0]);
            PG8_WAIT_V(8); PG8_WAIT_L(0); PG8_BAR; PG8_MMA(1, 0, At, B0); PG8_MMA(1, 1, At, B1); PG8_BAR; PG8_SCHED;
        }
        if constexpr (ALIGN_EPI) { if (wr == 0) PG8_BAR; }
        E(acc, cur, wr, wc, fr, fq);
        if (!has_next) break;
#pragma unroll
        for (int a = 0; a < 2; ++a)
#pragma unroll
            for (int b = 0; b < 2; ++b)
#pragma unroll
                for (int m = 0; m < 4; ++m)
#pragma unroll
                    for (int n = 0; n < 2; ++n) acc[a][b][m][n] = (acc_t){0, 0, 0, 0};
        cur = nxt; cA = nA; cB = nB; ++ui;
#pragma unroll
        for (int h = 0; h < 2; ++h)
#pragma unroll
            for (int i = 0; i < 2; ++i) offC[h][i] = offN[h][i];
        if constexpr (ALIGN_EPI) { if (wr == 1) PG8_BAR; }
    }
    PG8_WAIT_V(0);
    if constexpr (!ALIGN_EPI) { if (wr == 0) PG8_BAR; }
    PG8_BAR;
#undef PG8_SA
#undef PG8_SB
#undef PG8_STAGE
#undef PG8_LDA
#undef PG8_LDB
#undef PG8_MMA
#undef PG8_WAIT_V
#undef PG8_WAIT_L
#undef PG8_BAR
#undef PG8_SCHED
}

struct PlainProb {
    const char* A; const char* Bt; int lda, ldb, nt, nM, nN, G, c;
    DI bool next(int i, Unit& u) const {
        const long L = (long)i * G + c; const int nwg = nM * nN; if (L >= nwg) return false;
        int wgid = (int)L; { const int q = nwg / 8, r = nwg % 8, xcd = wgid % 8, off = wgid / 8; wgid = (xcd < r ? xcd * (q + 1) : r * (q + 1) + (xcd - r) * q) + off; }
        const int nig = 8 * nN, gid = wgid / nig, fm = gid * 8, gsz = (nM - fm) < 8 ? (nM - fm) : 8;
        u.pm = fm + ((wgid % nig) % gsz); u.pn = (wgid % nig) / gsz; u.e = 0; u.blk = 0; return true;
    }
    DI const char* a_base(const Unit& u) const { return A + (size_t)u.pm * 256 * lda * 2; }
    DI const char* b_base(const Unit& u) const { return Bt + (size_t)u.pn * 256 * ldb * 2; }
    DI unsigned a_off(const Unit&, int row) const { return (unsigned)row * (unsigned)lda * 2u; }
};
}

constexpr size_t MiB = 1u << 20;
constexpr size_t WS_CTL = 0, CTL_ZERO_BYTES = 1 * MiB;
constexpr size_t WS_MOD = 1 * MiB;
constexpr size_t WS_RT_EID = 3 * MiB;
constexpr size_t WS_RT_GATE = WS_RT_EID + 512 * 1024;
constexpr size_t WS_RT_PIE = WS_RT_GATE + 512 * 1024;
constexpr size_t WS_RT_SORT = WS_RT_PIE + 512 * 1024;
constexpr size_t WS_WIN = 8 * MiB;
constexpr size_t WS_WINSC = 8 * MiB + 5 * MiB;
constexpr size_t WS_HSC = 7 * MiB + 512 * 1024;
constexpr size_t WS_WOUT = 17 * MiB;
constexpr size_t WS_WMLA = 21 * MiB;
constexpr size_t WS_WGLU = 23 * MiB;
constexpr size_t WS_WR = 23 * MiB + 256 * 1024;
constexpr size_t WS_WLRU = 23 * MiB + 640 * 1024;
constexpr size_t WS_WLORA = 23 * MiB + 768 * 1024;
static_assert(WS_WGLU + 256 * 1024 <= WS_WR && WS_WR + 384 * 1024 <= WS_WLRU && WS_WLRU + 128 * 1024 <= WS_WLORA && WS_WLORA + 128 * 1024 <= 24 * MiB, "small weight map");
constexpr size_t WS_H = 24 * MiB;
constexpr size_t WS_Z = 152 * MiB;
constexpr size_t WS_WM1 = WS_Z;
constexpr size_t WS_WM2 = WS_Z + 64 * MiB;
constexpr size_t WS_WM1SC = WS_Z + 32 * MiB;
constexpr size_t WS_H2SC = 7 * MiB + 768 * 1024;
constexpr size_t WS_MIX = 440 * MiB;
constexpr size_t WS_HID = WS_MIX;
constexpr size_t WS_Y = 569 * MiB;
constexpr size_t WS_Q = 825 * MiB;
constexpr size_t WS_K = 873 * MiB;
constexpr size_t WS_VT = 921 * MiB;
constexpr size_t WS_ROWSS = WS_Q;
constexpr size_t WS_TAIL = 953 * MiB;
constexpr size_t WS_END = 1017 * MiB;
constexpr size_t WS_AMLA = WS_TAIL;
constexpr size_t WS_QKVRAW = WS_Y;
constexpr size_t WS_ATTO = WS_H;
constexpr size_t WS_RW_V = WS_Y + 64 * MiB, WS_RW_G = WS_H + 64 * MiB;
constexpr size_t WS_RC_RP = WS_H + 32 * MiB;
constexpr size_t WS_RC_MP = WS_H + 64 * MiB;
constexpr size_t WS_RC_HB = WS_H + 96 * MiB;
constexpr size_t WS_RC_Y0 = WS_Q;
constexpr size_t WS_RC_G = WS_Q + 64 * MiB;
constexpr int RC_REC = 24832;
constexpr size_t WS_RC_BS = WS_Q + 64 * MiB + 98 * MiB;
static_assert((size_t)4096 * RC_REC <= 98 * MiB && WS_RC_BS + 1 * MiB <= WS_END, "rwkv record map");
constexpr size_t WS_YS5 = WS_Y;
constexpr size_t WS_YS5G = WS_Y + 32 * MiB;
constexpr size_t WS_YL = WS_TAIL + 32 * MiB;
constexpr size_t WS_LA = WS_Y + 128 * MiB, WS_LB = WS_Y + 192 * MiB;
constexpr size_t WS_S5END = 2 * MiB;
constexpr size_t WS_S5BB = 5 * MiB;
constexpr size_t WS_S5CC = 5 * MiB + 128 * 1024;
constexpr size_t WS_LSUM = 5 * MiB + 512 * 1024;
static_assert(WS_RT_SORT + 512 * 1024 <= WS_LSUM && WS_LSUM + 2 * MiB <= WS_WIN && WS_S5END + 1 * MiB <= WS_RT_EID, "map");

constexpr int CW_BAR = 4096;
constexpr int CW_CNT = 16384;
constexpr int CW_INMAX = 32768;
constexpr int CW_COLMAX = 65536;
constexpr int CW_UTAB = 20480;

constexpr int NWAVES = 8, NTHR = 512;
constexpr int LDS_BYTES = 155648;
constexpr int MISC_OFF = 155648 - 256;

struct Args { const float* in[51]; const int* pos_off; float* out; unsigned char* ws; int ph_lo, ph_hi, use_bar, pad; };
typedef const __attribute__((address_space(4))) Args CArgs;
DI CArgs* get_args() { CArgs* ap = (CArgs*)__builtin_amdgcn_kernarg_segment_ptr(); asm volatile("" : "+s"(ap)); return ap; }

#define XB_TMO      128
#define XB_XCNT(j)  (256  + 64 * (j))
#define XB_XSUB(j)  (1280 + 64 * (j))
#define XB_XGEN(j)  (2304 + 64 * (j))
#define XB_TOP      3328
#define XB_TOPGEN   3392
#define XCD_BAR_WORDS 3456
#define XB_SPIN_CAP (1u << 18)
DI unsigned xb_ld(unsigned* p)              { return __hip_atomic_load(p, __ATOMIC_RELAXED, __HIP_MEMORY_SCOPE_AGENT); }
DI unsigned xb_add(unsigned* p, unsigned v) { return __hip_atomic_fetch_add(p, v, __ATOMIC_RELAXED, __HIP_MEMORY_SCOPE_AGENT); }
DI unsigned xb_xcc_id() { return (unsigned)__builtin_amdgcn_s_getreg((3 << 11) | 20) & 0xFu; }
#define XB_SPIN(cond, bar) do { unsigned _sp = 0; while (cond) { __builtin_amdgcn_s_sleep(1); \
    if ((++_sp & 255u) == 0u) { if (xb_ld(&(bar)[XB_TMO])) break; if (_sp > XB_SPIN_CAP) { atomicAdd(&(bar)[XB_TMO], 1u); break; } } } } while (0)
struct XcdBarrier { unsigned* bar; unsigned x; volatile LAS unsigned* st; };
DI XcdBarrier xcd_barrier_post(unsigned* bar, volatile LAS unsigned* st) {
    XcdBarrier b; b.bar = bar; b.x = xb_xcc_id(); b.st = st;
    if (threadIdx.x == 0) (void)xb_add(&bar[XB_XCNT(b.x)], 1u);
    return b;
}
DI void xcd_barrier_complete(unsigned* bar, unsigned x, unsigned& nloc, unsigned& nx) {
    const unsigned G = gridDim.x * gridDim.y * gridDim.z;
    unsigned sum, cnt, mine, sp = 0u;
    for (;;) {
        sum = 0u; cnt = 0u; mine = 0u;
#pragma unroll
        for (unsigned j = 0; j < 16; ++j) { const unsigned c = xb_ld(&bar[XB_XCNT(j)]); sum += c; cnt += (c > 0u) ? 1u : 0u; mine = (j == x) ? c : mine; }
        if (sum == G) break;
        __builtin_amdgcn_s_sleep(1);
        if ((++sp & 255u) == 0u) { if (xb_ld(&bar[XB_TMO])) break; if (sp > XB_SPIN_CAP) { atomicAdd(&bar[XB_TMO], 1u); break; } }
    }
    nloc = mine > 0u ? mine : 1u; nx = cnt > 0u ? cnt : 1u;
}
DI void xcd_barrier(const XcdBarrier& b) {
    asm volatile("s_waitcnt vmcnt(0)" ::: "memory");
    __syncthreads();
    if (threadIdx.x == 0) {
        unsigned* bar = b.bar;
        __builtin_amdgcn_s_waitcnt(0);
        unsigned nloc = b.st[0], nx = b.st[1];
        if (nloc == 0u) { xcd_barrier_complete(bar, b.x, nloc, nx); b.st[0] = nloc; b.st[1] = nx; }
        const unsigned old = xb_add(&bar[XB_XSUB(b.x)], 1u);
        const unsigned gen = old / nloc;
        if (old + 1u == (gen + 1u) * nloc) {
            __builtin_amdgcn_fence(__ATOMIC_RELEASE, "agent");
            asm volatile("s_waitcnt vmcnt(0)" ::: "memory");
            const unsigned og = xb_add(&bar[XB_TOP], 1u);
            const unsigned tg = og / nx;
            if (og + 1u == (tg + 1u) * nx) xb_add(&bar[XB_TOPGEN], 1u);
            else XB_SPIN(xb_ld(&bar[XB_TOPGEN]) == tg, bar);
            __builtin_amdgcn_fence(__ATOMIC_ACQUIRE, "agent");
            xb_add(&bar[XB_XGEN(b.x)], 1u);
            asm volatile("s_waitcnt vmcnt(0)" ::: "memory");
        } else {
            XB_SPIN(xb_ld(&bar[XB_XGEN(b.x)]) == gen, bar);
            __builtin_amdgcn_fence(__ATOMIC_ACQUIRE, "agent");
            asm volatile("s_waitcnt vmcnt(0)" ::: "memory");
        }
    }
    __syncthreads();
}

struct EpiBf16Plain {
    static constexpr bool PERM = true;
    bf16_t* O; int ldc;
    DI void operator()(const f32x4 (&acc)[2][2][4][2], const pg8::Unit& u, int wr, int wc, int fr, int fq) const {
        const int row0 = u.pm * 256 + wr * 64 + fr, col0 = u.pn * 256 + wc * 32 + 8 * fq;
#pragma unroll
        for (int ai = 0; ai < 2; ++ai)
#pragma unroll
            for (int m = 0; m < 4; ++m) { bf16_t* rowp = O + (size_t)(row0 + ai * 128 + m * 16) * ldc + col0;
#pragma unroll
                for (int bj = 0; bj < 2; ++bj) { const f32x4 v0 = acc[ai][bj][m][0], v1 = acc[ai][bj][m][1];
                    u32x4 w; w.x = pk2(v0[0], v0[1]); w.y = pk2(v0[2], v0[3]); w.z = pk2(v1[0], v1[1]); w.w = pk2(v1[2], v1[3]);
                    *(u32x4*)(rowp + bj * 128) = w; } }
    }
};
struct EpiBf16I8 {
    static constexpr bool PERM = true;
    bf16_t* O; int ldc; const float* sa; const float* sw;
    DI void operator()(const i32x4 (&acc)[2][2][4][2], const pg8::Unit& u, int wr, int wc, int fr, int fq) const {
        const int row0 = u.pm * 256 + wr * 64 + fr, col0 = u.pn * 256 + wc * 32 + 8 * fq;
        f32x4 w0[2], w1[2];
#pragma unroll
        for (int bj = 0; bj < 2; ++bj) { w0[bj] = *(const f32x4*)(sw + col0 + bj * 128); w1[bj] = *(const f32x4*)(sw + col0 + bj * 128 + 4); }
#pragma unroll
        for (int ai = 0; ai < 2; ++ai)
#pragma unroll
            for (int m = 0; m < 4; ++m) { const int row = row0 + ai * 128 + m * 16; const float ra = sa[row]; bf16_t* rowp = O + (size_t)row * ldc + col0;
#pragma unroll
                for (int bj = 0; bj < 2; ++bj) { const i32x4 a0 = acc[ai][bj][m][0], a1 = acc[ai][bj][m][1];
                    u32x4 w; w.x = pk2((float)a0[0] * ra * w0[bj][0], (float)a0[1] * ra * w0[bj][1]); w.y = pk2((float)a0[2] * ra * w0[bj][2], (float)a0[3] * ra * w0[bj][3]);
                    w.z = pk2((float)a1[0] * ra * w1[bj][0], (float)a1[1] * ra * w1[bj][1]); w.w = pk2((float)a1[2] * ra * w1[bj][2], (float)a1[3] * ra * w1[bj][3]);
                    *(u32x4*)(rowp + bj * 128) = w; } }
    }
};
struct EpiResGate {
    static constexpr bool PERM = false;
    const float* xin; float* out; const float* gt; float* rowss; const float* n2g;
    DI void operator()(const f32x4 (&acc)[2][2][4][2], const pg8::Unit& u, int wr, int wc, int fr, int fq) const {
        const int row0 = u.pm * 256 + wr * 64 + fr, col0 = u.pn * 256 + wc * 32 + 4 * fq;
        const int b = (u.pm * 256) / SEQ;
        const int ln = lane_opaque();
        f32x4 g[2][2], G2[2][2];
#pragma unroll
        for (int bj = 0; bj < 2; ++bj)
#pragma unroll
            for (int n = 0; n < 2; ++n) { g[bj][n] = *(const f32x4*)(gt + (size_t)b * 6144 + col0 + bj * 128 + n * 16);
                G2[bj][n] = *(const f32x4*)(n2g + col0 + bj * 128 + n * 16) * (*(const f32x4*)(gt + (size_t)b * 6144 + 2048 + col0 + bj * 128 + n * 16) + 1.f); }
#pragma unroll
        for (int ai = 0; ai < 2; ++ai)
#pragma unroll
            for (int m = 0; m < 4; ++m) { const size_t ro = (size_t)(row0 + ai * 128 + m * 16) * DM + col0; float ss = 0.f, mxg = 0.f;
#pragma unroll
                for (int bj = 0; bj < 2; ++bj)
#pragma unroll
                    for (int n = 0; n < 2; ++n) { const f32x4 xv = *(const f32x4*)(xin + ro + bj * 128 + n * 16); const f32x4 v = xv + g[bj][n] * acc[ai][bj][m][n];
                        *(f32x4*)(out + ro + bj * 128 + n * 16) = v; ss += (v[0] * v[0] + v[1] * v[1]) + (v[2] * v[2] + v[3] * v[3]);
                        const f32x4 vg = v * G2[bj][n]; mxg = fmaxf(mxg, fmaxf(fmaxf(fabsf(vg[0]), fabsf(vg[1])), fmaxf(fabsf(vg[2]), fabsf(vg[3])))); }
                ss += shfl_xor_l(ss, 16, ln); ss += shfl_xor_l(ss, 32, ln); mxg = fmaxf(mxg, shfl_xor_l(mxg, 16, ln)); mxg = fmaxf(mxg, shfl_xor_l(mxg, 32, ln));
                if (fq == 0) { float* rp = rowss + (size_t)(row0 + ai * 128 + m * 16) * 32 + u.pn * 4 + wc; rp[0] = ss; rp[16] = mxg; } }
    }
};
struct EpiGlu {
    static constexpr bool PERM = true;
    const bf16_t* Y; bf16_t* O; const float* bias;
    DI void operator()(const f32x4 (&acc)[2][2][4][2], const pg8::Unit& u, int wr, int wc, int fr, int fq) const {
        const int row0 = u.pm * 256 + wr * 64 + fr, col0 = wc * 32 + 8 * fq;
#pragma unroll
        for (int ai = 0; ai < 2; ++ai)
#pragma unroll
            for (int m = 0; m < 4; ++m) { const size_t ro = (size_t)(row0 + ai * 128 + m * 16) * 256 + col0;
#pragma unroll
                for (int bj = 0; bj < 2; ++bj) { const u32x4 yv = *(const u32x4*)(Y + ro + bj * 128);
                    const f32x4 b0 = *(const f32x4*)(bias + col0 + bj * 128), b1 = *(const f32x4*)(bias + col0 + bj * 128 + 4);
                    const f32x4 v0 = acc[ai][bj][m][0] + b0, v1 = acc[ai][bj][m][1] + b1;
                    u32x4 w;
                    w.x = pk2(bflo(yv.x) * sigmoidf_(v0[0]), bfhi(yv.x) * sigmoidf_(v0[1]));
                    w.y = pk2(bflo(yv.y) * sigmoidf_(v0[2]), bfhi(yv.y) * sigmoidf_(v0[3]));
                    w.z = pk2(bflo(yv.z) * sigmoidf_(v1[0]), bfhi(yv.z) * sigmoidf_(v1[1]));
                    w.w = pk2(bflo(yv.w) * sigmoidf_(v1[2]), bfhi(yv.w) * sigmoidf_(v1[3]));
                    *(u32x4*)(O + ro + bj * 128) = w; } }
    }
};

struct Frame { LAS unsigned char* lds; int tid, lane, wave, G, bid, gw, ngw; };

DI Frame make_frame(LAS unsigned char* lds, int wave0) {
    Frame F; F.lds = lds; int w = wave0; asm volatile("" : "+s"(w)); F.wave = w; F.lane = lane_opaque(); F.tid = w * 64 + F.lane;
    F.G = gridDim.x; F.bid = blockIdx.x; F.gw = F.bid * NWAVES + F.wave; F.ngw = F.G * NWAVES; return F;
}
DI void transpose_item(const float* src, int ld_src, int k0, int n0, bf16_t* dst, int ldd, int nd0, int kd0, LAS float* scr, int lane) {
#pragma unroll 8
    for (int i = 0; i < 32; ++i) { const int kk = 2 * i + (lane >> 5); scr[kk * 33 + (lane & 31)] = src[(size_t)(k0 + kk) * ld_src + n0 + (lane & 31)]; }
    asm volatile("s_waitcnt lgkmcnt(0)" ::: "memory");
    const int c = lane & 7;
#pragma unroll
    for (int j = 0; j < 4; ++j) { const int n = (lane >> 3) + 8 * j; const LAS float* s = scr + (8 * c) * 33 + n;
        u32x4 o; o.x = pk2(s[0 * 33], s[1 * 33]); o.y = pk2(s[2 * 33], s[3 * 33]); o.z = pk2(s[4 * 33], s[5 * 33]); o.w = pk2(s[6 * 33], s[7 * 33]);
        *(u32x4*)(dst + (size_t)(nd0 + n) * ldd + kd0 + 8 * c) = o; }
    asm volatile("s_waitcnt lgkmcnt(0)" ::: "memory");
}
DI void transpose_item64(const float* src, int ld_src, int k0, int n0, bf16_t* dst, int ldd, int nd0, int kd0, LAS float* scr, int lane) {
    f32x4 v[16];
#pragma unroll
    for (int i = 0; i < 16; ++i) v[i] = *(const f32x4*)(src + (size_t)(k0 + 4 * i + (lane >> 4)) * ld_src + n0 + 4 * (lane & 15));
#pragma unroll
    for (int i = 0; i < 16; ++i) { LAS float* p = scr + (4 * i + (lane >> 4)) * 65 + 4 * (lane & 15); p[0] = v[i][0]; p[1] = v[i][1]; p[2] = v[i][2]; p[3] = v[i][3]; }
    asm volatile("s_waitcnt lgkmcnt(0)" ::: "memory");
    const int c = lane & 7;
#pragma unroll
    for (int j = 0; j < 8; ++j) { const int n = (lane >> 3) + 8 * j; const LAS float* q = scr + (8 * c) * 65 + n;
        u32x4 o; o.x = pk2(q[0 * 65], q[1 * 65]); o.y = pk2(q[2 * 65], q[3 * 65]); o.z = pk2(q[4 * 65], q[5 * 65]); o.w = pk2(q[6 * 65], q[7 * 65]);
        *(u32x4*)(dst + (size_t)(nd0 + n) * ldd + kd0 + 8 * c) = o; }
    asm volatile("s_waitcnt lgkmcnt(0)" ::: "memory");
}
DI void quant_item64(const float* src, int ld_src, int k0, int n0, signed char* dst, int ldd, int nd0, int kd0, const unsigned* colmax, float* wsc, LAS float* scr, int lane, int nvalid = 1 << 30) {
    f32x4 v[16]; const bool okc = n0 + 4 * (lane & 15) < nvalid;
#pragma unroll
    for (int i = 0; i < 16; ++i) { v[i] = (f32x4){0.f, 0.f, 0.f, 0.f}; if (okc) v[i] = *(const f32x4*)(src + (size_t)(k0 + 4 * i + (lane >> 4)) * ld_src + n0 + 4 * (lane & 15)); }
#pragma unroll
    for (int i = 0; i < 16; ++i) { LAS float* p = scr + (4 * i + (lane >> 4)) * 65 + 4 * (lane & 15); p[0] = v[i][0]; p[1] = v[i][1]; p[2] = v[i][2]; p[3] = v[i][3]; }
    asm volatile("s_waitcnt lgkmcnt(0)" ::: "memory");
    const int c = lane & 7;
#pragma unroll
    for (int j = 0; j < 8; ++j) { const int n = (lane >> 3) + 8 * j; const LAS float* q = scr + (8 * c) * 65 + n;
        const float sc = fmaxf(__uint_as_float(colmax[n]), 1e-30f) * (1.f / 127.f), inv = 1.f / sc;
        if (wsc && c == 0) wsc[n] = sc;
        u32x2 o; o.x = q8x4((f32x4){q[0 * 65], q[1 * 65], q[2 * 65], q[3 * 65]}, inv); o.y = q8x4((f32x4){q[4 * 65], q[5 * 65], q[6 * 65], q[7 * 65]}, inv);
        *(u32x2*)(dst + (size_t)(nd0 + n) * ldd + kd0 + 8 * c) = o; }
    asm volatile("s_waitcnt lgkmcnt(0)" ::: "memory");
}
DI void quant_strip64(const float* src, int ld_src, int n0, int nvalid, signed char* dst, int ldd, float* scale, LAS float* scr, int lane) {
    const int c4 = n0 + 4 * (lane & 15); const bool okc = c4 < nvalid;
    float mx[4] = {0.f, 0.f, 0.f, 0.f};
    for (int kb = 0; kb < 16; ++kb) {
#pragma unroll
        for (int i = 0; i < 16; ++i) { f32x4 v = {0.f, 0.f, 0.f, 0.f}; if (okc) v = *(const f32x4*)(src + (size_t)(64 * kb + 4 * i + (lane >> 4)) * ld_src + c4);
            mx[0] = fmaxf(mx[0], fabsf(v[0])); mx[1] = fmaxf(mx[1], fabsf(v[1])); mx[2] = fmaxf(mx[2], fabsf(v[2])); mx[3] = fmaxf(mx[3], fabsf(v[3])); } }
#pragma unroll
    for (int q = 0; q < 4; ++q) { mx[q] = fmaxf(mx[q], shfl_xor_l(mx[q], 16, lane)); mx[q] = fmaxf(mx[q], shfl_xor_l(mx[q], 32, lane)); }
    LAS float* smax = scr + 64 * 65;
    if (lane < 16) {
#pragma unroll
        for (int q = 0; q < 4; ++q) { const float sc = fmaxf(mx[q], 1e-30f) * (1.f / 127.f); smax[4 * lane + q] = sc; scale[4 * lane + q] = sc; } }
    asm volatile("s_waitcnt lgkmcnt(0)" ::: "memory");
    for (int kb = 0; kb < 16; ++kb) {
        f32x4 v[16];
#pragma unroll
        for (int i = 0; i < 16; ++i) { v[i] = (f32x4){0.f, 0.f, 0.f, 0.f}; if (okc) v[i] = *(const f32x4*)(src + (size_t)(64 * kb + 4 * i + (lane >> 4)) * ld_src + c4); }
#pragma unroll
        for (int i = 0; i < 16; ++i) { LAS float* p = scr + (4 * i + (lane >> 4)) * 65 + 4 * (lane & 15); p[0] = v[i][0]; p[1] = v[i][1]; p[2] = v[i][2]; p[3] = v[i][3]; }
        asm volatile("s_waitcnt lgkmcnt(0)" ::: "memory");
        const int c = lane & 7;
#pragma unroll
        for (int j = 0; j < 8; ++j) { const int n = (lane >> 3) + 8 * j; const LAS float* q = scr + (8 * c) * 65 + n; const float inv = 1.f / smax[n];
            u32x2 o; o.x = q8x4((f32x4){q[0 * 65], q[1 * 65], q[2 * 65], q[3 * 65]}, inv); o.y = q8x4((f32x4){q[4 * 65], q[5 * 65], q[6 * 65], q[7 * 65]}, inv);
            *(u32x2*)(dst + (size_t)n * ldd + 64 * kb + 8 * c) = o; }
        asm volatile("s_waitcnt lgkmcnt(0)" ::: "memory");
    }
}
DI void zero_rows(bf16_t* dst, int ld, int r0, int nr, int c0, int nc, int gw, int ngw, int lane) {
    for (int r = gw; r < nr; r += ngw) for (int c = lane * 8; c < nc; c += 512) *(u32x4*)(dst + (size_t)(r0 + r) * ld + c0 + c) = (u32x4){0u, 0u, 0u, 0u};
}

DI void phase_prologue(const Frame& F, CArgs& A) {
    unsigned char* ws = A.ws;
    LAS float* sc = (LAS float*)F.lds;
    LAS float* part = (LAS float*)(F.lds + 32768);
    for (int i = F.tid; i < 8192; i += NTHR) sc[i] = siluf_(A.in[1][i]);
    __syncthreads();
    float* MOD = (float*)(ws + WS_MOD);
    for (int item = F.bid; item < 192; item += F.G) {
        const int l = item / 96, n0 = (item % 96) * 64, nl = F.tid & 63, kg = F.tid >> 6;
        const float* W = A.in[3] + (size_t)l * 1024 * 6144 + n0 + nl;
        float acc[8];
#pragma unroll
        for (int b = 0; b < 8; ++b) acc[b] = 0.f;
        for (int k = kg * 128; k < kg * 128 + 128; ++k) { const float w = W[(size_t)k * 6144];
#pragma unroll
            for (int b = 0; b < 8; ++b) acc[b] += sc[b * 1024 + k] * w; }
#pragma unroll
        for (int b = 0; b < 8; ++b) part[(kg * 8 + b) * 64 + nl] = acc[b];
        __syncthreads();
        { const int b = F.tid >> 6; float s = A.in[4][l * 6144 + n0 + nl];
#pragma unroll
          for (int g = 0; g < 8; ++g) s += part[(g * 8 + b) * 64 + nl];
          MOD[((size_t)l * 8 + b) * 6144 + n0 + nl] = s; }
        __syncthreads();
    }
    LAS float* scr = (LAS float*)(F.lds + F.wave * 16896);
    bf16_t* WIN = (bf16_t*)(ws + WS_WIN); bf16_t* WOUT = (bf16_t*)(ws + WS_WOUT); bf16_t* WMLA = (bf16_t*)(ws + WS_WMLA); bf16_t* WGLU = (bf16_t*)(ws + WS_WGLU);
    constexpr int I_IN = 0, I_INT = 0, I_OUT = 16 * 16, I_Q = 4 * 6, I_KV = 2 * 8, I_GLU = 4 * 4, I_L = I_IN + I_INT + I_OUT + I_Q + I_KV + I_GLU;
    for (int it = F.gw; it < 2 * I_L; it += F.ngw) {
        const int l = it / I_L; int r = it % I_L;
        if (r < I_IN) { transpose_item64(A.in[6] + (size_t)l * 1024 * D_IN, D_IN, 64 * (r / 32), 64 * (r % 32), WIN + (size_t)l * ZS * 1024, 1024, 64 * (r % 32), 64 * (r / 32), scr, F.lane); continue; } r -= I_IN;
        if (r < I_INT) { transpose_item(A.in[6] + (size_t)l * 1024 * D_IN, D_IN, 64 * r, 2048, WIN + (size_t)l * ZS * 1024, 1024, 2048, 64 * r, scr, F.lane); continue; } r -= I_INT;
        if (r < I_OUT) { transpose_item64(A.in[42] + (size_t)l * 1024 * 1024, 1024, 64 * (r / 16), 64 * (r % 16), WOUT + (size_t)l * 1024 * 1024, 1024, 64 * (r % 16), 64 * (r / 16), scr, F.lane); continue; } r -= I_OUT;
        if (r < I_Q) { transpose_item64(A.in[29] + (size_t)l * 256 * 384, 384, 64 * (r / 6), 64 * (r % 6), WMLA + (size_t)l * 1024 * 512, 512, 64 * (r % 6), 64 * (r / 6), scr, F.lane); continue; } r -= I_Q;
        if (r < I_KV) { transpose_item64(A.in[31] + (size_t)l * 128 * 512, 512, 64 * (r / 8), 64 * (r % 8), WMLA + (size_t)l * 1024 * 512, 512, 384 + 64 * (r % 8), 256 + 64 * (r / 8), scr, F.lane); continue; } r -= I_KV;
        transpose_item64(A.in[26] + (size_t)l * 256 * 256, 256, 64 * (r / 4), 64 * (r % 4), WGLU + (size_t)l * 256 * 256, 256, 64 * (r % 4), 64 * (r / 4), scr, F.lane);
    }
    { unsigned* CM = (unsigned*)(ws + WS_CTL) + CW_COLMAX;
      for (int it = F.gw; it < 2 * 32 * 2 * 128; it += F.ngw) { const int le = it >> 8, which = (it >> 7) & 1, kb = (it >> 3) & 15, nb = it & 7;
          const float* src = (which ? A.in[49] : A.in[48]) + (size_t)le * 1024 * 512 + (size_t)(64 * kb + (F.lane >> 4)) * 512 + 64 * nb + 4 * (F.lane & 15);
          float mx[4] = {0.f, 0.f, 0.f, 0.f};
#pragma unroll
          for (int i = 0; i < 16; ++i) { const f32x4 v = *(const f32x4*)(src + (size_t)(4 * i) * 512);
              mx[0] = fmaxf(mx[0], fabsf(v[0])); mx[1] = fmaxf(mx[1], fabsf(v[1])); mx[2] = fmaxf(mx[2], fabsf(v[2])); mx[3] = fmaxf(mx[3], fabsf(v[3])); }
#pragma unroll
          for (int q = 0; q < 4; ++q) { mx[q] = fmaxf(mx[q], shfl_xor_l(mx[q], 16, F.lane)); mx[q] = fmaxf(mx[q], shfl_xor_l(mx[q], 32, F.lane)); }
          if (F.lane < 16) { const int n0 = 64 * nb + 4 * F.lane, np = 256 * (n0 >> 7) + (n0 & 127) + 128 * which;
#pragma unroll
              for (int q = 0; q < 4; ++q) atomicMax(CM + (size_t)le * 1024 + np + q, __float_as_uint(mx[q])); } } }
    { unsigned* IM = (unsigned*)(ws + WS_CTL) + CW_INMAX;
      for (int it = F.gw; it < 2 * 16 * 33; it += F.ngw) { const int l = it / (16 * 33), r = it % (16 * 33), kb = r / 33, nb = r % 33;
          const int c4 = 64 * nb + 4 * (F.lane & 15); const bool okc = c4 < D_IN;
          const float* src = A.in[6] + (size_t)l * 1024 * D_IN + (size_t)(64 * kb + (F.lane >> 4)) * D_IN + c4;
          float mx[4] = {0.f, 0.f, 0.f, 0.f};
#pragma unroll
          for (int i = 0; i < 16; ++i) { f32x4 v = {0.f, 0.f, 0.f, 0.f}; if (okc) v = *(const f32x4*)(src + (size_t)(4 * i) * D_IN);
              mx[0] = fmaxf(mx[0], fabsf(v[0])); mx[1] = fmaxf(mx[1], fabsf(v[1])); mx[2] = fmaxf(mx[2], fabsf(v[2])); mx[3] = fmaxf(mx[3], fabsf(v[3])); }
#pragma unroll
          for (int q = 0; q < 4; ++q) { mx[q] = fmaxf(mx[q], shfl_xor_l(mx[q], 16, F.lane)); mx[q] = fmaxf(mx[q], shfl_xor_l(mx[q], 32, F.lane)); }
          if (F.lane < 16) {
#pragma unroll
              for (int q = 0; q < 4; ++q) atomicMax(IM + l * ZS + c4 + q, __float_as_uint(mx[q])); } }
      for (int l = 0; l < 2; ++l) {
          signed char* w8 = (signed char*)(ws + WS_WIN) + ((size_t)l * ZS + 2112) * 1024;
          for (int i = F.bid * NTHR + F.tid; i < 192 * 1024 / 16; i += F.G * NTHR) *(u32x4*)(w8 + (size_t)i * 16) = (u32x4){0u, 0u, 0u, 0u};
          for (int i = F.bid * NTHR + F.tid; i < 192; i += F.G * NTHR) ((float*)(ws + WS_WINSC))[l * ZS + 2112 + i] = 0.f; } }
    { bf16_t* WR = (bf16_t*)(ws + WS_WR);
      for (int i = F.bid * NTHR + F.tid; i < 2 * 48 * 1024; i += F.G * NTHR) { const int l = i / (48 * 1024), n = (i / 1024) % 48, k = i % 1024;
          const float v = n < 4 ? A.in[44][((size_t)l * 1024 + k) * 4 + n] : n < 36 ? A.in[46][((size_t)l * 1024 + k) * 32 + (n - 4)] : 0.f;
          const unsigned hi = f2bf(v); const float rem = v - __uint_as_float(hi << 16);
          WR[((size_t)(l * 2 + 0) * 48 + n) * 1024 + k] = (bf16_t)hi; WR[((size_t)(l * 2 + 1) * 48 + n) * 1024 + k] = (bf16_t)f2bf(rem); } }
    { bf16_t* WL = (bf16_t*)(ws + WS_WLRU); bf16_t* WO = (bf16_t*)(ws + WS_WLORA);
      for (int i = F.bid * NTHR + F.tid; i < 2 * 2 * 4 * 4096; i += F.G * NTHR) { const int l = i >> 15, wh = (i >> 14) & 1, n = (i >> 12) & 3, j = (i >> 6) & 63, k = i & 63;
          WL[i] = (bf16_t)f2bf((wh ? A.in[38] : A.in[36])[((size_t)(l * 4 + n) * 64 + k) * 64 + j]); }
      for (int i = F.bid * NTHR + F.tid; i < 2 * 32768; i += F.G * NTHR) { const int l = i >> 15, r = i & 32767;
          float v;
          if (r < 8192) v = A.in[9][(size_t)l * 8192 + (r & 31) * 256 + (r >> 5)];
          else if (r < 16384) v = A.in[11][(size_t)l * 8192 + ((r - 8192) & 31) * 256 + ((r - 8192) >> 5)];
          else v = A.in[12][(size_t)l * 16384 + ((r - 16384) & 63) * 256 + ((r - 16384) >> 6)];
          WO[i] = (bf16_t)f2bf(v); } }
    { bf16_t* BBt = (bf16_t*)(ws + WS_S5BB); bf16_t* CCt = (bf16_t*)(ws + WS_S5CC);
      for (int i = F.bid * NTHR + F.tid; i < 2 * 16 * 64; i += F.G * NTHR) { const int lg = i >> 6, p = i & 63;
          const float dt = __expf(A.in[25][lg]); const float lre = A.in[18][lg * 64 + p], lim = A.in[19][lg * 64 + p];
          const float mag = expf(lre * dt); float sn, cn; sincosf(lim * dt, &sn, &cn);
          const float are = mag * cn, aim = mag * sn, den = lre * lre + lim * lim;
          const float qre = ((are - 1.f) * lre + aim * lim) / den, qim = (aim * lre - (are - 1.f) * lim) / den;
          const float* br = A.in[20] + ((size_t)lg * 64 + p) * 16; const float* bi = A.in[21] + ((size_t)lg * 64 + p) * 16;
          for (int c = 0; c < 16; ++c) { const float x = br[c], y = bi[c];
              BBt[(((size_t)lg * 2 + 0) * 64 + p) * 16 + c] = (bf16_t)f2bf(qre * x - qim * y); BBt[(((size_t)lg * 2 + 1) * 64 + p) * 16 + c] = (bf16_t)f2bf(qre * y + qim * x); } }
      for (int i = F.bid * NTHR + F.tid; i < 2 * 16 * 16 * 128; i += F.G * NTHR) { const int lg = i >> 11, ii = (i >> 7) & 15, k = i & 127;
          CCt[i] = (bf16_t)f2bf(k < 64 ? A.in[22][((size_t)lg * 16 + ii) * 64 + k] : -A.in[23][((size_t)lg * 16 + ii) * 64 + (k - 64)]); } }
    for (int l = 0; l < 2; ++l) {
        bf16_t* wm = WMLA + (size_t)l * 1024 * 512;
        zero_rows(wm, 512, 0, 384, 256, 256, F.gw, F.ngw, F.lane);
        zero_rows(wm, 512, 384, 512, 0, 256, F.gw, F.ngw, F.lane);
        zero_rows(wm, 512, 384, 512, 384, 128, F.gw, F.ngw, F.lane);
        zero_rows(wm, 512, 896, 128, 0, 512, F.gw, F.ngw, F.lane);
    }
}

DI void phase_win_quant(const Frame& F, CArgs& A) {
    LAS float* scr = (LAS float*)(F.lds + F.wave * 16640);
    const unsigned* IM = (const unsigned*)(A.ws + WS_CTL) + CW_INMAX;
    for (int it = F.gw; it < 2 * 16 * 33; it += F.ngw) { const int l = it / (16 * 33), r = it % (16 * 33), kb = r / 33, nb = r % 33;
        quant_item64(A.in[6] + (size_t)l * 1024 * D_IN, D_IN, 64 * kb, 64 * nb, (signed char*)(A.ws + WS_WIN) + (size_t)l * ZS * 1024, 1024, 64 * nb, 64 * kb, IM + l * ZS + 64 * nb,
                     kb == 0 ? (float*)(A.ws + WS_WINSC) + l * ZS + 64 * nb : (float*)nullptr, scr, F.lane, D_IN); }
}
DI void phase_norm1(const Frame& F, CArgs& A, int l) {
    const float* MODL = (const float*)(A.ws + WS_MOD) + (size_t)l * 8 * 6144;
    const float* g = A.in[5] + l * 1024;
    const bf16_t* Y = (const bf16_t*)(A.ws + WS_Y);
    signed char* H8 = (signed char*)(A.ws + WS_H); float* HS = (float*)(A.ws + WS_HSC);
    const float* src = (l == 0) ? A.in[0] : A.out;
    for (int row0 = 2 * F.gw; row0 < T; row0 += 2 * F.ngw) {
        const int b = row0 / SEQ;
        f32x4 v[2][4]; u32x2 ya[2][4], yb[2][4];
#pragma unroll
        for (int r = 0; r < 2; ++r)
#pragma unroll
            for (int j = 0; j < 4; ++j) { const int col = 4 * (64 * j + F.lane); v[r][j] = *(const f32x4*)(src + (size_t)(row0 + r) * DM + col);
                if (l > 0) { ya[r][j] = *(const u32x2*)(Y + (size_t)(2 * (row0 + r)) * DM + col); yb[r][j] = *(const u32x2*)(Y + (size_t)(2 * (row0 + r) + 1) * DM + col); } }
#pragma unroll
        for (int r = 0; r < 2; ++r) {
            const int row = row0 + r; float ss = 0.f;
#pragma unroll
            for (int j = 0; j < 4; ++j) { const int col = 4 * (64 * j + F.lane);
                if (l > 0) { const u32x2 y0 = ya[r][j], y1 = yb[r][j];
                    v[r][j][0] += bflo(y0.x) + bflo(y1.x); v[r][j][1] += bfhi(y0.x) + bfhi(y1.x); v[r][j][2] += bflo(y0.y) + bflo(y1.y); v[r][j][3] += bfhi(y0.y) + bfhi(y1.y);
                    *(f32x4*)(A.out + (size_t)row * DM + col) = v[r][j]; }
                ss += v[r][j][0] * v[r][j][0] + v[r][j][1] * v[r][j][1] + v[r][j][2] * v[r][j][2] + v[r][j][3] * v[r][j][3]; }
            const float rstd = rsqrtf(wave_sum(ss) * (1.f / DM) + NORM_EPS);
#pragma unroll
            for (int j = 0; j < 4; ++j) { const int col = 4 * (64 * j + F.lane);
                const f32x4 gg = *(const f32x4*)(g + col), sh = *(const f32x4*)(MODL + (size_t)b * 6144 + col), scv = *(const f32x4*)(MODL + (size_t)b * 6144 + 1024 + col);
                v[r][j] = v[r][j] * rstd * gg * (scv + 1.f) + sh; }
            float mx = 0.f;
#pragma unroll
            for (int j = 0; j < 4; ++j) mx = fmaxf(mx, fmaxf(fmaxf(fabsf(v[r][j][0]), fabsf(v[r][j][1])), fmaxf(fabsf(v[r][j][2]), fabsf(v[r][j][3]))));
            mx = fmaxf(wave_max(mx), 1e-30f); const float inv = 127.f / mx;
            if (F.lane == 0) HS[row] = mx * (1.f / 127.f);
#pragma unroll
            for (int j = 0; j < 4; ++j) *(unsigned*)(H8 + (size_t)row * DM + 4 * (64 * j + F.lane)) = q8x4(v[r][j], inv);
        }
    }
}

DI void phase_mla_prep(const Frame& F, CArgs& A, int l) {
    const bf16_t* Z = (const bf16_t*)(A.ws + WS_Z); bf16_t* AM = (bf16_t*)(A.ws + WS_AMLA);
    const float* qg = A.in[28] + l * 256; const float* kg = A.in[30] + l * 128;
    for (int row = F.gw; row < T; row += F.ngw) {
        const bf16_t* zr = Z + (size_t)row * ZS;
        const u32x2 qv = *(const u32x2*)(zr + ZC_QA + 4 * F.lane); const unsigned kv = *(const unsigned*)(zr + ZC_KVA + 2 * F.lane);
        const float q0 = bflo(qv.x), q1 = bfhi(qv.x), q2 = bflo(qv.y), q3 = bfhi(qv.y), k0 = bflo(kv), k1 = bfhi(kv);
        const float rq = rsqrtf(wave_sum(q0 * q0 + q1 * q1 + q2 * q2 + q3 * q3) * (1.f / 256.f) + NORM_EPS);
        const float rk = rsqrtf(wave_sum(k0 * k0 + k1 * k1) * (1.f / 128.f) + NORM_EPS);
        const f32x4 g4 = *(const f32x4*)(qg + 4 * F.lane); const f32x2 g2 = *(const f32x2*)(kg + 2 * F.lane);
        u32x2 o; o.x = pk2(q0 * rq * g4[0], q1 * rq * g4[1]); o.y = pk2(q2 * rq * g4[2], q3 * rq * g4[3]);
        bf16_t* ar = AM + (size_t)row * 512;
        *(u32x2*)(ar + 4 * F.lane) = o;
        *(unsigned*)(ar + 256 + 2 * F.lane) = pk2(k0 * rk * g2[0], k1 * rk * g2[1]);
        *(unsigned*)(ar + 384 + 2 * F.lane) = 0u;
    }
}

DI void phase_mla_post(const Frame& F, CArgs& A, int l) {
    const bf16_t* Z = (const bf16_t*)(A.ws + WS_Z); const bf16_t* RAW = (const bf16_t*)(A.ws + WS_QKVRAW);
    bf16_t* Q = (bf16_t*)(A.ws + WS_Q); bf16_t* K = (bf16_t*)(A.ws + WS_K); bf16_t* VT = (bf16_t*)(A.ws + WS_VT);
    LAS float* cs = (LAS float*)F.lds;
    LAS bf16_t* vt = (LAS bf16_t*)(F.lds + 8192);
    const float* qhg = A.in[32] + l * 96; const float* khg = A.in[33] + l * 96;
    for (int tile = F.bid; tile < T / 64; tile += F.G) {
        const int t0 = tile * 64, b = t0 / SEQ, s0 = t0 % SEQ;
        int tz = F.tid; asm volatile("" : "+v"(tz));
        for (int idx = tz; idx < 1024; idx += NTHR) { const int tok = idx >> 4, i = idx & 15;
            const int pos = A.pos_off[b] + s0 + tok; const float inv = powf(10000.f, -(float)i * (1.f / 16.f));
            double ang = (double)(float)pos * (double)inv; ang -= 6.283185307179586 * floor(ang * 0.15915494309189535);
            float sn, cn; sincosf((float)ang, &sn, &cn); cs[idx * 2] = cn; cs[idx * 2 + 1] = sn; }
        lds_barrier();
        const int tok = tz >> 3, sub = tz & 7, h = sub >> 1, isk = sub & 1, t = t0 + tok;
        {
            float v[96];
            const bf16_t* p0 = isk ? RAW + (size_t)t * 1024 + 384 + 128 * h : RAW + (size_t)t * 1024 + 96 * h;
            const bf16_t* p1 = isk ? Z + (size_t)t * ZS + ZC_KPE : p0 + 64;
#pragma unroll
            for (int c = 0; c < 8; ++c) { const u32x4 w = *(const u32x4*)(p0 + 8 * c);
                v[8 * c] = bflo(w.x); v[8 * c + 1] = bfhi(w.x); v[8 * c + 2] = bflo(w.y); v[8 * c + 3] = bfhi(w.y); v[8 * c + 4] = bflo(w.z); v[8 * c + 5] = bfhi(w.z); v[8 * c + 6] = bflo(w.w); v[8 * c + 7] = bfhi(w.w); }
#pragma unroll
            for (int c = 0; c < 4; ++c) { const u32x4 w = *(const u32x4*)(p1 + 8 * c);
                v[64 + 8 * c] = bflo(w.x); v[65 + 8 * c] = bfhi(w.x); v[66 + 8 * c] = bflo(w.y); v[67 + 8 * c] = bfhi(w.y); v[68 + 8 * c] = bflo(w.z); v[69 + 8 * c] = bfhi(w.z); v[70 + 8 * c] = bflo(w.w); v[71 + 8 * c] = bfhi(w.w); }
            float ss = 0.f;
#pragma unroll
            for (int i = 0; i < 96; ++i) ss += v[i] * v[i];
            const float r = rsqrtf(ss * (1.f / 96.f) + NORM_EPS) * (isk ? 1.f : 0.10206207261596577f * 1.4426950408889634f);
            const float* hg = isk ? khg : qhg;
#pragma unroll
            for (int i = 0; i < 96; ++i) v[i] = v[i] * r * hg[i];
#pragma unroll
            for (int i = 0; i < 16; ++i) { const float cn = cs[(tok * 16 + i) * 2], sn = cs[(tok * 16 + i) * 2 + 1]; const float x1 = v[64 + i], x2 = v[80 + i];
                v[64 + i] = x1 * cn - x2 * sn; v[80 + i] = x1 * sn + x2 * cn; }
            bf16_t* dst = (isk ? K : Q) + ((size_t)t * 4 + h) * 96;
#pragma unroll
            for (int c = 0; c < 12; ++c) { u32x4 w; w.x = pk2(v[8 * c], v[8 * c + 1]); w.y = pk2(v[8 * c + 2], v[8 * c + 3]); w.z = pk2(v[8 * c + 4], v[8 * c + 5]); w.w = pk2(v[8 * c + 6], v[8 * c + 7]);
                *(u32x4*)(dst + 8 * c) = w; }
        }
        {
            const bf16_t* pv = RAW + (size_t)t * 1024 + 384 + 128 * h + 64 + 32 * isk;
#pragma unroll
            for (int c = 0; c < 4; ++c) { const u32x4 w = *(const u32x4*)(pv + 8 * c); const int r0 = h * 64 + 32 * isk + 8 * c;
                vt[(r0 + 0) * 72 + tok] = (bf16_t)(w.x & 0xffffu); vt[(r0 + 1) * 72 + tok] = (bf16_t)(w.x >> 16);
                vt[(r0 + 2) * 72 + tok] = (bf16_t)(w.y & 0xffffu); vt[(r0 + 3) * 72 + tok] = (bf16_t)(w.y >> 16);
                vt[(r0 + 4) * 72 + tok] = (bf16_t)(w.z & 0xffffu); vt[(r0 + 5) * 72 + tok] = (bf16_t)(w.z >> 16);
                vt[(r0 + 6) * 72 + tok] = (bf16_t)(w.w & 0xffffu); vt[(r0 + 7) * 72 + tok] = (bf16_t)(w.w >> 16); }
        }
        lds_barrier();
        { const int row = tz >> 1, hf = tz & 1;
          bf16_t* dst = VT + ((size_t)(b * 4) * 64 + row) * SEQ + s0 + 32 * hf;
#pragma unroll
          for (int c = 0; c < 4; ++c) *(u32x4*)(dst + 8 * c) = *(const LAS u32x4*)(vt + row * 72 + 32 * hf + 8 * c); }
        lds_barrier();
    }
}

DI void attn_unit(const Frame& F, const bf16_t* Q, const bf16_t* K, const bf16_t* VT, bf16_t* O, int bh, int u, float eoff) {
    constexpr int KP = 208, VP = 144, KB = 64 * KP, VB = 64 * VP;
    LAS unsigned char* Ks = F.lds; LAS unsigned char* Vs = F.lds + 2 * KB;
    int tz = F.tid; asm volatile("" : "+v"(tz));
    const int b = bh >> 2, h = bh & 3, lane = tz & 63, w = F.wave, ql = lane & 31, hh = lane >> 5;
    const int ntile = 8 * u + 8, myl = 8 * u + w;
    const size_t tq0 = (size_t)b * SEQ + 512 * u + 64 * w + ql;
    bf16x8 qf[2][6];
#pragma unroll
    for (int qt = 0; qt < 2; ++qt)
#pragma unroll
        for (int s = 0; s < 6; ++s) qf[qt][s] = *(const bf16x8*)(Q + ((tq0 + 32 * qt) * 4 + h) * 96 + 16 * s + 8 * hh);
    f32x16 ot[2][2];
#pragma unroll
    for (int i = 0; i < 16; ++i) { ot[0][0][i] = 0.f; ot[0][1][i] = 0.f; ot[1][0][i] = 0.f; ot[1][1][i] = 0.f; }
    float lrun[2] = {0.f, 0.f};
    const float neoff = -eoff;
    const int kp0 = tz, kp1 = tz + 512;
    const size_t kbase = ((size_t)b * SEQ * 4 + h) * 96;
    const bf16_t* vsrc = VT + ((size_t)bh * 64 + (tz >> 3)) * SEQ + 8 * (tz & 7);
    u32x4 rk0, rk1, rv;
    rk1 = (u32x4){0u, 0u, 0u, 0u};
#define ATT_LOAD(j) do { rk0 = *(const u32x4*)(K + kbase + (size_t)(64 * (j) + kp0 / 12) * 384 + 8 * (kp0 % 12)); \
        if (kp1 < 768) rk1 = *(const u32x4*)(K + kbase + (size_t)(64 * (j) + kp1 / 12) * 384 + 8 * (kp1 % 12)); \
        rv = *(const u32x4*)(vsrc + 64 * (j)); } while (0)
#define ATT_STORE(jj) do { *(LAS u32x4*)(Ks + ((jj) & 1) * KB + (kp0 / 12) * KP + (kp0 % 12) * 16) = rk0; \
        if (kp1 < 768) *(LAS u32x4*)(Ks + ((jj) & 1) * KB + (kp1 / 12) * KP + (kp1 % 12) * 16) = rk1; \
        { LAS unsigned char* vd_ = Vs + ((jj) % 3) * VB + (tz >> 3) * VP + ((tz & 7) >> 1) * 32 + (tz & 1) * 8; *(LAS u32x2*)vd_ = (u32x2){rv.x, rv.y}; *(LAS u32x2*)(vd_ + 16) = (u32x2){rv.z, rv.w}; } } while (0)
#define ATT_PV(vb, ktp) do { _Pragma("unroll") for (int c = 0; c < 2; ++c) { \
        _Pragma("unroll") for (int dt = 0; dt < 2; ++dt) { const bf16x8 vf = *(const LAS bf16x8*)(Vs + (vb) * VB + (32 * dt + ql) * VP + (32 * (ktp) + 16 * c) * 2 + 16 * hh); \
            ot[dt][0] = __builtin_amdgcn_mfma_f32_32x32x16_bf16(vf, pfo[0][c], ot[dt][0], 0, 0, 0); ot[dt][1] = __builtin_amdgcn_mfma_f32_32x32x16_bf16(vf, pfo[1][c], ot[dt][1], 0, 0, 0); } } } while (0)
#define ATT_SM() do { _Pragma("unroll") for (int qt = 0; qt < 2; ++qt) { f32x2 ps = {0.f, 0.f}; \
        _Pragma("unroll") for (int i = 0; i < 16; i += 2) { const float p0 = __builtin_amdgcn_exp2f(st[qt][i]), p1 = __builtin_amdgcn_exp2f(st[qt][i + 1]); st[qt][i] = p0; st[qt][i + 1] = p1; ps += (f32x2){p0, p1}; } \
        lrun[qt] += ps[0] + ps[1]; \
        _Pragma("unroll") for (int c = 0; c < 2; ++c) { u32x4 pw; pw.x = pk2(st[qt][8 * c], st[qt][8 * c + 1]); pw.y = pk2(st[qt][8 * c + 2], st[qt][8 * c + 3]); pw.z = pk2(st[qt][8 * c + 4], st[qt][8 * c + 5]); pw.w = pk2(st[qt][8 * c + 6], st[qt][8 * c + 7]); \
            pfn[qt][c] = __builtin_bit_cast(bf16x8, pw); } } } while (0)
#define ATT_MIX() do { _Pragma("unroll") for (int g_ = 0; g_ < 4; ++g_) { __builtin_amdgcn_sched_group_barrier(0x100, 2, 0); __builtin_amdgcn_sched_group_barrier(0x008, 1, 0); __builtin_amdgcn_sched_group_barrier(0x002, 14, 0); \
        __builtin_amdgcn_sched_group_barrier(0x008, 1, 0); __builtin_amdgcn_sched_group_barrier(0x002, 14, 0); } } while (0)
    ATT_LOAD(0); ATT_STORE(0);
    lds_barrier();
    bf16x8 pfo[2][2], pfn[2][2];
    bool owed = false;
    for (int j = 0; j < ntile; ++j) {
        if (j + 1 < ntile) ATT_LOAD(j + 1);
        if (j <= myl) {
#pragma unroll
            for (int kt = 0; kt < 2; ++kt) {
                f32x16 st[2];
#pragma unroll
                for (int i = 0; i < 16; ++i) { st[0][i] = neoff; st[1][i] = neoff; }
                __builtin_amdgcn_s_setprio(1);
#pragma unroll
                for (int s = 0; s < 6; ++s) { const bf16x8 kf = *(const LAS bf16x8*)(Ks + (j & 1) * KB + (32 * kt + ql) * KP + (16 * s + 8 * hh) * 2);
                    st[0] = __builtin_amdgcn_mfma_f32_32x32x16_bf16(kf, qf[0][s], st[0], 0, 0, 0);
                    st[1] = __builtin_amdgcn_mfma_f32_32x32x16_bf16(kf, qf[1][s], st[1], 0, 0, 0); }
                __builtin_amdgcn_s_setprio(0);
                __builtin_amdgcn_sched_barrier(0);
                if (kt == 0) { if (owed) { ATT_PV((j + 2) % 3, 1); ATT_SM(); ATT_MIX(); } else { ATT_SM(); } }
                else { ATT_PV(j % 3, 0); ATT_SM(); ATT_MIX(); }
                __builtin_amdgcn_sched_barrier(0);
#pragma unroll
                for (int qt = 0; qt < 2; ++qt) { pfo[qt][0] = pfn[qt][0]; pfo[qt][1] = pfn[qt][1]; }
            }
            owed = true;
        } else if (owed) { ATT_PV(myl % 3, 1); owed = false; }
        if (j + 1 < ntile) ATT_STORE(j + 1);
        lds_barrier();
    }
    if (owed) ATT_PV(myl % 3, 1);
#undef ATT_LOAD
#undef ATT_STORE
#undef ATT_PV
#undef ATT_SM
#undef ATT_MIX
    int lz2 = lane; asm volatile("" : "+v"(lz2));
    const unsigned tqe = (unsigned)(b * SEQ + 512 * u + 64 * w + (lz2 & 31));
#pragma unroll
    for (int qt = 0; qt < 2; ++qt) {
        const float linv = 1.f / (lrun[qt] + shfl_xor_l(lrun[qt], 32, lane));
        bf16_t* orow = O + (size_t)(tqe + 32 * qt) * 256 + h * 64;
#pragma unroll
        for (int dt = 0; dt < 2; ++dt)
#pragma unroll
            for (int g = 0; g < 4; ++g) { u32x2 o; o.x = pk2(ot[dt][qt][4 * g] * linv, ot[dt][qt][4 * g + 1] * linv); o.y = pk2(ot[dt][qt][4 * g + 2] * linv, ot[dt][qt][4 * g + 3] * linv);
                *(u32x2*)(orow + 32 * dt + 8 * g + 4 * hh) = o; }
    }
    lds_barrier();
}
DI void phase_attn(const Frame& F, CArgs& A, int l) {
    const bf16_t* Q = (const bf16_t*)(A.ws + WS_Q); const bf16_t* K = (const bf16_t*)(A.ws + WS_K); const bf16_t* VT = (const bf16_t*)(A.ws + WS_VT);
    bf16_t* O = (bf16_t*)(A.ws + WS_ATTO);
    float gq = 0.f, gk = 0.f;
    for (int i = 0; i < 96; ++i) { gq = fmaxf(gq, fabsf(A.in[32][l * 96 + i])); gk = fmaxf(gk, fabsf(A.in[33][l * 96 + i])); }
    const float eoff = 96.f * gq * gk * 0.10206207261596577f * 1.4426950408889634f * 1.0001f;
    for (int p = F.bid; p < 256; p += F.G) { const int bh = p >> 3, u = p & 7;
        attn_unit(F, Q, K, VT, O, bh, 15 - u, eoff);
        attn_unit(F, Q, K, VT, O, bh, u, eoff); }
}
DI f32x16 mfma32(bf16x8 a, bf16x8 b, f32x16 c) { return __builtin_amdgcn_mfma_f32_32x32x16_bf16(a, b, c, 0, 0, 0); }
DI bf16x8 ldfrag(const LAS unsigned char* base, int row, int ks, int h) { return *(const LAS bf16x8*)(base + row * 144 + (16 * ks + 8 * h) * 2); }
DI f32x16 zero16() { f32x16 z;
#pragma unroll
    for (int i = 0; i < 16; ++i) z[i] = 0.f;
    return z; }
DI bf16x8 pack8(const f32x16& x, int o) { u32x4 p; p.x = pk2(x[o], x[o + 1]); p.y = pk2(x[o + 2], x[o + 3]); p.z = pk2(x[o + 4], x[o + 5]); p.w = pk2(x[o + 6], x[o + 7]); return __builtin_bit_cast(bf16x8, p); }
DI f32x16 tileprod(const LAS unsigned char* Aimg, int a0, const LAS unsigned char* Bimg, int b0, f32x16 acc, int lr, int h2) {
#pragma unroll
    for (int ks = 0; ks < 4; ++ks) acc = mfma32(ldfrag(Aimg, a0 + lr, ks, h2), ldfrag(Bimg, b0 + lr, ks, h2), acc);
    return acc;
}
DI void put_tile(LAS unsigned char* img, int c0, int r0, const f32x16& a, int lr, int h2) {
#pragma unroll
    for (int g = 0; g < 4; ++g) { u32x2 o; o.x = pk2(a[4 * g], a[4 * g + 1]); o.y = pk2(a[4 * g + 2], a[4 * g + 3]); *(LAS u32x2*)(img + (c0 + lr) * 144 + (r0 + 8 * g + 4 * h2) * 2) = o; }
}
DI void phase_rwkv_A(const Frame& F, CArgs& A, int l) {
    const bf16_t* Z = (const bf16_t*)(A.ws + WS_Z); bf16_t* V_ = (bf16_t*)(A.ws + WS_RW_V); bf16_t* G_ = (bf16_t*)(A.ws + WS_RW_G);
    const float* mu = A.in[7] + l * 896; const float* w0 = A.in[8] + l * 256; const float* a0 = A.in[10] + l * 256; const float* k_k = A.in[13] + l * 256; const float* k_a = A.in[14] + l * 256;
    const bf16_t* WO = (const bf16_t*)(A.ws + WS_WLORA) + (size_t)l * 32768;
    bf16_t* RP = (bf16_t*)(A.ws + WS_RC_RP); float* Y0T = (float*)(A.ws + WS_RC_Y0); unsigned char* REC = A.ws + WS_RC_G;
    float* BSUM = (float*)(A.ws + WS_RC_BS);
    const float* r_k = A.in[15] + l * 256;
    constexpr int TB = 64 * 144;
#define TILE(i) (F.lds + (i) * TB)
    LAS float* XF = (LAS float*)TILE(13);
    const int w = F.wave;
    for (int ub = F.bid; ub < 1024; ub += F.G) {
      const int b = ub >> 7, c = ub & 127;
      const size_t t0 = (size_t)b * SEQ + 64 * c;
      bf16x8 xf[4];
      {
        int tid = F.tid; asm volatile("" : "+v"(tid)); const int lane = tid & 63, fr = lane & 15, fq = lane >> 4, mt = w & 3;
        const int tk = 16 * mt + fr; const size_t t = t0 + tk; const bool hp = (64 * c + tk) > 0;
        const bf16_t* zr = Z + t * ZS + ZC_WLO + 8 * fq;
#pragma unroll
        for (int ks = 0; ks < 4; ++ks) {
            const u32x4 zc = *(const u32x4*)(zr + 32 * ks); u32x4 zp = {0u, 0u, 0u, 0u}; if (hp) zp = *(const u32x4*)(zr + 32 * ks - ZS);
            const f32x4 m0 = *(const f32x4*)(mu + ZC_WLO + 32 * ks + 8 * fq), m1 = *(const f32x4*)(mu + ZC_WLO + 32 * ks + 8 * fq + 4);
            const unsigned cw[4] = {zc.x, zc.y, zc.z, zc.w}, pw[4] = {zp.x, zp.y, zp.z, zp.w}; const float mm[8] = {m0[0], m0[1], m0[2], m0[3], m1[0], m1[1], m1[2], m1[3]};
            float v[8];
#pragma unroll
            for (int i = 0; i < 8; ++i) { const float zcv = (i & 1) ? bfhi(cw[i >> 1]) : bflo(cw[i >> 1]), zpv = (i & 1) ? bfhi(pw[i >> 1]) : bflo(pw[i >> 1]);
                float x = zcv + (zpv - zcv) * mm[i]; if (ks == 0) x = fast_tanh(x); else if (ks >= 2) x = sigmoidf_(x); v[i] = x; }
            u32x4 o; o.x = pk2(v[0], v[1]); o.y = pk2(v[2], v[3]); o.z = pk2(v[4], v[5]); o.w = pk2(v[6], v[7]); xf[ks] = __builtin_bit_cast(bf16x8, o);
        }
      }
      for (int hd = 0; hd < 4; ++hd) {
        const int u = (b * 4 + hd) * 128 + c;
        {
        int tid = F.tid; asm volatile("" : "+v"(tid)); const int lane = tid & 63, fr = lane & 15, fq = lane >> 4, mt = w & 3, nh = w >> 2;
        const int tk = 16 * mt + fr; const size_t t = t0 + tk; const bool hp = (64 * c + tk) > 0;
        LAS float* hs = (LAS float*)TILE(12);
        f32x4 aw[2], aa[2], ag[2];
        {
#pragma unroll
            for (int nf = 0; nf < 2; ++nf) { const int ch = hd * 64 + 32 * nh + 8 * (fr >> 2) + 4 * nf + (fr & 3);     const f32x4 z4 = {0.f, 0.f, 0.f, 0.f};
                aw[nf] = __builtin_amdgcn_mfma_f32_16x16x32_bf16(*(const bf16x8*)(WO + ch * 32 + 8 * fq), xf[0], z4, 0, 0, 0);
                aa[nf] = __builtin_amdgcn_mfma_f32_16x16x32_bf16(*(const bf16x8*)(WO + 8192 + ch * 32 + 8 * fq), xf[1], z4, 0, 0, 0);
                ag[nf] = __builtin_amdgcn_mfma_f32_16x16x32_bf16(*(const bf16x8*)(WO + 16384 + ch * 64 + 8 * fq), xf[2], z4, 0, 0, 0);
                ag[nf] = __builtin_amdgcn_mfma_f32_16x16x32_bf16(*(const bf16x8*)(WO + 16384 + ch * 64 + 32 + 8 * fq), xf[3], ag[nf], 0, 0, 0); }
        }
        f32x4 rr[2], kq[2], km[2], vv4[2], lw4[2], a4[2];
        float ssq = 0.f, bsp = 0.f;
#pragma unroll
        for (int nf = 0; nf < 2; ++nf) { const int d4 = 32 * nh + 8 * fq + 4 * nf, ch4 = hd * 64 + d4;
            const u32x2 rc = *(const u32x2*)(Z + t * ZS + ZC_R + ch4), kc = *(const u32x2*)(Z + t * ZS + ZC_K + ch4), vc = *(const u32x2*)(Z + t * ZS + ZC_V + ch4);
            u32x2 rp = {0u, 0u}, kp = {0u, 0u}, vp = {0u, 0u};
            if (hp) { rp = *(const u32x2*)(Z + (t - 1) * ZS + ZC_R + ch4); kp = *(const u32x2*)(Z + (t - 1) * ZS + ZC_K + ch4); vp = *(const u32x2*)(Z + (t - 1) * ZS + ZC_V + ch4); }
            const f32x4 mr = *(const f32x4*)(mu + ZC_R + ch4), mk = *(const f32x4*)(mu + ZC_K + ch4), mv = *(const f32x4*)(mu + ZC_V + ch4), ka = *(const f32x4*)(k_a + ch4), kkw = *(const f32x4*)(k_k + ch4), rk4 = *(const f32x4*)(r_k + ch4);
            const f32x4 rcv = {bflo(rc.x), bfhi(rc.x), bflo(rc.y), bfhi(rc.y)}, rpv = {bflo(rp.x), bfhi(rp.x), bflo(rp.y), bfhi(rp.y)};
            const f32x4 kcv = {bflo(kc.x), bfhi(kc.x), bflo(kc.y), bfhi(kc.y)}, kpv = {bflo(kp.x), bfhi(kp.x), bflo(kp.y), bfhi(kp.y)};
            const f32x4 vcv = {bflo(vc.x), bfhi(vc.x), bflo(vc.y), bfhi(vc.y)}, vpv = {bflo(vp.x), bfhi(vp.x), bflo(vp.y), bfhi(vp.y)};
            const f32x4 r = rcv + (rpv - rcv) * mr, k = kcv + (kpv - kcv) * mk, v = vcv + (vpv - vcv) * mv;
            const f32x4 wv = aw[nf] + *(const f32x4*)(w0 + ch4), av = aa[nf] + *(const f32x4*)(a0 + ch4);
#pragma unroll
            for (int i = 0; i < 4; ++i) { lw4[nf][i] = -__expf(-fast_softplus(-wv[i]) - 0.5f); a4[nf][i] = sigmoidf_(av[i]); kq[nf][i] = k[i] * kkw[i]; km[nf][i] = k[i] * (1.f + (a4[nf][i] - 1.f) * ka[i]);
                ssq += kq[nf][i] * kq[nf][i]; bsp += r[i] * km[nf][i] * rk4[i]; }
            rr[nf] = r; vv4[nf] = v;
            *(LAS f32x4*)(XF + tk * 64 + d4) = lw4[nf];
            u32x2 p; p.x = pk2(ag[nf][0], ag[nf][1]); p.y = pk2(ag[nf][2], ag[nf][3]); *(u32x2*)(G_ + t * 256 + ch4) = p;
            p.x = pk2(v[0], v[1]); p.y = pk2(v[2], v[3]); *(u32x2*)(V_ + t * 256 + ch4) = p;
        }
        ssq += shfl_xor_l(ssq, 16, lane); ssq += shfl_xor_l(ssq, 32, lane); bsp += shfl_xor_l(bsp, 16, lane); bsp += shfl_xor_l(bsp, 32, lane);
        if (fq == 0) { hs[nh * 64 + tk] = ssq; hs[128 + nh * 64 + tk] = bsp; }
        lds_barrier();
        if (w == 0) { float cv[64];
#pragma unroll
            for (int i = 0; i < 64; ++i) cv[i] = XF[i * 64 + lane];
            float run = 0.f;
#pragma unroll
            for (int i = 0; i < 64; ++i) { run += cv[i]; XF[i * 64 + lane] = run; } }
        if (w == 1) BSUM[(t0 + lane) * 4 + hd] = hs[128 + lane] + hs[192 + lane];
        lds_barrier();
        const float rn = rsqrtf(fmaxf(hs[tk] + hs[64 + tk], 1e-24f));
#pragma unroll
        for (int nf = 0; nf < 2; ++nf) { const int d4 = 32 * nh + 8 * fq + 4 * nf;
            const f32x4 cum = *(const LAS f32x4*)(XF + tk * 64 + d4), c63 = *(const LAS f32x4*)(XF + 63 * 64 + d4);
            f32x4 al, bt, kt, rb, bhh, khh;
#pragma unroll
            for (int i = 0; i < 4; ++i) { const float kk = kq[nf][i] * rn; const float ec = __expf(cum[i]), em = __builtin_amdgcn_rcpf(ec), ep = __expf(cum[i] - lw4[nf][i]), p63 = __expf(c63[i]);
                al[i] = -kk * ep; bt[i] = kk * a4[nf][i] * em; kt[i] = km[nf][i] * em; rb[i] = rr[nf][i] * ec; bhh[i] = bt[i] * p63; khh[i] = kt[i] * p63;
                if (tk == 63) *(float*)(REC + (size_t)u * RC_REC + 24576 + (d4 + i) * 4) = p63; }
            u32x2 o;
            o.x = pk2(al[0], al[1]); o.y = pk2(al[2], al[3]); *(LAS u32x2*)(TILE(0) + tk * 144 + d4 * 2) = o;
            o.x = pk2(bt[0], bt[1]); o.y = pk2(bt[2], bt[3]); *(LAS u32x2*)(TILE(1) + tk * 144 + d4 * 2) = o;
            o.x = pk2(kt[0], kt[1]); o.y = pk2(kt[2], kt[3]); *(LAS u32x2*)(TILE(2) + tk * 144 + d4 * 2) = o;
            o.x = pk2(rb[0], rb[1]); o.y = pk2(rb[2], rb[3]); *(LAS u32x2*)(TILE(3) + tk * 144 + d4 * 2) = o;
#pragma unroll
            for (int i = 0; i < 4; ++i) { *(LAS bf16_t*)(TILE(4) + (d4 + i) * 144 + tk * 2) = (bf16_t)f2bf(vv4[nf][i]); *(LAS bf16_t*)(TILE(5) + (d4 + i) * 144 + tk * 2) = (bf16_t)f2bf(bhh[i]);
                *(LAS bf16_t*)(TILE(6) + (d4 + i) * 144 + tk * 2) = (bf16_t)f2bf(khh[i]); *(LAS bf16_t*)(TILE(7) + (d4 + i) * 144 + tk * 2) = (bf16_t)f2bf(al[i]); }
        }
        }
        lds_barrier();
        f32x16 Tacc = zero16();
        {
        int tl = F.tid; asm volatile("" : "+v"(tl)); const int lane = tl & 63, lr = lane & 31, h2 = lane >> 5;
        unsigned zz = 0u; asm volatile("" : "+v"(zz));
        for (int i = tl; i < 768; i += NTHR) { const int q = i >> 7, rr = (i & 127) >> 2, cc = i & 3; const int tile = q < 4 ? 8 + q : q == 4 ? 14 : 12;
            *(LAS u32x4*)(TILE(tile) + (q == 5 ? (32 + rr) * 144 : rr * 144 + 64) + cc * 16) = (u32x4){zz, zz, zz, zz}; }
#pragma unroll
        for (int rnd = 0; rnd < 2; ++rnd) {
            const int j = w + 8 * rnd;
            if (j < 15) {
                const int prod = j / 3, tile = j % 3, si = tile == 2 ? 1 : 0, ti = tile == 0 ? 0 : 1;
                if (prod == 1) {
                    f32x16 acc = tileprod(TILE(0), 32 * ti, TILE(1), 32 * si, zero16(), lr, h2);
                    const int ss = 32 * si + lr;
#pragma unroll
                    for (int q = 0; q < 16; ++q) { const int tt = 32 * ti + 8 * (q >> 2) + 4 * h2 + (q & 3); if (!(ss < tt)) acc[q] = 0.f; }
                    put_tile(TILE(12), 32 * si, 32 * ti, acc, lr, h2);
                } else {
                    const LAS unsigned char* Ao = (prod == 0 || prod == 3) ? TILE(1) : TILE(2); const LAS unsigned char* Bo = prod >= 3 ? TILE(3) : TILE(0);
                    f32x16 acc = tileprod(Ao, 32 * si, Bo, 32 * ti, zero16(), lr, h2);
                    const int tt = 32 * ti + lr, incl = prod >= 3 ? 1 : 0;
#pragma unroll
                    for (int q = 0; q < 16; ++q) { const int ss = 32 * si + 8 * (q >> 2) + 4 * h2 + (q & 3); if (!(ss < tt + incl)) acc[q] = 0.f; }
                    if (prod == 0) { put_tile(TILE(11), 32 * ti, 32 * si, acc, lr, h2);
#pragma unroll
                        for (int q = 0; q < 16; ++q) { const int ss = 32 * si + 8 * (q >> 2) + 4 * h2 + (q & 3); Tacc[q] = acc[q] + (ss == tt ? 1.f : 0.f); }
                        put_tile(TILE(14), 32 * ti, 32 * si, Tacc, lr, h2);
                    } else put_tile(TILE(prod == 2 ? 8 : prod == 3 ? 9 : 10), 32 * ti, 32 * si, acc, lr, h2);
                }
            }
        }
        }
        lds_barrier();
        {
        int tl = F.tid; asm volatile("" : "+v"(tl)); const int lane = tl & 63, lr = lane & 31, h2 = lane >> 5;
        if (tl < 384) { const int q = tl >> 7, rr = (tl & 127) >> 2, cc = tl & 3;
            unsigned zz = 0u; asm volatile("" : "+v"(zz));
            *(LAS u32x4*)(TILE(q) + (q == 1 ? (32 + rr) * 144 : rr * 144 + 64) + cc * 16) = (u32x4){zz, zz, zz, zz}; }
        lds_barrier();
#pragma unroll
        for (int k = 1; k <= 5; ++k) {
            LAS unsigned char* Ss = (k & 1) ? TILE(11) : TILE(0); LAS unsigned char* STs = (k & 1) ? TILE(12) : TILE(1);
            LAS unsigned char* Sd = (k & 1) ? TILE(0) : TILE(11); LAS unsigned char* STd = (k & 1) ? TILE(1) : TILE(12);
            LAS unsigned char* Ts = (k & 1) ? TILE(14) : TILE(2); LAS unsigned char* Td = (k & 1) ? TILE(2) : TILE(14);
            if (w < 6) { const int tile = w % 3, ti = tile == 0 ? 0 : 1, si = tile == 2 ? 1 : 0;
                if (w < 3) { f32x16 acc = tileprod(Ss, 32 * ti, STs, 32 * si, zero16(), lr, h2); put_tile(STd, 32 * si, 32 * ti, acc, lr, h2); }
                else { f32x16 acc = tileprod(STs, 32 * si, Ss, 32 * ti, zero16(), lr, h2); put_tile(Sd, 32 * ti, 32 * si, acc, lr, h2); }
            } else if (k == 1) {
#pragma unroll
                for (int jj = 0; jj < 2; ++jj) { const int tile = (w - 6) * 2 + jj, ti = tile >> 1, ei = tile & 1;
                    f32x16 acc = tileprod(TILE(8), 32 * ti, TILE(4), 32 * ei, zero16(), lr, h2); put_tile(TILE(13), 32 * ei, 32 * ti, acc, lr, h2); }
            }
            lds_barrier();
            if (w < 3) { const int si = w == 2 ? 1 : 0, ti = w == 0 ? 0 : 1;
                Tacc = tileprod(STd, 32 * si, Ts, 32 * ti, Tacc, lr, h2); put_tile(Td, 32 * ti, 32 * si, Tacc, lr, h2); }
        }
        lds_barrier();
        { const int tile = w & 3, ti = tile >> 1, ci = tile & 1;
          f32x16 acc = tileprod(TILE(2), 32 * ti, w < 4 ? TILE(13) : TILE(7), 32 * ci, zero16(), lr, h2); put_tile(w < 4 ? TILE(11) : TILE(12), 32 * ci, 32 * ti, acc, lr, h2); }
        }
        lds_barrier();
        {
        int tl = F.tid; asm volatile("" : "+v"(tl)); const int lane = tl & 63, lr = lane & 31, h2 = lane >> 5; const int tj = w & 3, ta = tj >> 1, tb = tj & 1;
        if (w < 4) {
            { f32x16 acc = tileprod(TILE(12), 32 * ta, TILE(9), 32 * tb, zero16(), lr, h2);
              const int tt = 32 * tb + lr;
#pragma unroll
              for (int g = 0; g < 4; ++g) { const int dd = 32 * ta + 8 * g + 4 * h2; const u32x2 rbv = *(const LAS u32x2*)(TILE(3) + tt * 144 + dd * 2);
                  u32x2 o; o.x = pk2(acc[4 * g] + bflo(rbv.x), acc[4 * g + 1] + bfhi(rbv.x)); o.y = pk2(acc[4 * g + 2] + bflo(rbv.y), acc[4 * g + 3] + bfhi(rbv.y));
                  *(u32x2*)(RP + ((size_t)u * 64 + tt) * 64 + dd) = o; } }
            { f32x16 acc = tileprod(TILE(12), 32 * ta, TILE(5), 32 * tb, zero16(), lr, h2);
              const int dcol = 32 * tb + lr;
#pragma unroll
              for (int g = 0; g < 4; ++g) { u32x2 o; o.x = pk2(acc[4 * g], acc[4 * g + 1]); o.y = pk2(acc[4 * g + 2], acc[4 * g + 3]);
                  *(u32x2*)(REC + (size_t)u * RC_REC + ((((dcol >> 4) * 2 + ta) * 64 + (2 * (g & 1) + h2) * 16 + (dcol & 15)) * 16) + 8 * (g >> 1)) = o; } }
        } else {
            f32x16 z2 = tileprod(TILE(4), 32 * ta, TILE(10), 32 * tb, zero16(), lr, h2);
            z2 = tileprod(TILE(11), 32 * ta, TILE(9), 32 * tb, z2, lr, h2);
            float* yo = Y0T + ((size_t)u * 64 + 32 * tb + lr) * 64 + 32 * ta + 4 * h2;
#pragma unroll
            for (int g = 0; g < 4; ++g) *(f32x4*)(yo + 8 * g) = (f32x4){z2[4 * g], z2[4 * g + 1], z2[4 * g + 2], z2[4 * g + 3]};
            f32x16 acc = tileprod(TILE(5), 32 * ta, TILE(11), 32 * tb, zero16(), lr, h2);
            acc = tileprod(TILE(6), 32 * ta, TILE(4), 32 * tb, acc, lr, h2);
            const int ecol = 32 * tb + lr;
#pragma unroll
            for (int g = 0; g < 4; ++g) *(f32x4*)(REC + (size_t)u * RC_REC + 8192 + ((((ecol >> 4) * 4 + 2 * ta + (g >> 1)) * 64 + (2 * (g & 1) + h2) * 16 + (ecol & 15)) * 16)) = (f32x4){acc[4 * g], acc[4 * g + 1], acc[4 * g + 2], acc[4 * g + 3]};
        }
        }
        lds_barrier();
      }
    }
#undef TILE
}
DI void phase_rwkv_B(const Frame& F, CArgs& A) {
    if (F.bid >= 32) return;
    const unsigned char* REC = A.ws + WS_RC_G; bf16_t* HB = (bf16_t*)(A.ws + WS_RC_HB);
    constexpr int SLOT = 25600, NSLOT = 6;
    const int bh = F.bid, w = F.wave, lane = F.lane, fr = lane & 15, fq = lane >> 4;
    const unsigned char* rec0 = REC + (size_t)bh * 128 * RC_REC;
    if (w >= 4) {
        const int lw = w - 4;
#define RB_ISSUE2(cs, cr) do { const unsigned char* r_ = rec0 + (size_t)(cr) * RC_REC; LAS unsigned char* s_ = F.lds + ((cs) % NSLOT) * SLOT; \
        _Pragma("unroll") for (int k = 0; k < 6; ++k) __builtin_amdgcn_global_load_lds((const unsigned*)(r_ + (lw + 4 * k) * 1024 + lane * 16), (LAS unsigned*)(s_ + (lw + 4 * k) * 1024), 16, 0, 0); \
        if (lw == 3) __builtin_amdgcn_global_load_lds((const unsigned*)(r_ + 24576 + lane * 4), (LAS unsigned*)(s_ + 24576), 4, 0, 0); } while (0)
        RB_ISSUE2(0, 0); RB_ISSUE2(1, 1); RB_ISSUE2(2, 2); RB_ISSUE2(3, 3); RB_ISSUE2(4, 4);
        if (lw == 3) asm volatile("s_waitcnt vmcnt(28)" ::: "memory"); else asm volatile("s_waitcnt vmcnt(24)" ::: "memory");
        __builtin_amdgcn_s_barrier();
        for (int c = 0; c < 128; ++c) {
            RB_ISSUE2(c + 5, (c + 5 < 128) ? c + 5 : 127);
            if (lw == 3) asm volatile("s_waitcnt vmcnt(28)" ::: "memory"); else asm volatile("s_waitcnt vmcnt(24)" ::: "memory");
            __builtin_amdgcn_s_barrier();
        }
        asm volatile("s_waitcnt vmcnt(0)" ::: "memory");
#undef RB_ISSUE2
    } else {
        const int ew = w;
        f32x4 acc[4];
#pragma unroll
        for (int dt = 0; dt < 4; ++dt) acc[dt] = (f32x4){0.f, 0.f, 0.f, 0.f};
        __builtin_amdgcn_s_barrier();
        for (int c = 0; c < 128; ++c) {
            const size_t u = (size_t)bh * 128 + c;
            const LAS unsigned char* sl = F.lds + (c % NSLOT) * SLOT;
            bf16x8 hb[2];
#pragma unroll
            for (int sk = 0; sk < 2; ++sk) { u32x4 p; p.x = pk2(acc[2 * sk][0], acc[2 * sk][1]); p.y = pk2(acc[2 * sk][2], acc[2 * sk][3]); p.z = pk2(acc[2 * sk + 1][0], acc[2 * sk + 1][1]); p.w = pk2(acc[2 * sk + 1][2], acc[2 * sk + 1][3]);
                hb[sk] = __builtin_bit_cast(bf16x8, p); *(bf16x8*)(HB + (((u * 4 + ew) * 2 + sk) * 64 + lane) * 8) = hb[sk]; }
#pragma unroll
            for (int dt = 0; dt < 4; ++dt) {
                const f32x4 g4 = *(const LAS f32x4*)(sl + 8192 + ((ew * 4 + dt) * 64 + lane) * 16), d4 = *(const LAS f32x4*)(sl + 24576 + (16 * dt + 4 * fq) * 4);
                const bf16x8 m0 = *(const LAS bf16x8*)(sl + ((dt * 2 + 0) * 64 + lane) * 16), m1 = *(const LAS bf16x8*)(sl + ((dt * 2 + 1) * 64 + lane) * 16);
                f32x4 n = d4 * acc[dt] + g4;
                n = __builtin_amdgcn_mfma_f32_16x16x32_bf16(m0, hb[0], n, 0, 0, 0); n = __builtin_amdgcn_mfma_f32_16x16x32_bf16(m1, hb[1], n, 0, 0, 0); acc[dt] = n; }
            asm volatile("s_waitcnt lgkmcnt(0)" ::: "memory");
            __builtin_amdgcn_s_barrier();
        }
    }
}
DI void phase_rwkv_C(const Frame& F, CArgs& A, int l) {
    const bf16_t* RP = (const bf16_t*)(A.ws + WS_RC_RP); const float* Y0 = (const float*)(A.ws + WS_RC_Y0); const bf16_t* HB = (const bf16_t*)(A.ws + WS_RC_HB); const float* BSUM = (const float*)(A.ws + WS_RC_BS);
    const bf16_t* V_ = (const bf16_t*)(A.ws + WS_RW_V); const bf16_t* G_ = (const bf16_t*)(A.ws + WS_RW_G); bf16_t* MIX = (bf16_t*)(A.ws + WS_MIX);
    const float* ln_w = A.in[16] + l * 256; const float* ln_b = A.in[17] + l * 256;
    for (int job = F.gw; job < 4096; job += F.ngw) {
        int lz = F.lane; asm volatile("" : "+v"(lz)); const int lane = lz, fr = lane & 15, fq = lane >> 4;
        const size_t u = (size_t)job; const int bh = job >> 7, c = job & 127, b = bh >> 2, hd = bh & 3;
        bf16x8 hf[4][2];
#pragma unroll
        for (int et = 0; et < 4; ++et)
#pragma unroll
            for (int sk = 0; sk < 2; ++sk) hf[et][sk] = *(const bf16x8*)(HB + (((u * 4 + et) * 2 + sk) * 64 + lane) * 8);
#pragma unroll
        for (int tb = 0; tb < 4; ++tb) {
            const size_t tok = (size_t)b * SEQ + 64 * c + 16 * tb + fr;
            const bf16_t* rrow = RP + (u * 64 + 16 * tb + fr) * 64 + 4 * fq;
            bf16x8 bfr[2];
#pragma unroll
            for (int sk = 0; sk < 2; ++sk) { const u32x2 m0 = *(const u32x2*)(rrow + 32 * sk), m1 = *(const u32x2*)(rrow + 32 * sk + 16); u32x4 mw; mw.x = m0.x; mw.y = m0.y; mw.z = m1.x; mw.w = m1.y; bfr[sk] = __builtin_bit_cast(bf16x8, mw); }
            f32x4 y[4]; float sm = 0.f;
#pragma unroll
            for (int et = 0; et < 4; ++et) { y[et] = *(const f32x4*)(Y0 + (u * 64 + 16 * tb + fr) * 64 + 16 * et + 4 * fq);
                y[et] = __builtin_amdgcn_mfma_f32_16x16x32_bf16(hf[et][0], bfr[0], y[et], 0, 0, 0); y[et] = __builtin_amdgcn_mfma_f32_16x16x32_bf16(hf[et][1], bfr[1], y[et], 0, 0, 0); }
#pragma unroll
            for (int et = 0; et < 4; ++et) sm += (y[et][0] + y[et][1]) + (y[et][2] + y[et][3]);
            sm += shfl_xor_l(sm, 16, lane); sm += shfl_xor_l(sm, 32, lane); const float mean = sm * (1.f / 64.f);
            float sq = 0.f;
#pragma unroll
            for (int et = 0; et < 4; ++et) { const f32x4 d = y[et] - mean; sq += (d[0] * d[0] + d[1] * d[1]) + (d[2] * d[2] + d[3] * d[3]); }
            sq += shfl_xor_l(sq, 16, lane); sq += shfl_xor_l(sq, 32, lane); const float rstd = rsqrtf(sq * (1.f / 64.f) + 64e-5f);
            const float bs = BSUM[tok * 4 + hd];
#pragma unroll
            for (int et = 0; et < 4; ++et) { const int e0 = hd * 64 + 16 * et + 4 * fq;
                const f32x4 lw = *(const f32x4*)(ln_w + e0), lb = *(const f32x4*)(ln_b + e0);
                const u32x2 vv = *(const u32x2*)(V_ + tok * 256 + e0), gv = *(const u32x2*)(G_ + tok * 256 + e0);
                const float o0 = ((y[et][0] - mean) * rstd * lw[0] + lb[0] + bs * bflo(vv.x)) * bflo(gv.x), o1 = ((y[et][1] - mean) * rstd * lw[1] + lb[1] + bs * bfhi(vv.x)) * bfhi(gv.x);
                const float o2 = ((y[et][2] - mean) * rstd * lw[2] + lb[2] + bs * bflo(vv.y)) * bflo(gv.y), o3 = ((y[et][3] - mean) * rstd * lw[3] + lb[3] + bs * bfhi(vv.y)) * bfhi(gv.y);
                u32x2 o; o.x = pk2(o0, o1); o.y = pk2(o2, o3);
                *(u32x2*)(MIX + tok * DM + e0) = o; }
        }
    }
}

template <int PASS>
DI void phase_s5(const Frame& F, CArgs& A, int l) {
    const bf16_t* Z = (const bf16_t*)(A.ws + WS_Z); float* SEND = (float*)(A.ws + WS_S5END); bf16_t* YS = (bf16_t*)(A.ws + WS_YS5);
    const bf16_t* BBt = (const bf16_t*)(A.ws + WS_S5BB); const bf16_t* CCt = (const bf16_t*)(A.ws + WS_S5CC);
    LAS unsigned char* himg = F.lds + F.wave * 17408;
    for (int it = F.gw; it < 8 * 16 * 16; it += F.ngw) {
        int lz = F.lane; asm volatile("" : "+v"(lz)); const int lane = lz, lr = lane & 31, hh = lane >> 5;
        const int b = it >> 8, g = (it >> 4) & 15, seg = it & 15, lg = l * 16 + g;
        const float dt = __expf(A.in[25][lg]);
        float are[2], aim[2], cr[2], ci[2];
        bf16x8 bbf[2][2];
#pragma unroll
        for (int st = 0; st < 2; ++st) { const int p = 32 * st + lr;
            const float lre = A.in[18][lg * 64 + p], lim = A.in[19][lg * 64 + p]; const float mag = expf(lre * dt); float sn, cn; sincosf(lim * dt, &sn, &cn); are[st] = mag * cn; aim[st] = mag * sn;
            cr[st] = 0.f; ci[st] = 0.f;
            if (PASS == 2) { const float m512 = expf(512.f * lre * dt); float s5, c5; sincosf(512.f * (lim * dt), &s5, &c5); const float pr = m512 * c5, pi_ = m512 * s5;
                for (int j = 0; j < seg; ++j) { const float* e = SEND + ((size_t)((b * 16 + g) * 16 + j)) * 128; const float er = e[p], ei = e[64 + p];
                    const float nr = pr * cr[st] - pi_ * ci[st] + er, ni = pr * ci[st] + pi_ * cr[st] + ei; cr[st] = nr; ci[st] = ni; } }
#pragma unroll
            for (int part = 0; part < 2; ++part) bbf[part][st] = *(const bf16x8*)(BBt + (((size_t)lg * 2 + part) * 64 + p) * 16 + 8 * hh); }
        bf16x8 ccf[4];
        if (PASS == 2) {
#pragma unroll
            for (int ks = 0; ks < 4; ++ks) ccf[ks] = *(const bf16x8*)(CCt + ((size_t)lg * 16 + (lane & 15)) * 128 + 32 * ks + 8 * (lane >> 4)); }
        for (int ch = 0; ch < 8; ++ch) {
            const size_t tok0 = (size_t)b * SEQ + seg * 512 + ch * 64;
#pragma unroll
            for (int tk = 0; tk < 2; ++tk) {
                const bf16x8 uf = *(const bf16x8*)(Z + (tok0 + 32 * tk + lr) * ZS + ZC_S5 + g * 16 + 8 * hh);
                f32x16 xr[2], xi[2];
#pragma unroll
                for (int st = 0; st < 2; ++st) { xr[st] = mfma32(uf, bbf[0][st], zero16()); xi[st] = mfma32(uf, bbf[1][st], zero16()); }
                asm volatile("s_nop 15\n\ts_nop 15" : "+v"(xr[0]), "+v"(xi[0]), "+v"(xr[1]), "+v"(xi[1]));
#pragma unroll
                for (int j = 0; j < 4; ++j) {
#pragma unroll
                    for (int half = 0; half < 2; ++half) {
                        const bool act = (hh == half);
#pragma unroll
                        for (int st = 0; st < 2; ++st) { float tr = cr[st], ti = ci[st];
#pragma unroll
                            for (int q = 0; q < 4; ++q) { const float nr = are[st] * tr - aim[st] * ti + xr[st][4 * j + q], ni = are[st] * ti + aim[st] * tr + xi[st][4 * j + q];
                                tr = nr; ti = ni; xr[st][4 * j + q] = act ? nr : xr[st][4 * j + q]; xi[st][4 * j + q] = act ? ni : xi[st][4 * j + q]; }
                            const float pr = shfl_xor_l(tr, 32, lane), pi2 = shfl_xor_l(ti, 32, lane);
                            cr[st] = act ? tr : pr; ci[st] = act ? ti : pi2; }
                    }
                }
                if (PASS == 2) {
                    unsigned hb = (unsigned)(uintptr_t)(himg + (4 * hh) * 272 + lr * 2); asm volatile("" : "+v"(hb));
                    LAS unsigned char* hp = (LAS unsigned char*)(uintptr_t)hb;
#pragma unroll
                    for (int st = 0; st < 2; ++st)
#pragma unroll
                        for (int q = 0; q < 16; ++q) { const int trow = 32 * tk + 8 * (q >> 2) + (q & 3);
                            *(LAS bf16_t*)(hp + trow * 272 + 64 * st) = (bf16_t)f2bf(xr[st][q]); *(LAS bf16_t*)(hp + trow * 272 + 128 + 64 * st) = (bf16_t)f2bf(xi[st][q]); }
                }
            }
            if (PASS == 2) {
                asm volatile("s_waitcnt lgkmcnt(0)" ::: "memory");
                const int fr = lane & 15, fq = lane >> 4;
                unsigned rb = (unsigned)(uintptr_t)(himg + fr * 272 + fq * 16); asm volatile("" : "+v"(rb)); const LAS unsigned char* rp = (const LAS unsigned char*)(uintptr_t)rb;
#pragma unroll
                for (int m = 0; m < 4; ++m) { f32x4 acc = {0.f, 0.f, 0.f, 0.f};
#pragma unroll
                    for (int ks = 0; ks < 4; ++ks) acc = __builtin_amdgcn_mfma_f32_16x16x32_bf16(ccf[ks], *(const LAS bf16x8*)(rp + (16 * m) * 272 + 64 * ks), acc, 0, 0, 0);
                    const size_t tok = tok0 + 16 * m + fr;
                    const u32x2 uu = *(const u32x2*)(Z + tok * ZS + ZC_S5 + g * 16 + 4 * fq);
                    const f32x4 dd = *(const f32x4*)(A.in[24] + l * 256 + g * 16 + 4 * fq);
                    u32x2 o; o.x = pk2(gelu_tanh(acc[0] + dd[0] * bflo(uu.x)), gelu_tanh(acc[1] + dd[1] * bfhi(uu.x))); o.y = pk2(gelu_tanh(acc[2] + dd[2] * bflo(uu.y)), gelu_tanh(acc[3] + dd[3] * bfhi(uu.y)));
                    *(u32x2*)(YS + tok * 256 + g * 16 + 4 * fq) = o; }
                asm volatile("s_waitcnt lgkmcnt(0)" ::: "memory");
            }
        }
        if (PASS == 1 && hh == 1) {
#pragma unroll
            for (int st = 0; st < 2; ++st) { float* e = SEND + ((size_t)((b * 16 + g) * 16 + seg)) * 128; e[32 * st + lr] = cr[st]; e[64 + 32 * st + lr] = ci[st]; } }
    }
}

DI void phase_lru_prep(const Frame& F, CArgs& A, int l) {
    const bf16_t* Z = (const bf16_t*)(A.ws + WS_Z); float* LA = (float*)(A.ws + WS_LA); float* LB = (float*)(A.ws + WS_LB);
    const float* cw = A.in[34] + l * 4 * 256; const float* cb = A.in[35] + l * 256; const float* ba = A.in[37] + l * 256; const float* bx = A.in[39] + l * 256; const float* lam = A.in[40] + l * 256;
    const bf16_t* WL = (const bf16_t*)(A.ws + WS_WLRU) + (size_t)l * 2 * 4 * 4096;
    LAS float* xs = (LAS float*)F.lds;
    const int w = F.wave, n = w >> 1, hf = w & 1;
    bf16x8 waf[2][2], wxf[2][2];
    { const int fr = F.lane & 15, fq = F.lane >> 4;
#pragma unroll
      for (int nf = 0; nf < 2; ++nf)
#pragma unroll
          for (int ks = 0; ks < 2; ++ks) { const int j = 32 * hf + 16 * nf + fr;
              waf[nf][ks] = *(const bf16x8*)(WL + ((size_t)(0 * 4 + n) * 64 + j) * 64 + 32 * ks + 8 * fq); wxf[nf][ks] = *(const bf16x8*)(WL + ((size_t)(1 * 4 + n) * 64 + j) * 64 + 32 * ks + 8 * fq); } }
    f32x4 c_ba[2], c_bx[2], c_sp[2];
    { const int fq0 = F.lane >> 4;
#pragma unroll
      for (int nf = 0; nf < 2; ++nf) { const int ch4 = n * 64 + 32 * hf + 16 * nf + 4 * fq0; c_ba[nf] = *(const f32x4*)(ba + ch4); c_bx[nf] = *(const f32x4*)(bx + ch4); const f32x4 lm = *(const f32x4*)(lam + ch4);
#pragma unroll
          for (int i = 0; i < 4; ++i) c_sp[nf][i] = -8.f * softplusf_(-lm[i]); } }
    for (int tile = F.bid; tile < T / 64; tile += F.G) {
        int tz = F.tid; asm volatile("" : "+v"(tz)); const int lane = tz & 63, fr = lane & 15, fq = lane >> 4;
        const int t0 = tile * 64, s0 = t0 % SEQ;
        f32x4 accA[4][2], accX[4][2];
#pragma unroll
        for (int m = 0; m < 4; ++m) {
            const int tok = 16 * m + fr, sq = s0 + tok;
            bf16x8 xf[2];
#pragma unroll
            for (int ks = 0; ks < 2; ++ks) { const int ch0 = n * 64 + 32 * ks + 8 * fq;
                const f32x4 b0 = *(const f32x4*)(cb + ch0), b1 = *(const f32x4*)(cb + ch0 + 4);
                float xc[8] = {b0[0], b0[1], b0[2], b0[3], b1[0], b1[1], b1[2], b1[3]};
#pragma unroll
                for (int j = 0; j < 4; ++j) if (sq - 3 + j >= 0) {
                    const u32x4 z8 = *(const u32x4*)(Z + (size_t)(t0 + tok - 3 + j) * ZS + ZC_LX + ch0);
                    const f32x4 c0 = *(const f32x4*)(cw + j * 256 + ch0), c1 = *(const f32x4*)(cw + j * 256 + ch0 + 4);
                    xc[0] += c0[0] * bflo(z8.x); xc[1] += c0[1] * bfhi(z8.x); xc[2] += c0[2] * bflo(z8.y); xc[3] += c0[3] * bfhi(z8.y);
                    xc[4] += c1[0] * bflo(z8.z); xc[5] += c1[1] * bfhi(z8.z); xc[6] += c1[2] * bflo(z8.w); xc[7] += c1[3] * bfhi(z8.w); }
                u32x4 o; o.x = pk2(xc[0], xc[1]); o.y = pk2(xc[2], xc[3]); o.z = pk2(xc[4], xc[5]); o.w = pk2(xc[6], xc[7]); xf[ks] = __builtin_bit_cast(bf16x8, o);
                if (hf == 0) { *(LAS f32x4*)(xs + tok * 260 + ch0) = (f32x4){xc[0], xc[1], xc[2], xc[3]}; *(LAS f32x4*)(xs + tok * 260 + ch0 + 4) = (f32x4){xc[4], xc[5], xc[6], xc[7]}; }
            }
#pragma unroll
            for (int nf = 0; nf < 2; ++nf) { const f32x4 z4 = {0.f, 0.f, 0.f, 0.f};
                accA[m][nf] = __builtin_amdgcn_mfma_f32_16x16x32_bf16(waf[nf][0], xf[0], z4, 0, 0, 0); accA[m][nf] = __builtin_amdgcn_mfma_f32_16x16x32_bf16(waf[nf][1], xf[1], accA[m][nf], 0, 0, 0);
                accX[m][nf] = __builtin_amdgcn_mfma_f32_16x16x32_bf16(wxf[nf][0], xf[0], z4, 0, 0, 0); accX[m][nf] = __builtin_amdgcn_mfma_f32_16x16x32_bf16(wxf[nf][1], xf[1], accX[m][nf], 0, 0, 0); }
        }
        lds_barrier();
#pragma unroll
        for (int m = 0; m < 4; ++m)
#pragma unroll
            for (int nf = 0; nf < 2; ++nf) { const int tok = 16 * m + fr, ch4 = n * 64 + 32 * hf + 16 * nf + 4 * fq;
                const f32x4 xc = *(const LAS f32x4*)(xs + tok * 260 + ch4);
                f32x4 av, bv;
#pragma unroll
                for (int i = 0; i < 4; ++i) { const float r = sigmoidf_(accA[m][nf][i] + c_ba[nf][i]), ig = sigmoidf_(accX[m][nf][i] + c_bx[nf][i]); const float log_a = r * c_sp[nf][i];
                    const float x2 = 2.f * log_a; float em1 = __expf(x2) - 1.f; if (x2 > -0.25f) em1 = x2 * (1.f + x2 * (0.5f + x2 * (0.16666667f + x2 * (0.041666668f + x2 * 0.008333334f))));
                    av[i] = __expf(log_a); bv[i] = __builtin_amdgcn_sqrtf(-em1) * (ig * xc[i]); }
                *(f32x4*)(LA + (size_t)(t0 + tok) * 256 + ch4) = av; *(f32x4*)(LB + (size_t)(t0 + tok) * 256 + ch4) = bv; }
        lds_barrier();
    }
}
DI void phase_lru_sum(const Frame& F, CArgs& A) {
    const float* LA = (const float*)(A.ws + WS_LA); const float* LB = (const float*)(A.ws + WS_LB); float* LS = (float*)(A.ws + WS_LSUM);
    for (int it = F.gw; it < 8 * 128; it += F.ngw) {
        const size_t r0 = (size_t)it * 64;
        f32x4 Ap = {1.f, 1.f, 1.f, 1.f}, Bp = {0.f, 0.f, 0.f, 0.f};
#pragma unroll 8
        for (int t = 0; t < 64; ++t) { const f32x4 a = *(const f32x4*)(LA + (r0 + t) * 256 + 4 * F.lane), bb = *(const f32x4*)(LB + (r0 + t) * 256 + 4 * F.lane); Bp = a * Bp + bb; Ap = Ap * a; }
        *(f32x4*)(LS + ((size_t)it * 2) * 256 + 4 * F.lane) = Ap; *(f32x4*)(LS + ((size_t)it * 2 + 1) * 256 + 4 * F.lane) = Bp;
    }
}
DI void phase_lru_fin(const Frame& F, CArgs& A, int l) {
    const float* LA = (const float*)(A.ws + WS_LA); const float* LB = (const float*)(A.ws + WS_LB); const float* LS = (const float*)(A.ws + WS_LSUM);
    const bf16_t* Z = (const bf16_t*)(A.ws + WS_Z); bf16_t* MIX = (bf16_t*)(A.ws + WS_MIX);
    const f32x4 bg = *(const f32x4*)(A.in[41] + l * 768 + 512 + 4 * F.lane);
    for (int it = F.gw; it < 8 * 128; it += F.ngw) {
        const int b = it >> 7, c = it & 127;
        f32x4 h = {0.f, 0.f, 0.f, 0.f};
        for (int j0 = 0; j0 < c; j0 += 8) {
            f32x4 sa[8], sb[8];
#pragma unroll
            for (int q = 0; q < 8; ++q) { const int j = (j0 + q < c) ? j0 + q : c - 1; sa[q] = *(const f32x4*)(LS + ((size_t)(b * 128 + j) * 2) * 256 + 4 * F.lane); sb[q] = *(const f32x4*)(LS + ((size_t)(b * 128 + j) * 2 + 1) * 256 + 4 * F.lane); }
#pragma unroll
            for (int q = 0; q < 8; ++q) if (j0 + q < c) h = sa[q] * h + sb[q]; }
        const size_t r0 = (size_t)it * 64;
        for (int t0 = 0; t0 < 64; t0 += 8) {
            f32x4 y[8]; float ss[8];
#pragma unroll
            for (int q = 0; q < 8; ++q) { const size_t r = r0 + t0 + q;
                const f32x4 a = *(const f32x4*)(LA + r * 256 + 4 * F.lane), bb = *(const f32x4*)(LB + r * 256 + 4 * F.lane); h = a * h + bb;
                const u32x2 gz = *(const u32x2*)(Z + r * ZS + ZC_LG + 4 * F.lane);
                y[q] = (f32x4){h[0] * gelu_tanh(bflo(gz.x)), h[1] * gelu_tanh(bfhi(gz.x)), h[2] * gelu_tanh(bflo(gz.y)), h[3] * gelu_tanh(bfhi(gz.y))};
                ss[q] = y[q][0] * y[q][0] + y[q][1] * y[q][1] + y[q][2] * y[q][2] + y[q][3] * y[q][3]; }
            const int ln = lane_opaque();
#pragma unroll
            for (int o = 1; o < 64; o <<= 1) {
#pragma unroll
                for (int q = 0; q < 8; ++q) ss[q] += shfl_xor_l(ss[q], o, ln); }
#pragma unroll
            for (int q = 0; q < 8; ++q) { const float r = rsqrtf(ss[q] * (1.f / 256.f) + NORM_EPS);
                u32x2 o; o.x = pk2(y[q][0] * r * bg[0], y[q][1] * r * bg[1]); o.y = pk2(y[q][2] * r * bg[2], y[q][3] * r * bg[3]);
                *(u32x2*)(MIX + (r0 + t0 + q) * DM + 768 + 4 * F.lane) = o; }
        }
    }
}

DI void phase_branch_norm(const Frame& F, CArgs& A, int l) {
    const bf16_t* S0 = (const bf16_t*)(A.ws + WS_YS5G); const bf16_t* S1 = (const bf16_t*)(A.ws + WS_ATTO);
    bf16_t* MIX = (bf16_t*)(A.ws + WS_MIX); const float* bg = A.in[41] + l * 768;
    for (int row0 = 4 * F.gw; row0 < T; row0 += 4 * F.ngw) {
        u32x2 v[4][2];
#pragma unroll
        for (int r = 0; r < 4; ++r) { v[r][0] = *(const u32x2*)(S0 + (size_t)(row0 + r) * 256 + 4 * F.lane); v[r][1] = *(const u32x2*)(S1 + (size_t)(row0 + r) * 256 + 4 * F.lane); }
#pragma unroll
        for (int r = 0; r < 4; ++r)
#pragma unroll
            for (int br = 0; br < 2; ++br) {
                const float x0 = bflo(v[r][br].x), x1 = bfhi(v[r][br].x), x2 = bflo(v[r][br].y), x3 = bfhi(v[r][br].y);
                const float rs = rsqrtf(wave_sum(x0 * x0 + x1 * x1 + x2 * x2 + x3 * x3) * (1.f / 256.f) + NORM_EPS);
                const f32x4 g = *(const f32x4*)(bg + br * 256 + 4 * F.lane);
                u32x2 o; o.x = pk2(x0 * rs * g[0], x1 * rs * g[1]); o.y = pk2(x2 * rs * g[2], x3 * rs * g[3]);
                *(u32x2*)(MIX + (size_t)(row0 + r) * DM + 256 * (br + 1) + 4 * F.lane) = o; }
    }
}

DI void phase_norm2_router(const Frame& F, CArgs& A, int l) {
    const float* MODL = (const float*)(A.ws + WS_MOD) + (size_t)l * 8 * 6144;
    const float* g = A.in[43] + l * 1024;
    signed char* H8 = (signed char*)(A.ws + WS_H); float* H2S = (float*)(A.ws + WS_H2SC);
    int* EID = (int*)(A.ws + WS_RT_EID); float* GATE = (float*)(A.ws + WS_RT_GATE); int* PIE = (int*)(A.ws + WS_RT_PIE);
    unsigned* CNT = (unsigned*)(A.ws + WS_CTL) + CW_CNT + l * 64;
    const bf16_t* WRh = (const bf16_t*)(A.ws + WS_WR) + (size_t)(l * 2) * 48 * 1024; const bf16_t* WRl = WRh + 48 * 1024;
    const float* ROWSS = (const float*)(A.ws + WS_ROWSS);
    LAS float* part = (LAS float*)F.lds;
    LAS float* red = part + 8 * 64 * 48;
    LAS float* lsum = red + 8 * 64;
    LAS unsigned* lcnt = (LAS unsigned*)(lsum + 64 * 36);
    LAS int* lsel = (LAS int*)(lcnt + 64);
    const float* bgp = A.in[45] + l * 4; const float* bep = A.in[47] + l * 32;
    const int w = F.wave, k0 = 128 * w;
    for (int tile = F.bid; tile < T / 64; tile += F.G) {
        int tz = F.tid; asm volatile("" : "+v"(tz)); const int lane = tz & 63, fr = lane & 15, fq = lane >> 4;
        const int row0 = tile * 64, b = row0 / SEQ;
        const unsigned xi = (unsigned)(row0 + fr) * DM + k0 + 8 * fq;
        const float* xb = A.out;
        if (tz < 32) lcnt[tz] = 0u;
        { float m2 = fmaxf(fabsf(MODL[(unsigned)(b * 6144 + 3072 + tz)]), fabsf(MODL[(unsigned)(b * 6144 + 3072 + 512 + tz)])); m2 = wave_max(m2); if (lane == 0) red[w] = m2; }
        lds_barrier();
        float shmax = 0.f;
#pragma unroll
        for (int ww = 0; ww < 8; ++ww) shmax = fmaxf(shmax, red[ww]);
        f32x4 acc[4][3]; float rsv[4], inv8[4];
#pragma unroll
        for (int m = 0; m < 4; ++m) { const float* rp = ROWSS + (unsigned)((row0 + 16 * m + fr) * 32);
            const f32x4 p0 = *(const f32x4*)rp, p1 = *(const f32x4*)(rp + 4), p2 = *(const f32x4*)(rp + 8), p3 = *(const f32x4*)(rp + 12);
            const f32x4 q0 = *(const f32x4*)(rp + 16), q1 = *(const f32x4*)(rp + 20), q2 = *(const f32x4*)(rp + 24), q3 = *(const f32x4*)(rp + 28);
            const float tot = (((p0[0] + p0[1]) + (p0[2] + p0[3])) + ((p1[0] + p1[1]) + (p1[2] + p1[3]))) + (((p2[0] + p2[1]) + (p2[2] + p2[3])) + ((p3[0] + p3[1]) + (p3[2] + p3[3])));
            const float mg = fmaxf(fmaxf(fmaxf(fmaxf(q0[0], q0[1]), fmaxf(q0[2], q0[3])), fmaxf(fmaxf(q1[0], q1[1]), fmaxf(q1[2], q1[3]))), fmaxf(fmaxf(fmaxf(q2[0], q2[1]), fmaxf(q2[2], q2[3])), fmaxf(fmaxf(q3[0], q3[1]), fmaxf(q3[2], q3[3]))));
            rsv[m] = rsqrtf(tot * (1.f / DM) + NORM_EPS);
            const float bound = fmaxf(rsv[m] * mg + shmax, 1e-30f) * 1.0001f;
            inv8[m] = 127.f / bound; if (w == 0 && fq == 0) H2S[(unsigned)(row0 + 16 * m + fr)] = bound * (1.f / 127.f);
#pragma unroll
            for (int n = 0; n < 3; ++n) acc[m][n] = (f32x4){0.f, 0.f, 0.f, 0.f}; }
#pragma unroll
        for (int ks = 0; ks < 4; ++ks) { const int kc = k0 + 32 * ks + 8 * fq;
            const f32x4 g0 = *(const f32x4*)(g + kc), g1 = *(const f32x4*)(g + kc + 4);
            const f32x4 s0 = *(const f32x4*)(MODL + (unsigned)(b * 6144 + 4096 + kc)) + 1.f, s1 = *(const f32x4*)(MODL + (unsigned)(b * 6144 + 4096 + kc + 4)) + 1.f;
            const f32x4 h0 = *(const f32x4*)(MODL + (unsigned)(b * 6144 + 3072 + kc)), h1 = *(const f32x4*)(MODL + (unsigned)(b * 6144 + 3072 + kc + 4));
            bf16x8 blf[3], bhf[3];
#pragma unroll
            for (int n = 0; n < 3; ++n) { blf[n] = *(const bf16x8*)(WRl + (unsigned)((16 * n + fr) * 1024 + kc)); bhf[n] = *(const bf16x8*)(WRh + (unsigned)((16 * n + fr) * 1024 + kc)); }
#pragma unroll
            for (int m = 0; m < 4; ++m) {
                const f32x4 x0 = *(const f32x4*)(xb + (xi + (unsigned)(16 * m * DM + 32 * ks))), x1 = *(const f32x4*)(xb + (xi + (unsigned)(16 * m * DM + 32 * ks + 4)));
                const f32x4 v0 = x0 * rsv[m] * g0 * s0 + h0, v1 = x1 * rsv[m] * g1 * s1 + h1;
                u32x2 o; o.x = q8x4(v0, inv8[m]); o.y = q8x4(v1, inv8[m]); *(u32x2*)(H8 + (unsigned)((row0 + 16 * m + fr) * DM + kc)) = o;
                u32x4 hi; hi.x = pk2(v0[0], v0[1]); hi.y = pk2(v0[2], v0[3]); hi.z = pk2(v1[0], v1[1]); hi.w = pk2(v1[2], v1[3]);
                u32x4 lo; lo.x = pk2(v0[0] - bflo(hi.x), v0[1] - bfhi(hi.x)); lo.y = pk2(v0[2] - bflo(hi.y), v0[3] - bfhi(hi.y)); lo.z = pk2(v1[0] - bflo(hi.z), v1[1] - bfhi(hi.z)); lo.w = pk2(v1[2] - bflo(hi.w), v1[3] - bfhi(hi.w));
                const bf16x8 ah = __builtin_bit_cast(bf16x8, hi), al = __builtin_bit_cast(bf16x8, lo);
#pragma unroll
                for (int n = 0; n < 3; ++n) { acc[m][n] = __builtin_amdgcn_mfma_f32_16x16x32_bf16(ah, bhf[n], acc[m][n], 0, 0, 0);
                    acc[m][n] = __builtin_amdgcn_mfma_f32_16x16x32_bf16(al, bhf[n], acc[m][n], 0, 0, 0); acc[m][n] = __builtin_amdgcn_mfma_f32_16x16x32_bf16(ah, blf[n], acc[m][n], 0, 0, 0); }
            }
            __builtin_amdgcn_sched_barrier(0);
        }
#pragma unroll
        for (int m = 0; m < 4; ++m)
#pragma unroll
            for (int n = 0; n < 3; ++n)
#pragma unroll
                for (int j = 0; j < 4; ++j) part[(w * 64 + 16 * m + 4 * fq + j) * 48 + 16 * n + fr] = acc[m][n][j];
        lds_barrier();
        for (int i = tz; i < 64 * 36; i += NTHR) { const int tok = i / 36, n = i % 36; float a = 0.f;
#pragma unroll
            for (int ww = 0; ww < 8; ++ww) a += part[(ww * 64 + tok) * 48 + n];
            lsum[i] = a; }
        lds_barrier();
        float g0 = 0.f, g1 = 0.f; int e0 = 0, e1 = 0; unsigned r0 = 0, r1 = 0;
        if (tz < 64) {
            const LAS float* L = lsum + tz * 36;
            int gs = 0; float gm = L[0] + bgp[0];
#pragma unroll
            for (int i = 1; i < 4; ++i) { const float v = L[i] + bgp[i]; if (v > gm) { gm = v; gs = i; } }
            float gden = 0.f;
#pragma unroll
            for (int i = 0; i < 4; ++i) gden += expf(L[i] + bgp[i] - gm);
            const float gprob = 1.f / gden;
            int i1 = 0; float v1 = L[4 + gs * 8] + bep[gs * 8];
#pragma unroll
            for (int j = 1; j < 8; ++j) { const float v = L[4 + gs * 8 + j] + bep[gs * 8 + j]; if (v > v1) { v1 = v; i1 = j; } }
            int i2 = -1; float v2 = -INFINITY;
#pragma unroll
            for (int j = 0; j < 8; ++j) { const float v = L[4 + gs * 8 + j] + bep[gs * 8 + j]; if (j != i1 && v > v2) { v2 = v; i2 = j; } }
            const float p2 = expf(v2 - v1);
            g0 = gprob / (1.f + p2); g1 = gprob * p2 / (1.f + p2); e0 = gs * 8 + i1; e1 = gs * 8 + i2;
            r0 = __hip_atomic_fetch_add(lcnt + e0, 1u, __ATOMIC_RELAXED, __HIP_MEMORY_SCOPE_WORKGROUP); r1 = __hip_atomic_fetch_add(lcnt + e1, 1u, __ATOMIC_RELAXED, __HIP_MEMORY_SCOPE_WORKGROUP);
        }
        lds_barrier();
        if (tz < 32) { const unsigned c = lcnt[tz]; lcnt[32 + tz] = c ? atomicAdd(CNT + tz, c) : 0u; }
        lds_barrier();
        if (tz < 64) { const int row = row0 + tz;
            EID[2 * row] = e0; EID[2 * row + 1] = e1; GATE[2 * row] = g0; GATE[2 * row + 1] = g1; PIE[2 * row] = (int)(lcnt[32 + e0] + r0); PIE[2 * row + 1] = (int)(lcnt[32 + e1] + r1); }
        lds_barrier();
    }
}

DI void phase_moe_convert(const Frame& F, CArgs& A, int l, int gw0, int ngw0) {
    LAS float* scr = (LAS float*)(F.lds + F.wave * 16640);
    bf16_t* WM2 = (bf16_t*)(A.ws + WS_WM2);
    for (int it = gw0; it < 32 * 384; it += ngw0) {
        const int e = it / 384; int r = it % 384;
        if (r < 256) { const int which = r >> 7; r &= 127; const int kb = r >> 3, nb = r & 7, n0 = 64 * nb;
            const float* src = (which ? A.in[49] : A.in[48]) + ((size_t)l * 32 + e) * 1024 * 512;
            const int np0 = 256 * (n0 >> 7) + (n0 & 127) + 128 * which;
            quant_item64(src, 512, 64 * kb, n0, (signed char*)(A.ws + WS_WM1) + (size_t)e * 1024 * 1024, 1024, np0, 64 * kb, (const unsigned*)(A.ws + WS_CTL) + CW_COLMAX + ((size_t)l * 32 + e) * 1024 + np0,
                         kb == 0 ? (float*)(A.ws + WS_WM1SC) + (size_t)e * 1024 + np0 : (float*)nullptr, scr, F.lane);
        } else { r -= 256; const int kb = r >> 4, nb = r & 15;
            transpose_item64(A.in[50] + ((size_t)l * 32 + e) * 512 * 1024, 1024, 64 * kb, 64 * nb, WM2 + (size_t)e * 1024 * 512, 512, 64 * nb, 64 * kb, scr, F.lane); }
    }
}

DI void phase_moe_scatter(const Frame& F, CArgs& A, int l) {
    const unsigned* CNT = (const unsigned*)(A.ws + WS_CTL) + CW_CNT + l * 64;
    unsigned* META = (unsigned*)(A.ws + WS_CTL) + CW_UTAB + l * 1024;
    const int* EID = (const int*)(A.ws + WS_RT_EID); const int* PIE = (const int*)(A.ws + WS_RT_PIE); int* SORT = (int*)(A.ws + WS_RT_SORT);
    LAS unsigned* st = (LAS unsigned*)F.lds;
    if (F.tid == 0) { unsigned s = 0; for (int e = 0; e < 32; ++e) { st[e] = s; s += CNT[e]; } }
    __syncthreads();
    if (F.bid == 0 && F.tid == 0) { unsigned nu = 0;
        for (int e = 0; e < 32; ++e) { const unsigned c = CNT[e]; META[1 + e] = st[e]; META[33 + e] = c; for (unsigned bk = 0; bk * 256 < c; ++bk) META[65 + nu++] = ((unsigned)e << 16) | bk; }
        META[0] = nu; }
    for (int a = F.bid * NTHR + F.tid; a < 2 * T; a += F.G * NTHR) SORT[st[EID[a]] + PIE[a]] = a;
}

struct MoeProb1 {
    const char* Hh; const char* WM1; const unsigned* META; const int* SORT; int lda, ldb, nt, G, c;
    DI bool next(int i, pg8::Unit& u) const { const int nu = (int)META[0]; int pm, pn;
        if ((G & 31) == 0) { const int jj = c >> 3; pn = jj & 3; pm = i * (G >> 2) + (c & 7) * (G >> 5) + (jj >> 2); } else { const int idx = i * G + c; pm = idx >> 2; pn = idx & 3; }
        if (pm >= nu) return false;
        const unsigned ent = META[65 + pm]; u.pm = pm; u.pn = pn; u.e = (int)(ent >> 16); u.blk = (int)(ent & 0xffffu); return true; }
    DI const char* a_base(const pg8::Unit&) const { return Hh; }
    DI const char* b_base(const pg8::Unit& u) const { return WM1 + ((size_t)u.e * 1024 + (size_t)u.pn * 256) * 1024; }
    DI unsigned a_off(const pg8::Unit& u, int row) const { const unsigned r = (unsigned)(u.blk * 256 + row), cnt = META[33 + u.e];
        const int a = r < cnt ? SORT[META[1 + u.e] + r] : 0; return (unsigned)(a >> 1) * 1024u; }
};
struct EpiMoe1 {
    static constexpr bool PERM = true;
    bf16_t* HID; const unsigned* META; const int* SORT; const float* H2S; const float* WSC;
    DI void operator()(const i32x4 (&acc)[2][2][4][2], const pg8::Unit& u, int wr, int wc, int fr, int fq) const {
        const unsigned cnt = META[33 + u.e], st = META[1 + u.e];
        const int col0 = 128 * u.pn + wc * 32 + 8 * fq;
        const float* wsp = WSC + (size_t)u.e * 1024 + 256 * u.pn + wc * 32 + 8 * fq;
        const f32x4 s10 = *(const f32x4*)wsp, s11 = *(const f32x4*)(wsp + 4), s30 = *(const f32x4*)(wsp + 128), s31 = *(const f32x4*)(wsp + 132);
#pragma unroll
        for (int ai = 0; ai < 2; ++ai)
#pragma unroll
            for (int m = 0; m < 4; ++m) { const unsigned r = (unsigned)(u.blk * 256 + ai * 128 + wr * 64 + m * 16 + fr);
                if (r < cnt) { const float sa = H2S[SORT[st + r] >> 1];
                    const i32x4 a0 = acc[ai][0][m][0], a1 = acc[ai][0][m][1], b0 = acc[ai][1][m][0], b1 = acc[ai][1][m][1];
                    float h[8];
#pragma unroll
                    for (int i = 0; i < 4; ++i) { h[i] = siluf_((float)a0[i] * sa * s10[i]) * ((float)b0[i] * sa * s30[i]); h[4 + i] = siluf_((float)a1[i] * sa * s11[i]) * ((float)b1[i] * sa * s31[i]); }
                    u32x4 w; w.x = pk2(h[0], h[1]); w.y = pk2(h[2], h[3]); w.z = pk2(h[4], h[5]); w.w = pk2(h[6], h[7]);
                    *(u32x4*)(HID + (size_t)(st + r) * 512 + col0) = w; } }
    }
};
struct MoeProb2 {
    const char* HID; const char* WM2; const unsigned* META; int lda, ldb, nt, G, c;
    DI bool next(int i, pg8::Unit& u) const { const int nu = (int)META[0]; int pm, pn;
        if ((G & 31) == 0) { const int jj = c >> 3; pn = jj & 3; pm = i * (G >> 2) + (c & 7) * (G >> 5) + (jj >> 2); } else { const int idx = i * G + c; pm = idx >> 2; pn = idx & 3; }
        if (pm >= nu) return false;
        const unsigned ent = META[65 + pm]; u.pm = pm; u.pn = pn; u.e = (int)(ent >> 16); u.blk = (int)(ent & 0xffffu); return true; }
    DI const char* a_base(const pg8::Unit& u) const { return HID + ((size_t)META[1 + u.e] + (size_t)u.blk * 256) * 512 * 2; }
    DI const char* b_base(const pg8::Unit& u) const { return WM2 + ((size_t)u.e * 1024 + (size_t)u.pn * 256) * 512 * 2; }
    DI unsigned a_off(const pg8::Unit&, int row) const { return (unsigned)row * 1024u; }
};
struct EpiMoe2 {
    static constexpr bool PERM = true;
    bf16_t* Y; const unsigned* META; const int* SORT; const float* GATE; const float* gt;
    DI void operator()(const f32x4 (&acc)[2][2][4][2], const pg8::Unit& u, int wr, int wc, int fr, int fq) const {
        const unsigned cnt = META[33 + u.e], st = META[1 + u.e];
        const int col0 = 256 * u.pn + wc * 32 + 8 * fq;
        int av[2][4]; float gw[2][4];
#pragma unroll
        for (int ai = 0; ai < 2; ++ai)
#pragma unroll
            for (int m = 0; m < 4; ++m) { const unsigned r = (unsigned)(u.blk * 256 + ai * 128 + wr * 64 + m * 16 + fr); av[ai][m] = r < cnt ? SORT[st + r] : -1; }
#pragma unroll
        for (int ai = 0; ai < 2; ++ai)
#pragma unroll
            for (int m = 0; m < 4; ++m) gw[ai][m] = av[ai][m] >= 0 ? GATE[av[ai][m]] : 0.f;
#pragma unroll
        for (int ai = 0; ai < 2; ++ai)
#pragma unroll
            for (int m = 0; m < 4; ++m) { const int a = av[ai][m];
                if (a >= 0) { const int b = (a >> 1) / SEQ; const float g = gw[ai][m];
#pragma unroll
                    for (int bj = 0; bj < 2; ++bj) { const f32x4 g0 = *(const f32x4*)(gt + (size_t)b * 6144 + col0 + bj * 128), g1 = *(const f32x4*)(gt + (size_t)b * 6144 + col0 + bj * 128 + 4);
                        const f32x4 v0 = acc[ai][bj][m][0] * g0 * g, v1 = acc[ai][bj][m][1] * g1 * g;
                        u32x4 w; w.x = pk2(v0[0], v0[1]); w.y = pk2(v0[2], v0[3]); w.z = pk2(v1[0], v1[1]); w.w = pk2(v1[2], v1[3]);
                        *(u32x4*)(Y + (size_t)a * DM + col0 + bj * 128) = w; } } }
    }
};

DI void phase_final(const Frame& F, CArgs& A) {
    const bf16_t* Y = (const bf16_t*)(A.ws + WS_Y);
    const size_t N4 = (size_t)T * DM / 4, stride = (size_t)F.G * NTHR;
    for (size_t i0 = (size_t)F.bid * NTHR + F.tid; i0 < N4; i0 += 4 * stride) {
        f32x4 v[4]; u32x2 y0[4], y1[4];
#pragma unroll
        for (int k = 0; k < 4; ++k) { const size_t i = i0 + k * stride; if (i < N4) { const size_t row = i >> 8, col = (i & 255) * 4;
            v[k] = *(const f32x4*)(A.out + row * DM + col); y0[k] = *(const u32x2*)(Y + (2 * row) * DM + col); y1[k] = *(const u32x2*)(Y + (2 * row + 1) * DM + col); } }
#pragma unroll
        for (int k = 0; k < 4; ++k) { const size_t i = i0 + k * stride; if (i < N4) { const size_t row = i >> 8, col = (i & 255) * 4;
            v[k][0] += bflo(y0[k].x) + bflo(y1[k].x); v[k][1] += bfhi(y0[k].x) + bfhi(y1[k].x); v[k][2] += bflo(y0[k].y) + bflo(y1[k].y); v[k][3] += bfhi(y0[k].y) + bfhi(y1[k].y);
            *(f32x4*)(A.out + row * DM + col) = v[k]; } }
    }
}

#ifndef REPMASK
#define REPMASK 0u
#endif
constexpr int NPL = 14, NPH = 1 + 2 * NPL + 1;
__global__ void __launch_bounds__(NTHR, 2) mk_fwd(Args args) {
    extern __shared__ __attribute__((aligned(16))) unsigned char lds_raw[];
    LAS unsigned char* const ldsb = (LAS unsigned char*)lds_raw;
    const int wave0 = __builtin_amdgcn_readfirstlane(threadIdx.x >> 6);
    volatile LAS unsigned* MISC = (volatile LAS unsigned*)(ldsb + MISC_OFF);
    if (threadIdx.x < 64) MISC[threadIdx.x] = 0u;
    __syncthreads();
    XcdBarrier bar; bar.bar = (unsigned*)(args.ws + WS_CTL) + CW_BAR; bar.x = 0; bar.st = nullptr;
    if (args.use_bar) bar = xcd_barrier_post((unsigned*)(args.ws + WS_CTL) + CW_BAR, MISC + 8);
    const int lo = args.ph_lo, hi = args.ph_hi;
#define IN(k) (lo <= (k) && (k) < hi)
#define SEAM(k) do { if (IN(k) && IN((k) + 1)) xcd_barrier(bar); } while (0)
    unsigned char* ws = args.ws;
    if (IN(0)) { const Frame F = make_frame(ldsb, wave0); CArgs& AA = *get_args(); phase_prologue(F, AA); } SEAM(0);
    for (int l = 0; l < DEPTH; ++l) {
        const int pb = 1 + l * NPL;
        const float* MODL = (const float*)(ws + WS_MOD) + (size_t)l * 8 * 6144;
        if (IN(pb + 0)) { { const Frame F = make_frame(ldsb, wave0); CArgs& AA = *get_args(); phase_norm1(F, AA, l); } if (l == 0) { const Frame F = make_frame(ldsb, wave0); CArgs& AA = *get_args(); phase_win_quant(F, AA); } } SEAM(pb + 0);
        if (IN(pb + 1)) { const Frame F = make_frame(ldsb, wave0); CArgs& AA = *get_args(); pg8::PlainProb P{(const char*)(ws + WS_H), (const char*)(ws + WS_WIN) + (size_t)l * ZS * 1024, 512, 512, 8, 256, 9, F.G, F.bid};
            EpiBf16I8 E{(bf16_t*)(ws + WS_Z), ZS, (const float*)(ws + WS_HSC), (const float*)(ws + WS_WINSC) + l * ZS}; pg8::gemm_phase<true, true>(F.lds, P, E, F.tid); } SEAM(pb + 1);
        if (IN(pb + 2)) { { const Frame F = make_frame(ldsb, wave0); CArgs& AA = *get_args(); phase_mla_prep(F, AA, l); } { const Frame F = make_frame(ldsb, wave0); CArgs& AA = *get_args(); phase_s5<1>(F, AA, l); } { const Frame F = make_frame(ldsb, wave0); CArgs& AA = *get_args(); phase_lru_prep(F, AA, l); } } SEAM(pb + 2);
        if (IN(pb + 3)) { { const Frame F = make_frame(ldsb, wave0); CArgs& AA = *get_args(); pg8::PlainProb P{(const char*)(ws + WS_AMLA), (const char*)(ws + WS_WMLA) + (size_t)l * 1024 * 512 * 2, 512, 512, 8, 256, 4, F.G, F.bid};
            EpiBf16Plain E{(bf16_t*)(ws + WS_QKVRAW), 1024}; pg8::gemm_phase(F.lds, P, E, F.tid); } { const Frame F = make_frame(ldsb, wave0); CArgs& AA = *get_args(); phase_lru_sum(F, AA); } } SEAM(pb + 3);
        if (IN(pb + 4)) { { const Frame F = make_frame(ldsb, wave0); CArgs& AA = *get_args(); phase_mla_post(F, AA, l); } { const Frame F = make_frame(ldsb, wave0); CArgs& AA = *get_args(); phase_lru_fin(F, AA, l); } } SEAM(pb + 4);
        if (IN(pb + 5)) { { const Frame F = make_frame(ldsb, wave0); CArgs& AA = *get_args(); phase_attn(F, AA, l); } lds_barrier(); { const Frame F = make_frame(ldsb, wave0); CArgs& AA = *get_args(); phase_s5<2>(F, AA, l); } } SEAM(pb + 5);
        if (IN(pb + 6)) { { const Frame F = make_frame(ldsb, wave0); CArgs& AA = *get_args(); phase_rwkv_A(F, AA, l); } lds_barrier(); { const Frame F = make_frame(ldsb, wave0); CArgs& AA = *get_args(); pg8::PlainProb P{(const char*)(ws + WS_YS5), (const char*)(ws + WS_WGLU) + (size_t)l * 256 * 256 * 2, 256, 256, 4, 256, 1, F.G, F.bid};
            EpiGlu E{(const bf16_t*)(ws + WS_YS5), (bf16_t*)(ws + WS_YS5G), AA.in[27] + l * 256}; pg8::gemm_phase(F.lds, P, E, F.tid); } } SEAM(pb + 6);
        if (IN(pb + 7)) { const Frame F = make_frame(ldsb, wave0); CArgs& AA = *get_args(); if (F.bid < 32) phase_rwkv_B(F, AA); else phase_moe_convert(F, AA, l, (F.bid - 32) * NWAVES + F.wave, (F.G - 32) * NWAVES); } SEAM(pb + 7);
        if (IN(pb + 8)) { { const Frame F = make_frame(ldsb, wave0); CArgs& AA = *get_args(); phase_rwkv_C(F, AA, l); } { const Frame F = make_frame(ldsb, wave0); CArgs& AA = *get_args(); phase_branch_norm(F, AA, l); } } SEAM(pb + 8);
        if (IN(pb + 9)) { const Frame F = make_frame(ldsb, wave0); CArgs& AA = *get_args(); pg8::PlainProb P{(const char*)(ws + WS_MIX), (const char*)(ws + WS_WOUT) + (size_t)l * 1024 * 1024 * 2, 1024, 1024, 16, 256, 4, F.G, F.bid};
            EpiResGate E{l == 0 ? AA.in[0] : AA.out, AA.out, MODL + 2048, (float*)(ws + WS_ROWSS), AA.in[43] + l * 1024}; pg8::gemm_phase(F.lds, P, E, F.tid); } SEAM(pb + 9);
        if (IN(pb + 10)) { const Frame F = make_frame(ldsb, wave0); CArgs& AA = *get_args(); phase_norm2_router(F, AA, l); } SEAM(pb + 10);
        if (IN(pb + 11)) { const Frame F = make_frame(ldsb, wave0); CArgs& AA = *get_args(); phase_moe_scatter(F, AA, l); } SEAM(pb + 11);
        const unsigned* META = (const unsigned*)(ws + WS_CTL) + CW_UTAB + l * 1024;
        if (IN(pb + 12)) { const Frame F = make_frame(ldsb, wave0); CArgs& AA = *get_args(); MoeProb1 P{(const char*)(ws + WS_H), (const char*)(ws + WS_WM1), META, (const int*)(ws + WS_RT_SORT), 512, 512, 8, F.G, F.bid};
            EpiMoe1 E{(bf16_t*)(ws + WS_HID), META, (const int*)(ws + WS_RT_SORT), (const float*)(ws + WS_H2SC), (const float*)(ws + WS_WM1SC)}; pg8::gemm_phase<true, true>(F.lds, P, E, F.tid); } SEAM(pb + 12);
        if (IN(pb + 13)) { const Frame F = make_frame(ldsb, wave0); CArgs& AA = *get_args(); MoeProb2 P{(const char*)(ws + WS_HID), (const char*)(ws + WS_WM2), META, 512, 512, 8, F.G, F.bid};
            EpiMoe2 E{(bf16_t*)(ws + WS_Y), META, (const int*)(ws + WS_RT_SORT), (const float*)(ws + WS_RT_GATE), MODL + 5120}; pg8::gemm_phase(F.lds, P, E, F.tid); } SEAM(pb + 13);
    }
    if (IN(NPH - 1)) { const Frame F = make_frame(ldsb, wave0); CArgs& AA = *get_args(); phase_final(F, AA); }
#undef IN
#undef SEAM
}

extern "C" void kernel_launch(void* const* d_in, const int* in_sizes, int n_in, void* d_out, int out_size, void* d_ws, size_t ws_size, hipStream_t stream) {
    static int grid = 0;
    if (grid == 0) {
        if (n_in != 51 || ws_size < WS_END) { fprintf(stderr, "kernel_launch: unexpected inputs (n_in %d, ws %zu)\n", n_in, ws_size); grid = -1; return; }
        int dev = 0, cus = 0;
        if (hipGetDevice(&dev) != hipSuccess || hipDeviceGetAttribute(&cus, hipDeviceAttributeMultiprocessorCount, dev) != hipSuccess) { grid = -1; return; }
        if (hipFuncSetAttribute((const void*)mk_fwd, hipFuncAttributeMaxDynamicSharedMemorySize, LDS_BYTES) != hipSuccess) { fprintf(stderr, "kernel_launch: hipFuncSetAttribute failed\n"); grid = -1; return; }
        grid = cus;
    }
    if (grid < 0) return;
    (void)hipMemsetAsync((char*)d_ws + WS_CTL, 0, CTL_ZERO_BYTES, stream);
    Args a{};
    for (int i = 0; i < 51; ++i) a.in[i] = (const float*)d_in[i];
    a.pos_off = (const int*)d_in[2]; a.out = (float*)d_out; a.ws = (unsigned char*)d_ws; a.pad = 0;
#if defined(MK_PER_PHASE)
    a.use_bar = 0;
    for (int p = 0; p < NPH; ++p) { a.ph_lo = p; a.ph_hi = p + 1;
        const int k = (p == 0) ? 30 : (p == NPH - 1) ? 31 : (p - 1) % NPL; const int reps = 1 + (int)((REPMASK >> k) & 1u);
        for (int r = 0; r < reps; ++r) hipLaunchKernelGGL(mk_fwd, dim3(grid), dim3(NTHR), LDS_BYTES, stream, a); }
#else
    a.use_bar = 1; a.ph_lo = 0; a.ph_hi = NPH;
    hipLaunchKernelGGL(mk_fwd, dim3(grid), dim3(NTHR), LDS_BYTES, stream, a);
#endif
}
```

```cpp
#include <hip/hip_runtime.h>
#include <cstdio>
#include <cstdint>
#include <type_traits>

#define LAS __attribute__((address_space(3)))
#define GAS __attribute__((address_space(1)))
#define DI __device__ __forceinline__
typedef unsigned short bf16_t;
typedef short bf16x8 __attribute__((ext_vector_type(8)));
typedef short s16x4 __attribute__((ext_vector_type(4)));
typedef float f32x4 __attribute__((ext_vector_type(4)));
typedef float f32x2 __attribute__((ext_vector_type(2)));
typedef float f32x16 __attribute__((ext_vector_type(16)));
typedef unsigned u32x4 __attribute__((ext_vector_type(4)));
typedef unsigned u32x2 __attribute__((ext_vector_type(2)));
typedef __bf16 bf16x2_t __attribute__((ext_vector_type(2)));
typedef int i32x4 __attribute__((ext_vector_type(4)));

constexpr int NB = 8, SEQ = 8192, DM = 1024, T = NB * SEQ, DEPTH = 2;
constexpr int WG = 256;
constexpr int ZS = 2304;
constexpr int ZC_R = 0, ZC_K = 256, ZC_V = 512, ZC_WLO = 768, ZC_ALO = 800, ZC_GLO = 832, ZC_S5 = 896, ZC_QA = 1152, ZC_KVA = 1408, ZC_KPE = 1536, ZC_LX = 1568, ZC_LG = 1824, D_IN = 2080;
constexpr int NEXP = 32, DFF = 512;
constexpr float NORM_EPS = 1e-6f;

DI unsigned f2bf(float f) { unsigned u = __float_as_uint(f); return (u + 0x7fffu + ((u >> 16) & 1u)) >> 16; }
DI unsigned pk2(float lo, float hi) { f32x2 v = {lo, hi}; bf16x2_t b = __builtin_convertvector(v, bf16x2_t); return __builtin_bit_cast(unsigned, b); }
DI float bflo(unsigned u) { return __uint_as_float(u << 16); }
DI float bfhi(unsigned u) { return __uint_as_float(u & 0xffff0000u); }
DI float bf2f(bf16_t b) { return __uint_as_float(((unsigned)b) << 16); }
DI int lane_opaque() { int l; asm volatile("v_mbcnt_lo_u32_b32 %0, -1, 0\n\tv_mbcnt_hi_u32_b32 %0, -1, %0" : "=v"(l)); return l; }
DI float shfl_xor_l(float v, int o, int lane) { return __int_as_float(__builtin_amdgcn_ds_bpermute((lane ^ o) << 2, __float_as_int(v))); }
DI float wave_max(float v) {
    const int l = lane_opaque();
#pragma unroll
    for (int o = 1; o < 64; o <<= 1) v = fmaxf(v, shfl_xor_l(v, o, l));
    return v;
}
DI unsigned q8x4(f32x4 v, float inv) { const int a = (int)rintf(v[0] * inv), b = (int)rintf(v[1] * inv), c = (int)rintf(v[2] * inv), d = (int)rintf(v[3] * inv);
    return (unsigned)(a & 255) | ((unsigned)(b & 255) << 8) | ((unsigned)(c & 255) << 16) | ((unsigned)(d & 255) << 24); }
DI float wave_sum(float v) {
    const int l = lane_opaque();
#pragma unroll
    for (int o = 1; o < 64; o <<= 1) v += shfl_xor_l(v, o, l);
    return v;
}
DI void lds_barrier() { asm volatile("s_waitcnt lgkmcnt(0)" ::: "memory"); __builtin_amdgcn_s_barrier(); asm volatile("" ::: "memory"); }
DI float sigmoidf_(float x) { return __builtin_amdgcn_rcpf(1.f + __expf(-x)); }
DI float fast_tanh(float x) { const float e = __expf(2.f * fminf(fmaxf(x, -15.f), 15.f)); return (e - 1.f) * __builtin_amdgcn_rcpf(e + 1.f); }
DI float fast_softplus(float x) { return fmaxf(x, 0.f) + __logf(1.f + __expf(-fabsf(x))); }
DI float softplusf_(float x) { return fmaxf(x, 0.f) + log1pf(__expf(-fabsf(x))); }
DI float gelu_tanh(float x) { const float u = 0.7978845608028654f * (x + 0.044715f * x * x * x); const float e = __expf(2.f * fminf(fmaxf(u, -15.f), 15.f)); return x * e * __builtin_amdgcn_rcpf(e + 1.f); }
DI float siluf_(float x) { return x / (1.f + __expf(-x)); }

namespace pg8 {
constexpr int BM = 256, BK = 64, HALF = 128, HTB = HALF * BK * 2, STAGE_BYTES = 8 * HTB;
DI int lds_byte(int r, int c) { const int st = (r >> 4) * 2 + (c >> 5), rr = r & 15, cc = c & 31, ob = rr * 64 + cc * 2; return st * 1024 + (ob ^ (((ob >> 9) & 1) << 5)); }
DI void stage_rc(int b, int& R, int& C) { const int st = b / 1024, sb = b % 1024, swz = sb ^ (((sb >> 9) & 1) << 5); R = (st >> 1) * 16 + swz / 64; C = (st & 1) * 32 + (swz % 64) / 2; }
DI int perm32(int rho) { const int n = rho >> 4, i = rho & 15; return 8 * (i >> 2) + 4 * n + (i & 3); }

struct Unit { int pm, pn, e, blk; };
DI f32x4 mma_any(bf16x8 a, bf16x8 b, f32x4 c) { return __builtin_amdgcn_mfma_f32_16x16x32_bf16(a, b, c, 0, 0, 0); }
DI i32x4 mma_any(bf16x8 a, bf16x8 b, i32x4 c) { return __builtin_amdgcn_mfma_i32_16x16x64_i8(__builtin_bit_cast(i32x4, a), __builtin_bit_cast(i32x4, b), c, 0, 0, 0); }

template <bool ALIGN_EPI = true, bool I8 = false, class Epi, class P>
DI void gemm_phase(LAS unsigned char* lds, const P& S, const Epi& E, int tid_in) {
    typedef typename std::conditional<I8, i32x4, f32x4>::type acc_t;
    const int tid = tid_in, wid = __builtin_amdgcn_readfirstlane(tid >> 6), lane = tid & 63, wr = wid >> 2, wc = wid & 3, fr = lane & 15, fq = lane >> 4;
    const int nt = S.nt;
    int Rr[2], Cc[2];
    unsigned voffB[2], offC[2][2], offN[2][2];
#pragma unroll
    for (int i = 0; i < 2; ++i) { int R, C; stage_rc(tid * 16 + i * 8192, R, C); Rr[i] = R; Cc[i] = C; const int Rb = Epi::PERM ? ((R & ~31) + perm32(R & 31)) : R;
        voffB[i] = (unsigned)(Rb * S.ldb + C) * 2u; }
    const size_t kstep = (size_t)(BK * 2);
    const size_t hstepB = (size_t)HALF * S.ldb * 2;
    const unsigned ldsw = (unsigned)wid * 1024u;
    const int aoff = lds_byte(wr * 64 + fr, fq * 8), boff = lds_byte(wc * 32 + fr, fq * 8);
#define PG8_SA(b, h) (((b) * 2 + (h)) * HTB)
#define PG8_SB(b, h) ((4 + (b) * 2 + (h)) * HTB)
#define PG8_STAGE(bufoff, gbase, voff) do { _Pragma("unroll") for (int _i = 0; _i < 2; ++_i) \
        __builtin_amdgcn_global_load_lds((const unsigned*)((const char*)(gbase) + (voff)[_i]), (LAS unsigned*)(lds + (bufoff) + ldsw + _i * 8192), 16, 0, 0); } while (0)
#define PG8_LDA(dst, b, h) do { _Pragma("unroll") for (int m = 0; m < 4; ++m) _Pragma("unroll") for (int k = 0; k < 2; ++k) dst[m][k] = *(const LAS bf16x8*)(lds + PG8_SA(b, h) + aoff + m * 2048 + k * 1024); } while (0)
#define PG8_LDB(dst, b, h) do { _Pragma("unroll") for (int n = 0; n < 2; ++n) _Pragma("unroll") for (int k = 0; k < 2; ++k) dst[n][k] = *(const LAS bf16x8*)(lds + PG8_SB(b, h) + boff + n * 2048 + k * 1024); } while (0)
#define PG8_MMA(ai, bj, At, Bt) do { __builtin_amdgcn_s_setprio(1); _Pragma("unroll") for (int m = 0; m < 4; ++m) _Pragma("unroll") for (int n = 0; n < 2; ++n) _Pragma("unroll") for (int k = 0; k < 2; ++k) \
        acc[ai][bj][m][n] = mma_any(Bt[n][k], At[m][k], acc[ai][bj][m][n]); __builtin_amdgcn_s_setprio(0); } while (0)
#define PG8_WAIT_V(n) asm volatile("s_waitcnt vmcnt(" #n ")" ::: "memory")
#define PG8_WAIT_L(n) asm volatile("s_waitcnt lgkmcnt(" #n ")" ::: "memory")
#define PG8_BAR __builtin_amdgcn_s_barrier()
#define PG8_SCHED __builtin_amdgcn_sched_barrier(0)
    Unit cur, nxt; int ui = 0;
    if (!S.next(0, cur)) return;
    acc_t acc[2][2][4][2];
#pragma unroll
    for (int a = 0; a < 2; ++a)
#pragma unroll
        for (int b = 0; b < 2; ++b)
#pragma unroll
            for (int m = 0; m < 4; ++m)
#pragma unroll
                for (int n = 0; n < 2; ++n) acc[a][b][m][n] = (acc_t){0, 0, 0, 0};
    bf16x8 At[4][2], B0[2][2], B1[2][2];
    const char* cA = S.a_base(cur); const char* cB = S.b_base(cur);
#pragma unroll
    for (int h = 0; h < 2; ++h)
#pragma unroll
        for (int i = 0; i < 2; ++i) { offC[h][i] = S.a_off(cur, h * HALF + Rr[i]) + (unsigned)Cc[i] * 2u; offN[h][i] = offC[h][i]; }
    PG8_STAGE(PG8_SB(0, 0), cB, voffB); PG8_STAGE(PG8_SB(0, 1), cB + hstepB, voffB); PG8_STAGE(PG8_SA(0, 0), cA, offC[0]); PG8_STAGE(PG8_SA(0, 1), cA, offC[1]);
    if (wr == 1) PG8_BAR;
    PG8_WAIT_V(2); PG8_BAR;
    PG8_STAGE(PG8_SB(1, 0), cB + kstep, voffB); PG8_STAGE(PG8_SA(1, 0), cA + kstep, offC[0]); PG8_STAGE(PG8_SB(1, 1), cB + hstepB + kstep, voffB);
    PG8_WAIT_V(6); PG8_BAR;
    for (;;) {
        const bool has_next = S.next(ui + 1, nxt);
        const char* nA = has_next ? S.a_base(nxt) : cA; const char* nB = has_next ? S.b_base(nxt) : cB;
        int pfi[2][2] = {{0, 0}, {0, 0}};
        if constexpr (P::GATHER_PF) { if (has_next) {
#pragma unroll
            for (int h = 0; h < 2; ++h)
#pragma unroll
                for (int i = 0; i < 2; ++i) pfi[h][i] = S.a_idx(nxt, h * HALF + Rr[i]); } }
        for (int t = 0; t < nt; t += 2) {
            const bool last = (t == nt - 2);
            const char* a1 = cA + (size_t)(t + 1) * kstep;
            const char* a2 = last ? nA : cA + (size_t)(t + 2) * kstep; const char* b2 = last ? nB : cB + (size_t)(t + 2) * kstep;
            const char* a3 = a2 + kstep; const char* b3 = b2 + kstep;
            if (last && has_next) {
#pragma unroll
                for (int h = 0; h < 2; ++h)
#pragma unroll
                    for (int i = 0; i < 2; ++i) { if constexpr (P::GATHER_PF) offN[h][i] = S.a_off_idx(pfi[h][i]) + (unsigned)Cc[i] * 2u; else offN[h][i] = S.a_off(nxt, h * HALF + Rr[i]) + (unsigned)Cc[i] * 2u; }
            }
            unsigned o2[2][2];
#pragma unroll
            for (int h = 0; h < 2; ++h)
#pragma unroll
                for (int i = 0; i < 2; ++i) o2[h][i] = last ? offN[h][i] : offC[h][i];
            PG8_LDB(B0, 0, 0); PG8_LDB(B1, 0, 1); PG8_SCHED; PG8_LDA(At, 0, 0); PG8_STAGE(PG8_SA(1, 1), a1, offC[1]);
            PG8_WAIT_V(8); PG8_WAIT_L(0); PG8_BAR; PG8_MMA(0, 0, At, B0); PG8_MMA(0, 1, At, B1); PG8_BAR; PG8_SCHED;
            PG8_LDA(At, 0, 1); PG8_STAGE(PG8_SB(0, 0), b2, voffB); PG8_STAGE(PG8_SB(0, 1), b2 + hstepB, voffB); PG8_STAGE(PG8_SA(0, 0), a2, o2[0]);
            PG8_WAIT_V(8); PG8_WAIT_L(0); PG8_BAR; PG8_MMA(1, 0, At, B0); PG8_MMA(1, 1, At, B1); PG8_BAR; PG8_SCHED;
            PG8_LDB(B0, 1, 0); PG8_LDB(B1, 1, 1); PG8_SCHED; PG8_LDA(At, 1, 0); PG8_STAGE(PG8_SA(0, 1), a2, o2[1]);
            PG8_WAIT_V(8); PG8_WAIT_L(0); PG8_BAR; PG8_MMA(0, 0, At, B0); PG8_MMA(0, 1, At, B1); PG8_BAR; PG8_SCHED;
            PG8_LDA(At, 1, 1); PG8_STAGE(PG8_SB(1, 0), b3, voffB); PG8_STAGE(PG8_SB(1, 1), b3 + hstepB, voffB); PG8_STAGE(PG8_SA(1, 0), a3, o2[0]);
            PG8_WAIT_V(8); PG8_WAIT_L(0); PG8_BAR; PG8_MMA(1, 0, At, B0); PG8_MMA(1, 1, At, B1); PG8_BAR; PG8_SCHED;
        }
        if constexpr (ALIGN_EPI) { if (wr == 0) PG8_BAR; }
        E(acc, cur, wr, wc, fr, fq);
        if (!has_next) break;
#pragma unroll
        for (int a = 0; a < 2; ++a)
#pragma unroll
            for (int b = 0; b < 2; ++b)
#pragma unroll
                for (int m = 0; m < 4; ++m)
#pragma unroll
                    for (int n = 0; n < 2; ++n) acc[a][b][m][n] = (acc_t){0, 0, 0, 0};
        cur = nxt; cA = nA; cB = nB; ++ui;
#pragma unroll
        for (int h = 0; h < 2; ++h)
#pragma unroll
            for (int i = 0; i < 2; ++i) offC[h][i] = offN[h][i];
        if constexpr (ALIGN_EPI) { if (wr == 1) PG8_BAR; }
    }
    PG8_WAIT_V(0);
    if constexpr (!ALIGN_EPI) { if (wr == 0) PG8_BAR; }
    PG8_BAR;
#undef PG8_SA
#undef PG8_SB
#undef PG8_STAGE
#undef PG8_LDA
#undef PG8_LDB
#undef PG8_MMA
#undef PG8_WAIT_V
#undef PG8_WAIT_L
#undef PG8_BAR
#undef PG8_SCHED
}

struct PlainProb {
    static constexpr bool GATHER_PF = false;
    const char* A; const char* Bt; int lda, ldb, nt, nM, nN, G, c;
    DI bool next(int i, Unit& u) const {
        const long L = (long)i * G + c; const int nwg = nM * nN; if (L >= nwg) return false;
        int wgid = (int)L; { const int q = nwg / 8, r = nwg % 8, xcd = wgid % 8, off = wgid / 8; wgid = (xcd < r ? xcd * (q + 1) : r * (q + 1) + (xcd - r) * q) + off; }
        const int nig = 8 * nN, gid = wgid / nig, fm = gid * 8, gsz = (nM - fm) < 8 ? (nM - fm) : 8;
        u.pm = fm + ((wgid % nig) % gsz); u.pn = (wgid % nig) / gsz; u.e = 0; u.blk = 0; return true;
    }
    DI const char* a_base(const Unit& u) const { return A + (size_t)u.pm * 256 * lda * 2; }
    DI const char* b_base(const Unit& u) const { return Bt + (size_t)u.pn * 256 * ldb * 2; }
    DI unsigned a_off(const Unit&, int row) const { return (unsigned)row * (unsigned)lda * 2u; }
};
}

constexpr size_t MiB = 1u << 20;
constexpr size_t WS_CTL = 0, CTL_ZERO_BYTES = 1 * MiB;
constexpr size_t WS_MOD = 1 * MiB;
constexpr size_t WS_RT_EID = 3 * MiB;
constexpr size_t WS_RT_GATE = WS_RT_EID + 512 * 1024;
constexpr size_t WS_RT_PIE = WS_RT_GATE + 512 * 1024;
constexpr size_t WS_RT_SORT = WS_RT_PIE + 512 * 1024;
constexpr size_t WS_WIN = 8 * MiB;
constexpr size_t WS_WINSC = 8 * MiB + 5 * MiB;
constexpr size_t WS_HSC = 7 * MiB + 512 * 1024;
constexpr size_t WS_WOUT = 17 * MiB;
constexpr size_t WS_WMLA = 21 * MiB;
constexpr size_t WS_WGLU = 23 * MiB;
constexpr size_t WS_WR = 23 * MiB + 256 * 1024;
constexpr size_t WS_WLRU = 23 * MiB + 640 * 1024;
constexpr size_t WS_WLORA = 23 * MiB + 768 * 1024;
static_assert(WS_WGLU + 256 * 1024 <= WS_WR && WS_WR + 384 * 1024 <= WS_WLRU && WS_WLRU + 128 * 1024 <= WS_WLORA && WS_WLORA + 128 * 1024 <= 24 * MiB, "small weight map");
constexpr size_t WS_H = 24 * MiB;
constexpr size_t WS_Z = 152 * MiB;
constexpr size_t WS_WM1 = WS_Z;
constexpr size_t WS_WM2 = WS_Z + 64 * MiB;
constexpr size_t WS_WM1SC = WS_Z + 32 * MiB;
constexpr size_t WS_H2SC = 7 * MiB + 768 * 1024;
constexpr size_t WS_MIX = 440 * MiB;
constexpr size_t WS_HID = WS_MIX;
constexpr size_t WS_Y = 569 * MiB;
constexpr size_t WS_Q = 825 * MiB;
constexpr size_t WS_K = 873 * MiB;
constexpr size_t WS_VT = 921 * MiB;
constexpr size_t WS_ROWSS = WS_Q;
constexpr size_t WS_TAIL = 953 * MiB;
constexpr size_t WS_END = 1017 * MiB;
constexpr size_t WS_AMLA = WS_TAIL;
constexpr size_t WS_QKVRAW = WS_Y;
constexpr size_t WS_ATTO = WS_H;
constexpr size_t WS_RW_V = WS_Y + 64 * MiB, WS_RW_G = WS_H + 64 * MiB;
constexpr size_t WS_RC_RP = WS_H + 32 * MiB;
constexpr size_t WS_RC_MP = WS_H + 64 * MiB;
constexpr size_t WS_RC_HB = WS_H + 96 * MiB;
constexpr size_t WS_RC_Y0 = WS_Q;
constexpr size_t WS_RC_G = WS_Q + 64 * MiB;
constexpr int RC_REC = 24832;
constexpr size_t WS_RC_BS = WS_Q + 64 * MiB + 98 * MiB;
static_assert((size_t)4096 * RC_REC <= 98 * MiB && WS_RC_BS + 1 * MiB <= WS_END, "rwkv record map");
constexpr size_t WS_YS5 = WS_Y;
constexpr size_t WS_YS5G = WS_Y + 32 * MiB;
constexpr size_t WS_YL = WS_TAIL + 32 * MiB;
constexpr size_t WS_LA = WS_Y + 128 * MiB, WS_LB = WS_Y + 192 * MiB;
constexpr size_t WS_S5END = 2 * MiB;
constexpr size_t WS_S5BB = 5 * MiB;
constexpr size_t WS_S5CC = 5 * MiB + 128 * 1024;
constexpr size_t WS_LSUM = 5 * MiB + 512 * 1024;
static_assert(WS_RT_SORT + 512 * 1024 <= WS_LSUM && WS_LSUM + 2 * MiB <= WS_WIN && WS_S5END + 1 * MiB <= WS_RT_EID, "map");

constexpr int CW_BAR = 4096;
constexpr int CW_CNT = 16384;
constexpr int CW_INMAX = 32768;
constexpr int CW_COLMAX = 65536;
constexpr int CW_UTAB = 20480;

constexpr int NWAVES = 8, NTHR = 512;
constexpr int LDS_BYTES = 155648;
constexpr int MISC_OFF = 155648 - 256;

struct Args { const float* in[51]; const int* pos_off; float* out; unsigned char* ws; int ph_lo, ph_hi, use_bar, pad; };
typedef const __attribute__((address_space(4))) Args CArgs;
DI CArgs* get_args() { CArgs* ap = (CArgs*)__builtin_amdgcn_kernarg_segment_ptr(); asm volatile("" : "+s"(ap)); return ap; }

#define XB_TMO      128
#define XB_XCNT(j)  (256  + 64 * (j))
#define XB_XSUB(j)  (1280 + 64 * (j))
#define XB_XGEN(j)  (2304 + 64 * (j))
#define XB_TOP      3328
#define XB_TOPGEN   3392
#define XCD_BAR_WORDS 3456
#define XB_SPIN_CAP (1u << 18)
DI unsigned xb_ld(unsigned* p)              { return __hip_atomic_load(p, __ATOMIC_RELAXED, __HIP_MEMORY_SCOPE_AGENT); }
DI unsigned xb_add(unsigned* p, unsigned v) { return __hip_atomic_fetch_add(p, v, __ATOMIC_RELAXED, __HIP_MEMORY_SCOPE_AGENT); }
DI unsigned xb_xcc_id() { return (unsigned)__builtin_amdgcn_s_getreg((3 << 11) | 20) & 0xFu; }
#define XB_SPIN(cond, bar) do { unsigned _sp = 0; while (cond) { __builtin_amdgcn_s_sleep(1); \
    if ((++_sp & 255u) == 0u) { if (xb_ld(&(bar)[XB_TMO])) break; if (_sp > XB_SPIN_CAP) { atomicAdd(&(bar)[XB_TMO], 1u); break; } } } } while (0)
struct XcdBarrier { unsigned* bar; unsigned x; volatile LAS unsigned* st; };
DI XcdBarrier xcd_barrier_post(unsigned* bar, volatile LAS unsigned* st) {
    XcdBarrier b; b.bar = bar; b.x = xb_xcc_id(); b.st = st;
    if (threadIdx.x == 0) (void)xb_add(&bar[XB_XCNT(b.x)], 1u);
    return b;
}
DI void xcd_barrier_complete(unsigned* bar, unsigned x, unsigned& nloc, unsigned& nx) {
    const unsigned G = gridDim.x * gridDim.y * gridDim.z;
    unsigned sum, cnt, mine, sp = 0u;
    for (;;) {
        sum = 0u; cnt = 0u; mine = 0u;
#pragma unroll
        for (unsigned j = 0; j < 16; ++j) { const unsigned c = xb_ld(&bar[XB_XCNT(j)]); sum += c; cnt += (c > 0u) ? 1u : 0u; mine = (j == x) ? c : mine; }
        if (sum == G) break;
        __builtin_amdgcn_s_sleep(1);
        if ((++sp & 255u) == 0u) { if (xb_ld(&bar[XB_TMO])) break; if (sp > XB_SPIN_CAP) { atomicAdd(&bar[XB_TMO], 1u); break; } }
    }
    nloc = mine > 0u ? mine : 1u; nx = cnt > 0u ? cnt : 1u;
}
DI void xcd_barrier(const XcdBarrier& b) {
    asm volatile("s_waitcnt vmcnt(0)" ::: "memory");
    __syncthreads();
    if (threadIdx.x == 0) {
        unsigned* bar = b.bar;
        __builtin_amdgcn_s_waitcnt(0);
        unsigned nloc = b.st[0], nx = b.st[1];
        if (nloc == 0u) { xcd_barrier_complete(bar, b.x, nloc, nx); b.st[0] = nloc; b.st[1] = nx; }
        const unsigned old = xb_add(&bar[XB_XSUB(b.x)], 1u);
        const unsigned gen = old / nloc;
        if (old + 1u == (gen + 1u) * nloc) {
            __builtin_amdgcn_fence(__ATOMIC_RELEASE, "agent");
            asm volatile("s_waitcnt vmcnt(0)" ::: "memory");
            const unsigned og = xb_add(&bar[XB_TOP], 1u);
            const unsigned tg = og / nx;
            if (og + 1u == (tg + 1u) * nx) xb_add(&bar[XB_TOPGEN], 1u);
            else XB_SPIN(xb_ld(&bar[XB_TOPGEN]) == tg, bar);
            __builtin_amdgcn_fence(__ATOMIC_ACQUIRE, "agent");
            xb_add(&bar[XB_XGEN(b.x)], 1u);
            asm volatile("s_waitcnt vmcnt(0)" ::: "memory");
        } else {
            XB_SPIN(xb_ld(&bar[XB_XGEN(b.x)]) == gen, bar);
            __builtin_amdgcn_fence(__ATOMIC_ACQUIRE, "agent");
            asm volatile("s_waitcnt vmcnt(0)" ::: "memory");
        }
    }
    __syncthreads();
}

struct EpiBf16Plain {
    static constexpr bool PERM = true;
    bf16_t* O; int ldc;
    DI void operator()(const f32x4 (&acc)[2][2][4][2], const pg8::Unit& u, int wr, int wc, int fr, int fq) const {
        const int row0 = u.pm * 256 + wr * 64 + fr, col0 = u.pn * 256 + wc * 32 + 8 * fq;
#pragma unroll
        for (int ai = 0; ai < 2; ++ai)
#pragma unroll
            for (int m = 0; m < 4; ++m) { bf16_t* rowp = O + (size_t)(row0 + ai * 128 + m * 16) * ldc + col0;
#pragma unroll
                for (int bj = 0; bj < 2; ++bj) { const f32x4 v0 = acc[ai][bj][m][0], v1 = acc[ai][bj][m][1];
                    u32x4 w; w.x = pk2(v0[0], v0[1]); w.y = pk2(v0[2], v0[3]); w.z = pk2(v1[0], v1[1]); w.w = pk2(v1[2], v1[3]);
                    *(u32x4*)(rowp + bj * 128) = w; } }
    }
};
struct EpiBf16I8 {
    static constexpr bool PERM = true;
    bf16_t* O; int ldc; const float* sa; const float* sw;
    DI void operator()(const i32x4 (&acc)[2][2][4][2], const pg8::Unit& u, int wr, int wc, int fr, int fq) const {
        const int row0 = u.pm * 256 + wr * 64 + fr, col0 = u.pn * 256 + wc * 32 + 8 * fq;
        f32x4 w0[2], w1[2];
#pragma unroll
        for (int bj = 0; bj < 2; ++bj) { w0[bj] = *(const f32x4*)(sw + col0 + bj * 128); w1[bj] = *(const f32x4*)(sw + col0 + bj * 128 + 4); }
#pragma unroll
        for (int ai = 0; ai < 2; ++ai)
#pragma unroll
            for (int m = 0; m < 4; ++m) { const int row = row0 + ai * 128 + m * 16; const float ra = sa[row]; bf16_t* rowp = O + (size_t)row * ldc + col0;
#pragma unroll
                for (int bj = 0; bj < 2; ++bj) { const i32x4 a0 = acc[ai][bj][m][0], a1 = acc[ai][bj][m][1];
                    u32x4 w; w.x = pk2((float)a0[0] * ra * w0[bj][0], (float)a0[1] * ra * w0[bj][1]); w.y = pk2((float)a0[2] * ra * w0[bj][2], (float)a0[3] * ra * w0[bj][3]);
                    w.z = pk2((float)a1[0] * ra * w1[bj][0], (float)a1[1] * ra * w1[bj][1]); w.w = pk2((float)a1[2] * ra * w1[bj][2], (float)a1[3] * ra * w1[bj][3]);
                    *(u32x4*)(rowp + bj * 128) = w; } }
    }
};
struct EpiResGate {
    static constexpr bool PERM = false;
    const float* xin; float* out; const float* gt; float* rowss; const float* n2g;
    DI void operator()(const f32x4 (&acc)[2][2][4][2], const pg8::Unit& u, int wr, int wc, int fr, int fq) const {
        const int row0 = u.pm * 256 + wr * 64 + fr, col0 = u.pn * 256 + wc * 32 + 4 * fq;
        const int b = (u.pm * 256) / SEQ;
        const int ln = lane_opaque();
        f32x4 g[2][2], G2[2][2];
#pragma unroll
        for (int bj = 0; bj < 2; ++bj)
#pragma unroll
            for (int n = 0; n < 2; ++n) { g[bj][n] = *(const f32x4*)(gt + (size_t)b * 6144 + col0 + bj * 128 + n * 16);
                G2[bj][n] = *(const f32x4*)(n2g + col0 + bj * 128 + n * 16) * (*(const f32x4*)(gt + (size_t)b * 6144 + 2048 + col0 + bj * 128 + n * 16) + 1.f); }
#pragma unroll
        for (int ai = 0; ai < 2; ++ai)
#pragma unroll
            for (int m = 0; m < 4; ++m) { const size_t ro = (size_t)(row0 + ai * 128 + m * 16) * DM + col0; float ss = 0.f, mxg = 0.f;
#pragma unroll
                for (int bj = 0; bj < 2; ++bj)
#pragma unroll
                    for (int n = 0; n < 2; ++n) { const f32x4 xv = *(const f32x4*)(xin + ro + bj * 128 + n * 16); const f32x4 v = xv + g[bj][n] * acc[ai][bj][m][n];
                        *(f32x4*)(out + ro + bj * 128 + n * 16) = v; ss += (v[0] * v[0] + v[1] * v[1]) + (v[2] * v[2] + v[3] * v[3]);
                        const f32x4 vg = v * G2[bj][n]; mxg = fmaxf(mxg, fmaxf(fmaxf(fabsf(vg[0]), fabsf(vg[1])), fmaxf(fabsf(vg[2]), fabsf(vg[3])))); }
                ss += shfl_xor_l(ss, 16, ln); ss += shfl_xor_l(ss, 32, ln); mxg = fmaxf(mxg, shfl_xor_l(mxg, 16, ln)); mxg = fmaxf(mxg, shfl_xor_l(mxg, 32, ln));
                if (fq == 0) { float* rp = rowss + (size_t)(row0 + ai * 128 + m * 16) * 32 + u.pn * 4 + wc; rp[0] = ss; rp[16] = mxg; } }
    }
};
struct EpiGlu {
    static constexpr bool PERM = true;
    const bf16_t* Y; bf16_t* O; const float* bias;
    DI void operator()(const f32x4 (&acc)[2][2][4][2], const pg8::Unit& u, int wr, int wc, int fr, int fq) const {
        const int row0 = u.pm * 256 + wr * 64 + fr, col0 = wc * 32 + 8 * fq;
#pragma unroll
        for (int ai = 0; ai < 2; ++ai)
#pragma unroll
            for (int m = 0; m < 4; ++m) { const size_t ro = (size_t)(row0 + ai * 128 + m * 16) * 256 + col0;
#pragma unroll
                for (int bj = 0; bj < 2; ++bj) { const u32x4 yv = *(const u32x4*)(Y + ro + bj * 128);
                    const f32x4 b0 = *(const f32x4*)(bias + col0 + bj * 128), b1 = *(const f32x4*)(bias + col0 + bj * 128 + 4);
                    const f32x4 v0 = acc[ai][bj][m][0] + b0, v1 = acc[ai][bj][m][1] + b1;
                    u32x4 w;
                    w.x = pk2(bflo(yv.x) * sigmoidf_(v0[0]), bfhi(yv.x) * sigmoidf_(v0[1]));
                    w.y = pk2(bflo(yv.y) * sigmoidf_(v0[2]), bfhi(yv.y) * sigmoidf_(v0[3]));
                    w.z = pk2(bflo(yv.z) * sigmoidf_(v1[0]), bfhi(yv.z) * sigmoidf_(v1[1]));
                    w.w = pk2(bflo(yv.w) * sigmoidf_(v1[2]), bfhi(yv.w) * sigmoidf_(v1[3]));
                    *(u32x4*)(O + ro + bj * 128) = w; } }
    }
};

struct Frame { LAS unsigned char* lds; int tid, lane, wave, G, bid, gw, ngw; };

DI Frame make_frame(LAS unsigned char* lds, int wave0) {
    Frame F; F.lds = lds; int w = wave0; asm volatile("" : "+s"(w)); F.wave = w; F.lane = lane_opaque(); F.tid = w * 64 + F.lane;
    F.G = gridDim.x; F.bid = blockIdx.x; F.gw = F.bid * NWAVES + F.wave; F.ngw = F.G * NWAVES; return F;
}
DI void transpose_item(const float* src, int ld_src, int k0, int n0, bf16_t* dst, int ldd, int nd0, int kd0, LAS float* scr, int lane) {
#pragma unroll 8
    for (int i = 0; i < 32; ++i) { const int kk = 2 * i + (lane >> 5); scr[kk * 33 + (lane & 31)] = src[(size_t)(k0 + kk) * ld_src + n0 + (lane & 31)]; }
    asm volatile("s_waitcnt lgkmcnt(0)" ::: "memory");
    const int c = lane & 7;
#pragma unroll
    for (int j = 0; j < 4; ++j) { const int n = (lane >> 3) + 8 * j; const LAS float* s = scr + (8 * c) * 33 + n;
        u32x4 o; o.x = pk2(s[0 * 33], s[1 * 33]); o.y = pk2(s[2 * 33], s[3 * 33]); o.z = pk2(s[4 * 33], s[5 * 33]); o.w = pk2(s[6 * 33], s[7 * 33]);
        *(u32x4*)(dst + (size_t)(nd0 + n) * ldd + kd0 + 8 * c) = o; }
    asm volatile("s_waitcnt lgkmcnt(0)" ::: "memory");
}
DI void transpose_item64(const float* src, int ld_src, int k0, int n0, bf16_t* dst, int ldd, int nd0, int kd0, LAS float* scr, int lane) {
    f32x4 v[16];
#pragma unroll
    for (int i = 0; i < 16; ++i) v[i] = *(const f32x4*)(src + (size_t)(k0 + 4 * i + (lane >> 4)) * ld_src + n0 + 4 * (lane & 15));
#pragma unroll
    for (int i = 0; i < 16; ++i) { LAS float* p = scr + (4 * i + (lane >> 4)) * 65 + 4 * (lane & 15); p[0] = v[i][0]; p[1] = v[i][1]; p[2] = v[i][2]; p[3] = v[i][3]; }
    asm volatile("s_waitcnt lgkmcnt(0)" ::: "memory");
    const int c = lane & 7;
#pragma unroll
    for (int j = 0; j < 8; ++j) { const int n = (lane >> 3) + 8 * j; const LAS float* q = scr + (8 * c) * 65 + n;
        u32x4 o; o.x = pk2(q[0 * 65], q[1 * 65]); o.y = pk2(q[2 * 65], q[3 * 65]); o.z = pk2(q[4 * 65], q[5 * 65]); o.w = pk2(q[6 * 65], q[7 * 65]);
        *(u32x4*)(dst + (size_t)(nd0 + n) * ldd + kd0 + 8 * c) = o; }
    asm volatile("s_waitcnt lgkmcnt(0)" ::: "memory");
}
DI void quant_item64(const float* src, int ld_src, int k0, int n0, signed char* dst, int ldd, int nd0, int kd0, const unsigned* colmax, float* wsc, LAS float* scr, int lane, int nvalid = 1 << 30) {
    f32x4 v[16]; const bool okc = n0 + 4 * (lane & 15) < nvalid;
#pragma unroll
    for (int i = 0; i < 16; ++i) { v[i] = (f32x4){0.f, 0.f, 0.f, 0.f}; if (okc) v[i] = *(const f32x4*)(src + (size_t)(k0 + 4 * i + (lane >> 4)) * ld_src + n0 + 4 * (lane & 15)); }
#pragma unroll
    for (int i = 0; i < 16; ++i) { LAS float* p = scr + (4 * i + (lane >> 4)) * 65 + 4 * (lane & 15); p[0] = v[i][0]; p[1] = v[i][1]; p[2] = v[i][2]; p[3] = v[i][3]; }
    asm volatile("s_waitcnt lgkmcnt(0)" ::: "memory");
    const int c = lane & 7;
#pragma unroll
    for (int j = 0; j < 8; ++j) { const int n = (lane >> 3) + 8 * j; const LAS float* q = scr + (8 * c) * 65 + n;
        const float sc = fmaxf(__uint_as_float(colmax[n]), 1e-30f) * (1.f / 127.f), inv = 1.f / sc;
        if (wsc && c == 0) wsc[n] = sc;
        u32x2 o; o.x = q8x4((f32x4){q[0 * 65], q[1 * 65], q[2 * 65], q[3 * 65]}, inv); o.y = q8x4((f32x4){q[4 * 65], q[5 * 65], q[6 * 65], q[7 * 65]}, inv);
        *(u32x2*)(dst + (size_t)(nd0 + n) * ldd + kd0 + 8 * c) = o; }
    asm volatile("s_waitcnt lgkmcnt(0)" ::: "memory");
}
DI void quant_strip64(const float* src, int ld_src, int n0, int nvalid, signed char* dst, int ldd, float* scale, LAS float* scr, int lane) {
    const int c4 = n0 + 4 * (lane & 15); const bool okc = c4 < nvalid;
    float mx[4] = {0.f, 0.f, 0.f, 0.f};
    for (int kb = 0; kb < 16; ++kb) {
#pragma unroll
        for (int i = 0; i < 16; ++i) { f32x4 v = {0.f, 0.f, 0.f, 0.f}; if (okc) v = *(const f32x4*)(src + (size_t)(64 * kb + 4 * i + (lane >> 4)) * ld_src + c4);
            mx[0] = fmaxf(mx[0], fabsf(v[0])); mx[1] = fmaxf(mx[1], fabsf(v[1])); mx[2] = fmaxf(mx[2], fabsf(v[2])); mx[3] = fmaxf(mx[3], fabsf(v[3])); } }
#pragma unroll
    for (int q = 0; q < 4; ++q) { mx[q] = fmaxf(mx[q], shfl_xor_l(mx[q], 16, lane)); mx[q] = fmaxf(mx[q], shfl_xor_l(mx[q], 32, lane)); }
    LAS float* smax = scr + 64 * 65;
    if (lane < 16) {
#pragma unroll
        for (int q = 0; q < 4; ++q) { const float sc = fmaxf(mx[q], 1e-30f) * (1.f / 127.f); smax[4 * lane + q] = sc; scale[4 * lane + q] = sc; } }
    asm volatile("s_waitcnt lgkmcnt(0)" ::: "memory");
    for (int kb = 0; kb < 16; ++kb) {
        f32x4 v[16];
#pragma unroll
        for (int i = 0; i < 16; ++i) { v[i] = (f32x4){0.f, 0.f, 0.f, 0.f}; if (okc) v[i] = *(const f32x4*)(src + (size_t)(64 * kb + 4 * i + (lane >> 4)) * ld_src + c4); }
#pragma unroll
        for (int i = 0; i < 16; ++i) { LAS float* p = scr + (4 * i + (lane >> 4)) * 65 + 4 * (lane & 15); p[0] = v[i][0]; p[1] = v[i][1]; p[2] = v[i][2]; p[3] = v[i][3]; }
        asm volatile("s_waitcnt lgkmcnt(0)" ::: "memory");
        const int c = lane & 7;
#pragma unroll
        for (int j = 0; j < 8; ++j) { const int n = (lane >> 3) + 8 * j; const LAS float* q = scr + (8 * c) * 65 + n; const float inv = 1.f / smax[n];
            u32x2 o; o.x = q8x4((f32x4){q[0 * 65], q[1 * 65], q[2 * 65], q[3 * 65]}, inv); o.y = q8x4((f32x4){q[4 * 65], q[5 * 65], q[6 * 65], q[7 * 65]}, inv);
            *(u32x2*)(dst + (size_t)n * ldd + 64 * kb + 8 * c) = o; }
        asm volatile("s_waitcnt lgkmcnt(0)" ::: "memory");
    }
}
DI void zero_rows(bf16_t* dst, int ld, int r0, int nr, int c0, int nc, int gw, int ngw, int lane) {
    for (int r = gw; r < nr; r += ngw) for (int c = lane * 8; c < nc; c += 512) *(u32x4*)(dst + (size_t)(r0 + r) * ld + c0 + c) = (u32x4){0u, 0u, 0u, 0u};
}

DI void phase_prologue(const Frame& F, CArgs& A) {
    unsigned char* ws = A.ws;
    LAS float* sc = (LAS float*)F.lds;
    LAS float* part = (LAS float*)(F.lds + 32768);
    for (int i = F.tid; i < 8192; i += NTHR) sc[i] = siluf_(A.in[1][i]);
    __syncthreads();
    float* MOD = (float*)(ws + WS_MOD);
    for (int item = F.bid; item < 192; item += F.G) {
        const int l = item / 96, n0 = (item % 96) * 64, nl = F.tid & 63, kg = F.tid >> 6;
        const float* W = A.in[3] + (size_t)l * 1024 * 6144 + n0 + nl;
        float acc[8];
#pragma unroll
        for (int b = 0; b < 8; ++b) acc[b] = 0.f;
        for (int k = kg * 128; k < kg * 128 + 128; ++k) { const float w = W[(size_t)k * 6144];
#pragma unroll
            for (int b = 0; b < 8; ++b) acc[b] += sc[b * 1024 + k] * w; }
#pragma unroll
        for (int b = 0; b < 8; ++b) part[(kg * 8 + b) * 64 + nl] = acc[b];
        __syncthreads();
        { const int b = F.tid >> 6; float s = A.in[4][l * 6144 + n0 + nl];
#pragma unroll
          for (int g = 0; g < 8; ++g) s += part[(g * 8 + b) * 64 + nl];
          MOD[((size_t)l * 8 + b) * 6144 + n0 + nl] = s; }
        __syncthreads();
    }
    LAS float* scr = (LAS float*)(F.lds + F.wave * 16896);
    bf16_t* WIN = (bf16_t*)(ws + WS_WIN); bf16_t* WOUT = (bf16_t*)(ws + WS_WOUT); bf16_t* WMLA = (bf16_t*)(ws + WS_WMLA); bf16_t* WGLU = (bf16_t*)(ws + WS_WGLU);
    constexpr int I_IN = 0, I_INT = 0, I_OUT = 16 * 16, I_Q = 4 * 6, I_KV = 2 * 8, I_GLU = 4 * 4, I_L = I_IN + I_INT + I_OUT + I_Q + I_KV + I_GLU;
    for (int it = F.gw; it < 2 * I_L; it += F.ngw) {
        const int l = it / I_L; int r = it % I_L;
        if (r < I_IN) { transpose_item64(A.in[6] + (size_t)l * 1024 * D_IN, D_IN, 64 * (r / 32), 64 * (r % 32), WIN + (size_t)l * ZS * 1024, 1024, 64 * (r % 32), 64 * (r / 32), scr, F.lane); continue; } r -= I_IN;
        if (r < I_INT) { transpose_item(A.in[6] + (size_t)l * 1024 * D_IN, D_IN, 64 * r, 2048, WIN + (size_t)l * ZS * 1024, 1024, 2048, 64 * r, scr, F.lane); continue; } r -= I_INT;
        if (r < I_OUT) { transpose_item64(A.in[42] + (size_t)l * 1024 * 1024, 1024, 64 * (r / 16), 64 * (r % 16), WOUT + (size_t)l * 1024 * 1024, 1024, 64 * (r % 16), 64 * (r / 16), scr, F.lane); continue; } r -= I_OUT;
        if (r < I_Q) { transpose_item64(A.in[29] + (size_t)l * 256 * 384, 384, 64 * (r / 6), 64 * (r % 6), WMLA + (size_t)l * 1024 * 512, 512, 64 * (r % 6), 64 * (r / 6), scr, F.lane); continue; } r -= I_Q;
        if (r < I_KV) { transpose_item64(A.in[31] + (size_t)l * 128 * 512, 512, 64 * (r / 8), 64 * (r % 8), WMLA + (size_t)l * 1024 * 512, 512, 384 + 64 * (r % 8), 256 + 64 * (r / 8), scr, F.lane); continue; } r -= I_KV;
        transpose_item64(A.in[26] + (size_t)l * 256 * 256, 256, 64 * (r / 4), 64 * (r % 4), WGLU + (size_t)l * 256 * 256, 256, 64 * (r % 4), 64 * (r / 4), scr, F.lane);
    }
    { unsigned* CM = (unsigned*)(ws + WS_CTL) + CW_COLMAX;
      for (int it = F.gw; it < 2 * 32 * 2 * 128; it += F.ngw) { const int le = it >> 8, which = (it >> 7) & 1, kb = (it >> 3) & 15, nb = it & 7;
          const float* src = (which ? A.in[49] : A.in[48]) + (size_t)le * 1024 * 512 + (size_t)(64 * kb + (F.lane >> 4)) * 512 + 64 * nb + 4 * (F.lane & 15);
          float mx[4] = {0.f, 0.f, 0.f, 0.f};
#pragma unroll
          for (int i = 0; i < 16; ++i) { const f32x4 v = *(const f32x4*)(src + (size_t)(4 * i) * 512);
              mx[0] = fmaxf(mx[0], fabsf(v[0])); mx[1] = fmaxf(mx[1], fabsf(v[1])); mx[2] = fmaxf(mx[2], fabsf(v[2])); mx[3] = fmaxf(mx[3], fabsf(v[3])); }
#pragma unroll
          for (int q = 0; q < 4; ++q) { mx[q] = fmaxf(mx[q], shfl_xor_l(mx[q], 16, F.lane)); mx[q] = fmaxf(mx[q], shfl_xor_l(mx[q], 32, F.lane)); }
          if (F.lane < 16) { const int n0 = 64 * nb + 4 * F.lane, np = 256 * (n0 >> 7) + (n0 & 127) + 128 * which;
#pragma unroll
              for (int q = 0; q < 4; ++q) atomicMax(CM + (size_t)le * 1024 + np + q, __float_as_uint(mx[q])); } } }
    { unsigned* IM = (unsigned*)(ws + WS_CTL) + CW_INMAX;
      for (int it = F.gw; it < 2 * 16 * 33; it += F.ngw) { const int l = it / (16 * 33), r = it % (16 * 33), kb = r / 33, nb = r % 33;
          const int c4 = 64 * nb + 4 * (F.lane & 15); const bool okc = c4 < D_IN;
          const float* src = A.in[6] + (size_t)l * 1024 * D_IN + (size_t)(64 * kb + (F.lane >> 4)) * D_IN + c4;
          float mx[4] = {0.f, 0.f, 0.f, 0.f};
#pragma unroll
          for (int i = 0; i < 16; ++i) { f32x4 v = {0.f, 0.f, 0.f, 0.f}; if (okc) v = *(const f32x4*)(src + (size_t)(4 * i) * D_IN);
              mx[0] = fmaxf(mx[0], fabsf(v[0])); mx[1] = fmaxf(mx[1], fabsf(v[1])); mx[2] = fmaxf(mx[2], fabsf(v[2])); mx[3] = fmaxf(mx[3], fabsf(v[3])); }
#pragma unroll
          for (int q = 0; q < 4; ++q) { mx[q] = fmaxf(mx[q], shfl_xor_l(mx[q], 16, F.lane)); mx[q] = fmaxf(mx[q], shfl_xor_l(mx[q], 32, F.lane)); }
          if (F.lane < 16) {
#pragma unroll
              for (int q = 0; q < 4; ++q) atomicMax(IM + l * ZS + c4 + q, __float_as_uint(mx[q])); } }
      for (int l = 0; l < 2; ++l) {
          signed char* w8 = (signed char*)(ws + WS_WIN) + ((size_t)l * ZS + 2112) * 1024;
          for (int i = F.bid * NTHR + F.tid; i < 192 * 1024 / 16; i += F.G * NTHR) *(u32x4*)(w8 + (size_t)i * 16) = (u32x4){0u, 0u, 0u, 0u};
          for (int i = F.bid * NTHR + F.tid; i < 192; i += F.G * NTHR) ((float*)(ws + WS_WINSC))[l * ZS + 2112 + i] = 0.f; } }
    { bf16_t* WR = (bf16_t*)(ws + WS_WR);
      for (int i = F.bid * NTHR + F.tid; i < 2 * 48 * 1024; i += F.G * NTHR) { const int l = i / (48 * 1024), n = (i / 1024) % 48, k = i % 1024;
          const float v = n < 4 ? A.in[44][((size_t)l * 1024 + k) * 4 + n] : n < 36 ? A.in[46][((size_t)l * 1024 + k) * 32 + (n - 4)] : 0.f;
          const unsigned hi = f2bf(v); const float rem = v - __uint_as_float(hi << 16);
          WR[((size_t)(l * 2 + 0) * 48 + n) * 1024 + k] = (bf16_t)hi; WR[((size_t)(l * 2 + 1) * 48 + n) * 1024 + k] = (bf16_t)f2bf(rem); } }
    { bf16_t* WL = (bf16_t*)(ws + WS_WLRU); bf16_t* WO = (bf16_t*)(ws + WS_WLORA);
      for (int i = F.bid * NTHR + F.tid; i < 2 * 2 * 4 * 4096; i += F.G * NTHR) { const int l = i >> 15, wh = (i >> 14) & 1, n = (i >> 12) & 3, j = (i >> 6) & 63, k = i & 63;
          WL[i] = (bf16_t)f2bf((wh ? A.in[38] : A.in[36])[((size_t)(l * 4 + n) * 64 + k) * 64 + j]); }
      for (int i = F.bid * NTHR + F.tid; i < 2 * 32768; i += F.G * NTHR) { const int l = i >> 15, r = i & 32767;
          float v;
          if (r < 8192) v = A.in[9][(size_t)l * 8192 + (r & 31) * 256 + (r >> 5)];
          else if (r < 16384) v = A.in[11][(size_t)l * 8192 + ((r - 8192) & 31) * 256 + ((r - 8192) >> 5)];
          else v = A.in[12][(size_t)l * 16384 + ((r - 16384) & 63) * 256 + ((r - 16384) >> 6)];
          WO[i] = (bf16_t)f2bf(v); } }
    { bf16_t* BBt = (bf16_t*)(ws + WS_S5BB); bf16_t* CCt = (bf16_t*)(ws + WS_S5CC);
      for (int i = F.bid * NTHR + F.tid; i < 2 * 16 * 64; i += F.G * NTHR) { const int lg = i >> 6, p = i & 63;
          const float dt = __expf(A.in[25][lg]); const float lre = A.in[18][lg * 64 + p], lim = A.in[19][lg * 64 + p];
          const float mag = expf(lre * dt); float sn, cn; sincosf(lim * dt, &sn, &cn);
          const float are = mag * cn, aim = mag * sn, den = lre * lre + lim * lim;
          const float qre = ((are - 1.f) * lre + aim * lim) / den, qim = (aim * lre - (are - 1.f) * lim) / den;
          const float* br = A.in[20] + ((size_t)lg * 64 + p) * 16; const float* bi = A.in[21] + ((size_t)lg * 64 + p) * 16;
          for (int c = 0; c < 16; ++c) { const float x = br[c], y = bi[c];
              BBt[(((size_t)lg * 2 + 0) * 64 + p) * 16 + c] = (bf16_t)f2bf(qre * x - qim * y); BBt[(((size_t)lg * 2 + 1) * 64 + p) * 16 + c] = (bf16_t)f2bf(qre * y + qim * x); } }
      for (int i = F.bid * NTHR + F.tid; i < 2 * 16 * 16 * 128; i += F.G * NTHR) { const int lg = i >> 11, ii = (i >> 7) & 15, k = i & 127;
          CCt[i] = (bf16_t)f2bf(k < 64 ? A.in[22][((size_t)lg * 16 + ii) * 64 + k] : -A.in[23][((size_t)lg * 16 + ii) * 64 + (k - 64)]); } }
    for (int l = 0; l < 2; ++l) {
        bf16_t* wm = WMLA + (size_t)l * 1024 * 512;
        zero_rows(wm, 512, 0, 384, 256, 256, F.gw, F.ngw, F.lane);
        zero_rows(wm, 512, 384, 512, 0, 256, F.gw, F.ngw, F.lane);
        zero_rows(wm, 512, 384, 512, 384, 128, F.gw, F.ngw, F.lane);
        zero_rows(wm, 512, 896, 128, 0, 512, F.gw, F.ngw, F.lane);
    }
}

DI void phase_win_quant(const Frame& F, CArgs& A) {
    LAS float* scr = (LAS float*)(F.lds + F.wave * 16640);
    const unsigned* IM = (const unsigned*)(A.ws + WS_CTL) + CW_INMAX;
    for (int it = F.gw; it < 2 * 16 * 33; it += F.ngw) { const int l = it / (16 * 33), r = it % (16 * 33), kb = r / 33, nb = r % 33;
        quant_item64(A.in[6] + (size_t)l * 1024 * D_IN, D_IN, 64 * kb, 64 * nb, (signed char*)(A.ws + WS_WIN) + (size_t)l * ZS * 1024, 1024, 64 * nb, 64 * kb, IM + l * ZS + 64 * nb,
                     kb == 0 ? (float*)(A.ws + WS_WINSC) + l * ZS + 64 * nb : (float*)nullptr, scr, F.lane, D_IN); }
}
DI void phase_norm1(const Frame& F, CArgs& A, int l) {
    const float* MODL = (const float*)(A.ws + WS_MOD) + (size_t)l * 8 * 6144;
    const float* g = A.in[5] + l * 1024;
    const bf16_t* Y = (const bf16_t*)(A.ws + WS_Y);
    signed char* H8 = (signed char*)(A.ws + WS_H); float* HS = (float*)(A.ws + WS_HSC);
    const float* src = (l == 0) ? A.in[0] : A.out;
    for (int row0 = 2 * F.gw; row0 < T; row0 += 2 * F.ngw) {
        const int b = row0 / SEQ;
        f32x4 v[2][4]; u32x2 ya[2][4], yb[2][4];
#pragma unroll
        for (int r = 0; r < 2; ++r)
#pragma unroll
            for (int j = 0; j < 4; ++j) { const int col = 4 * (64 * j + F.lane); v[r][j] = *(const f32x4*)(src + (size_t)(row0 + r) * DM + col);
                if (l > 0) { ya[r][j] = *(const u32x2*)(Y + (size_t)(2 * (row0 + r)) * DM + col); yb[r][j] = *(const u32x2*)(Y + (size_t)(2 * (row0 + r) + 1) * DM + col); } }
#pragma unroll
        for (int r = 0; r < 2; ++r) {
            const int row = row0 + r; float ss = 0.f;
#pragma unroll
            for (int j = 0; j < 4; ++j) { const int col = 4 * (64 * j + F.lane);
                if (l > 0) { const u32x2 y0 = ya[r][j], y1 = yb[r][j];
                    v[r][j][0] += bflo(y0.x) + bflo(y1.x); v[r][j][1] += bfhi(y0.x) + bfhi(y1.x); v[r][j][2] += bflo(y0.y) + bflo(y1.y); v[r][j][3] += bfhi(y0.y) + bfhi(y1.y);
                    *(f32x4*)(A.out + (size_t)row * DM + col) = v[r][j]; }
                ss += v[r][j][0] * v[r][j][0] + v[r][j][1] * v[r][j][1] + v[r][j][2] * v[r][j][2] + v[r][j][3] * v[r][j][3]; }
            const float rstd = rsqrtf(wave_sum(ss) * (1.f / DM) + NORM_EPS);
#pragma unroll
            for (int j = 0; j < 4; ++j) { const int col = 4 * (64 * j + F.lane);
                const f32x4 gg = *(const f32x4*)(g + col), sh = *(const f32x4*)(MODL + (size_t)b * 6144 + col), scv = *(const f32x4*)(MODL + (size_t)b * 6144 + 1024 + col);
                v[r][j] = v[r][j] * rstd * gg * (scv + 1.f) + sh; }
            float mx = 0.f;
#pragma unroll
            for (int j = 0; j < 4; ++j) mx = fmaxf(mx, fmaxf(fmaxf(fabsf(v[r][j][0]), fabsf(v[r][j][1])), fmaxf(fabsf(v[r][j][2]), fabsf(v[r][j][3]))));
            mx = fmaxf(wave_max(mx), 1e-30f); const float inv = 127.f / mx;
            if (F.lane == 0) HS[row] = mx * (1.f / 127.f);
#pragma unroll
            for (int j = 0; j < 4; ++j) *(unsigned*)(H8 + (size_t)row * DM + 4 * (64 * j + F.lane)) = q8x4(v[r][j], inv);
        }
    }
}

DI void phase_mla_prep(const Frame& F, CArgs& A, int l) {
    const bf16_t* Z = (const bf16_t*)(A.ws + WS_Z); bf16_t* AM = (bf16_t*)(A.ws + WS_AMLA);
    const float* qg = A.in[28] + l * 256; const float* kg = A.in[30] + l * 128;
    for (int row = F.gw; row < T; row += F.ngw) {
        const bf16_t* zr = Z + (size_t)row * ZS;
        const u32x2 qv = *(const u32x2*)(zr + ZC_QA + 4 * F.lane); const unsigned kv = *(const unsigned*)(zr + ZC_KVA + 2 * F.lane);
        const float q0 = bflo(qv.x), q1 = bfhi(qv.x), q2 = bflo(qv.y), q3 = bfhi(qv.y), k0 = bflo(kv), k1 = bfhi(kv);
        const float rq = rsqrtf(wave_sum(q0 * q0 + q1 * q1 + q2 * q2 + q3 * q3) * (1.f / 256.f) + NORM_EPS);
        const float rk = rsqrtf(wave_sum(k0 * k0 + k1 * k1) * (1.f / 128.f) + NORM_EPS);
        const f32x4 g4 = *(const f32x4*)(qg + 4 * F.lane); const f32x2 g2 = *(const f32x2*)(kg + 2 * F.lane);
        u32x2 o; o.x = pk2(q0 * rq * g4[0], q1 * rq * g4[1]); o.y = pk2(q2 * rq * g4[2], q3 * rq * g4[3]);
        bf16_t* ar = AM + (size_t)row * 512;
        *(u32x2*)(ar + 4 * F.lane) = o;
        *(unsigned*)(ar + 256 + 2 * F.lane) = pk2(k0 * rk * g2[0], k1 * rk * g2[1]);
        *(unsigned*)(ar + 384 + 2 * F.lane) = 0u;
    }
}

DI void phase_mla_post(const Frame& F, CArgs& A, int l) {
    const bf16_t* Z = (const bf16_t*)(A.ws + WS_Z); const bf16_t* RAW = (const bf16_t*)(A.ws + WS_QKVRAW);
    bf16_t* Q = (bf16_t*)(A.ws + WS_Q); bf16_t* K = (bf16_t*)(A.ws + WS_K); bf16_t* VT = (bf16_t*)(A.ws + WS_VT);
    LAS float* cs = (LAS float*)F.lds;
    LAS bf16_t* vt = (LAS bf16_t*)(F.lds + 8192);
    const float* qhg = A.in[32] + l * 96; const float* khg = A.in[33] + l * 96;
    for (int tile = F.bid; tile < T / 64; tile += F.G) {
        const int t0 = tile * 64, b = t0 / SEQ, s0 = t0 % SEQ;
        int tz = F.tid; asm volatile("" : "+v"(tz));
        for (int idx = tz; idx < 1024; idx += NTHR) { const int tok = idx >> 4, i = idx & 15;
            const int pos = A.pos_off[b] + s0 + tok; const float inv = powf(10000.f, -(float)i * (1.f / 16.f));
            double ang = (double)(float)pos * (double)inv; ang -= 6.283185307179586 * floor(ang * 0.15915494309189535);
            float sn, cn; sincosf((float)ang, &sn, &cn); cs[idx * 2] = cn; cs[idx * 2 + 1] = sn; }
        lds_barrier();
        const int tok = tz >> 3, sub = tz & 7, h = sub >> 1, isk = sub & 1, t = t0 + tok;
        {
            float v[96];
            const bf16_t* p0 = isk ? RAW + (size_t)t * 1024 + 384 + 128 * h : RAW + (size_t)t * 1024 + 96 * h;
            const bf16_t* p1 = isk ? Z + (size_t)t * ZS + ZC_KPE : p0 + 64;
#pragma unroll
            for (int c = 0; c < 8; ++c) { const u32x4 w = *(const u32x4*)(p0 + 8 * c);
                v[8 * c] = bflo(w.x); v[8 * c + 1] = bfhi(w.x); v[8 * c + 2] = bflo(w.y); v[8 * c + 3] = bfhi(w.y); v[8 * c + 4] = bflo(w.z); v[8 * c + 5] = bfhi(w.z); v[8 * c + 6] = bflo(w.w); v[8 * c + 7] = bfhi(w.w); }
#pragma unroll
            for (int c = 0; c < 4; ++c) { const u32x4 w = *(const u32x4*)(p1 + 8 * c);
                v[64 + 8 * c] = bflo(w.x); v[65 + 8 * c] = bfhi(w.x); v[66 + 8 * c] = bflo(w.y); v[67 + 8 * c] = bfhi(w.y); v[68 + 8 * c] = bflo(w.z); v[69 + 8 * c] = bfhi(w.z); v[70 + 8 * c] = bflo(w.w); v[71 + 8 * c] = bfhi(w.w); }
            float ss = 0.f;
#pragma unroll
            for (int i = 0; i < 96; ++i) ss += v[i] * v[i];
            const float r = rsqrtf(ss * (1.f / 96.f) + NORM_EPS) * (isk ? 1.f : 0.10206207261596577f * 1.4426950408889634f);
            const float* hg = isk ? khg : qhg;
#pragma unroll
            for (int i = 0; i < 96; ++i) v[i] = v[i] * r * hg[i];
#pragma unroll
            for (int i = 0; i < 16; ++i) { const float cn = cs[(tok * 16 + i) * 2], sn = cs[(tok * 16 + i) * 2 + 1]; const float x1 = v[64 + i], x2 = v[80 + i];
                v[64 + i] = x1 * cn - x2 * sn; v[80 + i] = x1 * sn + x2 * cn; }
            bf16_t* dst = (isk ? K : Q) + ((size_t)t * 4 + h) * 96;
#pragma unroll
            for (int c = 0; c < 12; ++c) { u32x4 w; w.x = pk2(v[8 * c], v[8 * c + 1]); w.y = pk2(v[8 * c + 2], v[8 * c + 3]); w.z = pk2(v[8 * c + 4], v[8 * c + 5]); w.w = pk2(v[8 * c + 6], v[8 * c + 7]);
                *(u32x4*)(dst + 8 * c) = w; }
        }
        {
            const bf16_t* pv = RAW + (size_t)t * 1024 + 384 + 128 * h + 64 + 32 * isk;
#pragma unroll
            for (int c = 0; c < 4; ++c) { const u32x4 w = *(const u32x4*)(pv + 8 * c); const int r0 = h * 64 + 32 * isk + 8 * c;
                vt[(r0 + 0) * 72 + tok] = (bf16_t)(w.x & 0xffffu); vt[(r0 + 1) * 72 + tok] = (bf16_t)(w.x >> 16);
                vt[(r0 + 2) * 72 + tok] = (bf16_t)(w.y & 0xffffu); vt[(r0 + 3) * 72 + tok] = (bf16_t)(w.y >> 16);
                vt[(r0 + 4) * 72 + tok] = (bf16_t)(w.z & 0xffffu); vt[(r0 + 5) * 72 + tok] = (bf16_t)(w.z >> 16);
                vt[(r0 + 6) * 72 + tok] = (bf16_t)(w.w & 0xffffu); vt[(r0 + 7) * 72 + tok] = (bf16_t)(w.w >> 16); }
        }
        lds_barrier();
        { const int row = tz >> 1, hf = tz & 1;
          bf16_t* dst = VT + ((size_t)(b * 4) * 64 + row) * SEQ + s0 + 32 * hf;
#pragma unroll
          for (int c = 0; c < 4; ++c) *(u32x4*)(dst + 8 * c) = *(const LAS u32x4*)(vt + row * 72 + 32 * hf + 8 * c); }
        lds_barrier();
    }
}

DI void attn_unit(const Frame& F, const bf16_t* Q, const bf16_t* K, const bf16_t* VT, bf16_t* O, int bh, int u, float eoff) {
    constexpr int KP = 208, VP = 144, KB = 64 * KP, VB = 64 * VP;
    LAS unsigned char* Ks = F.lds; LAS unsigned char* Vs = F.lds + 2 * KB;
    int tz = F.tid; asm volatile("" : "+v"(tz));
    const int b = bh >> 2, h = bh & 3, lane = tz & 63, w = F.wave, ql = lane & 31, hh = lane >> 5;
    const int ntile = 8 * u + 8, myl = 8 * u + w;
    const size_t tq0 = (size_t)b * SEQ + 512 * u + 64 * w + ql;
    bf16x8 qf[2][6];
#pragma unroll
    for (int qt = 0; qt < 2; ++qt)
#pragma unroll
        for (int s = 0; s < 6; ++s) qf[qt][s] = *(const bf16x8*)(Q + ((tq0 + 32 * qt) * 4 + h) * 96 + 16 * s + 8 * hh);
    f32x16 ot[2][2];
#pragma unroll
    for (int i = 0; i < 16; ++i) { ot[0][0][i] = 0.f; ot[0][1][i] = 0.f; ot[1][0][i] = 0.f; ot[1][1][i] = 0.f; }
    float lrun[2] = {0.f, 0.f};
    const float neoff = -eoff;
    const int kp0 = tz, kp1 = tz + 512;
    const size_t kbase = ((size_t)b * SEQ * 4 + h) * 96;
    const bf16_t* vsrc = VT + ((size_t)bh * 64 + (tz >> 3)) * SEQ + 8 * (tz & 7);
    u32x4 rk0, rk1, rv;
    rk1 = (u32x4){0u, 0u, 0u, 0u};
#define ATT_LOAD(j) do { rk0 = *(const u32x4*)(K + kbase + (size_t)(64 * (j) + kp0 / 12) * 384 + 8 * (kp0 % 12)); \
        if (kp1 < 768) rk1 = *(const u32x4*)(K + kbase + (size_t)(64 * (j) + kp1 / 12) * 384 + 8 * (kp1 % 12)); \
        rv = *(const u32x4*)(vsrc + 64 * (j)); } while (0)
#define ATT_STORE(jj) do { *(LAS u32x4*)(Ks + ((jj) & 1) * KB + (kp0 / 12) * KP + (kp0 % 12) * 16) = rk0; \
        if (kp1 < 768) *(LAS u32x4*)(Ks + ((jj) & 1) * KB + (kp1 / 12) * KP + (kp1 % 12) * 16) = rk1; \
        { LAS unsigned char* vd_ = Vs + ((jj) % 3) * VB + (tz >> 3) * VP + ((tz & 7) >> 1) * 32 + (tz & 1) * 8; *(LAS u32x2*)vd_ = (u32x2){rv.x, rv.y}; *(LAS u32x2*)(vd_ + 16) = (u32x2){rv.z, rv.w}; } } while (0)
#define ATT_PV(vb, ktp) do { _Pragma("unroll") for (int c = 0; c < 2; ++c) { \
        _Pragma("unroll") for (int dt = 0; dt < 2; ++dt) { const bf16x8 vf = *(const LAS bf16x8*)(Vs + (vb) * VB + (32 * dt + ql) * VP + (32 * (ktp) + 16 * c) * 2 + 16 * hh); \
            ot[dt][0] = __builtin_amdgcn_mfma_f32_32x32x16_bf16(vf, pfo[0][c], ot[dt][0], 0, 0, 0); ot[dt][1] = __builtin_amdgcn_mfma_f32_32x32x16_bf16(vf, pfo[1][c], ot[dt][1], 0, 0, 0); } } } while (0)
#define ATT_SM() do { _Pragma("unroll") for (int qt = 0; qt < 2; ++qt) { f32x2 ps = {0.f, 0.f}; \
        _Pragma("unroll") for (int i = 0; i < 16; i += 2) { const float p0 = __builtin_amdgcn_exp2f(st[qt][i]), p1 = __builtin_amdgcn_exp2f(st[qt][i + 1]); st[qt][i] = p0; st[qt][i + 1] = p1; ps += (f32x2){p0, p1}; } \
        lrun[qt] += ps[0] + ps[1]; \
        _Pragma("unroll") for (int c = 0; c < 2; ++c) { u32x4 pw; pw.x = pk2(st[qt][8 * c], st[qt][8 * c + 1]); pw.y = pk2(st[qt][8 * c + 2], st[qt][8 * c + 3]); pw.z = pk2(st[qt][8 * c + 4], st[qt][8 * c + 5]); pw.w = pk2(st[qt][8 * c + 6], st[qt][8 * c + 7]); \
            pfn[qt][c] = __builtin_bit_cast(bf16x8, pw); } } } while (0)
#define ATT_MIX() do { _Pragma("unroll") for (int g_ = 0; g_ < 4; ++g_) { __builtin_amdgcn_sched_group_barrier(0x100, 2, 0); __builtin_amdgcn_sched_group_barrier(0x008, 1, 0); __builtin_amdgcn_sched_group_barrier(0x002, 14, 0); \
        __builtin_amdgcn_sched_group_barrier(0x008, 1, 0); __builtin_amdgcn_sched_group_barrier(0x002, 14, 0); } } while (0)
    ATT_LOAD(0); ATT_STORE(0);
    lds_barrier();
    bf16x8 pfo[2][2], pfn[2][2];
    bool owed = false;
    for (int j = 0; j < ntile; ++j) {
        if (j + 1 < ntile) ATT_LOAD(j + 1);
        if (j <= myl) {
#pragma unroll
            for (int kt = 0; kt < 2; ++kt) {
                f32x16 st[2];
#pragma unroll
                for (int i = 0; i < 16; ++i) { st[0][i] = neoff; st[1][i] = neoff; }
                __builtin_amdgcn_s_setprio(1);
#pragma unroll
                for (int s = 0; s < 6; ++s) { const bf16x8 kf = *(const LAS bf16x8*)(Ks + (j & 1) * KB + (32 * kt + ql) * KP + (16 * s + 8 * hh) * 2);
                    st[0] = __builtin_amdgcn_mfma_f32_32x32x16_bf16(kf, qf[0][s], st[0], 0, 0, 0);
                    st[1] = __builtin_amdgcn_mfma_f32_32x32x16_bf16(kf, qf[1][s], st[1], 0, 0, 0); }
                __builtin_amdgcn_s_setprio(0);
                __builtin_amdgcn_sched_barrier(0);
                if (kt == 0) { if (owed) { ATT_PV((j + 2) % 3, 1); ATT_SM(); ATT_MIX(); } else { ATT_SM(); } }
                else { ATT_PV(j % 3, 0); ATT_SM(); ATT_MIX(); }
                __builtin_amdgcn_sched_barrier(0);
#pragma unroll
                for (int qt = 0; qt < 2; ++qt) { pfo[qt][0] = pfn[qt][0]; pfo[qt][1] = pfn[qt][1]; }
            }
            owed = true;
        } else if (owed) { ATT_PV(myl % 3, 1); owed = false; }
        if (j + 1 < ntile) ATT_STORE(j + 1);
        lds_barrier();
    }
    if (owed) ATT_PV(myl % 3, 1);
#undef ATT_LOAD
#undef ATT_STORE
#undef ATT_PV
#undef ATT_SM
#undef ATT_MIX
    int lz2 = lane; asm volatile("" : "+v"(lz2));
    const unsigned tqe = (unsigned)(b * SEQ + 512 * u + 64 * w + (lz2 & 31));
#pragma unroll
    for (int qt = 0; qt < 2; ++qt) {
        const float linv = 1.f / (lrun[qt] + shfl_xor_l(lrun[qt], 32, lane));
        bf16_t* orow = O + (size_t)(tqe + 32 * qt) * 256 + h * 64;
#pragma unroll
        for (int dt = 0; dt < 2; ++dt)
#pragma unroll
            for (int g = 0; g < 4; ++g) { u32x2 o; o.x = pk2(ot[dt][qt][4 * g] * linv, ot[dt][qt][4 * g + 1] * linv); o.y = pk2(ot[dt][qt][4 * g + 2] * linv, ot[dt][qt][4 * g + 3] * linv);
                *(u32x2*)(orow + 32 * dt + 8 * g + 4 * hh) = o; }
    }
    lds_barrier();
}
DI void phase_attn(const Frame& F, CArgs& A, int l) {
    const bf16_t* Q = (const bf16_t*)(A.ws + WS_Q); const bf16_t* K = (const bf16_t*)(A.ws + WS_K); const bf16_t* VT = (const bf16_t*)(A.ws + WS_VT);
    bf16_t* O = (bf16_t*)(A.ws + WS_ATTO);
    float gq = 0.f, gk = 0.f;
    for (int i = 0; i < 96; ++i) { gq = fmaxf(gq, fabsf(A.in[32][l * 96 + i])); gk = fmaxf(gk, fabsf(A.in[33][l * 96 + i])); }
    const float eoff = 96.f * gq * gk * 0.10206207261596577f * 1.4426950408889634f * 1.0001f;
    for (int p = F.bid; p < 256; p += F.G) { const int bh = p >> 3, u = p & 7;
        attn_unit(F, Q, K, VT, O, bh, 15 - u, eoff);
        attn_unit(F, Q, K, VT, O, bh, u, eoff); }
}
DI f32x16 mfma32(bf16x8 a, bf16x8 b, f32x16 c) { return __builtin_amdgcn_mfma_f32_32x32x16_bf16(a, b, c, 0, 0, 0); }
DI bf16x8 ldfrag(const LAS unsigned char* base, int row, int ks, int h) { return *(const LAS bf16x8*)(base + row * 144 + (16 * ks + 8 * h) * 2); }
DI f32x16 zero16() { f32x16 z;
#pragma unroll
    for (int i = 0; i < 16; ++i) z[i] = 0.f;
    return z; }
DI bf16x8 pack8(const f32x16& x, int o) { u32x4 p; p.x = pk2(x[o], x[o + 1]); p.y = pk2(x[o + 2], x[o + 3]); p.z = pk2(x[o + 4], x[o + 5]); p.w = pk2(x[o + 6], x[o + 7]); return __builtin_bit_cast(bf16x8, p); }
DI f32x16 tileprod(const LAS unsigned char* Aimg, int a0, const LAS unsigned char* Bimg, int b0, f32x16 acc, int lr, int h2) {
#pragma unroll
    for (int ks = 0; ks < 4; ++ks) acc = mfma32(ldfrag(Aimg, a0 + lr, ks, h2), ldfrag(Bimg, b0 + lr, ks, h2), acc);
    return acc;
}
DI void put_tile(LAS unsigned char* img, int c0, int r0, const f32x16& a, int lr, int h2) {
#pragma unroll
    for (int g = 0; g < 4; ++g) { u32x2 o; o.x = pk2(a[4 * g], a[4 * g + 1]); o.y = pk2(a[4 * g + 2], a[4 * g + 3]); *(LAS u32x2*)(img + (c0 + lr) * 144 + (r0 + 8 * g + 4 * h2) * 2) = o; }
}
DI void phase_rwkv_A(const Frame& F, CArgs& A, int l) {
    const bf16_t* Z = (const bf16_t*)(A.ws + WS_Z); bf16_t* V_ = (bf16_t*)(A.ws + WS_RW_V); bf16_t* G_ = (bf16_t*)(A.ws + WS_RW_G);
    const float* mu = A.in[7] + l * 896; const float* w0 = A.in[8] + l * 256; const float* a0 = A.in[10] + l * 256; const float* k_k = A.in[13] + l * 256; const float* k_a = A.in[14] + l * 256;
    const bf16_t* WO = (const bf16_t*)(A.ws + WS_WLORA) + (size_t)l * 32768;
    bf16_t* RP = (bf16_t*)(A.ws + WS_RC_RP); float* Y0T = (float*)(A.ws + WS_RC_Y0); unsigned char* REC = A.ws + WS_RC_G;
    float* BSUM = (float*)(A.ws + WS_RC_BS);
    const float* r_k = A.in[15] + l * 256;
    constexpr int TB = 64 * 144;
#define TILE(i) (F.lds + (i) * TB)
    LAS float* XF = (LAS float*)TILE(13);
    const int w = F.wave;
    for (int ub = F.bid; ub < 1024; ub += F.G) {
      const int b = ub >> 7, c = ub & 127;
      const size_t t0 = (size_t)b * SEQ + 64 * c;
      bf16x8 xf[4];
      {
        int tid = F.tid; asm volatile("" : "+v"(tid)); const int lane = tid & 63, fr = lane & 15, fq = lane >> 4, mt = w & 3;
        const int tk = 16 * mt + fr; const size_t t = t0 + tk; const bool hp = (64 * c + tk) > 0;
        const bf16_t* zr = Z + t * ZS + ZC_WLO + 8 * fq;
#pragma unroll
        for (int ks = 0; ks < 4; ++ks) {
            const u32x4 zc = *(const u32x4*)(zr + 32 * ks); u32x4 zp = {0u, 0u, 0u, 0u}; if (hp) zp = *(const u32x4*)(zr + 32 * ks - ZS);
            const f32x4 m0 = *(const f32x4*)(mu + ZC_WLO + 32 * ks + 8 * fq), m1 = *(const f32x4*)(mu + ZC_WLO + 32 * ks + 8 * fq + 4);
            const unsigned cw[4] = {zc.x, zc.y, zc.z, zc.w}, pw[4] = {zp.x, zp.y, zp.z, zp.w}; const float mm[8] = {m0[0], m0[1], m0[2], m0[3], m1[0], m1[1], m1[2], m1[3]};
            float v[8];
#pragma unroll
            for (int i = 0; i < 8; ++i) { const float zcv = (i & 1) ? bfhi(cw[i >> 1]) : bflo(cw[i >> 1]), zpv = (i & 1) ? bfhi(pw[i >> 1]) : bflo(pw[i >> 1]);
                float x = zcv + (zpv - zcv) * mm[i]; if (ks == 0) x = fast_tanh(x); else if (ks >= 2) x = sigmoidf_(x); v[i] = x; }
            u32x4 o; o.x = pk2(v[0], v[1]); o.y = pk2(v[2], v[3]); o.z = pk2(v[4], v[5]); o.w = pk2(v[6], v[7]); xf[ks] = __builtin_bit_cast(bf16x8, o);
        }
      }
      for (int hd = 0; hd < 4; ++hd) {
        const int u = (b * 4 + hd) * 128 + c;
        {
        int tid = F.tid; asm volatile("" : "+v"(tid)); const int lane = tid & 63, fr = lane & 15, fq = lane >> 4, mt = w & 3, nh = w >> 2;
        const int tk = 16 * mt + fr; const size_t t = t0 + tk; const bool hp = (64 * c + tk) > 0;
        LAS float* hs = (LAS float*)TILE(12);
        f32x4 aw[2], aa[2], ag[2];
        {
#pragma unroll
            for (int nf = 0; nf < 2; ++nf) { const int ch = hd * 64 + 32 * nh + 8 * (fr >> 2) + 4 * nf + (fr & 3);     const f32x4 z4 = {0.f, 0.f, 0.f, 0.f};
                aw[nf] = __builtin_amdgcn_mfma_f32_16x16x32_bf16(*(const bf16x8*)(WO + ch * 32 + 8 * fq), xf[0], z4, 0, 0, 0);
                aa[nf] = __builtin_amdgcn_mfma_f32_16x16x32_bf16(*(const bf16x8*)(WO + 8192 + ch * 32 + 8 * fq), xf[1], z4, 0, 0, 0);
                ag[nf] = __builtin_amdgcn_mfma_f32_16x16x32_bf16(*(const bf16x8*)(WO + 16384 + ch * 64 + 8 * fq), xf[2], z4, 0, 0, 0);
                ag[nf] = __builtin_amdgcn_mfma_f32_16x16x32_bf16(*(const bf16x8*)(WO + 16384 + ch * 64 + 32 + 8 * fq), xf[3], ag[nf], 0, 0, 0); }
        }
        f32x4 rr[2], kq[2], km[2], vv4[2], lw4[2], a4[2];
        float ssq = 0.f, bsp = 0.f;
#pragma unroll
        for (int nf = 0; nf < 2; ++nf) { const int d4 = 32 * nh + 8 * fq + 4 * nf, ch4 = hd * 64 + d4;
            const u32x2 rc = *(const u32x2*)(Z + t * ZS + ZC_R + ch4), kc = *(const u32x2*)(Z + t * ZS + ZC_K + ch4), vc = *(const u32x2*)(Z + t * ZS + ZC_V + ch4);
            u32x2 rp = {0u, 0u}, kp = {0u, 0u}, vp = {0u, 0u};
            if (hp) { rp = *(const u32x2*)(Z + (t - 1) * ZS + ZC_R + ch4); kp = *(const u32x2*)(Z + (t - 1) * ZS + ZC_K + ch4); vp = *(const u32x2*)(Z + (t - 1) * ZS + ZC_V + ch4); }
            const f32x4 mr = *(const f32x4*)(mu + ZC_R + ch4), mk = *(const f32x4*)(mu + ZC_K + ch4), mv = *(const f32x4*)(mu + ZC_V + ch4), ka = *(const f32x4*)(k_a + ch4), kkw = *(const f32x4*)(k_k + ch4), rk4 = *(const f32x4*)(r_k + ch4);
            const f32x4 rcv = {bflo(rc.x), bfhi(rc.x), bflo(rc.y), bfhi(rc.y)}, rpv = {bflo(rp.x), bfhi(rp.x), bflo(rp.y), bfhi(rp.y)};
            const f32x4 kcv = {bflo(kc.x), bfhi(kc.x), bflo(kc.y), bfhi(kc.y)}, kpv = {bflo(kp.x), bfhi(kp.x), bflo(kp.y), bfhi(kp.y)};
            const f32x4 vcv = {bflo(vc.x), bfhi(vc.x), bflo(vc.y), bfhi(vc.y)}, vpv = {bflo(vp.x), bfhi(vp.x), bflo(vp.y), bfhi(vp.y)};
            const f32x4 r = rcv + (rpv - rcv) * mr, k = kcv + (kpv - kcv) * mk, v = vcv + (vpv - vcv) * mv;
            const f32x4 wv = aw[nf] + *(const f32x4*)(w0 + ch4), av = aa[nf] + *(const f32x4*)(a0 + ch4);
#pragma unroll
            for (int i = 0; i < 4; ++i) { lw4[nf][i] = -__expf(-fast_softplus(-wv[i]) - 0.5f); a4[nf][i] = sigmoidf_(av[i]); kq[nf][i] = k[i] * kkw[i]; km[nf][i] = k[i] * (1.f + (a4[nf][i] - 1.f) * ka[i]);
                ssq += kq[nf][i] * kq[nf][i]; bsp += r[i] * km[nf][i] * rk4[i]; }
            rr[nf] = r; vv4[nf] = v;
            *(LAS f32x4*)(XF + tk * 64 + d4) = lw4[nf];
            u32x2 p; p.x = pk2(ag[nf][0], ag[nf][1]); p.y = pk2(ag[nf][2], ag[nf][3]); *(u32x2*)(G_ + t * 256 + ch4) = p;
            p.x = pk2(v[0], v[1]); p.y = pk2(v[2], v[3]); *(u32x2*)(V_ + t * 256 + ch4) = p;
        }
        ssq += shfl_xor_l(ssq, 16, lane); ssq += shfl_xor_l(ssq, 32, lane); bsp += shfl_xor_l(bsp, 16, lane); bsp += shfl_xor_l(bsp, 32, lane);
        if (fq == 0) { hs[nh * 64 + tk] = ssq; hs[128 + nh * 64 + tk] = bsp; }
        lds_barrier();
        if (w == 0) { float cv[64];
#pragma unroll
            for (int i = 0; i < 64; ++i) cv[i] = XF[i * 64 + lane];
            float run = 0.f;
#pragma unroll
            for (int i = 0; i < 64; ++i) { run += cv[i]; XF[i * 64 + lane] = run; } }
        if (w == 1) BSUM[(t0 + lane) * 4 + hd] = hs[128 + lane] + hs[192 + lane];
        lds_barrier();
        const float rn = rsqrtf(fmaxf(hs[tk] + hs[64 + tk], 1e-24f));
#pragma unroll
        for (int nf = 0; nf < 2; ++nf) { const int d4 = 32 * nh + 8 * fq + 4 * nf;
            const f32x4 cum = *(const LAS f32x4*)(XF + tk * 64 + d4), c63 = *(const LAS f32x4*)(XF + 63 * 64 + d4);
            f32x4 al, bt, kt, rb, bhh, khh;
#pragma unroll
            for (int i = 0; i < 4; ++i) { const float kk = kq[nf][i] * rn; const float ec = __expf(cum[i]), em = __builtin_amdgcn_rcpf(ec), ep = __expf(cum[i] - lw4[nf][i]), p63 = __expf(c63[i]);
                al[i] = -kk * ep; bt[i] = kk * a4[nf][i] * em; kt[i] = km[nf][i] * em; rb[i] = rr[nf][i] * ec; bhh[i] = bt[i] * p63; khh[i] = kt[i] * p63;
                if (tk == 63) *(float*)(REC + (size_t)u * RC_REC + 24576 + (d4 + i) * 4) = p63; }
            u32x2 o;
            o.x = pk2(al[0], al[1]); o.y = pk2(al[2], al[3]); *(LAS u32x2*)(TILE(0) + tk * 144 + d4 * 2) = o;
            o.x = pk2(bt[0], bt[1]); o.y = pk2(bt[2], bt[3]); *(LAS u32x2*)(TILE(1) + tk * 144 + d4 * 2) = o;
            o.x = pk2(kt[0], kt[1]); o.y = pk2(kt[2], kt[3]); *(LAS u32x2*)(TILE(2) + tk * 144 + d4 * 2) = o;
            o.x = pk2(rb[0], rb[1]); o.y = pk2(rb[2], rb[3]); *(LAS u32x2*)(TILE(3) + tk * 144 + d4 * 2) = o;
#pragma unroll
            for (int i = 0; i < 4; ++i) { *(LAS bf16_t*)(TILE(4) + (d4 + i) * 144 + tk * 2) = (bf16_t)f2bf(vv4[nf][i]); *(LAS bf16_t*)(TILE(5) + (d4 + i) * 144 + tk * 2) = (bf16_t)f2bf(bhh[i]);
                *(LAS bf16_t*)(TILE(6) + (d4 + i) * 144 + tk * 2) = (bf16_t)f2bf(khh[i]); *(LAS bf16_t*)(TILE(7) + (d4 + i) * 144 + tk * 2) = (bf16_t)f2bf(al[i]); }
        }
        }
        lds_barrier();
        f32x16 Tacc = zero16();
        {
        int tl = F.tid; asm volatile("" : "+v"(tl)); const int lane = tl & 63, lr = lane & 31, h2 = lane >> 5;
        unsigned zz = 0u; asm volatile("" : "+v"(zz));
        for (int i = tl; i < 768; i += NTHR) { const int q = i >> 7, rr = (i & 127) >> 2, cc = i & 3; const int tile = q < 4 ? 8 + q : q == 4 ? 14 : 12;
            *(LAS u32x4*)(TILE(tile) + (q == 5 ? (32 + rr) * 144 : rr * 144 + 64) + cc * 16) = (u32x4){zz, zz, zz, zz}; }
#pragma unroll
        for (int rnd = 0; rnd < 2; ++rnd) {
            const int j = w + 8 * rnd;
            if (j < 15) {
                const int prod = j / 3, tile = j % 3, si = tile == 2 ? 1 : 0, ti = tile == 0 ? 0 : 1;
                if (prod == 1) {
                    f32x16 acc = tileprod(TILE(0), 32 * ti, TILE(1), 32 * si, zero16(), lr, h2);
                    const int ss = 32 * si + lr;
#pragma unroll
                    for (int q = 0; q < 16; ++q) { const int tt = 32 * ti + 8 * (q >> 2) + 4 * h2 + (q & 3); if (!(ss < tt)) acc[q] = 0.f; }
                    put_tile(TILE(12), 32 * si, 32 * ti, acc, lr, h2);
                } else {
                    const LAS unsigned char* Ao = (prod == 0 || prod == 3) ? TILE(1) : TILE(2); const LAS unsigned char* Bo = prod >= 3 ? TILE(3) : TILE(0);
                    f32x16 acc = tileprod(Ao, 32 * si, Bo, 32 * ti, zero16(), lr, h2);
                    const int tt = 32 * ti + lr, incl = prod >= 3 ? 1 : 0;
#pragma unroll
                    for (int q = 0; q < 16; ++q) { const int ss = 32 * si + 8 * (q >> 2) + 4 * h2 + (q & 3); if (!(ss < tt + incl)) acc[q] = 0.f; }
                    if (prod == 0) { put_tile(TILE(11), 32 * ti, 32 * si, acc, lr, h2);
#pragma unroll
                        for (int q = 0; q < 16; ++q) { const int ss = 32 * si + 8 * (q >> 2) + 4 * h2 + (q & 3); Tacc[q] = acc[q] + (ss == tt ? 1.f : 0.f); }
                        put_tile(TILE(14), 32 * ti, 32 * si, Tacc, lr, h2);
                    } else put_tile(TILE(prod == 2 ? 8 : prod == 3 ? 9 : 10), 32 * ti, 32 * si, acc, lr, h2);
                }
            }
        }
        }
        lds_barrier();
        {
        int tl = F.tid; asm volatile("" : "+v"(tl)); const int lane = tl & 63, lr = lane & 31, h2 = lane >> 5;
        if (tl < 384) { const int q = tl >> 7, rr = (tl & 127) >> 2, cc = tl & 3;
            unsigned zz = 0u; asm volatile("" : "+v"(zz));
            *(LAS u32x4*)(TILE(q) + (q == 1 ? (32 + rr) * 144 : rr * 144 + 64) + cc * 16) = (u32x4){zz, zz, zz, zz}; }
        lds_barrier();
#pragma unroll
        for (int k = 1; k <= 5; ++k) {
            LAS unsigned char* Ss = (k & 1) ? TILE(11) : TILE(0); LAS unsigned char* STs = (k & 1) ? TILE(12) : TILE(1);
            LAS unsigned char* Sd = (k & 1) ? TILE(0) : TILE(11); LAS unsigned char* STd = (k & 1) ? TILE(1) : TILE(12);
            LAS unsigned char* Ts = (k & 1) ? TILE(14) : TILE(2); LAS unsigned char* Td = (k & 1) ? TILE(2) : TILE(14);
            if (w < 6) { const int tile = w % 3, ti = tile == 0 ? 0 : 1, si = tile == 2 ? 1 : 0;
                if (w < 3) { f32x16 acc = tileprod(Ss, 32 * ti, STs, 32 * si, zero16(), lr, h2); put_tile(STd, 32 * si, 32 * ti, acc, lr, h2); }
                else { f32x16 acc = tileprod(STs, 32 * si, Ss, 32 * ti, zero16(), lr, h2); put_tile(Sd, 32 * ti, 32 * si, acc, lr, h2); }
            } else if (k == 1) {
#pragma unroll
                for (int jj = 0; jj < 2; ++jj) { const int tile = (w - 6) * 2 + jj, ti = tile >> 1, ei = tile & 1;
                    f32x16 acc = tileprod(TILE(8), 32 * ti, TILE(4), 32 * ei, zero16(), lr, h2); put_tile(TILE(13), 32 * ei, 32 * ti, acc, lr, h2); }
            }
            lds_barrier();
            if (w < 3) { const int si = w == 2 ? 1 : 0, ti = w == 0 ? 0 : 1;
                Tacc = tileprod(STd, 32 * si, Ts, 32 * ti, Tacc, lr, h2); put_tile(Td, 32 * ti, 32 * si, Tacc, lr, h2); }
        }
        lds_barrier();
        { const int tile = w & 3, ti = tile >> 1, ci = tile & 1;
          f32x16 acc = tileprod(TILE(2), 32 * ti, w < 4 ? TILE(13) : TILE(7), 32 * ci, zero16(), lr, h2); put_tile(w < 4 ? TILE(11) : TILE(12), 32 * ci, 32 * ti, acc, lr, h2); }
        }
        lds_barrier();
        {
        int tl = F.tid; asm volatile("" : "+v"(tl)); const int lane = tl & 63, lr = lane & 31, h2 = lane >> 5; const int tj = w & 3, ta = tj >> 1, tb = tj & 1;
        if (w < 4) {
            { f32x16 acc = tileprod(TILE(12), 32 * ta, TILE(9), 32 * tb, zero16(), lr, h2);
              const int tt = 32 * tb + lr;
#pragma unroll
              for (int g = 0; g < 4; ++g) { const int dd = 32 * ta + 8 * g + 4 * h2; const u32x2 rbv = *(const LAS u32x2*)(TILE(3) + tt * 144 + dd * 2);
                  u32x2 o; o.x = pk2(acc[4 * g] + bflo(rbv.x), acc[4 * g + 1] + bfhi(rbv.x)); o.y = pk2(acc[4 * g + 2] + bflo(rbv.y), acc[4 * g + 3] + bfhi(rbv.y));
                  *(u32x2*)(RP + ((size_t)u * 64 + tt) * 64 + dd) = o; } }
            { f32x16 acc = tileprod(TILE(12), 32 * ta, TILE(5), 32 * tb, zero16(), lr, h2);
              const int dcol = 32 * tb + lr;
#pragma unroll
              for (int g = 0; g < 4; ++g) { u32x2 o; o.x = pk2(acc[4 * g], acc[4 * g + 1]); o.y = pk2(acc[4 * g + 2], acc[4 * g + 3]);
                  *(u32x2*)(REC + (size_t)u * RC_REC + ((((dcol >> 4) * 2 + ta) * 64 + (2 * (g & 1) + h2) * 16 + (dcol & 15)) * 16) + 8 * (g >> 1)) = o; } }
        } else {
            f32x16 z2 = tileprod(TILE(4), 32 * ta, TILE(10), 32 * tb, zero16(), lr, h2);
            z2 = tileprod(TILE(11), 32 * ta, TILE(9), 32 * tb, z2, lr, h2);
            float* yo = Y0T + ((size_t)u * 64 + 32 * tb + lr) * 64 + 32 * ta + 4 * h2;
#pragma unroll
            for (int g = 0; g < 4; ++g) *(f32x4*)(yo + 8 * g) = (f32x4){z2[4 * g], z2[4 * g + 1], z2[4 * g + 2], z2[4 * g + 3]};
            f32x16 acc = tileprod(TILE(5), 32 * ta, TILE(11), 32 * tb, zero16(), lr, h2);
            acc = tileprod(TILE(6), 32 * ta, TILE(4), 32 * tb, acc, lr, h2);
            const int ecol = 32 * tb + lr;
#pragma unroll
            for (int g = 0; g < 4; ++g) *(f32x4*)(REC + (size_t)u * RC_REC + 8192 + ((((ecol >> 4) * 4 + 2 * ta + (g >> 1)) * 64 + (2 * (g & 1) + h2) * 16 + (ecol & 15)) * 16)) = (f32x4){acc[4 * g], acc[4 * g + 1], acc[4 * g + 2], acc[4 * g + 3]};
        }
        }
        lds_barrier();
      }
    }
#undef TILE
}
DI void phase_rwkv_B(const Frame& F, CArgs& A) {
    if (F.bid >= 32) return;
    const unsigned char* REC = A.ws + WS_RC_G; bf16_t* HB = (bf16_t*)(A.ws + WS_RC_HB);
    constexpr int SLOT = 25600, NSLOT = 6;
    const int bh = F.bid, w = F.wave, lane = F.lane, fr = lane & 15, fq = lane >> 4;
    const unsigned char* rec0 = REC + (size_t)bh * 128 * RC_REC;
    if (w >= 4) {
        const int lw = w - 4;
#define RB_ISSUE2(cs, cr) do { const unsigned char* r_ = rec0 + (size_t)(cr) * RC_REC; LAS unsigned char* s_ = F.lds + ((cs) % NSLOT) * SLOT; \
        _Pragma("unroll") for (int k = 0; k < 6; ++k) __builtin_amdgcn_global_load_lds((const unsigned*)(r_ + (lw + 4 * k) * 1024 + lane * 16), (LAS unsigned*)(s_ + (lw + 4 * k) * 1024), 16, 0, 0); \
        if (lw == 3) __builtin_amdgcn_global_load_lds((const unsigned*)(r_ + 24576 + lane * 4), (LAS unsigned*)(s_ + 24576), 4, 0, 0); } while (0)
        RB_ISSUE2(0, 0); RB_ISSUE2(1, 1); RB_ISSUE2(2, 2); RB_ISSUE2(3, 3); RB_ISSUE2(4, 4);
        if (lw == 3) asm volatile("s_waitcnt vmcnt(28)" ::: "memory"); else asm volatile("s_waitcnt vmcnt(24)" ::: "memory");
        __builtin_amdgcn_s_barrier();
        for (int c = 0; c < 128; ++c) {
            RB_ISSUE2(c + 5, (c + 5 < 128) ? c + 5 : 127);
            if (lw == 3) asm volatile("s_waitcnt vmcnt(28)" ::: "memory"); else asm volatile("s_waitcnt vmcnt(24)" ::: "memory");
            __builtin_amdgcn_s_barrier();
        }
        asm volatile("s_waitcnt vmcnt(0)" ::: "memory");
#undef RB_ISSUE2
    } else {
        const int ew = w;
        f32x4 acc[4];
#pragma unroll
        for (int dt = 0; dt < 4; ++dt) acc[dt] = (f32x4){0.f, 0.f, 0.f, 0.f};
        __builtin_amdgcn_s_barrier();
        for (int c = 0; c < 128; ++c) {
            const size_t u = (size_t)bh * 128 + c;
            const LAS unsigned char* sl = F.lds + (c % NSLOT) * SLOT;
            bf16x8 hb[2];
#pragma unroll
            for (int sk = 0; sk < 2; ++sk) { u32x4 p; p.x = pk2(acc[2 * sk][0], acc[2 * sk][1]); p.y = pk2(acc[2 * sk][2], acc[2 * sk][3]); p.z = pk2(acc[2 * sk + 1][0], acc[2 * sk + 1][1]); p.w = pk2(acc[2 * sk + 1][2], acc[2 * sk + 1][3]);
                hb[sk] = __builtin_bit_cast(bf16x8, p); *(bf16x8*)(HB + (((u * 4 + ew) * 2 + sk) * 64 + lane) * 8) = hb[sk]; }
#pragma unroll
            for (int dt = 0; dt < 4; ++dt) {
                const f32x4 g4 = *(const LAS f32x4*)(sl + 8192 + ((ew * 4 + dt) * 64 + lane) * 16), d4 = *(const LAS f32x4*)(sl + 24576 + (16 * dt + 4 * fq) * 4);
                const bf16x8 m0 = *(const LAS bf16x8*)(sl + ((dt * 2 + 0) * 64 + lane) * 16), m1 = *(const LAS bf16x8*)(sl + ((dt * 2 + 1) * 64 + lane) * 16);
                f32x4 n = d4 * acc[dt] + g4;
                n = __builtin_amdgcn_mfma_f32_16x16x32_bf16(m0, hb[0], n, 0, 0, 0); n = __builtin_amdgcn_mfma_f32_16x16x32_bf16(m1, hb[1], n, 0, 0, 0); acc[dt] = n; }
            asm volatile("s_waitcnt lgkmcnt(0)" ::: "memory");
            __builtin_amdgcn_s_barrier();
        }
    }
}
DI void phase_rwkv_C(const Frame& F, CArgs& A, int l) {
    const bf16_t* RP = (const bf16_t*)(A.ws + WS_RC_RP); const float* Y0 = (const float*)(A.ws + WS_RC_Y0); const bf16_t* HB = (const bf16_t*)(A.ws + WS_RC_HB); const float* BSUM = (const float*)(A.ws + WS_RC_BS);
    const bf16_t* V_ = (const bf16_t*)(A.ws + WS_RW_V); const bf16_t* G_ = (const bf16_t*)(A.ws + WS_RW_G); bf16_t* MIX = (bf16_t*)(A.ws + WS_MIX);
    const float* ln_w = A.in[16] + l * 256; const float* ln_b = A.in[17] + l * 256;
    for (int job = F.gw; job < 4096; job += F.ngw) {
        int lz = F.lane; asm volatile("" : "+v"(lz)); const int lane = lz, fr = lane & 15, fq = lane >> 4;
        const size_t u = (size_t)job; const int bh = job >> 7, c = job & 127, b = bh >> 2, hd = bh & 3;
        bf16x8 hf[4][2];
#pragma unroll
        for (int et = 0; et < 4; ++et)
#pragma unroll
            for (int sk = 0; sk < 2; ++sk) hf[et][sk] = *(const bf16x8*)(HB + (((u * 4 + et) * 2 + sk) * 64 + lane) * 8);
#pragma unroll
        for (int tb = 0; tb < 4; ++tb) {
            const size_t tok = (size_t)b * SEQ + 64 * c + 16 * tb + fr;
            const bf16_t* rrow = RP + (u * 64 + 16 * tb + fr) * 64 + 4 * fq;
            bf16x8 bfr[2];
#pragma unroll
            for (int sk = 0; sk < 2; ++sk) { const u32x2 m0 = *(const u32x2*)(rrow + 32 * sk), m1 = *(const u32x2*)(rrow + 32 * sk + 16); u32x4 mw; mw.x = m0.x; mw.y = m0.y; mw.z = m1.x; mw.w = m1.y; bfr[sk] = __builtin_bit_cast(bf16x8, mw); }
            f32x4 y[4]; float sm = 0.f;
#pragma unroll
            for (int et = 0; et < 4; ++et) { y[et] = *(const f32x4*)(Y0 + (u * 64 + 16 * tb + fr) * 64 + 16 * et + 4 * fq);
                y[et] = __builtin_amdgcn_mfma_f32_16x16x32_bf16(hf[et][0], bfr[0], y[et], 0, 0, 0); y[et] = __builtin_amdgcn_mfma_f32_16x16x32_bf16(hf[et][1], bfr[1], y[et], 0, 0, 0); }
#pragma unroll
            for (int et = 0; et < 4; ++et) sm += (y[et][0] + y[et][1]) + (y[et][2] + y[et][3]);
            sm += shfl_xor_l(sm, 16, lane); sm += shfl_xor_l(sm, 32, lane); const float mean = sm * (1.f / 64.f);
            float sq = 0.f;
#pragma unroll
            for (int et = 0; et < 4; ++et) { const f32x4 d = y[et] - mean; sq += (d[0] * d[0] + d[1] * d[1]) + (d[2] * d[2] + d[3] * d[3]); }
            sq += shfl_xor_l(sq, 16, lane); sq += shfl_xor_l(sq, 32, lane); const float rstd = rsqrtf(sq * (1.f / 64.f) + 64e-5f);
            const float bs = BSUM[tok * 4 + hd];
#pragma unroll
            for (int et = 0; et < 4; ++et) { const int e0 = hd * 64 + 16 * et + 4 * fq;
                const f32x4 lw = *(const f32x4*)(ln_w + e0), lb = *(const f32x4*)(ln_b + e0);
                const u32x2 vv = *(const u32x2*)(V_ + tok * 256 + e0), gv = *(const u32x2*)(G_ + tok * 256 + e0);
                const float o0 = ((y[et][0] - mean) * rstd * lw[0] + lb[0] + bs * bflo(vv.x)) * bflo(gv.x), o1 = ((y[et][1] - mean) * rstd * lw[1] + lb[1] + bs * bfhi(vv.x)) * bfhi(gv.x);
                const float o2 = ((y[et][2] - mean) * rstd * lw[2] + lb[2] + bs * bflo(vv.y)) * bflo(gv.y), o3 = ((y[et][3] - mean) * rstd * lw[3] + lb[3] + bs * bfhi(vv.y)) * bfhi(gv.y);
                u32x2 o; o.x = pk2(o0, o1); o.y = pk2(o2, o3);
                *(u32x2*)(MIX + tok * DM + e0) = o; }
        }
    }
}

template <int PASS>
DI void phase_s5(const Frame& F, CArgs& A, int l) {
    const bf16_t* Z = (const bf16_t*)(A.ws + WS_Z); float* SEND = (float*)(A.ws + WS_S5END); bf16_t* YS = (bf16_t*)(A.ws + WS_YS5);
    const bf16_t* BBt = (const bf16_t*)(A.ws + WS_S5BB); const bf16_t* CCt = (const bf16_t*)(A.ws + WS_S5CC);
    LAS unsigned char* himg = F.lds + F.wave * 17408;
    for (int it = F.gw; it < 8 * 16 * 16; it += F.ngw) {
        int lz = F.lane; asm volatile("" : "+v"(lz)); const int lane = lz, lr = lane & 31, hh = lane >> 5;
        const int b = it >> 8, g = (it >> 4) & 15, seg = it & 15, lg = l * 16 + g;
        const float dt = __expf(A.in[25][lg]);
        float are[2], aim[2], cr[2], ci[2];
        bf16x8 bbf[2][2];
#pragma unroll
        for (int st = 0; st < 2; ++st) { const int p = 32 * st + lr;
            const float lre = A.in[18][lg * 64 + p], lim = A.in[19][lg * 64 + p]; const float mag = expf(lre * dt); float sn, cn; sincosf(lim * dt, &sn, &cn); are[st] = mag * cn; aim[st] = mag * sn;
            cr[st] = 0.f; ci[st] = 0.f;
            if (PASS == 2) { const float m512 = expf(512.f * lre * dt); float s5, c5; sincosf(512.f * (lim * dt), &s5, &c5); const float pr = m512 * c5, pi_ = m512 * s5;
                for (int j = 0; j < seg; ++j) { const float* e = SEND + ((size_t)((b * 16 + g) * 16 + j)) * 128; const float er = e[p], ei = e[64 + p];
                    const float nr = pr * cr[st] - pi_ * ci[st] + er, ni = pr * ci[st] + pi_ * cr[st] + ei; cr[st] = nr; ci[st] = ni; } }
#pragma unroll
            for (int part = 0; part < 2; ++part) bbf[part][st] = *(const bf16x8*)(BBt + (((size_t)lg * 2 + part) * 64 + p) * 16 + 8 * hh); }
        bf16x8 ccf[4];
        if (PASS == 2) {
#pragma unroll
            for (int ks = 0; ks < 4; ++ks) ccf[ks] = *(const bf16x8*)(CCt + ((size_t)lg * 16 + (lane & 15)) * 128 + 32 * ks + 8 * (lane >> 4)); }
        for (int ch = 0; ch < 8; ++ch) {
            const size_t tok0 = (size_t)b * SEQ + seg * 512 + ch * 64;
#pragma unroll
            for (int tk = 0; tk < 2; ++tk) {
                const bf16x8 uf = *(const bf16x8*)(Z + (tok0 + 32 * tk + lr) * ZS + ZC_S5 + g * 16 + 8 * hh);
                f32x16 xr[2], xi[2];
#pragma unroll
                for (int st = 0; st < 2; ++st) { xr[st] = mfma32(uf, bbf[0][st], zero16()); xi[st] = mfma32(uf, bbf[1][st], zero16()); }
                asm volatile("s_nop 15\n\ts_nop 15" : "+v"(xr[0]), "+v"(xi[0]), "+v"(xr[1]), "+v"(xi[1]));
#pragma unroll
                for (int j = 0; j < 4; ++j) {
#pragma unroll
                    for (int half = 0; half < 2; ++half) {
                        const bool act = (hh == half);
#pragma unroll
                        for (int st = 0; st < 2; ++st) { float tr = cr[st], ti = ci[st];
#pragma unroll
                            for (int q = 0; q < 4; ++q) { const float nr = are[st] * tr - aim[st] * ti + xr[st][4 * j + q], ni = are[st] * ti + aim[st] * tr + xi[st][4 * j + q];
                                tr = nr; ti = ni; xr[st][4 * j + q] = act ? nr : xr[st][4 * j + q]; xi[st][4 * j + q] = act ? ni : xi[st][4 * j + q]; }
                            const float pr = shfl_xor_l(tr, 32, lane), pi2 = shfl_xor_l(ti, 32, lane);
                            cr[st] = act ? tr : pr; ci[st] = act ? ti : pi2; }
                    }
                }
                if (PASS == 2) {
                    unsigned hb = (unsigned)(uintptr_t)(himg + (4 * hh) * 272 + lr * 2); asm volatile("" : "+v"(hb));
                    LAS unsigned char* hp = (LAS unsigned char*)(uintptr_t)hb;
#pragma unroll
                    for (int st = 0; st < 2; ++st)
#pragma unroll
                        for (int q = 0; q < 16; ++q) { const int trow = 32 * tk + 8 * (q >> 2) + (q & 3);
                            *(LAS bf16_t*)(hp + trow * 272 + 64 * st) = (bf16_t)f2bf(xr[st][q]); *(LAS bf16_t*)(hp + trow * 272 + 128 + 64 * st) = (bf16_t)f2bf(xi[st][q]); }
                }
            }
            if (PASS == 2) {
                asm volatile("s_waitcnt lgkmcnt(0)" ::: "memory");
                const int fr = lane & 15, fq = lane >> 4;
                unsigned rb = (unsigned)(uintptr_t)(himg + fr * 272 + fq * 16); asm volatile("" : "+v"(rb)); const LAS unsigned char* rp = (const LAS unsigned char*)(uintptr_t)rb;
#pragma unroll
                for (int m = 0; m < 4; ++m) { f32x4 acc = {0.f, 0.f, 0.f, 0.f};
#pragma unroll
                    for (int ks = 0; ks < 4; ++ks) acc = __builtin_amdgcn_mfma_f32_16x16x32_bf16(ccf[ks], *(const LAS bf16x8*)(rp + (16 * m) * 272 + 64 * ks), acc, 0, 0, 0);
                    const size_t tok = tok0 + 16 * m + fr;
                    const u32x2 uu = *(const u32x2*)(Z + tok * ZS + ZC_S5 + g * 16 + 4 * fq);
                    const f32x4 dd = *(const f32x4*)(A.in[24] + l * 256 + g * 16 + 4 * fq);
                    u32x2 o; o.x = pk2(gelu_tanh(acc[0] + dd[0] * bflo(uu.x)), gelu_tanh(acc[1] + dd[1] * bfhi(uu.x))); o.y = pk2(gelu_tanh(acc[2] + dd[2] * bflo(uu.y)), gelu_tanh(acc[3] + dd[3] * bfhi(uu.y)));
                    *(u32x2*)(YS + tok * 256 + g * 16 + 4 * fq) = o; }
                asm volatile("s_waitcnt lgkmcnt(0)" ::: "memory");
            }
        }
        if (PASS == 1 && hh == 1) {
#pragma unroll
            for (int st = 0; st < 2; ++st) { float* e = SEND + ((size_t)((b * 16 + g) * 16 + seg)) * 128; e[32 * st + lr] = cr[st]; e[64 + 32 * st + lr] = ci[st]; } }
    }
}

DI void phase_lru_prep(const Frame& F, CArgs& A, int l) {
    const bf16_t* Z = (const bf16_t*)(A.ws + WS_Z); float* LA = (float*)(A.ws + WS_LA); float* LB = (float*)(A.ws + WS_LB);
    const float* cw = A.in[34] + l * 4 * 256; const float* cb = A.in[35] + l * 256; const float* ba = A.in[37] + l * 256; const float* bx = A.in[39] + l * 256; const float* lam = A.in[40] + l * 256;
    const bf16_t* WL = (const bf16_t*)(A.ws + WS_WLRU) + (size_t)l * 2 * 4 * 4096;
    LAS float* xs = (LAS float*)F.lds;
    const int w = F.wave, n = w >> 1, hf = w & 1;
    bf16x8 waf[2][2], wxf[2][2];
    { const int fr = F.lane & 15, fq = F.lane >> 4;
#pragma unroll
      for (int nf = 0; nf < 2; ++nf)
#pragma unroll
          for (int ks = 0; ks < 2; ++ks) { const int j = 32 * hf + 16 * nf + fr;
              waf[nf][ks] = *(const bf16x8*)(WL + ((size_t)(0 * 4 + n) * 64 + j) * 64 + 32 * ks + 8 * fq); wxf[nf][ks] = *(const bf16x8*)(WL + ((size_t)(1 * 4 + n) * 64 + j) * 64 + 32 * ks + 8 * fq); } }
    f32x4 c_ba[2], c_bx[2], c_sp[2];
    { const int fq0 = F.lane >> 4;
#pragma unroll
      for (int nf = 0; nf < 2; ++nf) { const int ch4 = n * 64 + 32 * hf + 16 * nf + 4 * fq0; c_ba[nf] = *(const f32x4*)(ba + ch4); c_bx[nf] = *(const f32x4*)(bx + ch4); const f32x4 lm = *(const f32x4*)(lam + ch4);
#pragma unroll
          for (int i = 0; i < 4; ++i) c_sp[nf][i] = -8.f * softplusf_(-lm[i]); } }
    for (int tile = F.bid; tile < T / 64; tile += F.G) {
        int tz = F.tid; asm volatile("" : "+v"(tz)); const int lane = tz & 63, fr = lane & 15, fq = lane >> 4;
        const int t0 = tile * 64, s0 = t0 % SEQ;
        f32x4 accA[4][2], accX[4][2];
#pragma unroll
        for (int m = 0; m < 4; ++m) {
            const int tok = 16 * m + fr, sq = s0 + tok;
            bf16x8 xf[2];
#pragma unroll
            for (int ks = 0; ks < 2; ++ks) { const int ch0 = n * 64 + 32 * ks + 8 * fq;
                const f32x4 b0 = *(const f32x4*)(cb + ch0), b1 = *(const f32x4*)(cb + ch0 + 4);
                float xc[8] = {b0[0], b0[1], b0[2], b0[3], b1[0], b1[1], b1[2], b1[3]};
#pragma unroll
                for (int j = 0; j < 4; ++j) if (sq - 3 + j >= 0) {
                    const u32x4 z8 = *(const u32x4*)(Z + (size_t)(t0 + tok - 3 + j) * ZS + ZC_LX + ch0);
                    const f32x4 c0 = *(const f32x4*)(cw + j * 256 + ch0), c1 = *(const f32x4*)(cw + j * 256 + ch0 + 4);
                    xc[0] += c0[0] * bflo(z8.x); xc[1] += c0[1] * bfhi(z8.x); xc[2] += c0[2] * bflo(z8.y); xc[3] += c0[3] * bfhi(z8.y);
                    xc[4] += c1[0] * bflo(z8.z); xc[5] += c1[1] * bfhi(z8.z); xc[6] += c1[2] * bflo(z8.w); xc[7] += c1[3] * bfhi(z8.w); }
                u32x4 o; o.x = pk2(xc[0], xc[1]); o.y = pk2(xc[2], xc[3]); o.z = pk2(xc[4], xc[5]); o.w = pk2(xc[6], xc[7]); xf[ks] = __builtin_bit_cast(bf16x8, o);
                if (hf == 0) { *(LAS f32x4*)(xs + tok * 260 + ch0) = (f32x4){xc[0], xc[1], xc[2], xc[3]}; *(LAS f32x4*)(xs + tok * 260 + ch0 + 4) = (f32x4){xc[4], xc[5], xc[6], xc[7]}; }
            }
#pragma unroll
            for (int nf = 0; nf < 2; ++nf) { const f32x4 z4 = {0.f, 0.f, 0.f, 0.f};
                accA[m][nf] = __builtin_amdgcn_mfma_f32_16x16x32_bf16(waf[nf][0], xf[0], z4, 0, 0, 0); accA[m][nf] = __builtin_amdgcn_mfma_f32_16x16x32_bf16(waf[nf][1], xf[1], accA[m][nf], 0, 0, 0);
                accX[m][nf] = __builtin_amdgcn_mfma_f32_16x16x32_bf16(wxf[nf][0], xf[0], z4, 0, 0, 0); accX[m][nf] = __builtin_amdgcn_mfma_f32_16x16x32_bf16(wxf[nf][1], xf[1], accX[m][nf], 0, 0, 0); }
        }
        lds_barrier();
#pragma unroll
        for (int m = 0; m < 4; ++m)
#pragma unroll
            for (int nf = 0; nf < 2; ++nf) { const int tok = 16 * m + fr, ch4 = n * 64 + 32 * hf + 16 * nf + 4 * fq;
                const f32x4 xc = *(const LAS f32x4*)(xs + tok * 260 + ch4);
                f32x4 av, bv;
#pragma unroll
                for (int i = 0; i < 4; ++i) { const float r = sigmoidf_(accA[m][nf][i] + c_ba[nf][i]), ig = sigmoidf_(accX[m][nf][i] + c_bx[nf][i]); const float log_a = r * c_sp[nf][i];
                    const float x2 = 2.f * log_a; float em1 = __expf(x2) - 1.f; if (x2 > -0.25f) em1 = x2 * (1.f + x2 * (0.5f + x2 * (0.16666667f + x2 * (0.041666668f + x2 * 0.008333334f))));
                    av[i] = __expf(log_a); bv[i] = __builtin_amdgcn_sqrtf(-em1) * (ig * xc[i]); }
                *(f32x4*)(LA + (size_t)(t0 + tok) * 256 + ch4) = av; *(f32x4*)(LB + (size_t)(t0 + tok) * 256 + ch4) = bv; }
        lds_barrier();
    }
}
DI void phase_lru_sum(const Frame& F, CArgs& A) {
    const float* LA = (const float*)(A.ws + WS_LA); const float* LB = (const float*)(A.ws + WS_LB); float* LS = (float*)(A.ws + WS_LSUM);
    for (int it = F.gw; it < 8 * 128; it += F.ngw) {
        const size_t r0 = (size_t)it * 64;
        f32x4 Ap = {1.f, 1.f, 1.f, 1.f}, Bp = {0.f, 0.f, 0.f, 0.f};
#pragma unroll 8
        for (int t = 0; t < 64; ++t) { const f32x4 a = *(const f32x4*)(LA + (r0 + t) * 256 + 4 * F.lane), bb = *(const f32x4*)(LB + (r0 + t) * 256 + 4 * F.lane); Bp = a * Bp + bb; Ap = Ap * a; }
        *(f32x4*)(LS + ((size_t)it * 2) * 256 + 4 * F.lane) = Ap; *(f32x4*)(LS + ((size_t)it * 2 + 1) * 256 + 4 * F.lane) = Bp;
    }
}
DI void phase_lru_fin(const Frame& F, CArgs& A, int l) {
    const float* LA = (const float*)(A.ws + WS_LA); const float* LB = (const float*)(A.ws + WS_LB); const float* LS = (const float*)(A.ws + WS_LSUM);
    const bf16_t* Z = (const bf16_t*)(A.ws + WS_Z); bf16_t* MIX = (bf16_t*)(A.ws + WS_MIX);
    const f32x4 bg = *(const f32x4*)(A.in[41] + l * 768 + 512 + 4 * F.lane);
    for (int it = F.gw; it < 8 * 128; it += F.ngw) {
        const int b = it >> 7, c = it & 127;
        f32x4 h = {0.f, 0.f, 0.f, 0.f};
        for (int j0 = 0; j0 < c; j0 += 8) {
            f32x4 sa[8], sb[8];
#pragma unroll
            for (int q = 0; q < 8; ++q) { const int j = (j0 + q < c) ? j0 + q : c - 1; sa[q] = *(const f32x4*)(LS + ((size_t)(b * 128 + j) * 2) * 256 + 4 * F.lane); sb[q] = *(const f32x4*)(LS + ((size_t)(b * 128 + j) * 2 + 1) * 256 + 4 * F.lane); }
#pragma unroll
            for (int q = 0; q < 8; ++q) if (j0 + q < c) h = sa[q] * h + sb[q]; }
        const size_t r0 = (size_t)it * 64;
        for (int t0 = 0; t0 < 64; t0 += 8) {
            f32x4 y[8]; float ss[8];
#pragma unroll
            for (int q = 0; q < 8; ++q) { const size_t r = r0 + t0 + q;
                const f32x4 a = *(const f32x4*)(LA + r * 256 + 4 * F.lane), bb = *(const f32x4*)(LB + r * 256 + 4 * F.lane); h = a * h + bb;
                const u32x2 gz = *(const u32x2*)(Z + r * ZS + ZC_LG + 4 * F.lane);
                y[q] = (f32x4){h[0] * gelu_tanh(bflo(gz.x)), h[1] * gelu_tanh(bfhi(gz.x)), h[2] * gelu_tanh(bflo(gz.y)), h[3] * gelu_tanh(bfhi(gz.y))};
                ss[q] = y[q][0] * y[q][0] + y[q][1] * y[q][1] + y[q][2] * y[q][2] + y[q][3] * y[q][3]; }
            const int ln = lane_opaque();
#pragma unroll
            for (int o = 1; o < 64; o <<= 1) {
#pragma unroll
                for (int q = 0; q < 8; ++q) ss[q] += shfl_xor_l(ss[q], o, ln); }
#pragma unroll
            for (int q = 0; q < 8; ++q) { const float r = rsqrtf(ss[q] * (1.f / 256.f) + NORM_EPS);
                u32x2 o; o.x = pk2(y[q][0] * r * bg[0], y[q][1] * r * bg[1]); o.y = pk2(y[q][2] * r * bg[2], y[q][3] * r * bg[3]);
                *(u32x2*)(MIX + (r0 + t0 + q) * DM + 768 + 4 * F.lane) = o; }
        }
    }
}

DI void phase_branch_norm(const Frame& F, CArgs& A, int l) {
    const bf16_t* S0 = (const bf16_t*)(A.ws + WS_YS5G); const bf16_t* S1 = (const bf16_t*)(A.ws + WS_ATTO);
    bf16_t* MIX = (bf16_t*)(A.ws + WS_MIX); const float* bg = A.in[41] + l * 768;
    for (int row0 = 4 * F.gw; row0 < T; row0 += 4 * F.ngw) {
        u32x2 v[4][2];
#pragma unroll
        for (int r = 0; r < 4; ++r) { v[r][0] = *(const u32x2*)(S0 + (size_t)(row0 + r) * 256 + 4 * F.lane); v[r][1] = *(const u32x2*)(S1 + (size_t)(row0 + r) * 256 + 4 * F.lane); }
#pragma unroll
        for (int r = 0; r < 4; ++r)
#pragma unroll
            for (int br = 0; br < 2; ++br) {
                const float x0 = bflo(v[r][br].x), x1 = bfhi(v[r][br].x), x2 = bflo(v[r][br].y), x3 = bfhi(v[r][br].y);
                const float rs = rsqrtf(wave_sum(x0 * x0 + x1 * x1 + x2 * x2 + x3 * x3) * (1.f / 256.f) + NORM_EPS);
                const f32x4 g = *(const f32x4*)(bg + br * 256 + 4 * F.lane);
                u32x2 o; o.x = pk2(x0 * rs * g[0], x1 * rs * g[1]); o.y = pk2(x2 * rs * g[2], x3 * rs * g[3]);
                *(u32x2*)(MIX + (size_t)(row0 + r) * DM + 256 * (br + 1) + 4 * F.lane) = o; }
    }
}

DI void phase_norm2_router(const Frame& F, CArgs& A, int l) {
    const float* MODL = (const float*)(A.ws + WS_MOD) + (size_t)l * 8 * 6144;
    const float* g = A.in[43] + l * 1024;
    signed char* H8 = (signed char*)(A.ws + WS_H); float* H2S = (float*)(A.ws + WS_H2SC);
    int* EID = (int*)(A.ws + WS_RT_EID); float* GATE = (float*)(A.ws + WS_RT_GATE); int* PIE = (int*)(A.ws + WS_RT_PIE);
    unsigned* CNT = (unsigned*)(A.ws + WS_CTL) + CW_CNT + l * 64;
    const bf16_t* WRh = (const bf16_t*)(A.ws + WS_WR) + (size_t)(l * 2) * 48 * 1024; const bf16_t* WRl = WRh + 48 * 1024;
    const float* ROWSS = (const float*)(A.ws + WS_ROWSS);
    LAS float* part = (LAS float*)F.lds;
    LAS float* red = part + 8 * 64 * 48;
    LAS float* lsum = red + 8 * 64;
    LAS unsigned* lcnt = (LAS unsigned*)(lsum + 64 * 36);
    LAS int* lsel = (LAS int*)(lcnt + 64);
    const float* bgp = A.in[45] + l * 4; const float* bep = A.in[47] + l * 32;
    const int w = F.wave, k0 = 128 * w;
    for (int tile = F.bid; tile < T / 64; tile += F.G) {
        int tz = F.tid; asm volatile("" : "+v"(tz)); const int lane = tz & 63, fr = lane & 15, fq = lane >> 4;
        const int row0 = tile * 64, b = row0 / SEQ;
        const unsigned xi = (unsigned)(row0 + fr) * DM + k0 + 8 * fq;
        const float* xb = A.out;
        if (tz < 32) lcnt[tz] = 0u;
        { float m2 = fmaxf(fabsf(MODL[(unsigned)(b * 6144 + 3072 + tz)]), fabsf(MODL[(unsigned)(b * 6144 + 3072 + 512 + tz)])); m2 = wave_max(m2); if (lane == 0) red[w] = m2; }
        lds_barrier();
        float shmax = 0.f;
#pragma unroll
        for (int ww = 0; ww < 8; ++ww) shmax = fmaxf(shmax, red[ww]);
        f32x4 acc[4][3]; float rsv[4], inv8[4];
#pragma unroll
        for (int m = 0; m < 4; ++m) { const float* rp = ROWSS + (unsigned)((row0 + 16 * m + fr) * 32);
            const f32x4 p0 = *(const f32x4*)rp, p1 = *(const f32x4*)(rp + 4), p2 = *(const f32x4*)(rp + 8), p3 = *(const f32x4*)(rp + 12);
            const f32x4 q0 = *(const f32x4*)(rp + 16), q1 = *(const f32x4*)(rp + 20), q2 = *(const f32x4*)(rp + 24), q3 = *(const f32x4*)(rp + 28);
            const float tot = (((p0[0] + p0[1]) + (p0[2] + p0[3])) + ((p1[0] + p1[1]) + (p1[2] + p1[3]))) + (((p2[0] + p2[1]) + (p2[2] + p2[3])) + ((p3[0] + p3[1]) + (p3[2] + p3[3])));
            const float mg = fmaxf(fmaxf(fmaxf(fmaxf(q0[0], q0[1]), fmaxf(q0[2], q0[3])), fmaxf(fmaxf(q1[0], q1[1]), fmaxf(q1[2], q1[3]))), fmaxf(fmaxf(fmaxf(q2[0], q2[1]), fmaxf(q2[2], q2[3])), fmaxf(fmaxf(q3[0], q3[1]), fmaxf(q3[2], q3[3]))));
            rsv[m] = rsqrtf(tot * (1.f / DM) + NORM_EPS);
            const float bound = fmaxf(rsv[m] * mg + shmax, 1e-30f) * 1.0001f;
            inv8[m] = 127.f / bound; if (w == 0 && fq == 0) H2S[(unsigned)(row0 + 16 * m + fr)] = bound * (1.f / 127.f);
#pragma unroll
            for (int n = 0; n < 3; ++n) acc[m][n] = (f32x4){0.f, 0.f, 0.f, 0.f}; }
#pragma unroll
        for (int ks = 0; ks < 4; ++ks) { const int kc = k0 + 32 * ks + 8 * fq;
            const f32x4 g0 = *(const f32x4*)(g + kc), g1 = *(const f32x4*)(g + kc + 4);
            const f32x4 s0 = *(const f32x4*)(MODL + (unsigned)(b * 6144 + 4096 + kc)) + 1.f, s1 = *(const f32x4*)(MODL + (unsigned)(b * 6144 + 4096 + kc + 4)) + 1.f;
            const f32x4 h0 = *(const f32x4*)(MODL + (unsigned)(b * 6144 + 3072 + kc)), h1 = *(const f32x4*)(MODL + (unsigned)(b * 6144 + 3072 + kc + 4));
            bf16x8 blf[3], bhf[3];
#pragma unroll
            for (int n = 0; n < 3; ++n) { blf[n] = *(const bf16x8*)(WRl + (unsigned)((16 * n + fr) * 1024 + kc)); bhf[n] = *(const bf16x8*)(WRh + (unsigned)((16 * n + fr) * 1024 + kc)); }
#pragma unroll
            for (int m = 0; m < 4; ++m) {
                const f32x4 x0 = *(const f32x4*)(xb + (xi + (unsigned)(16 * m * DM + 32 * ks))), x1 = *(const f32x4*)(xb + (xi + (unsigned)(16 * m * DM + 32 * ks + 4)));
                const f32x4 v0 = x0 * rsv[m] * g0 * s0 + h0, v1 = x1 * rsv[m] * g1 * s1 + h1;
                u32x2 o; o.x = q8x4(v0, inv8[m]); o.y = q8x4(v1, inv8[m]); *(u32x2*)(H8 + (unsigned)((row0 + 16 * m + fr) * DM + kc)) = o;
                u32x4 hi; hi.x = pk2(v0[0], v0[1]); hi.y = pk2(v0[2], v0[3]); hi.z = pk2(v1[0], v1[1]); hi.w = pk2(v1[2], v1[3]);
                u32x4 lo; lo.x = pk2(v0[0] - bflo(hi.x), v0[1] - bfhi(hi.x)); lo.y = pk2(v0[2] - bflo(hi.y), v0[3] - bfhi(hi.y)); lo.z = pk2(v1[0] - bflo(hi.z), v1[1] - bfhi(hi.z)); lo.w = pk2(v1[2] - bflo(hi.w), v1[3] - bfhi(hi.w));
                const bf16x8 ah = __builtin_bit_cast(bf16x8, hi), al = __builtin_bit_cast(bf16x8, lo);
#pragma unroll
                for (int n = 0; n < 3; ++n) { acc[m][n] = __builtin_amdgcn_mfma_f32_16x16x32_bf16(ah, bhf[n], acc[m][n], 0, 0, 0);
                    acc[m][n] = __builtin_amdgcn_mfma_f32_16x16x32_bf16(al, bhf[n], acc[m][n], 0, 0, 0); acc[m][n] = __builtin_amdgcn_mfma_f32_16x16x32_bf16(ah, blf[n], acc[m][n], 0, 0, 0); }
            }
            __builtin_amdgcn_sched_barrier(0);
        }
#pragma unroll
        for (int m = 0; m < 4; ++m)
#pragma unroll
            for (int n = 0; n < 3; ++n)
#pragma unroll
                for (int j = 0; j < 4; ++j) part[(w * 64 + 16 * m + 4 * fq + j) * 48 + 16 * n + fr] = acc[m][n][j];
        lds_barrier();
        for (int i = tz; i < 64 * 36; i += NTHR) { const int tok = i / 36, n = i % 36; float a = 0.f;
#pragma unroll
            for (int ww = 0; ww < 8; ++ww) a += part[(ww * 64 + tok) * 48 + n];
            lsum[i] = a; }
        lds_barrier();
        float g0 = 0.f, g1 = 0.f; int e0 = 0, e1 = 0; unsigned r0 = 0, r1 = 0;
        if (tz < 64) {
            const LAS float* L = lsum + tz * 36;
            int gs = 0; float gm = L[0] + bgp[0];
#pragma unroll
            for (int i = 1; i < 4; ++i) { const float v = L[i] + bgp[i]; if (v > gm) { gm = v; gs = i; } }
            float gden = 0.f;
#pragma unroll
            for (int i = 0; i < 4; ++i) gden += expf(L[i] + bgp[i] - gm);
            const float gprob = 1.f / gden;
            int i1 = 0; float v1 = L[4 + gs * 8] + bep[gs * 8];
#pragma unroll
            for (int j = 1; j < 8; ++j) { const float v = L[4 + gs * 8 + j] + bep[gs * 8 + j]; if (v > v1) { v1 = v; i1 = j; } }
            int i2 = -1; float v2 = -INFINITY;
#pragma unroll
            for (int j = 0; j < 8; ++j) { const float v = L[4 + gs * 8 + j] + bep[gs * 8 + j]; if (j != i1 && v > v2) { v2 = v; i2 = j; } }
            const float p2 = expf(v2 - v1);
            g0 = gprob / (1.f + p2); g1 = gprob * p2 / (1.f + p2); e0 = gs * 8 + i1; e1 = gs * 8 + i2;
            r0 = __hip_atomic_fetch_add(lcnt + e0, 1u, __ATOMIC_RELAXED, __HIP_MEMORY_SCOPE_WORKGROUP); r1 = __hip_atomic_fetch_add(lcnt + e1, 1u, __ATOMIC_RELAXED, __HIP_MEMORY_SCOPE_WORKGROUP);
        }
        lds_barrier();
        if (tz < 32) { const unsigned c = lcnt[tz]; lcnt[32 + tz] = c ? atomicAdd(CNT + tz, c) : 0u; }
        lds_barrier();
        if (tz < 64) { const int row = row0 + tz;
            EID[2 * row] = e0; EID[2 * row + 1] = e1; GATE[2 * row] = g0; GATE[2 * row + 1] = g1; PIE[2 * row] = (int)(lcnt[32 + e0] + r0); PIE[2 * row + 1] = (int)(lcnt[32 + e1] + r1); }
        lds_barrier();
    }
}

DI void phase_moe_convert(const Frame& F, CArgs& A, int l, int gw0, int ngw0) {
    LAS float* scr = (LAS float*)(F.lds + F.wave * 16640);
    bf16_t* WM2 = (bf16_t*)(A.ws + WS_WM2);
    for (int it = gw0; it < 32 * 384; it += ngw0) {
        const int e = it / 384; int r = it % 384;
        if (r < 256) { const int which = r >> 7; r &= 127; const int kb = r >> 3, nb = r & 7, n0 = 64 * nb;
            const float* src = (which ? A.in[49] : A.in[48]) + ((size_t)l * 32 + e) * 1024 * 512;
            const int np0 = 256 * (n0 >> 7) + (n0 & 127) + 128 * which;
            quant_item64(src, 512, 64 * kb, n0, (signed char*)(A.ws + WS_WM1) + (size_t)e * 1024 * 1024, 1024, np0, 64 * kb, (const unsigned*)(A.ws + WS_CTL) + CW_COLMAX + ((size_t)l * 32 + e) * 1024 + np0,
                         kb == 0 ? (float*)(A.ws + WS_WM1SC) + (size_t)e * 1024 + np0 : (float*)nullptr, scr, F.lane);
        } else { r -= 256; const int kb = r >> 4, nb = r & 15;
            transpose_item64(A.in[50] + ((size_t)l * 32 + e) * 512 * 1024, 1024, 64 * kb, 64 * nb, WM2 + (size_t)e * 1024 * 512, 512, 64 * nb, 64 * kb, scr, F.lane); }
    }
}

DI void phase_moe_scatter(const Frame& F, CArgs& A, int l) {
    const unsigned* CNT = (const unsigned*)(A.ws + WS_CTL) + CW_CNT + l * 64;
    unsigned* META = (unsigned*)(A.ws + WS_CTL) + CW_UTAB + l * 1024;
    const int* EID = (const int*)(A.ws + WS_RT_EID); const int* PIE = (const int*)(A.ws + WS_RT_PIE); int* SORT = (int*)(A.ws + WS_RT_SORT);
    LAS unsigned* st = (LAS unsigned*)F.lds;
    if (F.tid == 0) { unsigned s = 0; for (int e = 0; e < 32; ++e) { st[e] = s; s += CNT[e]; } }
    __syncthreads();
    if (F.bid == 0 && F.tid == 0) { unsigned nu = 0;
        for (int e = 0; e < 32; ++e) { const unsigned c = CNT[e]; META[1 + e] = st[e]; META[33 + e] = c; for (unsigned bk = 0; bk * 256 < c; ++bk) META[65 + nu++] = ((unsigned)e << 16) | bk; }
        META[0] = nu; }
    for (int a = F.bid * NTHR + F.tid; a < 2 * T; a += F.G * NTHR) SORT[st[EID[a]] + PIE[a]] = a;
}

struct MoeProb1 {
    static constexpr bool GATHER_PF = true;
    const char* Hh; const char* WM1; const unsigned* META; const int* SORT; int lda, ldb, nt, G, c;
    DI bool next(int i, pg8::Unit& u) const { const int nu = (int)META[0]; int pm, pn;
        if ((G & 31) == 0) { const int jj = c >> 3; pn = jj & 3; pm = i * (G >> 2) + (c & 7) * (G >> 5) + (jj >> 2); } else { const int idx = i * G + c; pm = idx >> 2; pn = idx & 3; }
        if (pm >= nu) return false;
        const unsigned ent = META[65 + pm]; u.pm = pm; u.pn = pn; u.e = (int)(ent >> 16); u.blk = (int)(ent & 0xffffu); return true; }
    DI const char* a_base(const pg8::Unit&) const { return Hh; }
    DI const char* b_base(const pg8::Unit& u) const { return WM1 + ((size_t)u.e * 1024 + (size_t)u.pn * 256) * 1024; }
    DI unsigned a_off(const pg8::Unit& u, int row) const { const unsigned r = (unsigned)(u.blk * 256 + row), cnt = META[33 + u.e];
        const int a = r < cnt ? SORT[META[1 + u.e] + r] : 0; return (unsigned)(a >> 1) * 1024u; }
    DI int a_idx(const pg8::Unit& u, int row) const { const unsigned r = (unsigned)(u.blk * 256 + row), cnt = META[33 + u.e]; return SORT[META[1 + u.e] + (r < cnt ? r : cnt - 1u)]; }
    DI unsigned a_off_idx(int a) const { return (unsigned)(a >> 1) * 1024u; }
};
struct EpiMoe1 {
    static constexpr bool PERM = true;
    bf16_t* HID; const unsigned* META; const int* SORT; const float* H2S; const float* WSC;
    DI void operator()(const i32x4 (&acc)[2][2][4][2], const pg8::Unit& u, int wr, int wc, int fr, int fq) const {
        const unsigned cnt = META[33 + u.e], st = META[1 + u.e];
        const int col0 = 128 * u.pn + wc * 32 + 8 * fq;
        const float* wsp = WSC + (size_t)u.e * 1024 + 256 * u.pn + wc * 32 + 8 * fq;
        const f32x4 s10 = *(const f32x4*)wsp, s11 = *(const f32x4*)(wsp + 4), s30 = *(const f32x4*)(wsp + 128), s31 = *(const f32x4*)(wsp + 132);
#pragma unroll
        for (int ai = 0; ai < 2; ++ai)
#pragma unroll
            for (int m = 0; m < 4; ++m) { const unsigned r = (unsigned)(u.blk * 256 + ai * 128 + wr * 64 + m * 16 + fr);
                if (r < cnt) { const float sa = H2S[SORT[st + r] >> 1];
                    const i32x4 a0 = acc[ai][0][m][0], a1 = acc[ai][0][m][1], b0 = acc[ai][1][m][0], b1 = acc[ai][1][m][1];
                    float h[8];
#pragma unroll
                    for (int i = 0; i < 4; ++i) { h[i] = siluf_((float)a0[i] * sa * s10[i]) * ((float)b0[i] * sa * s30[i]); h[4 + i] = siluf_((float)a1[i] * sa * s11[i]) * ((float)b1[i] * sa * s31[i]); }
                    u32x4 w; w.x = pk2(h[0], h[1]); w.y = pk2(h[2], h[3]); w.z = pk2(h[4], h[5]); w.w = pk2(h[6], h[7]);
                    *(u32x4*)(HID + (size_t)(st + r) * 512 + col0) = w; } }
    }
};
struct MoeProb2 {
    static constexpr bool GATHER_PF = false;
    const char* HID; const char* WM2; const unsigned* META; int lda, ldb, nt, G, c;
    DI bool next(int i, pg8::Unit& u) const { const int nu = (int)META[0]; int pm, pn;
        if ((G & 31) == 0) { const int jj = c >> 3; pn = jj & 3; pm = i * (G >> 2) + (c & 7) * (G >> 5) + (jj >> 2); } else { const int idx = i * G + c; pm = idx >> 2; pn = idx & 3; }
        if (pm >= nu) return false;
        const unsigned ent = META[65 + pm]; u.pm = pm; u.pn = pn; u.e = (int)(ent >> 16); u.blk = (int)(ent & 0xffffu); return true; }
    DI const char* a_base(const pg8::Unit& u) const { return HID + ((size_t)META[1 + u.e] + (size_t)u.blk * 256) * 512 * 2; }
    DI const char* b_base(const pg8::Unit& u) const { return WM2 + ((size_t)u.e * 1024 + (size_t)u.pn * 256) * 512 * 2; }
    DI unsigned a_off(const pg8::Unit&, int row) const { return (unsigned)row * 1024u; }
};
struct EpiMoe2 {
    static constexpr bool PERM = true;
    bf16_t* Y; const unsigned* META; const int* SORT; const float* GATE; const float* gt;
    DI void operator()(const f32x4 (&acc)[2][2][4][2], const pg8::Unit& u, int wr, int wc, int fr, int fq) const {
        const unsigned cnt = META[33 + u.e], st = META[1 + u.e];
        const int col0 = 256 * u.pn + wc * 32 + 8 * fq;
        int av[2][4]; float gw[2][4];
#pragma unroll
        for (int ai = 0; ai < 2; ++ai)
#pragma unroll
            for (int m = 0; m < 4; ++m) { const unsigned r = (unsigned)(u.blk * 256 + ai * 128 + wr * 64 + m * 16 + fr); av[ai][m] = r < cnt ? SORT[st + r] : -1; }
#pragma unroll
        for (int ai = 0; ai < 2; ++ai)
#pragma unroll
            for (int m = 0; m < 4; ++m) gw[ai][m] = av[ai][m] >= 0 ? GATE[av[ai][m]] : 0.f;
#pragma unroll
        for (int ai = 0; ai < 2; ++ai)
#pragma unroll
            for (int m = 0; m < 4; ++m) { const int a = av[ai][m];
                if (a >= 0) { const int b = (a >> 1) / SEQ; const float g = gw[ai][m];
#pragma unroll
                    for (int bj = 0; bj < 2; ++bj) { const f32x4 g0 = *(const f32x4*)(gt + (size_t)b * 6144 + col0 + bj * 128), g1 = *(const f32x4*)(gt + (size_t)b * 6144 + col0 + bj * 128 + 4);
                        const f32x4 v0 = acc[ai][bj][m][0] * g0 * g, v1 = acc[ai][bj][m][1] * g1 * g;
                        u32x4 w; w.x = pk2(v0[0], v0[1]); w.y = pk2(v0[2], v0[3]); w.z = pk2(v1[0], v1[1]); w.w = pk2(v1[2], v1[3]);
                        *(u32x4*)(Y + (size_t)a * DM + col0 + bj * 128) = w; } } }
    }
};

DI void phase_final(const Frame& F, CArgs& A) {
    const bf16_t* Y = (const bf16_t*)(A.ws + WS_Y);
    const size_t N4 = (size_t)T * DM / 4, stride = (size_t)F.G * NTHR;
    for (size_t i0 = (size_t)F.bid * NTHR + F.tid; i0 < N4; i0 += 4 * stride) {
        f32x4 v[4]; u32x2 y0[4], y1[4];
#pragma unroll
        for (int k = 0; k < 4; ++k) { const size_t i = i0 + k * stride; if (i < N4) { const size_t row = i >> 8, col = (i & 255) * 4;
            v[k] = *(const f32x4*)(A.out + row * DM + col); y0[k] = *(const u32x2*)(Y + (2 * row) * DM + col); y1[k] = *(const u32x2*)(Y + (2 * row + 1) * DM + col); } }
#pragma unroll
        for (int k = 0; k < 4; ++k) { const size_t i = i0 + k * stride; if (i < N4) { const size_t row = i >> 8, col = (i & 255) * 4;
            v[k][0] += bflo(y0[k].x) + bflo(y1[k].x); v[k][1] += bfhi(y0[k].x) + bfhi(y1[k].x); v[k][2] += bflo(y0[k].y) + bflo(y1[k].y); v[k][3] += bfhi(y0[k].y) + bfhi(y1[k].y);
            *(f32x4*)(A.out + row * DM + col) = v[k]; } }
    }
}

#ifndef REPMASK
#define REPMASK 0u
#endif
constexpr int NPL = 14, NPH = 1 + 2 * NPL + 1;
__global__ void __launch_bounds__(NTHR, 2) mk_fwd(Args args) {
    extern __shared__ __attribute__((aligned(16))) unsigned char lds_raw[];
    LAS unsigned char* const ldsb = (LAS unsigned char*)lds_raw;
    const int wave0 = __builtin_amdgcn_readfirstlane(threadIdx.x >> 6);
    volatile LAS unsigned* MISC = (volatile LAS unsigned*)(ldsb + MISC_OFF);
    if (threadIdx.x < 64) MISC[threadIdx.x] = 0u;
    __syncthreads();
    XcdBarrier bar; bar.bar = (unsigned*)(args.ws + WS_CTL) + CW_BAR; bar.x = 0; bar.st = nullptr;
    if (args.use_bar) bar = xcd_barrier_post((unsigned*)(args.ws + WS_CTL) + CW_BAR, MISC + 8);
    const int lo = args.ph_lo, hi = args.ph_hi;
#define IN(k) (lo <= (k) && (k) < hi)
#define SEAM(k) do { if (IN(k) && IN((k) + 1)) xcd_barrier(bar); } while (0)
    unsigned char* ws = args.ws;
    if (IN(0)) { const Frame F = make_frame(ldsb, wave0); CArgs& AA = *get_args(); phase_prologue(F, AA); } SEAM(0);
    for (int l = 0; l < DEPTH; ++l) {
        const int pb = 1 + l * NPL;
        const float* MODL = (const float*)(ws + WS_MOD) + (size_t)l * 8 * 6144;
        if (IN(pb + 0)) { { const Frame F = make_frame(ldsb, wave0); CArgs& AA = *get_args(); phase_norm1(F, AA, l); } if (l == 0) { const Frame F = make_frame(ldsb, wave0); CArgs& AA = *get_args(); phase_win_quant(F, AA); } } SEAM(pb + 0);
        if (IN(pb + 1)) { const Frame F = make_frame(ldsb, wave0); CArgs& AA = *get_args(); pg8::PlainProb P{(const char*)(ws + WS_H), (const char*)(ws + WS_WIN) + (size_t)l * ZS * 1024, 512, 512, 8, 256, 9, F.G, F.bid};
            EpiBf16I8 E{(bf16_t*)(ws + WS_Z), ZS, (const float*)(ws + WS_HSC), (const float*)(ws + WS_WINSC) + l * ZS}; pg8::gemm_phase<true, true>(F.lds, P, E, F.tid); } SEAM(pb + 1);
        if (IN(pb + 2)) { { const Frame F = make_frame(ldsb, wave0); CArgs& AA = *get_args(); phase_mla_prep(F, AA, l); } { const Frame F = make_frame(ldsb, wave0); CArgs& AA = *get_args(); phase_s5<1>(F, AA, l); } { const Frame F = make_frame(ldsb, wave0); CArgs& AA = *get_args(); phase_lru_prep(F, AA, l); } } SEAM(pb + 2);
        if (IN(pb + 3)) { { const Frame F = make_frame(ldsb, wave0); CArgs& AA = *get_args(); pg8::PlainProb P{(const char*)(ws + WS_AMLA), (const char*)(ws + WS_WMLA) + (size_t)l * 1024 * 512 * 2, 512, 512, 8, 256, 4, F.G, F.bid};
            EpiBf16Plain E{(bf16_t*)(ws + WS_QKVRAW), 1024}; pg8::gemm_phase(F.lds, P, E, F.tid); } { const Frame F = make_frame(ldsb, wave0); CArgs& AA = *get_args(); phase_lru_sum(F, AA); } } SEAM(pb + 3);
        if (IN(pb + 4)) { { const Frame F = make_frame(ldsb, wave0); CArgs& AA = *get_args(); phase_mla_post(F, AA, l); } { const Frame F = make_frame(ldsb, wave0); CArgs& AA = *get_args(); phase_lru_fin(F, AA, l); } } SEAM(pb + 4);
        if (IN(pb + 5)) { { const Frame F = make_frame(ldsb, wave0); CArgs& AA = *get_args(); phase_attn(F, AA, l); } lds_barrier(); { const Frame F = make_frame(ldsb, wave0); CArgs& AA = *get_args(); phase_s5<2>(F, AA, l); } } SEAM(pb + 5);
        if (IN(pb + 6)) { { const Frame F = make_frame(ldsb, wave0); CArgs& AA = *get_args(); phase_rwkv_A(F, AA, l); } lds_barrier(); { const Frame F = make_frame(ldsb, wave0); CArgs& AA = *get_args(); pg8::PlainProb P{(const char*)(ws + WS_YS5), (const char*)(ws + WS_WGLU) + (size_t)l * 256 * 256 * 2, 256, 256, 4, 256, 1, F.G, F.bid};
            EpiGlu E{(const bf16_t*)(ws + WS_YS5), (bf16_t*)(ws + WS_YS5G), AA.in[27] + l * 256}; pg8::gemm_phase(F.lds, P, E, F.tid); } } SEAM(pb + 6);
        if (IN(pb + 7)) { const Frame F = make_frame(ldsb, wave0); CArgs& AA = *get_args(); if (F.bid < 32) phase_rwkv_B(F, AA); else phase_moe_convert(F, AA, l, (F.bid - 32) * NWAVES + F.wave, (F.G - 32) * NWAVES); } SEAM(pb + 7);
        if (IN(pb + 8)) { { const Frame F = make_frame(ldsb, wave0); CArgs& AA = *get_args(); phase_rwkv_C(F, AA, l); } { const Frame F = make_frame(ldsb, wave0); CArgs& AA = *get_args(); phase_branch_norm(F, AA, l); } } SEAM(pb + 8);
        if (IN(pb + 9)) { const Frame F = make_frame(ldsb, wave0); CArgs& AA = *get_args(); pg8::PlainProb P{(const char*)(ws + WS_MIX), (const char*)(ws + WS_WOUT) + (size_t)l * 1024 * 1024 * 2, 1024, 1024, 16, 256, 4, F.G, F.bid};
            EpiResGate E{l == 0 ? AA.in[0] : AA.out, AA.out, MODL + 2048, (float*)(ws + WS_ROWSS), AA.in[43] + l * 1024}; pg8::gemm_phase(F.lds, P, E, F.tid); } SEAM(pb + 9);
        if (IN(pb + 10)) { const Frame F = make_frame(ldsb, wave0); CArgs& AA = *get_args(); phase_norm2_router(F, AA, l); } SEAM(pb + 10);
        if (IN(pb + 11)) { const Frame F = make_frame(ldsb, wave0); CArgs& AA = *get_args(); phase_moe_scatter(F, AA, l); } SEAM(pb + 11);
        const unsigned* META = (const unsigned*)(ws + WS_CTL) + CW_UTAB + l * 1024;
        if (IN(pb + 12)) { const Frame F = make_frame(ldsb, wave0); CArgs& AA = *get_args(); MoeProb1 P{(const char*)(ws + WS_H), (const char*)(ws + WS_WM1), META, (const int*)(ws + WS_RT_SORT), 512, 512, 8, F.G, F.bid};
            EpiMoe1 E{(bf16_t*)(ws + WS_HID), META, (const int*)(ws + WS_RT_SORT), (const float*)(ws + WS_H2SC), (const float*)(ws + WS_WM1SC)}; pg8::gemm_phase<true, true>(F.lds, P, E, F.tid); } SEAM(pb + 12);
        if (IN(pb + 13)) { const Frame F = make_frame(ldsb, wave0); CArgs& AA = *get_args(); MoeProb2 P{(const char*)(ws + WS_HID), (const char*)(ws + WS_WM2), META, 512, 512, 8, F.G, F.bid};
            EpiMoe2 E{(bf16_t*)(ws + WS_Y), META, (const int*)(ws + WS_RT_SORT), (const float*)(ws + WS_RT_GATE), MODL + 5120}; pg8::gemm_phase(F.lds, P, E, F.tid); } SEAM(pb + 13);
    }
    if (IN(NPH - 1)) { const Frame F = make_frame(ldsb, wave0); CArgs& AA = *get_args(); phase_final(F, AA); }
#undef IN
#undef SEAM
}

extern "C" void kernel_launch(void* const* d_in, const int* in_sizes, int n_in, void* d_out, int out_size, void* d_ws, size_t ws_size, hipStream_t stream) {
    static int grid = 0;
    if (grid == 0) {
        if (n_in != 51 || ws_size < WS_END) { fprintf(stderr, "kernel_launch: unexpected inputs (n_in %d, ws %zu)\n", n_in, ws_size); grid = -1; return; }
        int dev = 0, cus = 0;
        if (hipGetDevice(&dev) != hipSuccess || hipDeviceGetAttribute(&cus, hipDeviceAttributeMultiprocessorCount, dev) != hipSuccess) { grid = -1; return; }
        if (hipFuncSetAttribute((const void*)mk_fwd, hipFuncAttributeMaxDynamicSharedMemorySize, LDS_BYTES) != hipSuccess) { fprintf(stderr, "kernel_launch: hipFuncSetAttribute failed\n"); grid = -1; return; }
        grid = cus;
    }
    if (grid < 0) return;
    (void)hipMemsetAsync((char*)d_ws + WS_CTL, 0, CTL_ZERO_BYTES, stream);
    Args a{};
    for (int i = 0; i < 51; ++i) a.in[i] = (const float*)d_in[i];
    a.pos_off = (const int*)d_in[2]; a.out = (float*)d_out; a.ws = (unsigned char*)d_ws; a.pad = 0;
#if defined(MK_PER_PHASE)
    a.use_bar = 0;
    for (int p = 0; p < NPH; ++p) { a.ph_lo = p; a.ph_hi = p + 1;
        const int k = (p == 0) ? 30 : (p == NPH - 1) ? 31 : (p - 1) % NPL; const int reps = 1 + (int)((REPMASK >> k) & 1u);
        for (int r = 0; r < reps; ++r) hipLaunchKernelGGL(mk_fwd, dim3(grid), dim3(NTHR), LDS_BYTES, stream, a); }
#else
    a.use_bar = 1; a.ph_lo = 0; a.ph_hi = NPH;
    hipLaunchKernelGGL(mk_fwd, dim3(grid), dim3(NTHR), LDS_BYTES, stream, a);
#endif
}
```
